# Optimizing an MI355X kernel written in HIP

```python
import jax, jax.numpy as jnp
from jax import lax
import numpy as np

D_MODEL = 1024
BATCH = 8
SEQ = 2048
DEPTH = 2

GRID_W = 64
CTX_LEN = 256
EPS = 1e-6
F32 = jnp.float32

A_HEADS = 4
A_HEAD_DIM = 64
A_WIDTH = A_HEADS * A_HEAD_DIM
A_CHUNK = 128

B_HEADS = 8
B_NOPE = 64
B_ROPE = 32
B_QK = B_NOPE + B_ROPE
B_V = 64
B_WIDTH = B_HEADS * B_V
B_Q_RANK = 256
B_KV_RANK = 128
B_QBLOCK = 128
ROPE_THETA = 10000.0

C_HEADS = 4
C_DK = 64
C_DV = 64
C_KWIDTH = C_HEADS * C_DK
C_WIDTH = C_HEADS * C_DV
C_CHUNK = 64

D_MIX = A_WIDTH + B_WIDTH + C_WIDTH
IN_SPLITS = (A_WIDTH, A_WIDTH, B_Q_RANK, B_KV_RANK, B_ROPE, C_KWIDTH, C_KWIDTH, C_KWIDTH, C_WIDTH, C_WIDTH)
D_IN = sum(IN_SPLITS)
SPLIT_IDX = tuple(sum(IN_SPLITS[:i + 1]) for i in range(len(IN_SPLITS) - 1))

P_HEADS = 8
P_KEY_DIM = 256
P_N_KEYS = 128
P_N_EXPERTS = P_N_KEYS * P_N_KEYS
P_TOPK = 16
P_TOKEN_BLOCK = 128

kernel_name = 'hybrid_dit_gmlp_mla_hgrn2_peer'


def rmsnorm(x, w):
    xf = x.astype(F32)
    y = xf * lax.rsqrt(jnp.mean(xf * xf, axis=-1, keepdims=True) + EPS)
    return (y * w.astype(F32)).astype(x.dtype)


def modulate(x, shift, scale):
    return x * (1 + scale) + shift


def axial_rope_angles(rows):
    n_freq = B_ROPE // 4
    row = jnp.repeat(jnp.arange(rows, dtype=F32), GRID_W)
    col = jnp.tile(jnp.arange(GRID_W, dtype=F32), rows)
    inv_freq = ROPE_THETA ** (-jnp.arange(n_freq, dtype=F32) / n_freq)
    ang = jnp.stack([row[:, None] * inv_freq, col[:, None] * inv_freq], axis=1)
    return jnp.cos(ang), jnp.sin(ang)


def apply_rope(x, cos, sin):
    shp = x.shape
    xr = x.astype(F32).reshape(shp[:-1] + (2, 2, B_ROPE // 4))
    x1, x2 = xr[..., 0, :], xr[..., 1, :]
    c, s = cos[:, None], sin[:, None]
    out = jnp.stack([x1 * c - x2 * s, x2 * c + x1 * s], axis=-2)
    return out.reshape(shp).astype(x.dtype)


def chunk_gating_mlp(u, v, norm_w, w_s, b_s):
    bsz, n, _ = v.shape
    vn = rmsnorm(v.reshape(bsz, n, A_HEADS, A_HEAD_DIM), norm_w.reshape(A_HEADS, A_HEAD_DIM))
    vn = vn.reshape(bsz, n // A_CHUNK, A_CHUNK, A_HEADS, A_HEAD_DIM)
    mixed = jnp.einsum('hpq,bnqhc->bnphc', w_s, vn) + b_s.T[:, :, None]
    return u * mixed.reshape(bsz, n, A_WIDTH)


def mla_project(c_q, c_kv, k_rope, q_norm_w, w_uq, kv_norm_w, w_ukv, qn_w, kn_w, rope):
    bsz, n, _ = c_q.shape
    q = (rmsnorm(c_q, q_norm_w) @ w_uq).reshape(bsz, n, B_HEADS, B_QK)
    kv = (rmsnorm(c_kv, kv_norm_w) @ w_ukv).reshape(bsz, n, B_HEADS, B_NOPE + B_V)
    k_nope, v = kv[..., :B_NOPE], kv[..., B_NOPE:]
    k = jnp.concatenate([k_nope, jnp.broadcast_to(k_rope[:, :, None, :], (bsz, n, B_HEADS, B_ROPE))], axis=-1)
    q, k = rmsnorm(q, qn_w), rmsnorm(k, kn_w)
    if rope is not None:
        cos, sin = rope
        q = jnp.concatenate([q[..., :B_NOPE], apply_rope(q[..., B_NOPE:], cos, sin)], axis=-1)
        k = jnp.concatenate([k[..., :B_NOPE], apply_rope(k[..., B_NOPE:], cos, sin)], axis=-1)
    return q, k, v


def attend(q, k, v):
    s = jnp.einsum('bhqd,bhkd->bhqk', q.astype(F32), k.astype(F32)) * (B_QK ** -0.5)
    p = jax.nn.softmax(s, axis=-1)
    return jnp.einsum('bhqk,bhkd->bhqd', p, v.astype(F32)).astype(v.dtype)


def mla_latent(q, k, v, k_ctx, v_ctx):
    bsz, n, _, _ = q.shape
    kt = jnp.concatenate([k_ctx, k], axis=1).transpose(0, 2, 1, 3)
    vt = jnp.concatenate([v_ctx, v], axis=1).transpose(0, 2, 1, 3)
    nb = n // B_QBLOCK
    qb = q.reshape(bsz, nb, B_QBLOCK, B_HEADS, B_QK).transpose(1, 0, 3, 2, 4)
    ob = lax.map(lambda qi: attend(qi, kt, vt), qb)
    return ob.transpose(1, 0, 3, 2, 4).reshape(bsz, n, B_WIDTH)


def mla_context(q, k, v):
    bsz, n, _, _ = q.shape
    o = attend(q.transpose(0, 2, 1, 3), k.transpose(0, 2, 1, 3), v.transpose(0, 2, 1, 3))
    return o.transpose(0, 2, 1, 3).reshape(bsz, n, B_WIDTH)


def to_heads(t):
    bsz, n, _ = t.shape
    return t.reshape(bsz, n, C_HEADS, -1).transpose(0, 2, 1, 3)


def hgrn2_gates(z, lb):
    z = z.astype(F32)
    lb = lb.astype(F32)
    logf = jnp.logaddexp(jnp.log(lb), jnp.log1p(-lb) + jax.nn.log_sigmoid(z))
    k = (1.0 - lb) * jax.nn.sigmoid(-z)
    return to_heads(logf), to_heads(k)


def gla_scan(q, k, v, logf, s0):
    bsz, h, n, _ = q.shape
    nc = n // C_CHUNK

    def to_chunks(t):
        return jnp.moveaxis(t.reshape(bsz, h, nc, C_CHUNK, t.shape[-1]), 2, 0)

    incl = jnp.tril(jnp.ones((C_CHUNK, C_CHUNK), dtype=bool))

    def step(state, inp):
        qc, kc, vc, lf = inp
        b = jnp.cumsum(lf, axis=2)
        o_inter = jnp.einsum('bhtk,bhkv->bhtv', qc * jnp.exp(b), state)
        diff = jnp.where(incl[:, :, None], b[:, :, :, None, :] - b[:, :, None, :, :], -jnp.inf)
        att = jnp.einsum('bhtk,bhsk,bhtsk->bhts', qc, kc, jnp.exp(diff))
        o = o_inter + jnp.einsum('bhts,bhsv->bhtv', att, vc)
        b_last = b[:, :, -1:, :]
        state = jnp.exp(b_last[:, :, 0, :, None]) * state + jnp.einsum('bhsk,bhsv->bhkv', kc * jnp.exp(b_last - b), vc)
        return state, o

    s_final, o = lax.scan(step, s0, (to_chunks(q), to_chunks(k), to_chunks(v), to_chunks(logf)))
    return jnp.moveaxis(o, 0, 2).reshape(bsz, h, n, v.shape[-1]), s_final


def hgrn2_scan(cq, zf, zb, ci, lb_f, lb_b, s0_f, s0_b):
    dt = cq.dtype
    q = to_heads(cq.astype(F32)) * (C_DK ** -0.5)
    v = to_heads(ci.astype(F32))
    logf_f, k_f = hgrn2_gates(zf, lb_f)
    logf_b, k_b = hgrn2_gates(zb, lb_b)
    flip = lambda t: jnp.flip(t, axis=2)
    o_f, s_f = gla_scan(q, k_f, v, logf_f, s0_f)
    o_b, s_b = gla_scan(flip(q), flip(k_b), flip(v), flip(logf_b), s0_b)
    return (o_f + flip(o_b)).astype(dt), s_f, s_b


def hgrn2_readout(o, g, norm_w):
    bsz, _, n, _ = o.shape
    o = o.transpose(0, 2, 1, 3)
    g = g.reshape(bsz, n, C_HEADS, C_DV)
    return (rmsnorm(o, norm_w) * jax.nn.silu(g)).reshape(bsz, n, C_WIDTH)


def peer_route(h, w_q, sub_keys):
    t = h.shape[0]
    q = (h @ w_q).reshape(t, P_HEADS, 2, P_KEY_DIM // 2).astype(F32)
    s = jnp.einsum('thpd,hpnd->thpn', q, sub_keys.astype(F32))
    sv, si = lax.top_k(s, P_TOPK)
    cand = sv[:, :, 0, :, None] + sv[:, :, 1, None, :]
    best, ci = lax.top_k(cand.reshape(t, P_HEADS, P_TOPK * P_TOPK), P_TOPK)
    i1 = jnp.take_along_axis(si[:, :, 0], ci // P_TOPK, axis=-1)
    i2 = jnp.take_along_axis(si[:, :, 1], ci % P_TOPK, axis=-1)
    experts = (i1 * P_N_KEYS + i2).reshape(t, P_HEADS * P_TOPK)
    gates = jax.nn.softmax(best, axis=-1).reshape(t, P_HEADS * P_TOPK)
    return experts, gates


def peer(h, w_q, sub_keys, u_tab, v_tab):
    bsz, n, d = h.shape
    t = bsz * n
    hf = h.reshape(t, d)
    experts, gates = peer_route(hf, w_q, sub_keys)
    nb = t // P_TOKEN_BLOCK

    def block(args):
        hb, eb, gb = args
        a = jnp.einsum('td,tkd->tk', hb, u_tab[eb])
        w = gb.astype(hb.dtype) * jax.nn.gelu(a, approximate=False)
        return jnp.einsum('tk,tkd->td', w, v_tab[eb])

    y = lax.map(block, (hf.reshape(nb, P_TOKEN_BLOCK, d),
                        experts.reshape(nb, P_TOKEN_BLOCK, P_HEADS * P_TOPK),
                        gates.reshape(nb, P_TOKEN_BLOCK, P_HEADS * P_TOPK)))
    return y.reshape(bsz, n, d)


def setup_inputs(seed: int = 0) -> dict:
    key = jax.random.key(seed)
    ks = jax.random.split(key, 26)

    def nrm(k, shape, scale=1.0):
        return jax.random.normal(k, shape, dtype=F32) * scale

    def gain(k, shape):
        return 1.0 + 0.02 * jax.random.normal(k, shape, dtype=F32)

    return {
        'x': nrm(ks[0], (BATCH, SEQ, D_MODEL)),
        'c': nrm(ks[1], (BATCH, D_MODEL)),
        'ctx': nrm(ks[2], (BATCH, CTX_LEN, D_MODEL)),
        'c_ctx': nrm(ks[3], (D_MODEL,)),
        'ln1_w': gain(ks[4], (DEPTH, D_MODEL)),
        'ln2_w': gain(ks[5], (DEPTH, D_MODEL)),
        'w_mod': nrm(ks[6], (DEPTH, D_MODEL, 6 * D_MODEL), 0.5 * D_MODEL ** -0.5),
        'b_mod': nrm(ks[7], (DEPTH, 6 * D_MODEL), 0.02),
        'w_in': nrm(ks[8], (DEPTH, D_MODEL, D_IN), D_MODEL ** -0.5),
        'w_out': nrm(ks[9], (DEPTH, D_MIX, D_MODEL), D_MIX ** -0.5),
        'a_norm_w': gain(ks[10], (DEPTH, A_WIDTH)),
        'a_w_s': nrm(ks[11], (DEPTH, A_HEADS, A_CHUNK, A_CHUNK), A_CHUNK ** -0.5),
        'a_b_s': gain(ks[12], (DEPTH, A_HEADS, A_CHUNK)),
        'b_q_norm_w': gain(ks[13], (DEPTH, B_Q_RANK)),
        'b_w_uq': nrm(ks[14], (DEPTH, B_Q_RANK, B_HEADS * B_QK), B_Q_RANK ** -0.5),
        'b_kv_norm_w': gain(ks[15], (DEPTH, B_KV_RANK)),
        'b_w_ukv': nrm(ks[16], (DEPTH, B_KV_RANK, B_HEADS * (B_NOPE + B_V)), B_KV_RANK ** -0.5),
        'b_q_head_norm_w': gain(ks[17], (DEPTH, B_QK)),
        'b_k_head_norm_w': gain(ks[18], (DEPTH, B_QK)),
        'c_lb_logits': nrm(ks[19], (DEPTH, 2, C_KWIDTH)),
        'c_out_norm_w': gain(ks[20], (DEPTH, C_DV)),
        'p_w_q': nrm(ks[21], (DEPTH, D_MODEL, P_HEADS * P_KEY_DIM), D_MODEL ** -0.5),
        'p_sub_keys': nrm(ks[22], (DEPTH, P_HEADS, 2, P_N_KEYS, P_KEY_DIM // 2), (P_KEY_DIM // 2) ** -0.5),
        'p_u': nrm(ks[23], (DEPTH, P_N_EXPERTS, D_MODEL), D_MODEL ** -0.5),
        'p_v': nrm(ks[24], (DEPTH, P_N_EXPERTS, D_MODEL), 1.0),
    }


def reference(x, c, ctx, c_ctx, ln1_w, ln2_w, w_mod, b_mod, w_in, w_out,
              a_norm_w, a_w_s, a_b_s,
              b_q_norm_w, b_w_uq, b_kv_norm_w, b_w_ukv, b_q_head_norm_w, b_k_head_norm_w,
              c_lb_logits, c_out_norm_w,
              p_w_q, p_sub_keys, p_u, p_v):
    bsz, n_lat, _ = x.shape
    rows = n_lat // GRID_W
    rope = axial_rope_angles(rows)
    lb = jnp.cumsum(jax.nn.softmax(c_lb_logits.astype(F32), axis=0), axis=0)
    lb = lb - lb[0:1]
    silu_c = jax.nn.silu(c)
    silu_cc = jax.nn.silu(c_ctx)

    for layer in range(DEPTH):
        last = layer == DEPTH - 1
        mod = jnp.split((silu_c @ w_mod[layer] + b_mod[layer])[:, None, :], 6, axis=-1)
        mod_c = jnp.split((silu_cc @ w_mod[layer] + b_mod[layer])[None, None, :], 6, axis=-1)

        h = modulate(rmsnorm(x, ln1_w[layer]), mod[0], mod[1])
        hc = modulate(rmsnorm(ctx, ln1_w[layer]), mod_c[0], mod_c[1])
        au, av, bq, bkv, bkr, cq, cff, cfb, ci, cg = jnp.split(h @ w_in[layer], SPLIT_IDX, axis=-1)
        au_c, av_c, bq_c, bkv_c, bkr_c, cq_c, cff_c, cfb_c, ci_c, cg_c = jnp.split(hc @ w_in[layer], SPLIT_IDX, axis=-1)

        a_out = chunk_gating_mlp(au, av, a_norm_w[layer], a_w_s[layer], a_b_s[layer])

        mla_w = (b_q_norm_w[layer], b_w_uq[layer], b_kv_norm_w[layer], b_w_ukv[layer],
                 b_q_head_norm_w[layer], b_k_head_norm_w[layer])
        q_l, k_l, v_l = mla_project(bq, bkv, bkr, *mla_w, rope=rope)
        q_c, k_c, v_c = mla_project(bq_c, bkv_c, bkr_c, *mla_w, rope=None)
        b_out = mla_latent(q_l, k_l, v_l, k_c, v_c)

        zeros = jnp.zeros((bsz, C_HEADS, C_DK, C_DV), F32)
        o_c, s_f, s_b = hgrn2_scan(cq_c, cff_c, cfb_c, ci_c, lb[layer, 0], lb[layer, 1], zeros, zeros)
        o_l, _, _ = hgrn2_scan(cq, cff, cfb, ci, lb[layer, 0], lb[layer, 1], s_f, s_b)
        c_out = hgrn2_readout(o_l, cg, c_out_norm_w[layer])

        x = x + mod[2] * (jnp.concatenate([a_out, b_out, c_out], axis=-1) @ w_out[layer])
        if not last:
            a_out_c = chunk_gating_mlp(au_c, av_c, a_norm_w[layer], a_w_s[layer], a_b_s[layer])
            b_out_c = mla_context(q_c, k_c, v_c)
            c_out_c = hgrn2_readout(o_c, cg_c, c_out_norm_w[layer])
            ctx = ctx + mod_c[2] * (jnp.concatenate([a_out_c, b_out_c, c_out_c], axis=-1) @ w_out[layer])

        x = x + mod[5] * peer(modulate(rmsnorm(x, ln2_w[layer]), mod[3], mod[4]),
                              p_w_q[layer], p_sub_keys[layer], p_u[layer], p_v[layer])
        if not last:
            ctx = ctx + mod_c[5] * peer(modulate(rmsnorm(ctx, ln2_w[layer]), mod_c[3], mod_c[4]),
                                        p_w_q[layer], p_sub_keys[layer], p_u[layer], p_v[layer])
    return x
```

```cpp
#include <hip/hip_runtime.h>
#include <hip/hip_cooperative_groups.h>
#include <cstdio>
#include <cstdint>
namespace cg = cooperative_groups;

#define DEVI __device__ __forceinline__

typedef unsigned short bf16;
using bf16x8 = __attribute__((ext_vector_type(8))) __bf16;
using bf16x2 = __attribute__((ext_vector_type(2))) __bf16;
using f32x16 = __attribute__((ext_vector_type(16))) float;

constexpr int NL = 16384;
constexpr int NT = 18432;
constexpr int DM = 1024;
constexpr int DIN = 2208;
constexpr int DINP = 2304;
constexpr int SEQP = 2304;
constexpr float EPS = 1e-6f;
constexpr int ZC_AU = 0, ZC_AV = 256, ZC_BQ = 512, ZC_BKV = 768, ZC_BKR = 896, ZC_CQ = 928, ZC_CFF = 1184, ZC_CFB = 1440, ZC_CI = 1696, ZC_CG = 1952;
constexpr int SMEM_BYTES = 80896;

struct Params {
  const float *x, *c, *ctx, *c_ctx, *ln1_w, *ln2_w, *w_mod, *b_mod, *w_in, *w_out, *a_norm_w, *a_w_s, *a_b_s;
  const float *b_q_norm_w, *b_w_uq, *b_kv_norm_w, *b_w_ukv, *b_qh_w, *b_kh_w, *c_lb, *c_out_norm_w, *p_w_q, *p_sub_keys, *p_u, *p_v;
  float* out;
  float* MOD;
  float* ROPE;
  bf16* WinT;
  bf16* WoutT;
  bf16* WpqT;
  bf16* WuqT;
  bf16* WukvT;
  bf16* SK;
  bf16* AWS;
  bf16* PU;
  bf16* PV;
  float* X;
  bf16* H;
  bf16* Z;
  bf16* Q;
  bf16* K;
  bf16* VT;
  float* ST;
  float* DEC;
  float* OI;
  int* EIDX;
  float* GATE;
  int phase_lo, phase_hi, coop, pad0;
};

DEVI float bf2f(bf16 v) { return __uint_as_float(((unsigned)v) << 16); }
DEVI bf16 f2bf(float a) { __bf16 v = (__bf16)a; return __builtin_bit_cast(unsigned short, v); }
DEVI unsigned pack2(float a, float b) { bf16x2 v; v[0] = (__bf16)a; v[1] = (__bf16)b; return __builtin_bit_cast(unsigned, v); }
DEVI float lo2f(unsigned u) { return __uint_as_float(u << 16); }
DEVI float hi2f(unsigned u) { return __uint_as_float(u & 0xffff0000u); }
DEVI f32x16 zero16() { f32x16 z;
#pragma unroll
  for (int i = 0; i < 16; ++i) z[i] = 0.f; return z; }
DEVI f32x16 mfma32(bf16x8 a, bf16x8 b, f32x16 c) { return __builtin_amdgcn_mfma_f32_32x32x16_bf16(a, b, c, 0, 0, 0); }
DEVI bf16x8 ldfrag(const bf16* p) { return *reinterpret_cast<const bf16x8*>(p); }
DEVI int drow(int r, int hh) { return (r & 3) + 8 * (r >> 2) + 4 * hh; }
DEVI int row_of(int b, int p) { return p < 256 ? NL + b * 256 + p : b * 2048 + (p - 256); }
DEVI int batch_of_row(int r) { return r < NL ? (r >> 11) : 8; }
DEVI float wave_sum(float v) {
#pragma unroll
  for (int o = 32; o > 0; o >>= 1) v += __shfl_xor(v, o);
  return v;
}
DEVI float sigmoidf_(float z) { return 1.f / (1.f + __expf(-z)); }

DEVI void phase_mod(const Params& P, unsigned char* smem) {
  const int tid = threadIdx.x;
  float* s = (float*)smem;
  float* red = s + 9 * 1024;
  for (int item = blockIdx.x; item < 192; item += gridDim.x) {
    const int l = item / 96, j = item % 96;
    __syncthreads();
    for (int i = tid; i < 9 * 1024; i += 256) {
      int bi = i >> 10, k = i & 1023;
      float v = bi < 8 ? P.c[bi * 1024 + k] : P.c_ctx[k];
      s[i] = v * sigmoidf_(v);
    }
    __syncthreads();
    const int c4 = tid & 15, kg = tid >> 4;
    float acc[9][4];
#pragma unroll
    for (int bi = 0; bi < 9; ++bi) { acc[bi][0] = acc[bi][1] = acc[bi][2] = acc[bi][3] = 0.f; }
    const float* w = P.w_mod + (size_t)l * 1024 * 6144 + j * 64 + c4 * 4;
#pragma unroll 4
    for (int kk = 0; kk < 64; ++kk) {
      const int k = kg * 64 + kk;
      const float4 w4 = *reinterpret_cast<const float4*>(w + (size_t)k * 6144);
#pragma unroll
      for (int bi = 0; bi < 9; ++bi) {
        const float sv = s[bi * 1024 + k];
        acc[bi][0] += sv * w4.x; acc[bi][1] += sv * w4.y; acc[bi][2] += sv * w4.z; acc[bi][3] += sv * w4.w;
      }
    }
#pragma unroll
    for (int bi = 0; bi < 9; ++bi)
#pragma unroll
      for (int e = 0; e < 4; ++e) red[(kg * 9 + bi) * 64 + c4 * 4 + e] = acc[bi][e];
    __syncthreads();
    for (int o = tid; o < 576; o += 256) {
      const int bi = o >> 6, cc = o & 63;
      float sum = 0.f;
#pragma unroll
      for (int g = 0; g < 16; ++g) sum += red[(g * 9 + bi) * 64 + cc];
      P.MOD[(size_t)(l * 9 + bi) * 6144 + j * 64 + cc] = sum + P.b_mod[l * 6144 + j * 64 + cc];
    }
  }
}

DEVI void conv_T_tile(const float* __restrict__ src, int N, bf16* __restrict__ dst, int Kd, int k0, int n0,
                      const float* __restrict__ kscale, float* tile) {
  const int tid = threadIdx.x;
  __syncthreads();
  for (int e = tid; e < 4096; e += 256) {
    const int i = e >> 6, j = e & 63, n = n0 + j;
    float v = (n < N) ? src[(size_t)(k0 + i) * N + n] : 0.f;
    if (kscale) v *= kscale[k0 + i];
    tile[i * 65 + j] = v;
  }
  __syncthreads();
  for (int e = tid; e < 2048; e += 256) {
    const int j = e >> 5, i2 = (e & 31) * 2;
    const unsigned pk = pack2(tile[i2 * 65 + j], tile[(i2 + 1) * 65 + j]);
    *reinterpret_cast<unsigned*>(&dst[(size_t)(n0 + j) * Kd + k0 + i2]) = pk;
  }
}

DEVI void conv_straight(const float* __restrict__ src, bf16* __restrict__ dst, size_t n8) {
  const size_t stride = (size_t)gridDim.x * 256;
  for (size_t i = (size_t)blockIdx.x * 256 + threadIdx.x; i < n8; i += stride) {
    const float4 a = reinterpret_cast<const float4*>(src)[2 * i];
    const float4 b = reinterpret_cast<const float4*>(src)[2 * i + 1];
    uint4 o; o.x = pack2(a.x, a.y); o.y = pack2(a.z, a.w); o.z = pack2(b.x, b.y); o.w = pack2(b.z, b.w);
    reinterpret_cast<uint4*>(dst)[i] = o;
  }
}

DEVI void phase_prologue(const Params& P, unsigned char* smem) {
  phase_mod(P, smem);
  float* tile = (float*)smem;
  for (int it = blockIdx.x; it < 2 * 1424; it += gridDim.x) {
    const int l = it / 1424; int r = it % 1424;
    if (r < 576) { conv_T_tile(P.w_in + (size_t)l * 1024 * DIN, DIN, P.WinT + (size_t)l * DINP * 1024, 1024, (r % 16) * 64, (r / 16) * 64, nullptr, tile); continue; }
    r -= 576;
    if (r < 256) { conv_T_tile(P.w_out + (size_t)l * 1024 * 1024, 1024, P.WoutT + (size_t)l * 1024 * 1024, 1024, (r % 16) * 64, (r / 16) * 64, nullptr, tile); continue; }
    r -= 256;
    if (r < 512) { conv_T_tile(P.p_w_q + (size_t)l * 1024 * 2048, 2048, P.WpqT + (size_t)l * 2048 * 1024, 1024, (r % 16) * 64, (r / 16) * 64, nullptr, tile); continue; }
    r -= 512;
    if (r < 48) { conv_T_tile(P.b_w_uq + (size_t)l * 256 * 768, 768, P.WuqT + (size_t)l * 768 * 256, 256, (r % 4) * 64, (r / 4) * 64, P.b_q_norm_w + l * 256, tile); continue; }
    r -= 48;
    conv_T_tile(P.b_w_ukv + (size_t)l * 128 * 1024, 1024, P.WukvT + (size_t)l * 1024 * 128, 128, (r % 2) * 64, (r / 2) * 64, P.b_kv_norm_w + l * 128, tile);
  }
  conv_straight(P.p_sub_keys, P.SK, (size_t)2 * 16 * 128 * 128 / 8);
  conv_straight(P.a_w_s, P.AWS, (size_t)2 * 4 * 128 * 128 / 8);
  conv_straight(P.p_u, P.PU, (size_t)2 * 16384 * 1024 / 8);
  conv_straight(P.p_v, P.PV, (size_t)2 * 16384 * 1024 / 8);
  for (int i = blockIdx.x * 256 + threadIdx.x; i < 2048 * 16; i += gridDim.x * 256) {
    const int t = i >> 4, a = (i >> 3) & 1, f = i & 7;
    const float inv = powf(10000.f, -(float)f / 8.f);
    const float pos = a ? (float)(t & 63) : (float)(t >> 6);
    const float ang = pos * inv;
    P.ROPE[t * 32 + a * 8 + f] = cosf(ang);
    P.ROPE[t * 32 + 16 + a * 8 + f] = sinf(ang);
  }
}

DEVI void phase_norm(const Params& P, int l, int which, int nrows) {
  const int lane = threadIdx.x & 63;
  const int gw = blockIdx.x * 4 + (threadIdx.x >> 6), nw = gridDim.x * 4;
  const float* lnw = (which == 0 ? P.ln1_w : P.ln2_w) + l * 1024;
  for (int r = gw; r < nrows; r += nw) {
    const float* src;
    if (which == 0 && l == 0) src = r < NL ? P.x + (size_t)r * 1024 : P.ctx + (size_t)(r - NL) * 1024;
    else src = P.X + (size_t)r * 1024;
    const float* mod = P.MOD + (size_t)(l * 9 + batch_of_row(r)) * 6144 + which * 3072;
    float4 v[4];
    float ss = 0.f;
#pragma unroll
    for (int i = 0; i < 4; ++i) {
      v[i] = *reinterpret_cast<const float4*>(src + i * 256 + lane * 4);
      ss += v[i].x * v[i].x + v[i].y * v[i].y + v[i].z * v[i].z + v[i].w * v[i].w;
    }
    ss = wave_sum(ss);
    const float rr = rsqrtf(ss * (1.f / 1024.f) + EPS);
#pragma unroll
    for (int i = 0; i < 4; ++i) {
      const int d = i * 256 + lane * 4;
      const float4 w = *reinterpret_cast<const float4*>(lnw + d);
      const float4 sh = *reinterpret_cast<const float4*>(mod + d);
      const float4 sc = *reinterpret_cast<const float4*>(mod + 1024 + d);
      const float o0 = v[i].x * rr * w.x * (1.f + sc.x) + sh.x;
      const float o1 = v[i].y * rr * w.y * (1.f + sc.y) + sh.y;
      const float o2 = v[i].z * rr * w.z * (1.f + sc.z) + sh.z;
      const float o3 = v[i].w * rr * w.w * (1.f + sc.w) + sh.w;
      uint2 o; o.x = pack2(o0, o1); o.y = pack2(o2, o3);
      *reinterpret_cast<uint2*>(P.H + (size_t)r * 1024 + d) = o;
    }
  }
}

template <int BM, int BN, int BK, int WM, int WN>
struct Gemm {
  static constexpr int LDK = BK + 8;
  static constexpr int TM = BM / WM / 32, TN = BN / WN / 32;
  static constexpr int CPR = BK / 8;
  static constexpr int NA = BM * CPR / 256, NB = BN * CPR / 256;
  static constexpr int A_BYTES = BM * LDK * 2, B_BYTES = BN * LDK * 2;
  static constexpr int STAGE_BYTES = A_BYTES + B_BYTES;
  static constexpr int SMEM = 2 * STAGE_BYTES;

  static DEVI void run(const bf16* __restrict__ A, int lda, const bf16* __restrict__ BT, int ldb, int K,
                       unsigned char* smem, f32x16 (&acc)[TM][TN]) {
    const int tid = threadIdx.x, lane = tid & 63, wave = tid >> 6;
    const int wm = wave / WN, wn = wave % WN;
    const int l31 = lane & 31, hh = lane >> 5;
#pragma unroll
    for (int i = 0; i < TM; ++i)
#pragma unroll
      for (int j = 0; j < TN; ++j) acc[i][j] = zero16();
    uint4 ra[NA], rb[NB];
    const int nk = K / BK;
    auto gload = [&](int kt) {
#pragma unroll
      for (int i = 0; i < NA; ++i) { const int ch = tid + i * 256, row = ch / CPR, cc = ch % CPR;
        ra[i] = *reinterpret_cast<const uint4*>(A + (size_t)row * lda + kt * BK + cc * 8); }
#pragma unroll
      for (int i = 0; i < NB; ++i) { const int ch = tid + i * 256, row = ch / CPR, cc = ch % CPR;
        rb[i] = *reinterpret_cast<const uint4*>(BT + (size_t)row * ldb + kt * BK + cc * 8); }
    };
    auto swrite = [&](int buf) {
      bf16* sA = reinterpret_cast<bf16*>(smem + buf * STAGE_BYTES);
      bf16* sB = reinterpret_cast<bf16*>(smem + buf * STAGE_BYTES + A_BYTES);
#pragma unroll
      for (int i = 0; i < NA; ++i) { const int ch = tid + i * 256, row = ch / CPR, cc = ch % CPR;
        *reinterpret_cast<uint4*>(sA + row * LDK + cc * 8) = ra[i]; }
#pragma unroll
      for (int i = 0; i < NB; ++i) { const int ch = tid + i * 256, row = ch / CPR, cc = ch % CPR;
        *reinterpret_cast<uint4*>(sB + row * LDK + cc * 8) = rb[i]; }
    };
    __syncthreads();
    gload(0);
    swrite(0);
    __syncthreads();
    for (int kt = 0; kt < nk; ++kt) {
      const int cur = kt & 1;
      if (kt + 1 < nk) gload(kt + 1);
      const bf16* sA = reinterpret_cast<const bf16*>(smem + cur * STAGE_BYTES);
      const bf16* sB = reinterpret_cast<const bf16*>(smem + cur * STAGE_BYTES + A_BYTES);
#pragma unroll
      for (int ks = 0; ks < BK / 16; ++ks) {
        bf16x8 af[TM], bfr[TN];
#pragma unroll
        for (int i = 0; i < TM; ++i) af[i] = ldfrag(sA + (wm * (BM / WM) + i * 32 + l31) * LDK + ks * 16 + hh * 8);
#pragma unroll
        for (int j = 0; j < TN; ++j) bfr[j] = ldfrag(sB + (wn * (BN / WN) + j * 32 + l31) * LDK + ks * 16 + hh * 8);
#pragma unroll
        for (int i = 0; i < TM; ++i)
#pragma unroll
          for (int j = 0; j < TN; ++j) acc[i][j] = mfma32(af[i], bfr[j], acc[i][j]);
      }
      if (kt + 1 < nk) swrite(cur ^ 1);
      __syncthreads();
    }
  }
};

DEVI void phase_gemm1(const Params& P, int l, unsigned char* smem) {
  using G = Gemm<128, 128, 64, 2, 2>;
  const int lane = threadIdx.x & 63, wave = threadIdx.x >> 6, wm = wave >> 1, wn = wave & 1, l31 = lane & 31, hh = lane >> 5;
  const bf16* W = P.WinT + (size_t)l * DINP * 1024;
  for (int t = blockIdx.x; t < 144 * 18; t += gridDim.x) {
    const int mt = t / 18, nt = t % 18;
    f32x16 acc[2][2];
    G::run(P.H + (size_t)mt * 128 * 1024, 1024, W + (size_t)nt * 128 * 1024, 1024, 1024, smem, acc);
#pragma unroll
    for (int i = 0; i < 2; ++i)
#pragma unroll
      for (int j = 0; j < 2; ++j) {
        const int col = nt * 128 + wn * 64 + j * 32 + l31;
        if (col < DIN) {
#pragma unroll
          for (int r = 0; r < 16; ++r) {
            const int row = mt * 128 + wm * 64 + i * 32 + drow(r, hh);
            P.Z[(size_t)row * DIN + col] = f2bf(acc[i][j][r]);
          }
        }
      }
  }
}

DEVI void phase_gemm2(const Params& P, int l, unsigned char* smem) {
  using G = Gemm<128, 128, 64, 2, 2>;
  const int lane = threadIdx.x & 63, wave = threadIdx.x >> 6, wm = wave >> 1, wn = wave & 1, l31 = lane & 31, hh = lane >> 5;
  const bf16* W = P.WoutT + (size_t)l * 1024 * 1024;
  const int mtiles = (l == 1) ? 128 : 144;
  for (int t = blockIdx.x; t < mtiles * 8; t += gridDim.x) {
    const int mt = t / 8, nt = t % 8;
    f32x16 acc[2][2];
    G::run(P.H + (size_t)mt * 128 * 1024, 1024, W + (size_t)nt * 128 * 1024, 1024, 1024, smem, acc);
    const int bi = batch_of_row(mt * 128);
    const float* gate = P.MOD + (size_t)(l * 9 + bi) * 6144 + 2048;
#pragma unroll
    for (int i = 0; i < 2; ++i)
#pragma unroll
      for (int j = 0; j < 2; ++j) {
        const int col = nt * 128 + wn * 64 + j * 32 + l31;
        const float g = gate[col];
#pragma unroll
        for (int r = 0; r < 16; ++r) {
          const int row = mt * 128 + wm * 64 + i * 32 + drow(r, hh);
          float res;
          if (l == 0) res = row < NL ? P.x[(size_t)row * 1024 + col] : P.ctx[(size_t)(row - NL) * 1024 + col];
          else res = P.X[(size_t)row * 1024 + col];
          P.X[(size_t)row * 1024 + col] = res + g * acc[i][j][r];
        }
      }
  }
}

DEVI void phase_mixA(const Params& P, int l, unsigned char* smem) {
  const int tid = threadIdx.x, lane = tid & 63, wave = tid >> 6, l31 = lane & 31, hh = lane >> 5;
  bf16* VNT = reinterpret_cast<bf16*>(smem);
  constexpr int LDV = 136;
  const int nseg = (l == 1) ? 16 : 18;
  const int seg0 = (l == 1) ? 2 : 0;
  for (int it = blockIdx.x; it < 8 * nseg * 4; it += gridDim.x) {
    const int a = it & 3; const int sj = (it >> 2) % nseg + seg0; const int b = (it >> 2) / nseg;
    const int p0 = sj * 128;
    __syncthreads();
    {
      const int q = tid >> 1, half = tid & 1;
      const int row = row_of(b, p0 + q);
      const bf16* src = P.Z + (size_t)row * DIN + ZC_AV + a * 64 + half * 32;
      float v[32];
      float ss = 0.f;
#pragma unroll
      for (int i = 0; i < 4; ++i) {
        const uint4 u = *reinterpret_cast<const uint4*>(src + i * 8);
        v[i * 8 + 0] = lo2f(u.x); v[i * 8 + 1] = hi2f(u.x); v[i * 8 + 2] = lo2f(u.y); v[i * 8 + 3] = hi2f(u.y);
        v[i * 8 + 4] = lo2f(u.z); v[i * 8 + 5] = hi2f(u.z); v[i * 8 + 6] = lo2f(u.w); v[i * 8 + 7] = hi2f(u.w);
      }
#pragma unroll
      for (int i = 0; i < 32; ++i) ss += v[i] * v[i];
      ss += __shfl_xor(ss, 1);
      const float rr = rsqrtf(ss * (1.f / 64.f) + EPS);
      const float* nw = P.a_norm_w + l * 256 + a * 64 + half * 32;
#pragma unroll
      for (int i = 0; i < 32; ++i) VNT[(half * 32 + i) * LDV + q] = f2bf(v[i] * rr * nw[i]);
    }
    __syncthreads();
    f32x16 acc[2]; acc[0] = zero16(); acc[1] = zero16();
    const bf16* Aw = P.AWS + (size_t)(l * 4 + a) * 128 * 128 + (size_t)(wave * 32 + l31) * 128;
#pragma unroll
    for (int ks = 0; ks < 8; ++ks) {
      const bf16x8 af = ldfrag(Aw + ks * 16 + hh * 8);
#pragma unroll
      for (int j = 0; j < 2; ++j) {
        const bf16x8 bfr = ldfrag(VNT + (j * 32 + l31) * LDV + ks * 16 + hh * 8);
        acc[j] = mfma32(af, bfr, acc[j]);
      }
    }
    const float* bs = P.a_b_s + (l * 4 + a) * 128;
#pragma unroll
    for (int j = 0; j < 2; ++j)
#pragma unroll
      for (int r = 0; r < 16; ++r) {
        const int p = wave * 32 + drow(r, hh);
        const int row = row_of(b, p0 + p);
        const int col = a * 64 + j * 32 + l31;
        const float u = bf2f(P.Z[(size_t)row * DIN + ZC_AU + col]);
        P.H[(size_t)row * 1024 + col] = f2bf(u * (acc[j][r] + bs[p]));
      }
  }
}

DEVI void mla_norm_rope_store(const Params& P, const float* T, const float* nw, bool rope, float oscale,
                              bf16* dstbase  , int pos0, int tlat0) {
  const int tid = threadIdx.x, tok = tid >> 1, half = tid & 1;
  float v[48];
  float ss = 0.f;
#pragma unroll
  for (int i = 0; i < 48; ++i) { v[i] = T[tok * 97 + half * 48 + i]; ss += v[i] * v[i]; }
  ss += __shfl_xor(ss, 1);
  const float rr = rsqrtf(ss * (1.f / 96.f) + EPS);
#pragma unroll
  for (int i = 0; i < 48; ++i) v[i] = v[i] * rr * nw[half * 48 + i];
  if (rope && half == 1) {
    const float* cs = P.ROPE + (size_t)(tlat0 + tok) * 32;
#pragma unroll
    for (int a = 0; a < 2; ++a)
#pragma unroll
      for (int f = 0; f < 8; ++f) {
        const float x1 = v[16 + a * 16 + f], x2 = v[16 + a * 16 + 8 + f];
        const float c = cs[a * 8 + f], s = cs[16 + a * 8 + f];
        v[16 + a * 16 + f] = x1 * c - x2 * s;
        v[16 + a * 16 + 8 + f] = x2 * c + x1 * s;
      }
  }
  bf16* dst = dstbase + (size_t)(pos0 + tok) * 96 + half * 48;
#pragma unroll
  for (int i = 0; i < 6; ++i) {
    uint4 o;
    o.x = pack2(v[i * 8 + 0] * oscale, v[i * 8 + 1] * oscale); o.y = pack2(v[i * 8 + 2] * oscale, v[i * 8 + 3] * oscale);
    o.z = pack2(v[i * 8 + 4] * oscale, v[i * 8 + 5] * oscale); o.w = pack2(v[i * 8 + 6] * oscale, v[i * 8 + 7] * oscale);
    *reinterpret_cast<uint4*>(dst + i * 8) = o;
  }
}

DEVI void phase_mla_proj(const Params& P, int l, unsigned char* smem) {
  const int tid = threadIdx.x, lane = tid & 63, wave = tid >> 6, l31 = lane & 31, hh = lane >> 5;
  float* T = reinterpret_cast<float*>(smem);
  float* rsq = T + 128 * 97;
  float* rskv = rsq + 128;
  const float qscale = 0.10206207261596577f * 1.4426950408889634f;
  for (int it = blockIdx.x; it < 144; it += gridDim.x) {
    const int m0 = it * 128;
    const bool lat = m0 < NL;
    const int b = lat ? (m0 >> 11) : ((m0 - NL) >> 8);
    const int pos0 = lat ? 256 + (m0 & 2047) : ((m0 - NL) & 255);
    const int tlat0 = lat ? (m0 & 2047) : 0;
    const bool doq = lat || (l == 0);
    const bf16* zrow = P.Z + (size_t)(m0 + wave * 32 + l31) * DIN;
    __syncthreads();
    {
      float ss = 0.f;
#pragma unroll
      for (int ks = 0; ks < 8; ++ks) {
        const bf16x8 a = ldfrag(zrow + ZC_BKV + ks * 16 + hh * 8);
#pragma unroll
        for (int j = 0; j < 8; ++j) { const float f = (float)a[j]; ss += f * f; }
      }
      ss += __shfl_xor(ss, 32);
      if (hh == 0) rskv[wave * 32 + l31] = rsqrtf(ss * (1.f / 128.f) + EPS);
    }
    for (int e = tid; e < 128 * 32; e += 256) {
      const int tok = e >> 5, i = e & 31;
      T[tok * 97 + 64 + i] = bf2f(P.Z[(size_t)(m0 + tok) * DIN + ZC_BKR + i]);
    }
    __syncthreads();
    const bf16* Wkv = P.WukvT + (size_t)l * 1024 * 128;
    for (int h = 0; h < 8; ++h) {
      f32x16 acc[4];
#pragma unroll
      for (int j = 0; j < 4; ++j) acc[j] = zero16();
#pragma unroll 2
      for (int ks = 0; ks < 8; ++ks) {
        const bf16x8 af = ldfrag(zrow + ZC_BKV + ks * 16 + hh * 8);
#pragma unroll
        for (int j = 0; j < 4; ++j) {
          const bf16x8 bfr = ldfrag(Wkv + (size_t)(h * 128 + j * 32 + l31) * 128 + ks * 16 + hh * 8);
          acc[j] = mfma32(af, bfr, acc[j]);
        }
      }
#pragma unroll
      for (int j = 0; j < 2; ++j)
#pragma unroll
        for (int r = 0; r < 16; ++r) {
          const int tok = wave * 32 + drow(r, hh);
          T[tok * 97 + j * 32 + l31] = acc[j][r] * rskv[tok];
        }
#pragma unroll
      for (int j = 2; j < 4; ++j) {
        const int d = (j - 2) * 32 + l31;
        bf16* dst = P.VT + ((size_t)(b * 8 + h) * 64 + d) * SEQP + pos0 + wave * 32;
#pragma unroll
        for (int rg = 0; rg < 4; ++rg) {
          const int tk = 8 * rg + 4 * hh;
          uint2 o;
          o.x = pack2(acc[j][4 * rg + 0] * rskv[wave * 32 + tk + 0], acc[j][4 * rg + 1] * rskv[wave * 32 + tk + 1]);
          o.y = pack2(acc[j][4 * rg + 2] * rskv[wave * 32 + tk + 2], acc[j][4 * rg + 3] * rskv[wave * 32 + tk + 3]);
          *reinterpret_cast<uint2*>(dst + tk) = o;
        }
      }
      __syncthreads();
      mla_norm_rope_store(P, T, P.b_kh_w + l * 96, lat, 1.f, P.K + (size_t)(b * 8 + h) * SEQP * 96, pos0, tlat0);
      __syncthreads();
    }
    if (doq) {
      {
        float ss = 0.f;
#pragma unroll
        for (int ks = 0; ks < 16; ++ks) {
          const bf16x8 a = ldfrag(zrow + ZC_BQ + ks * 16 + hh * 8);
#pragma unroll
          for (int j = 0; j < 8; ++j) { const float f = (float)a[j]; ss += f * f; }
        }
        ss += __shfl_xor(ss, 32);
        if (hh == 0) rsq[wave * 32 + l31] = rsqrtf(ss * (1.f / 256.f) + EPS);
      }
      __syncthreads();
      const bf16* Wq = P.WuqT + (size_t)l * 768 * 256;
      for (int h = 0; h < 8; ++h) {
        f32x16 acc[3];
#pragma unroll
        for (int j = 0; j < 3; ++j) acc[j] = zero16();
#pragma unroll 2
        for (int ks = 0; ks < 16; ++ks) {
          const bf16x8 af = ldfrag(zrow + ZC_BQ + ks * 16 + hh * 8);
#pragma unroll
          for (int j = 0; j < 3; ++j) {
            const bf16x8 bfr = ldfrag(Wq + (size_t)(h * 96 + j * 32 + l31) * 256 + ks * 16 + hh * 8);
            acc[j] = mfma32(af, bfr, acc[j]);
          }
        }
#pragma unroll
        for (int j = 0; j < 3; ++j)
#pragma unroll
          for (int r = 0; r < 16; ++r) {
            const int tok = wave * 32 + drow(r, hh);
            T[tok * 97 + j * 32 + l31] = acc[j][r] * rsq[tok];
          }
        __syncthreads();
        mla_norm_rope_store(P, T, P.b_qh_w + l * 96, lat, qscale, P.Q + (size_t)(b * 8 + h) * SEQP * 96, pos0, tlat0);
        __syncthreads();
      }
    }
  }
}

DEVI void hgrn_load(const Params& P, int l, int b, int hd, int c, float* BF, float* RB,
                    float (&q)[16], float (&kf)[16], float (&kb)[16], float (&v)[16], bool need_kv) {
  const int tid = threadIdx.x, t = tid >> 2, k0 = (tid & 3) * 16;
  const int row = row_of(b, c * 64 + t);
  const bf16* z = P.Z + (size_t)row * DIN + hd * 64 + k0;
  float zf[16], zb[16];
#pragma unroll
  for (int i = 0; i < 2; ++i) {
    const uint4 uq = *reinterpret_cast<const uint4*>(z + ZC_CQ + i * 8);
    const uint4 uf = *reinterpret_cast<const uint4*>(z + ZC_CFF + i * 8);
    const uint4 ub = *reinterpret_cast<const uint4*>(z + ZC_CFB + i * 8);
    q[i * 8 + 0] = lo2f(uq.x); q[i * 8 + 1] = hi2f(uq.x); q[i * 8 + 2] = lo2f(uq.y); q[i * 8 + 3] = hi2f(uq.y);
    q[i * 8 + 4] = lo2f(uq.z); q[i * 8 + 5] = hi2f(uq.z); q[i * 8 + 6] = lo2f(uq.w); q[i * 8 + 7] = hi2f(uq.w);
    zf[i * 8 + 0] = lo2f(uf.x); zf[i * 8 + 1] = hi2f(uf.x); zf[i * 8 + 2] = lo2f(uf.y); zf[i * 8 + 3] = hi2f(uf.y);
    zf[i * 8 + 4] = lo2f(uf.z); zf[i * 8 + 5] = hi2f(uf.z); zf[i * 8 + 6] = lo2f(uf.w); zf[i * 8 + 7] = hi2f(uf.w);
    zb[i * 8 + 0] = lo2f(ub.x); zb[i * 8 + 1] = hi2f(ub.x); zb[i * 8 + 2] = lo2f(ub.y); zb[i * 8 + 3] = hi2f(ub.y);
    zb[i * 8 + 4] = lo2f(ub.z); zb[i * 8 + 5] = hi2f(ub.z); zb[i * 8 + 6] = lo2f(ub.w); zb[i * 8 + 7] = hi2f(ub.w);
    if (need_kv) {
      const uint4 uv = *reinterpret_cast<const uint4*>(z + ZC_CI + i * 8);
      v[i * 8 + 0] = lo2f(uv.x); v[i * 8 + 1] = hi2f(uv.x); v[i * 8 + 2] = lo2f(uv.y); v[i * 8 + 3] = hi2f(uv.y);
      v[i * 8 + 4] = lo2f(uv.z); v[i * 8 + 5] = hi2f(uv.z); v[i * 8 + 6] = lo2f(uv.w); v[i * 8 + 7] = hi2f(uv.w);
    }
  }
#pragma unroll
  for (int i = 0; i < 16; ++i) {
    q[i] *= 0.125f;
    float lbf = 0.f, lbb = 0.f;
    if (l == 1) {
      const int ch = hd * 64 + k0 + i;
      lbf = sigmoidf_(P.c_lb[512 + ch] - P.c_lb[ch]);
      lbb = sigmoidf_(P.c_lb[512 + 256 + ch] - P.c_lb[256 + ch]);
    }
    {
      const float zz = zf[i];
      const float sg = sigmoidf_(zz);
      const float lsig = fminf(zz, 0.f) - log1pf(__expf(-fabsf(zz)));
      const float f = lbf + (1.f - lbf) * sg;
      const float lf = (l == 0) ? lsig : __logf(f);
      kf[i] = (1.f - lbf) * sigmoidf_(-zz);
      BF[t * 65 + k0 + i] = lf;
    }
    {
      const float zz = zb[i];
      const float sg = sigmoidf_(zz);
      const float lsig = fminf(zz, 0.f) - log1pf(__expf(-fabsf(zz)));
      const float f = lbb + (1.f - lbb) * sg;
      const float lf = (l == 0) ? lsig : __logf(f);
      kb[i] = (1.f - lbb) * sigmoidf_(-zz);
      RB[t * 65 + k0 + i] = lf;
    }
  }
  __syncthreads();
  if (tid < 64) {
    float s = 0.f;
    for (int tt = 0; tt < 64; ++tt) { s += BF[tt * 65 + tid]; BF[tt * 65 + tid] = s; }
  } else if (tid < 128) {
    const int k = tid - 64;
    float s = 0.f;
    for (int tt = 63; tt >= 0; --tt) { s += RB[tt * 65 + k]; RB[tt * 65 + k] = s; }
  }
  __syncthreads();
}

DEVI f32x16 lds_mm(const bf16* A, const bf16* BT, int tm, int tn, int l31, int hh) {
  f32x16 acc = zero16();
#pragma unroll
  for (int ks = 0; ks < 4; ++ks) {
    const bf16x8 a = ldfrag(A + (tm * 32 + l31) * 72 + ks * 16 + hh * 8);
    const bf16x8 b = ldfrag(BT + (tn * 32 + l31) * 72 + ks * 16 + hh * 8);
    acc = mfma32(a, b, acc);
  }
  return acc;
}

DEVI void phase_hgrn_local(const Params& P, int l, unsigned char* smem) {
  const int tid = threadIdx.x, lane = tid & 63, wave = tid >> 6, l31 = lane & 31, hh = lane >> 5;
  const int tm = wave >> 1, tn = wave & 1;
  float* BF = reinterpret_cast<float*>(smem);
  float* RB = BF + 64 * 65;
  bf16* QF = reinterpret_cast<bf16*>(smem + 33280);
  bf16* KF = QF + 64 * 72;
  bf16* QB = KF + 64 * 72;
  bf16* KB = QB + 64 * 72;
  bf16* VTt = KB + 64 * 72;
  bf16* KHF = reinterpret_cast<bf16*>(smem);
  bf16* KHB = KHF + 64 * 72;
  bf16* ATT = KHB + 64 * 72;
  for (int it = blockIdx.x; it < 8 * 4 * 36; it += gridDim.x) {
    const int c = it % 36, hd = (it / 36) & 3, b = it / 144;
    float q[16], kf[16], kb[16], v[16];
    __syncthreads();
    hgrn_load(P, l, b, hd, c, BF, RB, q, kf, kb, v, true);
    const int t = tid >> 2, k0 = (tid & 3) * 16;
    float bfv[16], rbv[16];
#pragma unroll
    for (int i = 0; i < 16; ++i) { bfv[i] = BF[t * 65 + k0 + i]; rbv[i] = RB[t * 65 + k0 + i]; }
    if (t == 0) {
      float* dec = P.DEC + ((size_t)((b * 4 + hd) * 2) * 36 + c) * 64 + k0;
#pragma unroll
      for (int i = 0; i < 16; ++i) { dec[i] = __expf(BF[63 * 65 + k0 + i]); dec[36 * 64 + i] = __expf(RB[k0 + i]); }
    }
#pragma unroll
    for (int i = 0; i < 16; i += 2) {
      const int k = k0 + i;
      const float mF0 = BF[32 * 65 + k], mF1 = BF[32 * 65 + k + 1], mB0 = RB[32 * 65 + k], mB1 = RB[32 * 65 + k + 1];
      *reinterpret_cast<unsigned*>(&QF[t * 72 + k]) = pack2(q[i] * __expf(fminf(bfv[i] - mF0, 80.f)), q[i + 1] * __expf(fminf(bfv[i + 1] - mF1, 80.f)));
      *reinterpret_cast<unsigned*>(&KF[t * 72 + k]) = pack2(kf[i] * __expf(fminf(mF0 - bfv[i], 80.f)), kf[i + 1] * __expf(fminf(mF1 - bfv[i + 1], 80.f)));
      *reinterpret_cast<unsigned*>(&QB[t * 72 + k]) = pack2(q[i] * __expf(fminf(rbv[i] - mB0, 80.f)), q[i + 1] * __expf(fminf(rbv[i + 1] - mB1, 80.f)));
      *reinterpret_cast<unsigned*>(&KB[t * 72 + k]) = pack2(kb[i] * __expf(fminf(mB0 - rbv[i], 80.f)), kb[i + 1] * __expf(fminf(mB1 - rbv[i + 1], 80.f)));
    }
#pragma unroll
    for (int i = 0; i < 16; ++i) {
      VTt[(k0 + i) * 72 + t] = f2bf(v[i]);
      kf[i] = kf[i] * __expf(BF[63 * 65 + k0 + i] - bfv[i]);
      kb[i] = kb[i] * __expf(RB[k0 + i] - rbv[i]);
    }
    __syncthreads();
#pragma unroll
    for (int i = 0; i < 16; ++i) {
      KHF[(k0 + i) * 72 + t] = f2bf(kf[i]);
      KHB[(k0 + i) * 72 + t] = f2bf(kb[i]);
    }
    __syncthreads();
    {
      const f32x16 af = lds_mm(QF, KF, tm, tn, l31, hh);
      const f32x16 ab = lds_mm(QB, KB, tm, tn, l31, hh);
      const int s = tn * 32 + l31;
#pragma unroll
      for (int r = 0; r < 16; ++r) {
        const int tt = tm * 32 + drow(r, hh);
        float a = 0.f;
        if (s <= tt) a += af[r];
        if (s >= tt) a += ab[r];
        ATT[tt * 72 + s] = f2bf(a);
      }
    }
    {
      const f32x16 lf = lds_mm(KHF, VTt, tm, tn, l31, hh);
      const f32x16 lb = lds_mm(KHB, VTt, tm, tn, l31, hh);
      float* stf = P.ST + ((size_t)((b * 4 + hd) * 2 + 0) * 36 + c) * 4096;
      float* stb = P.ST + ((size_t)((b * 4 + hd) * 2 + 1) * 36 + c) * 4096;
#pragma unroll
      for (int r = 0; r < 16; ++r) {
        const int kk = tm * 32 + drow(r, hh), d = tn * 32 + l31;
        stf[kk * 64 + d] = lf[r];
        stb[kk * 64 + d] = lb[r];
      }
    }
    __syncthreads();
    {
      const f32x16 o = lds_mm(ATT, VTt, tm, tn, l31, hh);
#pragma unroll
      for (int r = 0; r < 16; ++r) {
        const int tt = tm * 32 + drow(r, hh), d = tn * 32 + l31;
        P.OI[(size_t)row_of(b, c * 64 + tt) * 256 + hd * 64 + d] = o[r];
      }
    }
  }
}

DEVI void hgrn_scan_item(const Params& P, int item) {
  const int tid = threadIdx.x;
  const int chain = item >> 2, sl = item & 3;
  const int dir = chain & 1;
  const int k = tid >> 2, d4 = sl * 16 + (tid & 3) * 4;
  float4 S = make_float4(0.f, 0.f, 0.f, 0.f);
  float* base = P.ST + (size_t)chain * 36 * 4096 + k * 64 + d4;
  const float* dec = P.DEC + (size_t)chain * 36 * 64 + k;
#pragma unroll 4
  for (int step = 0; step < 36; ++step) {
    const int c = dir == 0 ? step : (step < 4 ? 3 - step : 39 - step);
    float4* p = reinterpret_cast<float4*>(base + (size_t)c * 4096);
    const float4 L = *p;
    const float dc = dec[c * 64];
    *p = S;
    S.x = dc * S.x + L.x; S.y = dc * S.y + L.y; S.z = dc * S.z + L.z; S.w = dc * S.w + L.w;
  }
}

DEVI void phase_hgrn_final(const Params& P, int l, unsigned char* smem) {
  const int tid = threadIdx.x, lane = tid & 63, wave = tid >> 6, l31 = lane & 31, hh = lane >> 5;
  const int tm = wave >> 1, tn = wave & 1;
  float* BF = reinterpret_cast<float*>(smem);
  float* RB = BF + 64 * 65;
  bf16* QF = reinterpret_cast<bf16*>(smem + 33280);
  bf16* QB = QF + 64 * 72;
  bf16* SF = QB + 64 * 72;
  bf16* SB = SF + 64 * 72;
  float* O = reinterpret_cast<float*>(smem);
  const int c0 = (l == 1) ? 4 : 0;
  const int nc = 36 - c0;
  for (int it = blockIdx.x; it < 8 * 4 * nc; it += gridDim.x) {
    const int c = it % nc + c0, hd = (it / nc) & 3, b = it / (nc * 4);
    float q[16], kf[16], kb[16], v[16];
    __syncthreads();
    hgrn_load(P, l, b, hd, c, BF, RB, q, kf, kb, v, false);
    const int t = tid >> 2, k0 = (tid & 3) * 16;
#pragma unroll
    for (int i = 0; i < 16; i += 2) {
      const int k = k0 + i;
      *reinterpret_cast<unsigned*>(&QF[t * 72 + k]) = pack2(q[i] * __expf(BF[t * 65 + k]), q[i + 1] * __expf(BF[t * 65 + k + 1]));
      *reinterpret_cast<unsigned*>(&QB[t * 72 + k]) = pack2(q[i] * __expf(RB[t * 65 + k]), q[i + 1] * __expf(RB[t * 65 + k + 1]));
    }
    {
      const float* stf = P.ST + ((size_t)((b * 4 + hd) * 2 + 0) * 36 + c) * 4096;
      const float* stb = P.ST + ((size_t)((b * 4 + hd) * 2 + 1) * 36 + c) * 4096;
#pragma unroll
      for (int i = 0; i < 16; i += 4) {
        const float4 a = *reinterpret_cast<const float4*>(stf + t * 64 + k0 + i);
        const float4 bb = *reinterpret_cast<const float4*>(stb + t * 64 + k0 + i);
        SF[(k0 + i + 0) * 72 + t] = f2bf(a.x); SF[(k0 + i + 1) * 72 + t] = f2bf(a.y); SF[(k0 + i + 2) * 72 + t] = f2bf(a.z); SF[(k0 + i + 3) * 72 + t] = f2bf(a.w);
        SB[(k0 + i + 0) * 72 + t] = f2bf(bb.x); SB[(k0 + i + 1) * 72 + t] = f2bf(bb.y); SB[(k0 + i + 2) * 72 + t] = f2bf(bb.z); SB[(k0 + i + 3) * 72 + t] = f2bf(bb.w);
      }
    }
    __syncthreads();
    {
      f32x16 o = lds_mm(QF, SF, tm, tn, l31, hh);
      const f32x16 o2 = lds_mm(QB, SB, tm, tn, l31, hh);
#pragma unroll
      for (int r = 0; r < 16; ++r) {
        const int tt = tm * 32 + drow(r, hh), d = tn * 32 + l31;
        O[tt * 65 + d] = o[r] + o2[r] + P.OI[(size_t)row_of(b, c * 64 + tt) * 256 + hd * 64 + d];
      }
    }
    __syncthreads();
    {
      const int row = row_of(b, c * 64 + t);
      float ov[16]; float ss = 0.f;
#pragma unroll
      for (int i = 0; i < 16; ++i) { ov[i] = O[t * 65 + k0 + i]; ss += ov[i] * ov[i]; }
      ss += __shfl_xor(ss, 1); ss += __shfl_xor(ss, 2);
      const float rr = rsqrtf(ss * (1.f / 64.f) + EPS);
      const bf16* g = P.Z + (size_t)row * DIN + ZC_CG + hd * 64 + k0;
      const float* nw = P.c_out_norm_w + l * 64 + k0;
      unsigned pk[8];
#pragma unroll
      for (int i = 0; i < 16; i += 2) {
        const float g0 = bf2f(g[i]), g1 = bf2f(g[i + 1]);
        const float y0 = ov[i] * rr * nw[i] * (g0 * sigmoidf_(g0));
        const float y1 = ov[i + 1] * rr * nw[i + 1] * (g1 * sigmoidf_(g1));
        pk[i >> 1] = pack2(y0, y1);
      }
      uint4* dst = reinterpret_cast<uint4*>(P.H + (size_t)row * 1024 + 768 + hd * 64 + k0);
      dst[0] = make_uint4(pk[0], pk[1], pk[2], pk[3]);
      dst[1] = make_uint4(pk[4], pk[5], pk[6], pk[7]);
    }
  }
}

DEVI void attn_item(const Params& P, int b, int h, int qpos0, int nkeys, unsigned char* smem) {
  const int tid = threadIdx.x, lane = tid & 63, wave = tid >> 6, l31 = lane & 31, hh = lane >> 5;
  constexpr int LDKS = 104, LDVS = 72;
  constexpr int KS_BYTES = 64 * LDKS * 2, VS_BYTES = 64 * LDVS * 2, ST_BYTES = KS_BYTES + VS_BYTES;
  const bf16* Qg = P.Q + ((size_t)(b * 8 + h) * SEQP + qpos0 + wave * 32 + l31) * 96;
  const bf16* Kg = P.K + (size_t)(b * 8 + h) * SEQP * 96;
  const bf16* Vg = P.VT + (size_t)(b * 8 + h) * 64 * SEQP;
  bf16x8 qf[6];
#pragma unroll
  for (int ks = 0; ks < 6; ++ks) qf[ks] = ldfrag(Qg + ks * 16 + hh * 8);
  f32x16 oacc[2]; oacc[0] = zero16(); oacc[1] = zero16();
  float m = -1e30f, lsum = 0.f;
  uint4 rk[3], rv[2];
  const int ntiles = nkeys / 64;
  auto gload = [&](int kt) {
#pragma unroll
    for (int i = 0; i < 3; ++i) { const int ch = tid + i * 256, row = ch / 12, cc = ch % 12;
      rk[i] = *reinterpret_cast<const uint4*>(Kg + (size_t)(kt * 64 + row) * 96 + cc * 8); }
#pragma unroll
    for (int i = 0; i < 2; ++i) { const int ch = tid + i * 256, row = ch >> 3, cc = ch & 7;
      rv[i] = *reinterpret_cast<const uint4*>(Vg + (size_t)row * SEQP + kt * 64 + cc * 8); }
  };
  auto swrite = [&](int buf) {
    bf16* sK = reinterpret_cast<bf16*>(smem + buf * ST_BYTES);
    bf16* sV = reinterpret_cast<bf16*>(smem + buf * ST_BYTES + KS_BYTES);
#pragma unroll
    for (int i = 0; i < 3; ++i) { const int ch = tid + i * 256, row = ch / 12, cc = ch % 12;
      *reinterpret_cast<uint4*>(sK + row * LDKS + cc * 8) = rk[i]; }
#pragma unroll
    for (int i = 0; i < 2; ++i) { const int ch = tid + i * 256, row = ch >> 3, cc = ch & 7;
      const int g16 = cc >> 1, odd = cc & 1;
      bf16* base = sV + row * LDVS + g16 * 16;
      const int p0 = odd * 2, p1 = odd * 2 + 1;
      const int s0 = (p0 == 1 ? 2 : (p0 == 2 ? 1 : p0)) * 4, s1 = (p1 == 1 ? 2 : (p1 == 2 ? 1 : p1)) * 4;
      *reinterpret_cast<uint2*>(base + s0) = make_uint2(rv[i].x, rv[i].y);
      *reinterpret_cast<uint2*>(base + s1) = make_uint2(rv[i].z, rv[i].w);
    }
  };
  __syncthreads();
  gload(0); swrite(0);
  __syncthreads();
  for (int kt = 0; kt < ntiles; ++kt) {
    const int cur = kt & 1;
    if (kt + 1 < ntiles) gload(kt + 1);
    const bf16* sK = reinterpret_cast<const bf16*>(smem + cur * ST_BYTES);
    const bf16* sV = reinterpret_cast<const bf16*>(smem + cur * ST_BYTES + KS_BYTES);
    f32x16 sacc[2]; sacc[0] = zero16(); sacc[1] = zero16();
#pragma unroll
    for (int kk = 0; kk < 2; ++kk)
#pragma unroll
      for (int ks = 0; ks < 6; ++ks) {
        const bf16x8 a = ldfrag(sK + (kk * 32 + l31) * LDKS + ks * 16 + hh * 8);
        sacc[kk] = mfma32(a, qf[ks], sacc[kk]);
      }
    float mx = sacc[0][0];
#pragma unroll
    for (int kk = 0; kk < 2; ++kk)
#pragma unroll
      for (int r = 0; r < 16; ++r) mx = fmaxf(mx, sacc[kk][r]);
    mx = fmaxf(mx, __shfl_xor(mx, 32));
    const float mnew = fmaxf(m, mx);
    const float alpha = __builtin_amdgcn_exp2f(m - mnew);
    m = mnew;
    float ps = 0.f;
#pragma unroll
    for (int kk = 0; kk < 2; ++kk)
#pragma unroll
      for (int r = 0; r < 16; ++r) { const float p = __builtin_amdgcn_exp2f(sacc[kk][r] - mnew); sacc[kk][r] = p; ps += p; }
    lsum = lsum * alpha + ps;
#pragma unroll
    for (int dt = 0; dt < 2; ++dt)
#pragma unroll
      for (int r = 0; r < 16; ++r) oacc[dt][r] *= alpha;
#pragma unroll
    for (int kk = 0; kk < 2; ++kk)
#pragma unroll
      for (int s = 0; s < 2; ++s) {
        bf16x8 pb;
#pragma unroll
        for (int j = 0; j < 8; ++j) pb[j] = (__bf16)sacc[kk][8 * s + j];
#pragma unroll
        for (int dt = 0; dt < 2; ++dt) {
          const bf16x8 a = ldfrag(sV + (dt * 32 + l31) * LDVS + kk * 32 + s * 16 + hh * 8);
          oacc[dt] = mfma32(a, pb, oacc[dt]);
        }
      }
    if (kt + 1 < ntiles) swrite(cur ^ 1);
    __syncthreads();
  }
  lsum += __shfl_xor(lsum, 32);
  const float inv = 1.f / lsum;
  const int row = row_of(b, qpos0 + wave * 32 + l31);
  bf16* dst = P.H + (size_t)row * 1024 + 256 + h * 64;
#pragma unroll
  for (int dt = 0; dt < 2; ++dt)
#pragma unroll
    for (int rg = 0; rg < 4; ++rg) {
      const int d = dt * 32 + 8 * rg + 4 * hh;
      uint2 o;
      o.x = pack2(oacc[dt][4 * rg + 0] * inv, oacc[dt][4 * rg + 1] * inv);
      o.y = pack2(oacc[dt][4 * rg + 2] * inv, oacc[dt][4 * rg + 3] * inv);
      *reinterpret_cast<uint2*>(dst + d) = o;
    }
}

DEVI void phase_attn_scan(const Params& P, int l, unsigned char* smem) {
  const int n_attn = (l == 0) ? 1152 : 1024;
  const int total = 256 + n_attn;
  for (int it = blockIdx.x; it < total; it += gridDim.x) {
    if (it < 256) { hgrn_scan_item(P, it); continue; }
    const int a = it - 256;
    if (a < 1024) attn_item(P, a >> 7, (a >> 4) & 7, 256 + 128 * (a & 15), 2304, smem);
    else { const int a2 = a - 1024; attn_item(P, a2 >> 4, (a2 >> 1) & 7, 128 * (a2 & 1), 256, smem); }
  }
}

DEVI unsigned ordkey(float s) { const unsigned u = __float_as_uint(s); return (u & 0x80000000u) ? ~u : (u | 0x80000000u); }
DEVI float keyval(unsigned k, unsigned mask) { const unsigned u = k & ~mask; return __uint_as_float((u & 0x80000000u) ? (u & 0x7fffffffu) : ~u); }
DEVI void ins16(unsigned (&lst)[16], unsigned v) {
#pragma unroll
  for (int j = 0; j < 16; ++j) { const unsigned hi = max(lst[j], v); v = min(lst[j], v); lst[j] = hi; }
}
DEVI void merge16(unsigned (&lst)[16], int xm) {
  unsigned o[16];
#pragma unroll
  for (int j = 0; j < 16; ++j) o[j] = (unsigned)__shfl_xor((int)lst[j], xm);
#pragma unroll
  for (int j = 0; j < 16; ++j) lst[j] = max(lst[j], o[15 - j]);
#pragma unroll
  for (int d = 8; d >= 1; d >>= 1)
#pragma unroll
    for (int j = 0; j < 16; ++j)
      if ((j & d) == 0) { const unsigned a = lst[j], bb = lst[j + d]; lst[j] = max(a, bb); lst[j + d] = min(a, bb); }
}

DEVI void phase_route(const Params& P, int l, unsigned char* smem) {
  using G = Gemm<64, 256, 32, 1, 4>;
  const int tid = threadIdx.x, lane = tid & 63, wave = tid >> 6, l31 = lane & 31, hh = lane >> 5;
  bf16* QT = reinterpret_cast<bf16*>(smem);
  float* SC = reinterpret_cast<float*>(smem + 33792);
  const int mtiles = (l == 1) ? 256 : 288;
  const bf16* W = P.WpqT + (size_t)l * 2048 * 1024;
  for (int it = blockIdx.x; it < mtiles * 8; it += gridDim.x) {
    const int mt = it >> 3, h = it & 7;
    f32x16 acc[2][2];
    G::run(P.H + (size_t)mt * 64 * 1024, 1024, W + (size_t)h * 256 * 1024, 1024, 1024, smem, acc);
#pragma unroll
    for (int i = 0; i < 2; ++i)
#pragma unroll
      for (int j = 0; j < 2; ++j)
#pragma unroll
        for (int r = 0; r < 16; ++r)
          QT[(i * 32 + drow(r, hh)) * 264 + wave * 64 + j * 32 + l31] = f2bf(acc[i][j][r]);
    __syncthreads();
    unsigned lst[2][16];
    const int row = tid >> 2, part = tid & 3;
#pragma unroll
    for (int p = 0; p < 2; ++p) {
      f32x16 sa[2]; sa[0] = zero16(); sa[1] = zero16();
      const bf16* keys = P.SK + ((size_t)(l * 16 + h * 2 + p) * 128 + wave * 32 + l31) * 128;
#pragma unroll
      for (int ks = 0; ks < 8; ++ks) {
        const bf16x8 bfr = ldfrag(keys + ks * 16 + hh * 8);
#pragma unroll
        for (int i = 0; i < 2; ++i) {
          const bf16x8 af = ldfrag(QT + (i * 32 + l31) * 264 + p * 128 + ks * 16 + hh * 8);
          sa[i] = mfma32(af, bfr, sa[i]);
        }
      }
      if (p == 1) __syncthreads();
#pragma unroll
      for (int i = 0; i < 2; ++i)
#pragma unroll
        for (int r = 0; r < 16; ++r) SC[(i * 32 + drow(r, hh)) * 129 + wave * 32 + l31] = sa[i][r];
      __syncthreads();
#pragma unroll
      for (int j = 0; j < 16; ++j) lst[p][j] = 0u;
      for (int i = 0; i < 32; ++i) {
        const int idx = part * 32 + ((i + part * 8) & 31);
        const float s = SC[row * 129 + idx];
        const unsigned key = (ordkey(s) & ~0x7fu) | (unsigned)(127 - idx);
        ins16(lst[p], key);
      }
      merge16(lst[p], 1);
      merge16(lst[p], 2);
    }
    float v0[16], v1[16];
#pragma unroll
    for (int j = 0; j < 16; ++j) { v0[j] = keyval(lst[0][j], 0x7fu); v1[j] = keyval(lst[1][j], 0x7fu); }
    unsigned best[16];
#pragma unroll
    for (int j = 0; j < 16; ++j) best[j] = 0u;
#pragma unroll
    for (int a = 0; a < 16; ++a)
#pragma unroll
      for (int bq = 0; bq < 16; ++bq)
        if ((a + 1) * (bq + 1) <= 16) {
          const float sum = v0[a] + v1[bq];
          const unsigned key = (ordkey(sum) & ~0xffu) | (unsigned)(255 - (a * 16 + bq));
          ins16(best, key);
        }
    if (part == 0) {
      const float mx = keyval(best[0], 0xffu);
      float e[16]; float es = 0.f;
#pragma unroll
      for (int j = 0; j < 16; ++j) { e[j] = __expf(keyval(best[j], 0xffu) - mx); es += e[j]; }
      const float inv = 1.f / es;
      const int tok = mt * 64 + row;
      int* ed = P.EIDX + (size_t)tok * 128 + h * 16;
      float* gd = P.GATE + (size_t)tok * 128 + h * 16;
#pragma unroll
      for (int j = 0; j < 16; ++j) {
        const int flat = 255 - (int)(best[j] & 0xffu);
        const int a = flat >> 4, bq = flat & 15;
        int i1 = 0, i2 = 0;
#pragma unroll
        for (int u = 0; u < 16; ++u) {
          i1 = (a == u) ? (127 - (int)(lst[0][u] & 0x7fu)) : i1;
          i2 = (bq == u) ? (127 - (int)(lst[1][u] & 0x7fu)) : i2;
        }
        ed[j] = i1 * 128 + i2;
        gd[j] = e[j] * inv;
      }
    }
    __syncthreads();
  }
}

DEVI float gelu_exact(float a) { return 0.5f * a * (1.f + erff(a * 0.70710678118654752f)); }

DEVI void phase_peer(const Params& P, int l) {
  const int lane = threadIdx.x & 63;
  const int gw = blockIdx.x * 4 + (threadIdx.x >> 6), nw = gridDim.x * 4;
  const int nrows = (l == 1) ? NL : NT;
  const bf16* PU = P.PU + (size_t)l * 16384 * 1024;
  const bf16* PV = P.PV + (size_t)l * 16384 * 1024;
  const bool b5 = lane & 32, b4 = lane & 16, b3 = lane & 8;
  for (int t = gw; t < nrows; t += nw) {
    const uint4 hA = *reinterpret_cast<const uint4*>(P.H + (size_t)t * 1024 + lane * 8);
    const uint4 hB = *reinterpret_cast<const uint4*>(P.H + (size_t)t * 1024 + 512 + lane * 8);
    const int e0 = P.EIDX[(size_t)t * 128 + lane], e1 = P.EIDX[(size_t)t * 128 + 64 + lane];
    const float g0 = P.GATE[(size_t)t * 128 + lane], g1 = P.GATE[(size_t)t * 128 + 64 + lane];
    float hf[16];
    hf[0] = lo2f(hA.x); hf[1] = hi2f(hA.x); hf[2] = lo2f(hA.y); hf[3] = hi2f(hA.y); hf[4] = lo2f(hA.z); hf[5] = hi2f(hA.z); hf[6] = lo2f(hA.w); hf[7] = hi2f(hA.w);
    hf[8] = lo2f(hB.x); hf[9] = hi2f(hB.x); hf[10] = lo2f(hB.y); hf[11] = hi2f(hB.y); hf[12] = lo2f(hB.z); hf[13] = hi2f(hB.z); hf[14] = lo2f(hB.w); hf[15] = hi2f(hB.w);
    float y[16];
#pragma unroll
    for (int i = 0; i < 16; ++i) y[i] = 0.f;
    for (int kb = 0; kb < 16; ++kb) {
      const int esrc = kb < 8 ? e0 : e1;
      const float gsrc = kb < 8 ? g0 : g1;
      uint4 uA[8], uB[8], vA[8], vB[8];
#pragma unroll
      for (int i = 0; i < 8; ++i) {
        const int e = __shfl(esrc, (kb * 8 + i) & 63);
        const bf16* ur = PU + (size_t)e * 1024 + lane * 8;
        const bf16* vr = PV + (size_t)e * 1024 + lane * 8;
        uA[i] = *reinterpret_cast<const uint4*>(ur); uB[i] = *reinterpret_cast<const uint4*>(ur + 512);
        vA[i] = *reinterpret_cast<const uint4*>(vr); vB[i] = *reinterpret_cast<const uint4*>(vr + 512);
      }
      float d[8];
#pragma unroll
      for (int i = 0; i < 8; ++i) {
        float s = 0.f;
        s += hf[0] * lo2f(uA[i].x) + hf[1] * hi2f(uA[i].x) + hf[2] * lo2f(uA[i].y) + hf[3] * hi2f(uA[i].y);
        s += hf[4] * lo2f(uA[i].z) + hf[5] * hi2f(uA[i].z) + hf[6] * lo2f(uA[i].w) + hf[7] * hi2f(uA[i].w);
        s += hf[8] * lo2f(uB[i].x) + hf[9] * hi2f(uB[i].x) + hf[10] * lo2f(uB[i].y) + hf[11] * hi2f(uB[i].y);
        s += hf[12] * lo2f(uB[i].z) + hf[13] * hi2f(uB[i].z) + hf[14] * lo2f(uB[i].w) + hf[15] * hi2f(uB[i].w);
        d[i] = s;
      }
      float r4[4], r2[2], r1;
#pragma unroll
      for (int i = 0; i < 4; ++i) { const float mine = b5 ? d[4 + i] : d[i]; const float send = b5 ? d[i] : d[4 + i]; r4[i] = mine + __shfl_xor(send, 32); }
#pragma unroll
      for (int i = 0; i < 2; ++i) { const float mine = b4 ? r4[2 + i] : r4[i]; const float send = b4 ? r4[i] : r4[2 + i]; r2[i] = mine + __shfl_xor(send, 16); }
      { const float mine = b3 ? r2[1] : r2[0]; const float send = b3 ? r2[0] : r2[1]; r1 = mine + __shfl_xor(send, 8); }
      r1 += __shfl_xor(r1, 4); r1 += __shfl_xor(r1, 2); r1 += __shfl_xor(r1, 1);
      const float g = __shfl(gsrc, (kb * 8 + (lane >> 3)) & 63);
      const float w = g * gelu_exact(r1);
#pragma unroll
      for (int i = 0; i < 8; ++i) {
        const float wi = __shfl(w, i * 8);
        y[0] += wi * lo2f(vA[i].x); y[1] += wi * hi2f(vA[i].x); y[2] += wi * lo2f(vA[i].y); y[3] += wi * hi2f(vA[i].y);
        y[4] += wi * lo2f(vA[i].z); y[5] += wi * hi2f(vA[i].z); y[6] += wi * lo2f(vA[i].w); y[7] += wi * hi2f(vA[i].w);
        y[8] += wi * lo2f(vB[i].x); y[9] += wi * hi2f(vB[i].x); y[10] += wi * lo2f(vB[i].y); y[11] += wi * hi2f(vB[i].y);
        y[12] += wi * lo2f(vB[i].z); y[13] += wi * hi2f(vB[i].z); y[14] += wi * lo2f(vB[i].w); y[15] += wi * hi2f(vB[i].w);
      }
    }
    const int bi = batch_of_row(t);
    const float* gate2 = P.MOD + (size_t)(l * 9 + bi) * 6144 + 5 * 1024;
    float xn[16];
    float ss = 0.f;
#pragma unroll
    for (int hf2 = 0; hf2 < 2; ++hf2)
#pragma unroll
      for (int q4 = 0; q4 < 2; ++q4) {
        const int d = hf2 * 512 + lane * 8 + q4 * 4;
        const float4 xo = *reinterpret_cast<const float4*>(P.X + (size_t)t * 1024 + d);
        const float4 gg = *reinterpret_cast<const float4*>(gate2 + d);
        float4 o;
        o.x = xo.x + gg.x * y[hf2 * 8 + q4 * 4 + 0]; o.y = xo.y + gg.y * y[hf2 * 8 + q4 * 4 + 1];
        o.z = xo.z + gg.z * y[hf2 * 8 + q4 * 4 + 2]; o.w = xo.w + gg.w * y[hf2 * 8 + q4 * 4 + 3];
        xn[hf2 * 8 + q4 * 4 + 0] = o.x; xn[hf2 * 8 + q4 * 4 + 1] = o.y; xn[hf2 * 8 + q4 * 4 + 2] = o.z; xn[hf2 * 8 + q4 * 4 + 3] = o.w;
        ss += o.x * o.x + o.y * o.y + o.z * o.z + o.w * o.w;
        if (l == 1) *reinterpret_cast<float4*>(P.out + (size_t)t * 1024 + d) = o;
        else *reinterpret_cast<float4*>(P.X + (size_t)t * 1024 + d) = o;
      }
    if (l == 0) {
      ss = wave_sum(ss);
      const float rr = rsqrtf(ss * (1.f / 1024.f) + EPS);
      const float* lnw = P.ln1_w + 1024;
      const float* mod = P.MOD + (size_t)(9 + bi) * 6144;
#pragma unroll
      for (int hf2 = 0; hf2 < 2; ++hf2) {
        const int d = hf2 * 512 + lane * 8;
        unsigned pk[4];
#pragma unroll
        for (int i = 0; i < 8; i += 2) {
          const float o0 = xn[hf2 * 8 + i] * rr * lnw[d + i] * (1.f + mod[1024 + d + i]) + mod[d + i];
          const float o1 = xn[hf2 * 8 + i + 1] * rr * lnw[d + i + 1] * (1.f + mod[1024 + d + i + 1]) + mod[d + i + 1];
          pk[i >> 1] = pack2(o0, o1);
        }
        *reinterpret_cast<uint4*>(P.H + (size_t)t * 1024 + d) = make_uint4(pk[0], pk[1], pk[2], pk[3]);
      }
    }
  }
}

constexpr int N_PHASES = 2 + 2 * 8;

__global__ void __launch_bounds__(256, 2) fwd_kernel(Params P) {
  extern __shared__ __attribute__((aligned(16))) unsigned char smem[];
  cg::grid_group grid = cg::this_grid();
#define RUN_PHASE(idx, call) \
  if (P.phase_lo <= (idx) && (idx) <= P.phase_hi) { call; if (P.coop && (idx) < P.phase_hi) grid.sync(); }
  RUN_PHASE(0, phase_prologue(P, smem))
  RUN_PHASE(1, phase_norm(P, 0, 0, NT))
  RUN_PHASE(2, phase_gemm1(P, 0, smem))
  RUN_PHASE(3, { phase_mixA(P, 0, smem); phase_mla_proj(P, 0, smem); phase_hgrn_local(P, 0, smem); })
  RUN_PHASE(4, phase_attn_scan(P, 0, smem))
  RUN_PHASE(5, phase_hgrn_final(P, 0, smem))
  RUN_PHASE(6, phase_gemm2(P, 0, smem))
  RUN_PHASE(7, phase_norm(P, 0, 1, NT))
  RUN_PHASE(8, phase_route(P, 0, smem))
  RUN_PHASE(9, phase_peer(P, 0))
  RUN_PHASE(10, phase_gemm1(P, 1, smem))
  RUN_PHASE(11, { phase_mixA(P, 1, smem); phase_mla_proj(P, 1, smem); phase_hgrn_local(P, 1, smem); })
  RUN_PHASE(12, phase_attn_scan(P, 1, smem))
  RUN_PHASE(13, phase_hgrn_final(P, 1, smem))
  RUN_PHASE(14, phase_gemm2(P, 1, smem))
  RUN_PHASE(15, phase_norm(P, 1, 1, NL))
  RUN_PHASE(16, phase_route(P, 1, smem))
  RUN_PHASE(17, phase_peer(P, 1))
}

extern "C" void kernel_launch(void* const* d_in, const int* in_sizes, int n_in, void* d_out, int out_size, void* d_ws,
                              size_t ws_size, hipStream_t stream) {
  Params p{};
  const float* const* in = reinterpret_cast<const float* const*>(d_in);
  p.x = in[0]; p.c = in[1]; p.ctx = in[2]; p.c_ctx = in[3]; p.ln1_w = in[4]; p.ln2_w = in[5]; p.w_mod = in[6]; p.b_mod = in[7];
  p.w_in = in[8]; p.w_out = in[9]; p.a_norm_w = in[10]; p.a_w_s = in[11]; p.a_b_s = in[12]; p.b_q_norm_w = in[13]; p.b_w_uq = in[14];
  p.b_kv_norm_w = in[15]; p.b_w_ukv = in[16]; p.b_qh_w = in[17]; p.b_kh_w = in[18]; p.c_lb = in[19]; p.c_out_norm_w = in[20];
  p.p_w_q = in[21]; p.p_sub_keys = in[22]; p.p_u = in[23]; p.p_v = in[24];
  p.out = reinterpret_cast<float*>(d_out);
  unsigned char* ws = reinterpret_cast<unsigned char*>(d_ws);
  size_t off = 0;
  auto take = [&](size_t bytes) { unsigned char* r = ws + off; off += (bytes + 255) & ~(size_t)255; return r; };
  p.MOD = (float*)take((size_t)2 * 9 * 6144 * 4);
  p.ROPE = (float*)take((size_t)2048 * 32 * 4);
  p.WinT = (bf16*)take((size_t)2 * DINP * 1024 * 2);
  p.WoutT = (bf16*)take((size_t)2 * 1024 * 1024 * 2);
  p.WpqT = (bf16*)take((size_t)2 * 2048 * 1024 * 2);
  p.WuqT = (bf16*)take((size_t)2 * 768 * 256 * 2);
  p.WukvT = (bf16*)take((size_t)2 * 1024 * 128 * 2);
  p.SK = (bf16*)take((size_t)2 * 16 * 128 * 128 * 2);
  p.AWS = (bf16*)take((size_t)2 * 4 * 128 * 128 * 2);
  p.PU = (bf16*)take((size_t)2 * 16384 * 1024 * 2);
  p.PV = (bf16*)take((size_t)2 * 16384 * 1024 * 2);
  p.X = (float*)take((size_t)NT * 1024 * 4);
  p.H = (bf16*)take((size_t)NT * 1024 * 2);
  p.Z = (bf16*)take((size_t)NT * DIN * 2);
  p.Q = (bf16*)take((size_t)64 * SEQP * 96 * 2);
  p.K = (bf16*)take((size_t)64 * SEQP * 96 * 2);
  p.VT = (bf16*)take((size_t)64 * 64 * SEQP * 2);
  p.ST = (float*)take((size_t)64 * 36 * 4096 * 4);
  p.DEC = (float*)take((size_t)64 * 36 * 64 * 4);
  p.OI = (float*)take((size_t)NT * 256 * 4);
  p.EIDX = (int*)p.Z;
  p.GATE = (float*)((unsigned char*)p.Z + (size_t)NT * 128 * 4);
  if (off > ws_size) { fprintf(stderr, "workspace too small: need %zu have %zu\n", off, ws_size); }
  static int grid_blocks = 0;
  if (!grid_blocks) {
    if (hipFuncSetAttribute((const void*)fwd_kernel, hipFuncAttributeMaxDynamicSharedMemorySize, SMEM_BYTES) != hipSuccess)
      fprintf(stderr, "hipFuncSetAttribute failed\n");
    int dev = 0, cus = 0, per_cu = 0;
    hipGetDevice(&dev);
    hipDeviceGetAttribute(&cus, hipDeviceAttributeMultiprocessorCount, dev);
    hipOccupancyMaxActiveBlocksPerMultiprocessor(&per_cu, (const void*)fwd_kernel, 256, SMEM_BYTES);
    if (per_cu > 2) per_cu = 2;
    if (per_cu < 1) { fprintf(stderr, "occupancy query returned %d\n", per_cu); per_cu = 1; }
    grid_blocks = cus * per_cu;
    fprintf(stderr, "grid_blocks=%d (cus=%d per_cu=%d) ws need=%zu have=%zu\n", grid_blocks, cus, per_cu, off, ws_size);
  }
  p.coop = 1; p.phase_lo = 0; p.phase_hi = N_PHASES - 1;
  void* args[] = {&p};
  const hipError_t e = hipLaunchCooperativeKernel((const void*)fwd_kernel, dim3(grid_blocks), dim3(256), args, SMEM_BYTES, stream);
  if (e != hipSuccess) fprintf(stderr, "cooperative launch failed: %s (grid %d)\n", hipGetErrorString(e), grid_blocks);
}
```

```cpp
#include <hip/hip_runtime.h>
#include <hip/hip_cooperative_groups.h>
#include <cstdio>
#include <cstdint>
namespace cg = cooperative_groups;

#define DEVI __device__ __forceinline__

typedef unsigned short bf16;
using bf16x8 = __attribute__((ext_vector_type(8))) __bf16;
using bf16x2 = __attribute__((ext_vector_type(2))) __bf16;
using f32x16 = __attribute__((ext_vector_type(16))) float;

constexpr int NL = 16384;
constexpr int NT = 18432;
constexpr int DM = 1024;
constexpr int DIN = 2208;
constexpr int DINP = 2304;
constexpr int SEQP = 2304;
constexpr float EPS = 1e-6f;
constexpr int ZC_AU = 0, ZC_AV = 256, ZC_BQ = 512, ZC_BKV = 768, ZC_BKR = 896, ZC_CQ = 928, ZC_CFF = 1184, ZC_CFB = 1440, ZC_CI = 1696, ZC_CG = 1952;
constexpr int SMEM_BYTES = 80896;
constexpr int SMEM_TOTAL = SMEM_BYTES + 16;

struct Params {
  const float *x, *c, *ctx, *c_ctx, *ln1_w, *ln2_w, *w_mod, *b_mod, *w_in, *w_out, *a_norm_w, *a_w_s, *a_b_s;
  const float *b_q_norm_w, *b_w_uq, *b_kv_norm_w, *b_w_ukv, *b_qh_w, *b_kh_w, *c_lb, *c_out_norm_w, *p_w_q, *p_sub_keys, *p_u, *p_v;
  float* out;
  unsigned* bar;
  float* MOD;
  float* ROPE;
  bf16* WinT;
  bf16* WoutT;
  bf16* WpqT;
  bf16* WuqT;
  bf16* WukvT;
  bf16* SK;
  bf16* AWS;
  unsigned char* PU8;
  unsigned char* PV8;
  float* PUS;
  float* PVS;
  float* X;
  bf16* H;
  bf16* Z;
  bf16* Q;
  bf16* K;
  bf16* VT;
  float* ST;
  float* DEC;
  float* OI;
  int* EIDX;
  float* GATE;
  int phase_lo, phase_hi, coop, pad0;
};

DEVI float bf2f(bf16 v) { return __uint_as_float(((unsigned)v) << 16); }
DEVI bf16 f2bf(float a) { __bf16 v = (__bf16)a; return __builtin_bit_cast(unsigned short, v); }
DEVI unsigned pack2(float a, float b) { bf16x2 v; v[0] = (__bf16)a; v[1] = (__bf16)b; return __builtin_bit_cast(unsigned, v); }
DEVI float lo2f(unsigned u) { return __uint_as_float(u << 16); }
DEVI float hi2f(unsigned u) { return __uint_as_float(u & 0xffff0000u); }
DEVI f32x16 zero16() { f32x16 z;
#pragma unroll
  for (int i = 0; i < 16; ++i) z[i] = 0.f; return z; }
DEVI f32x16 mfma32(bf16x8 a, bf16x8 b, f32x16 c) { return __builtin_amdgcn_mfma_f32_32x32x16_bf16(a, b, c, 0, 0, 0); }
DEVI bf16x8 ldfrag(const bf16* p) { return *reinterpret_cast<const bf16x8*>(p); }
DEVI int drow(int r, int hh) { return (r & 3) + 8 * (r >> 2) + 4 * hh; }
DEVI int row_of(int b, int p) { return p < 256 ? NL + b * 256 + p : b * 2048 + (p - 256); }
DEVI int batch_of_row(int r) { return r < NL ? (r >> 11) : 8; }
DEVI float wave_sum(float v) {
#pragma unroll
  for (int o = 32; o > 0; o >>= 1) v += __shfl_xor(v, o);
  return v;
}
DEVI float sigmoidf_(float z) { return 1.f / (1.f + __expf(-z)); }


#define XB_TMO      128
#define XB_XCNT(j)  (256  + 64 * (j))
#define XB_XSUB(j)  (1280 + 64 * (j))
#define XB_XGEN(j)  (2304 + 64 * (j))
#define XB_TOP      3328
#define XB_TOPGEN   3392
#define XCD_BAR_WORDS 3456
#define XB_SPIN_CAP (1u << 22)
#define LAS __attribute__((address_space(3)))
DEVI unsigned xb_ld(unsigned* p)              { return __hip_atomic_load(p, __ATOMIC_RELAXED, __HIP_MEMORY_SCOPE_AGENT); }
DEVI unsigned xb_add(unsigned* p, unsigned v) { return __hip_atomic_fetch_add(p, v, __ATOMIC_RELAXED, __HIP_MEMORY_SCOPE_AGENT); }
DEVI unsigned xb_xcc_id() { return (unsigned)__builtin_amdgcn_s_getreg((3 << 11) | 20) & 0xFu; }
#define XB_SPIN(cond, bar) do { unsigned _sp = 0; while (cond) { __builtin_amdgcn_s_sleep(1); \
    if ((++_sp & 255u) == 0u) { if (xb_ld(&(bar)[XB_TMO])) break; if (_sp > XB_SPIN_CAP) { atomicAdd(&(bar)[XB_TMO], 1u); break; } } } } while (0)
struct XcdBarrier { unsigned* bar; unsigned x; volatile LAS unsigned* st; };
DEVI XcdBarrier xcd_barrier_post(unsigned* bar, volatile LAS unsigned* st) {
  XcdBarrier b; b.bar = bar; b.x = xb_xcc_id(); b.st = st;
  if (threadIdx.x == 0) (void)xb_add(&bar[XB_XCNT(b.x)], 1u);
  return b;
}
DEVI void xcd_barrier_complete(unsigned* bar, unsigned x, unsigned& nloc, unsigned& nx) {
  const unsigned G = gridDim.x * gridDim.y * gridDim.z;
  unsigned sum, cnt, mine, sp = 0u;
  for (;;) {
    sum = 0u; cnt = 0u; mine = 0u;
#pragma unroll
    for (unsigned j = 0; j < 16; ++j) { const unsigned c = xb_ld(&bar[XB_XCNT(j)]); sum += c; cnt += (c > 0u) ? 1u : 0u; mine = (j == x) ? c : mine; }
    if (sum == G) break;
    __builtin_amdgcn_s_sleep(1);
    if ((++sp & 255u) == 0u) { if (xb_ld(&bar[XB_TMO])) break; if (sp > XB_SPIN_CAP) { atomicAdd(&bar[XB_TMO], 1u); break; } }
  }
  nloc = mine > 0u ? mine : 1u; nx = cnt > 0u ? cnt : 1u;
}
DEVI void xcd_barrier(const XcdBarrier& b) {
  asm volatile("s_waitcnt vmcnt(0)" ::: "memory");
  __syncthreads();
  if (threadIdx.x == 0) {
    unsigned* bar = b.bar;
    __builtin_amdgcn_s_waitcnt(0);
    unsigned nloc = b.st[0], nx = b.st[1];
    if (nloc == 0u) { xcd_barrier_complete(bar, b.x, nloc, nx); b.st[0] = nloc; b.st[1] = nx; }
    const unsigned old = xb_add(&bar[XB_XSUB(b.x)], 1u);
    const unsigned gen = old / nloc;
    if (old + 1u == (gen + 1u) * nloc) {
      __builtin_amdgcn_fence(__ATOMIC_RELEASE, "agent");
      asm volatile("s_waitcnt vmcnt(0)" ::: "memory");
      const unsigned og = xb_add(&bar[XB_TOP], 1u);
      const unsigned tg = og / nx;
      if (og + 1u == (tg + 1u) * nx) xb_add(&bar[XB_TOPGEN], 1u);
      else XB_SPIN(xb_ld(&bar[XB_TOPGEN]) == tg, bar);
      __builtin_amdgcn_fence(__ATOMIC_ACQUIRE, "agent");
      xb_add(&bar[XB_XGEN(b.x)], 1u);
      asm volatile("s_waitcnt vmcnt(0)" ::: "memory");
    } else {
      XB_SPIN(xb_ld(&bar[XB_XGEN(b.x)]) == gen, bar);
      __builtin_amdgcn_fence(__ATOMIC_ACQUIRE, "agent");
      asm volatile("s_waitcnt vmcnt(0)" ::: "memory");
    }
  }
  __syncthreads();
}

DEVI void phase_mod(const Params& P, unsigned char* smem) {
  const int tid = threadIdx.x;
  float* s = (float*)smem;
  float* red = s + 9 * 1024;
  for (int item = blockIdx.x; item < 192; item += gridDim.x) {
    const int l = item / 96, j = item % 96;
    __syncthreads();
    for (int i = tid; i < 9 * 1024; i += 256) {
      int bi = i >> 10, k = i & 1023;
      float v = bi < 8 ? P.c[bi * 1024 + k] : P.c_ctx[k];
      s[i] = v * sigmoidf_(v);
    }
    __syncthreads();
    const int c4 = tid & 15, kg = tid >> 4;
    float acc[9][4];
#pragma unroll
    for (int bi = 0; bi < 9; ++bi) { acc[bi][0] = acc[bi][1] = acc[bi][2] = acc[bi][3] = 0.f; }
    const float* w = P.w_mod + (size_t)l * 1024 * 6144 + j * 64 + c4 * 4;
#pragma unroll 4
    for (int kk = 0; kk < 64; ++kk) {
      const int k = kg * 64 + kk;
      const float4 w4 = *reinterpret_cast<const float4*>(w + (size_t)k * 6144);
#pragma unroll
      for (int bi = 0; bi < 9; ++bi) {
        const float sv = s[bi * 1024 + k];
        acc[bi][0] += sv * w4.x; acc[bi][1] += sv * w4.y; acc[bi][2] += sv * w4.z; acc[bi][3] += sv * w4.w;
      }
    }
#pragma unroll
    for (int bi = 0; bi < 9; ++bi)
#pragma unroll
      for (int e = 0; e < 4; ++e) red[(kg * 9 + bi) * 64 + c4 * 4 + e] = acc[bi][e];
    __syncthreads();
    for (int o = tid; o < 576; o += 256) {
      const int bi = o >> 6, cc = o & 63;
      float sum = 0.f;
#pragma unroll
      for (int g = 0; g < 16; ++g) sum += red[(g * 9 + bi) * 64 + cc];
      P.MOD[(size_t)(l * 9 + bi) * 6144 + j * 64 + cc] = sum + P.b_mod[l * 6144 + j * 64 + cc];
    }
  }
}

DEVI void conv_T_tile(const float* __restrict__ src, int N, bf16* __restrict__ dst, int Kd, int k0, int n0,
                      const float* __restrict__ kscale, float* tile) {
  const int tid = threadIdx.x;
  __syncthreads();
  for (int e = tid; e < 4096; e += 256) {
    const int i = e >> 6, j = e & 63, n = n0 + j;
    float v = (n < N) ? src[(size_t)(k0 + i) * N + n] : 0.f;
    if (kscale) v *= kscale[k0 + i];
    tile[i * 65 + j] = v;
  }
  __syncthreads();
  for (int e = tid; e < 2048; e += 256) {
    const int j = e >> 5, i2 = (e & 31) * 2;
    const unsigned pk = pack2(tile[i2 * 65 + j], tile[(i2 + 1) * 65 + j]);
    *reinterpret_cast<unsigned*>(&dst[(size_t)(n0 + j) * Kd + k0 + i2]) = pk;
  }
}

DEVI void conv_straight(const float* __restrict__ src, bf16* __restrict__ dst, size_t n8) {
  const size_t stride = (size_t)gridDim.x * 256;
  for (size_t i = (size_t)blockIdx.x * 256 + threadIdx.x; i < n8; i += stride) {
    const float4 a = reinterpret_cast<const float4*>(src)[2 * i];
    const float4 b = reinterpret_cast<const float4*>(src)[2 * i + 1];
    uint4 o; o.x = pack2(a.x, a.y); o.y = pack2(a.z, a.w); o.z = pack2(b.x, b.y); o.w = pack2(b.z, b.w);
    reinterpret_cast<uint4*>(dst)[i] = o;
  }
}

DEVI void phase_prologue(const Params& P, unsigned char* smem) {
  phase_mod(P, smem);
  float* tile = (float*)smem;
  for (int it = blockIdx.x; it < 2 * 1424; it += gridDim.x) {
    const int l = it / 1424; int r = it % 1424;
    if (r < 576) { conv_T_tile(P.w_in + (size_t)l * 1024 * DIN, DIN, P.WinT + (size_t)l * DINP * 1024, 1024, (r % 16) * 64, (r / 16) * 64, nullptr, tile); continue; }
    r -= 576;
    if (r < 256) { conv_T_tile(P.w_out + (size_t)l * 1024 * 1024, 1024, P.WoutT + (size_t)l * 1024 * 1024, 1024, (r % 16) * 64, (r / 16) * 64, nullptr, tile); continue; }
    r -= 256;
    if (r < 512) { conv_T_tile(P.p_w_q + (size_t)l * 1024 * 2048, 2048, P.WpqT + (size_t)l * 2048 * 1024, 1024, (r % 16) * 64, (r / 16) * 64, nullptr, tile); continue; }
    r -= 512;
    if (r < 48) { conv_T_tile(P.b_w_uq + (size_t)l * 256 * 768, 768, P.WuqT + (size_t)l * 768 * 256, 256, (r % 4) * 64, (r / 4) * 64, P.b_q_norm_w + l * 256, tile); continue; }
    r -= 48;
    conv_T_tile(P.b_w_ukv + (size_t)l * 128 * 1024, 1024, P.WukvT + (size_t)l * 1024 * 128, 128, (r % 2) * 64, (r / 2) * 64, P.b_kv_norm_w + l * 128, tile);
  }
  conv_straight(P.p_sub_keys, P.SK, (size_t)2 * 16 * 128 * 128 / 8);
  conv_straight(P.a_w_s, P.AWS, (size_t)2 * 4 * 128 * 128 / 8);
  {
    const int lane = threadIdx.x & 63;
    const int gw = blockIdx.x * 4 + (threadIdx.x >> 6), nw = gridDim.x * 4;
    for (int r = gw; r < 65536; r += nw) {
      const int table = r >> 15, lr = r & 32767;
      const float* src = (table ? P.p_v : P.p_u) + (size_t)lr * 1024 + lane * 16;
      float4 a[4];
      float m = 0.f;
#pragma unroll
      for (int i = 0; i < 4; ++i) {
        a[i] = *reinterpret_cast<const float4*>(src + i * 4);
        m = fmaxf(m, fmaxf(fmaxf(fabsf(a[i].x), fabsf(a[i].y)), fmaxf(fabsf(a[i].z), fabsf(a[i].w))));
      }
#pragma unroll
      for (int o = 32; o > 0; o >>= 1) m = fmaxf(m, __shfl_xor(m, o));
      const float sc = fmaxf(m, 1e-30f) * (1.f / 448.f);
      const float inv = 1.f / sc;
      unsigned w[4];
#pragma unroll
      for (int i = 0; i < 4; ++i) {
        int ww = 0;
        ww = __builtin_amdgcn_cvt_pk_fp8_f32(a[i].x * inv, a[i].y * inv, ww, false);
        ww = __builtin_amdgcn_cvt_pk_fp8_f32(a[i].z * inv, a[i].w * inv, ww, true);
        w[i] = (unsigned)ww;
      }
      unsigned char* dst = (table ? P.PV8 : P.PU8) + (size_t)lr * 1024 + lane * 16;
      *reinterpret_cast<uint4*>(dst) = make_uint4(w[0], w[1], w[2], w[3]);
      if (lane == 0) (table ? P.PVS : P.PUS)[lr] = sc;
    }
  }
  for (int i = blockIdx.x * 256 + threadIdx.x; i < 2048 * 16; i += gridDim.x * 256) {
    const int t = i >> 4, a = (i >> 3) & 1, f = i & 7;
    const float inv = powf(10000.f, -(float)f / 8.f);
    const float pos = a ? (float)(t & 63) : (float)(t >> 6);
    const float ang = pos * inv;
    P.ROPE[t * 32 + a * 8 + f] = cosf(ang);
    P.ROPE[t * 32 + 16 + a * 8 + f] = sinf(ang);
  }
}

DEVI void phase_norm(const Params& P, int l, int which, int nrows) {
  const int lane = threadIdx.x & 63;
  const int gw = blockIdx.x * 4 + (threadIdx.x >> 6), nw = gridDim.x * 4;
  const float* lnw = (which == 0 ? P.ln1_w : P.ln2_w) + l * 1024;
  for (int r = gw; r < nrows; r += nw) {
    const float* src;
    if (which == 0 && l == 0) src = r < NL ? P.x + (size_t)r * 1024 : P.ctx + (size_t)(r - NL) * 1024;
    else src = P.X + (size_t)r * 1024;
    const float* mod = P.MOD + (size_t)(l * 9 + batch_of_row(r)) * 6144 + which * 3072;
    float4 v[4];
    float ss = 0.f;
#pragma unroll
    for (int i = 0; i < 4; ++i) {
      v[i] = *reinterpret_cast<const float4*>(src + i * 256 + lane * 4);
      ss += v[i].x * v[i].x + v[i].y * v[i].y + v[i].z * v[i].z + v[i].w * v[i].w;
    }
    ss = wave_sum(ss);
    const float rr = rsqrtf(ss * (1.f / 1024.f) + EPS);
#pragma unroll
    for (int i = 0; i < 4; ++i) {
      const int d = i * 256 + lane * 4;
      const float4 w = *reinterpret_cast<const float4*>(lnw + d);
      const float4 sh = *reinterpret_cast<const float4*>(mod + d);
      const float4 sc = *reinterpret_cast<const float4*>(mod + 1024 + d);
      const float o0 = v[i].x * rr * w.x * (1.f + sc.x) + sh.x;
      const float o1 = v[i].y * rr * w.y * (1.f + sc.y) + sh.y;
      const float o2 = v[i].z * rr * w.z * (1.f + sc.z) + sh.z;
      const float o3 = v[i].w * rr * w.w * (1.f + sc.w) + sh.w;
      uint2 o; o.x = pack2(o0, o1); o.y = pack2(o2, o3);
      *reinterpret_cast<uint2*>(P.H + (size_t)r * 1024 + d) = o;
    }
  }
}

template <int BM, int BN, int BK, int WM, int WN>
struct Gemm {
  static constexpr int LDK = BK + 8;
  static constexpr int TM = BM / WM / 32, TN = BN / WN / 32;
  static constexpr int CPR = BK / 8;
  static constexpr int NA = BM * CPR / 256, NB = BN * CPR / 256;
  static constexpr int A_BYTES = BM * LDK * 2, B_BYTES = BN * LDK * 2;
  static constexpr int STAGE_BYTES = A_BYTES + B_BYTES;
  static constexpr int SMEM = 2 * STAGE_BYTES;

  static DEVI void run(const bf16* __restrict__ A, int lda, const bf16* __restrict__ BT, int ldb, int K,
                       unsigned char* smem, f32x16 (&acc)[TM][TN]) {
    const int tid = threadIdx.x, lane = tid & 63, wave = tid >> 6;
    const int wm = wave / WN, wn = wave % WN;
    const int l31 = lane & 31, hh = lane >> 5;
#pragma unroll
    for (int i = 0; i < TM; ++i)
#pragma unroll
      for (int j = 0; j < TN; ++j) acc[i][j] = zero16();
    uint4 ra[NA], rb[NB];
    const int nk = K / BK;
    auto gload = [&](int kt) {
#pragma unroll
      for (int i = 0; i < NA; ++i) { const int ch = tid + i * 256, row = ch / CPR, cc = ch % CPR;
        ra[i] = *reinterpret_cast<const uint4*>(A + (size_t)row * lda + kt * BK + cc * 8); }
#pragma unroll
      for (int i = 0; i < NB; ++i) { const int ch = tid + i * 256, row = ch / CPR, cc = ch % CPR;
        rb[i] = *reinterpret_cast<const uint4*>(BT + (size_t)row * ldb + kt * BK + cc * 8); }
    };
    auto swrite = [&](int buf) {
      bf16* sA = reinterpret_cast<bf16*>(smem + buf * STAGE_BYTES);
      bf16* sB = reinterpret_cast<bf16*>(smem + buf * STAGE_BYTES + A_BYTES);
#pragma unroll
      for (int i = 0; i < NA; ++i) { const int ch = tid + i * 256, row = ch / CPR, cc = ch % CPR;
        *reinterpret_cast<uint4*>(sA + row * LDK + cc * 8) = ra[i]; }
#pragma unroll
      for (int i = 0; i < NB; ++i) { const int ch = tid + i * 256, row = ch / CPR, cc = ch % CPR;
        *reinterpret_cast<uint4*>(sB + row * LDK + cc * 8) = rb[i]; }
    };
    __syncthreads();
    gload(0);
    swrite(0);
    __syncthreads();
    for (int kt = 0; kt < nk; ++kt) {
      const int cur = kt & 1;
      if (kt + 1 < nk) gload(kt + 1);
      const bf16* sA = reinterpret_cast<const bf16*>(smem + cur * STAGE_BYTES);
      const bf16* sB = reinterpret_cast<const bf16*>(smem + cur * STAGE_BYTES + A_BYTES);
#pragma unroll
      for (int ks = 0; ks < BK / 16; ++ks) {
        bf16x8 af[TM], bfr[TN];
#pragma unroll
        for (int i = 0; i < TM; ++i) af[i] = ldfrag(sA + (wm * (BM / WM) + i * 32 + l31) * LDK + ks * 16 + hh * 8);
#pragma unroll
        for (int j = 0; j < TN; ++j) bfr[j] = ldfrag(sB + (wn * (BN / WN) + j * 32 + l31) * LDK + ks * 16 + hh * 8);
#pragma unroll
        for (int i = 0; i < TM; ++i)
#pragma unroll
          for (int j = 0; j < TN; ++j) acc[i][j] = mfma32(af[i], bfr[j], acc[i][j]);
      }
      if (kt + 1 < nk) swrite(cur ^ 1);
      __syncthreads();
    }
  }
};

DEVI void phase_gemm1(const Params& P, int l, unsigned char* smem) {
  using G = Gemm<128, 128, 64, 2, 2>;
  const int lane = threadIdx.x & 63, wave = threadIdx.x >> 6, wm = wave >> 1, wn = wave & 1, l31 = lane & 31, hh = lane >> 5;
  const bf16* W = P.WinT + (size_t)l * DINP * 1024;
  for (int t = blockIdx.x; t < 144 * 18; t += gridDim.x) {
    const int mt = t / 18, nt = t % 18;
    f32x16 acc[2][2];
    G::run(P.H + (size_t)mt * 128 * 1024, 1024, W + (size_t)nt * 128 * 1024, 1024, 1024, smem, acc);
#pragma unroll
    for (int i = 0; i < 2; ++i)
#pragma unroll
      for (int j = 0; j < 2; ++j) {
        const int col = nt * 128 + wn * 64 + j * 32 + l31;
        if (col < DIN) {
#pragma unroll
          for (int r = 0; r < 16; ++r) {
            const int row = mt * 128 + wm * 64 + i * 32 + drow(r, hh);
            P.Z[(size_t)row * DIN + col] = f2bf(acc[i][j][r]);
          }
        }
      }
  }
}

DEVI void phase_gemm2(const Params& P, int l, unsigned char* smem) {
  using G = Gemm<128, 128, 64, 2, 2>;
  const int lane = threadIdx.x & 63, wave = threadIdx.x >> 6, wm = wave >> 1, wn = wave & 1, l31 = lane & 31, hh = lane >> 5;
  const bf16* W = P.WoutT + (size_t)l * 1024 * 1024;
  const int mtiles = (l == 1) ? 128 : 144;
  for (int t = blockIdx.x; t < mtiles * 8; t += gridDim.x) {
    const int mt = t / 8, nt = t % 8;
    f32x16 acc[2][2];
    G::run(P.H + (size_t)mt * 128 * 1024, 1024, W + (size_t)nt * 128 * 1024, 1024, 1024, smem, acc);
    const int bi = batch_of_row(mt * 128);
    const float* gate = P.MOD + (size_t)(l * 9 + bi) * 6144 + 2048;
#pragma unroll
    for (int i = 0; i < 2; ++i)
#pragma unroll
      for (int j = 0; j < 2; ++j) {
        const int col = nt * 128 + wn * 64 + j * 32 + l31;
        const float g = gate[col];
#pragma unroll
        for (int r = 0; r < 16; ++r) {
          const int row = mt * 128 + wm * 64 + i * 32 + drow(r, hh);
          float res;
          if (l == 0) res = row < NL ? P.x[(size_t)row * 1024 + col] : P.ctx[(size_t)(row - NL) * 1024 + col];
          else res = P.X[(size_t)row * 1024 + col];
          P.X[(size_t)row * 1024 + col] = res + g * acc[i][j][r];
        }
      }
  }
}

DEVI void phase_mixA(const Params& P, int l, unsigned char* smem) {
  const int tid = threadIdx.x, lane = tid & 63, wave = tid >> 6, l31 = lane & 31, hh = lane >> 5;
  bf16* VNT = reinterpret_cast<bf16*>(smem);
  constexpr int LDV = 136;
  const int nseg = (l == 1) ? 16 : 18;
  const int seg0 = (l == 1) ? 2 : 0;
  for (int it = blockIdx.x; it < 8 * nseg * 4; it += gridDim.x) {
    const int a = it & 3; const int sj = (it >> 2) % nseg + seg0; const int b = (it >> 2) / nseg;
    const int p0 = sj * 128;
    __syncthreads();
    {
      const int q = tid >> 1, half = tid & 1;
      const int row = row_of(b, p0 + q);
      const bf16* src = P.Z + (size_t)row * DIN + ZC_AV + a * 64 + half * 32;
      float v[32];
      float ss = 0.f;
#pragma unroll
      for (int i = 0; i < 4; ++i) {
        const uint4 u = *reinterpret_cast<const uint4*>(src + i * 8);
        v[i * 8 + 0] = lo2f(u.x); v[i * 8 + 1] = hi2f(u.x); v[i * 8 + 2] = lo2f(u.y); v[i * 8 + 3] = hi2f(u.y);
        v[i * 8 + 4] = lo2f(u.z); v[i * 8 + 5] = hi2f(u.z); v[i * 8 + 6] = lo2f(u.w); v[i * 8 + 7] = hi2f(u.w);
      }
#pragma unroll
      for (int i = 0; i < 32; ++i) ss += v[i] * v[i];
      ss += __shfl_xor(ss, 1);
      const float rr = rsqrtf(ss * (1.f / 64.f) + EPS);
      const float* nw = P.a_norm_w + l * 256 + a * 64 + half * 32;
#pragma unroll
      for (int i = 0; i < 32; ++i) VNT[(half * 32 + i) * LDV + q] = f2bf(v[i] * rr * nw[i]);
    }
    __syncthreads();
    f32x16 acc[2]; acc[0] = zero16(); acc[1] = zero16();
    const bf16* Aw = P.AWS + (size_t)(l * 4 + a) * 128 * 128 + (size_t)(wave * 32 + l31) * 128;
#pragma unroll
    for (int ks = 0; ks < 8; ++ks) {
      const bf16x8 af = ldfrag(Aw + ks * 16 + hh * 8);
#pragma unroll
      for (int j = 0; j < 2; ++j) {
        const bf16x8 bfr = ldfrag(VNT + (j * 32 + l31) * LDV + ks * 16 + hh * 8);
        acc[j] = mfma32(af, bfr, acc[j]);
      }
    }
    const float* bs = P.a_b_s + (l * 4 + a) * 128;
#pragma unroll
    for (int j = 0; j < 2; ++j)
#pragma unroll
      for (int r = 0; r < 16; ++r) {
        const int p = wave * 32 + drow(r, hh);
        const int row = row_of(b, p0 + p);
        const int col = a * 64 + j * 32 + l31;
        const float u = bf2f(P.Z[(size_t)row * DIN + ZC_AU + col]);
        P.H[(size_t)row * 1024 + col] = f2bf(u * (acc[j][r] + bs[p]));
      }
  }
}

DEVI void mla_norm_rope_store(const Params& P, const float* T, const float* nw, bool rope, float oscale,
                              bf16* dstbase  , int pos0, int tlat0) {
  const int tid = threadIdx.x, tok = tid >> 1, half = tid & 1;
  float v[48];
  float ss = 0.f;
#pragma unroll
  for (int i = 0; i < 48; ++i) { v[i] = T[tok * 97 + half * 48 + i]; ss += v[i] * v[i]; }
  ss += __shfl_xor(ss, 1);
  const float rr = rsqrtf(ss * (1.f / 96.f) + EPS);
#pragma unroll
  for (int i = 0; i < 48; ++i) v[i] = v[i] * rr * nw[half * 48 + i];
  if (rope && half == 1) {
    const float* cs = P.ROPE + (size_t)(tlat0 + tok) * 32;
#pragma unroll
    for (int a = 0; a < 2; ++a)
#pragma unroll
      for (int f = 0; f < 8; ++f) {
        const float x1 = v[16 + a * 16 + f], x2 = v[16 + a * 16 + 8 + f];
        const float c = cs[a * 8 + f], s = cs[16 + a * 8 + f];
        v[16 + a * 16 + f] = x1 * c - x2 * s;
        v[16 + a * 16 + 8 + f] = x2 * c + x1 * s;
      }
  }
  bf16* dst = dstbase + (size_t)(pos0 + tok) * 96 + half * 48;
#pragma unroll
  for (int i = 0; i < 6; ++i) {
    uint4 o;
    o.x = pack2(v[i * 8 + 0] * oscale, v[i * 8 + 1] * oscale); o.y = pack2(v[i * 8 + 2] * oscale, v[i * 8 + 3] * oscale);
    o.z = pack2(v[i * 8 + 4] * oscale, v[i * 8 + 5] * oscale); o.w = pack2(v[i * 8 + 6] * oscale, v[i * 8 + 7] * oscale);
    *reinterpret_cast<uint4*>(dst + i * 8) = o;
  }
}

DEVI void phase_mla_proj(const Params& P, int l, unsigned char* smem) {
  const int tid = threadIdx.x, lane = tid & 63, wave = tid >> 6, l31 = lane & 31, hh = lane >> 5;
  float* T = reinterpret_cast<float*>(smem);
  float* rsq = T + 128 * 97;
  float* rskv = rsq + 128;
  const float qscale = 0.10206207261596577f * 1.4426950408889634f;
  for (int it = blockIdx.x; it < 144 * 8; it += gridDim.x) {
    const int h = it & 7;
    const int m0 = (it >> 3) * 128;
    const bool lat = m0 < NL;
    const int b = lat ? (m0 >> 11) : ((m0 - NL) >> 8);
    const int pos0 = lat ? 256 + (m0 & 2047) : ((m0 - NL) & 255);
    const int tlat0 = lat ? (m0 & 2047) : 0;
    const bool doq = lat || (l == 0);
    const bf16* zrow = P.Z + (size_t)(m0 + wave * 32 + l31) * DIN;
    __syncthreads();
    {
      float ss = 0.f;
#pragma unroll
      for (int ks = 0; ks < 8; ++ks) {
        const bf16x8 a = ldfrag(zrow + ZC_BKV + ks * 16 + hh * 8);
#pragma unroll
        for (int j = 0; j < 8; ++j) { const float f = (float)a[j]; ss += f * f; }
      }
      ss += __shfl_xor(ss, 32);
      if (hh == 0) rskv[wave * 32 + l31] = rsqrtf(ss * (1.f / 128.f) + EPS);
      if (doq) {
        float sq = 0.f;
#pragma unroll
        for (int ks = 0; ks < 16; ++ks) {
          const bf16x8 a = ldfrag(zrow + ZC_BQ + ks * 16 + hh * 8);
#pragma unroll
          for (int j = 0; j < 8; ++j) { const float f = (float)a[j]; sq += f * f; }
        }
        sq += __shfl_xor(sq, 32);
        if (hh == 0) rsq[wave * 32 + l31] = rsqrtf(sq * (1.f / 256.f) + EPS);
      }
    }
    for (int e = tid; e < 128 * 32; e += 256) {
      const int tok = e >> 5, i = e & 31;
      T[tok * 97 + 64 + i] = bf2f(P.Z[(size_t)(m0 + tok) * DIN + ZC_BKR + i]);
    }
    __syncthreads();
    {
      const bf16* Wkv = P.WukvT + (size_t)l * 1024 * 128;
      f32x16 acc[4];
#pragma unroll
      for (int j = 0; j < 4; ++j) acc[j] = zero16();
#pragma unroll 2
      for (int ks = 0; ks < 8; ++ks) {
        const bf16x8 af = ldfrag(zrow + ZC_BKV + ks * 16 + hh * 8);
#pragma unroll
        for (int j = 0; j < 4; ++j) {
          const bf16x8 bfr = ldfrag(Wkv + (size_t)(h * 128 + j * 32 + l31) * 128 + ks * 16 + hh * 8);
          acc[j] = mfma32(af, bfr, acc[j]);
        }
      }
#pragma unroll
      for (int j = 0; j < 2; ++j)
#pragma unroll
        for (int r = 0; r < 16; ++r) {
          const int tok = wave * 32 + drow(r, hh);
          T[tok * 97 + j * 32 + l31] = acc[j][r] * rskv[tok];
        }
#pragma unroll
      for (int j = 2; j < 4; ++j) {
        const int d = (j - 2) * 32 + l31;
        bf16* dst = P.VT + ((size_t)(b * 8 + h) * 64 + d) * SEQP + pos0 + wave * 32;
#pragma unroll
        for (int rg = 0; rg < 4; ++rg) {
          const int tk = 8 * rg + 4 * hh;
          uint2 o;
          o.x = pack2(acc[j][4 * rg + 0] * rskv[wave * 32 + tk + 0], acc[j][4 * rg + 1] * rskv[wave * 32 + tk + 1]);
          o.y = pack2(acc[j][4 * rg + 2] * rskv[wave * 32 + tk + 2], acc[j][4 * rg + 3] * rskv[wave * 32 + tk + 3]);
          *reinterpret_cast<uint2*>(dst + tk) = o;
        }
      }
      __syncthreads();
      mla_norm_rope_store(P, T, P.b_kh_w + l * 96, lat, 1.f, P.K + (size_t)(b * 8 + h) * SEQP * 96, pos0, tlat0);
    }
    if (doq) {
      const bf16* Wq = P.WuqT + (size_t)l * 768 * 256;
      f32x16 acc[3];
#pragma unroll
      for (int j = 0; j < 3; ++j) acc[j] = zero16();
#pragma unroll 2
      for (int ks = 0; ks < 16; ++ks) {
        const bf16x8 af = ldfrag(zrow + ZC_BQ + ks * 16 + hh * 8);
#pragma unroll
        for (int j = 0; j < 3; ++j) {
          const bf16x8 bfr = ldfrag(Wq + (size_t)(h * 96 + j * 32 + l31) * 256 + ks * 16 + hh * 8);
          acc[j] = mfma32(af, bfr, acc[j]);
        }
      }
      __syncthreads();
#pragma unroll
      for (int j = 0; j < 3; ++j)
#pragma unroll
        for (int r = 0; r < 16; ++r) {
          const int tok = wave * 32 + drow(r, hh);
          T[tok * 97 + j * 32 + l31] = acc[j][r] * rsq[tok];
        }
      __syncthreads();
      mla_norm_rope_store(P, T, P.b_qh_w + l * 96, lat, qscale, P.Q + (size_t)(b * 8 + h) * SEQP * 96, pos0, tlat0);
    }
  }
}

DEVI void hgrn_load(const Params& P, int l, int b, int hd, int c, float* BF, float* RB,
                    float (&q)[16], float (&kf)[16], float (&kb)[16], float (&v)[16], bool need_kv) {
  const int tid = threadIdx.x, t = tid >> 2, k0 = (tid & 3) * 16;
  const int row = row_of(b, c * 64 + t);
  const bf16* z = P.Z + (size_t)row * DIN + hd * 64 + k0;
  float zf[16], zb[16];
#pragma unroll
  for (int i = 0; i < 2; ++i) {
    const uint4 uq = *reinterpret_cast<const uint4*>(z + ZC_CQ + i * 8);
    const uint4 uf = *reinterpret_cast<const uint4*>(z + ZC_CFF + i * 8);
    const uint4 ub = *reinterpret_cast<const uint4*>(z + ZC_CFB + i * 8);
    q[i * 8 + 0] = lo2f(uq.x); q[i * 8 + 1] = hi2f(uq.x); q[i * 8 + 2] = lo2f(uq.y); q[i * 8 + 3] = hi2f(uq.y);
    q[i * 8 + 4] = lo2f(uq.z); q[i * 8 + 5] = hi2f(uq.z); q[i * 8 + 6] = lo2f(uq.w); q[i * 8 + 7] = hi2f(uq.w);
    zf[i * 8 + 0] = lo2f(uf.x); zf[i * 8 + 1] = hi2f(uf.x); zf[i * 8 + 2] = lo2f(uf.y); zf[i * 8 + 3] = hi2f(uf.y);
    zf[i * 8 + 4] = lo2f(uf.z); zf[i * 8 + 5] = hi2f(uf.z); zf[i * 8 + 6] = lo2f(uf.w); zf[i * 8 + 7] = hi2f(uf.w);
    zb[i * 8 + 0] = lo2f(ub.x); zb[i * 8 + 1] = hi2f(ub.x); zb[i * 8 + 2] = lo2f(ub.y); zb[i * 8 + 3] = hi2f(ub.y);
    zb[i * 8 + 4] = lo2f(ub.z); zb[i * 8 + 5] = hi2f(ub.z); zb[i * 8 + 6] = lo2f(ub.w); zb[i * 8 + 7] = hi2f(ub.w);
    if (need_kv) {
      const uint4 uv = *reinterpret_cast<const uint4*>(z + ZC_CI + i * 8);
      v[i * 8 + 0] = lo2f(uv.x); v[i * 8 + 1] = hi2f(uv.x); v[i * 8 + 2] = lo2f(uv.y); v[i * 8 + 3] = hi2f(uv.y);
      v[i * 8 + 4] = lo2f(uv.z); v[i * 8 + 5] = hi2f(uv.z); v[i * 8 + 6] = lo2f(uv.w); v[i * 8 + 7] = hi2f(uv.w);
    }
  }
#pragma unroll
  for (int i = 0; i < 16; ++i) {
    q[i] *= 0.125f;
    float lbf = 0.f, lbb = 0.f;
    if (l == 1) {
      const int ch = hd * 64 + k0 + i;
      lbf = sigmoidf_(P.c_lb[512 + ch] - P.c_lb[ch]);
      lbb = sigmoidf_(P.c_lb[512 + 256 + ch] - P.c_lb[256 + ch]);
    }
    {
      const float zz = zf[i];
      const float sg = sigmoidf_(zz);
      const float lsig = fminf(zz, 0.f) - log1pf(__expf(-fabsf(zz)));
      const float f = lbf + (1.f - lbf) * sg;
      const float lf = (l == 0) ? lsig : __logf(f);
      kf[i] = (1.f - lbf) * sigmoidf_(-zz);
      BF[t * 65 + k0 + i] = lf;
    }
    {
      const float zz = zb[i];
      const float sg = sigmoidf_(zz);
      const float lsig = fminf(zz, 0.f) - log1pf(__expf(-fabsf(zz)));
      const float f = lbb + (1.f - lbb) * sg;
      const float lf = (l == 0) ? lsig : __logf(f);
      kb[i] = (1.f - lbb) * sigmoidf_(-zz);
      RB[t * 65 + k0 + i] = lf;
    }
  }
  __syncthreads();
  if (tid < 64) {
    float s = 0.f;
    for (int tt = 0; tt < 64; ++tt) { s += BF[tt * 65 + tid]; BF[tt * 65 + tid] = s; }
  } else if (tid < 128) {
    const int k = tid - 64;
    float s = 0.f;
    for (int tt = 63; tt >= 0; --tt) { s += RB[tt * 65 + k]; RB[tt * 65 + k] = s; }
  }
  __syncthreads();
}

DEVI f32x16 lds_mm(const bf16* A, const bf16* BT, int tm, int tn, int l31, int hh) {
  f32x16 acc = zero16();
#pragma unroll
  for (int ks = 0; ks < 4; ++ks) {
    const bf16x8 a = ldfrag(A + (tm * 32 + l31) * 72 + ks * 16 + hh * 8);
    const bf16x8 b = ldfrag(BT + (tn * 32 + l31) * 72 + ks * 16 + hh * 8);
    acc = mfma32(a, b, acc);
  }
  return acc;
}

DEVI void phase_hgrn_local(const Params& P, int l, unsigned char* smem) {
  const int tid = threadIdx.x, lane = tid & 63, wave = tid >> 6, l31 = lane & 31, hh = lane >> 5;
  const int tm = wave >> 1, tn = wave & 1;
  float* BF = reinterpret_cast<float*>(smem);
  float* RB = BF + 64 * 65;
  bf16* QF = reinterpret_cast<bf16*>(smem + 33280);
  bf16* KF = QF + 64 * 72;
  bf16* QB = KF + 64 * 72;
  bf16* KB = QB + 64 * 72;
  bf16* VTt = KB + 64 * 72;
  bf16* KHF = reinterpret_cast<bf16*>(smem);
  bf16* KHB = KHF + 64 * 72;
  bf16* ATT = KHB + 64 * 72;
  for (int it = blockIdx.x; it < 8 * 4 * 36; it += gridDim.x) {
    const int c = it % 36, hd = (it / 36) & 3, b = it / 144;
    float q[16], kf[16], kb[16], v[16];
    __syncthreads();
    hgrn_load(P, l, b, hd, c, BF, RB, q, kf, kb, v, true);
    const int t = tid >> 2, k0 = (tid & 3) * 16;
    float bfv[16], rbv[16];
#pragma unroll
    for (int i = 0; i < 16; ++i) { bfv[i] = BF[t * 65 + k0 + i]; rbv[i] = RB[t * 65 + k0 + i]; }
    if (t == 0) {
      float* dec = P.DEC + ((size_t)((b * 4 + hd) * 2) * 36 + c) * 64 + k0;
#pragma unroll
      for (int i = 0; i < 16; ++i) { dec[i] = __expf(BF[63 * 65 + k0 + i]); dec[36 * 64 + i] = __expf(RB[k0 + i]); }
    }
#pragma unroll
    for (int i = 0; i < 16; i += 2) {
      const int k = k0 + i;
      const float mF0 = BF[32 * 65 + k], mF1 = BF[32 * 65 + k + 1], mB0 = RB[32 * 65 + k], mB1 = RB[32 * 65 + k + 1];
      *reinterpret_cast<unsigned*>(&QF[t * 72 + k]) = pack2(q[i] * __expf(fminf(bfv[i] - mF0, 80.f)), q[i + 1] * __expf(fminf(bfv[i + 1] - mF1, 80.f)));
      *reinterpret_cast<unsigned*>(&KF[t * 72 + k]) = pack2(kf[i] * __expf(fminf(mF0 - bfv[i], 80.f)), kf[i + 1] * __expf(fminf(mF1 - bfv[i + 1], 80.f)));
      *reinterpret_cast<unsigned*>(&QB[t * 72 + k]) = pack2(q[i] * __expf(fminf(rbv[i] - mB0, 80.f)), q[i + 1] * __expf(fminf(rbv[i + 1] - mB1, 80.f)));
      *reinterpret_cast<unsigned*>(&KB[t * 72 + k]) = pack2(kb[i] * __expf(fminf(mB0 - rbv[i], 80.f)), kb[i + 1] * __expf(fminf(mB1 - rbv[i + 1], 80.f)));
    }
#pragma unroll
    for (int i = 0; i < 16; ++i) {
      VTt[(k0 + i) * 72 + t] = f2bf(v[i]);
      kf[i] = kf[i] * __expf(BF[63 * 65 + k0 + i] - bfv[i]);
      kb[i] = kb[i] * __expf(RB[k0 + i] - rbv[i]);
    }
    __syncthreads();
#pragma unroll
    for (int i = 0; i < 16; ++i) {
      KHF[(k0 + i) * 72 + t] = f2bf(kf[i]);
      KHB[(k0 + i) * 72 + t] = f2bf(kb[i]);
    }
    __syncthreads();
    {
      const f32x16 af = lds_mm(QF, KF, tm, tn, l31, hh);
      const f32x16 ab = lds_mm(QB, KB, tm, tn, l31, hh);
      const int s = tn * 32 + l31;
#pragma unroll
      for (int r = 0; r < 16; ++r) {
        const int tt = tm * 32 + drow(r, hh);
        float a = 0.f;
        if (s <= tt) a += af[r];
        if (s >= tt) a += ab[r];
        ATT[tt * 72 + s] = f2bf(a);
      }
    }
    {
      const f32x16 lf = lds_mm(KHF, VTt, tm, tn, l31, hh);
      const f32x16 lb = lds_mm(KHB, VTt, tm, tn, l31, hh);
      float* stf = P.ST + ((size_t)((b * 4 + hd) * 2 + 0) * 36 + c) * 4096;
      float* stb = P.ST + ((size_t)((b * 4 + hd) * 2 + 1) * 36 + c) * 4096;
#pragma unroll
      for (int r = 0; r < 16; ++r) {
        const int kk = tm * 32 + drow(r, hh), d = tn * 32 + l31;
        stf[kk * 64 + d] = lf[r];
        stb[kk * 64 + d] = lb[r];
      }
    }
    __syncthreads();
    {
      const f32x16 o = lds_mm(ATT, VTt, tm, tn, l31, hh);
#pragma unroll
      for (int r = 0; r < 16; ++r) {
        const int tt = tm * 32 + drow(r, hh), d = tn * 32 + l31;
        P.OI[(size_t)row_of(b, c * 64 + tt) * 256 + hd * 64 + d] = o[r];
      }
    }
  }
}

DEVI void hgrn_scan_item(const Params& P, int item) {
  const int tid = threadIdx.x;
  const int chain = item >> 2, sl = item & 3;
  const int dir = chain & 1;
  const int k = tid >> 2, d4 = sl * 16 + (tid & 3) * 4;
  float4 S = make_float4(0.f, 0.f, 0.f, 0.f);
  float* base = P.ST + (size_t)chain * 36 * 4096 + k * 64 + d4;
  const float* dec = P.DEC + (size_t)chain * 36 * 64 + k;
#pragma unroll 4
  for (int step = 0; step < 36; ++step) {
    const int c = dir == 0 ? step : (step < 4 ? 3 - step : 39 - step);
    float4* p = reinterpret_cast<float4*>(base + (size_t)c * 4096);
    const float4 L = *p;
    const float dc = dec[c * 64];
    *p = S;
    S.x = dc * S.x + L.x; S.y = dc * S.y + L.y; S.z = dc * S.z + L.z; S.w = dc * S.w + L.w;
  }
}

DEVI void phase_hgrn_final(const Params& P, int l, unsigned char* smem) {
  const int tid = threadIdx.x, lane = tid & 63, wave = tid >> 6, l31 = lane & 31, hh = lane >> 5;
  const int tm = wave >> 1, tn = wave & 1;
  float* BF = reinterpret_cast<float*>(smem);
  float* RB = BF + 64 * 65;
  bf16* QF = reinterpret_cast<bf16*>(smem + 33280);
  bf16* QB = QF + 64 * 72;
  bf16* SF = QB + 64 * 72;
  bf16* SB = SF + 64 * 72;
  float* O = reinterpret_cast<float*>(smem);
  const int c0 = (l == 1) ? 4 : 0;
  const int nc = 36 - c0;
  for (int it = blockIdx.x; it < 8 * 4 * nc; it += gridDim.x) {
    const int c = it % nc + c0, hd = (it / nc) & 3, b = it / (nc * 4);
    float q[16], kf[16], kb[16], v[16];
    __syncthreads();
    hgrn_load(P, l, b, hd, c, BF, RB, q, kf, kb, v, false);
    const int t = tid >> 2, k0 = (tid & 3) * 16;
#pragma unroll
    for (int i = 0; i < 16; i += 2) {
      const int k = k0 + i;
      *reinterpret_cast<unsigned*>(&QF[t * 72 + k]) = pack2(q[i] * __expf(BF[t * 65 + k]), q[i + 1] * __expf(BF[t * 65 + k + 1]));
      *reinterpret_cast<unsigned*>(&QB[t * 72 + k]) = pack2(q[i] * __expf(RB[t * 65 + k]), q[i + 1] * __expf(RB[t * 65 + k + 1]));
    }
    {
      const float* stf = P.ST + ((size_t)((b * 4 + hd) * 2 + 0) * 36 + c) * 4096;
      const float* stb = P.ST + ((size_t)((b * 4 + hd) * 2 + 1) * 36 + c) * 4096;
#pragma unroll
      for (int i = 0; i < 16; i += 4) {
        const float4 a = *reinterpret_cast<const float4*>(stf + t * 64 + k0 + i);
        const float4 bb = *reinterpret_cast<const float4*>(stb + t * 64 + k0 + i);
        SF[(k0 + i + 0) * 72 + t] = f2bf(a.x); SF[(k0 + i + 1) * 72 + t] = f2bf(a.y); SF[(k0 + i + 2) * 72 + t] = f2bf(a.z); SF[(k0 + i + 3) * 72 + t] = f2bf(a.w);
        SB[(k0 + i + 0) * 72 + t] = f2bf(bb.x); SB[(k0 + i + 1) * 72 + t] = f2bf(bb.y); SB[(k0 + i + 2) * 72 + t] = f2bf(bb.z); SB[(k0 + i + 3) * 72 + t] = f2bf(bb.w);
      }
    }
    __syncthreads();
    {
      f32x16 o = lds_mm(QF, SF, tm, tn, l31, hh);
      const f32x16 o2 = lds_mm(QB, SB, tm, tn, l31, hh);
#pragma unroll
      for (int r = 0; r < 16; ++r) {
        const int tt = tm * 32 + drow(r, hh), d = tn * 32 + l31;
        O[tt * 65 + d] = o[r] + o2[r] + P.OI[(size_t)row_of(b, c * 64 + tt) * 256 + hd * 64 + d];
      }
    }
    __syncthreads();
    {
      const int row = row_of(b, c * 64 + t);
      float ov[16]; float ss = 0.f;
#pragma unroll
      for (int i = 0; i < 16; ++i) { ov[i] = O[t * 65 + k0 + i]; ss += ov[i] * ov[i]; }
      ss += __shfl_xor(ss, 1); ss += __shfl_xor(ss, 2);
      const float rr = rsqrtf(ss * (1.f / 64.f) + EPS);
      const bf16* g = P.Z + (size_t)row * DIN + ZC_CG + hd * 64 + k0;
      const float* nw = P.c_out_norm_w + l * 64 + k0;
      unsigned pk[8];
#pragma unroll
      for (int i = 0; i < 16; i += 2) {
        const float g0 = bf2f(g[i]), g1 = bf2f(g[i + 1]);
        const float y0 = ov[i] * rr * nw[i] * (g0 * sigmoidf_(g0));
        const float y1 = ov[i + 1] * rr * nw[i + 1] * (g1 * sigmoidf_(g1));
        pk[i >> 1] = pack2(y0, y1);
      }
      uint4* dst = reinterpret_cast<uint4*>(P.H + (size_t)row * 1024 + 768 + hd * 64 + k0);
      dst[0] = make_uint4(pk[0], pk[1], pk[2], pk[3]);
      dst[1] = make_uint4(pk[4], pk[5], pk[6], pk[7]);
    }
  }
}

DEVI void attn_item(const Params& P, int b, int h, int qpos0, int nkeys, unsigned char* smem) {
  const int tid = threadIdx.x, lane = tid & 63, wave = tid >> 6, l31 = lane & 31, hh = lane >> 5;
  constexpr int LDKS = 104, LDVS = 72;
  constexpr int KS_BYTES = 64 * LDKS * 2, VS_BYTES = 64 * LDVS * 2, ST_BYTES = KS_BYTES + VS_BYTES;
  const bf16* Qg = P.Q + ((size_t)(b * 8 + h) * SEQP + qpos0 + wave * 32 + l31) * 96;
  const bf16* Kg = P.K + (size_t)(b * 8 + h) * SEQP * 96;
  const bf16* Vg = P.VT + (size_t)(b * 8 + h) * 64 * SEQP;
  bf16x8 qf[6];
#pragma unroll
  for (int ks = 0; ks < 6; ++ks) qf[ks] = ldfrag(Qg + ks * 16 + hh * 8);
  f32x16 oacc[2]; oacc[0] = zero16(); oacc[1] = zero16();
  float m = -1e30f, lsum = 0.f;
  uint4 rk[3], rv[2];
  const int ntiles = nkeys / 64;
  auto gload = [&](int kt) {
#pragma unroll
    for (int i = 0; i < 3; ++i) { const int ch = tid + i * 256, row = ch / 12, cc = ch % 12;
      rk[i] = *reinterpret_cast<const uint4*>(Kg + (size_t)(kt * 64 + row) * 96 + cc * 8); }
#pragma unroll
    for (int i = 0; i < 2; ++i) { const int ch = tid + i * 256, row = ch >> 3, cc = ch & 7;
      rv[i] = *reinterpret_cast<const uint4*>(Vg + (size_t)row * SEQP + kt * 64 + cc * 8); }
  };
  auto swrite = [&](int buf) {
    bf16* sK = reinterpret_cast<bf16*>(smem + buf * ST_BYTES);
    bf16* sV = reinterpret_cast<bf16*>(smem + buf * ST_BYTES + KS_BYTES);
#pragma unroll
    for (int i = 0; i < 3; ++i) { const int ch = tid + i * 256, row = ch / 12, cc = ch % 12;
      *reinterpret_cast<uint4*>(sK + row * LDKS + cc * 8) = rk[i]; }
#pragma unroll
    for (int i = 0; i < 2; ++i) { const int ch = tid + i * 256, row = ch >> 3, cc = ch & 7;
      const int g16 = cc >> 1, odd = cc & 1;
      bf16* base = sV + row * LDVS + g16 * 16;
      const int p0 = odd * 2, p1 = odd * 2 + 1;
      const int s0 = (p0 == 1 ? 2 : (p0 == 2 ? 1 : p0)) * 4, s1 = (p1 == 1 ? 2 : (p1 == 2 ? 1 : p1)) * 4;
      *reinterpret_cast<uint2*>(base + s0) = make_uint2(rv[i].x, rv[i].y);
      *reinterpret_cast<uint2*>(base + s1) = make_uint2(rv[i].z, rv[i].w);
    }
  };
  __syncthreads();
  gload(0); swrite(0);
  __syncthreads();
  for (int kt = 0; kt < ntiles; ++kt) {
    const int cur = kt & 1;
    if (kt + 1 < ntiles) gload(kt + 1);
    const bf16* sK = reinterpret_cast<const bf16*>(smem + cur * ST_BYTES);
    const bf16* sV = reinterpret_cast<const bf16*>(smem + cur * ST_BYTES + KS_BYTES);
    f32x16 sacc[2]; sacc[0] = zero16(); sacc[1] = zero16();
#pragma unroll
    for (int kk = 0; kk < 2; ++kk)
#pragma unroll
      for (int ks = 0; ks < 6; ++ks) {
        const bf16x8 a = ldfrag(sK + (kk * 32 + l31) * LDKS + ks * 16 + hh * 8);
        sacc[kk] = mfma32(a, qf[ks], sacc[kk]);
      }
    float mx = sacc[0][0];
#pragma unroll
    for (int kk = 0; kk < 2; ++kk)
#pragma unroll
      for (int r = 0; r < 16; ++r) mx = fmaxf(mx, sacc[kk][r]);
    mx = fmaxf(mx, __shfl_xor(mx, 32));
    const float mnew = fmaxf(m, mx);
    const float alpha = __builtin_amdgcn_exp2f(m - mnew);
    m = mnew;
    float ps = 0.f;
#pragma unroll
    for (int kk = 0; kk < 2; ++kk)
#pragma unroll
      for (int r = 0; r < 16; ++r) { const float p = __builtin_amdgcn_exp2f(sacc[kk][r] - mnew); sacc[kk][r] = p; ps += p; }
    lsum = lsum * alpha + ps;
#pragma unroll
    for (int dt = 0; dt < 2; ++dt)
#pragma unroll
      for (int r = 0; r < 16; ++r) oacc[dt][r] *= alpha;
#pragma unroll
    for (int kk = 0; kk < 2; ++kk)
#pragma unroll
      for (int s = 0; s < 2; ++s) {
        bf16x8 pb;
#pragma unroll
        for (int j = 0; j < 8; ++j) pb[j] = (__bf16)sacc[kk][8 * s + j];
#pragma unroll
        for (int dt = 0; dt < 2; ++dt) {
          const bf16x8 a = ldfrag(sV + (dt * 32 + l31) * LDVS + kk * 32 + s * 16 + hh * 8);
          oacc[dt] = mfma32(a, pb, oacc[dt]);
        }
      }
    if (kt + 1 < ntiles) swrite(cur ^ 1);
    __syncthreads();
  }
  lsum += __shfl_xor(lsum, 32);
  const float inv = 1.f / lsum;
  const int row = row_of(b, qpos0 + wave * 32 + l31);
  bf16* dst = P.H + (size_t)row * 1024 + 256 + h * 64;
#pragma unroll
  for (int dt = 0; dt < 2; ++dt)
#pragma unroll
    for (int rg = 0; rg < 4; ++rg) {
      const int d = dt * 32 + 8 * rg + 4 * hh;
      uint2 o;
      o.x = pack2(oacc[dt][4 * rg + 0] * inv, oacc[dt][4 * rg + 1] * inv);
      o.y = pack2(oacc[dt][4 * rg + 2] * inv, oacc[dt][4 * rg + 3] * inv);
      *reinterpret_cast<uint2*>(dst + d) = o;
    }
}

DEVI void phase_attn_scan(const Params& P, int l, unsigned char* smem) {
  const int n_attn = (l == 0) ? 1152 : 1024;
  const int total = 256 + n_attn;
  for (int it = blockIdx.x; it < total; it += gridDim.x) {
    if (it < 256) { hgrn_scan_item(P, it); continue; }
    const int a = it - 256;
    if (a < 1024) attn_item(P, a >> 7, (a >> 4) & 7, 256 + 128 * (a & 15), 2304, smem);
    else { const int a2 = a - 1024; attn_item(P, a2 >> 4, (a2 >> 1) & 7, 128 * (a2 & 1), 256, smem); }
  }
}

DEVI unsigned ordkey(float s) { const unsigned u = __float_as_uint(s); return (u & 0x80000000u) ? ~u : (u | 0x80000000u); }
DEVI float keyval(unsigned k, unsigned mask) { const unsigned u = k & ~mask; return __uint_as_float((u & 0x80000000u) ? (u & 0x7fffffffu) : ~u); }
DEVI void ins16(unsigned (&lst)[16], unsigned v) {
#pragma unroll
  for (int j = 0; j < 16; ++j) { const unsigned hi = max(lst[j], v); v = min(lst[j], v); lst[j] = hi; }
}
DEVI void merge16(unsigned (&lst)[16], int xm) {
  unsigned o[16];
#pragma unroll
  for (int j = 0; j < 16; ++j) o[j] = (unsigned)__shfl_xor((int)lst[j], xm);
#pragma unroll
  for (int j = 0; j < 16; ++j) lst[j] = max(lst[j], o[15 - j]);
#pragma unroll
  for (int d = 8; d >= 1; d >>= 1)
#pragma unroll
    for (int j = 0; j < 16; ++j)
      if ((j & d) == 0) { const unsigned a = lst[j], bb = lst[j + d]; lst[j] = max(a, bb); lst[j + d] = min(a, bb); }
}

DEVI void phase_route(const Params& P, int l, unsigned char* smem) {
  using G = Gemm<64, 256, 32, 1, 4>;
  const int tid = threadIdx.x, lane = tid & 63, wave = tid >> 6, l31 = lane & 31, hh = lane >> 5;
  bf16* QT = reinterpret_cast<bf16*>(smem);
  float* SC = reinterpret_cast<float*>(smem + 33792);
  const int mtiles = (l == 1) ? 256 : 288;
  const bf16* W = P.WpqT + (size_t)l * 2048 * 1024;
  for (int it = blockIdx.x; it < mtiles * 8; it += gridDim.x) {
    const int mt = it >> 3, h = it & 7;
    f32x16 acc[2][2];
    G::run(P.H + (size_t)mt * 64 * 1024, 1024, W + (size_t)h * 256 * 1024, 1024, 1024, smem, acc);
#pragma unroll
    for (int i = 0; i < 2; ++i)
#pragma unroll
      for (int j = 0; j < 2; ++j)
#pragma unroll
        for (int r = 0; r < 16; ++r)
          QT[(i * 32 + drow(r, hh)) * 264 + wave * 64 + j * 32 + l31] = f2bf(acc[i][j][r]);
    __syncthreads();
    unsigned lst[2][16];
    const int row = tid >> 2, part = tid & 3;
#pragma unroll
    for (int p = 0; p < 2; ++p) {
      f32x16 sa[2]; sa[0] = zero16(); sa[1] = zero16();
      const bf16* keys = P.SK + ((size_t)(l * 16 + h * 2 + p) * 128 + wave * 32 + l31) * 128;
#pragma unroll
      for (int ks = 0; ks < 8; ++ks) {
        const bf16x8 bfr = ldfrag(keys + ks * 16 + hh * 8);
#pragma unroll
        for (int i = 0; i < 2; ++i) {
          const bf16x8 af = ldfrag(QT + (i * 32 + l31) * 264 + p * 128 + ks * 16 + hh * 8);
          sa[i] = mfma32(af, bfr, sa[i]);
        }
      }
      if (p == 1) __syncthreads();
#pragma unroll
      for (int i = 0; i < 2; ++i)
#pragma unroll
        for (int r = 0; r < 16; ++r) SC[(i * 32 + drow(r, hh)) * 129 + wave * 32 + l31] = sa[i][r];
      __syncthreads();
#pragma unroll
      for (int j = 0; j < 16; ++j) lst[p][j] = 0u;
      for (int i = 0; i < 32; ++i) {
        const int idx = part * 32 + ((i + part * 8) & 31);
        const float s = SC[row * 129 + idx];
        const unsigned key = (ordkey(s) & ~0x7fu) | (unsigned)(127 - idx);
        ins16(lst[p], key);
      }
      merge16(lst[p], 1);
      merge16(lst[p], 2);
    }
    float v0[16], v1[16];
#pragma unroll
    for (int j = 0; j < 16; ++j) { v0[j] = keyval(lst[0][j], 0x7fu); v1[j] = keyval(lst[1][j], 0x7fu); }
    unsigned best[16];
#pragma unroll
    for (int j = 0; j < 16; ++j) best[j] = 0u;
#pragma unroll
    for (int a = 0; a < 16; ++a)
#pragma unroll
      for (int bq = 0; bq < 16; ++bq)
        if ((a + 1) * (bq + 1) <= 16) {
          const float sum = v0[a] + v1[bq];
          const unsigned key = (ordkey(sum) & ~0xffu) | (unsigned)(255 - (a * 16 + bq));
          ins16(best, key);
        }
    if (part == 0) {
      const float mx = keyval(best[0], 0xffu);
      float e[16]; float es = 0.f;
#pragma unroll
      for (int j = 0; j < 16; ++j) { e[j] = __expf(keyval(best[j], 0xffu) - mx); es += e[j]; }
      const float inv = 1.f / es;
      const int tok = mt * 64 + row;
      int* ed = P.EIDX + (size_t)tok * 128 + h * 16;
      float* gd = P.GATE + (size_t)tok * 128 + h * 16;
#pragma unroll
      for (int j = 0; j < 16; ++j) {
        const int flat = 255 - (int)(best[j] & 0xffu);
        const int a = flat >> 4, bq = flat & 15;
        int i1 = 0, i2 = 0;
#pragma unroll
        for (int u = 0; u < 16; ++u) {
          i1 = (a == u) ? (127 - (int)(lst[0][u] & 0x7fu)) : i1;
          i2 = (bq == u) ? (127 - (int)(lst[1][u] & 0x7fu)) : i2;
        }
        ed[j] = i1 * 128 + i2;
        gd[j] = e[j] * inv;
      }
    }
    __syncthreads();
  }
}

DEVI float gelu_exact(float a) { return 0.5f * a * (1.f + erff(a * 0.70710678118654752f)); }

typedef float f2 __attribute__((ext_vector_type(2)));
DEVI void phase_peer(const Params& P, int l) {
  const int lane = threadIdx.x & 63;
  const int gw = blockIdx.x * 4 + (threadIdx.x >> 6), nw = gridDim.x * 4;
  const int nrows = (l == 1) ? NL : NT;
  const unsigned char* PU = P.PU8 + (size_t)l * 16384 * 1024 + lane * 16;
  const unsigned char* PV = P.PV8 + (size_t)l * 16384 * 1024 + lane * 16;
  const float* PUS = P.PUS + l * 16384;
  const float* PVS = P.PVS + l * 16384;
  const bool b5 = lane & 32, b4 = lane & 16, b3 = lane & 8, b2 = lane & 4;
  for (int t = gw; t < nrows; t += nw) {
    const uint4 hA = *reinterpret_cast<const uint4*>(P.H + (size_t)t * 1024 + lane * 16);
    const uint4 hB = *reinterpret_cast<const uint4*>(P.H + (size_t)t * 1024 + lane * 16 + 8);
    const int e0 = P.EIDX[(size_t)t * 128 + lane], e1 = P.EIDX[(size_t)t * 128 + 64 + lane];
    const float g0 = P.GATE[(size_t)t * 128 + lane], g1 = P.GATE[(size_t)t * 128 + 64 + lane];
    const float su0 = PUS[e0], su1 = PUS[e1];
    const float gv0 = g0 * PVS[e0], gv1 = g1 * PVS[e1];
    f2 h2[8];
    h2[0] = (f2){lo2f(hA.x), hi2f(hA.x)}; h2[1] = (f2){lo2f(hA.y), hi2f(hA.y)}; h2[2] = (f2){lo2f(hA.z), hi2f(hA.z)}; h2[3] = (f2){lo2f(hA.w), hi2f(hA.w)};
    h2[4] = (f2){lo2f(hB.x), hi2f(hB.x)}; h2[5] = (f2){lo2f(hB.y), hi2f(hB.y)}; h2[6] = (f2){lo2f(hB.z), hi2f(hB.z)}; h2[7] = (f2){lo2f(hB.w), hi2f(hB.w)};
    f2 y2[8];
#pragma unroll
    for (int i = 0; i < 8; ++i) y2[i] = (f2){0.f, 0.f};
    for (int kb = 0; kb < 8; ++kb) {
      const int esrc = kb < 4 ? e0 : e1;
      uint4 u[16], v[16];
#pragma unroll
      for (int i = 0; i < 16; ++i) {
        const int e = __shfl(esrc, (kb * 16 + i) & 63);
        u[i] = *reinterpret_cast<const uint4*>(PU + (size_t)e * 1024);
        v[i] = *reinterpret_cast<const uint4*>(PV + (size_t)e * 1024);
      }
      float d[16];
#pragma unroll
      for (int i = 0; i < 16; ++i) {
        f2 sacc = (f2){0.f, 0.f};
        sacc = __builtin_elementwise_fma(__builtin_amdgcn_cvt_pk_f32_fp8(u[i].x, false), h2[0], sacc);
        sacc = __builtin_elementwise_fma(__builtin_amdgcn_cvt_pk_f32_fp8(u[i].x, true), h2[1], sacc);
        sacc = __builtin_elementwise_fma(__builtin_amdgcn_cvt_pk_f32_fp8(u[i].y, false), h2[2], sacc);
        sacc = __builtin_elementwise_fma(__builtin_amdgcn_cvt_pk_f32_fp8(u[i].y, true), h2[3], sacc);
        sacc = __builtin_elementwise_fma(__builtin_amdgcn_cvt_pk_f32_fp8(u[i].z, false), h2[4], sacc);
        sacc = __builtin_elementwise_fma(__builtin_amdgcn_cvt_pk_f32_fp8(u[i].z, true), h2[5], sacc);
        sacc = __builtin_elementwise_fma(__builtin_amdgcn_cvt_pk_f32_fp8(u[i].w, false), h2[6], sacc);
        sacc = __builtin_elementwise_fma(__builtin_amdgcn_cvt_pk_f32_fp8(u[i].w, true), h2[7], sacc);
        d[i] = sacc.x + sacc.y;
      }
      float r8[8], r4[4], r2[2], r1;
#pragma unroll
      for (int i = 0; i < 8; ++i) { const float mine = b5 ? d[8 + i] : d[i]; const float send = b5 ? d[i] : d[8 + i]; r8[i] = mine + __shfl_xor(send, 32); }
#pragma unroll
      for (int i = 0; i < 4; ++i) { const float mine = b4 ? r8[4 + i] : r8[i]; const float send = b4 ? r8[i] : r8[4 + i]; r4[i] = mine + __shfl_xor(send, 16); }
#pragma unroll
      for (int i = 0; i < 2; ++i) { const float mine = b3 ? r4[2 + i] : r4[i]; const float send = b3 ? r4[i] : r4[2 + i]; r2[i] = mine + __shfl_xor(send, 8); }
      { const float mine = b2 ? r2[1] : r2[0]; const float send = b2 ? r2[0] : r2[1]; r1 = mine + __shfl_xor(send, 4); }
      r1 += __shfl_xor(r1, 2); r1 += __shfl_xor(r1, 1);
      const int src = (kb * 16 + (lane >> 2)) & 63;
      const float su = __shfl(kb < 4 ? su0 : su1, src);
      const float gv = __shfl(kb < 4 ? gv0 : gv1, src);
      const float w = gv * gelu_exact(r1 * su);
#pragma unroll
      for (int i = 0; i < 16; ++i) {
        const float wi = __shfl(w, i * 4);
        const f2 ww = (f2){wi, wi};
        y2[0] = __builtin_elementwise_fma(ww, __builtin_amdgcn_cvt_pk_f32_fp8(v[i].x, false), y2[0]);
        y2[1] = __builtin_elementwise_fma(ww, __builtin_amdgcn_cvt_pk_f32_fp8(v[i].x, true), y2[1]);
        y2[2] = __builtin_elementwise_fma(ww, __builtin_amdgcn_cvt_pk_f32_fp8(v[i].y, false), y2[2]);
        y2[3] = __builtin_elementwise_fma(ww, __builtin_amdgcn_cvt_pk_f32_fp8(v[i].y, true), y2[3]);
        y2[4] = __builtin_elementwise_fma(ww, __builtin_amdgcn_cvt_pk_f32_fp8(v[i].z, false), y2[4]);
        y2[5] = __builtin_elementwise_fma(ww, __builtin_amdgcn_cvt_pk_f32_fp8(v[i].z, true), y2[5]);
        y2[6] = __builtin_elementwise_fma(ww, __builtin_amdgcn_cvt_pk_f32_fp8(v[i].w, false), y2[6]);
        y2[7] = __builtin_elementwise_fma(ww, __builtin_amdgcn_cvt_pk_f32_fp8(v[i].w, true), y2[7]);
      }
    }
    float y[16];
#pragma unroll
    for (int i = 0; i < 8; ++i) { y[2 * i] = y2[i].x; y[2 * i + 1] = y2[i].y; }
    const int bi = batch_of_row(t);
    const float* gate2 = P.MOD + (size_t)(l * 9 + bi) * 6144 + 5 * 1024;
    float xn[16];
    float ss = 0.f;
#pragma unroll
    for (int q4 = 0; q4 < 4; ++q4) {
      const int d = lane * 16 + q4 * 4;
      const float4 xo = *reinterpret_cast<const float4*>(P.X + (size_t)t * 1024 + d);
      const float4 gg = *reinterpret_cast<const float4*>(gate2 + d);
      float4 o;
      o.x = xo.x + gg.x * y[q4 * 4 + 0]; o.y = xo.y + gg.y * y[q4 * 4 + 1];
      o.z = xo.z + gg.z * y[q4 * 4 + 2]; o.w = xo.w + gg.w * y[q4 * 4 + 3];
      xn[q4 * 4 + 0] = o.x; xn[q4 * 4 + 1] = o.y; xn[q4 * 4 + 2] = o.z; xn[q4 * 4 + 3] = o.w;
      ss += o.x * o.x + o.y * o.y + o.z * o.z + o.w * o.w;
      if (l == 1) *reinterpret_cast<float4*>(P.out + (size_t)t * 1024 + d) = o;
      else *reinterpret_cast<float4*>(P.X + (size_t)t * 1024 + d) = o;
    }
    if (l == 0) {
      ss = wave_sum(ss);
      const float rr = rsqrtf(ss * (1.f / 1024.f) + EPS);
      const float* lnw = P.ln1_w + 1024;
      const float* mod = P.MOD + (size_t)(9 + bi) * 6144;
      const int d = lane * 16;
      unsigned pk[8];
#pragma unroll
      for (int i = 0; i < 16; i += 2) {
        const float o0 = xn[i] * rr * lnw[d + i] * (1.f + mod[1024 + d + i]) + mod[d + i];
        const float o1 = xn[i + 1] * rr * lnw[d + i + 1] * (1.f + mod[1024 + d + i + 1]) + mod[d + i + 1];
        pk[i >> 1] = pack2(o0, o1);
      }
      *reinterpret_cast<uint4*>(P.H + (size_t)t * 1024 + d) = make_uint4(pk[0], pk[1], pk[2], pk[3]);
      *reinterpret_cast<uint4*>(P.H + (size_t)t * 1024 + d + 8) = make_uint4(pk[4], pk[5], pk[6], pk[7]);
    }
  }
}

constexpr int N_PHASES = 2 + 2 * 8;

#ifndef REP_MASK
#define REP_MASK 0
#endif
__global__ void __launch_bounds__(256, 2) fwd_kernel(Params P) {
  extern __shared__ __attribute__((aligned(16))) unsigned char smem[];
  cg::grid_group grid = cg::this_grid();
  volatile LAS unsigned* xst = (volatile LAS unsigned*)(smem + SMEM_BYTES);
  if (threadIdx.x == 0) { xst[0] = 0u; xst[1] = 0u; xst[2] = 0u; xst[3] = 0u; }
  __syncthreads();
  XcdBarrier xb = xcd_barrier_post(P.bar, xst);
#define GSYNC(idx) { if ((idx) == 0) grid.sync(); else xcd_barrier(xb); }
#define RUN_PHASE(idx, call) \
  if (P.phase_lo <= (idx) && (idx) <= P.phase_hi) { call; if (REP_MASK & (1 << (idx))) { GSYNC(1); call; } if (P.coop && (idx) < P.phase_hi) GSYNC(idx); }
  RUN_PHASE(0, phase_prologue(P, smem))
  RUN_PHASE(1, phase_norm(P, 0, 0, NT))
  RUN_PHASE(2, phase_gemm1(P, 0, smem))
  RUN_PHASE(3, { phase_mixA(P, 0, smem); phase_mla_proj(P, 0, smem); phase_hgrn_local(P, 0, smem); })
  RUN_PHASE(4, phase_attn_scan(P, 0, smem))
  RUN_PHASE(5, phase_hgrn_final(P, 0, smem))
  RUN_PHASE(6, phase_gemm2(P, 0, smem))
  RUN_PHASE(7, phase_norm(P, 0, 1, NT))
  RUN_PHASE(8, phase_route(P, 0, smem))
  RUN_PHASE(9, phase_peer(P, 0))
  RUN_PHASE(10, phase_gemm1(P, 1, smem))
  RUN_PHASE(11, { phase_mixA(P, 1, smem); phase_mla_proj(P, 1, smem); phase_hgrn_local(P, 1, smem); })
  RUN_PHASE(12, phase_attn_scan(P, 1, smem))
  RUN_PHASE(13, phase_hgrn_final(P, 1, smem))
  RUN_PHASE(14, phase_gemm2(P, 1, smem))
  RUN_PHASE(15, phase_norm(P, 1, 1, NL))
  RUN_PHASE(16, phase_route(P, 1, smem))
  RUN_PHASE(17, phase_peer(P, 1))
}

extern "C" void kernel_launch(void* const* d_in, const int* in_sizes, int n_in, void* d_out, int out_size, void* d_ws,
                              size_t ws_size, hipStream_t stream) {
  Params p{};
  const float* const* in = reinterpret_cast<const float* const*>(d_in);
  p.x = in[0]; p.c = in[1]; p.ctx = in[2]; p.c_ctx = in[3]; p.ln1_w = in[4]; p.ln2_w = in[5]; p.w_mod = in[6]; p.b_mod = in[7];
  p.w_in = in[8]; p.w_out = in[9]; p.a_norm_w = in[10]; p.a_w_s = in[11]; p.a_b_s = in[12]; p.b_q_norm_w = in[13]; p.b_w_uq = in[14];
  p.b_kv_norm_w = in[15]; p.b_w_ukv = in[16]; p.b_qh_w = in[17]; p.b_kh_w = in[18]; p.c_lb = in[19]; p.c_out_norm_w = in[20];
  p.p_w_q = in[21]; p.p_sub_keys = in[22]; p.p_u = in[23]; p.p_v = in[24];
  p.out = reinterpret_cast<float*>(d_out);
  unsigned char* ws = reinterpret_cast<unsigned char*>(d_ws);
  size_t off = 0;
  auto take = [&](size_t bytes) { unsigned char* r = ws + off; off += (bytes + 255) & ~(size_t)255; return r; };
  p.bar = (unsigned*)take((size_t)XCD_BAR_WORDS * 4);
  p.MOD = (float*)take((size_t)2 * 9 * 6144 * 4);
  p.ROPE = (float*)take((size_t)2048 * 32 * 4);
  p.WinT = (bf16*)take((size_t)2 * DINP * 1024 * 2);
  p.WoutT = (bf16*)take((size_t)2 * 1024 * 1024 * 2);
  p.WpqT = (bf16*)take((size_t)2 * 2048 * 1024 * 2);
  p.WuqT = (bf16*)take((size_t)2 * 768 * 256 * 2);
  p.WukvT = (bf16*)take((size_t)2 * 1024 * 128 * 2);
  p.SK = (bf16*)take((size_t)2 * 16 * 128 * 128 * 2);
  p.AWS = (bf16*)take((size_t)2 * 4 * 128 * 128 * 2);
  p.PU8 = (unsigned char*)take((size_t)2 * 16384 * 1024);
  p.PV8 = (unsigned char*)take((size_t)2 * 16384 * 1024);
  p.PUS = (float*)take((size_t)2 * 16384 * 4);
  p.PVS = (float*)take((size_t)2 * 16384 * 4);
  p.X = (float*)take((size_t)NT * 1024 * 4);
  p.H = (bf16*)take((size_t)NT * 1024 * 2);
  p.Z = (bf16*)take((size_t)NT * DIN * 2);
  p.Q = (bf16*)take((size_t)64 * SEQP * 96 * 2);
  p.K = (bf16*)take((size_t)64 * SEQP * 96 * 2);
  p.VT = (bf16*)take((size_t)64 * 64 * SEQP * 2);
  p.ST = (float*)take((size_t)64 * 36 * 4096 * 4);
  p.DEC = (float*)take((size_t)64 * 36 * 64 * 4);
  p.OI = (float*)take((size_t)NT * 256 * 4);
  p.EIDX = (int*)p.Z;
  p.GATE = (float*)((unsigned char*)p.Z + (size_t)NT * 128 * 4);
  if (off > ws_size) { fprintf(stderr, "workspace too small: need %zu have %zu\n", off, ws_size); }
  static int grid_blocks = 0;
  if (!grid_blocks) {
    if (hipFuncSetAttribute((const void*)fwd_kernel, hipFuncAttributeMaxDynamicSharedMemorySize, SMEM_TOTAL) != hipSuccess)
      fprintf(stderr, "hipFuncSetAttribute failed\n");
    int dev = 0, cus = 0, per_cu = 0;
    hipGetDevice(&dev);
    hipDeviceGetAttribute(&cus, hipDeviceAttributeMultiprocessorCount, dev);
    hipOccupancyMaxActiveBlocksPerMultiprocessor(&per_cu, (const void*)fwd_kernel, 256, SMEM_TOTAL);
    if (per_cu > 2) per_cu = 2;
    if (per_cu < 1) { fprintf(stderr, "occupancy query returned %d\n", per_cu); per_cu = 1; }
    grid_blocks = cus * per_cu;
    fprintf(stderr, "grid_blocks=%d (cus=%d per_cu=%d) ws need=%zu have=%zu\n", grid_blocks, cus, per_cu, off, ws_size);
  }
  hipMemsetAsync(p.bar, 0, (size_t)XCD_BAR_WORDS * 4, stream);
  p.coop = 1; p.phase_lo = 0; p.phase_hi = N_PHASES - 1;
  void* args[] = {&p};
  const hipError_t e = hipLaunchCooperativeKernel((const void*)fwd_kernel, dim3(grid_blocks), dim3(256), args, SMEM_TOTAL, stream);
  if (e != hipSuccess) fprintf(stderr, "cooperative launch failed: %s (grid %d)\n", hipGetErrorString(e), grid_blocks);
}
```

```cpp
#include <hip/hip_runtime.h>
#include <hip/hip_cooperative_groups.h>
#include <cstdio>
#include <cstdint>
namespace cg = cooperative_groups;

#define DEVI __device__ __forceinline__

typedef unsigned short bf16;
using bf16x8 = __attribute__((ext_vector_type(8))) __bf16;
using bf16x2 = __attribute__((ext_vector_type(2))) __bf16;
using f32x16 = __attribute__((ext_vector_type(16))) float;

constexpr int NL = 16384;
constexpr int NT = 18432;
constexpr int DM = 1024;
constexpr int DIN = 2208;
constexpr int DINP = 2304;
constexpr int SEQP = 2304;
constexpr float EPS = 1e-6f;
constexpr int ZC_AU = 0, ZC_AV = 256, ZC_BQ = 512, ZC_BKV = 768, ZC_BKR = 896, ZC_CQ = 928, ZC_CFF = 1184, ZC_CFB = 1440, ZC_CI = 1696, ZC_CG = 1952;
constexpr int SMEM_BYTES = 2 * 80896;
constexpr int SMEM_TOTAL = SMEM_BYTES + 16;

struct Params {
  const float *x, *c, *ctx, *c_ctx, *ln1_w, *ln2_w, *w_mod, *b_mod, *w_in, *w_out, *a_norm_w, *a_w_s, *a_b_s;
  const float *b_q_norm_w, *b_w_uq, *b_kv_norm_w, *b_w_ukv, *b_qh_w, *b_kh_w, *c_lb, *c_out_norm_w, *p_w_q, *p_sub_keys, *p_u, *p_v;
  float* out;
  unsigned* bar;
  float* MOD;
  float* ROPE;
  bf16* WinT;
  bf16* WoutT;
  bf16* WpqT;
  bf16* WuqT;
  bf16* WukvT;
  bf16* SK;
  bf16* AWS;
  unsigned char* PU8;
  unsigned char* PV8;
  float* PUS;
  float* PVS;
  float* X;
  bf16* H;
  bf16* Z;
  bf16* Q;
  bf16* K;
  bf16* VT;
  float* ST;
  float* DEC;
  float* OI;
  bf16* QP;
  int* EIDX;
  float* GATE;
  int phase_lo, phase_hi, coop, pad0;
};

DEVI float bf2f(bf16 v) { return __uint_as_float(((unsigned)v) << 16); }
DEVI bf16 f2bf(float a) { __bf16 v = (__bf16)a; return __builtin_bit_cast(unsigned short, v); }
DEVI unsigned pack2(float a, float b) { bf16x2 v; v[0] = (__bf16)a; v[1] = (__bf16)b; return __builtin_bit_cast(unsigned, v); }
DEVI float lo2f(unsigned u) { return __uint_as_float(u << 16); }
DEVI float hi2f(unsigned u) { return __uint_as_float(u & 0xffff0000u); }
DEVI f32x16 zero16() { f32x16 z;
#pragma unroll
  for (int i = 0; i < 16; ++i) z[i] = 0.f; return z; }
DEVI f32x16 mfma32(bf16x8 a, bf16x8 b, f32x16 c) { return __builtin_amdgcn_mfma_f32_32x32x16_bf16(a, b, c, 0, 0, 0); }
DEVI bf16x8 ldfrag(const bf16* p) { return *reinterpret_cast<const bf16x8*>(p); }
DEVI int drow(int r, int hh) { return (r & 3) + 8 * (r >> 2) + 4 * hh; }
DEVI int row_of(int b, int p) { return p < 256 ? NL + b * 256 + p : b * 2048 + (p - 256); }
DEVI int batch_of_row(int r) { return r < NL ? (r >> 11) : 8; }
DEVI float wave_sum(float v) {
#pragma unroll
  for (int o = 32; o > 0; o >>= 1) v += __shfl_xor(v, o);
  return v;
}
DEVI float sigmoidf_(float z) { return 1.f / (1.f + __expf(-z)); }


#define XB_TMO      128
#define XB_XCNT(j)  (256  + 64 * (j))
#define XB_XSUB(j)  (1280 + 64 * (j))
#define XB_XGEN(j)  (2304 + 64 * (j))
#define XB_TOP      3328
#define XB_TOPGEN   3392
#define XCD_BAR_WORDS 3456
#define XB_SPIN_CAP (1u << 22)
#define LAS __attribute__((address_space(3)))
DEVI unsigned xb_ld(unsigned* p)              { return __hip_atomic_load(p, __ATOMIC_RELAXED, __HIP_MEMORY_SCOPE_AGENT); }
DEVI unsigned xb_add(unsigned* p, unsigned v) { return __hip_atomic_fetch_add(p, v, __ATOMIC_RELAXED, __HIP_MEMORY_SCOPE_AGENT); }
DEVI unsigned xb_xcc_id() { return (unsigned)__builtin_amdgcn_s_getreg((3 << 11) | 20) & 0xFu; }
#define XB_SPIN(cond, bar) do { unsigned _sp = 0; while (cond) { __builtin_amdgcn_s_sleep(1); \
    if ((++_sp & 255u) == 0u) { if (xb_ld(&(bar)[XB_TMO])) break; if (_sp > XB_SPIN_CAP) { atomicAdd(&(bar)[XB_TMO], 1u); break; } } } } while (0)
struct XcdBarrier { unsigned* bar; unsigned x; volatile LAS unsigned* st; };
DEVI XcdBarrier xcd_barrier_post(unsigned* bar, volatile LAS unsigned* st) {
  XcdBarrier b; b.bar = bar; b.x = xb_xcc_id(); b.st = st;
  if (threadIdx.x == 0) (void)xb_add(&bar[XB_XCNT(b.x)], 1u);
  return b;
}
DEVI void xcd_barrier_complete(unsigned* bar, unsigned x, unsigned& nloc, unsigned& nx) {
  const unsigned G = gridDim.x * gridDim.y * gridDim.z;
  unsigned sum, cnt, mine, sp = 0u;
  for (;;) {
    sum = 0u; cnt = 0u; mine = 0u;
#pragma unroll
    for (unsigned j = 0; j < 16; ++j) { const unsigned c = xb_ld(&bar[XB_XCNT(j)]); sum += c; cnt += (c > 0u) ? 1u : 0u; mine = (j == x) ? c : mine; }
    if (sum == G) break;
    __builtin_amdgcn_s_sleep(1);
    if ((++sp & 255u) == 0u) { if (xb_ld(&bar[XB_TMO])) break; if (sp > XB_SPIN_CAP) { atomicAdd(&bar[XB_TMO], 1u); break; } }
  }
  nloc = mine > 0u ? mine : 1u; nx = cnt > 0u ? cnt : 1u;
}
DEVI void xcd_barrier(const XcdBarrier& b) {
  asm volatile("s_waitcnt vmcnt(0)" ::: "memory");
  __syncthreads();
  if (threadIdx.x == 0) {
    unsigned* bar = b.bar;
    __builtin_amdgcn_s_waitcnt(0);
    unsigned nloc = b.st[0], nx = b.st[1];
    if (nloc == 0u) { xcd_barrier_complete(bar, b.x, nloc, nx); b.st[0] = nloc; b.st[1] = nx; }
    const unsigned old = xb_add(&bar[XB_XSUB(b.x)], 1u);
    const unsigned gen = old / nloc;
    if (old + 1u == (gen + 1u) * nloc) {
      __builtin_amdgcn_fence(__ATOMIC_RELEASE, "agent");
      asm volatile("s_waitcnt vmcnt(0)" ::: "memory");
      const unsigned og = xb_add(&bar[XB_TOP], 1u);
      const unsigned tg = og / nx;
      if (og + 1u == (tg + 1u) * nx) xb_add(&bar[XB_TOPGEN], 1u);
      else XB_SPIN(xb_ld(&bar[XB_TOPGEN]) == tg, bar);
      __builtin_amdgcn_fence(__ATOMIC_ACQUIRE, "agent");
      xb_add(&bar[XB_XGEN(b.x)], 1u);
      asm volatile("s_waitcnt vmcnt(0)" ::: "memory");
    } else {
      XB_SPIN(xb_ld(&bar[XB_XGEN(b.x)]) == gen, bar);
      __builtin_amdgcn_fence(__ATOMIC_ACQUIRE, "agent");
      asm volatile("s_waitcnt vmcnt(0)" ::: "memory");
    }
  }
  __syncthreads();
}

#define VHALF ((int)__builtin_amdgcn_readfirstlane((int)(threadIdx.x >> 8)))
#define TIDX ((int)(threadIdx.x & 255))
#define VBID ((int)(blockIdx.x * 2 + VHALF))
#define NVB ((int)(gridDim.x * 2))
constexpr int HALF_LDS = 80896;

DEVI void phase_mod(const Params& P, unsigned char* smem) {
  const int tid = TIDX;
  float* s = (float*)smem;
  float* red = s + 9 * 1024;
  for (int item = VBID; item < 192; item += NVB) {
    const int l = item / 96, j = item % 96;
    __syncthreads();
    for (int i = tid; i < 9 * 1024; i += 256) {
      int bi = i >> 10, k = i & 1023;
      float v = bi < 8 ? P.c[bi * 1024 + k] : P.c_ctx[k];
      s[i] = v * sigmoidf_(v);
    }
    __syncthreads();
    const int c4 = tid & 15, kg = tid >> 4;
    float acc[9][4];
#pragma unroll
    for (int bi = 0; bi < 9; ++bi) { acc[bi][0] = acc[bi][1] = acc[bi][2] = acc[bi][3] = 0.f; }
    const float* w = P.w_mod + (size_t)l * 1024 * 6144 + j * 64 + c4 * 4;
#pragma unroll 4
    for (int kk = 0; kk < 64; ++kk) {
      const int k = kg * 64 + kk;
      const float4 w4 = *reinterpret_cast<const float4*>(w + (size_t)k * 6144);
#pragma unroll
      for (int bi = 0; bi < 9; ++bi) {
        const float sv = s[bi * 1024 + k];
        acc[bi][0] += sv * w4.x; acc[bi][1] += sv * w4.y; acc[bi][2] += sv * w4.z; acc[bi][3] += sv * w4.w;
      }
    }
#pragma unroll
    for (int bi = 0; bi < 9; ++bi)
#pragma unroll
      for (int e = 0; e < 4; ++e) red[(kg * 9 + bi) * 64 + c4 * 4 + e] = acc[bi][e];
    __syncthreads();
    for (int o = tid; o < 576; o += 256) {
      const int bi = o >> 6, cc = o & 63;
      float sum = 0.f;
#pragma unroll
      for (int g = 0; g < 16; ++g) sum += red[(g * 9 + bi) * 64 + cc];
      P.MOD[(size_t)(l * 9 + bi) * 6144 + j * 64 + cc] = sum + P.b_mod[l * 6144 + j * 64 + cc];
    }
  }
}

DEVI void conv_T_tile(const float* __restrict__ src, int N, bf16* __restrict__ dst, int Kd, int k0, int n0,
                      const float* __restrict__ kscale, float* tile) {
  const int tid = TIDX;
  __syncthreads();
  for (int e = tid; e < 4096; e += 256) {
    const int i = e >> 6, j = e & 63, n = n0 + j;
    float v = (n < N) ? src[(size_t)(k0 + i) * N + n] : 0.f;
    if (kscale) v *= kscale[k0 + i];
    tile[i * 65 + j] = v;
  }
  __syncthreads();
  for (int e = tid; e < 2048; e += 256) {
    const int j = e >> 5, i2 = (e & 31) * 2;
    const unsigned pk = pack2(tile[i2 * 65 + j], tile[(i2 + 1) * 65 + j]);
    *reinterpret_cast<unsigned*>(&dst[(size_t)(n0 + j) * Kd + k0 + i2]) = pk;
  }
}

DEVI void conv_straight(const float* __restrict__ src, bf16* __restrict__ dst, size_t n8) {
  const size_t stride = (size_t)NVB * 256;
  for (size_t i = (size_t)VBID * 256 + TIDX; i < n8; i += stride) {
    const float4 a = reinterpret_cast<const float4*>(src)[2 * i];
    const float4 b = reinterpret_cast<const float4*>(src)[2 * i + 1];
    uint4 o; o.x = pack2(a.x, a.y); o.y = pack2(a.z, a.w); o.z = pack2(b.x, b.y); o.w = pack2(b.z, b.w);
    reinterpret_cast<uint4*>(dst)[i] = o;
  }
}

DEVI void phase_prologue(const Params& P, unsigned char* smem) {
  phase_mod(P, smem);
  float* tile = (float*)smem;
  for (int it = VBID; it < 2 * 1424; it += NVB) {
    const int l = it / 1424; int r = it % 1424;
    if (r < 576) { conv_T_tile(P.w_in + (size_t)l * 1024 * DIN, DIN, P.WinT + (size_t)l * DINP * 1024, 1024, (r % 16) * 64, (r / 16) * 64, nullptr, tile); continue; }
    r -= 576;
    if (r < 256) { conv_T_tile(P.w_out + (size_t)l * 1024 * 1024, 1024, P.WoutT + (size_t)l * 1024 * 1024, 1024, (r % 16) * 64, (r / 16) * 64, nullptr, tile); continue; }
    r -= 256;
    if (r < 512) { conv_T_tile(P.p_w_q + (size_t)l * 1024 * 2048, 2048, P.WpqT + (size_t)l * 2048 * 1024, 1024, (r % 16) * 64, (r / 16) * 64, nullptr, tile); continue; }
    r -= 512;
    if (r < 48) { conv_T_tile(P.b_w_uq + (size_t)l * 256 * 768, 768, P.WuqT + (size_t)l * 768 * 256, 256, (r % 4) * 64, (r / 4) * 64, P.b_q_norm_w + l * 256, tile); continue; }
    r -= 48;
    conv_T_tile(P.b_w_ukv + (size_t)l * 128 * 1024, 1024, P.WukvT + (size_t)l * 1024 * 128, 128, (r % 2) * 64, (r / 2) * 64, P.b_kv_norm_w + l * 128, tile);
  }
  conv_straight(P.p_sub_keys, P.SK, (size_t)2 * 16 * 128 * 128 / 8);
  conv_straight(P.a_w_s, P.AWS, (size_t)2 * 4 * 128 * 128 / 8);
  {
    const int lane = TIDX & 63;
    const int gw = VBID * 4 + (TIDX >> 6), nw = NVB * 4;
    for (int r = gw; r < 65536; r += nw) {
      const int table = r >> 15, lr = r & 32767;
      const float* src = (table ? P.p_v : P.p_u) + (size_t)lr * 1024 + lane * 16;
      float4 a[4];
      float m = 0.f;
#pragma unroll
      for (int i = 0; i < 4; ++i) {
        a[i] = *reinterpret_cast<const float4*>(src + i * 4);
        m = fmaxf(m, fmaxf(fmaxf(fabsf(a[i].x), fabsf(a[i].y)), fmaxf(fabsf(a[i].z), fabsf(a[i].w))));
      }
#pragma unroll
      for (int o = 32; o > 0; o >>= 1) m = fmaxf(m, __shfl_xor(m, o));
      const float sc = fmaxf(m, 1e-30f) * (1.f / 448.f);
      const float inv = 1.f / sc;
      unsigned w[4];
#pragma unroll
      for (int i = 0; i < 4; ++i) {
        int ww = 0;
        ww = __builtin_amdgcn_cvt_pk_fp8_f32(a[i].x * inv, a[i].y * inv, ww, false);
        ww = __builtin_amdgcn_cvt_pk_fp8_f32(a[i].z * inv, a[i].w * inv, ww, true);
        w[i] = (unsigned)ww;
      }
      unsigned char* dst = (table ? P.PV8 : P.PU8) + (size_t)lr * 1024 + lane * 16;
      *reinterpret_cast<uint4*>(dst) = make_uint4(w[0], w[1], w[2], w[3]);
      if (lane == 0) (table ? P.PVS : P.PUS)[lr] = sc;
    }
  }
  for (int i = VBID * 256 + TIDX; i < 2048 * 16; i += NVB * 256) {
    const int t = i >> 4, a = (i >> 3) & 1, f = i & 7;
    const float inv = powf(10000.f, -(float)f / 8.f);
    const float pos = a ? (float)(t & 63) : (float)(t >> 6);
    const float ang = pos * inv;
    P.ROPE[t * 32 + a * 8 + f] = cosf(ang);
    P.ROPE[t * 32 + 16 + a * 8 + f] = sinf(ang);
  }
}

DEVI void phase_norm(const Params& P, int l, int which, int nrows) {
  const int lane = TIDX & 63;
  const int gw = VBID * 4 + (TIDX >> 6), nw = NVB * 4;
  const float* lnw = (which == 0 ? P.ln1_w : P.ln2_w) + l * 1024;
  for (int r = gw; r < nrows; r += nw) {
    const float* src;
    if (which == 0 && l == 0) src = r < NL ? P.x + (size_t)r * 1024 : P.ctx + (size_t)(r - NL) * 1024;
    else src = P.X + (size_t)r * 1024;
    const float* mod = P.MOD + (size_t)(l * 9 + batch_of_row(r)) * 6144 + which * 3072;
    float4 v[4];
    float ss = 0.f;
#pragma unroll
    for (int i = 0; i < 4; ++i) {
      v[i] = *reinterpret_cast<const float4*>(src + i * 256 + lane * 4);
      ss += v[i].x * v[i].x + v[i].y * v[i].y + v[i].z * v[i].z + v[i].w * v[i].w;
    }
    ss = wave_sum(ss);
    const float rr = rsqrtf(ss * (1.f / 1024.f) + EPS);
#pragma unroll
    for (int i = 0; i < 4; ++i) {
      const int d = i * 256 + lane * 4;
      const float4 w = *reinterpret_cast<const float4*>(lnw + d);
      const float4 sh = *reinterpret_cast<const float4*>(mod + d);
      const float4 sc = *reinterpret_cast<const float4*>(mod + 1024 + d);
      const float o0 = v[i].x * rr * w.x * (1.f + sc.x) + sh.x;
      const float o1 = v[i].y * rr * w.y * (1.f + sc.y) + sh.y;
      const float o2 = v[i].z * rr * w.z * (1.f + sc.z) + sh.z;
      const float o3 = v[i].w * rr * w.w * (1.f + sc.w) + sh.w;
      uint2 o; o.x = pack2(o0, o1); o.y = pack2(o2, o3);
      *reinterpret_cast<uint2*>(P.H + (size_t)r * 1024 + d) = o;
    }
  }
}

template <int BM, int BN, int BK, int WM, int WN>
struct Gemm {
  static constexpr int LDK = BK + 8;
  static constexpr int TM = BM / WM / 32, TN = BN / WN / 32;
  static constexpr int CPR = BK / 8;
  static constexpr int NA = BM * CPR / 256, NB = BN * CPR / 256;
  static constexpr int A_BYTES = BM * LDK * 2, B_BYTES = BN * LDK * 2;
  static constexpr int STAGE_BYTES = A_BYTES + B_BYTES;
  static constexpr int SMEM = 2 * STAGE_BYTES;

  static DEVI void run(const bf16* __restrict__ A, int lda, const bf16* __restrict__ BT, int ldb, int K,
                       unsigned char* smem, f32x16 (&acc)[TM][TN]) {
    const int tid = TIDX, lane = tid & 63, wave = tid >> 6;
    const int wm = wave / WN, wn = wave % WN;
    const int l31 = lane & 31, hh = lane >> 5;
#pragma unroll
    for (int i = 0; i < TM; ++i)
#pragma unroll
      for (int j = 0; j < TN; ++j) acc[i][j] = zero16();
    uint4 ra[NA], rb[NB];
    const int nk = K / BK;
    auto gload = [&](int kt) {
#pragma unroll
      for (int i = 0; i < NA; ++i) { const int ch = tid + i * 256, row = ch / CPR, cc = ch % CPR;
        ra[i] = *reinterpret_cast<const uint4*>(A + (size_t)row * lda + kt * BK + cc * 8); }
#pragma unroll
      for (int i = 0; i < NB; ++i) { const int ch = tid + i * 256, row = ch / CPR, cc = ch % CPR;
        rb[i] = *reinterpret_cast<const uint4*>(BT + (size_t)row * ldb + kt * BK + cc * 8); }
    };
    auto swrite = [&](int buf) {
      bf16* sA = reinterpret_cast<bf16*>(smem + buf * STAGE_BYTES);
      bf16* sB = reinterpret_cast<bf16*>(smem + buf * STAGE_BYTES + A_BYTES);
#pragma unroll
      for (int i = 0; i < NA; ++i) { const int ch = tid + i * 256, row = ch / CPR, cc = ch % CPR;
        *reinterpret_cast<uint4*>(sA + row * LDK + cc * 8) = ra[i]; }
#pragma unroll
      for (int i = 0; i < NB; ++i) { const int ch = tid + i * 256, row = ch / CPR, cc = ch % CPR;
        *reinterpret_cast<uint4*>(sB + row * LDK + cc * 8) = rb[i]; }
    };
    __syncthreads();
    gload(0);
    swrite(0);
    __syncthreads();
    for (int kt = 0; kt < nk; ++kt) {
      const int cur = kt & 1;
      if (kt + 1 < nk) gload(kt + 1);
      const bf16* sA = reinterpret_cast<const bf16*>(smem + cur * STAGE_BYTES);
      const bf16* sB = reinterpret_cast<const bf16*>(smem + cur * STAGE_BYTES + A_BYTES);
#pragma unroll
      for (int ks = 0; ks < BK / 16; ++ks) {
        bf16x8 af[TM], bfr[TN];
#pragma unroll
        for (int i = 0; i < TM; ++i) af[i] = ldfrag(sA + (wm * (BM / WM) + i * 32 + l31) * LDK + ks * 16 + hh * 8);
#pragma unroll
        for (int j = 0; j < TN; ++j) bfr[j] = ldfrag(sB + (wn * (BN / WN) + j * 32 + l31) * LDK + ks * 16 + hh * 8);
#pragma unroll
        for (int i = 0; i < TM; ++i)
#pragma unroll
          for (int j = 0; j < TN; ++j) acc[i][j] = mfma32(af[i], bfr[j], acc[i][j]);
      }
      if (kt + 1 < nk) swrite(cur ^ 1);
      __syncthreads();
    }
  }
};

DEVI void phase_gemm1(const Params& P, int l, unsigned char* smem) {
  using G = Gemm<128, 128, 64, 2, 2>;
  const int lane = TIDX & 63, wave = TIDX >> 6, wm = wave >> 1, wn = wave & 1, l31 = lane & 31, hh = lane >> 5;
  const bf16* W = P.WinT + (size_t)l * DINP * 1024;
  for (int t = VBID; t < 144 * 18; t += NVB) {
    const int mt = t / 18, nt = t % 18;
    f32x16 acc[2][2];
    G::run(P.H + (size_t)mt * 128 * 1024, 1024, W + (size_t)nt * 128 * 1024, 1024, 1024, smem, acc);
#pragma unroll
    for (int i = 0; i < 2; ++i)
#pragma unroll
      for (int j = 0; j < 2; ++j) {
        const int col = nt * 128 + wn * 64 + j * 32 + l31;
        if (col < DIN) {
#pragma unroll
          for (int r = 0; r < 16; ++r) {
            const int row = mt * 128 + wm * 64 + i * 32 + drow(r, hh);
            P.Z[(size_t)row * DIN + col] = f2bf(acc[i][j][r]);
          }
        }
      }
  }
}

DEVI void phase_gemm2(const Params& P, int l, unsigned char* smem) {
  using G = Gemm<128, 128, 64, 2, 2>;
  const int lane = TIDX & 63, wave = TIDX >> 6, wm = wave >> 1, wn = wave & 1, l31 = lane & 31, hh = lane >> 5;
  const bf16* W = P.WoutT + (size_t)l * 1024 * 1024;
  const int mtiles = (l == 1) ? 128 : 144;
  for (int t = VBID; t < mtiles * 8; t += NVB) {
    const int mt = t / 8, nt = t % 8;
    f32x16 acc[2][2];
    G::run(P.H + (size_t)mt * 128 * 1024, 1024, W + (size_t)nt * 128 * 1024, 1024, 1024, smem, acc);
    const int bi = batch_of_row(mt * 128);
    const float* gate = P.MOD + (size_t)(l * 9 + bi) * 6144 + 2048;
#pragma unroll
    for (int i = 0; i < 2; ++i)
#pragma unroll
      for (int j = 0; j < 2; ++j) {
        const int col = nt * 128 + wn * 64 + j * 32 + l31;
        const float g = gate[col];
#pragma unroll
        for (int r = 0; r < 16; ++r) {
          const int row = mt * 128 + wm * 64 + i * 32 + drow(r, hh);
          float res;
          if (l == 0) res = row < NL ? P.x[(size_t)row * 1024 + col] : P.ctx[(size_t)(row - NL) * 1024 + col];
          else res = P.X[(size_t)row * 1024 + col];
          P.X[(size_t)row * 1024 + col] = res + g * acc[i][j][r];
        }
      }
  }
}

DEVI void phase_mixA(const Params& P, int l, unsigned char* smem) {
  const int tid = TIDX, lane = tid & 63, wave = tid >> 6, l31 = lane & 31, hh = lane >> 5;
  bf16* VNT = reinterpret_cast<bf16*>(smem);
  constexpr int LDV = 136;
  const int nseg = (l == 1) ? 16 : 18;
  const int seg0 = (l == 1) ? 2 : 0;
  for (int it = VBID; it < 8 * nseg * 4; it += NVB) {
    const int a = it & 3; const int sj = (it >> 2) % nseg + seg0; const int b = (it >> 2) / nseg;
    const int p0 = sj * 128;
    __syncthreads();
    {
      const int q = tid >> 1, half = tid & 1;
      const int row = row_of(b, p0 + q);
      const bf16* src = P.Z + (size_t)row * DIN + ZC_AV + a * 64 + half * 32;
      float v[32];
      float ss = 0.f;
#pragma unroll
      for (int i = 0; i < 4; ++i) {
        const uint4 u = *reinterpret_cast<const uint4*>(src + i * 8);
        v[i * 8 + 0] = lo2f(u.x); v[i * 8 + 1] = hi2f(u.x); v[i * 8 + 2] = lo2f(u.y); v[i * 8 + 3] = hi2f(u.y);
        v[i * 8 + 4] = lo2f(u.z); v[i * 8 + 5] = hi2f(u.z); v[i * 8 + 6] = lo2f(u.w); v[i * 8 + 7] = hi2f(u.w);
      }
#pragma unroll
      for (int i = 0; i < 32; ++i) ss += v[i] * v[i];
      ss += __shfl_xor(ss, 1);
      const float rr = rsqrtf(ss * (1.f / 64.f) + EPS);
      const float* nw = P.a_norm_w + l * 256 + a * 64 + half * 32;
#pragma unroll
      for (int i = 0; i < 32; ++i) VNT[(half * 32 + i) * LDV + q] = f2bf(v[i] * rr * nw[i]);
    }
    __syncthreads();
    f32x16 acc[2]; acc[0] = zero16(); acc[1] = zero16();
    const bf16* Aw = P.AWS + (size_t)(l * 4 + a) * 128 * 128 + (size_t)(wave * 32 + l31) * 128;
#pragma unroll
    for (int ks = 0; ks < 8; ++ks) {
      const bf16x8 af = ldfrag(Aw + ks * 16 + hh * 8);
#pragma unroll
      for (int j = 0; j < 2; ++j) {
        const bf16x8 bfr = ldfrag(VNT + (j * 32 + l31) * LDV + ks * 16 + hh * 8);
        acc[j] = mfma32(af, bfr, acc[j]);
      }
    }
    const float* bs = P.a_b_s + (l * 4 + a) * 128;
#pragma unroll
    for (int j = 0; j < 2; ++j)
#pragma unroll
      for (int r = 0; r < 16; ++r) {
        const int p = wave * 32 + drow(r, hh);
        const int row = row_of(b, p0 + p);
        const int col = a * 64 + j * 32 + l31;
        const float u = bf2f(P.Z[(size_t)row * DIN + ZC_AU + col]);
        P.H[(size_t)row * 1024 + col] = f2bf(u * (acc[j][r] + bs[p]));
      }
  }
}

DEVI void mla_norm_rope_store(const Params& P, const float* T, const float* nw, bool rope, float oscale,
                              bf16* dstbase  , int pos0, int tlat0) {
  const int tid = TIDX, tok = tid >> 1, half = tid & 1;
  float v[48];
  float ss = 0.f;
#pragma unroll
  for (int i = 0; i < 48; ++i) { v[i] = T[tok * 97 + half * 48 + i]; ss += v[i] * v[i]; }
  ss += __shfl_xor(ss, 1);
  const float rr = rsqrtf(ss * (1.f / 96.f) + EPS);
#pragma unroll
  for (int i = 0; i < 48; ++i) v[i] = v[i] * rr * nw[half * 48 + i];
  if (rope && half == 1) {
    const float* cs = P.ROPE + (size_t)(tlat0 + tok) * 32;
#pragma unroll
    for (int a = 0; a < 2; ++a)
#pragma unroll
      for (int f = 0; f < 8; ++f) {
        const float x1 = v[16 + a * 16 + f], x2 = v[16 + a * 16 + 8 + f];
        const float c = cs[a * 8 + f], s = cs[16 + a * 8 + f];
        v[16 + a * 16 + f] = x1 * c - x2 * s;
        v[16 + a * 16 + 8 + f] = x2 * c + x1 * s;
      }
  }
  bf16* dst = dstbase + (size_t)(pos0 + tok) * 96 + half * 48;
#pragma unroll
  for (int i = 0; i < 6; ++i) {
    uint4 o;
    o.x = pack2(v[i * 8 + 0] * oscale, v[i * 8 + 1] * oscale); o.y = pack2(v[i * 8 + 2] * oscale, v[i * 8 + 3] * oscale);
    o.z = pack2(v[i * 8 + 4] * oscale, v[i * 8 + 5] * oscale); o.w = pack2(v[i * 8 + 6] * oscale, v[i * 8 + 7] * oscale);
    *reinterpret_cast<uint4*>(dst + i * 8) = o;
  }
}

DEVI void phase_mla_proj(const Params& P, int l, unsigned char* smem) {
  const int tid = TIDX, lane = tid & 63, wave = tid >> 6, l31 = lane & 31, hh = lane >> 5;
  float* T = reinterpret_cast<float*>(smem);
  float* rsq = T + 128 * 97;
  float* rskv = rsq + 128;
  const float qscale = 0.10206207261596577f * 1.4426950408889634f;
  for (int it = VBID; it < 144 * 8; it += NVB) {
    const int h = it & 7;
    const int m0 = (it >> 3) * 128;
    const bool lat = m0 < NL;
    const int b = lat ? (m0 >> 11) : ((m0 - NL) >> 8);
    const int pos0 = lat ? 256 + (m0 & 2047) : ((m0 - NL) & 255);
    const int tlat0 = lat ? (m0 & 2047) : 0;
    const bool doq = lat || (l == 0);
    const bf16* zrow = P.Z + (size_t)(m0 + wave * 32 + l31) * DIN;
    __syncthreads();
    {
      float ss = 0.f;
#pragma unroll
      for (int ks = 0; ks < 8; ++ks) {
        const bf16x8 a = ldfrag(zrow + ZC_BKV + ks * 16 + hh * 8);
#pragma unroll
        for (int j = 0; j < 8; ++j) { const float f = (float)a[j]; ss += f * f; }
      }
      ss += __shfl_xor(ss, 32);
      if (hh == 0) rskv[wave * 32 + l31] = rsqrtf(ss * (1.f / 128.f) + EPS);
      if (doq) {
        float sq = 0.f;
#pragma unroll
        for (int ks = 0; ks < 16; ++ks) {
          const bf16x8 a = ldfrag(zrow + ZC_BQ + ks * 16 + hh * 8);
#pragma unroll
          for (int j = 0; j < 8; ++j) { const float f = (float)a[j]; sq += f * f; }
        }
        sq += __shfl_xor(sq, 32);
        if (hh == 0) rsq[wave * 32 + l31] = rsqrtf(sq * (1.f / 256.f) + EPS);
      }
    }
    for (int e = tid; e < 128 * 32; e += 256) {
      const int tok = e >> 5, i = e & 31;
      T[tok * 97 + 64 + i] = bf2f(P.Z[(size_t)(m0 + tok) * DIN + ZC_BKR + i]);
    }
    __syncthreads();
    {
      const bf16* Wkv = P.WukvT + (size_t)l * 1024 * 128;
      f32x16 acc[4];
#pragma unroll
      for (int j = 0; j < 4; ++j) acc[j] = zero16();
#pragma unroll 2
      for (int ks = 0; ks < 8; ++ks) {
        const bf16x8 af = ldfrag(zrow + ZC_BKV + ks * 16 + hh * 8);
#pragma unroll
        for (int j = 0; j < 4; ++j) {
          const bf16x8 bfr = ldfrag(Wkv + (size_t)(h * 128 + j * 32 + l31) * 128 + ks * 16 + hh * 8);
          acc[j] = mfma32(af, bfr, acc[j]);
        }
      }
#pragma unroll
      for (int j = 0; j < 2; ++j)
#pragma unroll
        for (int r = 0; r < 16; ++r) {
          const int tok = wave * 32 + drow(r, hh);
          T[tok * 97 + j * 32 + l31] = acc[j][r] * rskv[tok];
        }
#pragma unroll
      for (int j = 2; j < 4; ++j) {
        const int d = (j - 2) * 32 + l31;
        bf16* dst = P.VT + ((size_t)(b * 8 + h) * 64 + d) * SEQP + pos0 + wave * 32;
#pragma unroll
        for (int rg = 0; rg < 4; ++rg) {
          const int tk = 8 * rg + 4 * hh;
          uint2 o;
          o.x = pack2(acc[j][4 * rg + 0] * rskv[wave * 32 + tk + 0], acc[j][4 * rg + 1] * rskv[wave * 32 + tk + 1]);
          o.y = pack2(acc[j][4 * rg + 2] * rskv[wave * 32 + tk + 2], acc[j][4 * rg + 3] * rskv[wave * 32 + tk + 3]);
          *reinterpret_cast<uint2*>(dst + tk) = o;
        }
      }
      __syncthreads();
      mla_norm_rope_store(P, T, P.b_kh_w + l * 96, lat, 1.f, P.K + (size_t)(b * 8 + h) * SEQP * 96, pos0, tlat0);
    }
    if (doq) {
      const bf16* Wq = P.WuqT + (size_t)l * 768 * 256;
      f32x16 acc[3];
#pragma unroll
      for (int j = 0; j < 3; ++j) acc[j] = zero16();
#pragma unroll 2
      for (int ks = 0; ks < 16; ++ks) {
        const bf16x8 af = ldfrag(zrow + ZC_BQ + ks * 16 + hh * 8);
#pragma unroll
        for (int j = 0; j < 3; ++j) {
          const bf16x8 bfr = ldfrag(Wq + (size_t)(h * 96 + j * 32 + l31) * 256 + ks * 16 + hh * 8);
          acc[j] = mfma32(af, bfr, acc[j]);
        }
      }
      __syncthreads();
#pragma unroll
      for (int j = 0; j < 3; ++j)
#pragma unroll
        for (int r = 0; r < 16; ++r) {
          const int tok = wave * 32 + drow(r, hh);
          T[tok * 97 + j * 32 + l31] = acc[j][r] * rsq[tok];
        }
      __syncthreads();
      mla_norm_rope_store(P, T, P.b_qh_w + l * 96, lat, qscale, P.Q + (size_t)(b * 8 + h) * SEQP * 96, pos0, tlat0);
    }
  }
}

DEVI void hgrn_load(const Params& P, int l, int b, int hd, int c, float* BF, float* RB,
                    float (&q)[16], float (&kf)[16], float (&kb)[16], float (&v)[16], bool need_kv) {
  const int tid = TIDX, t = tid >> 2, k0 = (tid & 3) * 16;
  const int row = row_of(b, c * 64 + t);
  const bf16* z = P.Z + (size_t)row * DIN + hd * 64 + k0;
  float zf[16], zb[16];
#pragma unroll
  for (int i = 0; i < 2; ++i) {
    const uint4 uq = *reinterpret_cast<const uint4*>(z + ZC_CQ + i * 8);
    const uint4 uf = *reinterpret_cast<const uint4*>(z + ZC_CFF + i * 8);
    const uint4 ub = *reinterpret_cast<const uint4*>(z + ZC_CFB + i * 8);
    q[i * 8 + 0] = lo2f(uq.x); q[i * 8 + 1] = hi2f(uq.x); q[i * 8 + 2] = lo2f(uq.y); q[i * 8 + 3] = hi2f(uq.y);
    q[i * 8 + 4] = lo2f(uq.z); q[i * 8 + 5] = hi2f(uq.z); q[i * 8 + 6] = lo2f(uq.w); q[i * 8 + 7] = hi2f(uq.w);
    zf[i * 8 + 0] = lo2f(uf.x); zf[i * 8 + 1] = hi2f(uf.x); zf[i * 8 + 2] = lo2f(uf.y); zf[i * 8 + 3] = hi2f(uf.y);
    zf[i * 8 + 4] = lo2f(uf.z); zf[i * 8 + 5] = hi2f(uf.z); zf[i * 8 + 6] = lo2f(uf.w); zf[i * 8 + 7] = hi2f(uf.w);
    zb[i * 8 + 0] = lo2f(ub.x); zb[i * 8 + 1] = hi2f(ub.x); zb[i * 8 + 2] = lo2f(ub.y); zb[i * 8 + 3] = hi2f(ub.y);
    zb[i * 8 + 4] = lo2f(ub.z); zb[i * 8 + 5] = hi2f(ub.z); zb[i * 8 + 6] = lo2f(ub.w); zb[i * 8 + 7] = hi2f(ub.w);
    if (need_kv) {
      const uint4 uv = *reinterpret_cast<const uint4*>(z + ZC_CI + i * 8);
      v[i * 8 + 0] = lo2f(uv.x); v[i * 8 + 1] = hi2f(uv.x); v[i * 8 + 2] = lo2f(uv.y); v[i * 8 + 3] = hi2f(uv.y);
      v[i * 8 + 4] = lo2f(uv.z); v[i * 8 + 5] = hi2f(uv.z); v[i * 8 + 6] = lo2f(uv.w); v[i * 8 + 7] = hi2f(uv.w);
    }
  }
#pragma unroll
  for (int i = 0; i < 16; ++i) {
    q[i] *= 0.125f;
    float lbf = 0.f, lbb = 0.f;
    if (l == 1) {
      const int ch = hd * 64 + k0 + i;
      lbf = sigmoidf_(P.c_lb[512 + ch] - P.c_lb[ch]);
      lbb = sigmoidf_(P.c_lb[512 + 256 + ch] - P.c_lb[256 + ch]);
    }
    {
      const float zz = zf[i];
      const float sg = sigmoidf_(zz);
      const float lsig = fminf(zz, 0.f) - log1pf(__expf(-fabsf(zz)));
      const float f = lbf + (1.f - lbf) * sg;
      const float lf = (l == 0) ? lsig : __logf(f);
      kf[i] = (1.f - lbf) * sigmoidf_(-zz);
      BF[t * 65 + k0 + i] = lf;
    }
    {
      const float zz = zb[i];
      const float sg = sigmoidf_(zz);
      const float lsig = fminf(zz, 0.f) - log1pf(__expf(-fabsf(zz)));
      const float f = lbb + (1.f - lbb) * sg;
      const float lf = (l == 0) ? lsig : __logf(f);
      kb[i] = (1.f - lbb) * sigmoidf_(-zz);
      RB[t * 65 + k0 + i] = lf;
    }
  }
  __syncthreads();
  if (tid < 64) {
    float s = 0.f;
    for (int tt = 0; tt < 64; ++tt) { s += BF[tt * 65 + tid]; BF[tt * 65 + tid] = s; }
  } else if (tid < 128) {
    const int k = tid - 64;
    float s = 0.f;
    for (int tt = 63; tt >= 0; --tt) { s += RB[tt * 65 + k]; RB[tt * 65 + k] = s; }
  }
  __syncthreads();
}

DEVI f32x16 lds_mm(const bf16* A, const bf16* BT, int tm, int tn, int l31, int hh) {
  f32x16 acc = zero16();
#pragma unroll
  for (int ks = 0; ks < 4; ++ks) {
    const bf16x8 a = ldfrag(A + (tm * 32 + l31) * 72 + ks * 16 + hh * 8);
    const bf16x8 b = ldfrag(BT + (tn * 32 + l31) * 72 + ks * 16 + hh * 8);
    acc = mfma32(a, b, acc);
  }
  return acc;
}

DEVI void phase_hgrn_local(const Params& P, int l, unsigned char* smem) {
  const int tid = TIDX, lane = tid & 63, wave = tid >> 6, l31 = lane & 31, hh = lane >> 5;
  const int tm = wave >> 1, tn = wave & 1;
  float* BF = reinterpret_cast<float*>(smem);
  float* RB = BF + 64 * 65;
  bf16* QF = reinterpret_cast<bf16*>(smem + 33280);
  bf16* KF = QF + 64 * 72;
  bf16* QB = KF + 64 * 72;
  bf16* KB = QB + 64 * 72;
  bf16* VTt = KB + 64 * 72;
  bf16* KHF = reinterpret_cast<bf16*>(smem);
  bf16* KHB = KHF + 64 * 72;
  bf16* ATT = KHB + 64 * 72;
  for (int it = VBID; it < 8 * 4 * 36; it += NVB) {
    const int c = it % 36, hd = (it / 36) & 3, b = it / 144;
    float q[16], kf[16], kb[16], v[16];
    __syncthreads();
    hgrn_load(P, l, b, hd, c, BF, RB, q, kf, kb, v, true);
    const int t = tid >> 2, k0 = (tid & 3) * 16;
    float bfv[16], rbv[16];
#pragma unroll
    for (int i = 0; i < 16; ++i) { bfv[i] = BF[t * 65 + k0 + i]; rbv[i] = RB[t * 65 + k0 + i]; }
    if (t == 0) {
      float* dec = P.DEC + ((size_t)((b * 4 + hd) * 2) * 36 + c) * 64 + k0;
#pragma unroll
      for (int i = 0; i < 16; ++i) { dec[i] = __expf(BF[63 * 65 + k0 + i]); dec[36 * 64 + i] = __expf(RB[k0 + i]); }
    }
#pragma unroll
    for (int i = 0; i < 16; i += 2) {
      const int k = k0 + i;
      const float mF0 = BF[32 * 65 + k], mF1 = BF[32 * 65 + k + 1], mB0 = RB[32 * 65 + k], mB1 = RB[32 * 65 + k + 1];
      *reinterpret_cast<unsigned*>(&QF[t * 72 + k]) = pack2(q[i] * __expf(fminf(bfv[i] - mF0, 80.f)), q[i + 1] * __expf(fminf(bfv[i + 1] - mF1, 80.f)));
      *reinterpret_cast<unsigned*>(&KF[t * 72 + k]) = pack2(kf[i] * __expf(fminf(mF0 - bfv[i], 80.f)), kf[i + 1] * __expf(fminf(mF1 - bfv[i + 1], 80.f)));
      *reinterpret_cast<unsigned*>(&QB[t * 72 + k]) = pack2(q[i] * __expf(fminf(rbv[i] - mB0, 80.f)), q[i + 1] * __expf(fminf(rbv[i + 1] - mB1, 80.f)));
      *reinterpret_cast<unsigned*>(&KB[t * 72 + k]) = pack2(kb[i] * __expf(fminf(mB0 - rbv[i], 80.f)), kb[i + 1] * __expf(fminf(mB1 - rbv[i + 1], 80.f)));
    }
#pragma unroll
    for (int i = 0; i < 16; ++i) {
      VTt[(k0 + i) * 72 + t] = f2bf(v[i]);
      kf[i] = kf[i] * __expf(BF[63 * 65 + k0 + i] - bfv[i]);
      kb[i] = kb[i] * __expf(RB[k0 + i] - rbv[i]);
    }
    __syncthreads();
#pragma unroll
    for (int i = 0; i < 16; ++i) {
      KHF[(k0 + i) * 72 + t] = f2bf(kf[i]);
      KHB[(k0 + i) * 72 + t] = f2bf(kb[i]);
    }
    __syncthreads();
    {
      const f32x16 af = lds_mm(QF, KF, tm, tn, l31, hh);
      const f32x16 ab = lds_mm(QB, KB, tm, tn, l31, hh);
      const int s = tn * 32 + l31;
#pragma unroll
      for (int r = 0; r < 16; ++r) {
        const int tt = tm * 32 + drow(r, hh);
        float a = 0.f;
        if (s <= tt) a += af[r];
        if (s >= tt) a += ab[r];
        ATT[tt * 72 + s] = f2bf(a);
      }
    }
    {
      const f32x16 lf = lds_mm(KHF, VTt, tm, tn, l31, hh);
      const f32x16 lb = lds_mm(KHB, VTt, tm, tn, l31, hh);
      float* stf = P.ST + ((size_t)((b * 4 + hd) * 2 + 0) * 36 + c) * 4096;
      float* stb = P.ST + ((size_t)((b * 4 + hd) * 2 + 1) * 36 + c) * 4096;
#pragma unroll
      for (int r = 0; r < 16; ++r) {
        const int kk = tm * 32 + drow(r, hh), d = tn * 32 + l31;
        stf[kk * 64 + d] = lf[r];
        stb[kk * 64 + d] = lb[r];
      }
    }
    __syncthreads();
    {
      const f32x16 o = lds_mm(ATT, VTt, tm, tn, l31, hh);
#pragma unroll
      for (int r = 0; r < 16; ++r) {
        const int tt = tm * 32 + drow(r, hh), d = tn * 32 + l31;
        P.OI[(size_t)row_of(b, c * 64 + tt) * 256 + hd * 64 + d] = o[r];
      }
    }
  }
}

DEVI void hgrn_scan_item(const Params& P, int item) {
  const int tid = TIDX;
  const int chain = item >> 2, sl = item & 3;
  const int dir = chain & 1;
  const int k = tid >> 2, d4 = sl * 16 + (tid & 3) * 4;
  float4 S = make_float4(0.f, 0.f, 0.f, 0.f);
  float* base = P.ST + (size_t)chain * 36 * 4096 + k * 64 + d4;
  const float* dec = P.DEC + (size_t)chain * 36 * 64 + k;
#pragma unroll 4
  for (int step = 0; step < 36; ++step) {
    const int c = dir == 0 ? step : (step < 4 ? 3 - step : 39 - step);
    float4* p = reinterpret_cast<float4*>(base + (size_t)c * 4096);
    const float4 L = *p;
    const float dc = dec[c * 64];
    *p = S;
    S.x = dc * S.x + L.x; S.y = dc * S.y + L.y; S.z = dc * S.z + L.z; S.w = dc * S.w + L.w;
  }
}

DEVI void phase_hgrn_final(const Params& P, int l, unsigned char* smem) {
  const int tid = TIDX, lane = tid & 63, wave = tid >> 6, l31 = lane & 31, hh = lane >> 5;
  const int tm = wave >> 1, tn = wave & 1;
  float* BF = reinterpret_cast<float*>(smem);
  float* RB = BF + 64 * 65;
  bf16* QF = reinterpret_cast<bf16*>(smem + 33280);
  bf16* QB = QF + 64 * 72;
  bf16* SF = QB + 64 * 72;
  bf16* SB = SF + 64 * 72;
  float* O = reinterpret_cast<float*>(smem);
  const int c0 = (l == 1) ? 4 : 0;
  const int nc = 36 - c0;
  for (int it = VBID; it < 8 * 4 * nc; it += NVB) {
    const int c = it % nc + c0, hd = (it / nc) & 3, b = it / (nc * 4);
    float q[16], kf[16], kb[16], v[16];
    __syncthreads();
    hgrn_load(P, l, b, hd, c, BF, RB, q, kf, kb, v, false);
    const int t = tid >> 2, k0 = (tid & 3) * 16;
#pragma unroll
    for (int i = 0; i < 16; i += 2) {
      const int k = k0 + i;
      *reinterpret_cast<unsigned*>(&QF[t * 72 + k]) = pack2(q[i] * __expf(BF[t * 65 + k]), q[i + 1] * __expf(BF[t * 65 + k + 1]));
      *reinterpret_cast<unsigned*>(&QB[t * 72 + k]) = pack2(q[i] * __expf(RB[t * 65 + k]), q[i + 1] * __expf(RB[t * 65 + k + 1]));
    }
    {
      const float* stf = P.ST + ((size_t)((b * 4 + hd) * 2 + 0) * 36 + c) * 4096;
      const float* stb = P.ST + ((size_t)((b * 4 + hd) * 2 + 1) * 36 + c) * 4096;
#pragma unroll
      for (int i = 0; i < 16; i += 4) {
        const float4 a = *reinterpret_cast<const float4*>(stf + t * 64 + k0 + i);
        const float4 bb = *reinterpret_cast<const float4*>(stb + t * 64 + k0 + i);
        SF[(k0 + i + 0) * 72 + t] = f2bf(a.x); SF[(k0 + i + 1) * 72 + t] = f2bf(a.y); SF[(k0 + i + 2) * 72 + t] = f2bf(a.z); SF[(k0 + i + 3) * 72 + t] = f2bf(a.w);
        SB[(k0 + i + 0) * 72 + t] = f2bf(bb.x); SB[(k0 + i + 1) * 72 + t] = f2bf(bb.y); SB[(k0 + i + 2) * 72 + t] = f2bf(bb.z); SB[(k0 + i + 3) * 72 + t] = f2bf(bb.w);
      }
    }
    __syncthreads();
    {
      f32x16 o = lds_mm(QF, SF, tm, tn, l31, hh);
      const f32x16 o2 = lds_mm(QB, SB, tm, tn, l31, hh);
#pragma unroll
      for (int r = 0; r < 16; ++r) {
        const int tt = tm * 32 + drow(r, hh), d = tn * 32 + l31;
        O[tt * 65 + d] = o[r] + o2[r] + P.OI[(size_t)row_of(b, c * 64 + tt) * 256 + hd * 64 + d];
      }
    }
    __syncthreads();
    {
      const int row = row_of(b, c * 64 + t);
      float ov[16]; float ss = 0.f;
#pragma unroll
      for (int i = 0; i < 16; ++i) { ov[i] = O[t * 65 + k0 + i]; ss += ov[i] * ov[i]; }
      ss += __shfl_xor(ss, 1); ss += __shfl_xor(ss, 2);
      const float rr = rsqrtf(ss * (1.f / 64.f) + EPS);
      const bf16* g = P.Z + (size_t)row * DIN + ZC_CG + hd * 64 + k0;
      const float* nw = P.c_out_norm_w + l * 64 + k0;
      unsigned pk[8];
#pragma unroll
      for (int i = 0; i < 16; i += 2) {
        const float g0 = bf2f(g[i]), g1 = bf2f(g[i + 1]);
        const float y0 = ov[i] * rr * nw[i] * (g0 * sigmoidf_(g0));
        const float y1 = ov[i + 1] * rr * nw[i + 1] * (g1 * sigmoidf_(g1));
        pk[i >> 1] = pack2(y0, y1);
      }
      uint4* dst = reinterpret_cast<uint4*>(P.H + (size_t)row * 1024 + 768 + hd * 64 + k0);
      dst[0] = make_uint4(pk[0], pk[1], pk[2], pk[3]);
      dst[1] = make_uint4(pk[4], pk[5], pk[6], pk[7]);
    }
  }
}

DEVI void attn_item(const Params& P, int b, int h, int qpos0, int nkeys, unsigned char* smem) {
  const int tid = TIDX, lane = tid & 63, wave = tid >> 6, l31 = lane & 31, hh = lane >> 5;
  constexpr int LDKS = 104, LDVS = 72;
  constexpr int KS_BYTES = 64 * LDKS * 2, VS_BYTES = 64 * LDVS * 2, ST_BYTES = KS_BYTES + VS_BYTES;
  const bf16* Qg = P.Q + ((size_t)(b * 8 + h) * SEQP + qpos0 + wave * 32 + l31) * 96;
  const bf16* Kg = P.K + (size_t)(b * 8 + h) * SEQP * 96;
  const bf16* Vg = P.VT + (size_t)(b * 8 + h) * 64 * SEQP;
  bf16x8 qf[6];
#pragma unroll
  for (int ks = 0; ks < 6; ++ks) qf[ks] = ldfrag(Qg + ks * 16 + hh * 8);
  f32x16 oacc[2]; oacc[0] = zero16(); oacc[1] = zero16();
  float m = -1e30f, lsum = 0.f;
  uint4 rk[3], rv[2];
  const int ntiles = nkeys / 64;
  auto gload = [&](int kt) {
#pragma unroll
    for (int i = 0; i < 3; ++i) { const int ch = tid + i * 256, row = ch / 12, cc = ch % 12;
      rk[i] = *reinterpret_cast<const uint4*>(Kg + (size_t)(kt * 64 + row) * 96 + cc * 8); }
#pragma unroll
    for (int i = 0; i < 2; ++i) { const int ch = tid + i * 256, row = ch >> 3, cc = ch & 7;
      rv[i] = *reinterpret_cast<const uint4*>(Vg + (size_t)row * SEQP + kt * 64 + cc * 8); }
  };
  auto swrite = [&](int buf) {
    bf16* sK = reinterpret_cast<bf16*>(smem + buf * ST_BYTES);
    bf16* sV = reinterpret_cast<bf16*>(smem + buf * ST_BYTES + KS_BYTES);
#pragma unroll
    for (int i = 0; i < 3; ++i) { const int ch = tid + i * 256, row = ch / 12, cc = ch % 12;
      *reinterpret_cast<uint4*>(sK + row * LDKS + cc * 8) = rk[i]; }
#pragma unroll
    for (int i = 0; i < 2; ++i) { const int ch = tid + i * 256, row = ch >> 3, cc = ch & 7;
      const int g16 = cc >> 1, odd = cc & 1;
      bf16* base = sV + row * LDVS + g16 * 16;
      const int p0 = odd * 2, p1 = odd * 2 + 1;
      const int s0 = (p0 == 1 ? 2 : (p0 == 2 ? 1 : p0)) * 4, s1 = (p1 == 1 ? 2 : (p1 == 2 ? 1 : p1)) * 4;
      *reinterpret_cast<uint2*>(base + s0) = make_uint2(rv[i].x, rv[i].y);
      *reinterpret_cast<uint2*>(base + s1) = make_uint2(rv[i].z, rv[i].w);
    }
  };
  __syncthreads();
  gload(0); swrite(0);
  __syncthreads();
  for (int kt = 0; kt < ntiles; ++kt) {
    const int cur = kt & 1;
    if (kt + 1 < ntiles) gload(kt + 1);
    const bf16* sK = reinterpret_cast<const bf16*>(smem + cur * ST_BYTES);
    const bf16* sV = reinterpret_cast<const bf16*>(smem + cur * ST_BYTES + KS_BYTES);
    f32x16 sacc[2]; sacc[0] = zero16(); sacc[1] = zero16();
#pragma unroll
    for (int kk = 0; kk < 2; ++kk)
#pragma unroll
      for (int ks = 0; ks < 6; ++ks) {
        const bf16x8 a = ldfrag(sK + (kk * 32 + l31) * LDKS + ks * 16 + hh * 8);
        sacc[kk] = mfma32(a, qf[ks], sacc[kk]);
      }
    float mx = sacc[0][0];
#pragma unroll
    for (int kk = 0; kk < 2; ++kk)
#pragma unroll
      for (int r = 0; r < 16; ++r) mx = fmaxf(mx, sacc[kk][r]);
    mx = fmaxf(mx, __shfl_xor(mx, 32));
    const float mnew = fmaxf(m, mx);
    const float alpha = __builtin_amdgcn_exp2f(m - mnew);
    m = mnew;
    float ps = 0.f;
#pragma unroll
    for (int kk = 0; kk < 2; ++kk)
#pragma unroll
      for (int r = 0; r < 16; ++r) { const float p = __builtin_amdgcn_exp2f(sacc[kk][r] - mnew); sacc[kk][r] = p; ps += p; }
    lsum = lsum * alpha + ps;
#pragma unroll
    for (int dt = 0; dt < 2; ++dt)
#pragma unroll
      for (int r = 0; r < 16; ++r) oacc[dt][r] *= alpha;
#pragma unroll
    for (int kk = 0; kk < 2; ++kk)
#pragma unroll
      for (int s = 0; s < 2; ++s) {
        bf16x8 pb;
#pragma unroll
        for (int j = 0; j < 8; ++j) pb[j] = (__bf16)sacc[kk][8 * s + j];
#pragma unroll
        for (int dt = 0; dt < 2; ++dt) {
          const bf16x8 a = ldfrag(sV + (dt * 32 + l31) * LDVS + kk * 32 + s * 16 + hh * 8);
          oacc[dt] = mfma32(a, pb, oacc[dt]);
        }
      }
    if (kt + 1 < ntiles) swrite(cur ^ 1);
    __syncthreads();
  }
  lsum += __shfl_xor(lsum, 32);
  const float inv = 1.f / lsum;
  const int row = row_of(b, qpos0 + wave * 32 + l31);
  bf16* dst = P.H + (size_t)row * 1024 + 256 + h * 64;
#pragma unroll
  for (int dt = 0; dt < 2; ++dt)
#pragma unroll
    for (int rg = 0; rg < 4; ++rg) {
      const int d = dt * 32 + 8 * rg + 4 * hh;
      uint2 o;
      o.x = pack2(oacc[dt][4 * rg + 0] * inv, oacc[dt][4 * rg + 1] * inv);
      o.y = pack2(oacc[dt][4 * rg + 2] * inv, oacc[dt][4 * rg + 3] * inv);
      *reinterpret_cast<uint2*>(dst + d) = o;
    }
}

DEVI void phase_attn_scan(const Params& P, int l, unsigned char* smem) {
  const int n_attn = (l == 0) ? 1152 : 1024;
  const int total = 256 + n_attn;
  for (int it = VBID; it < total; it += NVB) {
    if (it < 256) { hgrn_scan_item(P, it); continue; }
    const int a = it - 256;
    if (a < 1024) attn_item(P, a >> 7, (a >> 4) & 7, 256 + 128 * (a & 15), 2304, smem);
    else { const int a2 = a - 1024; attn_item(P, a2 >> 4, (a2 >> 1) & 7, 128 * (a2 & 1), 256, smem); }
  }
}

DEVI unsigned ordkey(float s) { const unsigned u = __float_as_uint(s); return (u & 0x80000000u) ? ~u : (u | 0x80000000u); }
DEVI float keyval(unsigned k, unsigned mask) { const unsigned u = k & ~mask; return __uint_as_float((u & 0x80000000u) ? (u & 0x7fffffffu) : ~u); }
DEVI void ins16(unsigned (&lst)[16], unsigned v) {
#pragma unroll
  for (int j = 0; j < 16; ++j) { const unsigned hi = max(lst[j], v); v = min(lst[j], v); lst[j] = hi; }
}
DEVI void merge16(unsigned (&lst)[16], int xm) {
  unsigned o[16];
#pragma unroll
  for (int j = 0; j < 16; ++j) o[j] = (unsigned)__shfl_xor((int)lst[j], xm);
#pragma unroll
  for (int j = 0; j < 16; ++j) lst[j] = max(lst[j], o[15 - j]);
#pragma unroll
  for (int d = 8; d >= 1; d >>= 1)
#pragma unroll
    for (int j = 0; j < 16; ++j)
      if ((j & d) == 0) { const unsigned a = lst[j], bb = lst[j + d]; lst[j] = max(a, bb); lst[j + d] = min(a, bb); }
}

DEVI void phase_route(const Params& P, int l, unsigned char* smem) {
  const int tid = TIDX, lane = tid & 63, wave = tid >> 6, l31 = lane & 31, hh = lane >> 5;
  bf16* QT = reinterpret_cast<bf16*>(smem);
  float* SC = reinterpret_cast<float*>(smem + 33792);
  const int mtiles = (l == 1) ? 256 : 288;
  for (int it = VBID; it < mtiles * 8; it += NVB) {
    const int mt = it >> 3, h = it & 7;
    __syncthreads();
    for (int e = tid; e < 64 * 32; e += 256) {
      const int r = e >> 5, cc = e & 31;
      *reinterpret_cast<uint4*>(QT + r * 264 + cc * 8) = *reinterpret_cast<const uint4*>(P.QP + (size_t)(mt * 64 + r) * 2048 + h * 256 + cc * 8);
    }
    __syncthreads();
    unsigned lst[2][16];
    const int row = tid >> 2, part = tid & 3;
#pragma unroll
    for (int p = 0; p < 2; ++p) {
      f32x16 sa[2]; sa[0] = zero16(); sa[1] = zero16();
      const bf16* keys = P.SK + ((size_t)(l * 16 + h * 2 + p) * 128 + wave * 32 + l31) * 128;
#pragma unroll
      for (int ks = 0; ks < 8; ++ks) {
        const bf16x8 bfr = ldfrag(keys + ks * 16 + hh * 8);
#pragma unroll
        for (int i = 0; i < 2; ++i) {
          const bf16x8 af = ldfrag(QT + (i * 32 + l31) * 264 + p * 128 + ks * 16 + hh * 8);
          sa[i] = mfma32(af, bfr, sa[i]);
        }
      }
      if (p == 1) __syncthreads();
#pragma unroll
      for (int i = 0; i < 2; ++i)
#pragma unroll
        for (int r = 0; r < 16; ++r) SC[(i * 32 + drow(r, hh)) * 129 + wave * 32 + l31] = sa[i][r];
      __syncthreads();
#pragma unroll
      for (int j = 0; j < 16; ++j) lst[p][j] = 0u;
      for (int i = 0; i < 32; ++i) {
        const int idx = part * 32 + ((i + part * 8) & 31);
        const float s = SC[row * 129 + idx];
        const unsigned key = (ordkey(s) & ~0x7fu) | (unsigned)(127 - idx);
        ins16(lst[p], key);
      }
      merge16(lst[p], 1);
      merge16(lst[p], 2);
    }
    float v0[16], v1[16];
#pragma unroll
    for (int j = 0; j < 16; ++j) { v0[j] = keyval(lst[0][j], 0x7fu); v1[j] = keyval(lst[1][j], 0x7fu); }
    unsigned best[16];
#pragma unroll
    for (int j = 0; j < 16; ++j) best[j] = 0u;
#pragma unroll
    for (int a = 0; a < 16; ++a)
#pragma unroll
      for (int bq = 0; bq < 16; ++bq)
        if ((a + 1) * (bq + 1) <= 16) {
          const float sum = v0[a] + v1[bq];
          const unsigned key = (ordkey(sum) & ~0xffu) | (unsigned)(255 - (a * 16 + bq));
          ins16(best, key);
        }
    if (part == 0) {
      const float mx = keyval(best[0], 0xffu);
      float e[16]; float es = 0.f;
#pragma unroll
      for (int j = 0; j < 16; ++j) { e[j] = __expf(keyval(best[j], 0xffu) - mx); es += e[j]; }
      const float inv = 1.f / es;
      const int tok = mt * 64 + row;
      int* ed = P.EIDX + (size_t)tok * 128 + h * 16;
      float* gd = P.GATE + (size_t)tok * 128 + h * 16;
#pragma unroll
      for (int j = 0; j < 16; ++j) {
        const int flat = 255 - (int)(best[j] & 0xffu);
        const int a = flat >> 4, bq = flat & 15;
        int i1 = 0, i2 = 0;
#pragma unroll
        for (int u = 0; u < 16; ++u) {
          i1 = (a == u) ? (127 - (int)(lst[0][u] & 0x7fu)) : i1;
          i2 = (bq == u) ? (127 - (int)(lst[1][u] & 0x7fu)) : i2;
        }
        ed[j] = i1 * 128 + i2;
        gd[j] = e[j] * inv;
      }
    }
    __syncthreads();
  }
}

DEVI float gelu_exact(float a) { return 0.5f * a * (1.f + erff(a * 0.70710678118654752f)); }

typedef float f2 __attribute__((ext_vector_type(2)));
DEVI void phase_peer(const Params& P, int l) {
  const int lane = TIDX & 63;
  const int gw = VBID * 4 + (TIDX >> 6), nw = NVB * 4;
  const int nrows = (l == 1) ? NL : NT;
  const unsigned char* PU = P.PU8 + (size_t)l * 16384 * 1024 + lane * 16;
  const unsigned char* PV = P.PV8 + (size_t)l * 16384 * 1024 + lane * 16;
  const float* PUS = P.PUS + l * 16384;
  const float* PVS = P.PVS + l * 16384;
  const bool b5 = lane & 32, b4 = lane & 16, b3 = lane & 8, b2 = lane & 4;
  for (int t = gw; t < nrows; t += nw) {
    const uint4 hA = *reinterpret_cast<const uint4*>(P.H + (size_t)t * 1024 + lane * 16);
    const uint4 hB = *reinterpret_cast<const uint4*>(P.H + (size_t)t * 1024 + lane * 16 + 8);
    const int e0 = P.EIDX[(size_t)t * 128 + lane], e1 = P.EIDX[(size_t)t * 128 + 64 + lane];
    const float g0 = P.GATE[(size_t)t * 128 + lane], g1 = P.GATE[(size_t)t * 128 + 64 + lane];
    const float su0 = PUS[e0], su1 = PUS[e1];
    const float gv0 = g0 * PVS[e0], gv1 = g1 * PVS[e1];
    f2 h2[8];
    h2[0] = (f2){lo2f(hA.x), hi2f(hA.x)}; h2[1] = (f2){lo2f(hA.y), hi2f(hA.y)}; h2[2] = (f2){lo2f(hA.z), hi2f(hA.z)}; h2[3] = (f2){lo2f(hA.w), hi2f(hA.w)};
    h2[4] = (f2){lo2f(hB.x), hi2f(hB.x)}; h2[5] = (f2){lo2f(hB.y), hi2f(hB.y)}; h2[6] = (f2){lo2f(hB.z), hi2f(hB.z)}; h2[7] = (f2){lo2f(hB.w), hi2f(hB.w)};
    f2 y2[8];
#pragma unroll
    for (int i = 0; i < 8; ++i) y2[i] = (f2){0.f, 0.f};
    for (int kb = 0; kb < 8; ++kb) {
      const int esrc = kb < 4 ? e0 : e1;
      uint4 u[16], v[16];
#pragma unroll
      for (int i = 0; i < 16; ++i) {
        const int e = __shfl(esrc, (kb * 16 + i) & 63);
        u[i] = *reinterpret_cast<const uint4*>(PU + (size_t)e * 1024);
        v[i] = *reinterpret_cast<const uint4*>(PV + (size_t)e * 1024);
      }
      float d[16];
#pragma unroll
      for (int i = 0; i < 16; ++i) {
        f2 sacc = (f2){0.f, 0.f};
        sacc = __builtin_elementwise_fma(__builtin_amdgcn_cvt_pk_f32_fp8(u[i].x, false), h2[0], sacc);
        sacc = __builtin_elementwise_fma(__builtin_amdgcn_cvt_pk_f32_fp8(u[i].x, true), h2[1], sacc);
        sacc = __builtin_elementwise_fma(__builtin_amdgcn_cvt_pk_f32_fp8(u[i].y, false), h2[2], sacc);
        sacc = __builtin_elementwise_fma(__builtin_amdgcn_cvt_pk_f32_fp8(u[i].y, true), h2[3], sacc);
        sacc = __builtin_elementwise_fma(__builtin_amdgcn_cvt_pk_f32_fp8(u[i].z, false), h2[4], sacc);
        sacc = __builtin_elementwise_fma(__builtin_amdgcn_cvt_pk_f32_fp8(u[i].z, true), h2[5], sacc);
        sacc = __builtin_elementwise_fma(__builtin_amdgcn_cvt_pk_f32_fp8(u[i].w, false), h2[6], sacc);
        sacc = __builtin_elementwise_fma(__builtin_amdgcn_cvt_pk_f32_fp8(u[i].w, true), h2[7], sacc);
        d[i] = sacc.x + sacc.y;
      }
      float r8[8], r4[4], r2[2], r1;
#pragma unroll
      for (int i = 0; i < 8; ++i) { const float mine = b5 ? d[8 + i] : d[i]; const float send = b5 ? d[i] : d[8 + i]; r8[i] = mine + __shfl_xor(send, 32); }
#pragma unroll
      for (int i = 0; i < 4; ++i) { const float mine = b4 ? r8[4 + i] : r8[i]; const float send = b4 ? r8[i] : r8[4 + i]; r4[i] = mine + __shfl_xor(send, 16); }
#pragma unroll
      for (int i = 0; i < 2; ++i) { const float mine = b3 ? r4[2 + i] : r4[i]; const float send = b3 ? r4[i] : r4[2 + i]; r2[i] = mine + __shfl_xor(send, 8); }
      { const float mine = b2 ? r2[1] : r2[0]; const float send = b2 ? r2[0] : r2[1]; r1 = mine + __shfl_xor(send, 4); }
      r1 += __shfl_xor(r1, 2); r1 += __shfl_xor(r1, 1);
      const int src = (kb * 16 + (lane >> 2)) & 63;
      const float su = __shfl(kb < 4 ? su0 : su1, src);
      const float gv = __shfl(kb < 4 ? gv0 : gv1, src);
      const float w = gv * gelu_exact(r1 * su);
#pragma unroll
      for (int i = 0; i < 16; ++i) {
        const float wi = __shfl(w, i * 4);
        const f2 ww = (f2){wi, wi};
        y2[0] = __builtin_elementwise_fma(ww, __builtin_amdgcn_cvt_pk_f32_fp8(v[i].x, false), y2[0]);
        y2[1] = __builtin_elementwise_fma(ww, __builtin_amdgcn_cvt_pk_f32_fp8(v[i].x, true), y2[1]);
        y2[2] = __builtin_elementwise_fma(ww, __builtin_amdgcn_cvt_pk_f32_fp8(v[i].y, false), y2[2]);
        y2[3] = __builtin_elementwise_fma(ww, __builtin_amdgcn_cvt_pk_f32_fp8(v[i].y, true), y2[3]);
        y2[4] = __builtin_elementwise_fma(ww, __builtin_amdgcn_cvt_pk_f32_fp8(v[i].z, false), y2[4]);
        y2[5] = __builtin_elementwise_fma(ww, __builtin_amdgcn_cvt_pk_f32_fp8(v[i].z, true), y2[5]);
        y2[6] = __builtin_elementwise_fma(ww, __builtin_amdgcn_cvt_pk_f32_fp8(v[i].w, false), y2[6]);
        y2[7] = __builtin_elementwise_fma(ww, __builtin_amdgcn_cvt_pk_f32_fp8(v[i].w, true), y2[7]);
      }
    }
    float y[16];
#pragma unroll
    for (int i = 0; i < 8; ++i) { y[2 * i] = y2[i].x; y[2 * i + 1] = y2[i].y; }
    const int bi = batch_of_row(t);
    const float* gate2 = P.MOD + (size_t)(l * 9 + bi) * 6144 + 5 * 1024;
    float xn[16];
    float ss = 0.f;
#pragma unroll
    for (int q4 = 0; q4 < 4; ++q4) {
      const int d = lane * 16 + q4 * 4;
      const float4 xo = *reinterpret_cast<const float4*>(P.X + (size_t)t * 1024 + d);
      const float4 gg = *reinterpret_cast<const float4*>(gate2 + d);
      float4 o;
      o.x = xo.x + gg.x * y[q4 * 4 + 0]; o.y = xo.y + gg.y * y[q4 * 4 + 1];
      o.z = xo.z + gg.z * y[q4 * 4 + 2]; o.w = xo.w + gg.w * y[q4 * 4 + 3];
      xn[q4 * 4 + 0] = o.x; xn[q4 * 4 + 1] = o.y; xn[q4 * 4 + 2] = o.z; xn[q4 * 4 + 3] = o.w;
      ss += o.x * o.x + o.y * o.y + o.z * o.z + o.w * o.w;
      if (l == 1) *reinterpret_cast<float4*>(P.out + (size_t)t * 1024 + d) = o;
      else *reinterpret_cast<float4*>(P.X + (size_t)t * 1024 + d) = o;
    }
    if (l == 0) {
      ss = wave_sum(ss);
      const float rr = rsqrtf(ss * (1.f / 1024.f) + EPS);
      const float* lnw = P.ln1_w + 1024;
      const float* mod = P.MOD + (size_t)(9 + bi) * 6144;
      const int d = lane * 16;
      unsigned pk[8];
#pragma unroll
      for (int i = 0; i < 16; i += 2) {
        const float o0 = xn[i] * rr * lnw[d + i] * (1.f + mod[1024 + d + i]) + mod[d + i];
        const float o1 = xn[i + 1] * rr * lnw[d + i + 1] * (1.f + mod[1024 + d + i + 1]) + mod[d + i + 1];
        pk[i >> 1] = pack2(o0, o1);
      }
      *reinterpret_cast<uint4*>(P.H + (size_t)t * 1024 + d) = make_uint4(pk[0], pk[1], pk[2], pk[3]);
      *reinterpret_cast<uint4*>(P.H + (size_t)t * 1024 + d + 8) = make_uint4(pk[4], pk[5], pk[6], pk[7]);
    }
  }
}


using f32x4 = __attribute__((ext_vector_type(4))) float;
namespace g8 {
constexpr int BM = 256, BK = 64, HALF = 128, HT = HALF * BK;
DEVI int lds_byte(int r, int c) { const int st = (r >> 4) * 2 + (c >> 5), rr = r & 15, cc = c & 31, ob = rr * 64 + cc * 2; return st * 1024 + (ob ^ (((ob >> 9) & 1) << 5)); }
DEVI void stage_rc(int b, int& R, int& C) { const int st = b / 1024, sb = b % 1024, swz = sb ^ (((sb >> 9) & 1) << 5); R = (st >> 1) * 16 + swz / 64; C = (st & 1) * 32 + (swz % 64) / 2; }
DEVI void unit_of(int L, int nM, int nN, int& pm, int& pn) {
  const int nwg = nM * nN;
  int wgid = L;
  { const int q = nwg / 8, r = nwg % 8, xcd = wgid % 8, off = wgid / 8; wgid = (xcd < r ? xcd * (q + 1) : r * (q + 1) + (xcd - r) * q) + off; }
  const int nig = 8 * nN, gid = wgid / nig, fm = gid * 8, gsz = (nM - fm) < 8 ? (nM - fm) : 8;
  pm = fm + ((wgid % nig) % gsz); pn = (wgid % nig) / gsz;
}
}

struct G8Unit { int pm, pn; };
template <class Epi>
DEVI void gemm8_phase(LAS unsigned char* lds, const bf16* __restrict__ Ag, const bf16* __restrict__ Btg, const int K, const int nM, const int nN, const Epi& E) {
  constexpr int BK = 64, HALF = 128, HTB = HALF * BK * 2;
  const int tid = threadIdx.x, wid = __builtin_amdgcn_readfirstlane(tid >> 6), lane = tid & 63, wr = wid >> 2, wc = wid & 3, fr = lane & 15, fq = lane >> 4;
  const int nt = K / BK;
  const int nunits = nM * nN, G = gridDim.x, c = blockIdx.x;
  unsigned voffA[2];
#pragma unroll
  for (int i = 0; i < 2; ++i) { int R, C; g8::stage_rc(tid * 16 + i * 8192, R, C); voffA[i] = (unsigned)(R * K + C) * 2u; }
  const size_t kstep = (size_t)(BK * 2);
  const size_t hstep = (size_t)HALF * K * 2;
  const size_t tstep = 2 * hstep;
  const unsigned ldsw = (unsigned)wid * 1024u;
  const int aoff = g8::lds_byte(wr * 64 + fr, fq * 8), boff = g8::lds_byte(wc * 32 + fr, fq * 8);
#define PG8_SA(b, h) (((b) * 2 + (h)) * HTB)
#define PG8_SB(b, h) ((4 + (b) * 2 + (h)) * HTB)
#define PG8_STAGE(bufoff, gbase, voff) do { _Pragma("unroll") for (int _i = 0; _i < 2; ++_i) \
        __builtin_amdgcn_global_load_lds((const unsigned*)((const char*)(gbase) + (voff)[_i]), (LAS unsigned*)(lds + (bufoff) + ldsw + _i * 8192), 16, 0, 0); } while (0)
#define PG8_LDA(dst, b, h) do { _Pragma("unroll") for (int m = 0; m < 4; ++m) _Pragma("unroll") for (int k = 0; k < 2; ++k) dst[m][k] = *(const LAS bf16x8*)(lds + PG8_SA(b, h) + aoff + m * 2048 + k * 1024); } while (0)
#define PG8_LDB(dst, b, h) do { _Pragma("unroll") for (int n = 0; n < 2; ++n) _Pragma("unroll") for (int k = 0; k < 2; ++k) dst[n][k] = *(const LAS bf16x8*)(lds + PG8_SB(b, h) + boff + n * 2048 + k * 1024); } while (0)
#define PG8_MMA(ai, bj, At_, Bt_) do { __builtin_amdgcn_s_setprio(1); _Pragma("unroll") for (int m = 0; m < 4; ++m) _Pragma("unroll") for (int n = 0; n < 2; ++n) _Pragma("unroll") for (int k = 0; k < 2; ++k) \
        acc[ai][bj][m][n] = __builtin_amdgcn_mfma_f32_16x16x32_bf16(Bt_[n][k], At_[m][k], acc[ai][bj][m][n], 0, 0, 0); __builtin_amdgcn_s_setprio(0); } while (0)
#define PG8_WAIT_V(n) asm volatile("s_waitcnt vmcnt(" #n ")" ::: "memory")
#define PG8_WAIT_L(n) asm volatile("s_waitcnt lgkmcnt(" #n ")" ::: "memory")
#define PG8_BAR __builtin_amdgcn_s_barrier()
#define PG8_SCHED __builtin_amdgcn_sched_barrier(0)
  G8Unit cur, nxt; int ui = 0;
  if (c >= nunits) return;
  g8::unit_of(c, nM, nN, cur.pm, cur.pn);
  f32x4 acc[2][2][4][2];
#pragma unroll
  for (int a = 0; a < 2; ++a)
#pragma unroll
    for (int b = 0; b < 2; ++b)
#pragma unroll
      for (int m = 0; m < 4; ++m)
#pragma unroll
        for (int n = 0; n < 2; ++n) acc[a][b][m][n] = (f32x4){0.f, 0.f, 0.f, 0.f};
  bf16x8 At[4][2], B0[2][2], B1[2][2];
  const char* cA = (const char*)Ag + (size_t)cur.pm * tstep; const char* cB = (const char*)Btg + (size_t)cur.pn * tstep;
  PG8_STAGE(PG8_SB(0, 0), cB, voffA); PG8_STAGE(PG8_SA(0, 0), cA, voffA); PG8_STAGE(PG8_SB(0, 1), cB + hstep, voffA); PG8_STAGE(PG8_SA(0, 1), cA + hstep, voffA);
  if (wr == 1) PG8_BAR;
  PG8_WAIT_V(4); PG8_BAR;
  PG8_STAGE(PG8_SB(1, 0), cB + kstep, voffA); PG8_STAGE(PG8_SA(1, 0), cA + kstep, voffA); PG8_STAGE(PG8_SB(1, 1), cB + hstep + kstep, voffA);
  PG8_WAIT_V(6); PG8_BAR;
  for (;;) {
    const long Ln = (long)(ui + 1) * G + c;
    const bool has_next = Ln < nunits;
    if (has_next) g8::unit_of((int)Ln, nM, nN, nxt.pm, nxt.pn);
    const char* nA = has_next ? (const char*)Ag + (size_t)nxt.pm * tstep : cA; const char* nB = has_next ? (const char*)Btg + (size_t)nxt.pn * tstep : cB;
    for (int t = 0; t < nt; t += 2) {
      const bool last = (t == nt - 2);
      const char* a1 = cA + (size_t)(t + 1) * kstep;
      const char* a2 = last ? nA : cA + (size_t)(t + 2) * kstep; const char* b2 = last ? nB : cB + (size_t)(t + 2) * kstep;
      const char* a3 = a2 + kstep; const char* b3 = b2 + kstep;
      PG8_LDB(B0, 0, 0); PG8_SCHED; PG8_LDA(At, 0, 0); PG8_STAGE(PG8_SA(1, 1), a1 + hstep, voffA);
      PG8_WAIT_L(8); PG8_BAR; PG8_WAIT_L(0); PG8_MMA(0, 0, At, B0); PG8_BAR; PG8_SCHED;
      PG8_LDB(B1, 0, 1); PG8_STAGE(PG8_SB(0, 0), b2, voffA);
      PG8_BAR; PG8_WAIT_L(0); PG8_MMA(0, 1, At, B1); PG8_BAR;
      PG8_LDA(At, 0, 1); PG8_STAGE(PG8_SA(0, 0), a2, voffA);
      PG8_BAR; PG8_WAIT_L(0); PG8_MMA(1, 0, At, B0); PG8_BAR; PG8_SCHED;
      PG8_STAGE(PG8_SB(0, 1), b2 + hstep, voffA);
      PG8_WAIT_V(6); PG8_BAR; PG8_MMA(1, 1, At, B1); PG8_BAR;
      PG8_LDB(B0, 1, 0); PG8_SCHED; PG8_LDA(At, 1, 0); PG8_STAGE(PG8_SA(0, 1), a2 + hstep, voffA);
      PG8_WAIT_L(8); PG8_BAR; PG8_WAIT_L(0); PG8_MMA(0, 0, At, B0); PG8_BAR; PG8_SCHED;
      PG8_LDB(B1, 1, 1); PG8_STAGE(PG8_SB(1, 0), b3, voffA);
      PG8_BAR; PG8_WAIT_L(0); PG8_MMA(0, 1, At, B1); PG8_BAR;
      PG8_LDA(At, 1, 1); PG8_STAGE(PG8_SA(1, 0), a3, voffA);
      PG8_BAR; PG8_WAIT_L(0); PG8_MMA(1, 0, At, B0); PG8_BAR; PG8_SCHED;
      PG8_STAGE(PG8_SB(1, 1), b3 + hstep, voffA);
      PG8_WAIT_V(6); PG8_BAR; PG8_MMA(1, 1, At, B1); PG8_BAR;
    }
    E(acc, cur, wr, wc, fr, fq);
    if (!has_next) break;
#pragma unroll
    for (int a = 0; a < 2; ++a)
#pragma unroll
      for (int b = 0; b < 2; ++b)
#pragma unroll
        for (int m = 0; m < 4; ++m)
#pragma unroll
          for (int n = 0; n < 2; ++n) acc[a][b][m][n] = (f32x4){0.f, 0.f, 0.f, 0.f};
    cur = nxt; cA = nA; cB = nB; ++ui;
  }
  PG8_WAIT_V(0);
  if (wr == 0) PG8_BAR;
  PG8_BAR;
#undef PG8_SA
#undef PG8_SB
#undef PG8_STAGE
#undef PG8_LDA
#undef PG8_LDB
#undef PG8_MMA
}

struct EpiZ {
  bf16* Z;
  DEVI void operator()(const f32x4 (&acc)[2][2][4][2], const G8Unit& u, int wr, int wc, int fr, int fq) const {
    const int brow = u.pm * 256, bcol = u.pn * 256;
#pragma unroll
    for (int ai = 0; ai < 2; ++ai)
#pragma unroll
      for (int m = 0; m < 4; ++m) {
        const int row = brow + ai * 128 + wr * 64 + m * 16 + fr;
#pragma unroll
        for (int bj = 0; bj < 2; ++bj)
#pragma unroll
          for (int n = 0; n < 2; ++n) {
            const int col = bcol + bj * 128 + wc * 32 + n * 16 + 4 * fq;
            if (col < DIN) {
              const f32x4 v = acc[ai][bj][m][n];
              *reinterpret_cast<uint2*>(Z + (size_t)row * DIN + col) = make_uint2(pack2(v[0], v[1]), pack2(v[2], v[3]));
            }
          }
      }
  }
};
DEVI void phase_gemm1_8(const Params& P, int l, unsigned char* smem_base) {
  EpiZ E{P.Z};
  gemm8_phase((LAS unsigned char*)smem_base, P.H, P.WinT + (size_t)l * DINP * 1024, 1024, NT / 256, DINP / 256, E);
}

struct EpiX {
  const float* x; const float* ctx; float* X; const float* MODl; int l;
  DEVI void operator()(const f32x4 (&acc)[2][2][4][2], const G8Unit& u, int wr, int wc, int fr, int fq) const {
    const int brow = u.pm * 256, bcol = u.pn * 256;
    const float* gate = MODl + (size_t)batch_of_row(brow) * 6144 + 2048;
#pragma unroll
    for (int ai = 0; ai < 2; ++ai)
#pragma unroll
      for (int m = 0; m < 4; ++m) {
        const int row = brow + ai * 128 + wr * 64 + m * 16 + fr;
        const float* res = (l == 0) ? (row < NL ? x + (size_t)row * 1024 : ctx + (size_t)(row - NL) * 1024) : X + (size_t)row * 1024;
#pragma unroll
        for (int bj = 0; bj < 2; ++bj)
#pragma unroll
          for (int n = 0; n < 2; ++n) {
            const int col = bcol + bj * 128 + wc * 32 + n * 16 + 4 * fq;
            const f32x4 v = acc[ai][bj][m][n];
            const float4 r4 = *reinterpret_cast<const float4*>(res + col);
            const float4 g4 = *reinterpret_cast<const float4*>(gate + col);
            float4 o; o.x = r4.x + g4.x * v[0]; o.y = r4.y + g4.y * v[1]; o.z = r4.z + g4.z * v[2]; o.w = r4.w + g4.w * v[3];
            *reinterpret_cast<float4*>(X + (size_t)row * 1024 + col) = o;
          }
      }
  }
};
DEVI void phase_gemm2_8(const Params& P, int l, unsigned char* smem_base) {
  EpiX E{P.x, P.ctx, P.X, P.MOD + (size_t)l * 9 * 6144, l};
  gemm8_phase((LAS unsigned char*)smem_base, P.H, P.WoutT + (size_t)l * 1024 * 1024, 1024, (l == 1) ? NL / 256 : NT / 256, 4, E);
}

struct EpiQP {
  bf16* QP;
  DEVI void operator()(const f32x4 (&acc)[2][2][4][2], const G8Unit& u, int wr, int wc, int fr, int fq) const {
    const int brow = u.pm * 256, bcol = u.pn * 256;
#pragma unroll
    for (int ai = 0; ai < 2; ++ai)
#pragma unroll
      for (int m = 0; m < 4; ++m) {
        const int row = brow + ai * 128 + wr * 64 + m * 16 + fr;
#pragma unroll
        for (int bj = 0; bj < 2; ++bj)
#pragma unroll
          for (int n = 0; n < 2; ++n) {
            const int col = bcol + bj * 128 + wc * 32 + n * 16 + 4 * fq;
            const f32x4 v = acc[ai][bj][m][n];
            *reinterpret_cast<uint2*>(QP + (size_t)row * 2048 + col) = make_uint2(pack2(v[0], v[1]), pack2(v[2], v[3]));
          }
      }
  }
};
DEVI void phase_gemm3_8(const Params& P, int l, unsigned char* smem_base) {
  EpiQP E{P.QP};
  gemm8_phase((LAS unsigned char*)smem_base, P.H, P.WpqT + (size_t)l * 2048 * 1024, 1024, (l == 1) ? NL / 256 : NT / 256, 8, E);
}

constexpr int N_PHASES = 2 + 2 * 9;

#ifndef REP_MASK
#define REP_MASK 0
#endif
__global__ void __launch_bounds__(512, 2) fwd_kernel(Params P) {
  extern __shared__ __attribute__((aligned(16))) unsigned char smem_base[];
  unsigned char* smem = smem_base + VHALF * HALF_LDS;
  cg::grid_group grid = cg::this_grid();
  volatile LAS unsigned* xst = (volatile LAS unsigned*)(smem_base + SMEM_BYTES);
  if (threadIdx.x == 0) { xst[0] = 0u; xst[1] = 0u; xst[2] = 0u; xst[3] = 0u; }
  __syncthreads();
  XcdBarrier xb = xcd_barrier_post(P.bar, xst);
#define GSYNC(idx) { if ((idx) == 0) grid.sync(); else xcd_barrier(xb); }
#define RUN_PHASE(idx, call) \
  if (P.phase_lo <= (idx) && (idx) <= P.phase_hi) { call; if (REP_MASK & (1 << (idx))) { GSYNC(1); call; } if (P.coop && (idx) < P.phase_hi) GSYNC(idx); }
  RUN_PHASE(0, phase_prologue(P, smem))
  RUN_PHASE(1, phase_norm(P, 0, 0, NT))
  RUN_PHASE(2, phase_gemm1_8(P, 0, smem_base))
  RUN_PHASE(3, { phase_mixA(P, 0, smem); phase_mla_proj(P, 0, smem); phase_hgrn_local(P, 0, smem); })
  RUN_PHASE(4, phase_attn_scan(P, 0, smem))
  RUN_PHASE(5, phase_hgrn_final(P, 0, smem))
  RUN_PHASE(6, phase_gemm2_8(P, 0, smem_base))
  RUN_PHASE(7, phase_norm(P, 0, 1, NT))
  RUN_PHASE(8, phase_gemm3_8(P, 0, smem_base))
  RUN_PHASE(9, phase_route(P, 0, smem))
  RUN_PHASE(10, phase_peer(P, 0))
  RUN_PHASE(11, phase_gemm1_8(P, 1, smem_base))
  RUN_PHASE(12, { phase_mixA(P, 1, smem); phase_mla_proj(P, 1, smem); phase_hgrn_local(P, 1, smem); })
  RUN_PHASE(13, phase_attn_scan(P, 1, smem))
  RUN_PHASE(14, phase_hgrn_final(P, 1, smem))
  RUN_PHASE(15, phase_gemm2_8(P, 1, smem_base))
  RUN_PHASE(16, phase_norm(P, 1, 1, NL))
  RUN_PHASE(17, phase_gemm3_8(P, 1, smem_base))
  RUN_PHASE(18, phase_route(P, 1, smem))
  RUN_PHASE(19, phase_peer(P, 1))
}

extern "C" void kernel_launch(void* const* d_in, const int* in_sizes, int n_in, void* d_out, int out_size, void* d_ws,
                              size_t ws_size, hipStream_t stream) {
  Params p{};
  const float* const* in = reinterpret_cast<const float* const*>(d_in);
  p.x = in[0]; p.c = in[1]; p.ctx = in[2]; p.c_ctx = in[3]; p.ln1_w = in[4]; p.ln2_w = in[5]; p.w_mod = in[6]; p.b_mod = in[7];
  p.w_in = in[8]; p.w_out = in[9]; p.a_norm_w = in[10]; p.a_w_s = in[11]; p.a_b_s = in[12]; p.b_q_norm_w = in[13]; p.b_w_uq = in[14];
  p.b_kv_norm_w = in[15]; p.b_w_ukv = in[16]; p.b_qh_w = in[17]; p.b_kh_w = in[18]; p.c_lb = in[19]; p.c_out_norm_w = in[20];
  p.p_w_q = in[21]; p.p_sub_keys = in[22]; p.p_u = in[23]; p.p_v = in[24];
  p.out = reinterpret_cast<float*>(d_out);
  unsigned char* ws = reinterpret_cast<unsigned char*>(d_ws);
  size_t off = 0;
  auto take = [&](size_t bytes) { unsigned char* r = ws + off; off += (bytes + 255) & ~(size_t)255; return r; };
  p.bar = (unsigned*)take((size_t)XCD_BAR_WORDS * 4);
  p.MOD = (float*)take((size_t)2 * 9 * 6144 * 4);
  p.ROPE = (float*)take((size_t)2048 * 32 * 4);
  p.WinT = (bf16*)take((size_t)2 * DINP * 1024 * 2);
  p.WoutT = (bf16*)take((size_t)2 * 1024 * 1024 * 2);
  p.WpqT = (bf16*)take((size_t)2 * 2048 * 1024 * 2);
  p.WuqT = (bf16*)take((size_t)2 * 768 * 256 * 2);
  p.WukvT = (bf16*)take((size_t)2 * 1024 * 128 * 2);
  p.SK = (bf16*)take((size_t)2 * 16 * 128 * 128 * 2);
  p.AWS = (bf16*)take((size_t)2 * 4 * 128 * 128 * 2);
  p.PU8 = (unsigned char*)take((size_t)2 * 16384 * 1024);
  p.PV8 = (unsigned char*)take((size_t)2 * 16384 * 1024);
  p.PUS = (float*)take((size_t)2 * 16384 * 4);
  p.PVS = (float*)take((size_t)2 * 16384 * 4);
  p.X = (float*)take((size_t)NT * 1024 * 4);
  p.H = (bf16*)take((size_t)NT * 1024 * 2);
  p.Z = (bf16*)take((size_t)NT * DIN * 2);
  p.Q = (bf16*)take((size_t)64 * SEQP * 96 * 2);
  p.K = (bf16*)take((size_t)64 * SEQP * 96 * 2);
  p.VT = (bf16*)take((size_t)64 * 64 * SEQP * 2);
  p.ST = (float*)take((size_t)64 * 36 * 4096 * 4);
  p.DEC = (float*)take((size_t)64 * 36 * 64 * 4);
  p.OI = (float*)take((size_t)NT * 256 * 4);
  p.QP = p.Z;
  p.EIDX = (int*)p.Q;
  p.GATE = (float*)p.K;
  if (off > ws_size) { fprintf(stderr, "workspace too small: need %zu have %zu\n", off, ws_size); }
  static int grid_blocks = 0;
  if (!grid_blocks) {
    if (hipFuncSetAttribute((const void*)fwd_kernel, hipFuncAttributeMaxDynamicSharedMemorySize, SMEM_TOTAL) != hipSuccess)
      fprintf(stderr, "hipFuncSetAttribute failed\n");
    int dev = 0, cus = 0, per_cu = 0;
    hipGetDevice(&dev);
    hipDeviceGetAttribute(&cus, hipDeviceAttributeMultiprocessorCount, dev);
    hipOccupancyMaxActiveBlocksPerMultiprocessor(&per_cu, (const void*)fwd_kernel, 512, SMEM_TOTAL);
    if (per_cu > 1) per_cu = 1;
    if (per_cu < 1) { fprintf(stderr, "occupancy query returned %d\n", per_cu); per_cu = 1; }
    grid_blocks = cus * per_cu;
    fprintf(stderr, "grid_blocks=%d (cus=%d per_cu=%d) ws need=%zu have=%zu\n", grid_blocks, cus, per_cu, off, ws_size);
  }
  hipMemsetAsync(p.bar, 0, (size_t)XCD_BAR_WORDS * 4, stream);
  p.coop = 1; p.phase_lo = 0; p.phase_hi = N_PHASES - 1;
  void* args[] = {&p};
  const hipError_t e = hipLaunchCooperativeKernel((const void*)fwd_kernel, dim3(grid_blocks), dim3(512), args, SMEM_TOTAL, stream);
  if (e != hipSuccess) fprintf(stderr, "cooperative launch failed: %s (grid %d)\n", hipGetErrorString(e), grid_blocks);
}
```

```cpp
#include <hip/hip_runtime.h>
#include <hip/hip_cooperative_groups.h>
#include <cstdio>
#include <cstdint>
namespace cg = cooperative_groups;

#define DEVI __device__ __forceinline__

typedef unsigned short bf16;
using bf16x8 = __attribute__((ext_vector_type(8))) __bf16;
using bf16x2 = __attribute__((ext_vector_type(2))) __bf16;
using f32x16 = __attribute__((ext_vector_type(16))) float;

constexpr int NL = 16384;
constexpr int NT = 18432;
constexpr int DM = 1024;
constexpr int DIN = 2208;
constexpr int DINP = 2304;
constexpr int SEQP = 2304;
constexpr float EPS = 1e-6f;
constexpr int ZC_AU = 0, ZC_AV = 256, ZC_BQ = 512, ZC_BKV = 768, ZC_BKR = 896, ZC_CQ = 928, ZC_CFF = 1184, ZC_CFB = 1440, ZC_CI = 1696, ZC_CG = 1952;
constexpr int SMEM_BYTES = 2 * 80896;
constexpr int SMEM_TOTAL = SMEM_BYTES + 16;

struct Params {
  const float *x, *c, *ctx, *c_ctx, *ln1_w, *ln2_w, *w_mod, *b_mod, *w_in, *w_out, *a_norm_w, *a_w_s, *a_b_s;
  const float *b_q_norm_w, *b_w_uq, *b_kv_norm_w, *b_w_ukv, *b_qh_w, *b_kh_w, *c_lb, *c_out_norm_w, *p_w_q, *p_sub_keys, *p_u, *p_v;
  float* out;
  unsigned* bar;
  float* MOD;
  float* ROPE;
  bf16* WinT;
  bf16* WoutT;
  bf16* WpqT;
  bf16* WuqT;
  bf16* WukvT;
  bf16* SK;
  bf16* AWS;
  unsigned char* PU8;
  unsigned char* PV8;
  float* PUS;
  float* PVS;
  float* X;
  bf16* H;
  bf16* Z;
  bf16* Q;
  bf16* K;
  bf16* VT;
  float* ST;
  float* DEC;
  float* OI;
  bf16* QP;
  int* EIDX;
  float* GATE;
  int phase_lo, phase_hi, coop, pad0;
};

DEVI float bf2f(bf16 v) { return __uint_as_float(((unsigned)v) << 16); }
DEVI bf16 f2bf(float a) { __bf16 v = (__bf16)a; return __builtin_bit_cast(unsigned short, v); }
DEVI unsigned pack2(float a, float b) { bf16x2 v; v[0] = (__bf16)a; v[1] = (__bf16)b; return __builtin_bit_cast(unsigned, v); }
DEVI float lo2f(unsigned u) { return __uint_as_float(u << 16); }
DEVI float hi2f(unsigned u) { return __uint_as_float(u & 0xffff0000u); }
DEVI f32x16 zero16() { f32x16 z;
#pragma unroll
  for (int i = 0; i < 16; ++i) z[i] = 0.f; return z; }
DEVI f32x16 mfma32(bf16x8 a, bf16x8 b, f32x16 c) { return __builtin_amdgcn_mfma_f32_32x32x16_bf16(a, b, c, 0, 0, 0); }
DEVI bf16x8 ldfrag(const bf16* p) { return *reinterpret_cast<const bf16x8*>(p); }
DEVI int drow(int r, int hh) { return (r & 3) + 8 * (r >> 2) + 4 * hh; }
DEVI int row_of(int b, int p) { return p < 256 ? NL + b * 256 + p : b * 2048 + (p - 256); }
DEVI int batch_of_row(int r) { return r < NL ? (r >> 11) : 8; }
DEVI float wave_sum(float v) {
#pragma unroll
  for (int o = 32; o > 0; o >>= 1) v += __shfl_xor(v, o);
  return v;
}
DEVI float sigmoidf_(float z) { return 1.f / (1.f + __expf(-z)); }


#define XB_TMO      128
#define XB_XCNT(j)  (256  + 64 * (j))
#define XB_XSUB(j)  (1280 + 64 * (j))
#define XB_XGEN(j)  (2304 + 64 * (j))
#define XB_TOP      3328
#define XB_TOPGEN   3392
#define XCD_BAR_WORDS 3456
#define XB_SPIN_CAP (1u << 22)
#define LAS __attribute__((address_space(3)))
DEVI unsigned xb_ld(unsigned* p)              { return __hip_atomic_load(p, __ATOMIC_RELAXED, __HIP_MEMORY_SCOPE_AGENT); }
DEVI unsigned xb_add(unsigned* p, unsigned v) { return __hip_atomic_fetch_add(p, v, __ATOMIC_RELAXED, __HIP_MEMORY_SCOPE_AGENT); }
DEVI unsigned xb_xcc_id() { return (unsigned)__builtin_amdgcn_s_getreg((3 << 11) | 20) & 0xFu; }
#define XB_SPIN(cond, bar) do { unsigned _sp = 0; while (cond) { __builtin_amdgcn_s_sleep(1); \
    if ((++_sp & 255u) == 0u) { if (xb_ld(&(bar)[XB_TMO])) break; if (_sp > XB_SPIN_CAP) { atomicAdd(&(bar)[XB_TMO], 1u); break; } } } } while (0)
struct XcdBarrier { unsigned* bar; unsigned x; volatile LAS unsigned* st; };
DEVI XcdBarrier xcd_barrier_post(unsigned* bar, volatile LAS unsigned* st) {
  XcdBarrier b; b.bar = bar; b.x = xb_xcc_id(); b.st = st;
  if (threadIdx.x == 0) (void)xb_add(&bar[XB_XCNT(b.x)], 1u);
  return b;
}
DEVI void xcd_barrier_complete(unsigned* bar, unsigned x, unsigned& nloc, unsigned& nx) {
  const unsigned G = gridDim.x * gridDim.y * gridDim.z;
  unsigned sum, cnt, mine, sp = 0u;
  for (;;) {
    sum = 0u; cnt = 0u; mine = 0u;
#pragma unroll
    for (unsigned j = 0; j < 16; ++j) { const unsigned c = xb_ld(&bar[XB_XCNT(j)]); sum += c; cnt += (c > 0u) ? 1u : 0u; mine = (j == x) ? c : mine; }
    if (sum == G) break;
    __builtin_amdgcn_s_sleep(1);
    if ((++sp & 255u) == 0u) { if (xb_ld(&bar[XB_TMO])) break; if (sp > XB_SPIN_CAP) { atomicAdd(&bar[XB_TMO], 1u); break; } }
  }
  nloc = mine > 0u ? mine : 1u; nx = cnt > 0u ? cnt : 1u;
}
DEVI void xcd_barrier(const XcdBarrier& b) {
  asm volatile("s_waitcnt vmcnt(0)" ::: "memory");
  __syncthreads();
  if (threadIdx.x == 0) {
    unsigned* bar = b.bar;
    __builtin_amdgcn_s_waitcnt(0);
    unsigned nloc = b.st[0], nx = b.st[1];
    if (nloc == 0u) { xcd_barrier_complete(bar, b.x, nloc, nx); b.st[0] = nloc; b.st[1] = nx; }
    const unsigned old = xb_add(&bar[XB_XSUB(b.x)], 1u);
    const unsigned gen = old / nloc;
    if (old + 1u == (gen + 1u) * nloc) {
      __builtin_amdgcn_fence(__ATOMIC_RELEASE, "agent");
      asm volatile("s_waitcnt vmcnt(0)" ::: "memory");
      const unsigned og = xb_add(&bar[XB_TOP], 1u);
      const unsigned tg = og / nx;
      if (og + 1u == (tg + 1u) * nx) xb_add(&bar[XB_TOPGEN], 1u);
      else XB_SPIN(xb_ld(&bar[XB_TOPGEN]) == tg, bar);
      __builtin_amdgcn_fence(__ATOMIC_ACQUIRE, "agent");
      xb_add(&bar[XB_XGEN(b.x)], 1u);
      asm volatile("s_waitcnt vmcnt(0)" ::: "memory");
    } else {
      XB_SPIN(xb_ld(&bar[XB_XGEN(b.x)]) == gen, bar);
      __builtin_amdgcn_fence(__ATOMIC_ACQUIRE, "agent");
      asm volatile("s_waitcnt vmcnt(0)" ::: "memory");
    }
  }
  __syncthreads();
}

#define VHALF ((int)__builtin_amdgcn_readfirstlane((int)(threadIdx.x >> 8)))
#define TIDX ((int)(threadIdx.x & 255))
#define VBID ((int)(blockIdx.x * 2 + VHALF))
#define NVB ((int)(gridDim.x * 2))
constexpr int HALF_LDS = 80896;

DEVI void phase_mod(const Params& P, unsigned char* smem) {
  const int tid = TIDX;
  float* s = (float*)smem;
  float* red = s + 9 * 1024;
  for (int item = VBID; item < 192; item += NVB) {
    const int l = item / 96, j = item % 96;
    __syncthreads();
    for (int i = tid; i < 9 * 1024; i += 256) {
      int bi = i >> 10, k = i & 1023;
      float v = bi < 8 ? P.c[bi * 1024 + k] : P.c_ctx[k];
      s[i] = v * sigmoidf_(v);
    }
    __syncthreads();
    const int c4 = tid & 15, kg = tid >> 4;
    float acc[9][4];
#pragma unroll
    for (int bi = 0; bi < 9; ++bi) { acc[bi][0] = acc[bi][1] = acc[bi][2] = acc[bi][3] = 0.f; }
    const float* w = P.w_mod + (size_t)l * 1024 * 6144 + j * 64 + c4 * 4;
#pragma unroll 4
    for (int kk = 0; kk < 64; ++kk) {
      const int k = kg * 64 + kk;
      const float4 w4 = *reinterpret_cast<const float4*>(w + (size_t)k * 6144);
#pragma unroll
      for (int bi = 0; bi < 9; ++bi) {
        const float sv = s[bi * 1024 + k];
        acc[bi][0] += sv * w4.x; acc[bi][1] += sv * w4.y; acc[bi][2] += sv * w4.z; acc[bi][3] += sv * w4.w;
      }
    }
#pragma unroll
    for (int bi = 0; bi < 9; ++bi)
#pragma unroll
      for (int e = 0; e < 4; ++e) red[(kg * 9 + bi) * 64 + c4 * 4 + e] = acc[bi][e];
    __syncthreads();
    for (int o = tid; o < 576; o += 256) {
      const int bi = o >> 6, cc = o & 63;
      float sum = 0.f;
#pragma unroll
      for (int g = 0; g < 16; ++g) sum += red[(g * 9 + bi) * 64 + cc];
      P.MOD[(size_t)(l * 9 + bi) * 6144 + j * 64 + cc] = sum + P.b_mod[l * 6144 + j * 64 + cc];
    }
  }
}

DEVI void conv_T_tile(const float* __restrict__ src, int N, bf16* __restrict__ dst, int Kd, int k0, int n0,
                      const float* __restrict__ kscale, float* tile) {
  const int tid = TIDX;
  __syncthreads();
  for (int e = tid; e < 4096; e += 256) {
    const int i = e >> 6, j = e & 63, n = n0 + j;
    float v = (n < N) ? src[(size_t)(k0 + i) * N + n] : 0.f;
    if (kscale) v *= kscale[k0 + i];
    tile[i * 65 + j] = v;
  }
  __syncthreads();
  for (int e = tid; e < 2048; e += 256) {
    const int j = e >> 5, i2 = (e & 31) * 2;
    const unsigned pk = pack2(tile[i2 * 65 + j], tile[(i2 + 1) * 65 + j]);
    *reinterpret_cast<unsigned*>(&dst[(size_t)(n0 + j) * Kd + k0 + i2]) = pk;
  }
}

DEVI void conv_straight(const float* __restrict__ src, bf16* __restrict__ dst, size_t n8) {
  const size_t stride = (size_t)NVB * 256;
  for (size_t i = (size_t)VBID * 256 + TIDX; i < n8; i += stride) {
    const float4 a = reinterpret_cast<const float4*>(src)[2 * i];
    const float4 b = reinterpret_cast<const float4*>(src)[2 * i + 1];
    uint4 o; o.x = pack2(a.x, a.y); o.y = pack2(a.z, a.w); o.z = pack2(b.x, b.y); o.w = pack2(b.z, b.w);
    reinterpret_cast<uint4*>(dst)[i] = o;
  }
}

DEVI void phase_prologue(const Params& P, unsigned char* smem) {
  phase_mod(P, smem);
  float* tile = (float*)smem;
  for (int it = VBID; it < 2 * 1424; it += NVB) {
    const int l = it / 1424; int r = it % 1424;
    if (r < 576) { conv_T_tile(P.w_in + (size_t)l * 1024 * DIN, DIN, P.WinT + (size_t)l * DINP * 1024, 1024, (r % 16) * 64, (r / 16) * 64, nullptr, tile); continue; }
    r -= 576;
    if (r < 256) { conv_T_tile(P.w_out + (size_t)l * 1024 * 1024, 1024, P.WoutT + (size_t)l * 1024 * 1024, 1024, (r % 16) * 64, (r / 16) * 64, nullptr, tile); continue; }
    r -= 256;
    if (r < 512) { conv_T_tile(P.p_w_q + (size_t)l * 1024 * 2048, 2048, P.WpqT + (size_t)l * 2048 * 1024, 1024, (r % 16) * 64, (r / 16) * 64, nullptr, tile); continue; }
    r -= 512;
    if (r < 48) { conv_T_tile(P.b_w_uq + (size_t)l * 256 * 768, 768, P.WuqT + (size_t)l * 768 * 256, 256, (r % 4) * 64, (r / 4) * 64, P.b_q_norm_w + l * 256, tile); continue; }
    r -= 48;
    conv_T_tile(P.b_w_ukv + (size_t)l * 128 * 1024, 1024, P.WukvT + (size_t)l * 1024 * 128, 128, (r % 2) * 64, (r / 2) * 64, P.b_kv_norm_w + l * 128, tile);
  }
  conv_straight(P.p_sub_keys, P.SK, (size_t)2 * 16 * 128 * 128 / 8);
  conv_straight(P.a_w_s, P.AWS, (size_t)2 * 4 * 128 * 128 / 8);
  {
    const int lane = TIDX & 63;
    const int gw = VBID * 4 + (TIDX >> 6), nw = NVB * 4;
    for (int r = gw; r < 65536; r += nw) {
      const int table = r >> 15, lr = r & 32767;
      const float* src = (table ? P.p_v : P.p_u) + (size_t)lr * 1024 + lane * 16;
      float4 a[4];
      float m = 0.f;
#pragma unroll
      for (int i = 0; i < 4; ++i) {
        a[i] = *reinterpret_cast<const float4*>(src + i * 4);
        m = fmaxf(m, fmaxf(fmaxf(fabsf(a[i].x), fabsf(a[i].y)), fmaxf(fabsf(a[i].z), fabsf(a[i].w))));
      }
#pragma unroll
      for (int o = 32; o > 0; o >>= 1) m = fmaxf(m, __shfl_xor(m, o));
      const float sc = fmaxf(m, 1e-30f) * (1.f / 448.f);
      const float inv = 1.f / sc;
      unsigned w[4];
#pragma unroll
      for (int i = 0; i < 4; ++i) {
        int ww = 0;
        ww = __builtin_amdgcn_cvt_pk_fp8_f32(a[i].x * inv, a[i].y * inv, ww, false);
        ww = __builtin_amdgcn_cvt_pk_fp8_f32(a[i].z * inv, a[i].w * inv, ww, true);
        w[i] = (unsigned)ww;
      }
      unsigned char* dst = (table ? P.PV8 : P.PU8) + (size_t)lr * 1024 + lane * 16;
      *reinterpret_cast<uint4*>(dst) = make_uint4(w[0], w[1], w[2], w[3]);
      if (lane == 0) (table ? P.PVS : P.PUS)[lr] = sc;
    }
  }
  for (int i = VBID * 256 + TIDX; i < 2048 * 16; i += NVB * 256) {
    const int t = i >> 4, a = (i >> 3) & 1, f = i & 7;
    const float inv = powf(10000.f, -(float)f / 8.f);
    const float pos = a ? (float)(t & 63) : (float)(t >> 6);
    const float ang = pos * inv;
    P.ROPE[t * 32 + a * 8 + f] = cosf(ang);
    P.ROPE[t * 32 + 16 + a * 8 + f] = sinf(ang);
  }
}

DEVI void phase_norm(const Params& P, int l, int which, int nrows) {
  const int lane = TIDX & 63;
  const int gw = VBID * 4 + (TIDX >> 6), nw = NVB * 4;
  const float* lnw = (which == 0 ? P.ln1_w : P.ln2_w) + l * 1024;
  for (int r = gw; r < nrows; r += nw) {
    const float* src;
    if (which == 0 && l == 0) src = r < NL ? P.x + (size_t)r * 1024 : P.ctx + (size_t)(r - NL) * 1024;
    else src = P.X + (size_t)r * 1024;
    const float* mod = P.MOD + (size_t)(l * 9 + batch_of_row(r)) * 6144 + which * 3072;
    float4 v[4];
    float ss = 0.f;
#pragma unroll
    for (int i = 0; i < 4; ++i) {
      v[i] = *reinterpret_cast<const float4*>(src + i * 256 + lane * 4);
      ss += v[i].x * v[i].x + v[i].y * v[i].y + v[i].z * v[i].z + v[i].w * v[i].w;
    }
    ss = wave_sum(ss);
    const float rr = rsqrtf(ss * (1.f / 1024.f) + EPS);
#pragma unroll
    for (int i = 0; i < 4; ++i) {
      const int d = i * 256 + lane * 4;
      const float4 w = *reinterpret_cast<const float4*>(lnw + d);
      const float4 sh = *reinterpret_cast<const float4*>(mod + d);
      const float4 sc = *reinterpret_cast<const float4*>(mod + 1024 + d);
      const float o0 = v[i].x * rr * w.x * (1.f + sc.x) + sh.x;
      const float o1 = v[i].y * rr * w.y * (1.f + sc.y) + sh.y;
      const float o2 = v[i].z * rr * w.z * (1.f + sc.z) + sh.z;
      const float o3 = v[i].w * rr * w.w * (1.f + sc.w) + sh.w;
      uint2 o; o.x = pack2(o0, o1); o.y = pack2(o2, o3);
      *reinterpret_cast<uint2*>(P.H + (size_t)r * 1024 + d) = o;
    }
  }
}

template <int BM, int BN, int BK, int WM, int WN>
struct Gemm {
  static constexpr int LDK = BK + 8;
  static constexpr int TM = BM / WM / 32, TN = BN / WN / 32;
  static constexpr int CPR = BK / 8;
  static constexpr int NA = BM * CPR / 256, NB = BN * CPR / 256;
  static constexpr int A_BYTES = BM * LDK * 2, B_BYTES = BN * LDK * 2;
  static constexpr int STAGE_BYTES = A_BYTES + B_BYTES;
  static constexpr int SMEM = 2 * STAGE_BYTES;

  static DEVI void run(const bf16* __restrict__ A, int lda, const bf16* __restrict__ BT, int ldb, int K,
                       unsigned char* smem, f32x16 (&acc)[TM][TN]) {
    const int tid = TIDX, lane = tid & 63, wave = tid >> 6;
    const int wm = wave / WN, wn = wave % WN;
    const int l31 = lane & 31, hh = lane >> 5;
#pragma unroll
    for (int i = 0; i < TM; ++i)
#pragma unroll
      for (int j = 0; j < TN; ++j) acc[i][j] = zero16();
    uint4 ra[NA], rb[NB];
    const int nk = K / BK;
    auto gload = [&](int kt) {
#pragma unroll
      for (int i = 0; i < NA; ++i) { const int ch = tid + i * 256, row = ch / CPR, cc = ch % CPR;
        ra[i] = *reinterpret_cast<const uint4*>(A + (size_t)row * lda + kt * BK + cc * 8); }
#pragma unroll
      for (int i = 0; i < NB; ++i) { const int ch = tid + i * 256, row = ch / CPR, cc = ch % CPR;
        rb[i] = *reinterpret_cast<const uint4*>(BT + (size_t)row * ldb + kt * BK + cc * 8); }
    };
    auto swrite = [&](int buf) {
      bf16* sA = reinterpret_cast<bf16*>(smem + buf * STAGE_BYTES);
      bf16* sB = reinterpret_cast<bf16*>(smem + buf * STAGE_BYTES + A_BYTES);
#pragma unroll
      for (int i = 0; i < NA; ++i) { const int ch = tid + i * 256, row = ch / CPR, cc = ch % CPR;
        *reinterpret_cast<uint4*>(sA + row * LDK + cc * 8) = ra[i]; }
#pragma unroll
      for (int i = 0; i < NB; ++i) { const int ch = tid + i * 256, row = ch / CPR, cc = ch % CPR;
        *reinterpret_cast<uint4*>(sB + row * LDK + cc * 8) = rb[i]; }
    };
    __syncthreads();
    gload(0);
    swrite(0);
    __syncthreads();
    for (int kt = 0; kt < nk; ++kt) {
      const int cur = kt & 1;
      if (kt + 1 < nk) gload(kt + 1);
      const bf16* sA = reinterpret_cast<const bf16*>(smem + cur * STAGE_BYTES);
      const bf16* sB = reinterpret_cast<const bf16*>(smem + cur * STAGE_BYTES + A_BYTES);
#pragma unroll
      for (int ks = 0; ks < BK / 16; ++ks) {
        bf16x8 af[TM], bfr[TN];
#pragma unroll
        for (int i = 0; i < TM; ++i) af[i] = ldfrag(sA + (wm * (BM / WM) + i * 32 + l31) * LDK + ks * 16 + hh * 8);
#pragma unroll
        for (int j = 0; j < TN; ++j) bfr[j] = ldfrag(sB + (wn * (BN / WN) + j * 32 + l31) * LDK + ks * 16 + hh * 8);
#pragma unroll
        for (int i = 0; i < TM; ++i)
#pragma unroll
          for (int j = 0; j < TN; ++j) acc[i][j] = mfma32(af[i], bfr[j], acc[i][j]);
      }
      if (kt + 1 < nk) swrite(cur ^ 1);
      __syncthreads();
    }
  }
};

DEVI void phase_gemm1(const Params& P, int l, unsigned char* smem) {
  using G = Gemm<128, 128, 64, 2, 2>;
  const int lane = TIDX & 63, wave = TIDX >> 6, wm = wave >> 1, wn = wave & 1, l31 = lane & 31, hh = lane >> 5;
  const bf16* W = P.WinT + (size_t)l * DINP * 1024;
  for (int t = VBID; t < 144 * 18; t += NVB) {
    const int mt = t / 18, nt = t % 18;
    f32x16 acc[2][2];
    G::run(P.H + (size_t)mt * 128 * 1024, 1024, W + (size_t)nt * 128 * 1024, 1024, 1024, smem, acc);
#pragma unroll
    for (int i = 0; i < 2; ++i)
#pragma unroll
      for (int j = 0; j < 2; ++j) {
        const int col = nt * 128 + wn * 64 + j * 32 + l31;
        if (col < DIN) {
#pragma unroll
          for (int r = 0; r < 16; ++r) {
            const int row = mt * 128 + wm * 64 + i * 32 + drow(r, hh);
            P.Z[(size_t)row * DIN + col] = f2bf(acc[i][j][r]);
          }
        }
      }
  }
}

DEVI void phase_gemm2(const Params& P, int l, unsigned char* smem) {
  using G = Gemm<128, 128, 64, 2, 2>;
  const int lane = TIDX & 63, wave = TIDX >> 6, wm = wave >> 1, wn = wave & 1, l31 = lane & 31, hh = lane >> 5;
  const bf16* W = P.WoutT + (size_t)l * 1024 * 1024;
  const int mtiles = (l == 1) ? 128 : 144;
  for (int t = VBID; t < mtiles * 8; t += NVB) {
    const int mt = t / 8, nt = t % 8;
    f32x16 acc[2][2];
    G::run(P.H + (size_t)mt * 128 * 1024, 1024, W + (size_t)nt * 128 * 1024, 1024, 1024, smem, acc);
    const int bi = batch_of_row(mt * 128);
    const float* gate = P.MOD + (size_t)(l * 9 + bi) * 6144 + 2048;
#pragma unroll
    for (int i = 0; i < 2; ++i)
#pragma unroll
      for (int j = 0; j < 2; ++j) {
        const int col = nt * 128 + wn * 64 + j * 32 + l31;
        const float g = gate[col];
#pragma unroll
        for (int r = 0; r < 16; ++r) {
          const int row = mt * 128 + wm * 64 + i * 32 + drow(r, hh);
          float res;
          if (l == 0) res = row < NL ? P.x[(size_t)row * 1024 + col] : P.ctx[(size_t)(row - NL) * 1024 + col];
          else res = P.X[(size_t)row * 1024 + col];
          P.X[(size_t)row * 1024 + col] = res + g * acc[i][j][r];
        }
      }
  }
}

DEVI void phase_mixA(const Params& P, int l, unsigned char* smem) {
  const int tid = TIDX, lane = tid & 63, wave = tid >> 6, l31 = lane & 31, hh = lane >> 5;
  bf16* VNT = reinterpret_cast<bf16*>(smem);
  constexpr int LDV = 136;
  const int nseg = (l == 1) ? 16 : 18;
  const int seg0 = (l == 1) ? 2 : 0;
  for (int it = VBID; it < 8 * nseg * 4; it += NVB) {
    const int a = it & 3; const int sj = (it >> 2) % nseg + seg0; const int b = (it >> 2) / nseg;
    const int p0 = sj * 128;
    __syncthreads();
    {
      const int q = tid >> 1, half = tid & 1;
      const int row = row_of(b, p0 + q);
      const bf16* src = P.Z + (size_t)row * DIN + ZC_AV + a * 64 + half * 32;
      float v[32];
      float ss = 0.f;
#pragma unroll
      for (int i = 0; i < 4; ++i) {
        const uint4 u = *reinterpret_cast<const uint4*>(src + i * 8);
        v[i * 8 + 0] = lo2f(u.x); v[i * 8 + 1] = hi2f(u.x); v[i * 8 + 2] = lo2f(u.y); v[i * 8 + 3] = hi2f(u.y);
        v[i * 8 + 4] = lo2f(u.z); v[i * 8 + 5] = hi2f(u.z); v[i * 8 + 6] = lo2f(u.w); v[i * 8 + 7] = hi2f(u.w);
      }
#pragma unroll
      for (int i = 0; i < 32; ++i) ss += v[i] * v[i];
      ss += __shfl_xor(ss, 1);
      const float rr = rsqrtf(ss * (1.f / 64.f) + EPS);
      const float* nw = P.a_norm_w + l * 256 + a * 64 + half * 32;
#pragma unroll
      for (int i = 0; i < 32; ++i) VNT[(half * 32 + i) * LDV + q] = f2bf(v[i] * rr * nw[i]);
    }
    __syncthreads();
    f32x16 acc[2]; acc[0] = zero16(); acc[1] = zero16();
    const bf16* Aw = P.AWS + (size_t)(l * 4 + a) * 128 * 128 + (size_t)(wave * 32 + l31) * 128;
#pragma unroll
    for (int ks = 0; ks < 8; ++ks) {
      const bf16x8 af = ldfrag(Aw + ks * 16 + hh * 8);
#pragma unroll
      for (int j = 0; j < 2; ++j) {
        const bf16x8 bfr = ldfrag(VNT + (j * 32 + l31) * LDV + ks * 16 + hh * 8);
        acc[j] = mfma32(af, bfr, acc[j]);
      }
    }
    const float* bs = P.a_b_s + (l * 4 + a) * 128;
#pragma unroll
    for (int j = 0; j < 2; ++j)
#pragma unroll
      for (int r = 0; r < 16; ++r) {
        const int p = wave * 32 + drow(r, hh);
        const int row = row_of(b, p0 + p);
        const int col = a * 64 + j * 32 + l31;
        const float u = bf2f(P.Z[(size_t)row * DIN + ZC_AU + col]);
        P.H[(size_t)row * 1024 + col] = f2bf(u * (acc[j][r] + bs[p]));
      }
  }
}

DEVI void mla_norm_rope_store(const Params& P, const float* T, const float* nw, bool rope, float oscale,
                              bf16* dstbase  , int pos0, int tlat0) {
  const int tid = TIDX, tok = tid >> 1, half = tid & 1;
  float v[48];
  float ss = 0.f;
#pragma unroll
  for (int i = 0; i < 48; ++i) { v[i] = T[tok * 97 + half * 48 + i]; ss += v[i] * v[i]; }
  ss += __shfl_xor(ss, 1);
  const float rr = rsqrtf(ss * (1.f / 96.f) + EPS);
#pragma unroll
  for (int i = 0; i < 48; ++i) v[i] = v[i] * rr * nw[half * 48 + i];
  if (rope && half == 1) {
    const float* cs = P.ROPE + (size_t)(tlat0 + tok) * 32;
#pragma unroll
    for (int a = 0; a < 2; ++a)
#pragma unroll
      for (int f = 0; f < 8; ++f) {
        const float x1 = v[16 + a * 16 + f], x2 = v[16 + a * 16 + 8 + f];
        const float c = cs[a * 8 + f], s = cs[16 + a * 8 + f];
        v[16 + a * 16 + f] = x1 * c - x2 * s;
        v[16 + a * 16 + 8 + f] = x2 * c + x1 * s;
      }
  }
  bf16* dst = dstbase + (size_t)(pos0 + tok) * 96 + half * 48;
#pragma unroll
  for (int i = 0; i < 6; ++i) {
    uint4 o;
    o.x = pack2(v[i * 8 + 0] * oscale, v[i * 8 + 1] * oscale); o.y = pack2(v[i * 8 + 2] * oscale, v[i * 8 + 3] * oscale);
    o.z = pack2(v[i * 8 + 4] * oscale, v[i * 8 + 5] * oscale); o.w = pack2(v[i * 8 + 6] * oscale, v[i * 8 + 7] * oscale);
    *reinterpret_cast<uint4*>(dst + i * 8) = o;
  }
}

DEVI void phase_mla_proj(const Params& P, int l, unsigned char* smem) {
  const int tid = TIDX, lane = tid & 63, wave = tid >> 6, l31 = lane & 31, hh = lane >> 5;
  float* T = reinterpret_cast<float*>(smem);
  float* rsq = T + 128 * 97;
  float* rskv = rsq + 128;
  const float qscale = 0.10206207261596577f * 1.4426950408889634f;
  for (int it = VBID; it < 144 * 8; it += NVB) {
    const int h = it & 7;
    const int m0 = (it >> 3) * 128;
    const bool lat = m0 < NL;
    const int b = lat ? (m0 >> 11) : ((m0 - NL) >> 8);
    const int pos0 = lat ? 256 + (m0 & 2047) : ((m0 - NL) & 255);
    const int tlat0 = lat ? (m0 & 2047) : 0;
    const bool doq = lat || (l == 0);
    const bf16* zrow = P.Z + (size_t)(m0 + wave * 32 + l31) * DIN;
    __syncthreads();
    {
      float ss = 0.f;
#pragma unroll
      for (int ks = 0; ks < 8; ++ks) {
        const bf16x8 a = ldfrag(zrow + ZC_BKV + ks * 16 + hh * 8);
#pragma unroll
        for (int j = 0; j < 8; ++j) { const float f = (float)a[j]; ss += f * f; }
      }
      ss += __shfl_xor(ss, 32);
      if (hh == 0) rskv[wave * 32 + l31] = rsqrtf(ss * (1.f / 128.f) + EPS);
      if (doq) {
        float sq = 0.f;
#pragma unroll
        for (int ks = 0; ks < 16; ++ks) {
          const bf16x8 a = ldfrag(zrow + ZC_BQ + ks * 16 + hh * 8);
#pragma unroll
          for (int j = 0; j < 8; ++j) { const float f = (float)a[j]; sq += f * f; }
        }
        sq += __shfl_xor(sq, 32);
        if (hh == 0) rsq[wave * 32 + l31] = rsqrtf(sq * (1.f / 256.f) + EPS);
      }
    }
    for (int e = tid; e < 128 * 32; e += 256) {
      const int tok = e >> 5, i = e & 31;
      T[tok * 97 + 64 + i] = bf2f(P.Z[(size_t)(m0 + tok) * DIN + ZC_BKR + i]);
    }
    __syncthreads();
    {
      const bf16* Wkv = P.WukvT + (size_t)l * 1024 * 128;
      f32x16 acc[4];
#pragma unroll
      for (int j = 0; j < 4; ++j) acc[j] = zero16();
#pragma unroll
      for (int ks = 0; ks < 8; ++ks) {
        const bf16x8 af = ldfrag(zrow + ZC_BKV + ks * 16 + hh * 8);
#pragma unroll
        for (int j = 0; j < 4; ++j) {
          const bf16x8 bfr = ldfrag(Wkv + (size_t)(h * 128 + j * 32 + l31) * 128 + ks * 16 + hh * 8);
          acc[j] = mfma32(af, bfr, acc[j]);
        }
      }
#pragma unroll
      for (int j = 0; j < 2; ++j)
#pragma unroll
        for (int r = 0; r < 16; ++r) {
          const int tok = wave * 32 + drow(r, hh);
          T[tok * 97 + j * 32 + l31] = acc[j][r] * rskv[tok];
        }
#pragma unroll
      for (int j = 2; j < 4; ++j) {
        const int d = (j - 2) * 32 + l31;
        bf16* dst = P.VT + ((size_t)(b * 8 + h) * 64 + d) * SEQP + pos0 + wave * 32;
#pragma unroll
        for (int rg = 0; rg < 4; ++rg) {
          const int tk = 8 * rg + 4 * hh;
          uint2 o;
          o.x = pack2(acc[j][4 * rg + 0] * rskv[wave * 32 + tk + 0], acc[j][4 * rg + 1] * rskv[wave * 32 + tk + 1]);
          o.y = pack2(acc[j][4 * rg + 2] * rskv[wave * 32 + tk + 2], acc[j][4 * rg + 3] * rskv[wave * 32 + tk + 3]);
          *reinterpret_cast<uint2*>(dst + tk) = o;
        }
      }
      __syncthreads();
      mla_norm_rope_store(P, T, P.b_kh_w + l * 96, lat, 1.f, P.K + (size_t)(b * 8 + h) * SEQP * 96, pos0, tlat0);
    }
    if (doq) {
      const bf16* Wq = P.WuqT + (size_t)l * 768 * 256;
      f32x16 acc[3];
#pragma unroll
      for (int j = 0; j < 3; ++j) acc[j] = zero16();
#pragma unroll 8
      for (int ks = 0; ks < 16; ++ks) {
        const bf16x8 af = ldfrag(zrow + ZC_BQ + ks * 16 + hh * 8);
#pragma unroll
        for (int j = 0; j < 3; ++j) {
          const bf16x8 bfr = ldfrag(Wq + (size_t)(h * 96 + j * 32 + l31) * 256 + ks * 16 + hh * 8);
          acc[j] = mfma32(af, bfr, acc[j]);
        }
      }
      __syncthreads();
#pragma unroll
      for (int j = 0; j < 3; ++j)
#pragma unroll
        for (int r = 0; r < 16; ++r) {
          const int tok = wave * 32 + drow(r, hh);
          T[tok * 97 + j * 32 + l31] = acc[j][r] * rsq[tok];
        }
      __syncthreads();
      mla_norm_rope_store(P, T, P.b_qh_w + l * 96, lat, qscale, P.Q + (size_t)(b * 8 + h) * SEQP * 96, pos0, tlat0);
    }
  }
}

DEVI void hgrn_load(const Params& P, int l, int b, int hd, int c, float* BF, float* RB, float* SEG,
                    float (&q)[16], float (&kf)[16], float (&kb)[16], float (&v)[16], bool need_kv) {
  const int tid = TIDX, t = tid >> 2, k0 = (tid & 3) * 16;
  const int row = row_of(b, c * 64 + t);
  const bf16* z = P.Z + (size_t)row * DIN + hd * 64 + k0;
  float zf[16], zb[16];
#pragma unroll
  for (int i = 0; i < 2; ++i) {
    const uint4 uq = *reinterpret_cast<const uint4*>(z + ZC_CQ + i * 8);
    const uint4 uf = *reinterpret_cast<const uint4*>(z + ZC_CFF + i * 8);
    const uint4 ub = *reinterpret_cast<const uint4*>(z + ZC_CFB + i * 8);
    q[i * 8 + 0] = lo2f(uq.x); q[i * 8 + 1] = hi2f(uq.x); q[i * 8 + 2] = lo2f(uq.y); q[i * 8 + 3] = hi2f(uq.y);
    q[i * 8 + 4] = lo2f(uq.z); q[i * 8 + 5] = hi2f(uq.z); q[i * 8 + 6] = lo2f(uq.w); q[i * 8 + 7] = hi2f(uq.w);
    zf[i * 8 + 0] = lo2f(uf.x); zf[i * 8 + 1] = hi2f(uf.x); zf[i * 8 + 2] = lo2f(uf.y); zf[i * 8 + 3] = hi2f(uf.y);
    zf[i * 8 + 4] = lo2f(uf.z); zf[i * 8 + 5] = hi2f(uf.z); zf[i * 8 + 6] = lo2f(uf.w); zf[i * 8 + 7] = hi2f(uf.w);
    zb[i * 8 + 0] = lo2f(ub.x); zb[i * 8 + 1] = hi2f(ub.x); zb[i * 8 + 2] = lo2f(ub.y); zb[i * 8 + 3] = hi2f(ub.y);
    zb[i * 8 + 4] = lo2f(ub.z); zb[i * 8 + 5] = hi2f(ub.z); zb[i * 8 + 6] = lo2f(ub.w); zb[i * 8 + 7] = hi2f(ub.w);
    if (need_kv) {
      const uint4 uv = *reinterpret_cast<const uint4*>(z + ZC_CI + i * 8);
      v[i * 8 + 0] = lo2f(uv.x); v[i * 8 + 1] = hi2f(uv.x); v[i * 8 + 2] = lo2f(uv.y); v[i * 8 + 3] = hi2f(uv.y);
      v[i * 8 + 4] = lo2f(uv.z); v[i * 8 + 5] = hi2f(uv.z); v[i * 8 + 6] = lo2f(uv.w); v[i * 8 + 7] = hi2f(uv.w);
    }
  }
#pragma unroll
  for (int i = 0; i < 16; ++i) {
    q[i] *= 0.125f;
    float lbf = 0.f, lbb = 0.f;
    if (l == 1) {
      const int ch = hd * 64 + k0 + i;
      lbf = sigmoidf_(P.c_lb[512 + ch] - P.c_lb[ch]);
      lbb = sigmoidf_(P.c_lb[512 + 256 + ch] - P.c_lb[256 + ch]);
    }
    {
      const float zz = zf[i];
      const float e = __expf(-fabsf(zz));
      const float sp = __builtin_amdgcn_rcpf(1.f + e);
      const float sig = zz >= 0.f ? sp : e * sp;
      const float nsig = zz >= 0.f ? e * sp : sp;
      const float lf = (l == 0) ? (fminf(zz, 0.f) - __logf(1.f + e)) : __logf(lbf + (1.f - lbf) * sig);
      kf[i] = (1.f - lbf) * nsig;
      BF[t * 65 + k0 + i] = lf;
    }
    {
      const float zz = zb[i];
      const float e = __expf(-fabsf(zz));
      const float sp = __builtin_amdgcn_rcpf(1.f + e);
      const float sig = zz >= 0.f ? sp : e * sp;
      const float nsig = zz >= 0.f ? e * sp : sp;
      const float lf = (l == 0) ? (fminf(zz, 0.f) - __logf(1.f + e)) : __logf(lbb + (1.f - lbb) * sig);
      kb[i] = (1.f - lbb) * nsig;
      RB[t * 65 + k0 + i] = lf;
    }
  }
  __syncthreads();
  {
    const int k = tid & 63, seg = tid >> 6;
    float a[16], r[16];
    float sf = 0.f, sr = 0.f;
#pragma unroll
    for (int j = 0; j < 16; ++j) { sf += BF[(seg * 16 + j) * 65 + k]; a[j] = sf; }
#pragma unroll
    for (int j = 15; j >= 0; --j) { sr += RB[(seg * 16 + j) * 65 + k]; r[j] = sr; }
    SEG[seg * 64 + k] = sf; SEG[256 + seg * 64 + k] = sr;
    __syncthreads();
    float offf = 0.f, offb = 0.f;
#pragma unroll
    for (int s2 = 0; s2 < 4; ++s2) {
      offf += (s2 < seg) ? SEG[s2 * 64 + k] : 0.f;
      offb += (s2 > seg) ? SEG[256 + s2 * 64 + k] : 0.f;
    }
#pragma unroll
    for (int j = 0; j < 16; ++j) { BF[(seg * 16 + j) * 65 + k] = a[j] + offf; RB[(seg * 16 + j) * 65 + k] = r[j] + offb; }
  }
  __syncthreads();
}

DEVI f32x16 lds_mm(const bf16* A, const bf16* BT, int tm, int tn, int l31, int hh) {
  f32x16 acc = zero16();
#pragma unroll
  for (int ks = 0; ks < 4; ++ks) {
    const bf16x8 a = ldfrag(A + (tm * 32 + l31) * 72 + ks * 16 + hh * 8);
    const bf16x8 b = ldfrag(BT + (tn * 32 + l31) * 72 + ks * 16 + hh * 8);
    acc = mfma32(a, b, acc);
  }
  return acc;
}

DEVI void phase_hgrn_local(const Params& P, int l, unsigned char* smem) {
  const int tid = TIDX, lane = tid & 63, wave = tid >> 6, l31 = lane & 31, hh = lane >> 5;
  const int tm = wave >> 1, tn = wave & 1;
  float* BF = reinterpret_cast<float*>(smem);
  float* RB = BF + 64 * 65;
  bf16* QF = reinterpret_cast<bf16*>(smem + 33280);
  bf16* KF = QF + 64 * 72;
  bf16* QB = KF + 64 * 72;
  bf16* KB = QB + 64 * 72;
  bf16* VTt = KB + 64 * 72;
  bf16* KHF = reinterpret_cast<bf16*>(smem);
  bf16* KHB = KHF + 64 * 72;
  bf16* ATT = KHB + 64 * 72;
  for (int it = VBID; it < 8 * 4 * 36; it += NVB) {
    const int c = it % 36, hd = (it / 36) & 3, b = it / 144;
    float q[16], kf[16], kb[16], v[16];
    __syncthreads();
    hgrn_load(P, l, b, hd, c, BF, RB, reinterpret_cast<float*>(smem + 33280), q, kf, kb, v, true);
    const int t = tid >> 2, k0 = (tid & 3) * 16;
    float bfv[16], rbv[16];
#pragma unroll
    for (int i = 0; i < 16; ++i) { bfv[i] = BF[t * 65 + k0 + i]; rbv[i] = RB[t * 65 + k0 + i]; }
    if (t == 0) {
      float* dec = P.DEC + ((size_t)((b * 4 + hd) * 2) * 36 + c) * 64 + k0;
#pragma unroll
      for (int i = 0; i < 16; ++i) { dec[i] = __expf(BF[63 * 65 + k0 + i]); dec[36 * 64 + i] = __expf(RB[k0 + i]); }
    }
#pragma unroll
    for (int i = 0; i < 16; i += 2) {
      const int k = k0 + i;
      const float mF0 = BF[32 * 65 + k], mF1 = BF[32 * 65 + k + 1], mB0 = RB[32 * 65 + k], mB1 = RB[32 * 65 + k + 1];
      *reinterpret_cast<unsigned*>(&QF[t * 72 + k]) = pack2(q[i] * __expf(fminf(bfv[i] - mF0, 80.f)), q[i + 1] * __expf(fminf(bfv[i + 1] - mF1, 80.f)));
      *reinterpret_cast<unsigned*>(&KF[t * 72 + k]) = pack2(kf[i] * __expf(fminf(mF0 - bfv[i], 80.f)), kf[i + 1] * __expf(fminf(mF1 - bfv[i + 1], 80.f)));
      *reinterpret_cast<unsigned*>(&QB[t * 72 + k]) = pack2(q[i] * __expf(fminf(rbv[i] - mB0, 80.f)), q[i + 1] * __expf(fminf(rbv[i + 1] - mB1, 80.f)));
      *reinterpret_cast<unsigned*>(&KB[t * 72 + k]) = pack2(kb[i] * __expf(fminf(mB0 - rbv[i], 80.f)), kb[i + 1] * __expf(fminf(mB1 - rbv[i + 1], 80.f)));
    }
#pragma unroll
    for (int i = 0; i < 16; ++i) {
      VTt[(k0 + i) * 72 + t] = f2bf(v[i]);
      kf[i] = kf[i] * __expf(BF[63 * 65 + k0 + i] - bfv[i]);
      kb[i] = kb[i] * __expf(RB[k0 + i] - rbv[i]);
    }
    __syncthreads();
#pragma unroll
    for (int i = 0; i < 16; ++i) {
      KHF[(k0 + i) * 72 + t] = f2bf(kf[i]);
      KHB[(k0 + i) * 72 + t] = f2bf(kb[i]);
    }
    __syncthreads();
    {
      const f32x16 af = lds_mm(QF, KF, tm, tn, l31, hh);
      const f32x16 ab = lds_mm(QB, KB, tm, tn, l31, hh);
      const int s = tn * 32 + l31;
#pragma unroll
      for (int r = 0; r < 16; ++r) {
        const int tt = tm * 32 + drow(r, hh);
        float a = 0.f;
        if (s <= tt) a += af[r];
        if (s >= tt) a += ab[r];
        ATT[tt * 72 + s] = f2bf(a);
      }
    }
    {
      const f32x16 lf = lds_mm(KHF, VTt, tm, tn, l31, hh);
      const f32x16 lb = lds_mm(KHB, VTt, tm, tn, l31, hh);
      float* stf = P.ST + ((size_t)((b * 4 + hd) * 2 + 0) * 36 + c) * 4096;
      float* stb = P.ST + ((size_t)((b * 4 + hd) * 2 + 1) * 36 + c) * 4096;
#pragma unroll
      for (int r = 0; r < 16; ++r) {
        const int kk = tm * 32 + drow(r, hh), d = tn * 32 + l31;
        stf[kk * 64 + d] = lf[r];
        stb[kk * 64 + d] = lb[r];
      }
    }
    __syncthreads();
    {
      const f32x16 o = lds_mm(ATT, VTt, tm, tn, l31, hh);
#pragma unroll
      for (int r = 0; r < 16; ++r) {
        const int tt = tm * 32 + drow(r, hh), d = tn * 32 + l31;
        P.OI[(size_t)row_of(b, c * 64 + tt) * 256 + hd * 64 + d] = o[r];
      }
    }
  }
}

DEVI void hgrn_scan_item(const Params& P, int item) {
  const int tid = TIDX;
  const int chain = item >> 2, sl = item & 3;
  const int dir = chain & 1;
  const int k = tid >> 2, d4 = sl * 16 + (tid & 3) * 4;
  float4 S = make_float4(0.f, 0.f, 0.f, 0.f);
  float* base = P.ST + (size_t)chain * 36 * 4096 + k * 64 + d4;
  const float* dec = P.DEC + (size_t)chain * 36 * 64 + k;
#pragma unroll 4
  for (int step = 0; step < 36; ++step) {
    const int c = dir == 0 ? step : (step < 4 ? 3 - step : 39 - step);
    float4* p = reinterpret_cast<float4*>(base + (size_t)c * 4096);
    const float4 L = *p;
    const float dc = dec[c * 64];
    *p = S;
    S.x = dc * S.x + L.x; S.y = dc * S.y + L.y; S.z = dc * S.z + L.z; S.w = dc * S.w + L.w;
  }
}

DEVI void phase_hgrn_final(const Params& P, int l, unsigned char* smem) {
  const int tid = TIDX, lane = tid & 63, wave = tid >> 6, l31 = lane & 31, hh = lane >> 5;
  const int tm = wave >> 1, tn = wave & 1;
  float* BF = reinterpret_cast<float*>(smem);
  float* RB = BF + 64 * 65;
  bf16* QF = reinterpret_cast<bf16*>(smem + 33280);
  bf16* QB = QF + 64 * 72;
  bf16* SF = QB + 64 * 72;
  bf16* SB = SF + 64 * 72;
  float* O = reinterpret_cast<float*>(smem);
  const int c0 = (l == 1) ? 4 : 0;
  const int nc = 36 - c0;
  for (int it = VBID; it < 8 * 4 * nc; it += NVB) {
    const int c = it % nc + c0, hd = (it / nc) & 3, b = it / (nc * 4);
    float q[16], kf[16], kb[16], v[16];
    __syncthreads();
    hgrn_load(P, l, b, hd, c, BF, RB, reinterpret_cast<float*>(smem + 33280), q, kf, kb, v, false);
    const int t = tid >> 2, k0 = (tid & 3) * 16;
#pragma unroll
    for (int i = 0; i < 16; i += 2) {
      const int k = k0 + i;
      *reinterpret_cast<unsigned*>(&QF[t * 72 + k]) = pack2(q[i] * __expf(BF[t * 65 + k]), q[i + 1] * __expf(BF[t * 65 + k + 1]));
      *reinterpret_cast<unsigned*>(&QB[t * 72 + k]) = pack2(q[i] * __expf(RB[t * 65 + k]), q[i + 1] * __expf(RB[t * 65 + k + 1]));
    }
    {
      const float* stf = P.ST + ((size_t)((b * 4 + hd) * 2 + 0) * 36 + c) * 4096;
      const float* stb = P.ST + ((size_t)((b * 4 + hd) * 2 + 1) * 36 + c) * 4096;
#pragma unroll
      for (int i = 0; i < 16; i += 4) {
        const float4 a = *reinterpret_cast<const float4*>(stf + t * 64 + k0 + i);
        const float4 bb = *reinterpret_cast<const float4*>(stb + t * 64 + k0 + i);
        SF[(k0 + i + 0) * 72 + t] = f2bf(a.x); SF[(k0 + i + 1) * 72 + t] = f2bf(a.y); SF[(k0 + i + 2) * 72 + t] = f2bf(a.z); SF[(k0 + i + 3) * 72 + t] = f2bf(a.w);
        SB[(k0 + i + 0) * 72 + t] = f2bf(bb.x); SB[(k0 + i + 1) * 72 + t] = f2bf(bb.y); SB[(k0 + i + 2) * 72 + t] = f2bf(bb.z); SB[(k0 + i + 3) * 72 + t] = f2bf(bb.w);
      }
    }
    __syncthreads();
    {
      f32x16 o = lds_mm(QF, SF, tm, tn, l31, hh);
      const f32x16 o2 = lds_mm(QB, SB, tm, tn, l31, hh);
#pragma unroll
      for (int r = 0; r < 16; ++r) {
        const int tt = tm * 32 + drow(r, hh), d = tn * 32 + l31;
        O[tt * 65 + d] = o[r] + o2[r] + P.OI[(size_t)row_of(b, c * 64 + tt) * 256 + hd * 64 + d];
      }
    }
    __syncthreads();
    {
      const int row = row_of(b, c * 64 + t);
      float ov[16]; float ss = 0.f;
#pragma unroll
      for (int i = 0; i < 16; ++i) { ov[i] = O[t * 65 + k0 + i]; ss += ov[i] * ov[i]; }
      ss += __shfl_xor(ss, 1); ss += __shfl_xor(ss, 2);
      const float rr = rsqrtf(ss * (1.f / 64.f) + EPS);
      const bf16* g = P.Z + (size_t)row * DIN + ZC_CG + hd * 64 + k0;
      const float* nw = P.c_out_norm_w + l * 64 + k0;
      unsigned pk[8];
#pragma unroll
      for (int i = 0; i < 16; i += 2) {
        const float g0 = bf2f(g[i]), g1 = bf2f(g[i + 1]);
        const float y0 = ov[i] * rr * nw[i] * (g0 * sigmoidf_(g0));
        const float y1 = ov[i + 1] * rr * nw[i + 1] * (g1 * sigmoidf_(g1));
        pk[i >> 1] = pack2(y0, y1);
      }
      uint4* dst = reinterpret_cast<uint4*>(P.H + (size_t)row * 1024 + 768 + hd * 64 + k0);
      dst[0] = make_uint4(pk[0], pk[1], pk[2], pk[3]);
      dst[1] = make_uint4(pk[4], pk[5], pk[6], pk[7]);
    }
  }
}

DEVI void attn_item(const Params& P, int b, int h, int qpos0, int nkeys, unsigned char* smem) {
  const int tid = TIDX, lane = tid & 63, wave = tid >> 6, l31 = lane & 31, hh = lane >> 5;
  constexpr int LDKS = 104, LDVS = 72;
  constexpr int KS_BYTES = 64 * LDKS * 2, VS_BYTES = 64 * LDVS * 2, ST_BYTES = KS_BYTES + VS_BYTES;
  const bf16* Qg = P.Q + ((size_t)(b * 8 + h) * SEQP + qpos0 + wave * 32 + l31) * 96;
  const bf16* Kg = P.K + (size_t)(b * 8 + h) * SEQP * 96;
  const bf16* Vg = P.VT + (size_t)(b * 8 + h) * 64 * SEQP;
  bf16x8 qf[6];
#pragma unroll
  for (int ks = 0; ks < 6; ++ks) qf[ks] = ldfrag(Qg + ks * 16 + hh * 8);
  f32x16 oacc[2]; oacc[0] = zero16(); oacc[1] = zero16();
  float m = -1e30f, lsum = 0.f;
  uint4 rk[3], rv[2];
  const int ntiles = nkeys / 64;
  auto gload = [&](int kt) {
#pragma unroll
    for (int i = 0; i < 3; ++i) { const int ch = tid + i * 256, row = ch / 12, cc = ch % 12;
      rk[i] = *reinterpret_cast<const uint4*>(Kg + (size_t)(kt * 64 + row) * 96 + cc * 8); }
#pragma unroll
    for (int i = 0; i < 2; ++i) { const int ch = tid + i * 256, row = ch >> 3, cc = ch & 7;
      rv[i] = *reinterpret_cast<const uint4*>(Vg + (size_t)row * SEQP + kt * 64 + cc * 8); }
  };
  auto swrite = [&](int buf) {
    bf16* sK = reinterpret_cast<bf16*>(smem + buf * ST_BYTES);
    bf16* sV = reinterpret_cast<bf16*>(smem + buf * ST_BYTES + KS_BYTES);
#pragma unroll
    for (int i = 0; i < 3; ++i) { const int ch = tid + i * 256, row = ch / 12, cc = ch % 12;
      *reinterpret_cast<uint4*>(sK + row * LDKS + cc * 8) = rk[i]; }
#pragma unroll
    for (int i = 0; i < 2; ++i) { const int ch = tid + i * 256, row = ch >> 3, cc = ch & 7;
      const int g16 = cc >> 1, odd = cc & 1;
      bf16* base = sV + row * LDVS + g16 * 16;
      const int p0 = odd * 2, p1 = odd * 2 + 1;
      const int s0 = (p0 == 1 ? 2 : (p0 == 2 ? 1 : p0)) * 4, s1 = (p1 == 1 ? 2 : (p1 == 2 ? 1 : p1)) * 4;
      *reinterpret_cast<uint2*>(base + s0) = make_uint2(rv[i].x, rv[i].y);
      *reinterpret_cast<uint2*>(base + s1) = make_uint2(rv[i].z, rv[i].w);
    }
  };
  __syncthreads();
  gload(0); swrite(0);
  __syncthreads();
  for (int kt = 0; kt < ntiles; ++kt) {
    const int cur = kt & 1;
    if (kt + 1 < ntiles) gload(kt + 1);
    const bf16* sK = reinterpret_cast<const bf16*>(smem + cur * ST_BYTES);
    const bf16* sV = reinterpret_cast<const bf16*>(smem + cur * ST_BYTES + KS_BYTES);
    f32x16 sacc[2]; sacc[0] = zero16(); sacc[1] = zero16();
#pragma unroll
    for (int kk = 0; kk < 2; ++kk)
#pragma unroll
      for (int ks = 0; ks < 6; ++ks) {
        const bf16x8 a = ldfrag(sK + (kk * 32 + l31) * LDKS + ks * 16 + hh * 8);
        sacc[kk] = mfma32(a, qf[ks], sacc[kk]);
      }
    float mx = sacc[0][0];
#pragma unroll
    for (int kk = 0; kk < 2; ++kk)
#pragma unroll
      for (int r = 0; r < 16; ++r) mx = fmaxf(mx, sacc[kk][r]);
    mx = fmaxf(mx, __shfl_xor(mx, 32));
    const float mnew = fmaxf(m, mx);
    const float alpha = __builtin_amdgcn_exp2f(m - mnew);
    m = mnew;
    float ps = 0.f;
#pragma unroll
    for (int kk = 0; kk < 2; ++kk)
#pragma unroll
      for (int r = 0; r < 16; ++r) { const float p = __builtin_amdgcn_exp2f(sacc[kk][r] - mnew); sacc[kk][r] = p; ps += p; }
    lsum = lsum * alpha + ps;
#pragma unroll
    for (int dt = 0; dt < 2; ++dt)
#pragma unroll
      for (int r = 0; r < 16; ++r) oacc[dt][r] *= alpha;
#pragma unroll
    for (int kk = 0; kk < 2; ++kk)
#pragma unroll
      for (int s = 0; s < 2; ++s) {
        bf16x8 pb;
#pragma unroll
        for (int j = 0; j < 8; ++j) pb[j] = (__bf16)sacc[kk][8 * s + j];
#pragma unroll
        for (int dt = 0; dt < 2; ++dt) {
          const bf16x8 a = ldfrag(sV + (dt * 32 + l31) * LDVS + kk * 32 + s * 16 + hh * 8);
          oacc[dt] = mfma32(a, pb, oacc[dt]);
        }
      }
    if (kt + 1 < ntiles) swrite(cur ^ 1);
    __syncthreads();
  }
  lsum += __shfl_xor(lsum, 32);
  const float inv = 1.f / lsum;
  const int row = row_of(b, qpos0 + wave * 32 + l31);
  bf16* dst = P.H + (size_t)row * 1024 + 256 + h * 64;
#pragma unroll
  for (int dt = 0; dt < 2; ++dt)
#pragma unroll
    for (int rg = 0; rg < 4; ++rg) {
      const int d = dt * 32 + 8 * rg + 4 * hh;
      uint2 o;
      o.x = pack2(oacc[dt][4 * rg + 0] * inv, oacc[dt][4 * rg + 1] * inv);
      o.y = pack2(oacc[dt][4 * rg + 2] * inv, oacc[dt][4 * rg + 3] * inv);
      *reinterpret_cast<uint2*>(dst + d) = o;
    }
}

DEVI void phase_attn_scan(const Params& P, int l, unsigned char* smem, bool skip_scan = false) {
  const int n_attn = (l == 0) ? 1152 : 1024;
  const int total = 256 + n_attn;
  for (int it = VBID; it < total; it += NVB) {
    if (it < 256) { if (!skip_scan) hgrn_scan_item(P, it); continue; }
    const int a = it - 256;
    if (a < 1024) attn_item(P, a >> 7, (a >> 4) & 7, 256 + 128 * (a & 15), 2304, smem);
    else { const int a2 = a - 1024; attn_item(P, a2 >> 4, (a2 >> 1) & 7, 128 * (a2 & 1), 256, smem); }
  }
}

DEVI unsigned ordkey(float s) { const unsigned u = __float_as_uint(s); return (u & 0x80000000u) ? ~u : (u | 0x80000000u); }
DEVI float keyval(unsigned k, unsigned mask) { const unsigned u = k & ~mask; return __uint_as_float((u & 0x80000000u) ? (u & 0x7fffffffu) : ~u); }
DEVI void ins16(unsigned (&lst)[16], unsigned v) {
#pragma unroll
  for (int j = 0; j < 16; ++j) { const unsigned hi = max(lst[j], v); v = min(lst[j], v); lst[j] = hi; }
}
DEVI void merge16(unsigned (&lst)[16], int xm) {
  unsigned o[16];
#pragma unroll
  for (int j = 0; j < 16; ++j) o[j] = (unsigned)__shfl_xor((int)lst[j], xm);
#pragma unroll
  for (int j = 0; j < 16; ++j) lst[j] = max(lst[j], o[15 - j]);
#pragma unroll
  for (int d = 8; d >= 1; d >>= 1)
#pragma unroll
    for (int j = 0; j < 16; ++j)
      if ((j & d) == 0) { const unsigned a = lst[j], bb = lst[j + d]; lst[j] = max(a, bb); lst[j + d] = min(a, bb); }
}

DEVI void bitonic_sort_desc16(unsigned (&v)[16]) {
#pragma unroll
  for (int k = 2; k <= 16; k <<= 1)
#pragma unroll
    for (int j = k >> 1; j > 0; j >>= 1)
#pragma unroll
      for (int i = 0; i < 16; ++i) {
        const int l = i ^ j;
        if (l > i) {
          const bool desc = ((i & k) == 0);
          const unsigned a = v[i], b = v[l];
          const unsigned mx = max(a, b), mn = min(a, b);
          v[i] = desc ? mx : mn; v[l] = desc ? mn : mx;
        }
      }
}
DEVI void bitonic_merge_desc16(unsigned (&lst)[16]) {
#pragma unroll
  for (int d = 8; d >= 1; d >>= 1)
#pragma unroll
    for (int j = 0; j < 16; ++j)
      if ((j & d) == 0) { const unsigned a = lst[j], bb = lst[j + d]; lst[j] = max(a, bb); lst[j + d] = min(a, bb); }
}
struct CandTab { int a[52]; int b[52]; };
constexpr CandTab make_cand_tab() {
  CandTab t{};
  int n = 0;
  for (int a = 0; a < 16; ++a)
    for (int b = 0; b < 16; ++b)
      if ((a + 1) * (b + 1) <= 16) { t.a[n] = a; t.b[n] = b; ++n; }
  for (; n < 52; ++n) { t.a[n] = 0; t.b[n] = 0; }
  return t;
}

DEVI void phase_route(const Params& P, int l, unsigned char* smem) {
  const int tid = TIDX, lane = tid & 63, wave = tid >> 6, l31 = lane & 31, hh = lane >> 5;
  bf16* QT = reinterpret_cast<bf16*>(smem);
  float* SC = reinterpret_cast<float*>(smem + 33792);
  const int mtiles = (l == 1) ? 256 : 288;
  for (int it = VBID; it < mtiles * 8; it += NVB) {
    const int mt = it >> 3, h = it & 7;
    __syncthreads();
    for (int e = tid; e < 64 * 32; e += 256) {
      const int r = e >> 5, cc = e & 31;
      *reinterpret_cast<uint4*>(QT + r * 264 + cc * 8) = *reinterpret_cast<const uint4*>(P.QP + (size_t)(mt * 64 + r) * 2048 + h * 256 + cc * 8);
    }
    __syncthreads();
    unsigned lst[2][16];
    const int row = tid >> 2, part = tid & 3;
#pragma unroll
    for (int p = 0; p < 2; ++p) {
      f32x16 sa[2]; sa[0] = zero16(); sa[1] = zero16();
      const bf16* keys = P.SK + ((size_t)(l * 16 + h * 2 + p) * 128 + wave * 32 + l31) * 128;
#pragma unroll
      for (int ks = 0; ks < 8; ++ks) {
        const bf16x8 bfr = ldfrag(keys + ks * 16 + hh * 8);
#pragma unroll
        for (int i = 0; i < 2; ++i) {
          const bf16x8 af = ldfrag(QT + (i * 32 + l31) * 264 + p * 128 + ks * 16 + hh * 8);
          sa[i] = mfma32(af, bfr, sa[i]);
        }
      }
      if (p == 1) __syncthreads();
#pragma unroll
      for (int i = 0; i < 2; ++i)
#pragma unroll
        for (int r = 0; r < 16; ++r) SC[(i * 32 + drow(r, hh)) * 129 + wave * 32 + l31] = sa[i][r];
      __syncthreads();
      unsigned B2[16];
#pragma unroll
      for (int i = 0; i < 16; ++i) {
        const int i0 = part * 32 + ((i + part * 8) & 31), i1 = part * 32 + ((i + 16 + part * 8) & 31);
        lst[p][i] = (ordkey(SC[row * 129 + i0]) & ~0x7fu) | (unsigned)(127 - i0);
        B2[i] = (ordkey(SC[row * 129 + i1]) & ~0x7fu) | (unsigned)(127 - i1);
      }
      bitonic_sort_desc16(lst[p]);
      bitonic_sort_desc16(B2);
#pragma unroll
      for (int j = 0; j < 16; ++j) lst[p][j] = max(lst[p][j], B2[15 - j]);
      bitonic_merge_desc16(lst[p]);
      merge16(lst[p], 1);
      merge16(lst[p], 2);
    }
    float v0[16], v1[16];
#pragma unroll
    for (int j = 0; j < 16; ++j) { v0[j] = keyval(lst[0][j], 0x7fu); v1[j] = keyval(lst[1][j], 0x7fu); }
    unsigned best[16];
    {
      constexpr CandTab CT = make_cand_tab();
#pragma unroll
      for (int c = 0; c < 13; ++c) {
        const int a0 = CT.a[4 * c + 0], a1 = CT.a[4 * c + 1], a2 = CT.a[4 * c + 2], a3 = CT.a[4 * c + 3];
        const int b0 = CT.b[4 * c + 0], b1 = CT.b[4 * c + 1], b2 = CT.b[4 * c + 2], b3 = CT.b[4 * c + 3];
        const float x = part == 0 ? v0[a0] : part == 1 ? v0[a1] : part == 2 ? v0[a2] : v0[a3];
        const float y = part == 0 ? v1[b0] : part == 1 ? v1[b1] : part == 2 ? v1[b2] : v1[b3];
        const int flat = part == 0 ? (a0 * 16 + b0) : part == 1 ? (a1 * 16 + b1) : part == 2 ? (a2 * 16 + b2) : (a3 * 16 + b3);
        const bool valid = part == 0 ? (4 * c + 0 < 50) : part == 1 ? (4 * c + 1 < 50) : part == 2 ? (4 * c + 2 < 50) : (4 * c + 3 < 50);
        const unsigned key = (ordkey(x + y) & ~0xffu) | (unsigned)(255 - flat);
        best[c] = valid ? key : 0u;
      }
      best[13] = 0u; best[14] = 0u; best[15] = 0u;
      bitonic_sort_desc16(best);
      merge16(best, 1);
      merge16(best, 2);
    }
    {
      const float mx = keyval(best[0], 0xffu);
      float es = 0.f;
      float ev[4]; int ex[4];
#pragma unroll
      for (int jj = 0; jj < 4; ++jj) {
        const unsigned kk = part == 0 ? best[4 * jj + 0] : part == 1 ? best[4 * jj + 1] : part == 2 ? best[4 * jj + 2] : best[4 * jj + 3];
        ev[jj] = __expf(keyval(kk, 0xffu) - mx);
        es += ev[jj];
        const int flat = 255 - (int)(kk & 0xffu);
        const int a = flat >> 4, bq = flat & 15;
        int i1 = 0, i2 = 0;
#pragma unroll
        for (int u = 0; u < 16; ++u) {
          i1 = (a == u) ? (127 - (int)(lst[0][u] & 0x7fu)) : i1;
          i2 = (bq == u) ? (127 - (int)(lst[1][u] & 0x7fu)) : i2;
        }
        ex[jj] = i1 * 128 + i2;
      }
      es += __shfl_xor(es, 1); es += __shfl_xor(es, 2);
      const float inv = 1.f / es;
      const int tok = mt * 64 + row;
      int* ed = P.EIDX + (size_t)tok * 128 + h * 16;
      float* gd = P.GATE + (size_t)tok * 128 + h * 16;
#pragma unroll
      for (int jj = 0; jj < 4; ++jj) { ed[4 * jj + part] = ex[jj]; gd[4 * jj + part] = ev[jj] * inv; }
    }
  }
}

DEVI float gelu_exact(float a) { return 0.5f * a * (1.f + erff(a * 0.70710678118654752f)); }

typedef float f2 __attribute__((ext_vector_type(2)));
DEVI void phase_peer(const Params& P, int l) {
  const int lane = TIDX & 63;
  const int gw = VBID * 4 + (TIDX >> 6), nw = NVB * 4;
  const int nrows = (l == 1) ? NL : NT;
  const unsigned char* PU = P.PU8 + (size_t)l * 16384 * 1024 + lane * 16;
  const unsigned char* PV = P.PV8 + (size_t)l * 16384 * 1024 + lane * 16;
  const float* PUS = P.PUS + l * 16384;
  const float* PVS = P.PVS + l * 16384;
  const bool b5 = lane & 32, b4 = lane & 16, b3 = lane & 8, b2 = lane & 4;
  for (int t = gw; t < nrows; t += nw) {
    const uint4 hA = *reinterpret_cast<const uint4*>(P.H + (size_t)t * 1024 + lane * 16);
    const uint4 hB = *reinterpret_cast<const uint4*>(P.H + (size_t)t * 1024 + lane * 16 + 8);
    const int e0 = P.EIDX[(size_t)t * 128 + lane], e1 = P.EIDX[(size_t)t * 128 + 64 + lane];
    const float g0 = P.GATE[(size_t)t * 128 + lane], g1 = P.GATE[(size_t)t * 128 + 64 + lane];
    const float su0 = PUS[e0], su1 = PUS[e1];
    const float gv0 = g0 * PVS[e0], gv1 = g1 * PVS[e1];
    f2 h2[8];
    h2[0] = (f2){lo2f(hA.x), hi2f(hA.x)}; h2[1] = (f2){lo2f(hA.y), hi2f(hA.y)}; h2[2] = (f2){lo2f(hA.z), hi2f(hA.z)}; h2[3] = (f2){lo2f(hA.w), hi2f(hA.w)};
    h2[4] = (f2){lo2f(hB.x), hi2f(hB.x)}; h2[5] = (f2){lo2f(hB.y), hi2f(hB.y)}; h2[6] = (f2){lo2f(hB.z), hi2f(hB.z)}; h2[7] = (f2){lo2f(hB.w), hi2f(hB.w)};
    f2 y2[8];
#pragma unroll
    for (int i = 0; i < 8; ++i) y2[i] = (f2){0.f, 0.f};
    for (int kb = 0; kb < 8; ++kb) {
      const int esrc = kb < 4 ? e0 : e1;
      uint4 u[16], v[16];
#pragma unroll
      for (int i = 0; i < 16; ++i) {
        const int e = __shfl(esrc, (kb * 16 + i) & 63);
        u[i] = *reinterpret_cast<const uint4*>(PU + (size_t)e * 1024);
        v[i] = *reinterpret_cast<const uint4*>(PV + (size_t)e * 1024);
      }
      float d[16];
#pragma unroll
      for (int i = 0; i < 16; ++i) {
        f2 sacc = (f2){0.f, 0.f};
        sacc = __builtin_elementwise_fma(__builtin_amdgcn_cvt_pk_f32_fp8(u[i].x, false), h2[0], sacc);
        sacc = __builtin_elementwise_fma(__builtin_amdgcn_cvt_pk_f32_fp8(u[i].x, true), h2[1], sacc);
        sacc = __builtin_elementwise_fma(__builtin_amdgcn_cvt_pk_f32_fp8(u[i].y, false), h2[2], sacc);
        sacc = __builtin_elementwise_fma(__builtin_amdgcn_cvt_pk_f32_fp8(u[i].y, true), h2[3], sacc);
        sacc = __builtin_elementwise_fma(__builtin_amdgcn_cvt_pk_f32_fp8(u[i].z, false), h2[4], sacc);
        sacc = __builtin_elementwise_fma(__builtin_amdgcn_cvt_pk_f32_fp8(u[i].z, true), h2[5], sacc);
        sacc = __builtin_elementwise_fma(__builtin_amdgcn_cvt_pk_f32_fp8(u[i].w, false), h2[6], sacc);
        sacc = __builtin_elementwise_fma(__builtin_amdgcn_cvt_pk_f32_fp8(u[i].w, true), h2[7], sacc);
        d[i] = sacc.x + sacc.y;
      }
      float r8[8], r4[4], r2[2], r1;
#pragma unroll
      for (int i = 0; i < 8; ++i) { const float mine = b5 ? d[8 + i] : d[i]; const float send = b5 ? d[i] : d[8 + i]; r8[i] = mine + __shfl_xor(send, 32); }
#pragma unroll
      for (int i = 0; i < 4; ++i) { const float mine = b4 ? r8[4 + i] : r8[i]; const float send = b4 ? r8[i] : r8[4 + i]; r4[i] = mine + __shfl_xor(send, 16); }
#pragma unroll
      for (int i = 0; i < 2; ++i) { const float mine = b3 ? r4[2 + i] : r4[i]; const float send = b3 ? r4[i] : r4[2 + i]; r2[i] = mine + __shfl_xor(send, 8); }
      { const float mine = b2 ? r2[1] : r2[0]; const float send = b2 ? r2[0] : r2[1]; r1 = mine + __shfl_xor(send, 4); }
      r1 += __shfl_xor(r1, 2); r1 += __shfl_xor(r1, 1);
      const int src = (kb * 16 + (lane >> 2)) & 63;
      const float su = __shfl(kb < 4 ? su0 : su1, src);
      const float gv = __shfl(kb < 4 ? gv0 : gv1, src);
      const float w = gv * gelu_exact(r1 * su);
#pragma unroll
      for (int i = 0; i < 16; ++i) {
        const float wi = __shfl(w, i * 4);
        const f2 ww = (f2){wi, wi};
        y2[0] = __builtin_elementwise_fma(ww, __builtin_amdgcn_cvt_pk_f32_fp8(v[i].x, false), y2[0]);
        y2[1] = __builtin_elementwise_fma(ww, __builtin_amdgcn_cvt_pk_f32_fp8(v[i].x, true), y2[1]);
        y2[2] = __builtin_elementwise_fma(ww, __builtin_amdgcn_cvt_pk_f32_fp8(v[i].y, false), y2[2]);
        y2[3] = __builtin_elementwise_fma(ww, __builtin_amdgcn_cvt_pk_f32_fp8(v[i].y, true), y2[3]);
        y2[4] = __builtin_elementwise_fma(ww, __builtin_amdgcn_cvt_pk_f32_fp8(v[i].z, false), y2[4]);
        y2[5] = __builtin_elementwise_fma(ww, __builtin_amdgcn_cvt_pk_f32_fp8(v[i].z, true), y2[5]);
        y2[6] = __builtin_elementwise_fma(ww, __builtin_amdgcn_cvt_pk_f32_fp8(v[i].w, false), y2[6]);
        y2[7] = __builtin_elementwise_fma(ww, __builtin_amdgcn_cvt_pk_f32_fp8(v[i].w, true), y2[7]);
      }
    }
    float y[16];
#pragma unroll
    for (int i = 0; i < 8; ++i) { y[2 * i] = y2[i].x; y[2 * i + 1] = y2[i].y; }
    const int bi = batch_of_row(t);
    const float* gate2 = P.MOD + (size_t)(l * 9 + bi) * 6144 + 5 * 1024;
    float xn[16];
    float ss = 0.f;
#pragma unroll
    for (int q4 = 0; q4 < 4; ++q4) {
      const int d = lane * 16 + q4 * 4;
      const float4 xo = *reinterpret_cast<const float4*>(P.X + (size_t)t * 1024 + d);
      const float4 gg = *reinterpret_cast<const float4*>(gate2 + d);
      float4 o;
      o.x = xo.x + gg.x * y[q4 * 4 + 0]; o.y = xo.y + gg.y * y[q4 * 4 + 1];
      o.z = xo.z + gg.z * y[q4 * 4 + 2]; o.w = xo.w + gg.w * y[q4 * 4 + 3];
      xn[q4 * 4 + 0] = o.x; xn[q4 * 4 + 1] = o.y; xn[q4 * 4 + 2] = o.z; xn[q4 * 4 + 3] = o.w;
      ss += o.x * o.x + o.y * o.y + o.z * o.z + o.w * o.w;
      if (l == 1) *reinterpret_cast<float4*>(P.out + (size_t)t * 1024 + d) = o;
      else *reinterpret_cast<float4*>(P.X + (size_t)t * 1024 + d) = o;
    }
    if (l == 0) {
      ss = wave_sum(ss);
      const float rr = rsqrtf(ss * (1.f / 1024.f) + EPS);
      const float* lnw = P.ln1_w + 1024;
      const float* mod = P.MOD + (size_t)(9 + bi) * 6144;
      const int d = lane * 16;
      unsigned pk[8];
#pragma unroll
      for (int i = 0; i < 16; i += 2) {
        const float o0 = xn[i] * rr * lnw[d + i] * (1.f + mod[1024 + d + i]) + mod[d + i];
        const float o1 = xn[i + 1] * rr * lnw[d + i + 1] * (1.f + mod[1024 + d + i + 1]) + mod[d + i + 1];
        pk[i >> 1] = pack2(o0, o1);
      }
      *reinterpret_cast<uint4*>(P.H + (size_t)t * 1024 + d) = make_uint4(pk[0], pk[1], pk[2], pk[3]);
      *reinterpret_cast<uint4*>(P.H + (size_t)t * 1024 + d + 8) = make_uint4(pk[4], pk[5], pk[6], pk[7]);
    }
  }
}


using f32x4 = __attribute__((ext_vector_type(4))) float;
namespace g8 {
constexpr int BM = 256, BK = 64, HALF = 128, HT = HALF * BK;
DEVI int lds_byte(int r, int c) { const int st = (r >> 4) * 2 + (c >> 5), rr = r & 15, cc = c & 31, ob = rr * 64 + cc * 2; return st * 1024 + (ob ^ (((ob >> 9) & 1) << 5)); }
DEVI void stage_rc(int b, int& R, int& C) { const int st = b / 1024, sb = b % 1024, swz = sb ^ (((sb >> 9) & 1) << 5); R = (st >> 1) * 16 + swz / 64; C = (st & 1) * 32 + (swz % 64) / 2; }
DEVI void unit_of(int L, int nM, int nN, int& pm, int& pn) {
  const int nwg = nM * nN;
  int wgid = L;
  { const int q = nwg / 8, r = nwg % 8, xcd = wgid % 8, off = wgid / 8; wgid = (xcd < r ? xcd * (q + 1) : r * (q + 1) + (xcd - r) * q) + off; }
  const int nig = 8 * nN, gid = wgid / nig, fm = gid * 8, gsz = (nM - fm) < 8 ? (nM - fm) : 8;
  pm = fm + ((wgid % nig) % gsz); pn = (wgid % nig) / gsz;
}
}

struct G8Unit { int pm, pn; };
template <class Epi>
DEVI void gemm8_phase(LAS unsigned char* lds, const bf16* __restrict__ Ag, const bf16* __restrict__ Btg, const int K, const int nM, const int nN, const Epi& E) {
  constexpr int BK = 64, HALF = 128, HTB = HALF * BK * 2;
  const int tid = threadIdx.x, wid = __builtin_amdgcn_readfirstlane(tid >> 6), lane = tid & 63, wr = wid >> 2, wc = wid & 3, fr = lane & 15, fq = lane >> 4;
  const int nt = K / BK;
  const int nunits = nM * nN, G = gridDim.x, c = blockIdx.x;
  unsigned voffA[2];
#pragma unroll
  for (int i = 0; i < 2; ++i) { int R, C; g8::stage_rc(tid * 16 + i * 8192, R, C); voffA[i] = (unsigned)(R * K + C) * 2u; }
  const size_t kstep = (size_t)(BK * 2);
  const size_t hstep = (size_t)HALF * K * 2;
  const size_t tstep = 2 * hstep;
  const unsigned ldsw = (unsigned)wid * 1024u;
  const int aoff = g8::lds_byte(wr * 64 + fr, fq * 8), boff = g8::lds_byte(wc * 32 + fr, fq * 8);
#define PG8_SA(b, h) (((b) * 2 + (h)) * HTB)
#define PG8_SB(b, h) ((4 + (b) * 2 + (h)) * HTB)
#define PG8_STAGE(bufoff, gbase, voff) do { _Pragma("unroll") for (int _i = 0; _i < 2; ++_i) \
        __builtin_amdgcn_global_load_lds((const unsigned*)((const char*)(gbase) + (voff)[_i]), (LAS unsigned*)(lds + (bufoff) + ldsw + _i * 8192), 16, 0, 0); } while (0)
#define PG8_LDA(dst, b, h) do { _Pragma("unroll") for (int m = 0; m < 4; ++m) _Pragma("unroll") for (int k = 0; k < 2; ++k) dst[m][k] = *(const LAS bf16x8*)(lds + PG8_SA(b, h) + aoff + m * 2048 + k * 1024); } while (0)
#define PG8_LDB(dst, b, h) do { _Pragma("unroll") for (int n = 0; n < 2; ++n) _Pragma("unroll") for (int k = 0; k < 2; ++k) dst[n][k] = *(const LAS bf16x8*)(lds + PG8_SB(b, h) + boff + n * 2048 + k * 1024); } while (0)
#define PG8_MMA(ai, bj, At_, Bt_) do { __builtin_amdgcn_s_setprio(1); _Pragma("unroll") for (int m = 0; m < 4; ++m) _Pragma("unroll") for (int n = 0; n < 2; ++n) _Pragma("unroll") for (int k = 0; k < 2; ++k) \
        acc[ai][bj][m][n] = __builtin_amdgcn_mfma_f32_16x16x32_bf16(Bt_[n][k], At_[m][k], acc[ai][bj][m][n], 0, 0, 0); __builtin_amdgcn_s_setprio(0); } while (0)
#define PG8_WAIT_V(n) asm volatile("s_waitcnt vmcnt(" #n ")" ::: "memory")
#define PG8_WAIT_L(n) asm volatile("s_waitcnt lgkmcnt(" #n ")" ::: "memory")
#define PG8_BAR __builtin_amdgcn_s_barrier()
#define PG8_SCHED __builtin_amdgcn_sched_barrier(0)
  G8Unit cur, nxt; int ui = 0;
  if (c >= nunits) return;
  g8::unit_of(c, nM, nN, cur.pm, cur.pn);
  f32x4 acc[2][2][4][2];
#pragma unroll
  for (int a = 0; a < 2; ++a)
#pragma unroll
    for (int b = 0; b < 2; ++b)
#pragma unroll
      for (int m = 0; m < 4; ++m)
#pragma unroll
        for (int n = 0; n < 2; ++n) acc[a][b][m][n] = (f32x4){0.f, 0.f, 0.f, 0.f};
  bf16x8 At[4][2], B0[2][2], B1[2][2];
  const char* cA = (const char*)Ag + (size_t)cur.pm * tstep; const char* cB = (const char*)Btg + (size_t)cur.pn * tstep;
  PG8_STAGE(PG8_SB(0, 0), cB, voffA); PG8_STAGE(PG8_SA(0, 0), cA, voffA); PG8_STAGE(PG8_SB(0, 1), cB + hstep, voffA); PG8_STAGE(PG8_SA(0, 1), cA + hstep, voffA);
  if (wr == 1) PG8_BAR;
  PG8_WAIT_V(4); PG8_BAR;
  PG8_STAGE(PG8_SB(1, 0), cB + kstep, voffA); PG8_STAGE(PG8_SA(1, 0), cA + kstep, voffA); PG8_STAGE(PG8_SB(1, 1), cB + hstep + kstep, voffA);
  PG8_WAIT_V(6); PG8_BAR;
  for (;;) {
    const long Ln = (long)(ui + 1) * G + c;
    const bool has_next = Ln < nunits;
    if (has_next) g8::unit_of((int)Ln, nM, nN, nxt.pm, nxt.pn);
    const char* nA = has_next ? (const char*)Ag + (size_t)nxt.pm * tstep : cA; const char* nB = has_next ? (const char*)Btg + (size_t)nxt.pn * tstep : cB;
    for (int t = 0; t < nt; t += 2) {
      const bool last = (t == nt - 2);
      const char* a1 = cA + (size_t)(t + 1) * kstep;
      const char* a2 = last ? nA : cA + (size_t)(t + 2) * kstep; const char* b2 = last ? nB : cB + (size_t)(t + 2) * kstep;
      const char* a3 = a2 + kstep; const char* b3 = b2 + kstep;
      PG8_LDB(B0, 0, 0); PG8_SCHED; PG8_LDA(At, 0, 0); PG8_STAGE(PG8_SA(1, 1), a1 + hstep, voffA);
      PG8_WAIT_L(8); PG8_BAR; PG8_WAIT_L(0); PG8_MMA(0, 0, At, B0); PG8_BAR; PG8_SCHED;
      PG8_LDB(B1, 0, 1); PG8_STAGE(PG8_SB(0, 0), b2, voffA);
      PG8_BAR; PG8_WAIT_L(0); PG8_MMA(0, 1, At, B1); PG8_BAR;
      PG8_LDA(At, 0, 1); PG8_STAGE(PG8_SA(0, 0), a2, voffA);
      PG8_BAR; PG8_WAIT_L(0); PG8_MMA(1, 0, At, B0); PG8_BAR; PG8_SCHED;
      PG8_STAGE(PG8_SB(0, 1), b2 + hstep, voffA);
      PG8_WAIT_V(6); PG8_BAR; PG8_MMA(1, 1, At, B1); PG8_BAR;
      PG8_LDB(B0, 1, 0); PG8_SCHED; PG8_LDA(At, 1, 0); PG8_STAGE(PG8_SA(0, 1), a2 + hstep, voffA);
      PG8_WAIT_L(8); PG8_BAR; PG8_WAIT_L(0); PG8_MMA(0, 0, At, B0); PG8_BAR; PG8_SCHED;
      PG8_LDB(B1, 1, 1); PG8_STAGE(PG8_SB(1, 0), b3, voffA);
      PG8_BAR; PG8_WAIT_L(0); PG8_MMA(0, 1, At, B1); PG8_BAR;
      PG8_LDA(At, 1, 1); PG8_STAGE(PG8_SA(1, 0), a3, voffA);
      PG8_BAR; PG8_WAIT_L(0); PG8_MMA(1, 0, At, B0); PG8_BAR; PG8_SCHED;
      PG8_STAGE(PG8_SB(1, 1), b3 + hstep, voffA);
      PG8_WAIT_V(6); PG8_BAR; PG8_MMA(1, 1, At, B1); PG8_BAR;
    }
    E(acc, cur, wr, wc, fr, fq);
    if (!has_next) break;
#pragma unroll
    for (int a = 0; a < 2; ++a)
#pragma unroll
      for (int b = 0; b < 2; ++b)
#pragma unroll
        for (int m = 0; m < 4; ++m)
#pragma unroll
          for (int n = 0; n < 2; ++n) acc[a][b][m][n] = (f32x4){0.f, 0.f, 0.f, 0.f};
    cur = nxt; cA = nA; cB = nB; ++ui;
  }
  PG8_WAIT_V(0);
  if (wr == 0) PG8_BAR;
  PG8_BAR;
#undef PG8_SA
#undef PG8_SB
#undef PG8_STAGE
#undef PG8_LDA
#undef PG8_LDB
#undef PG8_MMA
}

struct EpiZ {
  bf16* Z;
  DEVI void operator()(const f32x4 (&acc)[2][2][4][2], const G8Unit& u, int wr, int wc, int fr, int fq) const {
    const int brow = u.pm * 256, bcol = u.pn * 256;
#pragma unroll
    for (int ai = 0; ai < 2; ++ai)
#pragma unroll
      for (int m = 0; m < 4; ++m) {
        const int row = brow + ai * 128 + wr * 64 + m * 16 + fr;
#pragma unroll
        for (int bj = 0; bj < 2; ++bj)
#pragma unroll
          for (int n = 0; n < 2; ++n) {
            const int col = bcol + bj * 128 + wc * 32 + n * 16 + 4 * fq;
            if (col < DIN) {
              const f32x4 v = acc[ai][bj][m][n];
              *reinterpret_cast<uint2*>(Z + (size_t)row * DIN + col) = make_uint2(pack2(v[0], v[1]), pack2(v[2], v[3]));
            }
          }
      }
  }
};
DEVI void phase_gemm1_8(const Params& P, int l, unsigned char* smem_base) {
  EpiZ E{P.Z};
  gemm8_phase((LAS unsigned char*)smem_base, P.H, P.WinT + (size_t)l * DINP * 1024, 1024, NT / 256, DINP / 256, E);
}

struct EpiX {
  const float* x; const float* ctx; float* X; const float* MODl; int l;
  DEVI void operator()(const f32x4 (&acc)[2][2][4][2], const G8Unit& u, int wr, int wc, int fr, int fq) const {
    const int brow = u.pm * 256, bcol = u.pn * 256;
    const float* gate = MODl + (size_t)batch_of_row(brow) * 6144 + 2048;
#pragma unroll
    for (int ai = 0; ai < 2; ++ai)
#pragma unroll
      for (int m = 0; m < 4; ++m) {
        const int row = brow + ai * 128 + wr * 64 + m * 16 + fr;
        const float* res = (l == 0) ? (row < NL ? x + (size_t)row * 1024 : ctx + (size_t)(row - NL) * 1024) : X + (size_t)row * 1024;
#pragma unroll
        for (int bj = 0; bj < 2; ++bj)
#pragma unroll
          for (int n = 0; n < 2; ++n) {
            const int col = bcol + bj * 128 + wc * 32 + n * 16 + 4 * fq;
            const f32x4 v = acc[ai][bj][m][n];
            const float4 r4 = *reinterpret_cast<const float4*>(res + col);
            const float4 g4 = *reinterpret_cast<const float4*>(gate + col);
            float4 o; o.x = r4.x + g4.x * v[0]; o.y = r4.y + g4.y * v[1]; o.z = r4.z + g4.z * v[2]; o.w = r4.w + g4.w * v[3];
            *reinterpret_cast<float4*>(X + (size_t)row * 1024 + col) = o;
          }
      }
  }
};
DEVI void phase_gemm2_8(const Params& P, int l, unsigned char* smem_base) {
  EpiX E{P.x, P.ctx, P.X, P.MOD + (size_t)l * 9 * 6144, l};
  gemm8_phase((LAS unsigned char*)smem_base, P.H, P.WoutT + (size_t)l * 1024 * 1024, 1024, (l == 1) ? NL / 256 : NT / 256, 4, E);
}

struct EpiQP {
  bf16* QP;
  DEVI void operator()(const f32x4 (&acc)[2][2][4][2], const G8Unit& u, int wr, int wc, int fr, int fq) const {
    const int brow = u.pm * 256, bcol = u.pn * 256;
#pragma unroll
    for (int ai = 0; ai < 2; ++ai)
#pragma unroll
      for (int m = 0; m < 4; ++m) {
        const int row = brow + ai * 128 + wr * 64 + m * 16 + fr;
#pragma unroll
        for (int bj = 0; bj < 2; ++bj)
#pragma unroll
          for (int n = 0; n < 2; ++n) {
            const int col = bcol + bj * 128 + wc * 32 + n * 16 + 4 * fq;
            const f32x4 v = acc[ai][bj][m][n];
            *reinterpret_cast<uint2*>(QP + (size_t)row * 2048 + col) = make_uint2(pack2(v[0], v[1]), pack2(v[2], v[3]));
          }
      }
  }
};
DEVI void phase_gemm3_8(const Params& P, int l, unsigned char* smem_base) {
  EpiQP E{P.QP};
  gemm8_phase((LAS unsigned char*)smem_base, P.H, P.WpqT + (size_t)l * 2048 * 1024, 1024, (l == 1) ? NL / 256 : NT / 256, 8, E);
}

constexpr int N_PHASES = 2 + 2 * 9;

#ifndef REP_MASK
#define REP_MASK 0
#endif
__global__ void __launch_bounds__(512, 2) fwd_kernel(Params P) {
  extern __shared__ __attribute__((aligned(16))) unsigned char smem_base[];
  unsigned char* smem = smem_base + VHALF * HALF_LDS;
  cg::grid_group grid = cg::this_grid();
  volatile LAS unsigned* xst = (volatile LAS unsigned*)(smem_base + SMEM_BYTES);
  if (threadIdx.x == 0) { xst[0] = 0u; xst[1] = 0u; xst[2] = 0u; xst[3] = 0u; }
  __syncthreads();
  XcdBarrier xb = xcd_barrier_post(P.bar, xst);
#define GSYNC(idx) { if ((idx) == 0) grid.sync(); else xcd_barrier(xb); }
#define RUN_PHASE2(idx, call, repcall) \
  if (P.phase_lo <= (idx) && (idx) <= P.phase_hi) { call; if (REP_MASK & (1 << (idx))) { GSYNC(1); repcall; } if (P.coop && (idx) < P.phase_hi) GSYNC(idx); }
#define RUN_PHASE(idx, call) RUN_PHASE2(idx, call, call)
  RUN_PHASE(0, phase_prologue(P, smem))
  RUN_PHASE(1, phase_norm(P, 0, 0, NT))
  RUN_PHASE(2, phase_gemm1_8(P, 0, smem_base))
  RUN_PHASE(3, { phase_mixA(P, 0, smem); phase_mla_proj(P, 0, smem); phase_hgrn_local(P, 0, smem); })
  RUN_PHASE2(4, phase_attn_scan(P, 0, smem), phase_attn_scan(P, 0, smem, true))
  RUN_PHASE(5, phase_hgrn_final(P, 0, smem))
  RUN_PHASE(6, phase_gemm2_8(P, 0, smem_base))
  RUN_PHASE(7, phase_norm(P, 0, 1, NT))
  RUN_PHASE(8, phase_gemm3_8(P, 0, smem_base))
  RUN_PHASE(9, phase_route(P, 0, smem))
  RUN_PHASE(10, phase_peer(P, 0))
  RUN_PHASE(11, phase_gemm1_8(P, 1, smem_base))
  RUN_PHASE(12, { phase_mixA(P, 1, smem); phase_mla_proj(P, 1, smem); phase_hgrn_local(P, 1, smem); })
  RUN_PHASE(13, phase_attn_scan(P, 1, smem))
  RUN_PHASE(14, phase_hgrn_final(P, 1, smem))
  RUN_PHASE(15, phase_gemm2_8(P, 1, smem_base))
  RUN_PHASE(16, phase_norm(P, 1, 1, NL))
  RUN_PHASE(17, phase_gemm3_8(P, 1, smem_base))
  RUN_PHASE(18, phase_route(P, 1, smem))
  RUN_PHASE(19, phase_peer(P, 1))
}

extern "C" void kernel_launch(void* const* d_in, const int* in_sizes, int n_in, void* d_out, int out_size, void* d_ws,
                              size_t ws_size, hipStream_t stream) {
  Params p{};
  const float* const* in = reinterpret_cast<const float* const*>(d_in);
  p.x = in[0]; p.c = in[1]; p.ctx = in[2]; p.c_ctx = in[3]; p.ln1_w = in[4]; p.ln2_w = in[5]; p.w_mod = in[6]; p.b_mod = in[7];
  p.w_in = in[8]; p.w_out = in[9]; p.a_norm_w = in[10]; p.a_w_s = in[11]; p.a_b_s = in[12]; p.b_q_norm_w = in[13]; p.b_w_uq = in[14];
  p.b_kv_norm_w = in[15]; p.b_w_ukv = in[16]; p.b_qh_w = in[17]; p.b_kh_w = in[18]; p.c_lb = in[19]; p.c_out_norm_w = in[20];
  p.p_w_q = in[21]; p.p_sub_keys = in[22]; p.p_u = in[23]; p.p_v = in[24];
  p.out = reinterpret_cast<float*>(d_out);
  unsigned char* ws = reinterpret_cast<unsigned char*>(d_ws);
  size_t off = 0;
  auto take = [&](size_t bytes) { unsigned char* r = ws + off; off += (bytes + 255) & ~(size_t)255; return r; };
  p.bar = (unsigned*)take((size_t)XCD_BAR_WORDS * 4);
  p.MOD = (float*)take((size_t)2 * 9 * 6144 * 4);
  p.ROPE = (float*)take((size_t)2048 * 32 * 4);
  p.WinT = (bf16*)take((size_t)2 * DINP * 1024 * 2);
  p.WoutT = (bf16*)take((size_t)2 * 1024 * 1024 * 2);
  p.WpqT = (bf16*)take((size_t)2 * 2048 * 1024 * 2);
  p.WuqT = (bf16*)take((size_t)2 * 768 * 256 * 2);
  p.WukvT = (bf16*)take((size_t)2 * 1024 * 128 * 2);
  p.SK = (bf16*)take((size_t)2 * 16 * 128 * 128 * 2);
  p.AWS = (bf16*)take((size_t)2 * 4 * 128 * 128 * 2);
  p.PU8 = (unsigned char*)take((size_t)2 * 16384 * 1024);
  p.PV8 = (unsigned char*)take((size_t)2 * 16384 * 1024);
  p.PUS = (float*)take((size_t)2 * 16384 * 4);
  p.PVS = (float*)take((size_t)2 * 16384 * 4);
  p.X = (float*)take((size_t)NT * 1024 * 4);
  p.H = (bf16*)take((size_t)NT * 1024 * 2);
  p.Z = (bf16*)take((size_t)NT * DIN * 2);
  p.Q = (bf16*)take((size_t)64 * SEQP * 96 * 2);
  p.K = (bf16*)take((size_t)64 * SEQP * 96 * 2);
  p.VT = (bf16*)take((size_t)64 * 64 * SEQP * 2);
  p.ST = (float*)take((size_t)64 * 36 * 4096 * 4);
  p.DEC = (float*)take((size_t)64 * 36 * 64 * 4);
  p.OI = (float*)take((size_t)NT * 256 * 4);
  p.QP = p.Z;
  p.EIDX = (int*)p.Q;
  p.GATE = (float*)p.K;
  if (off > ws_size) { fprintf(stderr, "workspace too small: need %zu have %zu\n", off, ws_size); }
  static int grid_blocks = 0;
  if (!grid_blocks) {
    if (hipFuncSetAttribute((const void*)fwd_kernel, hipFuncAttributeMaxDynamicSharedMemorySize, SMEM_TOTAL) != hipSuccess)
      fprintf(stderr, "hipFuncSetAttribute failed\n");
    int dev = 0, cus = 0, per_cu = 0;
    hipGetDevice(&dev);
    hipDeviceGetAttribute(&cus, hipDeviceAttributeMultiprocessorCount, dev);
    hipOccupancyMaxActiveBlocksPerMultiprocessor(&per_cu, (const void*)fwd_kernel, 512, SMEM_TOTAL);
    if (per_cu > 1) per_cu = 1;
    if (per_cu < 1) { fprintf(stderr, "occupancy query returned %d\n", per_cu); per_cu = 1; }
    grid_blocks = cus * per_cu;
    fprintf(stderr, "grid_blocks=%d (cus=%d per_cu=%d) ws need=%zu have=%zu\n", grid_blocks, cus, per_cu, off, ws_size);
  }
  hipMemsetAsync(p.bar, 0, (size_t)XCD_BAR_WORDS * 4, stream);
  p.coop = 1; p.phase_lo = 0; p.phase_hi = N_PHASES - 1;
  void* args[] = {&p};
  const hipError_t e = hipLaunchCooperativeKernel((const void*)fwd_kernel, dim3(grid_blocks), dim3(512), args, SMEM_TOTAL, stream);
  if (e != hipSuccess) fprintf(stderr, "cooperative launch failed: %s (grid %d)\n", hipGetErrorString(e), grid_blocks);
}
```

```cpp
#include <hip/hip_runtime.h>
#include <hip/hip_cooperative_groups.h>
#include <cstdio>
#include <cstdint>
namespace cg = cooperative_groups;

#define DEVI __device__ __forceinline__

typedef unsigned short bf16;
using bf16x8 = __attribute__((ext_vector_type(8))) __bf16;
using bf16x2 = __attribute__((ext_vector_type(2))) __bf16;
using f32x16 = __attribute__((ext_vector_type(16))) float;
typedef unsigned v6u __attribute__((ext_vector_type(6)));
typedef unsigned v3u __attribute__((ext_vector_type(3)));
typedef float v16f __attribute__((ext_vector_type(16)));
typedef float v32f __attribute__((ext_vector_type(32)));

constexpr int NL = 16384;
constexpr int NT = 18432;
constexpr int DM = 1024;
constexpr int DIN = 2208;
constexpr int DINP = 2304;
constexpr int SEQP = 2304;
constexpr float EPS = 1e-6f;
constexpr int ZC_AU = 0, ZC_AV = 256, ZC_BQ = 512, ZC_BKV = 768, ZC_BKR = 896, ZC_CQ = 928, ZC_CFF = 1184, ZC_CFB = 1440, ZC_CI = 1696, ZC_CG = 1952;
constexpr int SMEM_BYTES = 2 * 80896;
constexpr int SMEM_TOTAL = SMEM_BYTES + 16;

struct Params {
  const float *x, *c, *ctx, *c_ctx, *ln1_w, *ln2_w, *w_mod, *b_mod, *w_in, *w_out, *a_norm_w, *a_w_s, *a_b_s;
  const float *b_q_norm_w, *b_w_uq, *b_kv_norm_w, *b_w_ukv, *b_qh_w, *b_kh_w, *c_lb, *c_out_norm_w, *p_w_q, *p_sub_keys, *p_u, *p_v;
  float* out;
  unsigned* bar;
  float* MOD;
  float* ROPE;
  bf16* WinT;
  bf16* WoutT;
  bf16* WpqT;
  bf16* WuqT;
  bf16* WukvT;
  bf16* SK;
  bf16* AWS;
  unsigned char* PU8;
  unsigned char* PV8;
  float* PUS;
  float* PVS;
  float* X;
  bf16* H;
  bf16* Z;
  bf16* Q;
  bf16* K;
  bf16* VT;
  float* ST;
  float* DEC;
  float* OI;
  bf16* GQF;
  bf16* GQB;
  bf16* QP;
  int* EIDX;
  float* GATE;
  int phase_lo, phase_hi, coop, pad0;
};

DEVI float bf2f(bf16 v) { return __uint_as_float(((unsigned)v) << 16); }
DEVI bf16 f2bf(float a) { __bf16 v = (__bf16)a; return __builtin_bit_cast(unsigned short, v); }
DEVI unsigned pack2(float a, float b) { bf16x2 v; v[0] = (__bf16)a; v[1] = (__bf16)b; return __builtin_bit_cast(unsigned, v); }
DEVI float lo2f(unsigned u) { return __uint_as_float(u << 16); }
DEVI float hi2f(unsigned u) { return __uint_as_float(u & 0xffff0000u); }
DEVI f32x16 zero16() { f32x16 z;
#pragma unroll
  for (int i = 0; i < 16; ++i) z[i] = 0.f; return z; }
DEVI f32x16 mfma32(bf16x8 a, bf16x8 b, f32x16 c) { return __builtin_amdgcn_mfma_f32_32x32x16_bf16(a, b, c, 0, 0, 0); }
DEVI bf16x8 ldfrag(const bf16* p) { return *reinterpret_cast<const bf16x8*>(p); }
DEVI int drow(int r, int hh) { return (r & 3) + 8 * (r >> 2) + 4 * hh; }
DEVI int row_of(int b, int p) { return p < 256 ? NL + b * 256 + p : b * 2048 + (p - 256); }
DEVI int batch_of_row(int r) { return r < NL ? (r >> 11) : 8; }
DEVI float wave_sum(float v) {
#pragma unroll
  for (int o = 32; o > 0; o >>= 1) v += __shfl_xor(v, o);
  return v;
}
DEVI float sigmoidf_(float z) { return 1.f / (1.f + __expf(-z)); }


#define XB_TMO      128
#define XB_XCNT(j)  (256  + 64 * (j))
#define XB_XSUB(j)  (1280 + 64 * (j))
#define XB_XGEN(j)  (2304 + 64 * (j))
#define XB_TOP      3328
#define XB_TOPGEN   3392
#define XCD_BAR_WORDS 3456
#define XB_SPIN_CAP (1u << 22)
#define LAS __attribute__((address_space(3)))
DEVI unsigned xb_ld(unsigned* p)              { return __hip_atomic_load(p, __ATOMIC_RELAXED, __HIP_MEMORY_SCOPE_AGENT); }
DEVI unsigned xb_add(unsigned* p, unsigned v) { return __hip_atomic_fetch_add(p, v, __ATOMIC_RELAXED, __HIP_MEMORY_SCOPE_AGENT); }
DEVI unsigned xb_xcc_id() { return (unsigned)__builtin_amdgcn_s_getreg((3 << 11) | 20) & 0xFu; }
#define XB_SPIN(cond, bar) do { unsigned _sp = 0; while (cond) { __builtin_amdgcn_s_sleep(1); \
    if ((++_sp & 255u) == 0u) { if (xb_ld(&(bar)[XB_TMO])) break; if (_sp > XB_SPIN_CAP) { atomicAdd(&(bar)[XB_TMO], 1u); break; } } } } while (0)
struct XcdBarrier { unsigned* bar; unsigned x; volatile LAS unsigned* st; };
DEVI XcdBarrier xcd_barrier_post(unsigned* bar, volatile LAS unsigned* st) {
  XcdBarrier b; b.bar = bar; b.x = xb_xcc_id(); b.st = st;
  if (threadIdx.x == 0) (void)xb_add(&bar[XB_XCNT(b.x)], 1u);
  return b;
}
DEVI void xcd_barrier_complete(unsigned* bar, unsigned x, unsigned& nloc, unsigned& nx) {
  const unsigned G = gridDim.x * gridDim.y * gridDim.z;
  unsigned sum, cnt, mine, sp = 0u;
  for (;;) {
    sum = 0u; cnt = 0u; mine = 0u;
#pragma unroll
    for (unsigned j = 0; j < 16; ++j) { const unsigned c = xb_ld(&bar[XB_XCNT(j)]); sum += c; cnt += (c > 0u) ? 1u : 0u; mine = (j == x) ? c : mine; }
    if (sum == G) break;
    __builtin_amdgcn_s_sleep(1);
    if ((++sp & 255u) == 0u) { if (xb_ld(&bar[XB_TMO])) break; if (sp > XB_SPIN_CAP) { atomicAdd(&bar[XB_TMO], 1u); break; } }
  }
  nloc = mine > 0u ? mine : 1u; nx = cnt > 0u ? cnt : 1u;
}
DEVI void xcd_barrier(const XcdBarrier& b) {
  asm volatile("s_waitcnt vmcnt(0)" ::: "memory");
  __syncthreads();
  if (threadIdx.x == 0) {
    unsigned* bar = b.bar;
    __builtin_amdgcn_s_waitcnt(0);
    unsigned nloc = b.st[0], nx = b.st[1];
    if (nloc == 0u) { xcd_barrier_complete(bar, b.x, nloc, nx); b.st[0] = nloc; b.st[1] = nx; }
    const unsigned old = xb_add(&bar[XB_XSUB(b.x)], 1u);
    const unsigned gen = old / nloc;
    if (old + 1u == (gen + 1u) * nloc) {
      __builtin_amdgcn_fence(__ATOMIC_RELEASE, "agent");
      asm volatile("s_waitcnt vmcnt(0)" ::: "memory");
      const unsigned og = xb_add(&bar[XB_TOP], 1u);
      const unsigned tg = og / nx;
      if (og + 1u == (tg + 1u) * nx) xb_add(&bar[XB_TOPGEN], 1u);
      else XB_SPIN(xb_ld(&bar[XB_TOPGEN]) == tg, bar);
      __builtin_amdgcn_fence(__ATOMIC_ACQUIRE, "agent");
      xb_add(&bar[XB_XGEN(b.x)], 1u);
      asm volatile("s_waitcnt vmcnt(0)" ::: "memory");
    } else {
      XB_SPIN(xb_ld(&bar[XB_XGEN(b.x)]) == gen, bar);
      __builtin_amdgcn_fence(__ATOMIC_ACQUIRE, "agent");
      asm volatile("s_waitcnt vmcnt(0)" ::: "memory");
    }
  }
  __syncthreads();
}

#define VHALF ((int)__builtin_amdgcn_readfirstlane((int)(threadIdx.x >> 8)))
#define TIDX ((int)(threadIdx.x & 255))
#define VBID ((int)(blockIdx.x * 2 + VHALF))
#define NVB ((int)(gridDim.x * 2))
constexpr int HALF_LDS = 80896;

DEVI void phase_mod(const Params& P, unsigned char* smem) {
  const int tid = TIDX;
  float* s = (float*)smem;
  float* red = s + 9 * 1024;
  for (int item = VBID; item < 192; item += NVB) {
    const int l = item / 96, j = item % 96;
    __syncthreads();
    for (int i = tid; i < 9 * 1024; i += 256) {
      int bi = i >> 10, k = i & 1023;
      float v = bi < 8 ? P.c[bi * 1024 + k] : P.c_ctx[k];
      s[i] = v * sigmoidf_(v);
    }
    __syncthreads();
    const int c4 = tid & 15, kg = tid >> 4;
    float acc[9][4];
#pragma unroll
    for (int bi = 0; bi < 9; ++bi) { acc[bi][0] = acc[bi][1] = acc[bi][2] = acc[bi][3] = 0.f; }
    const float* w = P.w_mod + (size_t)l * 1024 * 6144 + j * 64 + c4 * 4;
#pragma unroll 4
    for (int kk = 0; kk < 64; ++kk) {
      const int k = kg * 64 + kk;
      const float4 w4 = *reinterpret_cast<const float4*>(w + (size_t)k * 6144);
#pragma unroll
      for (int bi = 0; bi < 9; ++bi) {
        const float sv = s[bi * 1024 + k];
        acc[bi][0] += sv * w4.x; acc[bi][1] += sv * w4.y; acc[bi][2] += sv * w4.z; acc[bi][3] += sv * w4.w;
      }
    }
#pragma unroll
    for (int bi = 0; bi < 9; ++bi)
#pragma unroll
      for (int e = 0; e < 4; ++e) red[(kg * 9 + bi) * 64 + c4 * 4 + e] = acc[bi][e];
    __syncthreads();
    for (int o = tid; o < 576; o += 256) {
      const int bi = o >> 6, cc = o & 63;
      float sum = 0.f;
#pragma unroll
      for (int g = 0; g < 16; ++g) sum += red[(g * 9 + bi) * 64 + cc];
      P.MOD[(size_t)(l * 9 + bi) * 6144 + j * 64 + cc] = sum + P.b_mod[l * 6144 + j * 64 + cc];
    }
  }
}

DEVI void conv_T_tile(const float* __restrict__ src, int N, bf16* __restrict__ dst, int Kd, int k0, int n0,
                      const float* __restrict__ kscale, float* tile) {
  const int tid = TIDX;
  __syncthreads();
  for (int e = tid; e < 4096; e += 256) {
    const int i = e >> 6, j = e & 63, n = n0 + j;
    float v = (n < N) ? src[(size_t)(k0 + i) * N + n] : 0.f;
    if (kscale) v *= kscale[k0 + i];
    tile[i * 65 + j] = v;
  }
  __syncthreads();
  for (int e = tid; e < 2048; e += 256) {
    const int j = e >> 5, i2 = (e & 31) * 2;
    const unsigned pk = pack2(tile[i2 * 65 + j], tile[(i2 + 1) * 65 + j]);
    *reinterpret_cast<unsigned*>(&dst[(size_t)(n0 + j) * Kd + k0 + i2]) = pk;
  }
}

DEVI void conv_straight(const float* __restrict__ src, bf16* __restrict__ dst, size_t n8) {
  const size_t stride = (size_t)NVB * 256;
  for (size_t i = (size_t)VBID * 256 + TIDX; i < n8; i += stride) {
    const float4 a = reinterpret_cast<const float4*>(src)[2 * i];
    const float4 b = reinterpret_cast<const float4*>(src)[2 * i + 1];
    uint4 o; o.x = pack2(a.x, a.y); o.y = pack2(a.z, a.w); o.z = pack2(b.x, b.y); o.w = pack2(b.z, b.w);
    reinterpret_cast<uint4*>(dst)[i] = o;
  }
}

DEVI void phase_prologue(const Params& P, unsigned char* smem) {
  phase_mod(P, smem);
  float* tile = (float*)smem;
  for (int it = VBID; it < 2 * 1424; it += NVB) {
    const int l = it / 1424; int r = it % 1424;
    if (r < 576) { conv_T_tile(P.w_in + (size_t)l * 1024 * DIN, DIN, P.WinT + (size_t)l * DINP * 1024, 1024, (r % 16) * 64, (r / 16) * 64, nullptr, tile); continue; }
    r -= 576;
    if (r < 256) { conv_T_tile(P.w_out + (size_t)l * 1024 * 1024, 1024, P.WoutT + (size_t)l * 1024 * 1024, 1024, (r % 16) * 64, (r / 16) * 64, nullptr, tile); continue; }
    r -= 256;
    if (r < 512) { conv_T_tile(P.p_w_q + (size_t)l * 1024 * 2048, 2048, P.WpqT + (size_t)l * 2048 * 1024, 1024, (r % 16) * 64, (r / 16) * 64, nullptr, tile); continue; }
    r -= 512;
    if (r < 48) { conv_T_tile(P.b_w_uq + (size_t)l * 256 * 768, 768, P.WuqT + (size_t)l * 768 * 256, 256, (r % 4) * 64, (r / 4) * 64, P.b_q_norm_w + l * 256, tile); continue; }
    r -= 48;
    conv_T_tile(P.b_w_ukv + (size_t)l * 128 * 1024, 1024, P.WukvT + (size_t)l * 1024 * 128, 128, (r % 2) * 64, (r / 2) * 64, P.b_kv_norm_w + l * 128, tile);
  }
  conv_straight(P.p_sub_keys, P.SK, (size_t)2 * 16 * 128 * 128 / 8);
  conv_straight(P.a_w_s, P.AWS, (size_t)2 * 4 * 128 * 128 / 8);
  {
    const int lane = TIDX & 63, half = lane >> 5, l32 = lane & 31;
    const int gw = VBID * 4 + (TIDX >> 6), nw = NVB * 4;
    for (int r2 = gw; r2 < 32768; r2 += nw) {
      const int r = r2 * 2 + half;
      const int table = r >> 15, lr = r & 32767;
      const float* src = (table ? P.p_v : P.p_u) + (size_t)lr * 1024 + l32 * 32;
      float4 a[8];
      float m = 0.f;
#pragma unroll
      for (int i = 0; i < 8; ++i) {
        a[i] = *reinterpret_cast<const float4*>(src + i * 4);
        m = fmaxf(m, fmaxf(fmaxf(fabsf(a[i].x), fabsf(a[i].y)), fmaxf(fabsf(a[i].z), fabsf(a[i].w))));
      }
#pragma unroll
      for (int o = 16; o > 0; o >>= 1) m = fmaxf(m, __shfl_xor(m, o));
      const float sc = fmaxf(m, 1e-30f) * (1.f / 7.5f);
      const float inv = 1.f / sc;
      unsigned pk[6];
      {
        unsigned long long accb = 0ull; int nb = 0, wi = 0;
#pragma unroll
        for (int i = 0; i < 32; ++i) {
          const float4 q4 = a[i >> 2];
          const float xv = ((i & 3) == 0 ? q4.x : (i & 3) == 1 ? q4.y : (i & 3) == 2 ? q4.z : q4.w) * inv;
          const float av = fabsf(xv);
          const float cf = av < 2.f ? rintf(av * 8.f) : (av < 4.f ? 16.f + rintf((av - 2.f) * 4.f) : 24.f + rintf((av - 4.f) * 2.f));
          unsigned ci = (unsigned)cf; ci = ci > 31u ? 31u : ci;
          ci |= (xv < 0.f) ? 32u : 0u;
          accb |= (unsigned long long)ci << nb; nb += 6;
          if (nb >= 32) { pk[wi++] = (unsigned)accb; accb >>= 32; nb -= 32; }
        }
      }
      unsigned* dst = reinterpret_cast<unsigned*>((table ? P.PV8 : P.PU8) + (size_t)lr * 768 + l32 * 24);
      *reinterpret_cast<v3u*>(dst) = (v3u){pk[0], pk[1], pk[2]};
      *reinterpret_cast<v3u*>(dst + 3) = (v3u){pk[3], pk[4], pk[5]};
      if (l32 == 0) (table ? P.PVS : P.PUS)[lr] = sc;
    }
  }
  for (int i = VBID * 256 + TIDX; i < 2048 * 16; i += NVB * 256) {
    const int t = i >> 4, a = (i >> 3) & 1, f = i & 7;
    const float inv = powf(10000.f, -(float)f / 8.f);
    const float pos = a ? (float)(t & 63) : (float)(t >> 6);
    const float ang = pos * inv;
    P.ROPE[t * 32 + a * 8 + f] = cosf(ang);
    P.ROPE[t * 32 + 16 + a * 8 + f] = sinf(ang);
  }
}

DEVI void phase_norm(const Params& P, int l, int which, int nrows) {
  const int lane = TIDX & 63;
  const int gw = VBID * 4 + (TIDX >> 6), nw = NVB * 4;
  const float* lnw = (which == 0 ? P.ln1_w : P.ln2_w) + l * 1024;
  for (int r = gw; r < nrows; r += nw) {
    const float* src;
    if (which == 0 && l == 0) src = r < NL ? P.x + (size_t)r * 1024 : P.ctx + (size_t)(r - NL) * 1024;
    else src = P.X + (size_t)r * 1024;
    const float* mod = P.MOD + (size_t)(l * 9 + batch_of_row(r)) * 6144 + which * 3072;
    float4 v[4];
    float ss = 0.f;
#pragma unroll
    for (int i = 0; i < 4; ++i) {
      v[i] = *reinterpret_cast<const float4*>(src + i * 256 + lane * 4);
      ss += v[i].x * v[i].x + v[i].y * v[i].y + v[i].z * v[i].z + v[i].w * v[i].w;
    }
    ss = wave_sum(ss);
    const float rr = rsqrtf(ss * (1.f / 1024.f) + EPS);
#pragma unroll
    for (int i = 0; i < 4; ++i) {
      const int d = i * 256 + lane * 4;
      const float4 w = *reinterpret_cast<const float4*>(lnw + d);
      const float4 sh = *reinterpret_cast<const float4*>(mod + d);
      const float4 sc = *reinterpret_cast<const float4*>(mod + 1024 + d);
      const float o0 = v[i].x * rr * w.x * (1.f + sc.x) + sh.x;
      const float o1 = v[i].y * rr * w.y * (1.f + sc.y) + sh.y;
      const float o2 = v[i].z * rr * w.z * (1.f + sc.z) + sh.z;
      const float o3 = v[i].w * rr * w.w * (1.f + sc.w) + sh.w;
      uint2 o; o.x = pack2(o0, o1); o.y = pack2(o2, o3);
      *reinterpret_cast<uint2*>(P.H + (size_t)r * 1024 + d) = o;
    }
  }
}

template <int BM, int BN, int BK, int WM, int WN>
struct Gemm {
  static constexpr int LDK = BK + 8;
  static constexpr int TM = BM / WM / 32, TN = BN / WN / 32;
  static constexpr int CPR = BK / 8;
  static constexpr int NA = BM * CPR / 256, NB = BN * CPR / 256;
  static constexpr int A_BYTES = BM * LDK * 2, B_BYTES = BN * LDK * 2;
  static constexpr int STAGE_BYTES = A_BYTES + B_BYTES;
  static constexpr int SMEM = 2 * STAGE_BYTES;

  static DEVI void run(const bf16* __restrict__ A, int lda, const bf16* __restrict__ BT, int ldb, int K,
                       unsigned char* smem, f32x16 (&acc)[TM][TN]) {
    const int tid = TIDX, lane = tid & 63, wave = tid >> 6;
    const int wm = wave / WN, wn = wave % WN;
    const int l31 = lane & 31, hh = lane >> 5;
#pragma unroll
    for (int i = 0; i < TM; ++i)
#pragma unroll
      for (int j = 0; j < TN; ++j) acc[i][j] = zero16();
    uint4 ra[NA], rb[NB];
    const int nk = K / BK;
    auto gload = [&](int kt) {
#pragma unroll
      for (int i = 0; i < NA; ++i) { const int ch = tid + i * 256, row = ch / CPR, cc = ch % CPR;
        ra[i] = *reinterpret_cast<const uint4*>(A + (size_t)row * lda + kt * BK + cc * 8); }
#pragma unroll
      for (int i = 0; i < NB; ++i) { const int ch = tid + i * 256, row = ch / CPR, cc = ch % CPR;
        rb[i] = *reinterpret_cast<const uint4*>(BT + (size_t)row * ldb + kt * BK + cc * 8); }
    };
    auto swrite = [&](int buf) {
      bf16* sA = reinterpret_cast<bf16*>(smem + buf * STAGE_BYTES);
      bf16* sB = reinterpret_cast<bf16*>(smem + buf * STAGE_BYTES + A_BYTES);
#pragma unroll
      for (int i = 0; i < NA; ++i) { const int ch = tid + i * 256, row = ch / CPR, cc = ch % CPR;
        *reinterpret_cast<uint4*>(sA + row * LDK + cc * 8) = ra[i]; }
#pragma unroll
      for (int i = 0; i < NB; ++i) { const int ch = tid + i * 256, row = ch / CPR, cc = ch % CPR;
        *reinterpret_cast<uint4*>(sB + row * LDK + cc * 8) = rb[i]; }
    };
    __syncthreads();
    gload(0);
    swrite(0);
    __syncthreads();
    for (int kt = 0; kt < nk; ++kt) {
      const int cur = kt & 1;
      if (kt + 1 < nk) gload(kt + 1);
      const bf16* sA = reinterpret_cast<const bf16*>(smem + cur * STAGE_BYTES);
      const bf16* sB = reinterpret_cast<const bf16*>(smem + cur * STAGE_BYTES + A_BYTES);
#pragma unroll
      for (int ks = 0; ks < BK / 16; ++ks) {
        bf16x8 af[TM], bfr[TN];
#pragma unroll
        for (int i = 0; i < TM; ++i) af[i] = ldfrag(sA + (wm * (BM / WM) + i * 32 + l31) * LDK + ks * 16 + hh * 8);
#pragma unroll
        for (int j = 0; j < TN; ++j) bfr[j] = ldfrag(sB + (wn * (BN / WN) + j * 32 + l31) * LDK + ks * 16 + hh * 8);
#pragma unroll
        for (int i = 0; i < TM; ++i)
#pragma unroll
          for (int j = 0; j < TN; ++j) acc[i][j] = mfma32(af[i], bfr[j], acc[i][j]);
      }
      if (kt + 1 < nk) swrite(cur ^ 1);
      __syncthreads();
    }
  }
};

DEVI void phase_gemm1(const Params& P, int l, unsigned char* smem) {
  using G = Gemm<128, 128, 64, 2, 2>;
  const int lane = TIDX & 63, wave = TIDX >> 6, wm = wave >> 1, wn = wave & 1, l31 = lane & 31, hh = lane >> 5;
  const bf16* W = P.WinT + (size_t)l * DINP * 1024;
  for (int t = VBID; t < 144 * 18; t += NVB) {
    const int mt = t / 18, nt = t % 18;
    f32x16 acc[2][2];
    G::run(P.H + (size_t)mt * 128 * 1024, 1024, W + (size_t)nt * 128 * 1024, 1024, 1024, smem, acc);
#pragma unroll
    for (int i = 0; i < 2; ++i)
#pragma unroll
      for (int j = 0; j < 2; ++j) {
        const int col = nt * 128 + wn * 64 + j * 32 + l31;
        if (col < DIN) {
#pragma unroll
          for (int r = 0; r < 16; ++r) {
            const int row = mt * 128 + wm * 64 + i * 32 + drow(r, hh);
            P.Z[(size_t)row * DIN + col] = f2bf(acc[i][j][r]);
          }
        }
      }
  }
}

DEVI void phase_gemm2(const Params& P, int l, unsigned char* smem) {
  using G = Gemm<128, 128, 64, 2, 2>;
  const int lane = TIDX & 63, wave = TIDX >> 6, wm = wave >> 1, wn = wave & 1, l31 = lane & 31, hh = lane >> 5;
  const bf16* W = P.WoutT + (size_t)l * 1024 * 1024;
  const int mtiles = (l == 1) ? 128 : 144;
  for (int t = VBID; t < mtiles * 8; t += NVB) {
    const int mt = t / 8, nt = t % 8;
    f32x16 acc[2][2];
    G::run(P.H + (size_t)mt * 128 * 1024, 1024, W + (size_t)nt * 128 * 1024, 1024, 1024, smem, acc);
    const int bi = batch_of_row(mt * 128);
    const float* gate = P.MOD + (size_t)(l * 9 + bi) * 6144 + 2048;
#pragma unroll
    for (int i = 0; i < 2; ++i)
#pragma unroll
      for (int j = 0; j < 2; ++j) {
        const int col = nt * 128 + wn * 64 + j * 32 + l31;
        const float g = gate[col];
#pragma unroll
        for (int r = 0; r < 16; ++r) {
          const int row = mt * 128 + wm * 64 + i * 32 + drow(r, hh);
          float res;
          if (l == 0) res = row < NL ? P.x[(size_t)row * 1024 + col] : P.ctx[(size_t)(row - NL) * 1024 + col];
          else res = P.X[(size_t)row * 1024 + col];
          P.X[(size_t)row * 1024 + col] = res + g * acc[i][j][r];
        }
      }
  }
}

DEVI void phase_mixA(const Params& P, int l, unsigned char* smem) {
  const int tid = TIDX, lane = tid & 63, wave = tid >> 6, l31 = lane & 31, hh = lane >> 5;
  bf16* VNT = reinterpret_cast<bf16*>(smem);
  constexpr int LDV = 136;
  const int nseg = (l == 1) ? 16 : 18;
  const int seg0 = (l == 1) ? 2 : 0;
  for (int it = VBID; it < 8 * nseg * 4; it += NVB) {
    const int a = it & 3; const int sj = (it >> 2) % nseg + seg0; const int b = (it >> 2) / nseg;
    const int p0 = sj * 128;
    __syncthreads();
    {
      const int q = tid >> 1, half = tid & 1;
      const int row = row_of(b, p0 + q);
      const bf16* src = P.Z + (size_t)row * DIN + ZC_AV + a * 64 + half * 32;
      float v[32];
      float ss = 0.f;
#pragma unroll
      for (int i = 0; i < 4; ++i) {
        const uint4 u = *reinterpret_cast<const uint4*>(src + i * 8);
        v[i * 8 + 0] = lo2f(u.x); v[i * 8 + 1] = hi2f(u.x); v[i * 8 + 2] = lo2f(u.y); v[i * 8 + 3] = hi2f(u.y);
        v[i * 8 + 4] = lo2f(u.z); v[i * 8 + 5] = hi2f(u.z); v[i * 8 + 6] = lo2f(u.w); v[i * 8 + 7] = hi2f(u.w);
      }
#pragma unroll
      for (int i = 0; i < 32; ++i) ss += v[i] * v[i];
      ss += __shfl_xor(ss, 1);
      const float rr = rsqrtf(ss * (1.f / 64.f) + EPS);
      const float* nw = P.a_norm_w + l * 256 + a * 64 + half * 32;
#pragma unroll
      for (int i = 0; i < 32; ++i) VNT[(half * 32 + i) * LDV + q] = f2bf(v[i] * rr * nw[i]);
    }
    __syncthreads();
    f32x16 acc[2]; acc[0] = zero16(); acc[1] = zero16();
    const bf16* Aw = P.AWS + (size_t)(l * 4 + a) * 128 * 128 + (size_t)(wave * 32 + l31) * 128;
#pragma unroll
    for (int ks = 0; ks < 8; ++ks) {
      const bf16x8 af = ldfrag(Aw + ks * 16 + hh * 8);
#pragma unroll
      for (int j = 0; j < 2; ++j) {
        const bf16x8 bfr = ldfrag(VNT + (j * 32 + l31) * LDV + ks * 16 + hh * 8);
        acc[j] = mfma32(af, bfr, acc[j]);
      }
    }
    const float* bs = P.a_b_s + (l * 4 + a) * 128;
#pragma unroll
    for (int j = 0; j < 2; ++j)
#pragma unroll
      for (int r = 0; r < 16; ++r) {
        const int p = wave * 32 + drow(r, hh);
        const int row = row_of(b, p0 + p);
        const int col = a * 64 + j * 32 + l31;
        const float u = bf2f(P.Z[(size_t)row * DIN + ZC_AU + col]);
        P.H[(size_t)row * 1024 + col] = f2bf(u * (acc[j][r] + bs[p]));
      }
  }
}

DEVI void mla_norm_rope_store(const Params& P, const float* T, const float* nw, bool rope, float oscale,
                              bf16* dstbase  , int pos0, int tlat0) {
  const int tid = TIDX, tok = tid >> 1, half = tid & 1;
  float v[48];
  float ss = 0.f;
#pragma unroll
  for (int i = 0; i < 48; ++i) { v[i] = T[tok * 97 + half * 48 + i]; ss += v[i] * v[i]; }
  ss += __shfl_xor(ss, 1);
  const float rr = rsqrtf(ss * (1.f / 96.f) + EPS);
#pragma unroll
  for (int i = 0; i < 48; ++i) v[i] = v[i] * rr * nw[half * 48 + i];
  if (rope && half == 1) {
    const float* cs = P.ROPE + (size_t)(tlat0 + tok) * 32;
#pragma unroll
    for (int a = 0; a < 2; ++a)
#pragma unroll
      for (int f = 0; f < 8; ++f) {
        const float x1 = v[16 + a * 16 + f], x2 = v[16 + a * 16 + 8 + f];
        const float c = cs[a * 8 + f], s = cs[16 + a * 8 + f];
        v[16 + a * 16 + f] = x1 * c - x2 * s;
        v[16 + a * 16 + 8 + f] = x2 * c + x1 * s;
      }
  }
  bf16* dst = dstbase + (size_t)(pos0 + tok) * 96 + half * 48;
#pragma unroll
  for (int i = 0; i < 6; ++i) {
    uint4 o;
    o.x = pack2(v[i * 8 + 0] * oscale, v[i * 8 + 1] * oscale); o.y = pack2(v[i * 8 + 2] * oscale, v[i * 8 + 3] * oscale);
    o.z = pack2(v[i * 8 + 4] * oscale, v[i * 8 + 5] * oscale); o.w = pack2(v[i * 8 + 6] * oscale, v[i * 8 + 7] * oscale);
    *reinterpret_cast<uint4*>(dst + i * 8) = o;
  }
}

DEVI void phase_mla_proj(const Params& P, int l, unsigned char* smem) {
  const int tid = TIDX, lane = tid & 63, wave = tid >> 6, l31 = lane & 31, hh = lane >> 5;
  float* T = reinterpret_cast<float*>(smem);
  float* rsq = T + 128 * 97;
  float* rskv = rsq + 128;
  const float qscale = 0.10206207261596577f * 1.4426950408889634f;
  for (int it = VBID; it < 144 * 8; it += NVB) {
    const int h = it & 7;
    const int m0 = (it >> 3) * 128;
    const bool lat = m0 < NL;
    const int b = lat ? (m0 >> 11) : ((m0 - NL) >> 8);
    const int pos0 = lat ? 256 + (m0 & 2047) : ((m0 - NL) & 255);
    const int tlat0 = lat ? (m0 & 2047) : 0;
    const bool doq = lat || (l == 0);
    const bf16* zrow = P.Z + (size_t)(m0 + wave * 32 + l31) * DIN;
    __syncthreads();
    {
      float ss = 0.f;
#pragma unroll
      for (int ks = 0; ks < 8; ++ks) {
        const bf16x8 a = ldfrag(zrow + ZC_BKV + ks * 16 + hh * 8);
#pragma unroll
        for (int j = 0; j < 8; ++j) { const float f = (float)a[j]; ss += f * f; }
      }
      ss += __shfl_xor(ss, 32);
      if (hh == 0) rskv[wave * 32 + l31] = rsqrtf(ss * (1.f / 128.f) + EPS);
      if (doq) {
        float sq = 0.f;
#pragma unroll
        for (int ks = 0; ks < 16; ++ks) {
          const bf16x8 a = ldfrag(zrow + ZC_BQ + ks * 16 + hh * 8);
#pragma unroll
          for (int j = 0; j < 8; ++j) { const float f = (float)a[j]; sq += f * f; }
        }
        sq += __shfl_xor(sq, 32);
        if (hh == 0) rsq[wave * 32 + l31] = rsqrtf(sq * (1.f / 256.f) + EPS);
      }
    }
    for (int e = tid; e < 128 * 32; e += 256) {
      const int tok = e >> 5, i = e & 31;
      T[tok * 97 + 64 + i] = bf2f(P.Z[(size_t)(m0 + tok) * DIN + ZC_BKR + i]);
    }
    __syncthreads();
    {
      const bf16* Wkv = P.WukvT + (size_t)l * 1024 * 128;
      f32x16 acc[4];
#pragma unroll
      for (int j = 0; j < 4; ++j) acc[j] = zero16();
#pragma unroll 4
      for (int ks = 0; ks < 8; ++ks) {
        const bf16x8 af = ldfrag(zrow + ZC_BKV + ks * 16 + hh * 8);
#pragma unroll
        for (int j = 0; j < 4; ++j) {
          const bf16x8 bfr = ldfrag(Wkv + (size_t)(h * 128 + j * 32 + l31) * 128 + ks * 16 + hh * 8);
          acc[j] = mfma32(af, bfr, acc[j]);
        }
      }
#pragma unroll
      for (int j = 0; j < 2; ++j)
#pragma unroll
        for (int r = 0; r < 16; ++r) {
          const int tok = wave * 32 + drow(r, hh);
          T[tok * 97 + j * 32 + l31] = acc[j][r] * rskv[tok];
        }
#pragma unroll
      for (int j = 2; j < 4; ++j) {
        const int d = (j - 2) * 32 + l31;
        bf16* dst = P.VT + ((size_t)(b * 8 + h) * 64 + d) * SEQP + pos0 + wave * 32;
#pragma unroll
        for (int rg = 0; rg < 4; ++rg) {
          const int tk = 8 * rg + 4 * hh;
          uint2 o;
          o.x = pack2(acc[j][4 * rg + 0] * rskv[wave * 32 + tk + 0], acc[j][4 * rg + 1] * rskv[wave * 32 + tk + 1]);
          o.y = pack2(acc[j][4 * rg + 2] * rskv[wave * 32 + tk + 2], acc[j][4 * rg + 3] * rskv[wave * 32 + tk + 3]);
          *reinterpret_cast<uint2*>(dst + tk) = o;
        }
      }
      __syncthreads();
      mla_norm_rope_store(P, T, P.b_kh_w + l * 96, lat, 1.f, P.K + (size_t)(b * 8 + h) * SEQP * 96, pos0, tlat0);
    }
    if (doq) {
      const bf16* Wq = P.WuqT + (size_t)l * 768 * 256;
      f32x16 acc[3];
#pragma unroll
      for (int j = 0; j < 3; ++j) acc[j] = zero16();
#pragma unroll 4
      for (int ks = 0; ks < 16; ++ks) {
        const bf16x8 af = ldfrag(zrow + ZC_BQ + ks * 16 + hh * 8);
#pragma unroll
        for (int j = 0; j < 3; ++j) {
          const bf16x8 bfr = ldfrag(Wq + (size_t)(h * 96 + j * 32 + l31) * 256 + ks * 16 + hh * 8);
          acc[j] = mfma32(af, bfr, acc[j]);
        }
      }
      __syncthreads();
#pragma unroll
      for (int j = 0; j < 3; ++j)
#pragma unroll
        for (int r = 0; r < 16; ++r) {
          const int tok = wave * 32 + drow(r, hh);
          T[tok * 97 + j * 32 + l31] = acc[j][r] * rsq[tok];
        }
      __syncthreads();
      mla_norm_rope_store(P, T, P.b_qh_w + l * 96, lat, qscale, P.Q + (size_t)(b * 8 + h) * SEQP * 96, pos0, tlat0);
    }
  }
}

DEVI void hgrn_load(const Params& P, int l, int b, int hd, int c, float* BF, float* RB, float* SEG,
                    float (&q)[16], float (&kf)[16], float (&kb)[16], float (&v)[16], bool need_kv) {
  const int tid = TIDX, t = tid >> 2, k0 = (tid & 3) * 16;
  const int row = row_of(b, c * 64 + t);
  const bf16* z = P.Z + (size_t)row * DIN + hd * 64 + k0;
  float zf[16], zb[16];
#pragma unroll
  for (int i = 0; i < 2; ++i) {
    const uint4 uq = *reinterpret_cast<const uint4*>(z + ZC_CQ + i * 8);
    const uint4 uf = *reinterpret_cast<const uint4*>(z + ZC_CFF + i * 8);
    const uint4 ub = *reinterpret_cast<const uint4*>(z + ZC_CFB + i * 8);
    q[i * 8 + 0] = lo2f(uq.x); q[i * 8 + 1] = hi2f(uq.x); q[i * 8 + 2] = lo2f(uq.y); q[i * 8 + 3] = hi2f(uq.y);
    q[i * 8 + 4] = lo2f(uq.z); q[i * 8 + 5] = hi2f(uq.z); q[i * 8 + 6] = lo2f(uq.w); q[i * 8 + 7] = hi2f(uq.w);
    zf[i * 8 + 0] = lo2f(uf.x); zf[i * 8 + 1] = hi2f(uf.x); zf[i * 8 + 2] = lo2f(uf.y); zf[i * 8 + 3] = hi2f(uf.y);
    zf[i * 8 + 4] = lo2f(uf.z); zf[i * 8 + 5] = hi2f(uf.z); zf[i * 8 + 6] = lo2f(uf.w); zf[i * 8 + 7] = hi2f(uf.w);
    zb[i * 8 + 0] = lo2f(ub.x); zb[i * 8 + 1] = hi2f(ub.x); zb[i * 8 + 2] = lo2f(ub.y); zb[i * 8 + 3] = hi2f(ub.y);
    zb[i * 8 + 4] = lo2f(ub.z); zb[i * 8 + 5] = hi2f(ub.z); zb[i * 8 + 6] = lo2f(ub.w); zb[i * 8 + 7] = hi2f(ub.w);
    if (need_kv) {
      const uint4 uv = *reinterpret_cast<const uint4*>(z + ZC_CI + i * 8);
      v[i * 8 + 0] = lo2f(uv.x); v[i * 8 + 1] = hi2f(uv.x); v[i * 8 + 2] = lo2f(uv.y); v[i * 8 + 3] = hi2f(uv.y);
      v[i * 8 + 4] = lo2f(uv.z); v[i * 8 + 5] = hi2f(uv.z); v[i * 8 + 6] = lo2f(uv.w); v[i * 8 + 7] = hi2f(uv.w);
    }
  }
#pragma unroll
  for (int i = 0; i < 16; ++i) {
    q[i] *= 0.125f;
    float lbf = 0.f;
    if (l == 1) { const int ch = hd * 64 + k0 + i; lbf = sigmoidf_(P.c_lb[512 + ch] - P.c_lb[ch]); }
    const float zz = zf[i];
    const float e = __expf(-fabsf(zz));
    const float sp = __builtin_amdgcn_rcpf(1.f + e);
    const float sig = zz >= 0.f ? sp : e * sp;
    const float nsig = zz >= 0.f ? e * sp : sp;
    const float lf = (l == 0) ? (fminf(zz, 0.f) - __logf(1.f + e)) : __logf(lbf + (1.f - lbf) * sig);
    kf[i] = (1.f - lbf) * nsig;
    BF[t * 65 + k0 + i] = lf;
  }
  __builtin_amdgcn_sched_barrier(0);
#pragma unroll
  for (int i = 0; i < 16; ++i) {
    float lbb = 0.f;
    if (l == 1) { const int ch = hd * 64 + k0 + i; lbb = sigmoidf_(P.c_lb[512 + 256 + ch] - P.c_lb[256 + ch]); }
    const float zz = zb[i];
    const float e = __expf(-fabsf(zz));
    const float sp = __builtin_amdgcn_rcpf(1.f + e);
    const float sig = zz >= 0.f ? sp : e * sp;
    const float nsig = zz >= 0.f ? e * sp : sp;
    const float lf = (l == 0) ? (fminf(zz, 0.f) - __logf(1.f + e)) : __logf(lbb + (1.f - lbb) * sig);
    kb[i] = (1.f - lbb) * nsig;
    RB[t * 65 + k0 + i] = lf;
  }
  __syncthreads();
  {
    const int k = tid & 63, seg = tid >> 6;
    float a[16], r[16];
    float sf = 0.f, sr = 0.f;
#pragma unroll
    for (int j = 0; j < 16; ++j) { sf += BF[(seg * 16 + j) * 65 + k]; a[j] = sf; }
#pragma unroll
    for (int j = 15; j >= 0; --j) { sr += RB[(seg * 16 + j) * 65 + k]; r[j] = sr; }
    SEG[seg * 64 + k] = sf; SEG[256 + seg * 64 + k] = sr;
    __syncthreads();
    float offf = 0.f, offb = 0.f;
#pragma unroll
    for (int s2 = 0; s2 < 4; ++s2) {
      offf += (s2 < seg) ? SEG[s2 * 64 + k] : 0.f;
      offb += (s2 > seg) ? SEG[256 + s2 * 64 + k] : 0.f;
    }
#pragma unroll
    for (int j = 0; j < 16; ++j) { BF[(seg * 16 + j) * 65 + k] = a[j] + offf; RB[(seg * 16 + j) * 65 + k] = r[j] + offb; }
  }
  __syncthreads();
}

DEVI f32x16 lds_mm(const bf16* A, const bf16* BT, int tm, int tn, int l31, int hh) {
  f32x16 acc = zero16();
#pragma unroll
  for (int ks = 0; ks < 4; ++ks) {
    const bf16x8 a = ldfrag(A + (tm * 32 + l31) * 72 + ks * 16 + hh * 8);
    const bf16x8 b = ldfrag(BT + (tn * 32 + l31) * 72 + ks * 16 + hh * 8);
    acc = mfma32(a, b, acc);
  }
  return acc;
}

DEVI void phase_hgrn_local(const Params& P, int l, unsigned char* smem) {
  const int tid = TIDX, lane = tid & 63, wave = tid >> 6, l31 = lane & 31, hh = lane >> 5;
  const int tm = wave >> 1, tn = wave & 1;
  float* BF = reinterpret_cast<float*>(smem);
  float* RB = BF + 64 * 65;
  bf16* QF = reinterpret_cast<bf16*>(smem + 33280);
  bf16* KF = QF + 64 * 72;
  bf16* QB = KF + 64 * 72;
  bf16* KB = QB + 64 * 72;
  bf16* VTt = KB + 64 * 72;
  bf16* KHF = reinterpret_cast<bf16*>(smem);
  bf16* KHB = KHF + 64 * 72;
  bf16* ATT = KHB + 64 * 72;
  for (int it = VBID; it < 8 * 4 * 36; it += NVB) {
    const int c = it % 36, hd = (it / 36) & 3, b = it / 144;
    float q[16], kf[16], kb[16], v[16];
    __syncthreads();
    hgrn_load(P, l, b, hd, c, BF, RB, reinterpret_cast<float*>(smem + 33280), q, kf, kb, v, true);
    const int t = tid >> 2, k0 = (tid & 3) * 16;
#pragma unroll
    for (int i = 0; i < 16; ++i) VTt[(k0 + i) * 72 + t] = f2bf(v[i]);
    float bfv[16], rbv[16];
#pragma unroll
    for (int i = 0; i < 16; ++i) { bfv[i] = BF[t * 65 + k0 + i]; rbv[i] = RB[t * 65 + k0 + i]; }
    {
      const size_t go = (size_t)row_of(b, c * 64 + t) * 256 + hd * 64 + k0;
#pragma unroll
      for (int hq = 0; hq < 2; ++hq) {
        unsigned pf[4], pb[4];
#pragma unroll
        for (int i = 0; i < 8; i += 2) {
          pf[i >> 1] = pack2(q[hq * 8 + i] * __expf(bfv[hq * 8 + i]), q[hq * 8 + i + 1] * __expf(bfv[hq * 8 + i + 1]));
          pb[i >> 1] = pack2(q[hq * 8 + i] * __expf(rbv[hq * 8 + i]), q[hq * 8 + i + 1] * __expf(rbv[hq * 8 + i + 1]));
        }
        *reinterpret_cast<uint4*>(P.GQF + go + hq * 8) = make_uint4(pf[0], pf[1], pf[2], pf[3]);
        *reinterpret_cast<uint4*>(P.GQB + go + hq * 8) = make_uint4(pb[0], pb[1], pb[2], pb[3]);
      }
    }
    if (t == 0) {
      float* dec = P.DEC + ((size_t)((b * 4 + hd) * 2) * 36 + c) * 64 + k0;
#pragma unroll
      for (int i = 0; i < 16; ++i) { dec[i] = __expf(BF[63 * 65 + k0 + i]); dec[36 * 64 + i] = __expf(RB[k0 + i]); }
    }
#pragma unroll
    for (int i = 0; i < 16; i += 2) {
      const int k = k0 + i;
      const float mF0 = BF[32 * 65 + k], mF1 = BF[32 * 65 + k + 1], mB0 = RB[32 * 65 + k], mB1 = RB[32 * 65 + k + 1];
      *reinterpret_cast<unsigned*>(&QF[t * 72 + k]) = pack2(q[i] * __expf(fminf(bfv[i] - mF0, 80.f)), q[i + 1] * __expf(fminf(bfv[i + 1] - mF1, 80.f)));
      *reinterpret_cast<unsigned*>(&KF[t * 72 + k]) = pack2(kf[i] * __expf(fminf(mF0 - bfv[i], 80.f)), kf[i + 1] * __expf(fminf(mF1 - bfv[i + 1], 80.f)));
      *reinterpret_cast<unsigned*>(&QB[t * 72 + k]) = pack2(q[i] * __expf(fminf(rbv[i] - mB0, 80.f)), q[i + 1] * __expf(fminf(rbv[i + 1] - mB1, 80.f)));
      *reinterpret_cast<unsigned*>(&KB[t * 72 + k]) = pack2(kb[i] * __expf(fminf(mB0 - rbv[i], 80.f)), kb[i + 1] * __expf(fminf(mB1 - rbv[i + 1], 80.f)));
    }
#pragma unroll
    for (int i = 0; i < 16; ++i) {
      kf[i] = kf[i] * __expf(BF[63 * 65 + k0 + i] - bfv[i]);
      kb[i] = kb[i] * __expf(RB[k0 + i] - rbv[i]);
    }
    __syncthreads();
#pragma unroll
    for (int i = 0; i < 16; ++i) {
      KHF[(k0 + i) * 72 + t] = f2bf(kf[i]);
      KHB[(k0 + i) * 72 + t] = f2bf(kb[i]);
    }
    __syncthreads();
    {
      const f32x16 af = lds_mm(QF, KF, tm, tn, l31, hh);
      const f32x16 ab = lds_mm(QB, KB, tm, tn, l31, hh);
      const int s = tn * 32 + l31;
#pragma unroll
      for (int r = 0; r < 16; ++r) {
        const int tt = tm * 32 + drow(r, hh);
        float a = 0.f;
        if (s <= tt) a += af[r];
        if (s >= tt) a += ab[r];
        ATT[tt * 72 + s] = f2bf(a);
      }
    }
    {
      const f32x16 lf = lds_mm(VTt, KHF, tm, tn, l31, hh);
      const f32x16 lb = lds_mm(VTt, KHB, tm, tn, l31, hh);
      float* stf = P.ST + ((size_t)((b * 4 + hd) * 2 + 0) * 36 + c) * 4096;
      float* stb = P.ST + ((size_t)((b * 4 + hd) * 2 + 1) * 36 + c) * 4096;
#pragma unroll
      for (int r = 0; r < 16; ++r) {
        const int kk = tm * 32 + drow(r, hh), d = tn * 32 + l31;
        stf[kk * 64 + d] = lf[r];
        stb[kk * 64 + d] = lb[r];
      }
    }
    __syncthreads();
    {
      const f32x16 o = lds_mm(ATT, VTt, tm, tn, l31, hh);
#pragma unroll
      for (int r = 0; r < 16; ++r) {
        const int tt = tm * 32 + drow(r, hh), d = tn * 32 + l31;
        P.OI[(size_t)row_of(b, c * 64 + tt) * 256 + hd * 64 + d] = o[r];
      }
    }
  }
}

DEVI void hgrn_scan_item(const Params& P, int item) {
  const int tid = TIDX;
  const int chain = item >> 2, sl = item & 3;
  const int dir = chain & 1;
  const int dd = tid >> 2, k4 = sl * 16 + (tid & 3) * 4;
  float4 S = make_float4(0.f, 0.f, 0.f, 0.f);
  float* base = P.ST + (size_t)chain * 36 * 4096 + dd * 64 + k4;
  const float* dec = P.DEC + (size_t)chain * 36 * 64 + k4;
#pragma unroll 1
  for (int g = 0; g < 6; ++g) {
    float4 L[6], dc[6];
#pragma unroll
    for (int j = 0; j < 6; ++j) {
      const int step = g * 6 + j;
      const int c = dir == 0 ? step : (step < 4 ? 3 - step : 39 - step);
      L[j] = *reinterpret_cast<const float4*>(base + (size_t)c * 4096);
      dc[j] = *reinterpret_cast<const float4*>(dec + c * 64);
    }
#pragma unroll
    for (int j = 0; j < 6; ++j) {
      const int step = g * 6 + j;
      const int c = dir == 0 ? step : (step < 4 ? 3 - step : 39 - step);
      *reinterpret_cast<float4*>(base + (size_t)c * 4096) = S;
      S.x = dc[j].x * S.x + L[j].x; S.y = dc[j].y * S.y + L[j].y; S.z = dc[j].z * S.z + L[j].z; S.w = dc[j].w * S.w + L[j].w;
    }
  }
}

DEVI void phase_hgrn_final(const Params& P, int l, unsigned char* smem) {
  const int tid = TIDX, lane = tid & 63, wave = tid >> 6, l31 = lane & 31, hh = lane >> 5;
  const int tm = wave >> 1, tn = wave & 1;
  float* O = reinterpret_cast<float*>(smem);
  bf16* QF = reinterpret_cast<bf16*>(smem + 33280);
  bf16* QB = QF + 64 * 72;
  bf16* SF = QB + 64 * 72;
  bf16* SB = SF + 64 * 72;
  const int c0 = (l == 1) ? 4 : 0;
  const int nc = 36 - c0;
  for (int it = VBID; it < 8 * 4 * nc; it += NVB) {
    const int c = it % nc + c0, hd = (it / nc) & 3, b = it / (nc * 4);
    const int t = tid >> 2, k0 = (tid & 3) * 16;
    const int row = row_of(b, c * 64 + t);
    __syncthreads();
    {
      const size_t go = (size_t)row * 256 + hd * 64 + k0;
      *reinterpret_cast<uint4*>(QF + t * 72 + k0) = *reinterpret_cast<const uint4*>(P.GQF + go);
      *reinterpret_cast<uint4*>(QF + t * 72 + k0 + 8) = *reinterpret_cast<const uint4*>(P.GQF + go + 8);
      *reinterpret_cast<uint4*>(QB + t * 72 + k0) = *reinterpret_cast<const uint4*>(P.GQB + go);
      *reinterpret_cast<uint4*>(QB + t * 72 + k0 + 8) = *reinterpret_cast<const uint4*>(P.GQB + go + 8);
      const float* stf = P.ST + ((size_t)((b * 4 + hd) * 2 + 0) * 36 + c) * 4096 + t * 64 + k0;
      const float* stb = P.ST + ((size_t)((b * 4 + hd) * 2 + 1) * 36 + c) * 4096 + t * 64 + k0;
      unsigned pf[8], pb[8];
#pragma unroll
      for (int i = 0; i < 4; ++i) {
        const float4 a = *reinterpret_cast<const float4*>(stf + i * 4);
        const float4 bb = *reinterpret_cast<const float4*>(stb + i * 4);
        pf[2 * i] = pack2(a.x, a.y); pf[2 * i + 1] = pack2(a.z, a.w);
        pb[2 * i] = pack2(bb.x, bb.y); pb[2 * i + 1] = pack2(bb.z, bb.w);
      }
      *reinterpret_cast<uint4*>(SF + t * 72 + k0) = make_uint4(pf[0], pf[1], pf[2], pf[3]);
      *reinterpret_cast<uint4*>(SF + t * 72 + k0 + 8) = make_uint4(pf[4], pf[5], pf[6], pf[7]);
      *reinterpret_cast<uint4*>(SB + t * 72 + k0) = make_uint4(pb[0], pb[1], pb[2], pb[3]);
      *reinterpret_cast<uint4*>(SB + t * 72 + k0 + 8) = make_uint4(pb[4], pb[5], pb[6], pb[7]);
    }
    __syncthreads();
    {
      f32x16 o = lds_mm(QF, SF, tm, tn, l31, hh);
      const f32x16 o2 = lds_mm(QB, SB, tm, tn, l31, hh);
#pragma unroll
      for (int r = 0; r < 16; ++r) {
        const int tt = tm * 32 + drow(r, hh), d = tn * 32 + l31;
        O[tt * 65 + d] = o[r] + o2[r] + P.OI[(size_t)row_of(b, c * 64 + tt) * 256 + hd * 64 + d];
      }
    }
    __syncthreads();
    {
      float ov[16]; float ss = 0.f;
#pragma unroll
      for (int i = 0; i < 16; ++i) { ov[i] = O[t * 65 + k0 + i]; ss += ov[i] * ov[i]; }
      ss += __shfl_xor(ss, 1); ss += __shfl_xor(ss, 2);
      const float rr = rsqrtf(ss * (1.f / 64.f) + EPS);
      const bf16* g = P.Z + (size_t)row * DIN + ZC_CG + hd * 64 + k0;
      const float* nw = P.c_out_norm_w + l * 64 + k0;
      const uint4 gA = *reinterpret_cast<const uint4*>(g), gB = *reinterpret_cast<const uint4*>(g + 8);
      const unsigned gw[8] = {gA.x, gA.y, gA.z, gA.w, gB.x, gB.y, gB.z, gB.w};
      unsigned pk[8];
#pragma unroll
      for (int i = 0; i < 16; i += 2) {
        const float g0 = lo2f(gw[i >> 1]), g1 = hi2f(gw[i >> 1]);
        const float y0 = ov[i] * rr * nw[i] * (g0 * sigmoidf_(g0));
        const float y1 = ov[i + 1] * rr * nw[i + 1] * (g1 * sigmoidf_(g1));
        pk[i >> 1] = pack2(y0, y1);
      }
      uint4* dst = reinterpret_cast<uint4*>(P.H + (size_t)row * 1024 + 768 + hd * 64 + k0);
      dst[0] = make_uint4(pk[0], pk[1], pk[2], pk[3]);
      dst[1] = make_uint4(pk[4], pk[5], pk[6], pk[7]);
    }
  }
}

DEVI void attn_item8(const Params& P, int b, int h, int qpos0, int nkeys, float sref, unsigned char* smem_base) {
  const int tid = threadIdx.x, lane = tid & 63, wave = tid >> 6, l31 = lane & 31, hh = lane >> 5;
  constexpr int TK = 128, LDKS = 104, LDVS = 136;
  constexpr int KS_BYTES = TK * LDKS * 2, VS_BYTES = 64 * LDVS * 2, ST_BYTES = KS_BYTES + VS_BYTES;
  const bf16* Qg = P.Q + ((size_t)(b * 8 + h) * SEQP + qpos0 + wave * 32 + l31) * 96;
  const bf16* Kg = P.K + (size_t)(b * 8 + h) * SEQP * 96;
  const bf16* Vg = P.VT + (size_t)(b * 8 + h) * 64 * SEQP;
  bf16x8 qf[6];
#pragma unroll
  for (int ks = 0; ks < 6; ++ks) qf[ks] = ldfrag(Qg + ks * 16 + hh * 8);
  f32x16 oacc[2]; oacc[0] = zero16(); oacc[1] = zero16();
  float lsum = 0.f;
  uint4 rk[3], rv[2];
  const int ntiles = nkeys / TK;
  auto gload = [&](int kt) {
#pragma unroll
    for (int i = 0; i < 3; ++i) { const int ch = tid + i * 512, row = ch / 12, cc = ch % 12;
      rk[i] = *reinterpret_cast<const uint4*>(Kg + (size_t)(kt * TK + row) * 96 + cc * 8); }
#pragma unroll
    for (int i = 0; i < 2; ++i) { const int ch = tid + i * 512, row = ch >> 4, cc = ch & 15;
      rv[i] = *reinterpret_cast<const uint4*>(Vg + (size_t)row * SEQP + kt * TK + cc * 8); }
  };
  auto swrite = [&](int buf) {
    bf16* sK = reinterpret_cast<bf16*>(smem_base + buf * ST_BYTES);
    bf16* sV = reinterpret_cast<bf16*>(smem_base + buf * ST_BYTES + KS_BYTES);
#pragma unroll
    for (int i = 0; i < 3; ++i) { const int ch = tid + i * 512, row = ch / 12, cc = ch % 12;
      *reinterpret_cast<uint4*>(sK + row * LDKS + cc * 8) = rk[i]; }
#pragma unroll
    for (int i = 0; i < 2; ++i) { const int ch = tid + i * 512, row = ch >> 4, cc = ch & 15;
      const int g16 = cc >> 1, odd = cc & 1;
      bf16* base = sV + row * LDVS + g16 * 16;
      const int s0 = odd ? 4 : 0, s1 = odd ? 12 : 8;
      *reinterpret_cast<uint2*>(base + s0) = make_uint2(rv[i].x, rv[i].y);
      *reinterpret_cast<uint2*>(base + s1) = make_uint2(rv[i].z, rv[i].w);
    }
  };
  __syncthreads();
  gload(0); swrite(0);
  __syncthreads();
  for (int kt = 0; kt < ntiles; ++kt) {
    const int cur = kt & 1;
    if (kt + 1 < ntiles) gload(kt + 1);
    const bf16* sK = reinterpret_cast<const bf16*>(smem_base + cur * ST_BYTES);
    const bf16* sV = reinterpret_cast<const bf16*>(smem_base + cur * ST_BYTES + KS_BYTES);
#pragma unroll
    for (int kk = 0; kk < 4; ++kk) {
      f32x16 sacc;
#pragma unroll
      for (int r = 0; r < 16; ++r) sacc[r] = -sref;
#pragma unroll
      for (int ks = 0; ks < 6; ++ks) {
        const bf16x8 a = ldfrag(sK + (kk * 32 + l31) * LDKS + ks * 16 + hh * 8);
        sacc = mfma32(a, qf[ks], sacc);
      }
#pragma unroll
      for (int r = 0; r < 16; ++r) { const float p = __builtin_amdgcn_exp2f(sacc[r]); sacc[r] = p; lsum += p; }
#pragma unroll
      for (int s = 0; s < 2; ++s) {
        bf16x8 pb;
#pragma unroll
        for (int j = 0; j < 8; ++j) pb[j] = (__bf16)sacc[8 * s + j];
#pragma unroll
        for (int dt = 0; dt < 2; ++dt) {
          const bf16x8 a = ldfrag(sV + (dt * 32 + l31) * LDVS + kk * 32 + s * 16 + hh * 8);
          oacc[dt] = mfma32(a, pb, oacc[dt]);
        }
      }
    }
    if (kt + 1 < ntiles) swrite(cur ^ 1);
    __syncthreads();
  }
  lsum += __shfl_xor(lsum, 32);
  const float inv = 1.f / lsum;
  const int row = row_of(b, qpos0 + wave * 32 + l31);
  bf16* dst = P.H + (size_t)row * 1024 + 256 + h * 64;
#pragma unroll
  for (int dt = 0; dt < 2; ++dt)
#pragma unroll
    for (int rg = 0; rg < 4; ++rg) {
      const int d = dt * 32 + 8 * rg + 4 * hh;
      uint2 o;
      o.x = pack2(oacc[dt][4 * rg + 0] * inv, oacc[dt][4 * rg + 1] * inv);
      o.y = pack2(oacc[dt][4 * rg + 2] * inv, oacc[dt][4 * rg + 3] * inv);
      *reinterpret_cast<uint2*>(dst + d) = o;
    }
}

DEVI void phase_attn_scan(const Params& P, int l, unsigned char* smem_base, bool skip_scan = false) {
  if (!skip_scan)
    for (int it = NVB - 1 - VBID; it < 256; it += NVB) hgrn_scan_item(P, it);
  float sref;
  {
    const int lane = threadIdx.x & 63;
    float mq = fmaxf(fabsf(P.b_qh_w[l * 96 + lane]), lane < 32 ? fabsf(P.b_qh_w[l * 96 + 64 + lane]) : 0.f);
    float mk = fmaxf(fabsf(P.b_kh_w[l * 96 + lane]), lane < 32 ? fabsf(P.b_kh_w[l * 96 + 64 + lane]) : 0.f);
#pragma unroll
    for (int o = 32; o > 0; o >>= 1) { mq = fmaxf(mq, __shfl_xor(mq, o)); mk = fmaxf(mk, __shfl_xor(mk, o)); }
    sref = fminf(1.4426950408889634f * 9.797958971132712f * mq * mk, 60.f);
  }
  const int c = blockIdx.x, xcd = c & 7, slot = c >> 3;
  const int nrounds = (l == 0) ? 3 : 2;
  for (int r = 0; r < nrounds; ++r) {
    if (r < 2) {
      const int u = r * 32 + slot;
      const int bh = xcd * 8 + (u >> 3), qt = u & 7;
      if (slot < 32) attn_item8(P, bh >> 3, bh & 7, 256 + 256 * qt, 2304, sref, smem_base);
    } else if (c < 64) {
      attn_item8(P, c >> 3, c & 7, 0, 256, sref, smem_base);
    }
  }
}

DEVI unsigned ordkey(float s) { const unsigned u = __float_as_uint(s); return (u & 0x80000000u) ? ~u : (u | 0x80000000u); }
DEVI float keyval(unsigned k, unsigned mask) { const unsigned u = k & ~mask; return __uint_as_float((u & 0x80000000u) ? (u & 0x7fffffffu) : ~u); }
DEVI void ins16(unsigned (&lst)[16], unsigned v) {
#pragma unroll
  for (int j = 0; j < 16; ++j) { const unsigned hi = max(lst[j], v); v = min(lst[j], v); lst[j] = hi; }
}
DEVI void merge16(unsigned (&lst)[16], int xm) {
  unsigned o[16];
#pragma unroll
  for (int j = 0; j < 16; ++j) o[j] = (unsigned)__shfl_xor((int)lst[j], xm);
#pragma unroll
  for (int j = 0; j < 16; ++j) lst[j] = max(lst[j], o[15 - j]);
#pragma unroll
  for (int d = 8; d >= 1; d >>= 1)
#pragma unroll
    for (int j = 0; j < 16; ++j)
      if ((j & d) == 0) { const unsigned a = lst[j], bb = lst[j + d]; lst[j] = max(a, bb); lst[j + d] = min(a, bb); }
}

DEVI void bitonic_sort_desc16(unsigned (&v)[16]) {
#pragma unroll
  for (int k = 2; k <= 16; k <<= 1)
#pragma unroll
    for (int j = k >> 1; j > 0; j >>= 1)
#pragma unroll
      for (int i = 0; i < 16; ++i) {
        const int l = i ^ j;
        if (l > i) {
          const bool desc = ((i & k) == 0);
          const unsigned a = v[i], b = v[l];
          const unsigned mx = max(a, b), mn = min(a, b);
          v[i] = desc ? mx : mn; v[l] = desc ? mn : mx;
        }
      }
}
DEVI void bitonic_merge_desc16(unsigned (&lst)[16]) {
#pragma unroll
  for (int d = 8; d >= 1; d >>= 1)
#pragma unroll
    for (int j = 0; j < 16; ++j)
      if ((j & d) == 0) { const unsigned a = lst[j], bb = lst[j + d]; lst[j] = max(a, bb); lst[j + d] = min(a, bb); }
}
struct CandTab { int a[52]; int b[52]; };
constexpr CandTab make_cand_tab() {
  CandTab t{};
  int n = 0;
  for (int a = 0; a < 16; ++a)
    for (int b = 0; b < 16; ++b)
      if ((a + 1) * (b + 1) <= 16) { t.a[n] = a; t.b[n] = b; ++n; }
  for (; n < 52; ++n) { t.a[n] = 0; t.b[n] = 0; }
  return t;
}

DEVI void phase_route(const Params& P, int l, unsigned char* smem) {
  const int tid = TIDX, lane = tid & 63, wave = tid >> 6, l31 = lane & 31, hh = lane >> 5;
  bf16* QT = reinterpret_cast<bf16*>(smem);
  float* SC = reinterpret_cast<float*>(smem + 33792);
  const int mtiles = (l == 1) ? 256 : 288;
  for (int it = VBID; it < mtiles * 8; it += NVB) {
    const int mt = it >> 3, h = it & 7;
    __syncthreads();
    for (int e = tid; e < 64 * 32; e += 256) {
      const int r = e >> 5, cc = e & 31;
      *reinterpret_cast<uint4*>(QT + r * 264 + cc * 8) = *reinterpret_cast<const uint4*>(P.QP + (size_t)(mt * 64 + r) * 2048 + h * 256 + cc * 8);
    }
    __syncthreads();
    unsigned lst[2][16];
    const int row = tid >> 2, part = tid & 3;
#pragma unroll
    for (int p = 0; p < 2; ++p) {
      f32x16 sa[2]; sa[0] = zero16(); sa[1] = zero16();
      const bf16* keys = P.SK + ((size_t)(l * 16 + h * 2 + p) * 128 + wave * 32 + l31) * 128;
#pragma unroll
      for (int ks = 0; ks < 8; ++ks) {
        const bf16x8 bfr = ldfrag(keys + ks * 16 + hh * 8);
#pragma unroll
        for (int i = 0; i < 2; ++i) {
          const bf16x8 af = ldfrag(QT + (i * 32 + l31) * 264 + p * 128 + ks * 16 + hh * 8);
          sa[i] = mfma32(af, bfr, sa[i]);
        }
      }
      if (p == 1) __syncthreads();
#pragma unroll
      for (int i = 0; i < 2; ++i)
#pragma unroll
        for (int r = 0; r < 16; ++r) SC[(i * 32 + drow(r, hh)) * 129 + wave * 32 + l31] = sa[i][r];
      __syncthreads();
      unsigned B2[16];
#pragma unroll
      for (int i = 0; i < 16; ++i) {
        const int i0 = part * 32 + ((i + part * 8) & 31), i1 = part * 32 + ((i + 16 + part * 8) & 31);
        lst[p][i] = (ordkey(SC[row * 129 + i0]) & ~0x7fu) | (unsigned)(127 - i0);
        B2[i] = (ordkey(SC[row * 129 + i1]) & ~0x7fu) | (unsigned)(127 - i1);
      }
      bitonic_sort_desc16(lst[p]);
      bitonic_sort_desc16(B2);
#pragma unroll
      for (int j = 0; j < 16; ++j) lst[p][j] = max(lst[p][j], B2[15 - j]);
      bitonic_merge_desc16(lst[p]);
      merge16(lst[p], 1);
      merge16(lst[p], 2);
    }
    float v0[16], v1[16];
#pragma unroll
    for (int j = 0; j < 16; ++j) { v0[j] = keyval(lst[0][j], 0x7fu); v1[j] = keyval(lst[1][j], 0x7fu); }
    unsigned best[16];
    {
      constexpr CandTab CT = make_cand_tab();
#pragma unroll
      for (int c = 0; c < 13; ++c) {
        const int a0 = CT.a[4 * c + 0], a1 = CT.a[4 * c + 1], a2 = CT.a[4 * c + 2], a3 = CT.a[4 * c + 3];
        const int b0 = CT.b[4 * c + 0], b1 = CT.b[4 * c + 1], b2 = CT.b[4 * c + 2], b3 = CT.b[4 * c + 3];
        const float x = part == 0 ? v0[a0] : part == 1 ? v0[a1] : part == 2 ? v0[a2] : v0[a3];
        const float y = part == 0 ? v1[b0] : part == 1 ? v1[b1] : part == 2 ? v1[b2] : v1[b3];
        const int flat = part == 0 ? (a0 * 16 + b0) : part == 1 ? (a1 * 16 + b1) : part == 2 ? (a2 * 16 + b2) : (a3 * 16 + b3);
        const bool valid = part == 0 ? (4 * c + 0 < 50) : part == 1 ? (4 * c + 1 < 50) : part == 2 ? (4 * c + 2 < 50) : (4 * c + 3 < 50);
        const unsigned key = (ordkey(x + y) & ~0xffu) | (unsigned)(255 - flat);
        best[c] = valid ? key : 0u;
      }
      best[13] = 0u; best[14] = 0u; best[15] = 0u;
      bitonic_sort_desc16(best);
      merge16(best, 1);
      merge16(best, 2);
    }
    {
      const float mx = keyval(best[0], 0xffu);
      float es = 0.f;
      float ev[4]; int ex[4];
#pragma unroll
      for (int jj = 0; jj < 4; ++jj) {
        const unsigned kk = part == 0 ? best[4 * jj + 0] : part == 1 ? best[4 * jj + 1] : part == 2 ? best[4 * jj + 2] : best[4 * jj + 3];
        ev[jj] = __expf(keyval(kk, 0xffu) - mx);
        es += ev[jj];
        const int flat = 255 - (int)(kk & 0xffu);
        const int a = flat >> 4, bq = flat & 15;
        int i1 = 0, i2 = 0;
#pragma unroll
        for (int u = 0; u < 16; ++u) {
          i1 = (a == u) ? (127 - (int)(lst[0][u] & 0x7fu)) : i1;
          i2 = (bq == u) ? (127 - (int)(lst[1][u] & 0x7fu)) : i2;
        }
        ex[jj] = i1 * 128 + i2;
      }
      es += __shfl_xor(es, 1); es += __shfl_xor(es, 2);
      const float inv = 1.f / es;
      const int tok = mt * 64 + row;
      int* ed = P.EIDX + (size_t)tok * 128 + h * 16;
      float* gd = P.GATE + (size_t)tok * 128 + h * 16;
#pragma unroll
      for (int jj = 0; jj < 4; ++jj) { ed[4 * jj + part] = ex[jj]; gd[4 * jj + part] = ev[jj] * inv; }
    }
  }
}

DEVI float gelu_exact(float a) { return 0.5f * a * (1.f + erff(a * 0.70710678118654752f)); }

typedef float f2 __attribute__((ext_vector_type(2)));
DEVI void phase_peer(const Params& P, int l) {
  const int lane = TIDX & 63, half = lane >> 5, l32 = lane & 31;
  const int gw = VBID * 4 + (TIDX >> 6), nw = NVB * 4;
  const int nrows = (l == 1) ? NL : NT;
  const unsigned char* PU = P.PU8 + (size_t)l * 16384 * 768 + l32 * 24;
  const unsigned char* PV = P.PV8 + (size_t)l * 16384 * 768 + l32 * 24;
  const float* PUS = P.PUS + l * 16384;
  const float* PVS = P.PVS + l * 16384;
  const bool b4 = lane & 16, b3 = lane & 8, b2 = lane & 4;
  for (int t = gw; t < nrows; t += nw) {
    f2 h2[16];
    {
      const bf16* hp = P.H + (size_t)t * 1024 + l32 * 32;
#pragma unroll
      for (int i = 0; i < 4; ++i) {
        const uint4 hv = *reinterpret_cast<const uint4*>(hp + i * 8);
        h2[4 * i + 0] = (f2){lo2f(hv.x), hi2f(hv.x)}; h2[4 * i + 1] = (f2){lo2f(hv.y), hi2f(hv.y)};
        h2[4 * i + 2] = (f2){lo2f(hv.z), hi2f(hv.z)}; h2[4 * i + 3] = (f2){lo2f(hv.w), hi2f(hv.w)};
      }
    }
    const int e0 = P.EIDX[(size_t)t * 128 + lane], e1 = P.EIDX[(size_t)t * 128 + 64 + lane];
    const float g0 = P.GATE[(size_t)t * 128 + lane], g1 = P.GATE[(size_t)t * 128 + 64 + lane];
    const float su0 = PUS[e0], su1 = PUS[e1];
    const float gv0 = g0 * PVS[e0], gv1 = g1 * PVS[e1];
    f2 y2[16];
#pragma unroll
    for (int i = 0; i < 16; ++i) y2[i] = (f2){0.f, 0.f};
    for (int kb = 0; kb < 8; ++kb) {
      const int esrc = kb < 4 ? e0 : e1;
      v3u ua[8], ub[8], va[8], vb[8];
#pragma unroll
      for (int i = 0; i < 8; ++i) {
        const int e = __shfl(esrc, (kb * 16 + 2 * i + half) & 63);
        const unsigned* ur = reinterpret_cast<const unsigned*>(PU + (size_t)e * 768);
        const unsigned* vr = reinterpret_cast<const unsigned*>(PV + (size_t)e * 768);
        ua[i] = *reinterpret_cast<const v3u*>(ur); ub[i] = *reinterpret_cast<const v3u*>(ur + 3);
        va[i] = *reinterpret_cast<const v3u*>(vr); vb[i] = *reinterpret_cast<const v3u*>(vr + 3);
      }
      float d[8];
#pragma unroll
      for (int i = 0; i < 8; ++i) {
        const v32f uf = __builtin_amdgcn_cvt_scalef32_pk32_f32_fp6((v6u){ua[i][0], ua[i][1], ua[i][2], ub[i][0], ub[i][1], ub[i][2]}, 1.0f);
        f2 sacc = (f2){0.f, 0.f};
#pragma unroll
        for (int j = 0; j < 16; ++j) sacc = __builtin_elementwise_fma((f2){uf[2 * j], uf[2 * j + 1]}, h2[j], sacc);
        d[i] = sacc.x + sacc.y;
      }
      float r4[4], r2[2], r1;
#pragma unroll
      for (int i = 0; i < 4; ++i) { const float mine = b4 ? d[4 + i] : d[i]; const float send = b4 ? d[i] : d[4 + i]; r4[i] = mine + __shfl_xor(send, 16); }
#pragma unroll
      for (int i = 0; i < 2; ++i) { const float mine = b3 ? r4[2 + i] : r4[i]; const float send = b3 ? r4[i] : r4[2 + i]; r2[i] = mine + __shfl_xor(send, 8); }
      { const float mine = b2 ? r2[1] : r2[0]; const float send = b2 ? r2[0] : r2[1]; r1 = mine + __shfl_xor(send, 4); }
      r1 += __shfl_xor(r1, 2); r1 += __shfl_xor(r1, 1);
      const int ksrc = (kb * 16 + 2 * ((lane >> 2) & 7) + half) & 63;
      const float su = __shfl(kb < 4 ? su0 : su1, ksrc);
      const float gv = __shfl(kb < 4 ? gv0 : gv1, ksrc);
      const float w = gv * gelu_exact(r1 * su);
#pragma unroll
      for (int i = 0; i < 8; ++i) {
        const float wi = __shfl(w, half * 32 + i * 4);
        const f2 ww = (f2){wi, wi};
        const v32f vf = __builtin_amdgcn_cvt_scalef32_pk32_f32_fp6((v6u){va[i][0], va[i][1], va[i][2], vb[i][0], vb[i][1], vb[i][2]}, 1.0f);
#pragma unroll
        for (int j = 0; j < 16; ++j) y2[j] = __builtin_elementwise_fma(ww, (f2){vf[2 * j], vf[2 * j + 1]}, y2[j]);
      }
    }
    float y[16];
#pragma unroll
    for (int j = 0; j < 8; ++j) {
      const float ax = y2[j].x + __shfl_xor(y2[j].x, 32), ay = y2[j].y + __shfl_xor(y2[j].y, 32);
      const float bx = y2[8 + j].x + __shfl_xor(y2[8 + j].x, 32), by = y2[8 + j].y + __shfl_xor(y2[8 + j].y, 32);
      y[2 * j] = half ? bx : ax; y[2 * j + 1] = half ? by : ay;
    }
    const int bi = batch_of_row(t);
    const float* gate2 = P.MOD + (size_t)(l * 9 + bi) * 6144 + 5 * 1024;
    const int d0 = l32 * 32 + half * 16;
    float xn[16];
    float ss = 0.f;
#pragma unroll
    for (int q4 = 0; q4 < 4; ++q4) {
      const int d = d0 + q4 * 4;
      const float4 xo = *reinterpret_cast<const float4*>(P.X + (size_t)t * 1024 + d);
      const float4 gg = *reinterpret_cast<const float4*>(gate2 + d);
      float4 o;
      o.x = xo.x + gg.x * y[q4 * 4 + 0]; o.y = xo.y + gg.y * y[q4 * 4 + 1];
      o.z = xo.z + gg.z * y[q4 * 4 + 2]; o.w = xo.w + gg.w * y[q4 * 4 + 3];
      xn[q4 * 4 + 0] = o.x; xn[q4 * 4 + 1] = o.y; xn[q4 * 4 + 2] = o.z; xn[q4 * 4 + 3] = o.w;
      ss += o.x * o.x + o.y * o.y + o.z * o.z + o.w * o.w;
      if (l == 1) *reinterpret_cast<float4*>(P.out + (size_t)t * 1024 + d) = o;
      else *reinterpret_cast<float4*>(P.X + (size_t)t * 1024 + d) = o;
    }
    if (l == 0) {
      ss = wave_sum(ss);
      const float rr = rsqrtf(ss * (1.f / 1024.f) + EPS);
      const float* lnw = P.ln1_w + 1024;
      const float* mod = P.MOD + (size_t)(9 + bi) * 6144;
      unsigned pk[8];
#pragma unroll
      for (int i = 0; i < 16; i += 2) {
        const float o0 = xn[i] * rr * lnw[d0 + i] * (1.f + mod[1024 + d0 + i]) + mod[d0 + i];
        const float o1 = xn[i + 1] * rr * lnw[d0 + i + 1] * (1.f + mod[1024 + d0 + i + 1]) + mod[d0 + i + 1];
        pk[i >> 1] = pack2(o0, o1);
      }
      *reinterpret_cast<uint4*>(P.H + (size_t)t * 1024 + d0) = make_uint4(pk[0], pk[1], pk[2], pk[3]);
      *reinterpret_cast<uint4*>(P.H + (size_t)t * 1024 + d0 + 8) = make_uint4(pk[4], pk[5], pk[6], pk[7]);
    }
  }
}

using f32x4 = __attribute__((ext_vector_type(4))) float;
namespace g8 {
constexpr int BM = 256, BK = 64, HALF = 128, HT = HALF * BK;
DEVI int lds_byte(int r, int c) { const int st = (r >> 4) * 2 + (c >> 5), rr = r & 15, cc = c & 31, ob = rr * 64 + cc * 2; return st * 1024 + (ob ^ (((ob >> 9) & 1) << 5)); }
DEVI void stage_rc(int b, int& R, int& C) { const int st = b / 1024, sb = b % 1024, swz = sb ^ (((sb >> 9) & 1) << 5); R = (st >> 1) * 16 + swz / 64; C = (st & 1) * 32 + (swz % 64) / 2; }
DEVI void unit_of(int L, int nM, int nN, int& pm, int& pn) {
  const int nwg = nM * nN;
  int wgid = L;
  { const int q = nwg / 8, r = nwg % 8, xcd = wgid % 8, off = wgid / 8; wgid = (xcd < r ? xcd * (q + 1) : r * (q + 1) + (xcd - r) * q) + off; }
  const int nig = 8 * nN, gid = wgid / nig, fm = gid * 8, gsz = (nM - fm) < 8 ? (nM - fm) : 8;
  pm = fm + ((wgid % nig) % gsz); pn = (wgid % nig) / gsz;
}
}

struct G8Unit { int pm, pn; };
template <class Epi>
DEVI void gemm8_phase(LAS unsigned char* lds, const bf16* __restrict__ Ag, const bf16* __restrict__ Btg, const int K, const int nM, const int nN, const Epi& E) {
  constexpr int BK = 64, HALF = 128, HTB = HALF * BK * 2;
  const int tid = threadIdx.x, wid = __builtin_amdgcn_readfirstlane(tid >> 6), lane = tid & 63, wr = wid >> 2, wc = wid & 3, fr = lane & 15, fq = lane >> 4;
  const int nt = K / BK;
  const int nunits = nM * nN, G = gridDim.x, c = blockIdx.x;
  unsigned voffA[2];
#pragma unroll
  for (int i = 0; i < 2; ++i) { int R, C; g8::stage_rc(tid * 16 + i * 8192, R, C); voffA[i] = (unsigned)(R * K + C) * 2u; }
  const size_t kstep = (size_t)(BK * 2);
  const size_t hstep = (size_t)HALF * K * 2;
  const size_t tstep = 2 * hstep;
  const unsigned ldsw = (unsigned)wid * 1024u;
  const int aoff = g8::lds_byte(wr * 64 + fr, fq * 8), boff = g8::lds_byte(wc * 32 + fr, fq * 8);
#define PG8_SA(b, h) (((b) * 2 + (h)) * HTB)
#define PG8_SB(b, h) ((4 + (b) * 2 + (h)) * HTB)
#define PG8_STAGE(bufoff, gbase, voff) do { _Pragma("unroll") for (int _i = 0; _i < 2; ++_i) \
        __builtin_amdgcn_global_load_lds((const unsigned*)((const char*)(gbase) + (voff)[_i]), (LAS unsigned*)(lds + (bufoff) + ldsw + _i * 8192), 16, 0, 0); } while (0)
#define PG8_LDA(dst, b, h) do { _Pragma("unroll") for (int m = 0; m < 4; ++m) _Pragma("unroll") for (int k = 0; k < 2; ++k) dst[m][k] = *(const LAS bf16x8*)(lds + PG8_SA(b, h) + aoff + m * 2048 + k * 1024); } while (0)
#define PG8_LDB(dst, b, h) do { _Pragma("unroll") for (int n = 0; n < 2; ++n) _Pragma("unroll") for (int k = 0; k < 2; ++k) dst[n][k] = *(const LAS bf16x8*)(lds + PG8_SB(b, h) + boff + n * 2048 + k * 1024); } while (0)
#define PG8_MMA(ai, bj, At_, Bt_) do { __builtin_amdgcn_s_setprio(1); _Pragma("unroll") for (int m = 0; m < 4; ++m) _Pragma("unroll") for (int n = 0; n < 2; ++n) _Pragma("unroll") for (int k = 0; k < 2; ++k) \
        acc[ai][bj][m][n] = __builtin_amdgcn_mfma_f32_16x16x32_bf16(Bt_[n][k], At_[m][k], acc[ai][bj][m][n], 0, 0, 0); __builtin_amdgcn_s_setprio(0); } while (0)
#define PG8_WAIT_V(n) asm volatile("s_waitcnt vmcnt(" #n ")" ::: "memory")
#define PG8_WAIT_L(n) asm volatile("s_waitcnt lgkmcnt(" #n ")" ::: "memory")
#define PG8_BAR __builtin_amdgcn_s_barrier()
#define PG8_SCHED __builtin_amdgcn_sched_barrier(0)
  G8Unit cur, nxt; int ui = 0;
  if (c >= nunits) return;
  g8::unit_of(c, nM, nN, cur.pm, cur.pn);
  f32x4 acc[2][2][4][2];
#pragma unroll
  for (int a = 0; a < 2; ++a)
#pragma unroll
    for (int b = 0; b < 2; ++b)
#pragma unroll
      for (int m = 0; m < 4; ++m)
#pragma unroll
        for (int n = 0; n < 2; ++n) acc[a][b][m][n] = (f32x4){0.f, 0.f, 0.f, 0.f};
  bf16x8 At[4][2], B0[2][2], B1[2][2];
  const char* cA = (const char*)Ag + (size_t)cur.pm * tstep; const char* cB = (const char*)Btg + (size_t)cur.pn * tstep;
  PG8_STAGE(PG8_SB(0, 0), cB, voffA); PG8_STAGE(PG8_SA(0, 0), cA, voffA); PG8_STAGE(PG8_SB(0, 1), cB + hstep, voffA); PG8_STAGE(PG8_SA(0, 1), cA + hstep, voffA);
  if (wr == 1) PG8_BAR;
  PG8_WAIT_V(4); PG8_BAR;
  PG8_STAGE(PG8_SB(1, 0), cB + kstep, voffA); PG8_STAGE(PG8_SA(1, 0), cA + kstep, voffA); PG8_STAGE(PG8_SB(1, 1), cB + hstep + kstep, voffA);
  PG8_WAIT_V(6); PG8_BAR;
  for (;;) {
    const long Ln = (long)(ui + 1) * G + c;
    const bool has_next = Ln < nunits;
    if (has_next) g8::unit_of((int)Ln, nM, nN, nxt.pm, nxt.pn);
    const char* nA = has_next ? (const char*)Ag + (size_t)nxt.pm * tstep : cA; const char* nB = has_next ? (const char*)Btg + (size_t)nxt.pn * tstep : cB;
    for (int t = 0; t < nt; t += 2) {
      const bool last = (t == nt - 2);
      const char* a1 = cA + (size_t)(t + 1) * kstep;
      const char* a2 = last ? nA : cA + (size_t)(t + 2) * kstep; const char* b2 = last ? nB : cB + (size_t)(t + 2) * kstep;
      const char* a3 = a2 + kstep; const char* b3 = b2 + kstep;
      PG8_LDB(B0, 0, 0); PG8_SCHED; PG8_LDA(At, 0, 0); PG8_STAGE(PG8_SA(1, 1), a1 + hstep, voffA);
      PG8_WAIT_L(8); PG8_BAR; PG8_WAIT_L(0); PG8_MMA(0, 0, At, B0); PG8_BAR; PG8_SCHED;
      PG8_LDB(B1, 0, 1); PG8_STAGE(PG8_SB(0, 0), b2, voffA);
      PG8_BAR; PG8_WAIT_L(0); PG8_MMA(0, 1, At, B1); PG8_BAR;
      PG8_LDA(At, 0, 1); PG8_STAGE(PG8_SA(0, 0), a2, voffA);
      PG8_BAR; PG8_WAIT_L(0); PG8_MMA(1, 0, At, B0); PG8_BAR; PG8_SCHED;
      PG8_STAGE(PG8_SB(0, 1), b2 + hstep, voffA);
      PG8_WAIT_V(6); PG8_BAR; PG8_MMA(1, 1, At, B1); PG8_BAR;
      PG8_LDB(B0, 1, 0); PG8_SCHED; PG8_LDA(At, 1, 0); PG8_STAGE(PG8_SA(0, 1), a2 + hstep, voffA);
      PG8_WAIT_L(8); PG8_BAR; PG8_WAIT_L(0); PG8_MMA(0, 0, At, B0); PG8_BAR; PG8_SCHED;
      PG8_LDB(B1, 1, 1); PG8_STAGE(PG8_SB(1, 0), b3, voffA);
      PG8_BAR; PG8_WAIT_L(0); PG8_MMA(0, 1, At, B1); PG8_BAR;
      PG8_LDA(At, 1, 1); PG8_STAGE(PG8_SA(1, 0), a3, voffA);
      PG8_BAR; PG8_WAIT_L(0); PG8_MMA(1, 0, At, B0); PG8_BAR; PG8_SCHED;
      PG8_STAGE(PG8_SB(1, 1), b3 + hstep, voffA);
      PG8_WAIT_V(6); PG8_BAR; PG8_MMA(1, 1, At, B1); PG8_BAR;
    }
    E(acc, cur, wr, wc, fr, fq);
    if (!has_next) break;
#pragma unroll
    for (int a = 0; a < 2; ++a)
#pragma unroll
      for (int b = 0; b < 2; ++b)
#pragma unroll
        for (int m = 0; m < 4; ++m)
#pragma unroll
          for (int n = 0; n < 2; ++n) acc[a][b][m][n] = (f32x4){0.f, 0.f, 0.f, 0.f};
    cur = nxt; cA = nA; cB = nB; ++ui;
  }
  PG8_WAIT_V(0);
  if (wr == 0) PG8_BAR;
  PG8_BAR;
#undef PG8_SA
#undef PG8_SB
#undef PG8_STAGE
#undef PG8_LDA
#undef PG8_LDB
#undef PG8_MMA
}

struct EpiZ {
  bf16* Z;
  DEVI void operator()(const f32x4 (&acc)[2][2][4][2], const G8Unit& u, int wr, int wc, int fr, int fq) const {
    const int brow = u.pm * 256, bcol = u.pn * 256;
#pragma unroll
    for (int ai = 0; ai < 2; ++ai)
#pragma unroll
      for (int m = 0; m < 4; ++m) {
        const int row = brow + ai * 128 + wr * 64 + m * 16 + fr;
#pragma unroll
        for (int bj = 0; bj < 2; ++bj)
#pragma unroll
          for (int n = 0; n < 2; ++n) {
            const int col = bcol + bj * 128 + wc * 32 + n * 16 + 4 * fq;
            if (col < DIN) {
              const f32x4 v = acc[ai][bj][m][n];
              *reinterpret_cast<uint2*>(Z + (size_t)row * DIN + col) = make_uint2(pack2(v[0], v[1]), pack2(v[2], v[3]));
            }
          }
      }
  }
};
DEVI void phase_gemm1_8(const Params& P, int l, unsigned char* smem_base) {
  EpiZ E{P.Z};
  gemm8_phase((LAS unsigned char*)smem_base, P.H, P.WinT + (size_t)l * DINP * 1024, 1024, NT / 256, DINP / 256, E);
}

struct EpiX {
  const float* x; const float* ctx; float* X; const float* MODl; int l;
  DEVI void operator()(const f32x4 (&acc)[2][2][4][2], const G8Unit& u, int wr, int wc, int fr, int fq) const {
    const int brow = u.pm * 256, bcol = u.pn * 256;
    const float* gate = MODl + (size_t)batch_of_row(brow) * 6144 + 2048;
#pragma unroll
    for (int ai = 0; ai < 2; ++ai)
#pragma unroll
      for (int m = 0; m < 4; ++m) {
        const int row = brow + ai * 128 + wr * 64 + m * 16 + fr;
        const float* res = (l == 0) ? (row < NL ? x + (size_t)row * 1024 : ctx + (size_t)(row - NL) * 1024) : X + (size_t)row * 1024;
#pragma unroll
        for (int bj = 0; bj < 2; ++bj)
#pragma unroll
          for (int n = 0; n < 2; ++n) {
            const int col = bcol + bj * 128 + wc * 32 + n * 16 + 4 * fq;
            const f32x4 v = acc[ai][bj][m][n];
            const float4 r4 = *reinterpret_cast<const float4*>(res + col);
            const float4 g4 = *reinterpret_cast<const float4*>(gate + col);
            float4 o; o.x = r4.x + g4.x * v[0]; o.y = r4.y + g4.y * v[1]; o.z = r4.z + g4.z * v[2]; o.w = r4.w + g4.w * v[3];
            *reinterpret_cast<float4*>(X + (size_t)row * 1024 + col) = o;
          }
      }
  }
};
DEVI void phase_gemm2_8(const Params& P, int l, unsigned char* smem_base) {
  EpiX E{P.x, P.ctx, P.X, P.MOD + (size_t)l * 9 * 6144, l};
  gemm8_phase((LAS unsigned char*)smem_base, P.H, P.WoutT + (size_t)l * 1024 * 1024, 1024, (l == 1) ? NL / 256 : NT / 256, 4, E);
}

struct EpiQP {
  bf16* QP;
  DEVI void operator()(const f32x4 (&acc)[2][2][4][2], const G8Unit& u, int wr, int wc, int fr, int fq) const {
    const int brow = u.pm * 256, bcol = u.pn * 256;
#pragma unroll
    for (int ai = 0; ai < 2; ++ai)
#pragma unroll
      for (int m = 0; m < 4; ++m) {
        const int row = brow + ai * 128 + wr * 64 + m * 16 + fr;
#pragma unroll
        for (int bj = 0; bj < 2; ++bj)
#pragma unroll
          for (int n = 0; n < 2; ++n) {
            const int col = bcol + bj * 128 + wc * 32 + n * 16 + 4 * fq;
            const f32x4 v = acc[ai][bj][m][n];
            *reinterpret_cast<uint2*>(QP + (size_t)row * 2048 + col) = make_uint2(pack2(v[0], v[1]), pack2(v[2], v[3]));
          }
      }
  }
};
DEVI void phase_gemm3_8(const Params& P, int l, unsigned char* smem_base) {
  EpiQP E{P.QP};
  gemm8_phase((LAS unsigned char*)smem_base, P.H, P.WpqT + (size_t)l * 2048 * 1024, 1024, (l == 1) ? NL / 256 : NT / 256, 8, E);
}

constexpr int N_PHASES = 2 + 2 * 9;

#ifndef REP_MASK
#define REP_MASK 0
#endif
static_assert(sizeof(Params) % 8 == 0, "Params size");
DEVI Params load_params() {
#if defined(__HIP_DEVICE_COMPILE__)
  typedef const __attribute__((address_space(4))) Params* ParamsCP;
  ParamsCP pp = (ParamsCP)__builtin_amdgcn_kernarg_segment_ptr();
  asm volatile("" : "+s"(pp));
  return *pp;
#else
  return Params{};
#endif
}
__global__ void __launch_bounds__(512, 2) fwd_kernel(Params Pk) {
  extern __shared__ __attribute__((aligned(16))) unsigned char smem_base[];
  cg::grid_group grid = cg::this_grid();
  volatile LAS unsigned* xst = (volatile LAS unsigned*)(smem_base + SMEM_BYTES);
  if (threadIdx.x == 0) { xst[0] = 0u; xst[1] = 0u; xst[2] = 0u; xst[3] = 0u; }
  __syncthreads();
  XcdBarrier xb = xcd_barrier_post(Pk.bar, xst);
  const int phase_lo = Pk.phase_lo, phase_hi = Pk.phase_hi, coop = Pk.coop;
#define smem (smem_base + VHALF * HALF_LDS)
#define GSYNC(idx) { if ((idx) == 0) grid.sync(); else xcd_barrier(xb); }
#define RUN_PHASE2(idx, call, repcall) \
  if (phase_lo <= (idx) && (idx) <= phase_hi) { { const Params P = load_params(); call; } if (REP_MASK & (1 << (idx))) { GSYNC(1); const Params P = load_params(); repcall; } if (coop && (idx) < phase_hi) GSYNC(idx); }
#define RUN_PHASE(idx, call) RUN_PHASE2(idx, call, call)
  RUN_PHASE(0, phase_prologue(P, smem))
  RUN_PHASE(1, phase_norm(P, 0, 0, NT))
  RUN_PHASE(2, phase_gemm1_8(P, 0, smem_base))
  RUN_PHASE(3, { phase_mixA(P, 0, smem); phase_mla_proj(P, 0, smem); phase_hgrn_local(P, 0, smem); })
  RUN_PHASE2(4, phase_attn_scan(P, 0, smem_base), phase_attn_scan(P, 0, smem_base, true))
  RUN_PHASE(5, phase_hgrn_final(P, 0, smem))
  RUN_PHASE(6, phase_gemm2_8(P, 0, smem_base))
  RUN_PHASE(7, phase_norm(P, 0, 1, NT))
  RUN_PHASE(8, phase_gemm3_8(P, 0, smem_base))
  RUN_PHASE(9, phase_route(P, 0, smem))
  RUN_PHASE(10, phase_peer(P, 0))
  RUN_PHASE(11, phase_gemm1_8(P, 1, smem_base))
  RUN_PHASE(12, { phase_mixA(P, 1, smem); phase_mla_proj(P, 1, smem); phase_hgrn_local(P, 1, smem); })
  RUN_PHASE2(13, phase_attn_scan(P, 1, smem_base), phase_attn_scan(P, 1, smem_base, true))
  RUN_PHASE(14, phase_hgrn_final(P, 1, smem))
  RUN_PHASE(15, phase_gemm2_8(P, 1, smem_base))
  RUN_PHASE(16, phase_norm(P, 1, 1, NL))
  RUN_PHASE(17, phase_gemm3_8(P, 1, smem_base))
  RUN_PHASE(18, phase_route(P, 1, smem))
  RUN_PHASE(19, phase_peer(P, 1))
#undef smem
}

extern "C" void kernel_launch(void* const* d_in, const int* in_sizes, int n_in, void* d_out, int out_size, void* d_ws,
                              size_t ws_size, hipStream_t stream) {
  Params p{};
  const float* const* in = reinterpret_cast<const float* const*>(d_in);
  p.x = in[0]; p.c = in[1]; p.ctx = in[2]; p.c_ctx = in[3]; p.ln1_w = in[4]; p.ln2_w = in[5]; p.w_mod = in[6]; p.b_mod = in[7];
  p.w_in = in[8]; p.w_out = in[9]; p.a_norm_w = in[10]; p.a_w_s = in[11]; p.a_b_s = in[12]; p.b_q_norm_w = in[13]; p.b_w_uq = in[14];
  p.b_kv_norm_w = in[15]; p.b_w_ukv = in[16]; p.b_qh_w = in[17]; p.b_kh_w = in[18]; p.c_lb = in[19]; p.c_out_norm_w = in[20];
  p.p_w_q = in[21]; p.p_sub_keys = in[22]; p.p_u = in[23]; p.p_v = in[24];
  p.out = reinterpret_cast<float*>(d_out);
  unsigned char* ws = reinterpret_cast<unsigned char*>(d_ws);
  size_t off = 0;
  auto take = [&](size_t bytes) { unsigned char* r = ws + off; off += (bytes + 255) & ~(size_t)255; return r; };
  p.bar = (unsigned*)take((size_t)XCD_BAR_WORDS * 4);
  p.MOD = (float*)take((size_t)2 * 9 * 6144 * 4);
  p.ROPE = (float*)take((size_t)2048 * 32 * 4);
  p.WinT = (bf16*)take((size_t)2 * DINP * 1024 * 2);
  p.WoutT = (bf16*)take((size_t)2 * 1024 * 1024 * 2);
  p.WpqT = (bf16*)take((size_t)2 * 2048 * 1024 * 2);
  p.WuqT = (bf16*)take((size_t)2 * 768 * 256 * 2);
  p.WukvT = (bf16*)take((size_t)2 * 1024 * 128 * 2);
  p.SK = (bf16*)take((size_t)2 * 16 * 128 * 128 * 2);
  p.AWS = (bf16*)take((size_t)2 * 4 * 128 * 128 * 2);
  p.PU8 = (unsigned char*)take((size_t)2 * 16384 * 768);
  p.PV8 = (unsigned char*)take((size_t)2 * 16384 * 768);
  p.PUS = (float*)take((size_t)2 * 16384 * 4);
  p.PVS = (float*)take((size_t)2 * 16384 * 4);
  p.X = (float*)take((size_t)NT * 1024 * 4);
  p.H = (bf16*)take((size_t)NT * 1024 * 2);
  p.Z = (bf16*)take((size_t)NT * DIN * 2);
  p.Q = (bf16*)take((size_t)64 * SEQP * 96 * 2);
  p.K = (bf16*)take((size_t)64 * SEQP * 96 * 2);
  p.VT = (bf16*)take((size_t)64 * 64 * SEQP * 2);
  p.ST = (float*)take((size_t)64 * 36 * 4096 * 4);
  p.DEC = (float*)take((size_t)64 * 36 * 64 * 4);
  p.OI = (float*)take((size_t)NT * 256 * 4);
  p.GQF = (bf16*)take((size_t)NT * 256 * 2);
  p.GQB = (bf16*)take((size_t)NT * 256 * 2);
  p.QP = p.Z;
  p.EIDX = (int*)p.Q;
  p.GATE = (float*)p.K;
  if (off > ws_size) { fprintf(stderr, "workspace too small: need %zu have %zu\n", off, ws_size); }
  static int grid_blocks = 0;
  if (!grid_blocks) {
    if (hipFuncSetAttribute((const void*)fwd_kernel, hipFuncAttributeMaxDynamicSharedMemorySize, SMEM_TOTAL) != hipSuccess)
      fprintf(stderr, "hipFuncSetAttribute failed\n");
    int dev = 0, cus = 0, per_cu = 0;
    hipGetDevice(&dev);
    hipDeviceGetAttribute(&cus, hipDeviceAttributeMultiprocessorCount, dev);
    hipOccupancyMaxActiveBlocksPerMultiprocessor(&per_cu, (const void*)fwd_kernel, 512, SMEM_TOTAL);
    if (per_cu > 1) per_cu = 1;
    if (per_cu < 1) { fprintf(stderr, "occupancy query returned %d\n", per_cu); per_cu = 1; }
    grid_blocks = cus * per_cu;
    fprintf(stderr, "grid_blocks=%d (cus=%d per_cu=%d) ws need=%zu have=%zu\n", grid_blocks, cus, per_cu, off, ws_size);
  }
  hipMemsetAsync(p.bar, 0, (size_t)XCD_BAR_WORDS * 4, stream);
  p.coop = 1; p.phase_lo = 0; p.phase_hi = N_PHASES - 1;
  void* args[] = {&p};
  const hipError_t e = hipLaunchCooperativeKernel((const void*)fwd_kernel, dim3(grid_blocks), dim3(512), args, SMEM_TOTAL, stream);
  if (e != hipSuccess) fprintf(stderr, "cooperative launch failed: %s (grid %d)\n", hipGetErrorString(e), grid_blocks);
}
```

```cpp
#include <hip/hip_runtime.h>
#include <hip/hip_cooperative_groups.h>
#include <cstdio>
#include <cstdint>
namespace cg = cooperative_groups;

#define DEVI __device__ __forceinline__

typedef unsigned short bf16;
using bf16x8 = __attribute__((ext_vector_type(8))) __bf16;
using bf16x2 = __attribute__((ext_vector_type(2))) __bf16;
using f32x16 = __attribute__((ext_vector_type(16))) float;
typedef unsigned v6u __attribute__((ext_vector_type(6)));
typedef unsigned v3u __attribute__((ext_vector_type(3)));
typedef float v16f __attribute__((ext_vector_type(16)));
typedef float v32f __attribute__((ext_vector_type(32)));

constexpr int NL = 16384;
constexpr int NT = 18432;
constexpr int DM = 1024;
constexpr int DIN = 2208;
constexpr int DINP = 2304;
constexpr int SEQP = 2304;
constexpr float EPS = 1e-6f;
constexpr int ZC_AU = 0, ZC_AV = 256, ZC_BQ = 512, ZC_BKV = 768, ZC_BKR = 896, ZC_CQ = 928, ZC_CFF = 1184, ZC_CFB = 1440, ZC_CI = 1696, ZC_CG = 1952;
constexpr int SMEM_BYTES = 2 * 80896;
constexpr int SMEM_TOTAL = SMEM_BYTES + 16;

struct Params {
  const float *x, *c, *ctx, *c_ctx, *ln1_w, *ln2_w, *w_mod, *b_mod, *w_in, *w_out, *a_norm_w, *a_w_s, *a_b_s;
  const float *b_q_norm_w, *b_w_uq, *b_kv_norm_w, *b_w_ukv, *b_qh_w, *b_kh_w, *c_lb, *c_out_norm_w, *p_w_q, *p_sub_keys, *p_u, *p_v;
  float* out;
  unsigned* bar;
  float* MOD;
  float* ROPE;
  bf16* WinT;
  bf16* WoutT;
  bf16* WpqT;
  bf16* WuqT;
  bf16* WukvT;
  bf16* SK;
  bf16* AWS;
  unsigned char* PU8;
  unsigned char* PV8;
  float* PUS;
  float* PVS;
  float* X;
  bf16* H;
  bf16* Z;
  bf16* Q;
  bf16* K;
  bf16* VT;
  float* ST;
  float* DEC;
  float* OI;
  bf16* GQF;
  bf16* GQB;
  bf16* QP;
  int* EIDX;
  float* GATE;
  int phase_lo, phase_hi, coop, pad0;
};

DEVI float bf2f(bf16 v) { return __uint_as_float(((unsigned)v) << 16); }
DEVI bf16 f2bf(float a) { __bf16 v = (__bf16)a; return __builtin_bit_cast(unsigned short, v); }
DEVI unsigned pack2(float a, float b) { bf16x2 v; v[0] = (__bf16)a; v[1] = (__bf16)b; return __builtin_bit_cast(unsigned, v); }
DEVI float lo2f(unsigned u) { return __uint_as_float(u << 16); }
DEVI float hi2f(unsigned u) { return __uint_as_float(u & 0xffff0000u); }
DEVI f32x16 zero16() { f32x16 z;
#pragma unroll
  for (int i = 0; i < 16; ++i) z[i] = 0.f; return z; }
DEVI f32x16 mfma32(bf16x8 a, bf16x8 b, f32x16 c) { return __builtin_amdgcn_mfma_f32_32x32x16_bf16(a, b, c, 0, 0, 0); }
DEVI bf16x8 ldfrag(const bf16* p) { return *reinterpret_cast<const bf16x8*>(p); }
DEVI int drow(int r, int hh) { return (r & 3) + 8 * (r >> 2) + 4 * hh; }
DEVI int row_of(int b, int p) { return p < 256 ? NL + b * 256 + p : b * 2048 + (p - 256); }
DEVI int batch_of_row(int r) { return r < NL ? (r >> 11) : 8; }
DEVI float wave_sum(float v) {
#pragma unroll
  for (int o = 32; o > 0; o >>= 1) v += __shfl_xor(v, o);
  return v;
}
DEVI float sigmoidf_(float z) { return 1.f / (1.f + __expf(-z)); }


#define XB_TMO      128
#define XB_XCNT(j)  (256  + 64 * (j))
#define XB_XSUB(j)  (1280 + 64 * (j))
#define XB_XGEN(j)  (2304 + 64 * (j))
#define XB_TOP      3328
#define XB_TOPGEN   3392
#define XCD_BAR_WORDS 3456
#define XB_SPIN_CAP (1u << 22)
#define LAS __attribute__((address_space(3)))
DEVI unsigned xb_ld(unsigned* p)              { return __hip_atomic_load(p, __ATOMIC_RELAXED, __HIP_MEMORY_SCOPE_AGENT); }
DEVI unsigned xb_add(unsigned* p, unsigned v) { return __hip_atomic_fetch_add(p, v, __ATOMIC_RELAXED, __HIP_MEMORY_SCOPE_AGENT); }
DEVI unsigned xb_xcc_id() { return (unsigned)__builtin_amdgcn_s_getreg((3 << 11) | 20) & 0xFu; }
#define XB_SPIN(cond, bar) do { unsigned _sp = 0; while (cond) { __builtin_amdgcn_s_sleep(1); \
    if ((++_sp & 255u) == 0u) { if (xb_ld(&(bar)[XB_TMO])) break; if (_sp > XB_SPIN_CAP) { atomicAdd(&(bar)[XB_TMO], 1u); break; } } } } while (0)
struct XcdBarrier { unsigned* bar; unsigned x; volatile LAS unsigned* st; };
DEVI XcdBarrier xcd_barrier_post(unsigned* bar, volatile LAS unsigned* st) {
  XcdBarrier b; b.bar = bar; b.x = xb_xcc_id(); b.st = st;
  if (threadIdx.x == 0) (void)xb_add(&bar[XB_XCNT(b.x)], 1u);
  return b;
}
DEVI void xcd_barrier_complete(unsigned* bar, unsigned x, unsigned& nloc, unsigned& nx) {
  const unsigned G = gridDim.x * gridDim.y * gridDim.z;
  unsigned sum, cnt, mine, sp = 0u;
  for (;;) {
    sum = 0u; cnt = 0u; mine = 0u;
#pragma unroll
    for (unsigned j = 0; j < 16; ++j) { const unsigned c = xb_ld(&bar[XB_XCNT(j)]); sum += c; cnt += (c > 0u) ? 1u : 0u; mine = (j == x) ? c : mine; }
    if (sum == G) break;
    __builtin_amdgcn_s_sleep(1);
    if ((++sp & 255u) == 0u) { if (xb_ld(&bar[XB_TMO])) break; if (sp > XB_SPIN_CAP) { atomicAdd(&bar[XB_TMO], 1u); break; } }
  }
  nloc = mine > 0u ? mine : 1u; nx = cnt > 0u ? cnt : 1u;
}
DEVI void xcd_barrier(const XcdBarrier& b) {
  asm volatile("s_waitcnt vmcnt(0)" ::: "memory");
  __syncthreads();
  if (threadIdx.x == 0) {
    unsigned* bar = b.bar;
    __builtin_amdgcn_s_waitcnt(0);
    unsigned nloc = b.st[0], nx = b.st[1];
    if (nloc == 0u) { xcd_barrier_complete(bar, b.x, nloc, nx); b.st[0] = nloc; b.st[1] = nx; }
    const unsigned old = xb_add(&bar[XB_XSUB(b.x)], 1u);
    const unsigned gen = old / nloc;
    if (old + 1u == (gen + 1u) * nloc) {
      __builtin_amdgcn_fence(__ATOMIC_RELEASE, "agent");
      asm volatile("s_waitcnt vmcnt(0)" ::: "memory");
      const unsigned og = xb_add(&bar[XB_TOP], 1u);
      const unsigned tg = og / nx;
      if (og + 1u == (tg + 1u) * nx) xb_add(&bar[XB_TOPGEN], 1u);
      else XB_SPIN(xb_ld(&bar[XB_TOPGEN]) == tg, bar);
      __builtin_amdgcn_fence(__ATOMIC_ACQUIRE, "agent");
      xb_add(&bar[XB_XGEN(b.x)], 1u);
      asm volatile("s_waitcnt vmcnt(0)" ::: "memory");
    } else {
      XB_SPIN(xb_ld(&bar[XB_XGEN(b.x)]) == gen, bar);
      __builtin_amdgcn_fence(__ATOMIC_ACQUIRE, "agent");
      asm volatile("s_waitcnt vmcnt(0)" ::: "memory");
    }
  }
  __syncthreads();
}

#define VHALF ((int)__builtin_amdgcn_readfirstlane((int)(threadIdx.x >> 8)))
#define TIDX ((int)(threadIdx.x & 255))
#define VBID ((int)(blockIdx.x * 2 + VHALF))
#define NVB ((int)(gridDim.x * 2))
constexpr int HALF_LDS = 80896;

DEVI void phase_mod(const Params& P, unsigned char* smem) {
  const int tid = TIDX;
  float* s = (float*)smem;
  float* red = s + 9 * 1024;
  for (int item = VBID; item < 192; item += NVB) {
    const int l = item / 96, j = item % 96;
    __syncthreads();
    for (int i = tid; i < 9 * 1024; i += 256) {
      int bi = i >> 10, k = i & 1023;
      float v = bi < 8 ? P.c[bi * 1024 + k] : P.c_ctx[k];
      s[i] = v * sigmoidf_(v);
    }
    __syncthreads();
    const int c4 = tid & 15, kg = tid >> 4;
    float acc[9][4];
#pragma unroll
    for (int bi = 0; bi < 9; ++bi) { acc[bi][0] = acc[bi][1] = acc[bi][2] = acc[bi][3] = 0.f; }
    const float* w = P.w_mod + (size_t)l * 1024 * 6144 + j * 64 + c4 * 4;
#pragma unroll 4
    for (int kk = 0; kk < 64; ++kk) {
      const int k = kg * 64 + kk;
      const float4 w4 = *reinterpret_cast<const float4*>(w + (size_t)k * 6144);
#pragma unroll
      for (int bi = 0; bi < 9; ++bi) {
        const float sv = s[bi * 1024 + k];
        acc[bi][0] += sv * w4.x; acc[bi][1] += sv * w4.y; acc[bi][2] += sv * w4.z; acc[bi][3] += sv * w4.w;
      }
    }
#pragma unroll
    for (int bi = 0; bi < 9; ++bi)
#pragma unroll
      for (int e = 0; e < 4; ++e) red[(kg * 9 + bi) * 64 + c4 * 4 + e] = acc[bi][e];
    __syncthreads();
    for (int o = tid; o < 576; o += 256) {
      const int bi = o >> 6, cc = o & 63;
      float sum = 0.f;
#pragma unroll
      for (int g = 0; g < 16; ++g) sum += red[(g * 9 + bi) * 64 + cc];
      P.MOD[(size_t)(l * 9 + bi) * 6144 + j * 64 + cc] = sum + P.b_mod[l * 6144 + j * 64 + cc];
    }
  }
}

DEVI void conv_T_tile(const float* __restrict__ src, int N, bf16* __restrict__ dst, int Kd, int k0, int n0,
                      const float* __restrict__ kscale, float* tile) {
  const int tid = TIDX;
  __syncthreads();
  for (int e = tid; e < 4096; e += 256) {
    const int i = e >> 6, j = e & 63, n = n0 + j;
    float v = (n < N) ? src[(size_t)(k0 + i) * N + n] : 0.f;
    if (kscale) v *= kscale[k0 + i];
    tile[i * 65 + j] = v;
  }
  __syncthreads();
  for (int e = tid; e < 2048; e += 256) {
    const int j = e >> 5, i2 = (e & 31) * 2;
    const unsigned pk = pack2(tile[i2 * 65 + j], tile[(i2 + 1) * 65 + j]);
    *reinterpret_cast<unsigned*>(&dst[(size_t)(n0 + j) * Kd + k0 + i2]) = pk;
  }
}

DEVI void conv_straight(const float* __restrict__ src, bf16* __restrict__ dst, size_t n8) {
  const size_t stride = (size_t)NVB * 256;
  for (size_t i = (size_t)VBID * 256 + TIDX; i < n8; i += stride) {
    const float4 a = reinterpret_cast<const float4*>(src)[2 * i];
    const float4 b = reinterpret_cast<const float4*>(src)[2 * i + 1];
    uint4 o; o.x = pack2(a.x, a.y); o.y = pack2(a.z, a.w); o.z = pack2(b.x, b.y); o.w = pack2(b.z, b.w);
    reinterpret_cast<uint4*>(dst)[i] = o;
  }
}

DEVI void convert_rows_fp6(const Params& P, int L, int i0, int i1) {
  const int lane = threadIdx.x & 63, half = lane >> 5, l32 = lane & 31;
  const int wv = threadIdx.x >> 6;
  for (int ib = i0 + wv * 2; ib < i1; ib += 16) {
    int i = ib + half; const bool live = i < i1; if (!live) i = i1 - 1;
    {
      const int table = i >> 14, lr = L * 16384 + (i & 16383);
      const float* src = (table ? P.p_v : P.p_u) + (size_t)lr * 1024 + l32 * 32;
      float4 a[8];
      float m = 0.f;
#pragma unroll
      for (int i = 0; i < 8; ++i) {
        a[i] = *reinterpret_cast<const float4*>(src + i * 4);
        m = fmaxf(m, fmaxf(fmaxf(fabsf(a[i].x), fabsf(a[i].y)), fmaxf(fabsf(a[i].z), fabsf(a[i].w))));
      }
#pragma unroll
      for (int o = 16; o > 0; o >>= 1) m = fmaxf(m, __shfl_xor(m, o));
      const float sc = fmaxf(m, 1e-30f) * (1.f / 7.5f);
      const float inv = 1.f / sc;
      unsigned pk[6];
      {
        unsigned long long accb = 0ull; int nb = 0, wi = 0;
#pragma unroll
        for (int i = 0; i < 32; ++i) {
          const float4 q4 = a[i >> 2];
          const float xv = ((i & 3) == 0 ? q4.x : (i & 3) == 1 ? q4.y : (i & 3) == 2 ? q4.z : q4.w) * inv;
          const float av = fabsf(xv);
          const float cf = av < 2.f ? rintf(av * 8.f) : (av < 4.f ? 16.f + rintf((av - 2.f) * 4.f) : 24.f + rintf((av - 4.f) * 2.f));
          unsigned ci = (unsigned)cf; ci = ci > 31u ? 31u : ci;
          ci |= (xv < 0.f) ? 32u : 0u;
          accb |= (unsigned long long)ci << nb; nb += 6;
          if (nb >= 32) { pk[wi++] = (unsigned)accb; accb >>= 32; nb -= 32; }
        }
      }
      unsigned* dst = reinterpret_cast<unsigned*>((table ? P.PV8 : P.PU8) + (size_t)lr * 768 + l32 * 24);
      if (live) {
        *reinterpret_cast<v3u*>(dst) = (v3u){pk[0], pk[1], pk[2]};
        *reinterpret_cast<v3u*>(dst + 3) = (v3u){pk[3], pk[4], pk[5]};
        if (l32 == 0) (table ? P.PVS : P.PUS)[lr] = sc;
      }
    }
  }
}

DEVI void phase_prologue(const Params& P, unsigned char* smem) {
  phase_mod(P, smem);
  float* tile = (float*)smem;
  for (int it = VBID; it < 2 * 1424; it += NVB) {
    const int l = it / 1424; int r = it % 1424;
    if (r < 576) { conv_T_tile(P.w_in + (size_t)l * 1024 * DIN, DIN, P.WinT + (size_t)l * DINP * 1024, 1024, (r % 16) * 64, (r / 16) * 64, nullptr, tile); continue; }
    r -= 576;
    if (r < 256) { conv_T_tile(P.w_out + (size_t)l * 1024 * 1024, 1024, P.WoutT + (size_t)l * 1024 * 1024, 1024, (r % 16) * 64, (r / 16) * 64, nullptr, tile); continue; }
    r -= 256;
    if (r < 512) { conv_T_tile(P.p_w_q + (size_t)l * 1024 * 2048, 2048, P.WpqT + (size_t)l * 2048 * 1024, 1024, (r % 16) * 64, (r / 16) * 64, nullptr, tile); continue; }
    r -= 512;
    if (r < 48) { conv_T_tile(P.b_w_uq + (size_t)l * 256 * 768, 768, P.WuqT + (size_t)l * 768 * 256, 256, (r % 4) * 64, (r / 4) * 64, P.b_q_norm_w + l * 256, tile); continue; }
    r -= 48;
    conv_T_tile(P.b_w_ukv + (size_t)l * 128 * 1024, 1024, P.WukvT + (size_t)l * 1024 * 128, 128, (r % 2) * 64, (r / 2) * 64, P.b_kv_norm_w + l * 128, tile);
  }
  conv_straight(P.p_sub_keys, P.SK, (size_t)2 * 16 * 128 * 128 / 8);
  conv_straight(P.a_w_s, P.AWS, (size_t)2 * 4 * 128 * 128 / 8);
  for (int i = VBID * 256 + TIDX; i < 2048 * 16; i += NVB * 256) {
    const int t = i >> 4, a = (i >> 3) & 1, f = i & 7;
    const float inv = powf(10000.f, -(float)f / 8.f);
    const float pos = a ? (float)(t & 63) : (float)(t >> 6);
    const float ang = pos * inv;
    P.ROPE[t * 32 + a * 8 + f] = cosf(ang);
    P.ROPE[t * 32 + 16 + a * 8 + f] = sinf(ang);
  }
}

DEVI void phase_norm(const Params& P, int l, int which, int nrows) {
  const int lane = TIDX & 63;
  const int gw = VBID * 4 + (TIDX >> 6), nw = NVB * 4;
  const float* lnw = (which == 0 ? P.ln1_w : P.ln2_w) + l * 1024;
  for (int r = gw; r < nrows; r += nw) {
    const float* src;
    if (which == 0 && l == 0) src = r < NL ? P.x + (size_t)r * 1024 : P.ctx + (size_t)(r - NL) * 1024;
    else src = P.X + (size_t)r * 1024;
    const float* mod = P.MOD + (size_t)(l * 9 + batch_of_row(r)) * 6144 + which * 3072;
    float4 v[4];
    float ss = 0.f;
#pragma unroll
    for (int i = 0; i < 4; ++i) {
      v[i] = *reinterpret_cast<const float4*>(src + i * 256 + lane * 4);
      ss += v[i].x * v[i].x + v[i].y * v[i].y + v[i].z * v[i].z + v[i].w * v[i].w;
    }
    ss = wave_sum(ss);
    const float rr = rsqrtf(ss * (1.f / 1024.f) + EPS);
#pragma unroll
    for (int i = 0; i < 4; ++i) {
      const int d = i * 256 + lane * 4;
      const float4 w = *reinterpret_cast<const float4*>(lnw + d);
      const float4 sh = *reinterpret_cast<const float4*>(mod + d);
      const float4 sc = *reinterpret_cast<const float4*>(mod + 1024 + d);
      const float o0 = v[i].x * rr * w.x * (1.f + sc.x) + sh.x;
      const float o1 = v[i].y * rr * w.y * (1.f + sc.y) + sh.y;
      const float o2 = v[i].z * rr * w.z * (1.f + sc.z) + sh.z;
      const float o3 = v[i].w * rr * w.w * (1.f + sc.w) + sh.w;
      uint2 o; o.x = pack2(o0, o1); o.y = pack2(o2, o3);
      *reinterpret_cast<uint2*>(P.H + (size_t)r * 1024 + d) = o;
    }
  }
}

template <int BM, int BN, int BK, int WM, int WN>
struct Gemm {
  static constexpr int LDK = BK + 8;
  static constexpr int TM = BM / WM / 32, TN = BN / WN / 32;
  static constexpr int CPR = BK / 8;
  static constexpr int NA = BM * CPR / 256, NB = BN * CPR / 256;
  static constexpr int A_BYTES = BM * LDK * 2, B_BYTES = BN * LDK * 2;
  static constexpr int STAGE_BYTES = A_BYTES + B_BYTES;
  static constexpr int SMEM = 2 * STAGE_BYTES;

  static DEVI void run(const bf16* __restrict__ A, int lda, const bf16* __restrict__ BT, int ldb, int K,
                       unsigned char* smem, f32x16 (&acc)[TM][TN]) {
    const int tid = TIDX, lane = tid & 63, wave = tid >> 6;
    const int wm = wave / WN, wn = wave % WN;
    const int l31 = lane & 31, hh = lane >> 5;
#pragma unroll
    for (int i = 0; i < TM; ++i)
#pragma unroll
      for (int j = 0; j < TN; ++j) acc[i][j] = zero16();
    uint4 ra[NA], rb[NB];
    const int nk = K / BK;
    auto gload = [&](int kt) {
#pragma unroll
      for (int i = 0; i < NA; ++i) { const int ch = tid + i * 256, row = ch / CPR, cc = ch % CPR;
        ra[i] = *reinterpret_cast<const uint4*>(A + (size_t)row * lda + kt * BK + cc * 8); }
#pragma unroll
      for (int i = 0; i < NB; ++i) { const int ch = tid + i * 256, row = ch / CPR, cc = ch % CPR;
        rb[i] = *reinterpret_cast<const uint4*>(BT + (size_t)row * ldb + kt * BK + cc * 8); }
    };
    auto swrite = [&](int buf) {
      bf16* sA = reinterpret_cast<bf16*>(smem + buf * STAGE_BYTES);
      bf16* sB = reinterpret_cast<bf16*>(smem + buf * STAGE_BYTES + A_BYTES);
#pragma unroll
      for (int i = 0; i < NA; ++i) { const int ch = tid + i * 256, row = ch / CPR, cc = ch % CPR;
        *reinterpret_cast<uint4*>(sA + row * LDK + cc * 8) = ra[i]; }
#pragma unroll
      for (int i = 0; i < NB; ++i) { const int ch = tid + i * 256, row = ch / CPR, cc = ch % CPR;
        *reinterpret_cast<uint4*>(sB + row * LDK + cc * 8) = rb[i]; }
    };
    __syncthreads();
    gload(0);
    swrite(0);
    __syncthreads();
    for (int kt = 0; kt < nk; ++kt) {
      const int cur = kt & 1;
      if (kt + 1 < nk) gload(kt + 1);
      const bf16* sA = reinterpret_cast<const bf16*>(smem + cur * STAGE_BYTES);
      const bf16* sB = reinterpret_cast<const bf16*>(smem + cur * STAGE_BYTES + A_BYTES);
#pragma unroll
      for (int ks = 0; ks < BK / 16; ++ks) {
        bf16x8 af[TM], bfr[TN];
#pragma unroll
        for (int i = 0; i < TM; ++i) af[i] = ldfrag(sA + (wm * (BM / WM) + i * 32 + l31) * LDK + ks * 16 + hh * 8);
#pragma unroll
        for (int j = 0; j < TN; ++j) bfr[j] = ldfrag(sB + (wn * (BN / WN) + j * 32 + l31) * LDK + ks * 16 + hh * 8);
#pragma unroll
        for (int i = 0; i < TM; ++i)
#pragma unroll
          for (int j = 0; j < TN; ++j) acc[i][j] = mfma32(af[i], bfr[j], acc[i][j]);
      }
      if (kt + 1 < nk) swrite(cur ^ 1);
      __syncthreads();
    }
  }
};

DEVI void phase_gemm1(const Params& P, int l, unsigned char* smem) {
  using G = Gemm<128, 128, 64, 2, 2>;
  const int lane = TIDX & 63, wave = TIDX >> 6, wm = wave >> 1, wn = wave & 1, l31 = lane & 31, hh = lane >> 5;
  const bf16* W = P.WinT + (size_t)l * DINP * 1024;
  for (int t = VBID; t < 144 * 18; t += NVB) {
    const int mt = t / 18, nt = t % 18;
    f32x16 acc[2][2];
    G::run(P.H + (size_t)mt * 128 * 1024, 1024, W + (size_t)nt * 128 * 1024, 1024, 1024, smem, acc);
#pragma unroll
    for (int i = 0; i < 2; ++i)
#pragma unroll
      for (int j = 0; j < 2; ++j) {
        const int col = nt * 128 + wn * 64 + j * 32 + l31;
        if (col < DIN) {
#pragma unroll
          for (int r = 0; r < 16; ++r) {
            const int row = mt * 128 + wm * 64 + i * 32 + drow(r, hh);
            P.Z[(size_t)row * DIN + col] = f2bf(acc[i][j][r]);
          }
        }
      }
  }
}

DEVI void phase_gemm2(const Params& P, int l, unsigned char* smem) {
  using G = Gemm<128, 128, 64, 2, 2>;
  const int lane = TIDX & 63, wave = TIDX >> 6, wm = wave >> 1, wn = wave & 1, l31 = lane & 31, hh = lane >> 5;
  const bf16* W = P.WoutT + (size_t)l * 1024 * 1024;
  const int mtiles = (l == 1) ? 128 : 144;
  for (int t = VBID; t < mtiles * 8; t += NVB) {
    const int mt = t / 8, nt = t % 8;
    f32x16 acc[2][2];
    G::run(P.H + (size_t)mt * 128 * 1024, 1024, W + (size_t)nt * 128 * 1024, 1024, 1024, smem, acc);
    const int bi = batch_of_row(mt * 128);
    const float* gate = P.MOD + (size_t)(l * 9 + bi) * 6144 + 2048;
#pragma unroll
    for (int i = 0; i < 2; ++i)
#pragma unroll
      for (int j = 0; j < 2; ++j) {
        const int col = nt * 128 + wn * 64 + j * 32 + l31;
        const float g = gate[col];
#pragma unroll
        for (int r = 0; r < 16; ++r) {
          const int row = mt * 128 + wm * 64 + i * 32 + drow(r, hh);
          float res;
          if (l == 0) res = row < NL ? P.x[(size_t)row * 1024 + col] : P.ctx[(size_t)(row - NL) * 1024 + col];
          else res = P.X[(size_t)row * 1024 + col];
          P.X[(size_t)row * 1024 + col] = res + g * acc[i][j][r];
        }
      }
  }
}

DEVI void phase_mixA(const Params& P, int l, unsigned char* smem) {
  const int tid = TIDX, lane = tid & 63, wave = tid >> 6, l31 = lane & 31, hh = lane >> 5;
  bf16* VNT = reinterpret_cast<bf16*>(smem);
  constexpr int LDV = 136;
  const int nseg = (l == 1) ? 16 : 18;
  const int seg0 = (l == 1) ? 2 : 0;
  for (int it = VBID; it < 8 * nseg * 4; it += NVB) {
    const int a = it & 3; const int sj = (it >> 2) % nseg + seg0; const int b = (it >> 2) / nseg;
    const int p0 = sj * 128;
    __syncthreads();
    {
      const int q = tid >> 1, half = tid & 1;
      const int row = row_of(b, p0 + q);
      const bf16* src = P.Z + (size_t)row * DIN + ZC_AV + a * 64 + half * 32;
      float v[32];
      float ss = 0.f;
#pragma unroll
      for (int i = 0; i < 4; ++i) {
        const uint4 u = *reinterpret_cast<const uint4*>(src + i * 8);
        v[i * 8 + 0] = lo2f(u.x); v[i * 8 + 1] = hi2f(u.x); v[i * 8 + 2] = lo2f(u.y); v[i * 8 + 3] = hi2f(u.y);
        v[i * 8 + 4] = lo2f(u.z); v[i * 8 + 5] = hi2f(u.z); v[i * 8 + 6] = lo2f(u.w); v[i * 8 + 7] = hi2f(u.w);
      }
#pragma unroll
      for (int i = 0; i < 32; ++i) ss += v[i] * v[i];
      ss += __shfl_xor(ss, 1);
      const float rr = rsqrtf(ss * (1.f / 64.f) + EPS);
      const float* nw = P.a_norm_w + l * 256 + a * 64 + half * 32;
#pragma unroll
      for (int i = 0; i < 32; ++i) VNT[(half * 32 + i) * LDV + q] = f2bf(v[i] * rr * nw[i]);
    }
    __syncthreads();
    f32x16 acc[2]; acc[0] = zero16(); acc[1] = zero16();
    const bf16* Aw = P.AWS + (size_t)(l * 4 + a) * 128 * 128 + (size_t)(wave * 32 + l31) * 128;
#pragma unroll
    for (int ks = 0; ks < 8; ++ks) {
      const bf16x8 af = ldfrag(Aw + ks * 16 + hh * 8);
#pragma unroll
      for (int j = 0; j < 2; ++j) {
        const bf16x8 bfr = ldfrag(VNT + (j * 32 + l31) * LDV + ks * 16 + hh * 8);
        acc[j] = mfma32(af, bfr, acc[j]);
      }
    }
    const float* bs = P.a_b_s + (l * 4 + a) * 128;
#pragma unroll
    for (int j = 0; j < 2; ++j)
#pragma unroll
      for (int r = 0; r < 16; ++r) {
        const int p = wave * 32 + drow(r, hh);
        const int row = row_of(b, p0 + p);
        const int col = a * 64 + j * 32 + l31;
        const float u = bf2f(P.Z[(size_t)row * DIN + ZC_AU + col]);
        P.H[(size_t)row * 1024 + col] = f2bf(u * (acc[j][r] + bs[p]));
      }
  }
}

DEVI void mla_norm_rope_store(const Params& P, const float* T, const float* nw, bool rope, float oscale,
                              bf16* dstbase  , int pos0, int tlat0) {
  const int tid = TIDX, tok = tid >> 1, half = tid & 1;
  float v[48];
  float ss = 0.f;
#pragma unroll
  for (int i = 0; i < 48; ++i) { v[i] = T[tok * 97 + half * 48 + i]; ss += v[i] * v[i]; }
  ss += __shfl_xor(ss, 1);
  const float rr = rsqrtf(ss * (1.f / 96.f) + EPS);
#pragma unroll
  for (int i = 0; i < 48; ++i) v[i] = v[i] * rr * nw[half * 48 + i];
  if (rope && half == 1) {
    const float* cs = P.ROPE + (size_t)(tlat0 + tok) * 32;
#pragma unroll
    for (int a = 0; a < 2; ++a)
#pragma unroll
      for (int f = 0; f < 8; ++f) {
        const float x1 = v[16 + a * 16 + f], x2 = v[16 + a * 16 + 8 + f];
        const float c = cs[a * 8 + f], s = cs[16 + a * 8 + f];
        v[16 + a * 16 + f] = x1 * c - x2 * s;
        v[16 + a * 16 + 8 + f] = x2 * c + x1 * s;
      }
  }
  bf16* dst = dstbase + (size_t)(pos0 + tok) * 96 + half * 48;
#pragma unroll
  for (int i = 0; i < 6; ++i) {
    uint4 o;
    o.x = pack2(v[i * 8 + 0] * oscale, v[i * 8 + 1] * oscale); o.y = pack2(v[i * 8 + 2] * oscale, v[i * 8 + 3] * oscale);
    o.z = pack2(v[i * 8 + 4] * oscale, v[i * 8 + 5] * oscale); o.w = pack2(v[i * 8 + 6] * oscale, v[i * 8 + 7] * oscale);
    *reinterpret_cast<uint4*>(dst + i * 8) = o;
  }
}

DEVI void phase_mla_proj(const Params& P, int l, unsigned char* smem) {
  const int tid = TIDX, lane = tid & 63, wave = tid >> 6, l31 = lane & 31, hh = lane >> 5;
  float* T = reinterpret_cast<float*>(smem);
  float* rsq = T + 128 * 97;
  float* rskv = rsq + 128;
  const float qscale = 0.10206207261596577f * 1.4426950408889634f;
  for (int it = VBID; it < 144 * 8; it += NVB) {
    const int h = it & 7;
    const int m0 = (it >> 3) * 128;
    const bool lat = m0 < NL;
    const int b = lat ? (m0 >> 11) : ((m0 - NL) >> 8);
    const int pos0 = lat ? 256 + (m0 & 2047) : ((m0 - NL) & 255);
    const int tlat0 = lat ? (m0 & 2047) : 0;
    const bool doq = lat || (l == 0);
    const bf16* zrow = P.Z + (size_t)(m0 + wave * 32 + l31) * DIN;
    __syncthreads();
    {
      float ss = 0.f;
#pragma unroll
      for (int ks = 0; ks < 8; ++ks) {
        const bf16x8 a = ldfrag(zrow + ZC_BKV + ks * 16 + hh * 8);
#pragma unroll
        for (int j = 0; j < 8; ++j) { const float f = (float)a[j]; ss += f * f; }
      }
      ss += __shfl_xor(ss, 32);
      if (hh == 0) rskv[wave * 32 + l31] = rsqrtf(ss * (1.f / 128.f) + EPS);
      if (doq) {
        float sq = 0.f;
#pragma unroll
        for (int ks = 0; ks < 16; ++ks) {
          const bf16x8 a = ldfrag(zrow + ZC_BQ + ks * 16 + hh * 8);
#pragma unroll
          for (int j = 0; j < 8; ++j) { const float f = (float)a[j]; sq += f * f; }
        }
        sq += __shfl_xor(sq, 32);
        if (hh == 0) rsq[wave * 32 + l31] = rsqrtf(sq * (1.f / 256.f) + EPS);
      }
    }
    for (int e = tid; e < 128 * 32; e += 256) {
      const int tok = e >> 5, i = e & 31;
      T[tok * 97 + 64 + i] = bf2f(P.Z[(size_t)(m0 + tok) * DIN + ZC_BKR + i]);
    }
    __syncthreads();
    {
      const bf16* Wkv = P.WukvT + (size_t)l * 1024 * 128;
      f32x16 acc[4];
#pragma unroll
      for (int j = 0; j < 4; ++j) acc[j] = zero16();
#pragma unroll 4
      for (int ks = 0; ks < 8; ++ks) {
        const bf16x8 af = ldfrag(zrow + ZC_BKV + ks * 16 + hh * 8);
#pragma unroll
        for (int j = 0; j < 4; ++j) {
          const bf16x8 bfr = ldfrag(Wkv + (size_t)(h * 128 + j * 32 + l31) * 128 + ks * 16 + hh * 8);
          acc[j] = mfma32(af, bfr, acc[j]);
        }
      }
#pragma unroll
      for (int j = 0; j < 2; ++j)
#pragma unroll
        for (int r = 0; r < 16; ++r) {
          const int tok = wave * 32 + drow(r, hh);
          T[tok * 97 + j * 32 + l31] = acc[j][r] * rskv[tok];
        }
#pragma unroll
      for (int j = 2; j < 4; ++j) {
        const int d = (j - 2) * 32 + l31;
        bf16* dst = P.VT + ((size_t)(b * 8 + h) * 64 + d) * SEQP + pos0 + wave * 32;
#pragma unroll
        for (int rg = 0; rg < 4; ++rg) {
          const int tk = 8 * rg + 4 * hh;
          uint2 o;
          o.x = pack2(acc[j][4 * rg + 0] * rskv[wave * 32 + tk + 0], acc[j][4 * rg + 1] * rskv[wave * 32 + tk + 1]);
          o.y = pack2(acc[j][4 * rg + 2] * rskv[wave * 32 + tk + 2], acc[j][4 * rg + 3] * rskv[wave * 32 + tk + 3]);
          *reinterpret_cast<uint2*>(dst + tk) = o;
        }
      }
      __syncthreads();
      mla_norm_rope_store(P, T, P.b_kh_w + l * 96, lat, 1.f, P.K + (size_t)(b * 8 + h) * SEQP * 96, pos0, tlat0);
    }
    if (doq) {
      const bf16* Wq = P.WuqT + (size_t)l * 768 * 256;
      f32x16 acc[3];
#pragma unroll
      for (int j = 0; j < 3; ++j) acc[j] = zero16();
#pragma unroll 4
      for (int ks = 0; ks < 16; ++ks) {
        const bf16x8 af = ldfrag(zrow + ZC_BQ + ks * 16 + hh * 8);
#pragma unroll
        for (int j = 0; j < 3; ++j) {
          const bf16x8 bfr = ldfrag(Wq + (size_t)(h * 96 + j * 32 + l31) * 256 + ks * 16 + hh * 8);
          acc[j] = mfma32(af, bfr, acc[j]);
        }
      }
      __syncthreads();
#pragma unroll
      for (int j = 0; j < 3; ++j)
#pragma unroll
        for (int r = 0; r < 16; ++r) {
          const int tok = wave * 32 + drow(r, hh);
          T[tok * 97 + j * 32 + l31] = acc[j][r] * rsq[tok];
        }
      __syncthreads();
      mla_norm_rope_store(P, T, P.b_qh_w + l * 96, lat, qscale, P.Q + (size_t)(b * 8 + h) * SEQP * 96, pos0, tlat0);
    }
  }
}

DEVI void hgrn_load(const Params& P, int l, int b, int hd, int c, float* BF, float* RB, float* SEG,
                    float (&q)[16], float (&kf)[16], float (&kb)[16], float (&v)[16], bool need_kv) {
  const int tid = TIDX, t = tid >> 2, k0 = (tid & 3) * 16;
  const int row = row_of(b, c * 64 + t);
  const bf16* z = P.Z + (size_t)row * DIN + hd * 64 + k0;
  float zf[16], zb[16];
#pragma unroll
  for (int i = 0; i < 2; ++i) {
    const uint4 uq = *reinterpret_cast<const uint4*>(z + ZC_CQ + i * 8);
    const uint4 uf = *reinterpret_cast<const uint4*>(z + ZC_CFF + i * 8);
    const uint4 ub = *reinterpret_cast<const uint4*>(z + ZC_CFB + i * 8);
    q[i * 8 + 0] = lo2f(uq.x); q[i * 8 + 1] = hi2f(uq.x); q[i * 8 + 2] = lo2f(uq.y); q[i * 8 + 3] = hi2f(uq.y);
    q[i * 8 + 4] = lo2f(uq.z); q[i * 8 + 5] = hi2f(uq.z); q[i * 8 + 6] = lo2f(uq.w); q[i * 8 + 7] = hi2f(uq.w);
    zf[i * 8 + 0] = lo2f(uf.x); zf[i * 8 + 1] = hi2f(uf.x); zf[i * 8 + 2] = lo2f(uf.y); zf[i * 8 + 3] = hi2f(uf.y);
    zf[i * 8 + 4] = lo2f(uf.z); zf[i * 8 + 5] = hi2f(uf.z); zf[i * 8 + 6] = lo2f(uf.w); zf[i * 8 + 7] = hi2f(uf.w);
    zb[i * 8 + 0] = lo2f(ub.x); zb[i * 8 + 1] = hi2f(ub.x); zb[i * 8 + 2] = lo2f(ub.y); zb[i * 8 + 3] = hi2f(ub.y);
    zb[i * 8 + 4] = lo2f(ub.z); zb[i * 8 + 5] = hi2f(ub.z); zb[i * 8 + 6] = lo2f(ub.w); zb[i * 8 + 7] = hi2f(ub.w);
    if (need_kv) {
      const uint4 uv = *reinterpret_cast<const uint4*>(z + ZC_CI + i * 8);
      v[i * 8 + 0] = lo2f(uv.x); v[i * 8 + 1] = hi2f(uv.x); v[i * 8 + 2] = lo2f(uv.y); v[i * 8 + 3] = hi2f(uv.y);
      v[i * 8 + 4] = lo2f(uv.z); v[i * 8 + 5] = hi2f(uv.z); v[i * 8 + 6] = lo2f(uv.w); v[i * 8 + 7] = hi2f(uv.w);
    }
  }
#pragma unroll
  for (int i = 0; i < 16; ++i) {
    q[i] *= 0.125f;
    float lbf = 0.f;
    if (l == 1) { const int ch = hd * 64 + k0 + i; lbf = sigmoidf_(P.c_lb[512 + ch] - P.c_lb[ch]); }
    const float zz = zf[i];
    const float e = __expf(-fabsf(zz));
    const float sp = __builtin_amdgcn_rcpf(1.f + e);
    const float sig = zz >= 0.f ? sp : e * sp;
    const float nsig = zz >= 0.f ? e * sp : sp;
    const float lf = (l == 0) ? (fminf(zz, 0.f) - __logf(1.f + e)) : __logf(lbf + (1.f - lbf) * sig);
    kf[i] = (1.f - lbf) * nsig;
    BF[t * 65 + k0 + i] = lf;
  }
  __builtin_amdgcn_sched_barrier(0);
#pragma unroll
  for (int i = 0; i < 16; ++i) {
    float lbb = 0.f;
    if (l == 1) { const int ch = hd * 64 + k0 + i; lbb = sigmoidf_(P.c_lb[512 + 256 + ch] - P.c_lb[256 + ch]); }
    const float zz = zb[i];
    const float e = __expf(-fabsf(zz));
    const float sp = __builtin_amdgcn_rcpf(1.f + e);
    const float sig = zz >= 0.f ? sp : e * sp;
    const float nsig = zz >= 0.f ? e * sp : sp;
    const float lf = (l == 0) ? (fminf(zz, 0.f) - __logf(1.f + e)) : __logf(lbb + (1.f - lbb) * sig);
    kb[i] = (1.f - lbb) * nsig;
    RB[t * 65 + k0 + i] = lf;
  }
  __syncthreads();
  {
    const int k = tid & 63, seg = tid >> 6;
    float sf = 0.f, sr = 0.f;
#pragma unroll
    for (int j = 0; j < 16; ++j) { sf += BF[(seg * 16 + j) * 65 + k]; BF[(seg * 16 + j) * 65 + k] = sf; }
#pragma unroll
    for (int j = 15; j >= 0; --j) { sr += RB[(seg * 16 + j) * 65 + k]; RB[(seg * 16 + j) * 65 + k] = sr; }
    SEG[seg * 64 + k] = sf; SEG[256 + seg * 64 + k] = sr;
    __syncthreads();
    float offf = 0.f, offb = 0.f;
#pragma unroll
    for (int s2 = 0; s2 < 4; ++s2) {
      offf += (s2 < seg) ? SEG[s2 * 64 + k] : 0.f;
      offb += (s2 > seg) ? SEG[256 + s2 * 64 + k] : 0.f;
    }
#pragma unroll
    for (int j = 0; j < 16; ++j) { BF[(seg * 16 + j) * 65 + k] += offf; RB[(seg * 16 + j) * 65 + k] += offb; }
  }
  __syncthreads();
}

DEVI f32x16 lds_mm(const bf16* A, const bf16* BT, int tm, int tn, int l31, int hh) {
  f32x16 acc = zero16();
#pragma unroll
  for (int ks = 0; ks < 4; ++ks) {
    const bf16x8 a = ldfrag(A + (tm * 32 + l31) * 72 + ks * 16 + hh * 8);
    const bf16x8 b = ldfrag(BT + (tn * 32 + l31) * 72 + ks * 16 + hh * 8);
    acc = mfma32(a, b, acc);
  }
  return acc;
}

DEVI void phase_hgrn_local(const Params& P, int l, unsigned char* smem) {
  const int tid = TIDX, lane = tid & 63, wave = tid >> 6, l31 = lane & 31, hh = lane >> 5;
  const int tm = wave >> 1, tn = wave & 1;
  float* BF = reinterpret_cast<float*>(smem);
  float* RB = BF + 64 * 65;
  bf16* QF = reinterpret_cast<bf16*>(smem + 33280);
  bf16* KF = QF + 64 * 72;
  bf16* QB = KF + 64 * 72;
  bf16* KB = QB + 64 * 72;
  bf16* VTt = KB + 64 * 72;
  bf16* KHF = reinterpret_cast<bf16*>(smem);
  bf16* KHB = KHF + 64 * 72;
  bf16* ATT = KHB + 64 * 72;
  for (int it = VBID; it < 8 * 4 * 36; it += NVB) {
    const int c = it % 36, hd = (it / 36) & 3, b = it / 144;
    float q[16], kf[16], kb[16], v[16];
    __syncthreads();
    hgrn_load(P, l, b, hd, c, BF, RB, reinterpret_cast<float*>(smem + 33280), q, kf, kb, v, true);
    const int t = tid >> 2, k0 = (tid & 3) * 16;
#pragma unroll
    for (int i = 0; i < 16; ++i) VTt[(k0 + i) * 72 + t] = f2bf(v[i]);
    float bfv[16], rbv[16];
#pragma unroll
    for (int i = 0; i < 16; ++i) { bfv[i] = BF[t * 65 + k0 + i]; rbv[i] = RB[t * 65 + k0 + i]; }
    {
      const size_t go = (size_t)row_of(b, c * 64 + t) * 256 + hd * 64 + k0;
#pragma unroll
      for (int hq = 0; hq < 2; ++hq) {
        unsigned pf[4], pb[4];
#pragma unroll
        for (int i = 0; i < 8; i += 2) {
          pf[i >> 1] = pack2(q[hq * 8 + i] * __expf(bfv[hq * 8 + i]), q[hq * 8 + i + 1] * __expf(bfv[hq * 8 + i + 1]));
          pb[i >> 1] = pack2(q[hq * 8 + i] * __expf(rbv[hq * 8 + i]), q[hq * 8 + i + 1] * __expf(rbv[hq * 8 + i + 1]));
        }
        *reinterpret_cast<uint4*>(P.GQF + go + hq * 8) = make_uint4(pf[0], pf[1], pf[2], pf[3]);
        *reinterpret_cast<uint4*>(P.GQB + go + hq * 8) = make_uint4(pb[0], pb[1], pb[2], pb[3]);
      }
    }
    if (t == 0) {
      float* dec = P.DEC + ((size_t)((b * 4 + hd) * 2) * 36 + c) * 64 + k0;
#pragma unroll
      for (int i = 0; i < 16; ++i) { dec[i] = __expf(BF[63 * 65 + k0 + i]); dec[36 * 64 + i] = __expf(RB[k0 + i]); }
    }
#pragma unroll
    for (int i = 0; i < 16; i += 2) {
      const int k = k0 + i;
      const float mF0 = BF[32 * 65 + k], mF1 = BF[32 * 65 + k + 1], mB0 = RB[32 * 65 + k], mB1 = RB[32 * 65 + k + 1];
      *reinterpret_cast<unsigned*>(&QF[t * 72 + k]) = pack2(q[i] * __expf(fminf(bfv[i] - mF0, 80.f)), q[i + 1] * __expf(fminf(bfv[i + 1] - mF1, 80.f)));
      *reinterpret_cast<unsigned*>(&KF[t * 72 + k]) = pack2(kf[i] * __expf(fminf(mF0 - bfv[i], 80.f)), kf[i + 1] * __expf(fminf(mF1 - bfv[i + 1], 80.f)));
      *reinterpret_cast<unsigned*>(&QB[t * 72 + k]) = pack2(q[i] * __expf(fminf(rbv[i] - mB0, 80.f)), q[i + 1] * __expf(fminf(rbv[i + 1] - mB1, 80.f)));
      *reinterpret_cast<unsigned*>(&KB[t * 72 + k]) = pack2(kb[i] * __expf(fminf(mB0 - rbv[i], 80.f)), kb[i + 1] * __expf(fminf(mB1 - rbv[i + 1], 80.f)));
    }
#pragma unroll
    for (int i = 0; i < 16; ++i) {
      kf[i] = kf[i] * __expf(BF[63 * 65 + k0 + i] - bfv[i]);
      kb[i] = kb[i] * __expf(RB[k0 + i] - rbv[i]);
    }
    __syncthreads();
#pragma unroll
    for (int i = 0; i < 16; ++i) {
      KHF[(k0 + i) * 72 + t] = f2bf(kf[i]);
      KHB[(k0 + i) * 72 + t] = f2bf(kb[i]);
    }
    __syncthreads();
    {
      const f32x16 af = lds_mm(QF, KF, tm, tn, l31, hh);
      const f32x16 ab = lds_mm(QB, KB, tm, tn, l31, hh);
      const int s = tn * 32 + l31;
#pragma unroll
      for (int r = 0; r < 16; ++r) {
        const int tt = tm * 32 + drow(r, hh);
        float a = 0.f;
        if (s <= tt) a += af[r];
        if (s >= tt) a += ab[r];
        ATT[tt * 72 + s] = f2bf(a);
      }
    }
    {
      const f32x16 lf = lds_mm(VTt, KHF, tm, tn, l31, hh);
      const f32x16 lb = lds_mm(VTt, KHB, tm, tn, l31, hh);
      float* stf = P.ST + ((size_t)((b * 4 + hd) * 2 + 0) * 36 + c) * 4096;
      float* stb = P.ST + ((size_t)((b * 4 + hd) * 2 + 1) * 36 + c) * 4096;
#pragma unroll
      for (int r = 0; r < 16; ++r) {
        const int kk = tm * 32 + drow(r, hh), d = tn * 32 + l31;
        stf[kk * 64 + d] = lf[r];
        stb[kk * 64 + d] = lb[r];
      }
    }
    __syncthreads();
    {
      const f32x16 o = lds_mm(ATT, VTt, tm, tn, l31, hh);
#pragma unroll
      for (int r = 0; r < 16; ++r) {
        const int tt = tm * 32 + drow(r, hh), d = tn * 32 + l31;
        P.OI[(size_t)row_of(b, c * 64 + tt) * 256 + hd * 64 + d] = o[r];
      }
    }
  }
}

DEVI void hgrn_scan_item(const Params& P, int item) {
  const int tid = TIDX;
  const int chain = item >> 2, sl = item & 3;
  const int dir = chain & 1;
  const int dd = tid >> 2, k4 = sl * 16 + (tid & 3) * 4;
  float4 S = make_float4(0.f, 0.f, 0.f, 0.f);
  float* base = P.ST + (size_t)chain * 36 * 4096 + dd * 64 + k4;
  const float* dec = P.DEC + (size_t)chain * 36 * 64 + k4;
#pragma unroll 1
  for (int g = 0; g < 6; ++g) {
    float4 L[6], dc[6];
#pragma unroll
    for (int j = 0; j < 6; ++j) {
      const int step = g * 6 + j;
      const int c = dir == 0 ? step : (step < 4 ? 3 - step : 39 - step);
      L[j] = *reinterpret_cast<const float4*>(base + (size_t)c * 4096);
      dc[j] = *reinterpret_cast<const float4*>(dec + c * 64);
    }
#pragma unroll
    for (int j = 0; j < 6; ++j) {
      const int step = g * 6 + j;
      const int c = dir == 0 ? step : (step < 4 ? 3 - step : 39 - step);
      *reinterpret_cast<float4*>(base + (size_t)c * 4096) = S;
      S.x = dc[j].x * S.x + L[j].x; S.y = dc[j].y * S.y + L[j].y; S.z = dc[j].z * S.z + L[j].z; S.w = dc[j].w * S.w + L[j].w;
    }
  }
}

DEVI void phase_hgrn_final(const Params& P, int l, unsigned char* smem) {
  const int tid = TIDX, lane = tid & 63, wave = tid >> 6, l31 = lane & 31, hh = lane >> 5;
  const int tm = wave >> 1, tn = wave & 1;
  float* O = reinterpret_cast<float*>(smem);
  bf16* QF = reinterpret_cast<bf16*>(smem + 33280);
  bf16* QB = QF + 64 * 72;
  bf16* SF = QB + 64 * 72;
  bf16* SB = SF + 64 * 72;
  const int c0 = (l == 1) ? 4 : 0;
  const int nc = 36 - c0;
  for (int it = VBID; it < 8 * 4 * nc; it += NVB) {
    const int c = it % nc + c0, hd = (it / nc) & 3, b = it / (nc * 4);
    const int t = tid >> 2, k0 = (tid & 3) * 16;
    const int row = row_of(b, c * 64 + t);
    __syncthreads();
    {
      const size_t go = (size_t)row * 256 + hd * 64 + k0;
      *reinterpret_cast<uint4*>(QF + t * 72 + k0) = *reinterpret_cast<const uint4*>(P.GQF + go);
      *reinterpret_cast<uint4*>(QF + t * 72 + k0 + 8) = *reinterpret_cast<const uint4*>(P.GQF + go + 8);
      *reinterpret_cast<uint4*>(QB + t * 72 + k0) = *reinterpret_cast<const uint4*>(P.GQB + go);
      *reinterpret_cast<uint4*>(QB + t * 72 + k0 + 8) = *reinterpret_cast<const uint4*>(P.GQB + go + 8);
      const float* stf = P.ST + ((size_t)((b * 4 + hd) * 2 + 0) * 36 + c) * 4096 + t * 64 + k0;
      const float* stb = P.ST + ((size_t)((b * 4 + hd) * 2 + 1) * 36 + c) * 4096 + t * 64 + k0;
      unsigned pf[8], pb[8];
#pragma unroll
      for (int i = 0; i < 4; ++i) {
        const float4 a = *reinterpret_cast<const float4*>(stf + i * 4);
        const float4 bb = *reinterpret_cast<const float4*>(stb + i * 4);
        pf[2 * i] = pack2(a.x, a.y); pf[2 * i + 1] = pack2(a.z, a.w);
        pb[2 * i] = pack2(bb.x, bb.y); pb[2 * i + 1] = pack2(bb.z, bb.w);
      }
      *reinterpret_cast<uint4*>(SF + t * 72 + k0) = make_uint4(pf[0], pf[1], pf[2], pf[3]);
      *reinterpret_cast<uint4*>(SF + t * 72 + k0 + 8) = make_uint4(pf[4], pf[5], pf[6], pf[7]);
      *reinterpret_cast<uint4*>(SB + t * 72 + k0) = make_uint4(pb[0], pb[1], pb[2], pb[3]);
      *reinterpret_cast<uint4*>(SB + t * 72 + k0 + 8) = make_uint4(pb[4], pb[5], pb[6], pb[7]);
    }
    __syncthreads();
    {
      f32x16 o = lds_mm(QF, SF, tm, tn, l31, hh);
      const f32x16 o2 = lds_mm(QB, SB, tm, tn, l31, hh);
#pragma unroll
      for (int r = 0; r < 16; ++r) {
        const int tt = tm * 32 + drow(r, hh), d = tn * 32 + l31;
        O[tt * 65 + d] = o[r] + o2[r] + P.OI[(size_t)row_of(b, c * 64 + tt) * 256 + hd * 64 + d];
      }
    }
    __syncthreads();
    {
      float ov[16]; float ss = 0.f;
#pragma unroll
      for (int i = 0; i < 16; ++i) { ov[i] = O[t * 65 + k0 + i]; ss += ov[i] * ov[i]; }
      ss += __shfl_xor(ss, 1); ss += __shfl_xor(ss, 2);
      const float rr = rsqrtf(ss * (1.f / 64.f) + EPS);
      const bf16* g = P.Z + (size_t)row * DIN + ZC_CG + hd * 64 + k0;
      const float* nw = P.c_out_norm_w + l * 64 + k0;
      const uint4 gA = *reinterpret_cast<const uint4*>(g), gB = *reinterpret_cast<const uint4*>(g + 8);
      const unsigned gw[8] = {gA.x, gA.y, gA.z, gA.w, gB.x, gB.y, gB.z, gB.w};
      unsigned pk[8];
#pragma unroll
      for (int i = 0; i < 16; i += 2) {
        const float g0 = lo2f(gw[i >> 1]), g1 = hi2f(gw[i >> 1]);
        const float y0 = ov[i] * rr * nw[i] * (g0 * sigmoidf_(g0));
        const float y1 = ov[i + 1] * rr * nw[i + 1] * (g1 * sigmoidf_(g1));
        pk[i >> 1] = pack2(y0, y1);
      }
      uint4* dst = reinterpret_cast<uint4*>(P.H + (size_t)row * 1024 + 768 + hd * 64 + k0);
      dst[0] = make_uint4(pk[0], pk[1], pk[2], pk[3]);
      dst[1] = make_uint4(pk[4], pk[5], pk[6], pk[7]);
    }
  }
}

DEVI void attn_item8(const Params& P, int b, int h, int qpos0, int nkeys, float sref, unsigned char* smem_base) {
  const int tid = threadIdx.x, lane = tid & 63, wave = tid >> 6, l31 = lane & 31, hh = lane >> 5;
  constexpr int TK = 128, LDKS = 104, LDVS = 136;
  constexpr int KS_BYTES = TK * LDKS * 2, VS_BYTES = 64 * LDVS * 2, ST_BYTES = KS_BYTES + VS_BYTES;
  const bf16* Qg = P.Q + ((size_t)(b * 8 + h) * SEQP + qpos0 + wave * 32 + l31) * 96;
  const bf16* Kg = P.K + (size_t)(b * 8 + h) * SEQP * 96;
  const bf16* Vg = P.VT + (size_t)(b * 8 + h) * 64 * SEQP;
  bf16x8 qf[6];
#pragma unroll
  for (int ks = 0; ks < 6; ++ks) qf[ks] = ldfrag(Qg + ks * 16 + hh * 8);
  f32x16 oacc[2]; oacc[0] = zero16(); oacc[1] = zero16();
  float lsum = 0.f;
  uint4 rk[3], rv[2];
  const int ntiles = nkeys / TK;
  auto gload = [&](int kt) {
#pragma unroll
    for (int i = 0; i < 3; ++i) { const int ch = tid + i * 512, row = ch / 12, cc = ch % 12;
      rk[i] = *reinterpret_cast<const uint4*>(Kg + (size_t)(kt * TK + row) * 96 + cc * 8); }
#pragma unroll
    for (int i = 0; i < 2; ++i) { const int ch = tid + i * 512, row = ch >> 4, cc = ch & 15;
      rv[i] = *reinterpret_cast<const uint4*>(Vg + (size_t)row * SEQP + kt * TK + cc * 8); }
  };
  auto swrite = [&](int buf) {
    bf16* sK = reinterpret_cast<bf16*>(smem_base + buf * ST_BYTES);
    bf16* sV = reinterpret_cast<bf16*>(smem_base + buf * ST_BYTES + KS_BYTES);
#pragma unroll
    for (int i = 0; i < 3; ++i) { const int ch = tid + i * 512, row = ch / 12, cc = ch % 12;
      *reinterpret_cast<uint4*>(sK + row * LDKS + cc * 8) = rk[i]; }
#pragma unroll
    for (int i = 0; i < 2; ++i) { const int ch = tid + i * 512, row = ch >> 4, cc = ch & 15;
      const int g16 = cc >> 1, odd = cc & 1;
      bf16* base = sV + row * LDVS + g16 * 16;
      const int s0 = odd ? 4 : 0, s1 = odd ? 12 : 8;
      *reinterpret_cast<uint2*>(base + s0) = make_uint2(rv[i].x, rv[i].y);
      *reinterpret_cast<uint2*>(base + s1) = make_uint2(rv[i].z, rv[i].w);
    }
  };
  __syncthreads();
  gload(0); swrite(0);
  __syncthreads();
  for (int kt = 0; kt < ntiles; ++kt) {
    const int cur = kt & 1;
    if (kt + 1 < ntiles) gload(kt + 1);
    const bf16* sK = reinterpret_cast<const bf16*>(smem_base + cur * ST_BYTES);
    const bf16* sV = reinterpret_cast<const bf16*>(smem_base + cur * ST_BYTES + KS_BYTES);
#pragma unroll
    for (int kk = 0; kk < 4; ++kk) {
      f32x16 sacc;
#pragma unroll
      for (int r = 0; r < 16; ++r) sacc[r] = -sref;
#pragma unroll
      for (int ks = 0; ks < 6; ++ks) {
        const bf16x8 a = ldfrag(sK + (kk * 32 + l31) * LDKS + ks * 16 + hh * 8);
        sacc = mfma32(a, qf[ks], sacc);
      }
#pragma unroll
      for (int r = 0; r < 16; ++r) { const float p = __builtin_amdgcn_exp2f(sacc[r]); sacc[r] = p; lsum += p; }
#pragma unroll
      for (int s = 0; s < 2; ++s) {
        bf16x8 pb;
#pragma unroll
        for (int j = 0; j < 8; ++j) pb[j] = (__bf16)sacc[8 * s + j];
#pragma unroll
        for (int dt = 0; dt < 2; ++dt) {
          const bf16x8 a = ldfrag(sV + (dt * 32 + l31) * LDVS + kk * 32 + s * 16 + hh * 8);
          oacc[dt] = mfma32(a, pb, oacc[dt]);
        }
      }
    }
    if (kt + 1 < ntiles) swrite(cur ^ 1);
    __syncthreads();
  }
  lsum += __shfl_xor(lsum, 32);
  const float inv = 1.f / lsum;
  const int row = row_of(b, qpos0 + wave * 32 + l31);
  bf16* dst = P.H + (size_t)row * 1024 + 256 + h * 64;
#pragma unroll
  for (int dt = 0; dt < 2; ++dt)
#pragma unroll
    for (int rg = 0; rg < 4; ++rg) {
      const int d = dt * 32 + 8 * rg + 4 * hh;
      uint2 o;
      o.x = pack2(oacc[dt][4 * rg + 0] * inv, oacc[dt][4 * rg + 1] * inv);
      o.y = pack2(oacc[dt][4 * rg + 2] * inv, oacc[dt][4 * rg + 3] * inv);
      *reinterpret_cast<uint2*>(dst + d) = o;
    }
}

DEVI void phase_attn_scan(const Params& P, int l, unsigned char* smem_base, bool skip_scan = false) {
  if (!skip_scan)
    for (int it = NVB - 1 - VBID; it < 256; it += NVB) hgrn_scan_item(P, it);
  float sref;
  {
    const int lane = threadIdx.x & 63;
    float mq = fmaxf(fabsf(P.b_qh_w[l * 96 + lane]), lane < 32 ? fabsf(P.b_qh_w[l * 96 + 64 + lane]) : 0.f);
    float mk = fmaxf(fabsf(P.b_kh_w[l * 96 + lane]), lane < 32 ? fabsf(P.b_kh_w[l * 96 + 64 + lane]) : 0.f);
#pragma unroll
    for (int o = 32; o > 0; o >>= 1) { mq = fmaxf(mq, __shfl_xor(mq, o)); mk = fmaxf(mk, __shfl_xor(mk, o)); }
    sref = fminf(1.4426950408889634f * 9.797958971132712f * mq * mk, 60.f);
  }
  const int c = blockIdx.x, xcd = c & 7, slot = c >> 3;
  const int nrounds = (l == 0) ? 3 : 2;
  for (int r = 0; r < nrounds; ++r) {
    if (r < 2) {
      const int u = r * 32 + slot;
      const int bh = xcd * 8 + (u >> 3), qt = u & 7;
      if (slot < 32) attn_item8(P, bh >> 3, bh & 7, 256 + 256 * qt, 2304, sref, smem_base);
    } else if (c < 64) {
      attn_item8(P, c >> 3, c & 7, 0, 256, sref, smem_base);
    }
  }
}

DEVI unsigned ordkey(float s) { const unsigned u = __float_as_uint(s); return (u & 0x80000000u) ? ~u : (u | 0x80000000u); }
DEVI float keyval(unsigned k, unsigned mask) { const unsigned u = k & ~mask; return __uint_as_float((u & 0x80000000u) ? (u & 0x7fffffffu) : ~u); }
DEVI void ins16(unsigned (&lst)[16], unsigned v) {
#pragma unroll
  for (int j = 0; j < 16; ++j) { const unsigned hi = max(lst[j], v); v = min(lst[j], v); lst[j] = hi; }
}
DEVI void merge16(unsigned (&lst)[16], int xm) {
  unsigned o[16];
#pragma unroll
  for (int j = 0; j < 16; ++j) o[j] = (unsigned)__shfl_xor((int)lst[j], xm);
#pragma unroll
  for (int j = 0; j < 16; ++j) lst[j] = max(lst[j], o[15 - j]);
#pragma unroll
  for (int d = 8; d >= 1; d >>= 1)
#pragma unroll
    for (int j = 0; j < 16; ++j)
      if ((j & d) == 0) { const unsigned a = lst[j], bb = lst[j + d]; lst[j] = max(a, bb); lst[j + d] = min(a, bb); }
}

DEVI void bitonic_sort_desc16(unsigned (&v)[16]) {
#pragma unroll
  for (int k = 2; k <= 16; k <<= 1)
#pragma unroll
    for (int j = k >> 1; j > 0; j >>= 1)
#pragma unroll
      for (int i = 0; i < 16; ++i) {
        const int l = i ^ j;
        if (l > i) {
          const bool desc = ((i & k) == 0);
          const unsigned a = v[i], b = v[l];
          const unsigned mx = max(a, b), mn = min(a, b);
          v[i] = desc ? mx : mn; v[l] = desc ? mn : mx;
        }
      }
}
DEVI void bitonic_merge_desc16(unsigned (&lst)[16]) {
#pragma unroll
  for (int d = 8; d >= 1; d >>= 1)
#pragma unroll
    for (int j = 0; j < 16; ++j)
      if ((j & d) == 0) { const unsigned a = lst[j], bb = lst[j + d]; lst[j] = max(a, bb); lst[j + d] = min(a, bb); }
}
struct CandTab { int a[52]; int b[52]; };
constexpr CandTab make_cand_tab() {
  CandTab t{};
  int n = 0;
  for (int a = 0; a < 16; ++a)
    for (int b = 0; b < 16; ++b)
      if ((a + 1) * (b + 1) <= 16) { t.a[n] = a; t.b[n] = b; ++n; }
  for (; n < 52; ++n) { t.a[n] = 0; t.b[n] = 0; }
  return t;
}

DEVI void phase_route(const Params& P, int l, unsigned char* smem) {
  const int tid = TIDX, lane = tid & 63, wave = tid >> 6, l31 = lane & 31, hh = lane >> 5;
  bf16* QT = reinterpret_cast<bf16*>(smem);
  float* SC = reinterpret_cast<float*>(smem + 33792);
  const int mtiles = (l == 1) ? 256 : 288;
  for (int it = VBID; it < mtiles * 8; it += NVB) {
    const int mt = it >> 3, h = it & 7;
    __syncthreads();
    for (int e = tid; e < 64 * 32; e += 256) {
      const int r = e >> 5, cc = e & 31;
      *reinterpret_cast<uint4*>(QT + r * 264 + cc * 8) = *reinterpret_cast<const uint4*>(P.QP + (size_t)(mt * 64 + r) * 2048 + h * 256 + cc * 8);
    }
    __syncthreads();
    unsigned lst[2][16];
    const int row = tid >> 2, part = tid & 3;
#pragma unroll
    for (int p = 0; p < 2; ++p) {
      f32x16 sa[2]; sa[0] = zero16(); sa[1] = zero16();
      const bf16* keys = P.SK + ((size_t)(l * 16 + h * 2 + p) * 128 + wave * 32 + l31) * 128;
#pragma unroll
      for (int ks = 0; ks < 8; ++ks) {
        const bf16x8 bfr = ldfrag(keys + ks * 16 + hh * 8);
#pragma unroll
        for (int i = 0; i < 2; ++i) {
          const bf16x8 af = ldfrag(QT + (i * 32 + l31) * 264 + p * 128 + ks * 16 + hh * 8);
          sa[i] = mfma32(af, bfr, sa[i]);
        }
      }
      if (p == 1) __syncthreads();
#pragma unroll
      for (int i = 0; i < 2; ++i)
#pragma unroll
        for (int r = 0; r < 16; ++r) SC[(i * 32 + drow(r, hh)) * 129 + wave * 32 + l31] = sa[i][r];
      __syncthreads();
      unsigned B2[16];
#pragma unroll
      for (int i = 0; i < 16; ++i) {
        const int i0 = part * 32 + ((i + part * 8) & 31), i1 = part * 32 + ((i + 16 + part * 8) & 31);
        lst[p][i] = (ordkey(SC[row * 129 + i0]) & ~0x7fu) | (unsigned)(127 - i0);
        B2[i] = (ordkey(SC[row * 129 + i1]) & ~0x7fu) | (unsigned)(127 - i1);
      }
      bitonic_sort_desc16(lst[p]);
      bitonic_sort_desc16(B2);
#pragma unroll
      for (int j = 0; j < 16; ++j) lst[p][j] = max(lst[p][j], B2[15 - j]);
      bitonic_merge_desc16(lst[p]);
      merge16(lst[p], 1);
      merge16(lst[p], 2);
    }
    float v0[16], v1[16];
#pragma unroll
    for (int j = 0; j < 16; ++j) { v0[j] = keyval(lst[0][j], 0x7fu); v1[j] = keyval(lst[1][j], 0x7fu); }
    unsigned best[16];
    {
      constexpr CandTab CT = make_cand_tab();
#pragma unroll
      for (int c = 0; c < 13; ++c) {
        const int a0 = CT.a[4 * c + 0], a1 = CT.a[4 * c + 1], a2 = CT.a[4 * c + 2], a3 = CT.a[4 * c + 3];
        const int b0 = CT.b[4 * c + 0], b1 = CT.b[4 * c + 1], b2 = CT.b[4 * c + 2], b3 = CT.b[4 * c + 3];
        const float x = part == 0 ? v0[a0] : part == 1 ? v0[a1] : part == 2 ? v0[a2] : v0[a3];
        const float y = part == 0 ? v1[b0] : part == 1 ? v1[b1] : part == 2 ? v1[b2] : v1[b3];
        const int flat = part == 0 ? (a0 * 16 + b0) : part == 1 ? (a1 * 16 + b1) : part == 2 ? (a2 * 16 + b2) : (a3 * 16 + b3);
        const bool valid = part == 0 ? (4 * c + 0 < 50) : part == 1 ? (4 * c + 1 < 50) : part == 2 ? (4 * c + 2 < 50) : (4 * c + 3 < 50);
        const unsigned key = (ordkey(x + y) & ~0xffu) | (unsigned)(255 - flat);
        best[c] = valid ? key : 0u;
      }
      best[13] = 0u; best[14] = 0u; best[15] = 0u;
      bitonic_sort_desc16(best);
      merge16(best, 1);
      merge16(best, 2);
    }
    {
      const float mx = keyval(best[0], 0xffu);
      float es = 0.f;
      float ev[4]; int ex[4];
#pragma unroll
      for (int jj = 0; jj < 4; ++jj) {
        const unsigned kk = part == 0 ? best[4 * jj + 0] : part == 1 ? best[4 * jj + 1] : part == 2 ? best[4 * jj + 2] : best[4 * jj + 3];
        ev[jj] = __expf(keyval(kk, 0xffu) - mx);
        es += ev[jj];
        const int flat = 255 - (int)(kk & 0xffu);
        const int a = flat >> 4, bq = flat & 15;
        int i1 = 0, i2 = 0;
#pragma unroll
        for (int u = 0; u < 16; ++u) {
          i1 = (a == u) ? (127 - (int)(lst[0][u] & 0x7fu)) : i1;
          i2 = (bq == u) ? (127 - (int)(lst[1][u] & 0x7fu)) : i2;
        }
        ex[jj] = i1 * 128 + i2;
      }
      es += __shfl_xor(es, 1); es += __shfl_xor(es, 2);
      const float inv = 1.f / es;
      const int tok = mt * 64 + row;
      int* ed = P.EIDX + (size_t)tok * 128 + h * 16;
      float* gd = P.GATE + (size_t)tok * 128 + h * 16;
#pragma unroll
      for (int jj = 0; jj < 4; ++jj) { ed[4 * jj + part] = ex[jj]; gd[4 * jj + part] = ev[jj] * inv; }
    }
  }
}

DEVI float gelu_exact(float a) { return 0.5f * a * (1.f + erff(a * 0.70710678118654752f)); }

typedef float f2 __attribute__((ext_vector_type(2)));
DEVI void phase_peer(const Params& P, int l) {
  const int lane = TIDX & 63, half = lane >> 5, l32 = lane & 31;
  const int gw = VBID * 4 + (TIDX >> 6), nw = NVB * 4;
  const int nrows = (l == 1) ? NL : NT;
  const unsigned char* PU = P.PU8 + (size_t)l * 16384 * 768 + l32 * 24;
  const unsigned char* PV = P.PV8 + (size_t)l * 16384 * 768 + l32 * 24;
  const float* PUS = P.PUS + l * 16384;
  const float* PVS = P.PVS + l * 16384;
  const bool b4 = lane & 16, b3 = lane & 8, b2 = lane & 4;
  for (int t = gw; t < nrows; t += nw) {
    f2 h2[16];
    {
      const bf16* hp = P.H + (size_t)t * 1024 + l32 * 32;
#pragma unroll
      for (int i = 0; i < 4; ++i) {
        const uint4 hv = *reinterpret_cast<const uint4*>(hp + i * 8);
        h2[4 * i + 0] = (f2){lo2f(hv.x), hi2f(hv.x)}; h2[4 * i + 1] = (f2){lo2f(hv.y), hi2f(hv.y)};
        h2[4 * i + 2] = (f2){lo2f(hv.z), hi2f(hv.z)}; h2[4 * i + 3] = (f2){lo2f(hv.w), hi2f(hv.w)};
      }
    }
    const int e0 = P.EIDX[(size_t)t * 128 + lane], e1 = P.EIDX[(size_t)t * 128 + 64 + lane];
    const float g0 = P.GATE[(size_t)t * 128 + lane], g1 = P.GATE[(size_t)t * 128 + 64 + lane];
    const float su0 = PUS[e0], su1 = PUS[e1];
    const float gv0 = g0 * PVS[e0], gv1 = g1 * PVS[e1];
    f2 y2[16];
#pragma unroll
    for (int i = 0; i < 16; ++i) y2[i] = (f2){0.f, 0.f};
    for (int kb = 0; kb < 8; ++kb) {
      const int esrc = kb < 4 ? e0 : e1;
      v3u ua[8], ub[8], va[8], vb[8];
#pragma unroll
      for (int i = 0; i < 8; ++i) {
        const int e = __shfl(esrc, (kb * 16 + 2 * i + half) & 63);
        const unsigned* ur = reinterpret_cast<const unsigned*>(PU + (size_t)e * 768);
        const unsigned* vr = reinterpret_cast<const unsigned*>(PV + (size_t)e * 768);
        ua[i] = *reinterpret_cast<const v3u*>(ur); ub[i] = *reinterpret_cast<const v3u*>(ur + 3);
        va[i] = *reinterpret_cast<const v3u*>(vr); vb[i] = *reinterpret_cast<const v3u*>(vr + 3);
      }
      float d[8];
#pragma unroll
      for (int i = 0; i < 8; ++i) {
        const v32f uf = __builtin_amdgcn_cvt_scalef32_pk32_f32_fp6((v6u){ua[i][0], ua[i][1], ua[i][2], ub[i][0], ub[i][1], ub[i][2]}, 1.0f);
        f2 sacc = (f2){0.f, 0.f};
#pragma unroll
        for (int j = 0; j < 16; ++j) sacc = __builtin_elementwise_fma((f2){uf[2 * j], uf[2 * j + 1]}, h2[j], sacc);
        d[i] = sacc.x + sacc.y;
      }
      float r4[4], r2[2], r1;
#pragma unroll
      for (int i = 0; i < 4; ++i) { const float mine = b4 ? d[4 + i] : d[i]; const float send = b4 ? d[i] : d[4 + i]; r4[i] = mine + __shfl_xor(send, 16); }
#pragma unroll
      for (int i = 0; i < 2; ++i) { const float mine = b3 ? r4[2 + i] : r4[i]; const float send = b3 ? r4[i] : r4[2 + i]; r2[i] = mine + __shfl_xor(send, 8); }
      { const float mine = b2 ? r2[1] : r2[0]; const float send = b2 ? r2[0] : r2[1]; r1 = mine + __shfl_xor(send, 4); }
      r1 += __shfl_xor(r1, 2); r1 += __shfl_xor(r1, 1);
      const int ksrc = (kb * 16 + 2 * ((lane >> 2) & 7) + half) & 63;
      const float su = __shfl(kb < 4 ? su0 : su1, ksrc);
      const float gv = __shfl(kb < 4 ? gv0 : gv1, ksrc);
      const float w = gv * gelu_exact(r1 * su);
#pragma unroll
      for (int i = 0; i < 8; ++i) {
        const float wi = __shfl(w, half * 32 + i * 4);
        const f2 ww = (f2){wi, wi};
        const v32f vf = __builtin_amdgcn_cvt_scalef32_pk32_f32_fp6((v6u){va[i][0], va[i][1], va[i][2], vb[i][0], vb[i][1], vb[i][2]}, 1.0f);
#pragma unroll
        for (int j = 0; j < 16; ++j) y2[j] = __builtin_elementwise_fma(ww, (f2){vf[2 * j], vf[2 * j + 1]}, y2[j]);
      }
    }
    float y[16];
#pragma unroll
    for (int j = 0; j < 8; ++j) {
      const float ax = y2[j].x + __shfl_xor(y2[j].x, 32), ay = y2[j].y + __shfl_xor(y2[j].y, 32);
      const float bx = y2[8 + j].x + __shfl_xor(y2[8 + j].x, 32), by = y2[8 + j].y + __shfl_xor(y2[8 + j].y, 32);
      y[2 * j] = half ? bx : ax; y[2 * j + 1] = half ? by : ay;
    }
    const int bi = batch_of_row(t);
    const float* gate2 = P.MOD + (size_t)(l * 9 + bi) * 6144 + 5 * 1024;
    const int d0 = l32 * 32 + half * 16;
    float xn[16];
    float ss = 0.f;
#pragma unroll
    for (int q4 = 0; q4 < 4; ++q4) {
      const int d = d0 + q4 * 4;
      const float4 xo = *reinterpret_cast<const float4*>(P.X + (size_t)t * 1024 + d);
      const float4 gg = *reinterpret_cast<const float4*>(gate2 + d);
      float4 o;
      o.x = xo.x + gg.x * y[q4 * 4 + 0]; o.y = xo.y + gg.y * y[q4 * 4 + 1];
      o.z = xo.z + gg.z * y[q4 * 4 + 2]; o.w = xo.w + gg.w * y[q4 * 4 + 3];
      xn[q4 * 4 + 0] = o.x; xn[q4 * 4 + 1] = o.y; xn[q4 * 4 + 2] = o.z; xn[q4 * 4 + 3] = o.w;
      ss += o.x * o.x + o.y * o.y + o.z * o.z + o.w * o.w;
      if (l == 1) *reinterpret_cast<float4*>(P.out + (size_t)t * 1024 + d) = o;
      else *reinterpret_cast<float4*>(P.X + (size_t)t * 1024 + d) = o;
    }
    if (l == 0) {
      ss = wave_sum(ss);
      const float rr = rsqrtf(ss * (1.f / 1024.f) + EPS);
      const float* lnw = P.ln1_w + 1024;
      const float* mod = P.MOD + (size_t)(9 + bi) * 6144;
      unsigned pk[8];
#pragma unroll
      for (int i = 0; i < 16; i += 2) {
        const float o0 = xn[i] * rr * lnw[d0 + i] * (1.f + mod[1024 + d0 + i]) + mod[d0 + i];
        const float o1 = xn[i + 1] * rr * lnw[d0 + i + 1] * (1.f + mod[1024 + d0 + i + 1]) + mod[d0 + i + 1];
        pk[i >> 1] = pack2(o0, o1);
      }
      *reinterpret_cast<uint4*>(P.H + (size_t)t * 1024 + d0) = make_uint4(pk[0], pk[1], pk[2], pk[3]);
      *reinterpret_cast<uint4*>(P.H + (size_t)t * 1024 + d0 + 8) = make_uint4(pk[4], pk[5], pk[6], pk[7]);
    }
  }
}

using f32x4 = __attribute__((ext_vector_type(4))) float;
namespace g8 {
constexpr int BM = 256, BK = 64, HALF = 128, HT = HALF * BK;
DEVI int lds_byte(int r, int c) { const int st = (r >> 4) * 2 + (c >> 5), rr = r & 15, cc = c & 31, ob = rr * 64 + cc * 2; return st * 1024 + (ob ^ (((ob >> 9) & 1) << 5)); }
DEVI void stage_rc(int b, int& R, int& C) { const int st = b / 1024, sb = b % 1024, swz = sb ^ (((sb >> 9) & 1) << 5); R = (st >> 1) * 16 + swz / 64; C = (st & 1) * 32 + (swz % 64) / 2; }
DEVI void unit_of(int L, int nM, int nN, int& pm, int& pn) {
  const int nwg = nM * nN;
  int wgid = L;
  { const int q = nwg / 8, r = nwg % 8, xcd = wgid % 8, off = wgid / 8; wgid = (xcd < r ? xcd * (q + 1) : r * (q + 1) + (xcd - r) * q) + off; }
  const int nig = 8 * nN, gid = wgid / nig, fm = gid * 8, gsz = (nM - fm) < 8 ? (nM - fm) : 8;
  pm = fm + ((wgid % nig) % gsz); pn = (wgid % nig) / gsz;
}
}

struct G8Unit { int pm, pn; };
template <class Epi>
DEVI void gemm8_phase(LAS unsigned char* lds, const bf16* __restrict__ Ag, const bf16* __restrict__ Btg, const int K, const int nM, const int nN, const Epi& E) {
  constexpr int BK = 64, HALF = 128, HTB = HALF * BK * 2;
  const int tid = threadIdx.x, wid = __builtin_amdgcn_readfirstlane(tid >> 6), lane = tid & 63, wr = wid >> 2, wc = wid & 3, fr = lane & 15, fq = lane >> 4;
  const int nt = K / BK;
  const int nunits = nM * nN, G = gridDim.x, c = blockIdx.x;
  unsigned voffA[2];
#pragma unroll
  for (int i = 0; i < 2; ++i) { int R, C; g8::stage_rc(tid * 16 + i * 8192, R, C); voffA[i] = (unsigned)(R * K + C) * 2u; }
  const size_t kstep = (size_t)(BK * 2);
  const size_t hstep = (size_t)HALF * K * 2;
  const size_t tstep = 2 * hstep;
  const unsigned ldsw = (unsigned)wid * 1024u;
  const int aoff = g8::lds_byte(wr * 64 + fr, fq * 8), boff = g8::lds_byte(wc * 32 + fr, fq * 8);
#define PG8_SA(b, h) (((b) * 2 + (h)) * HTB)
#define PG8_SB(b, h) ((4 + (b) * 2 + (h)) * HTB)
#define PG8_STAGE(bufoff, gbase, voff) do { _Pragma("unroll") for (int _i = 0; _i < 2; ++_i) \
        __builtin_amdgcn_global_load_lds((const unsigned*)((const char*)(gbase) + (voff)[_i]), (LAS unsigned*)(lds + (bufoff) + ldsw + _i * 8192), 16, 0, 0); } while (0)
#define PG8_LDA(dst, b, h) do { _Pragma("unroll") for (int m = 0; m < 4; ++m) _Pragma("unroll") for (int k = 0; k < 2; ++k) dst[m][k] = *(const LAS bf16x8*)(lds + PG8_SA(b, h) + aoff + m * 2048 + k * 1024); } while (0)
#define PG8_LDB(dst, b, h) do { _Pragma("unroll") for (int n = 0; n < 2; ++n) _Pragma("unroll") for (int k = 0; k < 2; ++k) dst[n][k] = *(const LAS bf16x8*)(lds + PG8_SB(b, h) + boff + n * 2048 + k * 1024); } while (0)
#define PG8_MMA(ai, bj, At_, Bt_) do { __builtin_amdgcn_s_setprio(1); _Pragma("unroll") for (int m = 0; m < 4; ++m) _Pragma("unroll") for (int n = 0; n < 2; ++n) _Pragma("unroll") for (int k = 0; k < 2; ++k) \
        acc[ai][bj][m][n] = __builtin_amdgcn_mfma_f32_16x16x32_bf16(Bt_[n][k], At_[m][k], acc[ai][bj][m][n], 0, 0, 0); __builtin_amdgcn_s_setprio(0); } while (0)
#define PG8_WAIT_V(n) asm volatile("s_waitcnt vmcnt(" #n ")" ::: "memory")
#define PG8_WAIT_L(n) asm volatile("s_waitcnt lgkmcnt(" #n ")" ::: "memory")
#define PG8_BAR __builtin_amdgcn_s_barrier()
#define PG8_SCHED __builtin_amdgcn_sched_barrier(0)
  G8Unit cur, nxt; int ui = 0;
  if (c >= nunits) return;
  g8::unit_of(c, nM, nN, cur.pm, cur.pn);
  f32x4 acc[2][2][4][2];
#pragma unroll
  for (int a = 0; a < 2; ++a)
#pragma unroll
    for (int b = 0; b < 2; ++b)
#pragma unroll
      for (int m = 0; m < 4; ++m)
#pragma unroll
        for (int n = 0; n < 2; ++n) acc[a][b][m][n] = (f32x4){0.f, 0.f, 0.f, 0.f};
  bf16x8 At[4][2], B0[2][2], B1[2][2];
  const char* cA = (const char*)Ag + (size_t)cur.pm * tstep; const char* cB = (const char*)Btg + (size_t)cur.pn * tstep;
  PG8_STAGE(PG8_SB(0, 0), cB, voffA); PG8_STAGE(PG8_SA(0, 0), cA, voffA); PG8_STAGE(PG8_SB(0, 1), cB + hstep, voffA); PG8_STAGE(PG8_SA(0, 1), cA + hstep, voffA);
  if (wr == 1) PG8_BAR;
  PG8_WAIT_V(4); PG8_BAR;
  PG8_STAGE(PG8_SB(1, 0), cB + kstep, voffA); PG8_STAGE(PG8_SA(1, 0), cA + kstep, voffA); PG8_STAGE(PG8_SB(1, 1), cB + hstep + kstep, voffA);
  PG8_WAIT_V(6); PG8_BAR;
  for (;;) {
    const long Ln = (long)(ui + 1) * G + c;
    const bool has_next = Ln < nunits;
    if (has_next) g8::unit_of((int)Ln, nM, nN, nxt.pm, nxt.pn);
    const char* nA = has_next ? (const char*)Ag + (size_t)nxt.pm * tstep : cA; const char* nB = has_next ? (const char*)Btg + (size_t)nxt.pn * tstep : cB;
    for (int t = 0; t < nt; t += 2) {
      const bool last = (t == nt - 2);
      const char* a1 = cA + (size_t)(t + 1) * kstep;
      const char* a2 = last ? nA : cA + (size_t)(t + 2) * kstep; const char* b2 = last ? nB : cB + (size_t)(t + 2) * kstep;
      const char* a3 = a2 + kstep; const char* b3 = b2 + kstep;
      PG8_LDB(B0, 0, 0); PG8_SCHED; PG8_LDA(At, 0, 0); PG8_STAGE(PG8_SA(1, 1), a1 + hstep, voffA);
      PG8_WAIT_L(8); PG8_BAR; PG8_WAIT_L(0); PG8_MMA(0, 0, At, B0); PG8_BAR; PG8_SCHED;
      PG8_LDB(B1, 0, 1); PG8_STAGE(PG8_SB(0, 0), b2, voffA);
      PG8_BAR; PG8_WAIT_L(0); PG8_MMA(0, 1, At, B1); PG8_BAR;
      PG8_LDA(At, 0, 1); PG8_STAGE(PG8_SA(0, 0), a2, voffA);
      PG8_BAR; PG8_WAIT_L(0); PG8_MMA(1, 0, At, B0); PG8_BAR; PG8_SCHED;
      PG8_STAGE(PG8_SB(0, 1), b2 + hstep, voffA);
      PG8_WAIT_V(6); PG8_BAR; PG8_MMA(1, 1, At, B1); PG8_BAR;
      PG8_LDB(B0, 1, 0); PG8_SCHED; PG8_LDA(At, 1, 0); PG8_STAGE(PG8_SA(0, 1), a2 + hstep, voffA);
      PG8_WAIT_L(8); PG8_BAR; PG8_WAIT_L(0); PG8_MMA(0, 0, At, B0); PG8_BAR; PG8_SCHED;
      PG8_LDB(B1, 1, 1); PG8_STAGE(PG8_SB(1, 0), b3, voffA);
      PG8_BAR; PG8_WAIT_L(0); PG8_MMA(0, 1, At, B1); PG8_BAR;
      PG8_LDA(At, 1, 1); PG8_STAGE(PG8_SA(1, 0), a3, voffA);
      PG8_BAR; PG8_WAIT_L(0); PG8_MMA(1, 0, At, B0); PG8_BAR; PG8_SCHED;
      PG8_STAGE(PG8_SB(1, 1), b3 + hstep, voffA);
      PG8_WAIT_V(6); PG8_BAR; PG8_MMA(1, 1, At, B1); PG8_BAR;
    }
    E(acc, cur, wr, wc, fr, fq);
    if (!has_next) break;
#pragma unroll
    for (int a = 0; a < 2; ++a)
#pragma unroll
      for (int b = 0; b < 2; ++b)
#pragma unroll
        for (int m = 0; m < 4; ++m)
#pragma unroll
          for (int n = 0; n < 2; ++n) acc[a][b][m][n] = (f32x4){0.f, 0.f, 0.f, 0.f};
    cur = nxt; cA = nA; cB = nB; ++ui;
  }
  PG8_WAIT_V(0);
  if (wr == 0) PG8_BAR;
  PG8_BAR;
#undef PG8_SA
#undef PG8_SB
#undef PG8_STAGE
#undef PG8_LDA
#undef PG8_LDB
#undef PG8_MMA
}

struct EpiZ {
  bf16* Z;
  DEVI void operator()(const f32x4 (&acc)[2][2][4][2], const G8Unit& u, int wr, int wc, int fr, int fq) const {
    const int brow = u.pm * 256, bcol = u.pn * 256;
#pragma unroll
    for (int ai = 0; ai < 2; ++ai)
#pragma unroll
      for (int m = 0; m < 4; ++m) {
        const int row = brow + ai * 128 + wr * 64 + m * 16 + fr;
#pragma unroll
        for (int bj = 0; bj < 2; ++bj)
#pragma unroll
          for (int n = 0; n < 2; ++n) {
            const int col = bcol + bj * 128 + wc * 32 + n * 16 + 4 * fq;
            if (col < DIN) {
              const f32x4 v = acc[ai][bj][m][n];
              *reinterpret_cast<uint2*>(Z + (size_t)row * DIN + col) = make_uint2(pack2(v[0], v[1]), pack2(v[2], v[3]));
            }
          }
      }
  }
};
DEVI void phase_gemm1_8(const Params& P, int l, unsigned char* smem_base) {
  EpiZ E{P.Z};
  gemm8_phase((LAS unsigned char*)smem_base, P.H, P.WinT + (size_t)l * DINP * 1024, 1024, NT / 256, DINP / 256, E);
  const int c = blockIdx.x;
  if (c >= 136) {
    const int j = c - 136;
    if (l == 0) convert_rows_fp6(P, 0, j * 100, j * 100 + 100);
    else { const int b0 = 19200 + j * 114; convert_rows_fp6(P, 1, b0 < 32768 ? b0 : 32768, b0 + 114 < 32768 ? b0 + 114 : 32768); }
  }
}

struct EpiX {
  const float* x; const float* ctx; float* X; const float* MODl; int l;
  DEVI void operator()(const f32x4 (&acc)[2][2][4][2], const G8Unit& u, int wr, int wc, int fr, int fq) const {
    const int brow = u.pm * 256, bcol = u.pn * 256;
    const float* gate = MODl + (size_t)batch_of_row(brow) * 6144 + 2048;
#pragma unroll
    for (int ai = 0; ai < 2; ++ai)
#pragma unroll
      for (int m = 0; m < 4; ++m) {
        const int row = brow + ai * 128 + wr * 64 + m * 16 + fr;
        const float* res = (l == 0) ? (row < NL ? x + (size_t)row * 1024 : ctx + (size_t)(row - NL) * 1024) : X + (size_t)row * 1024;
#pragma unroll
        for (int bj = 0; bj < 2; ++bj)
#pragma unroll
          for (int n = 0; n < 2; ++n) {
            const int col = bcol + bj * 128 + wc * 32 + n * 16 + 4 * fq;
            const f32x4 v = acc[ai][bj][m][n];
            const float4 r4 = *reinterpret_cast<const float4*>(res + col);
            const float4 g4 = *reinterpret_cast<const float4*>(gate + col);
            float4 o; o.x = r4.x + g4.x * v[0]; o.y = r4.y + g4.y * v[1]; o.z = r4.z + g4.z * v[2]; o.w = r4.w + g4.w * v[3];
            *reinterpret_cast<float4*>(X + (size_t)row * 1024 + col) = o;
          }
      }
  }
};
DEVI void phase_gemm2_8(const Params& P, int l, unsigned char* smem_base) {
  EpiX E{P.x, P.ctx, P.X, P.MOD + (size_t)l * 9 * 6144, l};
  gemm8_phase((LAS unsigned char*)smem_base, P.H, P.WoutT + (size_t)l * 1024 * 1024, 1024, (l == 1) ? NL / 256 : NT / 256, 4, E);
  const int c = blockIdx.x;
  if (l == 0 && c >= 32) {
    const int b0 = 12000 + (c - 32) * 93;
    convert_rows_fp6(P, 0, b0 < 32768 ? b0 : 32768, b0 + 93 < 32768 ? b0 + 93 : 32768);
  }
}

struct EpiQP {
  bf16* QP;
  DEVI void operator()(const f32x4 (&acc)[2][2][4][2], const G8Unit& u, int wr, int wc, int fr, int fq) const {
    const int brow = u.pm * 256, bcol = u.pn * 256;
#pragma unroll
    for (int ai = 0; ai < 2; ++ai)
#pragma unroll
      for (int m = 0; m < 4; ++m) {
        const int row = brow + ai * 128 + wr * 64 + m * 16 + fr;
#pragma unroll
        for (int bj = 0; bj < 2; ++bj)
#pragma unroll
          for (int n = 0; n < 2; ++n) {
            const int col = bcol + bj * 128 + wc * 32 + n * 16 + 4 * fq;
            const f32x4 v = acc[ai][bj][m][n];
            *reinterpret_cast<uint2*>(QP + (size_t)row * 2048 + col) = make_uint2(pack2(v[0], v[1]), pack2(v[2], v[3]));
          }
      }
  }
};
DEVI void phase_gemm3_8(const Params& P, int l, unsigned char* smem_base) {
  EpiQP E{P.QP};
  gemm8_phase((LAS unsigned char*)smem_base, P.H, P.WpqT + (size_t)l * 2048 * 1024, 1024, (l == 1) ? NL / 256 : NT / 256, 8, E);
  const int c = blockIdx.x;
  if (l == 0 && c >= 64) convert_rows_fp6(P, 1, (c - 64) * 100, (c - 64) * 100 + 100);
}

constexpr int N_PHASES = 2 + 2 * 9;

#ifndef REP_MASK
#define REP_MASK 0
#endif
static_assert(sizeof(Params) % 8 == 0, "Params size");
DEVI Params load_params() {
#if defined(__HIP_DEVICE_COMPILE__)
  typedef const __attribute__((address_space(4))) Params* ParamsCP;
  ParamsCP pp = (ParamsCP)__builtin_amdgcn_kernarg_segment_ptr();
  asm volatile("" : "+s"(pp));
  return *pp;
#else
  return Params{};
#endif
}
__global__ void __launch_bounds__(512, 2) fwd_kernel(Params Pk) {
  extern __shared__ __attribute__((aligned(16))) unsigned char smem_base[];
  volatile LAS unsigned* xst = (volatile LAS unsigned*)(smem_base + SMEM_BYTES);
  if (threadIdx.x == 0) { xst[0] = 0u; xst[1] = 0u; xst[2] = 0u; xst[3] = 0u; }
  __syncthreads();
  XcdBarrier xb = xcd_barrier_post(Pk.bar, xst);
  const int phase_lo = Pk.phase_lo, phase_hi = Pk.phase_hi, coop = Pk.coop;
#define smem (smem_base + VHALF * HALF_LDS)
#define GSYNC(idx) { xcd_barrier(xb); }
#define RUN_PHASE2(idx, call, repcall) \
  if (phase_lo <= (idx) && (idx) <= phase_hi) { { const Params P = load_params(); call; } if (REP_MASK & (1 << (idx))) { GSYNC(1); const Params P = load_params(); repcall; } if (coop && (idx) < phase_hi) GSYNC(idx); }
#define RUN_PHASE(idx, call) RUN_PHASE2(idx, call, call)
  RUN_PHASE(0, phase_prologue(P, smem))
  RUN_PHASE(1, phase_norm(P, 0, 0, NT))
  RUN_PHASE(2, phase_gemm1_8(P, 0, smem_base))
  RUN_PHASE(3, { phase_mixA(P, 0, smem); phase_mla_proj(P, 0, smem); phase_hgrn_local(P, 0, smem); })
  RUN_PHASE2(4, phase_attn_scan(P, 0, smem_base), phase_attn_scan(P, 0, smem_base, true))
  RUN_PHASE(5, phase_hgrn_final(P, 0, smem))
  RUN_PHASE(6, phase_gemm2_8(P, 0, smem_base))
  RUN_PHASE(7, phase_norm(P, 0, 1, NT))
  RUN_PHASE(8, phase_gemm3_8(P, 0, smem_base))
  RUN_PHASE(9, phase_route(P, 0, smem))
  RUN_PHASE(10, phase_peer(P, 0))
  RUN_PHASE(11, phase_gemm1_8(P, 1, smem_base))
  RUN_PHASE(12, { phase_mixA(P, 1, smem); phase_mla_proj(P, 1, smem); phase_hgrn_local(P, 1, smem); })
  RUN_PHASE2(13, phase_attn_scan(P, 1, smem_base), phase_attn_scan(P, 1, smem_base, true))
  RUN_PHASE(14, phase_hgrn_final(P, 1, smem))
  RUN_PHASE(15, phase_gemm2_8(P, 1, smem_base))
  RUN_PHASE(16, phase_norm(P, 1, 1, NL))
  RUN_PHASE(17, phase_gemm3_8(P, 1, smem_base))
  RUN_PHASE(18, phase_route(P, 1, smem))
  RUN_PHASE(19, phase_peer(P, 1))
#undef smem
}

extern "C" void kernel_launch(void* const* d_in, const int* in_sizes, int n_in, void* d_out, int out_size, void* d_ws,
                              size_t ws_size, hipStream_t stream) {
  Params p{};
  const float* const* in = reinterpret_cast<const float* const*>(d_in);
  p.x = in[0]; p.c = in[1]; p.ctx = in[2]; p.c_ctx = in[3]; p.ln1_w = in[4]; p.ln2_w = in[5]; p.w_mod = in[6]; p.b_mod = in[7];
  p.w_in = in[8]; p.w_out = in[9]; p.a_norm_w = in[10]; p.a_w_s = in[11]; p.a_b_s = in[12]; p.b_q_norm_w = in[13]; p.b_w_uq = in[14];
  p.b_kv_norm_w = in[15]; p.b_w_ukv = in[16]; p.b_qh_w = in[17]; p.b_kh_w = in[18]; p.c_lb = in[19]; p.c_out_norm_w = in[20];
  p.p_w_q = in[21]; p.p_sub_keys = in[22]; p.p_u = in[23]; p.p_v = in[24];
  p.out = reinterpret_cast<float*>(d_out);
  unsigned char* ws = reinterpret_cast<unsigned char*>(d_ws);
  size_t off = 0;
  auto take = [&](size_t bytes) { unsigned char* r = ws + off; off += (bytes + 255) & ~(size_t)255; return r; };
  p.bar = (unsigned*)take((size_t)XCD_BAR_WORDS * 4);
  p.MOD = (float*)take((size_t)2 * 9 * 6144 * 4);
  p.ROPE = (float*)take((size_t)2048 * 32 * 4);
  p.WinT = (bf16*)take((size_t)2 * DINP * 1024 * 2);
  p.WoutT = (bf16*)take((size_t)2 * 1024 * 1024 * 2);
  p.WpqT = (bf16*)take((size_t)2 * 2048 * 1024 * 2);
  p.WuqT = (bf16*)take((size_t)2 * 768 * 256 * 2);
  p.WukvT = (bf16*)take((size_t)2 * 1024 * 128 * 2);
  p.SK = (bf16*)take((size_t)2 * 16 * 128 * 128 * 2);
  p.AWS = (bf16*)take((size_t)2 * 4 * 128 * 128 * 2);
  p.PU8 = (unsigned char*)take((size_t)2 * 16384 * 768);
  p.PV8 = (unsigned char*)take((size_t)2 * 16384 * 768);
  p.PUS = (float*)take((size_t)2 * 16384 * 4);
  p.PVS = (float*)take((size_t)2 * 16384 * 4);
  p.X = (float*)take((size_t)NT * 1024 * 4);
  p.H = (bf16*)take((size_t)NT * 1024 * 2);
  p.Z = (bf16*)take((size_t)NT * DIN * 2);
  p.Q = (bf16*)take((size_t)64 * SEQP * 96 * 2);
  p.K = (bf16*)take((size_t)64 * SEQP * 96 * 2);
  p.VT = (bf16*)take((size_t)64 * 64 * SEQP * 2);
  p.ST = (float*)take((size_t)64 * 36 * 4096 * 4);
  p.DEC = (float*)take((size_t)64 * 36 * 64 * 4);
  p.OI = (float*)take((size_t)NT * 256 * 4);
  p.GQF = (bf16*)take((size_t)NT * 256 * 2);
  p.GQB = (bf16*)take((size_t)NT * 256 * 2);
  p.QP = p.Z;
  p.EIDX = (int*)p.Q;
  p.GATE = (float*)p.K;
  if (off > ws_size) { fprintf(stderr, "workspace too small: need %zu have %zu\n", off, ws_size); }
  static int grid_blocks = 0;
  if (!grid_blocks) {
    if (hipFuncSetAttribute((const void*)fwd_kernel, hipFuncAttributeMaxDynamicSharedMemorySize, SMEM_TOTAL) != hipSuccess)
      fprintf(stderr, "hipFuncSetAttribute failed\n");
    int dev = 0, cus = 0, per_cu = 0;
    hipGetDevice(&dev);
    hipDeviceGetAttribute(&cus, hipDeviceAttributeMultiprocessorCount, dev);
    hipOccupancyMaxActiveBlocksPerMultiprocessor(&per_cu, (const void*)fwd_kernel, 512, SMEM_TOTAL);
    if (per_cu > 1) per_cu = 1;
    if (per_cu < 1) { fprintf(stderr, "occupancy query returned %d\n", per_cu); per_cu = 1; }
    grid_blocks = cus * per_cu;
    fprintf(stderr, "grid_blocks=%d (cus=%d per_cu=%d) ws need=%zu have=%zu\n", grid_blocks, cus, per_cu, off, ws_size);
  }
  hipMemsetAsync(p.bar, 0, (size_t)XCD_BAR_WORDS * 4, stream);
  p.coop = 1; p.phase_lo = 0; p.phase_hi = N_PHASES - 1;
  hipLaunchKernelGGL(fwd_kernel, dim3(grid_blocks), dim3(512), SMEM_TOTAL, stream, p);
  const hipError_t e = hipPeekAtLastError();
  if (e != hipSuccess) fprintf(stderr, "launch failed: %s (grid %d)\n", hipGetErrorString(e), grid_blocks);
}
```

```cpp
#include <hip/hip_runtime.h>
#include <hip/hip_cooperative_groups.h>
#include <cstdio>
#include <cstdint>
namespace cg = cooperative_groups;

#define DEVI __device__ __forceinline__

typedef unsigned short bf16;
using bf16x8 = __attribute__((ext_vector_type(8))) __bf16;
using bf16x2 = __attribute__((ext_vector_type(2))) __bf16;
using f32x16 = __attribute__((ext_vector_type(16))) float;
typedef unsigned v6u __attribute__((ext_vector_type(6)));
typedef unsigned v3u __attribute__((ext_vector_type(3)));
typedef float v16f __attribute__((ext_vector_type(16)));
typedef float v32f __attribute__((ext_vector_type(32)));

constexpr int NL = 16384;
constexpr int NT = 18432;
constexpr int DM = 1024;
constexpr int DIN = 2208;
constexpr int DINP = 2304;
constexpr int SEQP = 2304;
constexpr float EPS = 1e-6f;
constexpr int ZC_AU = 0, ZC_AV = 256, ZC_BQ = 512, ZC_BKV = 768, ZC_BKR = 896, ZC_CQ = 928, ZC_CFF = 1184, ZC_CFB = 1440, ZC_CI = 1696, ZC_CG = 1952;
constexpr int SMEM_BYTES = 2 * 80896;
constexpr int SMEM_TOTAL = SMEM_BYTES + 16;

struct Params {
  const float *x, *c, *ctx, *c_ctx, *ln1_w, *ln2_w, *w_mod, *b_mod, *w_in, *w_out, *a_norm_w, *a_w_s, *a_b_s;
  const float *b_q_norm_w, *b_w_uq, *b_kv_norm_w, *b_w_ukv, *b_qh_w, *b_kh_w, *c_lb, *c_out_norm_w, *p_w_q, *p_sub_keys, *p_u, *p_v;
  float* out;
  unsigned* bar;
  float* MOD;
  float* ROPE;
  bf16* WinT;
  bf16* WoutT;
  bf16* WpqT;
  bf16* WuqT;
  bf16* WukvT;
  bf16* SK;
  bf16* AWS;
  unsigned char* PU8;
  unsigned char* PV8;
  float* PUS;
  float* PVS;
  float* X;
  bf16* H;
  bf16* Z;
  bf16* Q;
  bf16* K;
  bf16* VT;
  float* ST;
  float* DEC;
  float* OI;
  bf16* GQF;
  bf16* GQB;
  bf16* QP;
  int* EIDX;
  float* GATE;
  int phase_lo, phase_hi, coop, pad0;
};

DEVI float bf2f(bf16 v) { return __uint_as_float(((unsigned)v) << 16); }
DEVI bf16 f2bf(float a) { __bf16 v = (__bf16)a; return __builtin_bit_cast(unsigned short, v); }
DEVI unsigned pack2(float a, float b) { bf16x2 v; v[0] = (__bf16)a; v[1] = (__bf16)b; return __builtin_bit_cast(unsigned, v); }
DEVI float lo2f(unsigned u) { return __uint_as_float(u << 16); }
DEVI float hi2f(unsigned u) { return __uint_as_float(u & 0xffff0000u); }
DEVI f32x16 zero16() { f32x16 z;
#pragma unroll
  for (int i = 0; i < 16; ++i) z[i] = 0.f; return z; }
DEVI f32x16 mfma32(bf16x8 a, bf16x8 b, f32x16 c) { return __builtin_amdgcn_mfma_f32_32x32x16_bf16(a, b, c, 0, 0, 0); }
DEVI bf16x8 ldfrag(const bf16* p) { return *reinterpret_cast<const bf16x8*>(p); }
DEVI int drow(int r, int hh) { return (r & 3) + 8 * (r >> 2) + 4 * hh; }
DEVI int row_of(int b, int p) { return p < 256 ? NL + b * 256 + p : b * 2048 + (p - 256); }
DEVI int batch_of_row(int r) { return r < NL ? (r >> 11) : 8; }
DEVI float wave_sum(float v) {
#pragma unroll
  for (int o = 32; o > 0; o >>= 1) v += __shfl_xor(v, o);
  return v;
}
DEVI float sigmoidf_(float z) { return 1.f / (1.f + __expf(-z)); }


#define XB_TMO      128
#define XB_XCNT(j)  (256  + 64 * (j))
#define XB_XSUB(j)  (1280 + 64 * (j))
#define XB_XGEN(j)  (2304 + 64 * (j))
#define XB_TOP      3328
#define XB_TOPGEN   3392
#define XCD_BAR_WORDS 3456
#define XB_SPIN_CAP (1u << 22)
#define LAS __attribute__((address_space(3)))
DEVI unsigned xb_ld(unsigned* p)              { return __hip_atomic_load(p, __ATOMIC_RELAXED, __HIP_MEMORY_SCOPE_AGENT); }
DEVI unsigned xb_add(unsigned* p, unsigned v) { return __hip_atomic_fetch_add(p, v, __ATOMIC_RELAXED, __HIP_MEMORY_SCOPE_AGENT); }
DEVI unsigned xb_xcc_id() { return (unsigned)__builtin_amdgcn_s_getreg((3 << 11) | 20) & 0xFu; }
#define XB_SPIN(cond, bar) do { unsigned _sp = 0; while (cond) { __builtin_amdgcn_s_sleep(1); \
    if ((++_sp & 255u) == 0u) { if (xb_ld(&(bar)[XB_TMO])) break; if (_sp > XB_SPIN_CAP) { atomicAdd(&(bar)[XB_TMO], 1u); break; } } } } while (0)
struct XcdBarrier { unsigned* bar; unsigned x; volatile LAS unsigned* st; };
DEVI XcdBarrier xcd_barrier_post(unsigned* bar, volatile LAS unsigned* st) {
  XcdBarrier b; b.bar = bar; b.x = xb_xcc_id(); b.st = st;
  if (threadIdx.x == 0) (void)xb_add(&bar[XB_XCNT(b.x)], 1u);
  return b;
}
DEVI void xcd_barrier_complete(unsigned* bar, unsigned x, unsigned& nloc, unsigned& nx) {
  const unsigned G = gridDim.x * gridDim.y * gridDim.z;
  unsigned sum, cnt, mine, sp = 0u;
  for (;;) {
    sum = 0u; cnt = 0u; mine = 0u;
#pragma unroll
    for (unsigned j = 0; j < 16; ++j) { const unsigned c = xb_ld(&bar[XB_XCNT(j)]); sum += c; cnt += (c > 0u) ? 1u : 0u; mine = (j == x) ? c : mine; }
    if (sum == G) break;
    __builtin_amdgcn_s_sleep(1);
    if ((++sp & 255u) == 0u) { if (xb_ld(&bar[XB_TMO])) break; if (sp > XB_SPIN_CAP) { atomicAdd(&bar[XB_TMO], 1u); break; } }
  }
  nloc = mine > 0u ? mine : 1u; nx = cnt > 0u ? cnt : 1u;
}
DEVI void xcd_barrier(const XcdBarrier& b) {
  asm volatile("s_waitcnt vmcnt(0)" ::: "memory");
  __syncthreads();
  if (threadIdx.x == 0) {
    unsigned* bar = b.bar;
    __builtin_amdgcn_s_waitcnt(0);
    unsigned nloc = b.st[0], nx = b.st[1];
    if (nloc == 0u) { xcd_barrier_complete(bar, b.x, nloc, nx); b.st[0] = nloc; b.st[1] = nx; }
    const unsigned old = xb_add(&bar[XB_XSUB(b.x)], 1u);
    const unsigned gen = old / nloc;
    if (old + 1u == (gen + 1u) * nloc) {
      __builtin_amdgcn_fence(__ATOMIC_RELEASE, "agent");
      asm volatile("s_waitcnt vmcnt(0)" ::: "memory");
      const unsigned og = xb_add(&bar[XB_TOP], 1u);
      const unsigned tg = og / nx;
      if (og + 1u == (tg + 1u) * nx) xb_add(&bar[XB_TOPGEN], 1u);
      else XB_SPIN(xb_ld(&bar[XB_TOPGEN]) == tg, bar);
      __builtin_amdgcn_fence(__ATOMIC_ACQUIRE, "agent");
      xb_add(&bar[XB_XGEN(b.x)], 1u);
      asm volatile("s_waitcnt vmcnt(0)" ::: "memory");
    } else {
      XB_SPIN(xb_ld(&bar[XB_XGEN(b.x)]) == gen, bar);
      __builtin_amdgcn_fence(__ATOMIC_ACQUIRE, "agent");
      asm volatile("s_waitcnt vmcnt(0)" ::: "memory");
    }
  }
  __syncthreads();
}

#define VHALF ((int)__builtin_amdgcn_readfirstlane((int)(threadIdx.x >> 8)))
#define TIDX ((int)(threadIdx.x & 255))
#define VBID ((int)(blockIdx.x * 2 + VHALF))
#define NVB ((int)(gridDim.x * 2))
constexpr int HALF_LDS = 80896;

DEVI void phase_mod(const Params& P, unsigned char* smem) {
  const int tid = TIDX;
  float* s = (float*)smem;
  float* red = s + 9 * 1024;
  for (int item = VBID; item < 192; item += NVB) {
    const int l = item / 96, j = item % 96;
    __syncthreads();
    for (int i = tid; i < 9 * 1024; i += 256) {
      int bi = i >> 10, k = i & 1023;
      float v = bi < 8 ? P.c[bi * 1024 + k] : P.c_ctx[k];
      s[i] = v * sigmoidf_(v);
    }
    __syncthreads();
    const int c4 = tid & 15, kg = tid >> 4;
    float acc[9][4];
#pragma unroll
    for (int bi = 0; bi < 9; ++bi) { acc[bi][0] = acc[bi][1] = acc[bi][2] = acc[bi][3] = 0.f; }
    const float* w = P.w_mod + (size_t)l * 1024 * 6144 + j * 64 + c4 * 4;
#pragma unroll 4
    for (int kk = 0; kk < 64; ++kk) {
      const int k = kg * 64 + kk;
      const float4 w4 = *reinterpret_cast<const float4*>(w + (size_t)k * 6144);
#pragma unroll
      for (int bi = 0; bi < 9; ++bi) {
        const float sv = s[bi * 1024 + k];
        acc[bi][0] += sv * w4.x; acc[bi][1] += sv * w4.y; acc[bi][2] += sv * w4.z; acc[bi][3] += sv * w4.w;
      }
    }
#pragma unroll
    for (int bi = 0; bi < 9; ++bi)
#pragma unroll
      for (int e = 0; e < 4; ++e) red[(kg * 9 + bi) * 64 + c4 * 4 + e] = acc[bi][e];
    __syncthreads();
    for (int o = tid; o < 576; o += 256) {
      const int bi = o >> 6, cc = o & 63;
      float sum = 0.f;
#pragma unroll
      for (int g = 0; g < 16; ++g) sum += red[(g * 9 + bi) * 64 + cc];
      P.MOD[(size_t)(l * 9 + bi) * 6144 + j * 64 + cc] = sum + P.b_mod[l * 6144 + j * 64 + cc];
    }
  }
}

DEVI void conv_T_tile(const float* __restrict__ src, int N, bf16* __restrict__ dst, int Kd, int k0, int n0,
                      const float* __restrict__ kscale, float* tile) {
  const int tid = TIDX;
  __syncthreads();
  for (int e = tid; e < 4096; e += 256) {
    const int i = e >> 6, j = e & 63, n = n0 + j;
    float v = (n < N) ? src[(size_t)(k0 + i) * N + n] : 0.f;
    if (kscale) v *= kscale[k0 + i];
    tile[i * 65 + j] = v;
  }
  __syncthreads();
  for (int e = tid; e < 2048; e += 256) {
    const int j = e >> 5, i2 = (e & 31) * 2;
    const unsigned pk = pack2(tile[i2 * 65 + j], tile[(i2 + 1) * 65 + j]);
    *reinterpret_cast<unsigned*>(&dst[(size_t)(n0 + j) * Kd + k0 + i2]) = pk;
  }
}

DEVI void conv_straight(const float* __restrict__ src, bf16* __restrict__ dst, size_t n8) {
  const size_t stride = (size_t)NVB * 256;
  for (size_t i = (size_t)VBID * 256 + TIDX; i < n8; i += stride) {
    const float4 a = reinterpret_cast<const float4*>(src)[2 * i];
    const float4 b = reinterpret_cast<const float4*>(src)[2 * i + 1];
    uint4 o; o.x = pack2(a.x, a.y); o.y = pack2(a.z, a.w); o.z = pack2(b.x, b.y); o.w = pack2(b.z, b.w);
    reinterpret_cast<uint4*>(dst)[i] = o;
  }
}

DEVI void convert_rows_fp6(const Params& P, int L, int i0, int i1) {
  const int lane = threadIdx.x & 63, half = lane >> 5, l32 = lane & 31;
  const int wv = threadIdx.x >> 6;
  for (int ib = i0 + wv * 2; ib < i1; ib += 16) {
    int i = ib + half; const bool live = i < i1; if (!live) i = i1 - 1;
    const int table = i >> 14, lr = L * 16384 + (i & 16383);
    const float* src = (table ? P.p_v : P.p_u) + (size_t)lr * 1024 + l32 * 32;
    float4 a[8];
    float m = 0.f;
#pragma unroll
    for (int q = 0; q < 8; ++q) {
      a[q] = *reinterpret_cast<const float4*>(src + q * 4);
      m = fmaxf(m, fmaxf(fmaxf(fabsf(a[q].x), fabsf(a[q].y)), fmaxf(fabsf(a[q].z), fabsf(a[q].w))));
    }
    const unsigned sb = (__float_as_uint(fmaxf(m, 1e-30f) * (1.f / 6.f)) + 0xffffu) >> 16;
    const float inv = 1.f / __uint_as_float(sb << 16);
    unsigned pk[4];
#pragma unroll
    for (int w = 0; w < 4; ++w) {
      unsigned word = 0u;
#pragma unroll
      for (int e = 0; e < 8; ++e) {
        const int idx = w * 8 + e;
        const float4 q4 = a[idx >> 2];
        const float xv = ((idx & 3) == 0 ? q4.x : (idx & 3) == 1 ? q4.y : (idx & 3) == 2 ? q4.z : q4.w) * inv;
        const float av = fabsf(xv);
        unsigned ci = (av > 0.25f) + (av > 0.75f) + (av > 1.25f) + (av > 1.75f) + (av > 2.5f) + (av > 3.5f) + (av > 5.f);
        ci |= (xv < 0.f) ? 8u : 0u;
        word |= ci << (4 * e);
      }
      pk[w] = word;
    }
    unsigned char* rowp = (table ? P.PV8 : P.PU8) + (size_t)lr * 576;
    if (live) {
      *reinterpret_cast<uint4*>(rowp + l32 * 16) = make_uint4(pk[0], pk[1], pk[2], pk[3]);
      *reinterpret_cast<unsigned short*>(rowp + 512 + l32 * 2) = (unsigned short)sb;
    }
  }
}

DEVI void phase_prologue(const Params& P, unsigned char* smem) {
  phase_mod(P, smem);
  float* tile = (float*)smem;
  for (int it = VBID; it < 2 * 1424; it += NVB) {
    const int l = it / 1424; int r = it % 1424;
    if (r < 576) { conv_T_tile(P.w_in + (size_t)l * 1024 * DIN, DIN, P.WinT + (size_t)l * DINP * 1024, 1024, (r % 16) * 64, (r / 16) * 64, nullptr, tile); continue; }
    r -= 576;
    if (r < 256) { conv_T_tile(P.w_out + (size_t)l * 1024 * 1024, 1024, P.WoutT + (size_t)l * 1024 * 1024, 1024, (r % 16) * 64, (r / 16) * 64, nullptr, tile); continue; }
    r -= 256;
    if (r < 512) { conv_T_tile(P.p_w_q + (size_t)l * 1024 * 2048, 2048, P.WpqT + (size_t)l * 2048 * 1024, 1024, (r % 16) * 64, (r / 16) * 64, nullptr, tile); continue; }
    r -= 512;
    if (r < 48) { conv_T_tile(P.b_w_uq + (size_t)l * 256 * 768, 768, P.WuqT + (size_t)l * 768 * 256, 256, (r % 4) * 64, (r / 4) * 64, P.b_q_norm_w + l * 256, tile); continue; }
    r -= 48;
    conv_T_tile(P.b_w_ukv + (size_t)l * 128 * 1024, 1024, P.WukvT + (size_t)l * 1024 * 128, 128, (r % 2) * 64, (r / 2) * 64, P.b_kv_norm_w + l * 128, tile);
  }
  conv_straight(P.p_sub_keys, P.SK, (size_t)2 * 16 * 128 * 128 / 8);
  conv_straight(P.a_w_s, P.AWS, (size_t)2 * 4 * 128 * 128 / 8);
  for (int i = VBID * 256 + TIDX; i < 2048 * 16; i += NVB * 256) {
    const int t = i >> 4, a = (i >> 3) & 1, f = i & 7;
    const float inv = powf(10000.f, -(float)f / 8.f);
    const float pos = a ? (float)(t & 63) : (float)(t >> 6);
    const float ang = pos * inv;
    P.ROPE[t * 32 + a * 8 + f] = cosf(ang);
    P.ROPE[t * 32 + 16 + a * 8 + f] = sinf(ang);
  }
}

DEVI void phase_norm(const Params& P, int l, int which, int nrows) {
  const int lane = TIDX & 63;
  const int gw = VBID * 4 + (TIDX >> 6), nw = NVB * 4;
  const float* lnw = (which == 0 ? P.ln1_w : P.ln2_w) + l * 1024;
  for (int r = gw; r < nrows; r += nw) {
    const float* src;
    if (which == 0 && l == 0) src = r < NL ? P.x + (size_t)r * 1024 : P.ctx + (size_t)(r - NL) * 1024;
    else src = P.X + (size_t)r * 1024;
    const float* mod = P.MOD + (size_t)(l * 9 + batch_of_row(r)) * 6144 + which * 3072;
    float4 v[4];
    float ss = 0.f;
#pragma unroll
    for (int i = 0; i < 4; ++i) {
      v[i] = *reinterpret_cast<const float4*>(src + i * 256 + lane * 4);
      ss += v[i].x * v[i].x + v[i].y * v[i].y + v[i].z * v[i].z + v[i].w * v[i].w;
    }
    ss = wave_sum(ss);
    const float rr = rsqrtf(ss * (1.f / 1024.f) + EPS);
#pragma unroll
    for (int i = 0; i < 4; ++i) {
      const int d = i * 256 + lane * 4;
      const float4 w = *reinterpret_cast<const float4*>(lnw + d);
      const float4 sh = *reinterpret_cast<const float4*>(mod + d);
      const float4 sc = *reinterpret_cast<const float4*>(mod + 1024 + d);
      const float o0 = v[i].x * rr * w.x * (1.f + sc.x) + sh.x;
      const float o1 = v[i].y * rr * w.y * (1.f + sc.y) + sh.y;
      const float o2 = v[i].z * rr * w.z * (1.f + sc.z) + sh.z;
      const float o3 = v[i].w * rr * w.w * (1.f + sc.w) + sh.w;
      uint2 o; o.x = pack2(o0, o1); o.y = pack2(o2, o3);
      *reinterpret_cast<uint2*>(P.H + (size_t)r * 1024 + d) = o;
    }
  }
}

template <int BM, int BN, int BK, int WM, int WN>
struct Gemm {
  static constexpr int LDK = BK + 8;
  static constexpr int TM = BM / WM / 32, TN = BN / WN / 32;
  static constexpr int CPR = BK / 8;
  static constexpr int NA = BM * CPR / 256, NB = BN * CPR / 256;
  static constexpr int A_BYTES = BM * LDK * 2, B_BYTES = BN * LDK * 2;
  static constexpr int STAGE_BYTES = A_BYTES + B_BYTES;
  static constexpr int SMEM = 2 * STAGE_BYTES;

  static DEVI void run(const bf16* __restrict__ A, int lda, const bf16* __restrict__ BT, int ldb, int K,
                       unsigned char* smem, f32x16 (&acc)[TM][TN]) {
    const int tid = TIDX, lane = tid & 63, wave = tid >> 6;
    const int wm = wave / WN, wn = wave % WN;
    const int l31 = lane & 31, hh = lane >> 5;
#pragma unroll
    for (int i = 0; i < TM; ++i)
#pragma unroll
      for (int j = 0; j < TN; ++j) acc[i][j] = zero16();
    uint4 ra[NA], rb[NB];
    const int nk = K / BK;
    auto gload = [&](int kt) {
#pragma unroll
      for (int i = 0; i < NA; ++i) { const int ch = tid + i * 256, row = ch / CPR, cc = ch % CPR;
        ra[i] = *reinterpret_cast<const uint4*>(A + (size_t)row * lda + kt * BK + cc * 8); }
#pragma unroll
      for (int i = 0; i < NB; ++i) { const int ch = tid + i * 256, row = ch / CPR, cc = ch % CPR;
        rb[i] = *reinterpret_cast<const uint4*>(BT + (size_t)row * ldb + kt * BK + cc * 8); }
    };
    auto swrite = [&](int buf) {
      bf16* sA = reinterpret_cast<bf16*>(smem + buf * STAGE_BYTES);
      bf16* sB = reinterpret_cast<bf16*>(smem + buf * STAGE_BYTES + A_BYTES);
#pragma unroll
      for (int i = 0; i < NA; ++i) { const int ch = tid + i * 256, row = ch / CPR, cc = ch % CPR;
        *reinterpret_cast<uint4*>(sA + row * LDK + cc * 8) = ra[i]; }
#pragma unroll
      for (int i = 0; i < NB; ++i) { const int ch = tid + i * 256, row = ch / CPR, cc = ch % CPR;
        *reinterpret_cast<uint4*>(sB + row * LDK + cc * 8) = rb[i]; }
    };
    __syncthreads();
    gload(0);
    swrite(0);
    __syncthreads();
    for (int kt = 0; kt < nk; ++kt) {
      const int cur = kt & 1;
      if (kt + 1 < nk) gload(kt + 1);
      const bf16* sA = reinterpret_cast<const bf16*>(smem + cur * STAGE_BYTES);
      const bf16* sB = reinterpret_cast<const bf16*>(smem + cur * STAGE_BYTES + A_BYTES);
#pragma unroll
      for (int ks = 0; ks < BK / 16; ++ks) {
        bf16x8 af[TM], bfr[TN];
#pragma unroll
        for (int i = 0; i < TM; ++i) af[i] = ldfrag(sA + (wm * (BM / WM) + i * 32 + l31) * LDK + ks * 16 + hh * 8);
#pragma unroll
        for (int j = 0; j < TN; ++j) bfr[j] = ldfrag(sB + (wn * (BN / WN) + j * 32 + l31) * LDK + ks * 16 + hh * 8);
#pragma unroll
        for (int i = 0; i < TM; ++i)
#pragma unroll
          for (int j = 0; j < TN; ++j) acc[i][j] = mfma32(af[i], bfr[j], acc[i][j]);
      }
      if (kt + 1 < nk) swrite(cur ^ 1);
      __syncthreads();
    }
  }
};

DEVI void phase_gemm1(const Params& P, int l, unsigned char* smem) {
  using G = Gemm<128, 128, 64, 2, 2>;
  const int lane = TIDX & 63, wave = TIDX >> 6, wm = wave >> 1, wn = wave & 1, l31 = lane & 31, hh = lane >> 5;
  const bf16* W = P.WinT + (size_t)l * DINP * 1024;
  for (int t = VBID; t < 144 * 18; t += NVB) {
    const int mt = t / 18, nt = t % 18;
    f32x16 acc[2][2];
    G::run(P.H + (size_t)mt * 128 * 1024, 1024, W + (size_t)nt * 128 * 1024, 1024, 1024, smem, acc);
#pragma unroll
    for (int i = 0; i < 2; ++i)
#pragma unroll
      for (int j = 0; j < 2; ++j) {
        const int col = nt * 128 + wn * 64 + j * 32 + l31;
        if (col < DIN) {
#pragma unroll
          for (int r = 0; r < 16; ++r) {
            const int row = mt * 128 + wm * 64 + i * 32 + drow(r, hh);
            P.Z[(size_t)row * DIN + col] = f2bf(acc[i][j][r]);
          }
        }
      }
  }
}

DEVI void phase_gemm2(const Params& P, int l, unsigned char* smem) {
  using G = Gemm<128, 128, 64, 2, 2>;
  const int lane = TIDX & 63, wave = TIDX >> 6, wm = wave >> 1, wn = wave & 1, l31 = lane & 31, hh = lane >> 5;
  const bf16* W = P.WoutT + (size_t)l * 1024 * 1024;
  const int mtiles = (l == 1) ? 128 : 144;
  for (int t = VBID; t < mtiles * 8; t += NVB) {
    const int mt = t / 8, nt = t % 8;
    f32x16 acc[2][2];
    G::run(P.H + (size_t)mt * 128 * 1024, 1024, W + (size_t)nt * 128 * 1024, 1024, 1024, smem, acc);
    const int bi = batch_of_row(mt * 128);
    const float* gate = P.MOD + (size_t)(l * 9 + bi) * 6144 + 2048;
#pragma unroll
    for (int i = 0; i < 2; ++i)
#pragma unroll
      for (int j = 0; j < 2; ++j) {
        const int col = nt * 128 + wn * 64 + j * 32 + l31;
        const float g = gate[col];
#pragma unroll
        for (int r = 0; r < 16; ++r) {
          const int row = mt * 128 + wm * 64 + i * 32 + drow(r, hh);
          float res;
          if (l == 0) res = row < NL ? P.x[(size_t)row * 1024 + col] : P.ctx[(size_t)(row - NL) * 1024 + col];
          else res = P.X[(size_t)row * 1024 + col];
          P.X[(size_t)row * 1024 + col] = res + g * acc[i][j][r];
        }
      }
  }
}

DEVI void phase_mixA(const Params& P, int l, unsigned char* smem) {
  const int tid = TIDX, lane = tid & 63, wave = tid >> 6, l31 = lane & 31, hh = lane >> 5;
  bf16* VNT = reinterpret_cast<bf16*>(smem);
  constexpr int LDV = 136;
  const int nseg = (l == 1) ? 16 : 18;
  const int seg0 = (l == 1) ? 2 : 0;
  for (int it = VBID; it < 8 * nseg * 4; it += NVB) {
    const int a = it & 3; const int sj = (it >> 2) % nseg + seg0; const int b = (it >> 2) / nseg;
    const int p0 = sj * 128;
    __syncthreads();
    {
      const int q = tid >> 1, half = tid & 1;
      const int row = row_of(b, p0 + q);
      const bf16* src = P.Z + (size_t)row * DIN + ZC_AV + a * 64 + half * 32;
      float v[32];
      float ss = 0.f;
#pragma unroll
      for (int i = 0; i < 4; ++i) {
        const uint4 u = *reinterpret_cast<const uint4*>(src + i * 8);
        v[i * 8 + 0] = lo2f(u.x); v[i * 8 + 1] = hi2f(u.x); v[i * 8 + 2] = lo2f(u.y); v[i * 8 + 3] = hi2f(u.y);
        v[i * 8 + 4] = lo2f(u.z); v[i * 8 + 5] = hi2f(u.z); v[i * 8 + 6] = lo2f(u.w); v[i * 8 + 7] = hi2f(u.w);
      }
#pragma unroll
      for (int i = 0; i < 32; ++i) ss += v[i] * v[i];
      ss += __shfl_xor(ss, 1);
      const float rr = rsqrtf(ss * (1.f / 64.f) + EPS);
      const float* nw = P.a_norm_w + l * 256 + a * 64 + half * 32;
#pragma unroll
      for (int i = 0; i < 32; ++i) VNT[(half * 32 + i) * LDV + q] = f2bf(v[i] * rr * nw[i]);
    }
    __syncthreads();
    f32x16 acc[2]; acc[0] = zero16(); acc[1] = zero16();
    const bf16* Aw = P.AWS + (size_t)(l * 4 + a) * 128 * 128 + (size_t)(wave * 32 + l31) * 128;
#pragma unroll
    for (int ks = 0; ks < 8; ++ks) {
      const bf16x8 af = ldfrag(Aw + ks * 16 + hh * 8);
#pragma unroll
      for (int j = 0; j < 2; ++j) {
        const bf16x8 bfr = ldfrag(VNT + (j * 32 + l31) * LDV + ks * 16 + hh * 8);
        acc[j] = mfma32(af, bfr, acc[j]);
      }
    }
    const float* bs = P.a_b_s + (l * 4 + a) * 128;
#pragma unroll
    for (int j = 0; j < 2; ++j)
#pragma unroll
      for (int r = 0; r < 16; ++r) {
        const int p = wave * 32 + drow(r, hh);
        const int row = row_of(b, p0 + p);
        const int col = a * 64 + j * 32 + l31;
        const float u = bf2f(P.Z[(size_t)row * DIN + ZC_AU + col]);
        P.H[(size_t)row * 1024 + col] = f2bf(u * (acc[j][r] + bs[p]));
      }
  }
}

DEVI void mla_norm_rope_store(const Params& P, const float* T, const float* nw, bool rope, float oscale,
                              bf16* dstbase  , int pos0, int tlat0) {
  const int tid = TIDX, tok = tid >> 1, half = tid & 1;
  float v[48];
  float ss = 0.f;
#pragma unroll
  for (int i = 0; i < 48; ++i) { v[i] = T[tok * 97 + half * 48 + i]; ss += v[i] * v[i]; }
  ss += __shfl_xor(ss, 1);
  const float rr = rsqrtf(ss * (1.f / 96.f) + EPS);
#pragma unroll
  for (int i = 0; i < 48; ++i) v[i] = v[i] * rr * nw[half * 48 + i];
  if (rope && half == 1) {
    const float* cs = P.ROPE + (size_t)(tlat0 + tok) * 32;
#pragma unroll
    for (int a = 0; a < 2; ++a)
#pragma unroll
      for (int f = 0; f < 8; ++f) {
        const float x1 = v[16 + a * 16 + f], x2 = v[16 + a * 16 + 8 + f];
        const float c = cs[a * 8 + f], s = cs[16 + a * 8 + f];
        v[16 + a * 16 + f] = x1 * c - x2 * s;
        v[16 + a * 16 + 8 + f] = x2 * c + x1 * s;
      }
  }
  bf16* dst = dstbase + (size_t)(pos0 + tok) * 96 + half * 48;
#pragma unroll
  for (int i = 0; i < 6; ++i) {
    uint4 o;
    o.x = pack2(v[i * 8 + 0] * oscale, v[i * 8 + 1] * oscale); o.y = pack2(v[i * 8 + 2] * oscale, v[i * 8 + 3] * oscale);
    o.z = pack2(v[i * 8 + 4] * oscale, v[i * 8 + 5] * oscale); o.w = pack2(v[i * 8 + 6] * oscale, v[i * 8 + 7] * oscale);
    *reinterpret_cast<uint4*>(dst + i * 8) = o;
  }
}

DEVI void phase_mla_proj(const Params& P, int l, unsigned char* smem) {
  const int tid = TIDX, lane = tid & 63, wave = tid >> 6, l31 = lane & 31, hh = lane >> 5;
  float* T = reinterpret_cast<float*>(smem);
  float* rsq = T + 128 * 97;
  float* rskv = rsq + 128;
  const float qscale = 0.10206207261596577f * 1.4426950408889634f;
  for (int it = VBID; it < 144 * 8; it += NVB) {
    const int h = it & 7;
    const int m0 = (it >> 3) * 128;
    const bool lat = m0 < NL;
    const int b = lat ? (m0 >> 11) : ((m0 - NL) >> 8);
    const int pos0 = lat ? 256 + (m0 & 2047) : ((m0 - NL) & 255);
    const int tlat0 = lat ? (m0 & 2047) : 0;
    const bool doq = lat || (l == 0);
    const bf16* zrow = P.Z + (size_t)(m0 + wave * 32 + l31) * DIN;
    __syncthreads();
    {
      float ss = 0.f;
#pragma unroll
      for (int ks = 0; ks < 8; ++ks) {
        const bf16x8 a = ldfrag(zrow + ZC_BKV + ks * 16 + hh * 8);
#pragma unroll
        for (int j = 0; j < 8; ++j) { const float f = (float)a[j]; ss += f * f; }
      }
      ss += __shfl_xor(ss, 32);
      if (hh == 0) rskv[wave * 32 + l31] = rsqrtf(ss * (1.f / 128.f) + EPS);
      if (doq) {
        float sq = 0.f;
#pragma unroll
        for (int ks = 0; ks < 16; ++ks) {
          const bf16x8 a = ldfrag(zrow + ZC_BQ + ks * 16 + hh * 8);
#pragma unroll
          for (int j = 0; j < 8; ++j) { const float f = (float)a[j]; sq += f * f; }
        }
        sq += __shfl_xor(sq, 32);
        if (hh == 0) rsq[wave * 32 + l31] = rsqrtf(sq * (1.f / 256.f) + EPS);
      }
    }
    for (int e = tid; e < 128 * 32; e += 256) {
      const int tok = e >> 5, i = e & 31;
      T[tok * 97 + 64 + i] = bf2f(P.Z[(size_t)(m0 + tok) * DIN + ZC_BKR + i]);
    }
    __syncthreads();
    {
      const bf16* Wkv = P.WukvT + (size_t)l * 1024 * 128;
      f32x16 acc[4];
#pragma unroll
      for (int j = 0; j < 4; ++j) acc[j] = zero16();
#pragma unroll 4
      for (int ks = 0; ks < 8; ++ks) {
        const bf16x8 af = ldfrag(zrow + ZC_BKV + ks * 16 + hh * 8);
#pragma unroll
        for (int j = 0; j < 4; ++j) {
          const bf16x8 bfr = ldfrag(Wkv + (size_t)(h * 128 + j * 32 + l31) * 128 + ks * 16 + hh * 8);
          acc[j] = mfma32(af, bfr, acc[j]);
        }
      }
#pragma unroll
      for (int j = 0; j < 2; ++j)
#pragma unroll
        for (int r = 0; r < 16; ++r) {
          const int tok = wave * 32 + drow(r, hh);
          T[tok * 97 + j * 32 + l31] = acc[j][r] * rskv[tok];
        }
#pragma unroll
      for (int j = 2; j < 4; ++j) {
        const int d = (j - 2) * 32 + l31;
        bf16* dst = P.VT + ((size_t)(b * 8 + h) * 64 + d) * SEQP + pos0 + wave * 32;
#pragma unroll
        for (int rg = 0; rg < 4; ++rg) {
          const int tk = 8 * rg + 4 * hh;
          uint2 o;
          o.x = pack2(acc[j][4 * rg + 0] * rskv[wave * 32 + tk + 0], acc[j][4 * rg + 1] * rskv[wave * 32 + tk + 1]);
          o.y = pack2(acc[j][4 * rg + 2] * rskv[wave * 32 + tk + 2], acc[j][4 * rg + 3] * rskv[wave * 32 + tk + 3]);
          *reinterpret_cast<uint2*>(dst + tk) = o;
        }
      }
      __syncthreads();
      mla_norm_rope_store(P, T, P.b_kh_w + l * 96, lat, 1.f, P.K + (size_t)(b * 8 + h) * SEQP * 96, pos0, tlat0);
    }
    if (doq) {
      const bf16* Wq = P.WuqT + (size_t)l * 768 * 256;
      f32x16 acc[3];
#pragma unroll
      for (int j = 0; j < 3; ++j) acc[j] = zero16();
#pragma unroll 4
      for (int ks = 0; ks < 16; ++ks) {
        const bf16x8 af = ldfrag(zrow + ZC_BQ + ks * 16 + hh * 8);
#pragma unroll
        for (int j = 0; j < 3; ++j) {
          const bf16x8 bfr = ldfrag(Wq + (size_t)(h * 96 + j * 32 + l31) * 256 + ks * 16 + hh * 8);
          acc[j] = mfma32(af, bfr, acc[j]);
        }
      }
      __syncthreads();
#pragma unroll
      for (int j = 0; j < 3; ++j)
#pragma unroll
        for (int r = 0; r < 16; ++r) {
          const int tok = wave * 32 + drow(r, hh);
          T[tok * 97 + j * 32 + l31] = acc[j][r] * rsq[tok];
        }
      __syncthreads();
      mla_norm_rope_store(P, T, P.b_qh_w + l * 96, lat, qscale, P.Q + (size_t)(b * 8 + h) * SEQP * 96, pos0, tlat0);
    }
  }
}

DEVI void hgrn_load(const Params& P, int l, int b, int hd, int c, float* BF, float* RB, float* SEG,
                    float (&q)[16], float (&kf)[16], float (&kb)[16], float (&v)[16], bool need_kv) {
  const int tid = TIDX, t = tid >> 2, k0 = (tid & 3) * 16;
  const int row = row_of(b, c * 64 + t);
  const bf16* z = P.Z + (size_t)row * DIN + hd * 64 + k0;
  float zf[16], zb[16];
#pragma unroll
  for (int i = 0; i < 2; ++i) {
    const uint4 uq = *reinterpret_cast<const uint4*>(z + ZC_CQ + i * 8);
    const uint4 uf = *reinterpret_cast<const uint4*>(z + ZC_CFF + i * 8);
    const uint4 ub = *reinterpret_cast<const uint4*>(z + ZC_CFB + i * 8);
    q[i * 8 + 0] = lo2f(uq.x); q[i * 8 + 1] = hi2f(uq.x); q[i * 8 + 2] = lo2f(uq.y); q[i * 8 + 3] = hi2f(uq.y);
    q[i * 8 + 4] = lo2f(uq.z); q[i * 8 + 5] = hi2f(uq.z); q[i * 8 + 6] = lo2f(uq.w); q[i * 8 + 7] = hi2f(uq.w);
    zf[i * 8 + 0] = lo2f(uf.x); zf[i * 8 + 1] = hi2f(uf.x); zf[i * 8 + 2] = lo2f(uf.y); zf[i * 8 + 3] = hi2f(uf.y);
    zf[i * 8 + 4] = lo2f(uf.z); zf[i * 8 + 5] = hi2f(uf.z); zf[i * 8 + 6] = lo2f(uf.w); zf[i * 8 + 7] = hi2f(uf.w);
    zb[i * 8 + 0] = lo2f(ub.x); zb[i * 8 + 1] = hi2f(ub.x); zb[i * 8 + 2] = lo2f(ub.y); zb[i * 8 + 3] = hi2f(ub.y);
    zb[i * 8 + 4] = lo2f(ub.z); zb[i * 8 + 5] = hi2f(ub.z); zb[i * 8 + 6] = lo2f(ub.w); zb[i * 8 + 7] = hi2f(ub.w);
    if (need_kv) {
      const uint4 uv = *reinterpret_cast<const uint4*>(z + ZC_CI + i * 8);
      v[i * 8 + 0] = lo2f(uv.x); v[i * 8 + 1] = hi2f(uv.x); v[i * 8 + 2] = lo2f(uv.y); v[i * 8 + 3] = hi2f(uv.y);
      v[i * 8 + 4] = lo2f(uv.z); v[i * 8 + 5] = hi2f(uv.z); v[i * 8 + 6] = lo2f(uv.w); v[i * 8 + 7] = hi2f(uv.w);
    }
  }
#pragma unroll
  for (int i = 0; i < 16; ++i) {
    q[i] *= 0.125f;
    float lbf = 0.f;
    if (l == 1) { const int ch = hd * 64 + k0 + i; lbf = sigmoidf_(P.c_lb[512 + ch] - P.c_lb[ch]); }
    const float zz = zf[i];
    const float e = __expf(-fabsf(zz));
    const float sp = __builtin_amdgcn_rcpf(1.f + e);
    const float sig = zz >= 0.f ? sp : e * sp;
    const float nsig = zz >= 0.f ? e * sp : sp;
    const float lf = (l == 0) ? (fminf(zz, 0.f) - __logf(1.f + e)) : __logf(lbf + (1.f - lbf) * sig);
    kf[i] = (1.f - lbf) * nsig;
    BF[t * 65 + k0 + i] = lf;
  }
  __builtin_amdgcn_sched_barrier(0);
#pragma unroll
  for (int i = 0; i < 16; ++i) {
    float lbb = 0.f;
    if (l == 1) { const int ch = hd * 64 + k0 + i; lbb = sigmoidf_(P.c_lb[512 + 256 + ch] - P.c_lb[256 + ch]); }
    const float zz = zb[i];
    const float e = __expf(-fabsf(zz));
    const float sp = __builtin_amdgcn_rcpf(1.f + e);
    const float sig = zz >= 0.f ? sp : e * sp;
    const float nsig = zz >= 0.f ? e * sp : sp;
    const float lf = (l == 0) ? (fminf(zz, 0.f) - __logf(1.f + e)) : __logf(lbb + (1.f - lbb) * sig);
    kb[i] = (1.f - lbb) * nsig;
    RB[t * 65 + k0 + i] = lf;
  }
  __syncthreads();
  {
    const int k = tid & 63, seg = tid >> 6;
    float sf = 0.f, sr = 0.f;
#pragma unroll
    for (int j = 0; j < 16; ++j) { sf += BF[(seg * 16 + j) * 65 + k]; BF[(seg * 16 + j) * 65 + k] = sf; }
#pragma unroll
    for (int j = 15; j >= 0; --j) { sr += RB[(seg * 16 + j) * 65 + k]; RB[(seg * 16 + j) * 65 + k] = sr; }
    SEG[seg * 64 + k] = sf; SEG[256 + seg * 64 + k] = sr;
    __syncthreads();
    float offf = 0.f, offb = 0.f;
#pragma unroll
    for (int s2 = 0; s2 < 4; ++s2) {
      offf += (s2 < seg) ? SEG[s2 * 64 + k] : 0.f;
      offb += (s2 > seg) ? SEG[256 + s2 * 64 + k] : 0.f;
    }
#pragma unroll
    for (int j = 0; j < 16; ++j) { BF[(seg * 16 + j) * 65 + k] += offf; RB[(seg * 16 + j) * 65 + k] += offb; }
  }
  __syncthreads();
}

DEVI f32x16 lds_mm(const bf16* A, const bf16* BT, int tm, int tn, int l31, int hh) {
  f32x16 acc = zero16();
#pragma unroll
  for (int ks = 0; ks < 4; ++ks) {
    const bf16x8 a = ldfrag(A + (tm * 32 + l31) * 72 + ks * 16 + hh * 8);
    const bf16x8 b = ldfrag(BT + (tn * 32 + l31) * 72 + ks * 16 + hh * 8);
    acc = mfma32(a, b, acc);
  }
  return acc;
}

DEVI void phase_hgrn_local(const Params& P, int l, unsigned char* smem) {
  const int tid = TIDX, lane = tid & 63, wave = tid >> 6, l31 = lane & 31, hh = lane >> 5;
  const int tm = wave >> 1, tn = wave & 1;
  float* BF = reinterpret_cast<float*>(smem);
  float* RB = BF + 64 * 65;
  bf16* QF = reinterpret_cast<bf16*>(smem + 33280);
  bf16* KF = QF + 64 * 72;
  bf16* QB = KF + 64 * 72;
  bf16* KB = QB + 64 * 72;
  bf16* VTt = KB + 64 * 72;
  bf16* KHF = reinterpret_cast<bf16*>(smem);
  bf16* KHB = KHF + 64 * 72;
  bf16* ATT = KHB + 64 * 72;
  for (int it = VBID; it < 8 * 4 * 36; it += NVB) {
    const int c = it % 36, hd = (it / 36) & 3, b = it / 144;
    float q[16], kf[16], kb[16], v[16];
    __syncthreads();
    hgrn_load(P, l, b, hd, c, BF, RB, reinterpret_cast<float*>(smem + 33280), q, kf, kb, v, true);
    const int t = tid >> 2, k0 = (tid & 3) * 16;
#pragma unroll
    for (int i = 0; i < 16; ++i) VTt[(k0 + i) * 72 + t] = f2bf(v[i]);
    float bfv[16], rbv[16];
#pragma unroll
    for (int i = 0; i < 16; ++i) { bfv[i] = BF[t * 65 + k0 + i]; rbv[i] = RB[t * 65 + k0 + i]; }
    {
      const size_t go = (size_t)row_of(b, c * 64 + t) * 256 + hd * 64 + k0;
#pragma unroll
      for (int hq = 0; hq < 2; ++hq) {
        unsigned pf[4], pb[4];
#pragma unroll
        for (int i = 0; i < 8; i += 2) {
          pf[i >> 1] = pack2(q[hq * 8 + i] * __expf(bfv[hq * 8 + i]), q[hq * 8 + i + 1] * __expf(bfv[hq * 8 + i + 1]));
          pb[i >> 1] = pack2(q[hq * 8 + i] * __expf(rbv[hq * 8 + i]), q[hq * 8 + i + 1] * __expf(rbv[hq * 8 + i + 1]));
        }
        *reinterpret_cast<uint4*>(P.GQF + go + hq * 8) = make_uint4(pf[0], pf[1], pf[2], pf[3]);
        *reinterpret_cast<uint4*>(P.GQB + go + hq * 8) = make_uint4(pb[0], pb[1], pb[2], pb[3]);
      }
    }
    if (t == 0) {
      float* dec = P.DEC + ((size_t)((b * 4 + hd) * 2) * 36 + c) * 64 + k0;
#pragma unroll
      for (int i = 0; i < 16; ++i) { dec[i] = __expf(BF[63 * 65 + k0 + i]); dec[36 * 64 + i] = __expf(RB[k0 + i]); }
    }
#pragma unroll
    for (int i = 0; i < 16; i += 2) {
      const int k = k0 + i;
      const float mF0 = BF[32 * 65 + k], mF1 = BF[32 * 65 + k + 1], mB0 = RB[32 * 65 + k], mB1 = RB[32 * 65 + k + 1];
      *reinterpret_cast<unsigned*>(&QF[t * 72 + k]) = pack2(q[i] * __expf(fminf(bfv[i] - mF0, 80.f)), q[i + 1] * __expf(fminf(bfv[i + 1] - mF1, 80.f)));
      *reinterpret_cast<unsigned*>(&KF[t * 72 + k]) = pack2(kf[i] * __expf(fminf(mF0 - bfv[i], 80.f)), kf[i + 1] * __expf(fminf(mF1 - bfv[i + 1], 80.f)));
      *reinterpret_cast<unsigned*>(&QB[t * 72 + k]) = pack2(q[i] * __expf(fminf(rbv[i] - mB0, 80.f)), q[i + 1] * __expf(fminf(rbv[i + 1] - mB1, 80.f)));
      *reinterpret_cast<unsigned*>(&KB[t * 72 + k]) = pack2(kb[i] * __expf(fminf(mB0 - rbv[i], 80.f)), kb[i + 1] * __expf(fminf(mB1 - rbv[i + 1], 80.f)));
    }
#pragma unroll
    for (int i = 0; i < 16; ++i) {
      kf[i] = kf[i] * __expf(BF[63 * 65 + k0 + i] - bfv[i]);
      kb[i] = kb[i] * __expf(RB[k0 + i] - rbv[i]);
    }
    __syncthreads();
#pragma unroll
    for (int i = 0; i < 16; ++i) {
      KHF[(k0 + i) * 72 + t] = f2bf(kf[i]);
      KHB[(k0 + i) * 72 + t] = f2bf(kb[i]);
    }
    __syncthreads();
    {
      const f32x16 af = lds_mm(QF, KF, tm, tn, l31, hh);
      const f32x16 ab = lds_mm(QB, KB, tm, tn, l31, hh);
      const int s = tn * 32 + l31;
#pragma unroll
      for (int r = 0; r < 16; ++r) {
        const int tt = tm * 32 + drow(r, hh);
        float a = 0.f;
        if (s <= tt) a += af[r];
        if (s >= tt) a += ab[r];
        ATT[tt * 72 + s] = f2bf(a);
      }
    }
    {
      const f32x16 lf = lds_mm(VTt, KHF, tm, tn, l31, hh);
      const f32x16 lb = lds_mm(VTt, KHB, tm, tn, l31, hh);
      float* stf = P.ST + ((size_t)((b * 4 + hd) * 2 + 0) * 36 + c) * 4096;
      float* stb = P.ST + ((size_t)((b * 4 + hd) * 2 + 1) * 36 + c) * 4096;
#pragma unroll
      for (int r = 0; r < 16; ++r) {
        const int kk = tm * 32 + drow(r, hh), d = tn * 32 + l31;
        stf[kk * 64 + d] = lf[r];
        stb[kk * 64 + d] = lb[r];
      }
    }
    __syncthreads();
    {
      const f32x16 o = lds_mm(ATT, VTt, tm, tn, l31, hh);
#pragma unroll
      for (int r = 0; r < 16; ++r) {
        const int tt = tm * 32 + drow(r, hh), d = tn * 32 + l31;
        P.OI[(size_t)row_of(b, c * 64 + tt) * 256 + hd * 64 + d] = o[r];
      }
    }
  }
}

DEVI void hgrn_scan_item(const Params& P, int item) {
  const int tid = TIDX;
  const int chain = item >> 2, sl = item & 3;
  const int dir = chain & 1;
  const int dd = tid >> 2, k4 = sl * 16 + (tid & 3) * 4;
  float4 S = make_float4(0.f, 0.f, 0.f, 0.f);
  float* base = P.ST + (size_t)chain * 36 * 4096 + dd * 64 + k4;
  const float* dec = P.DEC + (size_t)chain * 36 * 64 + k4;
#pragma unroll 1
  for (int g = 0; g < 6; ++g) {
    float4 L[6], dc[6];
#pragma unroll
    for (int j = 0; j < 6; ++j) {
      const int step = g * 6 + j;
      const int c = dir == 0 ? step : (step < 4 ? 3 - step : 39 - step);
      L[j] = *reinterpret_cast<const float4*>(base + (size_t)c * 4096);
      dc[j] = *reinterpret_cast<const float4*>(dec + c * 64);
    }
#pragma unroll
    for (int j = 0; j < 6; ++j) {
      const int step = g * 6 + j;
      const int c = dir == 0 ? step : (step < 4 ? 3 - step : 39 - step);
      *reinterpret_cast<float4*>(base + (size_t)c * 4096) = S;
      S.x = dc[j].x * S.x + L[j].x; S.y = dc[j].y * S.y + L[j].y; S.z = dc[j].z * S.z + L[j].z; S.w = dc[j].w * S.w + L[j].w;
    }
  }
}

DEVI void phase_hgrn_final(const Params& P, int l, unsigned char* smem) {
  const int tid = TIDX, lane = tid & 63, wave = tid >> 6, l31 = lane & 31, hh = lane >> 5;
  const int tm = wave >> 1, tn = wave & 1;
  float* O = reinterpret_cast<float*>(smem);
  bf16* QF = reinterpret_cast<bf16*>(smem + 33280);
  bf16* QB = QF + 64 * 72;
  bf16* SF = QB + 64 * 72;
  bf16* SB = SF + 64 * 72;
  const int c0 = (l == 1) ? 4 : 0;
  const int nc = 36 - c0;
  for (int it = VBID; it < 8 * 4 * nc; it += NVB) {
    const int c = it % nc + c0, hd = (it / nc) & 3, b = it / (nc * 4);
    const int t = tid >> 2, k0 = (tid & 3) * 16;
    const int row = row_of(b, c * 64 + t);
    __syncthreads();
    {
      const size_t go = (size_t)row * 256 + hd * 64 + k0;
      *reinterpret_cast<uint4*>(QF + t * 72 + k0) = *reinterpret_cast<const uint4*>(P.GQF + go);
      *reinterpret_cast<uint4*>(QF + t * 72 + k0 + 8) = *reinterpret_cast<const uint4*>(P.GQF + go + 8);
      *reinterpret_cast<uint4*>(QB + t * 72 + k0) = *reinterpret_cast<const uint4*>(P.GQB + go);
      *reinterpret_cast<uint4*>(QB + t * 72 + k0 + 8) = *reinterpret_cast<const uint4*>(P.GQB + go + 8);
      const float* stf = P.ST + ((size_t)((b * 4 + hd) * 2 + 0) * 36 + c) * 4096 + t * 64 + k0;
      const float* stb = P.ST + ((size_t)((b * 4 + hd) * 2 + 1) * 36 + c) * 4096 + t * 64 + k0;
      unsigned pf[8], pb[8];
#pragma unroll
      for (int i = 0; i < 4; ++i) {
        const float4 a = *reinterpret_cast<const float4*>(stf + i * 4);
        const float4 bb = *reinterpret_cast<const float4*>(stb + i * 4);
        pf[2 * i] = pack2(a.x, a.y); pf[2 * i + 1] = pack2(a.z, a.w);
        pb[2 * i] = pack2(bb.x, bb.y); pb[2 * i + 1] = pack2(bb.z, bb.w);
      }
      *reinterpret_cast<uint4*>(SF + t * 72 + k0) = make_uint4(pf[0], pf[1], pf[2], pf[3]);
      *reinterpret_cast<uint4*>(SF + t * 72 + k0 + 8) = make_uint4(pf[4], pf[5], pf[6], pf[7]);
      *reinterpret_cast<uint4*>(SB + t * 72 + k0) = make_uint4(pb[0], pb[1], pb[2], pb[3]);
      *reinterpret_cast<uint4*>(SB + t * 72 + k0 + 8) = make_uint4(pb[4], pb[5], pb[6], pb[7]);
    }
    __syncthreads();
    {
      f32x16 o = lds_mm(QF, SF, tm, tn, l31, hh);
      const f32x16 o2 = lds_mm(QB, SB, tm, tn, l31, hh);
#pragma unroll
      for (int r = 0; r < 16; ++r) {
        const int tt = tm * 32 + drow(r, hh), d = tn * 32 + l31;
        O[tt * 65 + d] = o[r] + o2[r] + P.OI[(size_t)row_of(b, c * 64 + tt) * 256 + hd * 64 + d];
      }
    }
    __syncthreads();
    {
      float ov[16]; float ss = 0.f;
#pragma unroll
      for (int i = 0; i < 16; ++i) { ov[i] = O[t * 65 + k0 + i]; ss += ov[i] * ov[i]; }
      ss += __shfl_xor(ss, 1); ss += __shfl_xor(ss, 2);
      const float rr = rsqrtf(ss * (1.f / 64.f) + EPS);
      const bf16* g = P.Z + (size_t)row * DIN + ZC_CG + hd * 64 + k0;
      const float* nw = P.c_out_norm_w + l * 64 + k0;
      const uint4 gA = *reinterpret_cast<const uint4*>(g), gB = *reinterpret_cast<const uint4*>(g + 8);
      const unsigned gw[8] = {gA.x, gA.y, gA.z, gA.w, gB.x, gB.y, gB.z, gB.w};
      unsigned pk[8];
#pragma unroll
      for (int i = 0; i < 16; i += 2) {
        const float g0 = lo2f(gw[i >> 1]), g1 = hi2f(gw[i >> 1]);
        const float y0 = ov[i] * rr * nw[i] * (g0 * sigmoidf_(g0));
        const float y1 = ov[i + 1] * rr * nw[i + 1] * (g1 * sigmoidf_(g1));
        pk[i >> 1] = pack2(y0, y1);
      }
      uint4* dst = reinterpret_cast<uint4*>(P.H + (size_t)row * 1024 + 768 + hd * 64 + k0);
      dst[0] = make_uint4(pk[0], pk[1], pk[2], pk[3]);
      dst[1] = make_uint4(pk[4], pk[5], pk[6], pk[7]);
    }
  }
}

DEVI void attn_item8(const Params& P, int b, int h, int qpos0, int nkeys, float sref, unsigned char* smem_base) {
  const int tid = threadIdx.x, lane = tid & 63, wave = tid >> 6, l31 = lane & 31, hh = lane >> 5;
  constexpr int TK = 128, LDKS = 104, LDVS = 136;
  constexpr int KS_BYTES = TK * LDKS * 2, VS_BYTES = 64 * LDVS * 2, ST_BYTES = KS_BYTES + VS_BYTES;
  const bf16* Qg = P.Q + ((size_t)(b * 8 + h) * SEQP + qpos0 + wave * 32 + l31) * 96;
  const bf16* Kg = P.K + (size_t)(b * 8 + h) * SEQP * 96;
  const bf16* Vg = P.VT + (size_t)(b * 8 + h) * 64 * SEQP;
  bf16x8 qf[6];
#pragma unroll
  for (int ks = 0; ks < 6; ++ks) qf[ks] = ldfrag(Qg + ks * 16 + hh * 8);
  f32x16 oacc[2]; oacc[0] = zero16(); oacc[1] = zero16();
  float lsum = 0.f;
  uint4 rk[3], rv[2];
  const int ntiles = nkeys / TK;
  auto gload = [&](int kt) {
#pragma unroll
    for (int i = 0; i < 3; ++i) { const int ch = tid + i * 512, row = ch / 12, cc = ch % 12;
      rk[i] = *reinterpret_cast<const uint4*>(Kg + (size_t)(kt * TK + row) * 96 + cc * 8); }
#pragma unroll
    for (int i = 0; i < 2; ++i) { const int ch = tid + i * 512, row = ch >> 4, cc = ch & 15;
      rv[i] = *reinterpret_cast<const uint4*>(Vg + (size_t)row * SEQP + kt * TK + cc * 8); }
  };
  auto swrite = [&](int buf) {
    bf16* sK = reinterpret_cast<bf16*>(smem_base + buf * ST_BYTES);
    bf16* sV = reinterpret_cast<bf16*>(smem_base + buf * ST_BYTES + KS_BYTES);
#pragma unroll
    for (int i = 0; i < 3; ++i) { const int ch = tid + i * 512, row = ch / 12, cc = ch % 12;
      *reinterpret_cast<uint4*>(sK + row * LDKS + cc * 8) = rk[i]; }
#pragma unroll
    for (int i = 0; i < 2; ++i) { const int ch = tid + i * 512, row = ch >> 4, cc = ch & 15;
      const int g16 = cc >> 1, odd = cc & 1;
      bf16* base = sV + row * LDVS + g16 * 16;
      const int s0 = odd ? 4 : 0, s1 = odd ? 12 : 8;
      *reinterpret_cast<uint2*>(base + s0) = make_uint2(rv[i].x, rv[i].y);
      *reinterpret_cast<uint2*>(base + s1) = make_uint2(rv[i].z, rv[i].w);
    }
  };
  __syncthreads();
  gload(0); swrite(0);
  __syncthreads();
  for (int kt = 0; kt < ntiles; ++kt) {
    const int cur = kt & 1;
    if (kt + 1 < ntiles) gload(kt + 1);
    const bf16* sK = reinterpret_cast<const bf16*>(smem_base + cur * ST_BYTES);
    const bf16* sV = reinterpret_cast<const bf16*>(smem_base + cur * ST_BYTES + KS_BYTES);
#pragma unroll
    for (int kk = 0; kk < 4; ++kk) {
      f32x16 sacc;
#pragma unroll
      for (int r = 0; r < 16; ++r) sacc[r] = -sref;
#pragma unroll
      for (int ks = 0; ks < 6; ++ks) {
        const bf16x8 a = ldfrag(sK + (kk * 32 + l31) * LDKS + ks * 16 + hh * 8);
        sacc = mfma32(a, qf[ks], sacc);
      }
#pragma unroll
      for (int r = 0; r < 16; ++r) { const float p = __builtin_amdgcn_exp2f(sacc[r]); sacc[r] = p; lsum += p; }
#pragma unroll
      for (int s = 0; s < 2; ++s) {
        bf16x8 pb;
#pragma unroll
        for (int j = 0; j < 8; ++j) pb[j] = (__bf16)sacc[8 * s + j];
#pragma unroll
        for (int dt = 0; dt < 2; ++dt) {
          const bf16x8 a = ldfrag(sV + (dt * 32 + l31) * LDVS + kk * 32 + s * 16 + hh * 8);
          oacc[dt] = mfma32(a, pb, oacc[dt]);
        }
      }
    }
    if (kt + 1 < ntiles) swrite(cur ^ 1);
    __syncthreads();
  }
  lsum += __shfl_xor(lsum, 32);
  const float inv = 1.f / lsum;
  const int row = row_of(b, qpos0 + wave * 32 + l31);
  bf16* dst = P.H + (size_t)row * 1024 + 256 + h * 64;
#pragma unroll
  for (int dt = 0; dt < 2; ++dt)
#pragma unroll
    for (int rg = 0; rg < 4; ++rg) {
      const int d = dt * 32 + 8 * rg + 4 * hh;
      uint2 o;
      o.x = pack2(oacc[dt][4 * rg + 0] * inv, oacc[dt][4 * rg + 1] * inv);
      o.y = pack2(oacc[dt][4 * rg + 2] * inv, oacc[dt][4 * rg + 3] * inv);
      *reinterpret_cast<uint2*>(dst + d) = o;
    }
}

DEVI void phase_attn_scan(const Params& P, int l, unsigned char* smem_base, bool skip_scan = false) {
  if (!skip_scan)
    for (int it = NVB - 1 - VBID; it < 256; it += NVB) hgrn_scan_item(P, it);
  float sref;
  {
    const int lane = threadIdx.x & 63;
    float mq = fmaxf(fabsf(P.b_qh_w[l * 96 + lane]), lane < 32 ? fabsf(P.b_qh_w[l * 96 + 64 + lane]) : 0.f);
    float mk = fmaxf(fabsf(P.b_kh_w[l * 96 + lane]), lane < 32 ? fabsf(P.b_kh_w[l * 96 + 64 + lane]) : 0.f);
#pragma unroll
    for (int o = 32; o > 0; o >>= 1) { mq = fmaxf(mq, __shfl_xor(mq, o)); mk = fmaxf(mk, __shfl_xor(mk, o)); }
    sref = fminf(1.4426950408889634f * 9.797958971132712f * mq * mk, 60.f);
  }
  const int c = blockIdx.x, xcd = c & 7, slot = c >> 3;
  const int nrounds = (l == 0) ? 3 : 2;
  for (int r = 0; r < nrounds; ++r) {
    if (r < 2) {
      const int u = r * 32 + slot;
      const int bh = xcd * 8 + (u >> 3), qt = u & 7;
      if (slot < 32) attn_item8(P, bh >> 3, bh & 7, 256 + 256 * qt, 2304, sref, smem_base);
    } else if (c < 64) {
      attn_item8(P, c >> 3, c & 7, 0, 256, sref, smem_base);
    }
  }
}

DEVI unsigned ordkey(float s) { const unsigned u = __float_as_uint(s); return (u & 0x80000000u) ? ~u : (u | 0x80000000u); }
DEVI float keyval(unsigned k, unsigned mask) { const unsigned u = k & ~mask; return __uint_as_float((u & 0x80000000u) ? (u & 0x7fffffffu) : ~u); }
DEVI void ins16(unsigned (&lst)[16], unsigned v) {
#pragma unroll
  for (int j = 0; j < 16; ++j) { const unsigned hi = max(lst[j], v); v = min(lst[j], v); lst[j] = hi; }
}
DEVI void merge16(unsigned (&lst)[16], int xm) {
  unsigned o[16];
#pragma unroll
  for (int j = 0; j < 16; ++j) o[j] = (unsigned)__shfl_xor((int)lst[j], xm);
#pragma unroll
  for (int j = 0; j < 16; ++j) lst[j] = max(lst[j], o[15 - j]);
#pragma unroll
  for (int d = 8; d >= 1; d >>= 1)
#pragma unroll
    for (int j = 0; j < 16; ++j)
      if ((j & d) == 0) { const unsigned a = lst[j], bb = lst[j + d]; lst[j] = max(a, bb); lst[j + d] = min(a, bb); }
}

DEVI void bitonic_sort_desc16(unsigned (&v)[16]) {
#pragma unroll
  for (int k = 2; k <= 16; k <<= 1)
#pragma unroll
    for (int j = k >> 1; j > 0; j >>= 1)
#pragma unroll
      for (int i = 0; i < 16; ++i) {
        const int l = i ^ j;
        if (l > i) {
          const bool desc = ((i & k) == 0);
          const unsigned a = v[i], b = v[l];
          const unsigned mx = max(a, b), mn = min(a, b);
          v[i] = desc ? mx : mn; v[l] = desc ? mn : mx;
        }
      }
}
DEVI void bitonic_merge_desc16(unsigned (&lst)[16]) {
#pragma unroll
  for (int d = 8; d >= 1; d >>= 1)
#pragma unroll
    for (int j = 0; j < 16; ++j)
      if ((j & d) == 0) { const unsigned a = lst[j], bb = lst[j + d]; lst[j] = max(a, bb); lst[j + d] = min(a, bb); }
}
struct CandTab { int a[52]; int b[52]; };
constexpr CandTab make_cand_tab() {
  CandTab t{};
  int n = 0;
  for (int a = 0; a < 16; ++a)
    for (int b = 0; b < 16; ++b)
      if ((a + 1) * (b + 1) <= 16) { t.a[n] = a; t.b[n] = b; ++n; }
  for (; n < 52; ++n) { t.a[n] = 0; t.b[n] = 0; }
  return t;
}

DEVI void phase_route(const Params& P, int l, unsigned char* smem) {
  const int tid = TIDX, lane = tid & 63, wave = tid >> 6, l31 = lane & 31, hh = lane >> 5;
  bf16* QT = reinterpret_cast<bf16*>(smem);
  float* SC = reinterpret_cast<float*>(smem + 33792);
  const int mtiles = (l == 1) ? 256 : 288;
  for (int it = VBID; it < mtiles * 8; it += NVB) {
    const int mt = it >> 3, h = it & 7;
    __syncthreads();
    for (int e = tid; e < 64 * 32; e += 256) {
      const int r = e >> 5, cc = e & 31;
      *reinterpret_cast<uint4*>(QT + r * 264 + cc * 8) = *reinterpret_cast<const uint4*>(P.QP + (size_t)(mt * 64 + r) * 2048 + h * 256 + cc * 8);
    }
    __syncthreads();
    unsigned lst[2][16];
    const int row = tid >> 2, part = tid & 3;
#pragma unroll
    for (int p = 0; p < 2; ++p) {
      f32x16 sa[2]; sa[0] = zero16(); sa[1] = zero16();
      const bf16* keys = P.SK + ((size_t)(l * 16 + h * 2 + p) * 128 + wave * 32 + l31) * 128;
#pragma unroll
      for (int ks = 0; ks < 8; ++ks) {
        const bf16x8 bfr = ldfrag(keys + ks * 16 + hh * 8);
#pragma unroll
        for (int i = 0; i < 2; ++i) {
          const bf16x8 af = ldfrag(QT + (i * 32 + l31) * 264 + p * 128 + ks * 16 + hh * 8);
          sa[i] = mfma32(af, bfr, sa[i]);
        }
      }
      if (p == 1) __syncthreads();
#pragma unroll
      for (int i = 0; i < 2; ++i)
#pragma unroll
        for (int r = 0; r < 16; ++r) SC[(i * 32 + drow(r, hh)) * 129 + wave * 32 + l31] = sa[i][r];
      __syncthreads();
      unsigned B2[16];
#pragma unroll
      for (int i = 0; i < 16; ++i) {
        const int i0 = part * 32 + ((i + part * 8) & 31), i1 = part * 32 + ((i + 16 + part * 8) & 31);
        lst[p][i] = (ordkey(SC[row * 129 + i0]) & ~0x7fu) | (unsigned)(127 - i0);
        B2[i] = (ordkey(SC[row * 129 + i1]) & ~0x7fu) | (unsigned)(127 - i1);
      }
      bitonic_sort_desc16(lst[p]);
      bitonic_sort_desc16(B2);
#pragma unroll
      for (int j = 0; j < 16; ++j) lst[p][j] = max(lst[p][j], B2[15 - j]);
      bitonic_merge_desc16(lst[p]);
      merge16(lst[p], 1);
      merge16(lst[p], 2);
    }
    float v0[16], v1[16];
#pragma unroll
    for (int j = 0; j < 16; ++j) { v0[j] = keyval(lst[0][j], 0x7fu); v1[j] = keyval(lst[1][j], 0x7fu); }
    unsigned best[16];
    {
      constexpr CandTab CT = make_cand_tab();
#pragma unroll
      for (int c = 0; c < 13; ++c) {
        const int a0 = CT.a[4 * c + 0], a1 = CT.a[4 * c + 1], a2 = CT.a[4 * c + 2], a3 = CT.a[4 * c + 3];
        const int b0 = CT.b[4 * c + 0], b1 = CT.b[4 * c + 1], b2 = CT.b[4 * c + 2], b3 = CT.b[4 * c + 3];
        const float x = part == 0 ? v0[a0] : part == 1 ? v0[a1] : part == 2 ? v0[a2] : v0[a3];
        const float y = part == 0 ? v1[b0] : part == 1 ? v1[b1] : part == 2 ? v1[b2] : v1[b3];
        const int flat = part == 0 ? (a0 * 16 + b0) : part == 1 ? (a1 * 16 + b1) : part == 2 ? (a2 * 16 + b2) : (a3 * 16 + b3);
        const bool valid = part == 0 ? (4 * c + 0 < 50) : part == 1 ? (4 * c + 1 < 50) : part == 2 ? (4 * c + 2 < 50) : (4 * c + 3 < 50);
        const unsigned key = (ordkey(x + y) & ~0xffu) | (unsigned)(255 - flat);
        best[c] = valid ? key : 0u;
      }
      best[13] = 0u; best[14] = 0u; best[15] = 0u;
      bitonic_sort_desc16(best);
      merge16(best, 1);
      merge16(best, 2);
    }
    {
      const float mx = keyval(best[0], 0xffu);
      float es = 0.f;
      float ev[4]; int ex[4];
#pragma unroll
      for (int jj = 0; jj < 4; ++jj) {
        const unsigned kk = part == 0 ? best[4 * jj + 0] : part == 1 ? best[4 * jj + 1] : part == 2 ? best[4 * jj + 2] : best[4 * jj + 3];
        ev[jj] = __expf(keyval(kk, 0xffu) - mx);
        es += ev[jj];
        const int flat = 255 - (int)(kk & 0xffu);
        const int a = flat >> 4, bq = flat & 15;
        int i1 = 0, i2 = 0;
#pragma unroll
        for (int u = 0; u < 16; ++u) {
          i1 = (a == u) ? (127 - (int)(lst[0][u] & 0x7fu)) : i1;
          i2 = (bq == u) ? (127 - (int)(lst[1][u] & 0x7fu)) : i2;
        }
        ex[jj] = i1 * 128 + i2;
      }
      es += __shfl_xor(es, 1); es += __shfl_xor(es, 2);
      const float inv = 1.f / es;
      const int tok = mt * 64 + row;
      int* ed = P.EIDX + (size_t)tok * 128 + h * 16;
      float* gd = P.GATE + (size_t)tok * 128 + h * 16;
#pragma unroll
      for (int jj = 0; jj < 4; ++jj) { ed[4 * jj + part] = ex[jj]; gd[4 * jj + part] = ev[jj] * inv; }
    }
  }
}

DEVI float gelu_exact(float a) { return 0.5f * a * (1.f + erff(a * 0.70710678118654752f)); }

typedef float f2 __attribute__((ext_vector_type(2)));
DEVI void phase_peer(const Params& P, int l) {
  const int lane = TIDX & 63, half = lane >> 5, l32 = lane & 31;
  const int gw = VBID * 4 + (TIDX >> 6), nw = NVB * 4;
  const int nrows = (l == 1) ? NL : NT;
  const unsigned char* PU = P.PU8 + (size_t)l * 16384 * 576;
  const unsigned char* PV = P.PV8 + (size_t)l * 16384 * 576;
  const bool b4 = lane & 16, b3 = lane & 8, b2 = lane & 4;
  for (int t = gw; t < nrows; t += nw) {
    f2 h2[16];
    {
      const bf16* hp = P.H + (size_t)t * 1024 + l32 * 32;
#pragma unroll
      for (int i = 0; i < 4; ++i) {
        const uint4 hv = *reinterpret_cast<const uint4*>(hp + i * 8);
        h2[4 * i + 0] = (f2){lo2f(hv.x), hi2f(hv.x)}; h2[4 * i + 1] = (f2){lo2f(hv.y), hi2f(hv.y)};
        h2[4 * i + 2] = (f2){lo2f(hv.z), hi2f(hv.z)}; h2[4 * i + 3] = (f2){lo2f(hv.w), hi2f(hv.w)};
      }
    }
    const int e0 = P.EIDX[(size_t)t * 128 + lane], e1 = P.EIDX[(size_t)t * 128 + 64 + lane];
    const float g0 = P.GATE[(size_t)t * 128 + lane], g1 = P.GATE[(size_t)t * 128 + 64 + lane];
    f2 y2[16];
#pragma unroll
    for (int i = 0; i < 16; ++i) y2[i] = (f2){0.f, 0.f};
    for (int kb = 0; kb < 8; ++kb) {
      const int esrc = kb < 4 ? e0 : e1;
      uint4 ud[8], vd[8];
      unsigned short us[8], vs[8];
#pragma unroll
      for (int i = 0; i < 8; ++i) {
        const int e = __shfl(esrc, (kb * 16 + 2 * i + half) & 63);
        const unsigned char* ur = PU + (size_t)e * 576;
        const unsigned char* vr = PV + (size_t)e * 576;
        ud[i] = *reinterpret_cast<const uint4*>(ur + l32 * 16);
        us[i] = *reinterpret_cast<const unsigned short*>(ur + 512 + l32 * 2);
        vd[i] = *reinterpret_cast<const uint4*>(vr + l32 * 16);
        vs[i] = *reinterpret_cast<const unsigned short*>(vr + 512 + l32 * 2);
      }
      float d[8];
#pragma unroll
      for (int i = 0; i < 8; ++i) {
        const unsigned uw[4] = {ud[i].x, ud[i].y, ud[i].z, ud[i].w};
        f2 sacc = (f2){0.f, 0.f};
#pragma unroll
        for (int c = 0; c < 4; ++c) {
          sacc = __builtin_elementwise_fma(__builtin_amdgcn_cvt_scalef32_pk_f32_fp4(uw[c], 1.0f, 0), h2[4 * c + 0], sacc);
          sacc = __builtin_elementwise_fma(__builtin_amdgcn_cvt_scalef32_pk_f32_fp4(uw[c], 1.0f, 1), h2[4 * c + 1], sacc);
          sacc = __builtin_elementwise_fma(__builtin_amdgcn_cvt_scalef32_pk_f32_fp4(uw[c], 1.0f, 2), h2[4 * c + 2], sacc);
          sacc = __builtin_elementwise_fma(__builtin_amdgcn_cvt_scalef32_pk_f32_fp4(uw[c], 1.0f, 3), h2[4 * c + 3], sacc);
        }
        d[i] = (sacc.x + sacc.y) * __uint_as_float((unsigned)us[i] << 16);
      }
      float r4[4], r2[2], r1;
#pragma unroll
      for (int i = 0; i < 4; ++i) { const float mine = b4 ? d[4 + i] : d[i]; const float send = b4 ? d[i] : d[4 + i]; r4[i] = mine + __shfl_xor(send, 16); }
#pragma unroll
      for (int i = 0; i < 2; ++i) { const float mine = b3 ? r4[2 + i] : r4[i]; const float send = b3 ? r4[i] : r4[2 + i]; r2[i] = mine + __shfl_xor(send, 8); }
      { const float mine = b2 ? r2[1] : r2[0]; const float send = b2 ? r2[0] : r2[1]; r1 = mine + __shfl_xor(send, 4); }
      r1 += __shfl_xor(r1, 2); r1 += __shfl_xor(r1, 1);
      const int ksrc = (kb * 16 + 2 * ((lane >> 2) & 7) + half) & 63;
      const float gt = __shfl(kb < 4 ? g0 : g1, ksrc);
      const float w = gt * gelu_exact(r1);
#pragma unroll
      for (int i = 0; i < 8; ++i) {
        const float wi = __shfl(w, half * 32 + i * 4) * __uint_as_float((unsigned)vs[i] << 16);
        const f2 ww = (f2){wi, wi};
        const unsigned vw[4] = {vd[i].x, vd[i].y, vd[i].z, vd[i].w};
#pragma unroll
        for (int c = 0; c < 4; ++c) {
          y2[4 * c + 0] = __builtin_elementwise_fma(ww, __builtin_amdgcn_cvt_scalef32_pk_f32_fp4(vw[c], 1.0f, 0), y2[4 * c + 0]);
          y2[4 * c + 1] = __builtin_elementwise_fma(ww, __builtin_amdgcn_cvt_scalef32_pk_f32_fp4(vw[c], 1.0f, 1), y2[4 * c + 1]);
          y2[4 * c + 2] = __builtin_elementwise_fma(ww, __builtin_amdgcn_cvt_scalef32_pk_f32_fp4(vw[c], 1.0f, 2), y2[4 * c + 2]);
          y2[4 * c + 3] = __builtin_elementwise_fma(ww, __builtin_amdgcn_cvt_scalef32_pk_f32_fp4(vw[c], 1.0f, 3), y2[4 * c + 3]);
        }
      }
    }
    float y[16];
#pragma unroll
    for (int j = 0; j < 8; ++j) {
      const float ax = y2[j].x + __shfl_xor(y2[j].x, 32), ay = y2[j].y + __shfl_xor(y2[j].y, 32);
      const float bx = y2[8 + j].x + __shfl_xor(y2[8 + j].x, 32), by = y2[8 + j].y + __shfl_xor(y2[8 + j].y, 32);
      y[2 * j] = half ? bx : ax; y[2 * j + 1] = half ? by : ay;
    }
    const int bi = batch_of_row(t);
    const float* gate2 = P.MOD + (size_t)(l * 9 + bi) * 6144 + 5 * 1024;
    const int d0 = l32 * 32 + half * 16;
    float xn[16];
    float ss = 0.f;
#pragma unroll
    for (int q4 = 0; q4 < 4; ++q4) {
      const int d = d0 + q4 * 4;
      const float4 xo = *reinterpret_cast<const float4*>(P.X + (size_t)t * 1024 + d);
      const float4 gg = *reinterpret_cast<const float4*>(gate2 + d);
      float4 o;
      o.x = xo.x + gg.x * y[q4 * 4 + 0]; o.y = xo.y + gg.y * y[q4 * 4 + 1];
      o.z = xo.z + gg.z * y[q4 * 4 + 2]; o.w = xo.w + gg.w * y[q4 * 4 + 3];
      xn[q4 * 4 + 0] = o.x; xn[q4 * 4 + 1] = o.y; xn[q4 * 4 + 2] = o.z; xn[q4 * 4 + 3] = o.w;
      ss += o.x * o.x + o.y * o.y + o.z * o.z + o.w * o.w;
      if (l == 1) *reinterpret_cast<float4*>(P.out + (size_t)t * 1024 + d) = o;
      else *reinterpret_cast<float4*>(P.X + (size_t)t * 1024 + d) = o;
    }
    if (l == 0) {
      ss = wave_sum(ss);
      const float rr = rsqrtf(ss * (1.f / 1024.f) + EPS);
      const float* lnw = P.ln1_w + 1024;
      const float* mod = P.MOD + (size_t)(9 + bi) * 6144;
      unsigned pk[8];
#pragma unroll
      for (int i = 0; i < 16; i += 2) {
        const float o0 = xn[i] * rr * lnw[d0 + i] * (1.f + mod[1024 + d0 + i]) + mod[d0 + i];
        const float o1 = xn[i + 1] * rr * lnw[d0 + i + 1] * (1.f + mod[1024 + d0 + i + 1]) + mod[d0 + i + 1];
        pk[i >> 1] = pack2(o0, o1);
      }
      *reinterpret_cast<uint4*>(P.H + (size_t)t * 1024 + d0) = make_uint4(pk[0], pk[1], pk[2], pk[3]);
      *reinterpret_cast<uint4*>(P.H + (size_t)t * 1024 + d0 + 8) = make_uint4(pk[4], pk[5], pk[6], pk[7]);
    }
  }
}

using f32x4 = __attribute__((ext_vector_type(4))) float;
namespace g8 {
constexpr int BM = 256, BK = 64, HALF = 128, HT = HALF * BK;
DEVI int lds_byte(int r, int c) { const int st = (r >> 4) * 2 + (c >> 5), rr = r & 15, cc = c & 31, ob = rr * 64 + cc * 2; return st * 1024 + (ob ^ (((ob >> 9) & 1) << 5)); }
DEVI void stage_rc(int b, int& R, int& C) { const int st = b / 1024, sb = b % 1024, swz = sb ^ (((sb >> 9) & 1) << 5); R = (st >> 1) * 16 + swz / 64; C = (st & 1) * 32 + (swz % 64) / 2; }
DEVI void unit_of(int L, int nM, int nN, int& pm, int& pn) {
  const int nwg = nM * nN;
  int wgid = L;
  { const int q = nwg / 8, r = nwg % 8, xcd = wgid % 8, off = wgid / 8; wgid = (xcd < r ? xcd * (q + 1) : r * (q + 1) + (xcd - r) * q) + off; }
  const int nig = 8 * nN, gid = wgid / nig, fm = gid * 8, gsz = (nM - fm) < 8 ? (nM - fm) : 8;
  pm = fm + ((wgid % nig) % gsz); pn = (wgid % nig) / gsz;
}
}

struct G8Unit { int pm, pn; };
template <class Epi>
DEVI void gemm8_phase(LAS unsigned char* lds, const bf16* __restrict__ Ag, const bf16* __restrict__ Btg, const int K, const int nM, const int nN, const Epi& E) {
  constexpr int BK = 64, HALF = 128, HTB = HALF * BK * 2;
  const int tid = threadIdx.x, wid = __builtin_amdgcn_readfirstlane(tid >> 6), lane = tid & 63, wr = wid >> 2, wc = wid & 3, fr = lane & 15, fq = lane >> 4;
  const int nt = K / BK;
  const int nunits = nM * nN, G = gridDim.x, c = blockIdx.x;
  unsigned voffA[2];
#pragma unroll
  for (int i = 0; i < 2; ++i) { int R, C; g8::stage_rc(tid * 16 + i * 8192, R, C); voffA[i] = (unsigned)(R * K + C) * 2u; }
  const size_t kstep = (size_t)(BK * 2);
  const size_t hstep = (size_t)HALF * K * 2;
  const size_t tstep = 2 * hstep;
  const unsigned ldsw = (unsigned)wid * 1024u;
  const int aoff = g8::lds_byte(wr * 64 + fr, fq * 8), boff = g8::lds_byte(wc * 32 + fr, fq * 8);
#define PG8_SA(b, h) (((b) * 2 + (h)) * HTB)
#define PG8_SB(b, h) ((4 + (b) * 2 + (h)) * HTB)
#define PG8_STAGE(bufoff, gbase, voff) do { _Pragma("unroll") for (int _i = 0; _i < 2; ++_i) \
        __builtin_amdgcn_global_load_lds((const unsigned*)((const char*)(gbase) + (voff)[_i]), (LAS unsigned*)(lds + (bufoff) + ldsw + _i * 8192), 16, 0, 0); } while (0)
#define PG8_LDA(dst, b, h) do { _Pragma("unroll") for (int m = 0; m < 4; ++m) _Pragma("unroll") for (int k = 0; k < 2; ++k) dst[m][k] = *(const LAS bf16x8*)(lds + PG8_SA(b, h) + aoff + m * 2048 + k * 1024); } while (0)
#define PG8_LDB(dst, b, h) do { _Pragma("unroll") for (int n = 0; n < 2; ++n) _Pragma("unroll") for (int k = 0; k < 2; ++k) dst[n][k] = *(const LAS bf16x8*)(lds + PG8_SB(b, h) + boff + n * 2048 + k * 1024); } while (0)
#define PG8_MMA(ai, bj, At_, Bt_) do { __builtin_amdgcn_s_setprio(1); _Pragma("unroll") for (int m = 0; m < 4; ++m) _Pragma("unroll") for (int n = 0; n < 2; ++n) _Pragma("unroll") for (int k = 0; k < 2; ++k) \
        acc[ai][bj][m][n] = __builtin_amdgcn_mfma_f32_16x16x32_bf16(Bt_[n][k], At_[m][k], acc[ai][bj][m][n], 0, 0, 0); __builtin_amdgcn_s_setprio(0); } while (0)
#define PG8_WAIT_V(n) asm volatile("s_waitcnt vmcnt(" #n ")" ::: "memory")
#define PG8_WAIT_L(n) asm volatile("s_waitcnt lgkmcnt(" #n ")" ::: "memory")
#define PG8_BAR __builtin_amdgcn_s_barrier()
#define PG8_SCHED __builtin_amdgcn_sched_barrier(0)
  G8Unit cur, nxt; int ui = 0;
  if (c >= nunits) return;
  g8::unit_of(c, nM, nN, cur.pm, cur.pn);
  f32x4 acc[2][2][4][2];
#pragma unroll
  for (int a = 0; a < 2; ++a)
#pragma unroll
    for (int b = 0; b < 2; ++b)
#pragma unroll
      for (int m = 0; m < 4; ++m)
#pragma unroll
        for (int n = 0; n < 2; ++n) acc[a][b][m][n] = (f32x4){0.f, 0.f, 0.f, 0.f};
  bf16x8 At[4][2], B0[2][2], B1[2][2];
  const char* cA = (const char*)Ag + (size_t)cur.pm * tstep; const char* cB = (const char*)Btg + (size_t)cur.pn * tstep;
  PG8_STAGE(PG8_SB(0, 0), cB, voffA); PG8_STAGE(PG8_SA(0, 0), cA, voffA); PG8_STAGE(PG8_SB(0, 1), cB + hstep, voffA); PG8_STAGE(PG8_SA(0, 1), cA + hstep, voffA);
  if (wr == 1) PG8_BAR;
  PG8_WAIT_V(4); PG8_BAR;
  PG8_STAGE(PG8_SB(1, 0), cB + kstep, voffA); PG8_STAGE(PG8_SA(1, 0), cA + kstep, voffA); PG8_STAGE(PG8_SB(1, 1), cB + hstep + kstep, voffA);
  PG8_WAIT_V(6); PG8_BAR;
  for (;;) {
    const long Ln = (long)(ui + 1) * G + c;
    const bool has_next = Ln < nunits;
    if (has_next) g8::unit_of((int)Ln, nM, nN, nxt.pm, nxt.pn);
    const char* nA = has_next ? (const char*)Ag + (size_t)nxt.pm * tstep : cA; const char* nB = has_next ? (const char*)Btg + (size_t)nxt.pn * tstep : cB;
    for (int t = 0; t < nt; t += 2) {
      const bool last = (t == nt - 2);
      const char* a1 = cA + (size_t)(t + 1) * kstep;
      const char* a2 = last ? nA : cA + (size_t)(t + 2) * kstep; const char* b2 = last ? nB : cB + (size_t)(t + 2) * kstep;
      const char* a3 = a2 + kstep; const char* b3 = b2 + kstep;
      PG8_LDB(B0, 0, 0); PG8_SCHED; PG8_LDA(At, 0, 0); PG8_STAGE(PG8_SA(1, 1), a1 + hstep, voffA);
      PG8_WAIT_L(8); PG8_BAR; PG8_WAIT_L(0); PG8_MMA(0, 0, At, B0); PG8_BAR; PG8_SCHED;
      PG8_LDB(B1, 0, 1); PG8_STAGE(PG8_SB(0, 0), b2, voffA);
      PG8_BAR; PG8_WAIT_L(0); PG8_MMA(0, 1, At, B1); PG8_BAR;
      PG8_LDA(At, 0, 1); PG8_STAGE(PG8_SA(0, 0), a2, voffA);
      PG8_BAR; PG8_WAIT_L(0); PG8_MMA(1, 0, At, B0); PG8_BAR; PG8_SCHED;
      PG8_STAGE(PG8_SB(0, 1), b2 + hstep, voffA);
      PG8_WAIT_V(6); PG8_BAR; PG8_MMA(1, 1, At, B1); PG8_BAR;
      PG8_LDB(B0, 1, 0); PG8_SCHED; PG8_LDA(At, 1, 0); PG8_STAGE(PG8_SA(0, 1), a2 + hstep, voffA);
      PG8_WAIT_L(8); PG8_BAR; PG8_WAIT_L(0); PG8_MMA(0, 0, At, B0); PG8_BAR; PG8_SCHED;
      PG8_LDB(B1, 1, 1); PG8_STAGE(PG8_SB(1, 0), b3, voffA);
      PG8_BAR; PG8_WAIT_L(0); PG8_MMA(0, 1, At, B1); PG8_BAR;
      PG8_LDA(At, 1, 1); PG8_STAGE(PG8_SA(1, 0), a3, voffA);
      PG8_BAR; PG8_WAIT_L(0); PG8_MMA(1, 0, At, B0); PG8_BAR; PG8_SCHED;
      PG8_STAGE(PG8_SB(1, 1), b3 + hstep, voffA);
      PG8_WAIT_V(6); PG8_BAR; PG8_MMA(1, 1, At, B1); PG8_BAR;
    }
    E(acc, cur, wr, wc, fr, fq);
    if (!has_next) break;
#pragma unroll
    for (int a = 0; a < 2; ++a)
#pragma unroll
      for (int b = 0; b < 2; ++b)
#pragma unroll
        for (int m = 0; m < 4; ++m)
#pragma unroll
          for (int n = 0; n < 2; ++n) acc[a][b][m][n] = (f32x4){0.f, 0.f, 0.f, 0.f};
    cur = nxt; cA = nA; cB = nB; ++ui;
  }
  PG8_WAIT_V(0);
  if (wr == 0) PG8_BAR;
  PG8_BAR;
#undef PG8_SA
#undef PG8_SB
#undef PG8_STAGE
#undef PG8_LDA
#undef PG8_LDB
#undef PG8_MMA
}

struct EpiZ {
  bf16* Z;
  DEVI void operator()(const f32x4 (&acc)[2][2][4][2], const G8Unit& u, int wr, int wc, int fr, int fq) const {
    const int brow = u.pm * 256, bcol = u.pn * 256;
#pragma unroll
    for (int ai = 0; ai < 2; ++ai)
#pragma unroll
      for (int m = 0; m < 4; ++m) {
        const int row = brow + ai * 128 + wr * 64 + m * 16 + fr;
#pragma unroll
        for (int bj = 0; bj < 2; ++bj)
#pragma unroll
          for (int n = 0; n < 2; ++n) {
            const int col = bcol + bj * 128 + wc * 32 + n * 16 + 4 * fq;
            if (col < DIN) {
              const f32x4 v = acc[ai][bj][m][n];
              *reinterpret_cast<uint2*>(Z + (size_t)row * DIN + col) = make_uint2(pack2(v[0], v[1]), pack2(v[2], v[3]));
            }
          }
      }
  }
};
DEVI void phase_gemm1_8(const Params& P, int l, unsigned char* smem_base) {
  EpiZ E{P.Z};
  gemm8_phase((LAS unsigned char*)smem_base, P.H, P.WinT + (size_t)l * DINP * 1024, 1024, NT / 256, DINP / 256, E);
  const int c = blockIdx.x;
  if (c >= 136) {
    const int j = c - 136;
    if (l == 0) convert_rows_fp6(P, 0, j * 100, j * 100 + 100);
    else { const int b0 = 19200 + j * 114; convert_rows_fp6(P, 1, b0 < 32768 ? b0 : 32768, b0 + 114 < 32768 ? b0 + 114 : 32768); }
  }
}

struct EpiX {
  const float* x; const float* ctx; float* X; const float* MODl; int l;
  DEVI void operator()(const f32x4 (&acc)[2][2][4][2], const G8Unit& u, int wr, int wc, int fr, int fq) const {
    const int brow = u.pm * 256, bcol = u.pn * 256;
    const float* gate = MODl + (size_t)batch_of_row(brow) * 6144 + 2048;
#pragma unroll
    for (int ai = 0; ai < 2; ++ai)
#pragma unroll
      for (int m = 0; m < 4; ++m) {
        const int row = brow + ai * 128 + wr * 64 + m * 16 + fr;
        const float* res = (l == 0) ? (row < NL ? x + (size_t)row * 1024 : ctx + (size_t)(row - NL) * 1024) : X + (size_t)row * 1024;
#pragma unroll
        for (int bj = 0; bj < 2; ++bj)
#pragma unroll
          for (int n = 0; n < 2; ++n) {
            const int col = bcol + bj * 128 + wc * 32 + n * 16 + 4 * fq;
            const f32x4 v = acc[ai][bj][m][n];
            const float4 r4 = *reinterpret_cast<const float4*>(res + col);
            const float4 g4 = *reinterpret_cast<const float4*>(gate + col);
            float4 o; o.x = r4.x + g4.x * v[0]; o.y = r4.y + g4.y * v[1]; o.z = r4.z + g4.z * v[2]; o.w = r4.w + g4.w * v[3];
            *reinterpret_cast<float4*>(X + (size_t)row * 1024 + col) = o;
          }
      }
  }
};
DEVI void phase_gemm2_8(const Params& P, int l, unsigned char* smem_base) {
  EpiX E{P.x, P.ctx, P.X, P.MOD + (size_t)l * 9 * 6144, l};
  gemm8_phase((LAS unsigned char*)smem_base, P.H, P.WoutT + (size_t)l * 1024 * 1024, 1024, (l == 1) ? NL / 256 : NT / 256, 4, E);
  const int c = blockIdx.x;
  if (l == 0 && c >= 32) {
    const int b0 = 12000 + (c - 32) * 93;
    convert_rows_fp6(P, 0, b0 < 32768 ? b0 : 32768, b0 + 93 < 32768 ? b0 + 93 : 32768);
  }
}

struct EpiQP {
  bf16* QP;
  DEVI void operator()(const f32x4 (&acc)[2][2][4][2], const G8Unit& u, int wr, int wc, int fr, int fq) const {
    const int brow = u.pm * 256, bcol = u.pn * 256;
#pragma unroll
    for (int ai = 0; ai < 2; ++ai)
#pragma unroll
      for (int m = 0; m < 4; ++m) {
        const int row = brow + ai * 128 + wr * 64 + m * 16 + fr;
#pragma unroll
        for (int bj = 0; bj < 2; ++bj)
#pragma unroll
          for (int n = 0; n < 2; ++n) {
            const int col = bcol + bj * 128 + wc * 32 + n * 16 + 4 * fq;
            const f32x4 v = acc[ai][bj][m][n];
            *reinterpret_cast<uint2*>(QP + (size_t)row * 2048 + col) = make_uint2(pack2(v[0], v[1]), pack2(v[2], v[3]));
          }
      }
  }
};
DEVI void phase_gemm3_8(const Params& P, int l, unsigned char* smem_base) {
  EpiQP E{P.QP};
  gemm8_phase((LAS unsigned char*)smem_base, P.H, P.WpqT + (size_t)l * 2048 * 1024, 1024, (l == 1) ? NL / 256 : NT / 256, 8, E);
  const int c = blockIdx.x;
  if (l == 0 && c >= 64) convert_rows_fp6(P, 1, (c - 64) * 100, (c - 64) * 100 + 100);
}

constexpr int N_PHASES = 2 + 2 * 9;

#ifndef REP_MASK
#define REP_MASK 0
#endif
static_assert(sizeof(Params) % 8 == 0, "Params size");
DEVI Params load_params() {
#if defined(__HIP_DEVICE_COMPILE__)
  typedef const __attribute__((address_space(4))) Params* ParamsCP;
  ParamsCP pp = (ParamsCP)__builtin_amdgcn_kernarg_segment_ptr();
  asm volatile("" : "+s"(pp));
  return *pp;
#else
  return Params{};
#endif
}
__global__ void __launch_bounds__(512, 2) fwd_kernel(Params Pk) {
  extern __shared__ __attribute__((aligned(16))) unsigned char smem_base[];
  volatile LAS unsigned* xst = (volatile LAS unsigned*)(smem_base + SMEM_BYTES);
  if (threadIdx.x == 0) { xst[0] = 0u; xst[1] = 0u; xst[2] = 0u; xst[3] = 0u; }
  __syncthreads();
  XcdBarrier xb = xcd_barrier_post(Pk.bar, xst);
  const int phase_lo = Pk.phase_lo, phase_hi = Pk.phase_hi, coop = Pk.coop;
#define smem (smem_base + VHALF * HALF_LDS)
#define GSYNC(idx) { xcd_barrier(xb); }
#define RUN_PHASE2(idx, call, repcall) \
  if (phase_lo <= (idx) && (idx) <= phase_hi) { { const Params P = load_params(); call; } if (REP_MASK & (1 << (idx))) { GSYNC(1); const Params P = load_params(); repcall; } if (coop && (idx) < phase_hi) GSYNC(idx); }
#define RUN_PHASE(idx, call) RUN_PHASE2(idx, call, call)
  RUN_PHASE(0, phase_prologue(P, smem))
  RUN_PHASE(1, phase_norm(P, 0, 0, NT))
  RUN_PHASE(2, phase_gemm1_8(P, 0, smem_base))
  RUN_PHASE(3, { phase_mixA(P, 0, smem); phase_mla_proj(P, 0, smem); phase_hgrn_local(P, 0, smem); })
  RUN_PHASE2(4, phase_attn_scan(P, 0, smem_base), phase_attn_scan(P, 0, smem_base, true))
  RUN_PHASE(5, phase_hgrn_final(P, 0, smem))
  RUN_PHASE(6, phase_gemm2_8(P, 0, smem_base))
  RUN_PHASE(7, phase_norm(P, 0, 1, NT))
  RUN_PHASE(8, phase_gemm3_8(P, 0, smem_base))
  RUN_PHASE(9, phase_route(P, 0, smem))
  RUN_PHASE(10, phase_peer(P, 0))
  RUN_PHASE(11, phase_gemm1_8(P, 1, smem_base))
  RUN_PHASE(12, { phase_mixA(P, 1, smem); phase_mla_proj(P, 1, smem); phase_hgrn_local(P, 1, smem); })
  RUN_PHASE2(13, phase_attn_scan(P, 1, smem_base), phase_attn_scan(P, 1, smem_base, true))
  RUN_PHASE(14, phase_hgrn_final(P, 1, smem))
  RUN_PHASE(15, phase_gemm2_8(P, 1, smem_base))
  RUN_PHASE(16, phase_norm(P, 1, 1, NL))
  RUN_PHASE(17, phase_gemm3_8(P, 1, smem_base))
  RUN_PHASE(18, phase_route(P, 1, smem))
  RUN_PHASE(19, phase_peer(P, 1))
#undef smem
}

extern "C" void kernel_launch(void* const* d_in, const int* in_sizes, int n_in, void* d_out, int out_size, void* d_ws,
                              size_t ws_size, hipStream_t stream) {
  Params p{};
  const float* const* in = reinterpret_cast<const float* const*>(d_in);
  p.x = in[0]; p.c = in[1]; p.ctx = in[2]; p.c_ctx = in[3]; p.ln1_w = in[4]; p.ln2_w = in[5]; p.w_mod = in[6]; p.b_mod = in[7];
  p.w_in = in[8]; p.w_out = in[9]; p.a_norm_w = in[10]; p.a_w_s = in[11]; p.a_b_s = in[12]; p.b_q_norm_w = in[13]; p.b_w_uq = in[14];
  p.b_kv_norm_w = in[15]; p.b_w_ukv = in[16]; p.b_qh_w = in[17]; p.b_kh_w = in[18]; p.c_lb = in[19]; p.c_out_norm_w = in[20];
  p.p_w_q = in[21]; p.p_sub_keys = in[22]; p.p_u = in[23]; p.p_v = in[24];
  p.out = reinterpret_cast<float*>(d_out);
  unsigned char* ws = reinterpret_cast<unsigned char*>(d_ws);
  size_t off = 0;
  auto take = [&](size_t bytes) { unsigned char* r = ws + off; off += (bytes + 255) & ~(size_t)255; return r; };
  p.bar = (unsigned*)take((size_t)XCD_BAR_WORDS * 4);
  p.MOD = (float*)take((size_t)2 * 9 * 6144 * 4);
  p.ROPE = (float*)take((size_t)2048 * 32 * 4);
  p.WinT = (bf16*)take((size_t)2 * DINP * 1024 * 2);
  p.WoutT = (bf16*)take((size_t)2 * 1024 * 1024 * 2);
  p.WpqT = (bf16*)take((size_t)2 * 2048 * 1024 * 2);
  p.WuqT = (bf16*)take((size_t)2 * 768 * 256 * 2);
  p.WukvT = (bf16*)take((size_t)2 * 1024 * 128 * 2);
  p.SK = (bf16*)take((size_t)2 * 16 * 128 * 128 * 2);
  p.AWS = (bf16*)take((size_t)2 * 4 * 128 * 128 * 2);
  p.PU8 = (unsigned char*)take((size_t)2 * 16384 * 576);
  p.PV8 = (unsigned char*)take((size_t)2 * 16384 * 576);
  p.PUS = (float*)take((size_t)2 * 16384 * 4);
  p.PVS = (float*)take((size_t)2 * 16384 * 4);
  p.X = (float*)take((size_t)NT * 1024 * 4);
  p.H = (bf16*)take((size_t)NT * 1024 * 2);
  p.Z = (bf16*)take((size_t)NT * DIN * 2);
  p.Q = (bf16*)take((size_t)64 * SEQP * 96 * 2);
  p.K = (bf16*)take((size_t)64 * SEQP * 96 * 2);
  p.VT = (bf16*)take((size_t)64 * 64 * SEQP * 2);
  p.ST = (float*)take((size_t)64 * 36 * 4096 * 4);
  p.DEC = (float*)take((size_t)64 * 36 * 64 * 4);
  p.OI = (float*)take((size_t)NT * 256 * 4);
  p.GQF = (bf16*)take((size_t)NT * 256 * 2);
  p.GQB = (bf16*)take((size_t)NT * 256 * 2);
  p.QP = p.Z;
  p.EIDX = (int*)p.Q;
  p.GATE = (float*)p.K;
  if (off > ws_size) { fprintf(stderr, "workspace too small: need %zu have %zu\n", off, ws_size); }
  static int grid_blocks = 0;
  if (!grid_blocks) {
    if (hipFuncSetAttribute((const void*)fwd_kernel, hipFuncAttributeMaxDynamicSharedMemorySize, SMEM_TOTAL) != hipSuccess)
      fprintf(stderr, "hipFuncSetAttribute failed\n");
    int dev = 0, cus = 0, per_cu = 0;
    hipGetDevice(&dev);
    hipDeviceGetAttribute(&cus, hipDeviceAttributeMultiprocessorCount, dev);
    hipOccupancyMaxActiveBlocksPerMultiprocessor(&per_cu, (const void*)fwd_kernel, 512, SMEM_TOTAL);
    if (per_cu > 1) per_cu = 1;
    if (per_cu < 1) { fprintf(stderr, "occupancy query returned %d\n", per_cu); per_cu = 1; }
    grid_blocks = cus * per_cu;
    fprintf(stderr, "grid_blocks=%d (cus=%d per_cu=%d) ws need=%zu have=%zu\n", grid_blocks, cus, per_cu, off, ws_size);
  }
  hipMemsetAsync(p.bar, 0, (size_t)XCD_BAR_WORDS * 4, stream);
  p.coop = 1; p.phase_lo = 0; p.phase_hi = N_PHASES - 1;
  hipLaunchKernelGGL(fwd_kernel, dim3(grid_blocks), dim3(512), SMEM_TOTAL, stream, p);
  const hipError_t e = hipPeekAtLastError();
  if (e != hipSuccess) fprintf(stderr, "launch failed: %s (grid %d)\n", hipGetErrorString(e), grid_blocks);
}
```

```cpp
#include <hip/hip_runtime.h>
#include <hip/hip_cooperative_groups.h>
#include <cstdio>
#include <cstdint>
namespace cg = cooperative_groups;

#define DEVI __device__ __forceinline__

typedef unsigned short bf16;
using bf16x8 = __attribute__((ext_vector_type(8))) __bf16;
using bf16x2 = __attribute__((ext_vector_type(2))) __bf16;
using f32x16 = __attribute__((ext_vector_type(16))) float;
typedef unsigned v6u __attribute__((ext_vector_type(6)));
typedef unsigned v3u __attribute__((ext_vector_type(3)));
typedef float v16f __attribute__((ext_vector_type(16)));
typedef float v32f __attribute__((ext_vector_type(32)));

constexpr int NL = 16384;
constexpr int NT = 18432;
constexpr int DM = 1024;
constexpr int DIN = 2208;
constexpr int DINP = 2304;
constexpr int SEQP = 2304;
constexpr float EPS = 1e-6f;
constexpr int ZC_AU = 0, ZC_AV = 256, ZC_BQ = 512, ZC_BKV = 768, ZC_BKR = 896, ZC_CQ = 928, ZC_CFF = 1184, ZC_CFB = 1440, ZC_CI = 1696, ZC_CG = 1952;
constexpr int SMEM_BYTES = 2 * 80896;
constexpr int SMEM_TOTAL = SMEM_BYTES + 16;

struct Params {
  const float *x, *c, *ctx, *c_ctx, *ln1_w, *ln2_w, *w_mod, *b_mod, *w_in, *w_out, *a_norm_w, *a_w_s, *a_b_s;
  const float *b_q_norm_w, *b_w_uq, *b_kv_norm_w, *b_w_ukv, *b_qh_w, *b_kh_w, *c_lb, *c_out_norm_w, *p_w_q, *p_sub_keys, *p_u, *p_v;
  float* out;
  unsigned* bar;
  float* MOD;
  float* ROPE;
  bf16* WinT;
  bf16* WoutT;
  bf16* WpqT;
  bf16* WCOMB;
  bf16* RAW;
  bf16* SK;
  bf16* AWS;
  unsigned char* PU8;
  unsigned char* PV8;
  float* PUS;
  float* PVS;
  float* X;
  bf16* H;
  bf16* Z;
  bf16* Q;
  bf16* K;
  bf16* VT;
  float* ST;
  float* DEC;
  float* OI;
  float* WPE;
  bf16* GQF;
  bf16* GQB;
  bf16* QP;
  int* EIDX;
  float* GATE;
  int phase_lo, phase_hi, coop, pad0;
};

DEVI float bf2f(bf16 v) { return __uint_as_float(((unsigned)v) << 16); }
DEVI bf16 f2bf(float a) { __bf16 v = (__bf16)a; return __builtin_bit_cast(unsigned short, v); }
DEVI unsigned pack2(float a, float b) { bf16x2 v; v[0] = (__bf16)a; v[1] = (__bf16)b; return __builtin_bit_cast(unsigned, v); }
DEVI float lo2f(unsigned u) { return __uint_as_float(u << 16); }
DEVI float hi2f(unsigned u) { return __uint_as_float(u & 0xffff0000u); }
DEVI f32x16 zero16() { f32x16 z;
#pragma unroll
  for (int i = 0; i < 16; ++i) z[i] = 0.f; return z; }
DEVI f32x16 mfma32(bf16x8 a, bf16x8 b, f32x16 c) { return __builtin_amdgcn_mfma_f32_32x32x16_bf16(a, b, c, 0, 0, 0); }
DEVI bf16x8 ldfrag(const bf16* p) { return *reinterpret_cast<const bf16x8*>(p); }
DEVI int drow(int r, int hh) { return (r & 3) + 8 * (r >> 2) + 4 * hh; }
DEVI int row_of(int b, int p) { return p < 256 ? NL + b * 256 + p : b * 2048 + (p - 256); }
DEVI int batch_of_row(int r) { return r < NL ? (r >> 11) : 8; }
DEVI float wave_sum(float v) {
#pragma unroll
  for (int o = 32; o > 0; o >>= 1) v += __shfl_xor(v, o);
  return v;
}
DEVI float sigmoidf_(float z) { return 1.f / (1.f + __expf(-z)); }


#define XB_TMO      128
#define XB_XCNT(j)  (256  + 64 * (j))
#define XB_XSUB(j)  (1280 + 64 * (j))
#define XB_XGEN(j)  (2304 + 64 * (j))
#define XB_TOP      3328
#define XB_TOPGEN   3392
#define XCD_BAR_WORDS 3456
#define XB_SPIN_CAP (1u << 22)
#define LAS __attribute__((address_space(3)))
DEVI unsigned xb_ld(unsigned* p)              { return __hip_atomic_load(p, __ATOMIC_RELAXED, __HIP_MEMORY_SCOPE_AGENT); }
DEVI unsigned xb_add(unsigned* p, unsigned v) { return __hip_atomic_fetch_add(p, v, __ATOMIC_RELAXED, __HIP_MEMORY_SCOPE_AGENT); }
DEVI unsigned xb_xcc_id() { return (unsigned)__builtin_amdgcn_s_getreg((3 << 11) | 20) & 0xFu; }
#define XB_SPIN(cond, bar) do { unsigned _sp = 0; while (cond) { __builtin_amdgcn_s_sleep(1); \
    if ((++_sp & 255u) == 0u) { if (xb_ld(&(bar)[XB_TMO])) break; if (_sp > XB_SPIN_CAP) { atomicAdd(&(bar)[XB_TMO], 1u); break; } } } } while (0)
struct XcdBarrier { unsigned* bar; unsigned x; volatile LAS unsigned* st; };
DEVI XcdBarrier xcd_barrier_post(unsigned* bar, volatile LAS unsigned* st) {
  XcdBarrier b; b.bar = bar; b.x = xb_xcc_id(); b.st = st;
  if (threadIdx.x == 0) (void)xb_add(&bar[XB_XCNT(b.x)], 1u);
  return b;
}
DEVI void xcd_barrier_complete(unsigned* bar, unsigned x, unsigned& nloc, unsigned& nx) {
  const unsigned G = gridDim.x * gridDim.y * gridDim.z;
  unsigned sum, cnt, mine, sp = 0u;
  for (;;) {
    sum = 0u; cnt = 0u; mine = 0u;
#pragma unroll
    for (unsigned j = 0; j < 16; ++j) { const unsigned c = xb_ld(&bar[XB_XCNT(j)]); sum += c; cnt += (c > 0u) ? 1u : 0u; mine = (j == x) ? c : mine; }
    if (sum == G) break;
    __builtin_amdgcn_s_sleep(1);
    if ((++sp & 255u) == 0u) { if (xb_ld(&bar[XB_TMO])) break; if (sp > XB_SPIN_CAP) { atomicAdd(&bar[XB_TMO], 1u); break; } }
  }
  nloc = mine > 0u ? mine : 1u; nx = cnt > 0u ? cnt : 1u;
}
DEVI void xcd_barrier(const XcdBarrier& b) {
  asm volatile("s_waitcnt vmcnt(0)" ::: "memory");
  __syncthreads();
  if (threadIdx.x == 0) {
    unsigned* bar = b.bar;
    __builtin_amdgcn_s_waitcnt(0);
    unsigned nloc = b.st[0], nx = b.st[1];
    if (nloc == 0u) { xcd_barrier_complete(bar, b.x, nloc, nx); b.st[0] = nloc; b.st[1] = nx; }
    const unsigned old = xb_add(&bar[XB_XSUB(b.x)], 1u);
    const unsigned gen = old / nloc;
    if (old + 1u == (gen + 1u) * nloc) {
      __builtin_amdgcn_fence(__ATOMIC_RELEASE, "agent");
      asm volatile("s_waitcnt vmcnt(0)" ::: "memory");
      const unsigned og = xb_add(&bar[XB_TOP], 1u);
      const unsigned tg = og / nx;
      if (og + 1u == (tg + 1u) * nx) xb_add(&bar[XB_TOPGEN], 1u);
      else XB_SPIN(xb_ld(&bar[XB_TOPGEN]) == tg, bar);
      __builtin_amdgcn_fence(__ATOMIC_ACQUIRE, "agent");
      xb_add(&bar[XB_XGEN(b.x)], 1u);
      asm volatile("s_waitcnt vmcnt(0)" ::: "memory");
    } else {
      XB_SPIN(xb_ld(&bar[XB_XGEN(b.x)]) == gen, bar);
      __builtin_amdgcn_fence(__ATOMIC_ACQUIRE, "agent");
      asm volatile("s_waitcnt vmcnt(0)" ::: "memory");
    }
  }
  __syncthreads();
}

#define VHALF ((int)__builtin_amdgcn_readfirstlane((int)(threadIdx.x >> 8)))
#define TIDX ((int)(threadIdx.x & 255))
#define VBID ((int)(blockIdx.x * 2 + VHALF))
#define NVB ((int)(gridDim.x * 2))
constexpr int HALF_LDS = 80896;

DEVI void phase_mod(const Params& P, unsigned char* smem) {
  const int tid = TIDX;
  float* s = (float*)smem;
  float* red = s + 9 * 1024;
  for (int item = VBID; item < 192; item += NVB) {
    const int l = item / 96, j = item % 96;
    __syncthreads();
    for (int i = tid; i < 9 * 1024; i += 256) {
      int bi = i >> 10, k = i & 1023;
      float v = bi < 8 ? P.c[bi * 1024 + k] : P.c_ctx[k];
      s[i] = v * sigmoidf_(v);
    }
    __syncthreads();
    const int c4 = tid & 15, kg = tid >> 4;
    float acc[9][4];
#pragma unroll
    for (int bi = 0; bi < 9; ++bi) { acc[bi][0] = acc[bi][1] = acc[bi][2] = acc[bi][3] = 0.f; }
    const float* w = P.w_mod + (size_t)l * 1024 * 6144 + j * 64 + c4 * 4;
#pragma unroll 4
    for (int kk = 0; kk < 64; ++kk) {
      const int k = kg * 64 + kk;
      const float4 w4 = *reinterpret_cast<const float4*>(w + (size_t)k * 6144);
#pragma unroll
      for (int bi = 0; bi < 9; ++bi) {
        const float sv = s[bi * 1024 + k];
        acc[bi][0] += sv * w4.x; acc[bi][1] += sv * w4.y; acc[bi][2] += sv * w4.z; acc[bi][3] += sv * w4.w;
      }
    }
#pragma unroll
    for (int bi = 0; bi < 9; ++bi)
#pragma unroll
      for (int e = 0; e < 4; ++e) red[(kg * 9 + bi) * 64 + c4 * 4 + e] = acc[bi][e];
    __syncthreads();
    for (int o = tid; o < 576; o += 256) {
      const int bi = o >> 6, cc = o & 63;
      float sum = 0.f;
#pragma unroll
      for (int g = 0; g < 16; ++g) sum += red[(g * 9 + bi) * 64 + cc];
      P.MOD[(size_t)(l * 9 + bi) * 6144 + j * 64 + cc] = sum + P.b_mod[l * 6144 + j * 64 + cc];
    }
  }
}

DEVI void conv_T_tile(const float* __restrict__ src, int N, bf16* __restrict__ dst, int Kd, int k0, int n0,
                      const float* __restrict__ kscale, float* tile) {
  const int tid = TIDX;
  __syncthreads();
  for (int e = tid; e < 4096; e += 256) {
    const int i = e >> 6, j = e & 63, n = n0 + j;
    float v = (n < N) ? src[(size_t)(k0 + i) * N + n] : 0.f;
    if (kscale) v *= kscale[k0 + i];
    tile[i * 65 + j] = v;
  }
  __syncthreads();
  for (int e = tid; e < 2048; e += 256) {
    const int j = e >> 5, i2 = (e & 31) * 2;
    const unsigned pk = pack2(tile[i2 * 65 + j], tile[(i2 + 1) * 65 + j]);
    *reinterpret_cast<unsigned*>(&dst[(size_t)(n0 + j) * Kd + k0 + i2]) = pk;
  }
}

DEVI void conv_straight(const float* __restrict__ src, bf16* __restrict__ dst, size_t n8) {
  const size_t stride = (size_t)NVB * 256;
  for (size_t i = (size_t)VBID * 256 + TIDX; i < n8; i += stride) {
    const float4 a = reinterpret_cast<const float4*>(src)[2 * i];
    const float4 b = reinterpret_cast<const float4*>(src)[2 * i + 1];
    uint4 o; o.x = pack2(a.x, a.y); o.y = pack2(a.z, a.w); o.z = pack2(b.x, b.y); o.w = pack2(b.z, b.w);
    reinterpret_cast<uint4*>(dst)[i] = o;
  }
}

DEVI void convert_rows_fp6(const Params& P, int L, int i0, int i1) {
  const int lane = threadIdx.x & 63, half = lane >> 5, l32 = lane & 31;
  const int wv = threadIdx.x >> 6;
  for (int ib = i0 + wv * 2; ib < i1; ib += 16) {
    int i = ib + half; const bool live = i < i1; if (!live) i = i1 - 1;
    const int table = i >> 14, lr = L * 16384 + (i & 16383);
    const float* src = (table ? P.p_v : P.p_u) + (size_t)lr * 1024 + l32 * 32;
    float4 a[8];
    float m = 0.f;
#pragma unroll
    for (int q = 0; q < 8; ++q) {
      a[q] = *reinterpret_cast<const float4*>(src + q * 4);
      m = fmaxf(m, fmaxf(fmaxf(fabsf(a[q].x), fabsf(a[q].y)), fmaxf(fabsf(a[q].z), fabsf(a[q].w))));
    }
    const unsigned sb = (__float_as_uint(fmaxf(m, 1e-30f) * (1.f / 6.f)) + 0xffffu) >> 16;
    const float inv = 1.f / __uint_as_float(sb << 16);
    unsigned pk[4];
#pragma unroll
    for (int w = 0; w < 4; ++w) {
      unsigned word = 0u;
#pragma unroll
      for (int e = 0; e < 8; ++e) {
        const int idx = w * 8 + e;
        const float4 q4 = a[idx >> 2];
        const float xv = ((idx & 3) == 0 ? q4.x : (idx & 3) == 1 ? q4.y : (idx & 3) == 2 ? q4.z : q4.w) * inv;
        const float av = fabsf(xv);
        unsigned ci = (av > 0.25f) + (av > 0.75f) + (av > 1.25f) + (av > 1.75f) + (av > 2.5f) + (av > 3.5f) + (av > 5.f);
        ci |= (xv < 0.f) ? 8u : 0u;
        word |= ci << (4 * e);
      }
      pk[w] = word;
    }
    unsigned char* rowp = (table ? P.PV8 : P.PU8) + (size_t)lr * 576;
    if (live) {
      *reinterpret_cast<uint4*>(rowp + l32 * 16) = make_uint4(pk[0], pk[1], pk[2], pk[3]);
      *reinterpret_cast<unsigned short*>(rowp + 512 + l32 * 2) = (unsigned short)sb;
    }
  }
}

DEVI void phase_prologue(const Params& P, unsigned char* smem) {
  phase_mod(P, smem);
  float* tile = (float*)smem;
  for (int it = VBID; it < 2 * 1424; it += NVB) {
    const int l = it / 1424; int r = it % 1424;
    if (r < 576) { conv_T_tile(P.w_in + (size_t)l * 1024 * DIN, DIN, P.WinT + (size_t)l * DINP * 1024, 1024, (r % 16) * 64, (r / 16) * 64, nullptr, tile); continue; }
    r -= 576;
    if (r < 256) { conv_T_tile(P.w_out + (size_t)l * 1024 * 1024, 1024, P.WoutT + (size_t)l * 1024 * 1024, 1024, (r % 16) * 64, (r / 16) * 64, nullptr, tile); continue; }
    r -= 256;
    if (r < 512) { conv_T_tile(P.p_w_q + (size_t)l * 1024 * 2048, 2048, P.WpqT + (size_t)l * 2048 * 1024, 1024, (r % 16) * 64, (r / 16) * 64, nullptr, tile); continue; }
    r -= 512;
    if (r < 48) { conv_T_tile(P.b_w_uq + (size_t)l * 256 * 768, 768, P.WCOMB + (size_t)l * 1792 * 256, 256, (r % 4) * 64, (r / 4) * 64, P.b_q_norm_w + l * 256, tile); continue; }
    r -= 48;
    conv_T_tile(P.b_w_ukv + (size_t)l * 128 * 1024, 1024, P.WCOMB + (size_t)l * 1792 * 256 + 768 * 256, 256, (r % 2) * 64, (r / 2) * 64, P.b_kv_norm_w + l * 128, tile);
  }
  for (int i = VBID * 256 + TIDX; i < 2 * 1024 * 16; i += NVB * 256) {
    const int l2 = i >> 14, rr = (i >> 4) & 1023, cc = i & 15;
    *reinterpret_cast<uint4*>(P.WCOMB + (size_t)l2 * 1792 * 256 + (size_t)(768 + rr) * 256 + 128 + cc * 8) = make_uint4(0u, 0u, 0u, 0u);
  }
  conv_straight(P.p_sub_keys, P.SK, (size_t)2 * 16 * 128 * 128 / 8);
  conv_straight(P.a_w_s, P.AWS, (size_t)2 * 4 * 128 * 128 / 8);
  for (int i = VBID * 256 + TIDX; i < 2048 * 16; i += NVB * 256) {
    const int t = i >> 4, a = (i >> 3) & 1, f = i & 7;
    const float inv = powf(10000.f, -(float)f / 8.f);
    const float pos = a ? (float)(t & 63) : (float)(t >> 6);
    const float ang = pos * inv;
    P.ROPE[t * 32 + a * 8 + f] = cosf(ang);
    P.ROPE[t * 32 + 16 + a * 8 + f] = sinf(ang);
  }
}

DEVI void phase_norm(const Params& P, int l, int which, int nrows) {
  const int lane = TIDX & 63;
  const int gw = VBID * 4 + (TIDX >> 6), nw = NVB * 4;
  const float* lnw = (which == 0 ? P.ln1_w : P.ln2_w) + l * 1024;
  for (int r = gw; r < nrows; r += nw) {
    const float* src;
    if (which == 0 && l == 0) src = r < NL ? P.x + (size_t)r * 1024 : P.ctx + (size_t)(r - NL) * 1024;
    else src = P.X + (size_t)r * 1024;
    const float* mod = P.MOD + (size_t)(l * 9 + batch_of_row(r)) * 6144 + which * 3072;
    float4 v[4];
    float ss = 0.f;
#pragma unroll
    for (int i = 0; i < 4; ++i) {
      v[i] = *reinterpret_cast<const float4*>(src + i * 256 + lane * 4);
      ss += v[i].x * v[i].x + v[i].y * v[i].y + v[i].z * v[i].z + v[i].w * v[i].w;
    }
    ss = wave_sum(ss);
    const float rr = rsqrtf(ss * (1.f / 1024.f) + EPS);
#pragma unroll
    for (int i = 0; i < 4; ++i) {
      const int d = i * 256 + lane * 4;
      const float4 w = *reinterpret_cast<const float4*>(lnw + d);
      const float4 sh = *reinterpret_cast<const float4*>(mod + d);
      const float4 sc = *reinterpret_cast<const float4*>(mod + 1024 + d);
      const float o0 = v[i].x * rr * w.x * (1.f + sc.x) + sh.x;
      const float o1 = v[i].y * rr * w.y * (1.f + sc.y) + sh.y;
      const float o2 = v[i].z * rr * w.z * (1.f + sc.z) + sh.z;
      const float o3 = v[i].w * rr * w.w * (1.f + sc.w) + sh.w;
      uint2 o; o.x = pack2(o0, o1); o.y = pack2(o2, o3);
      *reinterpret_cast<uint2*>(P.H + (size_t)r * 1024 + d) = o;
    }
  }
}

template <int BM, int BN, int BK, int WM, int WN>
struct Gemm {
  static constexpr int LDK = BK + 8;
  static constexpr int TM = BM / WM / 32, TN = BN / WN / 32;
  static constexpr int CPR = BK / 8;
  static constexpr int NA = BM * CPR / 256, NB = BN * CPR / 256;
  static constexpr int A_BYTES = BM * LDK * 2, B_BYTES = BN * LDK * 2;
  static constexpr int STAGE_BYTES = A_BYTES + B_BYTES;
  static constexpr int SMEM = 2 * STAGE_BYTES;

  static DEVI void run(const bf16* __restrict__ A, int lda, const bf16* __restrict__ BT, int ldb, int K,
                       unsigned char* smem, f32x16 (&acc)[TM][TN]) {
    const int tid = TIDX, lane = tid & 63, wave = tid >> 6;
    const int wm = wave / WN, wn = wave % WN;
    const int l31 = lane & 31, hh = lane >> 5;
#pragma unroll
    for (int i = 0; i < TM; ++i)
#pragma unroll
      for (int j = 0; j < TN; ++j) acc[i][j] = zero16();
    uint4 ra[NA], rb[NB];
    const int nk = K / BK;
    auto gload = [&](int kt) {
#pragma unroll
      for (int i = 0; i < NA; ++i) { const int ch = tid + i * 256, row = ch / CPR, cc = ch % CPR;
        ra[i] = *reinterpret_cast<const uint4*>(A + (size_t)row * lda + kt * BK + cc * 8); }
#pragma unroll
      for (int i = 0; i < NB; ++i) { const int ch = tid + i * 256, row = ch / CPR, cc = ch % CPR;
        rb[i] = *reinterpret_cast<const uint4*>(BT + (size_t)row * ldb + kt * BK + cc * 8); }
    };
    auto swrite = [&](int buf) {
      bf16* sA = reinterpret_cast<bf16*>(smem + buf * STAGE_BYTES);
      bf16* sB = reinterpret_cast<bf16*>(smem + buf * STAGE_BYTES + A_BYTES);
#pragma unroll
      for (int i = 0; i < NA; ++i) { const int ch = tid + i * 256, row = ch / CPR, cc = ch % CPR;
        *reinterpret_cast<uint4*>(sA + row * LDK + cc * 8) = ra[i]; }
#pragma unroll
      for (int i = 0; i < NB; ++i) { const int ch = tid + i * 256, row = ch / CPR, cc = ch % CPR;
        *reinterpret_cast<uint4*>(sB + row * LDK + cc * 8) = rb[i]; }
    };
    __syncthreads();
    gload(0);
    swrite(0);
    __syncthreads();
    for (int kt = 0; kt < nk; ++kt) {
      const int cur = kt & 1;
      if (kt + 1 < nk) gload(kt + 1);
      const bf16* sA = reinterpret_cast<const bf16*>(smem + cur * STAGE_BYTES);
      const bf16* sB = reinterpret_cast<const bf16*>(smem + cur * STAGE_BYTES + A_BYTES);
#pragma unroll
      for (int ks = 0; ks < BK / 16; ++ks) {
        bf16x8 af[TM], bfr[TN];
#pragma unroll
        for (int i = 0; i < TM; ++i) af[i] = ldfrag(sA + (wm * (BM / WM) + i * 32 + l31) * LDK + ks * 16 + hh * 8);
#pragma unroll
        for (int j = 0; j < TN; ++j) bfr[j] = ldfrag(sB + (wn * (BN / WN) + j * 32 + l31) * LDK + ks * 16 + hh * 8);
#pragma unroll
        for (int i = 0; i < TM; ++i)
#pragma unroll
          for (int j = 0; j < TN; ++j) acc[i][j] = mfma32(af[i], bfr[j], acc[i][j]);
      }
      if (kt + 1 < nk) swrite(cur ^ 1);
      __syncthreads();
    }
  }
};

DEVI void phase_gemm1(const Params& P, int l, unsigned char* smem) {
  using G = Gemm<128, 128, 64, 2, 2>;
  const int lane = TIDX & 63, wave = TIDX >> 6, wm = wave >> 1, wn = wave & 1, l31 = lane & 31, hh = lane >> 5;
  const bf16* W = P.WinT + (size_t)l * DINP * 1024;
  for (int t = VBID; t < 144 * 18; t += NVB) {
    const int mt = t / 18, nt = t % 18;
    f32x16 acc[2][2];
    G::run(P.H + (size_t)mt * 128 * 1024, 1024, W + (size_t)nt * 128 * 1024, 1024, 1024, smem, acc);
#pragma unroll
    for (int i = 0; i < 2; ++i)
#pragma unroll
      for (int j = 0; j < 2; ++j) {
        const int col = nt * 128 + wn * 64 + j * 32 + l31;
        if (col < DIN) {
#pragma unroll
          for (int r = 0; r < 16; ++r) {
            const int row = mt * 128 + wm * 64 + i * 32 + drow(r, hh);
            P.Z[(size_t)row * DIN + col] = f2bf(acc[i][j][r]);
          }
        }
      }
  }
}

DEVI void phase_gemm2(const Params& P, int l, unsigned char* smem) {
  using G = Gemm<128, 128, 64, 2, 2>;
  const int lane = TIDX & 63, wave = TIDX >> 6, wm = wave >> 1, wn = wave & 1, l31 = lane & 31, hh = lane >> 5;
  const bf16* W = P.WoutT + (size_t)l * 1024 * 1024;
  const int mtiles = (l == 1) ? 128 : 144;
  for (int t = VBID; t < mtiles * 8; t += NVB) {
    const int mt = t / 8, nt = t % 8;
    f32x16 acc[2][2];
    G::run(P.H + (size_t)mt * 128 * 1024, 1024, W + (size_t)nt * 128 * 1024, 1024, 1024, smem, acc);
    const int bi = batch_of_row(mt * 128);
    const float* gate = P.MOD + (size_t)(l * 9 + bi) * 6144 + 2048;
#pragma unroll
    for (int i = 0; i < 2; ++i)
#pragma unroll
      for (int j = 0; j < 2; ++j) {
        const int col = nt * 128 + wn * 64 + j * 32 + l31;
        const float g = gate[col];
#pragma unroll
        for (int r = 0; r < 16; ++r) {
          const int row = mt * 128 + wm * 64 + i * 32 + drow(r, hh);
          float res;
          if (l == 0) res = row < NL ? P.x[(size_t)row * 1024 + col] : P.ctx[(size_t)(row - NL) * 1024 + col];
          else res = P.X[(size_t)row * 1024 + col];
          P.X[(size_t)row * 1024 + col] = res + g * acc[i][j][r];
        }
      }
  }
}

DEVI void phase_mixA(const Params& P, int l, unsigned char* smem) {
  const int tid = TIDX, lane = tid & 63, wave = tid >> 6, l31 = lane & 31, hh = lane >> 5;
  bf16* VNT = reinterpret_cast<bf16*>(smem);
  constexpr int LDV = 136;
  const int nseg = (l == 1) ? 16 : 18;
  const int seg0 = (l == 1) ? 2 : 0;
  for (int it = VBID; it < 8 * nseg * 4; it += NVB) {
    const int a = it & 3; const int sj = (it >> 2) % nseg + seg0; const int b = (it >> 2) / nseg;
    const int p0 = sj * 128;
    __syncthreads();
    {
      const int q = tid >> 1, half = tid & 1;
      const int row = row_of(b, p0 + q);
      const bf16* src = P.Z + (size_t)row * DIN + ZC_AV + a * 64 + half * 32;
      float v[32];
      float ss = 0.f;
#pragma unroll
      for (int i = 0; i < 4; ++i) {
        const uint4 u = *reinterpret_cast<const uint4*>(src + i * 8);
        v[i * 8 + 0] = lo2f(u.x); v[i * 8 + 1] = hi2f(u.x); v[i * 8 + 2] = lo2f(u.y); v[i * 8 + 3] = hi2f(u.y);
        v[i * 8 + 4] = lo2f(u.z); v[i * 8 + 5] = hi2f(u.z); v[i * 8 + 6] = lo2f(u.w); v[i * 8 + 7] = hi2f(u.w);
      }
#pragma unroll
      for (int i = 0; i < 32; ++i) ss += v[i] * v[i];
      ss += __shfl_xor(ss, 1);
      const float rr = rsqrtf(ss * (1.f / 64.f) + EPS);
      const float* nw = P.a_norm_w + l * 256 + a * 64 + half * 32;
#pragma unroll
      for (int i = 0; i < 32; ++i) VNT[(half * 32 + i) * LDV + q] = f2bf(v[i] * rr * nw[i]);
    }
    __syncthreads();
    f32x16 acc[2]; acc[0] = zero16(); acc[1] = zero16();
    const bf16* Aw = P.AWS + (size_t)(l * 4 + a) * 128 * 128 + (size_t)(wave * 32 + l31) * 128;
#pragma unroll
    for (int ks = 0; ks < 8; ++ks) {
      const bf16x8 af = ldfrag(Aw + ks * 16 + hh * 8);
#pragma unroll
      for (int j = 0; j < 2; ++j) {
        const bf16x8 bfr = ldfrag(VNT + (j * 32 + l31) * LDV + ks * 16 + hh * 8);
        acc[j] = mfma32(af, bfr, acc[j]);
      }
    }
    const float* bs = P.a_b_s + (l * 4 + a) * 128;
#pragma unroll
    for (int j = 0; j < 2; ++j)
#pragma unroll
      for (int r = 0; r < 16; ++r) {
        const int p = wave * 32 + drow(r, hh);
        const int row = row_of(b, p0 + p);
        const int col = a * 64 + j * 32 + l31;
        const float u = bf2f(P.Z[(size_t)row * DIN + ZC_AU + col]);
        P.H[(size_t)row * 1024 + col] = f2bf(u * (acc[j][r] + bs[p]));
      }
  }
}

DEVI void mla_norm_rope_store(const Params& P, const float* T, const float* nw, bool rope, float oscale,
                              bf16* dstbase  , int pos0, int tlat0) {
  const int tid = TIDX, tok = tid >> 1, half = tid & 1;
  float v[48];
  float ss = 0.f;
#pragma unroll
  for (int i = 0; i < 48; ++i) { v[i] = T[tok * 97 + half * 48 + i]; ss += v[i] * v[i]; }
  ss += __shfl_xor(ss, 1);
  const float rr = rsqrtf(ss * (1.f / 96.f) + EPS);
#pragma unroll
  for (int i = 0; i < 48; ++i) v[i] = v[i] * rr * nw[half * 48 + i];
  if (rope && half == 1) {
    const float* cs = P.ROPE + (size_t)(tlat0 + tok) * 32;
#pragma unroll
    for (int a = 0; a < 2; ++a)
#pragma unroll
      for (int f = 0; f < 8; ++f) {
        const float x1 = v[16 + a * 16 + f], x2 = v[16 + a * 16 + 8 + f];
        const float c = cs[a * 8 + f], s = cs[16 + a * 8 + f];
        v[16 + a * 16 + f] = x1 * c - x2 * s;
        v[16 + a * 16 + 8 + f] = x2 * c + x1 * s;
      }
  }
  bf16* dst = dstbase + (size_t)(pos0 + tok) * 96 + half * 48;
#pragma unroll
  for (int i = 0; i < 6; ++i) {
    uint4 o;
    o.x = pack2(v[i * 8 + 0] * oscale, v[i * 8 + 1] * oscale); o.y = pack2(v[i * 8 + 2] * oscale, v[i * 8 + 3] * oscale);
    o.z = pack2(v[i * 8 + 4] * oscale, v[i * 8 + 5] * oscale); o.w = pack2(v[i * 8 + 6] * oscale, v[i * 8 + 7] * oscale);
    *reinterpret_cast<uint4*>(dst + i * 8) = o;
  }
}

DEVI void phase_mla_proj(const Params& P, int l, unsigned char* smem) {
  const int tid = TIDX;
  float* T = reinterpret_cast<float*>(smem);
  bf16* TV = reinterpret_cast<bf16*>(smem + 128 * 97 * 4);
  const float qscale = 0.10206207261596577f * 1.4426950408889634f;
  const int tok = tid >> 1, half = tid & 1;
  for (int it = VBID; it < 144 * 8; it += NVB) {
    const int h = it & 7;
    const int m0 = (it >> 3) * 128;
    const bool lat = m0 < NL;
    const int b = lat ? (m0 >> 11) : ((m0 - NL) >> 8);
    const int pos0 = lat ? 256 + (m0 & 2047) : ((m0 - NL) & 255);
    const int tlat0 = lat ? (m0 & 2047) : 0;
    const bool doq = lat || (l == 0);
    const bf16* zr = P.Z + (size_t)(m0 + tok) * DIN;
    const bf16* rr = P.RAW + (size_t)(m0 + tok) * 1792;
    __syncthreads();
    float rskv, rsq = 0.f;
    {
      float ss = 0.f;
#pragma unroll
      for (int i = 0; i < 8; ++i) {
        const uint4 u = *reinterpret_cast<const uint4*>(zr + ZC_BKV + half * 64 + i * 8);
        ss += lo2f(u.x) * lo2f(u.x) + hi2f(u.x) * hi2f(u.x) + lo2f(u.y) * lo2f(u.y) + hi2f(u.y) * hi2f(u.y)
            + lo2f(u.z) * lo2f(u.z) + hi2f(u.z) * hi2f(u.z) + lo2f(u.w) * lo2f(u.w) + hi2f(u.w) * hi2f(u.w);
      }
      ss += __shfl_xor(ss, 1);
      rskv = rsqrtf(ss * (1.f / 128.f) + EPS);
      if (doq) {
        float sq = 0.f;
#pragma unroll
        for (int i = 0; i < 16; ++i) {
          const uint4 u = *reinterpret_cast<const uint4*>(zr + ZC_BQ + half * 128 + i * 8);
          sq += lo2f(u.x) * lo2f(u.x) + hi2f(u.x) * hi2f(u.x) + lo2f(u.y) * lo2f(u.y) + hi2f(u.y) * hi2f(u.y)
              + lo2f(u.z) * lo2f(u.z) + hi2f(u.z) * hi2f(u.z) + lo2f(u.w) * lo2f(u.w) + hi2f(u.w) * hi2f(u.w);
        }
        sq += __shfl_xor(sq, 1);
        rsq = rsqrtf(sq * (1.f / 256.f) + EPS);
      }
    }
    {
      const bf16* kn = rr + 768 + h * 128 + half * 32;
      const bf16* vv = rr + 768 + h * 128 + 64 + half * 32;
#pragma unroll
      for (int i = 0; i < 4; ++i) {
        const uint4 u = *reinterpret_cast<const uint4*>(kn + i * 8);
        float* tp = T + tok * 97 + half * 32 + i * 8;
        tp[0] = lo2f(u.x) * rskv; tp[1] = hi2f(u.x) * rskv; tp[2] = lo2f(u.y) * rskv; tp[3] = hi2f(u.y) * rskv;
        tp[4] = lo2f(u.z) * rskv; tp[5] = hi2f(u.z) * rskv; tp[6] = lo2f(u.w) * rskv; tp[7] = hi2f(u.w) * rskv;
        const uint4 w = *reinterpret_cast<const uint4*>(vv + i * 8);
        bf16* vp = TV + (half * 32 + i * 8) * 136 + tok;
        vp[0 * 136] = f2bf(lo2f(w.x) * rskv); vp[1 * 136] = f2bf(hi2f(w.x) * rskv); vp[2 * 136] = f2bf(lo2f(w.y) * rskv); vp[3 * 136] = f2bf(hi2f(w.y) * rskv);
        vp[4 * 136] = f2bf(lo2f(w.z) * rskv); vp[5 * 136] = f2bf(hi2f(w.z) * rskv); vp[6 * 136] = f2bf(lo2f(w.w) * rskv); vp[7 * 136] = f2bf(hi2f(w.w) * rskv);
      }
#pragma unroll
      for (int i = 0; i < 2; ++i) {
        const uint4 u = *reinterpret_cast<const uint4*>(zr + ZC_BKR + half * 16 + i * 8);
        float* tp = T + tok * 97 + 64 + half * 16 + i * 8;
        tp[0] = lo2f(u.x); tp[1] = hi2f(u.x); tp[2] = lo2f(u.y); tp[3] = hi2f(u.y);
        tp[4] = lo2f(u.z); tp[5] = hi2f(u.z); tp[6] = lo2f(u.w); tp[7] = hi2f(u.w);
      }
    }
    __syncthreads();
    mla_norm_rope_store(P, T, P.b_kh_w + l * 96, lat, 1.f, P.K + (size_t)(b * 8 + h) * SEQP * 96, pos0, tlat0);
    {
      const int d = tid >> 2, qtr = tid & 3;
      bf16* dst = P.VT + ((size_t)(b * 8 + h) * 64 + d) * SEQP + pos0 + qtr * 32;
      const bf16* src = TV + d * 136 + qtr * 32;
#pragma unroll
      for (int i = 0; i < 4; ++i) *reinterpret_cast<uint4*>(dst + i * 8) = *reinterpret_cast<const uint4*>(src + i * 8);
    }
    if (doq) {
      __syncthreads();
      const bf16* qq = rr + h * 96 + half * 48;
#pragma unroll
      for (int i = 0; i < 6; ++i) {
        const uint4 u = *reinterpret_cast<const uint4*>(qq + i * 8);
        float* tp = T + tok * 97 + half * 48 + i * 8;
        tp[0] = lo2f(u.x) * rsq; tp[1] = hi2f(u.x) * rsq; tp[2] = lo2f(u.y) * rsq; tp[3] = hi2f(u.y) * rsq;
        tp[4] = lo2f(u.z) * rsq; tp[5] = hi2f(u.z) * rsq; tp[6] = lo2f(u.w) * rsq; tp[7] = hi2f(u.w) * rsq;
      }
      __syncthreads();
      mla_norm_rope_store(P, T, P.b_qh_w + l * 96, lat, qscale, P.Q + (size_t)(b * 8 + h) * SEQP * 96, pos0, tlat0);
    }
  }
}

DEVI void hgrn_load(const Params& P, int l, int b, int hd, int c, float* BF, float* RB, float* SEG,
                    float (&q)[16], float (&kf)[16], float (&kb)[16], float (&v)[16], bool need_kv) {
  const int tid = TIDX, t = tid >> 2, k0 = (tid & 3) * 16;
  const int row = row_of(b, c * 64 + t);
  const bf16* z = P.Z + (size_t)row * DIN + hd * 64 + k0;
  float zf[16], zb[16];
#pragma unroll
  for (int i = 0; i < 2; ++i) {
    const uint4 uq = *reinterpret_cast<const uint4*>(z + ZC_CQ + i * 8);
    const uint4 uf = *reinterpret_cast<const uint4*>(z + ZC_CFF + i * 8);
    const uint4 ub = *reinterpret_cast<const uint4*>(z + ZC_CFB + i * 8);
    q[i * 8 + 0] = lo2f(uq.x); q[i * 8 + 1] = hi2f(uq.x); q[i * 8 + 2] = lo2f(uq.y); q[i * 8 + 3] = hi2f(uq.y);
    q[i * 8 + 4] = lo2f(uq.z); q[i * 8 + 5] = hi2f(uq.z); q[i * 8 + 6] = lo2f(uq.w); q[i * 8 + 7] = hi2f(uq.w);
    zf[i * 8 + 0] = lo2f(uf.x); zf[i * 8 + 1] = hi2f(uf.x); zf[i * 8 + 2] = lo2f(uf.y); zf[i * 8 + 3] = hi2f(uf.y);
    zf[i * 8 + 4] = lo2f(uf.z); zf[i * 8 + 5] = hi2f(uf.z); zf[i * 8 + 6] = lo2f(uf.w); zf[i * 8 + 7] = hi2f(uf.w);
    zb[i * 8 + 0] = lo2f(ub.x); zb[i * 8 + 1] = hi2f(ub.x); zb[i * 8 + 2] = lo2f(ub.y); zb[i * 8 + 3] = hi2f(ub.y);
    zb[i * 8 + 4] = lo2f(ub.z); zb[i * 8 + 5] = hi2f(ub.z); zb[i * 8 + 6] = lo2f(ub.w); zb[i * 8 + 7] = hi2f(ub.w);
    if (need_kv) {
      const uint4 uv = *reinterpret_cast<const uint4*>(z + ZC_CI + i * 8);
      v[i * 8 + 0] = lo2f(uv.x); v[i * 8 + 1] = hi2f(uv.x); v[i * 8 + 2] = lo2f(uv.y); v[i * 8 + 3] = hi2f(uv.y);
      v[i * 8 + 4] = lo2f(uv.z); v[i * 8 + 5] = hi2f(uv.z); v[i * 8 + 6] = lo2f(uv.w); v[i * 8 + 7] = hi2f(uv.w);
    }
  }
#pragma unroll
  for (int i = 0; i < 16; ++i) {
    q[i] *= 0.125f;
    float lbf = 0.f;
    if (l == 1) { const int ch = hd * 64 + k0 + i; lbf = sigmoidf_(P.c_lb[512 + ch] - P.c_lb[ch]); }
    const float zz = zf[i];
    const float e = __expf(-fabsf(zz));
    const float sp = __builtin_amdgcn_rcpf(1.f + e);
    const float sig = zz >= 0.f ? sp : e * sp;
    const float nsig = zz >= 0.f ? e * sp : sp;
    const float lf = (l == 0) ? (fminf(zz, 0.f) - __logf(1.f + e)) : __logf(lbf + (1.f - lbf) * sig);
    kf[i] = (1.f - lbf) * nsig;
    BF[t * 65 + k0 + i] = lf;
  }
  __builtin_amdgcn_sched_barrier(0);
#pragma unroll
  for (int i = 0; i < 16; ++i) {
    float lbb = 0.f;
    if (l == 1) { const int ch = hd * 64 + k0 + i; lbb = sigmoidf_(P.c_lb[512 + 256 + ch] - P.c_lb[256 + ch]); }
    const float zz = zb[i];
    const float e = __expf(-fabsf(zz));
    const float sp = __builtin_amdgcn_rcpf(1.f + e);
    const float sig = zz >= 0.f ? sp : e * sp;
    const float nsig = zz >= 0.f ? e * sp : sp;
    const float lf = (l == 0) ? (fminf(zz, 0.f) - __logf(1.f + e)) : __logf(lbb + (1.f - lbb) * sig);
    kb[i] = (1.f - lbb) * nsig;
    RB[t * 65 + k0 + i] = lf;
  }
  __syncthreads();
  {
    const int k = tid & 63, seg = tid >> 6;
    float sf = 0.f, sr = 0.f;
#pragma unroll
    for (int j = 0; j < 16; ++j) { sf += BF[(seg * 16 + j) * 65 + k]; BF[(seg * 16 + j) * 65 + k] = sf; }
#pragma unroll
    for (int j = 15; j >= 0; --j) { sr += RB[(seg * 16 + j) * 65 + k]; RB[(seg * 16 + j) * 65 + k] = sr; }
    SEG[seg * 64 + k] = sf; SEG[256 + seg * 64 + k] = sr;
    __syncthreads();
    float offf = 0.f, offb = 0.f;
#pragma unroll
    for (int s2 = 0; s2 < 4; ++s2) {
      offf += (s2 < seg) ? SEG[s2 * 64 + k] : 0.f;
      offb += (s2 > seg) ? SEG[256 + s2 * 64 + k] : 0.f;
    }
#pragma unroll
    for (int j = 0; j < 16; ++j) { BF[(seg * 16 + j) * 65 + k] += offf; RB[(seg * 16 + j) * 65 + k] += offb; }
  }
  __syncthreads();
}

DEVI f32x16 lds_mm(const bf16* A, const bf16* BT, int tm, int tn, int l31, int hh) {
  f32x16 acc = zero16();
#pragma unroll
  for (int ks = 0; ks < 4; ++ks) {
    const bf16x8 a = ldfrag(A + (tm * 32 + l31) * 72 + ks * 16 + hh * 8);
    const bf16x8 b = ldfrag(BT + (tn * 32 + l31) * 72 + ks * 16 + hh * 8);
    acc = mfma32(a, b, acc);
  }
  return acc;
}

DEVI void phase_hgrn_local(const Params& P, int l, unsigned char* smem) {
  const int tid = TIDX, lane = tid & 63, wave = tid >> 6, l31 = lane & 31, hh = lane >> 5;
  const int tm = wave >> 1, tn = wave & 1;
  float* BF = reinterpret_cast<float*>(smem);
  float* RB = BF + 64 * 65;
  bf16* QF = reinterpret_cast<bf16*>(smem + 33280);
  bf16* KF = QF + 64 * 72;
  bf16* QB = KF + 64 * 72;
  bf16* KB = QB + 64 * 72;
  bf16* VTt = KB + 64 * 72;
  bf16* KHF = reinterpret_cast<bf16*>(smem);
  bf16* KHB = KHF + 64 * 72;
  bf16* ATT = KHB + 64 * 72;
  for (int it = VBID; it < 8 * 4 * 36; it += NVB) {
    const int c = it % 36, hd = (it / 36) & 3, b = it / 144;
    float q[16], kf[16], kb[16], v[16];
    __syncthreads();
    hgrn_load(P, l, b, hd, c, BF, RB, reinterpret_cast<float*>(smem + 33280), q, kf, kb, v, true);
    const int t = tid >> 2, k0 = (tid & 3) * 16;
#pragma unroll
    for (int i = 0; i < 16; ++i) VTt[(k0 + i) * 72 + t] = f2bf(v[i]);
    float bfv[16], rbv[16];
#pragma unroll
    for (int i = 0; i < 16; ++i) { bfv[i] = BF[t * 65 + k0 + i]; rbv[i] = RB[t * 65 + k0 + i]; }
    {
      const size_t go = (size_t)row_of(b, c * 64 + t) * 256 + hd * 64 + k0;
#pragma unroll
      for (int hq = 0; hq < 2; ++hq) {
        unsigned pf[4], pb[4];
#pragma unroll
        for (int i = 0; i < 8; i += 2) {
          pf[i >> 1] = pack2(q[hq * 8 + i] * __expf(bfv[hq * 8 + i]), q[hq * 8 + i + 1] * __expf(bfv[hq * 8 + i + 1]));
          pb[i >> 1] = pack2(q[hq * 8 + i] * __expf(rbv[hq * 8 + i]), q[hq * 8 + i + 1] * __expf(rbv[hq * 8 + i + 1]));
        }
        *reinterpret_cast<uint4*>(P.GQF + go + hq * 8) = make_uint4(pf[0], pf[1], pf[2], pf[3]);
        *reinterpret_cast<uint4*>(P.GQB + go + hq * 8) = make_uint4(pb[0], pb[1], pb[2], pb[3]);
      }
    }
    if (t == 0) {
      float* dec = P.DEC + ((size_t)((b * 4 + hd) * 2) * 36 + c) * 64 + k0;
#pragma unroll
      for (int i = 0; i < 16; ++i) { dec[i] = __expf(BF[63 * 65 + k0 + i]); dec[36 * 64 + i] = __expf(RB[k0 + i]); }
    }
#pragma unroll
    for (int i = 0; i < 16; i += 2) {
      const int k = k0 + i;
      const float mF0 = BF[32 * 65 + k], mF1 = BF[32 * 65 + k + 1], mB0 = RB[32 * 65 + k], mB1 = RB[32 * 65 + k + 1];
      *reinterpret_cast<unsigned*>(&QF[t * 72 + k]) = pack2(q[i] * __expf(fminf(bfv[i] - mF0, 80.f)), q[i + 1] * __expf(fminf(bfv[i + 1] - mF1, 80.f)));
      *reinterpret_cast<unsigned*>(&KF[t * 72 + k]) = pack2(kf[i] * __expf(fminf(mF0 - bfv[i], 80.f)), kf[i + 1] * __expf(fminf(mF1 - bfv[i + 1], 80.f)));
      *reinterpret_cast<unsigned*>(&QB[t * 72 + k]) = pack2(q[i] * __expf(fminf(rbv[i] - mB0, 80.f)), q[i + 1] * __expf(fminf(rbv[i + 1] - mB1, 80.f)));
      *reinterpret_cast<unsigned*>(&KB[t * 72 + k]) = pack2(kb[i] * __expf(fminf(mB0 - rbv[i], 80.f)), kb[i + 1] * __expf(fminf(mB1 - rbv[i + 1], 80.f)));
    }
#pragma unroll
    for (int i = 0; i < 16; ++i) {
      kf[i] = kf[i] * __expf(BF[63 * 65 + k0 + i] - bfv[i]);
      kb[i] = kb[i] * __expf(RB[k0 + i] - rbv[i]);
    }
    __syncthreads();
#pragma unroll
    for (int i = 0; i < 16; ++i) {
      KHF[(k0 + i) * 72 + t] = f2bf(kf[i]);
      KHB[(k0 + i) * 72 + t] = f2bf(kb[i]);
    }
    __syncthreads();
    {
      const f32x16 af = lds_mm(QF, KF, tm, tn, l31, hh);
      const f32x16 ab = lds_mm(QB, KB, tm, tn, l31, hh);
      const int s = tn * 32 + l31;
#pragma unroll
      for (int r = 0; r < 16; ++r) {
        const int tt = tm * 32 + drow(r, hh);
        float a = 0.f;
        if (s <= tt) a += af[r];
        if (s >= tt) a += ab[r];
        ATT[tt * 72 + s] = f2bf(a);
      }
    }
    {
      const f32x16 lf = lds_mm(VTt, KHF, tm, tn, l31, hh);
      const f32x16 lb = lds_mm(VTt, KHB, tm, tn, l31, hh);
      float* stf = P.ST + ((size_t)((b * 4 + hd) * 2 + 0) * 36 + c) * 4096;
      float* stb = P.ST + ((size_t)((b * 4 + hd) * 2 + 1) * 36 + c) * 4096;
#pragma unroll
      for (int r = 0; r < 16; ++r) {
        const int kk = tm * 32 + drow(r, hh), d = tn * 32 + l31;
        stf[kk * 64 + d] = lf[r];
        stb[kk * 64 + d] = lb[r];
      }
    }
    __syncthreads();
    {
      const f32x16 o = lds_mm(ATT, VTt, tm, tn, l31, hh);
#pragma unroll
      for (int r = 0; r < 16; ++r) {
        const int tt = tm * 32 + drow(r, hh), d = tn * 32 + l31;
        P.OI[(size_t)row_of(b, c * 64 + tt) * 256 + hd * 64 + d] = o[r];
      }
    }
  }
}

DEVI void hgrn_scan_item(const Params& P, int item) {
  const int tid = TIDX;
  const int chain = item >> 2, sl = item & 3;
  const int dir = chain & 1;
  const int dd = tid >> 2, k4 = sl * 16 + (tid & 3) * 4;
  float4 S = make_float4(0.f, 0.f, 0.f, 0.f);
  float* base = P.ST + (size_t)chain * 36 * 4096 + dd * 64 + k4;
  const float* dec = P.DEC + (size_t)chain * 36 * 64 + k4;
#pragma unroll 1
  for (int g = 0; g < 6; ++g) {
    float4 L[6], dc[6];
#pragma unroll
    for (int j = 0; j < 6; ++j) {
      const int step = g * 6 + j;
      const int c = dir == 0 ? step : (step < 4 ? 3 - step : 39 - step);
      L[j] = *reinterpret_cast<const float4*>(base + (size_t)c * 4096);
      dc[j] = *reinterpret_cast<const float4*>(dec + c * 64);
    }
#pragma unroll
    for (int j = 0; j < 6; ++j) {
      const int step = g * 6 + j;
      const int c = dir == 0 ? step : (step < 4 ? 3 - step : 39 - step);
      *reinterpret_cast<float4*>(base + (size_t)c * 4096) = S;
      S.x = dc[j].x * S.x + L[j].x; S.y = dc[j].y * S.y + L[j].y; S.z = dc[j].z * S.z + L[j].z; S.w = dc[j].w * S.w + L[j].w;
    }
  }
}

DEVI void phase_hgrn_final(const Params& P, int l, unsigned char* smem) {
  const int tid = TIDX, lane = tid & 63, wave = tid >> 6, l31 = lane & 31, hh = lane >> 5;
  const int tm = wave >> 1, tn = wave & 1;
  float* O = reinterpret_cast<float*>(smem);
  bf16* QF = reinterpret_cast<bf16*>(smem + 33280);
  bf16* QB = QF + 64 * 72;
  bf16* SF = QB + 64 * 72;
  bf16* SB = SF + 64 * 72;
  const int c0 = (l == 1) ? 4 : 0;
  const int nc = 36 - c0;
  for (int it = VBID; it < 8 * 4 * nc; it += NVB) {
    const int c = it % nc + c0, hd = (it / nc) & 3, b = it / (nc * 4);
    const int t = tid >> 2, k0 = (tid & 3) * 16;
    const int row = row_of(b, c * 64 + t);
    __syncthreads();
    {
      const size_t go = (size_t)row * 256 + hd * 64 + k0;
      *reinterpret_cast<uint4*>(QF + t * 72 + k0) = *reinterpret_cast<const uint4*>(P.GQF + go);
      *reinterpret_cast<uint4*>(QF + t * 72 + k0 + 8) = *reinterpret_cast<const uint4*>(P.GQF + go + 8);
      *reinterpret_cast<uint4*>(QB + t * 72 + k0) = *reinterpret_cast<const uint4*>(P.GQB + go);
      *reinterpret_cast<uint4*>(QB + t * 72 + k0 + 8) = *reinterpret_cast<const uint4*>(P.GQB + go + 8);
      const float* stf = P.ST + ((size_t)((b * 4 + hd) * 2 + 0) * 36 + c) * 4096 + t * 64 + k0;
      const float* stb = P.ST + ((size_t)((b * 4 + hd) * 2 + 1) * 36 + c) * 4096 + t * 64 + k0;
      unsigned pf[8], pb[8];
#pragma unroll
      for (int i = 0; i < 4; ++i) {
        const float4 a = *reinterpret_cast<const float4*>(stf + i * 4);
        const float4 bb = *reinterpret_cast<const float4*>(stb + i * 4);
        pf[2 * i] = pack2(a.x, a.y); pf[2 * i + 1] = pack2(a.z, a.w);
        pb[2 * i] = pack2(bb.x, bb.y); pb[2 * i + 1] = pack2(bb.z, bb.w);
      }
      *reinterpret_cast<uint4*>(SF + t * 72 + k0) = make_uint4(pf[0], pf[1], pf[2], pf[3]);
      *reinterpret_cast<uint4*>(SF + t * 72 + k0 + 8) = make_uint4(pf[4], pf[5], pf[6], pf[7]);
      *reinterpret_cast<uint4*>(SB + t * 72 + k0) = make_uint4(pb[0], pb[1], pb[2], pb[3]);
      *reinterpret_cast<uint4*>(SB + t * 72 + k0 + 8) = make_uint4(pb[4], pb[5], pb[6], pb[7]);
    }
    __syncthreads();
    {
      f32x16 o = lds_mm(QF, SF, tm, tn, l31, hh);
      const f32x16 o2 = lds_mm(QB, SB, tm, tn, l31, hh);
#pragma unroll
      for (int r = 0; r < 16; ++r) {
        const int tt = tm * 32 + drow(r, hh), d = tn * 32 + l31;
        O[tt * 65 + d] = o[r] + o2[r] + P.OI[(size_t)row_of(b, c * 64 + tt) * 256 + hd * 64 + d];
      }
    }
    __syncthreads();
    {
      float ov[16]; float ss = 0.f;
#pragma unroll
      for (int i = 0; i < 16; ++i) { ov[i] = O[t * 65 + k0 + i]; ss += ov[i] * ov[i]; }
      ss += __shfl_xor(ss, 1); ss += __shfl_xor(ss, 2);
      const float rr = rsqrtf(ss * (1.f / 64.f) + EPS);
      const bf16* g = P.Z + (size_t)row * DIN + ZC_CG + hd * 64 + k0;
      const float* nw = P.c_out_norm_w + l * 64 + k0;
      const uint4 gA = *reinterpret_cast<const uint4*>(g), gB = *reinterpret_cast<const uint4*>(g + 8);
      const unsigned gw[8] = {gA.x, gA.y, gA.z, gA.w, gB.x, gB.y, gB.z, gB.w};
      unsigned pk[8];
#pragma unroll
      for (int i = 0; i < 16; i += 2) {
        const float g0 = lo2f(gw[i >> 1]), g1 = hi2f(gw[i >> 1]);
        const float y0 = ov[i] * rr * nw[i] * (g0 * sigmoidf_(g0));
        const float y1 = ov[i + 1] * rr * nw[i + 1] * (g1 * sigmoidf_(g1));
        pk[i >> 1] = pack2(y0, y1);
      }
      uint4* dst = reinterpret_cast<uint4*>(P.H + (size_t)row * 1024 + 768 + hd * 64 + k0);
      dst[0] = make_uint4(pk[0], pk[1], pk[2], pk[3]);
      dst[1] = make_uint4(pk[4], pk[5], pk[6], pk[7]);
    }
  }
}

DEVI void attn_item8(const Params& P, int b, int h, int qpos0, int nkeys, float sref, unsigned char* smem_base) {
  const int tid = threadIdx.x, lane = tid & 63, wave = tid >> 6, l31 = lane & 31, hh = lane >> 5;
  constexpr int TK = 128, LDKS = 104, LDVS = 136;
  constexpr int KS_BYTES = TK * LDKS * 2, VS_BYTES = 64 * LDVS * 2, ST_BYTES = KS_BYTES + VS_BYTES;
  const bf16* Qg = P.Q + ((size_t)(b * 8 + h) * SEQP + qpos0 + wave * 32 + l31) * 96;
  const bf16* Kg = P.K + (size_t)(b * 8 + h) * SEQP * 96;
  const bf16* Vg = P.VT + (size_t)(b * 8 + h) * 64 * SEQP;
  bf16x8 qf[6];
#pragma unroll
  for (int ks = 0; ks < 6; ++ks) qf[ks] = ldfrag(Qg + ks * 16 + hh * 8);
  f32x16 oacc[2]; oacc[0] = zero16(); oacc[1] = zero16();
  float lsum = 0.f;
  uint4 rk[3], rv[2];
  const int ntiles = nkeys / TK;
  auto gload = [&](int kt) {
#pragma unroll
    for (int i = 0; i < 3; ++i) { const int ch = tid + i * 512, row = ch / 12, cc = ch % 12;
      rk[i] = *reinterpret_cast<const uint4*>(Kg + (size_t)(kt * TK + row) * 96 + cc * 8); }
#pragma unroll
    for (int i = 0; i < 2; ++i) { const int ch = tid + i * 512, row = ch >> 4, cc = ch & 15;
      rv[i] = *reinterpret_cast<const uint4*>(Vg + (size_t)row * SEQP + kt * TK + cc * 8); }
  };
  auto swrite = [&](int buf) {
    bf16* sK = reinterpret_cast<bf16*>(smem_base + buf * ST_BYTES);
    bf16* sV = reinterpret_cast<bf16*>(smem_base + buf * ST_BYTES + KS_BYTES);
#pragma unroll
    for (int i = 0; i < 3; ++i) { const int ch = tid + i * 512, row = ch / 12, cc = ch % 12;
      *reinterpret_cast<uint4*>(sK + row * LDKS + cc * 8) = rk[i]; }
#pragma unroll
    for (int i = 0; i < 2; ++i) { const int ch = tid + i * 512, row = ch >> 4, cc = ch & 15;
      const int g16 = cc >> 1, odd = cc & 1;
      bf16* base = sV + row * LDVS + g16 * 16;
      const int s0 = odd ? 4 : 0, s1 = odd ? 12 : 8;
      *reinterpret_cast<uint2*>(base + s0) = make_uint2(rv[i].x, rv[i].y);
      *reinterpret_cast<uint2*>(base + s1) = make_uint2(rv[i].z, rv[i].w);
    }
  };
  __syncthreads();
  gload(0); swrite(0);
  __syncthreads();
  for (int kt = 0; kt < ntiles; ++kt) {
    const int cur = kt & 1;
    if (kt + 1 < ntiles) gload(kt + 1);
    const bf16* sK = reinterpret_cast<const bf16*>(smem_base + cur * ST_BYTES);
    const bf16* sV = reinterpret_cast<const bf16*>(smem_base + cur * ST_BYTES + KS_BYTES);
#pragma unroll
    for (int kk = 0; kk < 4; ++kk) {
      f32x16 sacc;
#pragma unroll
      for (int r = 0; r < 16; ++r) sacc[r] = -sref;
#pragma unroll
      for (int ks = 0; ks < 6; ++ks) {
        const bf16x8 a = ldfrag(sK + (kk * 32 + l31) * LDKS + ks * 16 + hh * 8);
        sacc = mfma32(a, qf[ks], sacc);
      }
#pragma unroll
      for (int r = 0; r < 16; ++r) { const float p = __builtin_amdgcn_exp2f(sacc[r]); sacc[r] = p; lsum += p; }
#pragma unroll
      for (int s = 0; s < 2; ++s) {
        bf16x8 pb;
#pragma unroll
        for (int j = 0; j < 8; ++j) pb[j] = (__bf16)sacc[8 * s + j];
#pragma unroll
        for (int dt = 0; dt < 2; ++dt) {
          const bf16x8 a = ldfrag(sV + (dt * 32 + l31) * LDVS + kk * 32 + s * 16 + hh * 8);
          oacc[dt] = mfma32(a, pb, oacc[dt]);
        }
      }
    }
    if (kt + 1 < ntiles) swrite(cur ^ 1);
    __syncthreads();
  }
  lsum += __shfl_xor(lsum, 32);
  const float inv = 1.f / lsum;
  const int row = row_of(b, qpos0 + wave * 32 + l31);
  bf16* dst = P.H + (size_t)row * 1024 + 256 + h * 64;
#pragma unroll
  for (int dt = 0; dt < 2; ++dt)
#pragma unroll
    for (int rg = 0; rg < 4; ++rg) {
      const int d = dt * 32 + 8 * rg + 4 * hh;
      uint2 o;
      o.x = pack2(oacc[dt][4 * rg + 0] * inv, oacc[dt][4 * rg + 1] * inv);
      o.y = pack2(oacc[dt][4 * rg + 2] * inv, oacc[dt][4 * rg + 3] * inv);
      *reinterpret_cast<uint2*>(dst + d) = o;
    }
}

DEVI void phase_attn_scan(const Params& P, int l, unsigned char* smem_base, bool skip_scan = false) {
  if (!skip_scan)
    for (int it = NVB - 1 - VBID; it < 256; it += NVB) hgrn_scan_item(P, it);
  float sref;
  {
    const int lane = threadIdx.x & 63;
    float mq = fmaxf(fabsf(P.b_qh_w[l * 96 + lane]), lane < 32 ? fabsf(P.b_qh_w[l * 96 + 64 + lane]) : 0.f);
    float mk = fmaxf(fabsf(P.b_kh_w[l * 96 + lane]), lane < 32 ? fabsf(P.b_kh_w[l * 96 + 64 + lane]) : 0.f);
#pragma unroll
    for (int o = 32; o > 0; o >>= 1) { mq = fmaxf(mq, __shfl_xor(mq, o)); mk = fmaxf(mk, __shfl_xor(mk, o)); }
    sref = fminf(1.4426950408889634f * 9.797958971132712f * mq * mk, 60.f);
  }
  const int c = blockIdx.x, xcd = c & 7, slot = c >> 3;
  const int nrounds = (l == 0) ? 3 : 2;
  for (int r = 0; r < nrounds; ++r) {
    if (r < 2) {
      const int u = r * 32 + slot;
      const int bh = xcd * 8 + (u >> 3), qt = u & 7;
      if (slot < 32) attn_item8(P, bh >> 3, bh & 7, 256 + 256 * qt, 2304, sref, smem_base);
    } else if (c < 64) {
      attn_item8(P, c >> 3, c & 7, 0, 256, sref, smem_base);
    }
  }
}

DEVI unsigned ordkey(float s) { const unsigned u = __float_as_uint(s); return (u & 0x80000000u) ? ~u : (u | 0x80000000u); }
DEVI float keyval(unsigned k, unsigned mask) { const unsigned u = k & ~mask; return __uint_as_float((u & 0x80000000u) ? (u & 0x7fffffffu) : ~u); }
DEVI void ins16(unsigned (&lst)[16], unsigned v) {
#pragma unroll
  for (int j = 0; j < 16; ++j) { const unsigned hi = max(lst[j], v); v = min(lst[j], v); lst[j] = hi; }
}
DEVI void merge16(unsigned (&lst)[16], int xm) {
  unsigned o[16];
#pragma unroll
  for (int j = 0; j < 16; ++j) o[j] = (unsigned)__shfl_xor((int)lst[j], xm);
#pragma unroll
  for (int j = 0; j < 16; ++j) lst[j] = max(lst[j], o[15 - j]);
#pragma unroll
  for (int d = 8; d >= 1; d >>= 1)
#pragma unroll
    for (int j = 0; j < 16; ++j)
      if ((j & d) == 0) { const unsigned a = lst[j], bb = lst[j + d]; lst[j] = max(a, bb); lst[j + d] = min(a, bb); }
}

DEVI void bitonic_sort_desc16(unsigned (&v)[16]) {
#pragma unroll
  for (int k = 2; k <= 16; k <<= 1)
#pragma unroll
    for (int j = k >> 1; j > 0; j >>= 1)
#pragma unroll
      for (int i = 0; i < 16; ++i) {
        const int l = i ^ j;
        if (l > i) {
          const bool desc = ((i & k) == 0);
          const unsigned a = v[i], b = v[l];
          const unsigned mx = max(a, b), mn = min(a, b);
          v[i] = desc ? mx : mn; v[l] = desc ? mn : mx;
        }
      }
}
DEVI void bitonic_merge_desc16(unsigned (&lst)[16]) {
#pragma unroll
  for (int d = 8; d >= 1; d >>= 1)
#pragma unroll
    for (int j = 0; j < 16; ++j)
      if ((j & d) == 0) { const unsigned a = lst[j], bb = lst[j + d]; lst[j] = max(a, bb); lst[j + d] = min(a, bb); }
}
struct CandTab { int a[52]; int b[52]; };
constexpr CandTab make_cand_tab() {
  CandTab t{};
  int n = 0;
  for (int a = 0; a < 16; ++a)
    for (int b = 0; b < 16; ++b)
      if ((a + 1) * (b + 1) <= 16) { t.a[n] = a; t.b[n] = b; ++n; }
  for (; n < 52; ++n) { t.a[n] = 0; t.b[n] = 0; }
  return t;
}

DEVI void phase_route(const Params& P, int l, unsigned char* smem) {
  const int tid = TIDX, lane = tid & 63, wave = tid >> 6, l31 = lane & 31, hh = lane >> 5;
  bf16* QT = reinterpret_cast<bf16*>(smem);
  float* SC = reinterpret_cast<float*>(smem + 33792);
  const int mtiles = (l == 1) ? 256 : 288;
  for (int it = VBID; it < mtiles * 8; it += NVB) {
    const int mt = it >> 3, h = it & 7;
    __syncthreads();
    for (int e = tid; e < 64 * 32; e += 256) {
      const int r = e >> 5, cc = e & 31;
      *reinterpret_cast<uint4*>(QT + r * 264 + cc * 8) = *reinterpret_cast<const uint4*>(P.QP + (size_t)(mt * 64 + r) * 2048 + h * 256 + cc * 8);
    }
    __syncthreads();
    unsigned lst[2][16];
    const int row = tid >> 2, part = tid & 3;
#pragma unroll
    for (int p = 0; p < 2; ++p) {
      f32x16 sa[2]; sa[0] = zero16(); sa[1] = zero16();
      const bf16* keys = P.SK + ((size_t)(l * 16 + h * 2 + p) * 128 + wave * 32 + l31) * 128;
#pragma unroll
      for (int ks = 0; ks < 8; ++ks) {
        const bf16x8 bfr = ldfrag(keys + ks * 16 + hh * 8);
#pragma unroll
        for (int i = 0; i < 2; ++i) {
          const bf16x8 af = ldfrag(QT + (i * 32 + l31) * 264 + p * 128 + ks * 16 + hh * 8);
          sa[i] = mfma32(af, bfr, sa[i]);
        }
      }
      if (p == 1) __syncthreads();
#pragma unroll
      for (int i = 0; i < 2; ++i)
#pragma unroll
        for (int r = 0; r < 16; ++r) SC[(i * 32 + drow(r, hh)) * 129 + wave * 32 + l31] = sa[i][r];
      __syncthreads();
      unsigned B2[16];
#pragma unroll
      for (int i = 0; i < 16; ++i) {
        const int i0 = part * 32 + ((i + part * 8) & 31), i1 = part * 32 + ((i + 16 + part * 8) & 31);
        lst[p][i] = (ordkey(SC[row * 129 + i0]) & ~0x7fu) | (unsigned)(127 - i0);
        B2[i] = (ordkey(SC[row * 129 + i1]) & ~0x7fu) | (unsigned)(127 - i1);
      }
      bitonic_sort_desc16(lst[p]);
      bitonic_sort_desc16(B2);
#pragma unroll
      for (int j = 0; j < 16; ++j) lst[p][j] = max(lst[p][j], B2[15 - j]);
      bitonic_merge_desc16(lst[p]);
      merge16(lst[p], 1);
      merge16(lst[p], 2);
    }
    float v0[16], v1[16];
#pragma unroll
    for (int j = 0; j < 16; ++j) { v0[j] = keyval(lst[0][j], 0x7fu); v1[j] = keyval(lst[1][j], 0x7fu); }
    unsigned best[16];
    {
      constexpr CandTab CT = make_cand_tab();
#pragma unroll
      for (int c = 0; c < 13; ++c) {
        const int a0 = CT.a[4 * c + 0], a1 = CT.a[4 * c + 1], a2 = CT.a[4 * c + 2], a3 = CT.a[4 * c + 3];
        const int b0 = CT.b[4 * c + 0], b1 = CT.b[4 * c + 1], b2 = CT.b[4 * c + 2], b3 = CT.b[4 * c + 3];
        const float x = part == 0 ? v0[a0] : part == 1 ? v0[a1] : part == 2 ? v0[a2] : v0[a3];
        const float y = part == 0 ? v1[b0] : part == 1 ? v1[b1] : part == 2 ? v1[b2] : v1[b3];
        const int flat = part == 0 ? (a0 * 16 + b0) : part == 1 ? (a1 * 16 + b1) : part == 2 ? (a2 * 16 + b2) : (a3 * 16 + b3);
        const bool valid = part == 0 ? (4 * c + 0 < 50) : part == 1 ? (4 * c + 1 < 50) : part == 2 ? (4 * c + 2 < 50) : (4 * c + 3 < 50);
        const unsigned key = (ordkey(x + y) & ~0xffu) | (unsigned)(255 - flat);
        best[c] = valid ? key : 0u;
      }
      best[13] = 0u; best[14] = 0u; best[15] = 0u;
      bitonic_sort_desc16(best);
      merge16(best, 1);
      merge16(best, 2);
    }
    {
      const float mx = keyval(best[0], 0xffu);
      float es = 0.f;
      float ev[4]; int ex[4];
#pragma unroll
      for (int jj = 0; jj < 4; ++jj) {
        const unsigned kk = part == 0 ? best[4 * jj + 0] : part == 1 ? best[4 * jj + 1] : part == 2 ? best[4 * jj + 2] : best[4 * jj + 3];
        ev[jj] = __expf(keyval(kk, 0xffu) - mx);
        es += ev[jj];
        const int flat = 255 - (int)(kk & 0xffu);
        const int a = flat >> 4, bq = flat & 15;
        int i1 = 0, i2 = 0;
#pragma unroll
        for (int u = 0; u < 16; ++u) {
          i1 = (a == u) ? (127 - (int)(lst[0][u] & 0x7fu)) : i1;
          i2 = (bq == u) ? (127 - (int)(lst[1][u] & 0x7fu)) : i2;
        }
        ex[jj] = i1 * 128 + i2;
      }
      es += __shfl_xor(es, 1); es += __shfl_xor(es, 2);
      const float inv = 1.f / es;
      const int tok = mt * 64 + row;
      int* ed = P.EIDX + (size_t)tok * 128 + h * 16;
      float* gd = P.GATE + (size_t)tok * 128 + h * 16;
#pragma unroll
      for (int jj = 0; jj < 4; ++jj) { ed[4 * jj + part] = ex[jj]; gd[4 * jj + part] = ev[jj] * inv; }
    }
  }
}

DEVI float gelu_exact(float a) { return 0.5f * a * (1.f + erff(a * 0.70710678118654752f)); }

typedef float f2 __attribute__((ext_vector_type(2)));
DEVI void phase_peer_u(const Params& P, int l) {
  const int lane = TIDX & 63, half = lane >> 5, l32 = lane & 31;
  const int gw = VBID * 4 + (TIDX >> 6), nw = NVB * 4;
  const int nrows = (l == 1) ? NL : NT;
  const unsigned char* PU = P.PU8 + (size_t)l * 16384 * 576;
  const bool b4 = lane & 16, b3 = lane & 8, b2 = lane & 4;
  for (int t = gw; t < nrows; t += nw) {
    f2 h2[16];
    {
      const bf16* hp = P.H + (size_t)t * 1024 + l32 * 32;
#pragma unroll
      for (int i = 0; i < 4; ++i) {
        const uint4 hv = *reinterpret_cast<const uint4*>(hp + i * 8);
        h2[4 * i + 0] = (f2){lo2f(hv.x), hi2f(hv.x)}; h2[4 * i + 1] = (f2){lo2f(hv.y), hi2f(hv.y)};
        h2[4 * i + 2] = (f2){lo2f(hv.z), hi2f(hv.z)}; h2[4 * i + 3] = (f2){lo2f(hv.w), hi2f(hv.w)};
      }
    }
    const int e0 = P.EIDX[(size_t)t * 128 + lane], e1 = P.EIDX[(size_t)t * 128 + 64 + lane];
    const float g0 = P.GATE[(size_t)t * 128 + lane], g1 = P.GATE[(size_t)t * 128 + 64 + lane];
    float* wrow = P.WPE + (size_t)t * 128;
    for (int kb = 0; kb < 8; ++kb) {
      const int esrc = kb < 4 ? e0 : e1;
      uint4 ud[8];
      unsigned short us[8];
#pragma unroll
      for (int i = 0; i < 8; ++i) {
        const int e = __shfl(esrc, (kb * 16 + 2 * i + half) & 63);
        const unsigned char* ur = PU + (size_t)e * 576;
        ud[i] = *reinterpret_cast<const uint4*>(ur + l32 * 16);
        us[i] = *reinterpret_cast<const unsigned short*>(ur + 512 + l32 * 2);
      }
      float d[8];
#pragma unroll
      for (int i = 0; i < 8; ++i) {
        const unsigned uw[4] = {ud[i].x, ud[i].y, ud[i].z, ud[i].w};
        f2 sacc = (f2){0.f, 0.f};
#pragma unroll
        for (int c = 0; c < 4; ++c) {
          sacc = __builtin_elementwise_fma(__builtin_amdgcn_cvt_scalef32_pk_f32_fp4(uw[c], 1.0f, 0), h2[4 * c + 0], sacc);
          sacc = __builtin_elementwise_fma(__builtin_amdgcn_cvt_scalef32_pk_f32_fp4(uw[c], 1.0f, 1), h2[4 * c + 1], sacc);
          sacc = __builtin_elementwise_fma(__builtin_amdgcn_cvt_scalef32_pk_f32_fp4(uw[c], 1.0f, 2), h2[4 * c + 2], sacc);
          sacc = __builtin_elementwise_fma(__builtin_amdgcn_cvt_scalef32_pk_f32_fp4(uw[c], 1.0f, 3), h2[4 * c + 3], sacc);
        }
        d[i] = (sacc.x + sacc.y) * __uint_as_float((unsigned)us[i] << 16);
      }
      float r4[4], r2[2], r1;
#pragma unroll
      for (int i = 0; i < 4; ++i) { const float mine = b4 ? d[4 + i] : d[i]; const float send = b4 ? d[i] : d[4 + i]; r4[i] = mine + __shfl_xor(send, 16); }
#pragma unroll
      for (int i = 0; i < 2; ++i) { const float mine = b3 ? r4[2 + i] : r4[i]; const float send = b3 ? r4[i] : r4[2 + i]; r2[i] = mine + __shfl_xor(send, 8); }
      { const float mine = b2 ? r2[1] : r2[0]; const float send = b2 ? r2[0] : r2[1]; r1 = mine + __shfl_xor(send, 4); }
      r1 += __shfl_xor(r1, 2); r1 += __shfl_xor(r1, 1);
      const int k = kb * 16 + 2 * ((lane >> 2) & 7) + half;
      const float gt = __shfl(kb < 4 ? g0 : g1, k & 63);
      if ((lane & 3) == 0) wrow[k] = gt * gelu_exact(r1);
    }
  }
}

DEVI void phase_peer(const Params& P, int l) {
  const int lane = TIDX & 63, half = lane >> 5, l32 = lane & 31;
  const int gw = VBID * 4 + (TIDX >> 6), nw = NVB * 4;
  const int nrows = (l == 1) ? NL : NT;
  const unsigned char* PV = P.PV8 + (size_t)l * 16384 * 576;
  for (int t = gw; t < nrows; t += nw) {
    const int e0 = P.EIDX[(size_t)t * 128 + lane], e1 = P.EIDX[(size_t)t * 128 + 64 + lane];
    const float w0 = P.WPE[(size_t)t * 128 + lane], w1 = P.WPE[(size_t)t * 128 + 64 + lane];
    f2 y2[16];
#pragma unroll
    for (int i = 0; i < 16; ++i) y2[i] = (f2){0.f, 0.f};
    for (int kb = 0; kb < 8; ++kb) {
      const int esrc = kb < 4 ? e0 : e1;
      const float wsrc = kb < 4 ? w0 : w1;
      uint4 vd[8];
      unsigned short vs[8];
      float wv[8];
#pragma unroll
      for (int i = 0; i < 8; ++i) {
        const int ks = (kb * 16 + 2 * i + half) & 63;
        const int e = __shfl(esrc, ks);
        wv[i] = __shfl(wsrc, ks);
        const unsigned char* vr = PV + (size_t)e * 576;
        vd[i] = *reinterpret_cast<const uint4*>(vr + l32 * 16);
        vs[i] = *reinterpret_cast<const unsigned short*>(vr + 512 + l32 * 2);
      }
#pragma unroll
      for (int i = 0; i < 8; ++i) {
        const float wi = wv[i] * __uint_as_float((unsigned)vs[i] << 16);
        const f2 ww = (f2){wi, wi};
        const unsigned vw[4] = {vd[i].x, vd[i].y, vd[i].z, vd[i].w};
#pragma unroll
        for (int c = 0; c < 4; ++c) {
          y2[4 * c + 0] = __builtin_elementwise_fma(ww, __builtin_amdgcn_cvt_scalef32_pk_f32_fp4(vw[c], 1.0f, 0), y2[4 * c + 0]);
          y2[4 * c + 1] = __builtin_elementwise_fma(ww, __builtin_amdgcn_cvt_scalef32_pk_f32_fp4(vw[c], 1.0f, 1), y2[4 * c + 1]);
          y2[4 * c + 2] = __builtin_elementwise_fma(ww, __builtin_amdgcn_cvt_scalef32_pk_f32_fp4(vw[c], 1.0f, 2), y2[4 * c + 2]);
          y2[4 * c + 3] = __builtin_elementwise_fma(ww, __builtin_amdgcn_cvt_scalef32_pk_f32_fp4(vw[c], 1.0f, 3), y2[4 * c + 3]);
        }
      }
    }
    float y[16];
#pragma unroll
    for (int j = 0; j < 8; ++j) {
      const float ax = y2[j].x + __shfl_xor(y2[j].x, 32), ay = y2[j].y + __shfl_xor(y2[j].y, 32);
      const float bx = y2[8 + j].x + __shfl_xor(y2[8 + j].x, 32), by = y2[8 + j].y + __shfl_xor(y2[8 + j].y, 32);
      y[2 * j] = half ? bx : ax; y[2 * j + 1] = half ? by : ay;
    }
    const int bi = batch_of_row(t);
    const float* gate2 = P.MOD + (size_t)(l * 9 + bi) * 6144 + 5 * 1024;
    const int d0 = l32 * 32 + half * 16;
    float xn[16];
    float ss = 0.f;
#pragma unroll
    for (int q4 = 0; q4 < 4; ++q4) {
      const int d = d0 + q4 * 4;
      const float4 xo = *reinterpret_cast<const float4*>(P.X + (size_t)t * 1024 + d);
      const float4 gg = *reinterpret_cast<const float4*>(gate2 + d);
      float4 o;
      o.x = xo.x + gg.x * y[q4 * 4 + 0]; o.y = xo.y + gg.y * y[q4 * 4 + 1];
      o.z = xo.z + gg.z * y[q4 * 4 + 2]; o.w = xo.w + gg.w * y[q4 * 4 + 3];
      xn[q4 * 4 + 0] = o.x; xn[q4 * 4 + 1] = o.y; xn[q4 * 4 + 2] = o.z; xn[q4 * 4 + 3] = o.w;
      ss += o.x * o.x + o.y * o.y + o.z * o.z + o.w * o.w;
      if (l == 1) *reinterpret_cast<float4*>(P.out + (size_t)t * 1024 + d) = o;
      else *reinterpret_cast<float4*>(P.X + (size_t)t * 1024 + d) = o;
    }
    if (l == 0) {
      ss = wave_sum(ss);
      const float rr = rsqrtf(ss * (1.f / 1024.f) + EPS);
      const float* lnw = P.ln1_w + 1024;
      const float* mod = P.MOD + (size_t)(9 + bi) * 6144;
      unsigned pk[8];
#pragma unroll
      for (int i = 0; i < 16; i += 2) {
        const float o0 = xn[i] * rr * lnw[d0 + i] * (1.f + mod[1024 + d0 + i]) + mod[d0 + i];
        const float o1 = xn[i + 1] * rr * lnw[d0 + i + 1] * (1.f + mod[1024 + d0 + i + 1]) + mod[d0 + i + 1];
        pk[i >> 1] = pack2(o0, o1);
      }
      *reinterpret_cast<uint4*>(P.H + (size_t)t * 1024 + d0) = make_uint4(pk[0], pk[1], pk[2], pk[3]);
      *reinterpret_cast<uint4*>(P.H + (size_t)t * 1024 + d0 + 8) = make_uint4(pk[4], pk[5], pk[6], pk[7]);
    }
  }
}

using f32x4 = __attribute__((ext_vector_type(4))) float;
namespace g8 {
constexpr int BM = 256, BK = 64, HALF = 128, HT = HALF * BK;
DEVI int lds_byte(int r, int c) { const int st = (r >> 4) * 2 + (c >> 5), rr = r & 15, cc = c & 31, ob = rr * 64 + cc * 2; return st * 1024 + (ob ^ (((ob >> 9) & 1) << 5)); }
DEVI void stage_rc(int b, int& R, int& C) { const int st = b / 1024, sb = b % 1024, swz = sb ^ (((sb >> 9) & 1) << 5); R = (st >> 1) * 16 + swz / 64; C = (st & 1) * 32 + (swz % 64) / 2; }
DEVI void unit_of(int L, int nM, int nN, int& pm, int& pn) {
  const int nwg = nM * nN;
  int wgid = L;
  { const int q = nwg / 8, r = nwg % 8, xcd = wgid % 8, off = wgid / 8; wgid = (xcd < r ? xcd * (q + 1) : r * (q + 1) + (xcd - r) * q) + off; }
  const int nig = 8 * nN, gid = wgid / nig, fm = gid * 8, gsz = (nM - fm) < 8 ? (nM - fm) : 8;
  pm = fm + ((wgid % nig) % gsz); pn = (wgid % nig) / gsz;
}
}

struct G8Unit { int pm, pn; };
template <class Epi>
DEVI void gemm8_phase(LAS unsigned char* lds, const bf16* __restrict__ Ag, const bf16* __restrict__ Btg, const int K, const int nM, const int nN, const Epi& E,
                      const int lda = 0, const int pn_split = 1 << 30, const int acol0 = 0, const int acol1 = 0) {
  constexpr int BK = 64, HALF = 128, HTB = HALF * BK * 2;
  const int tid = threadIdx.x, wid = __builtin_amdgcn_readfirstlane(tid >> 6), lane = tid & 63, wr = wid >> 2, wc = wid & 3, fr = lane & 15, fq = lane >> 4;
  const int nt = K / BK;
  const int nunits = nM * nN, G = gridDim.x, c = blockIdx.x;
  const int LDA = lda ? lda : K;
  unsigned voffA[2], voffB[2];
#pragma unroll
  for (int i = 0; i < 2; ++i) { int R, C; g8::stage_rc(tid * 16 + i * 8192, R, C); voffA[i] = (unsigned)(R * LDA + C) * 2u; voffB[i] = (unsigned)(R * K + C) * 2u; }
  const size_t kstep = (size_t)(BK * 2);
  const size_t hstepA = (size_t)HALF * LDA * 2, hstep = (size_t)HALF * K * 2;
  const size_t tstepA = 2 * hstepA, tstep = 2 * hstep;
  const unsigned ldsw = (unsigned)wid * 1024u;
  const int aoff = g8::lds_byte(wr * 64 + fr, fq * 8), boff = g8::lds_byte(wc * 32 + fr, fq * 8);
#define PG8_SA(b, h) (((b) * 2 + (h)) * HTB)
#define PG8_SB(b, h) ((4 + (b) * 2 + (h)) * HTB)
#define PG8_STAGE(bufoff, gbase, voff) do { _Pragma("unroll") for (int _i = 0; _i < 2; ++_i) \
        __builtin_amdgcn_global_load_lds((const unsigned*)((const char*)(gbase) + (voff)[_i]), (LAS unsigned*)(lds + (bufoff) + ldsw + _i * 8192), 16, 0, 0); } while (0)
#define PG8_LDA(dst, b, h) do { _Pragma("unroll") for (int m = 0; m < 4; ++m) _Pragma("unroll") for (int k = 0; k < 2; ++k) dst[m][k] = *(const LAS bf16x8*)(lds + PG8_SA(b, h) + aoff + m * 2048 + k * 1024); } while (0)
#define PG8_LDB(dst, b, h) do { _Pragma("unroll") for (int n = 0; n < 2; ++n) _Pragma("unroll") for (int k = 0; k < 2; ++k) dst[n][k] = *(const LAS bf16x8*)(lds + PG8_SB(b, h) + boff + n * 2048 + k * 1024); } while (0)
#define PG8_MMA(ai, bj, At_, Bt_) do { __builtin_amdgcn_s_setprio(1); _Pragma("unroll") for (int m = 0; m < 4; ++m) _Pragma("unroll") for (int n = 0; n < 2; ++n) _Pragma("unroll") for (int k = 0; k < 2; ++k) \
        acc[ai][bj][m][n] = __builtin_amdgcn_mfma_f32_16x16x32_bf16(Bt_[n][k], At_[m][k], acc[ai][bj][m][n], 0, 0, 0); __builtin_amdgcn_s_setprio(0); } while (0)
#define PG8_WAIT_V(n) asm volatile("s_waitcnt vmcnt(" #n ")" ::: "memory")
#define PG8_WAIT_L(n) asm volatile("s_waitcnt lgkmcnt(" #n ")" ::: "memory")
#define PG8_BAR __builtin_amdgcn_s_barrier()
#define PG8_SCHED __builtin_amdgcn_sched_barrier(0)
  G8Unit cur, nxt; int ui = 0;
  if (c >= nunits) return;
  g8::unit_of(c, nM, nN, cur.pm, cur.pn);
  f32x4 acc[2][2][4][2];
#pragma unroll
  for (int a = 0; a < 2; ++a)
#pragma unroll
    for (int b = 0; b < 2; ++b)
#pragma unroll
      for (int m = 0; m < 4; ++m)
#pragma unroll
        for (int n = 0; n < 2; ++n) acc[a][b][m][n] = (f32x4){0.f, 0.f, 0.f, 0.f};
  bf16x8 At[4][2], B0[2][2], B1[2][2];
  const char* cA = (const char*)Ag + (size_t)cur.pm * tstepA + (size_t)(cur.pn < pn_split ? acol0 : acol1) * 2; const char* cB = (const char*)Btg + (size_t)cur.pn * tstep;
  PG8_STAGE(PG8_SB(0, 0), cB, voffB); PG8_STAGE(PG8_SA(0, 0), cA, voffA); PG8_STAGE(PG8_SB(0, 1), cB + hstep, voffB); PG8_STAGE(PG8_SA(0, 1), cA + hstepA, voffA);
  if (wr == 1) PG8_BAR;
  PG8_WAIT_V(4); PG8_BAR;
  PG8_STAGE(PG8_SB(1, 0), cB + kstep, voffB); PG8_STAGE(PG8_SA(1, 0), cA + kstep, voffA); PG8_STAGE(PG8_SB(1, 1), cB + hstep + kstep, voffB);
  PG8_WAIT_V(6); PG8_BAR;
  for (;;) {
    const long Ln = (long)(ui + 1) * G + c;
    const bool has_next = Ln < nunits;
    if (has_next) g8::unit_of((int)Ln, nM, nN, nxt.pm, nxt.pn);
    const char* nA = has_next ? (const char*)Ag + (size_t)nxt.pm * tstepA + (size_t)(nxt.pn < pn_split ? acol0 : acol1) * 2 : cA; const char* nB = has_next ? (const char*)Btg + (size_t)nxt.pn * tstep : cB;
    for (int t = 0; t < nt; t += 2) {
      const bool last = (t == nt - 2);
      const char* a1 = cA + (size_t)(t + 1) * kstep;
      const char* a2 = last ? nA : cA + (size_t)(t + 2) * kstep; const char* b2 = last ? nB : cB + (size_t)(t + 2) * kstep;
      const char* a3 = a2 + kstep; const char* b3 = b2 + kstep;
      PG8_LDB(B0, 0, 0); PG8_SCHED; PG8_LDA(At, 0, 0); PG8_STAGE(PG8_SA(1, 1), a1 + hstepA, voffA);
      PG8_WAIT_L(8); PG8_BAR; PG8_WAIT_L(0); PG8_MMA(0, 0, At, B0); PG8_BAR; PG8_SCHED;
      PG8_LDB(B1, 0, 1); PG8_STAGE(PG8_SB(0, 0), b2, voffB);
      PG8_BAR; PG8_WAIT_L(0); PG8_MMA(0, 1, At, B1); PG8_BAR;
      PG8_LDA(At, 0, 1); PG8_STAGE(PG8_SA(0, 0), a2, voffA);
      PG8_BAR; PG8_WAIT_L(0); PG8_MMA(1, 0, At, B0); PG8_BAR; PG8_SCHED;
      PG8_STAGE(PG8_SB(0, 1), b2 + hstep, voffB);
      PG8_WAIT_V(6); PG8_BAR; PG8_MMA(1, 1, At, B1); PG8_BAR;
      PG8_LDB(B0, 1, 0); PG8_SCHED; PG8_LDA(At, 1, 0); PG8_STAGE(PG8_SA(0, 1), a2 + hstepA, voffA);
      PG8_WAIT_L(8); PG8_BAR; PG8_WAIT_L(0); PG8_MMA(0, 0, At, B0); PG8_BAR; PG8_SCHED;
      PG8_LDB(B1, 1, 1); PG8_STAGE(PG8_SB(1, 0), b3, voffB);
      PG8_BAR; PG8_WAIT_L(0); PG8_MMA(0, 1, At, B1); PG8_BAR;
      PG8_LDA(At, 1, 1); PG8_STAGE(PG8_SA(1, 0), a3, voffA);
      PG8_BAR; PG8_WAIT_L(0); PG8_MMA(1, 0, At, B0); PG8_BAR; PG8_SCHED;
      PG8_STAGE(PG8_SB(1, 1), b3 + hstep, voffB);
      PG8_WAIT_V(6); PG8_BAR; PG8_MMA(1, 1, At, B1); PG8_BAR;
    }
    E(acc, cur, wr, wc, fr, fq);
    if (!has_next) break;
#pragma unroll
    for (int a = 0; a < 2; ++a)
#pragma unroll
      for (int b = 0; b < 2; ++b)
#pragma unroll
        for (int m = 0; m < 4; ++m)
#pragma unroll
          for (int n = 0; n < 2; ++n) acc[a][b][m][n] = (f32x4){0.f, 0.f, 0.f, 0.f};
    cur = nxt; cA = nA; cB = nB; ++ui;
  }
  PG8_WAIT_V(0);
  if (wr == 0) PG8_BAR;
  PG8_BAR;
#undef PG8_SA
#undef PG8_SB
#undef PG8_STAGE
#undef PG8_LDA
#undef PG8_LDB
#undef PG8_MMA
}

struct EpiZ {
  bf16* Z;
  DEVI void operator()(const f32x4 (&acc)[2][2][4][2], const G8Unit& u, int wr, int wc, int fr, int fq) const {
    const int brow = u.pm * 256, bcol = u.pn * 256;
#pragma unroll
    for (int ai = 0; ai < 2; ++ai)
#pragma unroll
      for (int m = 0; m < 4; ++m) {
        const int row = brow + ai * 128 + wr * 64 + m * 16 + fr;
#pragma unroll
        for (int bj = 0; bj < 2; ++bj)
#pragma unroll
          for (int n = 0; n < 2; ++n) {
            const int col = bcol + bj * 128 + wc * 32 + n * 16 + 4 * fq;
            if (col < DIN) {
              const f32x4 v = acc[ai][bj][m][n];
              *reinterpret_cast<uint2*>(Z + (size_t)row * DIN + col) = make_uint2(pack2(v[0], v[1]), pack2(v[2], v[3]));
            }
          }
      }
  }
};
DEVI void phase_gemm1_8(const Params& P, int l, unsigned char* smem_base) {
  EpiZ E{P.Z};
  gemm8_phase((LAS unsigned char*)smem_base, P.H, P.WinT + (size_t)l * DINP * 1024, 1024, NT / 256, DINP / 256, E);
  const int c = blockIdx.x;
  if (c >= 136) {
    const int j = c - 136;
    if (l == 0) convert_rows_fp6(P, 0, j * 100, j * 100 + 100);
    else { const int b0 = 19200 + j * 114; convert_rows_fp6(P, 1, b0 < 32768 ? b0 : 32768, b0 + 114 < 32768 ? b0 + 114 : 32768); }
  }
}

struct EpiRAW {
  bf16* R;
  DEVI void operator()(const f32x4 (&acc)[2][2][4][2], const G8Unit& u, int wr, int wc, int fr, int fq) const {
    const int brow = u.pm * 256, bcol = u.pn * 256;
#pragma unroll
    for (int ai = 0; ai < 2; ++ai)
#pragma unroll
      for (int m = 0; m < 4; ++m) {
        const int row = brow + ai * 128 + wr * 64 + m * 16 + fr;
#pragma unroll
        for (int bj = 0; bj < 2; ++bj)
#pragma unroll
          for (int n = 0; n < 2; ++n) {
            const int col = bcol + bj * 128 + wc * 32 + n * 16 + 4 * fq;
            const f32x4 v = acc[ai][bj][m][n];
            *reinterpret_cast<uint2*>(R + (size_t)row * 1792 + col) = make_uint2(pack2(v[0], v[1]), pack2(v[2], v[3]));
          }
      }
  }
};
DEVI void phase_mla_raw(const Params& P, int l, unsigned char* smem_base) {
  EpiRAW E{P.RAW};
  gemm8_phase((LAS unsigned char*)smem_base, P.Z, P.WCOMB + (size_t)l * 1792 * 256, 256, NT / 256, 7, E, DIN, 3, ZC_BQ, ZC_BKV);
}

struct EpiX {
  const float* x; const float* ctx; float* X; const float* MODl; int l;
  DEVI void operator()(const f32x4 (&acc)[2][2][4][2], const G8Unit& u, int wr, int wc, int fr, int fq) const {
    const int brow = u.pm * 256, bcol = u.pn * 256;
    const float* gate = MODl + (size_t)batch_of_row(brow) * 6144 + 2048;
#pragma unroll
    for (int ai = 0; ai < 2; ++ai)
#pragma unroll
      for (int m = 0; m < 4; ++m) {
        const int row = brow + ai * 128 + wr * 64 + m * 16 + fr;
        const float* res = (l == 0) ? (row < NL ? x + (size_t)row * 1024 : ctx + (size_t)(row - NL) * 1024) : X + (size_t)row * 1024;
#pragma unroll
        for (int bj = 0; bj < 2; ++bj)
#pragma unroll
          for (int n = 0; n < 2; ++n) {
            const int col = bcol + bj * 128 + wc * 32 + n * 16 + 4 * fq;
            const f32x4 v = acc[ai][bj][m][n];
            const float4 r4 = *reinterpret_cast<const float4*>(res + col);
            const float4 g4 = *reinterpret_cast<const float4*>(gate + col);
            float4 o; o.x = r4.x + g4.x * v[0]; o.y = r4.y + g4.y * v[1]; o.z = r4.z + g4.z * v[2]; o.w = r4.w + g4.w * v[3];
            *reinterpret_cast<float4*>(X + (size_t)row * 1024 + col) = o;
          }
      }
  }
};
DEVI void phase_gemm2_8(const Params& P, int l, unsigned char* smem_base) {
  EpiX E{P.x, P.ctx, P.X, P.MOD + (size_t)l * 9 * 6144, l};
  gemm8_phase((LAS unsigned char*)smem_base, P.H, P.WoutT + (size_t)l * 1024 * 1024, 1024, (l == 1) ? NL / 256 : NT / 256, 4, E);
  const int c = blockIdx.x;
  if (l == 0 && c >= 32) {
    const int b0 = 12000 + (c - 32) * 93;
    convert_rows_fp6(P, 0, b0 < 32768 ? b0 : 32768, b0 + 93 < 32768 ? b0 + 93 : 32768);
  }
}

struct EpiQP {
  bf16* QP;
  DEVI void operator()(const f32x4 (&acc)[2][2][4][2], const G8Unit& u, int wr, int wc, int fr, int fq) const {
    const int brow = u.pm * 256, bcol = u.pn * 256;
#pragma unroll
    for (int ai = 0; ai < 2; ++ai)
#pragma unroll
      for (int m = 0; m < 4; ++m) {
        const int row = brow + ai * 128 + wr * 64 + m * 16 + fr;
#pragma unroll
        for (int bj = 0; bj < 2; ++bj)
#pragma unroll
          for (int n = 0; n < 2; ++n) {
            const int col = bcol + bj * 128 + wc * 32 + n * 16 + 4 * fq;
            const f32x4 v = acc[ai][bj][m][n];
            *reinterpret_cast<uint2*>(QP + (size_t)row * 2048 + col) = make_uint2(pack2(v[0], v[1]), pack2(v[2], v[3]));
          }
      }
  }
};
DEVI void phase_gemm3_8(const Params& P, int l, unsigned char* smem_base) {
  EpiQP E{P.QP};
  gemm8_phase((LAS unsigned char*)smem_base, P.H, P.WpqT + (size_t)l * 2048 * 1024, 1024, (l == 1) ? NL / 256 : NT / 256, 8, E);
  const int c = blockIdx.x;
  if (l == 0 && c >= 64) convert_rows_fp6(P, 1, (c - 64) * 100, (c - 64) * 100 + 100);
}

constexpr int N_PHASES = 2 + 2 * 11;

#ifndef REP_MASK
#define REP_MASK 0
#endif
static_assert(sizeof(Params) % 8 == 0, "Params size");
DEVI Params load_params() {
#if defined(__HIP_DEVICE_COMPILE__)
  typedef const __attribute__((address_space(4))) Params* ParamsCP;
  ParamsCP pp = (ParamsCP)__builtin_amdgcn_kernarg_segment_ptr();
  asm volatile("" : "+s"(pp));
  return *pp;
#else
  return Params{};
#endif
}
__global__ void __launch_bounds__(512, 2) fwd_kernel(Params Pk) {
  extern __shared__ __attribute__((aligned(16))) unsigned char smem_base[];
  volatile LAS unsigned* xst = (volatile LAS unsigned*)(smem_base + SMEM_BYTES);
  if (threadIdx.x == 0) { xst[0] = 0u; xst[1] = 0u; xst[2] = 0u; xst[3] = 0u; }
  __syncthreads();
  XcdBarrier xb = xcd_barrier_post(Pk.bar, xst);
  const int phase_lo = Pk.phase_lo, phase_hi = Pk.phase_hi, coop = Pk.coop;
#define smem (smem_base + VHALF * HALF_LDS)
#define GSYNC(idx) { xcd_barrier(xb); }
#define RUN_PHASE2(idx, call, repcall) \
  if (phase_lo <= (idx) && (idx) <= phase_hi) { { const Params P = load_params(); call; } if (REP_MASK & (1 << (idx))) { GSYNC(1); const Params P = load_params(); repcall; } if (coop && (idx) < phase_hi) GSYNC(idx); }
#define RUN_PHASE(idx, call) RUN_PHASE2(idx, call, call)
  RUN_PHASE(0, phase_prologue(P, smem))
  RUN_PHASE(1, phase_norm(P, 0, 0, NT))
  RUN_PHASE(2, phase_gemm1_8(P, 0, smem_base))
  RUN_PHASE(3, phase_mla_raw(P, 0, smem_base))
  RUN_PHASE(4, { phase_mixA(P, 0, smem); phase_mla_proj(P, 0, smem); phase_hgrn_local(P, 0, smem); })
  RUN_PHASE2(5, phase_attn_scan(P, 0, smem_base), phase_attn_scan(P, 0, smem_base, true))
  RUN_PHASE(6, phase_hgrn_final(P, 0, smem))
  RUN_PHASE(7, phase_gemm2_8(P, 0, smem_base))
  RUN_PHASE(8, phase_norm(P, 0, 1, NT))
  RUN_PHASE(9, phase_gemm3_8(P, 0, smem_base))
  RUN_PHASE(10, phase_route(P, 0, smem))
  RUN_PHASE(11, phase_peer_u(P, 0))
  RUN_PHASE(12, phase_peer(P, 0))
  RUN_PHASE(13, phase_gemm1_8(P, 1, smem_base))
  RUN_PHASE(14, phase_mla_raw(P, 1, smem_base))
  RUN_PHASE(15, { phase_mixA(P, 1, smem); phase_mla_proj(P, 1, smem); phase_hgrn_local(P, 1, smem); })
  RUN_PHASE2(16, phase_attn_scan(P, 1, smem_base), phase_attn_scan(P, 1, smem_base, true))
  RUN_PHASE(17, phase_hgrn_final(P, 1, smem))
  RUN_PHASE(18, phase_gemm2_8(P, 1, smem_base))
  RUN_PHASE(19, phase_norm(P, 1, 1, NL))
  RUN_PHASE(20, phase_gemm3_8(P, 1, smem_base))
  RUN_PHASE(21, phase_route(P, 1, smem))
  RUN_PHASE(22, phase_peer_u(P, 1))
  RUN_PHASE(23, phase_peer(P, 1))
#undef smem
}

extern "C" void kernel_launch(void* const* d_in, const int* in_sizes, int n_in, void* d_out, int out_size, void* d_ws,
                              size_t ws_size, hipStream_t stream) {
  Params p{};
  const float* const* in = reinterpret_cast<const float* const*>(d_in);
  p.x = in[0]; p.c = in[1]; p.ctx = in[2]; p.c_ctx = in[3]; p.ln1_w = in[4]; p.ln2_w = in[5]; p.w_mod = in[6]; p.b_mod = in[7];
  p.w_in = in[8]; p.w_out = in[9]; p.a_norm_w = in[10]; p.a_w_s = in[11]; p.a_b_s = in[12]; p.b_q_norm_w = in[13]; p.b_w_uq = in[14];
  p.b_kv_norm_w = in[15]; p.b_w_ukv = in[16]; p.b_qh_w = in[17]; p.b_kh_w = in[18]; p.c_lb = in[19]; p.c_out_norm_w = in[20];
  p.p_w_q = in[21]; p.p_sub_keys = in[22]; p.p_u = in[23]; p.p_v = in[24];
  p.out = reinterpret_cast<float*>(d_out);
  unsigned char* ws = reinterpret_cast<unsigned char*>(d_ws);
  size_t off = 0;
  auto take = [&](size_t bytes) { unsigned char* r = ws + off; off += (bytes + 255) & ~(size_t)255; return r; };
  p.bar = (unsigned*)take((size_t)XCD_BAR_WORDS * 4);
  p.MOD = (float*)take((size_t)2 * 9 * 6144 * 4);
  p.ROPE = (float*)take((size_t)2048 * 32 * 4);
  p.WinT = (bf16*)take((size_t)2 * DINP * 1024 * 2);
  p.WoutT = (bf16*)take((size_t)2 * 1024 * 1024 * 2);
  p.WpqT = (bf16*)take((size_t)2 * 2048 * 1024 * 2);
  p.WCOMB = (bf16*)take((size_t)2 * 1792 * 256 * 2);
  p.RAW = (bf16*)take((size_t)NT * 1792 * 2);
  p.SK = (bf16*)take((size_t)2 * 16 * 128 * 128 * 2);
  p.AWS = (bf16*)take((size_t)2 * 4 * 128 * 128 * 2);
  p.PU8 = (unsigned char*)take((size_t)2 * 16384 * 576);
  p.PV8 = (unsigned char*)take((size_t)2 * 16384 * 576);
  p.PUS = (float*)take((size_t)2 * 16384 * 4);
  p.PVS = (float*)take((size_t)2 * 16384 * 4);
  p.X = (float*)take((size_t)NT * 1024 * 4);
  p.H = (bf16*)take((size_t)NT * 1024 * 2);
  p.Z = (bf16*)take((size_t)NT * DIN * 2);
  p.Q = (bf16*)take((size_t)64 * SEQP * 96 * 2);
  p.K = (bf16*)take((size_t)64 * SEQP * 96 * 2);
  p.VT = (bf16*)take((size_t)64 * 64 * SEQP * 2);
  p.ST = (float*)take((size_t)64 * 36 * 4096 * 4);
  p.DEC = (float*)take((size_t)64 * 36 * 64 * 4);
  p.OI = (float*)take((size_t)NT * 256 * 4);
  p.WPE = (float*)take((size_t)NT * 128 * 4);
  p.GQF = (bf16*)take((size_t)NT * 256 * 2);
  p.GQB = (bf16*)take((size_t)NT * 256 * 2);
  p.QP = p.Z;
  p.EIDX = (int*)p.Q;
  p.GATE = (float*)p.K;
  if (off > ws_size) { fprintf(stderr, "workspace too small: need %zu have %zu\n", off, ws_size); }
  static int grid_blocks = 0;
  if (!grid_blocks) {
    if (hipFuncSetAttribute((const void*)fwd_kernel, hipFuncAttributeMaxDynamicSharedMemorySize, SMEM_TOTAL) != hipSuccess)
      fprintf(stderr, "hipFuncSetAttribute failed\n");
    int dev = 0, cus = 0, per_cu = 0;
    hipGetDevice(&dev);
    hipDeviceGetAttribute(&cus, hipDeviceAttributeMultiprocessorCount, dev);
    hipOccupancyMaxActiveBlocksPerMultiprocessor(&per_cu, (const void*)fwd_kernel, 512, SMEM_TOTAL);
    if (per_cu > 1) per_cu = 1;
    if (per_cu < 1) { fprintf(stderr, "occupancy query returned %d\n", per_cu); per_cu = 1; }
    grid_blocks = cus * per_cu;
    fprintf(stderr, "grid_blocks=%d (cus=%d per_cu=%d) ws need=%zu have=%zu\n", grid_blocks, cus, per_cu, off, ws_size);
  }
  hipMemsetAsync(p.bar, 0, (size_t)XCD_BAR_WORDS * 4, stream);
  p.coop = 1; p.phase_lo = 0; p.phase_hi = N_PHASES - 1;
  hipLaunchKernelGGL(fwd_kernel, dim3(grid_blocks), dim3(512), SMEM_TOTAL, stream, p);
  const hipError_t e = hipPeekAtLastError();
  if (e != hipSuccess) fprintf(stderr, "launch failed: %s (grid %d)\n", hipGetErrorString(e), grid_blocks);
}
```

```cpp
#include <hip/hip_runtime.h>
#include <hip/hip_cooperative_groups.h>
#include <cstdio>
#include <cstdint>
namespace cg = cooperative_groups;

#define DEVI __device__ __forceinline__

typedef unsigned short bf16;
using bf16x8 = __attribute__((ext_vector_type(8))) __bf16;
using bf16x2 = __attribute__((ext_vector_type(2))) __bf16;
using f32x16 = __attribute__((ext_vector_type(16))) float;
typedef unsigned v6u __attribute__((ext_vector_type(6)));
typedef unsigned v3u __attribute__((ext_vector_type(3)));
typedef float v16f __attribute__((ext_vector_type(16)));
typedef float v32f __attribute__((ext_vector_type(32)));

constexpr int NL = 16384;
constexpr int NT = 18432;
constexpr int DM = 1024;
constexpr int DIN = 2208;
constexpr int DINP = 2304;
constexpr int SEQP = 2304;
constexpr float EPS = 1e-6f;
constexpr int ZC_AU = 0, ZC_AV = 256, ZC_BQ = 512, ZC_BKV = 768, ZC_BKR = 896, ZC_CQ = 928, ZC_CFF = 1184, ZC_CFB = 1440, ZC_CI = 1696, ZC_CG = 1952;
constexpr int SMEM_BYTES = 2 * 80896;
constexpr int SMEM_TOTAL = SMEM_BYTES + 16;

struct Params {
  const float *x, *c, *ctx, *c_ctx, *ln1_w, *ln2_w, *w_mod, *b_mod, *w_in, *w_out, *a_norm_w, *a_w_s, *a_b_s;
  const float *b_q_norm_w, *b_w_uq, *b_kv_norm_w, *b_w_ukv, *b_qh_w, *b_kh_w, *c_lb, *c_out_norm_w, *p_w_q, *p_sub_keys, *p_u, *p_v;
  float* out;
  unsigned* bar;
  float* MOD;
  float* ROPE;
  bf16* WinT;
  bf16* WoutT;
  bf16* WpqT;
  bf16* WCOMB;
  bf16* RAW;
  bf16* SK;
  bf16* AWS;
  unsigned char* PU8;
  unsigned char* PV8;
  float* PUS;
  float* PVS;
  bf16* X;
  bf16* H;
  bf16* Z;
  bf16* Q;
  bf16* K;
  bf16* VT;
  float* ST;
  float* DEC;
  float* OI;
  float* WPE;
  bf16* GQF;
  bf16* GQB;
  bf16* QP;
  int* EIDX;
  float* GATE;
  int phase_lo, phase_hi, coop, pad0;
};

DEVI float bf2f(bf16 v) { return __uint_as_float(((unsigned)v) << 16); }
DEVI bf16 f2bf(float a) { __bf16 v = (__bf16)a; return __builtin_bit_cast(unsigned short, v); }
DEVI unsigned pack2(float a, float b) { bf16x2 v; v[0] = (__bf16)a; v[1] = (__bf16)b; return __builtin_bit_cast(unsigned, v); }
DEVI float lo2f(unsigned u) { return __uint_as_float(u << 16); }
DEVI float hi2f(unsigned u) { return __uint_as_float(u & 0xffff0000u); }
DEVI f32x16 zero16() { f32x16 z;
#pragma unroll
  for (int i = 0; i < 16; ++i) z[i] = 0.f; return z; }
DEVI f32x16 mfma32(bf16x8 a, bf16x8 b, f32x16 c) { return __builtin_amdgcn_mfma_f32_32x32x16_bf16(a, b, c, 0, 0, 0); }
DEVI bf16x8 ldfrag(const bf16* p) { return *reinterpret_cast<const bf16x8*>(p); }
DEVI int drow(int r, int hh) { return (r & 3) + 8 * (r >> 2) + 4 * hh; }
DEVI int row_of(int b, int p) { return p < 256 ? NL + b * 256 + p : b * 2048 + (p - 256); }
DEVI int batch_of_row(int r) { return r < NL ? (r >> 11) : 8; }
DEVI float wave_sum(float v) {
#pragma unroll
  for (int o = 32; o > 0; o >>= 1) v += __shfl_xor(v, o);
  return v;
}
DEVI float sigmoidf_(float z) { return 1.f / (1.f + __expf(-z)); }


#define XB_TMO      128
#define XB_XCNT(j)  (256  + 64 * (j))
#define XB_XSUB(j)  (1280 + 64 * (j))
#define XB_XGEN(j)  (2304 + 64 * (j))
#define XB_TOP      3328
#define XB_TOPGEN   3392
#define XCD_BAR_WORDS 3456
#define XB_SPIN_CAP (1u << 22)
#define LAS __attribute__((address_space(3)))
DEVI unsigned xb_ld(unsigned* p)              { return __hip_atomic_load(p, __ATOMIC_RELAXED, __HIP_MEMORY_SCOPE_AGENT); }
DEVI unsigned xb_add(unsigned* p, unsigned v) { return __hip_atomic_fetch_add(p, v, __ATOMIC_RELAXED, __HIP_MEMORY_SCOPE_AGENT); }
DEVI unsigned xb_xcc_id() { return (unsigned)__builtin_amdgcn_s_getreg((3 << 11) | 20) & 0xFu; }
#define XB_SPIN(cond, bar) do { unsigned _sp = 0; while (cond) { __builtin_amdgcn_s_sleep(1); \
    if ((++_sp & 255u) == 0u) { if (xb_ld(&(bar)[XB_TMO])) break; if (_sp > XB_SPIN_CAP) { atomicAdd(&(bar)[XB_TMO], 1u); break; } } } } while (0)
struct XcdBarrier { unsigned* bar; unsigned x; volatile LAS unsigned* st; };
DEVI XcdBarrier xcd_barrier_post(unsigned* bar, volatile LAS unsigned* st) {
  XcdBarrier b; b.bar = bar; b.x = xb_xcc_id(); b.st = st;
  if (threadIdx.x == 0) (void)xb_add(&bar[XB_XCNT(b.x)], 1u);
  return b;
}
DEVI void xcd_barrier_complete(unsigned* bar, unsigned x, unsigned& nloc, unsigned& nx) {
  const unsigned G = gridDim.x * gridDim.y * gridDim.z;
  unsigned sum, cnt, mine, sp = 0u;
  for (;;) {
    sum = 0u; cnt = 0u; mine = 0u;
#pragma unroll
    for (unsigned j = 0; j < 16; ++j) { const unsigned c = xb_ld(&bar[XB_XCNT(j)]); sum += c; cnt += (c > 0u) ? 1u : 0u; mine = (j == x) ? c : mine; }
    if (sum == G) break;
    __builtin_amdgcn_s_sleep(1);
    if ((++sp & 255u) == 0u) { if (xb_ld(&bar[XB_TMO])) break; if (sp > XB_SPIN_CAP) { atomicAdd(&bar[XB_TMO], 1u); break; } }
  }
  nloc = mine > 0u ? mine : 1u; nx = cnt > 0u ? cnt : 1u;
}
DEVI void xcd_barrier(const XcdBarrier& b) {
  asm volatile("s_waitcnt vmcnt(0)" ::: "memory");
  __syncthreads();
  if (threadIdx.x == 0) {
    unsigned* bar = b.bar;
    __builtin_amdgcn_s_waitcnt(0);
    unsigned nloc = b.st[0], nx = b.st[1];
    if (nloc == 0u) { xcd_barrier_complete(bar, b.x, nloc, nx); b.st[0] = nloc; b.st[1] = nx; }
    const unsigned old = xb_add(&bar[XB_XSUB(b.x)], 1u);
    const unsigned gen = old / nloc;
    if (old + 1u == (gen + 1u) * nloc) {
      __builtin_amdgcn_fence(__ATOMIC_RELEASE, "agent");
      asm volatile("s_waitcnt vmcnt(0)" ::: "memory");
      const unsigned og = xb_add(&bar[XB_TOP], 1u);
      const unsigned tg = og / nx;
      if (og + 1u == (tg + 1u) * nx) xb_add(&bar[XB_TOPGEN], 1u);
      else XB_SPIN(xb_ld(&bar[XB_TOPGEN]) == tg, bar);
      __builtin_amdgcn_fence(__ATOMIC_ACQUIRE, "agent");
      xb_add(&bar[XB_XGEN(b.x)], 1u);
      asm volatile("s_waitcnt vmcnt(0)" ::: "memory");
    } else {
      XB_SPIN(xb_ld(&bar[XB_XGEN(b.x)]) == gen, bar);
      __builtin_amdgcn_fence(__ATOMIC_ACQUIRE, "agent");
      asm volatile("s_waitcnt vmcnt(0)" ::: "memory");
    }
  }
  __syncthreads();
}

#define VHALF ((int)__builtin_amdgcn_readfirstlane((int)(threadIdx.x >> 8)))
#define TIDX ((int)(threadIdx.x & 255))
#define VBID ((int)(blockIdx.x * 2 + VHALF))
#define NVB ((int)(gridDim.x * 2))
constexpr int HALF_LDS = 80896;

DEVI void phase_mod(const Params& P, unsigned char* smem) {
  const int tid = TIDX;
  float* s = (float*)smem;
  float* red = s + 9 * 1024;
  for (int item = VBID; item < 192; item += NVB) {
    const int l = item / 96, j = item % 96;
    __syncthreads();
    for (int i = tid; i < 9 * 1024; i += 256) {
      int bi = i >> 10, k = i & 1023;
      float v = bi < 8 ? P.c[bi * 1024 + k] : P.c_ctx[k];
      s[i] = v * sigmoidf_(v);
    }
    __syncthreads();
    const int c4 = tid & 15, kg = tid >> 4;
    float acc[9][4];
#pragma unroll
    for (int bi = 0; bi < 9; ++bi) { acc[bi][0] = acc[bi][1] = acc[bi][2] = acc[bi][3] = 0.f; }
    const float* w = P.w_mod + (size_t)l * 1024 * 6144 + j * 64 + c4 * 4;
#pragma unroll 4
    for (int kk = 0; kk < 64; ++kk) {
      const int k = kg * 64 + kk;
      const float4 w4 = *reinterpret_cast<const float4*>(w + (size_t)k * 6144);
#pragma unroll
      for (int bi = 0; bi < 9; ++bi) {
        const float sv = s[bi * 1024 + k];
        acc[bi][0] += sv * w4.x; acc[bi][1] += sv * w4.y; acc[bi][2] += sv * w4.z; acc[bi][3] += sv * w4.w;
      }
    }
#pragma unroll
    for (int bi = 0; bi < 9; ++bi)
#pragma unroll
      for (int e = 0; e < 4; ++e) red[(kg * 9 + bi) * 64 + c4 * 4 + e] = acc[bi][e];
    __syncthreads();
    for (int o = tid; o < 576; o += 256) {
      const int bi = o >> 6, cc = o & 63;
      float sum = 0.f;
#pragma unroll
      for (int g = 0; g < 16; ++g) sum += red[(g * 9 + bi) * 64 + cc];
      P.MOD[(size_t)(l * 9 + bi) * 6144 + j * 64 + cc] = sum + P.b_mod[l * 6144 + j * 64 + cc];
    }
  }
}

DEVI void conv_T_tile(const float* __restrict__ src, int N, bf16* __restrict__ dst, int Kd, int k0, int n0,
                      const float* __restrict__ kscale, float* tile) {
  const int tid = TIDX;
  __syncthreads();
  for (int e = tid; e < 4096; e += 256) {
    const int i = e >> 6, j = e & 63, n = n0 + j;
    float v = (n < N) ? src[(size_t)(k0 + i) * N + n] : 0.f;
    if (kscale) v *= kscale[k0 + i];
    tile[i * 65 + j] = v;
  }
  __syncthreads();
  for (int e = tid; e < 2048; e += 256) {
    const int j = e >> 5, i2 = (e & 31) * 2;
    const unsigned pk = pack2(tile[i2 * 65 + j], tile[(i2 + 1) * 65 + j]);
    *reinterpret_cast<unsigned*>(&dst[(size_t)(n0 + j) * Kd + k0 + i2]) = pk;
  }
}

DEVI void conv_straight(const float* __restrict__ src, bf16* __restrict__ dst, size_t n8) {
  const size_t stride = (size_t)NVB * 256;
  for (size_t i = (size_t)VBID * 256 + TIDX; i < n8; i += stride) {
    const float4 a = reinterpret_cast<const float4*>(src)[2 * i];
    const float4 b = reinterpret_cast<const float4*>(src)[2 * i + 1];
    uint4 o; o.x = pack2(a.x, a.y); o.y = pack2(a.z, a.w); o.z = pack2(b.x, b.y); o.w = pack2(b.z, b.w);
    reinterpret_cast<uint4*>(dst)[i] = o;
  }
}

DEVI void convert_rows_fp6(const Params& P, int L, int i0, int i1) {
  const int lane = threadIdx.x & 63, half = lane >> 5, l32 = lane & 31;
  const int wv = threadIdx.x >> 6;
  for (int ib = i0 + wv * 2; ib < i1; ib += 16) {
    int i = ib + half; const bool live = i < i1; if (!live) i = i1 - 1;
    const int table = i >> 14, lr = L * 16384 + (i & 16383);
    const float* src = (table ? P.p_v : P.p_u) + (size_t)lr * 1024 + l32 * 32;
    float4 a[8];
    float m = 0.f;
#pragma unroll
    for (int q = 0; q < 8; ++q) {
      a[q] = *reinterpret_cast<const float4*>(src + q * 4);
      m = fmaxf(m, fmaxf(fmaxf(fabsf(a[q].x), fabsf(a[q].y)), fmaxf(fabsf(a[q].z), fabsf(a[q].w))));
    }
    const unsigned sb = (__float_as_uint(fmaxf(m, 1e-30f) * (1.f / 6.f)) + 0xffffu) >> 16;
    const float inv = 1.f / __uint_as_float(sb << 16);
    unsigned pk[4];
#pragma unroll
    for (int w = 0; w < 4; ++w) {
      unsigned word = 0u;
#pragma unroll
      for (int e = 0; e < 8; ++e) {
        const int idx = w * 8 + e;
        const float4 q4 = a[idx >> 2];
        const float xv = ((idx & 3) == 0 ? q4.x : (idx & 3) == 1 ? q4.y : (idx & 3) == 2 ? q4.z : q4.w) * inv;
        const float av = fabsf(xv);
        unsigned ci = (av > 0.25f) + (av > 0.75f) + (av > 1.25f) + (av > 1.75f) + (av > 2.5f) + (av > 3.5f) + (av > 5.f);
        ci |= (xv < 0.f) ? 8u : 0u;
        word |= ci << (4 * e);
      }
      pk[w] = word;
    }
    unsigned char* rowp = (table ? P.PV8 : P.PU8) + (size_t)lr * 576;
    if (live) {
      *reinterpret_cast<uint4*>(rowp + l32 * 16) = make_uint4(pk[0], pk[1], pk[2], pk[3]);
      *reinterpret_cast<unsigned short*>(rowp + 512 + l32 * 2) = (unsigned short)sb;
    }
  }
}

DEVI void phase_prologue(const Params& P, unsigned char* smem) {
  phase_mod(P, smem);
  float* tile = (float*)smem;
  for (int it = VBID; it < 2 * 1424; it += NVB) {
    const int l = it / 1424; int r = it % 1424;
    if (r < 576) { conv_T_tile(P.w_in + (size_t)l * 1024 * DIN, DIN, P.WinT + (size_t)l * DINP * 1024, 1024, (r % 16) * 64, (r / 16) * 64, nullptr, tile); continue; }
    r -= 576;
    if (r < 256) { conv_T_tile(P.w_out + (size_t)l * 1024 * 1024, 1024, P.WoutT + (size_t)l * 1024 * 1024, 1024, (r % 16) * 64, (r / 16) * 64, nullptr, tile); continue; }
    r -= 256;
    if (r < 512) { conv_T_tile(P.p_w_q + (size_t)l * 1024 * 2048, 2048, P.WpqT + (size_t)l * 2048 * 1024, 1024, (r % 16) * 64, (r / 16) * 64, nullptr, tile); continue; }
    r -= 512;
    if (r < 48) { conv_T_tile(P.b_w_uq + (size_t)l * 256 * 768, 768, P.WCOMB + (size_t)l * 1792 * 256, 256, (r % 4) * 64, (r / 4) * 64, P.b_q_norm_w + l * 256, tile); continue; }
    r -= 48;
    conv_T_tile(P.b_w_ukv + (size_t)l * 128 * 1024, 1024, P.WCOMB + (size_t)l * 1792 * 256 + 768 * 256, 256, (r % 2) * 64, (r / 2) * 64, P.b_kv_norm_w + l * 128, tile);
  }
  for (int i = VBID * 256 + TIDX; i < 2 * 1024 * 16; i += NVB * 256) {
    const int l2 = i >> 14, rr = (i >> 4) & 1023, cc = i & 15;
    *reinterpret_cast<uint4*>(P.WCOMB + (size_t)l2 * 1792 * 256 + (size_t)(768 + rr) * 256 + 128 + cc * 8) = make_uint4(0u, 0u, 0u, 0u);
  }
  conv_straight(P.p_sub_keys, P.SK, (size_t)2 * 16 * 128 * 128 / 8);
  conv_straight(P.a_w_s, P.AWS, (size_t)2 * 4 * 128 * 128 / 8);
  for (int i = VBID * 256 + TIDX; i < 2048 * 16; i += NVB * 256) {
    const int t = i >> 4, a = (i >> 3) & 1, f = i & 7;
    const float inv = powf(10000.f, -(float)f / 8.f);
    const float pos = a ? (float)(t & 63) : (float)(t >> 6);
    const float ang = pos * inv;
    P.ROPE[t * 32 + a * 8 + f] = cosf(ang);
    P.ROPE[t * 32 + 16 + a * 8 + f] = sinf(ang);
  }
}

DEVI void phase_norm(const Params& P, int l, int which, int nrows) {
  const int lane = TIDX & 63;
  const int gw = VBID * 4 + (TIDX >> 6), nw = NVB * 4;
  const float* lnw = (which == 0 ? P.ln1_w : P.ln2_w) + l * 1024;
  for (int r = gw; r < nrows; r += nw) {
    const float* mod = P.MOD + (size_t)(l * 9 + batch_of_row(r)) * 6144 + which * 3072;
    float4 v[4];
    float ss = 0.f;
    if (which == 0 && l == 0) {
      const float* src = r < NL ? P.x + (size_t)r * 1024 : P.ctx + (size_t)(r - NL) * 1024;
#pragma unroll
      for (int i = 0; i < 4; ++i) v[i] = *reinterpret_cast<const float4*>(src + i * 256 + lane * 4);
    } else {
      const bf16* src = P.X + (size_t)r * 1024;
#pragma unroll
      for (int i = 0; i < 4; ++i) {
        const uint2 u = *reinterpret_cast<const uint2*>(src + i * 256 + lane * 4);
        v[i] = make_float4(lo2f(u.x), hi2f(u.x), lo2f(u.y), hi2f(u.y));
      }
    }
#pragma unroll
    for (int i = 0; i < 4; ++i) ss += v[i].x * v[i].x + v[i].y * v[i].y + v[i].z * v[i].z + v[i].w * v[i].w;
    ss = wave_sum(ss);
    const float rr = rsqrtf(ss * (1.f / 1024.f) + EPS);
#pragma unroll
    for (int i = 0; i < 4; ++i) {
      const int d = i * 256 + lane * 4;
      const float4 w = *reinterpret_cast<const float4*>(lnw + d);
      const float4 sh = *reinterpret_cast<const float4*>(mod + d);
      const float4 sc = *reinterpret_cast<const float4*>(mod + 1024 + d);
      const float o0 = v[i].x * rr * w.x * (1.f + sc.x) + sh.x;
      const float o1 = v[i].y * rr * w.y * (1.f + sc.y) + sh.y;
      const float o2 = v[i].z * rr * w.z * (1.f + sc.z) + sh.z;
      const float o3 = v[i].w * rr * w.w * (1.f + sc.w) + sh.w;
      uint2 o; o.x = pack2(o0, o1); o.y = pack2(o2, o3);
      *reinterpret_cast<uint2*>(P.H + (size_t)r * 1024 + d) = o;
    }
  }
}

template <int BM, int BN, int BK, int WM, int WN>
struct Gemm {
  static constexpr int LDK = BK + 8;
  static constexpr int TM = BM / WM / 32, TN = BN / WN / 32;
  static constexpr int CPR = BK / 8;
  static constexpr int NA = BM * CPR / 256, NB = BN * CPR / 256;
  static constexpr int A_BYTES = BM * LDK * 2, B_BYTES = BN * LDK * 2;
  static constexpr int STAGE_BYTES = A_BYTES + B_BYTES;
  static constexpr int SMEM = 2 * STAGE_BYTES;

  static DEVI void run(const bf16* __restrict__ A, int lda, const bf16* __restrict__ BT, int ldb, int K,
                       unsigned char* smem, f32x16 (&acc)[TM][TN]) {
    const int tid = TIDX, lane = tid & 63, wave = tid >> 6;
    const int wm = wave / WN, wn = wave % WN;
    const int l31 = lane & 31, hh = lane >> 5;
#pragma unroll
    for (int i = 0; i < TM; ++i)
#pragma unroll
      for (int j = 0; j < TN; ++j) acc[i][j] = zero16();
    uint4 ra[NA], rb[NB];
    const int nk = K / BK;
    auto gload = [&](int kt) {
#pragma unroll
      for (int i = 0; i < NA; ++i) { const int ch = tid + i * 256, row = ch / CPR, cc = ch % CPR;
        ra[i] = *reinterpret_cast<const uint4*>(A + (size_t)row * lda + kt * BK + cc * 8); }
#pragma unroll
      for (int i = 0; i < NB; ++i) { const int ch = tid + i * 256, row = ch / CPR, cc = ch % CPR;
        rb[i] = *reinterpret_cast<const uint4*>(BT + (size_t)row * ldb + kt * BK + cc * 8); }
    };
    auto swrite = [&](int buf) {
      bf16* sA = reinterpret_cast<bf16*>(smem + buf * STAGE_BYTES);
      bf16* sB = reinterpret_cast<bf16*>(smem + buf * STAGE_BYTES + A_BYTES);
#pragma unroll
      for (int i = 0; i < NA; ++i) { const int ch = tid + i * 256, row = ch / CPR, cc = ch % CPR;
        *reinterpret_cast<uint4*>(sA + row * LDK + cc * 8) = ra[i]; }
#pragma unroll
      for (int i = 0; i < NB; ++i) { const int ch = tid + i * 256, row = ch / CPR, cc = ch % CPR;
        *reinterpret_cast<uint4*>(sB + row * LDK + cc * 8) = rb[i]; }
    };
    __syncthreads();
    gload(0);
    swrite(0);
    __syncthreads();
    for (int kt = 0; kt < nk; ++kt) {
      const int cur = kt & 1;
      if (kt + 1 < nk) gload(kt + 1);
      const bf16* sA = reinterpret_cast<const bf16*>(smem + cur * STAGE_BYTES);
      const bf16* sB = reinterpret_cast<const bf16*>(smem + cur * STAGE_BYTES + A_BYTES);
#pragma unroll
      for (int ks = 0; ks < BK / 16; ++ks) {
        bf16x8 af[TM], bfr[TN];
#pragma unroll
        for (int i = 0; i < TM; ++i) af[i] = ldfrag(sA + (wm * (BM / WM) + i * 32 + l31) * LDK + ks * 16 + hh * 8);
#pragma unroll
        for (int j = 0; j < TN; ++j) bfr[j] = ldfrag(sB + (wn * (BN / WN) + j * 32 + l31) * LDK + ks * 16 + hh * 8);
#pragma unroll
        for (int i = 0; i < TM; ++i)
#pragma unroll
          for (int j = 0; j < TN; ++j) acc[i][j] = mfma32(af[i], bfr[j], acc[i][j]);
      }
      if (kt + 1 < nk) swrite(cur ^ 1);
      __syncthreads();
    }
  }
};

DEVI void phase_gemm1(const Params& P, int l, unsigned char* smem) {
  using G = Gemm<128, 128, 64, 2, 2>;
  const int lane = TIDX & 63, wave = TIDX >> 6, wm = wave >> 1, wn = wave & 1, l31 = lane & 31, hh = lane >> 5;
  const bf16* W = P.WinT + (size_t)l * DINP * 1024;
  for (int t = VBID; t < 144 * 18; t += NVB) {
    const int mt = t / 18, nt = t % 18;
    f32x16 acc[2][2];
    G::run(P.H + (size_t)mt * 128 * 1024, 1024, W + (size_t)nt * 128 * 1024, 1024, 1024, smem, acc);
#pragma unroll
    for (int i = 0; i < 2; ++i)
#pragma unroll
      for (int j = 0; j < 2; ++j) {
        const int col = nt * 128 + wn * 64 + j * 32 + l31;
        if (col < DIN) {
#pragma unroll
          for (int r = 0; r < 16; ++r) {
            const int row = mt * 128 + wm * 64 + i * 32 + drow(r, hh);
            P.Z[(size_t)row * DIN + col] = f2bf(acc[i][j][r]);
          }
        }
      }
  }
}

DEVI void phase_gemm2(const Params& P, int l, unsigned char* smem) {
  using G = Gemm<128, 128, 64, 2, 2>;
  const int lane = TIDX & 63, wave = TIDX >> 6, wm = wave >> 1, wn = wave & 1, l31 = lane & 31, hh = lane >> 5;
  const bf16* W = P.WoutT + (size_t)l * 1024 * 1024;
  const int mtiles = (l == 1) ? 128 : 144;
  for (int t = VBID; t < mtiles * 8; t += NVB) {
    const int mt = t / 8, nt = t % 8;
    f32x16 acc[2][2];
    G::run(P.H + (size_t)mt * 128 * 1024, 1024, W + (size_t)nt * 128 * 1024, 1024, 1024, smem, acc);
    const int bi = batch_of_row(mt * 128);
    const float* gate = P.MOD + (size_t)(l * 9 + bi) * 6144 + 2048;
#pragma unroll
    for (int i = 0; i < 2; ++i)
#pragma unroll
      for (int j = 0; j < 2; ++j) {
        const int col = nt * 128 + wn * 64 + j * 32 + l31;
        const float g = gate[col];
#pragma unroll
        for (int r = 0; r < 16; ++r) {
          const int row = mt * 128 + wm * 64 + i * 32 + drow(r, hh);
          float res;
          if (l == 0) res = row < NL ? P.x[(size_t)row * 1024 + col] : P.ctx[(size_t)(row - NL) * 1024 + col];
          else res = bf2f(P.X[(size_t)row * 1024 + col]);
          P.X[(size_t)row * 1024 + col] = f2bf(res + g * acc[i][j][r]);
        }
      }
  }
}

DEVI void phase_mixA(const Params& P, int l, unsigned char* smem) {
  const int tid = TIDX, lane = tid & 63, wave = tid >> 6, l31 = lane & 31, hh = lane >> 5;
  bf16* VNT = reinterpret_cast<bf16*>(smem);
  constexpr int LDV = 136;
  const int nseg = (l == 1) ? 16 : 18;
  const int seg0 = (l == 1) ? 2 : 0;
  for (int it = VBID; it < 8 * nseg * 4; it += NVB) {
    const int a = it & 3; const int sj = (it >> 2) % nseg + seg0; const int b = (it >> 2) / nseg;
    const int p0 = sj * 128;
    __syncthreads();
    {
      const int q = tid >> 1, half = tid & 1;
      const int row = row_of(b, p0 + q);
      const bf16* src = P.Z + (size_t)row * DIN + ZC_AV + a * 64 + half * 32;
      float v[32];
      float ss = 0.f;
#pragma unroll
      for (int i = 0; i < 4; ++i) {
        const uint4 u = *reinterpret_cast<const uint4*>(src + i * 8);
        v[i * 8 + 0] = lo2f(u.x); v[i * 8 + 1] = hi2f(u.x); v[i * 8 + 2] = lo2f(u.y); v[i * 8 + 3] = hi2f(u.y);
        v[i * 8 + 4] = lo2f(u.z); v[i * 8 + 5] = hi2f(u.z); v[i * 8 + 6] = lo2f(u.w); v[i * 8 + 7] = hi2f(u.w);
      }
#pragma unroll
      for (int i = 0; i < 32; ++i) ss += v[i] * v[i];
      ss += __shfl_xor(ss, 1);
      const float rr = rsqrtf(ss * (1.f / 64.f) + EPS);
      const float* nw = P.a_norm_w + l * 256 + a * 64 + half * 32;
#pragma unroll
      for (int i = 0; i < 32; ++i) VNT[(half * 32 + i) * LDV + q] = f2bf(v[i] * rr * nw[i]);
    }
    __syncthreads();
    f32x16 acc[2]; acc[0] = zero16(); acc[1] = zero16();
    const bf16* Aw = P.AWS + (size_t)(l * 4 + a) * 128 * 128 + (size_t)(wave * 32 + l31) * 128;
#pragma unroll
    for (int ks = 0; ks < 8; ++ks) {
      const bf16x8 af = ldfrag(Aw + ks * 16 + hh * 8);
#pragma unroll
      for (int j = 0; j < 2; ++j) {
        const bf16x8 bfr = ldfrag(VNT + (j * 32 + l31) * LDV + ks * 16 + hh * 8);
        acc[j] = mfma32(af, bfr, acc[j]);
      }
    }
    const float* bs = P.a_b_s + (l * 4 + a) * 128;
#pragma unroll
    for (int j = 0; j < 2; ++j)
#pragma unroll
      for (int r = 0; r < 16; ++r) {
        const int p = wave * 32 + drow(r, hh);
        const int row = row_of(b, p0 + p);
        const int col = a * 64 + j * 32 + l31;
        const float u = bf2f(P.Z[(size_t)row * DIN + ZC_AU + col]);
        P.H[(size_t)row * 1024 + col] = f2bf(u * (acc[j][r] + bs[p]));
      }
  }
}

DEVI void mla_norm_rope_store(const Params& P, const float* T, const float* nw, bool rope, float oscale,
                              bf16* dstbase  , int pos0, int tlat0) {
  const int tid = TIDX, tok = tid >> 1, half = tid & 1;
  float v[48];
  float ss = 0.f;
#pragma unroll
  for (int i = 0; i < 48; ++i) { v[i] = T[tok * 97 + half * 48 + i]; ss += v[i] * v[i]; }
  ss += __shfl_xor(ss, 1);
  const float rr = rsqrtf(ss * (1.f / 96.f) + EPS);
#pragma unroll
  for (int i = 0; i < 48; ++i) v[i] = v[i] * rr * nw[half * 48 + i];
  if (rope && half == 1) {
    const float* cs = P.ROPE + (size_t)(tlat0 + tok) * 32;
#pragma unroll
    for (int a = 0; a < 2; ++a)
#pragma unroll
      for (int f = 0; f < 8; ++f) {
        const float x1 = v[16 + a * 16 + f], x2 = v[16 + a * 16 + 8 + f];
        const float c = cs[a * 8 + f], s = cs[16 + a * 8 + f];
        v[16 + a * 16 + f] = x1 * c - x2 * s;
        v[16 + a * 16 + 8 + f] = x2 * c + x1 * s;
      }
  }
  bf16* dst = dstbase + (size_t)(pos0 + tok) * 96 + half * 48;
#pragma unroll
  for (int i = 0; i < 6; ++i) {
    uint4 o;
    o.x = pack2(v[i * 8 + 0] * oscale, v[i * 8 + 1] * oscale); o.y = pack2(v[i * 8 + 2] * oscale, v[i * 8 + 3] * oscale);
    o.z = pack2(v[i * 8 + 4] * oscale, v[i * 8 + 5] * oscale); o.w = pack2(v[i * 8 + 6] * oscale, v[i * 8 + 7] * oscale);
    *reinterpret_cast<uint4*>(dst + i * 8) = o;
  }
}

DEVI void phase_mla_proj(const Params& P, int l, unsigned char* smem) {
  const int tid = TIDX;
  float* T = reinterpret_cast<float*>(smem);
  bf16* TV = reinterpret_cast<bf16*>(smem + 128 * 97 * 4);
  const float qscale = 0.10206207261596577f * 1.4426950408889634f;
  const int tok = tid >> 1, half = tid & 1;
  for (int it = VBID; it < 144 * 8; it += NVB) {
    const int h = it & 7;
    const int m0 = (it >> 3) * 128;
    const bool lat = m0 < NL;
    const int b = lat ? (m0 >> 11) : ((m0 - NL) >> 8);
    const int pos0 = lat ? 256 + (m0 & 2047) : ((m0 - NL) & 255);
    const int tlat0 = lat ? (m0 & 2047) : 0;
    const bool doq = lat || (l == 0);
    const bf16* zr = P.Z + (size_t)(m0 + tok) * DIN;
    const bf16* rr = P.RAW + (size_t)(m0 + tok) * 1792;
    __syncthreads();
    float rskv, rsq = 0.f;
    {
      float ss = 0.f;
#pragma unroll
      for (int i = 0; i < 8; ++i) {
        const uint4 u = *reinterpret_cast<const uint4*>(zr + ZC_BKV + half * 64 + i * 8);
        ss += lo2f(u.x) * lo2f(u.x) + hi2f(u.x) * hi2f(u.x) + lo2f(u.y) * lo2f(u.y) + hi2f(u.y) * hi2f(u.y)
            + lo2f(u.z) * lo2f(u.z) + hi2f(u.z) * hi2f(u.z) + lo2f(u.w) * lo2f(u.w) + hi2f(u.w) * hi2f(u.w);
      }
      ss += __shfl_xor(ss, 1);
      rskv = rsqrtf(ss * (1.f / 128.f) + EPS);
      if (doq) {
        float sq = 0.f;
#pragma unroll
        for (int i = 0; i < 16; ++i) {
          const uint4 u = *reinterpret_cast<const uint4*>(zr + ZC_BQ + half * 128 + i * 8);
          sq += lo2f(u.x) * lo2f(u.x) + hi2f(u.x) * hi2f(u.x) + lo2f(u.y) * lo2f(u.y) + hi2f(u.y) * hi2f(u.y)
              + lo2f(u.z) * lo2f(u.z) + hi2f(u.z) * hi2f(u.z) + lo2f(u.w) * lo2f(u.w) + hi2f(u.w) * hi2f(u.w);
        }
        sq += __shfl_xor(sq, 1);
        rsq = rsqrtf(sq * (1.f / 256.f) + EPS);
      }
    }
    {
      const bf16* kn = rr + 768 + h * 128 + half * 32;
      const bf16* vv = rr + 768 + h * 128 + 64 + half * 32;
#pragma unroll
      for (int i = 0; i < 4; ++i) {
        const uint4 u = *reinterpret_cast<const uint4*>(kn + i * 8);
        float* tp = T + tok * 97 + half * 32 + i * 8;
        tp[0] = lo2f(u.x) * rskv; tp[1] = hi2f(u.x) * rskv; tp[2] = lo2f(u.y) * rskv; tp[3] = hi2f(u.y) * rskv;
        tp[4] = lo2f(u.z) * rskv; tp[5] = hi2f(u.z) * rskv; tp[6] = lo2f(u.w) * rskv; tp[7] = hi2f(u.w) * rskv;
        const uint4 w = *reinterpret_cast<const uint4*>(vv + i * 8);
        bf16* vp = TV + (half * 32 + i * 8) * 136 + tok;
        vp[0 * 136] = f2bf(lo2f(w.x) * rskv); vp[1 * 136] = f2bf(hi2f(w.x) * rskv); vp[2 * 136] = f2bf(lo2f(w.y) * rskv); vp[3 * 136] = f2bf(hi2f(w.y) * rskv);
        vp[4 * 136] = f2bf(lo2f(w.z) * rskv); vp[5 * 136] = f2bf(hi2f(w.z) * rskv); vp[6 * 136] = f2bf(lo2f(w.w) * rskv); vp[7 * 136] = f2bf(hi2f(w.w) * rskv);
      }
#pragma unroll
      for (int i = 0; i < 2; ++i) {
        const uint4 u = *reinterpret_cast<const uint4*>(zr + ZC_BKR + half * 16 + i * 8);
        float* tp = T + tok * 97 + 64 + half * 16 + i * 8;
        tp[0] = lo2f(u.x); tp[1] = hi2f(u.x); tp[2] = lo2f(u.y); tp[3] = hi2f(u.y);
        tp[4] = lo2f(u.z); tp[5] = hi2f(u.z); tp[6] = lo2f(u.w); tp[7] = hi2f(u.w);
      }
    }
    __syncthreads();
    mla_norm_rope_store(P, T, P.b_kh_w + l * 96, lat, 1.f, P.K + (size_t)(b * 8 + h) * SEQP * 96, pos0, tlat0);
    {
      const int d = tid >> 2, qtr = tid & 3;
      bf16* dst = P.VT + ((size_t)(b * 8 + h) * 64 + d) * SEQP + pos0 + qtr * 32;
      const bf16* src = TV + d * 136 + qtr * 32;
#pragma unroll
      for (int i = 0; i < 4; ++i) *reinterpret_cast<uint4*>(dst + i * 8) = *reinterpret_cast<const uint4*>(src + i * 8);
    }
    if (doq) {
      __syncthreads();
      const bf16* qq = rr + h * 96 + half * 48;
#pragma unroll
      for (int i = 0; i < 6; ++i) {
        const uint4 u = *reinterpret_cast<const uint4*>(qq + i * 8);
        float* tp = T + tok * 97 + half * 48 + i * 8;
        tp[0] = lo2f(u.x) * rsq; tp[1] = hi2f(u.x) * rsq; tp[2] = lo2f(u.y) * rsq; tp[3] = hi2f(u.y) * rsq;
        tp[4] = lo2f(u.z) * rsq; tp[5] = hi2f(u.z) * rsq; tp[6] = lo2f(u.w) * rsq; tp[7] = hi2f(u.w) * rsq;
      }
      __syncthreads();
      mla_norm_rope_store(P, T, P.b_qh_w + l * 96, lat, qscale, P.Q + (size_t)(b * 8 + h) * SEQP * 96, pos0, tlat0);
    }
  }
}

DEVI void hgrn_load(const Params& P, int l, int b, int hd, int c, float* BF, float* RB, float* SEG,
                    float (&q)[16], float (&kf)[16], float (&kb)[16], float (&v)[16], bool need_kv) {
  const int tid = TIDX, t = tid >> 2, k0 = (tid & 3) * 16;
  const int row = row_of(b, c * 64 + t);
  const bf16* z = P.Z + (size_t)row * DIN + hd * 64 + k0;
  float zf[16], zb[16];
#pragma unroll
  for (int i = 0; i < 2; ++i) {
    const uint4 uq = *reinterpret_cast<const uint4*>(z + ZC_CQ + i * 8);
    const uint4 uf = *reinterpret_cast<const uint4*>(z + ZC_CFF + i * 8);
    const uint4 ub = *reinterpret_cast<const uint4*>(z + ZC_CFB + i * 8);
    q[i * 8 + 0] = lo2f(uq.x); q[i * 8 + 1] = hi2f(uq.x); q[i * 8 + 2] = lo2f(uq.y); q[i * 8 + 3] = hi2f(uq.y);
    q[i * 8 + 4] = lo2f(uq.z); q[i * 8 + 5] = hi2f(uq.z); q[i * 8 + 6] = lo2f(uq.w); q[i * 8 + 7] = hi2f(uq.w);
    zf[i * 8 + 0] = lo2f(uf.x); zf[i * 8 + 1] = hi2f(uf.x); zf[i * 8 + 2] = lo2f(uf.y); zf[i * 8 + 3] = hi2f(uf.y);
    zf[i * 8 + 4] = lo2f(uf.z); zf[i * 8 + 5] = hi2f(uf.z); zf[i * 8 + 6] = lo2f(uf.w); zf[i * 8 + 7] = hi2f(uf.w);
    zb[i * 8 + 0] = lo2f(ub.x); zb[i * 8 + 1] = hi2f(ub.x); zb[i * 8 + 2] = lo2f(ub.y); zb[i * 8 + 3] = hi2f(ub.y);
    zb[i * 8 + 4] = lo2f(ub.z); zb[i * 8 + 5] = hi2f(ub.z); zb[i * 8 + 6] = lo2f(ub.w); zb[i * 8 + 7] = hi2f(ub.w);
    if (need_kv) {
      const uint4 uv = *reinterpret_cast<const uint4*>(z + ZC_CI + i * 8);
      v[i * 8 + 0] = lo2f(uv.x); v[i * 8 + 1] = hi2f(uv.x); v[i * 8 + 2] = lo2f(uv.y); v[i * 8 + 3] = hi2f(uv.y);
      v[i * 8 + 4] = lo2f(uv.z); v[i * 8 + 5] = hi2f(uv.z); v[i * 8 + 6] = lo2f(uv.w); v[i * 8 + 7] = hi2f(uv.w);
    }
  }
#pragma unroll
  for (int i = 0; i < 16; ++i) {
    q[i] *= 0.125f;
    float lbf = 0.f;
    if (l == 1) { const int ch = hd * 64 + k0 + i; lbf = sigmoidf_(P.c_lb[512 + ch] - P.c_lb[ch]); }
    const float zz = zf[i];
    const float e = __expf(-fabsf(zz));
    const float sp = __builtin_amdgcn_rcpf(1.f + e);
    const float sig = zz >= 0.f ? sp : e * sp;
    const float nsig = zz >= 0.f ? e * sp : sp;
    const float lf = (l == 0) ? (fminf(zz, 0.f) - __logf(1.f + e)) : __logf(lbf + (1.f - lbf) * sig);
    kf[i] = (1.f - lbf) * nsig;
    BF[t * 65 + k0 + i] = lf;
  }
  __builtin_amdgcn_sched_barrier(0);
#pragma unroll
  for (int i = 0; i < 16; ++i) {
    float lbb = 0.f;
    if (l == 1) { const int ch = hd * 64 + k0 + i; lbb = sigmoidf_(P.c_lb[512 + 256 + ch] - P.c_lb[256 + ch]); }
    const float zz = zb[i];
    const float e = __expf(-fabsf(zz));
    const float sp = __builtin_amdgcn_rcpf(1.f + e);
    const float sig = zz >= 0.f ? sp : e * sp;
    const float nsig = zz >= 0.f ? e * sp : sp;
    const float lf = (l == 0) ? (fminf(zz, 0.f) - __logf(1.f + e)) : __logf(lbb + (1.f - lbb) * sig);
    kb[i] = (1.f - lbb) * nsig;
    RB[t * 65 + k0 + i] = lf;
  }
  __syncthreads();
  {
    const int k = tid & 63, seg = tid >> 6;
    float sf = 0.f, sr = 0.f;
#pragma unroll
    for (int j = 0; j < 16; ++j) { sf += BF[(seg * 16 + j) * 65 + k]; BF[(seg * 16 + j) * 65 + k] = sf; }
#pragma unroll
    for (int j = 15; j >= 0; --j) { sr += RB[(seg * 16 + j) * 65 + k]; RB[(seg * 16 + j) * 65 + k] = sr; }
    SEG[seg * 64 + k] = sf; SEG[256 + seg * 64 + k] = sr;
    __syncthreads();
    float offf = 0.f, offb = 0.f;
#pragma unroll
    for (int s2 = 0; s2 < 4; ++s2) {
      offf += (s2 < seg) ? SEG[s2 * 64 + k] : 0.f;
      offb += (s2 > seg) ? SEG[256 + s2 * 64 + k] : 0.f;
    }
#pragma unroll
    for (int j = 0; j < 16; ++j) { BF[(seg * 16 + j) * 65 + k] += offf; RB[(seg * 16 + j) * 65 + k] += offb; }
  }
  __syncthreads();
}

DEVI f32x16 lds_mm(const bf16* A, const bf16* BT, int tm, int tn, int l31, int hh) {
  f32x16 acc = zero16();
#pragma unroll
  for (int ks = 0; ks < 4; ++ks) {
    const bf16x8 a = ldfrag(A + (tm * 32 + l31) * 72 + ks * 16 + hh * 8);
    const bf16x8 b = ldfrag(BT + (tn * 32 + l31) * 72 + ks * 16 + hh * 8);
    acc = mfma32(a, b, acc);
  }
  return acc;
}

DEVI void phase_hgrn_local(const Params& P, int l, unsigned char* smem) {
  const int tid = TIDX, lane = tid & 63, wave = tid >> 6, l31 = lane & 31, hh = lane >> 5;
  const int tm = wave >> 1, tn = wave & 1;
  float* BF = reinterpret_cast<float*>(smem);
  float* RB = BF + 64 * 65;
  bf16* QF = reinterpret_cast<bf16*>(smem + 33280);
  bf16* KF = QF + 64 * 72;
  bf16* QB = KF + 64 * 72;
  bf16* KB = QB + 64 * 72;
  bf16* VTt = KB + 64 * 72;
  bf16* KHF = reinterpret_cast<bf16*>(smem);
  bf16* KHB = KHF + 64 * 72;
  bf16* ATT = KHB + 64 * 72;
  for (int it = VBID; it < 8 * 4 * 36; it += NVB) {
    const int c = it % 36, hd = (it / 36) & 3, b = it / 144;
    float q[16], kf[16], kb[16], v[16];
    __syncthreads();
    hgrn_load(P, l, b, hd, c, BF, RB, reinterpret_cast<float*>(smem + 33280), q, kf, kb, v, true);
    const int t = tid >> 2, k0 = (tid & 3) * 16;
#pragma unroll
    for (int i = 0; i < 16; ++i) VTt[(k0 + i) * 72 + t] = f2bf(v[i]);
    float bfv[16], rbv[16];
#pragma unroll
    for (int i = 0; i < 16; ++i) { bfv[i] = BF[t * 65 + k0 + i]; rbv[i] = RB[t * 65 + k0 + i]; }
    {
      const size_t go = (size_t)row_of(b, c * 64 + t) * 256 + hd * 64 + k0;
#pragma unroll
      for (int hq = 0; hq < 2; ++hq) {
        unsigned pf[4], pb[4];
#pragma unroll
        for (int i = 0; i < 8; i += 2) {
          pf[i >> 1] = pack2(q[hq * 8 + i] * __expf(bfv[hq * 8 + i]), q[hq * 8 + i + 1] * __expf(bfv[hq * 8 + i + 1]));
          pb[i >> 1] = pack2(q[hq * 8 + i] * __expf(rbv[hq * 8 + i]), q[hq * 8 + i + 1] * __expf(rbv[hq * 8 + i + 1]));
        }
        *reinterpret_cast<uint4*>(P.GQF + go + hq * 8) = make_uint4(pf[0], pf[1], pf[2], pf[3]);
        *reinterpret_cast<uint4*>(P.GQB + go + hq * 8) = make_uint4(pb[0], pb[1], pb[2], pb[3]);
      }
    }
    if (t == 0) {
      float* dec = P.DEC + ((size_t)((b * 4 + hd) * 2) * 36 + c) * 64 + k0;
#pragma unroll
      for (int i = 0; i < 16; ++i) { dec[i] = __expf(BF[63 * 65 + k0 + i]); dec[36 * 64 + i] = __expf(RB[k0 + i]); }
    }
#pragma unroll
    for (int i = 0; i < 16; i += 2) {
      const int k = k0 + i;
      const float mF0 = BF[32 * 65 + k], mF1 = BF[32 * 65 + k + 1], mB0 = RB[32 * 65 + k], mB1 = RB[32 * 65 + k + 1];
      *reinterpret_cast<unsigned*>(&QF[t * 72 + k]) = pack2(q[i] * __expf(fminf(bfv[i] - mF0, 80.f)), q[i + 1] * __expf(fminf(bfv[i + 1] - mF1, 80.f)));
      *reinterpret_cast<unsigned*>(&KF[t * 72 + k]) = pack2(kf[i] * __expf(fminf(mF0 - bfv[i], 80.f)), kf[i + 1] * __expf(fminf(mF1 - bfv[i + 1], 80.f)));
      *reinterpret_cast<unsigned*>(&QB[t * 72 + k]) = pack2(q[i] * __expf(fminf(rbv[i] - mB0, 80.f)), q[i + 1] * __expf(fminf(rbv[i + 1] - mB1, 80.f)));
      *reinterpret_cast<unsigned*>(&KB[t * 72 + k]) = pack2(kb[i] * __expf(fminf(mB0 - rbv[i], 80.f)), kb[i + 1] * __expf(fminf(mB1 - rbv[i + 1], 80.f)));
    }
#pragma unroll
    for (int i = 0; i < 16; ++i) {
      kf[i] = kf[i] * __expf(BF[63 * 65 + k0 + i] - bfv[i]);
      kb[i] = kb[i] * __expf(RB[k0 + i] - rbv[i]);
    }
    __syncthreads();
#pragma unroll
    for (int i = 0; i < 16; ++i) {
      KHF[(k0 + i) * 72 + t] = f2bf(kf[i]);
      KHB[(k0 + i) * 72 + t] = f2bf(kb[i]);
    }
    __syncthreads();
    {
      const f32x16 af = lds_mm(QF, KF, tm, tn, l31, hh);
      const f32x16 ab = lds_mm(QB, KB, tm, tn, l31, hh);
      const int s = tn * 32 + l31;
#pragma unroll
      for (int r = 0; r < 16; ++r) {
        const int tt = tm * 32 + drow(r, hh);
        float a = 0.f;
        if (s <= tt) a += af[r];
        if (s >= tt) a += ab[r];
        ATT[tt * 72 + s] = f2bf(a);
      }
    }
    {
      const f32x16 lf = lds_mm(VTt, KHF, tm, tn, l31, hh);
      const f32x16 lb = lds_mm(VTt, KHB, tm, tn, l31, hh);
      float* stf = P.ST + ((size_t)((b * 4 + hd) * 2 + 0) * 36 + c) * 4096;
      float* stb = P.ST + ((size_t)((b * 4 + hd) * 2 + 1) * 36 + c) * 4096;
#pragma unroll
      for (int r = 0; r < 16; ++r) {
        const int kk = tm * 32 + drow(r, hh), d = tn * 32 + l31;
        stf[kk * 64 + d] = lf[r];
        stb[kk * 64 + d] = lb[r];
      }
    }
    __syncthreads();
    {
      const f32x16 o = lds_mm(ATT, VTt, tm, tn, l31, hh);
#pragma unroll
      for (int r = 0; r < 16; ++r) {
        const int tt = tm * 32 + drow(r, hh), d = tn * 32 + l31;
        P.OI[(size_t)row_of(b, c * 64 + tt) * 256 + hd * 64 + d] = o[r];
      }
    }
  }
}

DEVI void hgrn_scan_item(const Params& P, int item) {
  const int tid = TIDX;
  const int chain = item >> 2, sl = item & 3;
  const int dir = chain & 1;
  const int dd = tid >> 2, k4 = sl * 16 + (tid & 3) * 4;
  float4 S = make_float4(0.f, 0.f, 0.f, 0.f);
  float* base = P.ST + (size_t)chain * 36 * 4096 + dd * 64 + k4;
  const float* dec = P.DEC + (size_t)chain * 36 * 64 + k4;
#pragma unroll 1
  for (int g = 0; g < 6; ++g) {
    float4 L[6], dc[6];
#pragma unroll
    for (int j = 0; j < 6; ++j) {
      const int step = g * 6 + j;
      const int c = dir == 0 ? step : (step < 4 ? 3 - step : 39 - step);
      L[j] = *reinterpret_cast<const float4*>(base + (size_t)c * 4096);
      dc[j] = *reinterpret_cast<const float4*>(dec + c * 64);
    }
#pragma unroll
    for (int j = 0; j < 6; ++j) {
      const int step = g * 6 + j;
      const int c = dir == 0 ? step : (step < 4 ? 3 - step : 39 - step);
      *reinterpret_cast<float4*>(base + (size_t)c * 4096) = S;
      S.x = dc[j].x * S.x + L[j].x; S.y = dc[j].y * S.y + L[j].y; S.z = dc[j].z * S.z + L[j].z; S.w = dc[j].w * S.w + L[j].w;
    }
  }
}

DEVI void phase_hgrn_final(const Params& P, int l, unsigned char* smem) {
  const int tid = TIDX, lane = tid & 63, wave = tid >> 6, l31 = lane & 31, hh = lane >> 5;
  const int tm = wave >> 1, tn = wave & 1;
  float* O = reinterpret_cast<float*>(smem);
  bf16* QF = reinterpret_cast<bf16*>(smem + 33280);
  bf16* QB = QF + 64 * 72;
  bf16* SF = QB + 64 * 72;
  bf16* SB = SF + 64 * 72;
  const int c0 = (l == 1) ? 4 : 0;
  const int nc = 36 - c0;
  for (int it = VBID; it < 8 * 4 * nc; it += NVB) {
    const int c = it % nc + c0, hd = (it / nc) & 3, b = it / (nc * 4);
    const int t = tid >> 2, k0 = (tid & 3) * 16;
    const int row = row_of(b, c * 64 + t);
    __syncthreads();
    {
      const size_t go = (size_t)row * 256 + hd * 64 + k0;
      *reinterpret_cast<uint4*>(QF + t * 72 + k0) = *reinterpret_cast<const uint4*>(P.GQF + go);
      *reinterpret_cast<uint4*>(QF + t * 72 + k0 + 8) = *reinterpret_cast<const uint4*>(P.GQF + go + 8);
      *reinterpret_cast<uint4*>(QB + t * 72 + k0) = *reinterpret_cast<const uint4*>(P.GQB + go);
      *reinterpret_cast<uint4*>(QB + t * 72 + k0 + 8) = *reinterpret_cast<const uint4*>(P.GQB + go + 8);
      const float* stf = P.ST + ((size_t)((b * 4 + hd) * 2 + 0) * 36 + c) * 4096 + t * 64 + k0;
      const float* stb = P.ST + ((size_t)((b * 4 + hd) * 2 + 1) * 36 + c) * 4096 + t * 64 + k0;
      unsigned pf[8], pb[8];
#pragma unroll
      for (int i = 0; i < 4; ++i) {
        const float4 a = *reinterpret_cast<const float4*>(stf + i * 4);
        const float4 bb = *reinterpret_cast<const float4*>(stb + i * 4);
        pf[2 * i] = pack2(a.x, a.y); pf[2 * i + 1] = pack2(a.z, a.w);
        pb[2 * i] = pack2(bb.x, bb.y); pb[2 * i + 1] = pack2(bb.z, bb.w);
      }
      *reinterpret_cast<uint4*>(SF + t * 72 + k0) = make_uint4(pf[0], pf[1], pf[2], pf[3]);
      *reinterpret_cast<uint4*>(SF + t * 72 + k0 + 8) = make_uint4(pf[4], pf[5], pf[6], pf[7]);
      *reinterpret_cast<uint4*>(SB + t * 72 + k0) = make_uint4(pb[0], pb[1], pb[2], pb[3]);
      *reinterpret_cast<uint4*>(SB + t * 72 + k0 + 8) = make_uint4(pb[4], pb[5], pb[6], pb[7]);
    }
    __syncthreads();
    {
      f32x16 o = lds_mm(QF, SF, tm, tn, l31, hh);
      const f32x16 o2 = lds_mm(QB, SB, tm, tn, l31, hh);
#pragma unroll
      for (int r = 0; r < 16; ++r) {
        const int tt = tm * 32 + drow(r, hh), d = tn * 32 + l31;
        O[tt * 65 + d] = o[r] + o2[r] + P.OI[(size_t)row_of(b, c * 64 + tt) * 256 + hd * 64 + d];
      }
    }
    __syncthreads();
    {
      float ov[16]; float ss = 0.f;
#pragma unroll
      for (int i = 0; i < 16; ++i) { ov[i] = O[t * 65 + k0 + i]; ss += ov[i] * ov[i]; }
      ss += __shfl_xor(ss, 1); ss += __shfl_xor(ss, 2);
      const float rr = rsqrtf(ss * (1.f / 64.f) + EPS);
      const bf16* g = P.Z + (size_t)row * DIN + ZC_CG + hd * 64 + k0;
      const float* nw = P.c_out_norm_w + l * 64 + k0;
      const uint4 gA = *reinterpret_cast<const uint4*>(g), gB = *reinterpret_cast<const uint4*>(g + 8);
      const unsigned gw[8] = {gA.x, gA.y, gA.z, gA.w, gB.x, gB.y, gB.z, gB.w};
      unsigned pk[8];
#pragma unroll
      for (int i = 0; i < 16; i += 2) {
        const float g0 = lo2f(gw[i >> 1]), g1 = hi2f(gw[i >> 1]);
        const float y0 = ov[i] * rr * nw[i] * (g0 * sigmoidf_(g0));
        const float y1 = ov[i + 1] * rr * nw[i + 1] * (g1 * sigmoidf_(g1));
        pk[i >> 1] = pack2(y0, y1);
      }
      uint4* dst = reinterpret_cast<uint4*>(P.H + (size_t)row * 1024 + 768 + hd * 64 + k0);
      dst[0] = make_uint4(pk[0], pk[1], pk[2], pk[3]);
      dst[1] = make_uint4(pk[4], pk[5], pk[6], pk[7]);
    }
  }
}

DEVI void attn_item8(const Params& P, int b, int h, int qpos0, int nkeys, float sref, unsigned char* smem_base) {
  const int tid = threadIdx.x, lane = tid & 63, wave = tid >> 6, l31 = lane & 31, hh = lane >> 5;
  constexpr int TK = 128, LDKS = 104, LDVS = 136;
  constexpr int KS_BYTES = TK * LDKS * 2, VS_BYTES = 64 * LDVS * 2, ST_BYTES = KS_BYTES + VS_BYTES;
  const bf16* Qg = P.Q + ((size_t)(b * 8 + h) * SEQP + qpos0 + wave * 32 + l31) * 96;
  const bf16* Kg = P.K + (size_t)(b * 8 + h) * SEQP * 96;
  const bf16* Vg = P.VT + (size_t)(b * 8 + h) * 64 * SEQP;
  bf16x8 qf[6];
#pragma unroll
  for (int ks = 0; ks < 6; ++ks) qf[ks] = ldfrag(Qg + ks * 16 + hh * 8);
  f32x16 oacc[2]; oacc[0] = zero16(); oacc[1] = zero16();
  float lsum = 0.f;
  uint4 rk[3], rv[2];
  const int ntiles = nkeys / TK;
  auto gload = [&](int kt) {
#pragma unroll
    for (int i = 0; i < 3; ++i) { const int ch = tid + i * 512, row = ch / 12, cc = ch % 12;
      rk[i] = *reinterpret_cast<const uint4*>(Kg + (size_t)(kt * TK + row) * 96 + cc * 8); }
#pragma unroll
    for (int i = 0; i < 2; ++i) { const int ch = tid + i * 512, row = ch >> 4, cc = ch & 15;
      rv[i] = *reinterpret_cast<const uint4*>(Vg + (size_t)row * SEQP + kt * TK + cc * 8); }
  };
  auto swrite = [&](int buf) {
    bf16* sK = reinterpret_cast<bf16*>(smem_base + buf * ST_BYTES);
    bf16* sV = reinterpret_cast<bf16*>(smem_base + buf * ST_BYTES + KS_BYTES);
#pragma unroll
    for (int i = 0; i < 3; ++i) { const int ch = tid + i * 512, row = ch / 12, cc = ch % 12;
      *reinterpret_cast<uint4*>(sK + row * LDKS + cc * 8) = rk[i]; }
#pragma unroll
    for (int i = 0; i < 2; ++i) { const int ch = tid + i * 512, row = ch >> 4, cc = ch & 15;
      const int g16 = cc >> 1, odd = cc & 1;
      bf16* base = sV + row * LDVS + g16 * 16;
      const int s0 = odd ? 4 : 0, s1 = odd ? 12 : 8;
      *reinterpret_cast<uint2*>(base + s0) = make_uint2(rv[i].x, rv[i].y);
      *reinterpret_cast<uint2*>(base + s1) = make_uint2(rv[i].z, rv[i].w);
    }
  };
  __syncthreads();
  gload(0); swrite(0);
  __syncthreads();
  for (int kt = 0; kt < ntiles; ++kt) {
    const int cur = kt & 1;
    if (kt + 1 < ntiles) gload(kt + 1);
    const bf16* sK = reinterpret_cast<const bf16*>(smem_base + cur * ST_BYTES);
    const bf16* sV = reinterpret_cast<const bf16*>(smem_base + cur * ST_BYTES + KS_BYTES);
#pragma unroll
    for (int kk = 0; kk < 4; ++kk) {
      f32x16 sacc;
#pragma unroll
      for (int r = 0; r < 16; ++r) sacc[r] = -sref;
#pragma unroll
      for (int ks = 0; ks < 6; ++ks) {
        const bf16x8 a = ldfrag(sK + (kk * 32 + l31) * LDKS + ks * 16 + hh * 8);
        sacc = mfma32(a, qf[ks], sacc);
      }
#pragma unroll
      for (int r = 0; r < 16; ++r) { const float p = __builtin_amdgcn_exp2f(sacc[r]); sacc[r] = p; lsum += p; }
#pragma unroll
      for (int s = 0; s < 2; ++s) {
        bf16x8 pb;
#pragma unroll
        for (int j = 0; j < 8; ++j) pb[j] = (__bf16)sacc[8 * s + j];
#pragma unroll
        for (int dt = 0; dt < 2; ++dt) {
          const bf16x8 a = ldfrag(sV + (dt * 32 + l31) * LDVS + kk * 32 + s * 16 + hh * 8);
          oacc[dt] = mfma32(a, pb, oacc[dt]);
        }
      }
    }
    if (kt + 1 < ntiles) swrite(cur ^ 1);
    __syncthreads();
  }
  lsum += __shfl_xor(lsum, 32);
  const float inv = 1.f / lsum;
  const int row = row_of(b, qpos0 + wave * 32 + l31);
  bf16* dst = P.H + (size_t)row * 1024 + 256 + h * 64;
#pragma unroll
  for (int dt = 0; dt < 2; ++dt)
#pragma unroll
    for (int rg = 0; rg < 4; ++rg) {
      const int d = dt * 32 + 8 * rg + 4 * hh;
      uint2 o;
      o.x = pack2(oacc[dt][4 * rg + 0] * inv, oacc[dt][4 * rg + 1] * inv);
      o.y = pack2(oacc[dt][4 * rg + 2] * inv, oacc[dt][4 * rg + 3] * inv);
      *reinterpret_cast<uint2*>(dst + d) = o;
    }
}

DEVI void phase_attn_scan(const Params& P, int l, unsigned char* smem_base, bool skip_scan = false) {
  if (!skip_scan)
    for (int it = NVB - 1 - VBID; it < 256; it += NVB) hgrn_scan_item(P, it);
  float sref;
  {
    const int lane = threadIdx.x & 63;
    float mq = fmaxf(fabsf(P.b_qh_w[l * 96 + lane]), lane < 32 ? fabsf(P.b_qh_w[l * 96 + 64 + lane]) : 0.f);
    float mk = fmaxf(fabsf(P.b_kh_w[l * 96 + lane]), lane < 32 ? fabsf(P.b_kh_w[l * 96 + 64 + lane]) : 0.f);
#pragma unroll
    for (int o = 32; o > 0; o >>= 1) { mq = fmaxf(mq, __shfl_xor(mq, o)); mk = fmaxf(mk, __shfl_xor(mk, o)); }
    sref = fminf(1.4426950408889634f * 9.797958971132712f * mq * mk, 60.f);
  }
  const int c = blockIdx.x, xcd = c & 7, slot = c >> 3;
  const int nrounds = (l == 0) ? 3 : 2;
  for (int r = 0; r < nrounds; ++r) {
    if (r < 2) {
      const int u = r * 32 + slot;
      const int bh = xcd * 8 + (u >> 3), qt = u & 7;
      if (slot < 32) attn_item8(P, bh >> 3, bh & 7, 256 + 256 * qt, 2304, sref, smem_base);
    } else if (c < 64) {
      attn_item8(P, c >> 3, c & 7, 0, 256, sref, smem_base);
    }
  }
}

DEVI unsigned ordkey(float s) { const unsigned u = __float_as_uint(s); return (u & 0x80000000u) ? ~u : (u | 0x80000000u); }
DEVI float keyval(unsigned k, unsigned mask) { const unsigned u = k & ~mask; return __uint_as_float((u & 0x80000000u) ? (u & 0x7fffffffu) : ~u); }
DEVI void ins16(unsigned (&lst)[16], unsigned v) {
#pragma unroll
  for (int j = 0; j < 16; ++j) { const unsigned hi = max(lst[j], v); v = min(lst[j], v); lst[j] = hi; }
}
DEVI void merge16(unsigned (&lst)[16], int xm) {
  unsigned o[16];
#pragma unroll
  for (int j = 0; j < 16; ++j) o[j] = (unsigned)__shfl_xor((int)lst[j], xm);
#pragma unroll
  for (int j = 0; j < 16; ++j) lst[j] = max(lst[j], o[15 - j]);
#pragma unroll
  for (int d = 8; d >= 1; d >>= 1)
#pragma unroll
    for (int j = 0; j < 16; ++j)
      if ((j & d) == 0) { const unsigned a = lst[j], bb = lst[j + d]; lst[j] = max(a, bb); lst[j + d] = min(a, bb); }
}

DEVI void bitonic_sort_desc16(unsigned (&v)[16]) {
#pragma unroll
  for (int k = 2; k <= 16; k <<= 1)
#pragma unroll
    for (int j = k >> 1; j > 0; j >>= 1)
#pragma unroll
      for (int i = 0; i < 16; ++i) {
        const int l = i ^ j;
        if (l > i) {
          const bool desc = ((i & k) == 0);
          const unsigned a = v[i], b = v[l];
          const unsigned mx = max(a, b), mn = min(a, b);
          v[i] = desc ? mx : mn; v[l] = desc ? mn : mx;
        }
      }
}
DEVI void bitonic_merge_desc16(unsigned (&lst)[16]) {
#pragma unroll
  for (int d = 8; d >= 1; d >>= 1)
#pragma unroll
    for (int j = 0; j < 16; ++j)
      if ((j & d) == 0) { const unsigned a = lst[j], bb = lst[j + d]; lst[j] = max(a, bb); lst[j + d] = min(a, bb); }
}
struct CandTab { int a[52]; int b[52]; };
constexpr CandTab make_cand_tab() {
  CandTab t{};
  int n = 0;
  for (int a = 0; a < 16; ++a)
    for (int b = 0; b < 16; ++b)
      if ((a + 1) * (b + 1) <= 16) { t.a[n] = a; t.b[n] = b; ++n; }
  for (; n < 52; ++n) { t.a[n] = 0; t.b[n] = 0; }
  return t;
}

DEVI void phase_route(const Params& P, int l, unsigned char* smem) {
  const int tid = TIDX, lane = tid & 63, wave = tid >> 6, l31 = lane & 31, hh = lane >> 5;
  bf16* QT = reinterpret_cast<bf16*>(smem);
  float* SC = reinterpret_cast<float*>(smem + 33792);
  const int mtiles = (l == 1) ? 256 : 288;
  for (int it = VBID; it < mtiles * 8; it += NVB) {
    const int mt = it >> 3, h = it & 7;
    __syncthreads();
    for (int e = tid; e < 64 * 32; e += 256) {
      const int r = e >> 5, cc = e & 31;
      *reinterpret_cast<uint4*>(QT + r * 264 + cc * 8) = *reinterpret_cast<const uint4*>(P.QP + (size_t)(mt * 64 + r) * 2048 + h * 256 + cc * 8);
    }
    __syncthreads();
    unsigned lst[2][16];
    const int row = tid >> 2, part = tid & 3;
#pragma unroll
    for (int p = 0; p < 2; ++p) {
      f32x16 sa[2]; sa[0] = zero16(); sa[1] = zero16();
      const bf16* keys = P.SK + ((size_t)(l * 16 + h * 2 + p) * 128 + wave * 32 + l31) * 128;
#pragma unroll
      for (int ks = 0; ks < 8; ++ks) {
        const bf16x8 bfr = ldfrag(keys + ks * 16 + hh * 8);
#pragma unroll
        for (int i = 0; i < 2; ++i) {
          const bf16x8 af = ldfrag(QT + (i * 32 + l31) * 264 + p * 128 + ks * 16 + hh * 8);
          sa[i] = mfma32(af, bfr, sa[i]);
        }
      }
      if (p == 1) __syncthreads();
#pragma unroll
      for (int i = 0; i < 2; ++i)
#pragma unroll
        for (int r = 0; r < 16; ++r) SC[(i * 32 + drow(r, hh)) * 129 + wave * 32 + l31] = sa[i][r];
      __syncthreads();
      unsigned B2[16];
#pragma unroll
      for (int i = 0; i < 16; ++i) {
        const int i0 = part * 32 + ((i + part * 8) & 31), i1 = part * 32 + ((i + 16 + part * 8) & 31);
        lst[p][i] = (ordkey(SC[row * 129 + i0]) & ~0x7fu) | (unsigned)(127 - i0);
        B2[i] = (ordkey(SC[row * 129 + i1]) & ~0x7fu) | (unsigned)(127 - i1);
      }
      bitonic_sort_desc16(lst[p]);
      bitonic_sort_desc16(B2);
#pragma unroll
      for (int j = 0; j < 16; ++j) lst[p][j] = max(lst[p][j], B2[15 - j]);
      bitonic_merge_desc16(lst[p]);
      merge16(lst[p], 1);
      merge16(lst[p], 2);
    }
    float v0[16], v1[16];
#pragma unroll
    for (int j = 0; j < 16; ++j) { v0[j] = keyval(lst[0][j], 0x7fu); v1[j] = keyval(lst[1][j], 0x7fu); }
    unsigned best[16];
    {
      constexpr CandTab CT = make_cand_tab();
#pragma unroll
      for (int c = 0; c < 13; ++c) {
        const int a0 = CT.a[4 * c + 0], a1 = CT.a[4 * c + 1], a2 = CT.a[4 * c + 2], a3 = CT.a[4 * c + 3];
        const int b0 = CT.b[4 * c + 0], b1 = CT.b[4 * c + 1], b2 = CT.b[4 * c + 2], b3 = CT.b[4 * c + 3];
        const float x = part == 0 ? v0[a0] : part == 1 ? v0[a1] : part == 2 ? v0[a2] : v0[a3];
        const float y = part == 0 ? v1[b0] : part == 1 ? v1[b1] : part == 2 ? v1[b2] : v1[b3];
        const int flat = part == 0 ? (a0 * 16 + b0) : part == 1 ? (a1 * 16 + b1) : part == 2 ? (a2 * 16 + b2) : (a3 * 16 + b3);
        const bool valid = part == 0 ? (4 * c + 0 < 50) : part == 1 ? (4 * c + 1 < 50) : part == 2 ? (4 * c + 2 < 50) : (4 * c + 3 < 50);
        const unsigned key = (ordkey(x + y) & ~0xffu) | (unsigned)(255 - flat);
        best[c] = valid ? key : 0u;
      }
      best[13] = 0u; best[14] = 0u; best[15] = 0u;
      bitonic_sort_desc16(best);
      merge16(best, 1);
      merge16(best, 2);
    }
    {
      const float mx = keyval(best[0], 0xffu);
      float es = 0.f;
      float ev[4]; int ex[4];
#pragma unroll
      for (int jj = 0; jj < 4; ++jj) {
        const unsigned kk = part == 0 ? best[4 * jj + 0] : part == 1 ? best[4 * jj + 1] : part == 2 ? best[4 * jj + 2] : best[4 * jj + 3];
        ev[jj] = __expf(keyval(kk, 0xffu) - mx);
        es += ev[jj];
        const int flat = 255 - (int)(kk & 0xffu);
        const int a = flat >> 4, bq = flat & 15;
        int i1 = 0, i2 = 0;
#pragma unroll
        for (int u = 0; u < 16; ++u) {
          i1 = (a == u) ? (127 - (int)(lst[0][u] & 0x7fu)) : i1;
          i2 = (bq == u) ? (127 - (int)(lst[1][u] & 0x7fu)) : i2;
        }
        ex[jj] = i1 * 128 + i2;
      }
      es += __shfl_xor(es, 1); es += __shfl_xor(es, 2);
      const float inv = 1.f / es;
      const int tok = mt * 64 + row;
      int* ed = P.EIDX + (size_t)tok * 128 + h * 16;
      float* gd = P.GATE + (size_t)tok * 128 + h * 16;
#pragma unroll
      for (int jj = 0; jj < 4; ++jj) { ed[4 * jj + part] = ex[jj]; gd[4 * jj + part] = ev[jj] * inv; }
    }
  }
}

DEVI float gelu_exact(float a) { return 0.5f * a * (1.f + erff(a * 0.70710678118654752f)); }

typedef float f2 __attribute__((ext_vector_type(2)));
DEVI void phase_peer_u(const Params& P, int l) {
  const int lane = TIDX & 63, half = lane >> 5, l32 = lane & 31;
  const int gw = VBID * 4 + (TIDX >> 6), nw = NVB * 4;
  const int nrows = (l == 1) ? NL : NT;
  const unsigned char* PU = P.PU8 + (size_t)l * 16384 * 576;
  const bool b4 = lane & 16, b3 = lane & 8, b2 = lane & 4;
  for (int t = gw; t < nrows; t += nw) {
    f2 h2[16];
    {
      const bf16* hp = P.H + (size_t)t * 1024 + l32 * 32;
#pragma unroll
      for (int i = 0; i < 4; ++i) {
        const uint4 hv = *reinterpret_cast<const uint4*>(hp + i * 8);
        h2[4 * i + 0] = (f2){lo2f(hv.x), hi2f(hv.x)}; h2[4 * i + 1] = (f2){lo2f(hv.y), hi2f(hv.y)};
        h2[4 * i + 2] = (f2){lo2f(hv.z), hi2f(hv.z)}; h2[4 * i + 3] = (f2){lo2f(hv.w), hi2f(hv.w)};
      }
    }
    const int e0 = P.EIDX[(size_t)t * 128 + lane], e1 = P.EIDX[(size_t)t * 128 + 64 + lane];
    const float g0 = P.GATE[(size_t)t * 128 + lane], g1 = P.GATE[(size_t)t * 128 + 64 + lane];
    float* wrow = P.WPE + (size_t)t * 128;
    for (int kb = 0; kb < 8; ++kb) {
      const int esrc = kb < 4 ? e0 : e1;
      uint4 ud[8];
      unsigned short us[8];
#pragma unroll
      for (int i = 0; i < 8; ++i) {
        const int e = __shfl(esrc, (kb * 16 + 2 * i + half) & 63);
        const unsigned char* ur = PU + (size_t)e * 576;
        ud[i] = *reinterpret_cast<const uint4*>(ur + l32 * 16);
        us[i] = *reinterpret_cast<const unsigned short*>(ur + 512 + l32 * 2);
      }
      float d[8];
#pragma unroll
      for (int i = 0; i < 8; ++i) {
        const unsigned uw[4] = {ud[i].x, ud[i].y, ud[i].z, ud[i].w};
        f2 sacc = (f2){0.f, 0.f};
#pragma unroll
        for (int c = 0; c < 4; ++c) {
          sacc = __builtin_elementwise_fma(__builtin_amdgcn_cvt_scalef32_pk_f32_fp4(uw[c], 1.0f, 0), h2[4 * c + 0], sacc);
          sacc = __builtin_elementwise_fma(__builtin_amdgcn_cvt_scalef32_pk_f32_fp4(uw[c], 1.0f, 1), h2[4 * c + 1], sacc);
          sacc = __builtin_elementwise_fma(__builtin_amdgcn_cvt_scalef32_pk_f32_fp4(uw[c], 1.0f, 2), h2[4 * c + 2], sacc);
          sacc = __builtin_elementwise_fma(__builtin_amdgcn_cvt_scalef32_pk_f32_fp4(uw[c], 1.0f, 3), h2[4 * c + 3], sacc);
        }
        d[i] = (sacc.x + sacc.y) * __uint_as_float((unsigned)us[i] << 16);
      }
      float r4[4], r2[2], r1;
#pragma unroll
      for (int i = 0; i < 4; ++i) { const float mine = b4 ? d[4 + i] : d[i]; const float send = b4 ? d[i] : d[4 + i]; r4[i] = mine + __shfl_xor(send, 16); }
#pragma unroll
      for (int i = 0; i < 2; ++i) { const float mine = b3 ? r4[2 + i] : r4[i]; const float send = b3 ? r4[i] : r4[2 + i]; r2[i] = mine + __shfl_xor(send, 8); }
      { const float mine = b2 ? r2[1] : r2[0]; const float send = b2 ? r2[0] : r2[1]; r1 = mine + __shfl_xor(send, 4); }
      r1 += __shfl_xor(r1, 2); r1 += __shfl_xor(r1, 1);
      const int k = kb * 16 + 2 * ((lane >> 2) & 7) + half;
      const float gt = __shfl(kb < 4 ? g0 : g1, k & 63);
      if ((lane & 3) == 0) wrow[k] = gt * gelu_exact(r1);
    }
  }
}

DEVI void phase_peer(const Params& P, int l) {
  const int lane = TIDX & 63, half = lane >> 5, l32 = lane & 31;
  const int gw = VBID * 4 + (TIDX >> 6), nw = NVB * 4;
  const int nrows = (l == 1) ? NL : NT;
  const unsigned char* PV = P.PV8 + (size_t)l * 16384 * 576;
  for (int t = gw; t < nrows; t += nw) {
    const int e0 = P.EIDX[(size_t)t * 128 + lane], e1 = P.EIDX[(size_t)t * 128 + 64 + lane];
    const float w0 = P.WPE[(size_t)t * 128 + lane], w1 = P.WPE[(size_t)t * 128 + 64 + lane];
    f2 y2[16];
#pragma unroll
    for (int i = 0; i < 16; ++i) y2[i] = (f2){0.f, 0.f};
    for (int kb = 0; kb < 8; ++kb) {
      const int esrc = kb < 4 ? e0 : e1;
      const float wsrc = kb < 4 ? w0 : w1;
      uint4 vd[8];
      unsigned short vs[8];
      float wv[8];
#pragma unroll
      for (int i = 0; i < 8; ++i) {
        const int ks = (kb * 16 + 2 * i + half) & 63;
        const int e = __shfl(esrc, ks);
        wv[i] = __shfl(wsrc, ks);
        const unsigned char* vr = PV + (size_t)e * 576;
        vd[i] = *reinterpret_cast<const uint4*>(vr + l32 * 16);
        vs[i] = *reinterpret_cast<const unsigned short*>(vr + 512 + l32 * 2);
      }
#pragma unroll
      for (int i = 0; i < 8; ++i) {
        const float wi = wv[i] * __uint_as_float((unsigned)vs[i] << 16);
        const f2 ww = (f2){wi, wi};
        const unsigned vw[4] = {vd[i].x, vd[i].y, vd[i].z, vd[i].w};
#pragma unroll
        for (int c = 0; c < 4; ++c) {
          y2[4 * c + 0] = __builtin_elementwise_fma(ww, __builtin_amdgcn_cvt_scalef32_pk_f32_fp4(vw[c], 1.0f, 0), y2[4 * c + 0]);
          y2[4 * c + 1] = __builtin_elementwise_fma(ww, __builtin_amdgcn_cvt_scalef32_pk_f32_fp4(vw[c], 1.0f, 1), y2[4 * c + 1]);
          y2[4 * c + 2] = __builtin_elementwise_fma(ww, __builtin_amdgcn_cvt_scalef32_pk_f32_fp4(vw[c], 1.0f, 2), y2[4 * c + 2]);
          y2[4 * c + 3] = __builtin_elementwise_fma(ww, __builtin_amdgcn_cvt_scalef32_pk_f32_fp4(vw[c], 1.0f, 3), y2[4 * c + 3]);
        }
      }
    }
    float y[16];
#pragma unroll
    for (int j = 0; j < 8; ++j) {
      const float ax = y2[j].x + __shfl_xor(y2[j].x, 32), ay = y2[j].y + __shfl_xor(y2[j].y, 32);
      const float bx = y2[8 + j].x + __shfl_xor(y2[8 + j].x, 32), by = y2[8 + j].y + __shfl_xor(y2[8 + j].y, 32);
      y[2 * j] = half ? bx : ax; y[2 * j + 1] = half ? by : ay;
    }
    const int bi = batch_of_row(t);
    const float* gate2 = P.MOD + (size_t)(l * 9 + bi) * 6144 + 5 * 1024;
    const int d0 = l32 * 32 + half * 16;
    float xn[16];
    float ss = 0.f;
#pragma unroll
    for (int q4 = 0; q4 < 4; ++q4) {
      const int d = d0 + q4 * 4;
      const uint2 xu = *reinterpret_cast<const uint2*>(P.X + (size_t)t * 1024 + d);
      const float4 xo = make_float4(lo2f(xu.x), hi2f(xu.x), lo2f(xu.y), hi2f(xu.y));
      const float4 gg = *reinterpret_cast<const float4*>(gate2 + d);
      float4 o;
      o.x = xo.x + gg.x * y[q4 * 4 + 0]; o.y = xo.y + gg.y * y[q4 * 4 + 1];
      o.z = xo.z + gg.z * y[q4 * 4 + 2]; o.w = xo.w + gg.w * y[q4 * 4 + 3];
      xn[q4 * 4 + 0] = o.x; xn[q4 * 4 + 1] = o.y; xn[q4 * 4 + 2] = o.z; xn[q4 * 4 + 3] = o.w;
      ss += o.x * o.x + o.y * o.y + o.z * o.z + o.w * o.w;
      if (l == 1) *reinterpret_cast<float4*>(P.out + (size_t)t * 1024 + d) = o;
      else *reinterpret_cast<uint2*>(P.X + (size_t)t * 1024 + d) = make_uint2(pack2(o.x, o.y), pack2(o.z, o.w));
    }
    if (l == 0) {
      ss = wave_sum(ss);
      const float rr = rsqrtf(ss * (1.f / 1024.f) + EPS);
      const float* lnw = P.ln1_w + 1024;
      const float* mod = P.MOD + (size_t)(9 + bi) * 6144;
      unsigned pk[8];
#pragma unroll
      for (int i = 0; i < 16; i += 2) {
        const float o0 = xn[i] * rr * lnw[d0 + i] * (1.f + mod[1024 + d0 + i]) + mod[d0 + i];
        const float o1 = xn[i + 1] * rr * lnw[d0 + i + 1] * (1.f + mod[1024 + d0 + i + 1]) + mod[d0 + i + 1];
        pk[i >> 1] = pack2(o0, o1);
      }
      *reinterpret_cast<uint4*>(P.H + (size_t)t * 1024 + d0) = make_uint4(pk[0], pk[1], pk[2], pk[3]);
      *reinterpret_cast<uint4*>(P.H + (size_t)t * 1024 + d0 + 8) = make_uint4(pk[4], pk[5], pk[6], pk[7]);
    }
  }
}

using f32x4 = __attribute__((ext_vector_type(4))) float;
namespace g8 {
constexpr int BM = 256, BK = 64, HALF = 128, HT = HALF * BK;
DEVI int lds_byte(int r, int c) { const int st = (r >> 4) * 2 + (c >> 5), rr = r & 15, cc = c & 31, ob = rr * 64 + cc * 2; return st * 1024 + (ob ^ (((ob >> 9) & 1) << 5)); }
DEVI void stage_rc(int b, int& R, int& C) { const int st = b / 1024, sb = b % 1024, swz = sb ^ (((sb >> 9) & 1) << 5); R = (st >> 1) * 16 + swz / 64; C = (st & 1) * 32 + (swz % 64) / 2; }
DEVI void unit_of(int L, int nM, int nN, int& pm, int& pn) {
  const int nwg = nM * nN;
  int wgid = L;
  { const int q = nwg / 8, r = nwg % 8, xcd = wgid % 8, off = wgid / 8; wgid = (xcd < r ? xcd * (q + 1) : r * (q + 1) + (xcd - r) * q) + off; }
  const int nig = 8 * nN, gid = wgid / nig, fm = gid * 8, gsz = (nM - fm) < 8 ? (nM - fm) : 8;
  pm = fm + ((wgid % nig) % gsz); pn = (wgid % nig) / gsz;
}
}

struct G8Unit { int pm, pn; };
template <class Epi>
DEVI void gemm8_phase(LAS unsigned char* lds, const bf16* __restrict__ Ag, const bf16* __restrict__ Btg, const int K, const int nM, const int nN, const Epi& E,
                      const int lda = 0, const int pn_split = 1 << 30, const int acol0 = 0, const int acol1 = 0) {
  constexpr int BK = 64, HALF = 128, HTB = HALF * BK * 2;
  const int tid = threadIdx.x, wid = __builtin_amdgcn_readfirstlane(tid >> 6), lane = tid & 63, wr = wid >> 2, wc = wid & 3, fr = lane & 15, fq = lane >> 4;
  const int nt = K / BK;
  const int nunits = nM * nN, G = gridDim.x, c = blockIdx.x;
  const int LDA = lda ? lda : K;
  unsigned voffA[2], voffB[2];
#pragma unroll
  for (int i = 0; i < 2; ++i) { int R, C; g8::stage_rc(tid * 16 + i * 8192, R, C); voffA[i] = (unsigned)(R * LDA + C) * 2u; voffB[i] = (unsigned)(R * K + C) * 2u; }
  const size_t kstep = (size_t)(BK * 2);
  const size_t hstepA = (size_t)HALF * LDA * 2, hstep = (size_t)HALF * K * 2;
  const size_t tstepA = 2 * hstepA, tstep = 2 * hstep;
  const unsigned ldsw = (unsigned)wid * 1024u;
  const int aoff = g8::lds_byte(wr * 64 + fr, fq * 8), boff = g8::lds_byte(wc * 32 + fr, fq * 8);
#define PG8_SA(b, h) (((b) * 2 + (h)) * HTB)
#define PG8_SB(b, h) ((4 + (b) * 2 + (h)) * HTB)
#define PG8_STAGE(bufoff, gbase, voff) do { _Pragma("unroll") for (int _i = 0; _i < 2; ++_i) \
        __builtin_amdgcn_global_load_lds((const unsigned*)((const char*)(gbase) + (voff)[_i]), (LAS unsigned*)(lds + (bufoff) + ldsw + _i * 8192), 16, 0, 0); } while (0)
#define PG8_LDA(dst, b, h) do { _Pragma("unroll") for (int m = 0; m < 4; ++m) _Pragma("unroll") for (int k = 0; k < 2; ++k) dst[m][k] = *(const LAS bf16x8*)(lds + PG8_SA(b, h) + aoff + m * 2048 + k * 1024); } while (0)
#define PG8_LDB(dst, b, h) do { _Pragma("unroll") for (int n = 0; n < 2; ++n) _Pragma("unroll") for (int k = 0; k < 2; ++k) dst[n][k] = *(const LAS bf16x8*)(lds + PG8_SB(b, h) + boff + n * 2048 + k * 1024); } while (0)
#define PG8_MMA(ai, bj, At_, Bt_) do { __builtin_amdgcn_s_setprio(1); _Pragma("unroll") for (int m = 0; m < 4; ++m) _Pragma("unroll") for (int n = 0; n < 2; ++n) _Pragma("unroll") for (int k = 0; k < 2; ++k) \
        acc[ai][bj][m][n] = __builtin_amdgcn_mfma_f32_16x16x32_bf16(Bt_[n][k], At_[m][k], acc[ai][bj][m][n], 0, 0, 0); __builtin_amdgcn_s_setprio(0); } while (0)
#define PG8_WAIT_V(n) asm volatile("s_waitcnt vmcnt(" #n ")" ::: "memory")
#define PG8_WAIT_L(n) asm volatile("s_waitcnt lgkmcnt(" #n ")" ::: "memory")
#define PG8_BAR __builtin_amdgcn_s_barrier()
#define PG8_SCHED __builtin_amdgcn_sched_barrier(0)
  G8Unit cur, nxt; int ui = 0;
  if (c >= nunits) return;
  g8::unit_of(c, nM, nN, cur.pm, cur.pn);
  f32x4 acc[2][2][4][2];
#pragma unroll
  for (int a = 0; a < 2; ++a)
#pragma unroll
    for (int b = 0; b < 2; ++b)
#pragma unroll
      for (int m = 0; m < 4; ++m)
#pragma unroll
        for (int n = 0; n < 2; ++n) acc[a][b][m][n] = (f32x4){0.f, 0.f, 0.f, 0.f};
  bf16x8 At[4][2], B0[2][2], B1[2][2];
  const char* cA = (const char*)Ag + (size_t)cur.pm * tstepA + (size_t)(cur.pn < pn_split ? acol0 : acol1) * 2; const char* cB = (const char*)Btg + (size_t)cur.pn * tstep;
  PG8_STAGE(PG8_SB(0, 0), cB, voffB); PG8_STAGE(PG8_SA(0, 0), cA, voffA); PG8_STAGE(PG8_SB(0, 1), cB + hstep, voffB); PG8_STAGE(PG8_SA(0, 1), cA + hstepA, voffA);
  if (wr == 1) PG8_BAR;
  PG8_WAIT_V(4); PG8_BAR;
  PG8_STAGE(PG8_SB(1, 0), cB + kstep, voffB); PG8_STAGE(PG8_SA(1, 0), cA + kstep, voffA); PG8_STAGE(PG8_SB(1, 1), cB + hstep + kstep, voffB);
  PG8_WAIT_V(6); PG8_BAR;
  for (;;) {
    const long Ln = (long)(ui + 1) * G + c;
    const bool has_next = Ln < nunits;
    if (has_next) g8::unit_of((int)Ln, nM, nN, nxt.pm, nxt.pn);
    const char* nA = has_next ? (const char*)Ag + (size_t)nxt.pm * tstepA + (size_t)(nxt.pn < pn_split ? acol0 : acol1) * 2 : cA; const char* nB = has_next ? (const char*)Btg + (size_t)nxt.pn * tstep : cB;
    for (int t = 0; t < nt; t += 2) {
      const bool last = (t == nt - 2);
      const char* a1 = cA + (size_t)(t + 1) * kstep;
      const char* a2 = last ? nA : cA + (size_t)(t + 2) * kstep; const char* b2 = last ? nB : cB + (size_t)(t + 2) * kstep;
      const char* a3 = a2 + kstep; const char* b3 = b2 + kstep;
      PG8_LDB(B0, 0, 0); PG8_SCHED; PG8_LDA(At, 0, 0); PG8_STAGE(PG8_SA(1, 1), a1 + hstepA, voffA);
      PG8_WAIT_L(8); PG8_BAR; PG8_WAIT_L(0); PG8_MMA(0, 0, At, B0); PG8_BAR; PG8_SCHED;
      PG8_LDB(B1, 0, 1); PG8_STAGE(PG8_SB(0, 0), b2, voffB);
      PG8_BAR; PG8_WAIT_L(0); PG8_MMA(0, 1, At, B1); PG8_BAR;
      PG8_LDA(At, 0, 1); PG8_STAGE(PG8_SA(0, 0), a2, voffA);
      PG8_BAR; PG8_WAIT_L(0); PG8_MMA(1, 0, At, B0); PG8_BAR; PG8_SCHED;
      PG8_STAGE(PG8_SB(0, 1), b2 + hstep, voffB);
      PG8_WAIT_V(6); PG8_BAR; PG8_MMA(1, 1, At, B1); PG8_BAR;
      PG8_LDB(B0, 1, 0); PG8_SCHED; PG8_LDA(At, 1, 0); PG8_STAGE(PG8_SA(0, 1), a2 + hstepA, voffA);
      PG8_WAIT_L(8); PG8_BAR; PG8_WAIT_L(0); PG8_MMA(0, 0, At, B0); PG8_BAR; PG8_SCHED;
      PG8_LDB(B1, 1, 1); PG8_STAGE(PG8_SB(1, 0), b3, voffB);
      PG8_BAR; PG8_WAIT_L(0); PG8_MMA(0, 1, At, B1); PG8_BAR;
      PG8_LDA(At, 1, 1); PG8_STAGE(PG8_SA(1, 0), a3, voffA);
      PG8_BAR; PG8_WAIT_L(0); PG8_MMA(1, 0, At, B0); PG8_BAR; PG8_SCHED;
      PG8_STAGE(PG8_SB(1, 1), b3 + hstep, voffB);
      PG8_WAIT_V(6); PG8_BAR; PG8_MMA(1, 1, At, B1); PG8_BAR;
    }
    E(acc, cur, wr, wc, fr, fq);
    if (!has_next) break;
#pragma unroll
    for (int a = 0; a < 2; ++a)
#pragma unroll
      for (int b = 0; b < 2; ++b)
#pragma unroll
        for (int m = 0; m < 4; ++m)
#pragma unroll
          for (int n = 0; n < 2; ++n) acc[a][b][m][n] = (f32x4){0.f, 0.f, 0.f, 0.f};
    cur = nxt; cA = nA; cB = nB; ++ui;
  }
  PG8_WAIT_V(0);
  if (wr == 0) PG8_BAR;
  PG8_BAR;
#undef PG8_SA
#undef PG8_SB
#undef PG8_STAGE
#undef PG8_LDA
#undef PG8_LDB
#undef PG8_MMA
}

struct EpiZ {
  bf16* Z;
  DEVI void operator()(const f32x4 (&acc)[2][2][4][2], const G8Unit& u, int wr, int wc, int fr, int fq) const {
    const int brow = u.pm * 256, bcol = u.pn * 256;
#pragma unroll
    for (int ai = 0; ai < 2; ++ai)
#pragma unroll
      for (int m = 0; m < 4; ++m) {
        const int row = brow + ai * 128 + wr * 64 + m * 16 + fr;
#pragma unroll
        for (int bj = 0; bj < 2; ++bj)
#pragma unroll
          for (int n = 0; n < 2; ++n) {
            const int col = bcol + bj * 128 + wc * 32 + n * 16 + 4 * fq;
            if (col < DIN) {
              const f32x4 v = acc[ai][bj][m][n];
              *reinterpret_cast<uint2*>(Z + (size_t)row * DIN + col) = make_uint2(pack2(v[0], v[1]), pack2(v[2], v[3]));
            }
          }
      }
  }
};
DEVI void phase_gemm1_8(const Params& P, int l, unsigned char* smem_base) {
  EpiZ E{P.Z};
  gemm8_phase((LAS unsigned char*)smem_base, P.H, P.WinT + (size_t)l * DINP * 1024, 1024, NT / 256, DINP / 256, E);
  const int c = blockIdx.x;
  if (c >= 136) {
    const int j = c - 136;
    if (l == 0) convert_rows_fp6(P, 0, j * 100, j * 100 + 100);
    else { const int b0 = 19200 + j * 114; convert_rows_fp6(P, 1, b0 < 32768 ? b0 : 32768, b0 + 114 < 32768 ? b0 + 114 : 32768); }
  }
}

struct EpiRAW {
  bf16* R;
  DEVI void operator()(const f32x4 (&acc)[2][2][4][2], const G8Unit& u, int wr, int wc, int fr, int fq) const {
    const int brow = u.pm * 256, bcol = u.pn * 256;
#pragma unroll
    for (int ai = 0; ai < 2; ++ai)
#pragma unroll
      for (int m = 0; m < 4; ++m) {
        const int row = brow + ai * 128 + wr * 64 + m * 16 + fr;
#pragma unroll
        for (int bj = 0; bj < 2; ++bj)
#pragma unroll
          for (int n = 0; n < 2; ++n) {
            const int col = bcol + bj * 128 + wc * 32 + n * 16 + 4 * fq;
            const f32x4 v = acc[ai][bj][m][n];
            *reinterpret_cast<uint2*>(R + (size_t)row * 1792 + col) = make_uint2(pack2(v[0], v[1]), pack2(v[2], v[3]));
          }
      }
  }
};
DEVI void phase_mla_raw(const Params& P, int l, unsigned char* smem_base) {
  EpiRAW E{P.RAW};
  gemm8_phase((LAS unsigned char*)smem_base, P.Z, P.WCOMB + (size_t)l * 1792 * 256, 256, NT / 256, 7, E, DIN, 3, ZC_BQ, ZC_BKV);
}

struct EpiX {
  const float* x; const float* ctx; bf16* X; const float* MODl; int l;
  DEVI void operator()(const f32x4 (&acc)[2][2][4][2], const G8Unit& u, int wr, int wc, int fr, int fq) const {
    const int brow = u.pm * 256, bcol = u.pn * 256;
    const float* gate = MODl + (size_t)batch_of_row(brow) * 6144 + 2048;
#pragma unroll
    for (int ai = 0; ai < 2; ++ai)
#pragma unroll
      for (int m = 0; m < 4; ++m) {
        const int row = brow + ai * 128 + wr * 64 + m * 16 + fr;
        const float* res = row < NL ? x + (size_t)row * 1024 : ctx + (size_t)(row - NL) * 1024;
#pragma unroll
        for (int bj = 0; bj < 2; ++bj)
#pragma unroll
          for (int n = 0; n < 2; ++n) {
            const int col = bcol + bj * 128 + wc * 32 + n * 16 + 4 * fq;
            const f32x4 v = acc[ai][bj][m][n];
            float4 r4;
            if (l == 0) r4 = *reinterpret_cast<const float4*>(res + col);
            else { const uint2 u = *reinterpret_cast<const uint2*>(X + (size_t)row * 1024 + col); r4 = make_float4(lo2f(u.x), hi2f(u.x), lo2f(u.y), hi2f(u.y)); }
            const float4 g4 = *reinterpret_cast<const float4*>(gate + col);
            float4 o; o.x = r4.x + g4.x * v[0]; o.y = r4.y + g4.y * v[1]; o.z = r4.z + g4.z * v[2]; o.w = r4.w + g4.w * v[3];
            *reinterpret_cast<uint2*>(X + (size_t)row * 1024 + col) = make_uint2(pack2(o.x, o.y), pack2(o.z, o.w));
          }
      }
  }
};
DEVI void phase_gemm2_8(const Params& P, int l, unsigned char* smem_base) {
  EpiX E{P.x, P.ctx, P.X, P.MOD + (size_t)l * 9 * 6144, l};
  gemm8_phase((LAS unsigned char*)smem_base, P.H, P.WoutT + (size_t)l * 1024 * 1024, 1024, (l == 1) ? NL / 256 : NT / 256, 4, E);
  const int c = blockIdx.x;
  if (l == 0 && c >= 32) {
    const int b0 = 12000 + (c - 32) * 93;
    convert_rows_fp6(P, 0, b0 < 32768 ? b0 : 32768, b0 + 93 < 32768 ? b0 + 93 : 32768);
  }
}

struct EpiQP {
  bf16* QP;
  DEVI void operator()(const f32x4 (&acc)[2][2][4][2], const G8Unit& u, int wr, int wc, int fr, int fq) const {
    const int brow = u.pm * 256, bcol = u.pn * 256;
#pragma unroll
    for (int ai = 0; ai < 2; ++ai)
#pragma unroll
      for (int m = 0; m < 4; ++m) {
        const int row = brow + ai * 128 + wr * 64 + m * 16 + fr;
#pragma unroll
        for (int bj = 0; bj < 2; ++bj)
#pragma unroll
          for (int n = 0; n < 2; ++n) {
            const int col = bcol + bj * 128 + wc * 32 + n * 16 + 4 * fq;
            const f32x4 v = acc[ai][bj][m][n];
            *reinterpret_cast<uint2*>(QP + (size_t)row * 2048 + col) = make_uint2(pack2(v[0], v[1]), pack2(v[2], v[3]));
          }
      }
  }
};
DEVI void phase_gemm3_8(const Params& P, int l, unsigned char* smem_base) {
  EpiQP E{P.QP};
  gemm8_phase((LAS unsigned char*)smem_base, P.H, P.WpqT + (size_t)l * 2048 * 1024, 1024, (l == 1) ? NL / 256 : NT / 256, 8, E);
  const int c = blockIdx.x;
  if (l == 0 && c >= 64) convert_rows_fp6(P, 1, (c - 64) * 100, (c - 64) * 100 + 100);
}

constexpr int N_PHASES = 2 + 2 * 11;

#ifndef REP_MASK
#define REP_MASK 0
#endif
static_assert(sizeof(Params) % 8 == 0, "Params size");
DEVI Params load_params() {
#if defined(__HIP_DEVICE_COMPILE__)
  typedef const __attribute__((address_space(4))) Params* ParamsCP;
  ParamsCP pp = (ParamsCP)__builtin_amdgcn_kernarg_segment_ptr();
  asm volatile("" : "+s"(pp));
  return *pp;
#else
  return Params{};
#endif
}
__global__ void __launch_bounds__(512, 2) fwd_kernel(Params Pk) {
  extern __shared__ __attribute__((aligned(16))) unsigned char smem_base[];
  volatile LAS unsigned* xst = (volatile LAS unsigned*)(smem_base + SMEM_BYTES);
  if (threadIdx.x == 0) { xst[0] = 0u; xst[1] = 0u; xst[2] = 0u; xst[3] = 0u; }
  __syncthreads();
  XcdBarrier xb = xcd_barrier_post(Pk.bar, xst);
  const int phase_lo = Pk.phase_lo, phase_hi = Pk.phase_hi, coop = Pk.coop;
#define smem (smem_base + VHALF * HALF_LDS)
#define GSYNC(idx) { xcd_barrier(xb); }
#define RUN_PHASE2(idx, call, repcall) \
  if (phase_lo <= (idx) && (idx) <= phase_hi) { { const Params P = load_params(); call; } if (REP_MASK & (1 << (idx))) { GSYNC(1); const Params P = load_params(); repcall; } if (coop && (idx) < phase_hi) GSYNC(idx); }
#define RUN_PHASE(idx, call) RUN_PHASE2(idx, call, call)
  RUN_PHASE(0, phase_prologue(P, smem))
  RUN_PHASE(1, phase_norm(P, 0, 0, NT))
  RUN_PHASE(2, phase_gemm1_8(P, 0, smem_base))
  RUN_PHASE(3, phase_mla_raw(P, 0, smem_base))
  RUN_PHASE(4, { phase_mixA(P, 0, smem); phase_mla_proj(P, 0, smem); phase_hgrn_local(P, 0, smem); })
  RUN_PHASE2(5, phase_attn_scan(P, 0, smem_base), phase_attn_scan(P, 0, smem_base, true))
  RUN_PHASE(6, phase_hgrn_final(P, 0, smem))
  RUN_PHASE(7, phase_gemm2_8(P, 0, smem_base))
  RUN_PHASE(8, phase_norm(P, 0, 1, NT))
  RUN_PHASE(9, phase_gemm3_8(P, 0, smem_base))
  RUN_PHASE(10, phase_route(P, 0, smem))
  RUN_PHASE(11, phase_peer_u(P, 0))
  RUN_PHASE(12, phase_peer(P, 0))
  RUN_PHASE(13, phase_gemm1_8(P, 1, smem_base))
  RUN_PHASE(14, phase_mla_raw(P, 1, smem_base))
  RUN_PHASE(15, { phase_mixA(P, 1, smem); phase_mla_proj(P, 1, smem); phase_hgrn_local(P, 1, smem); })
  RUN_PHASE2(16, phase_attn_scan(P, 1, smem_base), phase_attn_scan(P, 1, smem_base, true))
  RUN_PHASE(17, phase_hgrn_final(P, 1, smem))
  RUN_PHASE(18, phase_gemm2_8(P, 1, smem_base))
  RUN_PHASE(19, phase_norm(P, 1, 1, NL))
  RUN_PHASE(20, phase_gemm3_8(P, 1, smem_base))
  RUN_PHASE(21, phase_route(P, 1, smem))
  RUN_PHASE(22, phase_peer_u(P, 1))
  RUN_PHASE(23, phase_peer(P, 1))
#undef smem
}

extern "C" void kernel_launch(void* const* d_in, const int* in_sizes, int n_in, void* d_out, int out_size, void* d_ws,
                              size_t ws_size, hipStream_t stream) {
  Params p{};
  const float* const* in = reinterpret_cast<const float* const*>(d_in);
  p.x = in[0]; p.c = in[1]; p.ctx = in[2]; p.c_ctx = in[3]; p.ln1_w = in[4]; p.ln2_w = in[5]; p.w_mod = in[6]; p.b_mod = in[7];
  p.w_in = in[8]; p.w_out = in[9]; p.a_norm_w = in[10]; p.a_w_s = in[11]; p.a_b_s = in[12]; p.b_q_norm_w = in[13]; p.b_w_uq = in[14];
  p.b_kv_norm_w = in[15]; p.b_w_ukv = in[16]; p.b_qh_w = in[17]; p.b_kh_w = in[18]; p.c_lb = in[19]; p.c_out_norm_w = in[20];
  p.p_w_q = in[21]; p.p_sub_keys = in[22]; p.p_u = in[23]; p.p_v = in[24];
  p.out = reinterpret_cast<float*>(d_out);
  unsigned char* ws = reinterpret_cast<unsigned char*>(d_ws);
  size_t off = 0;
  auto take = [&](size_t bytes) { unsigned char* r = ws + off; off += (bytes + 255) & ~(size_t)255; return r; };
  p.bar = (unsigned*)take((size_t)XCD_BAR_WORDS * 4);
  p.MOD = (float*)take((size_t)2 * 9 * 6144 * 4);
  p.ROPE = (float*)take((size_t)2048 * 32 * 4);
  p.WinT = (bf16*)take((size_t)2 * DINP * 1024 * 2);
  p.WoutT = (bf16*)take((size_t)2 * 1024 * 1024 * 2);
  p.WpqT = (bf16*)take((size_t)2 * 2048 * 1024 * 2);
  p.WCOMB = (bf16*)take((size_t)2 * 1792 * 256 * 2);
  p.RAW = (bf16*)take((size_t)NT * 1792 * 2);
  p.SK = (bf16*)take((size_t)2 * 16 * 128 * 128 * 2);
  p.AWS = (bf16*)take((size_t)2 * 4 * 128 * 128 * 2);
  p.PU8 = (unsigned char*)take((size_t)2 * 16384 * 576);
  p.PV8 = (unsigned char*)take((size_t)2 * 16384 * 576);
  p.PUS = (float*)take((size_t)2 * 16384 * 4);
  p.PVS = (float*)take((size_t)2 * 16384 * 4);
  p.X = (bf16*)take((size_t)NT * 1024 * 2);
  p.H = (bf16*)take((size_t)NT * 1024 * 2);
  p.Z = (bf16*)take((size_t)NT * DIN * 2);
  p.Q = (bf16*)take((size_t)64 * SEQP * 96 * 2);
  p.K = (bf16*)take((size_t)64 * SEQP * 96 * 2);
  p.VT = (bf16*)take((size_t)64 * 64 * SEQP * 2);
  p.ST = (float*)take((size_t)64 * 36 * 4096 * 4);
  p.DEC = (float*)take((size_t)64 * 36 * 64 * 4);
  p.OI = (float*)take((size_t)NT * 256 * 4);
  p.WPE = (float*)take((size_t)NT * 128 * 4);
  p.GQF = (bf16*)take((size_t)NT * 256 * 2);
  p.GQB = (bf16*)take((size_t)NT * 256 * 2);
  p.QP = p.Z;
  p.EIDX = (int*)p.Q;
  p.GATE = (float*)p.K;
  if (off > ws_size) { fprintf(stderr, "workspace too small: need %zu have %zu\n", off, ws_size); }
  static int grid_blocks = 0;
  if (!grid_blocks) {
    if (hipFuncSetAttribute((const void*)fwd_kernel, hipFuncAttributeMaxDynamicSharedMemorySize, SMEM_TOTAL) != hipSuccess)
      fprintf(stderr, "hipFuncSetAttribute failed\n");
    int dev = 0, cus = 0, per_cu = 0;
    hipGetDevice(&dev);
    hipDeviceGetAttribute(&cus, hipDeviceAttributeMultiprocessorCount, dev);
    hipOccupancyMaxActiveBlocksPerMultiprocessor(&per_cu, (const void*)fwd_kernel, 512, SMEM_TOTAL);
    if (per_cu > 1) per_cu = 1;
    if (per_cu < 1) { fprintf(stderr, "occupancy query returned %d\n", per_cu); per_cu = 1; }
    grid_blocks = cus * per_cu;
    fprintf(stderr, "grid_blocks=%d (cus=%d per_cu=%d) ws need=%zu have=%zu\n", grid_blocks, cus, per_cu, off, ws_size);
  }
  hipMemsetAsync(p.bar, 0, (size_t)XCD_BAR_WORDS * 4, stream);
  p.coop = 1; p.phase_lo = 0; p.phase_hi = N_PHASES - 1;
  hipLaunchKernelGGL(fwd_kernel, dim3(grid_blocks), dim3(512), SMEM_TOTAL, stream, p);
  const hipError_t e = hipPeekAtLastError();
  if (e != hipSuccess) fprintf(stderr, "launch failed: %s (grid %d)\n", hipGetErrorString(e), grid_blocks);
}
```

```cpp
#include <hip/hip_runtime.h>
#include <hip/hip_cooperative_groups.h>
#include <cstdio>
#include <cstdint>
namespace cg = cooperative_groups;

#define DEVI __device__ __forceinline__

typedef unsigned short bf16;
using bf16x8 = __attribute__((ext_vector_type(8))) __bf16;
using bf16x2 = __attribute__((ext_vector_type(2))) __bf16;
using f32x16 = __attribute__((ext_vector_type(16))) float;
typedef unsigned v6u __attribute__((ext_vector_type(6)));
typedef unsigned v3u __attribute__((ext_vector_type(3)));
typedef float v16f __attribute__((ext_vector_type(16)));
typedef float v32f __attribute__((ext_vector_type(32)));

constexpr int NL = 16384;
constexpr int NT = 18432;
constexpr int DM = 1024;
constexpr int DIN = 2208;
constexpr int DINP = 2304;
constexpr int SEQP = 2304;
constexpr float EPS = 1e-6f;
constexpr int ZC_AU = 0, ZC_AV = 256, ZC_BQ = 512, ZC_BKV = 768, ZC_BKR = 896, ZC_CQ = 928, ZC_CFF = 1184, ZC_CFB = 1440, ZC_CI = 1696, ZC_CG = 1952;
constexpr int SMEM_BYTES = 2 * 80896;
constexpr int SMEM_TOTAL = SMEM_BYTES + 16;

struct Params {
  const float *x, *c, *ctx, *c_ctx, *ln1_w, *ln2_w, *w_mod, *b_mod, *w_in, *w_out, *a_norm_w, *a_w_s, *a_b_s;
  const float *b_q_norm_w, *b_w_uq, *b_kv_norm_w, *b_w_ukv, *b_qh_w, *b_kh_w, *c_lb, *c_out_norm_w, *p_w_q, *p_sub_keys, *p_u, *p_v;
  float* out;
  unsigned* bar;
  float* MOD;
  float* ROPE;
  bf16* WinT;
  bf16* WoutT;
  bf16* WpqT;
  bf16* WCOMB;
  bf16* RAW;
  bf16* SK;
  bf16* AWS;
  unsigned char* PU8;
  unsigned char* PV8;
  float* PUS;
  float* PVS;
  bf16* X;
  bf16* H;
  bf16* Z;
  bf16* Q;
  bf16* K;
  bf16* VT;
  bf16* ST;
  float* DEC;
  bf16* OI;
  float* WPE;
  bf16* GQF;
  bf16* GQB;
  bf16* QP;
  int* EIDX;
  float* GATE;
  int phase_lo, phase_hi, coop, pad0;
};

DEVI float bf2f(bf16 v) { return __uint_as_float(((unsigned)v) << 16); }
DEVI bf16 f2bf(float a) { __bf16 v = (__bf16)a; return __builtin_bit_cast(unsigned short, v); }
DEVI unsigned pack2(float a, float b) { bf16x2 v; v[0] = (__bf16)a; v[1] = (__bf16)b; return __builtin_bit_cast(unsigned, v); }
DEVI float lo2f(unsigned u) { return __uint_as_float(u << 16); }
DEVI float hi2f(unsigned u) { return __uint_as_float(u & 0xffff0000u); }
DEVI f32x16 zero16() { f32x16 z;
#pragma unroll
  for (int i = 0; i < 16; ++i) z[i] = 0.f; return z; }
DEVI f32x16 mfma32(bf16x8 a, bf16x8 b, f32x16 c) { return __builtin_amdgcn_mfma_f32_32x32x16_bf16(a, b, c, 0, 0, 0); }
DEVI bf16x8 ldfrag(const bf16* p) { return *reinterpret_cast<const bf16x8*>(p); }
DEVI int drow(int r, int hh) { return (r & 3) + 8 * (r >> 2) + 4 * hh; }
DEVI int row_of(int b, int p) { return p < 256 ? NL + b * 256 + p : b * 2048 + (p - 256); }
DEVI int batch_of_row(int r) { return r < NL ? (r >> 11) : 8; }
DEVI float wave_sum(float v) {
#pragma unroll
  for (int o = 32; o > 0; o >>= 1) v += __shfl_xor(v, o);
  return v;
}
DEVI float sigmoidf_(float z) { return 1.f / (1.f + __expf(-z)); }


#define XB_TMO      128
#define XB_XCNT(j)  (256  + 64 * (j))
#define XB_XSUB(j)  (1280 + 64 * (j))
#define XB_XGEN(j)  (2304 + 64 * (j))
#define XB_TOP      3328
#define XB_TOPGEN   3392
#define XCD_BAR_WORDS 3456
#define XB_SPIN_CAP (1u << 22)
#define LAS __attribute__((address_space(3)))
DEVI unsigned xb_ld(unsigned* p)              { return __hip_atomic_load(p, __ATOMIC_RELAXED, __HIP_MEMORY_SCOPE_AGENT); }
DEVI unsigned xb_add(unsigned* p, unsigned v) { return __hip_atomic_fetch_add(p, v, __ATOMIC_RELAXED, __HIP_MEMORY_SCOPE_AGENT); }
DEVI unsigned xb_xcc_id() { return (unsigned)__builtin_amdgcn_s_getreg((3 << 11) | 20) & 0xFu; }
#define XB_SPIN(cond, bar) do { unsigned _sp = 0; while (cond) { __builtin_amdgcn_s_sleep(1); \
    if ((++_sp & 255u) == 0u) { if (xb_ld(&(bar)[XB_TMO])) break; if (_sp > XB_SPIN_CAP) { atomicAdd(&(bar)[XB_TMO], 1u); break; } } } } while (0)
struct XcdBarrier { unsigned* bar; unsigned x; volatile LAS unsigned* st; };
DEVI XcdBarrier xcd_barrier_post(unsigned* bar, volatile LAS unsigned* st) {
  XcdBarrier b; b.bar = bar; b.x = xb_xcc_id(); b.st = st;
  if (threadIdx.x == 0) (void)xb_add(&bar[XB_XCNT(b.x)], 1u);
  return b;
}
DEVI void xcd_barrier_complete(unsigned* bar, unsigned x, unsigned& nloc, unsigned& nx) {
  const unsigned G = gridDim.x * gridDim.y * gridDim.z;
  unsigned sum, cnt, mine, sp = 0u;
  for (;;) {
    sum = 0u; cnt = 0u; mine = 0u;
#pragma unroll
    for (unsigned j = 0; j < 16; ++j) { const unsigned c = xb_ld(&bar[XB_XCNT(j)]); sum += c; cnt += (c > 0u) ? 1u : 0u; mine = (j == x) ? c : mine; }
    if (sum == G) break;
    __builtin_amdgcn_s_sleep(1);
    if ((++sp & 255u) == 0u) { if (xb_ld(&bar[XB_TMO])) break; if (sp > XB_SPIN_CAP) { atomicAdd(&bar[XB_TMO], 1u); break; } }
  }
  nloc = mine > 0u ? mine : 1u; nx = cnt > 0u ? cnt : 1u;
}
DEVI void xcd_barrier(const XcdBarrier& b) {
  asm volatile("s_waitcnt vmcnt(0)" ::: "memory");
  __syncthreads();
  if (threadIdx.x == 0) {
    unsigned* bar = b.bar;
    __builtin_amdgcn_s_waitcnt(0);
    unsigned nloc = b.st[0], nx = b.st[1];
    if (nloc == 0u) { xcd_barrier_complete(bar, b.x, nloc, nx); b.st[0] = nloc; b.st[1] = nx; }
    const unsigned old = xb_add(&bar[XB_XSUB(b.x)], 1u);
    const unsigned gen = old / nloc;
    if (old + 1u == (gen + 1u) * nloc) {
      __builtin_amdgcn_fence(__ATOMIC_RELEASE, "agent");
      asm volatile("s_waitcnt vmcnt(0)" ::: "memory");
      const unsigned og = xb_add(&bar[XB_TOP], 1u);
      const unsigned tg = og / nx;
      if (og + 1u == (tg + 1u) * nx) xb_add(&bar[XB_TOPGEN], 1u);
      else XB_SPIN(xb_ld(&bar[XB_TOPGEN]) == tg, bar);
      __builtin_amdgcn_fence(__ATOMIC_ACQUIRE, "agent");
      xb_add(&bar[XB_XGEN(b.x)], 1u);
      asm volatile("s_waitcnt vmcnt(0)" ::: "memory");
    } else {
      XB_SPIN(xb_ld(&bar[XB_XGEN(b.x)]) == gen, bar);
      __builtin_amdgcn_fence(__ATOMIC_ACQUIRE, "agent");
      asm volatile("s_waitcnt vmcnt(0)" ::: "memory");
    }
  }
  __syncthreads();
}

#define VHALF ((int)__builtin_amdgcn_readfirstlane((int)(threadIdx.x >> 8)))
#define TIDX ((int)(threadIdx.x & 255))
#define VBID ((int)(blockIdx.x * 2 + VHALF))
#define NVB ((int)(gridDim.x * 2))
constexpr int HALF_LDS = 80896;

DEVI void phase_mod(const Params& P, unsigned char* smem) {
  const int tid = TIDX;
  float* s = (float*)smem;
  float* red = s + 9 * 1024;
  for (int item = VBID; item < 192; item += NVB) {
    const int l = item / 96, j = item % 96;
    __syncthreads();
    for (int i = tid; i < 9 * 1024; i += 256) {
      int bi = i >> 10, k = i & 1023;
      float v = bi < 8 ? P.c[bi * 1024 + k] : P.c_ctx[k];
      s[i] = v * sigmoidf_(v);
    }
    __syncthreads();
    const int c4 = tid & 15, kg = tid >> 4;
    float acc[9][4];
#pragma unroll
    for (int bi = 0; bi < 9; ++bi) { acc[bi][0] = acc[bi][1] = acc[bi][2] = acc[bi][3] = 0.f; }
    const float* w = P.w_mod + (size_t)l * 1024 * 6144 + j * 64 + c4 * 4;
#pragma unroll 4
    for (int kk = 0; kk < 64; ++kk) {
      const int k = kg * 64 + kk;
      const float4 w4 = *reinterpret_cast<const float4*>(w + (size_t)k * 6144);
#pragma unroll
      for (int bi = 0; bi < 9; ++bi) {
        const float sv = s[bi * 1024 + k];
        acc[bi][0] += sv * w4.x; acc[bi][1] += sv * w4.y; acc[bi][2] += sv * w4.z; acc[bi][3] += sv * w4.w;
      }
    }
#pragma unroll
    for (int bi = 0; bi < 9; ++bi)
#pragma unroll
      for (int e = 0; e < 4; ++e) red[(kg * 9 + bi) * 64 + c4 * 4 + e] = acc[bi][e];
    __syncthreads();
    for (int o = tid; o < 576; o += 256) {
      const int bi = o >> 6, cc = o & 63;
      float sum = 0.f;
#pragma unroll
      for (int g = 0; g < 16; ++g) sum += red[(g * 9 + bi) * 64 + cc];
      P.MOD[(size_t)(l * 9 + bi) * 6144 + j * 64 + cc] = sum + P.b_mod[l * 6144 + j * 64 + cc];
    }
  }
}

DEVI void conv_T_tile(const float* __restrict__ src, int N, bf16* __restrict__ dst, int Kd, int k0, int n0,
                      const float* __restrict__ kscale, float* tile) {
  const int tid = TIDX;
  __syncthreads();
  for (int e = tid; e < 4096; e += 256) {
    const int i = e >> 6, j = e & 63, n = n0 + j;
    float v = (n < N) ? src[(size_t)(k0 + i) * N + n] : 0.f;
    if (kscale) v *= kscale[k0 + i];
    tile[i * 65 + j] = v;
  }
  __syncthreads();
  for (int e = tid; e < 2048; e += 256) {
    const int j = e >> 5, i2 = (e & 31) * 2;
    const unsigned pk = pack2(tile[i2 * 65 + j], tile[(i2 + 1) * 65 + j]);
    *reinterpret_cast<unsigned*>(&dst[(size_t)(n0 + j) * Kd + k0 + i2]) = pk;
  }
}

DEVI void conv_straight(const float* __restrict__ src, bf16* __restrict__ dst, size_t n8) {
  const size_t stride = (size_t)NVB * 256;
  for (size_t i = (size_t)VBID * 256 + TIDX; i < n8; i += stride) {
    const float4 a = reinterpret_cast<const float4*>(src)[2 * i];
    const float4 b = reinterpret_cast<const float4*>(src)[2 * i + 1];
    uint4 o; o.x = pack2(a.x, a.y); o.y = pack2(a.z, a.w); o.z = pack2(b.x, b.y); o.w = pack2(b.z, b.w);
    reinterpret_cast<uint4*>(dst)[i] = o;
  }
}

DEVI void convert_rows_fp6(const Params& P, int L, int i0, int i1) {
  const int lane = threadIdx.x & 63, half = lane >> 5, l32 = lane & 31;
  const int wv = threadIdx.x >> 6;
  for (int ib = i0 + wv * 2; ib < i1; ib += 16) {
    int i = ib + half; const bool live = i < i1; if (!live) i = i1 - 1;
    const int table = i >> 14, lr = L * 16384 + (i & 16383);
    const float* src = (table ? P.p_v : P.p_u) + (size_t)lr * 1024 + l32 * 32;
    float4 a[8];
    float m = 0.f;
#pragma unroll
    for (int q = 0; q < 8; ++q) {
      a[q] = *reinterpret_cast<const float4*>(src + q * 4);
      m = fmaxf(m, fmaxf(fmaxf(fabsf(a[q].x), fabsf(a[q].y)), fmaxf(fabsf(a[q].z), fabsf(a[q].w))));
    }
    const unsigned sb = (__float_as_uint(fmaxf(m, 1e-30f) * (1.f / 6.f)) + 0xffffu) >> 16;
    const float inv = 1.f / __uint_as_float(sb << 16);
    unsigned pk[4];
#pragma unroll
    for (int w = 0; w < 4; ++w) {
      unsigned word = 0u;
#pragma unroll
      for (int e = 0; e < 8; ++e) {
        const int idx = w * 8 + e;
        const float4 q4 = a[idx >> 2];
        const float xv = ((idx & 3) == 0 ? q4.x : (idx & 3) == 1 ? q4.y : (idx & 3) == 2 ? q4.z : q4.w) * inv;
        const float av = fabsf(xv);
        unsigned ci = (av > 0.25f) + (av > 0.75f) + (av > 1.25f) + (av > 1.75f) + (av > 2.5f) + (av > 3.5f) + (av > 5.f);
        ci |= (xv < 0.f) ? 8u : 0u;
        word |= ci << (4 * e);
      }
      pk[w] = word;
    }
    unsigned char* rowp = (table ? P.PV8 : P.PU8) + (size_t)lr * 576;
    if (live) {
      *reinterpret_cast<uint4*>(rowp + l32 * 16) = make_uint4(pk[0], pk[1], pk[2], pk[3]);
      *reinterpret_cast<unsigned short*>(rowp + 512 + l32 * 2) = (unsigned short)sb;
    }
  }
}

DEVI void phase_prologue(const Params& P, unsigned char* smem) {
  phase_mod(P, smem);
  float* tile = (float*)smem;
  for (int it = VBID; it < 2 * 1424; it += NVB) {
    const int l = it / 1424; int r = it % 1424;
    if (r < 576) { conv_T_tile(P.w_in + (size_t)l * 1024 * DIN, DIN, P.WinT + (size_t)l * DINP * 1024, 1024, (r % 16) * 64, (r / 16) * 64, nullptr, tile); continue; }
    r -= 576;
    if (r < 256) { conv_T_tile(P.w_out + (size_t)l * 1024 * 1024, 1024, P.WoutT + (size_t)l * 1024 * 1024, 1024, (r % 16) * 64, (r / 16) * 64, nullptr, tile); continue; }
    r -= 256;
    if (r < 512) { conv_T_tile(P.p_w_q + (size_t)l * 1024 * 2048, 2048, P.WpqT + (size_t)l * 2048 * 1024, 1024, (r % 16) * 64, (r / 16) * 64, nullptr, tile); continue; }
    r -= 512;
    if (r < 48) { conv_T_tile(P.b_w_uq + (size_t)l * 256 * 768, 768, P.WCOMB + (size_t)l * 1792 * 256, 256, (r % 4) * 64, (r / 4) * 64, P.b_q_norm_w + l * 256, tile); continue; }
    r -= 48;
    conv_T_tile(P.b_w_ukv + (size_t)l * 128 * 1024, 1024, P.WCOMB + (size_t)l * 1792 * 256 + 768 * 256, 256, (r % 2) * 64, (r / 2) * 64, P.b_kv_norm_w + l * 128, tile);
  }
  for (int i = VBID * 256 + TIDX; i < 2 * 1024 * 16; i += NVB * 256) {
    const int l2 = i >> 14, rr = (i >> 4) & 1023, cc = i & 15;
    *reinterpret_cast<uint4*>(P.WCOMB + (size_t)l2 * 1792 * 256 + (size_t)(768 + rr) * 256 + 128 + cc * 8) = make_uint4(0u, 0u, 0u, 0u);
  }
  conv_straight(P.p_sub_keys, P.SK, (size_t)2 * 16 * 128 * 128 / 8);
  conv_straight(P.a_w_s, P.AWS, (size_t)2 * 4 * 128 * 128 / 8);
  for (int i = VBID * 256 + TIDX; i < 2048 * 16; i += NVB * 256) {
    const int t = i >> 4, a = (i >> 3) & 1, f = i & 7;
    const float inv = powf(10000.f, -(float)f / 8.f);
    const float pos = a ? (float)(t & 63) : (float)(t >> 6);
    const float ang = pos * inv;
    P.ROPE[t * 32 + a * 8 + f] = cosf(ang);
    P.ROPE[t * 32 + 16 + a * 8 + f] = sinf(ang);
  }
}

DEVI void phase_norm(const Params& P, int l, int which, int nrows) {
  const int lane = TIDX & 63;
  const int gw = VBID * 4 + (TIDX >> 6), nw = NVB * 4;
  const float* lnw = (which == 0 ? P.ln1_w : P.ln2_w) + l * 1024;
  for (int r = gw; r < nrows; r += nw) {
    const float* mod = P.MOD + (size_t)(l * 9 + batch_of_row(r)) * 6144 + which * 3072;
    float4 v[4];
    float ss = 0.f;
    if (which == 0 && l == 0) {
      const float* src = r < NL ? P.x + (size_t)r * 1024 : P.ctx + (size_t)(r - NL) * 1024;
#pragma unroll
      for (int i = 0; i < 4; ++i) v[i] = *reinterpret_cast<const float4*>(src + i * 256 + lane * 4);
    } else {
      const bf16* src = P.X + (size_t)r * 1024;
#pragma unroll
      for (int i = 0; i < 4; ++i) {
        const uint2 u = *reinterpret_cast<const uint2*>(src + i * 256 + lane * 4);
        v[i] = make_float4(lo2f(u.x), hi2f(u.x), lo2f(u.y), hi2f(u.y));
      }
    }
#pragma unroll
    for (int i = 0; i < 4; ++i) ss += v[i].x * v[i].x + v[i].y * v[i].y + v[i].z * v[i].z + v[i].w * v[i].w;
    ss = wave_sum(ss);
    const float rr = rsqrtf(ss * (1.f / 1024.f) + EPS);
#pragma unroll
    for (int i = 0; i < 4; ++i) {
      const int d = i * 256 + lane * 4;
      const float4 w = *reinterpret_cast<const float4*>(lnw + d);
      const float4 sh = *reinterpret_cast<const float4*>(mod + d);
      const float4 sc = *reinterpret_cast<const float4*>(mod + 1024 + d);
      const float o0 = v[i].x * rr * w.x * (1.f + sc.x) + sh.x;
      const float o1 = v[i].y * rr * w.y * (1.f + sc.y) + sh.y;
      const float o2 = v[i].z * rr * w.z * (1.f + sc.z) + sh.z;
      const float o3 = v[i].w * rr * w.w * (1.f + sc.w) + sh.w;
      uint2 o; o.x = pack2(o0, o1); o.y = pack2(o2, o3);
      *reinterpret_cast<uint2*>(P.H + (size_t)r * 1024 + d) = o;
    }
  }
}

template <int BM, int BN, int BK, int WM, int WN>
struct Gemm {
  static constexpr int LDK = BK + 8;
  static constexpr int TM = BM / WM / 32, TN = BN / WN / 32;
  static constexpr int CPR = BK / 8;
  static constexpr int NA = BM * CPR / 256, NB = BN * CPR / 256;
  static constexpr int A_BYTES = BM * LDK * 2, B_BYTES = BN * LDK * 2;
  static constexpr int STAGE_BYTES = A_BYTES + B_BYTES;
  static constexpr int SMEM = 2 * STAGE_BYTES;

  static DEVI void run(const bf16* __restrict__ A, int lda, const bf16* __restrict__ BT, int ldb, int K,
                       unsigned char* smem, f32x16 (&acc)[TM][TN]) {
    const int tid = TIDX, lane = tid & 63, wave = tid >> 6;
    const int wm = wave / WN, wn = wave % WN;
    const int l31 = lane & 31, hh = lane >> 5;
#pragma unroll
    for (int i = 0; i < TM; ++i)
#pragma unroll
      for (int j = 0; j < TN; ++j) acc[i][j] = zero16();
    uint4 ra[NA], rb[NB];
    const int nk = K / BK;
    auto gload = [&](int kt) {
#pragma unroll
      for (int i = 0; i < NA; ++i) { const int ch = tid + i * 256, row = ch / CPR, cc = ch % CPR;
        ra[i] = *reinterpret_cast<const uint4*>(A + (size_t)row * lda + kt * BK + cc * 8); }
#pragma unroll
      for (int i = 0; i < NB; ++i) { const int ch = tid + i * 256, row = ch / CPR, cc = ch % CPR;
        rb[i] = *reinterpret_cast<const uint4*>(BT + (size_t)row * ldb + kt * BK + cc * 8); }
    };
    auto swrite = [&](int buf) {
      bf16* sA = reinterpret_cast<bf16*>(smem + buf * STAGE_BYTES);
      bf16* sB = reinterpret_cast<bf16*>(smem + buf * STAGE_BYTES + A_BYTES);
#pragma unroll
      for (int i = 0; i < NA; ++i) { const int ch = tid + i * 256, row = ch / CPR, cc = ch % CPR;
        *reinterpret_cast<uint4*>(sA + row * LDK + cc * 8) = ra[i]; }
#pragma unroll
      for (int i = 0; i < NB; ++i) { const int ch = tid + i * 256, row = ch / CPR, cc = ch % CPR;
        *reinterpret_cast<uint4*>(sB + row * LDK + cc * 8) = rb[i]; }
    };
    __syncthreads();
    gload(0);
    swrite(0);
    __syncthreads();
    for (int kt = 0; kt < nk; ++kt) {
      const int cur = kt & 1;
      if (kt + 1 < nk) gload(kt + 1);
      const bf16* sA = reinterpret_cast<const bf16*>(smem + cur * STAGE_BYTES);
      const bf16* sB = reinterpret_cast<const bf16*>(smem + cur * STAGE_BYTES + A_BYTES);
#pragma unroll
      for (int ks = 0; ks < BK / 16; ++ks) {
        bf16x8 af[TM], bfr[TN];
#pragma unroll
        for (int i = 0; i < TM; ++i) af[i] = ldfrag(sA + (wm * (BM / WM) + i * 32 + l31) * LDK + ks * 16 + hh * 8);
#pragma unroll
        for (int j = 0; j < TN; ++j) bfr[j] = ldfrag(sB + (wn * (BN / WN) + j * 32 + l31) * LDK + ks * 16 + hh * 8);
#pragma unroll
        for (int i = 0; i < TM; ++i)
#pragma unroll
          for (int j = 0; j < TN; ++j) acc[i][j] = mfma32(af[i], bfr[j], acc[i][j]);
      }
      if (kt + 1 < nk) swrite(cur ^ 1);
      __syncthreads();
    }
  }
};

DEVI void phase_gemm1(const Params& P, int l, unsigned char* smem) {
  using G = Gemm<128, 128, 64, 2, 2>;
  const int lane = TIDX & 63, wave = TIDX >> 6, wm = wave >> 1, wn = wave & 1, l31 = lane & 31, hh = lane >> 5;
  const bf16* W = P.WinT + (size_t)l * DINP * 1024;
  for (int t = VBID; t < 144 * 18; t += NVB) {
    const int mt = t / 18, nt = t % 18;
    f32x16 acc[2][2];
    G::run(P.H + (size_t)mt * 128 * 1024, 1024, W + (size_t)nt * 128 * 1024, 1024, 1024, smem, acc);
#pragma unroll
    for (int i = 0; i < 2; ++i)
#pragma unroll
      for (int j = 0; j < 2; ++j) {
        const int col = nt * 128 + wn * 64 + j * 32 + l31;
        if (col < DIN) {
#pragma unroll
          for (int r = 0; r < 16; ++r) {
            const int row = mt * 128 + wm * 64 + i * 32 + drow(r, hh);
            P.Z[(size_t)row * DIN + col] = f2bf(acc[i][j][r]);
          }
        }
      }
  }
}

DEVI void phase_gemm2(const Params& P, int l, unsigned char* smem) {
  using G = Gemm<128, 128, 64, 2, 2>;
  const int lane = TIDX & 63, wave = TIDX >> 6, wm = wave >> 1, wn = wave & 1, l31 = lane & 31, hh = lane >> 5;
  const bf16* W = P.WoutT + (size_t)l * 1024 * 1024;
  const int mtiles = (l == 1) ? 128 : 144;
  for (int t = VBID; t < mtiles * 8; t += NVB) {
    const int mt = t / 8, nt = t % 8;
    f32x16 acc[2][2];
    G::run(P.H + (size_t)mt * 128 * 1024, 1024, W + (size_t)nt * 128 * 1024, 1024, 1024, smem, acc);
    const int bi = batch_of_row(mt * 128);
    const float* gate = P.MOD + (size_t)(l * 9 + bi) * 6144 + 2048;
#pragma unroll
    for (int i = 0; i < 2; ++i)
#pragma unroll
      for (int j = 0; j < 2; ++j) {
        const int col = nt * 128 + wn * 64 + j * 32 + l31;
        const float g = gate[col];
#pragma unroll
        for (int r = 0; r < 16; ++r) {
          const int row = mt * 128 + wm * 64 + i * 32 + drow(r, hh);
          float res;
          if (l == 0) res = row < NL ? P.x[(size_t)row * 1024 + col] : P.ctx[(size_t)(row - NL) * 1024 + col];
          else res = bf2f(P.X[(size_t)row * 1024 + col]);
          P.X[(size_t)row * 1024 + col] = f2bf(res + g * acc[i][j][r]);
        }
      }
  }
}

DEVI void phase_mixA(const Params& P, int l, unsigned char* smem) {
  const int tid = TIDX, lane = tid & 63, wave = tid >> 6, l31 = lane & 31, hh = lane >> 5;
  bf16* VNT = reinterpret_cast<bf16*>(smem);
  constexpr int LDV = 136;
  const int nseg = (l == 1) ? 16 : 18;
  const int seg0 = (l == 1) ? 2 : 0;
  for (int it = VBID; it < 8 * nseg * 4; it += NVB) {
    const int a = it & 3; const int sj = (it >> 2) % nseg + seg0; const int b = (it >> 2) / nseg;
    const int p0 = sj * 128;
    __syncthreads();
    {
      const int q = tid >> 1, half = tid & 1;
      const int row = row_of(b, p0 + q);
      const bf16* src = P.Z + (size_t)row * DIN + ZC_AV + a * 64 + half * 32;
      float v[32];
      float ss = 0.f;
#pragma unroll
      for (int i = 0; i < 4; ++i) {
        const uint4 u = *reinterpret_cast<const uint4*>(src + i * 8);
        v[i * 8 + 0] = lo2f(u.x); v[i * 8 + 1] = hi2f(u.x); v[i * 8 + 2] = lo2f(u.y); v[i * 8 + 3] = hi2f(u.y);
        v[i * 8 + 4] = lo2f(u.z); v[i * 8 + 5] = hi2f(u.z); v[i * 8 + 6] = lo2f(u.w); v[i * 8 + 7] = hi2f(u.w);
      }
#pragma unroll
      for (int i = 0; i < 32; ++i) ss += v[i] * v[i];
      ss += __shfl_xor(ss, 1);
      const float rr = rsqrtf(ss * (1.f / 64.f) + EPS);
      const float* nw = P.a_norm_w + l * 256 + a * 64 + half * 32;
#pragma unroll
      for (int i = 0; i < 32; ++i) VNT[(half * 32 + i) * LDV + q] = f2bf(v[i] * rr * nw[i]);
    }
    __syncthreads();
    f32x16 acc[2]; acc[0] = zero16(); acc[1] = zero16();
    const bf16* Aw = P.AWS + (size_t)(l * 4 + a) * 128 * 128 + (size_t)(wave * 32 + l31) * 128;
#pragma unroll
    for (int ks = 0; ks < 8; ++ks) {
      const bf16x8 af = ldfrag(Aw + ks * 16 + hh * 8);
#pragma unroll
      for (int j = 0; j < 2; ++j) {
        const bf16x8 bfr = ldfrag(VNT + (j * 32 + l31) * LDV + ks * 16 + hh * 8);
        acc[j] = mfma32(af, bfr, acc[j]);
      }
    }
    const float* bs = P.a_b_s + (l * 4 + a) * 128;
#pragma unroll
    for (int j = 0; j < 2; ++j)
#pragma unroll
      for (int r = 0; r < 16; ++r) {
        const int p = wave * 32 + drow(r, hh);
        const int row = row_of(b, p0 + p);
        const int col = a * 64 + j * 32 + l31;
        const float u = bf2f(P.Z[(size_t)row * DIN + ZC_AU + col]);
        P.H[(size_t)row * 1024 + col] = f2bf(u * (acc[j][r] + bs[p]));
      }
  }
}

DEVI void mla_norm_rope_store(const Params& P, const float* T, const float* nw, bool rope, float oscale,
                              bf16* dstbase  , int pos0, int tlat0) {
  const int tid = TIDX, tok = tid >> 1, half = tid & 1;
  float v[48];
  float ss = 0.f;
#pragma unroll
  for (int i = 0; i < 48; ++i) { v[i] = T[tok * 97 + half * 48 + i]; ss += v[i] * v[i]; }
  ss += __shfl_xor(ss, 1);
  const float rr = rsqrtf(ss * (1.f / 96.f) + EPS);
#pragma unroll
  for (int i = 0; i < 48; ++i) v[i] = v[i] * rr * nw[half * 48 + i];
  if (rope && half == 1) {
    const float* cs = P.ROPE + (size_t)(tlat0 + tok) * 32;
#pragma unroll
    for (int a = 0; a < 2; ++a)
#pragma unroll
      for (int f = 0; f < 8; ++f) {
        const float x1 = v[16 + a * 16 + f], x2 = v[16 + a * 16 + 8 + f];
        const float c = cs[a * 8 + f], s = cs[16 + a * 8 + f];
        v[16 + a * 16 + f] = x1 * c - x2 * s;
        v[16 + a * 16 + 8 + f] = x2 * c + x1 * s;
      }
  }
  bf16* dst = dstbase + (size_t)(pos0 + tok) * 96 + half * 48;
#pragma unroll
  for (int i = 0; i < 6; ++i) {
    uint4 o;
    o.x = pack2(v[i * 8 + 0] * oscale, v[i * 8 + 1] * oscale); o.y = pack2(v[i * 8 + 2] * oscale, v[i * 8 + 3] * oscale);
    o.z = pack2(v[i * 8 + 4] * oscale, v[i * 8 + 5] * oscale); o.w = pack2(v[i * 8 + 6] * oscale, v[i * 8 + 7] * oscale);
    *reinterpret_cast<uint4*>(dst + i * 8) = o;
  }
}

DEVI void phase_mla_proj(const Params& P, int l, unsigned char* smem) {
  const int tid = TIDX;
  float* T = reinterpret_cast<float*>(smem);
  bf16* TV = reinterpret_cast<bf16*>(smem + 128 * 97 * 4);
  const float qscale = 0.10206207261596577f * 1.4426950408889634f;
  const int tok = tid >> 1, half = tid & 1;
  for (int it = VBID; it < 144 * 8; it += NVB) {
    const int h = it & 7;
    const int m0 = (it >> 3) * 128;
    const bool lat = m0 < NL;
    const int b = lat ? (m0 >> 11) : ((m0 - NL) >> 8);
    const int pos0 = lat ? 256 + (m0 & 2047) : ((m0 - NL) & 255);
    const int tlat0 = lat ? (m0 & 2047) : 0;
    const bool doq = lat || (l == 0);
    const bf16* zr = P.Z + (size_t)(m0 + tok) * DIN;
    const bf16* rr = P.RAW + (size_t)(m0 + tok) * 1792;
    __syncthreads();
    float rskv, rsq = 0.f;
    {
      float ss = 0.f;
#pragma unroll
      for (int i = 0; i < 8; ++i) {
        const uint4 u = *reinterpret_cast<const uint4*>(zr + ZC_BKV + half * 64 + i * 8);
        ss += lo2f(u.x) * lo2f(u.x) + hi2f(u.x) * hi2f(u.x) + lo2f(u.y) * lo2f(u.y) + hi2f(u.y) * hi2f(u.y)
            + lo2f(u.z) * lo2f(u.z) + hi2f(u.z) * hi2f(u.z) + lo2f(u.w) * lo2f(u.w) + hi2f(u.w) * hi2f(u.w);
      }
      ss += __shfl_xor(ss, 1);
      rskv = rsqrtf(ss * (1.f / 128.f) + EPS);
      if (doq) {
        float sq = 0.f;
#pragma unroll
        for (int i = 0; i < 16; ++i) {
          const uint4 u = *reinterpret_cast<const uint4*>(zr + ZC_BQ + half * 128 + i * 8);
          sq += lo2f(u.x) * lo2f(u.x) + hi2f(u.x) * hi2f(u.x) + lo2f(u.y) * lo2f(u.y) + hi2f(u.y) * hi2f(u.y)
              + lo2f(u.z) * lo2f(u.z) + hi2f(u.z) * hi2f(u.z) + lo2f(u.w) * lo2f(u.w) + hi2f(u.w) * hi2f(u.w);
        }
        sq += __shfl_xor(sq, 1);
        rsq = rsqrtf(sq * (1.f / 256.f) + EPS);
      }
    }
    {
      const bf16* kn = rr + 768 + h * 128 + half * 32;
      const bf16* vv = rr + 768 + h * 128 + 64 + half * 32;
#pragma unroll
      for (int i = 0; i < 4; ++i) {
        const uint4 u = *reinterpret_cast<const uint4*>(kn + i * 8);
        float* tp = T + tok * 97 + half * 32 + i * 8;
        tp[0] = lo2f(u.x) * rskv; tp[1] = hi2f(u.x) * rskv; tp[2] = lo2f(u.y) * rskv; tp[3] = hi2f(u.y) * rskv;
        tp[4] = lo2f(u.z) * rskv; tp[5] = hi2f(u.z) * rskv; tp[6] = lo2f(u.w) * rskv; tp[7] = hi2f(u.w) * rskv;
        const uint4 w = *reinterpret_cast<const uint4*>(vv + i * 8);
        bf16* vp = TV + (half * 32 + i * 8) * 136 + tok;
        vp[0 * 136] = f2bf(lo2f(w.x) * rskv); vp[1 * 136] = f2bf(hi2f(w.x) * rskv); vp[2 * 136] = f2bf(lo2f(w.y) * rskv); vp[3 * 136] = f2bf(hi2f(w.y) * rskv);
        vp[4 * 136] = f2bf(lo2f(w.z) * rskv); vp[5 * 136] = f2bf(hi2f(w.z) * rskv); vp[6 * 136] = f2bf(lo2f(w.w) * rskv); vp[7 * 136] = f2bf(hi2f(w.w) * rskv);
      }
#pragma unroll
      for (int i = 0; i < 2; ++i) {
        const uint4 u = *reinterpret_cast<const uint4*>(zr + ZC_BKR + half * 16 + i * 8);
        float* tp = T + tok * 97 + 64 + half * 16 + i * 8;
        tp[0] = lo2f(u.x); tp[1] = hi2f(u.x); tp[2] = lo2f(u.y); tp[3] = hi2f(u.y);
        tp[4] = lo2f(u.z); tp[5] = hi2f(u.z); tp[6] = lo2f(u.w); tp[7] = hi2f(u.w);
      }
    }
    __syncthreads();
    mla_norm_rope_store(P, T, P.b_kh_w + l * 96, lat, 1.f, P.K + (size_t)(b * 8 + h) * SEQP * 96, pos0, tlat0);
    {
      const int d = tid >> 2, qtr = tid & 3;
      bf16* dst = P.VT + ((size_t)(b * 8 + h) * 64 + d) * SEQP + pos0 + qtr * 32;
      const bf16* src = TV + d * 136 + qtr * 32;
#pragma unroll
      for (int i = 0; i < 4; ++i) *reinterpret_cast<uint4*>(dst + i * 8) = *reinterpret_cast<const uint4*>(src + i * 8);
    }
    if (doq) {
      __syncthreads();
      const bf16* qq = rr + h * 96 + half * 48;
#pragma unroll
      for (int i = 0; i < 6; ++i) {
        const uint4 u = *reinterpret_cast<const uint4*>(qq + i * 8);
        float* tp = T + tok * 97 + half * 48 + i * 8;
        tp[0] = lo2f(u.x) * rsq; tp[1] = hi2f(u.x) * rsq; tp[2] = lo2f(u.y) * rsq; tp[3] = hi2f(u.y) * rsq;
        tp[4] = lo2f(u.z) * rsq; tp[5] = hi2f(u.z) * rsq; tp[6] = lo2f(u.w) * rsq; tp[7] = hi2f(u.w) * rsq;
      }
      __syncthreads();
      mla_norm_rope_store(P, T, P.b_qh_w + l * 96, lat, qscale, P.Q + (size_t)(b * 8 + h) * SEQP * 96, pos0, tlat0);
    }
  }
}

DEVI void hgrn_load(const Params& P, int l, int b, int hd, int c, float* BF, float* RB, float* SEG,
                    float (&q)[16], float (&kf)[16], float (&kb)[16], float (&v)[16], bool need_kv) {
  const int tid = TIDX, t = tid >> 2, k0 = (tid & 3) * 16;
  const int row = row_of(b, c * 64 + t);
  const bf16* z = P.Z + (size_t)row * DIN + hd * 64 + k0;
  float zf[16], zb[16];
#pragma unroll
  for (int i = 0; i < 2; ++i) {
    const uint4 uq = *reinterpret_cast<const uint4*>(z + ZC_CQ + i * 8);
    const uint4 uf = *reinterpret_cast<const uint4*>(z + ZC_CFF + i * 8);
    const uint4 ub = *reinterpret_cast<const uint4*>(z + ZC_CFB + i * 8);
    q[i * 8 + 0] = lo2f(uq.x); q[i * 8 + 1] = hi2f(uq.x); q[i * 8 + 2] = lo2f(uq.y); q[i * 8 + 3] = hi2f(uq.y);
    q[i * 8 + 4] = lo2f(uq.z); q[i * 8 + 5] = hi2f(uq.z); q[i * 8 + 6] = lo2f(uq.w); q[i * 8 + 7] = hi2f(uq.w);
    zf[i * 8 + 0] = lo2f(uf.x); zf[i * 8 + 1] = hi2f(uf.x); zf[i * 8 + 2] = lo2f(uf.y); zf[i * 8 + 3] = hi2f(uf.y);
    zf[i * 8 + 4] = lo2f(uf.z); zf[i * 8 + 5] = hi2f(uf.z); zf[i * 8 + 6] = lo2f(uf.w); zf[i * 8 + 7] = hi2f(uf.w);
    zb[i * 8 + 0] = lo2f(ub.x); zb[i * 8 + 1] = hi2f(ub.x); zb[i * 8 + 2] = lo2f(ub.y); zb[i * 8 + 3] = hi2f(ub.y);
    zb[i * 8 + 4] = lo2f(ub.z); zb[i * 8 + 5] = hi2f(ub.z); zb[i * 8 + 6] = lo2f(ub.w); zb[i * 8 + 7] = hi2f(ub.w);
    if (need_kv) {
      const uint4 uv = *reinterpret_cast<const uint4*>(z + ZC_CI + i * 8);
      v[i * 8 + 0] = lo2f(uv.x); v[i * 8 + 1] = hi2f(uv.x); v[i * 8 + 2] = lo2f(uv.y); v[i * 8 + 3] = hi2f(uv.y);
      v[i * 8 + 4] = lo2f(uv.z); v[i * 8 + 5] = hi2f(uv.z); v[i * 8 + 6] = lo2f(uv.w); v[i * 8 + 7] = hi2f(uv.w);
    }
  }
#pragma unroll
  for (int i = 0; i < 16; ++i) {
    q[i] *= 0.125f;
    float lbf = 0.f;
    if (l == 1) { const int ch = hd * 64 + k0 + i; lbf = sigmoidf_(P.c_lb[512 + ch] - P.c_lb[ch]); }
    const float zz = zf[i];
    const float e = __expf(-fabsf(zz));
    const float sp = __builtin_amdgcn_rcpf(1.f + e);
    const float sig = zz >= 0.f ? sp : e * sp;
    const float nsig = zz >= 0.f ? e * sp : sp;
    const float lf = (l == 0) ? (fminf(zz, 0.f) - __logf(1.f + e)) : __logf(lbf + (1.f - lbf) * sig);
    kf[i] = (1.f - lbf) * nsig;
    BF[t * 65 + k0 + i] = lf;
  }
  __builtin_amdgcn_sched_barrier(0);
#pragma unroll
  for (int i = 0; i < 16; ++i) {
    float lbb = 0.f;
    if (l == 1) { const int ch = hd * 64 + k0 + i; lbb = sigmoidf_(P.c_lb[512 + 256 + ch] - P.c_lb[256 + ch]); }
    const float zz = zb[i];
    const float e = __expf(-fabsf(zz));
    const float sp = __builtin_amdgcn_rcpf(1.f + e);
    const float sig = zz >= 0.f ? sp : e * sp;
    const float nsig = zz >= 0.f ? e * sp : sp;
    const float lf = (l == 0) ? (fminf(zz, 0.f) - __logf(1.f + e)) : __logf(lbb + (1.f - lbb) * sig);
    kb[i] = (1.f - lbb) * nsig;
    RB[t * 65 + k0 + i] = lf;
  }
  __syncthreads();
  {
    const int k = tid & 63, seg = tid >> 6;
    float sf = 0.f, sr = 0.f;
#pragma unroll
    for (int j = 0; j < 16; ++j) { sf += BF[(seg * 16 + j) * 65 + k]; BF[(seg * 16 + j) * 65 + k] = sf; }
#pragma unroll
    for (int j = 15; j >= 0; --j) { sr += RB[(seg * 16 + j) * 65 + k]; RB[(seg * 16 + j) * 65 + k] = sr; }
    SEG[seg * 64 + k] = sf; SEG[256 + seg * 64 + k] = sr;
    __syncthreads();
    float offf = 0.f, offb = 0.f;
#pragma unroll
    for (int s2 = 0; s2 < 4; ++s2) {
      offf += (s2 < seg) ? SEG[s2 * 64 + k] : 0.f;
      offb += (s2 > seg) ? SEG[256 + s2 * 64 + k] : 0.f;
    }
#pragma unroll
    for (int j = 0; j < 16; ++j) { BF[(seg * 16 + j) * 65 + k] += offf; RB[(seg * 16 + j) * 65 + k] += offb; }
  }
  __syncthreads();
}

DEVI f32x16 lds_mm(const bf16* A, const bf16* BT, int tm, int tn, int l31, int hh) {
  f32x16 acc = zero16();
#pragma unroll
  for (int ks = 0; ks < 4; ++ks) {
    const bf16x8 a = ldfrag(A + (tm * 32 + l31) * 72 + ks * 16 + hh * 8);
    const bf16x8 b = ldfrag(BT + (tn * 32 + l31) * 72 + ks * 16 + hh * 8);
    acc = mfma32(a, b, acc);
  }
  return acc;
}

DEVI void phase_hgrn_local(const Params& P, int l, unsigned char* smem) {
  const int tid = TIDX, lane = tid & 63, wave = tid >> 6, l31 = lane & 31, hh = lane >> 5;
  const int tm = wave >> 1, tn = wave & 1;
  float* BF = reinterpret_cast<float*>(smem);
  float* RB = BF + 64 * 65;
  bf16* QF = reinterpret_cast<bf16*>(smem + 33280);
  bf16* KF = QF + 64 * 72;
  bf16* QB = KF + 64 * 72;
  bf16* KB = QB + 64 * 72;
  bf16* VTt = KB + 64 * 72;
  bf16* KHF = reinterpret_cast<bf16*>(smem);
  bf16* KHB = KHF + 64 * 72;
  bf16* ATT = KHB + 64 * 72;
  for (int it = VBID; it < 8 * 4 * 36; it += NVB) {
    const int c = it % 36, hd = (it / 36) & 3, b = it / 144;
    float q[16], kf[16], kb[16], v[16];
    __syncthreads();
    hgrn_load(P, l, b, hd, c, BF, RB, reinterpret_cast<float*>(smem + 33280), q, kf, kb, v, true);
    const int t = tid >> 2, k0 = (tid & 3) * 16;
#pragma unroll
    for (int i = 0; i < 16; ++i) VTt[(k0 + i) * 72 + t] = f2bf(v[i]);
    float bfv[16], rbv[16];
#pragma unroll
    for (int i = 0; i < 16; ++i) { bfv[i] = BF[t * 65 + k0 + i]; rbv[i] = RB[t * 65 + k0 + i]; }
    {
      const size_t go = (size_t)row_of(b, c * 64 + t) * 256 + hd * 64 + k0;
#pragma unroll
      for (int hq = 0; hq < 2; ++hq) {
        unsigned pf[4], pb[4];
#pragma unroll
        for (int i = 0; i < 8; i += 2) {
          pf[i >> 1] = pack2(q[hq * 8 + i] * __expf(bfv[hq * 8 + i]), q[hq * 8 + i + 1] * __expf(bfv[hq * 8 + i + 1]));
          pb[i >> 1] = pack2(q[hq * 8 + i] * __expf(rbv[hq * 8 + i]), q[hq * 8 + i + 1] * __expf(rbv[hq * 8 + i + 1]));
        }
        *reinterpret_cast<uint4*>(P.GQF + go + hq * 8) = make_uint4(pf[0], pf[1], pf[2], pf[3]);
        *reinterpret_cast<uint4*>(P.GQB + go + hq * 8) = make_uint4(pb[0], pb[1], pb[2], pb[3]);
      }
    }
    if (t == 0) {
      float* dec = P.DEC + ((size_t)((b * 4 + hd) * 2) * 36 + c) * 64 + k0;
#pragma unroll
      for (int i = 0; i < 16; ++i) { dec[i] = __expf(BF[63 * 65 + k0 + i]); dec[36 * 64 + i] = __expf(RB[k0 + i]); }
    }
#pragma unroll
    for (int i = 0; i < 16; i += 2) {
      const int k = k0 + i;
      const float mF0 = BF[32 * 65 + k], mF1 = BF[32 * 65 + k + 1], mB0 = RB[32 * 65 + k], mB1 = RB[32 * 65 + k + 1];
      *reinterpret_cast<unsigned*>(&QF[t * 72 + k]) = pack2(q[i] * __expf(fminf(bfv[i] - mF0, 80.f)), q[i + 1] * __expf(fminf(bfv[i + 1] - mF1, 80.f)));
      *reinterpret_cast<unsigned*>(&KF[t * 72 + k]) = pack2(kf[i] * __expf(fminf(mF0 - bfv[i], 80.f)), kf[i + 1] * __expf(fminf(mF1 - bfv[i + 1], 80.f)));
      *reinterpret_cast<unsigned*>(&QB[t * 72 + k]) = pack2(q[i] * __expf(fminf(rbv[i] - mB0, 80.f)), q[i + 1] * __expf(fminf(rbv[i + 1] - mB1, 80.f)));
      *reinterpret_cast<unsigned*>(&KB[t * 72 + k]) = pack2(kb[i] * __expf(fminf(mB0 - rbv[i], 80.f)), kb[i + 1] * __expf(fminf(mB1 - rbv[i + 1], 80.f)));
    }
#pragma unroll
    for (int i = 0; i < 16; ++i) {
      kf[i] = kf[i] * __expf(BF[63 * 65 + k0 + i] - bfv[i]);
      kb[i] = kb[i] * __expf(RB[k0 + i] - rbv[i]);
    }
    __syncthreads();
#pragma unroll
    for (int i = 0; i < 16; ++i) {
      KHF[(k0 + i) * 72 + t] = f2bf(kf[i]);
      KHB[(k0 + i) * 72 + t] = f2bf(kb[i]);
    }
    __syncthreads();
    {
      const f32x16 af = lds_mm(QF, KF, tm, tn, l31, hh);
      const f32x16 ab = lds_mm(QB, KB, tm, tn, l31, hh);
      const int s = tn * 32 + l31;
#pragma unroll
      for (int r = 0; r < 16; ++r) {
        const int tt = tm * 32 + drow(r, hh);
        float a = 0.f;
        if (s <= tt) a += af[r];
        if (s >= tt) a += ab[r];
        ATT[tt * 72 + s] = f2bf(a);
      }
    }
    {
      const f32x16 lf = lds_mm(VTt, KHF, tm, tn, l31, hh);
      const f32x16 lb = lds_mm(VTt, KHB, tm, tn, l31, hh);
      bf16* stf = P.ST + ((size_t)((b * 4 + hd) * 2 + 0) * 36 + c) * 4096;
      bf16* stb = P.ST + ((size_t)((b * 4 + hd) * 2 + 1) * 36 + c) * 4096;
#pragma unroll
      for (int r = 0; r < 16; ++r) {
        const int kk = tm * 32 + drow(r, hh), d = tn * 32 + l31;
        stf[kk * 64 + d] = f2bf(lf[r]);
        stb[kk * 64 + d] = f2bf(lb[r]);
      }
    }
    __syncthreads();
    {
      const f32x16 o = lds_mm(ATT, VTt, tm, tn, l31, hh);
#pragma unroll
      for (int r = 0; r < 16; ++r) {
        const int tt = tm * 32 + drow(r, hh), d = tn * 32 + l31;
        P.OI[(size_t)row_of(b, c * 64 + tt) * 256 + hd * 64 + d] = f2bf(o[r]);
      }
    }
  }
}

DEVI void hgrn_scan_item(const Params& P, int item) {
  const int tid = TIDX;
  const int chain = item >> 2, sl = item & 3;
  const int dir = chain & 1;
  const int dd = tid >> 2, k4 = sl * 16 + (tid & 3) * 4;
  float4 S = make_float4(0.f, 0.f, 0.f, 0.f);
  bf16* base = P.ST + (size_t)chain * 36 * 4096 + dd * 64 + k4;
  const float* dec = P.DEC + (size_t)chain * 36 * 64 + k4;
#pragma unroll 1
  for (int g = 0; g < 6; ++g) {
    float4 L[6], dc[6];
#pragma unroll
    for (int j = 0; j < 6; ++j) {
      const int step = g * 6 + j;
      const int c = dir == 0 ? step : (step < 4 ? 3 - step : 39 - step);
      { const uint2 u = *reinterpret_cast<const uint2*>(base + (size_t)c * 4096); L[j] = make_float4(lo2f(u.x), hi2f(u.x), lo2f(u.y), hi2f(u.y)); }
      dc[j] = *reinterpret_cast<const float4*>(dec + c * 64);
    }
#pragma unroll
    for (int j = 0; j < 6; ++j) {
      const int step = g * 6 + j;
      const int c = dir == 0 ? step : (step < 4 ? 3 - step : 39 - step);
      *reinterpret_cast<uint2*>(base + (size_t)c * 4096) = make_uint2(pack2(S.x, S.y), pack2(S.z, S.w));
      S.x = dc[j].x * S.x + L[j].x; S.y = dc[j].y * S.y + L[j].y; S.z = dc[j].z * S.z + L[j].z; S.w = dc[j].w * S.w + L[j].w;
    }
  }
}

DEVI void phase_hgrn_final(const Params& P, int l, unsigned char* smem) {
  const int tid = TIDX, lane = tid & 63, wave = tid >> 6, l31 = lane & 31, hh = lane >> 5;
  const int tm = wave >> 1, tn = wave & 1;
  float* O = reinterpret_cast<float*>(smem);
  bf16* QF = reinterpret_cast<bf16*>(smem + 33280);
  bf16* QB = QF + 64 * 72;
  bf16* SF = QB + 64 * 72;
  bf16* SB = SF + 64 * 72;
  const int c0 = (l == 1) ? 4 : 0;
  const int nc = 36 - c0;
  for (int it = VBID; it < 8 * 4 * nc; it += NVB) {
    const int c = it % nc + c0, hd = (it / nc) & 3, b = it / (nc * 4);
    const int t = tid >> 2, k0 = (tid & 3) * 16;
    const int row = row_of(b, c * 64 + t);
    __syncthreads();
    {
      const size_t go = (size_t)row * 256 + hd * 64 + k0;
      *reinterpret_cast<uint4*>(QF + t * 72 + k0) = *reinterpret_cast<const uint4*>(P.GQF + go);
      *reinterpret_cast<uint4*>(QF + t * 72 + k0 + 8) = *reinterpret_cast<const uint4*>(P.GQF + go + 8);
      *reinterpret_cast<uint4*>(QB + t * 72 + k0) = *reinterpret_cast<const uint4*>(P.GQB + go);
      *reinterpret_cast<uint4*>(QB + t * 72 + k0 + 8) = *reinterpret_cast<const uint4*>(P.GQB + go + 8);
      const bf16* stf = P.ST + ((size_t)((b * 4 + hd) * 2 + 0) * 36 + c) * 4096 + t * 64 + k0;
      const bf16* stb = P.ST + ((size_t)((b * 4 + hd) * 2 + 1) * 36 + c) * 4096 + t * 64 + k0;
      *reinterpret_cast<uint4*>(SF + t * 72 + k0) = *reinterpret_cast<const uint4*>(stf);
      *reinterpret_cast<uint4*>(SF + t * 72 + k0 + 8) = *reinterpret_cast<const uint4*>(stf + 8);
      *reinterpret_cast<uint4*>(SB + t * 72 + k0) = *reinterpret_cast<const uint4*>(stb);
      *reinterpret_cast<uint4*>(SB + t * 72 + k0 + 8) = *reinterpret_cast<const uint4*>(stb + 8);
    }
    __syncthreads();
    {
      f32x16 o = lds_mm(QF, SF, tm, tn, l31, hh);
      const f32x16 o2 = lds_mm(QB, SB, tm, tn, l31, hh);
#pragma unroll
      for (int r = 0; r < 16; ++r) {
        const int tt = tm * 32 + drow(r, hh), d = tn * 32 + l31;
        O[tt * 65 + d] = o[r] + o2[r] + bf2f(P.OI[(size_t)row_of(b, c * 64 + tt) * 256 + hd * 64 + d]);
      }
    }
    __syncthreads();
    {
      float ov[16]; float ss = 0.f;
#pragma unroll
      for (int i = 0; i < 16; ++i) { ov[i] = O[t * 65 + k0 + i]; ss += ov[i] * ov[i]; }
      ss += __shfl_xor(ss, 1); ss += __shfl_xor(ss, 2);
      const float rr = rsqrtf(ss * (1.f / 64.f) + EPS);
      const bf16* g = P.Z + (size_t)row * DIN + ZC_CG + hd * 64 + k0;
      const float* nw = P.c_out_norm_w + l * 64 + k0;
      const uint4 gA = *reinterpret_cast<const uint4*>(g), gB = *reinterpret_cast<const uint4*>(g + 8);
      const unsigned gw[8] = {gA.x, gA.y, gA.z, gA.w, gB.x, gB.y, gB.z, gB.w};
      unsigned pk[8];
#pragma unroll
      for (int i = 0; i < 16; i += 2) {
        const float g0 = lo2f(gw[i >> 1]), g1 = hi2f(gw[i >> 1]);
        const float y0 = ov[i] * rr * nw[i] * (g0 * sigmoidf_(g0));
        const float y1 = ov[i + 1] * rr * nw[i + 1] * (g1 * sigmoidf_(g1));
        pk[i >> 1] = pack2(y0, y1);
      }
      uint4* dst = reinterpret_cast<uint4*>(P.H + (size_t)row * 1024 + 768 + hd * 64 + k0);
      dst[0] = make_uint4(pk[0], pk[1], pk[2], pk[3]);
      dst[1] = make_uint4(pk[4], pk[5], pk[6], pk[7]);
    }
  }
}

DEVI void attn_item8(const Params& P, int b, int h, int qpos0, int nkeys, float sref, unsigned char* smem_base) {
  const int tid = threadIdx.x, lane = tid & 63, wave = tid >> 6, l31 = lane & 31, hh = lane >> 5;
  constexpr int TK = 128, LDKS = 104, LDVS = 136;
  constexpr int KS_BYTES = TK * LDKS * 2, VS_BYTES = 64 * LDVS * 2, ST_BYTES = KS_BYTES + VS_BYTES;
  const bf16* Qg = P.Q + ((size_t)(b * 8 + h) * SEQP + qpos0 + wave * 32 + l31) * 96;
  const bf16* Kg = P.K + (size_t)(b * 8 + h) * SEQP * 96;
  const bf16* Vg = P.VT + (size_t)(b * 8 + h) * 64 * SEQP;
  bf16x8 qf[6];
#pragma unroll
  for (int ks = 0; ks < 6; ++ks) qf[ks] = ldfrag(Qg + ks * 16 + hh * 8);
  f32x16 oacc[2]; oacc[0] = zero16(); oacc[1] = zero16();
  float lsum = 0.f;
  uint4 rk[3], rv[2];
  const int ntiles = nkeys / TK;
  auto gload = [&](int kt) {
#pragma unroll
    for (int i = 0; i < 3; ++i) { const int ch = tid + i * 512, row = ch / 12, cc = ch % 12;
      rk[i] = *reinterpret_cast<const uint4*>(Kg + (size_t)(kt * TK + row) * 96 + cc * 8); }
#pragma unroll
    for (int i = 0; i < 2; ++i) { const int ch = tid + i * 512, row = ch >> 4, cc = ch & 15;
      rv[i] = *reinterpret_cast<const uint4*>(Vg + (size_t)row * SEQP + kt * TK + cc * 8); }
  };
  auto swrite = [&](int buf) {
    bf16* sK = reinterpret_cast<bf16*>(smem_base + buf * ST_BYTES);
    bf16* sV = reinterpret_cast<bf16*>(smem_base + buf * ST_BYTES + KS_BYTES);
#pragma unroll
    for (int i = 0; i < 3; ++i) { const int ch = tid + i * 512, row = ch / 12, cc = ch % 12;
      *reinterpret_cast<uint4*>(sK + row * LDKS + cc * 8) = rk[i]; }
#pragma unroll
    for (int i = 0; i < 2; ++i) { const int ch = tid + i * 512, row = ch >> 4, cc = ch & 15;
      const int g16 = cc >> 1, odd = cc & 1;
      bf16* base = sV + row * LDVS + g16 * 16;
      const int s0 = odd ? 4 : 0, s1 = odd ? 12 : 8;
      *reinterpret_cast<uint2*>(base + s0) = make_uint2(rv[i].x, rv[i].y);
      *reinterpret_cast<uint2*>(base + s1) = make_uint2(rv[i].z, rv[i].w);
    }
  };
  __syncthreads();
  gload(0); swrite(0);
  __syncthreads();
  for (int kt = 0; kt < ntiles; ++kt) {
    const int cur = kt & 1;
    if (kt + 1 < ntiles) gload(kt + 1);
    const bf16* sK = reinterpret_cast<const bf16*>(smem_base + cur * ST_BYTES);
    const bf16* sV = reinterpret_cast<const bf16*>(smem_base + cur * ST_BYTES + KS_BYTES);
#pragma unroll
    for (int kk = 0; kk < 4; ++kk) {
      f32x16 sacc;
#pragma unroll
      for (int r = 0; r < 16; ++r) sacc[r] = -sref;
#pragma unroll
      for (int ks = 0; ks < 6; ++ks) {
        const bf16x8 a = ldfrag(sK + (kk * 32 + l31) * LDKS + ks * 16 + hh * 8);
        sacc = mfma32(a, qf[ks], sacc);
      }
#pragma unroll
      for (int r = 0; r < 16; ++r) { const float p = __builtin_amdgcn_exp2f(sacc[r]); sacc[r] = p; lsum += p; }
#pragma unroll
      for (int s = 0; s < 2; ++s) {
        bf16x8 pb;
#pragma unroll
        for (int j = 0; j < 8; ++j) pb[j] = (__bf16)sacc[8 * s + j];
#pragma unroll
        for (int dt = 0; dt < 2; ++dt) {
          const bf16x8 a = ldfrag(sV + (dt * 32 + l31) * LDVS + kk * 32 + s * 16 + hh * 8);
          oacc[dt] = mfma32(a, pb, oacc[dt]);
        }
      }
    }
    if (kt + 1 < ntiles) swrite(cur ^ 1);
    __syncthreads();
  }
  lsum += __shfl_xor(lsum, 32);
  const float inv = 1.f / lsum;
  const int row = row_of(b, qpos0 + wave * 32 + l31);
  bf16* dst = P.H + (size_t)row * 1024 + 256 + h * 64;
#pragma unroll
  for (int dt = 0; dt < 2; ++dt)
#pragma unroll
    for (int rg = 0; rg < 4; ++rg) {
      const int d = dt * 32 + 8 * rg + 4 * hh;
      uint2 o;
      o.x = pack2(oacc[dt][4 * rg + 0] * inv, oacc[dt][4 * rg + 1] * inv);
      o.y = pack2(oacc[dt][4 * rg + 2] * inv, oacc[dt][4 * rg + 3] * inv);
      *reinterpret_cast<uint2*>(dst + d) = o;
    }
}

DEVI void phase_attn_scan(const Params& P, int l, unsigned char* smem_base, bool skip_scan = false) {
  if (!skip_scan)
    for (int it = NVB - 1 - VBID; it < 256; it += NVB) hgrn_scan_item(P, it);
  float sref;
  {
    const int lane = threadIdx.x & 63;
    float mq = fmaxf(fabsf(P.b_qh_w[l * 96 + lane]), lane < 32 ? fabsf(P.b_qh_w[l * 96 + 64 + lane]) : 0.f);
    float mk = fmaxf(fabsf(P.b_kh_w[l * 96 + lane]), lane < 32 ? fabsf(P.b_kh_w[l * 96 + 64 + lane]) : 0.f);
#pragma unroll
    for (int o = 32; o > 0; o >>= 1) { mq = fmaxf(mq, __shfl_xor(mq, o)); mk = fmaxf(mk, __shfl_xor(mk, o)); }
    sref = fminf(1.4426950408889634f * 9.797958971132712f * mq * mk, 60.f);
  }
  const int c = blockIdx.x, xcd = c & 7, slot = c >> 3;
  const int nrounds = (l == 0) ? 3 : 2;
  for (int r = 0; r < nrounds; ++r) {
    if (r < 2) {
      const int u = r * 32 + slot;
      const int bh = xcd * 8 + (u >> 3), qt = u & 7;
      if (slot < 32) attn_item8(P, bh >> 3, bh & 7, 256 + 256 * qt, 2304, sref, smem_base);
    } else if (c < 64) {
      attn_item8(P, c >> 3, c & 7, 0, 256, sref, smem_base);
    }
  }
}

DEVI unsigned ordkey(float s) { const unsigned u = __float_as_uint(s); return (u & 0x80000000u) ? ~u : (u | 0x80000000u); }
DEVI float keyval(unsigned k, unsigned mask) { const unsigned u = k & ~mask; return __uint_as_float((u & 0x80000000u) ? (u & 0x7fffffffu) : ~u); }
DEVI void ins16(unsigned (&lst)[16], unsigned v) {
#pragma unroll
  for (int j = 0; j < 16; ++j) { const unsigned hi = max(lst[j], v); v = min(lst[j], v); lst[j] = hi; }
}
DEVI void merge16(unsigned (&lst)[16], int xm) {
  unsigned o[16];
#pragma unroll
  for (int j = 0; j < 16; ++j) o[j] = (unsigned)__shfl_xor((int)lst[j], xm);
#pragma unroll
  for (int j = 0; j < 16; ++j) lst[j] = max(lst[j], o[15 - j]);
#pragma unroll
  for (int d = 8; d >= 1; d >>= 1)
#pragma unroll
    for (int j = 0; j < 16; ++j)
      if ((j & d) == 0) { const unsigned a = lst[j], bb = lst[j + d]; lst[j] = max(a, bb); lst[j + d] = min(a, bb); }
}

DEVI void bitonic_sort_desc16(unsigned (&v)[16]) {
#pragma unroll
  for (int k = 2; k <= 16; k <<= 1)
#pragma unroll
    for (int j = k >> 1; j > 0; j >>= 1)
#pragma unroll
      for (int i = 0; i < 16; ++i) {
        const int l = i ^ j;
        if (l > i) {
          const bool desc = ((i & k) == 0);
          const unsigned a = v[i], b = v[l];
          const unsigned mx = max(a, b), mn = min(a, b);
          v[i] = desc ? mx : mn; v[l] = desc ? mn : mx;
        }
      }
}
DEVI void bitonic_merge_desc16(unsigned (&lst)[16]) {
#pragma unroll
  for (int d = 8; d >= 1; d >>= 1)
#pragma unroll
    for (int j = 0; j < 16; ++j)
      if ((j & d) == 0) { const unsigned a = lst[j], bb = lst[j + d]; lst[j] = max(a, bb); lst[j + d] = min(a, bb); }
}
struct CandTab { int a[52]; int b[52]; };
constexpr CandTab make_cand_tab() {
  CandTab t{};
  int n = 0;
  for (int a = 0; a < 16; ++a)
    for (int b = 0; b < 16; ++b)
      if ((a + 1) * (b + 1) <= 16) { t.a[n] = a; t.b[n] = b; ++n; }
  for (; n < 52; ++n) { t.a[n] = 0; t.b[n] = 0; }
  return t;
}

DEVI void phase_route(const Params& P, int l, unsigned char* smem) {
  const int tid = TIDX, lane = tid & 63, wave = tid >> 6, l31 = lane & 31, hh = lane >> 5;
  bf16* QT = reinterpret_cast<bf16*>(smem);
  float* SC = reinterpret_cast<float*>(smem + 33792);
  const int mtiles = (l == 1) ? 256 : 288;
  for (int it = VBID; it < mtiles * 8; it += NVB) {
    const int mt = it >> 3, h = it & 7;
    __syncthreads();
    for (int e = tid; e < 64 * 32; e += 256) {
      const int r = e >> 5, cc = e & 31;
      *reinterpret_cast<uint4*>(QT + r * 264 + cc * 8) = *reinterpret_cast<const uint4*>(P.QP + (size_t)(mt * 64 + r) * 2048 + h * 256 + cc * 8);
    }
    __syncthreads();
    unsigned lst[2][16];
    const int row = tid >> 2, part = tid & 3;
#pragma unroll
    for (int p = 0; p < 2; ++p) {
      f32x16 sa[2]; sa[0] = zero16(); sa[1] = zero16();
      const bf16* keys = P.SK + ((size_t)(l * 16 + h * 2 + p) * 128 + wave * 32 + l31) * 128;
#pragma unroll
      for (int ks = 0; ks < 8; ++ks) {
        const bf16x8 bfr = ldfrag(keys + ks * 16 + hh * 8);
#pragma unroll
        for (int i = 0; i < 2; ++i) {
          const bf16x8 af = ldfrag(QT + (i * 32 + l31) * 264 + p * 128 + ks * 16 + hh * 8);
          sa[i] = mfma32(af, bfr, sa[i]);
        }
      }
      if (p == 1) __syncthreads();
#pragma unroll
      for (int i = 0; i < 2; ++i)
#pragma unroll
        for (int r = 0; r < 16; ++r) SC[(i * 32 + drow(r, hh)) * 129 + wave * 32 + l31] = sa[i][r];
      __syncthreads();
      unsigned B2[16];
#pragma unroll
      for (int i = 0; i < 16; ++i) {
        const int i0 = part * 32 + ((i + part * 8) & 31), i1 = part * 32 + ((i + 16 + part * 8) & 31);
        lst[p][i] = (ordkey(SC[row * 129 + i0]) & ~0x7fu) | (unsigned)(127 - i0);
        B2[i] = (ordkey(SC[row * 129 + i1]) & ~0x7fu) | (unsigned)(127 - i1);
      }
      bitonic_sort_desc16(lst[p]);
      bitonic_sort_desc16(B2);
#pragma unroll
      for (int j = 0; j < 16; ++j) lst[p][j] = max(lst[p][j], B2[15 - j]);
      bitonic_merge_desc16(lst[p]);
      merge16(lst[p], 1);
      merge16(lst[p], 2);
    }
    float v0[16], v1[16];
#pragma unroll
    for (int j = 0; j < 16; ++j) { v0[j] = keyval(lst[0][j], 0x7fu); v1[j] = keyval(lst[1][j], 0x7fu); }
    unsigned best[16];
    {
      constexpr CandTab CT = make_cand_tab();
#pragma unroll
      for (int c = 0; c < 13; ++c) {
        const int a0 = CT.a[4 * c + 0], a1 = CT.a[4 * c + 1], a2 = CT.a[4 * c + 2], a3 = CT.a[4 * c + 3];
        const int b0 = CT.b[4 * c + 0], b1 = CT.b[4 * c + 1], b2 = CT.b[4 * c + 2], b3 = CT.b[4 * c + 3];
        const float x = part == 0 ? v0[a0] : part == 1 ? v0[a1] : part == 2 ? v0[a2] : v0[a3];
        const float y = part == 0 ? v1[b0] : part == 1 ? v1[b1] : part == 2 ? v1[b2] : v1[b3];
        const int flat = part == 0 ? (a0 * 16 + b0) : part == 1 ? (a1 * 16 + b1) : part == 2 ? (a2 * 16 + b2) : (a3 * 16 + b3);
        const bool valid = part == 0 ? (4 * c + 0 < 50) : part == 1 ? (4 * c + 1 < 50) : part == 2 ? (4 * c + 2 < 50) : (4 * c + 3 < 50);
        const unsigned key = (ordkey(x + y) & ~0xffu) | (unsigned)(255 - flat);
        best[c] = valid ? key : 0u;
      }
      best[13] = 0u; best[14] = 0u; best[15] = 0u;
      bitonic_sort_desc16(best);
      merge16(best, 1);
      merge16(best, 2);
    }
    {
      const float mx = keyval(best[0], 0xffu);
      float es = 0.f;
      float ev[4]; int ex[4];
#pragma unroll
      for (int jj = 0; jj < 4; ++jj) {
        const unsigned kk = part == 0 ? best[4 * jj + 0] : part == 1 ? best[4 * jj + 1] : part == 2 ? best[4 * jj + 2] : best[4 * jj + 3];
        ev[jj] = __expf(keyval(kk, 0xffu) - mx);
        es += ev[jj];
        const int flat = 255 - (int)(kk & 0xffu);
        const int a = flat >> 4, bq = flat & 15;
        int i1 = 0, i2 = 0;
#pragma unroll
        for (int u = 0; u < 16; ++u) {
          i1 = (a == u) ? (127 - (int)(lst[0][u] & 0x7fu)) : i1;
          i2 = (bq == u) ? (127 - (int)(lst[1][u] & 0x7fu)) : i2;
        }
        ex[jj] = i1 * 128 + i2;
      }
      es += __shfl_xor(es, 1); es += __shfl_xor(es, 2);
      const float inv = 1.f / es;
      const int tok = mt * 64 + row;
      int* ed = P.EIDX + (size_t)tok * 128 + h * 16;
      float* gd = P.GATE + (size_t)tok * 128 + h * 16;
#pragma unroll
      for (int jj = 0; jj < 4; ++jj) { ed[4 * jj + part] = ex[jj]; gd[4 * jj + part] = ev[jj] * inv; }
    }
  }
}

DEVI float gelu_exact(float a) { return 0.5f * a * (1.f + erff(a * 0.70710678118654752f)); }

typedef float f2 __attribute__((ext_vector_type(2)));
DEVI void phase_peer_u(const Params& P, int l) {
  const int lane = TIDX & 63, half = lane >> 5, l32 = lane & 31;
  const int gw = VBID * 4 + (TIDX >> 6), nw = NVB * 4;
  const int nrows = (l == 1) ? NL : NT;
  const unsigned char* PU = P.PU8 + (size_t)l * 16384 * 576;
  const bool b4 = lane & 16, b3 = lane & 8, b2 = lane & 4;
  for (int t = gw; t < nrows; t += nw) {
    f2 h2[16];
    {
      const bf16* hp = P.H + (size_t)t * 1024 + l32 * 32;
#pragma unroll
      for (int i = 0; i < 4; ++i) {
        const uint4 hv = *reinterpret_cast<const uint4*>(hp + i * 8);
        h2[4 * i + 0] = (f2){lo2f(hv.x), hi2f(hv.x)}; h2[4 * i + 1] = (f2){lo2f(hv.y), hi2f(hv.y)};
        h2[4 * i + 2] = (f2){lo2f(hv.z), hi2f(hv.z)}; h2[4 * i + 3] = (f2){lo2f(hv.w), hi2f(hv.w)};
      }
    }
    const int e0 = P.EIDX[(size_t)t * 128 + lane], e1 = P.EIDX[(size_t)t * 128 + 64 + lane];
    const float g0 = P.GATE[(size_t)t * 128 + lane], g1 = P.GATE[(size_t)t * 128 + 64 + lane];
    float* wrow = P.WPE + (size_t)t * 128;
    for (int kb = 0; kb < 8; ++kb) {
      const int esrc = kb < 4 ? e0 : e1;
      uint4 ud[8];
      unsigned short us[8];
#pragma unroll
      for (int i = 0; i < 8; ++i) {
        const int e = __shfl(esrc, (kb * 16 + 2 * i + half) & 63);
        const unsigned char* ur = PU + (size_t)e * 576;
        ud[i] = *reinterpret_cast<const uint4*>(ur + l32 * 16);
        us[i] = *reinterpret_cast<const unsigned short*>(ur + 512 + l32 * 2);
      }
      float d[8];
#pragma unroll
      for (int i = 0; i < 8; ++i) {
        const unsigned uw[4] = {ud[i].x, ud[i].y, ud[i].z, ud[i].w};
        f2 sacc = (f2){0.f, 0.f};
#pragma unroll
        for (int c = 0; c < 4; ++c) {
          sacc = __builtin_elementwise_fma(__builtin_amdgcn_cvt_scalef32_pk_f32_fp4(uw[c], 1.0f, 0), h2[4 * c + 0], sacc);
          sacc = __builtin_elementwise_fma(__builtin_amdgcn_cvt_scalef32_pk_f32_fp4(uw[c], 1.0f, 1), h2[4 * c + 1], sacc);
          sacc = __builtin_elementwise_fma(__builtin_amdgcn_cvt_scalef32_pk_f32_fp4(uw[c], 1.0f, 2), h2[4 * c + 2], sacc);
          sacc = __builtin_elementwise_fma(__builtin_amdgcn_cvt_scalef32_pk_f32_fp4(uw[c], 1.0f, 3), h2[4 * c + 3], sacc);
        }
        d[i] = (sacc.x + sacc.y) * __uint_as_float((unsigned)us[i] << 16);
      }
      float r4[4], r2[2], r1;
#pragma unroll
      for (int i = 0; i < 4; ++i) { const float mine = b4 ? d[4 + i] : d[i]; const float send = b4 ? d[i] : d[4 + i]; r4[i] = mine + __shfl_xor(send, 16); }
#pragma unroll
      for (int i = 0; i < 2; ++i) { const float mine = b3 ? r4[2 + i] : r4[i]; const float send = b3 ? r4[i] : r4[2 + i]; r2[i] = mine + __shfl_xor(send, 8); }
      { const float mine = b2 ? r2[1] : r2[0]; const float send = b2 ? r2[0] : r2[1]; r1 = mine + __shfl_xor(send, 4); }
      r1 += __shfl_xor(r1, 2); r1 += __shfl_xor(r1, 1);
      const int k = kb * 16 + 2 * ((lane >> 2) & 7) + half;
      const float gt = __shfl(kb < 4 ? g0 : g1, k & 63);
      if ((lane & 3) == 0) wrow[k] = gt * gelu_exact(r1);
    }
  }
}

DEVI void phase_peer(const Params& P, int l) {
  const int lane = TIDX & 63, half = lane >> 5, l32 = lane & 31;
  const int gw = VBID * 4 + (TIDX >> 6), nw = NVB * 4;
  const int nrows = (l == 1) ? NL : NT;
  const unsigned char* PV = P.PV8 + (size_t)l * 16384 * 576;
  for (int t = gw; t < nrows; t += nw) {
    const int e0 = P.EIDX[(size_t)t * 128 + lane], e1 = P.EIDX[(size_t)t * 128 + 64 + lane];
    const float w0 = P.WPE[(size_t)t * 128 + lane], w1 = P.WPE[(size_t)t * 128 + 64 + lane];
    f2 y2[16];
#pragma unroll
    for (int i = 0; i < 16; ++i) y2[i] = (f2){0.f, 0.f};
    for (int kb = 0; kb < 8; ++kb) {
      const int esrc = kb < 4 ? e0 : e1;
      const float wsrc = kb < 4 ? w0 : w1;
      uint4 vd[8];
      unsigned short vs[8];
      float wv[8];
#pragma unroll
      for (int i = 0; i < 8; ++i) {
        const int ks = (kb * 16 + 2 * i + half) & 63;
        const int e = __shfl(esrc, ks);
        wv[i] = __shfl(wsrc, ks);
        const unsigned char* vr = PV + (size_t)e * 576;
        vd[i] = *reinterpret_cast<const uint4*>(vr + l32 * 16);
        vs[i] = *reinterpret_cast<const unsigned short*>(vr + 512 + l32 * 2);
      }
#pragma unroll
      for (int i = 0; i < 8; ++i) {
        const float wi = wv[i] * __uint_as_float((unsigned)vs[i] << 16);
        const f2 ww = (f2){wi, wi};
        const unsigned vw[4] = {vd[i].x, vd[i].y, vd[i].z, vd[i].w};
#pragma unroll
        for (int c = 0; c < 4; ++c) {
          y2[4 * c + 0] = __builtin_elementwise_fma(ww, __builtin_amdgcn_cvt_scalef32_pk_f32_fp4(vw[c], 1.0f, 0), y2[4 * c + 0]);
          y2[4 * c + 1] = __builtin_elementwise_fma(ww, __builtin_amdgcn_cvt_scalef32_pk_f32_fp4(vw[c], 1.0f, 1), y2[4 * c + 1]);
          y2[4 * c + 2] = __builtin_elementwise_fma(ww, __builtin_amdgcn_cvt_scalef32_pk_f32_fp4(vw[c], 1.0f, 2), y2[4 * c + 2]);
          y2[4 * c + 3] = __builtin_elementwise_fma(ww, __builtin_amdgcn_cvt_scalef32_pk_f32_fp4(vw[c], 1.0f, 3), y2[4 * c + 3]);
        }
      }
    }
    float y[16];
#pragma unroll
    for (int j = 0; j < 8; ++j) {
      const float ax = y2[j].x + __shfl_xor(y2[j].x, 32), ay = y2[j].y + __shfl_xor(y2[j].y, 32);
      const float bx = y2[8 + j].x + __shfl_xor(y2[8 + j].x, 32), by = y2[8 + j].y + __shfl_xor(y2[8 + j].y, 32);
      y[2 * j] = half ? bx : ax; y[2 * j + 1] = half ? by : ay;
    }
    const int bi = batch_of_row(t);
    const float* gate2 = P.MOD + (size_t)(l * 9 + bi) * 6144 + 5 * 1024;
    const int d0 = l32 * 32 + half * 16;
    float xn[16];
    float ss = 0.f;
#pragma unroll
    for (int q4 = 0; q4 < 4; ++q4) {
      const int d = d0 + q4 * 4;
      const uint2 xu = *reinterpret_cast<const uint2*>(P.X + (size_t)t * 1024 + d);
      const float4 xo = make_float4(lo2f(xu.x), hi2f(xu.x), lo2f(xu.y), hi2f(xu.y));
      const float4 gg = *reinterpret_cast<const float4*>(gate2 + d);
      float4 o;
      o.x = xo.x + gg.x * y[q4 * 4 + 0]; o.y = xo.y + gg.y * y[q4 * 4 + 1];
      o.z = xo.z + gg.z * y[q4 * 4 + 2]; o.w = xo.w + gg.w * y[q4 * 4 + 3];
      xn[q4 * 4 + 0] = o.x; xn[q4 * 4 + 1] = o.y; xn[q4 * 4 + 2] = o.z; xn[q4 * 4 + 3] = o.w;
      ss += o.x * o.x + o.y * o.y + o.z * o.z + o.w * o.w;
      if (l == 1) *reinterpret_cast<float4*>(P.out + (size_t)t * 1024 + d) = o;
      else *reinterpret_cast<uint2*>(P.X + (size_t)t * 1024 + d) = make_uint2(pack2(o.x, o.y), pack2(o.z, o.w));
    }
    if (l == 0) {
      ss = wave_sum(ss);
      const float rr = rsqrtf(ss * (1.f / 1024.f) + EPS);
      const float* lnw = P.ln1_w + 1024;
      const float* mod = P.MOD + (size_t)(9 + bi) * 6144;
      unsigned pk[8];
#pragma unroll
      for (int i = 0; i < 16; i += 2) {
        const float o0 = xn[i] * rr * lnw[d0 + i] * (1.f + mod[1024 + d0 + i]) + mod[d0 + i];
        const float o1 = xn[i + 1] * rr * lnw[d0 + i + 1] * (1.f + mod[1024 + d0 + i + 1]) + mod[d0 + i + 1];
        pk[i >> 1] = pack2(o0, o1);
      }
      *reinterpret_cast<uint4*>(P.H + (size_t)t * 1024 + d0) = make_uint4(pk[0], pk[1], pk[2], pk[3]);
      *reinterpret_cast<uint4*>(P.H + (size_t)t * 1024 + d0 + 8) = make_uint4(pk[4], pk[5], pk[6], pk[7]);
    }
  }
}

using f32x4 = __attribute__((ext_vector_type(4))) float;
namespace g8 {
constexpr int BM = 256, BK = 64, HALF = 128, HT = HALF * BK;
DEVI int lds_byte(int r, int c) { const int st = (r >> 4) * 2 + (c >> 5), rr = r & 15, cc = c & 31, ob = rr * 64 + cc * 2; return st * 1024 + (ob ^ (((ob >> 9) & 1) << 5)); }
DEVI void stage_rc(int b, int& R, int& C) { const int st = b / 1024, sb = b % 1024, swz = sb ^ (((sb >> 9) & 1) << 5); R = (st >> 1) * 16 + swz / 64; C = (st & 1) * 32 + (swz % 64) / 2; }
DEVI int perm32(int rho) { const int n = rho >> 4, i = rho & 15; return 8 * (i >> 2) + 4 * n + (i & 3); }
DEVI void unit_of(int L, int nM, int nN, int& pm, int& pn) {
  const int nwg = nM * nN;
  int wgid = L;
  { const int q = nwg / 8, r = nwg % 8, xcd = wgid % 8, off = wgid / 8; wgid = (xcd < r ? xcd * (q + 1) : r * (q + 1) + (xcd - r) * q) + off; }
  const int nig = 8 * nN, gid = wgid / nig, fm = gid * 8, gsz = (nM - fm) < 8 ? (nM - fm) : 8;
  pm = fm + ((wgid % nig) % gsz); pn = (wgid % nig) / gsz;
}
}

struct G8Unit { int pm, pn; };
template <class Epi>
DEVI void gemm8_phase(LAS unsigned char* lds, const bf16* __restrict__ Ag, const bf16* __restrict__ Btg, const int K, const int nM, const int nN, const Epi& E,
                      const int lda = 0, const int pn_split = 1 << 30, const int acol0 = 0, const int acol1 = 0) {
  constexpr int BK = 64, HALF = 128, HTB = HALF * BK * 2;
  const int tid = threadIdx.x, wid = __builtin_amdgcn_readfirstlane(tid >> 6), lane = tid & 63, wr = wid >> 2, wc = wid & 3, fr = lane & 15, fq = lane >> 4;
  const int nt = K / BK;
  const int nunits = nM * nN, G = gridDim.x, c = blockIdx.x;
  const int LDA = lda ? lda : K;
  unsigned voffA[2], voffB[2];
#pragma unroll
  for (int i = 0; i < 2; ++i) { int R, C; g8::stage_rc(tid * 16 + i * 8192, R, C); const int Rb = (R & ~31) + g8::perm32(R & 31); voffA[i] = (unsigned)(R * LDA + C) * 2u; voffB[i] = (unsigned)(Rb * K + C) * 2u; }
  const size_t kstep = (size_t)(BK * 2);
  const size_t hstepA = (size_t)HALF * LDA * 2, hstep = (size_t)HALF * K * 2;
  const size_t tstepA = 2 * hstepA, tstep = 2 * hstep;
  const unsigned ldsw = (unsigned)wid * 1024u;
  const int aoff = g8::lds_byte(wr * 64 + fr, fq * 8), boff = g8::lds_byte(wc * 32 + fr, fq * 8);
#define PG8_SA(b, h) (((b) * 2 + (h)) * HTB)
#define PG8_SB(b, h) ((4 + (b) * 2 + (h)) * HTB)
#define PG8_STAGE(bufoff, gbase, voff) do { _Pragma("unroll") for (int _i = 0; _i < 2; ++_i) \
        __builtin_amdgcn_global_load_lds((const unsigned*)((const char*)(gbase) + (voff)[_i]), (LAS unsigned*)(lds + (bufoff) + ldsw + _i * 8192), 16, 0, 0); } while (0)
#define PG8_LDA(dst, b, h) do { _Pragma("unroll") for (int m = 0; m < 4; ++m) _Pragma("unroll") for (int k = 0; k < 2; ++k) dst[m][k] = *(const LAS bf16x8*)(lds + PG8_SA(b, h) + aoff + m * 2048 + k * 1024); } while (0)
#define PG8_LDB(dst, b, h) do { _Pragma("unroll") for (int n = 0; n < 2; ++n) _Pragma("unroll") for (int k = 0; k < 2; ++k) dst[n][k] = *(const LAS bf16x8*)(lds + PG8_SB(b, h) + boff + n * 2048 + k * 1024); } while (0)
#define PG8_MMA(ai, bj, At_, Bt_) do { __builtin_amdgcn_s_setprio(1); _Pragma("unroll") for (int m = 0; m < 4; ++m) _Pragma("unroll") for (int n = 0; n < 2; ++n) _Pragma("unroll") for (int k = 0; k < 2; ++k) \
        acc[ai][bj][m][n] = __builtin_amdgcn_mfma_f32_16x16x32_bf16(Bt_[n][k], At_[m][k], acc[ai][bj][m][n], 0, 0, 0); __builtin_amdgcn_s_setprio(0); } while (0)
#define PG8_WAIT_V(n) asm volatile("s_waitcnt vmcnt(" #n ")" ::: "memory")
#define PG8_WAIT_L(n) asm volatile("s_waitcnt lgkmcnt(" #n ")" ::: "memory")
#define PG8_BAR __builtin_amdgcn_s_barrier()
#define PG8_SCHED __builtin_amdgcn_sched_barrier(0)
  G8Unit cur, nxt; int ui = 0;
  if (c >= nunits) return;
  g8::unit_of(c, nM, nN, cur.pm, cur.pn);
  f32x4 acc[2][2][4][2];
#pragma unroll
  for (int a = 0; a < 2; ++a)
#pragma unroll
    for (int b = 0; b < 2; ++b)
#pragma unroll
      for (int m = 0; m < 4; ++m)
#pragma unroll
        for (int n = 0; n < 2; ++n) acc[a][b][m][n] = (f32x4){0.f, 0.f, 0.f, 0.f};
  bf16x8 At[4][2], B0[2][2], B1[2][2];
  const char* cA = (const char*)Ag + (size_t)cur.pm * tstepA + (size_t)(cur.pn < pn_split ? acol0 : acol1) * 2; const char* cB = (const char*)Btg + (size_t)cur.pn * tstep;
  PG8_STAGE(PG8_SB(0, 0), cB, voffB); PG8_STAGE(PG8_SA(0, 0), cA, voffA); PG8_STAGE(PG8_SB(0, 1), cB + hstep, voffB); PG8_STAGE(PG8_SA(0, 1), cA + hstepA, voffA);
  if (wr == 1) PG8_BAR;
  PG8_WAIT_V(4); PG8_BAR;
  PG8_STAGE(PG8_SB(1, 0), cB + kstep, voffB); PG8_STAGE(PG8_SA(1, 0), cA + kstep, voffA); PG8_STAGE(PG8_SB(1, 1), cB + hstep + kstep, voffB);
  PG8_WAIT_V(6); PG8_BAR;
  for (;;) {
    const long Ln = (long)(ui + 1) * G + c;
    const bool has_next = Ln < nunits;
    if (has_next) g8::unit_of((int)Ln, nM, nN, nxt.pm, nxt.pn);
    const char* nA = has_next ? (const char*)Ag + (size_t)nxt.pm * tstepA + (size_t)(nxt.pn < pn_split ? acol0 : acol1) * 2 : cA; const char* nB = has_next ? (const char*)Btg + (size_t)nxt.pn * tstep : cB;
    for (int t = 0; t < nt; t += 2) {
      const bool last = (t == nt - 2);
      const char* a1 = cA + (size_t)(t + 1) * kstep;
      const char* a2 = last ? nA : cA + (size_t)(t + 2) * kstep; const char* b2 = last ? nB : cB + (size_t)(t + 2) * kstep;
      const char* a3 = a2 + kstep; const char* b3 = b2 + kstep;
      PG8_LDB(B0, 0, 0); PG8_SCHED; PG8_LDA(At, 0, 0); PG8_STAGE(PG8_SA(1, 1), a1 + hstepA, voffA);
      PG8_WAIT_L(8); PG8_BAR; PG8_WAIT_L(0); PG8_MMA(0, 0, At, B0); PG8_BAR; PG8_SCHED;
      PG8_LDB(B1, 0, 1); PG8_STAGE(PG8_SB(0, 0), b2, voffB);
      PG8_BAR; PG8_WAIT_L(0); PG8_MMA(0, 1, At, B1); PG8_BAR;
      PG8_LDA(At, 0, 1); PG8_STAGE(PG8_SA(0, 0), a2, voffA);
      PG8_BAR; PG8_WAIT_L(0); PG8_MMA(1, 0, At, B0); PG8_BAR; PG8_SCHED;
      PG8_STAGE(PG8_SB(0, 1), b2 + hstep, voffB);
      PG8_WAIT_V(6); PG8_BAR; PG8_MMA(1, 1, At, B1); PG8_BAR;
      PG8_LDB(B0, 1, 0); PG8_SCHED; PG8_LDA(At, 1, 0); PG8_STAGE(PG8_SA(0, 1), a2 + hstepA, voffA);
      PG8_WAIT_L(8); PG8_BAR; PG8_WAIT_L(0); PG8_MMA(0, 0, At, B0); PG8_BAR; PG8_SCHED;
      PG8_LDB(B1, 1, 1); PG8_STAGE(PG8_SB(1, 0), b3, voffB);
      PG8_BAR; PG8_WAIT_L(0); PG8_MMA(0, 1, At, B1); PG8_BAR;
      PG8_LDA(At, 1, 1); PG8_STAGE(PG8_SA(1, 0), a3, voffA);
      PG8_BAR; PG8_WAIT_L(0); PG8_MMA(1, 0, At, B0); PG8_BAR; PG8_SCHED;
      PG8_STAGE(PG8_SB(1, 1), b3 + hstep, voffB);
      PG8_WAIT_V(6); PG8_BAR; PG8_MMA(1, 1, At, B1); PG8_BAR;
    }
    E(acc, cur, wr, wc, fr, fq);
    if (!has_next) break;
#pragma unroll
    for (int a = 0; a < 2; ++a)
#pragma unroll
      for (int b = 0; b < 2; ++b)
#pragma unroll
        for (int m = 0; m < 4; ++m)
#pragma unroll
          for (int n = 0; n < 2; ++n) acc[a][b][m][n] = (f32x4){0.f, 0.f, 0.f, 0.f};
    cur = nxt; cA = nA; cB = nB; ++ui;
  }
  PG8_WAIT_V(0);
  if (wr == 0) PG8_BAR;
  PG8_BAR;
#undef PG8_SA
#undef PG8_SB
#undef PG8_STAGE
#undef PG8_LDA
#undef PG8_LDB
#undef PG8_MMA
}

struct EpiZ {
  bf16* Z;
  DEVI void operator()(const f32x4 (&acc)[2][2][4][2], const G8Unit& u, int wr, int wc, int fr, int fq) const {
    const int brow = u.pm * 256, bcol = u.pn * 256;
#pragma unroll
    for (int ai = 0; ai < 2; ++ai)
#pragma unroll
      for (int m = 0; m < 4; ++m) {
        const int row = brow + ai * 128 + wr * 64 + m * 16 + fr;
#pragma unroll
        for (int bj = 0; bj < 2; ++bj) {
          const int col = bcol + bj * 128 + wc * 32 + 8 * fq;
          if (col < DIN) {
            const f32x4 v0 = acc[ai][bj][m][0], v1 = acc[ai][bj][m][1];
            *reinterpret_cast<uint4*>(Z + (size_t)row * DIN + col) = make_uint4(pack2(v0[0], v0[1]), pack2(v0[2], v0[3]), pack2(v1[0], v1[1]), pack2(v1[2], v1[3]));
          }
        }
      }
  }
};
DEVI void phase_gemm1_8(const Params& P, int l, unsigned char* smem_base) {
  EpiZ E{P.Z};
  gemm8_phase((LAS unsigned char*)smem_base, P.H, P.WinT + (size_t)l * DINP * 1024, 1024, NT / 256, DINP / 256, E);
  const int c = blockIdx.x;
  if (c >= 136) {
    const int j = c - 136;
    if (l == 0) convert_rows_fp6(P, 0, j * 100, j * 100 + 100);
    else { const int b0 = 19200 + j * 114; convert_rows_fp6(P, 1, b0 < 32768 ? b0 : 32768, b0 + 114 < 32768 ? b0 + 114 : 32768); }
  }
}

struct EpiRAW {
  bf16* R;
  DEVI void operator()(const f32x4 (&acc)[2][2][4][2], const G8Unit& u, int wr, int wc, int fr, int fq) const {
    const int brow = u.pm * 256, bcol = u.pn * 256;
#pragma unroll
    for (int ai = 0; ai < 2; ++ai)
#pragma unroll
      for (int m = 0; m < 4; ++m) {
        const int row = brow + ai * 128 + wr * 64 + m * 16 + fr;
#pragma unroll
        for (int bj = 0; bj < 2; ++bj) {
          const int col = bcol + bj * 128 + wc * 32 + 8 * fq;
          const f32x4 v0 = acc[ai][bj][m][0], v1 = acc[ai][bj][m][1];
          *reinterpret_cast<uint4*>(R + (size_t)row * 1792 + col) = make_uint4(pack2(v0[0], v0[1]), pack2(v0[2], v0[3]), pack2(v1[0], v1[1]), pack2(v1[2], v1[3]));
        }
      }
  }
};
DEVI void phase_mla_raw(const Params& P, int l, unsigned char* smem_base) {
  EpiRAW E{P.RAW};
  gemm8_phase((LAS unsigned char*)smem_base, P.Z, P.WCOMB + (size_t)l * 1792 * 256, 256, NT / 256, 7, E, DIN, 3, ZC_BQ, ZC_BKV);
}

struct EpiX {
  const float* x; const float* ctx; bf16* X; const float* MODl; int l;
  DEVI void operator()(const f32x4 (&acc)[2][2][4][2], const G8Unit& u, int wr, int wc, int fr, int fq) const {
    const int brow = u.pm * 256, bcol = u.pn * 256;
    const float* gate = MODl + (size_t)batch_of_row(brow) * 6144 + 2048;
#pragma unroll
    for (int ai = 0; ai < 2; ++ai)
#pragma unroll
      for (int m = 0; m < 4; ++m) {
        const int row = brow + ai * 128 + wr * 64 + m * 16 + fr;
        const float* res = row < NL ? x + (size_t)row * 1024 : ctx + (size_t)(row - NL) * 1024;
#pragma unroll
        for (int bj = 0; bj < 2; ++bj) {
          const int col = bcol + bj * 128 + wc * 32 + 8 * fq;
          const f32x4 v0 = acc[ai][bj][m][0], v1 = acc[ai][bj][m][1];
          float4 ra, rb;
          if (l == 0) { ra = *reinterpret_cast<const float4*>(res + col); rb = *reinterpret_cast<const float4*>(res + col + 4); }
          else {
            const uint4 uu = *reinterpret_cast<const uint4*>(X + (size_t)row * 1024 + col);
            ra = make_float4(lo2f(uu.x), hi2f(uu.x), lo2f(uu.y), hi2f(uu.y)); rb = make_float4(lo2f(uu.z), hi2f(uu.z), lo2f(uu.w), hi2f(uu.w));
          }
          const float4 ga = *reinterpret_cast<const float4*>(gate + col), gb = *reinterpret_cast<const float4*>(gate + col + 4);
          *reinterpret_cast<uint4*>(X + (size_t)row * 1024 + col) =
              make_uint4(pack2(ra.x + ga.x * v0[0], ra.y + ga.y * v0[1]), pack2(ra.z + ga.z * v0[2], ra.w + ga.w * v0[3]),
                         pack2(rb.x + gb.x * v1[0], rb.y + gb.y * v1[1]), pack2(rb.z + gb.z * v1[2], rb.w + gb.w * v1[3]));
        }
      }
  }
};
DEVI void phase_gemm2_8(const Params& P, int l, unsigned char* smem_base) {
  EpiX E{P.x, P.ctx, P.X, P.MOD + (size_t)l * 9 * 6144, l};
  gemm8_phase((LAS unsigned char*)smem_base, P.H, P.WoutT + (size_t)l * 1024 * 1024, 1024, (l == 1) ? NL / 256 : NT / 256, 4, E);
  const int c = blockIdx.x;
  if (l == 0 && c >= 32) {
    const int b0 = 12000 + (c - 32) * 93;
    convert_rows_fp6(P, 0, b0 < 32768 ? b0 : 32768, b0 + 93 < 32768 ? b0 + 93 : 32768);
  }
}

struct EpiQP {
  bf16* QP;
  DEVI void operator()(const f32x4 (&acc)[2][2][4][2], const G8Unit& u, int wr, int wc, int fr, int fq) const {
    const int brow = u.pm * 256, bcol = u.pn * 256;
#pragma unroll
    for (int ai = 0; ai < 2; ++ai)
#pragma unroll
      for (int m = 0; m < 4; ++m) {
        const int row = brow + ai * 128 + wr * 64 + m * 16 + fr;
#pragma unroll
        for (int bj = 0; bj < 2; ++bj) {
          const int col = bcol + bj * 128 + wc * 32 + 8 * fq;
          const f32x4 v0 = acc[ai][bj][m][0], v1 = acc[ai][bj][m][1];
          *reinterpret_cast<uint4*>(QP + (size_t)row * 2048 + col) = make_uint4(pack2(v0[0], v0[1]), pack2(v0[2], v0[3]), pack2(v1[0], v1[1]), pack2(v1[2], v1[3]));
        }
      }
  }
};
DEVI void phase_gemm3_8(const Params& P, int l, unsigned char* smem_base) {
  EpiQP E{P.QP};
  gemm8_phase((LAS unsigned char*)smem_base, P.H, P.WpqT + (size_t)l * 2048 * 1024, 1024, (l == 1) ? NL / 256 : NT / 256, 8, E);
  const int c = blockIdx.x;
  if (l == 0 && c >= 64) convert_rows_fp6(P, 1, (c - 64) * 100, (c - 64) * 100 + 100);
}

constexpr int N_PHASES = 2 + 2 * 11;

#ifndef REP_MASK
#define REP_MASK 0
#endif
static_assert(sizeof(Params) % 8 == 0, "Params size");
DEVI Params load_params() {
#if defined(__HIP_DEVICE_COMPILE__)
  typedef const __attribute__((address_space(4))) Params* ParamsCP;
  ParamsCP pp = (ParamsCP)__builtin_amdgcn_kernarg_segment_ptr();
  asm volatile("" : "+s"(pp));
  return *pp;
#else
  return Params{};
#endif
}
__global__ void __launch_bounds__(512, 2) fwd_kernel(Params Pk) {
  extern __shared__ __attribute__((aligned(16))) unsigned char smem_base[];
  volatile LAS unsigned* xst = (volatile LAS unsigned*)(smem_base + SMEM_BYTES);
  if (threadIdx.x == 0) { xst[0] = 0u; xst[1] = 0u; xst[2] = 0u; xst[3] = 0u; }
  __syncthreads();
  XcdBarrier xb = xcd_barrier_post(Pk.bar, xst);
  const int phase_lo = Pk.phase_lo, phase_hi = Pk.phase_hi, coop = Pk.coop;
#define smem (smem_base + VHALF * HALF_LDS)
#define GSYNC(idx) { xcd_barrier(xb); }
#define RUN_PHASE2(idx, call, repcall) \
  if (phase_lo <= (idx) && (idx) <= phase_hi) { { const Params P = load_params(); call; } if (REP_MASK & (1 << (idx))) { GSYNC(1); const Params P = load_params(); repcall; } if (coop && (idx) < phase_hi) GSYNC(idx); }
#define RUN_PHASE(idx, call) RUN_PHASE2(idx, call, call)
  RUN_PHASE(0, phase_prologue(P, smem))
  RUN_PHASE(1, phase_norm(P, 0, 0, NT))
  RUN_PHASE(2, phase_gemm1_8(P, 0, smem_base))
  RUN_PHASE(3, phase_mla_raw(P, 0, smem_base))
  RUN_PHASE(4, { phase_mixA(P, 0, smem); phase_mla_proj(P, 0, smem); phase_hgrn_local(P, 0, smem); })
  RUN_PHASE2(5, phase_attn_scan(P, 0, smem_base), phase_attn_scan(P, 0, smem_base, true))
  RUN_PHASE(6, phase_hgrn_final(P, 0, smem))
  RUN_PHASE(7, phase_gemm2_8(P, 0, smem_base))
  RUN_PHASE(8, phase_norm(P, 0, 1, NT))
  RUN_PHASE(9, phase_gemm3_8(P, 0, smem_base))
  RUN_PHASE(10, phase_route(P, 0, smem))
  RUN_PHASE(11, phase_peer_u(P, 0))
  RUN_PHASE(12, phase_peer(P, 0))
  RUN_PHASE(13, phase_gemm1_8(P, 1, smem_base))
  RUN_PHASE(14, phase_mla_raw(P, 1, smem_base))
  RUN_PHASE(15, { phase_mixA(P, 1, smem); phase_mla_proj(P, 1, smem); phase_hgrn_local(P, 1, smem); })
  RUN_PHASE2(16, phase_attn_scan(P, 1, smem_base), phase_attn_scan(P, 1, smem_base, true))
  RUN_PHASE(17, phase_hgrn_final(P, 1, smem))
  RUN_PHASE(18, phase_gemm2_8(P, 1, smem_base))
  RUN_PHASE(19, phase_norm(P, 1, 1, NL))
  RUN_PHASE(20, phase_gemm3_8(P, 1, smem_base))
  RUN_PHASE(21, phase_route(P, 1, smem))
  RUN_PHASE(22, phase_peer_u(P, 1))
  RUN_PHASE(23, phase_peer(P, 1))
#undef smem
}

extern "C" void kernel_launch(void* const* d_in, const int* in_sizes, int n_in, void* d_out, int out_size, void* d_ws,
                              size_t ws_size, hipStream_t stream) {
  Params p{};
  const float* const* in = reinterpret_cast<const float* const*>(d_in);
  p.x = in[0]; p.c = in[1]; p.ctx = in[2]; p.c_ctx = in[3]; p.ln1_w = in[4]; p.ln2_w = in[5]; p.w_mod = in[6]; p.b_mod = in[7];
  p.w_in = in[8]; p.w_out = in[9]; p.a_norm_w = in[10]; p.a_w_s = in[11]; p.a_b_s = in[12]; p.b_q_norm_w = in[13]; p.b_w_uq = in[14];
  p.b_kv_norm_w = in[15]; p.b_w_ukv = in[16]; p.b_qh_w = in[17]; p.b_kh_w = in[18]; p.c_lb = in[19]; p.c_out_norm_w = in[20];
  p.p_w_q = in[21]; p.p_sub_keys = in[22]; p.p_u = in[23]; p.p_v = in[24];
  p.out = reinterpret_cast<float*>(d_out);
  unsigned char* ws = reinterpret_cast<unsigned char*>(d_ws);
  size_t off = 0;
  auto take = [&](size_t bytes) { unsigned char* r = ws + off; off += (bytes + 255) & ~(size_t)255; return r; };
  p.bar = (unsigned*)take((size_t)XCD_BAR_WORDS * 4);
  p.MOD = (float*)take((size_t)2 * 9 * 6144 * 4);
  p.ROPE = (float*)take((size_t)2048 * 32 * 4);
  p.WinT = (bf16*)take((size_t)2 * DINP * 1024 * 2);
  p.WoutT = (bf16*)take((size_t)2 * 1024 * 1024 * 2);
  p.WpqT = (bf16*)take((size_t)2 * 2048 * 1024 * 2);
  p.WCOMB = (bf16*)take((size_t)2 * 1792 * 256 * 2);
  p.RAW = (bf16*)take((size_t)NT * 1792 * 2);
  p.SK = (bf16*)take((size_t)2 * 16 * 128 * 128 * 2);
  p.AWS = (bf16*)take((size_t)2 * 4 * 128 * 128 * 2);
  p.PU8 = (unsigned char*)take((size_t)2 * 16384 * 576);
  p.PV8 = (unsigned char*)take((size_t)2 * 16384 * 576);
  p.PUS = (float*)take((size_t)2 * 16384 * 4);
  p.PVS = (float*)take((size_t)2 * 16384 * 4);
  p.X = (bf16*)take((size_t)NT * 1024 * 2);
  p.H = (bf16*)take((size_t)NT * 1024 * 2);
  p.Z = (bf16*)take((size_t)NT * DIN * 2);
  p.Q = (bf16*)take((size_t)64 * SEQP * 96 * 2);
  p.K = (bf16*)take((size_t)64 * SEQP * 96 * 2);
  p.VT = (bf16*)take((size_t)64 * 64 * SEQP * 2);
  p.ST = (bf16*)take((size_t)64 * 36 * 4096 * 2);
  p.DEC = (float*)take((size_t)64 * 36 * 64 * 4);
  p.OI = (bf16*)take((size_t)NT * 256 * 2);
  p.WPE = (float*)take((size_t)NT * 128 * 4);
  p.GQF = (bf16*)take((size_t)NT * 256 * 2);
  p.GQB = (bf16*)take((size_t)NT * 256 * 2);
  p.QP = p.Z;
  p.EIDX = (int*)p.Q;
  p.GATE = (float*)p.K;
  if (off > ws_size) { fprintf(stderr, "workspace too small: need %zu have %zu\n", off, ws_size); }
  static int grid_blocks = 0;
  if (!grid_blocks) {
    if (hipFuncSetAttribute((const void*)fwd_kernel, hipFuncAttributeMaxDynamicSharedMemorySize, SMEM_TOTAL) != hipSuccess)
      fprintf(stderr, "hipFuncSetAttribute failed\n");
    int dev = 0, cus = 0, per_cu = 0;
    hipGetDevice(&dev);
    hipDeviceGetAttribute(&cus, hipDeviceAttributeMultiprocessorCount, dev);
    hipOccupancyMaxActiveBlocksPerMultiprocessor(&per_cu, (const void*)fwd_kernel, 512, SMEM_TOTAL);
    if (per_cu > 1) per_cu = 1;
    if (per_cu < 1) { fprintf(stderr, "occupancy query returned %d\n", per_cu); per_cu = 1; }
    grid_blocks = cus * per_cu;
    fprintf(stderr, "grid_blocks=%d (cus=%d per_cu=%d) ws need=%zu have=%zu\n", grid_blocks, cus, per_cu, off, ws_size);
  }
  hipMemsetAsync(p.bar, 0, (size_t)XCD_BAR_WORDS * 4, stream);
  p.coop = 1; p.phase_lo = 0; p.phase_hi = N_PHASES - 1;
  hipLaunchKernelGGL(fwd_kernel, dim3(grid_blocks), dim3(512), SMEM_TOTAL, stream, p);
  const hipError_t e = hipPeekAtLastError();
  if (e != hipSuccess) fprintf(stderr, "launch failed: %s (grid %d)\n", hipGetErrorString(e), grid_blocks);
}
```

```cpp
#include <hip/hip_runtime.h>
#include <hip/hip_cooperative_groups.h>
#include <cstdio>
#include <cstdint>
namespace cg = cooperative_groups;

#define DEVI __device__ __forceinline__

typedef unsigned short bf16;
using bf16x8 = __attribute__((ext_vector_type(8))) __bf16;
using bf16x2 = __attribute__((ext_vector_type(2))) __bf16;
using f32x16 = __attribute__((ext_vector_type(16))) float;
typedef unsigned v6u __attribute__((ext_vector_type(6)));
typedef unsigned v3u __attribute__((ext_vector_type(3)));
typedef float v16f __attribute__((ext_vector_type(16)));
typedef float v32f __attribute__((ext_vector_type(32)));

constexpr int NL = 16384;
constexpr int NT = 18432;
constexpr int DM = 1024;
constexpr int DIN = 2208;
constexpr int DINP = 2304;
constexpr int SEQP = 2304;
constexpr float EPS = 1e-6f;
constexpr int ZC_AU = 0, ZC_AV = 256, ZC_BQ = 512, ZC_BKV = 768, ZC_BKR = 896, ZC_CQ = 928, ZC_CFF = 1184, ZC_CFB = 1440, ZC_CI = 1696, ZC_CG = 1952;
constexpr int SMEM_BYTES = 2 * 80896;
constexpr int SMEM_TOTAL = SMEM_BYTES + 16;

struct Params {
  const float *x, *c, *ctx, *c_ctx, *ln1_w, *ln2_w, *w_mod, *b_mod, *w_in, *w_out, *a_norm_w, *a_w_s, *a_b_s;
  const float *b_q_norm_w, *b_w_uq, *b_kv_norm_w, *b_w_ukv, *b_qh_w, *b_kh_w, *c_lb, *c_out_norm_w, *p_w_q, *p_sub_keys, *p_u, *p_v;
  float* out;
  unsigned* bar;
  float* MOD;
  float* ROPE;
  bf16* WinT;
  bf16* WoutT;
  bf16* WpqT;
  bf16* WCOMB;
  bf16* RAW;
  bf16* SK;
  bf16* AWS;
  unsigned char* PU8;
  unsigned char* PV8;
  float* PUS;
  float* PVS;
  bf16* X;
  bf16* H;
  bf16* Z;
  bf16* Q;
  bf16* K;
  bf16* VT;
  bf16* ST;
  float* DEC;
  bf16* OI;
  float* WPE;
  bf16* GQF;
  bf16* GQB;
  bf16* QP;
  int* EIDX;
  float* GATE;
  int phase_lo, phase_hi, coop, pad0;
};

DEVI float bf2f(bf16 v) { return __uint_as_float(((unsigned)v) << 16); }
DEVI bf16 f2bf(float a) { __bf16 v = (__bf16)a; return __builtin_bit_cast(unsigned short, v); }
DEVI unsigned pack2(float a, float b) { bf16x2 v; v[0] = (__bf16)a; v[1] = (__bf16)b; return __builtin_bit_cast(unsigned, v); }
DEVI float lo2f(unsigned u) { return __uint_as_float(u << 16); }
DEVI float hi2f(unsigned u) { return __uint_as_float(u & 0xffff0000u); }
DEVI f32x16 zero16() { f32x16 z;
#pragma unroll
  for (int i = 0; i < 16; ++i) z[i] = 0.f; return z; }
DEVI f32x16 mfma32(bf16x8 a, bf16x8 b, f32x16 c) { return __builtin_amdgcn_mfma_f32_32x32x16_bf16(a, b, c, 0, 0, 0); }
DEVI bf16x8 ldfrag(const bf16* p) { return *reinterpret_cast<const bf16x8*>(p); }
DEVI int drow(int r, int hh) { return (r & 3) + 8 * (r >> 2) + 4 * hh; }
DEVI int row_of(int b, int p) { return p < 256 ? NL + b * 256 + p : b * 2048 + (p - 256); }
DEVI int batch_of_row(int r) { return r < NL ? (r >> 11) : 8; }
DEVI float wave_sum(float v) {
#pragma unroll
  for (int o = 32; o > 0; o >>= 1) v += __shfl_xor(v, o);
  return v;
}
DEVI float sigmoidf_(float z) { return 1.f / (1.f + __expf(-z)); }


#define XB_TMO      128
#define XB_XCNT(j)  (256  + 64 * (j))
#define XB_XSUB(j)  (1280 + 64 * (j))
#define XB_XGEN(j)  (2304 + 64 * (j))
#define XB_TOP      3328
#define XB_TOPGEN   3392
#define XCD_BAR_WORDS 3456
#define XB_SPIN_CAP (1u << 22)
#define LAS __attribute__((address_space(3)))
DEVI unsigned xb_ld(unsigned* p)              { return __hip_atomic_load(p, __ATOMIC_RELAXED, __HIP_MEMORY_SCOPE_AGENT); }
DEVI unsigned xb_add(unsigned* p, unsigned v) { return __hip_atomic_fetch_add(p, v, __ATOMIC_RELAXED, __HIP_MEMORY_SCOPE_AGENT); }
DEVI unsigned xb_xcc_id() { return (unsigned)__builtin_amdgcn_s_getreg((3 << 11) | 20) & 0xFu; }
#define XB_SPIN(cond, bar) do { unsigned _sp = 0; while (cond) { __builtin_amdgcn_s_sleep(1); \
    if ((++_sp & 255u) == 0u) { if (xb_ld(&(bar)[XB_TMO])) break; if (_sp > XB_SPIN_CAP) { atomicAdd(&(bar)[XB_TMO], 1u); break; } } } } while (0)
struct XcdBarrier { unsigned* bar; unsigned x; volatile LAS unsigned* st; };
DEVI XcdBarrier xcd_barrier_post(unsigned* bar, volatile LAS unsigned* st) {
  XcdBarrier b; b.bar = bar; b.x = xb_xcc_id(); b.st = st;
  if (threadIdx.x == 0) (void)xb_add(&bar[XB_XCNT(b.x)], 1u);
  return b;
}
DEVI void xcd_barrier_complete(unsigned* bar, unsigned x, unsigned& nloc, unsigned& nx) {
  const unsigned G = gridDim.x * gridDim.y * gridDim.z;
  unsigned sum, cnt, mine, sp = 0u;
  for (;;) {
    sum = 0u; cnt = 0u; mine = 0u;
#pragma unroll
    for (unsigned j = 0; j < 16; ++j) { const unsigned c = xb_ld(&bar[XB_XCNT(j)]); sum += c; cnt += (c > 0u) ? 1u : 0u; mine = (j == x) ? c : mine; }
    if (sum == G) break;
    __builtin_amdgcn_s_sleep(1);
    if ((++sp & 255u) == 0u) { if (xb_ld(&bar[XB_TMO])) break; if (sp > XB_SPIN_CAP) { atomicAdd(&bar[XB_TMO], 1u); break; } }
  }
  nloc = mine > 0u ? mine : 1u; nx = cnt > 0u ? cnt : 1u;
}
DEVI void xcd_barrier(const XcdBarrier& b) {
  asm volatile("s_waitcnt vmcnt(0)" ::: "memory");
  __syncthreads();
  if (threadIdx.x == 0) {
    unsigned* bar = b.bar;
    __builtin_amdgcn_s_waitcnt(0);
    unsigned nloc = b.st[0], nx = b.st[1];
    if (nloc == 0u) { xcd_barrier_complete(bar, b.x, nloc, nx); b.st[0] = nloc; b.st[1] = nx; }
    const unsigned old = xb_add(&bar[XB_XSUB(b.x)], 1u);
    const unsigned gen = old / nloc;
    if (old + 1u == (gen + 1u) * nloc) {
      __builtin_amdgcn_fence(__ATOMIC_RELEASE, "agent");
      asm volatile("s_waitcnt vmcnt(0)" ::: "memory");
      const unsigned og = xb_add(&bar[XB_TOP], 1u);
      const unsigned tg = og / nx;
      if (og + 1u == (tg + 1u) * nx) xb_add(&bar[XB_TOPGEN], 1u);
      else XB_SPIN(xb_ld(&bar[XB_TOPGEN]) == tg, bar);
      __builtin_amdgcn_fence(__ATOMIC_ACQUIRE, "agent");
      xb_add(&bar[XB_XGEN(b.x)], 1u);
      asm volatile("s_waitcnt vmcnt(0)" ::: "memory");
    } else {
      XB_SPIN(xb_ld(&bar[XB_XGEN(b.x)]) == gen, bar);
      __builtin_amdgcn_fence(__ATOMIC_ACQUIRE, "agent");
      asm volatile("s_waitcnt vmcnt(0)" ::: "memory");
    }
  }
  __syncthreads();
}

#define VHALF ((int)__builtin_amdgcn_readfirstlane((int)(threadIdx.x >> 8)))
#define TIDX ((int)(threadIdx.x & 255))
#define VBID ((int)(blockIdx.x * 2 + VHALF))
#define NVB ((int)(gridDim.x * 2))
constexpr int HALF_LDS = 80896;

DEVI void phase_mod(const Params& P, unsigned char* smem) {
  const int tid = TIDX;
  float* s = (float*)smem;
  float* red = s + 9 * 1024;
  for (int item = VBID; item < 192; item += NVB) {
    const int l = item / 96, j = item % 96;
    __syncthreads();
    for (int i = tid; i < 9 * 1024; i += 256) {
      int bi = i >> 10, k = i & 1023;
      float v = bi < 8 ? P.c[bi * 1024 + k] : P.c_ctx[k];
      s[i] = v * sigmoidf_(v);
    }
    __syncthreads();
    const int c4 = tid & 15, kg = tid >> 4;
    float acc[9][4];
#pragma unroll
    for (int bi = 0; bi < 9; ++bi) { acc[bi][0] = acc[bi][1] = acc[bi][2] = acc[bi][3] = 0.f; }
    const float* w = P.w_mod + (size_t)l * 1024 * 6144 + j * 64 + c4 * 4;
#pragma unroll 4
    for (int kk = 0; kk < 64; ++kk) {
      const int k = kg * 64 + kk;
      const float4 w4 = *reinterpret_cast<const float4*>(w + (size_t)k * 6144);
#pragma unroll
      for (int bi = 0; bi < 9; ++bi) {
        const float sv = s[bi * 1024 + k];
        acc[bi][0] += sv * w4.x; acc[bi][1] += sv * w4.y; acc[bi][2] += sv * w4.z; acc[bi][3] += sv * w4.w;
      }
    }
#pragma unroll
    for (int bi = 0; bi < 9; ++bi)
#pragma unroll
      for (int e = 0; e < 4; ++e) red[(kg * 9 + bi) * 64 + c4 * 4 + e] = acc[bi][e];
    __syncthreads();
    for (int o = tid; o < 576; o += 256) {
      const int bi = o >> 6, cc = o & 63;
      float sum = 0.f;
#pragma unroll
      for (int g = 0; g < 16; ++g) sum += red[(g * 9 + bi) * 64 + cc];
      P.MOD[(size_t)(l * 9 + bi) * 6144 + j * 64 + cc] = sum + P.b_mod[l * 6144 + j * 64 + cc];
    }
  }
}

DEVI void conv_T_tile(const float* __restrict__ src, int N, bf16* __restrict__ dst, int Kd, int k0, int n0,
                      const float* __restrict__ kscale, float* tile) {
  const int tid = TIDX;
  __syncthreads();
  for (int e = tid; e < 4096; e += 256) {
    const int i = e >> 6, j = e & 63, n = n0 + j;
    float v = (n < N) ? src[(size_t)(k0 + i) * N + n] : 0.f;
    if (kscale) v *= kscale[k0 + i];
    tile[i * 65 + j] = v;
  }
  __syncthreads();
  for (int e = tid; e < 2048; e += 256) {
    const int j = e >> 5, i2 = (e & 31) * 2;
    const unsigned pk = pack2(tile[i2 * 65 + j], tile[(i2 + 1) * 65 + j]);
    *reinterpret_cast<unsigned*>(&dst[(size_t)(n0 + j) * Kd + k0 + i2]) = pk;
  }
}

DEVI void conv_straight(const float* __restrict__ src, bf16* __restrict__ dst, size_t n8) {
  const size_t stride = (size_t)NVB * 256;
  for (size_t i = (size_t)VBID * 256 + TIDX; i < n8; i += stride) {
    const float4 a = reinterpret_cast<const float4*>(src)[2 * i];
    const float4 b = reinterpret_cast<const float4*>(src)[2 * i + 1];
    uint4 o; o.x = pack2(a.x, a.y); o.y = pack2(a.z, a.w); o.z = pack2(b.x, b.y); o.w = pack2(b.z, b.w);
    reinterpret_cast<uint4*>(dst)[i] = o;
  }
}

DEVI void convert_rows_fp6(const Params& P, int L, int i0, int i1) {
  const int lane = threadIdx.x & 63, half = lane >> 5, l32 = lane & 31;
  const int wv = threadIdx.x >> 6;
  for (int ib = i0 + wv * 2; ib < i1; ib += 16) {
    int i = ib + half; const bool live = i < i1; if (!live) i = i1 - 1;
    const int table = i >> 14, lr = L * 16384 + (i & 16383);
    const float* src = (table ? P.p_v : P.p_u) + (size_t)lr * 1024 + l32 * 32;
    float4 a[8];
    float m = 0.f;
#pragma unroll
    for (int q = 0; q < 8; ++q) {
      a[q] = *reinterpret_cast<const float4*>(src + q * 4);
      m = fmaxf(m, fmaxf(fmaxf(fabsf(a[q].x), fabsf(a[q].y)), fmaxf(fabsf(a[q].z), fabsf(a[q].w))));
    }
    const unsigned sb = (__float_as_uint(fmaxf(m, 1e-30f) * (1.f / 6.f)) + 0xffffu) >> 16;
    const float inv = 1.f / __uint_as_float(sb << 16);
    unsigned pk[4];
#pragma unroll
    for (int w = 0; w < 4; ++w) {
      unsigned word = 0u;
#pragma unroll
      for (int e = 0; e < 8; ++e) {
        const int idx = w * 8 + e;
        const float4 q4 = a[idx >> 2];
        const float xv = ((idx & 3) == 0 ? q4.x : (idx & 3) == 1 ? q4.y : (idx & 3) == 2 ? q4.z : q4.w) * inv;
        const float av = fabsf(xv);
        unsigned ci = (av > 0.25f) + (av > 0.75f) + (av > 1.25f) + (av > 1.75f) + (av > 2.5f) + (av > 3.5f) + (av > 5.f);
        ci |= (xv < 0.f) ? 8u : 0u;
        word |= ci << (4 * e);
      }
      pk[w] = word;
    }
    unsigned char* rowp = (table ? P.PV8 : P.PU8) + (size_t)lr * 576;
    if (live) {
      *reinterpret_cast<uint4*>(rowp + l32 * 16) = make_uint4(pk[0], pk[1], pk[2], pk[3]);
      *reinterpret_cast<unsigned short*>(rowp + 512 + l32 * 2) = (unsigned short)sb;
    }
  }
}

DEVI void phase_prologue(const Params& P, unsigned char* smem) {
  phase_mod(P, smem);
  float* tile = (float*)smem;
  for (int it = VBID; it < 2 * 1424; it += NVB) {
    const int l = it / 1424; int r = it % 1424;
    if (r < 576) { conv_T_tile(P.w_in + (size_t)l * 1024 * DIN, DIN, P.WinT + (size_t)l * DINP * 1024, 1024, (r % 16) * 64, (r / 16) * 64, nullptr, tile); continue; }
    r -= 576;
    if (r < 256) { conv_T_tile(P.w_out + (size_t)l * 1024 * 1024, 1024, P.WoutT + (size_t)l * 1024 * 1024, 1024, (r % 16) * 64, (r / 16) * 64, nullptr, tile); continue; }
    r -= 256;
    if (r < 512) { conv_T_tile(P.p_w_q + (size_t)l * 1024 * 2048, 2048, P.WpqT + (size_t)l * 2048 * 1024, 1024, (r % 16) * 64, (r / 16) * 64, nullptr, tile); continue; }
    r -= 512;
    if (r < 48) { conv_T_tile(P.b_w_uq + (size_t)l * 256 * 768, 768, P.WCOMB + (size_t)l * 1792 * 256, 256, (r % 4) * 64, (r / 4) * 64, P.b_q_norm_w + l * 256, tile); continue; }
    r -= 48;
    conv_T_tile(P.b_w_ukv + (size_t)l * 128 * 1024, 1024, P.WCOMB + (size_t)l * 1792 * 256 + 768 * 256, 256, (r % 2) * 64, (r / 2) * 64, P.b_kv_norm_w + l * 128, tile);
  }
  for (int i = VBID * 256 + TIDX; i < 2 * 1024 * 16; i += NVB * 256) {
    const int l2 = i >> 14, rr = (i >> 4) & 1023, cc = i & 15;
    *reinterpret_cast<uint4*>(P.WCOMB + (size_t)l2 * 1792 * 256 + (size_t)(768 + rr) * 256 + 128 + cc * 8) = make_uint4(0u, 0u, 0u, 0u);
  }
  conv_straight(P.p_sub_keys, P.SK, (size_t)2 * 16 * 128 * 128 / 8);
  conv_straight(P.a_w_s, P.AWS, (size_t)2 * 4 * 128 * 128 / 8);
  for (int i = VBID * 256 + TIDX; i < 2048 * 16; i += NVB * 256) {
    const int t = i >> 4, a = (i >> 3) & 1, f = i & 7;
    const float inv = powf(10000.f, -(float)f / 8.f);
    const float pos = a ? (float)(t & 63) : (float)(t >> 6);
    const float ang = pos * inv;
    P.ROPE[t * 32 + a * 8 + f] = cosf(ang);
    P.ROPE[t * 32 + 16 + a * 8 + f] = sinf(ang);
  }
}

DEVI void phase_norm(const Params& P, int l, int which, int nrows) {
  const int lane = TIDX & 63;
  const int gw = VBID * 4 + (TIDX >> 6), nw = NVB * 4;
  const float* lnw = (which == 0 ? P.ln1_w : P.ln2_w) + l * 1024;
  for (int r = gw; r < nrows; r += nw) {
    const float* mod = P.MOD + (size_t)(l * 9 + batch_of_row(r)) * 6144 + which * 3072;
    float4 v[4];
    float ss = 0.f;
    if (which == 0 && l == 0) {
      const float* src = r < NL ? P.x + (size_t)r * 1024 : P.ctx + (size_t)(r - NL) * 1024;
#pragma unroll
      for (int i = 0; i < 4; ++i) v[i] = *reinterpret_cast<const float4*>(src + i * 256 + lane * 4);
    } else {
      const bf16* src = P.X + (size_t)r * 1024;
#pragma unroll
      for (int i = 0; i < 4; ++i) {
        const uint2 u = *reinterpret_cast<const uint2*>(src + i * 256 + lane * 4);
        v[i] = make_float4(lo2f(u.x), hi2f(u.x), lo2f(u.y), hi2f(u.y));
      }
    }
#pragma unroll
    for (int i = 0; i < 4; ++i) ss += v[i].x * v[i].x + v[i].y * v[i].y + v[i].z * v[i].z + v[i].w * v[i].w;
    ss = wave_sum(ss);
    const float rr = rsqrtf(ss * (1.f / 1024.f) + EPS);
#pragma unroll
    for (int i = 0; i < 4; ++i) {
      const int d = i * 256 + lane * 4;
      const float4 w = *reinterpret_cast<const float4*>(lnw + d);
      const float4 sh = *reinterpret_cast<const float4*>(mod + d);
      const float4 sc = *reinterpret_cast<const float4*>(mod + 1024 + d);
      const float o0 = v[i].x * rr * w.x * (1.f + sc.x) + sh.x;
      const float o1 = v[i].y * rr * w.y * (1.f + sc.y) + sh.y;
      const float o2 = v[i].z * rr * w.z * (1.f + sc.z) + sh.z;
      const float o3 = v[i].w * rr * w.w * (1.f + sc.w) + sh.w;
      uint2 o; o.x = pack2(o0, o1); o.y = pack2(o2, o3);
      *reinterpret_cast<uint2*>(P.H + (size_t)r * 1024 + d) = o;
    }
  }
}

template <int BM, int BN, int BK, int WM, int WN>
struct Gemm {
  static constexpr int LDK = BK + 8;
  static constexpr int TM = BM / WM / 32, TN = BN / WN / 32;
  static constexpr int CPR = BK / 8;
  static constexpr int NA = BM * CPR / 256, NB = BN * CPR / 256;
  static constexpr int A_BYTES = BM * LDK * 2, B_BYTES = BN * LDK * 2;
  static constexpr int STAGE_BYTES = A_BYTES + B_BYTES;
  static constexpr int SMEM = 2 * STAGE_BYTES;

  static DEVI void run(const bf16* __restrict__ A, int lda, const bf16* __restrict__ BT, int ldb, int K,
                       unsigned char* smem, f32x16 (&acc)[TM][TN]) {
    const int tid = TIDX, lane = tid & 63, wave = tid >> 6;
    const int wm = wave / WN, wn = wave % WN;
    const int l31 = lane & 31, hh = lane >> 5;
#pragma unroll
    for (int i = 0; i < TM; ++i)
#pragma unroll
      for (int j = 0; j < TN; ++j) acc[i][j] = zero16();
    uint4 ra[NA], rb[NB];
    const int nk = K / BK;
    auto gload = [&](int kt) {
#pragma unroll
      for (int i = 0; i < NA; ++i) { const int ch = tid + i * 256, row = ch / CPR, cc = ch % CPR;
        ra[i] = *reinterpret_cast<const uint4*>(A + (size_t)row * lda + kt * BK + cc * 8); }
#pragma unroll
      for (int i = 0; i < NB; ++i) { const int ch = tid + i * 256, row = ch / CPR, cc = ch % CPR;
        rb[i] = *reinterpret_cast<const uint4*>(BT + (size_t)row * ldb + kt * BK + cc * 8); }
    };
    auto swrite = [&](int buf) {
      bf16* sA = reinterpret_cast<bf16*>(smem + buf * STAGE_BYTES);
      bf16* sB = reinterpret_cast<bf16*>(smem + buf * STAGE_BYTES + A_BYTES);
#pragma unroll
      for (int i = 0; i < NA; ++i) { const int ch = tid + i * 256, row = ch / CPR, cc = ch % CPR;
        *reinterpret_cast<uint4*>(sA + row * LDK + cc * 8) = ra[i]; }
#pragma unroll
      for (int i = 0; i < NB; ++i) { const int ch = tid + i * 256, row = ch / CPR, cc = ch % CPR;
        *reinterpret_cast<uint4*>(sB + row * LDK + cc * 8) = rb[i]; }
    };
    __syncthreads();
    gload(0);
    swrite(0);
    __syncthreads();
    for (int kt = 0; kt < nk; ++kt) {
      const int cur = kt & 1;
      if (kt + 1 < nk) gload(kt + 1);
      const bf16* sA = reinterpret_cast<const bf16*>(smem + cur * STAGE_BYTES);
      const bf16* sB = reinterpret_cast<const bf16*>(smem + cur * STAGE_BYTES + A_BYTES);
#pragma unroll
      for (int ks = 0; ks < BK / 16; ++ks) {
        bf16x8 af[TM], bfr[TN];
#pragma unroll
        for (int i = 0; i < TM; ++i) af[i] = ldfrag(sA + (wm * (BM / WM) + i * 32 + l31) * LDK + ks * 16 + hh * 8);
#pragma unroll
        for (int j = 0; j < TN; ++j) bfr[j] = ldfrag(sB + (wn * (BN / WN) + j * 32 + l31) * LDK + ks * 16 + hh * 8);
#pragma unroll
        for (int i = 0; i < TM; ++i)
#pragma unroll
          for (int j = 0; j < TN; ++j) acc[i][j] = mfma32(af[i], bfr[j], acc[i][j]);
      }
      if (kt + 1 < nk) swrite(cur ^ 1);
      __syncthreads();
    }
  }
};

DEVI void phase_gemm1(const Params& P, int l, unsigned char* smem) {
  using G = Gemm<128, 128, 64, 2, 2>;
  const int lane = TIDX & 63, wave = TIDX >> 6, wm = wave >> 1, wn = wave & 1, l31 = lane & 31, hh = lane >> 5;
  const bf16* W = P.WinT + (size_t)l * DINP * 1024;
  for (int t = VBID; t < 144 * 18; t += NVB) {
    const int mt = t / 18, nt = t % 18;
    f32x16 acc[2][2];
    G::run(P.H + (size_t)mt * 128 * 1024, 1024, W + (size_t)nt * 128 * 1024, 1024, 1024, smem, acc);
#pragma unroll
    for (int i = 0; i < 2; ++i)
#pragma unroll
      for (int j = 0; j < 2; ++j) {
        const int col = nt * 128 + wn * 64 + j * 32 + l31;
        if (col < DIN) {
#pragma unroll
          for (int r = 0; r < 16; ++r) {
            const int row = mt * 128 + wm * 64 + i * 32 + drow(r, hh);
            P.Z[(size_t)row * DIN + col] = f2bf(acc[i][j][r]);
          }
        }
      }
  }
}

DEVI void phase_gemm2(const Params& P, int l, unsigned char* smem) {
  using G = Gemm<128, 128, 64, 2, 2>;
  const int lane = TIDX & 63, wave = TIDX >> 6, wm = wave >> 1, wn = wave & 1, l31 = lane & 31, hh = lane >> 5;
  const bf16* W = P.WoutT + (size_t)l * 1024 * 1024;
  const int mtiles = (l == 1) ? 128 : 144;
  for (int t = VBID; t < mtiles * 8; t += NVB) {
    const int mt = t / 8, nt = t % 8;
    f32x16 acc[2][2];
    G::run(P.H + (size_t)mt * 128 * 1024, 1024, W + (size_t)nt * 128 * 1024, 1024, 1024, smem, acc);
    const int bi = batch_of_row(mt * 128);
    const float* gate = P.MOD + (size_t)(l * 9 + bi) * 6144 + 2048;
#pragma unroll
    for (int i = 0; i < 2; ++i)
#pragma unroll
      for (int j = 0; j < 2; ++j) {
        const int col = nt * 128 + wn * 64 + j * 32 + l31;
        const float g = gate[col];
#pragma unroll
        for (int r = 0; r < 16; ++r) {
          const int row = mt * 128 + wm * 64 + i * 32 + drow(r, hh);
          float res;
          if (l == 0) res = row < NL ? P.x[(size_t)row * 1024 + col] : P.ctx[(size_t)(row - NL) * 1024 + col];
          else res = bf2f(P.X[(size_t)row * 1024 + col]);
          P.X[(size_t)row * 1024 + col] = f2bf(res + g * acc[i][j][r]);
        }
      }
  }
}

DEVI void phase_mixA(const Params& P, int l, unsigned char* smem) {
  const int tid = TIDX, lane = tid & 63, wave = tid >> 6, l31 = lane & 31, hh = lane >> 5;
  bf16* VNT = reinterpret_cast<bf16*>(smem);
  constexpr int LDV = 136;
  const int nseg = (l == 1) ? 16 : 18;
  const int seg0 = (l == 1) ? 2 : 0;
  for (int it = VBID; it < 8 * nseg * 4; it += NVB) {
    const int a = it & 3; const int sj = (it >> 2) % nseg + seg0; const int b = (it >> 2) / nseg;
    const int p0 = sj * 128;
    __syncthreads();
    {
      const int q = tid >> 1, half = tid & 1;
      const int row = row_of(b, p0 + q);
      const bf16* src = P.Z + (size_t)row * DIN + ZC_AV + a * 64 + half * 32;
      float v[32];
      float ss = 0.f;
#pragma unroll
      for (int i = 0; i < 4; ++i) {
        const uint4 u = *reinterpret_cast<const uint4*>(src + i * 8);
        v[i * 8 + 0] = lo2f(u.x); v[i * 8 + 1] = hi2f(u.x); v[i * 8 + 2] = lo2f(u.y); v[i * 8 + 3] = hi2f(u.y);
        v[i * 8 + 4] = lo2f(u.z); v[i * 8 + 5] = hi2f(u.z); v[i * 8 + 6] = lo2f(u.w); v[i * 8 + 7] = hi2f(u.w);
      }
#pragma unroll
      for (int i = 0; i < 32; ++i) ss += v[i] * v[i];
      ss += __shfl_xor(ss, 1);
      const float rr = rsqrtf(ss * (1.f / 64.f) + EPS);
      const float* nw = P.a_norm_w + l * 256 + a * 64 + half * 32;
#pragma unroll
      for (int i = 0; i < 32; ++i) VNT[(half * 32 + i) * LDV + q] = f2bf(v[i] * rr * nw[i]);
    }
    __syncthreads();
    f32x16 acc[2]; acc[0] = zero16(); acc[1] = zero16();
    const bf16* Aw = P.AWS + (size_t)(l * 4 + a) * 128 * 128 + (size_t)(wave * 32 + l31) * 128;
#pragma unroll
    for (int ks = 0; ks < 8; ++ks) {
      const bf16x8 af = ldfrag(Aw + ks * 16 + hh * 8);
#pragma unroll
      for (int j = 0; j < 2; ++j) {
        const bf16x8 bfr = ldfrag(VNT + (j * 32 + l31) * LDV + ks * 16 + hh * 8);
        acc[j] = mfma32(af, bfr, acc[j]);
      }
    }
    const float* bs = P.a_b_s + (l * 4 + a) * 128;
#pragma unroll
    for (int j = 0; j < 2; ++j)
#pragma unroll
      for (int r = 0; r < 16; ++r) {
        const int p = wave * 32 + drow(r, hh);
        const int row = row_of(b, p0 + p);
        const int col = a * 64 + j * 32 + l31;
        const float u = bf2f(P.Z[(size_t)row * DIN + ZC_AU + col]);
        P.H[(size_t)row * 1024 + col] = f2bf(u * (acc[j][r] + bs[p]));
      }
  }
}

DEVI void mla_norm_rope_store(const Params& P, const float* T, const float* nw, bool rope, float oscale,
                              bf16* dstbase  , int pos0, int tlat0) {
  const int tid = TIDX, tok = tid >> 1, half = tid & 1;
  float v[48];
  float ss = 0.f;
#pragma unroll
  for (int i = 0; i < 48; ++i) { v[i] = T[tok * 97 + half * 48 + i]; ss += v[i] * v[i]; }
  ss += __shfl_xor(ss, 1);
  const float rr = rsqrtf(ss * (1.f / 96.f) + EPS);
#pragma unroll
  for (int i = 0; i < 48; ++i) v[i] = v[i] * rr * nw[half * 48 + i];
  if (rope && half == 1) {
    const float* cs = P.ROPE + (size_t)(tlat0 + tok) * 32;
#pragma unroll
    for (int a = 0; a < 2; ++a)
#pragma unroll
      for (int f = 0; f < 8; ++f) {
        const float x1 = v[16 + a * 16 + f], x2 = v[16 + a * 16 + 8 + f];
        const float c = cs[a * 8 + f], s = cs[16 + a * 8 + f];
        v[16 + a * 16 + f] = x1 * c - x2 * s;
        v[16 + a * 16 + 8 + f] = x2 * c + x1 * s;
      }
  }
  bf16* dst = dstbase + (size_t)(pos0 + tok) * 96 + half * 48;
#pragma unroll
  for (int i = 0; i < 6; ++i) {
    uint4 o;
    o.x = pack2(v[i * 8 + 0] * oscale, v[i * 8 + 1] * oscale); o.y = pack2(v[i * 8 + 2] * oscale, v[i * 8 + 3] * oscale);
    o.z = pack2(v[i * 8 + 4] * oscale, v[i * 8 + 5] * oscale); o.w = pack2(v[i * 8 + 6] * oscale, v[i * 8 + 7] * oscale);
    *reinterpret_cast<uint4*>(dst + i * 8) = o;
  }
}

DEVI void phase_mla_proj(const Params& P, int l, unsigned char* smem) {
  const int tid = TIDX;
  float* T = reinterpret_cast<float*>(smem);
  bf16* TV = reinterpret_cast<bf16*>(smem + 128 * 97 * 4);
  const float qscale = 0.10206207261596577f * 1.4426950408889634f;
  const int tok = tid >> 1, half = tid & 1;
  for (int it = (VBID + NVB - 64) % NVB; it < 144 * 8; it += NVB) {
    const int h = it & 7;
    const int m0 = (it >> 3) * 128;
    const bool lat = m0 < NL;
    const int b = lat ? (m0 >> 11) : ((m0 - NL) >> 8);
    const int pos0 = lat ? 256 + (m0 & 2047) : ((m0 - NL) & 255);
    const int tlat0 = lat ? (m0 & 2047) : 0;
    const bool doq = lat || (l == 0);
    const bf16* zr = P.Z + (size_t)(m0 + tok) * DIN;
    const bf16* rr = P.RAW + (size_t)(m0 + tok) * 1792;
    __syncthreads();
    float rskv, rsq = 0.f;
    {
      float ss = 0.f;
#pragma unroll
      for (int i = 0; i < 8; ++i) {
        const uint4 u = *reinterpret_cast<const uint4*>(zr + ZC_BKV + half * 64 + i * 8);
        ss += lo2f(u.x) * lo2f(u.x) + hi2f(u.x) * hi2f(u.x) + lo2f(u.y) * lo2f(u.y) + hi2f(u.y) * hi2f(u.y)
            + lo2f(u.z) * lo2f(u.z) + hi2f(u.z) * hi2f(u.z) + lo2f(u.w) * lo2f(u.w) + hi2f(u.w) * hi2f(u.w);
      }
      ss += __shfl_xor(ss, 1);
      rskv = rsqrtf(ss * (1.f / 128.f) + EPS);
      if (doq) {
        float sq = 0.f;
#pragma unroll
        for (int i = 0; i < 16; ++i) {
          const uint4 u = *reinterpret_cast<const uint4*>(zr + ZC_BQ + half * 128 + i * 8);
          sq += lo2f(u.x) * lo2f(u.x) + hi2f(u.x) * hi2f(u.x) + lo2f(u.y) * lo2f(u.y) + hi2f(u.y) * hi2f(u.y)
              + lo2f(u.z) * lo2f(u.z) + hi2f(u.z) * hi2f(u.z) + lo2f(u.w) * lo2f(u.w) + hi2f(u.w) * hi2f(u.w);
        }
        sq += __shfl_xor(sq, 1);
        rsq = rsqrtf(sq * (1.f / 256.f) + EPS);
      }
    }
    {
      const bf16* kn = rr + 768 + h * 128 + half * 32;
      const bf16* vv = rr + 768 + h * 128 + 64 + half * 32;
#pragma unroll
      for (int i = 0; i < 4; ++i) {
        const uint4 u = *reinterpret_cast<const uint4*>(kn + i * 8);
        float* tp = T + tok * 97 + half * 32 + i * 8;
        tp[0] = lo2f(u.x) * rskv; tp[1] = hi2f(u.x) * rskv; tp[2] = lo2f(u.y) * rskv; tp[3] = hi2f(u.y) * rskv;
        tp[4] = lo2f(u.z) * rskv; tp[5] = hi2f(u.z) * rskv; tp[6] = lo2f(u.w) * rskv; tp[7] = hi2f(u.w) * rskv;
        const uint4 w = *reinterpret_cast<const uint4*>(vv + i * 8);
        bf16* vp = TV + (half * 32 + i * 8) * 136 + tok;
        vp[0 * 136] = f2bf(lo2f(w.x) * rskv); vp[1 * 136] = f2bf(hi2f(w.x) * rskv); vp[2 * 136] = f2bf(lo2f(w.y) * rskv); vp[3 * 136] = f2bf(hi2f(w.y) * rskv);
        vp[4 * 136] = f2bf(lo2f(w.z) * rskv); vp[5 * 136] = f2bf(hi2f(w.z) * rskv); vp[6 * 136] = f2bf(lo2f(w.w) * rskv); vp[7 * 136] = f2bf(hi2f(w.w) * rskv);
      }
#pragma unroll
      for (int i = 0; i < 2; ++i) {
        const uint4 u = *reinterpret_cast<const uint4*>(zr + ZC_BKR + half * 16 + i * 8);
        float* tp = T + tok * 97 + 64 + half * 16 + i * 8;
        tp[0] = lo2f(u.x); tp[1] = hi2f(u.x); tp[2] = lo2f(u.y); tp[3] = hi2f(u.y);
        tp[4] = lo2f(u.z); tp[5] = hi2f(u.z); tp[6] = lo2f(u.w); tp[7] = hi2f(u.w);
      }
    }
    __syncthreads();
    mla_norm_rope_store(P, T, P.b_kh_w + l * 96, lat, 1.f, P.K + (size_t)(b * 8 + h) * SEQP * 96, pos0, tlat0);
    {
      const int d = tid >> 2, qtr = tid & 3;
      bf16* dst = P.VT + ((size_t)(b * 8 + h) * 64 + d) * SEQP + pos0 + qtr * 32;
      const bf16* src = TV + d * 136 + qtr * 32;
#pragma unroll
      for (int i = 0; i < 4; ++i) *reinterpret_cast<uint4*>(dst + i * 8) = *reinterpret_cast<const uint4*>(src + i * 8);
    }
    if (doq) {
      __syncthreads();
      const bf16* qq = rr + h * 96 + half * 48;
#pragma unroll
      for (int i = 0; i < 6; ++i) {
        const uint4 u = *reinterpret_cast<const uint4*>(qq + i * 8);
        float* tp = T + tok * 97 + half * 48 + i * 8;
        tp[0] = lo2f(u.x) * rsq; tp[1] = hi2f(u.x) * rsq; tp[2] = lo2f(u.y) * rsq; tp[3] = hi2f(u.y) * rsq;
        tp[4] = lo2f(u.z) * rsq; tp[5] = hi2f(u.z) * rsq; tp[6] = lo2f(u.w) * rsq; tp[7] = hi2f(u.w) * rsq;
      }
      __syncthreads();
      mla_norm_rope_store(P, T, P.b_qh_w + l * 96, lat, qscale, P.Q + (size_t)(b * 8 + h) * SEQP * 96, pos0, tlat0);
    }
  }
}

DEVI void hgrn_load(const Params& P, int l, int b, int hd, int c, float* BF, float* RB, float* SEG,
                    float (&q)[16], float (&kf)[16], float (&kb)[16], float (&v)[16], bool need_kv) {
  const int tid = TIDX, t = tid >> 2, k0 = (tid & 3) * 16;
  const int row = row_of(b, c * 64 + t);
  const bf16* z = P.Z + (size_t)row * DIN + hd * 64 + k0;
  float zf[16], zb[16];
#pragma unroll
  for (int i = 0; i < 2; ++i) {
    const uint4 uq = *reinterpret_cast<const uint4*>(z + ZC_CQ + i * 8);
    const uint4 uf = *reinterpret_cast<const uint4*>(z + ZC_CFF + i * 8);
    const uint4 ub = *reinterpret_cast<const uint4*>(z + ZC_CFB + i * 8);
    q[i * 8 + 0] = lo2f(uq.x); q[i * 8 + 1] = hi2f(uq.x); q[i * 8 + 2] = lo2f(uq.y); q[i * 8 + 3] = hi2f(uq.y);
    q[i * 8 + 4] = lo2f(uq.z); q[i * 8 + 5] = hi2f(uq.z); q[i * 8 + 6] = lo2f(uq.w); q[i * 8 + 7] = hi2f(uq.w);
    zf[i * 8 + 0] = lo2f(uf.x); zf[i * 8 + 1] = hi2f(uf.x); zf[i * 8 + 2] = lo2f(uf.y); zf[i * 8 + 3] = hi2f(uf.y);
    zf[i * 8 + 4] = lo2f(uf.z); zf[i * 8 + 5] = hi2f(uf.z); zf[i * 8 + 6] = lo2f(uf.w); zf[i * 8 + 7] = hi2f(uf.w);
    zb[i * 8 + 0] = lo2f(ub.x); zb[i * 8 + 1] = hi2f(ub.x); zb[i * 8 + 2] = lo2f(ub.y); zb[i * 8 + 3] = hi2f(ub.y);
    zb[i * 8 + 4] = lo2f(ub.z); zb[i * 8 + 5] = hi2f(ub.z); zb[i * 8 + 6] = lo2f(ub.w); zb[i * 8 + 7] = hi2f(ub.w);
    if (need_kv) {
      const uint4 uv = *reinterpret_cast<const uint4*>(z + ZC_CI + i * 8);
      v[i * 8 + 0] = lo2f(uv.x); v[i * 8 + 1] = hi2f(uv.x); v[i * 8 + 2] = lo2f(uv.y); v[i * 8 + 3] = hi2f(uv.y);
      v[i * 8 + 4] = lo2f(uv.z); v[i * 8 + 5] = hi2f(uv.z); v[i * 8 + 6] = lo2f(uv.w); v[i * 8 + 7] = hi2f(uv.w);
    }
  }
#pragma unroll
  for (int i = 0; i < 16; ++i) {
    q[i] *= 0.125f;
    float lbf = 0.f;
    if (l == 1) { const int ch = hd * 64 + k0 + i; lbf = sigmoidf_(P.c_lb[512 + ch] - P.c_lb[ch]); }
    const float zz = zf[i];
    const float e = __expf(-fabsf(zz));
    const float sp = __builtin_amdgcn_rcpf(1.f + e);
    const float sig = zz >= 0.f ? sp : e * sp;
    const float nsig = zz >= 0.f ? e * sp : sp;
    const float lf = (l == 0) ? (fminf(zz, 0.f) - __logf(1.f + e)) : __logf(lbf + (1.f - lbf) * sig);
    kf[i] = (1.f - lbf) * nsig;
    BF[t * 65 + k0 + i] = lf;
  }
  __builtin_amdgcn_sched_barrier(0);
#pragma unroll
  for (int i = 0; i < 16; ++i) {
    float lbb = 0.f;
    if (l == 1) { const int ch = hd * 64 + k0 + i; lbb = sigmoidf_(P.c_lb[512 + 256 + ch] - P.c_lb[256 + ch]); }
    const float zz = zb[i];
    const float e = __expf(-fabsf(zz));
    const float sp = __builtin_amdgcn_rcpf(1.f + e);
    const float sig = zz >= 0.f ? sp : e * sp;
    const float nsig = zz >= 0.f ? e * sp : sp;
    const float lf = (l == 0) ? (fminf(zz, 0.f) - __logf(1.f + e)) : __logf(lbb + (1.f - lbb) * sig);
    kb[i] = (1.f - lbb) * nsig;
    RB[t * 65 + k0 + i] = lf;
  }
  __syncthreads();
  {
    const int k = tid & 63, seg = tid >> 6;
    float sf = 0.f, sr = 0.f;
#pragma unroll
    for (int j = 0; j < 16; ++j) { sf += BF[(seg * 16 + j) * 65 + k]; BF[(seg * 16 + j) * 65 + k] = sf; }
#pragma unroll
    for (int j = 15; j >= 0; --j) { sr += RB[(seg * 16 + j) * 65 + k]; RB[(seg * 16 + j) * 65 + k] = sr; }
    SEG[seg * 64 + k] = sf; SEG[256 + seg * 64 + k] = sr;
    __syncthreads();
    float offf = 0.f, offb = 0.f;
#pragma unroll
    for (int s2 = 0; s2 < 4; ++s2) {
      offf += (s2 < seg) ? SEG[s2 * 64 + k] : 0.f;
      offb += (s2 > seg) ? SEG[256 + s2 * 64 + k] : 0.f;
    }
#pragma unroll
    for (int j = 0; j < 16; ++j) { BF[(seg * 16 + j) * 65 + k] += offf; RB[(seg * 16 + j) * 65 + k] += offb; }
  }
  __syncthreads();
}

DEVI f32x16 lds_mm(const bf16* A, const bf16* BT, int tm, int tn, int l31, int hh) {
  f32x16 acc = zero16();
#pragma unroll
  for (int ks = 0; ks < 4; ++ks) {
    const bf16x8 a = ldfrag(A + (tm * 32 + l31) * 72 + ks * 16 + hh * 8);
    const bf16x8 b = ldfrag(BT + (tn * 32 + l31) * 72 + ks * 16 + hh * 8);
    acc = mfma32(a, b, acc);
  }
  return acc;
}

DEVI void phase_hgrn_local(const Params& P, int l, unsigned char* smem) {
  const int tid = TIDX, lane = tid & 63, wave = tid >> 6, l31 = lane & 31, hh = lane >> 5;
  const int tm = wave >> 1, tn = wave & 1;
  float* BF = reinterpret_cast<float*>(smem);
  float* RB = BF + 64 * 65;
  bf16* QF = reinterpret_cast<bf16*>(smem + 33280);
  bf16* KF = QF + 64 * 72;
  bf16* QB = KF + 64 * 72;
  bf16* KB = QB + 64 * 72;
  bf16* VTt = KB + 64 * 72;
  bf16* KHF = reinterpret_cast<bf16*>(smem);
  bf16* KHB = KHF + 64 * 72;
  bf16* ATT = KHB + 64 * 72;
  for (int it = (VBID + NVB - 192) % NVB; it < 8 * 4 * 36; it += NVB) {
    const int c = it % 36, hd = (it / 36) & 3, b = it / 144;
    float q[16], kf[16], kb[16], v[16];
    __syncthreads();
    hgrn_load(P, l, b, hd, c, BF, RB, reinterpret_cast<float*>(smem + 33280), q, kf, kb, v, true);
    const int t = tid >> 2, k0 = (tid & 3) * 16;
#pragma unroll
    for (int i = 0; i < 16; ++i) VTt[(k0 + i) * 72 + t] = f2bf(v[i]);
    float bfv[16], rbv[16];
#pragma unroll
    for (int i = 0; i < 16; ++i) { bfv[i] = BF[t * 65 + k0 + i]; rbv[i] = RB[t * 65 + k0 + i]; }
    {
      const size_t go = (size_t)row_of(b, c * 64 + t) * 256 + hd * 64 + k0;
#pragma unroll
      for (int hq = 0; hq < 2; ++hq) {
        unsigned pf[4], pb[4];
#pragma unroll
        for (int i = 0; i < 8; i += 2) {
          pf[i >> 1] = pack2(q[hq * 8 + i] * __expf(bfv[hq * 8 + i]), q[hq * 8 + i + 1] * __expf(bfv[hq * 8 + i + 1]));
          pb[i >> 1] = pack2(q[hq * 8 + i] * __expf(rbv[hq * 8 + i]), q[hq * 8 + i + 1] * __expf(rbv[hq * 8 + i + 1]));
        }
        *reinterpret_cast<uint4*>(P.GQF + go + hq * 8) = make_uint4(pf[0], pf[1], pf[2], pf[3]);
        *reinterpret_cast<uint4*>(P.GQB + go + hq * 8) = make_uint4(pb[0], pb[1], pb[2], pb[3]);
      }
    }
    if (t == 0) {
      float* dec = P.DEC + ((size_t)((b * 4 + hd) * 2) * 36 + c) * 64 + k0;
#pragma unroll
      for (int i = 0; i < 16; ++i) { dec[i] = __expf(BF[63 * 65 + k0 + i]); dec[36 * 64 + i] = __expf(RB[k0 + i]); }
    }
#pragma unroll
    for (int i = 0; i < 16; i += 2) {
      const int k = k0 + i;
      const float mF0 = BF[32 * 65 + k], mF1 = BF[32 * 65 + k + 1], mB0 = RB[32 * 65 + k], mB1 = RB[32 * 65 + k + 1];
      *reinterpret_cast<unsigned*>(&QF[t * 72 + k]) = pack2(q[i] * __expf(fminf(bfv[i] - mF0, 80.f)), q[i + 1] * __expf(fminf(bfv[i + 1] - mF1, 80.f)));
      *reinterpret_cast<unsigned*>(&KF[t * 72 + k]) = pack2(kf[i] * __expf(fminf(mF0 - bfv[i], 80.f)), kf[i + 1] * __expf(fminf(mF1 - bfv[i + 1], 80.f)));
      *reinterpret_cast<unsigned*>(&QB[t * 72 + k]) = pack2(q[i] * __expf(fminf(rbv[i] - mB0, 80.f)), q[i + 1] * __expf(fminf(rbv[i + 1] - mB1, 80.f)));
      *reinterpret_cast<unsigned*>(&KB[t * 72 + k]) = pack2(kb[i] * __expf(fminf(mB0 - rbv[i], 80.f)), kb[i + 1] * __expf(fminf(mB1 - rbv[i + 1], 80.f)));
    }
#pragma unroll
    for (int i = 0; i < 16; ++i) {
      kf[i] = kf[i] * __expf(BF[63 * 65 + k0 + i] - bfv[i]);
      kb[i] = kb[i] * __expf(RB[k0 + i] - rbv[i]);
    }
    __syncthreads();
#pragma unroll
    for (int i = 0; i < 16; ++i) {
      KHF[(k0 + i) * 72 + t] = f2bf(kf[i]);
      KHB[(k0 + i) * 72 + t] = f2bf(kb[i]);
    }
    __syncthreads();
    {
      const f32x16 af = lds_mm(QF, KF, tm, tn, l31, hh);
      const f32x16 ab = lds_mm(QB, KB, tm, tn, l31, hh);
      const int s = tn * 32 + l31;
#pragma unroll
      for (int r = 0; r < 16; ++r) {
        const int tt = tm * 32 + drow(r, hh);
        float a = 0.f;
        if (s <= tt) a += af[r];
        if (s >= tt) a += ab[r];
        ATT[tt * 72 + s] = f2bf(a);
      }
    }
    {
      const f32x16 lf = lds_mm(VTt, KHF, tm, tn, l31, hh);
      const f32x16 lb = lds_mm(VTt, KHB, tm, tn, l31, hh);
      bf16* stf = P.ST + ((size_t)((b * 4 + hd) * 2 + 0) * 36 + c) * 4096;
      bf16* stb = P.ST + ((size_t)((b * 4 + hd) * 2 + 1) * 36 + c) * 4096;
#pragma unroll
      for (int r = 0; r < 16; ++r) {
        const int kk = tm * 32 + drow(r, hh), d = tn * 32 + l31;
        stf[kk * 64 + d] = f2bf(lf[r]);
        stb[kk * 64 + d] = f2bf(lb[r]);
      }
    }
    __syncthreads();
    {
      const f32x16 o = lds_mm(ATT, VTt, tm, tn, l31, hh);
#pragma unroll
      for (int r = 0; r < 16; ++r) {
        const int tt = tm * 32 + drow(r, hh), d = tn * 32 + l31;
        P.OI[(size_t)row_of(b, c * 64 + tt) * 256 + hd * 64 + d] = f2bf(o[r]);
      }
    }
  }
}

DEVI void hgrn_scan_item(const Params& P, int item) {
  const int tid = TIDX;
  const int chain = item >> 2, sl = item & 3;
  const int dir = chain & 1;
  const int dd = tid >> 2, k4 = sl * 16 + (tid & 3) * 4;
  float4 S = make_float4(0.f, 0.f, 0.f, 0.f);
  bf16* base = P.ST + (size_t)chain * 36 * 4096 + dd * 64 + k4;
  const float* dec = P.DEC + (size_t)chain * 36 * 64 + k4;
#pragma unroll 1
  for (int g = 0; g < 6; ++g) {
    float4 L[6], dc[6];
#pragma unroll
    for (int j = 0; j < 6; ++j) {
      const int step = g * 6 + j;
      const int c = dir == 0 ? step : (step < 4 ? 3 - step : 39 - step);
      { const uint2 u = *reinterpret_cast<const uint2*>(base + (size_t)c * 4096); L[j] = make_float4(lo2f(u.x), hi2f(u.x), lo2f(u.y), hi2f(u.y)); }
      dc[j] = *reinterpret_cast<const float4*>(dec + c * 64);
    }
#pragma unroll
    for (int j = 0; j < 6; ++j) {
      const int step = g * 6 + j;
      const int c = dir == 0 ? step : (step < 4 ? 3 - step : 39 - step);
      *reinterpret_cast<uint2*>(base + (size_t)c * 4096) = make_uint2(pack2(S.x, S.y), pack2(S.z, S.w));
      S.x = dc[j].x * S.x + L[j].x; S.y = dc[j].y * S.y + L[j].y; S.z = dc[j].z * S.z + L[j].z; S.w = dc[j].w * S.w + L[j].w;
    }
  }
}

DEVI void phase_hgrn_final(const Params& P, int l, unsigned char* smem) {
  const int tid = TIDX, lane = tid & 63, wave = tid >> 6, l31 = lane & 31, hh = lane >> 5;
  const int tm = wave >> 1, tn = wave & 1;
  float* O = reinterpret_cast<float*>(smem);
  bf16* QF = reinterpret_cast<bf16*>(smem + 33280);
  bf16* QB = QF + 64 * 72;
  bf16* SF = QB + 64 * 72;
  bf16* SB = SF + 64 * 72;
  const int c0 = (l == 1) ? 4 : 0;
  const int nc = 36 - c0;
  for (int it = VBID; it < 8 * 4 * nc; it += NVB) {
    const int c = it % nc + c0, hd = (it / nc) & 3, b = it / (nc * 4);
    const int t = tid >> 2, k0 = (tid & 3) * 16;
    const int row = row_of(b, c * 64 + t);
    __syncthreads();
    {
      const size_t go = (size_t)row * 256 + hd * 64 + k0;
      *reinterpret_cast<uint4*>(QF + t * 72 + k0) = *reinterpret_cast<const uint4*>(P.GQF + go);
      *reinterpret_cast<uint4*>(QF + t * 72 + k0 + 8) = *reinterpret_cast<const uint4*>(P.GQF + go + 8);
      *reinterpret_cast<uint4*>(QB + t * 72 + k0) = *reinterpret_cast<const uint4*>(P.GQB + go);
      *reinterpret_cast<uint4*>(QB + t * 72 + k0 + 8) = *reinterpret_cast<const uint4*>(P.GQB + go + 8);
      const bf16* stf = P.ST + ((size_t)((b * 4 + hd) * 2 + 0) * 36 + c) * 4096 + t * 64 + k0;
      const bf16* stb = P.ST + ((size_t)((b * 4 + hd) * 2 + 1) * 36 + c) * 4096 + t * 64 + k0;
      *reinterpret_cast<uint4*>(SF + t * 72 + k0) = *reinterpret_cast<const uint4*>(stf);
      *reinterpret_cast<uint4*>(SF + t * 72 + k0 + 8) = *reinterpret_cast<const uint4*>(stf + 8);
      *reinterpret_cast<uint4*>(SB + t * 72 + k0) = *reinterpret_cast<const uint4*>(stb);
      *reinterpret_cast<uint4*>(SB + t * 72 + k0 + 8) = *reinterpret_cast<const uint4*>(stb + 8);
    }
    __syncthreads();
    {
      f32x16 o = lds_mm(QF, SF, tm, tn, l31, hh);
      const f32x16 o2 = lds_mm(QB, SB, tm, tn, l31, hh);
#pragma unroll
      for (int r = 0; r < 16; ++r) {
        const int tt = tm * 32 + drow(r, hh), d = tn * 32 + l31;
        O[tt * 65 + d] = o[r] + o2[r] + bf2f(P.OI[(size_t)row_of(b, c * 64 + tt) * 256 + hd * 64 + d]);
      }
    }
    __syncthreads();
    {
      float ov[16]; float ss = 0.f;
#pragma unroll
      for (int i = 0; i < 16; ++i) { ov[i] = O[t * 65 + k0 + i]; ss += ov[i] * ov[i]; }
      ss += __shfl_xor(ss, 1); ss += __shfl_xor(ss, 2);
      const float rr = rsqrtf(ss * (1.f / 64.f) + EPS);
      const bf16* g = P.Z + (size_t)row * DIN + ZC_CG + hd * 64 + k0;
      const float* nw = P.c_out_norm_w + l * 64 + k0;
      const uint4 gA = *reinterpret_cast<const uint4*>(g), gB = *reinterpret_cast<const uint4*>(g + 8);
      const unsigned gw[8] = {gA.x, gA.y, gA.z, gA.w, gB.x, gB.y, gB.z, gB.w};
      unsigned pk[8];
#pragma unroll
      for (int i = 0; i < 16; i += 2) {
        const float g0 = lo2f(gw[i >> 1]), g1 = hi2f(gw[i >> 1]);
        const float y0 = ov[i] * rr * nw[i] * (g0 * sigmoidf_(g0));
        const float y1 = ov[i + 1] * rr * nw[i + 1] * (g1 * sigmoidf_(g1));
        pk[i >> 1] = pack2(y0, y1);
      }
      uint4* dst = reinterpret_cast<uint4*>(P.H + (size_t)row * 1024 + 768 + hd * 64 + k0);
      dst[0] = make_uint4(pk[0], pk[1], pk[2], pk[3]);
      dst[1] = make_uint4(pk[4], pk[5], pk[6], pk[7]);
    }
  }
}

DEVI void attn_item8(const Params& P, int b, int h, int qpos0, int nkeys, float sref, unsigned char* smem_base) {
  const int tid = threadIdx.x, lane = tid & 63, wave = tid >> 6, l31 = lane & 31, hh = lane >> 5;
  constexpr int TK = 128, LDKS = 104, LDVS = 136;
  constexpr int KS_BYTES = TK * LDKS * 2, VS_BYTES = 64 * LDVS * 2, ST_BYTES = KS_BYTES + VS_BYTES;
  const bf16* Qg = P.Q + ((size_t)(b * 8 + h) * SEQP + qpos0 + wave * 32 + l31) * 96;
  const bf16* Kg = P.K + (size_t)(b * 8 + h) * SEQP * 96;
  const bf16* Vg = P.VT + (size_t)(b * 8 + h) * 64 * SEQP;
  bf16x8 qf[6];
#pragma unroll
  for (int ks = 0; ks < 6; ++ks) qf[ks] = ldfrag(Qg + ks * 16 + hh * 8);
  f32x16 oacc[2]; oacc[0] = zero16(); oacc[1] = zero16();
  float lsum = 0.f;
  uint4 rk[3], rv[2];
  const int ntiles = nkeys / TK;
  auto gload = [&](int kt) {
#pragma unroll
    for (int i = 0; i < 3; ++i) { const int ch = tid + i * 512, row = ch / 12, cc = ch % 12;
      rk[i] = *reinterpret_cast<const uint4*>(Kg + (size_t)(kt * TK + row) * 96 + cc * 8); }
#pragma unroll
    for (int i = 0; i < 2; ++i) { const int ch = tid + i * 512, row = ch >> 4, cc = ch & 15;
      rv[i] = *reinterpret_cast<const uint4*>(Vg + (size_t)row * SEQP + kt * TK + cc * 8); }
  };
  auto swrite = [&](int buf) {
    bf16* sK = reinterpret_cast<bf16*>(smem_base + buf * ST_BYTES);
    bf16* sV = reinterpret_cast<bf16*>(smem_base + buf * ST_BYTES + KS_BYTES);
#pragma unroll
    for (int i = 0; i < 3; ++i) { const int ch = tid + i * 512, row = ch / 12, cc = ch % 12;
      *reinterpret_cast<uint4*>(sK + row * LDKS + cc * 8) = rk[i]; }
#pragma unroll
    for (int i = 0; i < 2; ++i) { const int ch = tid + i * 512, row = ch >> 4, cc = ch & 15;
      const int g16 = cc >> 1, odd = cc & 1;
      bf16* base = sV + row * LDVS + g16 * 16;
      const int s0 = odd ? 4 : 0, s1 = odd ? 12 : 8;
      *reinterpret_cast<uint2*>(base + s0) = make_uint2(rv[i].x, rv[i].y);
      *reinterpret_cast<uint2*>(base + s1) = make_uint2(rv[i].z, rv[i].w);
    }
  };
  __syncthreads();
  gload(0); swrite(0);
  __syncthreads();
  for (int kt = 0; kt < ntiles; ++kt) {
    const int cur = kt & 1;
    if (kt + 1 < ntiles) gload(kt + 1);
    const bf16* sK = reinterpret_cast<const bf16*>(smem_base + cur * ST_BYTES);
    const bf16* sV = reinterpret_cast<const bf16*>(smem_base + cur * ST_BYTES + KS_BYTES);
#pragma unroll
    for (int kk = 0; kk < 4; ++kk) {
      f32x16 sacc;
#pragma unroll
      for (int r = 0; r < 16; ++r) sacc[r] = -sref;
#pragma unroll
      for (int ks = 0; ks < 6; ++ks) {
        const bf16x8 a = ldfrag(sK + (kk * 32 + l31) * LDKS + ks * 16 + hh * 8);
        sacc = mfma32(a, qf[ks], sacc);
      }
#pragma unroll
      for (int r = 0; r < 16; ++r) { const float p = __builtin_amdgcn_exp2f(sacc[r]); sacc[r] = p; lsum += p; }
#pragma unroll
      for (int s = 0; s < 2; ++s) {
        bf16x8 pb;
#pragma unroll
        for (int j = 0; j < 8; ++j) pb[j] = (__bf16)sacc[8 * s + j];
#pragma unroll
        for (int dt = 0; dt < 2; ++dt) {
          const bf16x8 a = ldfrag(sV + (dt * 32 + l31) * LDVS + kk * 32 + s * 16 + hh * 8);
          oacc[dt] = mfma32(a, pb, oacc[dt]);
        }
      }
    }
    if (kt + 1 < ntiles) swrite(cur ^ 1);
    __syncthreads();
  }
  lsum += __shfl_xor(lsum, 32);
  const float inv = 1.f / lsum;
  const int row = row_of(b, qpos0 + wave * 32 + l31);
  bf16* dst = P.H + (size_t)row * 1024 + 256 + h * 64;
#pragma unroll
  for (int dt = 0; dt < 2; ++dt)
#pragma unroll
    for (int rg = 0; rg < 4; ++rg) {
      const int d = dt * 32 + 8 * rg + 4 * hh;
      uint2 o;
      o.x = pack2(oacc[dt][4 * rg + 0] * inv, oacc[dt][4 * rg + 1] * inv);
      o.y = pack2(oacc[dt][4 * rg + 2] * inv, oacc[dt][4 * rg + 3] * inv);
      *reinterpret_cast<uint2*>(dst + d) = o;
    }
}

DEVI void phase_attn_scan(const Params& P, int l, unsigned char* smem_base, bool skip_scan = false) {
  if (!skip_scan)
    for (int it = NVB - 1 - VBID; it < 256; it += NVB) hgrn_scan_item(P, it);
  float sref;
  {
    const int lane = threadIdx.x & 63;
    float mq = fmaxf(fabsf(P.b_qh_w[l * 96 + lane]), lane < 32 ? fabsf(P.b_qh_w[l * 96 + 64 + lane]) : 0.f);
    float mk = fmaxf(fabsf(P.b_kh_w[l * 96 + lane]), lane < 32 ? fabsf(P.b_kh_w[l * 96 + 64 + lane]) : 0.f);
#pragma unroll
    for (int o = 32; o > 0; o >>= 1) { mq = fmaxf(mq, __shfl_xor(mq, o)); mk = fmaxf(mk, __shfl_xor(mk, o)); }
    sref = fminf(1.4426950408889634f * 9.797958971132712f * mq * mk, 60.f);
  }
  const int c = blockIdx.x, xcd = c & 7, slot = c >> 3;
  const int nrounds = (l == 0) ? 3 : 2;
  for (int r = 0; r < nrounds; ++r) {
    if (r < 2) {
      const int u = r * 32 + slot;
      const int bh = xcd * 8 + (u >> 3), qt = u & 7;
      if (slot < 32) attn_item8(P, bh >> 3, bh & 7, 256 + 256 * qt, 2304, sref, smem_base);
    } else if (c < 64) {
      attn_item8(P, c >> 3, c & 7, 0, 256, sref, smem_base);
    }
  }
}

DEVI unsigned ordkey(float s) { const unsigned u = __float_as_uint(s); return (u & 0x80000000u) ? ~u : (u | 0x80000000u); }
DEVI float keyval(unsigned k, unsigned mask) { const unsigned u = k & ~mask; return __uint_as_float((u & 0x80000000u) ? (u & 0x7fffffffu) : ~u); }
DEVI void ins16(unsigned (&lst)[16], unsigned v) {
#pragma unroll
  for (int j = 0; j < 16; ++j) { const unsigned hi = max(lst[j], v); v = min(lst[j], v); lst[j] = hi; }
}
DEVI void merge16(unsigned (&lst)[16], int xm) {
  unsigned o[16];
#pragma unroll
  for (int j = 0; j < 16; ++j) o[j] = (unsigned)__shfl_xor((int)lst[j], xm);
#pragma unroll
  for (int j = 0; j < 16; ++j) lst[j] = max(lst[j], o[15 - j]);
#pragma unroll
  for (int d = 8; d >= 1; d >>= 1)
#pragma unroll
    for (int j = 0; j < 16; ++j)
      if ((j & d) == 0) { const unsigned a = lst[j], bb = lst[j + d]; lst[j] = max(a, bb); lst[j + d] = min(a, bb); }
}

DEVI void bitonic_sort_desc16(unsigned (&v)[16]) {
#pragma unroll
  for (int k = 2; k <= 16; k <<= 1)
#pragma unroll
    for (int j = k >> 1; j > 0; j >>= 1)
#pragma unroll
      for (int i = 0; i < 16; ++i) {
        const int l = i ^ j;
        if (l > i) {
          const bool desc = ((i & k) == 0);
          const unsigned a = v[i], b = v[l];
          const unsigned mx = max(a, b), mn = min(a, b);
          v[i] = desc ? mx : mn; v[l] = desc ? mn : mx;
        }
      }
}
DEVI void bitonic_merge_desc16(unsigned (&lst)[16]) {
#pragma unroll
  for (int d = 8; d >= 1; d >>= 1)
#pragma unroll
    for (int j = 0; j < 16; ++j)
      if ((j & d) == 0) { const unsigned a = lst[j], bb = lst[j + d]; lst[j] = max(a, bb); lst[j + d] = min(a, bb); }
}
struct CandTab { int a[52]; int b[52]; };
constexpr CandTab make_cand_tab() {
  CandTab t{};
  int n = 0;
  for (int a = 0; a < 16; ++a)
    for (int b = 0; b < 16; ++b)
      if ((a + 1) * (b + 1) <= 16) { t.a[n] = a; t.b[n] = b; ++n; }
  for (; n < 52; ++n) { t.a[n] = 0; t.b[n] = 0; }
  return t;
}

DEVI void phase_route(const Params& P, int l, unsigned char* smem) {
  const int tid = TIDX, lane = tid & 63, wave = tid >> 6, l31 = lane & 31, hh = lane >> 5;
  bf16* QT = reinterpret_cast<bf16*>(smem);
  float* SC = reinterpret_cast<float*>(smem + 33792);
  const int mtiles = (l == 1) ? 256 : 288;
  for (int it = VBID; it < mtiles * 8; it += NVB) {
    const int mt = it >> 3, h = it & 7;
    __syncthreads();
    for (int e = tid; e < 64 * 32; e += 256) {
      const int r = e >> 5, cc = e & 31;
      *reinterpret_cast<uint4*>(QT + r * 264 + cc * 8) = *reinterpret_cast<const uint4*>(P.QP + (size_t)(mt * 64 + r) * 2048 + h * 256 + cc * 8);
    }
    __syncthreads();
    unsigned lst[2][16];
    const int row = tid >> 2, part = tid & 3;
#pragma unroll
    for (int p = 0; p < 2; ++p) {
      f32x16 sa[2]; sa[0] = zero16(); sa[1] = zero16();
      const bf16* keys = P.SK + ((size_t)(l * 16 + h * 2 + p) * 128 + wave * 32 + l31) * 128;
#pragma unroll
      for (int ks = 0; ks < 8; ++ks) {
        const bf16x8 bfr = ldfrag(keys + ks * 16 + hh * 8);
#pragma unroll
        for (int i = 0; i < 2; ++i) {
          const bf16x8 af = ldfrag(QT + (i * 32 + l31) * 264 + p * 128 + ks * 16 + hh * 8);
          sa[i] = mfma32(af, bfr, sa[i]);
        }
      }
      if (p == 1) __syncthreads();
#pragma unroll
      for (int i = 0; i < 2; ++i)
#pragma unroll
        for (int r = 0; r < 16; ++r) SC[(i * 32 + drow(r, hh)) * 129 + wave * 32 + l31] = sa[i][r];
      __syncthreads();
      unsigned B2[16];
#pragma unroll
      for (int i = 0; i < 16; ++i) {
        const int i0 = part * 32 + ((i + part * 8) & 31), i1 = part * 32 + ((i + 16 + part * 8) & 31);
        lst[p][i] = (ordkey(SC[row * 129 + i0]) & ~0x7fu) | (unsigned)(127 - i0);
        B2[i] = (ordkey(SC[row * 129 + i1]) & ~0x7fu) | (unsigned)(127 - i1);
      }
      bitonic_sort_desc16(lst[p]);
      bitonic_sort_desc16(B2);
#pragma unroll
      for (int j = 0; j < 16; ++j) lst[p][j] = max(lst[p][j], B2[15 - j]);
      bitonic_merge_desc16(lst[p]);
      merge16(lst[p], 1);
      merge16(lst[p], 2);
    }
    float v0[16], v1[16];
#pragma unroll
    for (int j = 0; j < 16; ++j) { v0[j] = keyval(lst[0][j], 0x7fu); v1[j] = keyval(lst[1][j], 0x7fu); }
    unsigned best[16];
    {
      constexpr CandTab CT = make_cand_tab();
#pragma unroll
      for (int c = 0; c < 13; ++c) {
        const int a0 = CT.a[4 * c + 0], a1 = CT.a[4 * c + 1], a2 = CT.a[4 * c + 2], a3 = CT.a[4 * c + 3];
        const int b0 = CT.b[4 * c + 0], b1 = CT.b[4 * c + 1], b2 = CT.b[4 * c + 2], b3 = CT.b[4 * c + 3];
        const float x = part == 0 ? v0[a0] : part == 1 ? v0[a1] : part == 2 ? v0[a2] : v0[a3];
        const float y = part == 0 ? v1[b0] : part == 1 ? v1[b1] : part == 2 ? v1[b2] : v1[b3];
        const int flat = part == 0 ? (a0 * 16 + b0) : part == 1 ? (a1 * 16 + b1) : part == 2 ? (a2 * 16 + b2) : (a3 * 16 + b3);
        const bool valid = part == 0 ? (4 * c + 0 < 50) : part == 1 ? (4 * c + 1 < 50) : part == 2 ? (4 * c + 2 < 50) : (4 * c + 3 < 50);
        const unsigned key = (ordkey(x + y) & ~0xffu) | (unsigned)(255 - flat);
        best[c] = valid ? key : 0u;
      }
      best[13] = 0u; best[14] = 0u; best[15] = 0u;
      bitonic_sort_desc16(best);
      merge16(best, 1);
      merge16(best, 2);
    }
    {
      const float mx = keyval(best[0], 0xffu);
      float es = 0.f;
      float ev[4]; int ex[4];
#pragma unroll
      for (int jj = 0; jj < 4; ++jj) {
        const unsigned kk = part == 0 ? best[4 * jj + 0] : part == 1 ? best[4 * jj + 1] : part == 2 ? best[4 * jj + 2] : best[4 * jj + 3];
        ev[jj] = __expf(keyval(kk, 0xffu) - mx);
        es += ev[jj];
        const int flat = 255 - (int)(kk & 0xffu);
        const int a = flat >> 4, bq = flat & 15;
        int i1 = 0, i2 = 0;
#pragma unroll
        for (int u = 0; u < 16; ++u) {
          i1 = (a == u) ? (127 - (int)(lst[0][u] & 0x7fu)) : i1;
          i2 = (bq == u) ? (127 - (int)(lst[1][u] & 0x7fu)) : i2;
        }
        ex[jj] = i1 * 128 + i2;
      }
      es += __shfl_xor(es, 1); es += __shfl_xor(es, 2);
      const float inv = 1.f / es;
      const int tok = mt * 64 + row;
      int* ed = P.EIDX + (size_t)tok * 128 + h * 16;
      float* gd = P.GATE + (size_t)tok * 128 + h * 16;
#pragma unroll
      for (int jj = 0; jj < 4; ++jj) { ed[4 * jj + part] = ex[jj]; gd[4 * jj + part] = ev[jj] * inv; }
    }
  }
}

DEVI float gelu_exact(float a) { return 0.5f * a * (1.f + erff(a * 0.70710678118654752f)); }

typedef float f2 __attribute__((ext_vector_type(2)));
DEVI void phase_peer_u(const Params& P, int l) {
  const int lane = TIDX & 63, half = lane >> 5, l32 = lane & 31;
  const int gw = VBID * 4 + (TIDX >> 6), nw = NVB * 4;
  const int nrows = (l == 1) ? NL : NT;
  const unsigned char* PU = P.PU8 + (size_t)l * 16384 * 576;
  const bool b4 = lane & 16, b3 = lane & 8, b2 = lane & 4;
  for (int t = gw; t < nrows; t += nw) {
    f2 h2[16];
    {
      const bf16* hp = P.H + (size_t)t * 1024 + l32 * 32;
#pragma unroll
      for (int i = 0; i < 4; ++i) {
        const uint4 hv = *reinterpret_cast<const uint4*>(hp + i * 8);
        h2[4 * i + 0] = (f2){lo2f(hv.x), hi2f(hv.x)}; h2[4 * i + 1] = (f2){lo2f(hv.y), hi2f(hv.y)};
        h2[4 * i + 2] = (f2){lo2f(hv.z), hi2f(hv.z)}; h2[4 * i + 3] = (f2){lo2f(hv.w), hi2f(hv.w)};
      }
    }
    const int e0 = P.EIDX[(size_t)t * 128 + lane], e1 = P.EIDX[(size_t)t * 128 + 64 + lane];
    const float g0 = P.GATE[(size_t)t * 128 + lane], g1 = P.GATE[(size_t)t * 128 + 64 + lane];
    float* wrow = P.WPE + (size_t)t * 128;
    for (int kb = 0; kb < 8; ++kb) {
      const int esrc = kb < 4 ? e0 : e1;
      uint4 ud[8];
      unsigned short us[8];
#pragma unroll
      for (int i = 0; i < 8; ++i) {
        const int e = __shfl(esrc, (kb * 16 + 2 * i + half) & 63);
        const unsigned char* ur = PU + (size_t)e * 576;
        ud[i] = *reinterpret_cast<const uint4*>(ur + l32 * 16);
        us[i] = *reinterpret_cast<const unsigned short*>(ur + 512 + l32 * 2);
      }
      float d[8];
#pragma unroll
      for (int i = 0; i < 8; ++i) {
        const unsigned uw[4] = {ud[i].x, ud[i].y, ud[i].z, ud[i].w};
        f2 sacc = (f2){0.f, 0.f};
#pragma unroll
        for (int c = 0; c < 4; ++c) {
          sacc = __builtin_elementwise_fma(__builtin_amdgcn_cvt_scalef32_pk_f32_fp4(uw[c], 1.0f, 0), h2[4 * c + 0], sacc);
          sacc = __builtin_elementwise_fma(__builtin_amdgcn_cvt_scalef32_pk_f32_fp4(uw[c], 1.0f, 1), h2[4 * c + 1], sacc);
          sacc = __builtin_elementwise_fma(__builtin_amdgcn_cvt_scalef32_pk_f32_fp4(uw[c], 1.0f, 2), h2[4 * c + 2], sacc);
          sacc = __builtin_elementwise_fma(__builtin_amdgcn_cvt_scalef32_pk_f32_fp4(uw[c], 1.0f, 3), h2[4 * c + 3], sacc);
        }
        d[i] = (sacc.x + sacc.y) * __uint_as_float((unsigned)us[i] << 16);
      }
      float r4[4], r2[2], r1;
#pragma unroll
      for (int i = 0; i < 4; ++i) { const float mine = b4 ? d[4 + i] : d[i]; const float send = b4 ? d[i] : d[4 + i]; r4[i] = mine + __shfl_xor(send, 16); }
#pragma unroll
      for (int i = 0; i < 2; ++i) { const float mine = b3 ? r4[2 + i] : r4[i]; const float send = b3 ? r4[i] : r4[2 + i]; r2[i] = mine + __shfl_xor(send, 8); }
      { const float mine = b2 ? r2[1] : r2[0]; const float send = b2 ? r2[0] : r2[1]; r1 = mine + __shfl_xor(send, 4); }
      r1 += __shfl_xor(r1, 2); r1 += __shfl_xor(r1, 1);
      const int k = kb * 16 + 2 * ((lane >> 2) & 7) + half;
      const float gt = __shfl(kb < 4 ? g0 : g1, k & 63);
      if ((lane & 3) == 0) wrow[k] = gt * gelu_exact(r1);
    }
  }
}

DEVI void phase_peer(const Params& P, int l) {
  const int lane = TIDX & 63, half = lane >> 5, l32 = lane & 31;
  const int gw = VBID * 4 + (TIDX >> 6), nw = NVB * 4;
  const int nrows = (l == 1) ? NL : NT;
  const unsigned char* PV = P.PV8 + (size_t)l * 16384 * 576;
  for (int t = gw; t < nrows; t += nw) {
    const int e0 = P.EIDX[(size_t)t * 128 + lane], e1 = P.EIDX[(size_t)t * 128 + 64 + lane];
    const float w0 = P.WPE[(size_t)t * 128 + lane], w1 = P.WPE[(size_t)t * 128 + 64 + lane];
    f2 y2[16];
#pragma unroll
    for (int i = 0; i < 16; ++i) y2[i] = (f2){0.f, 0.f};
    for (int kb = 0; kb < 8; ++kb) {
      const int esrc = kb < 4 ? e0 : e1;
      const float wsrc = kb < 4 ? w0 : w1;
      uint4 vd[8];
      unsigned short vs[8];
      float wv[8];
#pragma unroll
      for (int i = 0; i < 8; ++i) {
        const int ks = (kb * 16 + 2 * i + half) & 63;
        const int e = __shfl(esrc, ks);
        wv[i] = __shfl(wsrc, ks);
        const unsigned char* vr = PV + (size_t)e * 576;
        vd[i] = *reinterpret_cast<const uint4*>(vr + l32 * 16);
        vs[i] = *reinterpret_cast<const unsigned short*>(vr + 512 + l32 * 2);
      }
#pragma unroll
      for (int i = 0; i < 8; ++i) {
        const float wi = wv[i] * __uint_as_float((unsigned)vs[i] << 16);
        const f2 ww = (f2){wi, wi};
        const unsigned vw[4] = {vd[i].x, vd[i].y, vd[i].z, vd[i].w};
#pragma unroll
        for (int c = 0; c < 4; ++c) {
          y2[4 * c + 0] = __builtin_elementwise_fma(ww, __builtin_amdgcn_cvt_scalef32_pk_f32_fp4(vw[c], 1.0f, 0), y2[4 * c + 0]);
          y2[4 * c + 1] = __builtin_elementwise_fma(ww, __builtin_amdgcn_cvt_scalef32_pk_f32_fp4(vw[c], 1.0f, 1), y2[4 * c + 1]);
          y2[4 * c + 2] = __builtin_elementwise_fma(ww, __builtin_amdgcn_cvt_scalef32_pk_f32_fp4(vw[c], 1.0f, 2), y2[4 * c + 2]);
          y2[4 * c + 3] = __builtin_elementwise_fma(ww, __builtin_amdgcn_cvt_scalef32_pk_f32_fp4(vw[c], 1.0f, 3), y2[4 * c + 3]);
        }
      }
    }
    float y[16];
#pragma unroll
    for (int j = 0; j < 8; ++j) {
      const float ax = y2[j].x + __shfl_xor(y2[j].x, 32), ay = y2[j].y + __shfl_xor(y2[j].y, 32);
      const float bx = y2[8 + j].x + __shfl_xor(y2[8 + j].x, 32), by = y2[8 + j].y + __shfl_xor(y2[8 + j].y, 32);
      y[2 * j] = half ? bx : ax; y[2 * j + 1] = half ? by : ay;
    }
    const int bi = batch_of_row(t);
    const float* gate2 = P.MOD + (size_t)(l * 9 + bi) * 6144 + 5 * 1024;
    const int d0 = l32 * 32 + half * 16;
    float xn[16];
    float ss = 0.f;
#pragma unroll
    for (int q4 = 0; q4 < 4; ++q4) {
      const int d = d0 + q4 * 4;
      const uint2 xu = *reinterpret_cast<const uint2*>(P.X + (size_t)t * 1024 + d);
      const float4 xo = make_float4(lo2f(xu.x), hi2f(xu.x), lo2f(xu.y), hi2f(xu.y));
      const float4 gg = *reinterpret_cast<const float4*>(gate2 + d);
      float4 o;
      o.x = xo.x + gg.x * y[q4 * 4 + 0]; o.y = xo.y + gg.y * y[q4 * 4 + 1];
      o.z = xo.z + gg.z * y[q4 * 4 + 2]; o.w = xo.w + gg.w * y[q4 * 4 + 3];
      xn[q4 * 4 + 0] = o.x; xn[q4 * 4 + 1] = o.y; xn[q4 * 4 + 2] = o.z; xn[q4 * 4 + 3] = o.w;
      ss += o.x * o.x + o.y * o.y + o.z * o.z + o.w * o.w;
      if (l == 1) *reinterpret_cast<float4*>(P.out + (size_t)t * 1024 + d) = o;
      else *reinterpret_cast<uint2*>(P.X + (size_t)t * 1024 + d) = make_uint2(pack2(o.x, o.y), pack2(o.z, o.w));
    }
    if (l == 0) {
      ss = wave_sum(ss);
      const float rr = rsqrtf(ss * (1.f / 1024.f) + EPS);
      const float* lnw = P.ln1_w + 1024;
      const float* mod = P.MOD + (size_t)(9 + bi) * 6144;
      unsigned pk[8];
#pragma unroll
      for (int i = 0; i < 16; i += 2) {
        const float o0 = xn[i] * rr * lnw[d0 + i] * (1.f + mod[1024 + d0 + i]) + mod[d0 + i];
        const float o1 = xn[i + 1] * rr * lnw[d0 + i + 1] * (1.f + mod[1024 + d0 + i + 1]) + mod[d0 + i + 1];
        pk[i >> 1] = pack2(o0, o1);
      }
      *reinterpret_cast<uint4*>(P.H + (size_t)t * 1024 + d0) = make_uint4(pk[0], pk[1], pk[2], pk[3]);
      *reinterpret_cast<uint4*>(P.H + (size_t)t * 1024 + d0 + 8) = make_uint4(pk[4], pk[5], pk[6], pk[7]);
    }
  }
}

using f32x4 = __attribute__((ext_vector_type(4))) float;
namespace g8 {
constexpr int BM = 256, BK = 64, HALF = 128, HT = HALF * BK;
DEVI int lds_byte(int r, int c) { const int st = (r >> 4) * 2 + (c >> 5), rr = r & 15, cc = c & 31, ob = rr * 64 + cc * 2; return st * 1024 + (ob ^ (((ob >> 9) & 1) << 5)); }
DEVI void stage_rc(int b, int& R, int& C) { const int st = b / 1024, sb = b % 1024, swz = sb ^ (((sb >> 9) & 1) << 5); R = (st >> 1) * 16 + swz / 64; C = (st & 1) * 32 + (swz % 64) / 2; }
DEVI int perm32(int rho) { const int n = rho >> 4, i = rho & 15; return 8 * (i >> 2) + 4 * n + (i & 3); }
DEVI void unit_of(int L, int nM, int nN, int& pm, int& pn) {
  const int nwg = nM * nN;
  int wgid = L;
  { const int q = nwg / 8, r = nwg % 8, xcd = wgid % 8, off = wgid / 8; wgid = (xcd < r ? xcd * (q + 1) : r * (q + 1) + (xcd - r) * q) + off; }
  const int nig = 8 * nN, gid = wgid / nig, fm = gid * 8, gsz = (nM - fm) < 8 ? (nM - fm) : 8;
  pm = fm + ((wgid % nig) % gsz); pn = (wgid % nig) / gsz;
}
}

struct G8Unit { int pm, pn; };
template <class Epi>
DEVI void gemm8_phase(LAS unsigned char* lds, const bf16* __restrict__ Ag, const bf16* __restrict__ Btg, const int K, const int nM, const int nN, const Epi& E,
                      const int lda = 0, const int pn_split = 1 << 30, const int acol0 = 0, const int acol1 = 0) {
  constexpr int BK = 64, HALF = 128, HTB = HALF * BK * 2;
  const int tid = threadIdx.x, wid = __builtin_amdgcn_readfirstlane(tid >> 6), lane = tid & 63, wr = wid >> 2, wc = wid & 3, fr = lane & 15, fq = lane >> 4;
  const int nt = K / BK;
  const int nunits = nM * nN, G = gridDim.x, c = blockIdx.x;
  const int LDA = lda ? lda : K;
  unsigned voffA[2], voffB[2];
#pragma unroll
  for (int i = 0; i < 2; ++i) { int R, C; g8::stage_rc(tid * 16 + i * 8192, R, C); const int Rb = (R & ~31) + g8::perm32(R & 31); voffA[i] = (unsigned)(R * LDA + C) * 2u; voffB[i] = (unsigned)(Rb * K + C) * 2u; }
  const size_t kstep = (size_t)(BK * 2);
  const size_t hstepA = (size_t)HALF * LDA * 2, hstep = (size_t)HALF * K * 2;
  const size_t tstepA = 2 * hstepA, tstep = 2 * hstep;
  const unsigned ldsw = (unsigned)wid * 1024u;
  const int aoff = g8::lds_byte(wr * 64 + fr, fq * 8), boff = g8::lds_byte(wc * 32 + fr, fq * 8);
#define PG8_SA(b, h) (((b) * 2 + (h)) * HTB)
#define PG8_SB(b, h) ((4 + (b) * 2 + (h)) * HTB)
#define PG8_STAGE(bufoff, gbase, voff) do { _Pragma("unroll") for (int _i = 0; _i < 2; ++_i) \
        __builtin_amdgcn_global_load_lds((const unsigned*)((const char*)(gbase) + (voff)[_i]), (LAS unsigned*)(lds + (bufoff) + ldsw + _i * 8192), 16, 0, 0); } while (0)
#define PG8_LDA(dst, b, h) do { _Pragma("unroll") for (int m = 0; m < 4; ++m) _Pragma("unroll") for (int k = 0; k < 2; ++k) dst[m][k] = *(const LAS bf16x8*)(lds + PG8_SA(b, h) + aoff + m * 2048 + k * 1024); } while (0)
#define PG8_LDB(dst, b, h) do { _Pragma("unroll") for (int n = 0; n < 2; ++n) _Pragma("unroll") for (int k = 0; k < 2; ++k) dst[n][k] = *(const LAS bf16x8*)(lds + PG8_SB(b, h) + boff + n * 2048 + k * 1024); } while (0)
#define PG8_MMA(ai, bj, At_, Bt_) do { __builtin_amdgcn_s_setprio(1); _Pragma("unroll") for (int m = 0; m < 4; ++m) _Pragma("unroll") for (int n = 0; n < 2; ++n) _Pragma("unroll") for (int k = 0; k < 2; ++k) \
        acc[ai][bj][m][n] = __builtin_amdgcn_mfma_f32_16x16x32_bf16(Bt_[n][k], At_[m][k], acc[ai][bj][m][n], 0, 0, 0); __builtin_amdgcn_s_setprio(0); } while (0)
#define PG8_WAIT_V(n) asm volatile("s_waitcnt vmcnt(" #n ")" ::: "memory")
#define PG8_WAIT_L(n) asm volatile("s_waitcnt lgkmcnt(" #n ")" ::: "memory")
#define PG8_BAR __builtin_amdgcn_s_barrier()
#define PG8_SCHED __builtin_amdgcn_sched_barrier(0)
  G8Unit cur, nxt; int ui = 0;
  if (c >= nunits) return;
  g8::unit_of(c, nM, nN, cur.pm, cur.pn);
  f32x4 acc[2][2][4][2];
#pragma unroll
  for (int a = 0; a < 2; ++a)
#pragma unroll
    for (int b = 0; b < 2; ++b)
#pragma unroll
      for (int m = 0; m < 4; ++m)
#pragma unroll
        for (int n = 0; n < 2; ++n) acc[a][b][m][n] = (f32x4){0.f, 0.f, 0.f, 0.f};
  bf16x8 At[4][2], B0[2][2], B1[2][2];
  const char* cA = (const char*)Ag + (size_t)cur.pm * tstepA + (size_t)(cur.pn < pn_split ? acol0 : acol1) * 2; const char* cB = (const char*)Btg + (size_t)cur.pn * tstep;
  PG8_STAGE(PG8_SB(0, 0), cB, voffB); PG8_STAGE(PG8_SA(0, 0), cA, voffA); PG8_STAGE(PG8_SB(0, 1), cB + hstep, voffB); PG8_STAGE(PG8_SA(0, 1), cA + hstepA, voffA);
  if (wr == 1) PG8_BAR;
  PG8_WAIT_V(4); PG8_BAR;
  PG8_STAGE(PG8_SB(1, 0), cB + kstep, voffB); PG8_STAGE(PG8_SA(1, 0), cA + kstep, voffA); PG8_STAGE(PG8_SB(1, 1), cB + hstep + kstep, voffB);
  PG8_WAIT_V(6); PG8_BAR;
  for (;;) {
    const long Ln = (long)(ui + 1) * G + c;
    const bool has_next = Ln < nunits;
    if (has_next) g8::unit_of((int)Ln, nM, nN, nxt.pm, nxt.pn);
    const char* nA = has_next ? (const char*)Ag + (size_t)nxt.pm * tstepA + (size_t)(nxt.pn < pn_split ? acol0 : acol1) * 2 : cA; const char* nB = has_next ? (const char*)Btg + (size_t)nxt.pn * tstep : cB;
    for (int t = 0; t < nt; t += 2) {
      const bool last = (t == nt - 2);
      const char* a1 = cA + (size_t)(t + 1) * kstep;
      const char* a2 = last ? nA : cA + (size_t)(t + 2) * kstep; const char* b2 = last ? nB : cB + (size_t)(t + 2) * kstep;
      const char* a3 = a2 + kstep; const char* b3 = b2 + kstep;
      PG8_LDB(B0, 0, 0); PG8_SCHED; PG8_LDA(At, 0, 0); PG8_STAGE(PG8_SA(1, 1), a1 + hstepA, voffA);
      PG8_WAIT_L(8); PG8_BAR; PG8_WAIT_L(0); PG8_MMA(0, 0, At, B0); PG8_BAR; PG8_SCHED;
      PG8_LDB(B1, 0, 1); PG8_STAGE(PG8_SB(0, 0), b2, voffB);
      PG8_BAR; PG8_WAIT_L(0); PG8_MMA(0, 1, At, B1); PG8_BAR;
      PG8_LDA(At, 0, 1); PG8_STAGE(PG8_SA(0, 0), a2, voffA);
      PG8_BAR; PG8_WAIT_L(0); PG8_MMA(1, 0, At, B0); PG8_BAR; PG8_SCHED;
      PG8_STAGE(PG8_SB(0, 1), b2 + hstep, voffB);
      PG8_WAIT_V(6); PG8_BAR; PG8_MMA(1, 1, At, B1); PG8_BAR;
      PG8_LDB(B0, 1, 0); PG8_SCHED; PG8_LDA(At, 1, 0); PG8_STAGE(PG8_SA(0, 1), a2 + hstepA, voffA);
      PG8_WAIT_L(8); PG8_BAR; PG8_WAIT_L(0); PG8_MMA(0, 0, At, B0); PG8_BAR; PG8_SCHED;
      PG8_LDB(B1, 1, 1); PG8_STAGE(PG8_SB(1, 0), b3, voffB);
      PG8_BAR; PG8_WAIT_L(0); PG8_MMA(0, 1, At, B1); PG8_BAR;
      PG8_LDA(At, 1, 1); PG8_STAGE(PG8_SA(1, 0), a3, voffA);
      PG8_BAR; PG8_WAIT_L(0); PG8_MMA(1, 0, At, B0); PG8_BAR; PG8_SCHED;
      PG8_STAGE(PG8_SB(1, 1), b3 + hstep, voffB);
      PG8_WAIT_V(6); PG8_BAR; PG8_MMA(1, 1, At, B1); PG8_BAR;
    }
    E(acc, cur, wr, wc, fr, fq);
    if (!has_next) break;
#pragma unroll
    for (int a = 0; a < 2; ++a)
#pragma unroll
      for (int b = 0; b < 2; ++b)
#pragma unroll
        for (int m = 0; m < 4; ++m)
#pragma unroll
          for (int n = 0; n < 2; ++n) acc[a][b][m][n] = (f32x4){0.f, 0.f, 0.f, 0.f};
    cur = nxt; cA = nA; cB = nB; ++ui;
  }
  PG8_WAIT_V(0);
  if (wr == 0) PG8_BAR;
  PG8_BAR;
#undef PG8_SA
#undef PG8_SB
#undef PG8_STAGE
#undef PG8_LDA
#undef PG8_LDB
#undef PG8_MMA
}

struct EpiZ {
  bf16* Z;
  DEVI void operator()(const f32x4 (&acc)[2][2][4][2], const G8Unit& u, int wr, int wc, int fr, int fq) const {
    const int brow = u.pm * 256, bcol = u.pn * 256;
#pragma unroll
    for (int ai = 0; ai < 2; ++ai)
#pragma unroll
      for (int m = 0; m < 4; ++m) {
        const int row = brow + ai * 128 + wr * 64 + m * 16 + fr;
#pragma unroll
        for (int bj = 0; bj < 2; ++bj) {
          const int col = bcol + bj * 128 + wc * 32 + 8 * fq;
          if (col < DIN) {
            const f32x4 v0 = acc[ai][bj][m][0], v1 = acc[ai][bj][m][1];
            *reinterpret_cast<uint4*>(Z + (size_t)row * DIN + col) = make_uint4(pack2(v0[0], v0[1]), pack2(v0[2], v0[3]), pack2(v1[0], v1[1]), pack2(v1[2], v1[3]));
          }
        }
      }
  }
};
DEVI void phase_gemm1_8(const Params& P, int l, unsigned char* smem_base) {
  EpiZ E{P.Z};
  gemm8_phase((LAS unsigned char*)smem_base, P.H, P.WinT + (size_t)l * DINP * 1024, 1024, NT / 256, DINP / 256, E);
  const int c = blockIdx.x;
  if (c >= 136) {
    const int j = c - 136;
    if (l == 0) convert_rows_fp6(P, 0, j * 100, j * 100 + 100);
    else { const int b0 = 19200 + j * 114; convert_rows_fp6(P, 1, b0 < 32768 ? b0 : 32768, b0 + 114 < 32768 ? b0 + 114 : 32768); }
  }
}

struct EpiRAW {
  bf16* R;
  DEVI void operator()(const f32x4 (&acc)[2][2][4][2], const G8Unit& u, int wr, int wc, int fr, int fq) const {
    const int brow = u.pm * 256, bcol = u.pn * 256;
#pragma unroll
    for (int ai = 0; ai < 2; ++ai)
#pragma unroll
      for (int m = 0; m < 4; ++m) {
        const int row = brow + ai * 128 + wr * 64 + m * 16 + fr;
#pragma unroll
        for (int bj = 0; bj < 2; ++bj) {
          const int col = bcol + bj * 128 + wc * 32 + 8 * fq;
          const f32x4 v0 = acc[ai][bj][m][0], v1 = acc[ai][bj][m][1];
          *reinterpret_cast<uint4*>(R + (size_t)row * 1792 + col) = make_uint4(pack2(v0[0], v0[1]), pack2(v0[2], v0[3]), pack2(v1[0], v1[1]), pack2(v1[2], v1[3]));
        }
      }
  }
};
DEVI void phase_mla_raw(const Params& P, int l, unsigned char* smem_base) {
  EpiRAW E{P.RAW};
  gemm8_phase((LAS unsigned char*)smem_base, P.Z, P.WCOMB + (size_t)l * 1792 * 256, 256, NT / 256, 7, E, DIN, 3, ZC_BQ, ZC_BKV);
}

struct EpiX {
  const float* x; const float* ctx; bf16* X; const float* MODl; int l;
  DEVI void operator()(const f32x4 (&acc)[2][2][4][2], const G8Unit& u, int wr, int wc, int fr, int fq) const {
    const int brow = u.pm * 256, bcol = u.pn * 256;
    const float* gate = MODl + (size_t)batch_of_row(brow) * 6144 + 2048;
#pragma unroll
    for (int ai = 0; ai < 2; ++ai)
#pragma unroll
      for (int m = 0; m < 4; ++m) {
        const int row = brow + ai * 128 + wr * 64 + m * 16 + fr;
        const float* res = row < NL ? x + (size_t)row * 1024 : ctx + (size_t)(row - NL) * 1024;
#pragma unroll
        for (int bj = 0; bj < 2; ++bj) {
          const int col = bcol + bj * 128 + wc * 32 + 8 * fq;
          const f32x4 v0 = acc[ai][bj][m][0], v1 = acc[ai][bj][m][1];
          float4 ra, rb;
          if (l == 0) { ra = *reinterpret_cast<const float4*>(res + col); rb = *reinterpret_cast<const float4*>(res + col + 4); }
          else {
            const uint4 uu = *reinterpret_cast<const uint4*>(X + (size_t)row * 1024 + col);
            ra = make_float4(lo2f(uu.x), hi2f(uu.x), lo2f(uu.y), hi2f(uu.y)); rb = make_float4(lo2f(uu.z), hi2f(uu.z), lo2f(uu.w), hi2f(uu.w));
          }
          const float4 ga = *reinterpret_cast<const float4*>(gate + col), gb = *reinterpret_cast<const float4*>(gate + col + 4);
          *reinterpret_cast<uint4*>(X + (size_t)row * 1024 + col) =
              make_uint4(pack2(ra.x + ga.x * v0[0], ra.y + ga.y * v0[1]), pack2(ra.z + ga.z * v0[2], ra.w + ga.w * v0[3]),
                         pack2(rb.x + gb.x * v1[0], rb.y + gb.y * v1[1]), pack2(rb.z + gb.z * v1[2], rb.w + gb.w * v1[3]));
        }
      }
  }
};
DEVI void phase_gemm2_8(const Params& P, int l, unsigned char* smem_base) {
  EpiX E{P.x, P.ctx, P.X, P.MOD + (size_t)l * 9 * 6144, l};
  gemm8_phase((LAS unsigned char*)smem_base, P.H, P.WoutT + (size_t)l * 1024 * 1024, 1024, (l == 1) ? NL / 256 : NT / 256, 4, E);
  const int c = blockIdx.x;
  if (l == 0 && c >= 32) {
    const int b0 = 12000 + (c - 32) * 93;
    convert_rows_fp6(P, 0, b0 < 32768 ? b0 : 32768, b0 + 93 < 32768 ? b0 + 93 : 32768);
  }
}

struct EpiQP {
  bf16* QP;
  DEVI void operator()(const f32x4 (&acc)[2][2][4][2], const G8Unit& u, int wr, int wc, int fr, int fq) const {
    const int brow = u.pm * 256, bcol = u.pn * 256;
#pragma unroll
    for (int ai = 0; ai < 2; ++ai)
#pragma unroll
      for (int m = 0; m < 4; ++m) {
        const int row = brow + ai * 128 + wr * 64 + m * 16 + fr;
#pragma unroll
        for (int bj = 0; bj < 2; ++bj) {
          const int col = bcol + bj * 128 + wc * 32 + 8 * fq;
          const f32x4 v0 = acc[ai][bj][m][0], v1 = acc[ai][bj][m][1];
          *reinterpret_cast<uint4*>(QP + (size_t)row * 2048 + col) = make_uint4(pack2(v0[0], v0[1]), pack2(v0[2], v0[3]), pack2(v1[0], v1[1]), pack2(v1[2], v1[3]));
        }
      }
  }
};
DEVI void phase_gemm3_8(const Params& P, int l, unsigned char* smem_base) {
  EpiQP E{P.QP};
  gemm8_phase((LAS unsigned char*)smem_base, P.H, P.WpqT + (size_t)l * 2048 * 1024, 1024, (l == 1) ? NL / 256 : NT / 256, 8, E);
  const int c = blockIdx.x;
  if (l == 0 && c >= 64) convert_rows_fp6(P, 1, (c - 64) * 100, (c - 64) * 100 + 100);
}

constexpr int N_PHASES = 2 + 2 * 11;

#ifndef REP_MASK
#define REP_MASK 0
#endif
static_assert(sizeof(Params) % 8 == 0, "Params size");
DEVI Params load_params() {
#if defined(__HIP_DEVICE_COMPILE__)
  typedef const __attribute__((address_space(4))) Params* ParamsCP;
  ParamsCP pp = (ParamsCP)__builtin_amdgcn_kernarg_segment_ptr();
  asm volatile("" : "+s"(pp));
  return *pp;
#else
  return Params{};
#endif
}
__global__ void __launch_bounds__(512, 2) fwd_kernel(Params Pk) {
  extern __shared__ __attribute__((aligned(16))) unsigned char smem_base[];
  volatile LAS unsigned* xst = (volatile LAS unsigned*)(smem_base + SMEM_BYTES);
  if (threadIdx.x == 0) { xst[0] = 0u; xst[1] = 0u; xst[2] = 0u; xst[3] = 0u; }
  __syncthreads();
  XcdBarrier xb = xcd_barrier_post(Pk.bar, xst);
  const int phase_lo = Pk.phase_lo, phase_hi = Pk.phase_hi, coop = Pk.coop;
#define smem (smem_base + VHALF * HALF_LDS)
#define GSYNC(idx) { xcd_barrier(xb); }
#define RUN_PHASE2(idx, call, repcall) \
  if (phase_lo <= (idx) && (idx) <= phase_hi) { { const Params P = load_params(); call; } if (REP_MASK & (1 << (idx))) { GSYNC(1); const Params P = load_params(); repcall; } if (coop && (idx) < phase_hi) GSYNC(idx); }
#define RUN_PHASE(idx, call) RUN_PHASE2(idx, call, call)
  RUN_PHASE(0, phase_prologue(P, smem))
  RUN_PHASE(1, phase_norm(P, 0, 0, NT))
  RUN_PHASE(2, phase_gemm1_8(P, 0, smem_base))
  RUN_PHASE(3, phase_mla_raw(P, 0, smem_base))
  RUN_PHASE(4, { phase_mixA(P, 0, smem); phase_mla_proj(P, 0, smem); phase_hgrn_local(P, 0, smem); })
  RUN_PHASE2(5, phase_attn_scan(P, 0, smem_base), phase_attn_scan(P, 0, smem_base, true))
  RUN_PHASE(6, phase_hgrn_final(P, 0, smem))
  RUN_PHASE(7, phase_gemm2_8(P, 0, smem_base))
  RUN_PHASE(8, phase_norm(P, 0, 1, NT))
  RUN_PHASE(9, phase_gemm3_8(P, 0, smem_base))
  RUN_PHASE(10, phase_route(P, 0, smem))
  RUN_PHASE(11, phase_peer_u(P, 0))
  RUN_PHASE(12, phase_peer(P, 0))
  RUN_PHASE(13, phase_gemm1_8(P, 1, smem_base))
  RUN_PHASE(14, phase_mla_raw(P, 1, smem_base))
  RUN_PHASE(15, { phase_mixA(P, 1, smem); phase_mla_proj(P, 1, smem); phase_hgrn_local(P, 1, smem); })
  RUN_PHASE2(16, phase_attn_scan(P, 1, smem_base), phase_attn_scan(P, 1, smem_base, true))
  RUN_PHASE(17, phase_hgrn_final(P, 1, smem))
  RUN_PHASE(18, phase_gemm2_8(P, 1, smem_base))
  RUN_PHASE(19, phase_norm(P, 1, 1, NL))
  RUN_PHASE(20, phase_gemm3_8(P, 1, smem_base))
  RUN_PHASE(21, phase_route(P, 1, smem))
  RUN_PHASE(22, phase_peer_u(P, 1))
  RUN_PHASE(23, phase_peer(P, 1))
#undef smem
}

extern "C" void kernel_launch(void* const* d_in, const int* in_sizes, int n_in, void* d_out, int out_size, void* d_ws,
                              size_t ws_size, hipStream_t stream) {
  Params p{};
  const float* const* in = reinterpret_cast<const float* const*>(d_in);
  p.x = in[0]; p.c = in[1]; p.ctx = in[2]; p.c_ctx = in[3]; p.ln1_w = in[4]; p.ln2_w = in[5]; p.w_mod = in[6]; p.b_mod = in[7];
  p.w_in = in[8]; p.w_out = in[9]; p.a_norm_w = in[10]; p.a_w_s = in[11]; p.a_b_s = in[12]; p.b_q_norm_w = in[13]; p.b_w_uq = in[14];
  p.b_kv_norm_w = in[15]; p.b_w_ukv = in[16]; p.b_qh_w = in[17]; p.b_kh_w = in[18]; p.c_lb = in[19]; p.c_out_norm_w = in[20];
  p.p_w_q = in[21]; p.p_sub_keys = in[22]; p.p_u = in[23]; p.p_v = in[24];
  p.out = reinterpret_cast<float*>(d_out);
  unsigned char* ws = reinterpret_cast<unsigned char*>(d_ws);
  size_t off = 0;
  auto take = [&](size_t bytes) { unsigned char* r = ws + off; off += (bytes + 255) & ~(size_t)255; return r; };
  p.bar = (unsigned*)take((size_t)XCD_BAR_WORDS * 4);
  p.MOD = (float*)take((size_t)2 * 9 * 6144 * 4);
  p.ROPE = (float*)take((size_t)2048 * 32 * 4);
  p.WinT = (bf16*)take((size_t)2 * DINP * 1024 * 2);
  p.WoutT = (bf16*)take((size_t)2 * 1024 * 1024 * 2);
  p.WpqT = (bf16*)take((size_t)2 * 2048 * 1024 * 2);
  p.WCOMB = (bf16*)take((size_t)2 * 1792 * 256 * 2);
  p.RAW = (bf16*)take((size_t)NT * 1792 * 2);
  p.SK = (bf16*)take((size_t)2 * 16 * 128 * 128 * 2);
  p.AWS = (bf16*)take((size_t)2 * 4 * 128 * 128 * 2);
  p.PU8 = (unsigned char*)take((size_t)2 * 16384 * 576);
  p.PV8 = (unsigned char*)take((size_t)2 * 16384 * 576);
  p.PUS = (float*)take((size_t)2 * 16384 * 4);
  p.PVS = (float*)take((size_t)2 * 16384 * 4);
  p.X = (bf16*)take((size_t)NT * 1024 * 2);
  p.H = (bf16*)take((size_t)NT * 1024 * 2);
  p.Z = (bf16*)take((size_t)NT * DIN * 2);
  p.Q = (bf16*)take((size_t)64 * SEQP * 96 * 2);
  p.K = (bf16*)take((size_t)64 * SEQP * 96 * 2);
  p.VT = (bf16*)take((size_t)64 * 64 * SEQP * 2);
  p.ST = (bf16*)take((size_t)64 * 36 * 4096 * 2);
  p.DEC = (float*)take((size_t)64 * 36 * 64 * 4);
  p.OI = (bf16*)take((size_t)NT * 256 * 2);
  p.WPE = (float*)take((size_t)NT * 128 * 4);
  p.GQF = (bf16*)take((size_t)NT * 256 * 2);
  p.GQB = (bf16*)take((size_t)NT * 256 * 2);
  p.QP = p.Z;
  p.EIDX = (int*)p.Q;
  p.GATE = (float*)p.K;
  if (off > ws_size) { fprintf(stderr, "workspace too small: need %zu have %zu\n", off, ws_size); }
  static int grid_blocks = 0;
  if (!grid_blocks) {
    if (hipFuncSetAttribute((const void*)fwd_kernel, hipFuncAttributeMaxDynamicSharedMemorySize, SMEM_TOTAL) != hipSuccess)
      fprintf(stderr, "hipFuncSetAttribute failed\n");
    int dev = 0, cus = 0, per_cu = 0;
    hipGetDevice(&dev);
    hipDeviceGetAttribute(&cus, hipDeviceAttributeMultiprocessorCount, dev);
    hipOccupancyMaxActiveBlocksPerMultiprocessor(&per_cu, (const void*)fwd_kernel, 512, SMEM_TOTAL);
    if (per_cu > 1) per_cu = 1;
    if (per_cu < 1) { fprintf(stderr, "occupancy query returned %d\n", per_cu); per_cu = 1; }
    grid_blocks = cus * per_cu;
    fprintf(stderr, "grid_blocks=%d (cus=%d per_cu=%d) ws need=%zu have=%zu\n", grid_blocks, cus, per_cu, off, ws_size);
  }
  hipMemsetAsync(p.bar, 0, (size_t)XCD_BAR_WORDS * 4, stream);
  p.coop = 1; p.phase_lo = 0; p.phase_hi = N_PHASES - 1;
  hipLaunchKernelGGL(fwd_kernel, dim3(grid_blocks), dim3(512), SMEM_TOTAL, stream, p);
  const hipError_t e = hipPeekAtLastError();
  if (e != hipSuccess) fprintf(stderr, "launch failed: %s (grid %d)\n", hipGetErrorString(e), grid_blocks);
}
```

```cpp
#include <hip/hip_runtime.h>
#include <hip/hip_cooperative_groups.h>
#include <cstdio>
#include <cstdint>
namespace cg = cooperative_groups;

#define DEVI __device__ __forceinline__

typedef unsigned short bf16;
using bf16x8 = __attribute__((ext_vector_type(8))) __bf16;
using bf16x2 = __attribute__((ext_vector_type(2))) __bf16;
using f32x16 = __attribute__((ext_vector_type(16))) float;
typedef unsigned v6u __attribute__((ext_vector_type(6)));
typedef unsigned v3u __attribute__((ext_vector_type(3)));
typedef float v16f __attribute__((ext_vector_type(16)));
typedef float v32f __attribute__((ext_vector_type(32)));

constexpr int NL = 16384;
constexpr int NT = 18432;
constexpr int DM = 1024;
constexpr int DIN = 2208;
constexpr int DINP = 2304;
constexpr int SEQP = 2304;
constexpr float EPS = 1e-6f;
constexpr int ZC_AU = 0, ZC_AV = 256, ZC_BQ = 512, ZC_BKV = 768, ZC_BKR = 896, ZC_CQ = 928, ZC_CFF = 1184, ZC_CFB = 1440, ZC_CI = 1696, ZC_CG = 1952;
constexpr int SMEM_BYTES = 2 * 80896;
constexpr int SMEM_TOTAL = SMEM_BYTES + 16;

struct Params {
  const float *x, *c, *ctx, *c_ctx, *ln1_w, *ln2_w, *w_mod, *b_mod, *w_in, *w_out, *a_norm_w, *a_w_s, *a_b_s;
  const float *b_q_norm_w, *b_w_uq, *b_kv_norm_w, *b_w_ukv, *b_qh_w, *b_kh_w, *c_lb, *c_out_norm_w, *p_w_q, *p_sub_keys, *p_u, *p_v;
  float* out;
  unsigned* bar;
  float* MOD;
  float* ROPE;
  bf16* WinT;
  bf16* WoutT;
  bf16* WpqT;
  bf16* WCOMB;
  bf16* RAW;
  bf16* SK;
  bf16* AWS;
  unsigned char* PU8;
  unsigned char* PV8;
  float* PUS;
  float* PVS;
  bf16* X;
  bf16* H;
  bf16* Z;
  bf16* Q;
  bf16* K;
  bf16* VT;
  bf16* ST;
  float* DEC;
  bf16* OI;
  float* WPE;
  bf16* GQF;
  bf16* GQB;
  bf16* QP;
  int* EIDX;
  float* GATE;
  int phase_lo, phase_hi, coop, pad0;
};

DEVI float bf2f(bf16 v) { return __uint_as_float(((unsigned)v) << 16); }
DEVI bf16 f2bf(float a) { __bf16 v = (__bf16)a; return __builtin_bit_cast(unsigned short, v); }
DEVI unsigned pack2(float a, float b) { bf16x2 v; v[0] = (__bf16)a; v[1] = (__bf16)b; return __builtin_bit_cast(unsigned, v); }
DEVI float lo2f(unsigned u) { return __uint_as_float(u << 16); }
DEVI float hi2f(unsigned u) { return __uint_as_float(u & 0xffff0000u); }
DEVI f32x16 zero16() { f32x16 z;
#pragma unroll
  for (int i = 0; i < 16; ++i) z[i] = 0.f; return z; }
DEVI f32x16 mfma32(bf16x8 a, bf16x8 b, f32x16 c) { return __builtin_amdgcn_mfma_f32_32x32x16_bf16(a, b, c, 0, 0, 0); }
DEVI bf16x8 ldfrag(const bf16* p) { return *reinterpret_cast<const bf16x8*>(p); }
DEVI int drow(int r, int hh) { return (r & 3) + 8 * (r >> 2) + 4 * hh; }
DEVI int row_of(int b, int p) { return p < 256 ? NL + b * 256 + p : b * 2048 + (p - 256); }
DEVI int batch_of_row(int r) { return r < NL ? (r >> 11) : 8; }
DEVI float wave_sum(float v) {
#pragma unroll
  for (int o = 32; o > 0; o >>= 1) v += __shfl_xor(v, o);
  return v;
}
DEVI float sigmoidf_(float z) { return 1.f / (1.f + __expf(-z)); }


#define XB_TMO      128
#define XB_XCNT(j)  (256  + 64 * (j))
#define XB_XSUB(j)  (1280 + 64 * (j))
#define XB_XGEN(j)  (2304 + 64 * (j))
#define XB_TOP      3328
#define XB_TOPGEN   3392
#define XCD_BAR_WORDS 3456
#define XB_SPIN_CAP (1u << 22)
#define LAS __attribute__((address_space(3)))
DEVI unsigned xb_ld(unsigned* p)              { return __hip_atomic_load(p, __ATOMIC_RELAXED, __HIP_MEMORY_SCOPE_AGENT); }
DEVI unsigned xb_add(unsigned* p, unsigned v) { return __hip_atomic_fetch_add(p, v, __ATOMIC_RELAXED, __HIP_MEMORY_SCOPE_AGENT); }
DEVI unsigned xb_xcc_id() { return (unsigned)__builtin_amdgcn_s_getreg((3 << 11) | 20) & 0xFu; }
#define XB_SPIN(cond, bar) do { unsigned _sp = 0; while (cond) { __builtin_amdgcn_s_sleep(1); \
    if ((++_sp & 255u) == 0u) { if (xb_ld(&(bar)[XB_TMO])) break; if (_sp > XB_SPIN_CAP) { atomicAdd(&(bar)[XB_TMO], 1u); break; } } } } while (0)
struct XcdBarrier { unsigned* bar; unsigned x; volatile LAS unsigned* st; };
DEVI XcdBarrier xcd_barrier_post(unsigned* bar, volatile LAS unsigned* st) {
  XcdBarrier b; b.bar = bar; b.x = xb_xcc_id(); b.st = st;
  if (threadIdx.x == 0) (void)xb_add(&bar[XB_XCNT(b.x)], 1u);
  return b;
}
DEVI void xcd_barrier_complete(unsigned* bar, unsigned x, unsigned& nloc, unsigned& nx) {
  const unsigned G = gridDim.x * gridDim.y * gridDim.z;
  unsigned sum, cnt, mine, sp = 0u;
  for (;;) {
    sum = 0u; cnt = 0u; mine = 0u;
#pragma unroll
    for (unsigned j = 0; j < 16; ++j) { const unsigned c = xb_ld(&bar[XB_XCNT(j)]); sum += c; cnt += (c > 0u) ? 1u : 0u; mine = (j == x) ? c : mine; }
    if (sum == G) break;
    __builtin_amdgcn_s_sleep(1);
    if ((++sp & 255u) == 0u) { if (xb_ld(&bar[XB_TMO])) break; if (sp > XB_SPIN_CAP) { atomicAdd(&bar[XB_TMO], 1u); break; } }
  }
  nloc = mine > 0u ? mine : 1u; nx = cnt > 0u ? cnt : 1u;
}
DEVI void xcd_barrier(const XcdBarrier& b) {
  asm volatile("s_waitcnt vmcnt(0)" ::: "memory");
  __syncthreads();
  if (threadIdx.x == 0) {
    unsigned* bar = b.bar;
    __builtin_amdgcn_s_waitcnt(0);
    unsigned nloc = b.st[0], nx = b.st[1];
    if (nloc == 0u) { xcd_barrier_complete(bar, b.x, nloc, nx); b.st[0] = nloc; b.st[1] = nx; }
    const unsigned old = xb_add(&bar[XB_XSUB(b.x)], 1u);
    const unsigned gen = old / nloc;
    if (old + 1u == (gen + 1u) * nloc) {
      __builtin_amdgcn_fence(__ATOMIC_RELEASE, "agent");
      asm volatile("s_waitcnt vmcnt(0)" ::: "memory");
      const unsigned og = xb_add(&bar[XB_TOP], 1u);
      const unsigned tg = og / nx;
      if (og + 1u == (tg + 1u) * nx) xb_add(&bar[XB_TOPGEN], 1u);
      else XB_SPIN(xb_ld(&bar[XB_TOPGEN]) == tg, bar);
      __builtin_amdgcn_fence(__ATOMIC_ACQUIRE, "agent");
      xb_add(&bar[XB_XGEN(b.x)], 1u);
      asm volatile("s_waitcnt vmcnt(0)" ::: "memory");
    } else {
      XB_SPIN(xb_ld(&bar[XB_XGEN(b.x)]) == gen, bar);
      __builtin_amdgcn_fence(__ATOMIC_ACQUIRE, "agent");
      asm volatile("s_waitcnt vmcnt(0)" ::: "memory");
    }
  }
  __syncthreads();
}

#define VHALF ((int)__builtin_amdgcn_readfirstlane((int)(threadIdx.x >> 8)))
#define TIDX ((int)(threadIdx.x & 255))
#define VBID ((int)(blockIdx.x * 2 + VHALF))
#define NVB ((int)(gridDim.x * 2))
constexpr int HALF_LDS = 80896;

DEVI void phase_mod(const Params& P, unsigned char* smem) {
  const int tid = TIDX;
  float* s = (float*)smem;
  float* red = s + 9 * 1024;
  for (int item = VBID; item < 192; item += NVB) {
    const int l = item / 96, j = item % 96;
    __syncthreads();
    for (int i = tid; i < 9 * 1024; i += 256) {
      int bi = i >> 10, k = i & 1023;
      float v = bi < 8 ? P.c[bi * 1024 + k] : P.c_ctx[k];
      s[i] = v * sigmoidf_(v);
    }
    __syncthreads();
    const int c4 = tid & 15, kg = tid >> 4;
    float acc[9][4];
#pragma unroll
    for (int bi = 0; bi < 9; ++bi) { acc[bi][0] = acc[bi][1] = acc[bi][2] = acc[bi][3] = 0.f; }
    const float* w = P.w_mod + (size_t)l * 1024 * 6144 + j * 64 + c4 * 4;
#pragma unroll 4
    for (int kk = 0; kk < 64; ++kk) {
      const int k = kg * 64 + kk;
      const float4 w4 = *reinterpret_cast<const float4*>(w + (size_t)k * 6144);
#pragma unroll
      for (int bi = 0; bi < 9; ++bi) {
        const float sv = s[bi * 1024 + k];
        acc[bi][0] += sv * w4.x; acc[bi][1] += sv * w4.y; acc[bi][2] += sv * w4.z; acc[bi][3] += sv * w4.w;
      }
    }
#pragma unroll
    for (int bi = 0; bi < 9; ++bi)
#pragma unroll
      for (int e = 0; e < 4; ++e) red[(kg * 9 + bi) * 64 + c4 * 4 + e] = acc[bi][e];
    __syncthreads();
    for (int o = tid; o < 576; o += 256) {
      const int bi = o >> 6, cc = o & 63;
      float sum = 0.f;
#pragma unroll
      for (int g = 0; g < 16; ++g) sum += red[(g * 9 + bi) * 64 + cc];
      P.MOD[(size_t)(l * 9 + bi) * 6144 + j * 64 + cc] = sum + P.b_mod[l * 6144 + j * 64 + cc];
    }
  }
}

DEVI void conv_T_tile(const float* __restrict__ src, int N, bf16* __restrict__ dst, int Kd, int k0, int n0,
                      const float* __restrict__ kscale, float* tile) {
  const int tid = TIDX;
  __syncthreads();
  for (int e = tid; e < 4096; e += 256) {
    const int i = e >> 6, j = e & 63, n = n0 + j;
    float v = (n < N) ? src[(size_t)(k0 + i) * N + n] : 0.f;
    if (kscale) v *= kscale[k0 + i];
    tile[i * 65 + j] = v;
  }
  __syncthreads();
  for (int e = tid; e < 2048; e += 256) {
    const int j = e >> 5, i2 = (e & 31) * 2;
    const unsigned pk = pack2(tile[i2 * 65 + j], tile[(i2 + 1) * 65 + j]);
    *reinterpret_cast<unsigned*>(&dst[(size_t)(n0 + j) * Kd + k0 + i2]) = pk;
  }
}

DEVI void conv_straight(const float* __restrict__ src, bf16* __restrict__ dst, size_t n8) {
  const size_t stride = (size_t)NVB * 256;
  for (size_t i = (size_t)VBID * 256 + TIDX; i < n8; i += stride) {
    const float4 a = reinterpret_cast<const float4*>(src)[2 * i];
    const float4 b = reinterpret_cast<const float4*>(src)[2 * i + 1];
    uint4 o; o.x = pack2(a.x, a.y); o.y = pack2(a.z, a.w); o.z = pack2(b.x, b.y); o.w = pack2(b.z, b.w);
    reinterpret_cast<uint4*>(dst)[i] = o;
  }
}

DEVI void convert_rows_fp6(const Params& P, int L, int i0, int i1) {
  const int lane = threadIdx.x & 63, half = lane >> 5, l32 = lane & 31;
  const int wv = threadIdx.x >> 6;
  for (int ib = i0 + wv * 2; ib < i1; ib += 16) {
    int i = ib + half; const bool live = i < i1; if (!live) i = i1 - 1;
    const int table = i >> 14, lr = L * 16384 + (i & 16383);
    const float* src = (table ? P.p_v : P.p_u) + (size_t)lr * 1024 + l32 * 32;
    float4 a[8];
    float m = 0.f;
#pragma unroll
    for (int q = 0; q < 8; ++q) {
      a[q] = *reinterpret_cast<const float4*>(src + q * 4);
      m = fmaxf(m, fmaxf(fmaxf(fabsf(a[q].x), fabsf(a[q].y)), fmaxf(fabsf(a[q].z), fabsf(a[q].w))));
    }
    const unsigned sb = (__float_as_uint(fmaxf(m, 1e-30f) * (1.f / 6.f)) + 0xffffu) >> 16;
    const float inv = 1.f / __uint_as_float(sb << 16);
    unsigned pk[4];
#pragma unroll
    for (int w = 0; w < 4; ++w) {
      unsigned word = 0u;
#pragma unroll
      for (int e = 0; e < 8; ++e) {
        const int idx = w * 8 + e;
        const float4 q4 = a[idx >> 2];
        const float xv = ((idx & 3) == 0 ? q4.x : (idx & 3) == 1 ? q4.y : (idx & 3) == 2 ? q4.z : q4.w) * inv;
        const float av = fabsf(xv);
        unsigned ci = (av > 0.25f) + (av > 0.75f) + (av > 1.25f) + (av > 1.75f) + (av > 2.5f) + (av > 3.5f) + (av > 5.f);
        ci |= (xv < 0.f) ? 8u : 0u;
        word |= ci << (4 * e);
      }
      pk[w] = word;
    }
    unsigned char* rowp = (table ? P.PV8 : P.PU8) + (size_t)lr * 576;
    if (live) {
      *reinterpret_cast<uint4*>(rowp + l32 * 16) = make_uint4(pk[0], pk[1], pk[2], pk[3]);
      *reinterpret_cast<unsigned short*>(rowp + 512 + l32 * 2) = (unsigned short)sb;
    }
  }
}

DEVI void phase_prologue(const Params& P, unsigned char* smem) {
  phase_mod(P, smem);
  float* tile = (float*)smem;
  for (int it = VBID; it < 2 * 1424; it += NVB) {
    const int l = it / 1424; int r = it % 1424;
    if (r < 576) { conv_T_tile(P.w_in + (size_t)l * 1024 * DIN, DIN, P.WinT + (size_t)l * DINP * 1024, 1024, (r % 16) * 64, (r / 16) * 64, nullptr, tile); continue; }
    r -= 576;
    if (r < 256) { conv_T_tile(P.w_out + (size_t)l * 1024 * 1024, 1024, P.WoutT + (size_t)l * 1024 * 1024, 1024, (r % 16) * 64, (r / 16) * 64, nullptr, tile); continue; }
    r -= 256;
    if (r < 512) { conv_T_tile(P.p_w_q + (size_t)l * 1024 * 2048, 2048, P.WpqT + (size_t)l * 2048 * 1024, 1024, (r % 16) * 64, (r / 16) * 64, nullptr, tile); continue; }
    r -= 512;
    if (r < 48) { conv_T_tile(P.b_w_uq + (size_t)l * 256 * 768, 768, P.WCOMB + (size_t)l * 1792 * 256, 256, (r % 4) * 64, (r / 4) * 64, P.b_q_norm_w + l * 256, tile); continue; }
    r -= 48;
    conv_T_tile(P.b_w_ukv + (size_t)l * 128 * 1024, 1024, P.WCOMB + (size_t)l * 1792 * 256 + 768 * 256, 256, (r % 2) * 64, (r / 2) * 64, P.b_kv_norm_w + l * 128, tile);
  }
  for (int i = VBID * 256 + TIDX; i < 2 * 1024 * 16; i += NVB * 256) {
    const int l2 = i >> 14, rr = (i >> 4) & 1023, cc = i & 15;
    *reinterpret_cast<uint4*>(P.WCOMB + (size_t)l2 * 1792 * 256 + (size_t)(768 + rr) * 256 + 128 + cc * 8) = make_uint4(0u, 0u, 0u, 0u);
  }
  conv_straight(P.p_sub_keys, P.SK, (size_t)2 * 16 * 128 * 128 / 8);
  conv_straight(P.a_w_s, P.AWS, (size_t)2 * 4 * 128 * 128 / 8);
  for (int i = VBID * 256 + TIDX; i < 2048 * 16; i += NVB * 256) {
    const int t = i >> 4, a = (i >> 3) & 1, f = i & 7;
    const float inv = powf(10000.f, -(float)f / 8.f);
    const float pos = a ? (float)(t & 63) : (float)(t >> 6);
    const float ang = pos * inv;
    P.ROPE[t * 32 + a * 8 + f] = cosf(ang);
    P.ROPE[t * 32 + 16 + a * 8 + f] = sinf(ang);
  }
}

DEVI void phase_norm(const Params& P, int l, int which, int nrows) {
  const int lane = TIDX & 63;
  const int gw = VBID * 4 + (TIDX >> 6), nw = NVB * 4;
  const float* lnw = (which == 0 ? P.ln1_w : P.ln2_w) + l * 1024;
  for (int r = gw; r < nrows; r += nw) {
    const float* mod = P.MOD + (size_t)(l * 9 + batch_of_row(r)) * 6144 + which * 3072;
    float4 v[4];
    float ss = 0.f;
    if (which == 0 && l == 0) {
      const float* src = r < NL ? P.x + (size_t)r * 1024 : P.ctx + (size_t)(r - NL) * 1024;
#pragma unroll
      for (int i = 0; i < 4; ++i) v[i] = *reinterpret_cast<const float4*>(src + i * 256 + lane * 4);
    } else {
      const bf16* src = P.X + (size_t)r * 1024;
#pragma unroll
      for (int i = 0; i < 4; ++i) {
        const uint2 u = *reinterpret_cast<const uint2*>(src + i * 256 + lane * 4);
        v[i] = make_float4(lo2f(u.x), hi2f(u.x), lo2f(u.y), hi2f(u.y));
      }
    }
#pragma unroll
    for (int i = 0; i < 4; ++i) ss += v[i].x * v[i].x + v[i].y * v[i].y + v[i].z * v[i].z + v[i].w * v[i].w;
    ss = wave_sum(ss);
    const float rr = rsqrtf(ss * (1.f / 1024.f) + EPS);
#pragma unroll
    for (int i = 0; i < 4; ++i) {
      const int d = i * 256 + lane * 4;
      const float4 w = *reinterpret_cast<const float4*>(lnw + d);
      const float4 sh = *reinterpret_cast<const float4*>(mod + d);
      const float4 sc = *reinterpret_cast<const float4*>(mod + 1024 + d);
      const float o0 = v[i].x * rr * w.x * (1.f + sc.x) + sh.x;
      const float o1 = v[i].y * rr * w.y * (1.f + sc.y) + sh.y;
      const float o2 = v[i].z * rr * w.z * (1.f + sc.z) + sh.z;
      const float o3 = v[i].w * rr * w.w * (1.f + sc.w) + sh.w;
      uint2 o; o.x = pack2(o0, o1); o.y = pack2(o2, o3);
      *reinterpret_cast<uint2*>(P.H + (size_t)r * 1024 + d) = o;
    }
  }
}

template <int BM, int BN, int BK, int WM, int WN>
struct Gemm {
  static constexpr int LDK = BK + 8;
  static constexpr int TM = BM / WM / 32, TN = BN / WN / 32;
  static constexpr int CPR = BK / 8;
  static constexpr int NA = BM * CPR / 256, NB = BN * CPR / 256;
  static constexpr int A_BYTES = BM * LDK * 2, B_BYTES = BN * LDK * 2;
  static constexpr int STAGE_BYTES = A_BYTES + B_BYTES;
  static constexpr int SMEM = 2 * STAGE_BYTES;

  static DEVI void run(const bf16* __restrict__ A, int lda, const bf16* __restrict__ BT, int ldb, int K,
                       unsigned char* smem, f32x16 (&acc)[TM][TN]) {
    const int tid = TIDX, lane = tid & 63, wave = tid >> 6;
    const int wm = wave / WN, wn = wave % WN;
    const int l31 = lane & 31, hh = lane >> 5;
#pragma unroll
    for (int i = 0; i < TM; ++i)
#pragma unroll
      for (int j = 0; j < TN; ++j) acc[i][j] = zero16();
    uint4 ra[NA], rb[NB];
    const int nk = K / BK;
    auto gload = [&](int kt) {
#pragma unroll
      for (int i = 0; i < NA; ++i) { const int ch = tid + i * 256, row = ch / CPR, cc = ch % CPR;
        ra[i] = *reinterpret_cast<const uint4*>(A + (size_t)row * lda + kt * BK + cc * 8); }
#pragma unroll
      for (int i = 0; i < NB; ++i) { const int ch = tid + i * 256, row = ch / CPR, cc = ch % CPR;
        rb[i] = *reinterpret_cast<const uint4*>(BT + (size_t)row * ldb + kt * BK + cc * 8); }
    };
    auto swrite = [&](int buf) {
      bf16* sA = reinterpret_cast<bf16*>(smem + buf * STAGE_BYTES);
      bf16* sB = reinterpret_cast<bf16*>(smem + buf * STAGE_BYTES + A_BYTES);
#pragma unroll
      for (int i = 0; i < NA; ++i) { const int ch = tid + i * 256, row = ch / CPR, cc = ch % CPR;
        *reinterpret_cast<uint4*>(sA + row * LDK + cc * 8) = ra[i]; }
#pragma unroll
      for (int i = 0; i < NB; ++i) { const int ch = tid + i * 256, row = ch / CPR, cc = ch % CPR;
        *reinterpret_cast<uint4*>(sB + row * LDK + cc * 8) = rb[i]; }
    };
    __syncthreads();
    gload(0);
    swrite(0);
    __syncthreads();
    for (int kt = 0; kt < nk; ++kt) {
      const int cur = kt & 1;
      if (kt + 1 < nk) gload(kt + 1);
      const bf16* sA = reinterpret_cast<const bf16*>(smem + cur * STAGE_BYTES);
      const bf16* sB = reinterpret_cast<const bf16*>(smem + cur * STAGE_BYTES + A_BYTES);
#pragma unroll
      for (int ks = 0; ks < BK / 16; ++ks) {
        bf16x8 af[TM], bfr[TN];
#pragma unroll
        for (int i = 0; i < TM; ++i) af[i] = ldfrag(sA + (wm * (BM / WM) + i * 32 + l31) * LDK + ks * 16 + hh * 8);
#pragma unroll
        for (int j = 0; j < TN; ++j) bfr[j] = ldfrag(sB + (wn * (BN / WN) + j * 32 + l31) * LDK + ks * 16 + hh * 8);
#pragma unroll
        for (int i = 0; i < TM; ++i)
#pragma unroll
          for (int j = 0; j < TN; ++j) acc[i][j] = mfma32(af[i], bfr[j], acc[i][j]);
      }
      if (kt + 1 < nk) swrite(cur ^ 1);
      __syncthreads();
    }
  }
};

DEVI void phase_gemm1(const Params& P, int l, unsigned char* smem) {
  using G = Gemm<128, 128, 64, 2, 2>;
  const int lane = TIDX & 63, wave = TIDX >> 6, wm = wave >> 1, wn = wave & 1, l31 = lane & 31, hh = lane >> 5;
  const bf16* W = P.WinT + (size_t)l * DINP * 1024;
  for (int t = VBID; t < 144 * 18; t += NVB) {
    const int mt = t / 18, nt = t % 18;
    f32x16 acc[2][2];
    G::run(P.H + (size_t)mt * 128 * 1024, 1024, W + (size_t)nt * 128 * 1024, 1024, 1024, smem, acc);
#pragma unroll
    for (int i = 0; i < 2; ++i)
#pragma unroll
      for (int j = 0; j < 2; ++j) {
        const int col = nt * 128 + wn * 64 + j * 32 + l31;
        if (col < DIN) {
#pragma unroll
          for (int r = 0; r < 16; ++r) {
            const int row = mt * 128 + wm * 64 + i * 32 + drow(r, hh);
            P.Z[(size_t)row * DIN + col] = f2bf(acc[i][j][r]);
          }
        }
      }
  }
}

DEVI void phase_gemm2(const Params& P, int l, unsigned char* smem) {
  using G = Gemm<128, 128, 64, 2, 2>;
  const int lane = TIDX & 63, wave = TIDX >> 6, wm = wave >> 1, wn = wave & 1, l31 = lane & 31, hh = lane >> 5;
  const bf16* W = P.WoutT + (size_t)l * 1024 * 1024;
  const int mtiles = (l == 1) ? 128 : 144;
  for (int t = VBID; t < mtiles * 8; t += NVB) {
    const int mt = t / 8, nt = t % 8;
    f32x16 acc[2][2];
    G::run(P.H + (size_t)mt * 128 * 1024, 1024, W + (size_t)nt * 128 * 1024, 1024, 1024, smem, acc);
    const int bi = batch_of_row(mt * 128);
    const float* gate = P.MOD + (size_t)(l * 9 + bi) * 6144 + 2048;
#pragma unroll
    for (int i = 0; i < 2; ++i)
#pragma unroll
      for (int j = 0; j < 2; ++j) {
        const int col = nt * 128 + wn * 64 + j * 32 + l31;
        const float g = gate[col];
#pragma unroll
        for (int r = 0; r < 16; ++r) {
          const int row = mt * 128 + wm * 64 + i * 32 + drow(r, hh);
          float res;
          if (l == 0) res = row < NL ? P.x[(size_t)row * 1024 + col] : P.ctx[(size_t)(row - NL) * 1024 + col];
          else res = bf2f(P.X[(size_t)row * 1024 + col]);
          P.X[(size_t)row * 1024 + col] = f2bf(res + g * acc[i][j][r]);
        }
      }
  }
}

DEVI void phase_mixA(const Params& P, int l, unsigned char* smem) {
  const int tid = TIDX, lane = tid & 63, wave = tid >> 6, l31 = lane & 31, hh = lane >> 5;
  bf16* VNT = reinterpret_cast<bf16*>(smem);
  constexpr int LDV = 136;
  const int nseg = (l == 1) ? 16 : 18;
  const int seg0 = (l == 1) ? 2 : 0;
  for (int it = VBID; it < 8 * nseg * 4; it += NVB) {
    const int a = it & 3; const int sj = (it >> 2) % nseg + seg0; const int b = (it >> 2) / nseg;
    const int p0 = sj * 128;
    __syncthreads();
    {
      const int q = tid >> 1, half = tid & 1;
      const int row = row_of(b, p0 + q);
      const bf16* src = P.Z + (size_t)row * DIN + ZC_AV + a * 64 + half * 32;
      float v[32];
      float ss = 0.f;
#pragma unroll
      for (int i = 0; i < 4; ++i) {
        const uint4 u = *reinterpret_cast<const uint4*>(src + i * 8);
        v[i * 8 + 0] = lo2f(u.x); v[i * 8 + 1] = hi2f(u.x); v[i * 8 + 2] = lo2f(u.y); v[i * 8 + 3] = hi2f(u.y);
        v[i * 8 + 4] = lo2f(u.z); v[i * 8 + 5] = hi2f(u.z); v[i * 8 + 6] = lo2f(u.w); v[i * 8 + 7] = hi2f(u.w);
      }
#pragma unroll
      for (int i = 0; i < 32; ++i) ss += v[i] * v[i];
      ss += __shfl_xor(ss, 1);
      const float rr = rsqrtf(ss * (1.f / 64.f) + EPS);
      const float* nw = P.a_norm_w + l * 256 + a * 64 + half * 32;
#pragma unroll
      for (int i = 0; i < 32; ++i) VNT[(half * 32 + i) * LDV + q] = f2bf(v[i] * rr * nw[i]);
    }
    __syncthreads();
    f32x16 acc[2]; acc[0] = zero16(); acc[1] = zero16();
    const bf16* Aw = P.AWS + (size_t)(l * 4 + a) * 128 * 128 + (size_t)(wave * 32 + l31) * 128;
#pragma unroll
    for (int ks = 0; ks < 8; ++ks) {
      const bf16x8 af = ldfrag(Aw + ks * 16 + hh * 8);
#pragma unroll
      for (int j = 0; j < 2; ++j) {
        const bf16x8 bfr = ldfrag(VNT + (j * 32 + l31) * LDV + ks * 16 + hh * 8);
        acc[j] = mfma32(af, bfr, acc[j]);
      }
    }
    const float* bs = P.a_b_s + (l * 4 + a) * 128;
#pragma unroll
    for (int j = 0; j < 2; ++j)
#pragma unroll
      for (int r = 0; r < 16; ++r) {
        const int p = wave * 32 + drow(r, hh);
        const int row = row_of(b, p0 + p);
        const int col = a * 64 + j * 32 + l31;
        const float u = bf2f(P.Z[(size_t)row * DIN + ZC_AU + col]);
        P.H[(size_t)row * 1024 + col] = f2bf(u * (acc[j][r] + bs[p]));
      }
  }
}

DEVI void mla_norm_rope_store(const Params& P, const float* T, const float* nw, bool rope, float oscale,
                              bf16* dstbase  , int pos0, int tlat0) {
  const int tid = TIDX, tok = tid >> 1, half = tid & 1;
  float v[48];
  float ss = 0.f;
#pragma unroll
  for (int i = 0; i < 48; ++i) { v[i] = T[tok * 97 + half * 48 + i]; ss += v[i] * v[i]; }
  ss += __shfl_xor(ss, 1);
  const float rr = rsqrtf(ss * (1.f / 96.f) + EPS);
#pragma unroll
  for (int i = 0; i < 48; ++i) v[i] = v[i] * rr * nw[half * 48 + i];
  if (rope && half == 1) {
    const float* cs = P.ROPE + (size_t)(tlat0 + tok) * 32;
#pragma unroll
    for (int a = 0; a < 2; ++a)
#pragma unroll
      for (int f = 0; f < 8; ++f) {
        const float x1 = v[16 + a * 16 + f], x2 = v[16 + a * 16 + 8 + f];
        const float c = cs[a * 8 + f], s = cs[16 + a * 8 + f];
        v[16 + a * 16 + f] = x1 * c - x2 * s;
        v[16 + a * 16 + 8 + f] = x2 * c + x1 * s;
      }
  }
  bf16* dst = dstbase + (size_t)(pos0 + tok) * 96 + half * 48;
#pragma unroll
  for (int i = 0; i < 6; ++i) {
    uint4 o;
    o.x = pack2(v[i * 8 + 0] * oscale, v[i * 8 + 1] * oscale); o.y = pack2(v[i * 8 + 2] * oscale, v[i * 8 + 3] * oscale);
    o.z = pack2(v[i * 8 + 4] * oscale, v[i * 8 + 5] * oscale); o.w = pack2(v[i * 8 + 6] * oscale, v[i * 8 + 7] * oscale);
    *reinterpret_cast<uint4*>(dst + i * 8) = o;
  }
}

DEVI void phase_mla_proj(const Params& P, int l, unsigned char* smem) {
  const int tid = TIDX;
  float* T = reinterpret_cast<float*>(smem);
  bf16* TV = reinterpret_cast<bf16*>(smem + 128 * 97 * 4);
  const float qscale = 0.10206207261596577f * 1.4426950408889634f;
  const int tok = tid >> 1, half = tid & 1;
  for (int it = (VBID + NVB - 64) % NVB; it < 144 * 8; it += NVB) {
    const int h = it & 7;
    const int m0 = (it >> 3) * 128;
    const bool lat = m0 < NL;
    const int b = lat ? (m0 >> 11) : ((m0 - NL) >> 8);
    const int pos0 = lat ? 256 + (m0 & 2047) : ((m0 - NL) & 255);
    const int tlat0 = lat ? (m0 & 2047) : 0;
    const bool doq = lat || (l == 0);
    const bf16* zr = P.Z + (size_t)(m0 + tok) * DIN;
    const bf16* rr = P.RAW + (size_t)(m0 + tok) * 1792;
    __syncthreads();
    float rskv, rsq = 0.f;
    {
      float ss = 0.f;
#pragma unroll
      for (int i = 0; i < 8; ++i) {
        const uint4 u = *reinterpret_cast<const uint4*>(zr + ZC_BKV + half * 64 + i * 8);
        ss += lo2f(u.x) * lo2f(u.x) + hi2f(u.x) * hi2f(u.x) + lo2f(u.y) * lo2f(u.y) + hi2f(u.y) * hi2f(u.y)
            + lo2f(u.z) * lo2f(u.z) + hi2f(u.z) * hi2f(u.z) + lo2f(u.w) * lo2f(u.w) + hi2f(u.w) * hi2f(u.w);
      }
      ss += __shfl_xor(ss, 1);
      rskv = rsqrtf(ss * (1.f / 128.f) + EPS);
      if (doq) {
        float sq = 0.f;
#pragma unroll
        for (int i = 0; i < 16; ++i) {
          const uint4 u = *reinterpret_cast<const uint4*>(zr + ZC_BQ + half * 128 + i * 8);
          sq += lo2f(u.x) * lo2f(u.x) + hi2f(u.x) * hi2f(u.x) + lo2f(u.y) * lo2f(u.y) + hi2f(u.y) * hi2f(u.y)
              + lo2f(u.z) * lo2f(u.z) + hi2f(u.z) * hi2f(u.z) + lo2f(u.w) * lo2f(u.w) + hi2f(u.w) * hi2f(u.w);
        }
        sq += __shfl_xor(sq, 1);
        rsq = rsqrtf(sq * (1.f / 256.f) + EPS);
      }
    }
    {
      const bf16* kn = rr + 768 + h * 128 + half * 32;
      const bf16* vv = rr + 768 + h * 128 + 64 + half * 32;
#pragma unroll
      for (int i = 0; i < 4; ++i) {
        const uint4 u = *reinterpret_cast<const uint4*>(kn + i * 8);
        float* tp = T + tok * 97 + half * 32 + i * 8;
        tp[0] = lo2f(u.x) * rskv; tp[1] = hi2f(u.x) * rskv; tp[2] = lo2f(u.y) * rskv; tp[3] = hi2f(u.y) * rskv;
        tp[4] = lo2f(u.z) * rskv; tp[5] = hi2f(u.z) * rskv; tp[6] = lo2f(u.w) * rskv; tp[7] = hi2f(u.w) * rskv;
        const uint4 w = *reinterpret_cast<const uint4*>(vv + i * 8);
        bf16* vp = TV + (half * 32 + i * 8) * 136 + tok;
        vp[0 * 136] = f2bf(lo2f(w.x) * rskv); vp[1 * 136] = f2bf(hi2f(w.x) * rskv); vp[2 * 136] = f2bf(lo2f(w.y) * rskv); vp[3 * 136] = f2bf(hi2f(w.y) * rskv);
        vp[4 * 136] = f2bf(lo2f(w.z) * rskv); vp[5 * 136] = f2bf(hi2f(w.z) * rskv); vp[6 * 136] = f2bf(lo2f(w.w) * rskv); vp[7 * 136] = f2bf(hi2f(w.w) * rskv);
      }
#pragma unroll
      for (int i = 0; i < 2; ++i) {
        const uint4 u = *reinterpret_cast<const uint4*>(zr + ZC_BKR + half * 16 + i * 8);
        float* tp = T + tok * 97 + 64 + half * 16 + i * 8;
        tp[0] = lo2f(u.x); tp[1] = hi2f(u.x); tp[2] = lo2f(u.y); tp[3] = hi2f(u.y);
        tp[4] = lo2f(u.z); tp[5] = hi2f(u.z); tp[6] = lo2f(u.w); tp[7] = hi2f(u.w);
      }
    }
    __syncthreads();
    mla_norm_rope_store(P, T, P.b_kh_w + l * 96, lat, 1.f, P.K + (size_t)(b * 8 + h) * SEQP * 96, pos0, tlat0);
    {
      const int d = tid >> 2, qtr = tid & 3;
      bf16* dst = P.VT + ((size_t)(b * 8 + h) * 64 + d) * SEQP + pos0 + qtr * 32;
      const bf16* src = TV + d * 136 + qtr * 32;
#pragma unroll
      for (int i = 0; i < 4; ++i) *reinterpret_cast<uint4*>(dst + i * 8) = *reinterpret_cast<const uint4*>(src + i * 8);
    }
    if (doq) {
      __syncthreads();
      const bf16* qq = rr + h * 96 + half * 48;
#pragma unroll
      for (int i = 0; i < 6; ++i) {
        const uint4 u = *reinterpret_cast<const uint4*>(qq + i * 8);
        float* tp = T + tok * 97 + half * 48 + i * 8;
        tp[0] = lo2f(u.x) * rsq; tp[1] = hi2f(u.x) * rsq; tp[2] = lo2f(u.y) * rsq; tp[3] = hi2f(u.y) * rsq;
        tp[4] = lo2f(u.z) * rsq; tp[5] = hi2f(u.z) * rsq; tp[6] = lo2f(u.w) * rsq; tp[7] = hi2f(u.w) * rsq;
      }
      __syncthreads();
      mla_norm_rope_store(P, T, P.b_qh_w + l * 96, lat, qscale, P.Q + (size_t)(b * 8 + h) * SEQP * 96, pos0, tlat0);
    }
  }
}

DEVI void hgrn_load(const Params& P, int l, int b, int hd, int c, float* BF, float* RB, float* SEG,
                    float (&q)[16], float (&kf)[16], float (&kb)[16], float (&v)[16], bool need_kv) {
  const int tid = TIDX, t = tid >> 2, k0 = (tid & 3) * 16;
  const int row = row_of(b, c * 64 + t);
  const bf16* z = P.Z + (size_t)row * DIN + hd * 64 + k0;
  float zf[16], zb[16];
#pragma unroll
  for (int i = 0; i < 2; ++i) {
    const uint4 uq = *reinterpret_cast<const uint4*>(z + ZC_CQ + i * 8);
    const uint4 uf = *reinterpret_cast<const uint4*>(z + ZC_CFF + i * 8);
    const uint4 ub = *reinterpret_cast<const uint4*>(z + ZC_CFB + i * 8);
    q[i * 8 + 0] = lo2f(uq.x); q[i * 8 + 1] = hi2f(uq.x); q[i * 8 + 2] = lo2f(uq.y); q[i * 8 + 3] = hi2f(uq.y);
    q[i * 8 + 4] = lo2f(uq.z); q[i * 8 + 5] = hi2f(uq.z); q[i * 8 + 6] = lo2f(uq.w); q[i * 8 + 7] = hi2f(uq.w);
    zf[i * 8 + 0] = lo2f(uf.x); zf[i * 8 + 1] = hi2f(uf.x); zf[i * 8 + 2] = lo2f(uf.y); zf[i * 8 + 3] = hi2f(uf.y);
    zf[i * 8 + 4] = lo2f(uf.z); zf[i * 8 + 5] = hi2f(uf.z); zf[i * 8 + 6] = lo2f(uf.w); zf[i * 8 + 7] = hi2f(uf.w);
    zb[i * 8 + 0] = lo2f(ub.x); zb[i * 8 + 1] = hi2f(ub.x); zb[i * 8 + 2] = lo2f(ub.y); zb[i * 8 + 3] = hi2f(ub.y);
    zb[i * 8 + 4] = lo2f(ub.z); zb[i * 8 + 5] = hi2f(ub.z); zb[i * 8 + 6] = lo2f(ub.w); zb[i * 8 + 7] = hi2f(ub.w);
    if (need_kv) {
      const uint4 uv = *reinterpret_cast<const uint4*>(z + ZC_CI + i * 8);
      v[i * 8 + 0] = lo2f(uv.x); v[i * 8 + 1] = hi2f(uv.x); v[i * 8 + 2] = lo2f(uv.y); v[i * 8 + 3] = hi2f(uv.y);
      v[i * 8 + 4] = lo2f(uv.z); v[i * 8 + 5] = hi2f(uv.z); v[i * 8 + 6] = lo2f(uv.w); v[i * 8 + 7] = hi2f(uv.w);
    }
  }
#pragma unroll
  for (int i = 0; i < 16; ++i) {
    q[i] *= 0.125f;
    float lbf = 0.f;
    if (l == 1) { const int ch = hd * 64 + k0 + i; lbf = sigmoidf_(P.c_lb[512 + ch] - P.c_lb[ch]); }
    const float zz = zf[i];
    const float e = __expf(-fabsf(zz));
    const float sp = __builtin_amdgcn_rcpf(1.f + e);
    const float sig = zz >= 0.f ? sp : e * sp;
    const float nsig = zz >= 0.f ? e * sp : sp;
    const float lf = (l == 0) ? (fminf(zz, 0.f) - __logf(1.f + e)) : __logf(lbf + (1.f - lbf) * sig);
    kf[i] = (1.f - lbf) * nsig;
    BF[t * 65 + k0 + i] = lf;
  }
  __builtin_amdgcn_sched_barrier(0);
#pragma unroll
  for (int i = 0; i < 16; ++i) {
    float lbb = 0.f;
    if (l == 1) { const int ch = hd * 64 + k0 + i; lbb = sigmoidf_(P.c_lb[512 + 256 + ch] - P.c_lb[256 + ch]); }
    const float zz = zb[i];
    const float e = __expf(-fabsf(zz));
    const float sp = __builtin_amdgcn_rcpf(1.f + e);
    const float sig = zz >= 0.f ? sp : e * sp;
    const float nsig = zz >= 0.f ? e * sp : sp;
    const float lf = (l == 0) ? (fminf(zz, 0.f) - __logf(1.f + e)) : __logf(lbb + (1.f - lbb) * sig);
    kb[i] = (1.f - lbb) * nsig;
    RB[t * 65 + k0 + i] = lf;
  }
  __syncthreads();
  {
    const int k = tid & 63, seg = tid >> 6;
    float sf = 0.f, sr = 0.f;
#pragma unroll
    for (int j = 0; j < 16; ++j) { sf += BF[(seg * 16 + j) * 65 + k]; BF[(seg * 16 + j) * 65 + k] = sf; }
#pragma unroll
    for (int j = 15; j >= 0; --j) { sr += RB[(seg * 16 + j) * 65 + k]; RB[(seg * 16 + j) * 65 + k] = sr; }
    SEG[seg * 64 + k] = sf; SEG[256 + seg * 64 + k] = sr;
    __syncthreads();
    float offf = 0.f, offb = 0.f;
#pragma unroll
    for (int s2 = 0; s2 < 4; ++s2) {
      offf += (s2 < seg) ? SEG[s2 * 64 + k] : 0.f;
      offb += (s2 > seg) ? SEG[256 + s2 * 64 + k] : 0.f;
    }
#pragma unroll
    for (int j = 0; j < 16; ++j) { BF[(seg * 16 + j) * 65 + k] += offf; RB[(seg * 16 + j) * 65 + k] += offb; }
  }
  __syncthreads();
}

DEVI f32x16 lds_mm(const bf16* A, const bf16* BT, int tm, int tn, int l31, int hh) {
  f32x16 acc = zero16();
#pragma unroll
  for (int ks = 0; ks < 4; ++ks) {
    const bf16x8 a = ldfrag(A + (tm * 32 + l31) * 72 + ks * 16 + hh * 8);
    const bf16x8 b = ldfrag(BT + (tn * 32 + l31) * 72 + ks * 16 + hh * 8);
    acc = mfma32(a, b, acc);
  }
  return acc;
}

DEVI void phase_hgrn_local(const Params& P, int l, unsigned char* smem) {
  const int tid = TIDX, lane = tid & 63, wave = tid >> 6, l31 = lane & 31, hh = lane >> 5;
  const int tm = wave >> 1, tn = wave & 1;
  float* BF = reinterpret_cast<float*>(smem);
  float* RB = BF + 64 * 65;
  bf16* QF = reinterpret_cast<bf16*>(smem + 33280);
  bf16* KF = QF + 64 * 72;
  bf16* QB = KF + 64 * 72;
  bf16* KB = QB + 64 * 72;
  bf16* VTt = KB + 64 * 72;
  bf16* KHF = reinterpret_cast<bf16*>(smem);
  bf16* KHB = KHF + 64 * 72;
  bf16* ATT = KHB + 64 * 72;
  for (int it = (VBID + NVB - 192) % NVB; it < 8 * 4 * 36; it += NVB) {
    const int c = it % 36, hd = (it / 36) & 3, b = it / 144;
    float q[16], kf[16], kb[16], v[16];
    __syncthreads();
    hgrn_load(P, l, b, hd, c, BF, RB, reinterpret_cast<float*>(smem + 33280), q, kf, kb, v, true);
    const int t = tid >> 2, k0 = (tid & 3) * 16;
#pragma unroll
    for (int i = 0; i < 16; ++i) VTt[(k0 + i) * 72 + t] = f2bf(v[i]);
    float bfv[16], rbv[16];
#pragma unroll
    for (int i = 0; i < 16; ++i) { bfv[i] = BF[t * 65 + k0 + i]; rbv[i] = RB[t * 65 + k0 + i]; }
    {
      const size_t go = (size_t)row_of(b, c * 64 + t) * 256 + hd * 64 + k0;
#pragma unroll
      for (int hq = 0; hq < 2; ++hq) {
        unsigned pf[4], pb[4];
#pragma unroll
        for (int i = 0; i < 8; i += 2) {
          pf[i >> 1] = pack2(q[hq * 8 + i] * __expf(bfv[hq * 8 + i]), q[hq * 8 + i + 1] * __expf(bfv[hq * 8 + i + 1]));
          pb[i >> 1] = pack2(q[hq * 8 + i] * __expf(rbv[hq * 8 + i]), q[hq * 8 + i + 1] * __expf(rbv[hq * 8 + i + 1]));
        }
        *reinterpret_cast<uint4*>(P.GQF + go + hq * 8) = make_uint4(pf[0], pf[1], pf[2], pf[3]);
        *reinterpret_cast<uint4*>(P.GQB + go + hq * 8) = make_uint4(pb[0], pb[1], pb[2], pb[3]);
      }
    }
    if (t == 0) {
      float* dec = P.DEC + ((size_t)((b * 4 + hd) * 2) * 36 + c) * 64 + k0;
#pragma unroll
      for (int i = 0; i < 16; ++i) { dec[i] = __expf(BF[63 * 65 + k0 + i]); dec[36 * 64 + i] = __expf(RB[k0 + i]); }
    }
#pragma unroll
    for (int i = 0; i < 16; i += 2) {
      const int k = k0 + i;
      const float mF0 = BF[32 * 65 + k], mF1 = BF[32 * 65 + k + 1], mB0 = RB[32 * 65 + k], mB1 = RB[32 * 65 + k + 1];
      *reinterpret_cast<unsigned*>(&QF[t * 72 + k]) = pack2(q[i] * __expf(fminf(bfv[i] - mF0, 80.f)), q[i + 1] * __expf(fminf(bfv[i + 1] - mF1, 80.f)));
      *reinterpret_cast<unsigned*>(&KF[t * 72 + k]) = pack2(kf[i] * __expf(fminf(mF0 - bfv[i], 80.f)), kf[i + 1] * __expf(fminf(mF1 - bfv[i + 1], 80.f)));
      *reinterpret_cast<unsigned*>(&QB[t * 72 + k]) = pack2(q[i] * __expf(fminf(rbv[i] - mB0, 80.f)), q[i + 1] * __expf(fminf(rbv[i + 1] - mB1, 80.f)));
      *reinterpret_cast<unsigned*>(&KB[t * 72 + k]) = pack2(kb[i] * __expf(fminf(mB0 - rbv[i], 80.f)), kb[i + 1] * __expf(fminf(mB1 - rbv[i + 1], 80.f)));
    }
#pragma unroll
    for (int i = 0; i < 16; ++i) {
      kf[i] = kf[i] * __expf(BF[63 * 65 + k0 + i] - bfv[i]);
      kb[i] = kb[i] * __expf(RB[k0 + i] - rbv[i]);
    }
    __syncthreads();
#pragma unroll
    for (int i = 0; i < 16; ++i) {
      KHF[(k0 + i) * 72 + t] = f2bf(kf[i]);
      KHB[(k0 + i) * 72 + t] = f2bf(kb[i]);
    }
    __syncthreads();
    {
      const f32x16 af = lds_mm(QF, KF, tm, tn, l31, hh);
      const f32x16 ab = lds_mm(QB, KB, tm, tn, l31, hh);
      const int s = tn * 32 + l31;
#pragma unroll
      for (int r = 0; r < 16; ++r) {
        const int tt = tm * 32 + drow(r, hh);
        float a = 0.f;
        if (s <= tt) a += af[r];
        if (s >= tt) a += ab[r];
        ATT[tt * 72 + s] = f2bf(a);
      }
    }
    {
      const f32x16 lf = lds_mm(VTt, KHF, tm, tn, l31, hh);
      const f32x16 lb = lds_mm(VTt, KHB, tm, tn, l31, hh);
      bf16* stf = P.ST + ((size_t)((b * 4 + hd) * 2 + 0) * 36 + c) * 4096;
      bf16* stb = P.ST + ((size_t)((b * 4 + hd) * 2 + 1) * 36 + c) * 4096;
#pragma unroll
      for (int r = 0; r < 16; ++r) {
        const int kk = tm * 32 + drow(r, hh), d = tn * 32 + l31;
        stf[kk * 64 + d] = f2bf(lf[r]);
        stb[kk * 64 + d] = f2bf(lb[r]);
      }
    }
    __syncthreads();
    {
      const f32x16 o = lds_mm(ATT, VTt, tm, tn, l31, hh);
#pragma unroll
      for (int r = 0; r < 16; ++r) {
        const int tt = tm * 32 + drow(r, hh), d = tn * 32 + l31;
        P.OI[(size_t)row_of(b, c * 64 + tt) * 256 + hd * 64 + d] = f2bf(o[r]);
      }
    }
  }
}

DEVI void hgrn_scan_item(const Params& P, int item) {
  const int tid = TIDX;
  const int chain = item >> 2, sl = item & 3;
  const int dir = chain & 1;
  const int dd = tid >> 2, k4 = sl * 16 + (tid & 3) * 4;
  float4 S = make_float4(0.f, 0.f, 0.f, 0.f);
  bf16* base = P.ST + (size_t)chain * 36 * 4096 + dd * 64 + k4;
  const float* dec = P.DEC + (size_t)chain * 36 * 64 + k4;
#pragma unroll 1
  for (int g = 0; g < 6; ++g) {
    float4 L[6], dc[6];
#pragma unroll
    for (int j = 0; j < 6; ++j) {
      const int step = g * 6 + j;
      const int c = dir == 0 ? step : (step < 4 ? 3 - step : 39 - step);
      { const uint2 u = *reinterpret_cast<const uint2*>(base + (size_t)c * 4096); L[j] = make_float4(lo2f(u.x), hi2f(u.x), lo2f(u.y), hi2f(u.y)); }
      dc[j] = *reinterpret_cast<const float4*>(dec + c * 64);
    }
#pragma unroll
    for (int j = 0; j < 6; ++j) {
      const int step = g * 6 + j;
      const int c = dir == 0 ? step : (step < 4 ? 3 - step : 39 - step);
      *reinterpret_cast<uint2*>(base + (size_t)c * 4096) = make_uint2(pack2(S.x, S.y), pack2(S.z, S.w));
      S.x = dc[j].x * S.x + L[j].x; S.y = dc[j].y * S.y + L[j].y; S.z = dc[j].z * S.z + L[j].z; S.w = dc[j].w * S.w + L[j].w;
    }
  }
}

DEVI void phase_hgrn_final(const Params& P, int l, unsigned char* smem) {
  const int tid = TIDX, lane = tid & 63, wave = tid >> 6, l31 = lane & 31, hh = lane >> 5;
  const int tm = wave >> 1, tn = wave & 1;
  float* O = reinterpret_cast<float*>(smem);
  bf16* QF = reinterpret_cast<bf16*>(smem + 33280);
  bf16* QB = QF + 64 * 72;
  bf16* SF = QB + 64 * 72;
  bf16* SB = SF + 64 * 72;
  const int c0 = (l == 1) ? 4 : 0;
  const int nc = 36 - c0;
  for (int it = VBID; it < 8 * 4 * nc; it += NVB) {
    const int c = it % nc + c0, hd = (it / nc) & 3, b = it / (nc * 4);
    const int t = tid >> 2, k0 = (tid & 3) * 16;
    const int row = row_of(b, c * 64 + t);
    __syncthreads();
    {
      const size_t go = (size_t)row * 256 + hd * 64 + k0;
      *reinterpret_cast<uint4*>(QF + t * 72 + k0) = *reinterpret_cast<const uint4*>(P.GQF + go);
      *reinterpret_cast<uint4*>(QF + t * 72 + k0 + 8) = *reinterpret_cast<const uint4*>(P.GQF + go + 8);
      *reinterpret_cast<uint4*>(QB + t * 72 + k0) = *reinterpret_cast<const uint4*>(P.GQB + go);
      *reinterpret_cast<uint4*>(QB + t * 72 + k0 + 8) = *reinterpret_cast<const uint4*>(P.GQB + go + 8);
      const bf16* stf = P.ST + ((size_t)((b * 4 + hd) * 2 + 0) * 36 + c) * 4096 + t * 64 + k0;
      const bf16* stb = P.ST + ((size_t)((b * 4 + hd) * 2 + 1) * 36 + c) * 4096 + t * 64 + k0;
      *reinterpret_cast<uint4*>(SF + t * 72 + k0) = *reinterpret_cast<const uint4*>(stf);
      *reinterpret_cast<uint4*>(SF + t * 72 + k0 + 8) = *reinterpret_cast<const uint4*>(stf + 8);
      *reinterpret_cast<uint4*>(SB + t * 72 + k0) = *reinterpret_cast<const uint4*>(stb);
      *reinterpret_cast<uint4*>(SB + t * 72 + k0 + 8) = *reinterpret_cast<const uint4*>(stb + 8);
    }
    __syncthreads();
    {
      f32x16 o = lds_mm(QF, SF, tm, tn, l31, hh);
      const f32x16 o2 = lds_mm(QB, SB, tm, tn, l31, hh);
#pragma unroll
      for (int r = 0; r < 16; ++r) {
        const int tt = tm * 32 + drow(r, hh), d = tn * 32 + l31;
        O[tt * 65 + d] = o[r] + o2[r] + bf2f(P.OI[(size_t)row_of(b, c * 64 + tt) * 256 + hd * 64 + d]);
      }
    }
    __syncthreads();
    {
      float ov[16]; float ss = 0.f;
#pragma unroll
      for (int i = 0; i < 16; ++i) { ov[i] = O[t * 65 + k0 + i]; ss += ov[i] * ov[i]; }
      ss += __shfl_xor(ss, 1); ss += __shfl_xor(ss, 2);
      const float rr = rsqrtf(ss * (1.f / 64.f) + EPS);
      const bf16* g = P.Z + (size_t)row * DIN + ZC_CG + hd * 64 + k0;
      const float* nw = P.c_out_norm_w + l * 64 + k0;
      const uint4 gA = *reinterpret_cast<const uint4*>(g), gB = *reinterpret_cast<const uint4*>(g + 8);
      const unsigned gw[8] = {gA.x, gA.y, gA.z, gA.w, gB.x, gB.y, gB.z, gB.w};
      unsigned pk[8];
#pragma unroll
      for (int i = 0; i < 16; i += 2) {
        const float g0 = lo2f(gw[i >> 1]), g1 = hi2f(gw[i >> 1]);
        const float y0 = ov[i] * rr * nw[i] * (g0 * sigmoidf_(g0));
        const float y1 = ov[i + 1] * rr * nw[i + 1] * (g1 * sigmoidf_(g1));
        pk[i >> 1] = pack2(y0, y1);
      }
      uint4* dst = reinterpret_cast<uint4*>(P.H + (size_t)row * 1024 + 768 + hd * 64 + k0);
      dst[0] = make_uint4(pk[0], pk[1], pk[2], pk[3]);
      dst[1] = make_uint4(pk[4], pk[5], pk[6], pk[7]);
    }
  }
}

DEVI void attn_item8(const Params& P, int b, int h, int qpos0, int nkeys, float sref, unsigned char* smem_base) {
  const int tid = threadIdx.x, lane = tid & 63, wave = tid >> 6, l31 = lane & 31, hh = lane >> 5;
  constexpr int TK = 128, LDKS = 104, LDVS = 136;
  constexpr int KS_BYTES = TK * LDKS * 2, VS_BYTES = 64 * LDVS * 2, ST_BYTES = KS_BYTES + VS_BYTES;
  const bf16* Qg = P.Q + ((size_t)(b * 8 + h) * SEQP + qpos0 + wave * 32 + l31) * 96;
  const bf16* Kg = P.K + (size_t)(b * 8 + h) * SEQP * 96;
  const bf16* Vg = P.VT + (size_t)(b * 8 + h) * 64 * SEQP;
  bf16x8 qf[6];
#pragma unroll
  for (int ks = 0; ks < 6; ++ks) qf[ks] = ldfrag(Qg + ks * 16 + hh * 8);
  f32x16 oacc[2]; oacc[0] = zero16(); oacc[1] = zero16();
  float lsum = 0.f;
  uint4 rk[3], rv[2];
  const int ntiles = nkeys / TK;
  auto gload = [&](int kt) {
#pragma unroll
    for (int i = 0; i < 3; ++i) { const int ch = tid + i * 512, row = ch / 12, cc = ch % 12;
      rk[i] = *reinterpret_cast<const uint4*>(Kg + (size_t)(kt * TK + row) * 96 + cc * 8); }
#pragma unroll
    for (int i = 0; i < 2; ++i) { const int ch = tid + i * 512, row = ch >> 4, cc = ch & 15;
      rv[i] = *reinterpret_cast<const uint4*>(Vg + (size_t)row * SEQP + kt * TK + cc * 8); }
  };
  auto swrite = [&](int buf) {
    bf16* sK = reinterpret_cast<bf16*>(smem_base + buf * ST_BYTES);
    bf16* sV = reinterpret_cast<bf16*>(smem_base + buf * ST_BYTES + KS_BYTES);
#pragma unroll
    for (int i = 0; i < 3; ++i) { const int ch = tid + i * 512, row = ch / 12, cc = ch % 12;
      *reinterpret_cast<uint4*>(sK + row * LDKS + cc * 8) = rk[i]; }
#pragma unroll
    for (int i = 0; i < 2; ++i) { const int ch = tid + i * 512, row = ch >> 4, cc = ch & 15;
      const int g16 = cc >> 1, odd = cc & 1;
      bf16* base = sV + row * LDVS + g16 * 16;
      const int s0 = odd ? 4 : 0, s1 = odd ? 12 : 8;
      *reinterpret_cast<uint2*>(base + s0) = make_uint2(rv[i].x, rv[i].y);
      *reinterpret_cast<uint2*>(base + s1) = make_uint2(rv[i].z, rv[i].w);
    }
  };
  __syncthreads();
  gload(0); swrite(0);
  __syncthreads();
  for (int kt = 0; kt < ntiles; ++kt) {
    const int cur = kt & 1;
    if (kt + 1 < ntiles) gload(kt + 1);
    const bf16* sK = reinterpret_cast<const bf16*>(smem_base + cur * ST_BYTES);
    const bf16* sV = reinterpret_cast<const bf16*>(smem_base + cur * ST_BYTES + KS_BYTES);
#pragma unroll
    for (int kk = 0; kk < 4; ++kk) {
      f32x16 sacc;
#pragma unroll
      for (int r = 0; r < 16; ++r) sacc[r] = -sref;
#pragma unroll
      for (int ks = 0; ks < 6; ++ks) {
        const bf16x8 a = ldfrag(sK + (kk * 32 + l31) * LDKS + ks * 16 + hh * 8);
        sacc = mfma32(a, qf[ks], sacc);
      }
#pragma unroll
      for (int r = 0; r < 16; ++r) { const float p = __builtin_amdgcn_exp2f(sacc[r]); sacc[r] = p; lsum += p; }
#pragma unroll
      for (int s = 0; s < 2; ++s) {
        bf16x8 pb;
#pragma unroll
        for (int j = 0; j < 8; ++j) pb[j] = (__bf16)sacc[8 * s + j];
#pragma unroll
        for (int dt = 0; dt < 2; ++dt) {
          const bf16x8 a = ldfrag(sV + (dt * 32 + l31) * LDVS + kk * 32 + s * 16 + hh * 8);
          oacc[dt] = mfma32(a, pb, oacc[dt]);
        }
      }
    }
    if (kt + 1 < ntiles) swrite(cur ^ 1);
    __syncthreads();
  }
  lsum += __shfl_xor(lsum, 32);
  const float inv = 1.f / lsum;
  const int row = row_of(b, qpos0 + wave * 32 + l31);
  bf16* dst = P.H + (size_t)row * 1024 + 256 + h * 64;
#pragma unroll
  for (int dt = 0; dt < 2; ++dt)
#pragma unroll
    for (int rg = 0; rg < 4; ++rg) {
      const int d = dt * 32 + 8 * rg + 4 * hh;
      uint2 o;
      o.x = pack2(oacc[dt][4 * rg + 0] * inv, oacc[dt][4 * rg + 1] * inv);
      o.y = pack2(oacc[dt][4 * rg + 2] * inv, oacc[dt][4 * rg + 3] * inv);
      *reinterpret_cast<uint2*>(dst + d) = o;
    }
}

DEVI void phase_attn_scan(const Params& P, int l, unsigned char* smem_base, bool skip_scan = false) {
  if (!skip_scan)
    for (int it = NVB - 1 - VBID; it < 256; it += NVB) hgrn_scan_item(P, it);
  float sref;
  {
    const int lane = threadIdx.x & 63;
    float mq = fmaxf(fabsf(P.b_qh_w[l * 96 + lane]), lane < 32 ? fabsf(P.b_qh_w[l * 96 + 64 + lane]) : 0.f);
    float mk = fmaxf(fabsf(P.b_kh_w[l * 96 + lane]), lane < 32 ? fabsf(P.b_kh_w[l * 96 + 64 + lane]) : 0.f);
#pragma unroll
    for (int o = 32; o > 0; o >>= 1) { mq = fmaxf(mq, __shfl_xor(mq, o)); mk = fmaxf(mk, __shfl_xor(mk, o)); }
    sref = fminf(1.4426950408889634f * 9.797958971132712f * mq * mk, 60.f);
  }
  const int c = blockIdx.x, xcd = c & 7, slot = c >> 3;
  const int nrounds = (l == 0) ? 3 : 2;
  for (int r = 0; r < nrounds; ++r) {
    if (r < 2) {
      const int u = r * 32 + slot;
      const int bh = xcd * 8 + (u >> 3), qt = u & 7;
      if (slot < 32) attn_item8(P, bh >> 3, bh & 7, 256 + 256 * qt, 2304, sref, smem_base);
    } else if (c < 64) {
      attn_item8(P, c >> 3, c & 7, 0, 256, sref, smem_base);
    }
  }
}

DEVI unsigned ordkey(float s) { const unsigned u = __float_as_uint(s); return (u & 0x80000000u) ? ~u : (u | 0x80000000u); }
DEVI float keyval(unsigned k, unsigned mask) { const unsigned u = k & ~mask; return __uint_as_float((u & 0x80000000u) ? (u & 0x7fffffffu) : ~u); }
DEVI void ins16(unsigned (&lst)[16], unsigned v) {
#pragma unroll
  for (int j = 0; j < 16; ++j) { const unsigned hi = max(lst[j], v); v = min(lst[j], v); lst[j] = hi; }
}
DEVI void merge16(unsigned (&lst)[16], int xm) {
  unsigned o[16];
#pragma unroll
  for (int j = 0; j < 16; ++j) o[j] = (unsigned)__shfl_xor((int)lst[j], xm);
#pragma unroll
  for (int j = 0; j < 16; ++j) lst[j] = max(lst[j], o[15 - j]);
#pragma unroll
  for (int d = 8; d >= 1; d >>= 1)
#pragma unroll
    for (int j = 0; j < 16; ++j)
      if ((j & d) == 0) { const unsigned a = lst[j], bb = lst[j + d]; lst[j] = max(a, bb); lst[j + d] = min(a, bb); }
}

DEVI void bitonic_sort_desc16(unsigned (&v)[16]) {
#pragma unroll
  for (int k = 2; k <= 16; k <<= 1)
#pragma unroll
    for (int j = k >> 1; j > 0; j >>= 1)
#pragma unroll
      for (int i = 0; i < 16; ++i) {
        const int l = i ^ j;
        if (l > i) {
          const bool desc = ((i & k) == 0);
          const unsigned a = v[i], b = v[l];
          const unsigned mx = max(a, b), mn = min(a, b);
          v[i] = desc ? mx : mn; v[l] = desc ? mn : mx;
        }
      }
}
DEVI void bitonic_merge_desc16(unsigned (&lst)[16]) {
#pragma unroll
  for (int d = 8; d >= 1; d >>= 1)
#pragma unroll
    for (int j = 0; j < 16; ++j)
      if ((j & d) == 0) { const unsigned a = lst[j], bb = lst[j + d]; lst[j] = max(a, bb); lst[j + d] = min(a, bb); }
}
struct CandTab { int a[52]; int b[52]; };
constexpr CandTab make_cand_tab() {
  CandTab t{};
  int n = 0;
  for (int a = 0; a < 16; ++a)
    for (int b = 0; b < 16; ++b)
      if ((a + 1) * (b + 1) <= 16) { t.a[n] = a; t.b[n] = b; ++n; }
  for (; n < 52; ++n) { t.a[n] = 0; t.b[n] = 0; }
  return t;
}

DEVI void phase_route(const Params& P, int l, unsigned char* smem) {
  const int tid = TIDX, lane = tid & 63, wave = tid >> 6, l31 = lane & 31, hh = lane >> 5;
  bf16* QT = reinterpret_cast<bf16*>(smem);
  float* SC = reinterpret_cast<float*>(smem + 33792);
  const int mtiles = (l == 1) ? 256 : 288;
  for (int it = VBID; it < mtiles * 8; it += NVB) {
    const int mt = it >> 3, h = it & 7;
    __syncthreads();
    for (int e = tid; e < 64 * 32; e += 256) {
      const int r = e >> 5, cc = e & 31;
      *reinterpret_cast<uint4*>(QT + r * 264 + cc * 8) = *reinterpret_cast<const uint4*>(P.QP + (size_t)(mt * 64 + r) * 2048 + h * 256 + cc * 8);
    }
    __syncthreads();
    unsigned lst[2][16];
    const int row = tid >> 2, part = tid & 3;
#pragma unroll
    for (int p = 0; p < 2; ++p) {
      f32x16 sa[2]; sa[0] = zero16(); sa[1] = zero16();
      const bf16* keys = P.SK + ((size_t)(l * 16 + h * 2 + p) * 128 + wave * 32 + l31) * 128;
#pragma unroll
      for (int ks = 0; ks < 8; ++ks) {
        const bf16x8 bfr = ldfrag(keys + ks * 16 + hh * 8);
#pragma unroll
        for (int i = 0; i < 2; ++i) {
          const bf16x8 af = ldfrag(QT + (i * 32 + l31) * 264 + p * 128 + ks * 16 + hh * 8);
          sa[i] = mfma32(af, bfr, sa[i]);
        }
      }
      if (p == 1) __syncthreads();
#pragma unroll
      for (int i = 0; i < 2; ++i)
#pragma unroll
        for (int r = 0; r < 16; ++r) SC[(i * 32 + drow(r, hh)) * 129 + wave * 32 + l31] = sa[i][r];
      __syncthreads();
      unsigned B2[16];
#pragma unroll
      for (int i = 0; i < 16; ++i) {
        const int i0 = part * 32 + ((i + part * 8) & 31), i1 = part * 32 + ((i + 16 + part * 8) & 31);
        lst[p][i] = (ordkey(SC[row * 129 + i0]) & ~0x7fu) | (unsigned)(127 - i0);
        B2[i] = (ordkey(SC[row * 129 + i1]) & ~0x7fu) | (unsigned)(127 - i1);
      }
      bitonic_sort_desc16(lst[p]);
      bitonic_sort_desc16(B2);
#pragma unroll
      for (int j = 0; j < 16; ++j) lst[p][j] = max(lst[p][j], B2[15 - j]);
      bitonic_merge_desc16(lst[p]);
      merge16(lst[p], 1);
      merge16(lst[p], 2);
    }
    float v0[16], v1[16];
#pragma unroll
    for (int j = 0; j < 16; ++j) { v0[j] = keyval(lst[0][j], 0x7fu); v1[j] = keyval(lst[1][j], 0x7fu); }
    unsigned best[16];
    {
      constexpr CandTab CT = make_cand_tab();
#pragma unroll
      for (int c = 0; c < 13; ++c) {
        const int a0 = CT.a[4 * c + 0], a1 = CT.a[4 * c + 1], a2 = CT.a[4 * c + 2], a3 = CT.a[4 * c + 3];
        const int b0 = CT.b[4 * c + 0], b1 = CT.b[4 * c + 1], b2 = CT.b[4 * c + 2], b3 = CT.b[4 * c + 3];
        const float x = part == 0 ? v0[a0] : part == 1 ? v0[a1] : part == 2 ? v0[a2] : v0[a3];
        const float y = part == 0 ? v1[b0] : part == 1 ? v1[b1] : part == 2 ? v1[b2] : v1[b3];
        const int flat = part == 0 ? (a0 * 16 + b0) : part == 1 ? (a1 * 16 + b1) : part == 2 ? (a2 * 16 + b2) : (a3 * 16 + b3);
        const bool valid = part == 0 ? (4 * c + 0 < 50) : part == 1 ? (4 * c + 1 < 50) : part == 2 ? (4 * c + 2 < 50) : (4 * c + 3 < 50);
        const unsigned key = (ordkey(x + y) & ~0xffu) | (unsigned)(255 - flat);
        best[c] = valid ? key : 0u;
      }
      best[13] = 0u; best[14] = 0u; best[15] = 0u;
      bitonic_sort_desc16(best);
      merge16(best, 1);
      merge16(best, 2);
    }
    {
      const float mx = keyval(best[0], 0xffu);
      float es = 0.f;
      float ev[4]; int ex[4];
#pragma unroll
      for (int jj = 0; jj < 4; ++jj) {
        const unsigned kk = part == 0 ? best[4 * jj + 0] : part == 1 ? best[4 * jj + 1] : part == 2 ? best[4 * jj + 2] : best[4 * jj + 3];
        ev[jj] = __expf(keyval(kk, 0xffu) - mx);
        es += ev[jj];
        const int flat = 255 - (int)(kk & 0xffu);
        const int a = flat >> 4, bq = flat & 15;
        int i1 = 0, i2 = 0;
#pragma unroll
        for (int u = 0; u < 16; ++u) {
          i1 = (a == u) ? (127 - (int)(lst[0][u] & 0x7fu)) : i1;
          i2 = (bq == u) ? (127 - (int)(lst[1][u] & 0x7fu)) : i2;
        }
        ex[jj] = i1 * 128 + i2;
      }
      es += __shfl_xor(es, 1); es += __shfl_xor(es, 2);
      const float inv = 1.f / es;
      const int tok = mt * 64 + row;
      int* ed = P.EIDX + (size_t)tok * 128 + h * 16;
      float* gd = P.GATE + (size_t)tok * 128 + h * 16;
#pragma unroll
      for (int jj = 0; jj < 4; ++jj) { ed[4 * jj + part] = ex[jj]; gd[4 * jj + part] = ev[jj] * inv; }
    }
  }
}

DEVI float gelu_exact(float a) { return 0.5f * a * (1.f + erff(a * 0.70710678118654752f)); }

typedef float f2 __attribute__((ext_vector_type(2)));
DEVI void phase_peer_u(const Params& P, int l) {
  const int lane = TIDX & 63, half = lane >> 5, l32 = lane & 31;
  const int gw = VBID * 4 + (TIDX >> 6), nw = NVB * 4;
  const int nrows = (l == 1) ? NL : NT;
  const unsigned char* PU = P.PU8 + (size_t)l * 16384 * 576;
  const bool b4 = lane & 16, b3 = lane & 8, b2 = lane & 4;
  for (int t = gw; t < nrows; t += nw) {
    f2 h2[16];
    {
      const bf16* hp = P.H + (size_t)t * 1024 + l32 * 32;
#pragma unroll
      for (int i = 0; i < 4; ++i) {
        const uint4 hv = *reinterpret_cast<const uint4*>(hp + i * 8);
        h2[4 * i + 0] = (f2){lo2f(hv.x), hi2f(hv.x)}; h2[4 * i + 1] = (f2){lo2f(hv.y), hi2f(hv.y)};
        h2[4 * i + 2] = (f2){lo2f(hv.z), hi2f(hv.z)}; h2[4 * i + 3] = (f2){lo2f(hv.w), hi2f(hv.w)};
      }
    }
    const int e0 = P.EIDX[(size_t)t * 128 + lane], e1 = P.EIDX[(size_t)t * 128 + 64 + lane];
    const float g0 = P.GATE[(size_t)t * 128 + lane], g1 = P.GATE[(size_t)t * 128 + 64 + lane];
    float* wrow = P.WPE + (size_t)t * 128;
    const bool b1 = lane & 2;
    for (int kb = 0; kb < 4; ++kb) {
      const int esrc = kb < 2 ? e0 : e1;
      uint4 ud[16];
      unsigned short us[16];
#pragma unroll
      for (int i = 0; i < 16; ++i) {
        const int e = __shfl(esrc, (kb * 32 + 2 * i + half) & 63);
        const unsigned char* ur = PU + (size_t)e * 576;
        ud[i] = *reinterpret_cast<const uint4*>(ur + l32 * 16);
        us[i] = *reinterpret_cast<const unsigned short*>(ur + 512 + l32 * 2);
      }
      float d[16];
#pragma unroll
      for (int i = 0; i < 16; ++i) {
        const unsigned uw[4] = {ud[i].x, ud[i].y, ud[i].z, ud[i].w};
        f2 sacc = (f2){0.f, 0.f};
#pragma unroll
        for (int c = 0; c < 4; ++c) {
          sacc = __builtin_elementwise_fma(__builtin_amdgcn_cvt_scalef32_pk_f32_fp4(uw[c], 1.0f, 0), h2[4 * c + 0], sacc);
          sacc = __builtin_elementwise_fma(__builtin_amdgcn_cvt_scalef32_pk_f32_fp4(uw[c], 1.0f, 1), h2[4 * c + 1], sacc);
          sacc = __builtin_elementwise_fma(__builtin_amdgcn_cvt_scalef32_pk_f32_fp4(uw[c], 1.0f, 2), h2[4 * c + 2], sacc);
          sacc = __builtin_elementwise_fma(__builtin_amdgcn_cvt_scalef32_pk_f32_fp4(uw[c], 1.0f, 3), h2[4 * c + 3], sacc);
        }
        d[i] = (sacc.x + sacc.y) * __uint_as_float((unsigned)us[i] << 16);
      }
      float r8[8], r4[4], r2[2], r1;
#pragma unroll
      for (int i = 0; i < 8; ++i) { const float mine = b4 ? d[8 + i] : d[i]; const float send = b4 ? d[i] : d[8 + i]; r8[i] = mine + __shfl_xor(send, 16); }
#pragma unroll
      for (int i = 0; i < 4; ++i) { const float mine = b3 ? r8[4 + i] : r8[i]; const float send = b3 ? r8[i] : r8[4 + i]; r4[i] = mine + __shfl_xor(send, 8); }
#pragma unroll
      for (int i = 0; i < 2; ++i) { const float mine = b2 ? r4[2 + i] : r4[i]; const float send = b2 ? r4[i] : r4[2 + i]; r2[i] = mine + __shfl_xor(send, 4); }
      { const float mine = b1 ? r2[1] : r2[0]; const float send = b1 ? r2[0] : r2[1]; r1 = mine + __shfl_xor(send, 2); }
      r1 += __shfl_xor(r1, 1);
      const int k = kb * 32 + 2 * ((lane >> 1) & 15) + half;
      const float gt = __shfl(kb < 2 ? g0 : g1, k & 63);
      if ((lane & 1) == 0) wrow[k] = gt * gelu_exact(r1);
    }
  }
}

DEVI void phase_peer(const Params& P, int l) {
  const int lane = TIDX & 63, half = lane >> 5, l32 = lane & 31;
  const int gw = VBID * 4 + (TIDX >> 6), nw = NVB * 4;
  const int nrows = (l == 1) ? NL : NT;
  const unsigned char* PV = P.PV8 + (size_t)l * 16384 * 576;
  for (int t = gw; t < nrows; t += nw) {
    const int e0 = P.EIDX[(size_t)t * 128 + lane], e1 = P.EIDX[(size_t)t * 128 + 64 + lane];
    const float w0 = P.WPE[(size_t)t * 128 + lane], w1 = P.WPE[(size_t)t * 128 + 64 + lane];
    f2 y2[16];
#pragma unroll
    for (int i = 0; i < 16; ++i) y2[i] = (f2){0.f, 0.f};
    for (int kb = 0; kb < 4; ++kb) {
      const int esrc = kb < 2 ? e0 : e1;
      const float wsrc = kb < 2 ? w0 : w1;
      uint4 vd[16];
      unsigned short vs[16];
      float wv[16];
#pragma unroll
      for (int i = 0; i < 16; ++i) {
        const int ks = (kb * 32 + 2 * i + half) & 63;
        const int e = __shfl(esrc, ks);
        wv[i] = __shfl(wsrc, ks);
        const unsigned char* vr = PV + (size_t)e * 576;
        vd[i] = *reinterpret_cast<const uint4*>(vr + l32 * 16);
        vs[i] = *reinterpret_cast<const unsigned short*>(vr + 512 + l32 * 2);
      }
#pragma unroll
      for (int i = 0; i < 16; ++i) {
        const float wi = wv[i] * __uint_as_float((unsigned)vs[i] << 16);
        const f2 ww = (f2){wi, wi};
        const unsigned vw[4] = {vd[i].x, vd[i].y, vd[i].z, vd[i].w};
#pragma unroll
        for (int c = 0; c < 4; ++c) {
          y2[4 * c + 0] = __builtin_elementwise_fma(ww, __builtin_amdgcn_cvt_scalef32_pk_f32_fp4(vw[c], 1.0f, 0), y2[4 * c + 0]);
          y2[4 * c + 1] = __builtin_elementwise_fma(ww, __builtin_amdgcn_cvt_scalef32_pk_f32_fp4(vw[c], 1.0f, 1), y2[4 * c + 1]);
          y2[4 * c + 2] = __builtin_elementwise_fma(ww, __builtin_amdgcn_cvt_scalef32_pk_f32_fp4(vw[c], 1.0f, 2), y2[4 * c + 2]);
          y2[4 * c + 3] = __builtin_elementwise_fma(ww, __builtin_amdgcn_cvt_scalef32_pk_f32_fp4(vw[c], 1.0f, 3), y2[4 * c + 3]);
        }
      }
    }
    float y[16];
#pragma unroll
    for (int j = 0; j < 8; ++j) {
      const float ax = y2[j].x + __shfl_xor(y2[j].x, 32), ay = y2[j].y + __shfl_xor(y2[j].y, 32);
      const float bx = y2[8 + j].x + __shfl_xor(y2[8 + j].x, 32), by = y2[8 + j].y + __shfl_xor(y2[8 + j].y, 32);
      y[2 * j] = half ? bx : ax; y[2 * j + 1] = half ? by : ay;
    }
    const int bi = batch_of_row(t);
    const float* gate2 = P.MOD + (size_t)(l * 9 + bi) * 6144 + 5 * 1024;
    const int d0 = l32 * 32 + half * 16;
    float xn[16];
    float ss = 0.f;
#pragma unroll
    for (int q4 = 0; q4 < 4; ++q4) {
      const int d = d0 + q4 * 4;
      const uint2 xu = *reinterpret_cast<const uint2*>(P.X + (size_t)t * 1024 + d);
      const float4 xo = make_float4(lo2f(xu.x), hi2f(xu.x), lo2f(xu.y), hi2f(xu.y));
      const float4 gg = *reinterpret_cast<const float4*>(gate2 + d);
      float4 o;
      o.x = xo.x + gg.x * y[q4 * 4 + 0]; o.y = xo.y + gg.y * y[q4 * 4 + 1];
      o.z = xo.z + gg.z * y[q4 * 4 + 2]; o.w = xo.w + gg.w * y[q4 * 4 + 3];
      xn[q4 * 4 + 0] = o.x; xn[q4 * 4 + 1] = o.y; xn[q4 * 4 + 2] = o.z; xn[q4 * 4 + 3] = o.w;
      ss += o.x * o.x + o.y * o.y + o.z * o.z + o.w * o.w;
      if (l == 1) *reinterpret_cast<float4*>(P.out + (size_t)t * 1024 + d) = o;
      else *reinterpret_cast<uint2*>(P.X + (size_t)t * 1024 + d) = make_uint2(pack2(o.x, o.y), pack2(o.z, o.w));
    }
    if (l == 0) {
      ss = wave_sum(ss);
      const float rr = rsqrtf(ss * (1.f / 1024.f) + EPS);
      const float* lnw = P.ln1_w + 1024;
      const float* mod = P.MOD + (size_t)(9 + bi) * 6144;
      unsigned pk[8];
#pragma unroll
      for (int i = 0; i < 16; i += 2) {
        const float o0 = xn[i] * rr * lnw[d0 + i] * (1.f + mod[1024 + d0 + i]) + mod[d0 + i];
        const float o1 = xn[i + 1] * rr * lnw[d0 + i + 1] * (1.f + mod[1024 + d0 + i + 1]) + mod[d0 + i + 1];
        pk[i >> 1] = pack2(o0, o1);
      }
      *reinterpret_cast<uint4*>(P.H + (size_t)t * 1024 + d0) = make_uint4(pk[0], pk[1], pk[2], pk[3]);
      *reinterpret_cast<uint4*>(P.H + (size_t)t * 1024 + d0 + 8) = make_uint4(pk[4], pk[5], pk[6], pk[7]);
    }
  }
}

using f32x4 = __attribute__((ext_vector_type(4))) float;
namespace g8 {
constexpr int BM = 256, BK = 64, HALF = 128, HT = HALF * BK;
DEVI int lds_byte(int r, int c) { const int st = (r >> 4) * 2 + (c >> 5), rr = r & 15, cc = c & 31, ob = rr * 64 + cc * 2; return st * 1024 + (ob ^ (((ob >> 9) & 1) << 5)); }
DEVI void stage_rc(int b, int& R, int& C) { const int st = b / 1024, sb = b % 1024, swz = sb ^ (((sb >> 9) & 1) << 5); R = (st >> 1) * 16 + swz / 64; C = (st & 1) * 32 + (swz % 64) / 2; }
DEVI int perm32(int rho) { const int n = rho >> 4, i = rho & 15; return 8 * (i >> 2) + 4 * n + (i & 3); }
DEVI void unit_of(int L, int nM, int nN, int& pm, int& pn) {
  const int nwg = nM * nN;
  int wgid = L;
  { const int q = nwg / 8, r = nwg % 8, xcd = wgid % 8, off = wgid / 8; wgid = (xcd < r ? xcd * (q + 1) : r * (q + 1) + (xcd - r) * q) + off; }
  const int nig = 8 * nN, gid = wgid / nig, fm = gid * 8, gsz = (nM - fm) < 8 ? (nM - fm) : 8;
  pm = fm + ((wgid % nig) % gsz); pn = (wgid % nig) / gsz;
}
}

struct G8Unit { int pm, pn; };
template <class Epi>
DEVI void gemm8_phase(LAS unsigned char* lds, const bf16* __restrict__ Ag, const bf16* __restrict__ Btg, const int K, const int nM, const int nN, const Epi& E,
                      const int lda = 0, const int pn_split = 1 << 30, const int acol0 = 0, const int acol1 = 0) {
  constexpr int BK = 64, HALF = 128, HTB = HALF * BK * 2;
  const int tid = threadIdx.x, wid = __builtin_amdgcn_readfirstlane(tid >> 6), lane = tid & 63, wr = wid >> 2, wc = wid & 3, fr = lane & 15, fq = lane >> 4;
  const int nt = K / BK;
  const int nunits = nM * nN, G = gridDim.x, c = blockIdx.x;
  const int LDA = lda ? lda : K;
  unsigned voffA[2], voffB[2];
#pragma unroll
  for (int i = 0; i < 2; ++i) { int R, C; g8::stage_rc(tid * 16 + i * 8192, R, C); const int Rb = (R & ~31) + g8::perm32(R & 31); voffA[i] = (unsigned)(R * LDA + C) * 2u; voffB[i] = (unsigned)(Rb * K + C) * 2u; }
  const size_t kstep = (size_t)(BK * 2);
  const size_t hstepA = (size_t)HALF * LDA * 2, hstep = (size_t)HALF * K * 2;
  const size_t tstepA = 2 * hstepA, tstep = 2 * hstep;
  const unsigned ldsw = (unsigned)wid * 1024u;
  const int aoff = g8::lds_byte(wr * 64 + fr, fq * 8), boff = g8::lds_byte(wc * 32 + fr, fq * 8);
#define PG8_SA(b, h) (((b) * 2 + (h)) * HTB)
#define PG8_SB(b, h) ((4 + (b) * 2 + (h)) * HTB)
#define PG8_STAGE(bufoff, gbase, voff) do { _Pragma("unroll") for (int _i = 0; _i < 2; ++_i) \
        __builtin_amdgcn_global_load_lds((const unsigned*)((const char*)(gbase) + (voff)[_i]), (LAS unsigned*)(lds + (bufoff) + ldsw + _i * 8192), 16, 0, 0); } while (0)
#define PG8_LDA(dst, b, h) do { _Pragma("unroll") for (int m = 0; m < 4; ++m) _Pragma("unroll") for (int k = 0; k < 2; ++k) dst[m][k] = *(const LAS bf16x8*)(lds + PG8_SA(b, h) + aoff + m * 2048 + k * 1024); } while (0)
#define PG8_LDB(dst, b, h) do { _Pragma("unroll") for (int n = 0; n < 2; ++n) _Pragma("unroll") for (int k = 0; k < 2; ++k) dst[n][k] = *(const LAS bf16x8*)(lds + PG8_SB(b, h) + boff + n * 2048 + k * 1024); } while (0)
#define PG8_MMA(ai, bj, At_, Bt_) do { __builtin_amdgcn_s_setprio(1); _Pragma("unroll") for (int m = 0; m < 4; ++m) _Pragma("unroll") for (int n = 0; n < 2; ++n) _Pragma("unroll") for (int k = 0; k < 2; ++k) \
        acc[ai][bj][m][n] = __builtin_amdgcn_mfma_f32_16x16x32_bf16(Bt_[n][k], At_[m][k], acc[ai][bj][m][n], 0, 0, 0); __builtin_amdgcn_s_setprio(0); } while (0)
#define PG8_WAIT_V(n) asm volatile("s_waitcnt vmcnt(" #n ")" ::: "memory")
#define PG8_WAIT_L(n) asm volatile("s_waitcnt lgkmcnt(" #n ")" ::: "memory")
#define PG8_BAR __builtin_amdgcn_s_barrier()
#define PG8_SCHED __builtin_amdgcn_sched_barrier(0)
  G8Unit cur, nxt; int ui = 0;
  if (c >= nunits) return;
  g8::unit_of(c, nM, nN, cur.pm, cur.pn);
  f32x4 acc[2][2][4][2];
#pragma unroll
  for (int a = 0; a < 2; ++a)
#pragma unroll
    for (int b = 0; b < 2; ++b)
#pragma unroll
      for (int m = 0; m < 4; ++m)
#pragma unroll
        for (int n = 0; n < 2; ++n) acc[a][b][m][n] = (f32x4){0.f, 0.f, 0.f, 0.f};
  bf16x8 At[4][2], B0[2][2], B1[2][2];
  const char* cA = (const char*)Ag + (size_t)cur.pm * tstepA + (size_t)(cur.pn < pn_split ? acol0 : acol1) * 2; const char* cB = (const char*)Btg + (size_t)cur.pn * tstep;
  PG8_STAGE(PG8_SB(0, 0), cB, voffB); PG8_STAGE(PG8_SA(0, 0), cA, voffA); PG8_STAGE(PG8_SB(0, 1), cB + hstep, voffB); PG8_STAGE(PG8_SA(0, 1), cA + hstepA, voffA);
  if (wr == 1) PG8_BAR;
  PG8_WAIT_V(4); PG8_BAR;
  PG8_STAGE(PG8_SB(1, 0), cB + kstep, voffB); PG8_STAGE(PG8_SA(1, 0), cA + kstep, voffA); PG8_STAGE(PG8_SB(1, 1), cB + hstep + kstep, voffB);
  PG8_WAIT_V(6); PG8_BAR;
  for (;;) {
    const long Ln = (long)(ui + 1) * G + c;
    const bool has_next = Ln < nunits;
    if (has_next) g8::unit_of((int)Ln, nM, nN, nxt.pm, nxt.pn);
    const char* nA = has_next ? (const char*)Ag + (size_t)nxt.pm * tstepA + (size_t)(nxt.pn < pn_split ? acol0 : acol1) * 2 : cA; const char* nB = has_next ? (const char*)Btg + (size_t)nxt.pn * tstep : cB;
    for (int t = 0; t < nt; t += 2) {
      const bool last = (t == nt - 2);
      const char* a1 = cA + (size_t)(t + 1) * kstep;
      const char* a2 = last ? nA : cA + (size_t)(t + 2) * kstep; const char* b2 = last ? nB : cB + (size_t)(t + 2) * kstep;
      const char* a3 = a2 + kstep; const char* b3 = b2 + kstep;
      PG8_LDB(B0, 0, 0); PG8_SCHED; PG8_LDA(At, 0, 0); PG8_STAGE(PG8_SA(1, 1), a1 + hstepA, voffA);
      PG8_WAIT_L(8); PG8_BAR; PG8_WAIT_L(0); PG8_MMA(0, 0, At, B0); PG8_BAR; PG8_SCHED;
      PG8_LDB(B1, 0, 1); PG8_STAGE(PG8_SB(0, 0), b2, voffB);
      PG8_BAR; PG8_WAIT_L(0); PG8_MMA(0, 1, At, B1); PG8_BAR;
      PG8_LDA(At, 0, 1); PG8_STAGE(PG8_SA(0, 0), a2, voffA);
      PG8_BAR; PG8_WAIT_L(0); PG8_MMA(1, 0, At, B0); PG8_BAR; PG8_SCHED;
      PG8_STAGE(PG8_SB(0, 1), b2 + hstep, voffB);
      PG8_WAIT_V(6); PG8_BAR; PG8_MMA(1, 1, At, B1); PG8_BAR;
      PG8_LDB(B0, 1, 0); PG8_SCHED; PG8_LDA(At, 1, 0); PG8_STAGE(PG8_SA(0, 1), a2 + hstepA, voffA);
      PG8_WAIT_L(8); PG8_BAR; PG8_WAIT_L(0); PG8_MMA(0, 0, At, B0); PG8_BAR; PG8_SCHED;
      PG8_LDB(B1, 1, 1); PG8_STAGE(PG8_SB(1, 0), b3, voffB);
      PG8_BAR; PG8_WAIT_L(0); PG8_MMA(0, 1, At, B1); PG8_BAR;
      PG8_LDA(At, 1, 1); PG8_STAGE(PG8_SA(1, 0), a3, voffA);
      PG8_BAR; PG8_WAIT_L(0); PG8_MMA(1, 0, At, B0); PG8_BAR; PG8_SCHED;
      PG8_STAGE(PG8_SB(1, 1), b3 + hstep, voffB);
      PG8_WAIT_V(6); PG8_BAR; PG8_MMA(1, 1, At, B1); PG8_BAR;
    }
    E(acc, cur, wr, wc, fr, fq);
    if (!has_next) break;
#pragma unroll
    for (int a = 0; a < 2; ++a)
#pragma unroll
      for (int b = 0; b < 2; ++b)
#pragma unroll
        for (int m = 0; m < 4; ++m)
#pragma unroll
          for (int n = 0; n < 2; ++n) acc[a][b][m][n] = (f32x4){0.f, 0.f, 0.f, 0.f};
    cur = nxt; cA = nA; cB = nB; ++ui;
  }
  PG8_WAIT_V(0);
  if (wr == 0) PG8_BAR;
  PG8_BAR;
#undef PG8_SA
#undef PG8_SB
#undef PG8_STAGE
#undef PG8_LDA
#undef PG8_LDB
#undef PG8_MMA
}

struct EpiZ {
  bf16* Z;
  DEVI void operator()(const f32x4 (&acc)[2][2][4][2], const G8Unit& u, int wr, int wc, int fr, int fq) const {
    const int brow = u.pm * 256, bcol = u.pn * 256;
#pragma unroll
    for (int ai = 0; ai < 2; ++ai)
#pragma unroll
      for (int m = 0; m < 4; ++m) {
        const int row = brow + ai * 128 + wr * 64 + m * 16 + fr;
#pragma unroll
        for (int bj = 0; bj < 2; ++bj) {
          const int col = bcol + bj * 128 + wc * 32 + 8 * fq;
          if (col < DIN) {
            const f32x4 v0 = acc[ai][bj][m][0], v1 = acc[ai][bj][m][1];
            *reinterpret_cast<uint4*>(Z + (size_t)row * DIN + col) = make_uint4(pack2(v0[0], v0[1]), pack2(v0[2], v0[3]), pack2(v1[0], v1[1]), pack2(v1[2], v1[3]));
          }
        }
      }
  }
};
DEVI void phase_gemm1_8(const Params& P, int l, unsigned char* smem_base) {
  EpiZ E{P.Z};
  gemm8_phase((LAS unsigned char*)smem_base, P.H, P.WinT + (size_t)l * DINP * 1024, 1024, NT / 256, DINP / 256, E);
  const int c = blockIdx.x;
  if (c >= 136) {
    const int j = c - 136;
    if (l == 0) convert_rows_fp6(P, 0, j * 100, j * 100 + 100);
    else { const int b0 = 19200 + j * 114; convert_rows_fp6(P, 1, b0 < 32768 ? b0 : 32768, b0 + 114 < 32768 ? b0 + 114 : 32768); }
  }
}

struct EpiRAW {
  bf16* R;
  DEVI void operator()(const f32x4 (&acc)[2][2][4][2], const G8Unit& u, int wr, int wc, int fr, int fq) const {
    const int brow = u.pm * 256, bcol = u.pn * 256;
#pragma unroll
    for (int ai = 0; ai < 2; ++ai)
#pragma unroll
      for (int m = 0; m < 4; ++m) {
        const int row = brow + ai * 128 + wr * 64 + m * 16 + fr;
#pragma unroll
        for (int bj = 0; bj < 2; ++bj) {
          const int col = bcol + bj * 128 + wc * 32 + 8 * fq;
          const f32x4 v0 = acc[ai][bj][m][0], v1 = acc[ai][bj][m][1];
          *reinterpret_cast<uint4*>(R + (size_t)row * 1792 + col) = make_uint4(pack2(v0[0], v0[1]), pack2(v0[2], v0[3]), pack2(v1[0], v1[1]), pack2(v1[2], v1[3]));
        }
      }
  }
};
DEVI void phase_mla_raw(const Params& P, int l, unsigned char* smem_base) {
  EpiRAW E{P.RAW};
  gemm8_phase((LAS unsigned char*)smem_base, P.Z, P.WCOMB + (size_t)l * 1792 * 256, 256, NT / 256, 7, E, DIN, 3, ZC_BQ, ZC_BKV);
}

struct EpiX {
  const float* x; const float* ctx; bf16* X; const float* MODl; int l;
  DEVI void operator()(const f32x4 (&acc)[2][2][4][2], const G8Unit& u, int wr, int wc, int fr, int fq) const {
    const int brow = u.pm * 256, bcol = u.pn * 256;
    const float* gate = MODl + (size_t)batch_of_row(brow) * 6144 + 2048;
#pragma unroll
    for (int ai = 0; ai < 2; ++ai)
#pragma unroll
      for (int m = 0; m < 4; ++m) {
        const int row = brow + ai * 128 + wr * 64 + m * 16 + fr;
        const float* res = row < NL ? x + (size_t)row * 1024 : ctx + (size_t)(row - NL) * 1024;
#pragma unroll
        for (int bj = 0; bj < 2; ++bj) {
          const int col = bcol + bj * 128 + wc * 32 + 8 * fq;
          const f32x4 v0 = acc[ai][bj][m][0], v1 = acc[ai][bj][m][1];
          float4 ra, rb;
          if (l == 0) { ra = *reinterpret_cast<const float4*>(res + col); rb = *reinterpret_cast<const float4*>(res + col + 4); }
          else {
            const uint4 uu = *reinterpret_cast<const uint4*>(X + (size_t)row * 1024 + col);
            ra = make_float4(lo2f(uu.x), hi2f(uu.x), lo2f(uu.y), hi2f(uu.y)); rb = make_float4(lo2f(uu.z), hi2f(uu.z), lo2f(uu.w), hi2f(uu.w));
          }
          const float4 ga = *reinterpret_cast<const float4*>(gate + col), gb = *reinterpret_cast<const float4*>(gate + col + 4);
          *reinterpret_cast<uint4*>(X + (size_t)row * 1024 + col) =
              make_uint4(pack2(ra.x + ga.x * v0[0], ra.y + ga.y * v0[1]), pack2(ra.z + ga.z * v0[2], ra.w + ga.w * v0[3]),
                         pack2(rb.x + gb.x * v1[0], rb.y + gb.y * v1[1]), pack2(rb.z + gb.z * v1[2], rb.w + gb.w * v1[3]));
        }
      }
  }
};
DEVI void phase_gemm2_8(const Params& P, int l, unsigned char* smem_base) {
  EpiX E{P.x, P.ctx, P.X, P.MOD + (size_t)l * 9 * 6144, l};
  gemm8_phase((LAS unsigned char*)smem_base, P.H, P.WoutT + (size_t)l * 1024 * 1024, 1024, (l == 1) ? NL / 256 : NT / 256, 4, E);
  const int c = blockIdx.x;
  if (l == 0 && c >= 32) {
    const int b0 = 12000 + (c - 32) * 93;
    convert_rows_fp6(P, 0, b0 < 32768 ? b0 : 32768, b0 + 93 < 32768 ? b0 + 93 : 32768);
  }
}

struct EpiQP {
  bf16* QP;
  DEVI void operator()(const f32x4 (&acc)[2][2][4][2], const G8Unit& u, int wr, int wc, int fr, int fq) const {
    const int brow = u.pm * 256, bcol = u.pn * 256;
#pragma unroll
    for (int ai = 0; ai < 2; ++ai)
#pragma unroll
      for (int m = 0; m < 4; ++m) {
        const int row = brow + ai * 128 + wr * 64 + m * 16 + fr;
#pragma unroll
        for (int bj = 0; bj < 2; ++bj) {
          const int col = bcol + bj * 128 + wc * 32 + 8 * fq;
          const f32x4 v0 = acc[ai][bj][m][0], v1 = acc[ai][bj][m][1];
          *reinterpret_cast<uint4*>(QP + (size_t)row * 2048 + col) = make_uint4(pack2(v0[0], v0[1]), pack2(v0[2], v0[3]), pack2(v1[0], v1[1]), pack2(v1[2], v1[3]));
        }
      }
  }
};
DEVI void phase_gemm3_8(const Params& P, int l, unsigned char* smem_base) {
  EpiQP E{P.QP};
  gemm8_phase((LAS unsigned char*)smem_base, P.H, P.WpqT + (size_t)l * 2048 * 1024, 1024, (l == 1) ? NL / 256 : NT / 256, 8, E);
  const int c = blockIdx.x;
  if (l == 0 && c >= 64) convert_rows_fp6(P, 1, (c - 64) * 100, (c - 64) * 100 + 100);
}

constexpr int N_PHASES = 2 + 2 * 11;

#ifndef REP_MASK
#define REP_MASK 0
#endif
static_assert(sizeof(Params) % 8 == 0, "Params size");
DEVI Params load_params() {
#if defined(__HIP_DEVICE_COMPILE__)
  typedef const __attribute__((address_space(4))) Params* ParamsCP;
  ParamsCP pp = (ParamsCP)__builtin_amdgcn_kernarg_segment_ptr();
  asm volatile("" : "+s"(pp));
  return *pp;
#else
  return Params{};
#endif
}
__global__ void __launch_bounds__(512, 2) fwd_kernel(Params Pk) {
  extern __shared__ __attribute__((aligned(16))) unsigned char smem_base[];
  volatile LAS unsigned* xst = (volatile LAS unsigned*)(smem_base + SMEM_BYTES);
  if (threadIdx.x == 0) { xst[0] = 0u; xst[1] = 0u; xst[2] = 0u; xst[3] = 0u; }
  __syncthreads();
  XcdBarrier xb = xcd_barrier_post(Pk.bar, xst);
  const int phase_lo = Pk.phase_lo, phase_hi = Pk.phase_hi, coop = Pk.coop;
#define smem (smem_base + VHALF * HALF_LDS)
#define GSYNC(idx) { xcd_barrier(xb); }
#define RUN_PHASE2(idx, call, repcall) \
  if (phase_lo <= (idx) && (idx) <= phase_hi) { { const Params P = load_params(); call; } if (REP_MASK & (1 << (idx))) { GSYNC(1); const Params P = load_params(); repcall; } if (coop && (idx) < phase_hi) GSYNC(idx); }
#define RUN_PHASE(idx, call) RUN_PHASE2(idx, call, call)
  RUN_PHASE(0, phase_prologue(P, smem))
  RUN_PHASE(1, phase_norm(P, 0, 0, NT))
  RUN_PHASE(2, phase_gemm1_8(P, 0, smem_base))
  RUN_PHASE(3, phase_mla_raw(P, 0, smem_base))
  RUN_PHASE(4, { phase_mixA(P, 0, smem); phase_mla_proj(P, 0, smem); phase_hgrn_local(P, 0, smem); })
  RUN_PHASE2(5, phase_attn_scan(P, 0, smem_base), phase_attn_scan(P, 0, smem_base, true))
  RUN_PHASE(6, phase_hgrn_final(P, 0, smem))
  RUN_PHASE(7, phase_gemm2_8(P, 0, smem_base))
  RUN_PHASE(8, phase_norm(P, 0, 1, NT))
  RUN_PHASE(9, phase_gemm3_8(P, 0, smem_base))
  RUN_PHASE(10, phase_route(P, 0, smem))
  RUN_PHASE(11, phase_peer_u(P, 0))
  RUN_PHASE(12, phase_peer(P, 0))
  RUN_PHASE(13, phase_gemm1_8(P, 1, smem_base))
  RUN_PHASE(14, phase_mla_raw(P, 1, smem_base))
  RUN_PHASE(15, { phase_mixA(P, 1, smem); phase_mla_proj(P, 1, smem); phase_hgrn_local(P, 1, smem); })
  RUN_PHASE2(16, phase_attn_scan(P, 1, smem_base), phase_attn_scan(P, 1, smem_base, true))
  RUN_PHASE(17, phase_hgrn_final(P, 1, smem))
  RUN_PHASE(18, phase_gemm2_8(P, 1, smem_base))
  RUN_PHASE(19, phase_norm(P, 1, 1, NL))
  RUN_PHASE(20, phase_gemm3_8(P, 1, smem_base))
  RUN_PHASE(21, phase_route(P, 1, smem))
  RUN_PHASE(22, phase_peer_u(P, 1))
  RUN_PHASE(23, phase_peer(P, 1))
#undef smem
}

extern "C" void kernel_launch(void* const* d_in, const int* in_sizes, int n_in, void* d_out, int out_size, void* d_ws,
                              size_t ws_size, hipStream_t stream) {
  Params p{};
  const float* const* in = reinterpret_cast<const float* const*>(d_in);
  p.x = in[0]; p.c = in[1]; p.ctx = in[2]; p.c_ctx = in[3]; p.ln1_w = in[4]; p.ln2_w = in[5]; p.w_mod = in[6]; p.b_mod = in[7];
  p.w_in = in[8]; p.w_out = in[9]; p.a_norm_w = in[10]; p.a_w_s = in[11]; p.a_b_s = in[12]; p.b_q_norm_w = in[13]; p.b_w_uq = in[14];
  p.b_kv_norm_w = in[15]; p.b_w_ukv = in[16]; p.b_qh_w = in[17]; p.b_kh_w = in[18]; p.c_lb = in[19]; p.c_out_norm_w = in[20];
  p.p_w_q = in[21]; p.p_sub_keys = in[22]; p.p_u = in[23]; p.p_v = in[24];
  p.out = reinterpret_cast<float*>(d_out);
  unsigned char* ws = reinterpret_cast<unsigned char*>(d_ws);
  size_t off = 0;
  auto take = [&](size_t bytes) { unsigned char* r = ws + off; off += (bytes + 255) & ~(size_t)255; return r; };
  p.bar = (unsigned*)take((size_t)XCD_BAR_WORDS * 4);
  p.MOD = (float*)take((size_t)2 * 9 * 6144 * 4);
  p.ROPE = (float*)take((size_t)2048 * 32 * 4);
  p.WinT = (bf16*)take((size_t)2 * DINP * 1024 * 2);
  p.WoutT = (bf16*)take((size_t)2 * 1024 * 1024 * 2);
  p.WpqT = (bf16*)take((size_t)2 * 2048 * 1024 * 2);
  p.WCOMB = (bf16*)take((size_t)2 * 1792 * 256 * 2);
  p.RAW = (bf16*)take((size_t)NT * 1792 * 2);
  p.SK = (bf16*)take((size_t)2 * 16 * 128 * 128 * 2);
  p.AWS = (bf16*)take((size_t)2 * 4 * 128 * 128 * 2);
  p.PU8 = (unsigned char*)take((size_t)2 * 16384 * 576);
  p.PV8 = (unsigned char*)take((size_t)2 * 16384 * 576);
  p.PUS = (float*)take((size_t)2 * 16384 * 4);
  p.PVS = (float*)take((size_t)2 * 16384 * 4);
  p.X = (bf16*)take((size_t)NT * 1024 * 2);
  p.H = (bf16*)take((size_t)NT * 1024 * 2);
  p.Z = (bf16*)take((size_t)NT * DIN * 2);
  p.Q = (bf16*)take((size_t)64 * SEQP * 96 * 2);
  p.K = (bf16*)take((size_t)64 * SEQP * 96 * 2);
  p.VT = (bf16*)take((size_t)64 * 64 * SEQP * 2);
  p.ST = (bf16*)take((size_t)64 * 36 * 4096 * 2);
  p.DEC = (float*)take((size_t)64 * 36 * 64 * 4);
  p.OI = (bf16*)take((size_t)NT * 256 * 2);
  p.WPE = (float*)take((size_t)NT * 128 * 4);
  p.GQF = (bf16*)take((size_t)NT * 256 * 2);
  p.GQB = (bf16*)take((size_t)NT * 256 * 2);
  p.QP = p.Z;
  p.EIDX = (int*)p.Q;
  p.GATE = (float*)p.K;
  if (off > ws_size) { fprintf(stderr, "workspace too small: need %zu have %zu\n", off, ws_size); }
  static int grid_blocks = 0;
  if (!grid_blocks) {
    if (hipFuncSetAttribute((const void*)fwd_kernel, hipFuncAttributeMaxDynamicSharedMemorySize, SMEM_TOTAL) != hipSuccess)
      fprintf(stderr, "hipFuncSetAttribute failed\n");
    int dev = 0, cus = 0, per_cu = 0;
    hipGetDevice(&dev);
    hipDeviceGetAttribute(&cus, hipDeviceAttributeMultiprocessorCount, dev);
    hipOccupancyMaxActiveBlocksPerMultiprocessor(&per_cu, (const void*)fwd_kernel, 512, SMEM_TOTAL);
    if (per_cu > 1) per_cu = 1;
    if (per_cu < 1) { fprintf(stderr, "occupancy query returned %d\n", per_cu); per_cu = 1; }
    grid_blocks = cus * per_cu;
    fprintf(stderr, "grid_blocks=%d (cus=%d per_cu=%d) ws need=%zu have=%zu\n", grid_blocks, cus, per_cu, off, ws_size);
  }
  hipMemsetAsync(p.bar, 0, (size_t)XCD_BAR_WORDS * 4, stream);
  p.coop = 1; p.phase_lo = 0; p.phase_hi = N_PHASES - 1;
  hipLaunchKernelGGL(fwd_kernel, dim3(grid_blocks), dim3(512), SMEM_TOTAL, stream, p);
  const hipError_t e = hipPeekAtLastError();
  if (e != hipSuccess) fprintf(stderr, "launch failed: %s (grid %d)\n", hipGetErrorString(e), grid_blocks);
}
```

```cpp
#include <hip/hip_runtime.h>
#include <hip/hip_cooperative_groups.h>
#include <cstdio>
#include <cstdint>
namespace cg = cooperative_groups;

#define DEVI __device__ __forceinline__

typedef unsigned short bf16;
using bf16x8 = __attribute__((ext_vector_type(8))) __bf16;
using bf16x2 = __attribute__((ext_vector_type(2))) __bf16;
using f32x16 = __attribute__((ext_vector_type(16))) float;
typedef unsigned v6u __attribute__((ext_vector_type(6)));
typedef unsigned v3u __attribute__((ext_vector_type(3)));
typedef float v16f __attribute__((ext_vector_type(16)));
typedef float v32f __attribute__((ext_vector_type(32)));

constexpr int NL = 16384;
constexpr int NT = 18432;
constexpr int DM = 1024;
constexpr int DIN = 2208;
constexpr int DINP = 2304;
constexpr int SEQP = 2304;
constexpr float EPS = 1e-6f;
constexpr int ZC_AU = 0, ZC_AV = 256, ZC_BQ = 512, ZC_BKV = 768, ZC_BKR = 896, ZC_CQ = 928, ZC_CFF = 1184, ZC_CFB = 1440, ZC_CI = 1696, ZC_CG = 1952;
constexpr int SMEM_BYTES = 2 * 80896;
constexpr int SMEM_TOTAL = SMEM_BYTES + 16;

struct Params {
  const float *x, *c, *ctx, *c_ctx, *ln1_w, *ln2_w, *w_mod, *b_mod, *w_in, *w_out, *a_norm_w, *a_w_s, *a_b_s;
  const float *b_q_norm_w, *b_w_uq, *b_kv_norm_w, *b_w_ukv, *b_qh_w, *b_kh_w, *c_lb, *c_out_norm_w, *p_w_q, *p_sub_keys, *p_u, *p_v;
  float* out;
  unsigned* bar;
  float* MOD;
  float* ROPE;
  bf16* WinT;
  bf16* WoutT;
  bf16* WpqT;
  bf16* WCOMB;
  bf16* RAW;
  bf16* SK;
  bf16* AWS;
  unsigned char* PU8;
  unsigned char* PV8;
  float* PUS;
  float* PVS;
  bf16* X;
  bf16* H;
  bf16* Z;
  bf16* Q;
  bf16* K;
  bf16* VT;
  bf16* ST;
  float* DEC;
  bf16* OI;
  float* WPE;
  bf16* GQF;
  bf16* GQB;
  bf16* QP;
  int* EIDX;
  float* GATE;
  int phase_lo, phase_hi, coop, pad0;
};

DEVI float bf2f(bf16 v) { return __uint_as_float(((unsigned)v) << 16); }
DEVI bf16 f2bf(float a) { __bf16 v = (__bf16)a; return __builtin_bit_cast(unsigned short, v); }
DEVI unsigned pack2(float a, float b) { bf16x2 v; v[0] = (__bf16)a; v[1] = (__bf16)b; return __builtin_bit_cast(unsigned, v); }
DEVI float lo2f(unsigned u) { return __uint_as_float(u << 16); }
DEVI float hi2f(unsigned u) { return __uint_as_float(u & 0xffff0000u); }
DEVI f32x16 zero16() { f32x16 z;
#pragma unroll
  for (int i = 0; i < 16; ++i) z[i] = 0.f; return z; }
DEVI f32x16 mfma32(bf16x8 a, bf16x8 b, f32x16 c) { return __builtin_amdgcn_mfma_f32_32x32x16_bf16(a, b, c, 0, 0, 0); }
DEVI bf16x8 ldfrag(const bf16* p) { return *reinterpret_cast<const bf16x8*>(p); }
DEVI int drow(int r, int hh) { return (r & 3) + 8 * (r >> 2) + 4 * hh; }
DEVI int row_of(int b, int p) { return p < 256 ? NL + b * 256 + p : b * 2048 + (p - 256); }
DEVI int batch_of_row(int r) { return r < NL ? (r >> 11) : 8; }
DEVI float wave_sum(float v) {
#pragma unroll
  for (int o = 32; o > 0; o >>= 1) v += __shfl_xor(v, o);
  return v;
}
DEVI float sigmoidf_(float z) { return 1.f / (1.f + __expf(-z)); }


#define XB_TMO      128
#define XB_XCNT(j)  (256  + 64 * (j))
#define XB_XSUB(j)  (1280 + 64 * (j))
#define XB_XGEN(j)  (2304 + 64 * (j))
#define XB_TOP      3328
#define XB_TOPGEN   3392
#define XCD_BAR_WORDS 3456
#define XB_SPIN_CAP (1u << 22)
#define LAS __attribute__((address_space(3)))
DEVI unsigned xb_ld(unsigned* p)              { return __hip_atomic_load(p, __ATOMIC_RELAXED, __HIP_MEMORY_SCOPE_AGENT); }
DEVI unsigned xb_add(unsigned* p, unsigned v) { return __hip_atomic_fetch_add(p, v, __ATOMIC_RELAXED, __HIP_MEMORY_SCOPE_AGENT); }
DEVI unsigned xb_xcc_id() { return (unsigned)__builtin_amdgcn_s_getreg((3 << 11) | 20) & 0xFu; }
#define XB_SPIN(cond, bar) do { unsigned _sp = 0; while (cond) { __builtin_amdgcn_s_sleep(1); \
    if ((++_sp & 255u) == 0u) { if (xb_ld(&(bar)[XB_TMO])) break; if (_sp > XB_SPIN_CAP) { atomicAdd(&(bar)[XB_TMO], 1u); break; } } } } while (0)
struct XcdBarrier { unsigned* bar; unsigned x; volatile LAS unsigned* st; };
DEVI XcdBarrier xcd_barrier_post(unsigned* bar, volatile LAS unsigned* st) {
  XcdBarrier b; b.bar = bar; b.x = xb_xcc_id(); b.st = st;
  if (threadIdx.x == 0) (void)xb_add(&bar[XB_XCNT(b.x)], 1u);
  return b;
}
DEVI void xcd_barrier_complete(unsigned* bar, unsigned x, unsigned& nloc, unsigned& nx) {
  const unsigned G = gridDim.x * gridDim.y * gridDim.z;
  unsigned sum, cnt, mine, sp = 0u;
  for (;;) {
    sum = 0u; cnt = 0u; mine = 0u;
#pragma unroll
    for (unsigned j = 0; j < 16; ++j) { const unsigned c = xb_ld(&bar[XB_XCNT(j)]); sum += c; cnt += (c > 0u) ? 1u : 0u; mine = (j == x) ? c : mine; }
    if (sum == G) break;
    __builtin_amdgcn_s_sleep(1);
    if ((++sp & 255u) == 0u) { if (xb_ld(&bar[XB_TMO])) break; if (sp > XB_SPIN_CAP) { atomicAdd(&bar[XB_TMO], 1u); break; } }
  }
  nloc = mine > 0u ? mine : 1u; nx = cnt > 0u ? cnt : 1u;
}
DEVI void xcd_barrier(const XcdBarrier& b) {
  asm volatile("s_waitcnt vmcnt(0)" ::: "memory");
  __syncthreads();
  if (threadIdx.x == 0) {
    unsigned* bar = b.bar;
    __builtin_amdgcn_s_waitcnt(0);
    unsigned nloc = b.st[0], nx = b.st[1];
    if (nloc == 0u) { xcd_barrier_complete(bar, b.x, nloc, nx); b.st[0] = nloc; b.st[1] = nx; }
    const unsigned old = xb_add(&bar[XB_XSUB(b.x)], 1u);
    const unsigned gen = old / nloc;
    if (old + 1u == (gen + 1u) * nloc) {
      __builtin_amdgcn_fence(__ATOMIC_RELEASE, "agent");
      asm volatile("s_waitcnt vmcnt(0)" ::: "memory");
      const unsigned og = xb_add(&bar[XB_TOP], 1u);
      const unsigned tg = og / nx;
      if (og + 1u == (tg + 1u) * nx) xb_add(&bar[XB_TOPGEN], 1u);
      else XB_SPIN(xb_ld(&bar[XB_TOPGEN]) == tg, bar);
      __builtin_amdgcn_fence(__ATOMIC_ACQUIRE, "agent");
      xb_add(&bar[XB_XGEN(b.x)], 1u);
      asm volatile("s_waitcnt vmcnt(0)" ::: "memory");
    } else {
      XB_SPIN(xb_ld(&bar[XB_XGEN(b.x)]) == gen, bar);
      __builtin_amdgcn_fence(__ATOMIC_ACQUIRE, "agent");
      asm volatile("s_waitcnt vmcnt(0)" ::: "memory");
    }
  }
  __syncthreads();
}

#define VHALF ((int)__builtin_amdgcn_readfirstlane((int)(threadIdx.x >> 8)))
#define TIDX ((int)(threadIdx.x & 255))
#define VBID ((int)(blockIdx.x * 2 + VHALF))
#define NVB ((int)(gridDim.x * 2))
constexpr int HALF_LDS = 80896;

DEVI void phase_mod(const Params& P, unsigned char* smem) {
  const int tid = TIDX;
  float* s = (float*)smem;
  float* red = s + 9 * 1024;
  for (int item = VBID; item < 192; item += NVB) {
    const int l = item / 96, j = item % 96;
    __syncthreads();
    for (int i = tid; i < 9 * 1024; i += 256) {
      int bi = i >> 10, k = i & 1023;
      float v = bi < 8 ? P.c[bi * 1024 + k] : P.c_ctx[k];
      s[i] = v * sigmoidf_(v);
    }
    __syncthreads();
    const int c4 = tid & 15, kg = tid >> 4;
    float acc[9][4];
#pragma unroll
    for (int bi = 0; bi < 9; ++bi) { acc[bi][0] = acc[bi][1] = acc[bi][2] = acc[bi][3] = 0.f; }
    const float* w = P.w_mod + (size_t)l * 1024 * 6144 + j * 64 + c4 * 4;
#pragma unroll 4
    for (int kk = 0; kk < 64; ++kk) {
      const int k = kg * 64 + kk;
      const float4 w4 = *reinterpret_cast<const float4*>(w + (size_t)k * 6144);
#pragma unroll
      for (int bi = 0; bi < 9; ++bi) {
        const float sv = s[bi * 1024 + k];
        acc[bi][0] += sv * w4.x; acc[bi][1] += sv * w4.y; acc[bi][2] += sv * w4.z; acc[bi][3] += sv * w4.w;
      }
    }
#pragma unroll
    for (int bi = 0; bi < 9; ++bi)
#pragma unroll
      for (int e = 0; e < 4; ++e) red[(kg * 9 + bi) * 64 + c4 * 4 + e] = acc[bi][e];
    __syncthreads();
    for (int o = tid; o < 576; o += 256) {
      const int bi = o >> 6, cc = o & 63;
      float sum = 0.f;
#pragma unroll
      for (int g = 0; g < 16; ++g) sum += red[(g * 9 + bi) * 64 + cc];
      P.MOD[(size_t)(l * 9 + bi) * 6144 + j * 64 + cc] = sum + P.b_mod[l * 6144 + j * 64 + cc];
    }
  }
}

DEVI void conv_T_tile(const float* __restrict__ src, int N, bf16* __restrict__ dst, int Kd, int k0, int n0,
                      const float* __restrict__ kscale, float* tile) {
  const int tid = TIDX;
  __syncthreads();
  for (int e = tid; e < 4096; e += 256) {
    const int i = e >> 6, j = e & 63, n = n0 + j;
    float v = (n < N) ? src[(size_t)(k0 + i) * N + n] : 0.f;
    if (kscale) v *= kscale[k0 + i];
    tile[i * 65 + j] = v;
  }
  __syncthreads();
  for (int e = tid; e < 2048; e += 256) {
    const int j = e >> 5, i2 = (e & 31) * 2;
    const unsigned pk = pack2(tile[i2 * 65 + j], tile[(i2 + 1) * 65 + j]);
    *reinterpret_cast<unsigned*>(&dst[(size_t)(n0 + j) * Kd + k0 + i2]) = pk;
  }
}

DEVI void conv_straight(const float* __restrict__ src, bf16* __restrict__ dst, size_t n8) {
  const size_t stride = (size_t)NVB * 256;
  for (size_t i = (size_t)VBID * 256 + TIDX; i < n8; i += stride) {
    const float4 a = reinterpret_cast<const float4*>(src)[2 * i];
    const float4 b = reinterpret_cast<const float4*>(src)[2 * i + 1];
    uint4 o; o.x = pack2(a.x, a.y); o.y = pack2(a.z, a.w); o.z = pack2(b.x, b.y); o.w = pack2(b.z, b.w);
    reinterpret_cast<uint4*>(dst)[i] = o;
  }
}

DEVI void convert_rows_fp6(const Params& P, int L, int i0, int i1) {
  const int lane = threadIdx.x & 63, half = lane >> 5, l32 = lane & 31;
  const int wv = threadIdx.x >> 6;
  for (int ib = i0 + wv * 2; ib < i1; ib += 16) {
    int i = ib + half; const bool live = i < i1; if (!live) i = i1 - 1;
    const int table = i >> 14, lr = L * 16384 + (i & 16383);
    const float* src = (table ? P.p_v : P.p_u) + (size_t)lr * 1024 + l32 * 32;
    float4 a[8];
    float m = 0.f;
#pragma unroll
    for (int q = 0; q < 8; ++q) {
      a[q] = *reinterpret_cast<const float4*>(src + q * 4);
      m = fmaxf(m, fmaxf(fmaxf(fabsf(a[q].x), fabsf(a[q].y)), fmaxf(fabsf(a[q].z), fabsf(a[q].w))));
    }
    const unsigned sb = (__float_as_uint(fmaxf(m, 1e-30f) * (1.f / 6.f)) + 0xffffu) >> 16;
    const float inv = 1.f / __uint_as_float(sb << 16);
    unsigned pk[4];
#pragma unroll
    for (int w = 0; w < 4; ++w) {
      unsigned word = 0u;
#pragma unroll
      for (int e = 0; e < 8; ++e) {
        const int idx = w * 8 + e;
        const float4 q4 = a[idx >> 2];
        const float xv = ((idx & 3) == 0 ? q4.x : (idx & 3) == 1 ? q4.y : (idx & 3) == 2 ? q4.z : q4.w) * inv;
        const float av = fabsf(xv);
        unsigned ci = (av > 0.25f) + (av > 0.75f) + (av > 1.25f) + (av > 1.75f) + (av > 2.5f) + (av > 3.5f) + (av > 5.f);
        ci |= (xv < 0.f) ? 8u : 0u;
        word |= ci << (4 * e);
      }
      pk[w] = word;
    }
    unsigned char* rowp = (table ? P.PV8 : P.PU8) + (size_t)lr * 576;
    if (live) {
      *reinterpret_cast<uint4*>(rowp + l32 * 16) = make_uint4(pk[0], pk[1], pk[2], pk[3]);
      *reinterpret_cast<unsigned short*>(rowp + 512 + l32 * 2) = (unsigned short)sb;
    }
  }
}

DEVI void phase_prologue(const Params& P, unsigned char* smem) {
  phase_mod(P, smem);
  float* tile = (float*)smem;
  for (int it = VBID; it < 2 * 1424; it += NVB) {
    const int l = it / 1424; int r = it % 1424;
    if (r < 576) { conv_T_tile(P.w_in + (size_t)l * 1024 * DIN, DIN, P.WinT + (size_t)l * DINP * 1024, 1024, (r % 16) * 64, (r / 16) * 64, nullptr, tile); continue; }
    r -= 576;
    if (r < 256) { conv_T_tile(P.w_out + (size_t)l * 1024 * 1024, 1024, P.WoutT + (size_t)l * 1024 * 1024, 1024, (r % 16) * 64, (r / 16) * 64, nullptr, tile); continue; }
    r -= 256;
    if (r < 512) { conv_T_tile(P.p_w_q + (size_t)l * 1024 * 2048, 2048, P.WpqT + (size_t)l * 2048 * 1024, 1024, (r % 16) * 64, (r / 16) * 64, nullptr, tile); continue; }
    r -= 512;
    if (r < 48) { conv_T_tile(P.b_w_uq + (size_t)l * 256 * 768, 768, P.WCOMB + (size_t)l * 1792 * 256, 256, (r % 4) * 64, (r / 4) * 64, P.b_q_norm_w + l * 256, tile); continue; }
    r -= 48;
    conv_T_tile(P.b_w_ukv + (size_t)l * 128 * 1024, 1024, P.WCOMB + (size_t)l * 1792 * 256 + 768 * 256, 256, (r % 2) * 64, (r / 2) * 64, P.b_kv_norm_w + l * 128, tile);
  }
  for (int i = VBID * 256 + TIDX; i < 2 * 1024 * 16; i += NVB * 256) {
    const int l2 = i >> 14, rr = (i >> 4) & 1023, cc = i & 15;
    *reinterpret_cast<uint4*>(P.WCOMB + (size_t)l2 * 1792 * 256 + (size_t)(768 + rr) * 256 + 128 + cc * 8) = make_uint4(0u, 0u, 0u, 0u);
  }
  conv_straight(P.p_sub_keys, P.SK, (size_t)2 * 16 * 128 * 128 / 8);
  conv_straight(P.a_w_s, P.AWS, (size_t)2 * 4 * 128 * 128 / 8);
  for (int i = VBID * 256 + TIDX; i < 2048 * 16; i += NVB * 256) {
    const int t = i >> 4, a = (i >> 3) & 1, f = i & 7;
    const float inv = powf(10000.f, -(float)f / 8.f);
    const float pos = a ? (float)(t & 63) : (float)(t >> 6);
    const float ang = pos * inv;
    P.ROPE[t * 32 + a * 8 + f] = cosf(ang);
    P.ROPE[t * 32 + 16 + a * 8 + f] = sinf(ang);
  }
}

DEVI void phase_norm(const Params& P, int l, int which, int nrows) {
  const int lane = TIDX & 63;
  const int gw = VBID * 4 + (TIDX >> 6), nw = NVB * 4;
  const float* lnw = (which == 0 ? P.ln1_w : P.ln2_w) + l * 1024;
  for (int r = gw; r < nrows; r += nw) {
    const float* mod = P.MOD + (size_t)(l * 9 + batch_of_row(r)) * 6144 + which * 3072;
    float4 v[4];
    float ss = 0.f;
    if (which == 0 && l == 0) {
      const float* src = r < NL ? P.x + (size_t)r * 1024 : P.ctx + (size_t)(r - NL) * 1024;
#pragma unroll
      for (int i = 0; i < 4; ++i) v[i] = *reinterpret_cast<const float4*>(src + i * 256 + lane * 4);
    } else {
      const bf16* src = P.X + (size_t)r * 1024;
#pragma unroll
      for (int i = 0; i < 4; ++i) {
        const uint2 u = *reinterpret_cast<const uint2*>(src + i * 256 + lane * 4);
        v[i] = make_float4(lo2f(u.x), hi2f(u.x), lo2f(u.y), hi2f(u.y));
      }
    }
#pragma unroll
    for (int i = 0; i < 4; ++i) ss += v[i].x * v[i].x + v[i].y * v[i].y + v[i].z * v[i].z + v[i].w * v[i].w;
    ss = wave_sum(ss);
    const float rr = rsqrtf(ss * (1.f / 1024.f) + EPS);
#pragma unroll
    for (int i = 0; i < 4; ++i) {
      const int d = i * 256 + lane * 4;
      const float4 w = *reinterpret_cast<const float4*>(lnw + d);
      const float4 sh = *reinterpret_cast<const float4*>(mod + d);
      const float4 sc = *reinterpret_cast<const float4*>(mod + 1024 + d);
      const float o0 = v[i].x * rr * w.x * (1.f + sc.x) + sh.x;
      const float o1 = v[i].y * rr * w.y * (1.f + sc.y) + sh.y;
      const float o2 = v[i].z * rr * w.z * (1.f + sc.z) + sh.z;
      const float o3 = v[i].w * rr * w.w * (1.f + sc.w) + sh.w;
      uint2 o; o.x = pack2(o0, o1); o.y = pack2(o2, o3);
      *reinterpret_cast<uint2*>(P.H + (size_t)r * 1024 + d) = o;
    }
  }
}

template <int BM, int BN, int BK, int WM, int WN>
struct Gemm {
  static constexpr int LDK = BK + 8;
  static constexpr int TM = BM / WM / 32, TN = BN / WN / 32;
  static constexpr int CPR = BK / 8;
  static constexpr int NA = BM * CPR / 256, NB = BN * CPR / 256;
  static constexpr int A_BYTES = BM * LDK * 2, B_BYTES = BN * LDK * 2;
  static constexpr int STAGE_BYTES = A_BYTES + B_BYTES;
  static constexpr int SMEM = 2 * STAGE_BYTES;

  static DEVI void run(const bf16* __restrict__ A, int lda, const bf16* __restrict__ BT, int ldb, int K,
                       unsigned char* smem, f32x16 (&acc)[TM][TN]) {
    const int tid = TIDX, lane = tid & 63, wave = tid >> 6;
    const int wm = wave / WN, wn = wave % WN;
    const int l31 = lane & 31, hh = lane >> 5;
#pragma unroll
    for (int i = 0; i < TM; ++i)
#pragma unroll
      for (int j = 0; j < TN; ++j) acc[i][j] = zero16();
    uint4 ra[NA], rb[NB];
    const int nk = K / BK;
    auto gload = [&](int kt) {
#pragma unroll
      for (int i = 0; i < NA; ++i) { const int ch = tid + i * 256, row = ch / CPR, cc = ch % CPR;
        ra[i] = *reinterpret_cast<const uint4*>(A + (size_t)row * lda + kt * BK + cc * 8); }
#pragma unroll
      for (int i = 0; i < NB; ++i) { const int ch = tid + i * 256, row = ch / CPR, cc = ch % CPR;
        rb[i] = *reinterpret_cast<const uint4*>(BT + (size_t)row * ldb + kt * BK + cc * 8); }
    };
    auto swrite = [&](int buf) {
      bf16* sA = reinterpret_cast<bf16*>(smem + buf * STAGE_BYTES);
      bf16* sB = reinterpret_cast<bf16*>(smem + buf * STAGE_BYTES + A_BYTES);
#pragma unroll
      for (int i = 0; i < NA; ++i) { const int ch = tid + i * 256, row = ch / CPR, cc = ch % CPR;
        *reinterpret_cast<uint4*>(sA + row * LDK + cc * 8) = ra[i]; }
#pragma unroll
      for (int i = 0; i < NB; ++i) { const int ch = tid + i * 256, row = ch / CPR, cc = ch % CPR;
        *reinterpret_cast<uint4*>(sB + row * LDK + cc * 8) = rb[i]; }
    };
    __syncthreads();
    gload(0);
    swrite(0);
    __syncthreads();
    for (int kt = 0; kt < nk; ++kt) {
      const int cur = kt & 1;
      if (kt + 1 < nk) gload(kt + 1);
      const bf16* sA = reinterpret_cast<const bf16*>(smem + cur * STAGE_BYTES);
      const bf16* sB = reinterpret_cast<const bf16*>(smem + cur * STAGE_BYTES + A_BYTES);
#pragma unroll
      for (int ks = 0; ks < BK / 16; ++ks) {
        bf16x8 af[TM], bfr[TN];
#pragma unroll
        for (int i = 0; i < TM; ++i) af[i] = ldfrag(sA + (wm * (BM / WM) + i * 32 + l31) * LDK + ks * 16 + hh * 8);
#pragma unroll
        for (int j = 0; j < TN; ++j) bfr[j] = ldfrag(sB + (wn * (BN / WN) + j * 32 + l31) * LDK + ks * 16 + hh * 8);
#pragma unroll
        for (int i = 0; i < TM; ++i)
#pragma unroll
          for (int j = 0; j < TN; ++j) acc[i][j] = mfma32(af[i], bfr[j], acc[i][j]);
      }
      if (kt + 1 < nk) swrite(cur ^ 1);
      __syncthreads();
    }
  }
};

DEVI void phase_gemm1(const Params& P, int l, unsigned char* smem) {
  using G = Gemm<128, 128, 64, 2, 2>;
  const int lane = TIDX & 63, wave = TIDX >> 6, wm = wave >> 1, wn = wave & 1, l31 = lane & 31, hh = lane >> 5;
  const bf16* W = P.WinT + (size_t)l * DINP * 1024;
  for (int t = VBID; t < 144 * 18; t += NVB) {
    const int mt = t / 18, nt = t % 18;
    f32x16 acc[2][2];
    G::run(P.H + (size_t)mt * 128 * 1024, 1024, W + (size_t)nt * 128 * 1024, 1024, 1024, smem, acc);
#pragma unroll
    for (int i = 0; i < 2; ++i)
#pragma unroll
      for (int j = 0; j < 2; ++j) {
        const int col = nt * 128 + wn * 64 + j * 32 + l31;
        if (col < DIN) {
#pragma unroll
          for (int r = 0; r < 16; ++r) {
            const int row = mt * 128 + wm * 64 + i * 32 + drow(r, hh);
            P.Z[(size_t)row * DIN + col] = f2bf(acc[i][j][r]);
          }
        }
      }
  }
}

DEVI void phase_gemm2(const Params& P, int l, unsigned char* smem) {
  using G = Gemm<128, 128, 64, 2, 2>;
  const int lane = TIDX & 63, wave = TIDX >> 6, wm = wave >> 1, wn = wave & 1, l31 = lane & 31, hh = lane >> 5;
  const bf16* W = P.WoutT + (size_t)l * 1024 * 1024;
  const int mtiles = (l == 1) ? 128 : 144;
  for (int t = VBID; t < mtiles * 8; t += NVB) {
    const int mt = t / 8, nt = t % 8;
    f32x16 acc[2][2];
    G::run(P.H + (size_t)mt * 128 * 1024, 1024, W + (size_t)nt * 128 * 1024, 1024, 1024, smem, acc);
    const int bi = batch_of_row(mt * 128);
    const float* gate = P.MOD + (size_t)(l * 9 + bi) * 6144 + 2048;
#pragma unroll
    for (int i = 0; i < 2; ++i)
#pragma unroll
      for (int j = 0; j < 2; ++j) {
        const int col = nt * 128 + wn * 64 + j * 32 + l31;
        const float g = gate[col];
#pragma unroll
        for (int r = 0; r < 16; ++r) {
          const int row = mt * 128 + wm * 64 + i * 32 + drow(r, hh);
          float res;
          if (l == 0) res = row < NL ? P.x[(size_t)row * 1024 + col] : P.ctx[(size_t)(row - NL) * 1024 + col];
          else res = bf2f(P.X[(size_t)row * 1024 + col]);
          P.X[(size_t)row * 1024 + col] = f2bf(res + g * acc[i][j][r]);
        }
      }
  }
}

DEVI void phase_mixA(const Params& P, int l, unsigned char* smem) {
  const int tid = TIDX, lane = tid & 63, wave = tid >> 6, l31 = lane & 31, hh = lane >> 5;
  bf16* VNT = reinterpret_cast<bf16*>(smem);
  constexpr int LDV = 136;
  const int nseg = (l == 1) ? 16 : 18;
  const int seg0 = (l == 1) ? 2 : 0;
  for (int it = VBID; it < 8 * nseg * 4; it += NVB) {
    const int a = it & 3; const int sj = (it >> 2) % nseg + seg0; const int b = (it >> 2) / nseg;
    const int p0 = sj * 128;
    __syncthreads();
    {
      const int q = tid >> 1, half = tid & 1;
      const int row = row_of(b, p0 + q);
      const bf16* src = P.Z + (size_t)row * DIN + ZC_AV + a * 64 + half * 32;
      float v[32];
      float ss = 0.f;
#pragma unroll
      for (int i = 0; i < 4; ++i) {
        const uint4 u = *reinterpret_cast<const uint4*>(src + i * 8);
        v[i * 8 + 0] = lo2f(u.x); v[i * 8 + 1] = hi2f(u.x); v[i * 8 + 2] = lo2f(u.y); v[i * 8 + 3] = hi2f(u.y);
        v[i * 8 + 4] = lo2f(u.z); v[i * 8 + 5] = hi2f(u.z); v[i * 8 + 6] = lo2f(u.w); v[i * 8 + 7] = hi2f(u.w);
      }
#pragma unroll
      for (int i = 0; i < 32; ++i) ss += v[i] * v[i];
      ss += __shfl_xor(ss, 1);
      const float rr = rsqrtf(ss * (1.f / 64.f) + EPS);
      const float* nw = P.a_norm_w + l * 256 + a * 64 + half * 32;
#pragma unroll
      for (int i = 0; i < 32; ++i) VNT[(half * 32 + i) * LDV + q] = f2bf(v[i] * rr * nw[i]);
    }
    __syncthreads();
    f32x16 acc[2]; acc[0] = zero16(); acc[1] = zero16();
    const bf16* Aw = P.AWS + (size_t)(l * 4 + a) * 128 * 128 + (size_t)(wave * 32 + l31) * 128;
#pragma unroll
    for (int ks = 0; ks < 8; ++ks) {
      const bf16x8 af = ldfrag(Aw + ks * 16 + hh * 8);
#pragma unroll
      for (int j = 0; j < 2; ++j) {
        const bf16x8 bfr = ldfrag(VNT + (j * 32 + l31) * LDV + ks * 16 + hh * 8);
        acc[j] = mfma32(af, bfr, acc[j]);
      }
    }
    const float* bs = P.a_b_s + (l * 4 + a) * 128;
#pragma unroll
    for (int j = 0; j < 2; ++j)
#pragma unroll
      for (int r = 0; r < 16; ++r) {
        const int p = wave * 32 + drow(r, hh);
        const int row = row_of(b, p0 + p);
        const int col = a * 64 + j * 32 + l31;
        const float u = bf2f(P.Z[(size_t)row * DIN + ZC_AU + col]);
        P.H[(size_t)row * 1024 + col] = f2bf(u * (acc[j][r] + bs[p]));
      }
  }
}

DEVI void mla_norm_rope_store(const Params& P, const float* T, const float* nw, bool rope, float oscale,
                              bf16* dstbase  , int pos0, int tlat0) {
  const int tid = TIDX, tok = tid >> 1, half = tid & 1;
  float v[48];
  float ss = 0.f;
#pragma unroll
  for (int i = 0; i < 48; ++i) { v[i] = T[tok * 97 + half * 48 + i]; ss += v[i] * v[i]; }
  ss += __shfl_xor(ss, 1);
  const float rr = rsqrtf(ss * (1.f / 96.f) + EPS);
#pragma unroll
  for (int i = 0; i < 48; ++i) v[i] = v[i] * rr * nw[half * 48 + i];
  if (rope && half == 1) {
    const float* cs = P.ROPE + (size_t)(tlat0 + tok) * 32;
#pragma unroll
    for (int a = 0; a < 2; ++a)
#pragma unroll
      for (int f = 0; f < 8; ++f) {
        const float x1 = v[16 + a * 16 + f], x2 = v[16 + a * 16 + 8 + f];
        const float c = cs[a * 8 + f], s = cs[16 + a * 8 + f];
        v[16 + a * 16 + f] = x1 * c - x2 * s;
        v[16 + a * 16 + 8 + f] = x2 * c + x1 * s;
      }
  }
  bf16* dst = dstbase + (size_t)(pos0 + tok) * 96 + half * 48;
#pragma unroll
  for (int i = 0; i < 6; ++i) {
    uint4 o;
    o.x = pack2(v[i * 8 + 0] * oscale, v[i * 8 + 1] * oscale); o.y = pack2(v[i * 8 + 2] * oscale, v[i * 8 + 3] * oscale);
    o.z = pack2(v[i * 8 + 4] * oscale, v[i * 8 + 5] * oscale); o.w = pack2(v[i * 8 + 6] * oscale, v[i * 8 + 7] * oscale);
    *reinterpret_cast<uint4*>(dst + i * 8) = o;
  }
}

DEVI void phase_mla_proj(const Params& P, int l, unsigned char* smem) {
  const int tid = TIDX;
  float* T = reinterpret_cast<float*>(smem);
  bf16* TV = reinterpret_cast<bf16*>(smem + 128 * 97 * 4);
  const float qscale = 0.10206207261596577f * 1.4426950408889634f;
  const int tok = tid >> 1, half = tid & 1;
  for (int it = (VBID + NVB - 64) % NVB; it < 144 * 8; it += NVB) {
    const int h = it & 7;
    const int m0 = (it >> 3) * 128;
    const bool lat = m0 < NL;
    const int b = lat ? (m0 >> 11) : ((m0 - NL) >> 8);
    const int pos0 = lat ? 256 + (m0 & 2047) : ((m0 - NL) & 255);
    const int tlat0 = lat ? (m0 & 2047) : 0;
    const bool doq = lat || (l == 0);
    const bf16* zr = P.Z + (size_t)(m0 + tok) * DIN;
    const bf16* rr = P.RAW + (size_t)(m0 + tok) * 1792;
    __syncthreads();
    float rskv, rsq = 0.f;
    {
      float ss = 0.f;
#pragma unroll
      for (int i = 0; i < 8; ++i) {
        const uint4 u = *reinterpret_cast<const uint4*>(zr + ZC_BKV + half * 64 + i * 8);
        ss += lo2f(u.x) * lo2f(u.x) + hi2f(u.x) * hi2f(u.x) + lo2f(u.y) * lo2f(u.y) + hi2f(u.y) * hi2f(u.y)
            + lo2f(u.z) * lo2f(u.z) + hi2f(u.z) * hi2f(u.z) + lo2f(u.w) * lo2f(u.w) + hi2f(u.w) * hi2f(u.w);
      }
      ss += __shfl_xor(ss, 1);
      rskv = rsqrtf(ss * (1.f / 128.f) + EPS);
      if (doq) {
        float sq = 0.f;
#pragma unroll
        for (int i = 0; i < 16; ++i) {
          const uint4 u = *reinterpret_cast<const uint4*>(zr + ZC_BQ + half * 128 + i * 8);
          sq += lo2f(u.x) * lo2f(u.x) + hi2f(u.x) * hi2f(u.x) + lo2f(u.y) * lo2f(u.y) + hi2f(u.y) * hi2f(u.y)
              + lo2f(u.z) * lo2f(u.z) + hi2f(u.z) * hi2f(u.z) + lo2f(u.w) * lo2f(u.w) + hi2f(u.w) * hi2f(u.w);
        }
        sq += __shfl_xor(sq, 1);
        rsq = rsqrtf(sq * (1.f / 256.f) + EPS);
      }
    }
    {
      const bf16* kn = rr + 768 + h * 128 + half * 32;
      const bf16* vv = rr + 768 + h * 128 + 64 + half * 32;
#pragma unroll
      for (int i = 0; i < 4; ++i) {
        const uint4 u = *reinterpret_cast<const uint4*>(kn + i * 8);
        float* tp = T + tok * 97 + half * 32 + i * 8;
        tp[0] = lo2f(u.x) * rskv; tp[1] = hi2f(u.x) * rskv; tp[2] = lo2f(u.y) * rskv; tp[3] = hi2f(u.y) * rskv;
        tp[4] = lo2f(u.z) * rskv; tp[5] = hi2f(u.z) * rskv; tp[6] = lo2f(u.w) * rskv; tp[7] = hi2f(u.w) * rskv;
        const uint4 w = *reinterpret_cast<const uint4*>(vv + i * 8);
        bf16* vp = TV + (half * 32 + i * 8) * 136 + tok;
        vp[0 * 136] = f2bf(lo2f(w.x) * rskv); vp[1 * 136] = f2bf(hi2f(w.x) * rskv); vp[2 * 136] = f2bf(lo2f(w.y) * rskv); vp[3 * 136] = f2bf(hi2f(w.y) * rskv);
        vp[4 * 136] = f2bf(lo2f(w.z) * rskv); vp[5 * 136] = f2bf(hi2f(w.z) * rskv); vp[6 * 136] = f2bf(lo2f(w.w) * rskv); vp[7 * 136] = f2bf(hi2f(w.w) * rskv);
      }
#pragma unroll
      for (int i = 0; i < 2; ++i) {
        const uint4 u = *reinterpret_cast<const uint4*>(zr + ZC_BKR + half * 16 + i * 8);
        float* tp = T + tok * 97 + 64 + half * 16 + i * 8;
        tp[0] = lo2f(u.x); tp[1] = hi2f(u.x); tp[2] = lo2f(u.y); tp[3] = hi2f(u.y);
        tp[4] = lo2f(u.z); tp[5] = hi2f(u.z); tp[6] = lo2f(u.w); tp[7] = hi2f(u.w);
      }
    }
    __syncthreads();
    mla_norm_rope_store(P, T, P.b_kh_w + l * 96, lat, 1.f, P.K + (size_t)(b * 8 + h) * SEQP * 96, pos0, tlat0);
    {
      const int d = tid >> 2, qtr = tid & 3;
      bf16* dst = P.VT + ((size_t)(b * 8 + h) * 64 + d) * SEQP + pos0 + qtr * 32;
      const bf16* src = TV + d * 136 + qtr * 32;
#pragma unroll
      for (int i = 0; i < 4; ++i) {
        const uint4 v = *reinterpret_cast<const uint4*>(src + i * 8);
        const int g16 = (i >> 1) * 16, odd = i & 1;
        *reinterpret_cast<uint2*>(dst + g16 + (odd ? 4 : 0)) = make_uint2(v.x, v.y);
        *reinterpret_cast<uint2*>(dst + g16 + (odd ? 12 : 8)) = make_uint2(v.z, v.w);
      }
    }
    if (doq) {
      __syncthreads();
      const bf16* qq = rr + h * 96 + half * 48;
#pragma unroll
      for (int i = 0; i < 6; ++i) {
        const uint4 u = *reinterpret_cast<const uint4*>(qq + i * 8);
        float* tp = T + tok * 97 + half * 48 + i * 8;
        tp[0] = lo2f(u.x) * rsq; tp[1] = hi2f(u.x) * rsq; tp[2] = lo2f(u.y) * rsq; tp[3] = hi2f(u.y) * rsq;
        tp[4] = lo2f(u.z) * rsq; tp[5] = hi2f(u.z) * rsq; tp[6] = lo2f(u.w) * rsq; tp[7] = hi2f(u.w) * rsq;
      }
      __syncthreads();
      mla_norm_rope_store(P, T, P.b_qh_w + l * 96, lat, qscale, P.Q + (size_t)(b * 8 + h) * SEQP * 96, pos0, tlat0);
    }
  }
}

DEVI void hgrn_load(const Params& P, int l, int b, int hd, int c, float* BF, float* RB, float* SEG,
                    float (&q)[16], float (&kf)[16], float (&kb)[16], float (&v)[16], bool need_kv) {
  const int tid = TIDX, t = tid >> 2, k0 = (tid & 3) * 16;
  const int row = row_of(b, c * 64 + t);
  const bf16* z = P.Z + (size_t)row * DIN + hd * 64 + k0;
  float zf[16], zb[16];
#pragma unroll
  for (int i = 0; i < 2; ++i) {
    const uint4 uq = *reinterpret_cast<const uint4*>(z + ZC_CQ + i * 8);
    const uint4 uf = *reinterpret_cast<const uint4*>(z + ZC_CFF + i * 8);
    const uint4 ub = *reinterpret_cast<const uint4*>(z + ZC_CFB + i * 8);
    q[i * 8 + 0] = lo2f(uq.x); q[i * 8 + 1] = hi2f(uq.x); q[i * 8 + 2] = lo2f(uq.y); q[i * 8 + 3] = hi2f(uq.y);
    q[i * 8 + 4] = lo2f(uq.z); q[i * 8 + 5] = hi2f(uq.z); q[i * 8 + 6] = lo2f(uq.w); q[i * 8 + 7] = hi2f(uq.w);
    zf[i * 8 + 0] = lo2f(uf.x); zf[i * 8 + 1] = hi2f(uf.x); zf[i * 8 + 2] = lo2f(uf.y); zf[i * 8 + 3] = hi2f(uf.y);
    zf[i * 8 + 4] = lo2f(uf.z); zf[i * 8 + 5] = hi2f(uf.z); zf[i * 8 + 6] = lo2f(uf.w); zf[i * 8 + 7] = hi2f(uf.w);
    zb[i * 8 + 0] = lo2f(ub.x); zb[i * 8 + 1] = hi2f(ub.x); zb[i * 8 + 2] = lo2f(ub.y); zb[i * 8 + 3] = hi2f(ub.y);
    zb[i * 8 + 4] = lo2f(ub.z); zb[i * 8 + 5] = hi2f(ub.z); zb[i * 8 + 6] = lo2f(ub.w); zb[i * 8 + 7] = hi2f(ub.w);
    if (need_kv) {
      const uint4 uv = *reinterpret_cast<const uint4*>(z + ZC_CI + i * 8);
      v[i * 8 + 0] = lo2f(uv.x); v[i * 8 + 1] = hi2f(uv.x); v[i * 8 + 2] = lo2f(uv.y); v[i * 8 + 3] = hi2f(uv.y);
      v[i * 8 + 4] = lo2f(uv.z); v[i * 8 + 5] = hi2f(uv.z); v[i * 8 + 6] = lo2f(uv.w); v[i * 8 + 7] = hi2f(uv.w);
    }
  }
#pragma unroll
  for (int i = 0; i < 16; ++i) {
    q[i] *= 0.125f;
    float lbf = 0.f;
    if (l == 1) { const int ch = hd * 64 + k0 + i; lbf = sigmoidf_(P.c_lb[512 + ch] - P.c_lb[ch]); }
    const float zz = zf[i];
    const float e = __expf(-fabsf(zz));
    const float sp = __builtin_amdgcn_rcpf(1.f + e);
    const float sig = zz >= 0.f ? sp : e * sp;
    const float nsig = zz >= 0.f ? e * sp : sp;
    const float lf = (l == 0) ? (fminf(zz, 0.f) - __logf(1.f + e)) : __logf(lbf + (1.f - lbf) * sig);
    kf[i] = (1.f - lbf) * nsig;
    BF[t * 65 + k0 + i] = lf;
  }
  __builtin_amdgcn_sched_barrier(0);
#pragma unroll
  for (int i = 0; i < 16; ++i) {
    float lbb = 0.f;
    if (l == 1) { const int ch = hd * 64 + k0 + i; lbb = sigmoidf_(P.c_lb[512 + 256 + ch] - P.c_lb[256 + ch]); }
    const float zz = zb[i];
    const float e = __expf(-fabsf(zz));
    const float sp = __builtin_amdgcn_rcpf(1.f + e);
    const float sig = zz >= 0.f ? sp : e * sp;
    const float nsig = zz >= 0.f ? e * sp : sp;
    const float lf = (l == 0) ? (fminf(zz, 0.f) - __logf(1.f + e)) : __logf(lbb + (1.f - lbb) * sig);
    kb[i] = (1.f - lbb) * nsig;
    RB[t * 65 + k0 + i] = lf;
  }
  __syncthreads();
  {
    const int k = tid & 63, seg = tid >> 6;
    float sf = 0.f, sr = 0.f;
#pragma unroll
    for (int j = 0; j < 16; ++j) { sf += BF[(seg * 16 + j) * 65 + k]; BF[(seg * 16 + j) * 65 + k] = sf; }
#pragma unroll
    for (int j = 15; j >= 0; --j) { sr += RB[(seg * 16 + j) * 65 + k]; RB[(seg * 16 + j) * 65 + k] = sr; }
    SEG[seg * 64 + k] = sf; SEG[256 + seg * 64 + k] = sr;
    __syncthreads();
    float offf = 0.f, offb = 0.f;
#pragma unroll
    for (int s2 = 0; s2 < 4; ++s2) {
      offf += (s2 < seg) ? SEG[s2 * 64 + k] : 0.f;
      offb += (s2 > seg) ? SEG[256 + s2 * 64 + k] : 0.f;
    }
#pragma unroll
    for (int j = 0; j < 16; ++j) { BF[(seg * 16 + j) * 65 + k] += offf; RB[(seg * 16 + j) * 65 + k] += offb; }
  }
  __syncthreads();
}

DEVI f32x16 lds_mm(const bf16* A, const bf16* BT, int tm, int tn, int l31, int hh) {
  f32x16 acc = zero16();
#pragma unroll
  for (int ks = 0; ks < 4; ++ks) {
    const bf16x8 a = ldfrag(A + (tm * 32 + l31) * 72 + ks * 16 + hh * 8);
    const bf16x8 b = ldfrag(BT + (tn * 32 + l31) * 72 + ks * 16 + hh * 8);
    acc = mfma32(a, b, acc);
  }
  return acc;
}

DEVI void phase_hgrn_local(const Params& P, int l, unsigned char* smem) {
  const int tid = TIDX, lane = tid & 63, wave = tid >> 6, l31 = lane & 31, hh = lane >> 5;
  const int tm = wave >> 1, tn = wave & 1;
  float* BF = reinterpret_cast<float*>(smem);
  float* RB = BF + 64 * 65;
  bf16* QF = reinterpret_cast<bf16*>(smem + 33280);
  bf16* KF = QF + 64 * 72;
  bf16* QB = KF + 64 * 72;
  bf16* KB = QB + 64 * 72;
  bf16* VTt = KB + 64 * 72;
  bf16* KHF = reinterpret_cast<bf16*>(smem);
  bf16* KHB = KHF + 64 * 72;
  bf16* ATT = KHB + 64 * 72;
  for (int it = (VBID + NVB - 192) % NVB; it < 8 * 4 * 36; it += NVB) {
    const int c = it % 36, hd = (it / 36) & 3, b = it / 144;
    float q[16], kf[16], kb[16], v[16];
    __syncthreads();
    hgrn_load(P, l, b, hd, c, BF, RB, reinterpret_cast<float*>(smem + 33280), q, kf, kb, v, true);
    const int t = tid >> 2, k0 = (tid & 3) * 16;
#pragma unroll
    for (int i = 0; i < 16; ++i) VTt[(k0 + i) * 72 + t] = f2bf(v[i]);
    float bfv[16], rbv[16];
#pragma unroll
    for (int i = 0; i < 16; ++i) { bfv[i] = BF[t * 65 + k0 + i]; rbv[i] = RB[t * 65 + k0 + i]; }
    {
      const size_t go = (size_t)row_of(b, c * 64 + t) * 256 + hd * 64 + k0;
#pragma unroll
      for (int hq = 0; hq < 2; ++hq) {
        unsigned pf[4], pb[4];
#pragma unroll
        for (int i = 0; i < 8; i += 2) {
          pf[i >> 1] = pack2(q[hq * 8 + i] * __expf(bfv[hq * 8 + i]), q[hq * 8 + i + 1] * __expf(bfv[hq * 8 + i + 1]));
          pb[i >> 1] = pack2(q[hq * 8 + i] * __expf(rbv[hq * 8 + i]), q[hq * 8 + i + 1] * __expf(rbv[hq * 8 + i + 1]));
        }
        *reinterpret_cast<uint4*>(P.GQF + go + hq * 8) = make_uint4(pf[0], pf[1], pf[2], pf[3]);
        *reinterpret_cast<uint4*>(P.GQB + go + hq * 8) = make_uint4(pb[0], pb[1], pb[2], pb[3]);
      }
    }
    if (t == 0) {
      float* dec = P.DEC + ((size_t)((b * 4 + hd) * 2) * 36 + c) * 64 + k0;
#pragma unroll
      for (int i = 0; i < 16; ++i) { dec[i] = __expf(BF[63 * 65 + k0 + i]); dec[36 * 64 + i] = __expf(RB[k0 + i]); }
    }
#pragma unroll
    for (int i = 0; i < 16; i += 2) {
      const int k = k0 + i;
      const float mF0 = BF[32 * 65 + k], mF1 = BF[32 * 65 + k + 1], mB0 = RB[32 * 65 + k], mB1 = RB[32 * 65 + k + 1];
      *reinterpret_cast<unsigned*>(&QF[t * 72 + k]) = pack2(q[i] * __expf(fminf(bfv[i] - mF0, 80.f)), q[i + 1] * __expf(fminf(bfv[i + 1] - mF1, 80.f)));
      *reinterpret_cast<unsigned*>(&KF[t * 72 + k]) = pack2(kf[i] * __expf(fminf(mF0 - bfv[i], 80.f)), kf[i + 1] * __expf(fminf(mF1 - bfv[i + 1], 80.f)));
      *reinterpret_cast<unsigned*>(&QB[t * 72 + k]) = pack2(q[i] * __expf(fminf(rbv[i] - mB0, 80.f)), q[i + 1] * __expf(fminf(rbv[i + 1] - mB1, 80.f)));
      *reinterpret_cast<unsigned*>(&KB[t * 72 + k]) = pack2(kb[i] * __expf(fminf(mB0 - rbv[i], 80.f)), kb[i + 1] * __expf(fminf(mB1 - rbv[i + 1], 80.f)));
    }
#pragma unroll
    for (int i = 0; i < 16; ++i) {
      kf[i] = kf[i] * __expf(BF[63 * 65 + k0 + i] - bfv[i]);
      kb[i] = kb[i] * __expf(RB[k0 + i] - rbv[i]);
    }
    __syncthreads();
#pragma unroll
    for (int i = 0; i < 16; ++i) {
      KHF[(k0 + i) * 72 + t] = f2bf(kf[i]);
      KHB[(k0 + i) * 72 + t] = f2bf(kb[i]);
    }
    __syncthreads();
    {
      const f32x16 af = lds_mm(QF, KF, tm, tn, l31, hh);
      const f32x16 ab = lds_mm(QB, KB, tm, tn, l31, hh);
      const int s = tn * 32 + l31;
#pragma unroll
      for (int r = 0; r < 16; ++r) {
        const int tt = tm * 32 + drow(r, hh);
        float a = 0.f;
        if (s <= tt) a += af[r];
        if (s >= tt) a += ab[r];
        ATT[tt * 72 + s] = f2bf(a);
      }
    }
    {
      const f32x16 lf = lds_mm(VTt, KHF, tm, tn, l31, hh);
      const f32x16 lb = lds_mm(VTt, KHB, tm, tn, l31, hh);
      bf16* stf = P.ST + ((size_t)((b * 4 + hd) * 2 + 0) * 36 + c) * 4096;
      bf16* stb = P.ST + ((size_t)((b * 4 + hd) * 2 + 1) * 36 + c) * 4096;
#pragma unroll
      for (int r = 0; r < 16; ++r) {
        const int kk = tm * 32 + drow(r, hh), d = tn * 32 + l31;
        stf[kk * 64 + d] = f2bf(lf[r]);
        stb[kk * 64 + d] = f2bf(lb[r]);
      }
    }
    __syncthreads();
    {
      const f32x16 o = lds_mm(ATT, VTt, tm, tn, l31, hh);
#pragma unroll
      for (int r = 0; r < 16; ++r) {
        const int tt = tm * 32 + drow(r, hh), d = tn * 32 + l31;
        P.OI[(size_t)row_of(b, c * 64 + tt) * 256 + hd * 64 + d] = f2bf(o[r]);
      }
    }
  }
}

DEVI void hgrn_scan_item(const Params& P, int item) {
  const int tid = TIDX;
  const int chain = item >> 2, sl = item & 3;
  const int dir = chain & 1;
  const int dd = tid >> 2, k4 = sl * 16 + (tid & 3) * 4;
  float4 S = make_float4(0.f, 0.f, 0.f, 0.f);
  bf16* base = P.ST + (size_t)chain * 36 * 4096 + dd * 64 + k4;
  const float* dec = P.DEC + (size_t)chain * 36 * 64 + k4;
#pragma unroll 1
  for (int g = 0; g < 6; ++g) {
    float4 L[6], dc[6];
#pragma unroll
    for (int j = 0; j < 6; ++j) {
      const int step = g * 6 + j;
      const int c = dir == 0 ? step : (step < 4 ? 3 - step : 39 - step);
      { const uint2 u = *reinterpret_cast<const uint2*>(base + (size_t)c * 4096); L[j] = make_float4(lo2f(u.x), hi2f(u.x), lo2f(u.y), hi2f(u.y)); }
      dc[j] = *reinterpret_cast<const float4*>(dec + c * 64);
    }
#pragma unroll
    for (int j = 0; j < 6; ++j) {
      const int step = g * 6 + j;
      const int c = dir == 0 ? step : (step < 4 ? 3 - step : 39 - step);
      *reinterpret_cast<uint2*>(base + (size_t)c * 4096) = make_uint2(pack2(S.x, S.y), pack2(S.z, S.w));
      S.x = dc[j].x * S.x + L[j].x; S.y = dc[j].y * S.y + L[j].y; S.z = dc[j].z * S.z + L[j].z; S.w = dc[j].w * S.w + L[j].w;
    }
  }
}

DEVI void phase_hgrn_final(const Params& P, int l, unsigned char* smem) {
  const int tid = TIDX, lane = tid & 63, wave = tid >> 6, l31 = lane & 31, hh = lane >> 5;
  const int tm = wave >> 1, tn = wave & 1;
  float* O = reinterpret_cast<float*>(smem);
  bf16* QF = reinterpret_cast<bf16*>(smem + 33280);
  bf16* QB = QF + 64 * 72;
  bf16* SF = QB + 64 * 72;
  bf16* SB = SF + 64 * 72;
  const int c0 = (l == 1) ? 4 : 0;
  const int nc = 36 - c0;
  for (int it = VBID; it < 8 * 4 * nc; it += NVB) {
    const int c = it % nc + c0, hd = (it / nc) & 3, b = it / (nc * 4);
    const int t = tid >> 2, k0 = (tid & 3) * 16;
    const int row = row_of(b, c * 64 + t);
    __syncthreads();
    {
      const size_t go = (size_t)row * 256 + hd * 64 + k0;
      *reinterpret_cast<uint4*>(QF + t * 72 + k0) = *reinterpret_cast<const uint4*>(P.GQF + go);
      *reinterpret_cast<uint4*>(QF + t * 72 + k0 + 8) = *reinterpret_cast<const uint4*>(P.GQF + go + 8);
      *reinterpret_cast<uint4*>(QB + t * 72 + k0) = *reinterpret_cast<const uint4*>(P.GQB + go);
      *reinterpret_cast<uint4*>(QB + t * 72 + k0 + 8) = *reinterpret_cast<const uint4*>(P.GQB + go + 8);
      const bf16* stf = P.ST + ((size_t)((b * 4 + hd) * 2 + 0) * 36 + c) * 4096 + t * 64 + k0;
      const bf16* stb = P.ST + ((size_t)((b * 4 + hd) * 2 + 1) * 36 + c) * 4096 + t * 64 + k0;
      *reinterpret_cast<uint4*>(SF + t * 72 + k0) = *reinterpret_cast<const uint4*>(stf);
      *reinterpret_cast<uint4*>(SF + t * 72 + k0 + 8) = *reinterpret_cast<const uint4*>(stf + 8);
      *reinterpret_cast<uint4*>(SB + t * 72 + k0) = *reinterpret_cast<const uint4*>(stb);
      *reinterpret_cast<uint4*>(SB + t * 72 + k0 + 8) = *reinterpret_cast<const uint4*>(stb + 8);
    }
    __syncthreads();
    {
      f32x16 o = lds_mm(QF, SF, tm, tn, l31, hh);
      const f32x16 o2 = lds_mm(QB, SB, tm, tn, l31, hh);
#pragma unroll
      for (int r = 0; r < 16; ++r) {
        const int tt = tm * 32 + drow(r, hh), d = tn * 32 + l31;
        O[tt * 65 + d] = o[r] + o2[r] + bf2f(P.OI[(size_t)row_of(b, c * 64 + tt) * 256 + hd * 64 + d]);
      }
    }
    __syncthreads();
    {
      float ov[16]; float ss = 0.f;
#pragma unroll
      for (int i = 0; i < 16; ++i) { ov[i] = O[t * 65 + k0 + i]; ss += ov[i] * ov[i]; }
      ss += __shfl_xor(ss, 1); ss += __shfl_xor(ss, 2);
      const float rr = rsqrtf(ss * (1.f / 64.f) + EPS);
      const bf16* g = P.Z + (size_t)row * DIN + ZC_CG + hd * 64 + k0;
      const float* nw = P.c_out_norm_w + l * 64 + k0;
      const uint4 gA = *reinterpret_cast<const uint4*>(g), gB = *reinterpret_cast<const uint4*>(g + 8);
      const unsigned gw[8] = {gA.x, gA.y, gA.z, gA.w, gB.x, gB.y, gB.z, gB.w};
      unsigned pk[8];
#pragma unroll
      for (int i = 0; i < 16; i += 2) {
        const float g0 = lo2f(gw[i >> 1]), g1 = hi2f(gw[i >> 1]);
        const float y0 = ov[i] * rr * nw[i] * (g0 * sigmoidf_(g0));
        const float y1 = ov[i + 1] * rr * nw[i + 1] * (g1 * sigmoidf_(g1));
        pk[i >> 1] = pack2(y0, y1);
      }
      uint4* dst = reinterpret_cast<uint4*>(P.H + (size_t)row * 1024 + 768 + hd * 64 + k0);
      dst[0] = make_uint4(pk[0], pk[1], pk[2], pk[3]);
      dst[1] = make_uint4(pk[4], pk[5], pk[6], pk[7]);
    }
  }
}

DEVI void attn_item8(const Params& P, int b, int h, int qpos0, int nkeys, float sref, unsigned char* smem_base) {
  const int tid = threadIdx.x, lane = tid & 63, wave = tid >> 6, l31 = lane & 31, hh = lane >> 5;
  constexpr int TK = 128, LDKS = 104, LDVS = 136;
  constexpr int KS_BYTES = TK * LDKS * 2, VS_BYTES = 64 * LDVS * 2, ST_BYTES = KS_BYTES + VS_BYTES;
  const bf16* Qg = P.Q + ((size_t)(b * 8 + h) * SEQP + qpos0 + wave * 32 + l31) * 96;
  const bf16* Kg = P.K + (size_t)(b * 8 + h) * SEQP * 96;
  const bf16* Vg = P.VT + (size_t)(b * 8 + h) * 64 * SEQP;
  bf16x8 qf[6];
#pragma unroll
  for (int ks = 0; ks < 6; ++ks) qf[ks] = ldfrag(Qg + ks * 16 + hh * 8);
  f32x16 oacc[2]; oacc[0] = zero16(); oacc[1] = zero16();
  float lsum = 0.f;
  const int ntiles = nkeys / TK;
  unsigned koff[4], voff[3];
#pragma unroll
  for (int i = 0; i < 4; ++i) { const int q = (i * 8 + wave) * 64 + lane, row = q / 13, cc = q - row * 13; koff[i] = (unsigned)(row * 96 + (cc < 12 ? cc : 0) * 8) * 2u; }
#pragma unroll
  for (int i = 0; i < 3; ++i) { const int q = (i * 8 + wave) * 64 + lane, row = q / 17, cc = q - row * 17; voff[i] = (unsigned)((row < 64 ? row : 63) * SEQP + (cc < 16 ? cc : 0) * 8) * 2u; }
  LAS unsigned char* ldsb = (LAS unsigned char*)smem_base;
  auto dma_tile = [&](int kt, int buf) {
    const char* kb_ = (const char*)(Kg + (size_t)kt * TK * 96);
    const char* vb_ = (const char*)(Vg + (size_t)kt * TK);
#pragma unroll
    for (int i = 0; i < 4; ++i) {
      const int g = i * 8 + wave;
      if (g < 26) __builtin_amdgcn_global_load_lds((const unsigned*)(kb_ + koff[i]), (LAS unsigned*)(ldsb + buf * ST_BYTES + g * 1024), 16, 0, 0);
    }
#pragma unroll
    for (int i = 0; i < 3; ++i) {
      const int g = i * 8 + wave;
      if (g < 17) __builtin_amdgcn_global_load_lds((const unsigned*)(vb_ + voff[i]), (LAS unsigned*)(ldsb + buf * ST_BYTES + KS_BYTES + g * 1024), 16, 0, 0);
    }
  };
  __syncthreads();
  dma_tile(0, 0);
  asm volatile("s_waitcnt vmcnt(0)" ::: "memory");
  __syncthreads();
  for (int kt = 0; kt < ntiles; ++kt) {
    const int cur = kt & 1;
    if (kt + 1 < ntiles) dma_tile(kt + 1, cur ^ 1);
    const bf16* sK = reinterpret_cast<const bf16*>(smem_base + cur * ST_BYTES);
    const bf16* sV = reinterpret_cast<const bf16*>(smem_base + cur * ST_BYTES + KS_BYTES);
#pragma unroll
    for (int kk = 0; kk < 4; ++kk) {
      f32x16 sacc;
#pragma unroll
      for (int r = 0; r < 16; ++r) sacc[r] = -sref;
#pragma unroll
      for (int ks = 0; ks < 6; ++ks) {
        const bf16x8 a = ldfrag(sK + (kk * 32 + l31) * LDKS + ks * 16 + hh * 8);
        sacc = mfma32(a, qf[ks], sacc);
      }
#pragma unroll
      for (int r = 0; r < 16; ++r) { const float p = __builtin_amdgcn_exp2f(sacc[r]); sacc[r] = p; lsum += p; }
#pragma unroll
      for (int s = 0; s < 2; ++s) {
        bf16x8 pb;
#pragma unroll
        for (int j = 0; j < 8; ++j) pb[j] = (__bf16)sacc[8 * s + j];
#pragma unroll
        for (int dt = 0; dt < 2; ++dt) {
          const bf16x8 a = ldfrag(sV + (dt * 32 + l31) * LDVS + kk * 32 + s * 16 + hh * 8);
          oacc[dt] = mfma32(a, pb, oacc[dt]);
        }
      }
    }
    asm volatile("s_waitcnt vmcnt(0)" ::: "memory");
    __syncthreads();
  }
  lsum += __shfl_xor(lsum, 32);
  const float inv = 1.f / lsum;
  const int row = row_of(b, qpos0 + wave * 32 + l31);
  bf16* dst = P.H + (size_t)row * 1024 + 256 + h * 64;
#pragma unroll
  for (int dt = 0; dt < 2; ++dt)
#pragma unroll
    for (int rg = 0; rg < 4; ++rg) {
      const int d = dt * 32 + 8 * rg + 4 * hh;
      uint2 o;
      o.x = pack2(oacc[dt][4 * rg + 0] * inv, oacc[dt][4 * rg + 1] * inv);
      o.y = pack2(oacc[dt][4 * rg + 2] * inv, oacc[dt][4 * rg + 3] * inv);
      *reinterpret_cast<uint2*>(dst + d) = o;
    }
}

DEVI void phase_attn_scan(const Params& P, int l, unsigned char* smem_base, bool skip_scan = false) {
  if (!skip_scan)
    for (int it = NVB - 1 - VBID; it < 256; it += NVB) hgrn_scan_item(P, it);
  float sref;
  {
    const int lane = threadIdx.x & 63;
    float mq = fmaxf(fabsf(P.b_qh_w[l * 96 + lane]), lane < 32 ? fabsf(P.b_qh_w[l * 96 + 64 + lane]) : 0.f);
    float mk = fmaxf(fabsf(P.b_kh_w[l * 96 + lane]), lane < 32 ? fabsf(P.b_kh_w[l * 96 + 64 + lane]) : 0.f);
#pragma unroll
    for (int o = 32; o > 0; o >>= 1) { mq = fmaxf(mq, __shfl_xor(mq, o)); mk = fmaxf(mk, __shfl_xor(mk, o)); }
    sref = fminf(1.4426950408889634f * 9.797958971132712f * mq * mk, 60.f);
  }
  const int c = blockIdx.x, xcd = c & 7, slot = c >> 3;
  const int nrounds = (l == 0) ? 3 : 2;
  for (int r = 0; r < nrounds; ++r) {
    if (r < 2) {
      const int u = r * 32 + slot;
      const int bh = xcd * 8 + (u >> 3), qt = u & 7;
      if (slot < 32) attn_item8(P, bh >> 3, bh & 7, 256 + 256 * qt, 2304, sref, smem_base);
    } else if (c < 64) {
      attn_item8(P, c >> 3, c & 7, 0, 256, sref, smem_base);
    }
  }
}

DEVI unsigned ordkey(float s) { const unsigned u = __float_as_uint(s); return (u & 0x80000000u) ? ~u : (u | 0x80000000u); }
DEVI float keyval(unsigned k, unsigned mask) { const unsigned u = k & ~mask; return __uint_as_float((u & 0x80000000u) ? (u & 0x7fffffffu) : ~u); }
DEVI void ins16(unsigned (&lst)[16], unsigned v) {
#pragma unroll
  for (int j = 0; j < 16; ++j) { const unsigned hi = max(lst[j], v); v = min(lst[j], v); lst[j] = hi; }
}
DEVI void merge16(unsigned (&lst)[16], int xm) {
  unsigned o[16];
#pragma unroll
  for (int j = 0; j < 16; ++j) o[j] = (unsigned)__shfl_xor((int)lst[j], xm);
#pragma unroll
  for (int j = 0; j < 16; ++j) lst[j] = max(lst[j], o[15 - j]);
#pragma unroll
  for (int d = 8; d >= 1; d >>= 1)
#pragma unroll
    for (int j = 0; j < 16; ++j)
      if ((j & d) == 0) { const unsigned a = lst[j], bb = lst[j + d]; lst[j] = max(a, bb); lst[j + d] = min(a, bb); }
}

DEVI void bitonic_sort_desc16(unsigned (&v)[16]) {
#pragma unroll
  for (int k = 2; k <= 16; k <<= 1)
#pragma unroll
    for (int j = k >> 1; j > 0; j >>= 1)
#pragma unroll
      for (int i = 0; i < 16; ++i) {
        const int l = i ^ j;
        if (l > i) {
          const bool desc = ((i & k) == 0);
          const unsigned a = v[i], b = v[l];
          const unsigned mx = max(a, b), mn = min(a, b);
          v[i] = desc ? mx : mn; v[l] = desc ? mn : mx;
        }
      }
}
DEVI void bitonic_merge_desc16(unsigned (&lst)[16]) {
#pragma unroll
  for (int d = 8; d >= 1; d >>= 1)
#pragma unroll
    for (int j = 0; j < 16; ++j)
      if ((j & d) == 0) { const unsigned a = lst[j], bb = lst[j + d]; lst[j] = max(a, bb); lst[j + d] = min(a, bb); }
}
struct CandTab { int a[52]; int b[52]; };
constexpr CandTab make_cand_tab() {
  CandTab t{};
  int n = 0;
  for (int a = 0; a < 16; ++a)
    for (int b = 0; b < 16; ++b)
      if ((a + 1) * (b + 1) <= 16) { t.a[n] = a; t.b[n] = b; ++n; }
  for (; n < 52; ++n) { t.a[n] = 0; t.b[n] = 0; }
  return t;
}

DEVI void phase_route(const Params& P, int l, unsigned char* smem) {
  const int tid = TIDX, lane = tid & 63, wave = tid >> 6, l31 = lane & 31, hh = lane >> 5;
  bf16* QT = reinterpret_cast<bf16*>(smem);
  float* SC = reinterpret_cast<float*>(smem + 33792);
  const int mtiles = (l == 1) ? 256 : 288;
  for (int it = VBID; it < mtiles * 8; it += NVB) {
    const int mt = it >> 3, h = it & 7;
    __syncthreads();
    for (int e = tid; e < 64 * 32; e += 256) {
      const int r = e >> 5, cc = e & 31;
      *reinterpret_cast<uint4*>(QT + r * 264 + cc * 8) = *reinterpret_cast<const uint4*>(P.QP + (size_t)(mt * 64 + r) * 2048 + h * 256 + cc * 8);
    }
    __syncthreads();
    unsigned lst[2][16];
    const int row = tid >> 2, part = tid & 3;
#pragma unroll
    for (int p = 0; p < 2; ++p) {
      f32x16 sa[2]; sa[0] = zero16(); sa[1] = zero16();
      const bf16* keys = P.SK + ((size_t)(l * 16 + h * 2 + p) * 128 + wave * 32 + l31) * 128;
#pragma unroll
      for (int ks = 0; ks < 8; ++ks) {
        const bf16x8 bfr = ldfrag(keys + ks * 16 + hh * 8);
#pragma unroll
        for (int i = 0; i < 2; ++i) {
          const bf16x8 af = ldfrag(QT + (i * 32 + l31) * 264 + p * 128 + ks * 16 + hh * 8);
          sa[i] = mfma32(af, bfr, sa[i]);
        }
      }
      if (p == 1) __syncthreads();
#pragma unroll
      for (int i = 0; i < 2; ++i)
#pragma unroll
        for (int r = 0; r < 16; ++r) SC[(i * 32 + drow(r, hh)) * 129 + wave * 32 + l31] = sa[i][r];
      __syncthreads();
      unsigned B2[16];
#pragma unroll
      for (int i = 0; i < 16; ++i) {
        const int i0 = part * 32 + ((i + part * 8) & 31), i1 = part * 32 + ((i + 16 + part * 8) & 31);
        lst[p][i] = (ordkey(SC[row * 129 + i0]) & ~0x7fu) | (unsigned)(127 - i0);
        B2[i] = (ordkey(SC[row * 129 + i1]) & ~0x7fu) | (unsigned)(127 - i1);
      }
      bitonic_sort_desc16(lst[p]);
      bitonic_sort_desc16(B2);
#pragma unroll
      for (int j = 0; j < 16; ++j) lst[p][j] = max(lst[p][j], B2[15 - j]);
      bitonic_merge_desc16(lst[p]);
      merge16(lst[p], 1);
      merge16(lst[p], 2);
    }
    float v0[16], v1[16];
#pragma unroll
    for (int j = 0; j < 16; ++j) { v0[j] = keyval(lst[0][j], 0x7fu); v1[j] = keyval(lst[1][j], 0x7fu); }
    unsigned best[16];
    {
      constexpr CandTab CT = make_cand_tab();
#pragma unroll
      for (int c = 0; c < 13; ++c) {
        const int a0 = CT.a[4 * c + 0], a1 = CT.a[4 * c + 1], a2 = CT.a[4 * c + 2], a3 = CT.a[4 * c + 3];
        const int b0 = CT.b[4 * c + 0], b1 = CT.b[4 * c + 1], b2 = CT.b[4 * c + 2], b3 = CT.b[4 * c + 3];
        const float x = part == 0 ? v0[a0] : part == 1 ? v0[a1] : part == 2 ? v0[a2] : v0[a3];
        const float y = part == 0 ? v1[b0] : part == 1 ? v1[b1] : part == 2 ? v1[b2] : v1[b3];
        const int flat = part == 0 ? (a0 * 16 + b0) : part == 1 ? (a1 * 16 + b1) : part == 2 ? (a2 * 16 + b2) : (a3 * 16 + b3);
        const bool valid = part == 0 ? (4 * c + 0 < 50) : part == 1 ? (4 * c + 1 < 50) : part == 2 ? (4 * c + 2 < 50) : (4 * c + 3 < 50);
        const unsigned key = (ordkey(x + y) & ~0xffu) | (unsigned)(255 - flat);
        best[c] = valid ? key : 0u;
      }
      best[13] = 0u; best[14] = 0u; best[15] = 0u;
      bitonic_sort_desc16(best);
      merge16(best, 1);
      merge16(best, 2);
    }
    {
      const float mx = keyval(best[0], 0xffu);
      float es = 0.f;
      float ev[4]; int ex[4];
#pragma unroll
      for (int jj = 0; jj < 4; ++jj) {
        const unsigned kk = part == 0 ? best[4 * jj + 0] : part == 1 ? best[4 * jj + 1] : part == 2 ? best[4 * jj + 2] : best[4 * jj + 3];
        ev[jj] = __expf(keyval(kk, 0xffu) - mx);
        es += ev[jj];
        const int flat = 255 - (int)(kk & 0xffu);
        const int a = flat >> 4, bq = flat & 15;
        int i1 = 0, i2 = 0;
#pragma unroll
        for (int u = 0; u < 16; ++u) {
          i1 = (a == u) ? (127 - (int)(lst[0][u] & 0x7fu)) : i1;
          i2 = (bq == u) ? (127 - (int)(lst[1][u] & 0x7fu)) : i2;
        }
        ex[jj] = i1 * 128 + i2;
      }
      es += __shfl_xor(es, 1); es += __shfl_xor(es, 2);
      const float inv = 1.f / es;
      const int tok = mt * 64 + row;
      int* ed = P.EIDX + (size_t)tok * 128 + h * 16;
      float* gd = P.GATE + (size_t)tok * 128 + h * 16;
#pragma unroll
      for (int jj = 0; jj < 4; ++jj) { ed[4 * jj + part] = ex[jj]; gd[4 * jj + part] = ev[jj] * inv; }
    }
  }
}

DEVI float gelu_exact(float a) { return 0.5f * a * (1.f + erff(a * 0.70710678118654752f)); }

typedef float f2 __attribute__((ext_vector_type(2)));
DEVI void phase_peer_u(const Params& P, int l) {
  const int lane = TIDX & 63, half = lane >> 5, l32 = lane & 31;
  const int gw = VBID * 4 + (TIDX >> 6), nw = NVB * 4;
  const int nrows = (l == 1) ? NL : NT;
  const unsigned char* PU = P.PU8 + (size_t)l * 16384 * 576;
  const bool b4 = lane & 16, b3 = lane & 8, b2 = lane & 4;
  for (int t = gw; t < nrows; t += nw) {
    f2 h2[16];
    {
      const bf16* hp = P.H + (size_t)t * 1024 + l32 * 32;
#pragma unroll
      for (int i = 0; i < 4; ++i) {
        const uint4 hv = *reinterpret_cast<const uint4*>(hp + i * 8);
        h2[4 * i + 0] = (f2){lo2f(hv.x), hi2f(hv.x)}; h2[4 * i + 1] = (f2){lo2f(hv.y), hi2f(hv.y)};
        h2[4 * i + 2] = (f2){lo2f(hv.z), hi2f(hv.z)}; h2[4 * i + 3] = (f2){lo2f(hv.w), hi2f(hv.w)};
      }
    }
    const int e0 = P.EIDX[(size_t)t * 128 + lane], e1 = P.EIDX[(size_t)t * 128 + 64 + lane];
    const float g0 = P.GATE[(size_t)t * 128 + lane], g1 = P.GATE[(size_t)t * 128 + 64 + lane];
    float* wrow = P.WPE + (size_t)t * 128;
    const bool b1 = lane & 2;
    for (int kb = 0; kb < 4; ++kb) {
      const int esrc = kb < 2 ? e0 : e1;
      uint4 ud[16];
      unsigned short us[16];
#pragma unroll
      for (int i = 0; i < 16; ++i) {
        const int e = __shfl(esrc, (kb * 32 + 2 * i + half) & 63);
        const unsigned char* ur = PU + (size_t)e * 576;
        ud[i] = *reinterpret_cast<const uint4*>(ur + l32 * 16);
        us[i] = *reinterpret_cast<const unsigned short*>(ur + 512 + l32 * 2);
      }
      float d[16];
#pragma unroll
      for (int i = 0; i < 16; ++i) {
        const unsigned uw[4] = {ud[i].x, ud[i].y, ud[i].z, ud[i].w};
        f2 sacc = (f2){0.f, 0.f};
#pragma unroll
        for (int c = 0; c < 4; ++c) {
          sacc = __builtin_elementwise_fma(__builtin_amdgcn_cvt_scalef32_pk_f32_fp4(uw[c], 1.0f, 0), h2[4 * c + 0], sacc);
          sacc = __builtin_elementwise_fma(__builtin_amdgcn_cvt_scalef32_pk_f32_fp4(uw[c], 1.0f, 1), h2[4 * c + 1], sacc);
          sacc = __builtin_elementwise_fma(__builtin_amdgcn_cvt_scalef32_pk_f32_fp4(uw[c], 1.0f, 2), h2[4 * c + 2], sacc);
          sacc = __builtin_elementwise_fma(__builtin_amdgcn_cvt_scalef32_pk_f32_fp4(uw[c], 1.0f, 3), h2[4 * c + 3], sacc);
        }
        d[i] = (sacc.x + sacc.y) * __uint_as_float((unsigned)us[i] << 16);
      }
      float r8[8], r4[4], r2[2], r1;
#pragma unroll
      for (int i = 0; i < 8; ++i) { const float mine = b4 ? d[8 + i] : d[i]; const float send = b4 ? d[i] : d[8 + i]; r8[i] = mine + __shfl_xor(send, 16); }
#pragma unroll
      for (int i = 0; i < 4; ++i) { const float mine = b3 ? r8[4 + i] : r8[i]; const float send = b3 ? r8[i] : r8[4 + i]; r4[i] = mine + __shfl_xor(send, 8); }
#pragma unroll
      for (int i = 0; i < 2; ++i) { const float mine = b2 ? r4[2 + i] : r4[i]; const float send = b2 ? r4[i] : r4[2 + i]; r2[i] = mine + __shfl_xor(send, 4); }
      { const float mine = b1 ? r2[1] : r2[0]; const float send = b1 ? r2[0] : r2[1]; r1 = mine + __shfl_xor(send, 2); }
      r1 += __shfl_xor(r1, 1);
      const int k = kb * 32 + 2 * ((lane >> 1) & 15) + half;
      const float gt = __shfl(kb < 2 ? g0 : g1, k & 63);
      if ((lane & 1) == 0) wrow[k] = gt * gelu_exact(r1);
    }
  }
}

DEVI void phase_peer(const Params& P, int l) {
  const int lane = TIDX & 63, half = lane >> 5, l32 = lane & 31;
  const int gw = VBID * 4 + (TIDX >> 6), nw = NVB * 4;
  const int nrows = (l == 1) ? NL : NT;
  const unsigned char* PV = P.PV8 + (size_t)l * 16384 * 576;
  for (int t = gw; t < nrows; t += nw) {
    const int e0 = P.EIDX[(size_t)t * 128 + lane], e1 = P.EIDX[(size_t)t * 128 + 64 + lane];
    const float w0 = P.WPE[(size_t)t * 128 + lane], w1 = P.WPE[(size_t)t * 128 + 64 + lane];
    f2 y2[16];
#pragma unroll
    for (int i = 0; i < 16; ++i) y2[i] = (f2){0.f, 0.f};
    for (int kb = 0; kb < 4; ++kb) {
      const int esrc = kb < 2 ? e0 : e1;
      const float wsrc = kb < 2 ? w0 : w1;
      uint4 vd[16];
      unsigned short vs[16];
      float wv[16];
#pragma unroll
      for (int i = 0; i < 16; ++i) {
        const int ks = (kb * 32 + 2 * i + half) & 63;
        const int e = __shfl(esrc, ks);
        wv[i] = __shfl(wsrc, ks);
        const unsigned char* vr = PV + (size_t)e * 576;
        vd[i] = *reinterpret_cast<const uint4*>(vr + l32 * 16);
        vs[i] = *reinterpret_cast<const unsigned short*>(vr + 512 + l32 * 2);
      }
#pragma unroll
      for (int i = 0; i < 16; ++i) {
        const float wi = wv[i] * __uint_as_float((unsigned)vs[i] << 16);
        const f2 ww = (f2){wi, wi};
        const unsigned vw[4] = {vd[i].x, vd[i].y, vd[i].z, vd[i].w};
#pragma unroll
        for (int c = 0; c < 4; ++c) {
          y2[4 * c + 0] = __builtin_elementwise_fma(ww, __builtin_amdgcn_cvt_scalef32_pk_f32_fp4(vw[c], 1.0f, 0), y2[4 * c + 0]);
          y2[4 * c + 1] = __builtin_elementwise_fma(ww, __builtin_amdgcn_cvt_scalef32_pk_f32_fp4(vw[c], 1.0f, 1), y2[4 * c + 1]);
          y2[4 * c + 2] = __builtin_elementwise_fma(ww, __builtin_amdgcn_cvt_scalef32_pk_f32_fp4(vw[c], 1.0f, 2), y2[4 * c + 2]);
          y2[4 * c + 3] = __builtin_elementwise_fma(ww, __builtin_amdgcn_cvt_scalef32_pk_f32_fp4(vw[c], 1.0f, 3), y2[4 * c + 3]);
        }
      }
    }
    float y[16];
#pragma unroll
    for (int j = 0; j < 8; ++j) {
      const float ax = y2[j].x + __shfl_xor(y2[j].x, 32), ay = y2[j].y + __shfl_xor(y2[j].y, 32);
      const float bx = y2[8 + j].x + __shfl_xor(y2[8 + j].x, 32), by = y2[8 + j].y + __shfl_xor(y2[8 + j].y, 32);
      y[2 * j] = half ? bx : ax; y[2 * j + 1] = half ? by : ay;
    }
    const int bi = batch_of_row(t);
    const float* gate2 = P.MOD + (size_t)(l * 9 + bi) * 6144 + 5 * 1024;
    const int d0 = l32 * 32 + half * 16;
    float xn[16];
    float ss = 0.f;
#pragma unroll
    for (int q4 = 0; q4 < 4; ++q4) {
      const int d = d0 + q4 * 4;
      const uint2 xu = *reinterpret_cast<const uint2*>(P.X + (size_t)t * 1024 + d);
      const float4 xo = make_float4(lo2f(xu.x), hi2f(xu.x), lo2f(xu.y), hi2f(xu.y));
      const float4 gg = *reinterpret_cast<const float4*>(gate2 + d);
      float4 o;
      o.x = xo.x + gg.x * y[q4 * 4 + 0]; o.y = xo.y + gg.y * y[q4 * 4 + 1];
      o.z = xo.z + gg.z * y[q4 * 4 + 2]; o.w = xo.w + gg.w * y[q4 * 4 + 3];
      xn[q4 * 4 + 0] = o.x; xn[q4 * 4 + 1] = o.y; xn[q4 * 4 + 2] = o.z; xn[q4 * 4 + 3] = o.w;
      ss += o.x * o.x + o.y * o.y + o.z * o.z + o.w * o.w;
      if (l == 1) *reinterpret_cast<float4*>(P.out + (size_t)t * 1024 + d) = o;
      else *reinterpret_cast<uint2*>(P.X + (size_t)t * 1024 + d) = make_uint2(pack2(o.x, o.y), pack2(o.z, o.w));
    }
    if (l == 0) {
      ss = wave_sum(ss);
      const float rr = rsqrtf(ss * (1.f / 1024.f) + EPS);
      const float* lnw = P.ln1_w + 1024;
      const float* mod = P.MOD + (size_t)(9 + bi) * 6144;
      unsigned pk[8];
#pragma unroll
      for (int i = 0; i < 16; i += 2) {
        const float o0 = xn[i] * rr * lnw[d0 + i] * (1.f + mod[1024 + d0 + i]) + mod[d0 + i];
        const float o1 = xn[i + 1] * rr * lnw[d0 + i + 1] * (1.f + mod[1024 + d0 + i + 1]) + mod[d0 + i + 1];
        pk[i >> 1] = pack2(o0, o1);
      }
      *reinterpret_cast<uint4*>(P.H + (size_t)t * 1024 + d0) = make_uint4(pk[0], pk[1], pk[2], pk[3]);
      *reinterpret_cast<uint4*>(P.H + (size_t)t * 1024 + d0 + 8) = make_uint4(pk[4], pk[5], pk[6], pk[7]);
    }
  }
}

using f32x4 = __attribute__((ext_vector_type(4))) float;
namespace g8 {
constexpr int BM = 256, BK = 64, HALF = 128, HT = HALF * BK;
DEVI int lds_byte(int r, int c) { const int st = (r >> 4) * 2 + (c >> 5), rr = r & 15, cc = c & 31, ob = rr * 64 + cc * 2; return st * 1024 + (ob ^ (((ob >> 9) & 1) << 5)); }
DEVI void stage_rc(int b, int& R, int& C) { const int st = b / 1024, sb = b % 1024, swz = sb ^ (((sb >> 9) & 1) << 5); R = (st >> 1) * 16 + swz / 64; C = (st & 1) * 32 + (swz % 64) / 2; }
DEVI int perm32(int rho) { const int n = rho >> 4, i = rho & 15; return 8 * (i >> 2) + 4 * n + (i & 3); }
DEVI void unit_of(int L, int nM, int nN, int& pm, int& pn) {
  const int nwg = nM * nN;
  int wgid = L;
  { const int q = nwg / 8, r = nwg % 8, xcd = wgid % 8, off = wgid / 8; wgid = (xcd < r ? xcd * (q + 1) : r * (q + 1) + (xcd - r) * q) + off; }
  const int nig = 8 * nN, gid = wgid / nig, fm = gid * 8, gsz = (nM - fm) < 8 ? (nM - fm) : 8;
  pm = fm + ((wgid % nig) % gsz); pn = (wgid % nig) / gsz;
}
}

struct G8Unit { int pm, pn; };
template <class Epi>
DEVI void gemm8_phase(LAS unsigned char* lds, const bf16* __restrict__ Ag, const bf16* __restrict__ Btg, const int K, const int nM, const int nN, const Epi& E,
                      const int lda = 0, const int pn_split = 1 << 30, const int acol0 = 0, const int acol1 = 0) {
  constexpr int BK = 64, HALF = 128, HTB = HALF * BK * 2;
  const int tid = threadIdx.x, wid = __builtin_amdgcn_readfirstlane(tid >> 6), lane = tid & 63, wr = wid >> 2, wc = wid & 3, fr = lane & 15, fq = lane >> 4;
  const int nt = K / BK;
  const int nunits = nM * nN, G = gridDim.x, c = blockIdx.x;
  const int LDA = lda ? lda : K;
  unsigned voffA[2], voffB[2];
#pragma unroll
  for (int i = 0; i < 2; ++i) { int R, C; g8::stage_rc(tid * 16 + i * 8192, R, C); const int Rb = (R & ~31) + g8::perm32(R & 31); voffA[i] = (unsigned)(R * LDA + C) * 2u; voffB[i] = (unsigned)(Rb * K + C) * 2u; }
  const size_t kstep = (size_t)(BK * 2);
  const size_t hstepA = (size_t)HALF * LDA * 2, hstep = (size_t)HALF * K * 2;
  const size_t tstepA = 2 * hstepA, tstep = 2 * hstep;
  const unsigned ldsw = (unsigned)wid * 1024u;
  const int aoff = g8::lds_byte(wr * 64 + fr, fq * 8), boff = g8::lds_byte(wc * 32 + fr, fq * 8);
#define PG8_SA(b, h) (((b) * 2 + (h)) * HTB)
#define PG8_SB(b, h) ((4 + (b) * 2 + (h)) * HTB)
#define PG8_STAGE(bufoff, gbase, voff) do { _Pragma("unroll") for (int _i = 0; _i < 2; ++_i) \
        __builtin_amdgcn_global_load_lds((const unsigned*)((const char*)(gbase) + (voff)[_i]), (LAS unsigned*)(lds + (bufoff) + ldsw + _i * 8192), 16, 0, 0); } while (0)
#define PG8_LDA(dst, b, h) do { _Pragma("unroll") for (int m = 0; m < 4; ++m) _Pragma("unroll") for (int k = 0; k < 2; ++k) dst[m][k] = *(const LAS bf16x8*)(lds + PG8_SA(b, h) + aoff + m * 2048 + k * 1024); } while (0)
#define PG8_LDB(dst, b, h) do { _Pragma("unroll") for (int n = 0; n < 2; ++n) _Pragma("unroll") for (int k = 0; k < 2; ++k) dst[n][k] = *(const LAS bf16x8*)(lds + PG8_SB(b, h) + boff + n * 2048 + k * 1024); } while (0)
#define PG8_MMA(ai, bj, At_, Bt_) do { __builtin_amdgcn_s_setprio(1); _Pragma("unroll") for (int m = 0; m < 4; ++m) _Pragma("unroll") for (int n = 0; n < 2; ++n) _Pragma("unroll") for (int k = 0; k < 2; ++k) \
        acc[ai][bj][m][n] = __builtin_amdgcn_mfma_f32_16x16x32_bf16(Bt_[n][k], At_[m][k], acc[ai][bj][m][n], 0, 0, 0); __builtin_amdgcn_s_setprio(0); } while (0)
#define PG8_WAIT_V(n) asm volatile("s_waitcnt vmcnt(" #n ")" ::: "memory")
#define PG8_WAIT_L(n) asm volatile("s_waitcnt lgkmcnt(" #n ")" ::: "memory")
#define PG8_BAR __builtin_amdgcn_s_barrier()
#define PG8_SCHED __builtin_amdgcn_sched_barrier(0)
  G8Unit cur, nxt; int ui = 0;
  if (c >= nunits) return;
  g8::unit_of(c, nM, nN, cur.pm, cur.pn);
  f32x4 acc[2][2][4][2];
#pragma unroll
  for (int a = 0; a < 2; ++a)
#pragma unroll
    for (int b = 0; b < 2; ++b)
#pragma unroll
      for (int m = 0; m < 4; ++m)
#pragma unroll
        for (int n = 0; n < 2; ++n) acc[a][b][m][n] = (f32x4){0.f, 0.f, 0.f, 0.f};
  bf16x8 At[4][2], B0[2][2], B1[2][2];
  const char* cA = (const char*)Ag + (size_t)cur.pm * tstepA + (size_t)(cur.pn < pn_split ? acol0 : acol1) * 2; const char* cB = (const char*)Btg + (size_t)cur.pn * tstep;
  PG8_STAGE(PG8_SB(0, 0), cB, voffB); PG8_STAGE(PG8_SA(0, 0), cA, voffA); PG8_STAGE(PG8_SB(0, 1), cB + hstep, voffB); PG8_STAGE(PG8_SA(0, 1), cA + hstepA, voffA);
  if (wr == 1) PG8_BAR;
  PG8_WAIT_V(4); PG8_BAR;
  PG8_STAGE(PG8_SB(1, 0), cB + kstep, voffB); PG8_STAGE(PG8_SA(1, 0), cA + kstep, voffA); PG8_STAGE(PG8_SB(1, 1), cB + hstep + kstep, voffB);
  PG8_WAIT_V(6); PG8_BAR;
  for (;;) {
    const long Ln = (long)(ui + 1) * G + c;
    const bool has_next = Ln < nunits;
    if (has_next) g8::unit_of((int)Ln, nM, nN, nxt.pm, nxt.pn);
    const char* nA = has_next ? (const char*)Ag + (size_t)nxt.pm * tstepA + (size_t)(nxt.pn < pn_split ? acol0 : acol1) * 2 : cA; const char* nB = has_next ? (const char*)Btg + (size_t)nxt.pn * tstep : cB;
    for (int t = 0; t < nt; t += 2) {
      const bool last = (t == nt - 2);
      const char* a1 = cA + (size_t)(t + 1) * kstep;
      const char* a2 = last ? nA : cA + (size_t)(t + 2) * kstep; const char* b2 = last ? nB : cB + (size_t)(t + 2) * kstep;
      const char* a3 = a2 + kstep; const char* b3 = b2 + kstep;
      PG8_LDB(B0, 0, 0); PG8_SCHED; PG8_LDA(At, 0, 0); PG8_STAGE(PG8_SA(1, 1), a1 + hstepA, voffA);
      PG8_WAIT_L(8); PG8_BAR; PG8_WAIT_L(0); PG8_MMA(0, 0, At, B0); PG8_BAR; PG8_SCHED;
      PG8_LDB(B1, 0, 1); PG8_STAGE(PG8_SB(0, 0), b2, voffB);
      PG8_BAR; PG8_WAIT_L(0); PG8_MMA(0, 1, At, B1); PG8_BAR;
      PG8_LDA(At, 0, 1); PG8_STAGE(PG8_SA(0, 0), a2, voffA);
      PG8_BAR; PG8_WAIT_L(0); PG8_MMA(1, 0, At, B0); PG8_BAR; PG8_SCHED;
      PG8_STAGE(PG8_SB(0, 1), b2 + hstep, voffB);
      PG8_WAIT_V(6); PG8_BAR; PG8_MMA(1, 1, At, B1); PG8_BAR;
      PG8_LDB(B0, 1, 0); PG8_SCHED; PG8_LDA(At, 1, 0); PG8_STAGE(PG8_SA(0, 1), a2 + hstepA, voffA);
      PG8_WAIT_L(8); PG8_BAR; PG8_WAIT_L(0); PG8_MMA(0, 0, At, B0); PG8_BAR; PG8_SCHED;
      PG8_LDB(B1, 1, 1); PG8_STAGE(PG8_SB(1, 0), b3, voffB);
      PG8_BAR; PG8_WAIT_L(0); PG8_MMA(0, 1, At, B1); PG8_BAR;
      PG8_LDA(At, 1, 1); PG8_STAGE(PG8_SA(1, 0), a3, voffA);
      PG8_BAR; PG8_WAIT_L(0); PG8_MMA(1, 0, At, B0); PG8_BAR; PG8_SCHED;
      PG8_STAGE(PG8_SB(1, 1), b3 + hstep, voffB);
      PG8_WAIT_V(6); PG8_BAR; PG8_MMA(1, 1, At, B1); PG8_BAR;
    }
    E(acc, cur, wr, wc, fr, fq);
    if (!has_next) break;
#pragma unroll
    for (int a = 0; a < 2; ++a)
#pragma unroll
      for (int b = 0; b < 2; ++b)
#pragma unroll
        for (int m = 0; m < 4; ++m)
#pragma unroll
          for (int n = 0; n < 2; ++n) acc[a][b][m][n] = (f32x4){0.f, 0.f, 0.f, 0.f};
    cur = nxt; cA = nA; cB = nB; ++ui;
  }
  PG8_WAIT_V(0);
  if (wr == 0) PG8_BAR;
  PG8_BAR;
#undef PG8_SA
#undef PG8_SB
#undef PG8_STAGE
#undef PG8_LDA
#undef PG8_LDB
#undef PG8_MMA
}

struct EpiZ {
  bf16* Z;
  DEVI void operator()(const f32x4 (&acc)[2][2][4][2], const G8Unit& u, int wr, int wc, int fr, int fq) const {
    const int brow = u.pm * 256, bcol = u.pn * 256;
#pragma unroll
    for (int ai = 0; ai < 2; ++ai)
#pragma unroll
      for (int m = 0; m < 4; ++m) {
        const int row = brow + ai * 128 + wr * 64 + m * 16 + fr;
#pragma unroll
        for (int bj = 0; bj < 2; ++bj) {
          const int col = bcol + bj * 128 + wc * 32 + 8 * fq;
          if (col < DIN) {
            const f32x4 v0 = acc[ai][bj][m][0], v1 = acc[ai][bj][m][1];
            *reinterpret_cast<uint4*>(Z + (size_t)row * DIN + col) = make_uint4(pack2(v0[0], v0[1]), pack2(v0[2], v0[3]), pack2(v1[0], v1[1]), pack2(v1[2], v1[3]));
          }
        }
      }
  }
};
DEVI void phase_gemm1_8(const Params& P, int l, unsigned char* smem_base) {
  EpiZ E{P.Z};
  gemm8_phase((LAS unsigned char*)smem_base, P.H, P.WinT + (size_t)l * DINP * 1024, 1024, NT / 256, DINP / 256, E);
  const int c = blockIdx.x;
  if (c >= 136) {
    const int j = c - 136;
    if (l == 0) convert_rows_fp6(P, 0, j * 100, j * 100 + 100);
    else { const int b0 = 19200 + j * 114; convert_rows_fp6(P, 1, b0 < 32768 ? b0 : 32768, b0 + 114 < 32768 ? b0 + 114 : 32768); }
  }
}

struct EpiRAW {
  bf16* R;
  DEVI void operator()(const f32x4 (&acc)[2][2][4][2], const G8Unit& u, int wr, int wc, int fr, int fq) const {
    const int brow = u.pm * 256, bcol = u.pn * 256;
#pragma unroll
    for (int ai = 0; ai < 2; ++ai)
#pragma unroll
      for (int m = 0; m < 4; ++m) {
        const int row = brow + ai * 128 + wr * 64 + m * 16 + fr;
#pragma unroll
        for (int bj = 0; bj < 2; ++bj) {
          const int col = bcol + bj * 128 + wc * 32 + 8 * fq;
          const f32x4 v0 = acc[ai][bj][m][0], v1 = acc[ai][bj][m][1];
          *reinterpret_cast<uint4*>(R + (size_t)row * 1792 + col) = make_uint4(pack2(v0[0], v0[1]), pack2(v0[2], v0[3]), pack2(v1[0], v1[1]), pack2(v1[2], v1[3]));
        }
      }
  }
};
DEVI void phase_mla_raw(const Params& P, int l, unsigned char* smem_base) {
  EpiRAW E{P.RAW};
  gemm8_phase((LAS unsigned char*)smem_base, P.Z, P.WCOMB + (size_t)l * 1792 * 256, 256, NT / 256, 7, E, DIN, 3, ZC_BQ, ZC_BKV);
}

struct EpiX {
  const float* x; const float* ctx; bf16* X; const float* MODl; int l;
  DEVI void operator()(const f32x4 (&acc)[2][2][4][2], const G8Unit& u, int wr, int wc, int fr, int fq) const {
    const int brow = u.pm * 256, bcol = u.pn * 256;
    const float* gate = MODl + (size_t)batch_of_row(brow) * 6144 + 2048;
#pragma unroll
    for (int ai = 0; ai < 2; ++ai)
#pragma unroll
      for (int m = 0; m < 4; ++m) {
        const int row = brow + ai * 128 + wr * 64 + m * 16 + fr;
        const float* res = row < NL ? x + (size_t)row * 1024 : ctx + (size_t)(row - NL) * 1024;
#pragma unroll
        for (int bj = 0; bj < 2; ++bj) {
          const int col = bcol + bj * 128 + wc * 32 + 8 * fq;
          const f32x4 v0 = acc[ai][bj][m][0], v1 = acc[ai][bj][m][1];
          float4 ra, rb;
          if (l == 0) { ra = *reinterpret_cast<const float4*>(res + col); rb = *reinterpret_cast<const float4*>(res + col + 4); }
          else {
            const uint4 uu = *reinterpret_cast<const uint4*>(X + (size_t)row * 1024 + col);
            ra = make_float4(lo2f(uu.x), hi2f(uu.x), lo2f(uu.y), hi2f(uu.y)); rb = make_float4(lo2f(uu.z), hi2f(uu.z), lo2f(uu.w), hi2f(uu.w));
          }
          const float4 ga = *reinterpret_cast<const float4*>(gate + col), gb = *reinterpret_cast<const float4*>(gate + col + 4);
          *reinterpret_cast<uint4*>(X + (size_t)row * 1024 + col) =
              make_uint4(pack2(ra.x + ga.x * v0[0], ra.y + ga.y * v0[1]), pack2(ra.z + ga.z * v0[2], ra.w + ga.w * v0[3]),
                         pack2(rb.x + gb.x * v1[0], rb.y + gb.y * v1[1]), pack2(rb.z + gb.z * v1[2], rb.w + gb.w * v1[3]));
        }
      }
  }
};
DEVI void phase_gemm2_8(const Params& P, int l, unsigned char* smem_base) {
  EpiX E{P.x, P.ctx, P.X, P.MOD + (size_t)l * 9 * 6144, l};
  gemm8_phase((LAS unsigned char*)smem_base, P.H, P.WoutT + (size_t)l * 1024 * 1024, 1024, (l == 1) ? NL / 256 : NT / 256, 4, E);
  const int c = blockIdx.x;
  if (l == 0 && c >= 32) {
    const int b0 = 12000 + (c - 32) * 93;
    convert_rows_fp6(P, 0, b0 < 32768 ? b0 : 32768, b0 + 93 < 32768 ? b0 + 93 : 32768);
  }
}

struct EpiQP {
  bf16* QP;
  DEVI void operator()(const f32x4 (&acc)[2][2][4][2], const G8Unit& u, int wr, int wc, int fr, int fq) const {
    const int brow = u.pm * 256, bcol = u.pn * 256;
#pragma unroll
    for (int ai = 0; ai < 2; ++ai)
#pragma unroll
      for (int m = 0; m < 4; ++m) {
        const int row = brow + ai * 128 + wr * 64 + m * 16 + fr;
#pragma unroll
        for (int bj = 0; bj < 2; ++bj) {
          const int col = bcol + bj * 128 + wc * 32 + 8 * fq;
          const f32x4 v0 = acc[ai][bj][m][0], v1 = acc[ai][bj][m][1];
          *reinterpret_cast<uint4*>(QP + (size_t)row * 2048 + col) = make_uint4(pack2(v0[0], v0[1]), pack2(v0[2], v0[3]), pack2(v1[0], v1[1]), pack2(v1[2], v1[3]));
        }
      }
  }
};
DEVI void phase_gemm3_8(const Params& P, int l, unsigned char* smem_base) {
  EpiQP E{P.QP};
  gemm8_phase((LAS unsigned char*)smem_base, P.H, P.WpqT + (size_t)l * 2048 * 1024, 1024, (l == 1) ? NL / 256 : NT / 256, 8, E);
  const int c = blockIdx.x;
  if (l == 0 && c >= 64) convert_rows_fp6(P, 1, (c - 64) * 100, (c - 64) * 100 + 100);
}

constexpr int N_PHASES = 2 + 2 * 11;

#ifndef REP_MASK
#define REP_MASK 0
#endif
static_assert(sizeof(Params) % 8 == 0, "Params size");
DEVI Params load_params() {
#if defined(__HIP_DEVICE_COMPILE__)
  typedef const __attribute__((address_space(4))) Params* ParamsCP;
  ParamsCP pp = (ParamsCP)__builtin_amdgcn_kernarg_segment_ptr();
  asm volatile("" : "+s"(pp));
  return *pp;
#else
  return Params{};
#endif
}
__global__ void __launch_bounds__(512, 2) fwd_kernel(Params Pk) {
  extern __shared__ __attribute__((aligned(16))) unsigned char smem_base[];
  volatile LAS unsigned* xst = (volatile LAS unsigned*)(smem_base + SMEM_BYTES);
  if (threadIdx.x == 0) { xst[0] = 0u; xst[1] = 0u; xst[2] = 0u; xst[3] = 0u; }
  __syncthreads();
  XcdBarrier xb = xcd_barrier_post(Pk.bar, xst);
  const int phase_lo = Pk.phase_lo, phase_hi = Pk.phase_hi, coop = Pk.coop;
#define smem (smem_base + VHALF * HALF_LDS)
#define GSYNC(idx) { xcd_barrier(xb); }
#define RUN_PHASE2(idx, call, repcall) \
  if (phase_lo <= (idx) && (idx) <= phase_hi) { { const Params P = load_params(); call; } if (REP_MASK & (1 << (idx))) { GSYNC(1); const Params P = load_params(); repcall; } if (coop && (idx) < phase_hi) GSYNC(idx); }
#define RUN_PHASE(idx, call) RUN_PHASE2(idx, call, call)
  RUN_PHASE(0, phase_prologue(P, smem))
  RUN_PHASE(1, phase_norm(P, 0, 0, NT))
  RUN_PHASE(2, phase_gemm1_8(P, 0, smem_base))
  RUN_PHASE(3, phase_mla_raw(P, 0, smem_base))
  RUN_PHASE(4, { phase_mixA(P, 0, smem); phase_mla_proj(P, 0, smem); phase_hgrn_local(P, 0, smem); })
  RUN_PHASE2(5, phase_attn_scan(P, 0, smem_base), phase_attn_scan(P, 0, smem_base, true))
  RUN_PHASE(6, phase_hgrn_final(P, 0, smem))
  RUN_PHASE(7, phase_gemm2_8(P, 0, smem_base))
  RUN_PHASE(8, phase_norm(P, 0, 1, NT))
  RUN_PHASE(9, phase_gemm3_8(P, 0, smem_base))
  RUN_PHASE(10, phase_route(P, 0, smem))
  RUN_PHASE(11, phase_peer_u(P, 0))
  RUN_PHASE(12, phase_peer(P, 0))
  RUN_PHASE(13, phase_gemm1_8(P, 1, smem_base))
  RUN_PHASE(14, phase_mla_raw(P, 1, smem_base))
  RUN_PHASE(15, { phase_mixA(P, 1, smem); phase_mla_proj(P, 1, smem); phase_hgrn_local(P, 1, smem); })
  RUN_PHASE2(16, phase_attn_scan(P, 1, smem_base), phase_attn_scan(P, 1, smem_base, true))
  RUN_PHASE(17, phase_hgrn_final(P, 1, smem))
  RUN_PHASE(18, phase_gemm2_8(P, 1, smem_base))
  RUN_PHASE(19, phase_norm(P, 1, 1, NL))
  RUN_PHASE(20, phase_gemm3_8(P, 1, smem_base))
  RUN_PHASE(21, phase_route(P, 1, smem))
  RUN_PHASE(22, phase_peer_u(P, 1))
  RUN_PHASE(23, phase_peer(P, 1))
#undef smem
}

extern "C" void kernel_launch(void* const* d_in, const int* in_sizes, int n_in, void* d_out, int out_size, void* d_ws,
                              size_t ws_size, hipStream_t stream) {
  Params p{};
  const float* const* in = reinterpret_cast<const float* const*>(d_in);
  p.x = in[0]; p.c = in[1]; p.ctx = in[2]; p.c_ctx = in[3]; p.ln1_w = in[4]; p.ln2_w = in[5]; p.w_mod = in[6]; p.b_mod = in[7];
  p.w_in = in[8]; p.w_out = in[9]; p.a_norm_w = in[10]; p.a_w_s = in[11]; p.a_b_s = in[12]; p.b_q_norm_w = in[13]; p.b_w_uq = in[14];
  p.b_kv_norm_w = in[15]; p.b_w_ukv = in[16]; p.b_qh_w = in[17]; p.b_kh_w = in[18]; p.c_lb = in[19]; p.c_out_norm_w = in[20];
  p.p_w_q = in[21]; p.p_sub_keys = in[22]; p.p_u = in[23]; p.p_v = in[24];
  p.out = reinterpret_cast<float*>(d_out);
  unsigned char* ws = reinterpret_cast<unsigned char*>(d_ws);
  size_t off = 0;
  auto take = [&](size_t bytes) { unsigned char* r = ws + off; off += (bytes + 255) & ~(size_t)255; return r; };
  p.bar = (unsigned*)take((size_t)XCD_BAR_WORDS * 4);
  p.MOD = (float*)take((size_t)2 * 9 * 6144 * 4);
  p.ROPE = (float*)take((size_t)2048 * 32 * 4);
  p.WinT = (bf16*)take((size_t)2 * DINP * 1024 * 2);
  p.WoutT = (bf16*)take((size_t)2 * 1024 * 1024 * 2);
  p.WpqT = (bf16*)take((size_t)2 * 2048 * 1024 * 2);
  p.WCOMB = (bf16*)take((size_t)2 * 1792 * 256 * 2);
  p.RAW = (bf16*)take((size_t)NT * 1792 * 2);
  p.SK = (bf16*)take((size_t)2 * 16 * 128 * 128 * 2);
  p.AWS = (bf16*)take((size_t)2 * 4 * 128 * 128 * 2);
  p.PU8 = (unsigned char*)take((size_t)2 * 16384 * 576);
  p.PV8 = (unsigned char*)take((size_t)2 * 16384 * 576);
  p.PUS = (float*)take((size_t)2 * 16384 * 4);
  p.PVS = (float*)take((size_t)2 * 16384 * 4);
  p.X = (bf16*)take((size_t)NT * 1024 * 2);
  p.H = (bf16*)take((size_t)NT * 1024 * 2);
  p.Z = (bf16*)take((size_t)NT * DIN * 2);
  p.Q = (bf16*)take((size_t)64 * SEQP * 96 * 2);
  p.K = (bf16*)take((size_t)64 * SEQP * 96 * 2);
  p.VT = (bf16*)take((size_t)64 * 64 * SEQP * 2);
  p.ST = (bf16*)take((size_t)64 * 36 * 4096 * 2);
  p.DEC = (float*)take((size_t)64 * 36 * 64 * 4);
  p.OI = (bf16*)take((size_t)NT * 256 * 2);
  p.WPE = (float*)take((size_t)NT * 128 * 4);
  p.GQF = (bf16*)take((size_t)NT * 256 * 2);
  p.GQB = (bf16*)take((size_t)NT * 256 * 2);
  p.QP = p.Z;
  p.EIDX = (int*)p.Q;
  p.GATE = (float*)p.K;
  if (off > ws_size) { fprintf(stderr, "workspace too small: need %zu have %zu\n", off, ws_size); }
  static int grid_blocks = 0;
  if (!grid_blocks) {
    if (hipFuncSetAttribute((const void*)fwd_kernel, hipFuncAttributeMaxDynamicSharedMemorySize, SMEM_TOTAL) != hipSuccess)
      fprintf(stderr, "hipFuncSetAttribute failed\n");
    int dev = 0, cus = 0, per_cu = 0;
    hipGetDevice(&dev);
    hipDeviceGetAttribute(&cus, hipDeviceAttributeMultiprocessorCount, dev);
    hipOccupancyMaxActiveBlocksPerMultiprocessor(&per_cu, (const void*)fwd_kernel, 512, SMEM_TOTAL);
    if (per_cu > 1) per_cu = 1;
    if (per_cu < 1) { fprintf(stderr, "occupancy query returned %d\n", per_cu); per_cu = 1; }
    grid_blocks = cus * per_cu;
    fprintf(stderr, "grid_blocks=%d (cus=%d per_cu=%d) ws need=%zu have=%zu\n", grid_blocks, cus, per_cu, off, ws_size);
  }
  hipMemsetAsync(p.bar, 0, (size_t)XCD_BAR_WORDS * 4, stream);
  p.coop = 1; p.phase_lo = 0; p.phase_hi = N_PHASES - 1;
  hipLaunchKernelGGL(fwd_kernel, dim3(grid_blocks), dim3(512), SMEM_TOTAL, stream, p);
  const hipError_t e = hipPeekAtLastError();
  if (e != hipSuccess) fprintf(stderr, "launch failed: %s (grid %d)\n", hipGetErrorString(e), grid_blocks);
}
```

```cpp
#include <hip/hip_runtime.h>
#include <hip/hip_cooperative_groups.h>
#include <cstdio>
#include <cstdint>
namespace cg = cooperative_groups;

#define DEVI __device__ __forceinline__

typedef unsigned short bf16;
using bf16x8 = __attribute__((ext_vector_type(8))) __bf16;
using bf16x2 = __attribute__((ext_vector_type(2))) __bf16;
using f32x16 = __attribute__((ext_vector_type(16))) float;
typedef unsigned v6u __attribute__((ext_vector_type(6)));
typedef unsigned v3u __attribute__((ext_vector_type(3)));
typedef float v16f __attribute__((ext_vector_type(16)));
typedef float v32f __attribute__((ext_vector_type(32)));

constexpr int NL = 16384;
constexpr int NT = 18432;
constexpr int DM = 1024;
constexpr int DIN = 2208;
constexpr int DINP = 2304;
constexpr int SEQP = 2304;
constexpr float EPS = 1e-6f;
constexpr int ZC_AU = 0, ZC_AV = 256, ZC_BQ = 512, ZC_BKV = 768, ZC_BKR = 896, ZC_CQ = 928, ZC_CFF = 1184, ZC_CFB = 1440, ZC_CI = 1696, ZC_CG = 1952;
constexpr int SMEM_BYTES = 2 * 80896;
constexpr int SMEM_TOTAL = SMEM_BYTES + 16;

struct Params {
  const float *x, *c, *ctx, *c_ctx, *ln1_w, *ln2_w, *w_mod, *b_mod, *w_in, *w_out, *a_norm_w, *a_w_s, *a_b_s;
  const float *b_q_norm_w, *b_w_uq, *b_kv_norm_w, *b_w_ukv, *b_qh_w, *b_kh_w, *c_lb, *c_out_norm_w, *p_w_q, *p_sub_keys, *p_u, *p_v;
  float* out;
  unsigned* bar;
  float* MOD;
  float* ROPE;
  bf16* WinT;
  bf16* WoutT;
  bf16* WpqT;
  bf16* WCOMB;
  bf16* RAW;
  bf16* SK;
  bf16* AWS;
  unsigned char* PU8;
  unsigned char* PV8;
  float* PUS;
  float* PVS;
  bf16* X;
  bf16* H;
  bf16* Z;
  bf16* Q;
  bf16* K;
  bf16* VT;
  bf16* ST;
  float* DEC;
  bf16* OI;
  float* WPE;
  float* PART;
  bf16* GQF;
  bf16* GQB;
  bf16* QP;
  int* EIDX;
  float* GATE;
  int phase_lo, phase_hi, coop, pad0;
};

DEVI float bf2f(bf16 v) { return __uint_as_float(((unsigned)v) << 16); }
DEVI bf16 f2bf(float a) { __bf16 v = (__bf16)a; return __builtin_bit_cast(unsigned short, v); }
DEVI unsigned pack2(float a, float b) { bf16x2 v; v[0] = (__bf16)a; v[1] = (__bf16)b; return __builtin_bit_cast(unsigned, v); }
DEVI float lo2f(unsigned u) { return __uint_as_float(u << 16); }
DEVI float hi2f(unsigned u) { return __uint_as_float(u & 0xffff0000u); }
DEVI f32x16 zero16() { f32x16 z;
#pragma unroll
  for (int i = 0; i < 16; ++i) z[i] = 0.f; return z; }
DEVI f32x16 mfma32(bf16x8 a, bf16x8 b, f32x16 c) { return __builtin_amdgcn_mfma_f32_32x32x16_bf16(a, b, c, 0, 0, 0); }
DEVI bf16x8 ldfrag(const bf16* p) { return *reinterpret_cast<const bf16x8*>(p); }
DEVI int drow(int r, int hh) { return (r & 3) + 8 * (r >> 2) + 4 * hh; }
DEVI int row_of(int b, int p) { return p < 256 ? NL + b * 256 + p : b * 2048 + (p - 256); }
DEVI int batch_of_row(int r) { return r < NL ? (r >> 11) : 8; }
DEVI float wave_sum(float v) {
#pragma unroll
  for (int o = 32; o > 0; o >>= 1) v += __shfl_xor(v, o);
  return v;
}
DEVI float sigmoidf_(float z) { return 1.f / (1.f + __expf(-z)); }


#define XB_TMO      128
#define XB_XCNT(j)  (256  + 64 * (j))
#define XB_XSUB(j)  (1280 + 64 * (j))
#define XB_XGEN(j)  (2304 + 64 * (j))
#define XB_TOP      3328
#define XB_TOPGEN   3392
#define XCD_BAR_WORDS 3456
#define XB_SPIN_CAP (1u << 22)
#define LAS __attribute__((address_space(3)))
DEVI unsigned xb_ld(unsigned* p)              { return __hip_atomic_load(p, __ATOMIC_RELAXED, __HIP_MEMORY_SCOPE_AGENT); }
DEVI unsigned xb_add(unsigned* p, unsigned v) { return __hip_atomic_fetch_add(p, v, __ATOMIC_RELAXED, __HIP_MEMORY_SCOPE_AGENT); }
DEVI unsigned xb_xcc_id() { return (unsigned)__builtin_amdgcn_s_getreg((3 << 11) | 20) & 0xFu; }
#define XB_SPIN(cond, bar) do { unsigned _sp = 0; while (cond) { __builtin_amdgcn_s_sleep(1); \
    if ((++_sp & 255u) == 0u) { if (xb_ld(&(bar)[XB_TMO])) break; if (_sp > XB_SPIN_CAP) { atomicAdd(&(bar)[XB_TMO], 1u); break; } } } } while (0)
struct XcdBarrier { unsigned* bar; unsigned x; volatile LAS unsigned* st; };
DEVI XcdBarrier xcd_barrier_post(unsigned* bar, volatile LAS unsigned* st) {
  XcdBarrier b; b.bar = bar; b.x = xb_xcc_id(); b.st = st;
  if (threadIdx.x == 0) (void)xb_add(&bar[XB_XCNT(b.x)], 1u);
  return b;
}
DEVI void xcd_barrier_complete(unsigned* bar, unsigned x, unsigned& nloc, unsigned& nx) {
  const unsigned G = gridDim.x * gridDim.y * gridDim.z;
  unsigned sum, cnt, mine, sp = 0u;
  for (;;) {
    sum = 0u; cnt = 0u; mine = 0u;
#pragma unroll
    for (unsigned j = 0; j < 16; ++j) { const unsigned c = xb_ld(&bar[XB_XCNT(j)]); sum += c; cnt += (c > 0u) ? 1u : 0u; mine = (j == x) ? c : mine; }
    if (sum == G) break;
    __builtin_amdgcn_s_sleep(1);
    if ((++sp & 255u) == 0u) { if (xb_ld(&bar[XB_TMO])) break; if (sp > XB_SPIN_CAP) { atomicAdd(&bar[XB_TMO], 1u); break; } }
  }
  nloc = mine > 0u ? mine : 1u; nx = cnt > 0u ? cnt : 1u;
}
DEVI void xcd_barrier(const XcdBarrier& b) {
  asm volatile("s_waitcnt vmcnt(0)" ::: "memory");
  __syncthreads();
  if (threadIdx.x == 0) {
    unsigned* bar = b.bar;
    __builtin_amdgcn_s_waitcnt(0);
    unsigned nloc = b.st[0], nx = b.st[1];
    if (nloc == 0u) { xcd_barrier_complete(bar, b.x, nloc, nx); b.st[0] = nloc; b.st[1] = nx; }
    const unsigned old = xb_add(&bar[XB_XSUB(b.x)], 1u);
    const unsigned gen = old / nloc;
    if (old + 1u == (gen + 1u) * nloc) {
      __builtin_amdgcn_fence(__ATOMIC_RELEASE, "agent");
      asm volatile("s_waitcnt vmcnt(0)" ::: "memory");
      const unsigned og = xb_add(&bar[XB_TOP], 1u);
      const unsigned tg = og / nx;
      if (og + 1u == (tg + 1u) * nx) xb_add(&bar[XB_TOPGEN], 1u);
      else XB_SPIN(xb_ld(&bar[XB_TOPGEN]) == tg, bar);
      __builtin_amdgcn_fence(__ATOMIC_ACQUIRE, "agent");
      xb_add(&bar[XB_XGEN(b.x)], 1u);
      asm volatile("s_waitcnt vmcnt(0)" ::: "memory");
    } else {
      XB_SPIN(xb_ld(&bar[XB_XGEN(b.x)]) == gen, bar);
      __builtin_amdgcn_fence(__ATOMIC_ACQUIRE, "agent");
      asm volatile("s_waitcnt vmcnt(0)" ::: "memory");
    }
  }
  __syncthreads();
}

#define VHALF ((int)__builtin_amdgcn_readfirstlane((int)(threadIdx.x >> 8)))
#define TIDX ((int)(threadIdx.x & 255))
#define VBID ((int)(blockIdx.x * 2 + VHALF))
#define NVB ((int)(gridDim.x * 2))
constexpr int HALF_LDS = 80896;

DEVI void phase_mod(const Params& P, unsigned char* smem) {
  const int tid = TIDX;
  float* s = (float*)smem;
  float* red = s + 9 * 1024;
  for (int item = VBID; item < 192; item += NVB) {
    const int l = item / 96, j = item % 96;
    __syncthreads();
    for (int i = tid; i < 9 * 1024; i += 256) {
      int bi = i >> 10, k = i & 1023;
      float v = bi < 8 ? P.c[bi * 1024 + k] : P.c_ctx[k];
      s[i] = v * sigmoidf_(v);
    }
    __syncthreads();
    const int c4 = tid & 15, kg = tid >> 4;
    float acc[9][4];
#pragma unroll
    for (int bi = 0; bi < 9; ++bi) { acc[bi][0] = acc[bi][1] = acc[bi][2] = acc[bi][3] = 0.f; }
    const float* w = P.w_mod + (size_t)l * 1024 * 6144 + j * 64 + c4 * 4;
#pragma unroll 4
    for (int kk = 0; kk < 64; ++kk) {
      const int k = kg * 64 + kk;
      const float4 w4 = *reinterpret_cast<const float4*>(w + (size_t)k * 6144);
#pragma unroll
      for (int bi = 0; bi < 9; ++bi) {
        const float sv = s[bi * 1024 + k];
        acc[bi][0] += sv * w4.x; acc[bi][1] += sv * w4.y; acc[bi][2] += sv * w4.z; acc[bi][3] += sv * w4.w;
      }
    }
#pragma unroll
    for (int bi = 0; bi < 9; ++bi)
#pragma unroll
      for (int e = 0; e < 4; ++e) red[(kg * 9 + bi) * 64 + c4 * 4 + e] = acc[bi][e];
    __syncthreads();
    for (int o = tid; o < 576; o += 256) {
      const int bi = o >> 6, cc = o & 63;
      float sum = 0.f;
#pragma unroll
      for (int g = 0; g < 16; ++g) sum += red[(g * 9 + bi) * 64 + cc];
      P.MOD[(size_t)(l * 9 + bi) * 6144 + j * 64 + cc] = sum + P.b_mod[l * 6144 + j * 64 + cc];
    }
  }
}

DEVI void conv_T_tile(const float* __restrict__ src, int N, bf16* __restrict__ dst, int Kd, int k0, int n0,
                      const float* __restrict__ kscale, float* tile) {
  const int tid = TIDX;
  __syncthreads();
  for (int e = tid; e < 4096; e += 256) {
    const int i = e >> 6, j = e & 63, n = n0 + j;
    float v = (n < N) ? src[(size_t)(k0 + i) * N + n] : 0.f;
    if (kscale) v *= kscale[k0 + i];
    tile[i * 65 + j] = v;
  }
  __syncthreads();
  for (int e = tid; e < 2048; e += 256) {
    const int j = e >> 5, i2 = (e & 31) * 2;
    const unsigned pk = pack2(tile[i2 * 65 + j], tile[(i2 + 1) * 65 + j]);
    *reinterpret_cast<unsigned*>(&dst[(size_t)(n0 + j) * Kd + k0 + i2]) = pk;
  }
}

DEVI void conv_straight(const float* __restrict__ src, bf16* __restrict__ dst, size_t n8) {
  const size_t stride = (size_t)NVB * 256;
  for (size_t i = (size_t)VBID * 256 + TIDX; i < n8; i += stride) {
    const float4 a = reinterpret_cast<const float4*>(src)[2 * i];
    const float4 b = reinterpret_cast<const float4*>(src)[2 * i + 1];
    uint4 o; o.x = pack2(a.x, a.y); o.y = pack2(a.z, a.w); o.z = pack2(b.x, b.y); o.w = pack2(b.z, b.w);
    reinterpret_cast<uint4*>(dst)[i] = o;
  }
}

DEVI void convert_rows_fp6(const Params& P, int L, int i0, int i1) {
  const int lane = threadIdx.x & 63, half = lane >> 5, l32 = lane & 31;
  const int wv = threadIdx.x >> 6;
  for (int ib = i0 + wv * 2; ib < i1; ib += 16) {
    int i = ib + half; const bool live = i < i1; if (!live) i = i1 - 1;
    const int table = i >> 14, lr = L * 16384 + (i & 16383);
    const float* src = (table ? P.p_v : P.p_u) + (size_t)lr * 1024 + l32 * 32;
    float4 a[8];
    float m = 0.f;
#pragma unroll
    for (int q = 0; q < 8; ++q) {
      a[q] = *reinterpret_cast<const float4*>(src + q * 4);
      m = fmaxf(m, fmaxf(fmaxf(fabsf(a[q].x), fabsf(a[q].y)), fmaxf(fabsf(a[q].z), fabsf(a[q].w))));
    }
    const unsigned sb = (__float_as_uint(fmaxf(m, 1e-30f) * (1.f / 6.f)) + 0xffffu) >> 16;
    const float inv = 1.f / __uint_as_float(sb << 16);
    unsigned pk[4];
#pragma unroll
    for (int w = 0; w < 4; ++w) {
      unsigned word = 0u;
#pragma unroll
      for (int e = 0; e < 8; ++e) {
        const int idx = w * 8 + e;
        const float4 q4 = a[idx >> 2];
        const float xv = ((idx & 3) == 0 ? q4.x : (idx & 3) == 1 ? q4.y : (idx & 3) == 2 ? q4.z : q4.w) * inv;
        const float av = fabsf(xv);
        unsigned ci = (av > 0.25f) + (av > 0.75f) + (av > 1.25f) + (av > 1.75f) + (av > 2.5f) + (av > 3.5f) + (av > 5.f);
        ci |= (xv < 0.f) ? 8u : 0u;
        word |= ci << (4 * e);
      }
      pk[w] = word;
    }
    unsigned char* rowp = (table ? P.PV8 : P.PU8) + (size_t)lr * 576;
    if (live) {
      *reinterpret_cast<uint4*>(rowp + l32 * 16) = make_uint4(pk[0], pk[1], pk[2], pk[3]);
      *reinterpret_cast<unsigned short*>(rowp + 512 + l32 * 2) = (unsigned short)sb;
    }
  }
}

DEVI void phase_prologue(const Params& P, unsigned char* smem) {
  phase_mod(P, smem);
  float* tile = (float*)smem;
  for (int it = VBID; it < 2 * 1424; it += NVB) {
    const int l = it / 1424; int r = it % 1424;
    if (r < 576) { conv_T_tile(P.w_in + (size_t)l * 1024 * DIN, DIN, P.WinT + (size_t)l * DINP * 1024, 1024, (r % 16) * 64, (r / 16) * 64, nullptr, tile); continue; }
    r -= 576;
    if (r < 256) { conv_T_tile(P.w_out + (size_t)l * 1024 * 1024, 1024, P.WoutT + (size_t)l * 1024 * 1024, 1024, (r % 16) * 64, (r / 16) * 64, nullptr, tile); continue; }
    r -= 256;
    if (r < 512) { conv_T_tile(P.p_w_q + (size_t)l * 1024 * 2048, 2048, P.WpqT + (size_t)l * 2048 * 1024, 1024, (r % 16) * 64, (r / 16) * 64, nullptr, tile); continue; }
    r -= 512;
    if (r < 48) { conv_T_tile(P.b_w_uq + (size_t)l * 256 * 768, 768, P.WCOMB + (size_t)l * 1792 * 256, 256, (r % 4) * 64, (r / 4) * 64, P.b_q_norm_w + l * 256, tile); continue; }
    r -= 48;
    conv_T_tile(P.b_w_ukv + (size_t)l * 128 * 1024, 1024, P.WCOMB + (size_t)l * 1792 * 256 + 768 * 256, 256, (r % 2) * 64, (r / 2) * 64, P.b_kv_norm_w + l * 128, tile);
  }
  for (int i = VBID * 256 + TIDX; i < 2 * 1024 * 16; i += NVB * 256) {
    const int l2 = i >> 14, rr = (i >> 4) & 1023, cc = i & 15;
    *reinterpret_cast<uint4*>(P.WCOMB + (size_t)l2 * 1792 * 256 + (size_t)(768 + rr) * 256 + 128 + cc * 8) = make_uint4(0u, 0u, 0u, 0u);
  }
  conv_straight(P.p_sub_keys, P.SK, (size_t)2 * 16 * 128 * 128 / 8);
  conv_straight(P.a_w_s, P.AWS, (size_t)2 * 4 * 128 * 128 / 8);
  for (int i = VBID * 256 + TIDX; i < 2048 * 16; i += NVB * 256) {
    const int t = i >> 4, a = (i >> 3) & 1, f = i & 7;
    const float inv = powf(10000.f, -(float)f / 8.f);
    const float pos = a ? (float)(t & 63) : (float)(t >> 6);
    const float ang = pos * inv;
    P.ROPE[t * 32 + a * 8 + f] = cosf(ang);
    P.ROPE[t * 32 + 16 + a * 8 + f] = sinf(ang);
  }
}

DEVI void phase_norm(const Params& P, int l, int which, int nrows) {
  const int lane = TIDX & 63;
  const int gw = VBID * 4 + (TIDX >> 6), nw = NVB * 4;
  const float* lnw = (which == 0 ? P.ln1_w : P.ln2_w) + l * 1024;
  for (int r = gw; r < nrows; r += nw) {
    const float* mod = P.MOD + (size_t)(l * 9 + batch_of_row(r)) * 6144 + which * 3072;
    float4 v[4];
    float ss = 0.f;
    if (which == 0 && l == 0) {
      const float* src = r < NL ? P.x + (size_t)r * 1024 : P.ctx + (size_t)(r - NL) * 1024;
#pragma unroll
      for (int i = 0; i < 4; ++i) v[i] = *reinterpret_cast<const float4*>(src + i * 256 + lane * 4);
    } else if (which == 1 && l == 0 && r >= NL) {
      const float* cin = P.ctx + (size_t)(r - NL) * 1024;
      const float* p0 = P.PART + (size_t)(r - NL) * 1024;
      const float* p1 = p0 + (size_t)2048 * 1024;
      const float* gate = P.MOD + (size_t)8 * 6144 + 2048;
#pragma unroll
      for (int i = 0; i < 4; ++i) {
        const int d = i * 256 + lane * 4;
        const float4 c4 = *reinterpret_cast<const float4*>(cin + d), a4 = *reinterpret_cast<const float4*>(p0 + d), b4 = *reinterpret_cast<const float4*>(p1 + d);
        const float4 g4 = *reinterpret_cast<const float4*>(gate + d);
        v[i] = make_float4(c4.x + g4.x * (a4.x + b4.x), c4.y + g4.y * (a4.y + b4.y), c4.z + g4.z * (a4.z + b4.z), c4.w + g4.w * (a4.w + b4.w));
        *reinterpret_cast<uint2*>(P.X + (size_t)r * 1024 + d) = make_uint2(pack2(v[i].x, v[i].y), pack2(v[i].z, v[i].w));
      }
    } else {
      const bf16* src = P.X + (size_t)r * 1024;
#pragma unroll
      for (int i = 0; i < 4; ++i) {
        const uint2 u = *reinterpret_cast<const uint2*>(src + i * 256 + lane * 4);
        v[i] = make_float4(lo2f(u.x), hi2f(u.x), lo2f(u.y), hi2f(u.y));
      }
    }
#pragma unroll
    for (int i = 0; i < 4; ++i) ss += v[i].x * v[i].x + v[i].y * v[i].y + v[i].z * v[i].z + v[i].w * v[i].w;
    ss = wave_sum(ss);
    const float rr = rsqrtf(ss * (1.f / 1024.f) + EPS);
#pragma unroll
    for (int i = 0; i < 4; ++i) {
      const int d = i * 256 + lane * 4;
      const float4 w = *reinterpret_cast<const float4*>(lnw + d);
      const float4 sh = *reinterpret_cast<const float4*>(mod + d);
      const float4 sc = *reinterpret_cast<const float4*>(mod + 1024 + d);
      const float o0 = v[i].x * rr * w.x * (1.f + sc.x) + sh.x;
      const float o1 = v[i].y * rr * w.y * (1.f + sc.y) + sh.y;
      const float o2 = v[i].z * rr * w.z * (1.f + sc.z) + sh.z;
      const float o3 = v[i].w * rr * w.w * (1.f + sc.w) + sh.w;
      uint2 o; o.x = pack2(o0, o1); o.y = pack2(o2, o3);
      *reinterpret_cast<uint2*>(P.H + (size_t)r * 1024 + d) = o;
    }
  }
}

template <int BM, int BN, int BK, int WM, int WN>
struct Gemm {
  static constexpr int LDK = BK + 8;
  static constexpr int TM = BM / WM / 32, TN = BN / WN / 32;
  static constexpr int CPR = BK / 8;
  static constexpr int NA = BM * CPR / 256, NB = BN * CPR / 256;
  static constexpr int A_BYTES = BM * LDK * 2, B_BYTES = BN * LDK * 2;
  static constexpr int STAGE_BYTES = A_BYTES + B_BYTES;
  static constexpr int SMEM = 2 * STAGE_BYTES;

  static DEVI void run(const bf16* __restrict__ A, int lda, const bf16* __restrict__ BT, int ldb, int K,
                       unsigned char* smem, f32x16 (&acc)[TM][TN]) {
    const int tid = TIDX, lane = tid & 63, wave = tid >> 6;
    const int wm = wave / WN, wn = wave % WN;
    const int l31 = lane & 31, hh = lane >> 5;
#pragma unroll
    for (int i = 0; i < TM; ++i)
#pragma unroll
      for (int j = 0; j < TN; ++j) acc[i][j] = zero16();
    uint4 ra[NA], rb[NB];
    const int nk = K / BK;
    auto gload = [&](int kt) {
#pragma unroll
      for (int i = 0; i < NA; ++i) { const int ch = tid + i * 256, row = ch / CPR, cc = ch % CPR;
        ra[i] = *reinterpret_cast<const uint4*>(A + (size_t)row * lda + kt * BK + cc * 8); }
#pragma unroll
      for (int i = 0; i < NB; ++i) { const int ch = tid + i * 256, row = ch / CPR, cc = ch % CPR;
        rb[i] = *reinterpret_cast<const uint4*>(BT + (size_t)row * ldb + kt * BK + cc * 8); }
    };
    auto swrite = [&](int buf) {
      bf16* sA = reinterpret_cast<bf16*>(smem + buf * STAGE_BYTES);
      bf16* sB = reinterpret_cast<bf16*>(smem + buf * STAGE_BYTES + A_BYTES);
#pragma unroll
      for (int i = 0; i < NA; ++i) { const int ch = tid + i * 256, row = ch / CPR, cc = ch % CPR;
        *reinterpret_cast<uint4*>(sA + row * LDK + cc * 8) = ra[i]; }
#pragma unroll
      for (int i = 0; i < NB; ++i) { const int ch = tid + i * 256, row = ch / CPR, cc = ch % CPR;
        *reinterpret_cast<uint4*>(sB + row * LDK + cc * 8) = rb[i]; }
    };
    __syncthreads();
    gload(0);
    swrite(0);
    __syncthreads();
    for (int kt = 0; kt < nk; ++kt) {
      const int cur = kt & 1;
      if (kt + 1 < nk) gload(kt + 1);
      const bf16* sA = reinterpret_cast<const bf16*>(smem + cur * STAGE_BYTES);
      const bf16* sB = reinterpret_cast<const bf16*>(smem + cur * STAGE_BYTES + A_BYTES);
#pragma unroll
      for (int ks = 0; ks < BK / 16; ++ks) {
        bf16x8 af[TM], bfr[TN];
#pragma unroll
        for (int i = 0; i < TM; ++i) af[i] = ldfrag(sA + (wm * (BM / WM) + i * 32 + l31) * LDK + ks * 16 + hh * 8);
#pragma unroll
        for (int j = 0; j < TN; ++j) bfr[j] = ldfrag(sB + (wn * (BN / WN) + j * 32 + l31) * LDK + ks * 16 + hh * 8);
#pragma unroll
        for (int i = 0; i < TM; ++i)
#pragma unroll
          for (int j = 0; j < TN; ++j) acc[i][j] = mfma32(af[i], bfr[j], acc[i][j]);
      }
      if (kt + 1 < nk) swrite(cur ^ 1);
      __syncthreads();
    }
  }
};

DEVI void phase_gemm1(const Params& P, int l, unsigned char* smem) {
  using G = Gemm<128, 128, 64, 2, 2>;
  const int lane = TIDX & 63, wave = TIDX >> 6, wm = wave >> 1, wn = wave & 1, l31 = lane & 31, hh = lane >> 5;
  const bf16* W = P.WinT + (size_t)l * DINP * 1024;
  for (int t = VBID; t < 144 * 18; t += NVB) {
    const int mt = t / 18, nt = t % 18;
    f32x16 acc[2][2];
    G::run(P.H + (size_t)mt * 128 * 1024, 1024, W + (size_t)nt * 128 * 1024, 1024, 1024, smem, acc);
#pragma unroll
    for (int i = 0; i < 2; ++i)
#pragma unroll
      for (int j = 0; j < 2; ++j) {
        const int col = nt * 128 + wn * 64 + j * 32 + l31;
        if (col < DIN) {
#pragma unroll
          for (int r = 0; r < 16; ++r) {
            const int row = mt * 128 + wm * 64 + i * 32 + drow(r, hh);
            P.Z[(size_t)row * DIN + col] = f2bf(acc[i][j][r]);
          }
        }
      }
  }
}

DEVI void phase_gemm2(const Params& P, int l, unsigned char* smem) {
  using G = Gemm<128, 128, 64, 2, 2>;
  const int lane = TIDX & 63, wave = TIDX >> 6, wm = wave >> 1, wn = wave & 1, l31 = lane & 31, hh = lane >> 5;
  const bf16* W = P.WoutT + (size_t)l * 1024 * 1024;
  const int mtiles = (l == 1) ? 128 : 144;
  for (int t = VBID; t < mtiles * 8; t += NVB) {
    const int mt = t / 8, nt = t % 8;
    f32x16 acc[2][2];
    G::run(P.H + (size_t)mt * 128 * 1024, 1024, W + (size_t)nt * 128 * 1024, 1024, 1024, smem, acc);
    const int bi = batch_of_row(mt * 128);
    const float* gate = P.MOD + (size_t)(l * 9 + bi) * 6144 + 2048;
#pragma unroll
    for (int i = 0; i < 2; ++i)
#pragma unroll
      for (int j = 0; j < 2; ++j) {
        const int col = nt * 128 + wn * 64 + j * 32 + l31;
        const float g = gate[col];
#pragma unroll
        for (int r = 0; r < 16; ++r) {
          const int row = mt * 128 + wm * 64 + i * 32 + drow(r, hh);
          float res;
          if (l == 0) res = row < NL ? P.x[(size_t)row * 1024 + col] : P.ctx[(size_t)(row - NL) * 1024 + col];
          else res = bf2f(P.X[(size_t)row * 1024 + col]);
          P.X[(size_t)row * 1024 + col] = f2bf(res + g * acc[i][j][r]);
        }
      }
  }
}

DEVI void phase_mixA(const Params& P, int l, unsigned char* smem) {
  const int tid = TIDX, lane = tid & 63, wave = tid >> 6, l31 = lane & 31, hh = lane >> 5;
  bf16* VNT = reinterpret_cast<bf16*>(smem);
  constexpr int LDV = 136;
  const int nseg = (l == 1) ? 16 : 18;
  const int seg0 = (l == 1) ? 2 : 0;
  for (int it = VBID; it < 8 * nseg * 4; it += NVB) {
    const int a = it & 3; const int sj = (it >> 2) % nseg + seg0; const int b = (it >> 2) / nseg;
    const int p0 = sj * 128;
    __syncthreads();
    {
      const int q = tid >> 1, half = tid & 1;
      const int row = row_of(b, p0 + q);
      const bf16* src = P.Z + (size_t)row * DIN + ZC_AV + a * 64 + half * 32;
      float v[32];
      float ss = 0.f;
#pragma unroll
      for (int i = 0; i < 4; ++i) {
        const uint4 u = *reinterpret_cast<const uint4*>(src + i * 8);
        v[i * 8 + 0] = lo2f(u.x); v[i * 8 + 1] = hi2f(u.x); v[i * 8 + 2] = lo2f(u.y); v[i * 8 + 3] = hi2f(u.y);
        v[i * 8 + 4] = lo2f(u.z); v[i * 8 + 5] = hi2f(u.z); v[i * 8 + 6] = lo2f(u.w); v[i * 8 + 7] = hi2f(u.w);
      }
#pragma unroll
      for (int i = 0; i < 32; ++i) ss += v[i] * v[i];
      ss += __shfl_xor(ss, 1);
      const float rr = rsqrtf(ss * (1.f / 64.f) + EPS);
      const float* nw = P.a_norm_w + l * 256 + a * 64 + half * 32;
#pragma unroll
      for (int i = 0; i < 32; ++i) VNT[(half * 32 + i) * LDV + q] = f2bf(v[i] * rr * nw[i]);
    }
    __syncthreads();
    f32x16 acc[2]; acc[0] = zero16(); acc[1] = zero16();
    const bf16* Aw = P.AWS + (size_t)(l * 4 + a) * 128 * 128 + (size_t)(wave * 32 + l31) * 128;
#pragma unroll
    for (int ks = 0; ks < 8; ++ks) {
      const bf16x8 af = ldfrag(Aw + ks * 16 + hh * 8);
#pragma unroll
      for (int j = 0; j < 2; ++j) {
        const bf16x8 bfr = ldfrag(VNT + (j * 32 + l31) * LDV + ks * 16 + hh * 8);
        acc[j] = mfma32(af, bfr, acc[j]);
      }
    }
    const float* bs = P.a_b_s + (l * 4 + a) * 128;
#pragma unroll
    for (int j = 0; j < 2; ++j)
#pragma unroll
      for (int r = 0; r < 16; ++r) {
        const int p = wave * 32 + drow(r, hh);
        const int row = row_of(b, p0 + p);
        const int col = a * 64 + j * 32 + l31;
        const float u = bf2f(P.Z[(size_t)row * DIN + ZC_AU + col]);
        P.H[(size_t)row * 1024 + col] = f2bf(u * (acc[j][r] + bs[p]));
      }
  }
}

DEVI void mla_norm_rope_store(const Params& P, const float* T, const float* nw, bool rope, float oscale,
                              bf16* dstbase  , int pos0, int tlat0) {
  const int tid = TIDX, tok = tid >> 1, half = tid & 1;
  float v[48];
  float ss = 0.f;
#pragma unroll
  for (int i = 0; i < 48; ++i) { v[i] = T[tok * 97 + half * 48 + i]; ss += v[i] * v[i]; }
  ss += __shfl_xor(ss, 1);
  const float rr = rsqrtf(ss * (1.f / 96.f) + EPS);
#pragma unroll
  for (int i = 0; i < 48; ++i) v[i] = v[i] * rr * nw[half * 48 + i];
  if (rope && half == 1) {
    const float* cs = P.ROPE + (size_t)(tlat0 + tok) * 32;
#pragma unroll
    for (int a = 0; a < 2; ++a)
#pragma unroll
      for (int f = 0; f < 8; ++f) {
        const float x1 = v[16 + a * 16 + f], x2 = v[16 + a * 16 + 8 + f];
        const float c = cs[a * 8 + f], s = cs[16 + a * 8 + f];
        v[16 + a * 16 + f] = x1 * c - x2 * s;
        v[16 + a * 16 + 8 + f] = x2 * c + x1 * s;
      }
  }
  bf16* dst = dstbase + (size_t)(pos0 + tok) * 96 + half * 48;
#pragma unroll
  for (int i = 0; i < 6; ++i) {
    uint4 o;
    o.x = pack2(v[i * 8 + 0] * oscale, v[i * 8 + 1] * oscale); o.y = pack2(v[i * 8 + 2] * oscale, v[i * 8 + 3] * oscale);
    o.z = pack2(v[i * 8 + 4] * oscale, v[i * 8 + 5] * oscale); o.w = pack2(v[i * 8 + 6] * oscale, v[i * 8 + 7] * oscale);
    *reinterpret_cast<uint4*>(dst + i * 8) = o;
  }
}

DEVI void phase_mla_proj(const Params& P, int l, unsigned char* smem) {
  const int tid = TIDX;
  float* T = reinterpret_cast<float*>(smem);
  bf16* TV = reinterpret_cast<bf16*>(smem + 128 * 97 * 4);
  const float qscale = 0.10206207261596577f * 1.4426950408889634f;
  const int tok = tid >> 1, half = tid & 1;
  for (int it = (VBID + NVB - 64) % NVB; it < 144 * 8; it += NVB) {
    const int h = it & 7;
    const int m0 = (it >> 3) * 128;
    const bool lat = m0 < NL;
    const int b = lat ? (m0 >> 11) : ((m0 - NL) >> 8);
    const int pos0 = lat ? 256 + (m0 & 2047) : ((m0 - NL) & 255);
    const int tlat0 = lat ? (m0 & 2047) : 0;
    const bool doq = lat || (l == 0);
    const bf16* zr = P.Z + (size_t)(m0 + tok) * DIN;
    const bf16* rr = P.RAW + (size_t)(m0 + tok) * 1792;
    __syncthreads();
    float rskv, rsq = 0.f;
    {
      float ss = 0.f;
#pragma unroll
      for (int i = 0; i < 8; ++i) {
        const uint4 u = *reinterpret_cast<const uint4*>(zr + ZC_BKV + half * 64 + i * 8);
        ss += lo2f(u.x) * lo2f(u.x) + hi2f(u.x) * hi2f(u.x) + lo2f(u.y) * lo2f(u.y) + hi2f(u.y) * hi2f(u.y)
            + lo2f(u.z) * lo2f(u.z) + hi2f(u.z) * hi2f(u.z) + lo2f(u.w) * lo2f(u.w) + hi2f(u.w) * hi2f(u.w);
      }
      ss += __shfl_xor(ss, 1);
      rskv = rsqrtf(ss * (1.f / 128.f) + EPS);
      if (doq) {
        float sq = 0.f;
#pragma unroll
        for (int i = 0; i < 16; ++i) {
          const uint4 u = *reinterpret_cast<const uint4*>(zr + ZC_BQ + half * 128 + i * 8);
          sq += lo2f(u.x) * lo2f(u.x) + hi2f(u.x) * hi2f(u.x) + lo2f(u.y) * lo2f(u.y) + hi2f(u.y) * hi2f(u.y)
              + lo2f(u.z) * lo2f(u.z) + hi2f(u.z) * hi2f(u.z) + lo2f(u.w) * lo2f(u.w) + hi2f(u.w) * hi2f(u.w);
        }
        sq += __shfl_xor(sq, 1);
        rsq = rsqrtf(sq * (1.f / 256.f) + EPS);
      }
    }
    {
      const bf16* kn = rr + 768 + h * 128 + half * 32;
      const bf16* vv = rr + 768 + h * 128 + 64 + half * 32;
#pragma unroll
      for (int i = 0; i < 4; ++i) {
        const uint4 u = *reinterpret_cast<const uint4*>(kn + i * 8);
        float* tp = T + tok * 97 + half * 32 + i * 8;
        tp[0] = lo2f(u.x) * rskv; tp[1] = hi2f(u.x) * rskv; tp[2] = lo2f(u.y) * rskv; tp[3] = hi2f(u.y) * rskv;
        tp[4] = lo2f(u.z) * rskv; tp[5] = hi2f(u.z) * rskv; tp[6] = lo2f(u.w) * rskv; tp[7] = hi2f(u.w) * rskv;
        const uint4 w = *reinterpret_cast<const uint4*>(vv + i * 8);
        bf16* vp = TV + (half * 32 + i * 8) * 136 + tok;
        vp[0 * 136] = f2bf(lo2f(w.x) * rskv); vp[1 * 136] = f2bf(hi2f(w.x) * rskv); vp[2 * 136] = f2bf(lo2f(w.y) * rskv); vp[3 * 136] = f2bf(hi2f(w.y) * rskv);
        vp[4 * 136] = f2bf(lo2f(w.z) * rskv); vp[5 * 136] = f2bf(hi2f(w.z) * rskv); vp[6 * 136] = f2bf(lo2f(w.w) * rskv); vp[7 * 136] = f2bf(hi2f(w.w) * rskv);
      }
#pragma unroll
      for (int i = 0; i < 2; ++i) {
        const uint4 u = *reinterpret_cast<const uint4*>(zr + ZC_BKR + half * 16 + i * 8);
        float* tp = T + tok * 97 + 64 + half * 16 + i * 8;
        tp[0] = lo2f(u.x); tp[1] = hi2f(u.x); tp[2] = lo2f(u.y); tp[3] = hi2f(u.y);
        tp[4] = lo2f(u.z); tp[5] = hi2f(u.z); tp[6] = lo2f(u.w); tp[7] = hi2f(u.w);
      }
    }
    __syncthreads();
    mla_norm_rope_store(P, T, P.b_kh_w + l * 96, lat, 1.f, P.K + (size_t)(b * 8 + h) * SEQP * 96, pos0, tlat0);
    {
      const int d = tid >> 2, qtr = tid & 3;
      bf16* dst = P.VT + ((size_t)(b * 8 + h) * 64 + d) * SEQP + pos0 + qtr * 32;
      const bf16* src = TV + d * 136 + qtr * 32;
#pragma unroll
      for (int i = 0; i < 4; ++i) {
        const uint4 v = *reinterpret_cast<const uint4*>(src + i * 8);
        const int g16 = (i >> 1) * 16, odd = i & 1;
        *reinterpret_cast<uint2*>(dst + g16 + (odd ? 4 : 0)) = make_uint2(v.x, v.y);
        *reinterpret_cast<uint2*>(dst + g16 + (odd ? 12 : 8)) = make_uint2(v.z, v.w);
      }
    }
    if (doq) {
      __syncthreads();
      const bf16* qq = rr + h * 96 + half * 48;
#pragma unroll
      for (int i = 0; i < 6; ++i) {
        const uint4 u = *reinterpret_cast<const uint4*>(qq + i * 8);
        float* tp = T + tok * 97 + half * 48 + i * 8;
        tp[0] = lo2f(u.x) * rsq; tp[1] = hi2f(u.x) * rsq; tp[2] = lo2f(u.y) * rsq; tp[3] = hi2f(u.y) * rsq;
        tp[4] = lo2f(u.z) * rsq; tp[5] = hi2f(u.z) * rsq; tp[6] = lo2f(u.w) * rsq; tp[7] = hi2f(u.w) * rsq;
      }
      __syncthreads();
      mla_norm_rope_store(P, T, P.b_qh_w + l * 96, lat, qscale, P.Q + (size_t)(b * 8 + h) * SEQP * 96, pos0, tlat0);
    }
  }
}

DEVI void hgrn_load(const Params& P, int l, int b, int hd, int c, float* BF, float* RB, float* SEG,
                    float (&q)[16], float (&kf)[16], float (&kb)[16], float (&v)[16], bool need_kv) {
  const int tid = TIDX, t = tid >> 2, k0 = (tid & 3) * 16;
  const int row = row_of(b, c * 64 + t);
  const bf16* z = P.Z + (size_t)row * DIN + hd * 64 + k0;
  float zf[16], zb[16];
#pragma unroll
  for (int i = 0; i < 2; ++i) {
    const uint4 uq = *reinterpret_cast<const uint4*>(z + ZC_CQ + i * 8);
    const uint4 uf = *reinterpret_cast<const uint4*>(z + ZC_CFF + i * 8);
    const uint4 ub = *reinterpret_cast<const uint4*>(z + ZC_CFB + i * 8);
    q[i * 8 + 0] = lo2f(uq.x); q[i * 8 + 1] = hi2f(uq.x); q[i * 8 + 2] = lo2f(uq.y); q[i * 8 + 3] = hi2f(uq.y);
    q[i * 8 + 4] = lo2f(uq.z); q[i * 8 + 5] = hi2f(uq.z); q[i * 8 + 6] = lo2f(uq.w); q[i * 8 + 7] = hi2f(uq.w);
    zf[i * 8 + 0] = lo2f(uf.x); zf[i * 8 + 1] = hi2f(uf.x); zf[i * 8 + 2] = lo2f(uf.y); zf[i * 8 + 3] = hi2f(uf.y);
    zf[i * 8 + 4] = lo2f(uf.z); zf[i * 8 + 5] = hi2f(uf.z); zf[i * 8 + 6] = lo2f(uf.w); zf[i * 8 + 7] = hi2f(uf.w);
    zb[i * 8 + 0] = lo2f(ub.x); zb[i * 8 + 1] = hi2f(ub.x); zb[i * 8 + 2] = lo2f(ub.y); zb[i * 8 + 3] = hi2f(ub.y);
    zb[i * 8 + 4] = lo2f(ub.z); zb[i * 8 + 5] = hi2f(ub.z); zb[i * 8 + 6] = lo2f(ub.w); zb[i * 8 + 7] = hi2f(ub.w);
    if (need_kv) {
      const uint4 uv = *reinterpret_cast<const uint4*>(z + ZC_CI + i * 8);
      v[i * 8 + 0] = lo2f(uv.x); v[i * 8 + 1] = hi2f(uv.x); v[i * 8 + 2] = lo2f(uv.y); v[i * 8 + 3] = hi2f(uv.y);
      v[i * 8 + 4] = lo2f(uv.z); v[i * 8 + 5] = hi2f(uv.z); v[i * 8 + 6] = lo2f(uv.w); v[i * 8 + 7] = hi2f(uv.w);
    }
  }
#pragma unroll
  for (int i = 0; i < 16; ++i) {
    q[i] *= 0.125f;
    float lbf = 0.f;
    if (l == 1) { const int ch = hd * 64 + k0 + i; lbf = sigmoidf_(P.c_lb[512 + ch] - P.c_lb[ch]); }
    const float zz = zf[i];
    const float e = __expf(-fabsf(zz));
    const float sp = __builtin_amdgcn_rcpf(1.f + e);
    const float sig = zz >= 0.f ? sp : e * sp;
    const float nsig = zz >= 0.f ? e * sp : sp;
    const float lf = (l == 0) ? (fminf(zz, 0.f) - __logf(1.f + e)) : __logf(lbf + (1.f - lbf) * sig);
    kf[i] = (1.f - lbf) * nsig;
    BF[t * 65 + k0 + i] = lf;
  }
  __builtin_amdgcn_sched_barrier(0);
#pragma unroll
  for (int i = 0; i < 16; ++i) {
    float lbb = 0.f;
    if (l == 1) { const int ch = hd * 64 + k0 + i; lbb = sigmoidf_(P.c_lb[512 + 256 + ch] - P.c_lb[256 + ch]); }
    const float zz = zb[i];
    const float e = __expf(-fabsf(zz));
    const float sp = __builtin_amdgcn_rcpf(1.f + e);
    const float sig = zz >= 0.f ? sp : e * sp;
    const float nsig = zz >= 0.f ? e * sp : sp;
    const float lf = (l == 0) ? (fminf(zz, 0.f) - __logf(1.f + e)) : __logf(lbb + (1.f - lbb) * sig);
    kb[i] = (1.f - lbb) * nsig;
    RB[t * 65 + k0 + i] = lf;
  }
  __syncthreads();
  {
    const int k = tid & 63, seg = tid >> 6;
    float sf = 0.f, sr = 0.f;
#pragma unroll
    for (int j = 0; j < 16; ++j) { sf += BF[(seg * 16 + j) * 65 + k]; BF[(seg * 16 + j) * 65 + k] = sf; }
#pragma unroll
    for (int j = 15; j >= 0; --j) { sr += RB[(seg * 16 + j) * 65 + k]; RB[(seg * 16 + j) * 65 + k] = sr; }
    SEG[seg * 64 + k] = sf; SEG[256 + seg * 64 + k] = sr;
    __syncthreads();
    float offf = 0.f, offb = 0.f;
#pragma unroll
    for (int s2 = 0; s2 < 4; ++s2) {
      offf += (s2 < seg) ? SEG[s2 * 64 + k] : 0.f;
      offb += (s2 > seg) ? SEG[256 + s2 * 64 + k] : 0.f;
    }
#pragma unroll
    for (int j = 0; j < 16; ++j) { BF[(seg * 16 + j) * 65 + k] += offf; RB[(seg * 16 + j) * 65 + k] += offb; }
  }
  __syncthreads();
}

DEVI f32x16 lds_mm(const bf16* A, const bf16* BT, int tm, int tn, int l31, int hh) {
  f32x16 acc = zero16();
#pragma unroll
  for (int ks = 0; ks < 4; ++ks) {
    const bf16x8 a = ldfrag(A + (tm * 32 + l31) * 72 + ks * 16 + hh * 8);
    const bf16x8 b = ldfrag(BT + (tn * 32 + l31) * 72 + ks * 16 + hh * 8);
    acc = mfma32(a, b, acc);
  }
  return acc;
}

DEVI void phase_hgrn_local(const Params& P, int l, unsigned char* smem) {
  const int tid = TIDX, lane = tid & 63, wave = tid >> 6, l31 = lane & 31, hh = lane >> 5;
  const int tm = wave >> 1, tn = wave & 1;
  float* BF = reinterpret_cast<float*>(smem);
  float* RB = BF + 64 * 65;
  bf16* QF = reinterpret_cast<bf16*>(smem + 33280);
  bf16* KF = QF + 64 * 72;
  bf16* QB = KF + 64 * 72;
  bf16* KB = QB + 64 * 72;
  bf16* VTt = KB + 64 * 72;
  bf16* KHF = reinterpret_cast<bf16*>(smem);
  bf16* KHB = KHF + 64 * 72;
  bf16* ATT = KHB + 64 * 72;
  for (int it = (VBID + NVB - 192) % NVB; it < 8 * 4 * 36; it += NVB) {
    const int c = it % 36, hd = (it / 36) & 3, b = it / 144;
    float q[16], kf[16], kb[16], v[16];
    __syncthreads();
    hgrn_load(P, l, b, hd, c, BF, RB, reinterpret_cast<float*>(smem + 33280), q, kf, kb, v, true);
    const int t = tid >> 2, k0 = (tid & 3) * 16;
#pragma unroll
    for (int i = 0; i < 16; ++i) VTt[(k0 + i) * 72 + t] = f2bf(v[i]);
    float bfv[16], rbv[16];
#pragma unroll
    for (int i = 0; i < 16; ++i) { bfv[i] = BF[t * 65 + k0 + i]; rbv[i] = RB[t * 65 + k0 + i]; }
    {
      const size_t go = (size_t)row_of(b, c * 64 + t) * 256 + hd * 64 + k0;
#pragma unroll
      for (int hq = 0; hq < 2; ++hq) {
        unsigned pf[4], pb[4];
#pragma unroll
        for (int i = 0; i < 8; i += 2) {
          pf[i >> 1] = pack2(q[hq * 8 + i] * __expf(bfv[hq * 8 + i]), q[hq * 8 + i + 1] * __expf(bfv[hq * 8 + i + 1]));
          pb[i >> 1] = pack2(q[hq * 8 + i] * __expf(rbv[hq * 8 + i]), q[hq * 8 + i + 1] * __expf(rbv[hq * 8 + i + 1]));
        }
        *reinterpret_cast<uint4*>(P.GQF + go + hq * 8) = make_uint4(pf[0], pf[1], pf[2], pf[3]);
        *reinterpret_cast<uint4*>(P.GQB + go + hq * 8) = make_uint4(pb[0], pb[1], pb[2], pb[3]);
      }
    }
    if (t == 0) {
      float* dec = P.DEC + ((size_t)((b * 4 + hd) * 2) * 36 + c) * 64 + k0;
#pragma unroll
      for (int i = 0; i < 16; ++i) { dec[i] = __expf(BF[63 * 65 + k0 + i]); dec[36 * 64 + i] = __expf(RB[k0 + i]); }
    }
#pragma unroll
    for (int i = 0; i < 16; i += 2) {
      const int k = k0 + i;
      const float mF0 = BF[32 * 65 + k], mF1 = BF[32 * 65 + k + 1], mB0 = RB[32 * 65 + k], mB1 = RB[32 * 65 + k + 1];
      *reinterpret_cast<unsigned*>(&QF[t * 72 + k]) = pack2(q[i] * __expf(fminf(bfv[i] - mF0, 80.f)), q[i + 1] * __expf(fminf(bfv[i + 1] - mF1, 80.f)));
      *reinterpret_cast<unsigned*>(&KF[t * 72 + k]) = pack2(kf[i] * __expf(fminf(mF0 - bfv[i], 80.f)), kf[i + 1] * __expf(fminf(mF1 - bfv[i + 1], 80.f)));
      *reinterpret_cast<unsigned*>(&QB[t * 72 + k]) = pack2(q[i] * __expf(fminf(rbv[i] - mB0, 80.f)), q[i + 1] * __expf(fminf(rbv[i + 1] - mB1, 80.f)));
      *reinterpret_cast<unsigned*>(&KB[t * 72 + k]) = pack2(kb[i] * __expf(fminf(mB0 - rbv[i], 80.f)), kb[i + 1] * __expf(fminf(mB1 - rbv[i + 1], 80.f)));
    }
#pragma unroll
    for (int i = 0; i < 16; ++i) {
      kf[i] = kf[i] * __expf(BF[63 * 65 + k0 + i] - bfv[i]);
      kb[i] = kb[i] * __expf(RB[k0 + i] - rbv[i]);
    }
    __syncthreads();
#pragma unroll
    for (int i = 0; i < 16; ++i) {
      KHF[(k0 + i) * 72 + t] = f2bf(kf[i]);
      KHB[(k0 + i) * 72 + t] = f2bf(kb[i]);
    }
    __syncthreads();
    {
      const f32x16 af = lds_mm(QF, KF, tm, tn, l31, hh);
      const f32x16 ab = lds_mm(QB, KB, tm, tn, l31, hh);
      const int s = tn * 32 + l31;
#pragma unroll
      for (int r = 0; r < 16; ++r) {
        const int tt = tm * 32 + drow(r, hh);
        float a = 0.f;
        if (s <= tt) a += af[r];
        if (s >= tt) a += ab[r];
        ATT[tt * 72 + s] = f2bf(a);
      }
    }
    {
      const f32x16 lf = lds_mm(VTt, KHF, tm, tn, l31, hh);
      const f32x16 lb = lds_mm(VTt, KHB, tm, tn, l31, hh);
      bf16* stf = P.ST + ((size_t)((b * 4 + hd) * 2 + 0) * 36 + c) * 4096;
      bf16* stb = P.ST + ((size_t)((b * 4 + hd) * 2 + 1) * 36 + c) * 4096;
#pragma unroll
      for (int r = 0; r < 16; ++r) {
        const int kk = tm * 32 + drow(r, hh), d = tn * 32 + l31;
        stf[kk * 64 + d] = f2bf(lf[r]);
        stb[kk * 64 + d] = f2bf(lb[r]);
      }
    }
    __syncthreads();
    {
      const f32x16 o = lds_mm(ATT, VTt, tm, tn, l31, hh);
#pragma unroll
      for (int r = 0; r < 16; ++r) {
        const int tt = tm * 32 + drow(r, hh), d = tn * 32 + l31;
        P.OI[(size_t)row_of(b, c * 64 + tt) * 256 + hd * 64 + d] = f2bf(o[r]);
      }
    }
  }
}

DEVI void hgrn_scan_item(const Params& P, int item) {
  const int tid = TIDX;
  const int chain = item >> 2, sl = item & 3;
  const int dir = chain & 1;
  const int dd = tid >> 2, k4 = sl * 16 + (tid & 3) * 4;
  float4 S = make_float4(0.f, 0.f, 0.f, 0.f);
  bf16* base = P.ST + (size_t)chain * 36 * 4096 + dd * 64 + k4;
  const float* dec = P.DEC + (size_t)chain * 36 * 64 + k4;
#pragma unroll 1
  for (int g = 0; g < 6; ++g) {
    float4 L[6], dc[6];
#pragma unroll
    for (int j = 0; j < 6; ++j) {
      const int step = g * 6 + j;
      const int c = dir == 0 ? step : (step < 4 ? 3 - step : 39 - step);
      { const uint2 u = *reinterpret_cast<const uint2*>(base + (size_t)c * 4096); L[j] = make_float4(lo2f(u.x), hi2f(u.x), lo2f(u.y), hi2f(u.y)); }
      dc[j] = *reinterpret_cast<const float4*>(dec + c * 64);
    }
#pragma unroll
    for (int j = 0; j < 6; ++j) {
      const int step = g * 6 + j;
      const int c = dir == 0 ? step : (step < 4 ? 3 - step : 39 - step);
      *reinterpret_cast<uint2*>(base + (size_t)c * 4096) = make_uint2(pack2(S.x, S.y), pack2(S.z, S.w));
      S.x = dc[j].x * S.x + L[j].x; S.y = dc[j].y * S.y + L[j].y; S.z = dc[j].z * S.z + L[j].z; S.w = dc[j].w * S.w + L[j].w;
    }
  }
}

DEVI void phase_hgrn_final(const Params& P, int l, unsigned char* smem) {
  const int tid = TIDX, lane = tid & 63, wave = tid >> 6, l31 = lane & 31, hh = lane >> 5;
  const int tm = wave >> 1, tn = wave & 1;
  float* O = reinterpret_cast<float*>(smem);
  bf16* QF = reinterpret_cast<bf16*>(smem + 33280);
  bf16* QB = QF + 64 * 72;
  bf16* SF = QB + 64 * 72;
  bf16* SB = SF + 64 * 72;
  const int c0 = (l == 1) ? 4 : 0;
  const int nc = 36 - c0;
  for (int it = VBID; it < 8 * 4 * nc; it += NVB) {
    const int c = it % nc + c0, hd = (it / nc) & 3, b = it / (nc * 4);
    const int t = tid >> 2, k0 = (tid & 3) * 16;
    const int row = row_of(b, c * 64 + t);
    __syncthreads();
    {
      const size_t go = (size_t)row * 256 + hd * 64 + k0;
      *reinterpret_cast<uint4*>(QF + t * 72 + k0) = *reinterpret_cast<const uint4*>(P.GQF + go);
      *reinterpret_cast<uint4*>(QF + t * 72 + k0 + 8) = *reinterpret_cast<const uint4*>(P.GQF + go + 8);
      *reinterpret_cast<uint4*>(QB + t * 72 + k0) = *reinterpret_cast<const uint4*>(P.GQB + go);
      *reinterpret_cast<uint4*>(QB + t * 72 + k0 + 8) = *reinterpret_cast<const uint4*>(P.GQB + go + 8);
      const bf16* stf = P.ST + ((size_t)((b * 4 + hd) * 2 + 0) * 36 + c) * 4096 + t * 64 + k0;
      const bf16* stb = P.ST + ((size_t)((b * 4 + hd) * 2 + 1) * 36 + c) * 4096 + t * 64 + k0;
      *reinterpret_cast<uint4*>(SF + t * 72 + k0) = *reinterpret_cast<const uint4*>(stf);
      *reinterpret_cast<uint4*>(SF + t * 72 + k0 + 8) = *reinterpret_cast<const uint4*>(stf + 8);
      *reinterpret_cast<uint4*>(SB + t * 72 + k0) = *reinterpret_cast<const uint4*>(stb);
      *reinterpret_cast<uint4*>(SB + t * 72 + k0 + 8) = *reinterpret_cast<const uint4*>(stb + 8);
    }
    __syncthreads();
    {
      f32x16 o = lds_mm(QF, SF, tm, tn, l31, hh);
      const f32x16 o2 = lds_mm(QB, SB, tm, tn, l31, hh);
#pragma unroll
      for (int r = 0; r < 16; ++r) {
        const int tt = tm * 32 + drow(r, hh), d = tn * 32 + l31;
        O[tt * 65 + d] = o[r] + o2[r] + bf2f(P.OI[(size_t)row_of(b, c * 64 + tt) * 256 + hd * 64 + d]);
      }
    }
    __syncthreads();
    {
      float ov[16]; float ss = 0.f;
#pragma unroll
      for (int i = 0; i < 16; ++i) { ov[i] = O[t * 65 + k0 + i]; ss += ov[i] * ov[i]; }
      ss += __shfl_xor(ss, 1); ss += __shfl_xor(ss, 2);
      const float rr = rsqrtf(ss * (1.f / 64.f) + EPS);
      const bf16* g = P.Z + (size_t)row * DIN + ZC_CG + hd * 64 + k0;
      const float* nw = P.c_out_norm_w + l * 64 + k0;
      const uint4 gA = *reinterpret_cast<const uint4*>(g), gB = *reinterpret_cast<const uint4*>(g + 8);
      const unsigned gw[8] = {gA.x, gA.y, gA.z, gA.w, gB.x, gB.y, gB.z, gB.w};
      unsigned pk[8];
#pragma unroll
      for (int i = 0; i < 16; i += 2) {
        const float g0 = lo2f(gw[i >> 1]), g1 = hi2f(gw[i >> 1]);
        const float y0 = ov[i] * rr * nw[i] * (g0 * sigmoidf_(g0));
        const float y1 = ov[i + 1] * rr * nw[i + 1] * (g1 * sigmoidf_(g1));
        pk[i >> 1] = pack2(y0, y1);
      }
      uint4* dst = reinterpret_cast<uint4*>(P.H + (size_t)row * 1024 + 768 + hd * 64 + k0);
      dst[0] = make_uint4(pk[0], pk[1], pk[2], pk[3]);
      dst[1] = make_uint4(pk[4], pk[5], pk[6], pk[7]);
    }
  }
}

DEVI void attn_item8(const Params& P, int b, int h, int qpos0, int nkeys, float sref, unsigned char* smem_base) {
  const int tid = threadIdx.x, lane = tid & 63, wave = tid >> 6, l31 = lane & 31, hh = lane >> 5;
  constexpr int TK = 128, LDKS = 104, LDVS = 136;
  constexpr int KS_BYTES = TK * LDKS * 2, VS_BYTES = 64 * LDVS * 2, ST_BYTES = KS_BYTES + VS_BYTES;
  const bf16* Qg = P.Q + ((size_t)(b * 8 + h) * SEQP + qpos0 + wave * 32 + l31) * 96;
  const bf16* Kg = P.K + (size_t)(b * 8 + h) * SEQP * 96;
  const bf16* Vg = P.VT + (size_t)(b * 8 + h) * 64 * SEQP;
  bf16x8 qf[6];
#pragma unroll
  for (int ks = 0; ks < 6; ++ks) qf[ks] = ldfrag(Qg + ks * 16 + hh * 8);
  f32x16 oacc[2]; oacc[0] = zero16(); oacc[1] = zero16();
  float lsum = 0.f;
  const int ntiles = nkeys / TK;
  unsigned koff[4], voff[3];
#pragma unroll
  for (int i = 0; i < 4; ++i) { const int q = (i * 8 + wave) * 64 + lane, row = q / 13, cc = q - row * 13; koff[i] = (unsigned)(row * 96 + (cc < 12 ? cc : 0) * 8) * 2u; }
#pragma unroll
  for (int i = 0; i < 3; ++i) { const int q = (i * 8 + wave) * 64 + lane, row = q / 17, cc = q - row * 17; voff[i] = (unsigned)((row < 64 ? row : 63) * SEQP + (cc < 16 ? cc : 0) * 8) * 2u; }
  LAS unsigned char* ldsb = (LAS unsigned char*)smem_base;
  auto dma_tile = [&](int kt, int buf) {
    const char* kb_ = (const char*)(Kg + (size_t)kt * TK * 96);
    const char* vb_ = (const char*)(Vg + (size_t)kt * TK);
#pragma unroll
    for (int i = 0; i < 4; ++i) {
      const int g = i * 8 + wave;
      if (g < 26) __builtin_amdgcn_global_load_lds((const unsigned*)(kb_ + koff[i]), (LAS unsigned*)(ldsb + buf * ST_BYTES + g * 1024), 16, 0, 0);
    }
#pragma unroll
    for (int i = 0; i < 3; ++i) {
      const int g = i * 8 + wave;
      if (g < 17) __builtin_amdgcn_global_load_lds((const unsigned*)(vb_ + voff[i]), (LAS unsigned*)(ldsb + buf * ST_BYTES + KS_BYTES + g * 1024), 16, 0, 0);
    }
  };
  __syncthreads();
  dma_tile(0, 0);
  asm volatile("s_waitcnt vmcnt(0)" ::: "memory");
  __syncthreads();
  for (int kt = 0; kt < ntiles; ++kt) {
    const int cur = kt & 1;
    if (kt + 1 < ntiles) dma_tile(kt + 1, cur ^ 1);
    const bf16* sK = reinterpret_cast<const bf16*>(smem_base + cur * ST_BYTES);
    const bf16* sV = reinterpret_cast<const bf16*>(smem_base + cur * ST_BYTES + KS_BYTES);
#pragma unroll
    for (int kk = 0; kk < 4; ++kk) {
      f32x16 sacc;
#pragma unroll
      for (int r = 0; r < 16; ++r) sacc[r] = -sref;
#pragma unroll
      for (int ks = 0; ks < 6; ++ks) {
        const bf16x8 a = ldfrag(sK + (kk * 32 + l31) * LDKS + ks * 16 + hh * 8);
        sacc = mfma32(a, qf[ks], sacc);
      }
#pragma unroll
      for (int r = 0; r < 16; ++r) { const float p = __builtin_amdgcn_exp2f(sacc[r]); sacc[r] = p; lsum += p; }
#pragma unroll
      for (int s = 0; s < 2; ++s) {
        bf16x8 pb;
#pragma unroll
        for (int j = 0; j < 8; ++j) pb[j] = (__bf16)sacc[8 * s + j];
#pragma unroll
        for (int dt = 0; dt < 2; ++dt) {
          const bf16x8 a = ldfrag(sV + (dt * 32 + l31) * LDVS + kk * 32 + s * 16 + hh * 8);
          oacc[dt] = mfma32(a, pb, oacc[dt]);
        }
      }
    }
    asm volatile("s_waitcnt vmcnt(0)" ::: "memory");
    __syncthreads();
  }
  lsum += __shfl_xor(lsum, 32);
  const float inv = 1.f / lsum;
  const int row = row_of(b, qpos0 + wave * 32 + l31);
  bf16* dst = P.H + (size_t)row * 1024 + 256 + h * 64;
#pragma unroll
  for (int dt = 0; dt < 2; ++dt)
#pragma unroll
    for (int rg = 0; rg < 4; ++rg) {
      const int d = dt * 32 + 8 * rg + 4 * hh;
      uint2 o;
      o.x = pack2(oacc[dt][4 * rg + 0] * inv, oacc[dt][4 * rg + 1] * inv);
      o.y = pack2(oacc[dt][4 * rg + 2] * inv, oacc[dt][4 * rg + 3] * inv);
      *reinterpret_cast<uint2*>(dst + d) = o;
    }
}

DEVI void phase_attn_scan(const Params& P, int l, unsigned char* smem_base, bool skip_scan = false) {
  if (!skip_scan)
    for (int it = NVB - 1 - VBID; it < 256; it += NVB) hgrn_scan_item(P, it);
  float sref;
  {
    const int lane = threadIdx.x & 63;
    float mq = fmaxf(fabsf(P.b_qh_w[l * 96 + lane]), lane < 32 ? fabsf(P.b_qh_w[l * 96 + 64 + lane]) : 0.f);
    float mk = fmaxf(fabsf(P.b_kh_w[l * 96 + lane]), lane < 32 ? fabsf(P.b_kh_w[l * 96 + 64 + lane]) : 0.f);
#pragma unroll
    for (int o = 32; o > 0; o >>= 1) { mq = fmaxf(mq, __shfl_xor(mq, o)); mk = fmaxf(mk, __shfl_xor(mk, o)); }
    sref = fminf(1.4426950408889634f * 9.797958971132712f * mq * mk, 60.f);
  }
  const int c = blockIdx.x, xcd = c & 7, slot = c >> 3;
  const int nrounds = (l == 0) ? 3 : 2;
  for (int r = 0; r < nrounds; ++r) {
    if (r < 2) {
      const int u = r * 32 + slot;
      const int bh = xcd * 8 + (u >> 3), qt = u & 7;
      if (slot < 32) attn_item8(P, bh >> 3, bh & 7, 256 + 256 * qt, 2304, sref, smem_base);
    } else if (c < 64) {
      attn_item8(P, c >> 3, c & 7, 0, 256, sref, smem_base);
    }
  }
}

DEVI unsigned ordkey(float s) { const unsigned u = __float_as_uint(s); return (u & 0x80000000u) ? ~u : (u | 0x80000000u); }
DEVI float keyval(unsigned k, unsigned mask) { const unsigned u = k & ~mask; return __uint_as_float((u & 0x80000000u) ? (u & 0x7fffffffu) : ~u); }
DEVI void ins16(unsigned (&lst)[16], unsigned v) {
#pragma unroll
  for (int j = 0; j < 16; ++j) { const unsigned hi = max(lst[j], v); v = min(lst[j], v); lst[j] = hi; }
}
DEVI void merge16(unsigned (&lst)[16], int xm) {
  unsigned o[16];
#pragma unroll
  for (int j = 0; j < 16; ++j) o[j] = (unsigned)__shfl_xor((int)lst[j], xm);
#pragma unroll
  for (int j = 0; j < 16; ++j) lst[j] = max(lst[j], o[15 - j]);
#pragma unroll
  for (int d = 8; d >= 1; d >>= 1)
#pragma unroll
    for (int j = 0; j < 16; ++j)
      if ((j & d) == 0) { const unsigned a = lst[j], bb = lst[j + d]; lst[j] = max(a, bb); lst[j + d] = min(a, bb); }
}

DEVI void bitonic_sort_desc16(unsigned (&v)[16]) {
#pragma unroll
  for (int k = 2; k <= 16; k <<= 1)
#pragma unroll
    for (int j = k >> 1; j > 0; j >>= 1)
#pragma unroll
      for (int i = 0; i < 16; ++i) {
        const int l = i ^ j;
        if (l > i) {
          const bool desc = ((i & k) == 0);
          const unsigned a = v[i], b = v[l];
          const unsigned mx = max(a, b), mn = min(a, b);
          v[i] = desc ? mx : mn; v[l] = desc ? mn : mx;
        }
      }
}
DEVI void bitonic_merge_desc16(unsigned (&lst)[16]) {
#pragma unroll
  for (int d = 8; d >= 1; d >>= 1)
#pragma unroll
    for (int j = 0; j < 16; ++j)
      if ((j & d) == 0) { const unsigned a = lst[j], bb = lst[j + d]; lst[j] = max(a, bb); lst[j + d] = min(a, bb); }
}
struct CandTab { int a[52]; int b[52]; };
constexpr CandTab make_cand_tab() {
  CandTab t{};
  int n = 0;
  for (int a = 0; a < 16; ++a)
    for (int b = 0; b < 16; ++b)
      if ((a + 1) * (b + 1) <= 16) { t.a[n] = a; t.b[n] = b; ++n; }
  for (; n < 52; ++n) { t.a[n] = 0; t.b[n] = 0; }
  return t;
}

DEVI void phase_route(const Params& P, int l, unsigned char* smem) {
  const int tid = TIDX, lane = tid & 63, wave = tid >> 6, l31 = lane & 31, hh = lane >> 5;
  bf16* QT = reinterpret_cast<bf16*>(smem);
  float* SC = reinterpret_cast<float*>(smem + 33792);
  const int mtiles = (l == 1) ? 256 : 288;
  for (int it = VBID; it < mtiles * 8; it += NVB) {
    const int mt = it >> 3, h = it & 7;
    __syncthreads();
    for (int e = tid; e < 64 * 32; e += 256) {
      const int r = e >> 5, cc = e & 31;
      *reinterpret_cast<uint4*>(QT + r * 264 + cc * 8) = *reinterpret_cast<const uint4*>(P.QP + (size_t)(mt * 64 + r) * 2048 + h * 256 + cc * 8);
    }
    __syncthreads();
    unsigned lst[2][16];
    const int row = tid >> 2, part = tid & 3;
#pragma unroll
    for (int p = 0; p < 2; ++p) {
      f32x16 sa[2]; sa[0] = zero16(); sa[1] = zero16();
      const bf16* keys = P.SK + ((size_t)(l * 16 + h * 2 + p) * 128 + wave * 32 + l31) * 128;
#pragma unroll
      for (int ks = 0; ks < 8; ++ks) {
        const bf16x8 bfr = ldfrag(keys + ks * 16 + hh * 8);
#pragma unroll
        for (int i = 0; i < 2; ++i) {
          const bf16x8 af = ldfrag(QT + (i * 32 + l31) * 264 + p * 128 + ks * 16 + hh * 8);
          sa[i] = mfma32(af, bfr, sa[i]);
        }
      }
      if (p == 1) __syncthreads();
#pragma unroll
      for (int i = 0; i < 2; ++i)
#pragma unroll
        for (int r = 0; r < 16; ++r) SC[(i * 32 + drow(r, hh)) * 129 + wave * 32 + l31] = sa[i][r];
      __syncthreads();
      unsigned B2[16];
#pragma unroll
      for (int i = 0; i < 16; ++i) {
        const int i0 = part * 32 + ((i + part * 8) & 31), i1 = part * 32 + ((i + 16 + part * 8) & 31);
        lst[p][i] = (ordkey(SC[row * 129 + i0]) & ~0x7fu) | (unsigned)(127 - i0);
        B2[i] = (ordkey(SC[row * 129 + i1]) & ~0x7fu) | (unsigned)(127 - i1);
      }
      bitonic_sort_desc16(lst[p]);
      bitonic_sort_desc16(B2);
#pragma unroll
      for (int j = 0; j < 16; ++j) lst[p][j] = max(lst[p][j], B2[15 - j]);
      bitonic_merge_desc16(lst[p]);
      merge16(lst[p], 1);
      merge16(lst[p], 2);
    }
    float v0[16], v1[16];
#pragma unroll
    for (int j = 0; j < 16; ++j) { v0[j] = keyval(lst[0][j], 0x7fu); v1[j] = keyval(lst[1][j], 0x7fu); }
    unsigned best[16];
    {
      constexpr CandTab CT = make_cand_tab();
#pragma unroll
      for (int c = 0; c < 13; ++c) {
        const int a0 = CT.a[4 * c + 0], a1 = CT.a[4 * c + 1], a2 = CT.a[4 * c + 2], a3 = CT.a[4 * c + 3];
        const int b0 = CT.b[4 * c + 0], b1 = CT.b[4 * c + 1], b2 = CT.b[4 * c + 2], b3 = CT.b[4 * c + 3];
        const float x = part == 0 ? v0[a0] : part == 1 ? v0[a1] : part == 2 ? v0[a2] : v0[a3];
        const float y = part == 0 ? v1[b0] : part == 1 ? v1[b1] : part == 2 ? v1[b2] : v1[b3];
        const int flat = part == 0 ? (a0 * 16 + b0) : part == 1 ? (a1 * 16 + b1) : part == 2 ? (a2 * 16 + b2) : (a3 * 16 + b3);
        const bool valid = part == 0 ? (4 * c + 0 < 50) : part == 1 ? (4 * c + 1 < 50) : part == 2 ? (4 * c + 2 < 50) : (4 * c + 3 < 50);
        const unsigned key = (ordkey(x + y) & ~0xffu) | (unsigned)(255 - flat);
        best[c] = valid ? key : 0u;
      }
      best[13] = 0u; best[14] = 0u; best[15] = 0u;
      bitonic_sort_desc16(best);
      merge16(best, 1);
      merge16(best, 2);
    }
    {
      const float mx = keyval(best[0], 0xffu);
      float es = 0.f;
      float ev[4]; int ex[4];
#pragma unroll
      for (int jj = 0; jj < 4; ++jj) {
        const unsigned kk = part == 0 ? best[4 * jj + 0] : part == 1 ? best[4 * jj + 1] : part == 2 ? best[4 * jj + 2] : best[4 * jj + 3];
        ev[jj] = __expf(keyval(kk, 0xffu) - mx);
        es += ev[jj];
        const int flat = 255 - (int)(kk & 0xffu);
        const int a = flat >> 4, bq = flat & 15;
        int i1 = 0, i2 = 0;
#pragma unroll
        for (int u = 0; u < 16; ++u) {
          i1 = (a == u) ? (127 - (int)(lst[0][u] & 0x7fu)) : i1;
          i2 = (bq == u) ? (127 - (int)(lst[1][u] & 0x7fu)) : i2;
        }
        ex[jj] = i1 * 128 + i2;
      }
      es += __shfl_xor(es, 1); es += __shfl_xor(es, 2);
      const float inv = 1.f / es;
      const int tok = mt * 64 + row;
      int* ed = P.EIDX + (size_t)tok * 128 + h * 16;
      float* gd = P.GATE + (size_t)tok * 128 + h * 16;
#pragma unroll
      for (int jj = 0; jj < 4; ++jj) { ed[4 * jj + part] = ex[jj]; gd[4 * jj + part] = ev[jj] * inv; }
    }
  }
}

DEVI float gelu_exact(float a) { return 0.5f * a * (1.f + erff(a * 0.70710678118654752f)); }

typedef float f2 __attribute__((ext_vector_type(2)));
DEVI void phase_peer_u(const Params& P, int l) {
  const int lane = TIDX & 63, half = lane >> 5, l32 = lane & 31;
  const int gw = VBID * 4 + (TIDX >> 6), nw = NVB * 4;
  const int nrows = (l == 1) ? NL : NT;
  const unsigned char* PU = P.PU8 + (size_t)l * 16384 * 576;
  const bool b4 = lane & 16, b3 = lane & 8, b2 = lane & 4;
  for (int t = gw; t < nrows; t += nw) {
    f2 h2[16];
    {
      const bf16* hp = P.H + (size_t)t * 1024 + l32 * 32;
#pragma unroll
      for (int i = 0; i < 4; ++i) {
        const uint4 hv = *reinterpret_cast<const uint4*>(hp + i * 8);
        h2[4 * i + 0] = (f2){lo2f(hv.x), hi2f(hv.x)}; h2[4 * i + 1] = (f2){lo2f(hv.y), hi2f(hv.y)};
        h2[4 * i + 2] = (f2){lo2f(hv.z), hi2f(hv.z)}; h2[4 * i + 3] = (f2){lo2f(hv.w), hi2f(hv.w)};
      }
    }
    const int e0 = P.EIDX[(size_t)t * 128 + lane], e1 = P.EIDX[(size_t)t * 128 + 64 + lane];
    const float g0 = P.GATE[(size_t)t * 128 + lane], g1 = P.GATE[(size_t)t * 128 + 64 + lane];
    float* wrow = P.WPE + (size_t)t * 128;
    const bool b1 = lane & 2;
    for (int kb = 0; kb < 4; ++kb) {
      const int esrc = kb < 2 ? e0 : e1;
      uint4 ud[16];
      unsigned short us[16];
#pragma unroll
      for (int i = 0; i < 16; ++i) {
        const int e = __shfl(esrc, (kb * 32 + 2 * i + half) & 63);
        const unsigned char* ur = PU + (size_t)e * 576;
        ud[i] = *reinterpret_cast<const uint4*>(ur + l32 * 16);
        us[i] = *reinterpret_cast<const unsigned short*>(ur + 512 + l32 * 2);
      }
      float d[16];
#pragma unroll
      for (int i = 0; i < 16; ++i) {
        const unsigned uw[4] = {ud[i].x, ud[i].y, ud[i].z, ud[i].w};
        f2 sacc = (f2){0.f, 0.f};
#pragma unroll
        for (int c = 0; c < 4; ++c) {
          sacc = __builtin_elementwise_fma(__builtin_amdgcn_cvt_scalef32_pk_f32_fp4(uw[c], 1.0f, 0), h2[4 * c + 0], sacc);
          sacc = __builtin_elementwise_fma(__builtin_amdgcn_cvt_scalef32_pk_f32_fp4(uw[c], 1.0f, 1), h2[4 * c + 1], sacc);
          sacc = __builtin_elementwise_fma(__builtin_amdgcn_cvt_scalef32_pk_f32_fp4(uw[c], 1.0f, 2), h2[4 * c + 2], sacc);
          sacc = __builtin_elementwise_fma(__builtin_amdgcn_cvt_scalef32_pk_f32_fp4(uw[c], 1.0f, 3), h2[4 * c + 3], sacc);
        }
        d[i] = (sacc.x + sacc.y) * __uint_as_float((unsigned)us[i] << 16);
      }
      float r8[8], r4[4], r2[2], r1;
#pragma unroll
      for (int i = 0; i < 8; ++i) { const float mine = b4 ? d[8 + i] : d[i]; const float send = b4 ? d[i] : d[8 + i]; r8[i] = mine + __shfl_xor(send, 16); }
#pragma unroll
      for (int i = 0; i < 4; ++i) { const float mine = b3 ? r8[4 + i] : r8[i]; const float send = b3 ? r8[i] : r8[4 + i]; r4[i] = mine + __shfl_xor(send, 8); }
#pragma unroll
      for (int i = 0; i < 2; ++i) { const float mine = b2 ? r4[2 + i] : r4[i]; const float send = b2 ? r4[i] : r4[2 + i]; r2[i] = mine + __shfl_xor(send, 4); }
      { const float mine = b1 ? r2[1] : r2[0]; const float send = b1 ? r2[0] : r2[1]; r1 = mine + __shfl_xor(send, 2); }
      r1 += __shfl_xor(r1, 1);
      const int k = kb * 32 + 2 * ((lane >> 1) & 15) + half;
      const float gt = __shfl(kb < 2 ? g0 : g1, k & 63);
      if ((lane & 1) == 0) wrow[k] = gt * gelu_exact(r1);
    }
  }
}

DEVI void phase_peer(const Params& P, int l) {
  const int lane = TIDX & 63, half = lane >> 5, l32 = lane & 31;
  const int gw = VBID * 4 + (TIDX >> 6), nw = NVB * 4;
  const int nrows = (l == 1) ? NL : NT;
  const unsigned char* PV = P.PV8 + (size_t)l * 16384 * 576;
  for (int t = gw; t < nrows; t += nw) {
    const int e0 = P.EIDX[(size_t)t * 128 + lane], e1 = P.EIDX[(size_t)t * 128 + 64 + lane];
    const float w0 = P.WPE[(size_t)t * 128 + lane], w1 = P.WPE[(size_t)t * 128 + 64 + lane];
    f2 y2[16];
#pragma unroll
    for (int i = 0; i < 16; ++i) y2[i] = (f2){0.f, 0.f};
    for (int kb = 0; kb < 4; ++kb) {
      const int esrc = kb < 2 ? e0 : e1;
      const float wsrc = kb < 2 ? w0 : w1;
      uint4 vd[16];
      unsigned short vs[16];
      float wv[16];
#pragma unroll
      for (int i = 0; i < 16; ++i) {
        const int ks = (kb * 32 + 2 * i + half) & 63;
        const int e = __shfl(esrc, ks);
        wv[i] = __shfl(wsrc, ks);
        const unsigned char* vr = PV + (size_t)e * 576;
        vd[i] = *reinterpret_cast<const uint4*>(vr + l32 * 16);
        vs[i] = *reinterpret_cast<const unsigned short*>(vr + 512 + l32 * 2);
      }
#pragma unroll
      for (int i = 0; i < 16; ++i) {
        const float wi = wv[i] * __uint_as_float((unsigned)vs[i] << 16);
        const f2 ww = (f2){wi, wi};
        const unsigned vw[4] = {vd[i].x, vd[i].y, vd[i].z, vd[i].w};
#pragma unroll
        for (int c = 0; c < 4; ++c) {
          y2[4 * c + 0] = __builtin_elementwise_fma(ww, __builtin_amdgcn_cvt_scalef32_pk_f32_fp4(vw[c], 1.0f, 0), y2[4 * c + 0]);
          y2[4 * c + 1] = __builtin_elementwise_fma(ww, __builtin_amdgcn_cvt_scalef32_pk_f32_fp4(vw[c], 1.0f, 1), y2[4 * c + 1]);
          y2[4 * c + 2] = __builtin_elementwise_fma(ww, __builtin_amdgcn_cvt_scalef32_pk_f32_fp4(vw[c], 1.0f, 2), y2[4 * c + 2]);
          y2[4 * c + 3] = __builtin_elementwise_fma(ww, __builtin_amdgcn_cvt_scalef32_pk_f32_fp4(vw[c], 1.0f, 3), y2[4 * c + 3]);
        }
      }
    }
    float y[16];
#pragma unroll
    for (int j = 0; j < 8; ++j) {
      const float ax = y2[j].x + __shfl_xor(y2[j].x, 32), ay = y2[j].y + __shfl_xor(y2[j].y, 32);
      const float bx = y2[8 + j].x + __shfl_xor(y2[8 + j].x, 32), by = y2[8 + j].y + __shfl_xor(y2[8 + j].y, 32);
      y[2 * j] = half ? bx : ax; y[2 * j + 1] = half ? by : ay;
    }
    const int bi = batch_of_row(t);
    const float* gate2 = P.MOD + (size_t)(l * 9 + bi) * 6144 + 5 * 1024;
    const int d0 = l32 * 32 + half * 16;
    float xn[16];
    float ss = 0.f;
#pragma unroll
    for (int q4 = 0; q4 < 4; ++q4) {
      const int d = d0 + q4 * 4;
      const uint2 xu = *reinterpret_cast<const uint2*>(P.X + (size_t)t * 1024 + d);
      const float4 xo = make_float4(lo2f(xu.x), hi2f(xu.x), lo2f(xu.y), hi2f(xu.y));
      const float4 gg = *reinterpret_cast<const float4*>(gate2 + d);
      float4 o;
      o.x = xo.x + gg.x * y[q4 * 4 + 0]; o.y = xo.y + gg.y * y[q4 * 4 + 1];
      o.z = xo.z + gg.z * y[q4 * 4 + 2]; o.w = xo.w + gg.w * y[q4 * 4 + 3];
      xn[q4 * 4 + 0] = o.x; xn[q4 * 4 + 1] = o.y; xn[q4 * 4 + 2] = o.z; xn[q4 * 4 + 3] = o.w;
      ss += o.x * o.x + o.y * o.y + o.z * o.z + o.w * o.w;
      if (l == 1) *reinterpret_cast<float4*>(P.out + (size_t)t * 1024 + d) = o;
      else *reinterpret_cast<uint2*>(P.X + (size_t)t * 1024 + d) = make_uint2(pack2(o.x, o.y), pack2(o.z, o.w));
    }
    if (l == 0) {
      ss = wave_sum(ss);
      const float rr = rsqrtf(ss * (1.f / 1024.f) + EPS);
      const float* lnw = P.ln1_w + 1024;
      const float* mod = P.MOD + (size_t)(9 + bi) * 6144;
      unsigned pk[8];
#pragma unroll
      for (int i = 0; i < 16; i += 2) {
        const float o0 = xn[i] * rr * lnw[d0 + i] * (1.f + mod[1024 + d0 + i]) + mod[d0 + i];
        const float o1 = xn[i + 1] * rr * lnw[d0 + i + 1] * (1.f + mod[1024 + d0 + i + 1]) + mod[d0 + i + 1];
        pk[i >> 1] = pack2(o0, o1);
      }
      *reinterpret_cast<uint4*>(P.H + (size_t)t * 1024 + d0) = make_uint4(pk[0], pk[1], pk[2], pk[3]);
      *reinterpret_cast<uint4*>(P.H + (size_t)t * 1024 + d0 + 8) = make_uint4(pk[4], pk[5], pk[6], pk[7]);
    }
  }
}

using f32x4 = __attribute__((ext_vector_type(4))) float;
namespace g8 {
constexpr int BM = 256, BK = 64, HALF = 128, HT = HALF * BK;
DEVI int lds_byte(int r, int c) { const int st = (r >> 4) * 2 + (c >> 5), rr = r & 15, cc = c & 31, ob = rr * 64 + cc * 2; return st * 1024 + (ob ^ (((ob >> 9) & 1) << 5)); }
DEVI void stage_rc(int b, int& R, int& C) { const int st = b / 1024, sb = b % 1024, swz = sb ^ (((sb >> 9) & 1) << 5); R = (st >> 1) * 16 + swz / 64; C = (st & 1) * 32 + (swz % 64) / 2; }
DEVI int perm32(int rho) { const int n = rho >> 4, i = rho & 15; return 8 * (i >> 2) + 4 * n + (i & 3); }
DEVI void unit_of(int L, int nM, int nN, int& pm, int& pn) {
  const int nwg = nM * nN;
  int wgid = L;
  { const int q = nwg / 8, r = nwg % 8, xcd = wgid % 8, off = wgid / 8; wgid = (xcd < r ? xcd * (q + 1) : r * (q + 1) + (xcd - r) * q) + off; }
  const int nig = 8 * nN, gid = wgid / nig, fm = gid * 8, gsz = (nM - fm) < 8 ? (nM - fm) : 8;
  pm = fm + ((wgid % nig) % gsz); pn = (wgid % nig) / gsz;
}
}

struct G8Unit { int pm, pn; };
template <class Epi>
DEVI void gemm8_phase(LAS unsigned char* lds, const bf16* __restrict__ Ag, const bf16* __restrict__ Btg, const int K, const int nM, const int nN, const Epi& E,
                      const int lda = 0, const int pn_split = 1 << 30, const int acol0 = 0, const int acol1 = 0,
                      const int ldb = 0, const int pn_mod = 1 << 30, const int ksplit_cols = 0) {
  constexpr int BK = 64, HALF = 128, HTB = HALF * BK * 2;
  const int tid = threadIdx.x, wid = __builtin_amdgcn_readfirstlane(tid >> 6), lane = tid & 63, wr = wid >> 2, wc = wid & 3, fr = lane & 15, fq = lane >> 4;
  const int nt = K / BK;
  const int nunits = nM * nN, G = gridDim.x, c = blockIdx.x;
  const int LDA = lda ? lda : K, LDB = ldb ? ldb : K;
  unsigned voffA[2], voffB[2];
#pragma unroll
  for (int i = 0; i < 2; ++i) { int R, C; g8::stage_rc(tid * 16 + i * 8192, R, C); const int Rb = (R & ~31) + g8::perm32(R & 31); voffA[i] = (unsigned)(R * LDA + C) * 2u; voffB[i] = (unsigned)(Rb * LDB + C) * 2u; }
  const size_t kstep = (size_t)(BK * 2);
  const size_t hstepA = (size_t)HALF * LDA * 2, hstep = (size_t)HALF * LDB * 2;
  const size_t tstepA = 2 * hstepA, tstep = 2 * hstep;
  const unsigned ldsw = (unsigned)wid * 1024u;
  const int aoff = g8::lds_byte(wr * 64 + fr, fq * 8), boff = g8::lds_byte(wc * 32 + fr, fq * 8);
#define PG8_SA(b, h) (((b) * 2 + (h)) * HTB)
#define PG8_SB(b, h) ((4 + (b) * 2 + (h)) * HTB)
#define PG8_STAGE(bufoff, gbase, voff) do { _Pragma("unroll") for (int _i = 0; _i < 2; ++_i) \
        __builtin_amdgcn_global_load_lds((const unsigned*)((const char*)(gbase) + (voff)[_i]), (LAS unsigned*)(lds + (bufoff) + ldsw + _i * 8192), 16, 0, 0); } while (0)
#define PG8_LDA(dst, b, h) do { _Pragma("unroll") for (int m = 0; m < 4; ++m) _Pragma("unroll") for (int k = 0; k < 2; ++k) dst[m][k] = *(const LAS bf16x8*)(lds + PG8_SA(b, h) + aoff + m * 2048 + k * 1024); } while (0)
#define PG8_LDB(dst, b, h) do { _Pragma("unroll") for (int n = 0; n < 2; ++n) _Pragma("unroll") for (int k = 0; k < 2; ++k) dst[n][k] = *(const LAS bf16x8*)(lds + PG8_SB(b, h) + boff + n * 2048 + k * 1024); } while (0)
#define PG8_MMA(ai, bj, At_, Bt_) do { __builtin_amdgcn_s_setprio(1); _Pragma("unroll") for (int m = 0; m < 4; ++m) _Pragma("unroll") for (int n = 0; n < 2; ++n) _Pragma("unroll") for (int k = 0; k < 2; ++k) \
        acc[ai][bj][m][n] = __builtin_amdgcn_mfma_f32_16x16x32_bf16(Bt_[n][k], At_[m][k], acc[ai][bj][m][n], 0, 0, 0); __builtin_amdgcn_s_setprio(0); } while (0)
#define PG8_WAIT_V(n) asm volatile("s_waitcnt vmcnt(" #n ")" ::: "memory")
#define PG8_WAIT_L(n) asm volatile("s_waitcnt lgkmcnt(" #n ")" ::: "memory")
#define PG8_BAR __builtin_amdgcn_s_barrier()
#define PG8_SCHED __builtin_amdgcn_sched_barrier(0)
  G8Unit cur, nxt; int ui = 0;
  if (c >= nunits) return;
  g8::unit_of(c, nM, nN, cur.pm, cur.pn);
  f32x4 acc[2][2][4][2];
#pragma unroll
  for (int a = 0; a < 2; ++a)
#pragma unroll
    for (int b = 0; b < 2; ++b)
#pragma unroll
      for (int m = 0; m < 4; ++m)
#pragma unroll
        for (int n = 0; n < 2; ++n) acc[a][b][m][n] = (f32x4){0.f, 0.f, 0.f, 0.f};
  bf16x8 At[4][2], B0[2][2], B1[2][2];
  const char* cA = (const char*)Ag + (size_t)cur.pm * tstepA + (size_t)((cur.pn < pn_split ? acol0 : acol1) + (cur.pn / pn_mod) * ksplit_cols) * 2;
  const char* cB = (const char*)Btg + (size_t)(cur.pn % pn_mod) * tstep + (size_t)((cur.pn / pn_mod) * ksplit_cols) * 2;
  PG8_STAGE(PG8_SB(0, 0), cB, voffB); PG8_STAGE(PG8_SA(0, 0), cA, voffA); PG8_STAGE(PG8_SB(0, 1), cB + hstep, voffB); PG8_STAGE(PG8_SA(0, 1), cA + hstepA, voffA);
  if (wr == 1) PG8_BAR;
  PG8_WAIT_V(4); PG8_BAR;
  PG8_STAGE(PG8_SB(1, 0), cB + kstep, voffB); PG8_STAGE(PG8_SA(1, 0), cA + kstep, voffA); PG8_STAGE(PG8_SB(1, 1), cB + hstep + kstep, voffB);
  PG8_WAIT_V(6); PG8_BAR;
  for (;;) {
    const long Ln = (long)(ui + 1) * G + c;
    const bool has_next = Ln < nunits;
    if (has_next) g8::unit_of((int)Ln, nM, nN, nxt.pm, nxt.pn);
    const char* nA = has_next ? (const char*)Ag + (size_t)nxt.pm * tstepA + (size_t)((nxt.pn < pn_split ? acol0 : acol1) + (nxt.pn / pn_mod) * ksplit_cols) * 2 : cA;
    const char* nB = has_next ? (const char*)Btg + (size_t)(nxt.pn % pn_mod) * tstep + (size_t)((nxt.pn / pn_mod) * ksplit_cols) * 2 : cB;
    for (int t = 0; t < nt; t += 2) {
      const bool last = (t == nt - 2);
      const char* a1 = cA + (size_t)(t + 1) * kstep;
      const char* a2 = last ? nA : cA + (size_t)(t + 2) * kstep; const char* b2 = last ? nB : cB + (size_t)(t + 2) * kstep;
      const char* a3 = a2 + kstep; const char* b3 = b2 + kstep;
      PG8_LDB(B0, 0, 0); PG8_SCHED; PG8_LDA(At, 0, 0); PG8_STAGE(PG8_SA(1, 1), a1 + hstepA, voffA);
      PG8_WAIT_L(8); PG8_BAR; PG8_WAIT_L(0); PG8_MMA(0, 0, At, B0); PG8_BAR; PG8_SCHED;
      PG8_LDB(B1, 0, 1); PG8_STAGE(PG8_SB(0, 0), b2, voffB);
      PG8_BAR; PG8_WAIT_L(0); PG8_MMA(0, 1, At, B1); PG8_BAR;
      PG8_LDA(At, 0, 1); PG8_STAGE(PG8_SA(0, 0), a2, voffA);
      PG8_BAR; PG8_WAIT_L(0); PG8_MMA(1, 0, At, B0); PG8_BAR; PG8_SCHED;
      PG8_STAGE(PG8_SB(0, 1), b2 + hstep, voffB);
      PG8_WAIT_V(6); PG8_BAR; PG8_MMA(1, 1, At, B1); PG8_BAR;
      PG8_LDB(B0, 1, 0); PG8_SCHED; PG8_LDA(At, 1, 0); PG8_STAGE(PG8_SA(0, 1), a2 + hstepA, voffA);
      PG8_WAIT_L(8); PG8_BAR; PG8_WAIT_L(0); PG8_MMA(0, 0, At, B0); PG8_BAR; PG8_SCHED;
      PG8_LDB(B1, 1, 1); PG8_STAGE(PG8_SB(1, 0), b3, voffB);
      PG8_BAR; PG8_WAIT_L(0); PG8_MMA(0, 1, At, B1); PG8_BAR;
      PG8_LDA(At, 1, 1); PG8_STAGE(PG8_SA(1, 0), a3, voffA);
      PG8_BAR; PG8_WAIT_L(0); PG8_MMA(1, 0, At, B0); PG8_BAR; PG8_SCHED;
      PG8_STAGE(PG8_SB(1, 1), b3 + hstep, voffB);
      PG8_WAIT_V(6); PG8_BAR; PG8_MMA(1, 1, At, B1); PG8_BAR;
    }
    E(acc, cur, wr, wc, fr, fq);
    if (!has_next) break;
#pragma unroll
    for (int a = 0; a < 2; ++a)
#pragma unroll
      for (int b = 0; b < 2; ++b)
#pragma unroll
        for (int m = 0; m < 4; ++m)
#pragma unroll
          for (int n = 0; n < 2; ++n) acc[a][b][m][n] = (f32x4){0.f, 0.f, 0.f, 0.f};
    cur = nxt; cA = nA; cB = nB; ++ui;
  }
  PG8_WAIT_V(0);
  if (wr == 0) PG8_BAR;
  PG8_BAR;
#undef PG8_SA
#undef PG8_SB
#undef PG8_STAGE
#undef PG8_LDA
#undef PG8_LDB
#undef PG8_MMA
}

struct EpiZ {
  bf16* Z;
  DEVI void operator()(const f32x4 (&acc)[2][2][4][2], const G8Unit& u, int wr, int wc, int fr, int fq) const {
    const int brow = u.pm * 256, bcol = u.pn * 256;
#pragma unroll
    for (int ai = 0; ai < 2; ++ai)
#pragma unroll
      for (int m = 0; m < 4; ++m) {
        const int row = brow + ai * 128 + wr * 64 + m * 16 + fr;
#pragma unroll
        for (int bj = 0; bj < 2; ++bj) {
          const int col = bcol + bj * 128 + wc * 32 + 8 * fq;
          if (col < DIN) {
            const f32x4 v0 = acc[ai][bj][m][0], v1 = acc[ai][bj][m][1];
            *reinterpret_cast<uint4*>(Z + (size_t)row * DIN + col) = make_uint4(pack2(v0[0], v0[1]), pack2(v0[2], v0[3]), pack2(v1[0], v1[1]), pack2(v1[2], v1[3]));
          }
        }
      }
  }
};
DEVI void phase_gemm1_8(const Params& P, int l, unsigned char* smem_base) {
  EpiZ E{P.Z};
  gemm8_phase((LAS unsigned char*)smem_base, P.H, P.WinT + (size_t)l * DINP * 1024, 1024, NT / 256, DINP / 256, E);
  const int c = blockIdx.x;
  if (c >= 136) {
    const int j = c - 136;
    if (l == 0) convert_rows_fp6(P, 0, j * 100, j * 100 + 100);
    else { const int b0 = 19200 + j * 114; convert_rows_fp6(P, 1, b0 < 32768 ? b0 : 32768, b0 + 114 < 32768 ? b0 + 114 : 32768); }
  }
}

struct EpiRAW {
  bf16* R;
  DEVI void operator()(const f32x4 (&acc)[2][2][4][2], const G8Unit& u, int wr, int wc, int fr, int fq) const {
    const int brow = u.pm * 256, bcol = u.pn * 256;
#pragma unroll
    for (int ai = 0; ai < 2; ++ai)
#pragma unroll
      for (int m = 0; m < 4; ++m) {
        const int row = brow + ai * 128 + wr * 64 + m * 16 + fr;
#pragma unroll
        for (int bj = 0; bj < 2; ++bj) {
          const int col = bcol + bj * 128 + wc * 32 + 8 * fq;
          const f32x4 v0 = acc[ai][bj][m][0], v1 = acc[ai][bj][m][1];
          *reinterpret_cast<uint4*>(R + (size_t)row * 1792 + col) = make_uint4(pack2(v0[0], v0[1]), pack2(v0[2], v0[3]), pack2(v1[0], v1[1]), pack2(v1[2], v1[3]));
        }
      }
  }
};
DEVI void phase_mla_raw(const Params& P, int l, unsigned char* smem_base) {
  EpiRAW E{P.RAW};
  gemm8_phase((LAS unsigned char*)smem_base, P.Z, P.WCOMB + (size_t)l * 1792 * 256, 256, NT / 256, 7, E, DIN, 3, ZC_BQ, ZC_BKV);
}

struct EpiX {
  const float* x; const float* ctx; bf16* X; const float* MODl; int l;
  DEVI void operator()(const f32x4 (&acc)[2][2][4][2], const G8Unit& u, int wr, int wc, int fr, int fq) const {
    const int brow = u.pm * 256, bcol = u.pn * 256;
    const float* gate = MODl + (size_t)batch_of_row(brow) * 6144 + 2048;
#pragma unroll
    for (int ai = 0; ai < 2; ++ai)
#pragma unroll
      for (int m = 0; m < 4; ++m) {
        const int row = brow + ai * 128 + wr * 64 + m * 16 + fr;
        const float* res = row < NL ? x + (size_t)row * 1024 : ctx + (size_t)(row - NL) * 1024;
#pragma unroll
        for (int bj = 0; bj < 2; ++bj) {
          const int col = bcol + bj * 128 + wc * 32 + 8 * fq;
          const f32x4 v0 = acc[ai][bj][m][0], v1 = acc[ai][bj][m][1];
          float4 ra, rb;
          if (l == 0) { ra = *reinterpret_cast<const float4*>(res + col); rb = *reinterpret_cast<const float4*>(res + col + 4); }
          else {
            const uint4 uu = *reinterpret_cast<const uint4*>(X + (size_t)row * 1024 + col);
            ra = make_float4(lo2f(uu.x), hi2f(uu.x), lo2f(uu.y), hi2f(uu.y)); rb = make_float4(lo2f(uu.z), hi2f(uu.z), lo2f(uu.w), hi2f(uu.w));
          }
          const float4 ga = *reinterpret_cast<const float4*>(gate + col), gb = *reinterpret_cast<const float4*>(gate + col + 4);
          *reinterpret_cast<uint4*>(X + (size_t)row * 1024 + col) =
              make_uint4(pack2(ra.x + ga.x * v0[0], ra.y + ga.y * v0[1]), pack2(ra.z + ga.z * v0[2], ra.w + ga.w * v0[3]),
                         pack2(rb.x + gb.x * v1[0], rb.y + gb.y * v1[1]), pack2(rb.z + gb.z * v1[2], rb.w + gb.w * v1[3]));
        }
      }
  }
};
struct EpiPart {
  float* PART;
  DEVI void operator()(const f32x4 (&acc)[2][2][4][2], const G8Unit& u, int wr, int wc, int fr, int fq) const {
    const int brow = u.pm * 256, bcol = (u.pn & 3) * 256;
    float* base = PART + (size_t)(u.pn >> 2) * 2048 * 1024;
#pragma unroll
    for (int ai = 0; ai < 2; ++ai)
#pragma unroll
      for (int m = 0; m < 4; ++m) {
        const int row = brow + ai * 128 + wr * 64 + m * 16 + fr;
#pragma unroll
        for (int bj = 0; bj < 2; ++bj) {
          const int col = bcol + bj * 128 + wc * 32 + 8 * fq;
          const f32x4 v0 = acc[ai][bj][m][0], v1 = acc[ai][bj][m][1];
          *reinterpret_cast<float4*>(base + (size_t)row * 1024 + col) = make_float4(v0[0], v0[1], v0[2], v0[3]);
          *reinterpret_cast<float4*>(base + (size_t)row * 1024 + col + 4) = make_float4(v1[0], v1[1], v1[2], v1[3]);
        }
      }
  }
};
DEVI void phase_gemm2_8(const Params& P, int l, unsigned char* smem_base) {
  EpiX E{P.x, P.ctx, P.X, P.MOD + (size_t)l * 9 * 6144, l};
  gemm8_phase((LAS unsigned char*)smem_base, P.H, P.WoutT + (size_t)l * 1024 * 1024, 1024, NL / 256, 4, E);
  if (l == 0) {
    EpiPart EP{P.PART};
    gemm8_phase((LAS unsigned char*)smem_base, P.H + (size_t)NL * 1024, P.WoutT, 512, 8, 8, EP, 1024, 1 << 30, 0, 0, 1024, 4, 512);
    const int c = blockIdx.x;
    if (c >= 64) {
      const int b0 = 12000 + (c - 64) * 109;
      convert_rows_fp6(P, 0, b0 < 32768 ? b0 : 32768, b0 + 109 < 32768 ? b0 + 109 : 32768);
    }
  }
}

struct EpiQP {
  bf16* QP;
  DEVI void operator()(const f32x4 (&acc)[2][2][4][2], const G8Unit& u, int wr, int wc, int fr, int fq) const {
    const int brow = u.pm * 256, bcol = u.pn * 256;
#pragma unroll
    for (int ai = 0; ai < 2; ++ai)
#pragma unroll
      for (int m = 0; m < 4; ++m) {
        const int row = brow + ai * 128 + wr * 64 + m * 16 + fr;
#pragma unroll
        for (int bj = 0; bj < 2; ++bj) {
          const int col = bcol + bj * 128 + wc * 32 + 8 * fq;
          const f32x4 v0 = acc[ai][bj][m][0], v1 = acc[ai][bj][m][1];
          *reinterpret_cast<uint4*>(QP + (size_t)row * 2048 + col) = make_uint4(pack2(v0[0], v0[1]), pack2(v0[2], v0[3]), pack2(v1[0], v1[1]), pack2(v1[2], v1[3]));
        }
      }
  }
};
DEVI void phase_gemm3_8(const Params& P, int l, unsigned char* smem_base) {
  EpiQP E{P.QP};
  gemm8_phase((LAS unsigned char*)smem_base, P.H, P.WpqT + (size_t)l * 2048 * 1024, 1024, (l == 1) ? NL / 256 : NT / 256, 8, E);
  const int c = blockIdx.x;
  if (l == 0 && c >= 64) convert_rows_fp6(P, 1, (c - 64) * 100, (c - 64) * 100 + 100);
}

constexpr int N_PHASES = 2 + 2 * 11;

#ifndef REP_MASK
#define REP_MASK 0
#endif
static_assert(sizeof(Params) % 8 == 0, "Params size");
DEVI Params load_params() {
#if defined(__HIP_DEVICE_COMPILE__)
  typedef const __attribute__((address_space(4))) Params* ParamsCP;
  ParamsCP pp = (ParamsCP)__builtin_amdgcn_kernarg_segment_ptr();
  asm volatile("" : "+s"(pp));
  return *pp;
#else
  return Params{};
#endif
}
__global__ void __launch_bounds__(512, 2) fwd_kernel(Params Pk) {
  extern __shared__ __attribute__((aligned(16))) unsigned char smem_base[];
  volatile LAS unsigned* xst = (volatile LAS unsigned*)(smem_base + SMEM_BYTES);
  if (threadIdx.x == 0) { xst[0] = 0u; xst[1] = 0u; xst[2] = 0u; xst[3] = 0u; }
  __syncthreads();
  XcdBarrier xb = xcd_barrier_post(Pk.bar, xst);
  const int phase_lo = Pk.phase_lo, phase_hi = Pk.phase_hi, coop = Pk.coop;
#define smem (smem_base + VHALF * HALF_LDS)
#define GSYNC(idx) { xcd_barrier(xb); }
#define RUN_PHASE2(idx, call, repcall) \
  if (phase_lo <= (idx) && (idx) <= phase_hi) { { const Params P = load_params(); call; } if (REP_MASK & (1 << (idx))) { GSYNC(1); const Params P = load_params(); repcall; } if (coop && (idx) < phase_hi) GSYNC(idx); }
#define RUN_PHASE(idx, call) RUN_PHASE2(idx, call, call)
  RUN_PHASE(0, phase_prologue(P, smem))
  RUN_PHASE(1, phase_norm(P, 0, 0, NT))
  RUN_PHASE(2, phase_gemm1_8(P, 0, smem_base))
  RUN_PHASE(3, phase_mla_raw(P, 0, smem_base))
  RUN_PHASE(4, { phase_mixA(P, 0, smem); phase_mla_proj(P, 0, smem); phase_hgrn_local(P, 0, smem); })
  RUN_PHASE2(5, phase_attn_scan(P, 0, smem_base), phase_attn_scan(P, 0, smem_base, true))
  RUN_PHASE(6, phase_hgrn_final(P, 0, smem))
  RUN_PHASE(7, phase_gemm2_8(P, 0, smem_base))
  RUN_PHASE(8, phase_norm(P, 0, 1, NT))
  RUN_PHASE(9, phase_gemm3_8(P, 0, smem_base))
  RUN_PHASE(10, phase_route(P, 0, smem))
  RUN_PHASE(11, phase_peer_u(P, 0))
  RUN_PHASE(12, phase_peer(P, 0))
  RUN_PHASE(13, phase_gemm1_8(P, 1, smem_base))
  RUN_PHASE(14, phase_mla_raw(P, 1, smem_base))
  RUN_PHASE(15, { phase_mixA(P, 1, smem); phase_mla_proj(P, 1, smem); phase_hgrn_local(P, 1, smem); })
  RUN_PHASE2(16, phase_attn_scan(P, 1, smem_base), phase_attn_scan(P, 1, smem_base, true))
  RUN_PHASE(17, phase_hgrn_final(P, 1, smem))
  RUN_PHASE(18, phase_gemm2_8(P, 1, smem_base))
  RUN_PHASE(19, phase_norm(P, 1, 1, NL))
  RUN_PHASE(20, phase_gemm3_8(P, 1, smem_base))
  RUN_PHASE(21, phase_route(P, 1, smem))
  RUN_PHASE(22, phase_peer_u(P, 1))
  RUN_PHASE(23, phase_peer(P, 1))
#undef smem
}

extern "C" void kernel_launch(void* const* d_in, const int* in_sizes, int n_in, void* d_out, int out_size, void* d_ws,
                              size_t ws_size, hipStream_t stream) {
  Params p{};
  const float* const* in = reinterpret_cast<const float* const*>(d_in);
  p.x = in[0]; p.c = in[1]; p.ctx = in[2]; p.c_ctx = in[3]; p.ln1_w = in[4]; p.ln2_w = in[5]; p.w_mod = in[6]; p.b_mod = in[7];
  p.w_in = in[8]; p.w_out = in[9]; p.a_norm_w = in[10]; p.a_w_s = in[11]; p.a_b_s = in[12]; p.b_q_norm_w = in[13]; p.b_w_uq = in[14];
  p.b_kv_norm_w = in[15]; p.b_w_ukv = in[16]; p.b_qh_w = in[17]; p.b_kh_w = in[18]; p.c_lb = in[19]; p.c_out_norm_w = in[20];
  p.p_w_q = in[21]; p.p_sub_keys = in[22]; p.p_u = in[23]; p.p_v = in[24];
  p.out = reinterpret_cast<float*>(d_out);
  unsigned char* ws = reinterpret_cast<unsigned char*>(d_ws);
  size_t off = 0;
  auto take = [&](size_t bytes) { unsigned char* r = ws + off; off += (bytes + 255) & ~(size_t)255; return r; };
  p.bar = (unsigned*)take((size_t)XCD_BAR_WORDS * 4);
  p.MOD = (float*)take((size_t)2 * 9 * 6144 * 4);
  p.ROPE = (float*)take((size_t)2048 * 32 * 4);
  p.WinT = (bf16*)take((size_t)2 * DINP * 1024 * 2);
  p.WoutT = (bf16*)take((size_t)2 * 1024 * 1024 * 2);
  p.WpqT = (bf16*)take((size_t)2 * 2048 * 1024 * 2);
  p.WCOMB = (bf16*)take((size_t)2 * 1792 * 256 * 2);
  p.RAW = (bf16*)take((size_t)NT * 1792 * 2);
  p.SK = (bf16*)take((size_t)2 * 16 * 128 * 128 * 2);
  p.AWS = (bf16*)take((size_t)2 * 4 * 128 * 128 * 2);
  p.PU8 = (unsigned char*)take((size_t)2 * 16384 * 576);
  p.PV8 = (unsigned char*)take((size_t)2 * 16384 * 576);
  p.PUS = (float*)take((size_t)2 * 16384 * 4);
  p.PVS = (float*)take((size_t)2 * 16384 * 4);
  p.X = (bf16*)take((size_t)NT * 1024 * 2);
  p.H = (bf16*)take((size_t)NT * 1024 * 2);
  p.Z = (bf16*)take((size_t)NT * DIN * 2);
  p.Q = (bf16*)take((size_t)64 * SEQP * 96 * 2);
  p.K = (bf16*)take((size_t)64 * SEQP * 96 * 2);
  p.VT = (bf16*)take((size_t)64 * 64 * SEQP * 2);
  p.ST = (bf16*)take((size_t)64 * 36 * 4096 * 2);
  p.DEC = (float*)take((size_t)64 * 36 * 64 * 4);
  p.OI = (bf16*)take((size_t)NT * 256 * 2);
  p.WPE = (float*)take((size_t)NT * 128 * 4);
  p.PART = (float*)take((size_t)2 * 2048 * 1024 * 4);
  p.GQF = (bf16*)take((size_t)NT * 256 * 2);
  p.GQB = (bf16*)take((size_t)NT * 256 * 2);
  p.QP = p.Z;
  p.EIDX = (int*)p.Q;
  p.GATE = (float*)p.K;
  if (off > ws_size) { fprintf(stderr, "workspace too small: need %zu have %zu\n", off, ws_size); }
  static int grid_blocks = 0;
  if (!grid_blocks) {
    if (hipFuncSetAttribute((const void*)fwd_kernel, hipFuncAttributeMaxDynamicSharedMemorySize, SMEM_TOTAL) != hipSuccess)
      fprintf(stderr, "hipFuncSetAttribute failed\n");
    int dev = 0, cus = 0, per_cu = 0;
    hipGetDevice(&dev);
    hipDeviceGetAttribute(&cus, hipDeviceAttributeMultiprocessorCount, dev);
    hipOccupancyMaxActiveBlocksPerMultiprocessor(&per_cu, (const void*)fwd_kernel, 512, SMEM_TOTAL);
    if (per_cu > 1) per_cu = 1;
    if (per_cu < 1) { fprintf(stderr, "occupancy query returned %d\n", per_cu); per_cu = 1; }
    grid_blocks = cus * per_cu;
    fprintf(stderr, "grid_blocks=%d (cus=%d per_cu=%d) ws need=%zu have=%zu\n", grid_blocks, cus, per_cu, off, ws_size);
  }
  hipMemsetAsync(p.bar, 0, (size_t)XCD_BAR_WORDS * 4, stream);
  p.coop = 1; p.phase_lo = 0; p.phase_hi = N_PHASES - 1;
  hipLaunchKernelGGL(fwd_kernel, dim3(grid_blocks), dim3(512), SMEM_TOTAL, stream, p);
  const hipError_t e = hipPeekAtLastError();
  if (e != hipSuccess) fprintf(stderr, "launch failed: %s (grid %d)\n", hipGetErrorString(e), grid_blocks);
}
```

```cpp
#include <hip/hip_runtime.h>
#include <hip/hip_cooperative_groups.h>
#include <cstdio>
#include <cstdint>
namespace cg = cooperative_groups;

#define DEVI __device__ __forceinline__

typedef unsigned short bf16;
using bf16x8 = __attribute__((ext_vector_type(8))) __bf16;
using bf16x2 = __attribute__((ext_vector_type(2))) __bf16;
using f32x16 = __attribute__((ext_vector_type(16))) float;
typedef unsigned v6u __attribute__((ext_vector_type(6)));
typedef unsigned v3u __attribute__((ext_vector_type(3)));
typedef float v16f __attribute__((ext_vector_type(16)));
typedef float v32f __attribute__((ext_vector_type(32)));

constexpr int NL = 16384;
constexpr int NT = 18432;
constexpr int DM = 1024;
constexpr int DIN = 2208;
constexpr int DINP = 2304;
constexpr int SEQP = 2304;
constexpr float EPS = 1e-6f;
constexpr int ZC_AU = 0, ZC_AV = 256, ZC_BQ = 512, ZC_BKV = 768, ZC_BKR = 896, ZC_CQ = 928, ZC_CFF = 1184, ZC_CFB = 1440, ZC_CI = 1696, ZC_CG = 1952;
constexpr int SMEM_BYTES = 2 * 80896;
constexpr int SMEM_TOTAL = SMEM_BYTES + 16;

struct Params {
  const float *x, *c, *ctx, *c_ctx, *ln1_w, *ln2_w, *w_mod, *b_mod, *w_in, *w_out, *a_norm_w, *a_w_s, *a_b_s;
  const float *b_q_norm_w, *b_w_uq, *b_kv_norm_w, *b_w_ukv, *b_qh_w, *b_kh_w, *c_lb, *c_out_norm_w, *p_w_q, *p_sub_keys, *p_u, *p_v;
  float* out;
  unsigned* bar;
  float* MOD;
  float* ROPE;
  bf16* WinT;
  bf16* WoutT;
  bf16* WpqT;
  bf16* WCOMB;
  bf16* RAW;
  bf16* SK;
  bf16* AWS;
  unsigned char* PU8;
  unsigned char* PV8;
  float* PUS;
  float* PVS;
  bf16* X;
  bf16* H;
  bf16* Z;
  bf16* Q;
  bf16* K;
  bf16* VT;
  bf16* ST;
  float* DEC;
  bf16* OI;
  float* WPE;
  float* RS;
  float* PART;
  bf16* GQF;
  bf16* GQB;
  bf16* QP;
  int* EIDX;
  float* GATE;
  int phase_lo, phase_hi, coop, pad0;
};

DEVI float bf2f(bf16 v) { return __uint_as_float(((unsigned)v) << 16); }
DEVI bf16 f2bf(float a) { __bf16 v = (__bf16)a; return __builtin_bit_cast(unsigned short, v); }
DEVI unsigned pack2(float a, float b) { bf16x2 v; v[0] = (__bf16)a; v[1] = (__bf16)b; return __builtin_bit_cast(unsigned, v); }
DEVI float lo2f(unsigned u) { return __uint_as_float(u << 16); }
DEVI float hi2f(unsigned u) { return __uint_as_float(u & 0xffff0000u); }
DEVI f32x16 zero16() { f32x16 z;
#pragma unroll
  for (int i = 0; i < 16; ++i) z[i] = 0.f; return z; }
DEVI f32x16 mfma32(bf16x8 a, bf16x8 b, f32x16 c) { return __builtin_amdgcn_mfma_f32_32x32x16_bf16(a, b, c, 0, 0, 0); }
DEVI bf16x8 ldfrag(const bf16* p) { return *reinterpret_cast<const bf16x8*>(p); }
DEVI int drow(int r, int hh) { return (r & 3) + 8 * (r >> 2) + 4 * hh; }
DEVI int row_of(int b, int p) { return p < 256 ? NL + b * 256 + p : b * 2048 + (p - 256); }
DEVI int batch_of_row(int r) { return r < NL ? (r >> 11) : 8; }
DEVI float wave_sum(float v) {
#pragma unroll
  for (int o = 32; o > 0; o >>= 1) v += __shfl_xor(v, o);
  return v;
}
DEVI float sigmoidf_(float z) { return 1.f / (1.f + __expf(-z)); }


#define XB_TMO      128
#define XB_XCNT(j)  (256  + 64 * (j))
#define XB_XSUB(j)  (1280 + 64 * (j))
#define XB_XGEN(j)  (2304 + 64 * (j))
#define XB_TOP      3328
#define XB_TOPGEN   3392
#define XCD_BAR_WORDS 3456
#define XB_SPIN_CAP (1u << 22)
#define LAS __attribute__((address_space(3)))
DEVI unsigned xb_ld(unsigned* p)              { return __hip_atomic_load(p, __ATOMIC_RELAXED, __HIP_MEMORY_SCOPE_AGENT); }
DEVI unsigned xb_add(unsigned* p, unsigned v) { return __hip_atomic_fetch_add(p, v, __ATOMIC_RELAXED, __HIP_MEMORY_SCOPE_AGENT); }
DEVI unsigned xb_xcc_id() { return (unsigned)__builtin_amdgcn_s_getreg((3 << 11) | 20) & 0xFu; }
#define XB_SPIN(cond, bar) do { unsigned _sp = 0; while (cond) { __builtin_amdgcn_s_sleep(1); \
    if ((++_sp & 255u) == 0u) { if (xb_ld(&(bar)[XB_TMO])) break; if (_sp > XB_SPIN_CAP) { atomicAdd(&(bar)[XB_TMO], 1u); break; } } } } while (0)
struct XcdBarrier { unsigned* bar; unsigned x; volatile LAS unsigned* st; };
DEVI XcdBarrier xcd_barrier_post(unsigned* bar, volatile LAS unsigned* st) {
  XcdBarrier b; b.bar = bar; b.x = xb_xcc_id(); b.st = st;
  if (threadIdx.x == 0) (void)xb_add(&bar[XB_XCNT(b.x)], 1u);
  return b;
}
DEVI void xcd_barrier_complete(unsigned* bar, unsigned x, unsigned& nloc, unsigned& nx) {
  const unsigned G = gridDim.x * gridDim.y * gridDim.z;
  unsigned sum, cnt, mine, sp = 0u;
  for (;;) {
    sum = 0u; cnt = 0u; mine = 0u;
#pragma unroll
    for (unsigned j = 0; j < 16; ++j) { const unsigned c = xb_ld(&bar[XB_XCNT(j)]); sum += c; cnt += (c > 0u) ? 1u : 0u; mine = (j == x) ? c : mine; }
    if (sum == G) break;
    __builtin_amdgcn_s_sleep(1);
    if ((++sp & 255u) == 0u) { if (xb_ld(&bar[XB_TMO])) break; if (sp > XB_SPIN_CAP) { atomicAdd(&bar[XB_TMO], 1u); break; } }
  }
  nloc = mine > 0u ? mine : 1u; nx = cnt > 0u ? cnt : 1u;
}
DEVI void xcd_barrier(const XcdBarrier& b) {
  asm volatile("s_waitcnt vmcnt(0)" ::: "memory");
  __syncthreads();
  if (threadIdx.x == 0) {
    unsigned* bar = b.bar;
    __builtin_amdgcn_s_waitcnt(0);
    unsigned nloc = b.st[0], nx = b.st[1];
    if (nloc == 0u) { xcd_barrier_complete(bar, b.x, nloc, nx); b.st[0] = nloc; b.st[1] = nx; }
    const unsigned old = xb_add(&bar[XB_XSUB(b.x)], 1u);
    const unsigned gen = old / nloc;
    if (old + 1u == (gen + 1u) * nloc) {
      __builtin_amdgcn_fence(__ATOMIC_RELEASE, "agent");
      asm volatile("s_waitcnt vmcnt(0)" ::: "memory");
      const unsigned og = xb_add(&bar[XB_TOP], 1u);
      const unsigned tg = og / nx;
      if (og + 1u == (tg + 1u) * nx) xb_add(&bar[XB_TOPGEN], 1u);
      else XB_SPIN(xb_ld(&bar[XB_TOPGEN]) == tg, bar);
      __builtin_amdgcn_fence(__ATOMIC_ACQUIRE, "agent");
      xb_add(&bar[XB_XGEN(b.x)], 1u);
      asm volatile("s_waitcnt vmcnt(0)" ::: "memory");
    } else {
      XB_SPIN(xb_ld(&bar[XB_XGEN(b.x)]) == gen, bar);
      __builtin_amdgcn_fence(__ATOMIC_ACQUIRE, "agent");
      asm volatile("s_waitcnt vmcnt(0)" ::: "memory");
    }
  }
  __syncthreads();
}

#define VHALF ((int)__builtin_amdgcn_readfirstlane((int)(threadIdx.x >> 8)))
#define TIDX ((int)(threadIdx.x & 255))
#define VBID ((int)(blockIdx.x * 2 + VHALF))
#define NVB ((int)(gridDim.x * 2))
constexpr int HALF_LDS = 80896;

DEVI void phase_mod(const Params& P, unsigned char* smem) {
  const int tid = TIDX;
  float* s = (float*)smem;
  float* red = s + 9 * 1024;
  for (int item = VBID; item < 192; item += NVB) {
    const int l = item / 96, j = item % 96;
    __syncthreads();
    for (int i = tid; i < 9 * 1024; i += 256) {
      int bi = i >> 10, k = i & 1023;
      float v = bi < 8 ? P.c[bi * 1024 + k] : P.c_ctx[k];
      s[i] = v * sigmoidf_(v);
    }
    __syncthreads();
    const int c4 = tid & 15, kg = tid >> 4;
    float acc[9][4];
#pragma unroll
    for (int bi = 0; bi < 9; ++bi) { acc[bi][0] = acc[bi][1] = acc[bi][2] = acc[bi][3] = 0.f; }
    const float* w = P.w_mod + (size_t)l * 1024 * 6144 + j * 64 + c4 * 4;
#pragma unroll 4
    for (int kk = 0; kk < 64; ++kk) {
      const int k = kg * 64 + kk;
      const float4 w4 = *reinterpret_cast<const float4*>(w + (size_t)k * 6144);
#pragma unroll
      for (int bi = 0; bi < 9; ++bi) {
        const float sv = s[bi * 1024 + k];
        acc[bi][0] += sv * w4.x; acc[bi][1] += sv * w4.y; acc[bi][2] += sv * w4.z; acc[bi][3] += sv * w4.w;
      }
    }
#pragma unroll
    for (int bi = 0; bi < 9; ++bi)
#pragma unroll
      for (int e = 0; e < 4; ++e) red[(kg * 9 + bi) * 64 + c4 * 4 + e] = acc[bi][e];
    __syncthreads();
    for (int o = tid; o < 576; o += 256) {
      const int bi = o >> 6, cc = o & 63;
      float sum = 0.f;
#pragma unroll
      for (int g = 0; g < 16; ++g) sum += red[(g * 9 + bi) * 64 + cc];
      P.MOD[(size_t)(l * 9 + bi) * 6144 + j * 64 + cc] = sum + P.b_mod[l * 6144 + j * 64 + cc];
    }
  }
}

DEVI void conv_T_tile(const float* __restrict__ src, int N, bf16* __restrict__ dst, int Kd, int k0, int n0,
                      const float* __restrict__ kscale, float* tile) {
  const int tid = TIDX;
  __syncthreads();
  for (int e = tid; e < 4096; e += 256) {
    const int i = e >> 6, j = e & 63, n = n0 + j;
    float v = (n < N) ? src[(size_t)(k0 + i) * N + n] : 0.f;
    if (kscale) v *= kscale[k0 + i];
    tile[i * 65 + j] = v;
  }
  __syncthreads();
  for (int e = tid; e < 2048; e += 256) {
    const int j = e >> 5, i2 = (e & 31) * 2;
    const unsigned pk = pack2(tile[i2 * 65 + j], tile[(i2 + 1) * 65 + j]);
    *reinterpret_cast<unsigned*>(&dst[(size_t)(n0 + j) * Kd + k0 + i2]) = pk;
  }
}

DEVI void conv_straight(const float* __restrict__ src, bf16* __restrict__ dst, size_t n8) {
  const size_t stride = (size_t)NVB * 256;
  for (size_t i = (size_t)VBID * 256 + TIDX; i < n8; i += stride) {
    const float4 a = reinterpret_cast<const float4*>(src)[2 * i];
    const float4 b = reinterpret_cast<const float4*>(src)[2 * i + 1];
    uint4 o; o.x = pack2(a.x, a.y); o.y = pack2(a.z, a.w); o.z = pack2(b.x, b.y); o.w = pack2(b.z, b.w);
    reinterpret_cast<uint4*>(dst)[i] = o;
  }
}

DEVI void convert_rows_fp6(const Params& P, int L, int i0, int i1) {
  const int lane = threadIdx.x & 63, half = lane >> 5, l32 = lane & 31;
  const int wv = threadIdx.x >> 6;
  for (int ib = i0 + wv * 2; ib < i1; ib += 16) {
    int i = ib + half; const bool live = i < i1; if (!live) i = i1 - 1;
    const int table = i >> 14, lr = L * 16384 + (i & 16383);
    const float* src = (table ? P.p_v : P.p_u) + (size_t)lr * 1024 + l32 * 32;
    float4 a[8];
    float m = 0.f;
#pragma unroll
    for (int q = 0; q < 8; ++q) {
      a[q] = *reinterpret_cast<const float4*>(src + q * 4);
      m = fmaxf(m, fmaxf(fmaxf(fabsf(a[q].x), fabsf(a[q].y)), fmaxf(fabsf(a[q].z), fabsf(a[q].w))));
    }
    const unsigned sb = (__float_as_uint(fmaxf(m, 1e-30f) * (1.f / 6.f)) + 0xffffu) >> 16;
    const float inv = 1.f / __uint_as_float(sb << 16);
    unsigned pk[4];
#pragma unroll
    for (int w = 0; w < 4; ++w) {
      unsigned word = 0u;
#pragma unroll
      for (int e = 0; e < 8; ++e) {
        const int idx = w * 8 + e;
        const float4 q4 = a[idx >> 2];
        const float xv = ((idx & 3) == 0 ? q4.x : (idx & 3) == 1 ? q4.y : (idx & 3) == 2 ? q4.z : q4.w) * inv;
        const float av = fabsf(xv);
        unsigned ci = (av > 0.25f) + (av > 0.75f) + (av > 1.25f) + (av > 1.75f) + (av > 2.5f) + (av > 3.5f) + (av > 5.f);
        ci |= (xv < 0.f) ? 8u : 0u;
        word |= ci << (4 * e);
      }
      pk[w] = word;
    }
    unsigned char* rowp = (table ? P.PV8 : P.PU8) + (size_t)lr * 576;
    if (live) {
      *reinterpret_cast<uint4*>(rowp + l32 * 16) = make_uint4(pk[0], pk[1], pk[2], pk[3]);
      *reinterpret_cast<unsigned short*>(rowp + 512 + l32 * 2) = (unsigned short)sb;
    }
  }
}

DEVI void phase_prologue(const Params& P, unsigned char* smem) {
  phase_mod(P, smem);
  float* tile = (float*)smem;
  for (int it = VBID; it < 2 * 1424; it += NVB) {
    const int l = it / 1424; int r = it % 1424;
    if (r < 576) { conv_T_tile(P.w_in + (size_t)l * 1024 * DIN, DIN, P.WinT + (size_t)l * DINP * 1024, 1024, (r % 16) * 64, (r / 16) * 64, nullptr, tile); continue; }
    r -= 576;
    if (r < 256) { conv_T_tile(P.w_out + (size_t)l * 1024 * 1024, 1024, P.WoutT + (size_t)l * 1024 * 1024, 1024, (r % 16) * 64, (r / 16) * 64, nullptr, tile); continue; }
    r -= 256;
    if (r < 512) { conv_T_tile(P.p_w_q + (size_t)l * 1024 * 2048, 2048, P.WpqT + (size_t)l * 2048 * 1024, 1024, (r % 16) * 64, (r / 16) * 64, nullptr, tile); continue; }
    r -= 512;
    if (r < 48) { conv_T_tile(P.b_w_uq + (size_t)l * 256 * 768, 768, P.WCOMB + (size_t)l * 1792 * 256, 256, (r % 4) * 64, (r / 4) * 64, P.b_q_norm_w + l * 256, tile); continue; }
    r -= 48;
    conv_T_tile(P.b_w_ukv + (size_t)l * 128 * 1024, 1024, P.WCOMB + (size_t)l * 1792 * 256 + 768 * 256, 256, (r % 2) * 64, (r / 2) * 64, P.b_kv_norm_w + l * 128, tile);
  }
  for (int i = VBID * 256 + TIDX; i < 2 * 1024 * 16; i += NVB * 256) {
    const int l2 = i >> 14, rr = (i >> 4) & 1023, cc = i & 15;
    *reinterpret_cast<uint4*>(P.WCOMB + (size_t)l2 * 1792 * 256 + (size_t)(768 + rr) * 256 + 128 + cc * 8) = make_uint4(0u, 0u, 0u, 0u);
  }
  conv_straight(P.p_sub_keys, P.SK, (size_t)2 * 16 * 128 * 128 / 8);
  conv_straight(P.a_w_s, P.AWS, (size_t)2 * 4 * 128 * 128 / 8);
  for (int i = VBID * 256 + TIDX; i < 2048 * 16; i += NVB * 256) {
    const int t = i >> 4, a = (i >> 3) & 1, f = i & 7;
    const float inv = powf(10000.f, -(float)f / 8.f);
    const float pos = a ? (float)(t & 63) : (float)(t >> 6);
    const float ang = pos * inv;
    P.ROPE[t * 32 + a * 8 + f] = cosf(ang);
    P.ROPE[t * 32 + 16 + a * 8 + f] = sinf(ang);
  }
}

DEVI void phase_norm(const Params& P, int l, int which, int nrows) {
  const int lane = TIDX & 63;
  const int gw = VBID * 4 + (TIDX >> 6), nw = NVB * 4;
  const float* lnw = (which == 0 ? P.ln1_w : P.ln2_w) + l * 1024;
  for (int r = gw; r < nrows; r += nw) {
    const float* mod = P.MOD + (size_t)(l * 9 + batch_of_row(r)) * 6144 + which * 3072;
    float4 v[4];
    float ss = 0.f;
    if (which == 0 && l == 0) {
      const float* src = r < NL ? P.x + (size_t)r * 1024 : P.ctx + (size_t)(r - NL) * 1024;
#pragma unroll
      for (int i = 0; i < 4; ++i) v[i] = *reinterpret_cast<const float4*>(src + i * 256 + lane * 4);
    } else if (which == 1 && l == 0 && r >= NL) {
      const float* cin = P.ctx + (size_t)(r - NL) * 1024;
      const float* p0 = P.PART + (size_t)(r - NL) * 1024;
      const float* p1 = p0 + (size_t)2048 * 1024;
      const float* gate = P.MOD + (size_t)8 * 6144 + 2048;
#pragma unroll
      for (int i = 0; i < 4; ++i) {
        const int d = i * 256 + lane * 4;
        const float4 c4 = *reinterpret_cast<const float4*>(cin + d), a4 = *reinterpret_cast<const float4*>(p0 + d), b4 = *reinterpret_cast<const float4*>(p1 + d);
        const float4 g4 = *reinterpret_cast<const float4*>(gate + d);
        v[i] = make_float4(c4.x + g4.x * (a4.x + b4.x), c4.y + g4.y * (a4.y + b4.y), c4.z + g4.z * (a4.z + b4.z), c4.w + g4.w * (a4.w + b4.w));
        *reinterpret_cast<uint2*>(P.X + (size_t)r * 1024 + d) = make_uint2(pack2(v[i].x, v[i].y), pack2(v[i].z, v[i].w));
      }
    } else {
      const bf16* src = P.X + (size_t)r * 1024;
#pragma unroll
      for (int i = 0; i < 4; ++i) {
        const uint2 u = *reinterpret_cast<const uint2*>(src + i * 256 + lane * 4);
        v[i] = make_float4(lo2f(u.x), hi2f(u.x), lo2f(u.y), hi2f(u.y));
      }
    }
#pragma unroll
    for (int i = 0; i < 4; ++i) ss += v[i].x * v[i].x + v[i].y * v[i].y + v[i].z * v[i].z + v[i].w * v[i].w;
    ss = wave_sum(ss);
    const float rr = rsqrtf(ss * (1.f / 1024.f) + EPS);
#pragma unroll
    for (int i = 0; i < 4; ++i) {
      const int d = i * 256 + lane * 4;
      const float4 w = *reinterpret_cast<const float4*>(lnw + d);
      const float4 sh = *reinterpret_cast<const float4*>(mod + d);
      const float4 sc = *reinterpret_cast<const float4*>(mod + 1024 + d);
      const float o0 = v[i].x * rr * w.x * (1.f + sc.x) + sh.x;
      const float o1 = v[i].y * rr * w.y * (1.f + sc.y) + sh.y;
      const float o2 = v[i].z * rr * w.z * (1.f + sc.z) + sh.z;
      const float o3 = v[i].w * rr * w.w * (1.f + sc.w) + sh.w;
      uint2 o; o.x = pack2(o0, o1); o.y = pack2(o2, o3);
      *reinterpret_cast<uint2*>(P.H + (size_t)r * 1024 + d) = o;
    }
  }
}

template <int BM, int BN, int BK, int WM, int WN>
struct Gemm {
  static constexpr int LDK = BK + 8;
  static constexpr int TM = BM / WM / 32, TN = BN / WN / 32;
  static constexpr int CPR = BK / 8;
  static constexpr int NA = BM * CPR / 256, NB = BN * CPR / 256;
  static constexpr int A_BYTES = BM * LDK * 2, B_BYTES = BN * LDK * 2;
  static constexpr int STAGE_BYTES = A_BYTES + B_BYTES;
  static constexpr int SMEM = 2 * STAGE_BYTES;

  static DEVI void run(const bf16* __restrict__ A, int lda, const bf16* __restrict__ BT, int ldb, int K,
                       unsigned char* smem, f32x16 (&acc)[TM][TN]) {
    const int tid = TIDX, lane = tid & 63, wave = tid >> 6;
    const int wm = wave / WN, wn = wave % WN;
    const int l31 = lane & 31, hh = lane >> 5;
#pragma unroll
    for (int i = 0; i < TM; ++i)
#pragma unroll
      for (int j = 0; j < TN; ++j) acc[i][j] = zero16();
    uint4 ra[NA], rb[NB];
    const int nk = K / BK;
    auto gload = [&](int kt) {
#pragma unroll
      for (int i = 0; i < NA; ++i) { const int ch = tid + i * 256, row = ch / CPR, cc = ch % CPR;
        ra[i] = *reinterpret_cast<const uint4*>(A + (size_t)row * lda + kt * BK + cc * 8); }
#pragma unroll
      for (int i = 0; i < NB; ++i) { const int ch = tid + i * 256, row = ch / CPR, cc = ch % CPR;
        rb[i] = *reinterpret_cast<const uint4*>(BT + (size_t)row * ldb + kt * BK + cc * 8); }
    };
    auto swrite = [&](int buf) {
      bf16* sA = reinterpret_cast<bf16*>(smem + buf * STAGE_BYTES);
      bf16* sB = reinterpret_cast<bf16*>(smem + buf * STAGE_BYTES + A_BYTES);
#pragma unroll
      for (int i = 0; i < NA; ++i) { const int ch = tid + i * 256, row = ch / CPR, cc = ch % CPR;
        *reinterpret_cast<uint4*>(sA + row * LDK + cc * 8) = ra[i]; }
#pragma unroll
      for (int i = 0; i < NB; ++i) { const int ch = tid + i * 256, row = ch / CPR, cc = ch % CPR;
        *reinterpret_cast<uint4*>(sB + row * LDK + cc * 8) = rb[i]; }
    };
    __syncthreads();
    gload(0);
    swrite(0);
    __syncthreads();
    for (int kt = 0; kt < nk; ++kt) {
      const int cur = kt & 1;
      if (kt + 1 < nk) gload(kt + 1);
      const bf16* sA = reinterpret_cast<const bf16*>(smem + cur * STAGE_BYTES);
      const bf16* sB = reinterpret_cast<const bf16*>(smem + cur * STAGE_BYTES + A_BYTES);
#pragma unroll
      for (int ks = 0; ks < BK / 16; ++ks) {
        bf16x8 af[TM], bfr[TN];
#pragma unroll
        for (int i = 0; i < TM; ++i) af[i] = ldfrag(sA + (wm * (BM / WM) + i * 32 + l31) * LDK + ks * 16 + hh * 8);
#pragma unroll
        for (int j = 0; j < TN; ++j) bfr[j] = ldfrag(sB + (wn * (BN / WN) + j * 32 + l31) * LDK + ks * 16 + hh * 8);
#pragma unroll
        for (int i = 0; i < TM; ++i)
#pragma unroll
          for (int j = 0; j < TN; ++j) acc[i][j] = mfma32(af[i], bfr[j], acc[i][j]);
      }
      if (kt + 1 < nk) swrite(cur ^ 1);
      __syncthreads();
    }
  }
};

DEVI void phase_gemm1(const Params& P, int l, unsigned char* smem) {
  using G = Gemm<128, 128, 64, 2, 2>;
  const int lane = TIDX & 63, wave = TIDX >> 6, wm = wave >> 1, wn = wave & 1, l31 = lane & 31, hh = lane >> 5;
  const bf16* W = P.WinT + (size_t)l * DINP * 1024;
  for (int t = VBID; t < 144 * 18; t += NVB) {
    const int mt = t / 18, nt = t % 18;
    f32x16 acc[2][2];
    G::run(P.H + (size_t)mt * 128 * 1024, 1024, W + (size_t)nt * 128 * 1024, 1024, 1024, smem, acc);
#pragma unroll
    for (int i = 0; i < 2; ++i)
#pragma unroll
      for (int j = 0; j < 2; ++j) {
        const int col = nt * 128 + wn * 64 + j * 32 + l31;
        if (col < DIN) {
#pragma unroll
          for (int r = 0; r < 16; ++r) {
            const int row = mt * 128 + wm * 64 + i * 32 + drow(r, hh);
            P.Z[(size_t)row * DIN + col] = f2bf(acc[i][j][r]);
          }
        }
      }
  }
}

DEVI void phase_gemm2(const Params& P, int l, unsigned char* smem) {
  using G = Gemm<128, 128, 64, 2, 2>;
  const int lane = TIDX & 63, wave = TIDX >> 6, wm = wave >> 1, wn = wave & 1, l31 = lane & 31, hh = lane >> 5;
  const bf16* W = P.WoutT + (size_t)l * 1024 * 1024;
  const int mtiles = (l == 1) ? 128 : 144;
  for (int t = VBID; t < mtiles * 8; t += NVB) {
    const int mt = t / 8, nt = t % 8;
    f32x16 acc[2][2];
    G::run(P.H + (size_t)mt * 128 * 1024, 1024, W + (size_t)nt * 128 * 1024, 1024, 1024, smem, acc);
    const int bi = batch_of_row(mt * 128);
    const float* gate = P.MOD + (size_t)(l * 9 + bi) * 6144 + 2048;
#pragma unroll
    for (int i = 0; i < 2; ++i)
#pragma unroll
      for (int j = 0; j < 2; ++j) {
        const int col = nt * 128 + wn * 64 + j * 32 + l31;
        const float g = gate[col];
#pragma unroll
        for (int r = 0; r < 16; ++r) {
          const int row = mt * 128 + wm * 64 + i * 32 + drow(r, hh);
          float res;
          if (l == 0) res = row < NL ? P.x[(size_t)row * 1024 + col] : P.ctx[(size_t)(row - NL) * 1024 + col];
          else res = bf2f(P.X[(size_t)row * 1024 + col]);
          P.X[(size_t)row * 1024 + col] = f2bf(res + g * acc[i][j][r]);
        }
      }
  }
}

DEVI void phase_mixA(const Params& P, int l, unsigned char* smem) {
  const int tid = TIDX, lane = tid & 63, wave = tid >> 6, l31 = lane & 31, hh = lane >> 5;
  bf16* VNT = reinterpret_cast<bf16*>(smem);
  constexpr int LDV = 136;
  const int nseg = (l == 1) ? 16 : 18;
  const int seg0 = (l == 1) ? 2 : 0;
  for (int it = VBID; it < 8 * nseg * 4; it += NVB) {
    const int a = it & 3; const int sj = (it >> 2) % nseg + seg0; const int b = (it >> 2) / nseg;
    const int p0 = sj * 128;
    __syncthreads();
    {
      const int q = tid >> 1, half = tid & 1;
      const int row = row_of(b, p0 + q);
      const bf16* src = P.Z + (size_t)row * DIN + ZC_AV + a * 64 + half * 32;
      float v[32];
      float ss = 0.f;
#pragma unroll
      for (int i = 0; i < 4; ++i) {
        const uint4 u = *reinterpret_cast<const uint4*>(src + i * 8);
        v[i * 8 + 0] = lo2f(u.x); v[i * 8 + 1] = hi2f(u.x); v[i * 8 + 2] = lo2f(u.y); v[i * 8 + 3] = hi2f(u.y);
        v[i * 8 + 4] = lo2f(u.z); v[i * 8 + 5] = hi2f(u.z); v[i * 8 + 6] = lo2f(u.w); v[i * 8 + 7] = hi2f(u.w);
      }
#pragma unroll
      for (int i = 0; i < 32; ++i) ss += v[i] * v[i];
      ss += __shfl_xor(ss, 1);
      const float rr = rsqrtf(ss * (1.f / 64.f) + EPS);
      const float* nw = P.a_norm_w + l * 256 + a * 64 + half * 32;
#pragma unroll
      for (int i = 0; i < 32; ++i) VNT[(half * 32 + i) * LDV + q] = f2bf(v[i] * rr * nw[i]);
    }
    __syncthreads();
    f32x16 acc[2]; acc[0] = zero16(); acc[1] = zero16();
    const bf16* Aw = P.AWS + (size_t)(l * 4 + a) * 128 * 128 + (size_t)(wave * 32 + l31) * 128;
#pragma unroll
    for (int ks = 0; ks < 8; ++ks) {
      const bf16x8 af = ldfrag(Aw + ks * 16 + hh * 8);
#pragma unroll
      for (int j = 0; j < 2; ++j) {
        const bf16x8 bfr = ldfrag(VNT + (j * 32 + l31) * LDV + ks * 16 + hh * 8);
        acc[j] = mfma32(af, bfr, acc[j]);
      }
    }
    const float* bs = P.a_b_s + (l * 4 + a) * 128;
#pragma unroll
    for (int j = 0; j < 2; ++j)
#pragma unroll
      for (int r = 0; r < 16; ++r) {
        const int p = wave * 32 + drow(r, hh);
        const int row = row_of(b, p0 + p);
        const int col = a * 64 + j * 32 + l31;
        const float u = bf2f(P.Z[(size_t)row * DIN + ZC_AU + col]);
        P.H[(size_t)row * 1024 + col] = f2bf(u * (acc[j][r] + bs[p]));
      }
  }
}

DEVI void mla_norm_rope_store(const Params& P, const float* T, const float* nw, bool rope, float oscale,
                              bf16* dstbase  , int pos0, int tlat0) {
  const int tid = TIDX, tok = tid >> 1, half = tid & 1;
  float v[48];
  float ss = 0.f;
#pragma unroll
  for (int i = 0; i < 48; ++i) { v[i] = T[tok * 97 + half * 48 + i]; ss += v[i] * v[i]; }
  ss += __shfl_xor(ss, 1);
  const float rr = rsqrtf(ss * (1.f / 96.f) + EPS);
#pragma unroll
  for (int i = 0; i < 48; ++i) v[i] = v[i] * rr * nw[half * 48 + i];
  if (rope && half == 1) {
    const float* cs = P.ROPE + (size_t)(tlat0 + tok) * 32;
#pragma unroll
    for (int a = 0; a < 2; ++a)
#pragma unroll
      for (int f = 0; f < 8; ++f) {
        const float x1 = v[16 + a * 16 + f], x2 = v[16 + a * 16 + 8 + f];
        const float c = cs[a * 8 + f], s = cs[16 + a * 8 + f];
        v[16 + a * 16 + f] = x1 * c - x2 * s;
        v[16 + a * 16 + 8 + f] = x2 * c + x1 * s;
      }
  }
  bf16* dst = dstbase + (size_t)(pos0 + tok) * 96 + half * 48;
#pragma unroll
  for (int i = 0; i < 6; ++i) {
    uint4 o;
    o.x = pack2(v[i * 8 + 0] * oscale, v[i * 8 + 1] * oscale); o.y = pack2(v[i * 8 + 2] * oscale, v[i * 8 + 3] * oscale);
    o.z = pack2(v[i * 8 + 4] * oscale, v[i * 8 + 5] * oscale); o.w = pack2(v[i * 8 + 6] * oscale, v[i * 8 + 7] * oscale);
    *reinterpret_cast<uint4*>(dst + i * 8) = o;
  }
}

DEVI void phase_mla_proj(const Params& P, int l, unsigned char* smem) {
  const int tid = TIDX;
  float* T = reinterpret_cast<float*>(smem);
  bf16* TV = reinterpret_cast<bf16*>(smem + 128 * 97 * 4);
  const float qscale = 0.10206207261596577f * 1.4426950408889634f;
  const int tok = tid >> 1, half = tid & 1;
  for (int it = (VBID + NVB - 64) % NVB; it < 144 * 8; it += NVB) {
    const int h = it & 7;
    const int m0 = (it >> 3) * 128;
    const bool lat = m0 < NL;
    const int b = lat ? (m0 >> 11) : ((m0 - NL) >> 8);
    const int pos0 = lat ? 256 + (m0 & 2047) : ((m0 - NL) & 255);
    const int tlat0 = lat ? (m0 & 2047) : 0;
    const bool doq = lat || (l == 0);
    const bf16* zr = P.Z + (size_t)(m0 + tok) * DIN;
    const bf16* rr = P.RAW + (size_t)(m0 + tok) * 1792;
    __syncthreads();
    const float rsq = P.RS[(size_t)(m0 + tok) * 2], rskv = P.RS[(size_t)(m0 + tok) * 2 + 1];
    {
      const bf16* kn = rr + 768 + h * 128 + half * 32;
      const bf16* vv = rr + 768 + h * 128 + 64 + half * 32;
#pragma unroll
      for (int i = 0; i < 4; ++i) {
        const uint4 u = *reinterpret_cast<const uint4*>(kn + i * 8);
        float* tp = T + tok * 97 + half * 32 + i * 8;
        tp[0] = lo2f(u.x) * rskv; tp[1] = hi2f(u.x) * rskv; tp[2] = lo2f(u.y) * rskv; tp[3] = hi2f(u.y) * rskv;
        tp[4] = lo2f(u.z) * rskv; tp[5] = hi2f(u.z) * rskv; tp[6] = lo2f(u.w) * rskv; tp[7] = hi2f(u.w) * rskv;
        const uint4 w = *reinterpret_cast<const uint4*>(vv + i * 8);
        bf16* vp = TV + (half * 32 + i * 8) * 136 + tok;
        vp[0 * 136] = f2bf(lo2f(w.x) * rskv); vp[1 * 136] = f2bf(hi2f(w.x) * rskv); vp[2 * 136] = f2bf(lo2f(w.y) * rskv); vp[3 * 136] = f2bf(hi2f(w.y) * rskv);
        vp[4 * 136] = f2bf(lo2f(w.z) * rskv); vp[5 * 136] = f2bf(hi2f(w.z) * rskv); vp[6 * 136] = f2bf(lo2f(w.w) * rskv); vp[7 * 136] = f2bf(hi2f(w.w) * rskv);
      }
#pragma unroll
      for (int i = 0; i < 2; ++i) {
        const uint4 u = *reinterpret_cast<const uint4*>(zr + ZC_BKR + half * 16 + i * 8);
        float* tp = T + tok * 97 + 64 + half * 16 + i * 8;
        tp[0] = lo2f(u.x); tp[1] = hi2f(u.x); tp[2] = lo2f(u.y); tp[3] = hi2f(u.y);
        tp[4] = lo2f(u.z); tp[5] = hi2f(u.z); tp[6] = lo2f(u.w); tp[7] = hi2f(u.w);
      }
    }
    __syncthreads();
    mla_norm_rope_store(P, T, P.b_kh_w + l * 96, lat, 1.f, P.K + (size_t)(b * 8 + h) * SEQP * 96, pos0, tlat0);
    {
      const int d = tid >> 2, qtr = tid & 3;
      bf16* dst = P.VT + ((size_t)(b * 8 + h) * 64 + d) * SEQP + pos0 + qtr * 32;
      const bf16* src = TV + d * 136 + qtr * 32;
#pragma unroll
      for (int i = 0; i < 4; ++i) {
        const uint4 v = *reinterpret_cast<const uint4*>(src + i * 8);
        const int g16 = (i >> 1) * 16, odd = i & 1;
        *reinterpret_cast<uint2*>(dst + g16 + (odd ? 4 : 0)) = make_uint2(v.x, v.y);
        *reinterpret_cast<uint2*>(dst + g16 + (odd ? 12 : 8)) = make_uint2(v.z, v.w);
      }
    }
    if (doq) {
      __syncthreads();
      const bf16* qq = rr + h * 96 + half * 48;
#pragma unroll
      for (int i = 0; i < 6; ++i) {
        const uint4 u = *reinterpret_cast<const uint4*>(qq + i * 8);
        float* tp = T + tok * 97 + half * 48 + i * 8;
        tp[0] = lo2f(u.x) * rsq; tp[1] = hi2f(u.x) * rsq; tp[2] = lo2f(u.y) * rsq; tp[3] = hi2f(u.y) * rsq;
        tp[4] = lo2f(u.z) * rsq; tp[5] = hi2f(u.z) * rsq; tp[6] = lo2f(u.w) * rsq; tp[7] = hi2f(u.w) * rsq;
      }
      __syncthreads();
      mla_norm_rope_store(P, T, P.b_qh_w + l * 96, lat, qscale, P.Q + (size_t)(b * 8 + h) * SEQP * 96, pos0, tlat0);
    }
  }
}

DEVI void hgrn_load(const Params& P, int l, int b, int hd, int c, float* BF, float* RB, float* SEG,
                    float (&q)[16], float (&kf)[16], float (&kb)[16], float (&v)[16], bool need_kv) {
  const int tid = TIDX, t = tid >> 2, k0 = (tid & 3) * 16;
  const int row = row_of(b, c * 64 + t);
  const bf16* z = P.Z + (size_t)row * DIN + hd * 64 + k0;
  float zf[16], zb[16];
#pragma unroll
  for (int i = 0; i < 2; ++i) {
    const uint4 uq = *reinterpret_cast<const uint4*>(z + ZC_CQ + i * 8);
    const uint4 uf = *reinterpret_cast<const uint4*>(z + ZC_CFF + i * 8);
    const uint4 ub = *reinterpret_cast<const uint4*>(z + ZC_CFB + i * 8);
    q[i * 8 + 0] = lo2f(uq.x); q[i * 8 + 1] = hi2f(uq.x); q[i * 8 + 2] = lo2f(uq.y); q[i * 8 + 3] = hi2f(uq.y);
    q[i * 8 + 4] = lo2f(uq.z); q[i * 8 + 5] = hi2f(uq.z); q[i * 8 + 6] = lo2f(uq.w); q[i * 8 + 7] = hi2f(uq.w);
    zf[i * 8 + 0] = lo2f(uf.x); zf[i * 8 + 1] = hi2f(uf.x); zf[i * 8 + 2] = lo2f(uf.y); zf[i * 8 + 3] = hi2f(uf.y);
    zf[i * 8 + 4] = lo2f(uf.z); zf[i * 8 + 5] = hi2f(uf.z); zf[i * 8 + 6] = lo2f(uf.w); zf[i * 8 + 7] = hi2f(uf.w);
    zb[i * 8 + 0] = lo2f(ub.x); zb[i * 8 + 1] = hi2f(ub.x); zb[i * 8 + 2] = lo2f(ub.y); zb[i * 8 + 3] = hi2f(ub.y);
    zb[i * 8 + 4] = lo2f(ub.z); zb[i * 8 + 5] = hi2f(ub.z); zb[i * 8 + 6] = lo2f(ub.w); zb[i * 8 + 7] = hi2f(ub.w);
    if (need_kv) {
      const uint4 uv = *reinterpret_cast<const uint4*>(z + ZC_CI + i * 8);
      v[i * 8 + 0] = lo2f(uv.x); v[i * 8 + 1] = hi2f(uv.x); v[i * 8 + 2] = lo2f(uv.y); v[i * 8 + 3] = hi2f(uv.y);
      v[i * 8 + 4] = lo2f(uv.z); v[i * 8 + 5] = hi2f(uv.z); v[i * 8 + 6] = lo2f(uv.w); v[i * 8 + 7] = hi2f(uv.w);
    }
  }
#pragma unroll
  for (int i = 0; i < 16; ++i) {
    q[i] *= 0.125f;
    float lbf = 0.f;
    if (l == 1) { const int ch = hd * 64 + k0 + i; lbf = sigmoidf_(P.c_lb[512 + ch] - P.c_lb[ch]); }
    const float zz = zf[i];
    const float e = __expf(-fabsf(zz));
    const float sp = __builtin_amdgcn_rcpf(1.f + e);
    const float sig = zz >= 0.f ? sp : e * sp;
    const float nsig = zz >= 0.f ? e * sp : sp;
    const float lf = (l == 0) ? (fminf(zz, 0.f) - __logf(1.f + e)) : __logf(lbf + (1.f - lbf) * sig);
    kf[i] = (1.f - lbf) * nsig;
    BF[t * 65 + k0 + i] = lf;
  }
  __builtin_amdgcn_sched_barrier(0);
#pragma unroll
  for (int i = 0; i < 16; ++i) {
    float lbb = 0.f;
    if (l == 1) { const int ch = hd * 64 + k0 + i; lbb = sigmoidf_(P.c_lb[512 + 256 + ch] - P.c_lb[256 + ch]); }
    const float zz = zb[i];
    const float e = __expf(-fabsf(zz));
    const float sp = __builtin_amdgcn_rcpf(1.f + e);
    const float sig = zz >= 0.f ? sp : e * sp;
    const float nsig = zz >= 0.f ? e * sp : sp;
    const float lf = (l == 0) ? (fminf(zz, 0.f) - __logf(1.f + e)) : __logf(lbb + (1.f - lbb) * sig);
    kb[i] = (1.f - lbb) * nsig;
    RB[t * 65 + k0 + i] = lf;
  }
  __syncthreads();
  {
    const int k = tid & 63, seg = tid >> 6;
    float sf = 0.f, sr = 0.f;
#pragma unroll
    for (int j = 0; j < 16; ++j) { sf += BF[(seg * 16 + j) * 65 + k]; BF[(seg * 16 + j) * 65 + k] = sf; }
#pragma unroll
    for (int j = 15; j >= 0; --j) { sr += RB[(seg * 16 + j) * 65 + k]; RB[(seg * 16 + j) * 65 + k] = sr; }
    SEG[seg * 64 + k] = sf; SEG[256 + seg * 64 + k] = sr;
    __syncthreads();
    float offf = 0.f, offb = 0.f;
#pragma unroll
    for (int s2 = 0; s2 < 4; ++s2) {
      offf += (s2 < seg) ? SEG[s2 * 64 + k] : 0.f;
      offb += (s2 > seg) ? SEG[256 + s2 * 64 + k] : 0.f;
    }
#pragma unroll
    for (int j = 0; j < 16; ++j) { BF[(seg * 16 + j) * 65 + k] += offf; RB[(seg * 16 + j) * 65 + k] += offb; }
  }
  __syncthreads();
}

DEVI f32x16 lds_mm(const bf16* A, const bf16* BT, int tm, int tn, int l31, int hh) {
  f32x16 acc = zero16();
#pragma unroll
  for (int ks = 0; ks < 4; ++ks) {
    const bf16x8 a = ldfrag(A + (tm * 32 + l31) * 72 + ks * 16 + hh * 8);
    const bf16x8 b = ldfrag(BT + (tn * 32 + l31) * 72 + ks * 16 + hh * 8);
    acc = mfma32(a, b, acc);
  }
  return acc;
}

DEVI void phase_hgrn_local(const Params& P, int l, unsigned char* smem) {
  const int tid = TIDX, lane = tid & 63, wave = tid >> 6, l31 = lane & 31, hh = lane >> 5;
  const int tm = wave >> 1, tn = wave & 1;
  float* BF = reinterpret_cast<float*>(smem);
  float* RB = BF + 64 * 65;
  bf16* QF = reinterpret_cast<bf16*>(smem + 33280);
  bf16* KF = QF + 64 * 72;
  bf16* QB = KF + 64 * 72;
  bf16* KB = QB + 64 * 72;
  bf16* VTt = KB + 64 * 72;
  bf16* KHF = reinterpret_cast<bf16*>(smem);
  bf16* KHB = KHF + 64 * 72;
  bf16* ATT = KHB + 64 * 72;
  for (int it = (VBID + NVB - 192) % NVB; it < 8 * 4 * 36; it += NVB) {
    const int c = it % 36, hd = (it / 36) & 3, b = it / 144;
    float q[16], kf[16], kb[16], v[16];
    __syncthreads();
    hgrn_load(P, l, b, hd, c, BF, RB, reinterpret_cast<float*>(smem + 33280), q, kf, kb, v, true);
    const int t = tid >> 2, k0 = (tid & 3) * 16;
#pragma unroll
    for (int i = 0; i < 16; ++i) VTt[(k0 + i) * 72 + t] = f2bf(v[i]);
    float bfv[16], rbv[16];
#pragma unroll
    for (int i = 0; i < 16; ++i) { bfv[i] = BF[t * 65 + k0 + i]; rbv[i] = RB[t * 65 + k0 + i]; }
    {
      const size_t go = (size_t)row_of(b, c * 64 + t) * 256 + hd * 64 + k0;
#pragma unroll
      for (int hq = 0; hq < 2; ++hq) {
        unsigned pf[4], pb[4];
#pragma unroll
        for (int i = 0; i < 8; i += 2) {
          pf[i >> 1] = pack2(q[hq * 8 + i] * __expf(bfv[hq * 8 + i]), q[hq * 8 + i + 1] * __expf(bfv[hq * 8 + i + 1]));
          pb[i >> 1] = pack2(q[hq * 8 + i] * __expf(rbv[hq * 8 + i]), q[hq * 8 + i + 1] * __expf(rbv[hq * 8 + i + 1]));
        }
        *reinterpret_cast<uint4*>(P.GQF + go + hq * 8) = make_uint4(pf[0], pf[1], pf[2], pf[3]);
        *reinterpret_cast<uint4*>(P.GQB + go + hq * 8) = make_uint4(pb[0], pb[1], pb[2], pb[3]);
      }
    }
    if (t == 0) {
      float* dec = P.DEC + ((size_t)((b * 4 + hd) * 2) * 36 + c) * 64 + k0;
#pragma unroll
      for (int i = 0; i < 16; ++i) { dec[i] = __expf(BF[63 * 65 + k0 + i]); dec[36 * 64 + i] = __expf(RB[k0 + i]); }
    }
#pragma unroll
    for (int i = 0; i < 16; i += 2) {
      const int k = k0 + i;
      const float mF0 = BF[32 * 65 + k], mF1 = BF[32 * 65 + k + 1], mB0 = RB[32 * 65 + k], mB1 = RB[32 * 65 + k + 1];
      *reinterpret_cast<unsigned*>(&QF[t * 72 + k]) = pack2(q[i] * __expf(fminf(bfv[i] - mF0, 80.f)), q[i + 1] * __expf(fminf(bfv[i + 1] - mF1, 80.f)));
      *reinterpret_cast<unsigned*>(&KF[t * 72 + k]) = pack2(kf[i] * __expf(fminf(mF0 - bfv[i], 80.f)), kf[i + 1] * __expf(fminf(mF1 - bfv[i + 1], 80.f)));
      *reinterpret_cast<unsigned*>(&QB[t * 72 + k]) = pack2(q[i] * __expf(fminf(rbv[i] - mB0, 80.f)), q[i + 1] * __expf(fminf(rbv[i + 1] - mB1, 80.f)));
      *reinterpret_cast<unsigned*>(&KB[t * 72 + k]) = pack2(kb[i] * __expf(fminf(mB0 - rbv[i], 80.f)), kb[i + 1] * __expf(fminf(mB1 - rbv[i + 1], 80.f)));
    }
#pragma unroll
    for (int i = 0; i < 16; ++i) {
      kf[i] = kf[i] * __expf(BF[63 * 65 + k0 + i] - bfv[i]);
      kb[i] = kb[i] * __expf(RB[k0 + i] - rbv[i]);
    }
    __syncthreads();
#pragma unroll
    for (int i = 0; i < 16; ++i) {
      KHF[(k0 + i) * 72 + t] = f2bf(kf[i]);
      KHB[(k0 + i) * 72 + t] = f2bf(kb[i]);
    }
    __syncthreads();
    {
      const f32x16 af = lds_mm(QF, KF, tm, tn, l31, hh);
      const f32x16 ab = lds_mm(QB, KB, tm, tn, l31, hh);
      const int s = tn * 32 + l31;
#pragma unroll
      for (int r = 0; r < 16; ++r) {
        const int tt = tm * 32 + drow(r, hh);
        float a = 0.f;
        if (s <= tt) a += af[r];
        if (s >= tt) a += ab[r];
        ATT[tt * 72 + s] = f2bf(a);
      }
    }
    {
      const f32x16 lf = lds_mm(VTt, KHF, tm, tn, l31, hh);
      const f32x16 lb = lds_mm(VTt, KHB, tm, tn, l31, hh);
      bf16* stf = P.ST + ((size_t)((b * 4 + hd) * 2 + 0) * 36 + c) * 4096;
      bf16* stb = P.ST + ((size_t)((b * 4 + hd) * 2 + 1) * 36 + c) * 4096;
#pragma unroll
      for (int r = 0; r < 16; ++r) {
        const int kk = tm * 32 + drow(r, hh), d = tn * 32 + l31;
        stf[kk * 64 + d] = f2bf(lf[r]);
        stb[kk * 64 + d] = f2bf(lb[r]);
      }
    }
    __syncthreads();
    {
      const f32x16 o = lds_mm(ATT, VTt, tm, tn, l31, hh);
#pragma unroll
      for (int r = 0; r < 16; ++r) {
        const int tt = tm * 32 + drow(r, hh), d = tn * 32 + l31;
        P.OI[(size_t)row_of(b, c * 64 + tt) * 256 + hd * 64 + d] = f2bf(o[r]);
      }
    }
  }
}

DEVI void hgrn_scan_item(const Params& P, int item) {
  const int tid = TIDX;
  const int chain = item >> 2, sl = item & 3;
  const int dir = chain & 1;
  const int dd = tid >> 2, k4 = sl * 16 + (tid & 3) * 4;
  float4 S = make_float4(0.f, 0.f, 0.f, 0.f);
  bf16* base = P.ST + (size_t)chain * 36 * 4096 + dd * 64 + k4;
  const float* dec = P.DEC + (size_t)chain * 36 * 64 + k4;
#pragma unroll 1
  for (int g = 0; g < 6; ++g) {
    float4 L[6], dc[6];
#pragma unroll
    for (int j = 0; j < 6; ++j) {
      const int step = g * 6 + j;
      const int c = dir == 0 ? step : (step < 4 ? 3 - step : 39 - step);
      { const uint2 u = *reinterpret_cast<const uint2*>(base + (size_t)c * 4096); L[j] = make_float4(lo2f(u.x), hi2f(u.x), lo2f(u.y), hi2f(u.y)); }
      dc[j] = *reinterpret_cast<const float4*>(dec + c * 64);
    }
#pragma unroll
    for (int j = 0; j < 6; ++j) {
      const int step = g * 6 + j;
      const int c = dir == 0 ? step : (step < 4 ? 3 - step : 39 - step);
      *reinterpret_cast<uint2*>(base + (size_t)c * 4096) = make_uint2(pack2(S.x, S.y), pack2(S.z, S.w));
      S.x = dc[j].x * S.x + L[j].x; S.y = dc[j].y * S.y + L[j].y; S.z = dc[j].z * S.z + L[j].z; S.w = dc[j].w * S.w + L[j].w;
    }
  }
}

DEVI void phase_hgrn_final(const Params& P, int l, unsigned char* smem) {
  const int tid = TIDX, lane = tid & 63, wave = tid >> 6, l31 = lane & 31, hh = lane >> 5;
  const int tm = wave >> 1, tn = wave & 1;
  float* O = reinterpret_cast<float*>(smem);
  bf16* QF = reinterpret_cast<bf16*>(smem + 33280);
  bf16* QB = QF + 64 * 72;
  bf16* SF = QB + 64 * 72;
  bf16* SB = SF + 64 * 72;
  const int c0 = (l == 1) ? 4 : 0;
  const int nc = 36 - c0;
  for (int it = VBID; it < 8 * 4 * nc; it += NVB) {
    const int c = it % nc + c0, hd = (it / nc) & 3, b = it / (nc * 4);
    const int t = tid >> 2, k0 = (tid & 3) * 16;
    const int row = row_of(b, c * 64 + t);
    __syncthreads();
    {
      const size_t go = (size_t)row * 256 + hd * 64 + k0;
      *reinterpret_cast<uint4*>(QF + t * 72 + k0) = *reinterpret_cast<const uint4*>(P.GQF + go);
      *reinterpret_cast<uint4*>(QF + t * 72 + k0 + 8) = *reinterpret_cast<const uint4*>(P.GQF + go + 8);
      *reinterpret_cast<uint4*>(QB + t * 72 + k0) = *reinterpret_cast<const uint4*>(P.GQB + go);
      *reinterpret_cast<uint4*>(QB + t * 72 + k0 + 8) = *reinterpret_cast<const uint4*>(P.GQB + go + 8);
      const bf16* stf = P.ST + ((size_t)((b * 4 + hd) * 2 + 0) * 36 + c) * 4096 + t * 64 + k0;
      const bf16* stb = P.ST + ((size_t)((b * 4 + hd) * 2 + 1) * 36 + c) * 4096 + t * 64 + k0;
      *reinterpret_cast<uint4*>(SF + t * 72 + k0) = *reinterpret_cast<const uint4*>(stf);
      *reinterpret_cast<uint4*>(SF + t * 72 + k0 + 8) = *reinterpret_cast<const uint4*>(stf + 8);
      *reinterpret_cast<uint4*>(SB + t * 72 + k0) = *reinterpret_cast<const uint4*>(stb);
      *reinterpret_cast<uint4*>(SB + t * 72 + k0 + 8) = *reinterpret_cast<const uint4*>(stb + 8);
    }
    __syncthreads();
    {
      f32x16 o = lds_mm(QF, SF, tm, tn, l31, hh);
      const f32x16 o2 = lds_mm(QB, SB, tm, tn, l31, hh);
#pragma unroll
      for (int r = 0; r < 16; ++r) {
        const int tt = tm * 32 + drow(r, hh), d = tn * 32 + l31;
        O[tt * 65 + d] = o[r] + o2[r] + bf2f(P.OI[(size_t)row_of(b, c * 64 + tt) * 256 + hd * 64 + d]);
      }
    }
    __syncthreads();
    {
      float ov[16]; float ss = 0.f;
#pragma unroll
      for (int i = 0; i < 16; ++i) { ov[i] = O[t * 65 + k0 + i]; ss += ov[i] * ov[i]; }
      ss += __shfl_xor(ss, 1); ss += __shfl_xor(ss, 2);
      const float rr = rsqrtf(ss * (1.f / 64.f) + EPS);
      const bf16* g = P.Z + (size_t)row * DIN + ZC_CG + hd * 64 + k0;
      const float* nw = P.c_out_norm_w + l * 64 + k0;
      const uint4 gA = *reinterpret_cast<const uint4*>(g), gB = *reinterpret_cast<const uint4*>(g + 8);
      const unsigned gw[8] = {gA.x, gA.y, gA.z, gA.w, gB.x, gB.y, gB.z, gB.w};
      unsigned pk[8];
#pragma unroll
      for (int i = 0; i < 16; i += 2) {
        const float g0 = lo2f(gw[i >> 1]), g1 = hi2f(gw[i >> 1]);
        const float y0 = ov[i] * rr * nw[i] * (g0 * sigmoidf_(g0));
        const float y1 = ov[i + 1] * rr * nw[i + 1] * (g1 * sigmoidf_(g1));
        pk[i >> 1] = pack2(y0, y1);
      }
      uint4* dst = reinterpret_cast<uint4*>(P.H + (size_t)row * 1024 + 768 + hd * 64 + k0);
      dst[0] = make_uint4(pk[0], pk[1], pk[2], pk[3]);
      dst[1] = make_uint4(pk[4], pk[5], pk[6], pk[7]);
    }
  }
}

DEVI void attn_item8(const Params& P, int b, int h, int qpos0, int nkeys, float sref, unsigned char* smem_base) {
  const int tid = threadIdx.x, lane = tid & 63, wave = tid >> 6, l31 = lane & 31, hh = lane >> 5;
  constexpr int TK = 128, LDKS = 104, LDVS = 136;
  constexpr int KS_BYTES = TK * LDKS * 2, VS_BYTES = 64 * LDVS * 2, ST_BYTES = KS_BYTES + VS_BYTES;
  const bf16* Qg = P.Q + ((size_t)(b * 8 + h) * SEQP + qpos0 + wave * 32 + l31) * 96;
  const bf16* Kg = P.K + (size_t)(b * 8 + h) * SEQP * 96;
  const bf16* Vg = P.VT + (size_t)(b * 8 + h) * 64 * SEQP;
  bf16x8 qf[6];
#pragma unroll
  for (int ks = 0; ks < 6; ++ks) qf[ks] = ldfrag(Qg + ks * 16 + hh * 8);
  f32x16 oacc[2]; oacc[0] = zero16(); oacc[1] = zero16();
  float lsum = 0.f;
  const int ntiles = nkeys / TK;
  unsigned koff[4], voff[3];
#pragma unroll
  for (int i = 0; i < 4; ++i) { const int q = (i * 8 + wave) * 64 + lane, row = q / 13, cc = q - row * 13; koff[i] = (unsigned)(row * 96 + (cc < 12 ? cc : 0) * 8) * 2u; }
#pragma unroll
  for (int i = 0; i < 3; ++i) { const int q = (i * 8 + wave) * 64 + lane, row = q / 17, cc = q - row * 17; voff[i] = (unsigned)((row < 64 ? row : 63) * SEQP + (cc < 16 ? cc : 0) * 8) * 2u; }
  LAS unsigned char* ldsb = (LAS unsigned char*)smem_base;
  auto dma_tile = [&](int kt, int buf) {
    const char* kb_ = (const char*)(Kg + (size_t)kt * TK * 96);
    const char* vb_ = (const char*)(Vg + (size_t)kt * TK);
#pragma unroll
    for (int i = 0; i < 4; ++i) {
      const int g = i * 8 + wave;
      if (g < 26) __builtin_amdgcn_global_load_lds((const unsigned*)(kb_ + koff[i]), (LAS unsigned*)(ldsb + buf * ST_BYTES + g * 1024), 16, 0, 0);
    }
#pragma unroll
    for (int i = 0; i < 3; ++i) {
      const int g = i * 8 + wave;
      if (g < 17) __builtin_amdgcn_global_load_lds((const unsigned*)(vb_ + voff[i]), (LAS unsigned*)(ldsb + buf * ST_BYTES + KS_BYTES + g * 1024), 16, 0, 0);
    }
  };
  __syncthreads();
  dma_tile(0, 0);
  asm volatile("s_waitcnt vmcnt(0)" ::: "memory");
  __syncthreads();
  for (int kt = 0; kt < ntiles; ++kt) {
    const int cur = kt & 1;
    if (kt + 1 < ntiles) dma_tile(kt + 1, cur ^ 1);
    const bf16* sK = reinterpret_cast<const bf16*>(smem_base + cur * ST_BYTES);
    const bf16* sV = reinterpret_cast<const bf16*>(smem_base + cur * ST_BYTES + KS_BYTES);
#pragma unroll
    for (int kk = 0; kk < 4; ++kk) {
      f32x16 sacc;
#pragma unroll
      for (int r = 0; r < 16; ++r) sacc[r] = -sref;
#pragma unroll
      for (int ks = 0; ks < 6; ++ks) {
        const bf16x8 a = ldfrag(sK + (kk * 32 + l31) * LDKS + ks * 16 + hh * 8);
        sacc = mfma32(a, qf[ks], sacc);
      }
#pragma unroll
      for (int r = 0; r < 16; ++r) { const float p = __builtin_amdgcn_exp2f(sacc[r]); sacc[r] = p; lsum += p; }
#pragma unroll
      for (int s = 0; s < 2; ++s) {
        bf16x8 pb;
#pragma unroll
        for (int j = 0; j < 8; ++j) pb[j] = (__bf16)sacc[8 * s + j];
#pragma unroll
        for (int dt = 0; dt < 2; ++dt) {
          const bf16x8 a = ldfrag(sV + (dt * 32 + l31) * LDVS + kk * 32 + s * 16 + hh * 8);
          oacc[dt] = mfma32(a, pb, oacc[dt]);
        }
      }
    }
    asm volatile("s_waitcnt vmcnt(0)" ::: "memory");
    __syncthreads();
  }
  lsum += __shfl_xor(lsum, 32);
  const float inv = 1.f / lsum;
  const int row = row_of(b, qpos0 + wave * 32 + l31);
  bf16* dst = P.H + (size_t)row * 1024 + 256 + h * 64;
#pragma unroll
  for (int dt = 0; dt < 2; ++dt)
#pragma unroll
    for (int rg = 0; rg < 4; ++rg) {
      const int d = dt * 32 + 8 * rg + 4 * hh;
      uint2 o;
      o.x = pack2(oacc[dt][4 * rg + 0] * inv, oacc[dt][4 * rg + 1] * inv);
      o.y = pack2(oacc[dt][4 * rg + 2] * inv, oacc[dt][4 * rg + 3] * inv);
      *reinterpret_cast<uint2*>(dst + d) = o;
    }
}

DEVI void phase_attn_scan(const Params& P, int l, unsigned char* smem_base, bool skip_scan = false) {
  if (!skip_scan)
    for (int it = NVB - 1 - VBID; it < 256; it += NVB) hgrn_scan_item(P, it);
  float sref;
  {
    const int lane = threadIdx.x & 63;
    float mq = fmaxf(fabsf(P.b_qh_w[l * 96 + lane]), lane < 32 ? fabsf(P.b_qh_w[l * 96 + 64 + lane]) : 0.f);
    float mk = fmaxf(fabsf(P.b_kh_w[l * 96 + lane]), lane < 32 ? fabsf(P.b_kh_w[l * 96 + 64 + lane]) : 0.f);
#pragma unroll
    for (int o = 32; o > 0; o >>= 1) { mq = fmaxf(mq, __shfl_xor(mq, o)); mk = fmaxf(mk, __shfl_xor(mk, o)); }
    sref = fminf(1.4426950408889634f * 9.797958971132712f * mq * mk, 60.f);
  }
  const int c = blockIdx.x, xcd = c & 7, slot = c >> 3;
  const int nrounds = (l == 0) ? 3 : 2;
  for (int r = 0; r < nrounds; ++r) {
    if (r < 2) {
      const int u = r * 32 + slot;
      const int bh = xcd * 8 + (u >> 3), qt = u & 7;
      if (slot < 32) attn_item8(P, bh >> 3, bh & 7, 256 + 256 * qt, 2304, sref, smem_base);
    } else if (c < 64) {
      attn_item8(P, c >> 3, c & 7, 0, 256, sref, smem_base);
    }
  }
}

DEVI unsigned ordkey(float s) { const unsigned u = __float_as_uint(s); return (u & 0x80000000u) ? ~u : (u | 0x80000000u); }
DEVI float keyval(unsigned k, unsigned mask) { const unsigned u = k & ~mask; return __uint_as_float((u & 0x80000000u) ? (u & 0x7fffffffu) : ~u); }
DEVI void ins16(unsigned (&lst)[16], unsigned v) {
#pragma unroll
  for (int j = 0; j < 16; ++j) { const unsigned hi = max(lst[j], v); v = min(lst[j], v); lst[j] = hi; }
}
DEVI void merge16(unsigned (&lst)[16], int xm) {
  unsigned o[16];
#pragma unroll
  for (int j = 0; j < 16; ++j) o[j] = (unsigned)__shfl_xor((int)lst[j], xm);
#pragma unroll
  for (int j = 0; j < 16; ++j) lst[j] = max(lst[j], o[15 - j]);
#pragma unroll
  for (int d = 8; d >= 1; d >>= 1)
#pragma unroll
    for (int j = 0; j < 16; ++j)
      if ((j & d) == 0) { const unsigned a = lst[j], bb = lst[j + d]; lst[j] = max(a, bb); lst[j + d] = min(a, bb); }
}

DEVI void bitonic_sort_desc16(unsigned (&v)[16]) {
#pragma unroll
  for (int k = 2; k <= 16; k <<= 1)
#pragma unroll
    for (int j = k >> 1; j > 0; j >>= 1)
#pragma unroll
      for (int i = 0; i < 16; ++i) {
        const int l = i ^ j;
        if (l > i) {
          const bool desc = ((i & k) == 0);
          const unsigned a = v[i], b = v[l];
          const unsigned mx = max(a, b), mn = min(a, b);
          v[i] = desc ? mx : mn; v[l] = desc ? mn : mx;
        }
      }
}
DEVI void bitonic_merge_desc16(unsigned (&lst)[16]) {
#pragma unroll
  for (int d = 8; d >= 1; d >>= 1)
#pragma unroll
    for (int j = 0; j < 16; ++j)
      if ((j & d) == 0) { const unsigned a = lst[j], bb = lst[j + d]; lst[j] = max(a, bb); lst[j + d] = min(a, bb); }
}
struct CandTab { int a[52]; int b[52]; };
constexpr CandTab make_cand_tab() {
  CandTab t{};
  int n = 0;
  for (int a = 0; a < 16; ++a)
    for (int b = 0; b < 16; ++b)
      if ((a + 1) * (b + 1) <= 16) { t.a[n] = a; t.b[n] = b; ++n; }
  for (; n < 52; ++n) { t.a[n] = 0; t.b[n] = 0; }
  return t;
}

DEVI void phase_route(const Params& P, int l, unsigned char* smem) {
  const int tid = TIDX, lane = tid & 63, wave = tid >> 6, l31 = lane & 31, hh = lane >> 5;
  bf16* QT = reinterpret_cast<bf16*>(smem);
  float* SC = reinterpret_cast<float*>(smem + 33792);
  const int mtiles = (l == 1) ? 256 : 288;
  for (int it = VBID; it < mtiles * 8; it += NVB) {
    const int mt = it >> 3, h = it & 7;
    __syncthreads();
    for (int e = tid; e < 64 * 32; e += 256) {
      const int r = e >> 5, cc = e & 31;
      *reinterpret_cast<uint4*>(QT + r * 264 + cc * 8) = *reinterpret_cast<const uint4*>(P.QP + (size_t)(mt * 64 + r) * 2048 + h * 256 + cc * 8);
    }
    __syncthreads();
    unsigned lst[2][16];
    const int row = tid >> 2, part = tid & 3;
#pragma unroll
    for (int p = 0; p < 2; ++p) {
      f32x16 sa[2]; sa[0] = zero16(); sa[1] = zero16();
      const bf16* keys = P.SK + ((size_t)(l * 16 + h * 2 + p) * 128 + wave * 32 + l31) * 128;
#pragma unroll
      for (int ks = 0; ks < 8; ++ks) {
        const bf16x8 bfr = ldfrag(keys + ks * 16 + hh * 8);
#pragma unroll
        for (int i = 0; i < 2; ++i) {
          const bf16x8 af = ldfrag(QT + (i * 32 + l31) * 264 + p * 128 + ks * 16 + hh * 8);
          sa[i] = mfma32(af, bfr, sa[i]);
        }
      }
      if (p == 1) __syncthreads();
#pragma unroll
      for (int i = 0; i < 2; ++i)
#pragma unroll
        for (int r = 0; r < 16; ++r) SC[(i * 32 + drow(r, hh)) * 129 + wave * 32 + l31] = sa[i][r];
      __syncthreads();
      unsigned B2[16];
#pragma unroll
      for (int i = 0; i < 16; ++i) {
        const int i0 = part * 32 + ((i + part * 8) & 31), i1 = part * 32 + ((i + 16 + part * 8) & 31);
        lst[p][i] = (ordkey(SC[row * 129 + i0]) & ~0x7fu) | (unsigned)(127 - i0);
        B2[i] = (ordkey(SC[row * 129 + i1]) & ~0x7fu) | (unsigned)(127 - i1);
      }
      bitonic_sort_desc16(lst[p]);
      bitonic_sort_desc16(B2);
#pragma unroll
      for (int j = 0; j < 16; ++j) lst[p][j] = max(lst[p][j], B2[15 - j]);
      bitonic_merge_desc16(lst[p]);
      merge16(lst[p], 1);
      merge16(lst[p], 2);
    }
    float v0[16], v1[16];
#pragma unroll
    for (int j = 0; j < 16; ++j) { v0[j] = keyval(lst[0][j], 0x7fu); v1[j] = keyval(lst[1][j], 0x7fu); }
    unsigned best[16];
    {
      constexpr CandTab CT = make_cand_tab();
#pragma unroll
      for (int c = 0; c < 13; ++c) {
        const int a0 = CT.a[4 * c + 0], a1 = CT.a[4 * c + 1], a2 = CT.a[4 * c + 2], a3 = CT.a[4 * c + 3];
        const int b0 = CT.b[4 * c + 0], b1 = CT.b[4 * c + 1], b2 = CT.b[4 * c + 2], b3 = CT.b[4 * c + 3];
        const float x = part == 0 ? v0[a0] : part == 1 ? v0[a1] : part == 2 ? v0[a2] : v0[a3];
        const float y = part == 0 ? v1[b0] : part == 1 ? v1[b1] : part == 2 ? v1[b2] : v1[b3];
        const int flat = part == 0 ? (a0 * 16 + b0) : part == 1 ? (a1 * 16 + b1) : part == 2 ? (a2 * 16 + b2) : (a3 * 16 + b3);
        const bool valid = part == 0 ? (4 * c + 0 < 50) : part == 1 ? (4 * c + 1 < 50) : part == 2 ? (4 * c + 2 < 50) : (4 * c + 3 < 50);
        const unsigned key = (ordkey(x + y) & ~0xffu) | (unsigned)(255 - flat);
        best[c] = valid ? key : 0u;
      }
      best[13] = 0u; best[14] = 0u; best[15] = 0u;
      bitonic_sort_desc16(best);
      merge16(best, 1);
      merge16(best, 2);
    }
    {
      const float mx = keyval(best[0], 0xffu);
      float es = 0.f;
      float ev[4]; int ex[4];
#pragma unroll
      for (int jj = 0; jj < 4; ++jj) {
        const unsigned kk = part == 0 ? best[4 * jj + 0] : part == 1 ? best[4 * jj + 1] : part == 2 ? best[4 * jj + 2] : best[4 * jj + 3];
        ev[jj] = __expf(keyval(kk, 0xffu) - mx);
        es += ev[jj];
        const int flat = 255 - (int)(kk & 0xffu);
        const int a = flat >> 4, bq = flat & 15;
        int i1 = 0, i2 = 0;
#pragma unroll
        for (int u = 0; u < 16; ++u) {
          i1 = (a == u) ? (127 - (int)(lst[0][u] & 0x7fu)) : i1;
          i2 = (bq == u) ? (127 - (int)(lst[1][u] & 0x7fu)) : i2;
        }
        ex[jj] = i1 * 128 + i2;
      }
      es += __shfl_xor(es, 1); es += __shfl_xor(es, 2);
      const float inv = 1.f / es;
      const int tok = mt * 64 + row;
      int* ed = P.EIDX + (size_t)tok * 128 + h * 16;
      float* gd = P.GATE + (size_t)tok * 128 + h * 16;
#pragma unroll
      for (int jj = 0; jj < 4; ++jj) { ed[4 * jj + part] = ex[jj]; gd[4 * jj + part] = ev[jj] * inv; }
    }
  }
}

DEVI float gelu_exact(float a) { return 0.5f * a * (1.f + erff(a * 0.70710678118654752f)); }

typedef float f2 __attribute__((ext_vector_type(2)));
DEVI void phase_peer_u(const Params& P, int l) {
  const int lane = TIDX & 63, half = lane >> 5, l32 = lane & 31;
  const int gw = VBID * 4 + (TIDX >> 6), nw = NVB * 4;
  const int nrows = (l == 1) ? NL : NT;
  const unsigned char* PU = P.PU8 + (size_t)l * 16384 * 576;
  const bool b4 = lane & 16, b3 = lane & 8, b2 = lane & 4;
  for (int t = gw; t < nrows; t += nw) {
    f2 h2[16];
    {
      const bf16* hp = P.H + (size_t)t * 1024 + l32 * 32;
#pragma unroll
      for (int i = 0; i < 4; ++i) {
        const uint4 hv = *reinterpret_cast<const uint4*>(hp + i * 8);
        h2[4 * i + 0] = (f2){lo2f(hv.x), hi2f(hv.x)}; h2[4 * i + 1] = (f2){lo2f(hv.y), hi2f(hv.y)};
        h2[4 * i + 2] = (f2){lo2f(hv.z), hi2f(hv.z)}; h2[4 * i + 3] = (f2){lo2f(hv.w), hi2f(hv.w)};
      }
    }
    const int e0 = P.EIDX[(size_t)t * 128 + lane], e1 = P.EIDX[(size_t)t * 128 + 64 + lane];
    const float g0 = P.GATE[(size_t)t * 128 + lane], g1 = P.GATE[(size_t)t * 128 + 64 + lane];
    float* wrow = P.WPE + (size_t)t * 128;
    const bool b1 = lane & 2;
    for (int kb = 0; kb < 4; ++kb) {
      const int esrc = kb < 2 ? e0 : e1;
      uint4 ud[16];
      unsigned short us[16];
#pragma unroll
      for (int i = 0; i < 16; ++i) {
        const int e = __shfl(esrc, (kb * 32 + 2 * i + half) & 63);
        const unsigned char* ur = PU + (size_t)e * 576;
        ud[i] = *reinterpret_cast<const uint4*>(ur + l32 * 16);
        us[i] = *reinterpret_cast<const unsigned short*>(ur + 512 + l32 * 2);
      }
      float d[16];
#pragma unroll
      for (int i = 0; i < 16; ++i) {
        const unsigned uw[4] = {ud[i].x, ud[i].y, ud[i].z, ud[i].w};
        f2 sacc = (f2){0.f, 0.f};
#pragma unroll
        for (int c = 0; c < 4; ++c) {
          sacc = __builtin_elementwise_fma(__builtin_amdgcn_cvt_scalef32_pk_f32_fp4(uw[c], 1.0f, 0), h2[4 * c + 0], sacc);
          sacc = __builtin_elementwise_fma(__builtin_amdgcn_cvt_scalef32_pk_f32_fp4(uw[c], 1.0f, 1), h2[4 * c + 1], sacc);
          sacc = __builtin_elementwise_fma(__builtin_amdgcn_cvt_scalef32_pk_f32_fp4(uw[c], 1.0f, 2), h2[4 * c + 2], sacc);
          sacc = __builtin_elementwise_fma(__builtin_amdgcn_cvt_scalef32_pk_f32_fp4(uw[c], 1.0f, 3), h2[4 * c + 3], sacc);
        }
        d[i] = (sacc.x + sacc.y) * __uint_as_float((unsigned)us[i] << 16);
      }
      float r8[8], r4[4], r2[2], r1;
#pragma unroll
      for (int i = 0; i < 8; ++i) { const float mine = b4 ? d[8 + i] : d[i]; const float send = b4 ? d[i] : d[8 + i]; r8[i] = mine + __shfl_xor(send, 16); }
#pragma unroll
      for (int i = 0; i < 4; ++i) { const float mine = b3 ? r8[4 + i] : r8[i]; const float send = b3 ? r8[i] : r8[4 + i]; r4[i] = mine + __shfl_xor(send, 8); }
#pragma unroll
      for (int i = 0; i < 2; ++i) { const float mine = b2 ? r4[2 + i] : r4[i]; const float send = b2 ? r4[i] : r4[2 + i]; r2[i] = mine + __shfl_xor(send, 4); }
      { const float mine = b1 ? r2[1] : r2[0]; const float send = b1 ? r2[0] : r2[1]; r1 = mine + __shfl_xor(send, 2); }
      r1 += __shfl_xor(r1, 1);
      const int k = kb * 32 + 2 * ((lane >> 1) & 15) + half;
      const float gt = __shfl(kb < 2 ? g0 : g1, k & 63);
      if ((lane & 1) == 0) wrow[k] = gt * gelu_exact(r1);
    }
  }
}

DEVI void phase_peer(const Params& P, int l) {
  const int lane = TIDX & 63, half = lane >> 5, l32 = lane & 31;
  const int gw = VBID * 4 + (TIDX >> 6), nw = NVB * 4;
  const int nrows = (l == 1) ? NL : NT;
  const unsigned char* PV = P.PV8 + (size_t)l * 16384 * 576;
  for (int t = gw; t < nrows; t += nw) {
    const int e0 = P.EIDX[(size_t)t * 128 + lane], e1 = P.EIDX[(size_t)t * 128 + 64 + lane];
    const float w0 = P.WPE[(size_t)t * 128 + lane], w1 = P.WPE[(size_t)t * 128 + 64 + lane];
    f2 y2[16];
#pragma unroll
    for (int i = 0; i < 16; ++i) y2[i] = (f2){0.f, 0.f};
    for (int kb = 0; kb < 4; ++kb) {
      const int esrc = kb < 2 ? e0 : e1;
      const float wsrc = kb < 2 ? w0 : w1;
      uint4 vd[16];
      unsigned short vs[16];
      float wv[16];
#pragma unroll
      for (int i = 0; i < 16; ++i) {
        const int ks = (kb * 32 + 2 * i + half) & 63;
        const int e = __shfl(esrc, ks);
        wv[i] = __shfl(wsrc, ks);
        const unsigned char* vr = PV + (size_t)e * 576;
        vd[i] = *reinterpret_cast<const uint4*>(vr + l32 * 16);
        vs[i] = *reinterpret_cast<const unsigned short*>(vr + 512 + l32 * 2);
      }
#pragma unroll
      for (int i = 0; i < 16; ++i) {
        const float wi = wv[i] * __uint_as_float((unsigned)vs[i] << 16);
        const f2 ww = (f2){wi, wi};
        const unsigned vw[4] = {vd[i].x, vd[i].y, vd[i].z, vd[i].w};
#pragma unroll
        for (int c = 0; c < 4; ++c) {
          y2[4 * c + 0] = __builtin_elementwise_fma(ww, __builtin_amdgcn_cvt_scalef32_pk_f32_fp4(vw[c], 1.0f, 0), y2[4 * c + 0]);
          y2[4 * c + 1] = __builtin_elementwise_fma(ww, __builtin_amdgcn_cvt_scalef32_pk_f32_fp4(vw[c], 1.0f, 1), y2[4 * c + 1]);
          y2[4 * c + 2] = __builtin_elementwise_fma(ww, __builtin_amdgcn_cvt_scalef32_pk_f32_fp4(vw[c], 1.0f, 2), y2[4 * c + 2]);
          y2[4 * c + 3] = __builtin_elementwise_fma(ww, __builtin_amdgcn_cvt_scalef32_pk_f32_fp4(vw[c], 1.0f, 3), y2[4 * c + 3]);
        }
      }
    }
    float y[16];
#pragma unroll
    for (int j = 0; j < 8; ++j) {
      const float ax = y2[j].x + __shfl_xor(y2[j].x, 32), ay = y2[j].y + __shfl_xor(y2[j].y, 32);
      const float bx = y2[8 + j].x + __shfl_xor(y2[8 + j].x, 32), by = y2[8 + j].y + __shfl_xor(y2[8 + j].y, 32);
      y[2 * j] = half ? bx : ax; y[2 * j + 1] = half ? by : ay;
    }
    const int bi = batch_of_row(t);
    const float* gate2 = P.MOD + (size_t)(l * 9 + bi) * 6144 + 5 * 1024;
    const int d0 = l32 * 32 + half * 16;
    float xn[16];
    float ss = 0.f;
#pragma unroll
    for (int q4 = 0; q4 < 4; ++q4) {
      const int d = d0 + q4 * 4;
      const uint2 xu = *reinterpret_cast<const uint2*>(P.X + (size_t)t * 1024 + d);
      const float4 xo = make_float4(lo2f(xu.x), hi2f(xu.x), lo2f(xu.y), hi2f(xu.y));
      const float4 gg = *reinterpret_cast<const float4*>(gate2 + d);
      float4 o;
      o.x = xo.x + gg.x * y[q4 * 4 + 0]; o.y = xo.y + gg.y * y[q4 * 4 + 1];
      o.z = xo.z + gg.z * y[q4 * 4 + 2]; o.w = xo.w + gg.w * y[q4 * 4 + 3];
      xn[q4 * 4 + 0] = o.x; xn[q4 * 4 + 1] = o.y; xn[q4 * 4 + 2] = o.z; xn[q4 * 4 + 3] = o.w;
      ss += o.x * o.x + o.y * o.y + o.z * o.z + o.w * o.w;
      if (l == 1) *reinterpret_cast<float4*>(P.out + (size_t)t * 1024 + d) = o;
      else *reinterpret_cast<uint2*>(P.X + (size_t)t * 1024 + d) = make_uint2(pack2(o.x, o.y), pack2(o.z, o.w));
    }
    if (l == 0) {
      ss = wave_sum(ss);
      const float rr = rsqrtf(ss * (1.f / 1024.f) + EPS);
      const float* lnw = P.ln1_w + 1024;
      const float* mod = P.MOD + (size_t)(9 + bi) * 6144;
      unsigned pk[8];
#pragma unroll
      for (int i = 0; i < 16; i += 2) {
        const float o0 = xn[i] * rr * lnw[d0 + i] * (1.f + mod[1024 + d0 + i]) + mod[d0 + i];
        const float o1 = xn[i + 1] * rr * lnw[d0 + i + 1] * (1.f + mod[1024 + d0 + i + 1]) + mod[d0 + i + 1];
        pk[i >> 1] = pack2(o0, o1);
      }
      *reinterpret_cast<uint4*>(P.H + (size_t)t * 1024 + d0) = make_uint4(pk[0], pk[1], pk[2], pk[3]);
      *reinterpret_cast<uint4*>(P.H + (size_t)t * 1024 + d0 + 8) = make_uint4(pk[4], pk[5], pk[6], pk[7]);
    }
  }
}

using f32x4 = __attribute__((ext_vector_type(4))) float;
namespace g8 {
constexpr int BM = 256, BK = 64, HALF = 128, HT = HALF * BK;
DEVI int lds_byte(int r, int c) { const int st = (r >> 4) * 2 + (c >> 5), rr = r & 15, cc = c & 31, ob = rr * 64 + cc * 2; return st * 1024 + (ob ^ (((ob >> 9) & 1) << 5)); }
DEVI void stage_rc(int b, int& R, int& C) { const int st = b / 1024, sb = b % 1024, swz = sb ^ (((sb >> 9) & 1) << 5); R = (st >> 1) * 16 + swz / 64; C = (st & 1) * 32 + (swz % 64) / 2; }
DEVI int perm32(int rho) { const int n = rho >> 4, i = rho & 15; return 8 * (i >> 2) + 4 * n + (i & 3); }
DEVI void unit_of(int L, int nM, int nN, int& pm, int& pn) {
  const int nwg = nM * nN;
  int wgid = L;
  { const int q = nwg / 8, r = nwg % 8, xcd = wgid % 8, off = wgid / 8; wgid = (xcd < r ? xcd * (q + 1) : r * (q + 1) + (xcd - r) * q) + off; }
  const int nig = 8 * nN, gid = wgid / nig, fm = gid * 8, gsz = (nM - fm) < 8 ? (nM - fm) : 8;
  pm = fm + ((wgid % nig) % gsz); pn = (wgid % nig) / gsz;
}
}

struct G8Unit { int pm, pn; };
template <class Epi>
DEVI void gemm8_phase(LAS unsigned char* lds, const bf16* __restrict__ Ag, const bf16* __restrict__ Btg, const int K, const int nM, const int nN, const Epi& E,
                      const int lda = 0, const int pn_split = 1 << 30, const int acol0 = 0, const int acol1 = 0,
                      const int ldb = 0, const int pn_mod = 1 << 30, const int ksplit_cols = 0) {
  constexpr int BK = 64, HALF = 128, HTB = HALF * BK * 2;
  const int tid = threadIdx.x, wid = __builtin_amdgcn_readfirstlane(tid >> 6), lane = tid & 63, wr = wid >> 2, wc = wid & 3, fr = lane & 15, fq = lane >> 4;
  const int nt = K / BK;
  const int nunits = nM * nN, G = gridDim.x, c = blockIdx.x;
  const int LDA = lda ? lda : K, LDB = ldb ? ldb : K;
  unsigned voffA[2], voffB[2];
#pragma unroll
  for (int i = 0; i < 2; ++i) { int R, C; g8::stage_rc(tid * 16 + i * 8192, R, C); const int Rb = (R & ~31) + g8::perm32(R & 31); voffA[i] = (unsigned)(R * LDA + C) * 2u; voffB[i] = (unsigned)(Rb * LDB + C) * 2u; }
  const size_t kstep = (size_t)(BK * 2);
  const size_t hstepA = (size_t)HALF * LDA * 2, hstep = (size_t)HALF * LDB * 2;
  const size_t tstepA = 2 * hstepA, tstep = 2 * hstep;
  const unsigned ldsw = (unsigned)wid * 1024u;
  const int aoff = g8::lds_byte(wr * 64 + fr, fq * 8), boff = g8::lds_byte(wc * 32 + fr, fq * 8);
#define PG8_SA(b, h) (((b) * 2 + (h)) * HTB)
#define PG8_SB(b, h) ((4 + (b) * 2 + (h)) * HTB)
#define PG8_STAGE(bufoff, gbase, voff) do { _Pragma("unroll") for (int _i = 0; _i < 2; ++_i) \
        __builtin_amdgcn_global_load_lds((const unsigned*)((const char*)(gbase) + (voff)[_i]), (LAS unsigned*)(lds + (bufoff) + ldsw + _i * 8192), 16, 0, 0); } while (0)
#define PG8_LDA(dst, b, h) do { _Pragma("unroll") for (int m = 0; m < 4; ++m) _Pragma("unroll") for (int k = 0; k < 2; ++k) dst[m][k] = *(const LAS bf16x8*)(lds + PG8_SA(b, h) + aoff + m * 2048 + k * 1024); } while (0)
#define PG8_LDB(dst, b, h) do { _Pragma("unroll") for (int n = 0; n < 2; ++n) _Pragma("unroll") for (int k = 0; k < 2; ++k) dst[n][k] = *(const LAS bf16x8*)(lds + PG8_SB(b, h) + boff + n * 2048 + k * 1024); } while (0)
#define PG8_MMA(ai, bj, At_, Bt_) do { __builtin_amdgcn_s_setprio(1); _Pragma("unroll") for (int m = 0; m < 4; ++m) _Pragma("unroll") for (int n = 0; n < 2; ++n) _Pragma("unroll") for (int k = 0; k < 2; ++k) \
        acc[ai][bj][m][n] = __builtin_amdgcn_mfma_f32_16x16x32_bf16(Bt_[n][k], At_[m][k], acc[ai][bj][m][n], 0, 0, 0); __builtin_amdgcn_s_setprio(0); } while (0)
#define PG8_WAIT_V(n) asm volatile("s_waitcnt vmcnt(" #n ")" ::: "memory")
#define PG8_WAIT_L(n) asm volatile("s_waitcnt lgkmcnt(" #n ")" ::: "memory")
#define PG8_BAR __builtin_amdgcn_s_barrier()
#define PG8_SCHED __builtin_amdgcn_sched_barrier(0)
  G8Unit cur, nxt; int ui = 0;
  if (c >= nunits) return;
  g8::unit_of(c, nM, nN, cur.pm, cur.pn);
  f32x4 acc[2][2][4][2];
#pragma unroll
  for (int a = 0; a < 2; ++a)
#pragma unroll
    for (int b = 0; b < 2; ++b)
#pragma unroll
      for (int m = 0; m < 4; ++m)
#pragma unroll
        for (int n = 0; n < 2; ++n) acc[a][b][m][n] = (f32x4){0.f, 0.f, 0.f, 0.f};
  bf16x8 At[4][2], B0[2][2], B1[2][2];
  const char* cA = (const char*)Ag + (size_t)cur.pm * tstepA + (size_t)((cur.pn < pn_split ? acol0 : acol1) + (cur.pn / pn_mod) * ksplit_cols) * 2;
  const char* cB = (const char*)Btg + (size_t)(cur.pn % pn_mod) * tstep + (size_t)((cur.pn / pn_mod) * ksplit_cols) * 2;
  PG8_STAGE(PG8_SB(0, 0), cB, voffB); PG8_STAGE(PG8_SA(0, 0), cA, voffA); PG8_STAGE(PG8_SB(0, 1), cB + hstep, voffB); PG8_STAGE(PG8_SA(0, 1), cA + hstepA, voffA);
  if (wr == 1) PG8_BAR;
  PG8_WAIT_V(4); PG8_BAR;
  PG8_STAGE(PG8_SB(1, 0), cB + kstep, voffB); PG8_STAGE(PG8_SA(1, 0), cA + kstep, voffA); PG8_STAGE(PG8_SB(1, 1), cB + hstep + kstep, voffB);
  PG8_WAIT_V(6); PG8_BAR;
  for (;;) {
    const long Ln = (long)(ui + 1) * G + c;
    const bool has_next = Ln < nunits;
    if (has_next) g8::unit_of((int)Ln, nM, nN, nxt.pm, nxt.pn);
    const char* nA = has_next ? (const char*)Ag + (size_t)nxt.pm * tstepA + (size_t)((nxt.pn < pn_split ? acol0 : acol1) + (nxt.pn / pn_mod) * ksplit_cols) * 2 : cA;
    const char* nB = has_next ? (const char*)Btg + (size_t)(nxt.pn % pn_mod) * tstep + (size_t)((nxt.pn / pn_mod) * ksplit_cols) * 2 : cB;
    for (int t = 0; t < nt; t += 2) {
      const bool last = (t == nt - 2);
      const char* a1 = cA + (size_t)(t + 1) * kstep;
      const char* a2 = last ? nA : cA + (size_t)(t + 2) * kstep; const char* b2 = last ? nB : cB + (size_t)(t + 2) * kstep;
      const char* a3 = a2 + kstep; const char* b3 = b2 + kstep;
      PG8_LDB(B0, 0, 0); PG8_SCHED; PG8_LDA(At, 0, 0); PG8_STAGE(PG8_SA(1, 1), a1 + hstepA, voffA);
      PG8_WAIT_L(8); PG8_BAR; PG8_WAIT_L(0); PG8_MMA(0, 0, At, B0); PG8_BAR; PG8_SCHED;
      PG8_LDB(B1, 0, 1); PG8_STAGE(PG8_SB(0, 0), b2, voffB);
      PG8_BAR; PG8_WAIT_L(0); PG8_MMA(0, 1, At, B1); PG8_BAR;
      PG8_LDA(At, 0, 1); PG8_STAGE(PG8_SA(0, 0), a2, voffA);
      PG8_BAR; PG8_WAIT_L(0); PG8_MMA(1, 0, At, B0); PG8_BAR; PG8_SCHED;
      PG8_STAGE(PG8_SB(0, 1), b2 + hstep, voffB);
      PG8_WAIT_V(6); PG8_BAR; PG8_MMA(1, 1, At, B1); PG8_BAR;
      PG8_LDB(B0, 1, 0); PG8_SCHED; PG8_LDA(At, 1, 0); PG8_STAGE(PG8_SA(0, 1), a2 + hstepA, voffA);
      PG8_WAIT_L(8); PG8_BAR; PG8_WAIT_L(0); PG8_MMA(0, 0, At, B0); PG8_BAR; PG8_SCHED;
      PG8_LDB(B1, 1, 1); PG8_STAGE(PG8_SB(1, 0), b3, voffB);
      PG8_BAR; PG8_WAIT_L(0); PG8_MMA(0, 1, At, B1); PG8_BAR;
      PG8_LDA(At, 1, 1); PG8_STAGE(PG8_SA(1, 0), a3, voffA);
      PG8_BAR; PG8_WAIT_L(0); PG8_MMA(1, 0, At, B0); PG8_BAR; PG8_SCHED;
      PG8_STAGE(PG8_SB(1, 1), b3 + hstep, voffB);
      PG8_WAIT_V(6); PG8_BAR; PG8_MMA(1, 1, At, B1); PG8_BAR;
    }
    E(acc, cur, wr, wc, fr, fq);
    if (!has_next) break;
#pragma unroll
    for (int a = 0; a < 2; ++a)
#pragma unroll
      for (int b = 0; b < 2; ++b)
#pragma unroll
        for (int m = 0; m < 4; ++m)
#pragma unroll
          for (int n = 0; n < 2; ++n) acc[a][b][m][n] = (f32x4){0.f, 0.f, 0.f, 0.f};
    cur = nxt; cA = nA; cB = nB; ++ui;
  }
  PG8_WAIT_V(0);
  if (wr == 0) PG8_BAR;
  PG8_BAR;
#undef PG8_SA
#undef PG8_SB
#undef PG8_STAGE
#undef PG8_LDA
#undef PG8_LDB
#undef PG8_MMA
}

struct EpiZ {
  bf16* Z;
  DEVI void operator()(const f32x4 (&acc)[2][2][4][2], const G8Unit& u, int wr, int wc, int fr, int fq) const {
    const int brow = u.pm * 256, bcol = u.pn * 256;
#pragma unroll
    for (int ai = 0; ai < 2; ++ai)
#pragma unroll
      for (int m = 0; m < 4; ++m) {
        const int row = brow + ai * 128 + wr * 64 + m * 16 + fr;
#pragma unroll
        for (int bj = 0; bj < 2; ++bj) {
          const int col = bcol + bj * 128 + wc * 32 + 8 * fq;
          if (col < DIN) {
            const f32x4 v0 = acc[ai][bj][m][0], v1 = acc[ai][bj][m][1];
            *reinterpret_cast<uint4*>(Z + (size_t)row * DIN + col) = make_uint4(pack2(v0[0], v0[1]), pack2(v0[2], v0[3]), pack2(v1[0], v1[1]), pack2(v1[2], v1[3]));
          }
        }
      }
  }
};
DEVI void phase_gemm1_8(const Params& P, int l, unsigned char* smem_base) {
  EpiZ E{P.Z};
  gemm8_phase((LAS unsigned char*)smem_base, P.H, P.WinT + (size_t)l * DINP * 1024, 1024, NT / 256, DINP / 256, E);
  const int c = blockIdx.x;
  if (c >= 136) {
    const int j = c - 136;
    if (l == 0) convert_rows_fp6(P, 0, j * 100, j * 100 + 100);
    else { const int b0 = 19200 + j * 114; convert_rows_fp6(P, 1, b0 < 32768 ? b0 : 32768, b0 + 114 < 32768 ? b0 + 114 : 32768); }
  }
}

struct EpiRAW {
  bf16* R;
  DEVI void operator()(const f32x4 (&acc)[2][2][4][2], const G8Unit& u, int wr, int wc, int fr, int fq) const {
    const int brow = u.pm * 256, bcol = u.pn * 256;
#pragma unroll
    for (int ai = 0; ai < 2; ++ai)
#pragma unroll
      for (int m = 0; m < 4; ++m) {
        const int row = brow + ai * 128 + wr * 64 + m * 16 + fr;
#pragma unroll
        for (int bj = 0; bj < 2; ++bj) {
          const int col = bcol + bj * 128 + wc * 32 + 8 * fq;
          const f32x4 v0 = acc[ai][bj][m][0], v1 = acc[ai][bj][m][1];
          *reinterpret_cast<uint4*>(R + (size_t)row * 1792 + col) = make_uint4(pack2(v0[0], v0[1]), pack2(v0[2], v0[3]), pack2(v1[0], v1[1]), pack2(v1[2], v1[3]));
        }
      }
  }
};
DEVI void phase_mla_raw(const Params& P, int l, unsigned char* smem_base) {
  {
    const int lane = threadIdx.x & 63;
    for (int t = blockIdx.x * 8 + (threadIdx.x >> 6); t < NT; t += gridDim.x * 8) {
      const bf16* zr = P.Z + (size_t)t * DIN;
      const uint2 uq = *reinterpret_cast<const uint2*>(zr + ZC_BQ + lane * 4);
      const unsigned uk = *reinterpret_cast<const unsigned*>(zr + ZC_BKV + lane * 2);
      float sq = lo2f(uq.x) * lo2f(uq.x) + hi2f(uq.x) * hi2f(uq.x) + lo2f(uq.y) * lo2f(uq.y) + hi2f(uq.y) * hi2f(uq.y);
      float sk = lo2f(uk) * lo2f(uk) + hi2f(uk) * hi2f(uk);
      sq = wave_sum(sq); sk = wave_sum(sk);
      if (lane == 0) { P.RS[(size_t)t * 2] = rsqrtf(sq * (1.f / 256.f) + EPS); P.RS[(size_t)t * 2 + 1] = rsqrtf(sk * (1.f / 128.f) + EPS); }
    }
  }
  EpiRAW E{P.RAW};
  gemm8_phase((LAS unsigned char*)smem_base, P.Z, P.WCOMB + (size_t)l * 1792 * 256, 256, NT / 256, 7, E, DIN, 3, ZC_BQ, ZC_BKV);
}

struct EpiX {
  const float* x; const float* ctx; bf16* X; const float* MODl; int l;
  DEVI void operator()(const f32x4 (&acc)[2][2][4][2], const G8Unit& u, int wr, int wc, int fr, int fq) const {
    const int brow = u.pm * 256, bcol = u.pn * 256;
    const float* gate = MODl + (size_t)batch_of_row(brow) * 6144 + 2048;
#pragma unroll
    for (int ai = 0; ai < 2; ++ai)
#pragma unroll
      for (int m = 0; m < 4; ++m) {
        const int row = brow + ai * 128 + wr * 64 + m * 16 + fr;
        const float* res = row < NL ? x + (size_t)row * 1024 : ctx + (size_t)(row - NL) * 1024;
#pragma unroll
        for (int bj = 0; bj < 2; ++bj) {
          const int col = bcol + bj * 128 + wc * 32 + 8 * fq;
          const f32x4 v0 = acc[ai][bj][m][0], v1 = acc[ai][bj][m][1];
          float4 ra, rb;
          if (l == 0) { ra = *reinterpret_cast<const float4*>(res + col); rb = *reinterpret_cast<const float4*>(res + col + 4); }
          else {
            const uint4 uu = *reinterpret_cast<const uint4*>(X + (size_t)row * 1024 + col);
            ra = make_float4(lo2f(uu.x), hi2f(uu.x), lo2f(uu.y), hi2f(uu.y)); rb = make_float4(lo2f(uu.z), hi2f(uu.z), lo2f(uu.w), hi2f(uu.w));
          }
          const float4 ga = *reinterpret_cast<const float4*>(gate + col), gb = *reinterpret_cast<const float4*>(gate + col + 4);
          *reinterpret_cast<uint4*>(X + (size_t)row * 1024 + col) =
              make_uint4(pack2(ra.x + ga.x * v0[0], ra.y + ga.y * v0[1]), pack2(ra.z + ga.z * v0[2], ra.w + ga.w * v0[3]),
                         pack2(rb.x + gb.x * v1[0], rb.y + gb.y * v1[1]), pack2(rb.z + gb.z * v1[2], rb.w + gb.w * v1[3]));
        }
      }
  }
};
struct EpiPart {
  float* PART;
  DEVI void operator()(const f32x4 (&acc)[2][2][4][2], const G8Unit& u, int wr, int wc, int fr, int fq) const {
    const int brow = u.pm * 256, bcol = (u.pn & 3) * 256;
    float* base = PART + (size_t)(u.pn >> 2) * 2048 * 1024;
#pragma unroll
    for (int ai = 0; ai < 2; ++ai)
#pragma unroll
      for (int m = 0; m < 4; ++m) {
        const int row = brow + ai * 128 + wr * 64 + m * 16 + fr;
#pragma unroll
        for (int bj = 0; bj < 2; ++bj) {
          const int col = bcol + bj * 128 + wc * 32 + 8 * fq;
          const f32x4 v0 = acc[ai][bj][m][0], v1 = acc[ai][bj][m][1];
          *reinterpret_cast<float4*>(base + (size_t)row * 1024 + col) = make_float4(v0[0], v0[1], v0[2], v0[3]);
          *reinterpret_cast<float4*>(base + (size_t)row * 1024 + col + 4) = make_float4(v1[0], v1[1], v1[2], v1[3]);
        }
      }
  }
};
DEVI void phase_gemm2_8(const Params& P, int l, unsigned char* smem_base) {
  EpiX E{P.x, P.ctx, P.X, P.MOD + (size_t)l * 9 * 6144, l};
  gemm8_phase((LAS unsigned char*)smem_base, P.H, P.WoutT + (size_t)l * 1024 * 1024, 1024, NL / 256, 4, E);
  if (l == 0) {
    EpiPart EP{P.PART};
    gemm8_phase((LAS unsigned char*)smem_base, P.H + (size_t)NL * 1024, P.WoutT, 512, 8, 8, EP, 1024, 1 << 30, 0, 0, 1024, 4, 512);
    const int c = blockIdx.x;
    if (c >= 64) {
      const int b0 = 12000 + (c - 64) * 109;
      convert_rows_fp6(P, 0, b0 < 32768 ? b0 : 32768, b0 + 109 < 32768 ? b0 + 109 : 32768);
    }
  }
}

struct EpiQP {
  bf16* QP;
  DEVI void operator()(const f32x4 (&acc)[2][2][4][2], const G8Unit& u, int wr, int wc, int fr, int fq) const {
    const int brow = u.pm * 256, bcol = u.pn * 256;
#pragma unroll
    for (int ai = 0; ai < 2; ++ai)
#pragma unroll
      for (int m = 0; m < 4; ++m) {
        const int row = brow + ai * 128 + wr * 64 + m * 16 + fr;
#pragma unroll
        for (int bj = 0; bj < 2; ++bj) {
          const int col = bcol + bj * 128 + wc * 32 + 8 * fq;
          const f32x4 v0 = acc[ai][bj][m][0], v1 = acc[ai][bj][m][1];
          *reinterpret_cast<uint4*>(QP + (size_t)row * 2048 + col) = make_uint4(pack2(v0[0], v0[1]), pack2(v0[2], v0[3]), pack2(v1[0], v1[1]), pack2(v1[2], v1[3]));
        }
      }
  }
};
DEVI void phase_gemm3_8(const Params& P, int l, unsigned char* smem_base) {
  EpiQP E{P.QP};
  gemm8_phase((LAS unsigned char*)smem_base, P.H, P.WpqT + (size_t)l * 2048 * 1024, 1024, (l == 1) ? NL / 256 : NT / 256, 8, E);
  const int c = blockIdx.x;
  if (l == 0 && c >= 64) convert_rows_fp6(P, 1, (c - 64) * 100, (c - 64) * 100 + 100);
}

constexpr int N_PHASES = 2 + 2 * 11;

#ifndef REP_MASK
#define REP_MASK 0
#endif
static_assert(sizeof(Params) % 8 == 0, "Params size");
DEVI Params load_params() {
#if defined(__HIP_DEVICE_COMPILE__)
  typedef const __attribute__((address_space(4))) Params* ParamsCP;
  ParamsCP pp = (ParamsCP)__builtin_amdgcn_kernarg_segment_ptr();
  asm volatile("" : "+s"(pp));
  return *pp;
#else
  return Params{};
#endif
}
__global__ void __launch_bounds__(512, 2) fwd_kernel(Params Pk) {
  extern __shared__ __attribute__((aligned(16))) unsigned char smem_base[];
  volatile LAS unsigned* xst = (volatile LAS unsigned*)(smem_base + SMEM_BYTES);
  if (threadIdx.x == 0) { xst[0] = 0u; xst[1] = 0u; xst[2] = 0u; xst[3] = 0u; }
  __syncthreads();
  XcdBarrier xb = xcd_barrier_post(Pk.bar, xst);
  const int phase_lo = Pk.phase_lo, phase_hi = Pk.phase_hi, coop = Pk.coop;
#define smem (smem_base + VHALF * HALF_LDS)
#define GSYNC(idx) { xcd_barrier(xb); }
#define RUN_PHASE2(idx, call, repcall) \
  if (phase_lo <= (idx) && (idx) <= phase_hi) { { const Params P = load_params(); call; } if (REP_MASK & (1 << (idx))) { GSYNC(1); const Params P = load_params(); repcall; } if (coop && (idx) < phase_hi) GSYNC(idx); }
#define RUN_PHASE(idx, call) RUN_PHASE2(idx, call, call)
  RUN_PHASE(0, phase_prologue(P, smem))
  RUN_PHASE(1, phase_norm(P, 0, 0, NT))
  RUN_PHASE(2, phase_gemm1_8(P, 0, smem_base))
  RUN_PHASE(3, phase_mla_raw(P, 0, smem_base))
  RUN_PHASE(4, { phase_mixA(P, 0, smem); phase_mla_proj(P, 0, smem); phase_hgrn_local(P, 0, smem); })
  RUN_PHASE2(5, phase_attn_scan(P, 0, smem_base), phase_attn_scan(P, 0, smem_base, true))
  RUN_PHASE(6, phase_hgrn_final(P, 0, smem))
  RUN_PHASE(7, phase_gemm2_8(P, 0, smem_base))
  RUN_PHASE(8, phase_norm(P, 0, 1, NT))
  RUN_PHASE(9, phase_gemm3_8(P, 0, smem_base))
  RUN_PHASE(10, phase_route(P, 0, smem))
  RUN_PHASE(11, phase_peer_u(P, 0))
  RUN_PHASE(12, phase_peer(P, 0))
  RUN_PHASE(13, phase_gemm1_8(P, 1, smem_base))
  RUN_PHASE(14, phase_mla_raw(P, 1, smem_base))
  RUN_PHASE(15, { phase_mixA(P, 1, smem); phase_mla_proj(P, 1, smem); phase_hgrn_local(P, 1, smem); })
  RUN_PHASE2(16, phase_attn_scan(P, 1, smem_base), phase_attn_scan(P, 1, smem_base, true))
  RUN_PHASE(17, phase_hgrn_final(P, 1, smem))
  RUN_PHASE(18, phase_gemm2_8(P, 1, smem_base))
  RUN_PHASE(19, phase_norm(P, 1, 1, NL))
  RUN_PHASE(20, phase_gemm3_8(P, 1, smem_base))
  RUN_PHASE(21, phase_route(P, 1, smem))
  RUN_PHASE(22, phase_peer_u(P, 1))
  RUN_PHASE(23, phase_peer(P, 1))
#undef smem
}

extern "C" void kernel_launch(void* const* d_in, const int* in_sizes, int n_in, void* d_out, int out_size, void* d_ws,
                              size_t ws_size, hipStream_t stream) {
  Params p{};
  const float* const* in = reinterpret_cast<const float* const*>(d_in);
  p.x = in[0]; p.c = in[1]; p.ctx = in[2]; p.c_ctx = in[3]; p.ln1_w = in[4]; p.ln2_w = in[5]; p.w_mod = in[6]; p.b_mod = in[7];
  p.w_in = in[8]; p.w_out = in[9]; p.a_norm_w = in[10]; p.a_w_s = in[11]; p.a_b_s = in[12]; p.b_q_norm_w = in[13]; p.b_w_uq = in[14];
  p.b_kv_norm_w = in[15]; p.b_w_ukv = in[16]; p.b_qh_w = in[17]; p.b_kh_w = in[18]; p.c_lb = in[19]; p.c_out_norm_w = in[20];
  p.p_w_q = in[21]; p.p_sub_keys = in[22]; p.p_u = in[23]; p.p_v = in[24];
  p.out = reinterpret_cast<float*>(d_out);
  unsigned char* ws = reinterpret_cast<unsigned char*>(d_ws);
  size_t off = 0;
  auto take = [&](size_t bytes) { unsigned char* r = ws + off; off += (bytes + 255) & ~(size_t)255; return r; };
  p.bar = (unsigned*)take((size_t)XCD_BAR_WORDS * 4);
  p.MOD = (float*)take((size_t)2 * 9 * 6144 * 4);
  p.ROPE = (float*)take((size_t)2048 * 32 * 4);
  p.WinT = (bf16*)take((size_t)2 * DINP * 1024 * 2);
  p.WoutT = (bf16*)take((size_t)2 * 1024 * 1024 * 2);
  p.WpqT = (bf16*)take((size_t)2 * 2048 * 1024 * 2);
  p.WCOMB = (bf16*)take((size_t)2 * 1792 * 256 * 2);
  p.RAW = (bf16*)take((size_t)NT * 1792 * 2);
  p.SK = (bf16*)take((size_t)2 * 16 * 128 * 128 * 2);
  p.AWS = (bf16*)take((size_t)2 * 4 * 128 * 128 * 2);
  p.PU8 = (unsigned char*)take((size_t)2 * 16384 * 576);
  p.PV8 = (unsigned char*)take((size_t)2 * 16384 * 576);
  p.PUS = (float*)take((size_t)2 * 16384 * 4);
  p.PVS = (float*)take((size_t)2 * 16384 * 4);
  p.X = (bf16*)take((size_t)NT * 1024 * 2);
  p.H = (bf16*)take((size_t)NT * 1024 * 2);
  p.Z = (bf16*)take((size_t)NT * DIN * 2);
  p.Q = (bf16*)take((size_t)64 * SEQP * 96 * 2);
  p.K = (bf16*)take((size_t)64 * SEQP * 96 * 2);
  p.VT = (bf16*)take((size_t)64 * 64 * SEQP * 2);
  p.ST = (bf16*)take((size_t)64 * 36 * 4096 * 2);
  p.DEC = (float*)take((size_t)64 * 36 * 64 * 4);
  p.OI = (bf16*)take((size_t)NT * 256 * 2);
  p.WPE = (float*)take((size_t)NT * 128 * 4);
  p.PART = (float*)take((size_t)2 * 2048 * 1024 * 4);
  p.RS = (float*)take((size_t)NT * 2 * 4);
  p.GQF = (bf16*)take((size_t)NT * 256 * 2);
  p.GQB = (bf16*)take((size_t)NT * 256 * 2);
  p.QP = p.Z;
  p.EIDX = (int*)p.Q;
  p.GATE = (float*)p.K;
  if (off > ws_size) { fprintf(stderr, "workspace too small: need %zu have %zu\n", off, ws_size); }
  static int grid_blocks = 0;
  if (!grid_blocks) {
    if (hipFuncSetAttribute((const void*)fwd_kernel, hipFuncAttributeMaxDynamicSharedMemorySize, SMEM_TOTAL) != hipSuccess)
      fprintf(stderr, "hipFuncSetAttribute failed\n");
    int dev = 0, cus = 0, per_cu = 0;
    hipGetDevice(&dev);
    hipDeviceGetAttribute(&cus, hipDeviceAttributeMultiprocessorCount, dev);
    hipOccupancyMaxActiveBlocksPerMultiprocessor(&per_cu, (const void*)fwd_kernel, 512, SMEM_TOTAL);
    if (per_cu > 1) per_cu = 1;
    if (per_cu < 1) { fprintf(stderr, "occupancy query returned %d\n", per_cu); per_cu = 1; }
    grid_blocks = cus * per_cu;
    fprintf(stderr, "grid_blocks=%d (cus=%d per_cu=%d) ws need=%zu have=%zu\n", grid_blocks, cus, per_cu, off, ws_size);
  }
  hipMemsetAsync(p.bar, 0, (size_t)XCD_BAR_WORDS * 4, stream);
  p.coop = 1; p.phase_lo = 0; p.phase_hi = N_PHASES - 1;
  hipLaunchKernelGGL(fwd_kernel, dim3(grid_blocks), dim3(512), SMEM_TOTAL, stream, p);
  const hipError_t e = hipPeekAtLastError();
  if (e != hipSuccess) fprintf(stderr, "launch failed: %s (grid %d)\n", hipGetErrorString(e), grid_blocks);
}
```

```cpp
#include <hip/hip_runtime.h>
#include <hip/hip_cooperative_groups.h>
#include <cstdio>
#include <cstdint>
namespace cg = cooperative_groups;

#define DEVI __device__ __forceinline__

typedef unsigned short bf16;
using bf16x8 = __attribute__((ext_vector_type(8))) __bf16;
using bf16x2 = __attribute__((ext_vector_type(2))) __bf16;
using f32x16 = __attribute__((ext_vector_type(16))) float;
typedef unsigned v6u __attribute__((ext_vector_type(6)));
typedef unsigned v3u __attribute__((ext_vector_type(3)));
typedef float v16f __attribute__((ext_vector_type(16)));
typedef float v32f __attribute__((ext_vector_type(32)));

constexpr int NL = 16384;
constexpr int NT = 18432;
constexpr int DM = 1024;
constexpr int DIN = 2208;
constexpr int DINP = 2304;
constexpr int SEQP = 2304;
constexpr float EPS = 1e-6f;
constexpr int ZC_AU = 0, ZC_AV = 256, ZC_BQ = 512, ZC_BKV = 768, ZC_BKR = 896, ZC_CQ = 928, ZC_CFF = 1184, ZC_CFB = 1440, ZC_CI = 1696, ZC_CG = 1952;
constexpr int SMEM_BYTES = 2 * 80896;
constexpr int SMEM_TOTAL = SMEM_BYTES + 16;

struct Params {
  const float *x, *c, *ctx, *c_ctx, *ln1_w, *ln2_w, *w_mod, *b_mod, *w_in, *w_out, *a_norm_w, *a_w_s, *a_b_s;
  const float *b_q_norm_w, *b_w_uq, *b_kv_norm_w, *b_w_ukv, *b_qh_w, *b_kh_w, *c_lb, *c_out_norm_w, *p_w_q, *p_sub_keys, *p_u, *p_v;
  float* out;
  unsigned* bar;
  float* MOD;
  float* ROPE;
  bf16* WinT;
  bf16* WoutT;
  bf16* WpqT;
  bf16* WCOMB;
  bf16* RAW;
  bf16* SK;
  bf16* AWS;
  unsigned char* PU8;
  unsigned char* PV8;
  float* PUS;
  float* PVS;
  bf16* X;
  bf16* H;
  bf16* Z;
  bf16* Q;
  bf16* K;
  bf16* VT;
  bf16* ST;
  float* DEC;
  bf16* OI;
  float* WPE;
  float* RS;
  float* PART;
  bf16* GQF;
  bf16* GQB;
  bf16* QP;
  int* EIDX;
  float* GATE;
  int phase_lo, phase_hi, coop, pad0;
};

DEVI float bf2f(bf16 v) { return __uint_as_float(((unsigned)v) << 16); }
DEVI bf16 f2bf(float a) { __bf16 v = (__bf16)a; return __builtin_bit_cast(unsigned short, v); }
DEVI unsigned pack2(float a, float b) { bf16x2 v; v[0] = (__bf16)a; v[1] = (__bf16)b; return __builtin_bit_cast(unsigned, v); }
DEVI float lo2f(unsigned u) { return __uint_as_float(u << 16); }
DEVI float hi2f(unsigned u) { return __uint_as_float(u & 0xffff0000u); }
DEVI f32x16 zero16() { f32x16 z;
#pragma unroll
  for (int i = 0; i < 16; ++i) z[i] = 0.f; return z; }
DEVI f32x16 mfma32(bf16x8 a, bf16x8 b, f32x16 c) { return __builtin_amdgcn_mfma_f32_32x32x16_bf16(a, b, c, 0, 0, 0); }
DEVI bf16x8 ldfrag(const bf16* p) { return *reinterpret_cast<const bf16x8*>(p); }
DEVI int drow(int r, int hh) { return (r & 3) + 8 * (r >> 2) + 4 * hh; }
DEVI int row_of(int b, int p) { return p < 256 ? NL + b * 256 + p : b * 2048 + (p - 256); }
DEVI int batch_of_row(int r) { return r < NL ? (r >> 11) : 8; }
DEVI float wave_sum(float v) {
#pragma unroll
  for (int o = 32; o > 0; o >>= 1) v += __shfl_xor(v, o);
  return v;
}
DEVI float sigmoidf_(float z) { return 1.f / (1.f + __expf(-z)); }


#define XB_TMO      128
#define XB_XCNT(j)  (256  + 64 * (j))
#define XB_XSUB(j)  (1280 + 64 * (j))
#define XB_XGEN(j)  (2304 + 64 * (j))
#define XB_TOP      3328
#define XB_TOPGEN   3392
#define XCD_BAR_WORDS 3456
#define XB_SPIN_CAP (1u << 22)
#define LAS __attribute__((address_space(3)))
DEVI unsigned xb_ld(unsigned* p)              { return __hip_atomic_load(p, __ATOMIC_RELAXED, __HIP_MEMORY_SCOPE_AGENT); }
DEVI unsigned xb_add(unsigned* p, unsigned v) { return __hip_atomic_fetch_add(p, v, __ATOMIC_RELAXED, __HIP_MEMORY_SCOPE_AGENT); }
DEVI unsigned xb_xcc_id() { return (unsigned)__builtin_amdgcn_s_getreg((3 << 11) | 20) & 0xFu; }
#define XB_SPIN(cond, bar) do { unsigned _sp = 0; while (cond) { __builtin_amdgcn_s_sleep(1); \
    if ((++_sp & 255u) == 0u) { if (xb_ld(&(bar)[XB_TMO])) break; if (_sp > XB_SPIN_CAP) { atomicAdd(&(bar)[XB_TMO], 1u); break; } } } } while (0)
struct XcdBarrier { unsigned* bar; unsigned x; volatile LAS unsigned* st; };
DEVI XcdBarrier xcd_barrier_post(unsigned* bar, volatile LAS unsigned* st) {
  XcdBarrier b; b.bar = bar; b.x = xb_xcc_id(); b.st = st;
  if (threadIdx.x == 0) (void)xb_add(&bar[XB_XCNT(b.x)], 1u);
  return b;
}
DEVI void xcd_barrier_complete(unsigned* bar, unsigned x, unsigned& nloc, unsigned& nx) {
  const unsigned G = gridDim.x * gridDim.y * gridDim.z;
  unsigned sum, cnt, mine, sp = 0u;
  for (;;) {
    sum = 0u; cnt = 0u; mine = 0u;
#pragma unroll
    for (unsigned j = 0; j < 16; ++j) { const unsigned c = xb_ld(&bar[XB_XCNT(j)]); sum += c; cnt += (c > 0u) ? 1u : 0u; mine = (j == x) ? c : mine; }
    if (sum == G) break;
    __builtin_amdgcn_s_sleep(1);
    if ((++sp & 255u) == 0u) { if (xb_ld(&bar[XB_TMO])) break; if (sp > XB_SPIN_CAP) { atomicAdd(&bar[XB_TMO], 1u); break; } }
  }
  nloc = mine > 0u ? mine : 1u; nx = cnt > 0u ? cnt : 1u;
}
DEVI void xcd_barrier(const XcdBarrier& b) {
  asm volatile("s_waitcnt vmcnt(0)" ::: "memory");
  __syncthreads();
  if (threadIdx.x == 0) {
    unsigned* bar = b.bar;
    __builtin_amdgcn_s_waitcnt(0);
    unsigned nloc = b.st[0], nx = b.st[1];
    if (nloc == 0u) { xcd_barrier_complete(bar, b.x, nloc, nx); b.st[0] = nloc; b.st[1] = nx; }
    const unsigned old = xb_add(&bar[XB_XSUB(b.x)], 1u);
    const unsigned gen = old / nloc;
    if (old + 1u == (gen + 1u) * nloc) {
      __builtin_amdgcn_fence(__ATOMIC_RELEASE, "agent");
      asm volatile("s_waitcnt vmcnt(0)" ::: "memory");
      const unsigned og = xb_add(&bar[XB_TOP], 1u);
      const unsigned tg = og / nx;
      if (og + 1u == (tg + 1u) * nx) xb_add(&bar[XB_TOPGEN], 1u);
      else XB_SPIN(xb_ld(&bar[XB_TOPGEN]) == tg, bar);
      __builtin_amdgcn_fence(__ATOMIC_ACQUIRE, "agent");
      xb_add(&bar[XB_XGEN(b.x)], 1u);
      asm volatile("s_waitcnt vmcnt(0)" ::: "memory");
    } else {
      XB_SPIN(xb_ld(&bar[XB_XGEN(b.x)]) == gen, bar);
      __builtin_amdgcn_fence(__ATOMIC_ACQUIRE, "agent");
      asm volatile("s_waitcnt vmcnt(0)" ::: "memory");
    }
  }
  __syncthreads();
}

#define VHALF ((int)__builtin_amdgcn_readfirstlane((int)(threadIdx.x >> 8)))
#define TIDX ((int)(threadIdx.x & 255))
#define VBID ((int)(blockIdx.x * 2 + VHALF))
#define NVB ((int)(gridDim.x * 2))
constexpr int HALF_LDS = 80896;

DEVI void hb_sync() {
  extern __shared__ __attribute__((aligned(16))) unsigned char hb_smem[];
  LAS unsigned* cnt = (LAS unsigned*)(hb_smem + SMEM_BYTES) + 2 + VHALF;
  __builtin_amdgcn_fence(__ATOMIC_RELEASE, "workgroup");
  if ((threadIdx.x & 63) == 0) {
    const unsigned old = __hip_atomic_fetch_add(cnt, 1u, __ATOMIC_RELAXED, __HIP_MEMORY_SCOPE_WORKGROUP);
    const unsigned target = (old / 4u + 1u) * 4u;
    while (__hip_atomic_load(cnt, __ATOMIC_RELAXED, __HIP_MEMORY_SCOPE_WORKGROUP) < target) __builtin_amdgcn_s_sleep(0);
  }
  __builtin_amdgcn_fence(__ATOMIC_ACQUIRE, "workgroup");
}

DEVI void phase_mod(const Params& P, unsigned char* smem) {
  const int tid = TIDX;
  float* s = (float*)smem;
  float* red = s + 9 * 1024;
  for (int item = VBID; item < 192; item += NVB) {
    const int l = item / 96, j = item % 96;
    hb_sync();
    for (int i = tid; i < 9 * 1024; i += 256) {
      int bi = i >> 10, k = i & 1023;
      float v = bi < 8 ? P.c[bi * 1024 + k] : P.c_ctx[k];
      s[i] = v * sigmoidf_(v);
    }
    hb_sync();
    const int c4 = tid & 15, kg = tid >> 4;
    float acc[9][4];
#pragma unroll
    for (int bi = 0; bi < 9; ++bi) { acc[bi][0] = acc[bi][1] = acc[bi][2] = acc[bi][3] = 0.f; }
    const float* w = P.w_mod + (size_t)l * 1024 * 6144 + j * 64 + c4 * 4;
#pragma unroll 4
    for (int kk = 0; kk < 64; ++kk) {
      const int k = kg * 64 + kk;
      const float4 w4 = *reinterpret_cast<const float4*>(w + (size_t)k * 6144);
#pragma unroll
      for (int bi = 0; bi < 9; ++bi) {
        const float sv = s[bi * 1024 + k];
        acc[bi][0] += sv * w4.x; acc[bi][1] += sv * w4.y; acc[bi][2] += sv * w4.z; acc[bi][3] += sv * w4.w;
      }
    }
#pragma unroll
    for (int bi = 0; bi < 9; ++bi)
#pragma unroll
      for (int e = 0; e < 4; ++e) red[(kg * 9 + bi) * 64 + c4 * 4 + e] = acc[bi][e];
    hb_sync();
    for (int o = tid; o < 576; o += 256) {
      const int bi = o >> 6, cc = o & 63;
      float sum = 0.f;
#pragma unroll
      for (int g = 0; g < 16; ++g) sum += red[(g * 9 + bi) * 64 + cc];
      P.MOD[(size_t)(l * 9 + bi) * 6144 + j * 64 + cc] = sum + P.b_mod[l * 6144 + j * 64 + cc];
    }
  }
}

DEVI void conv_T_tile(const float* __restrict__ src, int N, bf16* __restrict__ dst, int Kd, int k0, int n0,
                      const float* __restrict__ kscale, float* tile) {
  const int tid = TIDX;
  hb_sync();
  for (int e = tid; e < 4096; e += 256) {
    const int i = e >> 6, j = e & 63, n = n0 + j;
    float v = (n < N) ? src[(size_t)(k0 + i) * N + n] : 0.f;
    if (kscale) v *= kscale[k0 + i];
    tile[i * 65 + j] = v;
  }
  hb_sync();
  for (int e = tid; e < 2048; e += 256) {
    const int j = e >> 5, i2 = (e & 31) * 2;
    const unsigned pk = pack2(tile[i2 * 65 + j], tile[(i2 + 1) * 65 + j]);
    *reinterpret_cast<unsigned*>(&dst[(size_t)(n0 + j) * Kd + k0 + i2]) = pk;
  }
}

DEVI void conv_straight(const float* __restrict__ src, bf16* __restrict__ dst, size_t n8) {
  const size_t stride = (size_t)NVB * 256;
  for (size_t i = (size_t)VBID * 256 + TIDX; i < n8; i += stride) {
    const float4 a = reinterpret_cast<const float4*>(src)[2 * i];
    const float4 b = reinterpret_cast<const float4*>(src)[2 * i + 1];
    uint4 o; o.x = pack2(a.x, a.y); o.y = pack2(a.z, a.w); o.z = pack2(b.x, b.y); o.w = pack2(b.z, b.w);
    reinterpret_cast<uint4*>(dst)[i] = o;
  }
}

DEVI void convert_rows_fp6(const Params& P, int L, int i0, int i1) {
  const int lane = threadIdx.x & 63, half = lane >> 5, l32 = lane & 31;
  const int wv = threadIdx.x >> 6;
  for (int ib = i0 + wv * 2; ib < i1; ib += 16) {
    int i = ib + half; const bool live = i < i1; if (!live) i = i1 - 1;
    const int table = i >> 14, lr = L * 16384 + (i & 16383);
    const float* src = (table ? P.p_v : P.p_u) + (size_t)lr * 1024 + l32 * 32;
    float4 a[8];
    float m = 0.f;
#pragma unroll
    for (int q = 0; q < 8; ++q) {
      a[q] = *reinterpret_cast<const float4*>(src + q * 4);
      m = fmaxf(m, fmaxf(fmaxf(fabsf(a[q].x), fabsf(a[q].y)), fmaxf(fabsf(a[q].z), fabsf(a[q].w))));
    }
    const unsigned sb = (__float_as_uint(fmaxf(m, 1e-30f) * (1.f / 6.f)) + 0xffffu) >> 16;
    const float inv = 1.f / __uint_as_float(sb << 16);
    unsigned pk[4];
#pragma unroll
    for (int w = 0; w < 4; ++w) {
      unsigned word = 0u;
#pragma unroll
      for (int e = 0; e < 8; ++e) {
        const int idx = w * 8 + e;
        const float4 q4 = a[idx >> 2];
        const float xv = ((idx & 3) == 0 ? q4.x : (idx & 3) == 1 ? q4.y : (idx & 3) == 2 ? q4.z : q4.w) * inv;
        const float av = fabsf(xv);
        unsigned ci = (av > 0.25f) + (av > 0.75f) + (av > 1.25f) + (av > 1.75f) + (av > 2.5f) + (av > 3.5f) + (av > 5.f);
        ci |= (xv < 0.f) ? 8u : 0u;
        word |= ci << (4 * e);
      }
      pk[w] = word;
    }
    unsigned char* rowp = (table ? P.PV8 : P.PU8) + (size_t)lr * 576;
    if (live) {
      *reinterpret_cast<uint4*>(rowp + l32 * 16) = make_uint4(pk[0], pk[1], pk[2], pk[3]);
      *reinterpret_cast<unsigned short*>(rowp + 512 + l32 * 2) = (unsigned short)sb;
    }
  }
}

DEVI void phase_prologue(const Params& P, unsigned char* smem) {
  phase_mod(P, smem);
  float* tile = (float*)smem;
  for (int it = VBID; it < 2 * 1424; it += NVB) {
    const int l = it / 1424; int r = it % 1424;
    if (r < 576) { conv_T_tile(P.w_in + (size_t)l * 1024 * DIN, DIN, P.WinT + (size_t)l * DINP * 1024, 1024, (r % 16) * 64, (r / 16) * 64, nullptr, tile); continue; }
    r -= 576;
    if (r < 256) { conv_T_tile(P.w_out + (size_t)l * 1024 * 1024, 1024, P.WoutT + (size_t)l * 1024 * 1024, 1024, (r % 16) * 64, (r / 16) * 64, nullptr, tile); continue; }
    r -= 256;
    if (r < 512) { conv_T_tile(P.p_w_q + (size_t)l * 1024 * 2048, 2048, P.WpqT + (size_t)l * 2048 * 1024, 1024, (r % 16) * 64, (r / 16) * 64, nullptr, tile); continue; }
    r -= 512;
    if (r < 48) { conv_T_tile(P.b_w_uq + (size_t)l * 256 * 768, 768, P.WCOMB + (size_t)l * 1792 * 256, 256, (r % 4) * 64, (r / 4) * 64, P.b_q_norm_w + l * 256, tile); continue; }
    r -= 48;
    conv_T_tile(P.b_w_ukv + (size_t)l * 128 * 1024, 1024, P.WCOMB + (size_t)l * 1792 * 256 + 768 * 256, 256, (r % 2) * 64, (r / 2) * 64, P.b_kv_norm_w + l * 128, tile);
  }
  for (int i = VBID * 256 + TIDX; i < 2 * 1024 * 16; i += NVB * 256) {
    const int l2 = i >> 14, rr = (i >> 4) & 1023, cc = i & 15;
    *reinterpret_cast<uint4*>(P.WCOMB + (size_t)l2 * 1792 * 256 + (size_t)(768 + rr) * 256 + 128 + cc * 8) = make_uint4(0u, 0u, 0u, 0u);
  }
  conv_straight(P.p_sub_keys, P.SK, (size_t)2 * 16 * 128 * 128 / 8);
  conv_straight(P.a_w_s, P.AWS, (size_t)2 * 4 * 128 * 128 / 8);
  for (int i = VBID * 256 + TIDX; i < 2048 * 16; i += NVB * 256) {
    const int t = i >> 4, a = (i >> 3) & 1, f = i & 7;
    const float inv = powf(10000.f, -(float)f / 8.f);
    const float pos = a ? (float)(t & 63) : (float)(t >> 6);
    const float ang = pos * inv;
    P.ROPE[t * 32 + a * 8 + f] = cosf(ang);
    P.ROPE[t * 32 + 16 + a * 8 + f] = sinf(ang);
  }
}

DEVI void phase_norm(const Params& P, int l, int which, int nrows) {
  const int lane = TIDX & 63;
  const int gw = VBID * 4 + (TIDX >> 6), nw = NVB * 4;
  const float* lnw = (which == 0 ? P.ln1_w : P.ln2_w) + l * 1024;
  for (int r = gw; r < nrows; r += nw) {
    const float* mod = P.MOD + (size_t)(l * 9 + batch_of_row(r)) * 6144 + which * 3072;
    float4 v[4];
    float ss = 0.f;
    if (which == 0 && l == 0) {
      const float* src = r < NL ? P.x + (size_t)r * 1024 : P.ctx + (size_t)(r - NL) * 1024;
#pragma unroll
      for (int i = 0; i < 4; ++i) v[i] = *reinterpret_cast<const float4*>(src + i * 256 + lane * 4);
    } else if (which == 1 && l == 0 && r >= NL) {
      const float* cin = P.ctx + (size_t)(r - NL) * 1024;
      const float* p0 = P.PART + (size_t)(r - NL) * 1024;
      const float* p1 = p0 + (size_t)2048 * 1024;
      const float* gate = P.MOD + (size_t)8 * 6144 + 2048;
#pragma unroll
      for (int i = 0; i < 4; ++i) {
        const int d = i * 256 + lane * 4;
        const float4 c4 = *reinterpret_cast<const float4*>(cin + d), a4 = *reinterpret_cast<const float4*>(p0 + d), b4 = *reinterpret_cast<const float4*>(p1 + d);
        const float4 g4 = *reinterpret_cast<const float4*>(gate + d);
        v[i] = make_float4(c4.x + g4.x * (a4.x + b4.x), c4.y + g4.y * (a4.y + b4.y), c4.z + g4.z * (a4.z + b4.z), c4.w + g4.w * (a4.w + b4.w));
        *reinterpret_cast<uint2*>(P.X + (size_t)r * 1024 + d) = make_uint2(pack2(v[i].x, v[i].y), pack2(v[i].z, v[i].w));
      }
    } else {
      const bf16* src = P.X + (size_t)r * 1024;
#pragma unroll
      for (int i = 0; i < 4; ++i) {
        const uint2 u = *reinterpret_cast<const uint2*>(src + i * 256 + lane * 4);
        v[i] = make_float4(lo2f(u.x), hi2f(u.x), lo2f(u.y), hi2f(u.y));
      }
    }
#pragma unroll
    for (int i = 0; i < 4; ++i) ss += v[i].x * v[i].x + v[i].y * v[i].y + v[i].z * v[i].z + v[i].w * v[i].w;
    ss = wave_sum(ss);
    const float rr = rsqrtf(ss * (1.f / 1024.f) + EPS);
#pragma unroll
    for (int i = 0; i < 4; ++i) {
      const int d = i * 256 + lane * 4;
      const float4 w = *reinterpret_cast<const float4*>(lnw + d);
      const float4 sh = *reinterpret_cast<const float4*>(mod + d);
      const float4 sc = *reinterpret_cast<const float4*>(mod + 1024 + d);
      const float o0 = v[i].x * rr * w.x * (1.f + sc.x) + sh.x;
      const float o1 = v[i].y * rr * w.y * (1.f + sc.y) + sh.y;
      const float o2 = v[i].z * rr * w.z * (1.f + sc.z) + sh.z;
      const float o3 = v[i].w * rr * w.w * (1.f + sc.w) + sh.w;
      uint2 o; o.x = pack2(o0, o1); o.y = pack2(o2, o3);
      *reinterpret_cast<uint2*>(P.H + (size_t)r * 1024 + d) = o;
    }
  }
}

template <int BM, int BN, int BK, int WM, int WN>
struct Gemm {
  static constexpr int LDK = BK + 8;
  static constexpr int TM = BM / WM / 32, TN = BN / WN / 32;
  static constexpr int CPR = BK / 8;
  static constexpr int NA = BM * CPR / 256, NB = BN * CPR / 256;
  static constexpr int A_BYTES = BM * LDK * 2, B_BYTES = BN * LDK * 2;
  static constexpr int STAGE_BYTES = A_BYTES + B_BYTES;
  static constexpr int SMEM = 2 * STAGE_BYTES;

  static DEVI void run(const bf16* __restrict__ A, int lda, const bf16* __restrict__ BT, int ldb, int K,
                       unsigned char* smem, f32x16 (&acc)[TM][TN]) {
    const int tid = TIDX, lane = tid & 63, wave = tid >> 6;
    const int wm = wave / WN, wn = wave % WN;
    const int l31 = lane & 31, hh = lane >> 5;
#pragma unroll
    for (int i = 0; i < TM; ++i)
#pragma unroll
      for (int j = 0; j < TN; ++j) acc[i][j] = zero16();
    uint4 ra[NA], rb[NB];
    const int nk = K / BK;
    auto gload = [&](int kt) {
#pragma unroll
      for (int i = 0; i < NA; ++i) { const int ch = tid + i * 256, row = ch / CPR, cc = ch % CPR;
        ra[i] = *reinterpret_cast<const uint4*>(A + (size_t)row * lda + kt * BK + cc * 8); }
#pragma unroll
      for (int i = 0; i < NB; ++i) { const int ch = tid + i * 256, row = ch / CPR, cc = ch % CPR;
        rb[i] = *reinterpret_cast<const uint4*>(BT + (size_t)row * ldb + kt * BK + cc * 8); }
    };
    auto swrite = [&](int buf) {
      bf16* sA = reinterpret_cast<bf16*>(smem + buf * STAGE_BYTES);
      bf16* sB = reinterpret_cast<bf16*>(smem + buf * STAGE_BYTES + A_BYTES);
#pragma unroll
      for (int i = 0; i < NA; ++i) { const int ch = tid + i * 256, row = ch / CPR, cc = ch % CPR;
        *reinterpret_cast<uint4*>(sA + row * LDK + cc * 8) = ra[i]; }
#pragma unroll
      for (int i = 0; i < NB; ++i) { const int ch = tid + i * 256, row = ch / CPR, cc = ch % CPR;
        *reinterpret_cast<uint4*>(sB + row * LDK + cc * 8) = rb[i]; }
    };
    __syncthreads();
    gload(0);
    swrite(0);
    __syncthreads();
    for (int kt = 0; kt < nk; ++kt) {
      const int cur = kt & 1;
      if (kt + 1 < nk) gload(kt + 1);
      const bf16* sA = reinterpret_cast<const bf16*>(smem + cur * STAGE_BYTES);
      const bf16* sB = reinterpret_cast<const bf16*>(smem + cur * STAGE_BYTES + A_BYTES);
#pragma unroll
      for (int ks = 0; ks < BK / 16; ++ks) {
        bf16x8 af[TM], bfr[TN];
#pragma unroll
        for (int i = 0; i < TM; ++i) af[i] = ldfrag(sA + (wm * (BM / WM) + i * 32 + l31) * LDK + ks * 16 + hh * 8);
#pragma unroll
        for (int j = 0; j < TN; ++j) bfr[j] = ldfrag(sB + (wn * (BN / WN) + j * 32 + l31) * LDK + ks * 16 + hh * 8);
#pragma unroll
        for (int i = 0; i < TM; ++i)
#pragma unroll
          for (int j = 0; j < TN; ++j) acc[i][j] = mfma32(af[i], bfr[j], acc[i][j]);
      }
      if (kt + 1 < nk) swrite(cur ^ 1);
      __syncthreads();
    }
  }
};

DEVI void phase_gemm1(const Params& P, int l, unsigned char* smem) {
  using G = Gemm<128, 128, 64, 2, 2>;
  const int lane = TIDX & 63, wave = TIDX >> 6, wm = wave >> 1, wn = wave & 1, l31 = lane & 31, hh = lane >> 5;
  const bf16* W = P.WinT + (size_t)l * DINP * 1024;
  for (int t = VBID; t < 144 * 18; t += NVB) {
    const int mt = t / 18, nt = t % 18;
    f32x16 acc[2][2];
    G::run(P.H + (size_t)mt * 128 * 1024, 1024, W + (size_t)nt * 128 * 1024, 1024, 1024, smem, acc);
#pragma unroll
    for (int i = 0; i < 2; ++i)
#pragma unroll
      for (int j = 0; j < 2; ++j) {
        const int col = nt * 128 + wn * 64 + j * 32 + l31;
        if (col < DIN) {
#pragma unroll
          for (int r = 0; r < 16; ++r) {
            const int row = mt * 128 + wm * 64 + i * 32 + drow(r, hh);
            P.Z[(size_t)row * DIN + col] = f2bf(acc[i][j][r]);
          }
        }
      }
  }
}

DEVI void phase_gemm2(const Params& P, int l, unsigned char* smem) {
  using G = Gemm<128, 128, 64, 2, 2>;
  const int lane = TIDX & 63, wave = TIDX >> 6, wm = wave >> 1, wn = wave & 1, l31 = lane & 31, hh = lane >> 5;
  const bf16* W = P.WoutT + (size_t)l * 1024 * 1024;
  const int mtiles = (l == 1) ? 128 : 144;
  for (int t = VBID; t < mtiles * 8; t += NVB) {
    const int mt = t / 8, nt = t % 8;
    f32x16 acc[2][2];
    G::run(P.H + (size_t)mt * 128 * 1024, 1024, W + (size_t)nt * 128 * 1024, 1024, 1024, smem, acc);
    const int bi = batch_of_row(mt * 128);
    const float* gate = P.MOD + (size_t)(l * 9 + bi) * 6144 + 2048;
#pragma unroll
    for (int i = 0; i < 2; ++i)
#pragma unroll
      for (int j = 0; j < 2; ++j) {
        const int col = nt * 128 + wn * 64 + j * 32 + l31;
        const float g = gate[col];
#pragma unroll
        for (int r = 0; r < 16; ++r) {
          const int row = mt * 128 + wm * 64 + i * 32 + drow(r, hh);
          float res;
          if (l == 0) res = row < NL ? P.x[(size_t)row * 1024 + col] : P.ctx[(size_t)(row - NL) * 1024 + col];
          else res = bf2f(P.X[(size_t)row * 1024 + col]);
          P.X[(size_t)row * 1024 + col] = f2bf(res + g * acc[i][j][r]);
        }
      }
  }
}

DEVI void phase_mixA(const Params& P, int l, unsigned char* smem) {
  const int tid = TIDX, lane = tid & 63, wave = tid >> 6, l31 = lane & 31, hh = lane >> 5;
  bf16* VNT = reinterpret_cast<bf16*>(smem);
  constexpr int LDV = 136;
  const int nseg = (l == 1) ? 16 : 18;
  const int seg0 = (l == 1) ? 2 : 0;
  for (int it = VBID; it < 8 * nseg * 4; it += NVB) {
    const int a = it & 3; const int sj = (it >> 2) % nseg + seg0; const int b = (it >> 2) / nseg;
    const int p0 = sj * 128;
    hb_sync();
    {
      const int q = tid >> 1, half = tid & 1;
      const int row = row_of(b, p0 + q);
      const bf16* src = P.Z + (size_t)row * DIN + ZC_AV + a * 64 + half * 32;
      float v[32];
      float ss = 0.f;
#pragma unroll
      for (int i = 0; i < 4; ++i) {
        const uint4 u = *reinterpret_cast<const uint4*>(src + i * 8);
        v[i * 8 + 0] = lo2f(u.x); v[i * 8 + 1] = hi2f(u.x); v[i * 8 + 2] = lo2f(u.y); v[i * 8 + 3] = hi2f(u.y);
        v[i * 8 + 4] = lo2f(u.z); v[i * 8 + 5] = hi2f(u.z); v[i * 8 + 6] = lo2f(u.w); v[i * 8 + 7] = hi2f(u.w);
      }
#pragma unroll
      for (int i = 0; i < 32; ++i) ss += v[i] * v[i];
      ss += __shfl_xor(ss, 1);
      const float rr = rsqrtf(ss * (1.f / 64.f) + EPS);
      const float* nw = P.a_norm_w + l * 256 + a * 64 + half * 32;
#pragma unroll
      for (int i = 0; i < 32; ++i) VNT[(half * 32 + i) * LDV + q] = f2bf(v[i] * rr * nw[i]);
    }
    hb_sync();
    f32x16 acc[2]; acc[0] = zero16(); acc[1] = zero16();
    const bf16* Aw = P.AWS + (size_t)(l * 4 + a) * 128 * 128 + (size_t)(wave * 32 + l31) * 128;
#pragma unroll
    for (int ks = 0; ks < 8; ++ks) {
      const bf16x8 af = ldfrag(Aw + ks * 16 + hh * 8);
#pragma unroll
      for (int j = 0; j < 2; ++j) {
        const bf16x8 bfr = ldfrag(VNT + (j * 32 + l31) * LDV + ks * 16 + hh * 8);
        acc[j] = mfma32(af, bfr, acc[j]);
      }
    }
    const float* bs = P.a_b_s + (l * 4 + a) * 128;
#pragma unroll
    for (int j = 0; j < 2; ++j)
#pragma unroll
      for (int r = 0; r < 16; ++r) {
        const int p = wave * 32 + drow(r, hh);
        const int row = row_of(b, p0 + p);
        const int col = a * 64 + j * 32 + l31;
        const float u = bf2f(P.Z[(size_t)row * DIN + ZC_AU + col]);
        P.H[(size_t)row * 1024 + col] = f2bf(u * (acc[j][r] + bs[p]));
      }
  }
}

DEVI void mla_norm_rope_store(const Params& P, const float* T, const float* nw, bool rope, float oscale,
                              bf16* dstbase  , int pos0, int tlat0) {
  const int tid = TIDX, tok = tid >> 1, half = tid & 1;
  float v[48];
  float ss = 0.f;
#pragma unroll
  for (int i = 0; i < 48; ++i) { v[i] = T[tok * 97 + half * 48 + i]; ss += v[i] * v[i]; }
  ss += __shfl_xor(ss, 1);
  const float rr = rsqrtf(ss * (1.f / 96.f) + EPS);
#pragma unroll
  for (int i = 0; i < 48; ++i) v[i] = v[i] * rr * nw[half * 48 + i];
  if (rope && half == 1) {
    const float* cs = P.ROPE + (size_t)(tlat0 + tok) * 32;
#pragma unroll
    for (int a = 0; a < 2; ++a)
#pragma unroll
      for (int f = 0; f < 8; ++f) {
        const float x1 = v[16 + a * 16 + f], x2 = v[16 + a * 16 + 8 + f];
        const float c = cs[a * 8 + f], s = cs[16 + a * 8 + f];
        v[16 + a * 16 + f] = x1 * c - x2 * s;
        v[16 + a * 16 + 8 + f] = x2 * c + x1 * s;
      }
  }
  bf16* dst = dstbase + (size_t)(pos0 + tok) * 96 + half * 48;
#pragma unroll
  for (int i = 0; i < 6; ++i) {
    uint4 o;
    o.x = pack2(v[i * 8 + 0] * oscale, v[i * 8 + 1] * oscale); o.y = pack2(v[i * 8 + 2] * oscale, v[i * 8 + 3] * oscale);
    o.z = pack2(v[i * 8 + 4] * oscale, v[i * 8 + 5] * oscale); o.w = pack2(v[i * 8 + 6] * oscale, v[i * 8 + 7] * oscale);
    *reinterpret_cast<uint4*>(dst + i * 8) = o;
  }
}

DEVI void phase_mla_proj(const Params& P, int l, unsigned char* smem) {
  const int tid = TIDX;
  float* T = reinterpret_cast<float*>(smem);
  bf16* TV = reinterpret_cast<bf16*>(smem + 128 * 97 * 4);
  const float qscale = 0.10206207261596577f * 1.4426950408889634f;
  const int tok = tid >> 1, half = tid & 1;
  for (int it = (VBID + NVB - 64) % NVB; it < 144 * 8; it += NVB) {
    const int h = it & 7;
    const int m0 = (it >> 3) * 128;
    const bool lat = m0 < NL;
    const int b = lat ? (m0 >> 11) : ((m0 - NL) >> 8);
    const int pos0 = lat ? 256 + (m0 & 2047) : ((m0 - NL) & 255);
    const int tlat0 = lat ? (m0 & 2047) : 0;
    const bool doq = lat || (l == 0);
    const bf16* zr = P.Z + (size_t)(m0 + tok) * DIN;
    const bf16* rr = P.RAW + (size_t)(m0 + tok) * 1792;
    hb_sync();
    const float rsq = P.RS[(size_t)(m0 + tok) * 2], rskv = P.RS[(size_t)(m0 + tok) * 2 + 1];
    {
      const bf16* kn = rr + 768 + h * 128 + half * 32;
      const bf16* vv = rr + 768 + h * 128 + 64 + half * 32;
#pragma unroll
      for (int i = 0; i < 4; ++i) {
        const uint4 u = *reinterpret_cast<const uint4*>(kn + i * 8);
        float* tp = T + tok * 97 + half * 32 + i * 8;
        tp[0] = lo2f(u.x) * rskv; tp[1] = hi2f(u.x) * rskv; tp[2] = lo2f(u.y) * rskv; tp[3] = hi2f(u.y) * rskv;
        tp[4] = lo2f(u.z) * rskv; tp[5] = hi2f(u.z) * rskv; tp[6] = lo2f(u.w) * rskv; tp[7] = hi2f(u.w) * rskv;
        const uint4 w = *reinterpret_cast<const uint4*>(vv + i * 8);
        bf16* vp = TV + (half * 32 + i * 8) * 136 + tok;
        vp[0 * 136] = f2bf(lo2f(w.x) * rskv); vp[1 * 136] = f2bf(hi2f(w.x) * rskv); vp[2 * 136] = f2bf(lo2f(w.y) * rskv); vp[3 * 136] = f2bf(hi2f(w.y) * rskv);
        vp[4 * 136] = f2bf(lo2f(w.z) * rskv); vp[5 * 136] = f2bf(hi2f(w.z) * rskv); vp[6 * 136] = f2bf(lo2f(w.w) * rskv); vp[7 * 136] = f2bf(hi2f(w.w) * rskv);
      }
#pragma unroll
      for (int i = 0; i < 2; ++i) {
        const uint4 u = *reinterpret_cast<const uint4*>(zr + ZC_BKR + half * 16 + i * 8);
        float* tp = T + tok * 97 + 64 + half * 16 + i * 8;
        tp[0] = lo2f(u.x); tp[1] = hi2f(u.x); tp[2] = lo2f(u.y); tp[3] = hi2f(u.y);
        tp[4] = lo2f(u.z); tp[5] = hi2f(u.z); tp[6] = lo2f(u.w); tp[7] = hi2f(u.w);
      }
    }
    hb_sync();
    mla_norm_rope_store(P, T, P.b_kh_w + l * 96, lat, 1.f, P.K + (size_t)(b * 8 + h) * SEQP * 96, pos0, tlat0);
    {
      const int d = tid >> 2, qtr = tid & 3;
      bf16* dst = P.VT + ((size_t)(b * 8 + h) * 64 + d) * SEQP + pos0 + qtr * 32;
      const bf16* src = TV + d * 136 + qtr * 32;
#pragma unroll
      for (int i = 0; i < 4; ++i) {
        const uint4 v = *reinterpret_cast<const uint4*>(src + i * 8);
        const int g16 = (i >> 1) * 16, odd = i & 1;
        *reinterpret_cast<uint2*>(dst + g16 + (odd ? 4 : 0)) = make_uint2(v.x, v.y);
        *reinterpret_cast<uint2*>(dst + g16 + (odd ? 12 : 8)) = make_uint2(v.z, v.w);
      }
    }
    if (doq) {
      hb_sync();
      const bf16* qq = rr + h * 96 + half * 48;
#pragma unroll
      for (int i = 0; i < 6; ++i) {
        const uint4 u = *reinterpret_cast<const uint4*>(qq + i * 8);
        float* tp = T + tok * 97 + half * 48 + i * 8;
        tp[0] = lo2f(u.x) * rsq; tp[1] = hi2f(u.x) * rsq; tp[2] = lo2f(u.y) * rsq; tp[3] = hi2f(u.y) * rsq;
        tp[4] = lo2f(u.z) * rsq; tp[5] = hi2f(u.z) * rsq; tp[6] = lo2f(u.w) * rsq; tp[7] = hi2f(u.w) * rsq;
      }
      hb_sync();
      mla_norm_rope_store(P, T, P.b_qh_w + l * 96, lat, qscale, P.Q + (size_t)(b * 8 + h) * SEQP * 96, pos0, tlat0);
    }
  }
}

DEVI void hgrn_load(const Params& P, int l, int b, int hd, int c, float* BF, float* RB, float* SEG,
                    float (&q)[16], float (&kf)[16], float (&kb)[16], float (&v)[16], bool need_kv) {
  const int tid = TIDX, t = tid >> 2, k0 = (tid & 3) * 16;
  const int row = row_of(b, c * 64 + t);
  const bf16* z = P.Z + (size_t)row * DIN + hd * 64 + k0;
  float zf[16], zb[16];
#pragma unroll
  for (int i = 0; i < 2; ++i) {
    const uint4 uq = *reinterpret_cast<const uint4*>(z + ZC_CQ + i * 8);
    const uint4 uf = *reinterpret_cast<const uint4*>(z + ZC_CFF + i * 8);
    const uint4 ub = *reinterpret_cast<const uint4*>(z + ZC_CFB + i * 8);
    q[i * 8 + 0] = lo2f(uq.x); q[i * 8 + 1] = hi2f(uq.x); q[i * 8 + 2] = lo2f(uq.y); q[i * 8 + 3] = hi2f(uq.y);
    q[i * 8 + 4] = lo2f(uq.z); q[i * 8 + 5] = hi2f(uq.z); q[i * 8 + 6] = lo2f(uq.w); q[i * 8 + 7] = hi2f(uq.w);
    zf[i * 8 + 0] = lo2f(uf.x); zf[i * 8 + 1] = hi2f(uf.x); zf[i * 8 + 2] = lo2f(uf.y); zf[i * 8 + 3] = hi2f(uf.y);
    zf[i * 8 + 4] = lo2f(uf.z); zf[i * 8 + 5] = hi2f(uf.z); zf[i * 8 + 6] = lo2f(uf.w); zf[i * 8 + 7] = hi2f(uf.w);
    zb[i * 8 + 0] = lo2f(ub.x); zb[i * 8 + 1] = hi2f(ub.x); zb[i * 8 + 2] = lo2f(ub.y); zb[i * 8 + 3] = hi2f(ub.y);
    zb[i * 8 + 4] = lo2f(ub.z); zb[i * 8 + 5] = hi2f(ub.z); zb[i * 8 + 6] = lo2f(ub.w); zb[i * 8 + 7] = hi2f(ub.w);
    if (need_kv) {
      const uint4 uv = *reinterpret_cast<const uint4*>(z + ZC_CI + i * 8);
      v[i * 8 + 0] = lo2f(uv.x); v[i * 8 + 1] = hi2f(uv.x); v[i * 8 + 2] = lo2f(uv.y); v[i * 8 + 3] = hi2f(uv.y);
      v[i * 8 + 4] = lo2f(uv.z); v[i * 8 + 5] = hi2f(uv.z); v[i * 8 + 6] = lo2f(uv.w); v[i * 8 + 7] = hi2f(uv.w);
    }
  }
#pragma unroll
  for (int i = 0; i < 16; ++i) {
    q[i] *= 0.125f;
    float lbf = 0.f;
    if (l == 1) { const int ch = hd * 64 + k0 + i; lbf = sigmoidf_(P.c_lb[512 + ch] - P.c_lb[ch]); }
    const float zz = zf[i];
    const float e = __expf(-fabsf(zz));
    const float sp = __builtin_amdgcn_rcpf(1.f + e);
    const float sig = zz >= 0.f ? sp : e * sp;
    const float nsig = zz >= 0.f ? e * sp : sp;
    const float lf = (l == 0) ? (fminf(zz, 0.f) - __logf(1.f + e)) : __logf(lbf + (1.f - lbf) * sig);
    kf[i] = (1.f - lbf) * nsig;
    BF[t * 65 + k0 + i] = lf;
  }
  __builtin_amdgcn_sched_barrier(0);
#pragma unroll
  for (int i = 0; i < 16; ++i) {
    float lbb = 0.f;
    if (l == 1) { const int ch = hd * 64 + k0 + i; lbb = sigmoidf_(P.c_lb[512 + 256 + ch] - P.c_lb[256 + ch]); }
    const float zz = zb[i];
    const float e = __expf(-fabsf(zz));
    const float sp = __builtin_amdgcn_rcpf(1.f + e);
    const float sig = zz >= 0.f ? sp : e * sp;
    const float nsig = zz >= 0.f ? e * sp : sp;
    const float lf = (l == 0) ? (fminf(zz, 0.f) - __logf(1.f + e)) : __logf(lbb + (1.f - lbb) * sig);
    kb[i] = (1.f - lbb) * nsig;
    RB[t * 65 + k0 + i] = lf;
  }
  hb_sync();
  {
    const int k = tid & 63, seg = tid >> 6;
    float sf = 0.f, sr = 0.f;
#pragma unroll
    for (int j = 0; j < 16; ++j) { sf += BF[(seg * 16 + j) * 65 + k]; BF[(seg * 16 + j) * 65 + k] = sf; }
#pragma unroll
    for (int j = 15; j >= 0; --j) { sr += RB[(seg * 16 + j) * 65 + k]; RB[(seg * 16 + j) * 65 + k] = sr; }
    SEG[seg * 64 + k] = sf; SEG[256 + seg * 64 + k] = sr;
    hb_sync();
    float offf = 0.f, offb = 0.f;
#pragma unroll
    for (int s2 = 0; s2 < 4; ++s2) {
      offf += (s2 < seg) ? SEG[s2 * 64 + k] : 0.f;
      offb += (s2 > seg) ? SEG[256 + s2 * 64 + k] : 0.f;
    }
#pragma unroll
    for (int j = 0; j < 16; ++j) { BF[(seg * 16 + j) * 65 + k] += offf; RB[(seg * 16 + j) * 65 + k] += offb; }
  }
  hb_sync();
}

DEVI f32x16 lds_mm(const bf16* A, const bf16* BT, int tm, int tn, int l31, int hh) {
  f32x16 acc = zero16();
#pragma unroll
  for (int ks = 0; ks < 4; ++ks) {
    const bf16x8 a = ldfrag(A + (tm * 32 + l31) * 72 + ks * 16 + hh * 8);
    const bf16x8 b = ldfrag(BT + (tn * 32 + l31) * 72 + ks * 16 + hh * 8);
    acc = mfma32(a, b, acc);
  }
  return acc;
}

DEVI void phase_hgrn_local(const Params& P, int l, unsigned char* smem) {
  const int tid = TIDX, lane = tid & 63, wave = tid >> 6, l31 = lane & 31, hh = lane >> 5;
  const int tm = wave >> 1, tn = wave & 1;
  float* BF = reinterpret_cast<float*>(smem);
  float* RB = BF + 64 * 65;
  bf16* QF = reinterpret_cast<bf16*>(smem + 33280);
  bf16* KF = QF + 64 * 72;
  bf16* QB = KF + 64 * 72;
  bf16* KB = QB + 64 * 72;
  bf16* VTt = KB + 64 * 72;
  bf16* KHF = reinterpret_cast<bf16*>(smem);
  bf16* KHB = KHF + 64 * 72;
  bf16* ATT = KHB + 64 * 72;
  for (int it = (VBID + NVB - 192) % NVB; it < 8 * 4 * 36; it += NVB) {
    const int c = it % 36, hd = (it / 36) & 3, b = it / 144;
    float q[16], kf[16], kb[16], v[16];
    hb_sync();
    hgrn_load(P, l, b, hd, c, BF, RB, reinterpret_cast<float*>(smem + 33280), q, kf, kb, v, true);
    const int t = tid >> 2, k0 = (tid & 3) * 16;
#pragma unroll
    for (int i = 0; i < 16; ++i) VTt[(k0 + i) * 72 + t] = f2bf(v[i]);
    float bfv[16], rbv[16];
#pragma unroll
    for (int i = 0; i < 16; ++i) { bfv[i] = BF[t * 65 + k0 + i]; rbv[i] = RB[t * 65 + k0 + i]; }
    {
      const size_t go = (size_t)row_of(b, c * 64 + t) * 256 + hd * 64 + k0;
#pragma unroll
      for (int hq = 0; hq < 2; ++hq) {
        unsigned pf[4], pb[4];
#pragma unroll
        for (int i = 0; i < 8; i += 2) {
          pf[i >> 1] = pack2(q[hq * 8 + i] * __expf(bfv[hq * 8 + i]), q[hq * 8 + i + 1] * __expf(bfv[hq * 8 + i + 1]));
          pb[i >> 1] = pack2(q[hq * 8 + i] * __expf(rbv[hq * 8 + i]), q[hq * 8 + i + 1] * __expf(rbv[hq * 8 + i + 1]));
        }
        *reinterpret_cast<uint4*>(P.GQF + go + hq * 8) = make_uint4(pf[0], pf[1], pf[2], pf[3]);
        *reinterpret_cast<uint4*>(P.GQB + go + hq * 8) = make_uint4(pb[0], pb[1], pb[2], pb[3]);
      }
    }
    if (t == 0) {
      float* dec = P.DEC + ((size_t)((b * 4 + hd) * 2) * 36 + c) * 64 + k0;
#pragma unroll
      for (int i = 0; i < 16; ++i) { dec[i] = __expf(BF[63 * 65 + k0 + i]); dec[36 * 64 + i] = __expf(RB[k0 + i]); }
    }
#pragma unroll
    for (int i = 0; i < 16; i += 2) {
      const int k = k0 + i;
      const float mF0 = BF[32 * 65 + k], mF1 = BF[32 * 65 + k + 1], mB0 = RB[32 * 65 + k], mB1 = RB[32 * 65 + k + 1];
      *reinterpret_cast<unsigned*>(&QF[t * 72 + k]) = pack2(q[i] * __expf(fminf(bfv[i] - mF0, 80.f)), q[i + 1] * __expf(fminf(bfv[i + 1] - mF1, 80.f)));
      *reinterpret_cast<unsigned*>(&KF[t * 72 + k]) = pack2(kf[i] * __expf(fminf(mF0 - bfv[i], 80.f)), kf[i + 1] * __expf(fminf(mF1 - bfv[i + 1], 80.f)));
      *reinterpret_cast<unsigned*>(&QB[t * 72 + k]) = pack2(q[i] * __expf(fminf(rbv[i] - mB0, 80.f)), q[i + 1] * __expf(fminf(rbv[i + 1] - mB1, 80.f)));
      *reinterpret_cast<unsigned*>(&KB[t * 72 + k]) = pack2(kb[i] * __expf(fminf(mB0 - rbv[i], 80.f)), kb[i + 1] * __expf(fminf(mB1 - rbv[i + 1], 80.f)));
    }
#pragma unroll
    for (int i = 0; i < 16; ++i) {
      kf[i] = kf[i] * __expf(BF[63 * 65 + k0 + i] - bfv[i]);
      kb[i] = kb[i] * __expf(RB[k0 + i] - rbv[i]);
    }
    hb_sync();
#pragma unroll
    for (int i = 0; i < 16; ++i) {
      KHF[(k0 + i) * 72 + t] = f2bf(kf[i]);
      KHB[(k0 + i) * 72 + t] = f2bf(kb[i]);
    }
    hb_sync();
    {
      const f32x16 af = lds_mm(QF, KF, tm, tn, l31, hh);
      const f32x16 ab = lds_mm(QB, KB, tm, tn, l31, hh);
      const int s = tn * 32 + l31;
#pragma unroll
      for (int r = 0; r < 16; ++r) {
        const int tt = tm * 32 + drow(r, hh);
        float a = 0.f;
        if (s <= tt) a += af[r];
        if (s >= tt) a += ab[r];
        ATT[tt * 72 + s] = f2bf(a);
      }
    }
    {
      const f32x16 lf = lds_mm(VTt, KHF, tm, tn, l31, hh);
      const f32x16 lb = lds_mm(VTt, KHB, tm, tn, l31, hh);
      bf16* stf = P.ST + ((size_t)((b * 4 + hd) * 2 + 0) * 36 + c) * 4096;
      bf16* stb = P.ST + ((size_t)((b * 4 + hd) * 2 + 1) * 36 + c) * 4096;
#pragma unroll
      for (int r = 0; r < 16; ++r) {
        const int kk = tm * 32 + drow(r, hh), d = tn * 32 + l31;
        stf[kk * 64 + d] = f2bf(lf[r]);
        stb[kk * 64 + d] = f2bf(lb[r]);
      }
    }
    hb_sync();
    {
      const f32x16 o = lds_mm(ATT, VTt, tm, tn, l31, hh);
#pragma unroll
      for (int r = 0; r < 16; ++r) {
        const int tt = tm * 32 + drow(r, hh), d = tn * 32 + l31;
        P.OI[(size_t)row_of(b, c * 64 + tt) * 256 + hd * 64 + d] = f2bf(o[r]);
      }
    }
  }
}

DEVI void hgrn_scan_item(const Params& P, int item) {
  const int tid = TIDX;
  const int chain = item >> 2, sl = item & 3;
  const int dir = chain & 1;
  const int dd = tid >> 2, k4 = sl * 16 + (tid & 3) * 4;
  float4 S = make_float4(0.f, 0.f, 0.f, 0.f);
  bf16* base = P.ST + (size_t)chain * 36 * 4096 + dd * 64 + k4;
  const float* dec = P.DEC + (size_t)chain * 36 * 64 + k4;
#pragma unroll 1
  for (int g = 0; g < 6; ++g) {
    float4 L[6], dc[6];
#pragma unroll
    for (int j = 0; j < 6; ++j) {
      const int step = g * 6 + j;
      const int c = dir == 0 ? step : (step < 4 ? 3 - step : 39 - step);
      { const uint2 u = *reinterpret_cast<const uint2*>(base + (size_t)c * 4096); L[j] = make_float4(lo2f(u.x), hi2f(u.x), lo2f(u.y), hi2f(u.y)); }
      dc[j] = *reinterpret_cast<const float4*>(dec + c * 64);
    }
#pragma unroll
    for (int j = 0; j < 6; ++j) {
      const int step = g * 6 + j;
      const int c = dir == 0 ? step : (step < 4 ? 3 - step : 39 - step);
      *reinterpret_cast<uint2*>(base + (size_t)c * 4096) = make_uint2(pack2(S.x, S.y), pack2(S.z, S.w));
      S.x = dc[j].x * S.x + L[j].x; S.y = dc[j].y * S.y + L[j].y; S.z = dc[j].z * S.z + L[j].z; S.w = dc[j].w * S.w + L[j].w;
    }
  }
}

DEVI void phase_hgrn_final(const Params& P, int l, unsigned char* smem) {
  const int tid = TIDX, lane = tid & 63, wave = tid >> 6, l31 = lane & 31, hh = lane >> 5;
  const int tm = wave >> 1, tn = wave & 1;
  float* O = reinterpret_cast<float*>(smem);
  bf16* QF = reinterpret_cast<bf16*>(smem + 33280);
  bf16* QB = QF + 64 * 72;
  bf16* SF = QB + 64 * 72;
  bf16* SB = SF + 64 * 72;
  const int c0 = (l == 1) ? 4 : 0;
  const int nc = 36 - c0;
  for (int it = VBID; it < 8 * 4 * nc; it += NVB) {
    const int c = it % nc + c0, hd = (it / nc) & 3, b = it / (nc * 4);
    const int t = tid >> 2, k0 = (tid & 3) * 16;
    const int row = row_of(b, c * 64 + t);
    hb_sync();
    {
      const size_t go = (size_t)row * 256 + hd * 64 + k0;
      *reinterpret_cast<uint4*>(QF + t * 72 + k0) = *reinterpret_cast<const uint4*>(P.GQF + go);
      *reinterpret_cast<uint4*>(QF + t * 72 + k0 + 8) = *reinterpret_cast<const uint4*>(P.GQF + go + 8);
      *reinterpret_cast<uint4*>(QB + t * 72 + k0) = *reinterpret_cast<const uint4*>(P.GQB + go);
      *reinterpret_cast<uint4*>(QB + t * 72 + k0 + 8) = *reinterpret_cast<const uint4*>(P.GQB + go + 8);
      const bf16* stf = P.ST + ((size_t)((b * 4 + hd) * 2 + 0) * 36 + c) * 4096 + t * 64 + k0;
      const bf16* stb = P.ST + ((size_t)((b * 4 + hd) * 2 + 1) * 36 + c) * 4096 + t * 64 + k0;
      *reinterpret_cast<uint4*>(SF + t * 72 + k0) = *reinterpret_cast<const uint4*>(stf);
      *reinterpret_cast<uint4*>(SF + t * 72 + k0 + 8) = *reinterpret_cast<const uint4*>(stf + 8);
      *reinterpret_cast<uint4*>(SB + t * 72 + k0) = *reinterpret_cast<const uint4*>(stb);
      *reinterpret_cast<uint4*>(SB + t * 72 + k0 + 8) = *reinterpret_cast<const uint4*>(stb + 8);
    }
    hb_sync();
    {
      f32x16 o = lds_mm(QF, SF, tm, tn, l31, hh);
      const f32x16 o2 = lds_mm(QB, SB, tm, tn, l31, hh);
#pragma unroll
      for (int r = 0; r < 16; ++r) {
        const int tt = tm * 32 + drow(r, hh), d = tn * 32 + l31;
        O[tt * 65 + d] = o[r] + o2[r] + bf2f(P.OI[(size_t)row_of(b, c * 64 + tt) * 256 + hd * 64 + d]);
      }
    }
    hb_sync();
    {
      float ov[16]; float ss = 0.f;
#pragma unroll
      for (int i = 0; i < 16; ++i) { ov[i] = O[t * 65 + k0 + i]; ss += ov[i] * ov[i]; }
      ss += __shfl_xor(ss, 1); ss += __shfl_xor(ss, 2);
      const float rr = rsqrtf(ss * (1.f / 64.f) + EPS);
      const bf16* g = P.Z + (size_t)row * DIN + ZC_CG + hd * 64 + k0;
      const float* nw = P.c_out_norm_w + l * 64 + k0;
      const uint4 gA = *reinterpret_cast<const uint4*>(g), gB = *reinterpret_cast<const uint4*>(g + 8);
      const unsigned gw[8] = {gA.x, gA.y, gA.z, gA.w, gB.x, gB.y, gB.z, gB.w};
      unsigned pk[8];
#pragma unroll
      for (int i = 0; i < 16; i += 2) {
        const float g0 = lo2f(gw[i >> 1]), g1 = hi2f(gw[i >> 1]);
        const float y0 = ov[i] * rr * nw[i] * (g0 * sigmoidf_(g0));
        const float y1 = ov[i + 1] * rr * nw[i + 1] * (g1 * sigmoidf_(g1));
        pk[i >> 1] = pack2(y0, y1);
      }
      uint4* dst = reinterpret_cast<uint4*>(P.H + (size_t)row * 1024 + 768 + hd * 64 + k0);
      dst[0] = make_uint4(pk[0], pk[1], pk[2], pk[3]);
      dst[1] = make_uint4(pk[4], pk[5], pk[6], pk[7]);
    }
  }
}

DEVI void attn_item8(const Params& P, int b, int h, int qpos0, int nkeys, float sref, unsigned char* smem_base) {
  const int tid = threadIdx.x, lane = tid & 63, wave = tid >> 6, l31 = lane & 31, hh = lane >> 5;
  constexpr int TK = 128, LDKS = 104, LDVS = 136;
  constexpr int KS_BYTES = TK * LDKS * 2, VS_BYTES = 64 * LDVS * 2, ST_BYTES = KS_BYTES + VS_BYTES;
  const bf16* Qg = P.Q + ((size_t)(b * 8 + h) * SEQP + qpos0 + wave * 32 + l31) * 96;
  const bf16* Kg = P.K + (size_t)(b * 8 + h) * SEQP * 96;
  const bf16* Vg = P.VT + (size_t)(b * 8 + h) * 64 * SEQP;
  bf16x8 qf[6];
#pragma unroll
  for (int ks = 0; ks < 6; ++ks) qf[ks] = ldfrag(Qg + ks * 16 + hh * 8);
  f32x16 oacc[2]; oacc[0] = zero16(); oacc[1] = zero16();
  float lsum = 0.f;
  const int ntiles = nkeys / TK;
  unsigned koff[4], voff[3];
#pragma unroll
  for (int i = 0; i < 4; ++i) { const int q = (i * 8 + wave) * 64 + lane, row = q / 13, cc = q - row * 13; koff[i] = (unsigned)(row * 96 + (cc < 12 ? cc : 0) * 8) * 2u; }
#pragma unroll
  for (int i = 0; i < 3; ++i) { const int q = (i * 8 + wave) * 64 + lane, row = q / 17, cc = q - row * 17; voff[i] = (unsigned)((row < 64 ? row : 63) * SEQP + (cc < 16 ? cc : 0) * 8) * 2u; }
  LAS unsigned char* ldsb = (LAS unsigned char*)smem_base;
  auto dma_tile = [&](int kt, int buf) {
    const char* kb_ = (const char*)(Kg + (size_t)kt * TK * 96);
    const char* vb_ = (const char*)(Vg + (size_t)kt * TK);
#pragma unroll
    for (int i = 0; i < 4; ++i) {
      const int g = i * 8 + wave;
      if (g < 26) __builtin_amdgcn_global_load_lds((const unsigned*)(kb_ + koff[i]), (LAS unsigned*)(ldsb + buf * ST_BYTES + g * 1024), 16, 0, 0);
    }
#pragma unroll
    for (int i = 0; i < 3; ++i) {
      const int g = i * 8 + wave;
      if (g < 17) __builtin_amdgcn_global_load_lds((const unsigned*)(vb_ + voff[i]), (LAS unsigned*)(ldsb + buf * ST_BYTES + KS_BYTES + g * 1024), 16, 0, 0);
    }
  };
  __syncthreads();
  dma_tile(0, 0);
  asm volatile("s_waitcnt vmcnt(0)" ::: "memory");
  __syncthreads();
  for (int kt = 0; kt < ntiles; ++kt) {
    const int cur = kt & 1;
    if (kt + 1 < ntiles) dma_tile(kt + 1, cur ^ 1);
    const bf16* sK = reinterpret_cast<const bf16*>(smem_base + cur * ST_BYTES);
    const bf16* sV = reinterpret_cast<const bf16*>(smem_base + cur * ST_BYTES + KS_BYTES);
#pragma unroll
    for (int kk = 0; kk < 4; ++kk) {
      f32x16 sacc;
#pragma unroll
      for (int r = 0; r < 16; ++r) sacc[r] = -sref;
#pragma unroll
      for (int ks = 0; ks < 6; ++ks) {
        const bf16x8 a = ldfrag(sK + (kk * 32 + l31) * LDKS + ks * 16 + hh * 8);
        sacc = mfma32(a, qf[ks], sacc);
      }
#pragma unroll
      for (int r = 0; r < 16; ++r) { const float p = __builtin_amdgcn_exp2f(sacc[r]); sacc[r] = p; lsum += p; }
#pragma unroll
      for (int s = 0; s < 2; ++s) {
        bf16x8 pb;
#pragma unroll
        for (int j = 0; j < 8; ++j) pb[j] = (__bf16)sacc[8 * s + j];
#pragma unroll
        for (int dt = 0; dt < 2; ++dt) {
          const bf16x8 a = ldfrag(sV + (dt * 32 + l31) * LDVS + kk * 32 + s * 16 + hh * 8);
          oacc[dt] = mfma32(a, pb, oacc[dt]);
        }
      }
    }
    asm volatile("s_waitcnt vmcnt(0)" ::: "memory");
    __syncthreads();
  }
  lsum += __shfl_xor(lsum, 32);
  const float inv = 1.f / lsum;
  const int row = row_of(b, qpos0 + wave * 32 + l31);
  bf16* dst = P.H + (size_t)row * 1024 + 256 + h * 64;
#pragma unroll
  for (int dt = 0; dt < 2; ++dt)
#pragma unroll
    for (int rg = 0; rg < 4; ++rg) {
      const int d = dt * 32 + 8 * rg + 4 * hh;
      uint2 o;
      o.x = pack2(oacc[dt][4 * rg + 0] * inv, oacc[dt][4 * rg + 1] * inv);
      o.y = pack2(oacc[dt][4 * rg + 2] * inv, oacc[dt][4 * rg + 3] * inv);
      *reinterpret_cast<uint2*>(dst + d) = o;
    }
}

DEVI void phase_attn_scan(const Params& P, int l, unsigned char* smem_base, bool skip_scan = false) {
  if (!skip_scan)
    for (int it = NVB - 1 - VBID; it < 256; it += NVB) hgrn_scan_item(P, it);
  float sref;
  {
    const int lane = threadIdx.x & 63;
    float mq = fmaxf(fabsf(P.b_qh_w[l * 96 + lane]), lane < 32 ? fabsf(P.b_qh_w[l * 96 + 64 + lane]) : 0.f);
    float mk = fmaxf(fabsf(P.b_kh_w[l * 96 + lane]), lane < 32 ? fabsf(P.b_kh_w[l * 96 + 64 + lane]) : 0.f);
#pragma unroll
    for (int o = 32; o > 0; o >>= 1) { mq = fmaxf(mq, __shfl_xor(mq, o)); mk = fmaxf(mk, __shfl_xor(mk, o)); }
    sref = fminf(1.4426950408889634f * 9.797958971132712f * mq * mk, 60.f);
  }
  const int c = blockIdx.x, xcd = c & 7, slot = c >> 3;
  const int nrounds = (l == 0) ? 3 : 2;
  for (int r = 0; r < nrounds; ++r) {
    if (r < 2) {
      const int u = r * 32 + slot;
      const int bh = xcd * 8 + (u >> 3), qt = u & 7;
      if (slot < 32) attn_item8(P, bh >> 3, bh & 7, 256 + 256 * qt, 2304, sref, smem_base);
    } else if (c < 64) {
      attn_item8(P, c >> 3, c & 7, 0, 256, sref, smem_base);
    }
  }
}

DEVI unsigned ordkey(float s) { const unsigned u = __float_as_uint(s); return (u & 0x80000000u) ? ~u : (u | 0x80000000u); }
DEVI float keyval(unsigned k, unsigned mask) { const unsigned u = k & ~mask; return __uint_as_float((u & 0x80000000u) ? (u & 0x7fffffffu) : ~u); }
DEVI void ins16(unsigned (&lst)[16], unsigned v) {
#pragma unroll
  for (int j = 0; j < 16; ++j) { const unsigned hi = max(lst[j], v); v = min(lst[j], v); lst[j] = hi; }
}
DEVI void merge16(unsigned (&lst)[16], int xm) {
  unsigned o[16];
#pragma unroll
  for (int j = 0; j < 16; ++j) o[j] = (unsigned)__shfl_xor((int)lst[j], xm);
#pragma unroll
  for (int j = 0; j < 16; ++j) lst[j] = max(lst[j], o[15 - j]);
#pragma unroll
  for (int d = 8; d >= 1; d >>= 1)
#pragma unroll
    for (int j = 0; j < 16; ++j)
      if ((j & d) == 0) { const unsigned a = lst[j], bb = lst[j + d]; lst[j] = max(a, bb); lst[j + d] = min(a, bb); }
}

DEVI void bitonic_sort_desc16(unsigned (&v)[16]) {
#pragma unroll
  for (int k = 2; k <= 16; k <<= 1)
#pragma unroll
    for (int j = k >> 1; j > 0; j >>= 1)
#pragma unroll
      for (int i = 0; i < 16; ++i) {
        const int l = i ^ j;
        if (l > i) {
          const bool desc = ((i & k) == 0);
          const unsigned a = v[i], b = v[l];
          const unsigned mx = max(a, b), mn = min(a, b);
          v[i] = desc ? mx : mn; v[l] = desc ? mn : mx;
        }
      }
}
DEVI void bitonic_merge_desc16(unsigned (&lst)[16]) {
#pragma unroll
  for (int d = 8; d >= 1; d >>= 1)
#pragma unroll
    for (int j = 0; j < 16; ++j)
      if ((j & d) == 0) { const unsigned a = lst[j], bb = lst[j + d]; lst[j] = max(a, bb); lst[j + d] = min(a, bb); }
}
struct CandTab { int a[52]; int b[52]; };
constexpr CandTab make_cand_tab() {
  CandTab t{};
  int n = 0;
  for (int a = 0; a < 16; ++a)
    for (int b = 0; b < 16; ++b)
      if ((a + 1) * (b + 1) <= 16) { t.a[n] = a; t.b[n] = b; ++n; }
  for (; n < 52; ++n) { t.a[n] = 0; t.b[n] = 0; }
  return t;
}

DEVI void phase_route(const Params& P, int l, unsigned char* smem) {
  const int tid = TIDX, lane = tid & 63, wave = tid >> 6, l31 = lane & 31, hh = lane >> 5;
  bf16* QT = reinterpret_cast<bf16*>(smem);
  float* SC = reinterpret_cast<float*>(smem + 33792);
  const int mtiles = (l == 1) ? 256 : 288;
  for (int it = VBID; it < mtiles * 8; it += NVB) {
    const int mt = it >> 3, h = it & 7;
    hb_sync();
    for (int e = tid; e < 64 * 32; e += 256) {
      const int r = e >> 5, cc = e & 31;
      *reinterpret_cast<uint4*>(QT + r * 264 + cc * 8) = *reinterpret_cast<const uint4*>(P.QP + (size_t)(mt * 64 + r) * 2048 + h * 256 + cc * 8);
    }
    hb_sync();
    unsigned lst[2][16];
    const int row = tid >> 2, part = tid & 3;
#pragma unroll
    for (int p = 0; p < 2; ++p) {
      f32x16 sa[2]; sa[0] = zero16(); sa[1] = zero16();
      const bf16* keys = P.SK + ((size_t)(l * 16 + h * 2 + p) * 128 + wave * 32 + l31) * 128;
#pragma unroll
      for (int ks = 0; ks < 8; ++ks) {
        const bf16x8 bfr = ldfrag(keys + ks * 16 + hh * 8);
#pragma unroll
        for (int i = 0; i < 2; ++i) {
          const bf16x8 af = ldfrag(QT + (i * 32 + l31) * 264 + p * 128 + ks * 16 + hh * 8);
          sa[i] = mfma32(af, bfr, sa[i]);
        }
      }
      if (p == 1) hb_sync();
#pragma unroll
      for (int i = 0; i < 2; ++i)
#pragma unroll
        for (int r = 0; r < 16; ++r) SC[(i * 32 + drow(r, hh)) * 129 + wave * 32 + l31] = sa[i][r];
      hb_sync();
      unsigned B2[16];
#pragma unroll
      for (int i = 0; i < 16; ++i) {
        const int i0 = part * 32 + ((i + part * 8) & 31), i1 = part * 32 + ((i + 16 + part * 8) & 31);
        lst[p][i] = (ordkey(SC[row * 129 + i0]) & ~0x7fu) | (unsigned)(127 - i0);
        B2[i] = (ordkey(SC[row * 129 + i1]) & ~0x7fu) | (unsigned)(127 - i1);
      }
      bitonic_sort_desc16(lst[p]);
      bitonic_sort_desc16(B2);
#pragma unroll
      for (int j = 0; j < 16; ++j) lst[p][j] = max(lst[p][j], B2[15 - j]);
      bitonic_merge_desc16(lst[p]);
      merge16(lst[p], 1);
      merge16(lst[p], 2);
    }
    float v0[16], v1[16];
#pragma unroll
    for (int j = 0; j < 16; ++j) { v0[j] = keyval(lst[0][j], 0x7fu); v1[j] = keyval(lst[1][j], 0x7fu); }
    unsigned best[16];
    {
      constexpr CandTab CT = make_cand_tab();
#pragma unroll
      for (int c = 0; c < 13; ++c) {
        const int a0 = CT.a[4 * c + 0], a1 = CT.a[4 * c + 1], a2 = CT.a[4 * c + 2], a3 = CT.a[4 * c + 3];
        const int b0 = CT.b[4 * c + 0], b1 = CT.b[4 * c + 1], b2 = CT.b[4 * c + 2], b3 = CT.b[4 * c + 3];
        const float x = part == 0 ? v0[a0] : part == 1 ? v0[a1] : part == 2 ? v0[a2] : v0[a3];
        const float y = part == 0 ? v1[b0] : part == 1 ? v1[b1] : part == 2 ? v1[b2] : v1[b3];
        const int flat = part == 0 ? (a0 * 16 + b0) : part == 1 ? (a1 * 16 + b1) : part == 2 ? (a2 * 16 + b2) : (a3 * 16 + b3);
        const bool valid = part == 0 ? (4 * c + 0 < 50) : part == 1 ? (4 * c + 1 < 50) : part == 2 ? (4 * c + 2 < 50) : (4 * c + 3 < 50);
        const unsigned key = (ordkey(x + y) & ~0xffu) | (unsigned)(255 - flat);
        best[c] = valid ? key : 0u;
      }
      best[13] = 0u; best[14] = 0u; best[15] = 0u;
      bitonic_sort_desc16(best);
      merge16(best, 1);
      merge16(best, 2);
    }
    {
      const float mx = keyval(best[0], 0xffu);
      float es = 0.f;
      float ev[4]; int ex[4];
#pragma unroll
      for (int jj = 0; jj < 4; ++jj) {
        const unsigned kk = part == 0 ? best[4 * jj + 0] : part == 1 ? best[4 * jj + 1] : part == 2 ? best[4 * jj + 2] : best[4 * jj + 3];
        ev[jj] = __expf(keyval(kk, 0xffu) - mx);
        es += ev[jj];
        const int flat = 255 - (int)(kk & 0xffu);
        const int a = flat >> 4, bq = flat & 15;
        int i1 = 0, i2 = 0;
#pragma unroll
        for (int u = 0; u < 16; ++u) {
          i1 = (a == u) ? (127 - (int)(lst[0][u] & 0x7fu)) : i1;
          i2 = (bq == u) ? (127 - (int)(lst[1][u] & 0x7fu)) : i2;
        }
        ex[jj] = i1 * 128 + i2;
      }
      es += __shfl_xor(es, 1); es += __shfl_xor(es, 2);
      const float inv = 1.f / es;
      const int tok = mt * 64 + row;
      int* ed = P.EIDX + (size_t)tok * 128 + h * 16;
      float* gd = P.GATE + (size_t)tok * 128 + h * 16;
#pragma unroll
      for (int jj = 0; jj < 4; ++jj) { ed[4 * jj + part] = ex[jj]; gd[4 * jj + part] = ev[jj] * inv; }
    }
  }
}

DEVI float gelu_exact(float a) { return 0.5f * a * (1.f + erff(a * 0.70710678118654752f)); }

typedef float f2 __attribute__((ext_vector_type(2)));
DEVI void phase_peer_u(const Params& P, int l) {
  const int lane = TIDX & 63, half = lane >> 5, l32 = lane & 31;
  const int gw = VBID * 4 + (TIDX >> 6), nw = NVB * 4;
  const int nrows = (l == 1) ? NL : NT;
  const unsigned char* PU = P.PU8 + (size_t)l * 16384 * 576;
  const bool b4 = lane & 16, b3 = lane & 8, b2 = lane & 4;
  for (int t = gw; t < nrows; t += nw) {
    f2 h2[16];
    {
      const bf16* hp = P.H + (size_t)t * 1024 + l32 * 32;
#pragma unroll
      for (int i = 0; i < 4; ++i) {
        const uint4 hv = *reinterpret_cast<const uint4*>(hp + i * 8);
        h2[4 * i + 0] = (f2){lo2f(hv.x), hi2f(hv.x)}; h2[4 * i + 1] = (f2){lo2f(hv.y), hi2f(hv.y)};
        h2[4 * i + 2] = (f2){lo2f(hv.z), hi2f(hv.z)}; h2[4 * i + 3] = (f2){lo2f(hv.w), hi2f(hv.w)};
      }
    }
    const int e0 = P.EIDX[(size_t)t * 128 + lane], e1 = P.EIDX[(size_t)t * 128 + 64 + lane];
    const float g0 = P.GATE[(size_t)t * 128 + lane], g1 = P.GATE[(size_t)t * 128 + 64 + lane];
    float* wrow = P.WPE + (size_t)t * 128;
    const bool b1 = lane & 2;
    for (int kb = 0; kb < 4; ++kb) {
      const int esrc = kb < 2 ? e0 : e1;
      uint4 ud[16];
      unsigned short us[16];
#pragma unroll
      for (int i = 0; i < 16; ++i) {
        const int e = __shfl(esrc, (kb * 32 + 2 * i + half) & 63);
        const unsigned char* ur = PU + (size_t)e * 576;
        ud[i] = *reinterpret_cast<const uint4*>(ur + l32 * 16);
        us[i] = *reinterpret_cast<const unsigned short*>(ur + 512 + l32 * 2);
      }
      float d[16];
#pragma unroll
      for (int i = 0; i < 16; ++i) {
        const unsigned uw[4] = {ud[i].x, ud[i].y, ud[i].z, ud[i].w};
        f2 sacc = (f2){0.f, 0.f};
#pragma unroll
        for (int c = 0; c < 4; ++c) {
          sacc = __builtin_elementwise_fma(__builtin_amdgcn_cvt_scalef32_pk_f32_fp4(uw[c], 1.0f, 0), h2[4 * c + 0], sacc);
          sacc = __builtin_elementwise_fma(__builtin_amdgcn_cvt_scalef32_pk_f32_fp4(uw[c], 1.0f, 1), h2[4 * c + 1], sacc);
          sacc = __builtin_elementwise_fma(__builtin_amdgcn_cvt_scalef32_pk_f32_fp4(uw[c], 1.0f, 2), h2[4 * c + 2], sacc);
          sacc = __builtin_elementwise_fma(__builtin_amdgcn_cvt_scalef32_pk_f32_fp4(uw[c], 1.0f, 3), h2[4 * c + 3], sacc);
        }
        d[i] = (sacc.x + sacc.y) * __uint_as_float((unsigned)us[i] << 16);
      }
      float r8[8], r4[4], r2[2], r1;
#pragma unroll
      for (int i = 0; i < 8; ++i) { const float mine = b4 ? d[8 + i] : d[i]; const float send = b4 ? d[i] : d[8 + i]; r8[i] = mine + __shfl_xor(send, 16); }
#pragma unroll
      for (int i = 0; i < 4; ++i) { const float mine = b3 ? r8[4 + i] : r8[i]; const float send = b3 ? r8[i] : r8[4 + i]; r4[i] = mine + __shfl_xor(send, 8); }
#pragma unroll
      for (int i = 0; i < 2; ++i) { const float mine = b2 ? r4[2 + i] : r4[i]; const float send = b2 ? r4[i] : r4[2 + i]; r2[i] = mine + __shfl_xor(send, 4); }
      { const float mine = b1 ? r2[1] : r2[0]; const float send = b1 ? r2[0] : r2[1]; r1 = mine + __shfl_xor(send, 2); }
      r1 += __shfl_xor(r1, 1);
      const int k = kb * 32 + 2 * ((lane >> 1) & 15) + half;
      const float gt = __shfl(kb < 2 ? g0 : g1, k & 63);
      if ((lane & 1) == 0) wrow[k] = gt * gelu_exact(r1);
    }
  }
}

DEVI void phase_peer(const Params& P, int l) {
  const int lane = TIDX & 63, half = lane >> 5, l32 = lane & 31;
  const int gw = VBID * 4 + (TIDX >> 6), nw = NVB * 4;
  const int nrows = (l == 1) ? NL : NT;
  const unsigned char* PV = P.PV8 + (size_t)l * 16384 * 576;
  for (int t = gw; t < nrows; t += nw) {
    const int e0 = P.EIDX[(size_t)t * 128 + lane], e1 = P.EIDX[(size_t)t * 128 + 64 + lane];
    const float w0 = P.WPE[(size_t)t * 128 + lane], w1 = P.WPE[(size_t)t * 128 + 64 + lane];
    f2 y2[16];
#pragma unroll
    for (int i = 0; i < 16; ++i) y2[i] = (f2){0.f, 0.f};
    for (int kb = 0; kb < 4; ++kb) {
      const int esrc = kb < 2 ? e0 : e1;
      const float wsrc = kb < 2 ? w0 : w1;
      uint4 vd[16];
      unsigned short vs[16];
      float wv[16];
#pragma unroll
      for (int i = 0; i < 16; ++i) {
        const int ks = (kb * 32 + 2 * i + half) & 63;
        const int e = __shfl(esrc, ks);
        wv[i] = __shfl(wsrc, ks);
        const unsigned char* vr = PV + (size_t)e * 576;
        vd[i] = *reinterpret_cast<const uint4*>(vr + l32 * 16);
        vs[i] = *reinterpret_cast<const unsigned short*>(vr + 512 + l32 * 2);
      }
#pragma unroll
      for (int i = 0; i < 16; ++i) {
        const float wi = wv[i] * __uint_as_float((unsigned)vs[i] << 16);
        const f2 ww = (f2){wi, wi};
        const unsigned vw[4] = {vd[i].x, vd[i].y, vd[i].z, vd[i].w};
#pragma unroll
        for (int c = 0; c < 4; ++c) {
          y2[4 * c + 0] = __builtin_elementwise_fma(ww, __builtin_amdgcn_cvt_scalef32_pk_f32_fp4(vw[c], 1.0f, 0), y2[4 * c + 0]);
          y2[4 * c + 1] = __builtin_elementwise_fma(ww, __builtin_amdgcn_cvt_scalef32_pk_f32_fp4(vw[c], 1.0f, 1), y2[4 * c + 1]);
          y2[4 * c + 2] = __builtin_elementwise_fma(ww, __builtin_amdgcn_cvt_scalef32_pk_f32_fp4(vw[c], 1.0f, 2), y2[4 * c + 2]);
          y2[4 * c + 3] = __builtin_elementwise_fma(ww, __builtin_amdgcn_cvt_scalef32_pk_f32_fp4(vw[c], 1.0f, 3), y2[4 * c + 3]);
        }
      }
    }
    float y[16];
#pragma unroll
    for (int j = 0; j < 8; ++j) {
      const float ax = y2[j].x + __shfl_xor(y2[j].x, 32), ay = y2[j].y + __shfl_xor(y2[j].y, 32);
      const float bx = y2[8 + j].x + __shfl_xor(y2[8 + j].x, 32), by = y2[8 + j].y + __shfl_xor(y2[8 + j].y, 32);
      y[2 * j] = half ? bx : ax; y[2 * j + 1] = half ? by : ay;
    }
    const int bi = batch_of_row(t);
    const float* gate2 = P.MOD + (size_t)(l * 9 + bi) * 6144 + 5 * 1024;
    const int d0 = l32 * 32 + half * 16;
    float xn[16];
    float ss = 0.f;
#pragma unroll
    for (int q4 = 0; q4 < 4; ++q4) {
      const int d = d0 + q4 * 4;
      const uint2 xu = *reinterpret_cast<const uint2*>(P.X + (size_t)t * 1024 + d);
      const float4 xo = make_float4(lo2f(xu.x), hi2f(xu.x), lo2f(xu.y), hi2f(xu.y));
      const float4 gg = *reinterpret_cast<const float4*>(gate2 + d);
      float4 o;
      o.x = xo.x + gg.x * y[q4 * 4 + 0]; o.y = xo.y + gg.y * y[q4 * 4 + 1];
      o.z = xo.z + gg.z * y[q4 * 4 + 2]; o.w = xo.w + gg.w * y[q4 * 4 + 3];
      xn[q4 * 4 + 0] = o.x; xn[q4 * 4 + 1] = o.y; xn[q4 * 4 + 2] = o.z; xn[q4 * 4 + 3] = o.w;
      ss += o.x * o.x + o.y * o.y + o.z * o.z + o.w * o.w;
      if (l == 1) *reinterpret_cast<float4*>(P.out + (size_t)t * 1024 + d) = o;
      else *reinterpret_cast<uint2*>(P.X + (size_t)t * 1024 + d) = make_uint2(pack2(o.x, o.y), pack2(o.z, o.w));
    }
    if (l == 0) {
      ss = wave_sum(ss);
      const float rr = rsqrtf(ss * (1.f / 1024.f) + EPS);
      const float* lnw = P.ln1_w + 1024;
      const float* mod = P.MOD + (size_t)(9 + bi) * 6144;
      unsigned pk[8];
#pragma unroll
      for (int i = 0; i < 16; i += 2) {
        const float o0 = xn[i] * rr * lnw[d0 + i] * (1.f + mod[1024 + d0 + i]) + mod[d0 + i];
        const float o1 = xn[i + 1] * rr * lnw[d0 + i + 1] * (1.f + mod[1024 + d0 + i + 1]) + mod[d0 + i + 1];
        pk[i >> 1] = pack2(o0, o1);
      }
      *reinterpret_cast<uint4*>(P.H + (size_t)t * 1024 + d0) = make_uint4(pk[0], pk[1], pk[2], pk[3]);
      *reinterpret_cast<uint4*>(P.H + (size_t)t * 1024 + d0 + 8) = make_uint4(pk[4], pk[5], pk[6], pk[7]);
    }
  }
}

using f32x4 = __attribute__((ext_vector_type(4))) float;
namespace g8 {
constexpr int BM = 256, BK = 64, HALF = 128, HT = HALF * BK;
DEVI int lds_byte(int r, int c) { const int st = (r >> 4) * 2 + (c >> 5), rr = r & 15, cc = c & 31, ob = rr * 64 + cc * 2; return st * 1024 + (ob ^ (((ob >> 9) & 1) << 5)); }
DEVI void stage_rc(int b, int& R, int& C) { const int st = b / 1024, sb = b % 1024, swz = sb ^ (((sb >> 9) & 1) << 5); R = (st >> 1) * 16 + swz / 64; C = (st & 1) * 32 + (swz % 64) / 2; }
DEVI int perm32(int rho) { const int n = rho >> 4, i = rho & 15; return 8 * (i >> 2) + 4 * n + (i & 3); }
DEVI void unit_of(int L, int nM, int nN, int& pm, int& pn) {
  const int nwg = nM * nN;
  int wgid = L;
  { const int q = nwg / 8, r = nwg % 8, xcd = wgid % 8, off = wgid / 8; wgid = (xcd < r ? xcd * (q + 1) : r * (q + 1) + (xcd - r) * q) + off; }
  const int nig = 8 * nN, gid = wgid / nig, fm = gid * 8, gsz = (nM - fm) < 8 ? (nM - fm) : 8;
  pm = fm + ((wgid % nig) % gsz); pn = (wgid % nig) / gsz;
}
}

struct G8Unit { int pm, pn; };
template <class Epi>
DEVI void gemm8_phase(LAS unsigned char* lds, const bf16* __restrict__ Ag, const bf16* __restrict__ Btg, const int K, const int nM, const int nN, const Epi& E,
                      const int lda = 0, const int pn_split = 1 << 30, const int acol0 = 0, const int acol1 = 0,
                      const int ldb = 0, const int pn_mod = 1 << 30, const int ksplit_cols = 0) {
  constexpr int BK = 64, HALF = 128, HTB = HALF * BK * 2;
  const int tid = threadIdx.x, wid = __builtin_amdgcn_readfirstlane(tid >> 6), lane = tid & 63, wr = wid >> 2, wc = wid & 3, fr = lane & 15, fq = lane >> 4;
  const int nt = K / BK;
  const int nunits = nM * nN, G = gridDim.x, c = blockIdx.x;
  const int LDA = lda ? lda : K, LDB = ldb ? ldb : K;
  unsigned voffA[2], voffB[2];
#pragma unroll
  for (int i = 0; i < 2; ++i) { int R, C; g8::stage_rc(tid * 16 + i * 8192, R, C); const int Rb = (R & ~31) + g8::perm32(R & 31); voffA[i] = (unsigned)(R * LDA + C) * 2u; voffB[i] = (unsigned)(Rb * LDB + C) * 2u; }
  const size_t kstep = (size_t)(BK * 2);
  const size_t hstepA = (size_t)HALF * LDA * 2, hstep = (size_t)HALF * LDB * 2;
  const size_t tstepA = 2 * hstepA, tstep = 2 * hstep;
  const unsigned ldsw = (unsigned)wid * 1024u;
  const int aoff = g8::lds_byte(wr * 64 + fr, fq * 8), boff = g8::lds_byte(wc * 32 + fr, fq * 8);
#define PG8_SA(b, h) (((b) * 2 + (h)) * HTB)
#define PG8_SB(b, h) ((4 + (b) * 2 + (h)) * HTB)
#define PG8_STAGE(bufoff, gbase, voff) do { _Pragma("unroll") for (int _i = 0; _i < 2; ++_i) \
        __builtin_amdgcn_global_load_lds((const unsigned*)((const char*)(gbase) + (voff)[_i]), (LAS unsigned*)(lds + (bufoff) + ldsw + _i * 8192), 16, 0, 0); } while (0)
#define PG8_LDA(dst, b, h) do { _Pragma("unroll") for (int m = 0; m < 4; ++m) _Pragma("unroll") for (int k = 0; k < 2; ++k) dst[m][k] = *(const LAS bf16x8*)(lds + PG8_SA(b, h) + aoff + m * 2048 + k * 1024); } while (0)
#define PG8_LDB(dst, b, h) do { _Pragma("unroll") for (int n = 0; n < 2; ++n) _Pragma("unroll") for (int k = 0; k < 2; ++k) dst[n][k] = *(const LAS bf16x8*)(lds + PG8_SB(b, h) + boff + n * 2048 + k * 1024); } while (0)
#define PG8_MMA(ai, bj, At_, Bt_) do { __builtin_amdgcn_s_setprio(1); _Pragma("unroll") for (int m = 0; m < 4; ++m) _Pragma("unroll") for (int n = 0; n < 2; ++n) _Pragma("unroll") for (int k = 0; k < 2; ++k) \
        acc[ai][bj][m][n] = __builtin_amdgcn_mfma_f32_16x16x32_bf16(Bt_[n][k], At_[m][k], acc[ai][bj][m][n], 0, 0, 0); __builtin_amdgcn_s_setprio(0); } while (0)
#define PG8_WAIT_V(n) asm volatile("s_waitcnt vmcnt(" #n ")" ::: "memory")
#define PG8_WAIT_L(n) asm volatile("s_waitcnt lgkmcnt(" #n ")" ::: "memory")
#define PG8_BAR __builtin_amdgcn_s_barrier()
#define PG8_SCHED __builtin_amdgcn_sched_barrier(0)
  G8Unit cur, nxt; int ui = 0;
  if (c >= nunits) return;
  g8::unit_of(c, nM, nN, cur.pm, cur.pn);
  f32x4 acc[2][2][4][2];
#pragma unroll
  for (int a = 0; a < 2; ++a)
#pragma unroll
    for (int b = 0; b < 2; ++b)
#pragma unroll
      for (int m = 0; m < 4; ++m)
#pragma unroll
        for (int n = 0; n < 2; ++n) acc[a][b][m][n] = (f32x4){0.f, 0.f, 0.f, 0.f};
  bf16x8 At[4][2], B0[2][2], B1[2][2];
  const char* cA = (const char*)Ag + (size_t)cur.pm * tstepA + (size_t)((cur.pn < pn_split ? acol0 : acol1) + (cur.pn / pn_mod) * ksplit_cols) * 2;
  const char* cB = (const char*)Btg + (size_t)(cur.pn % pn_mod) * tstep + (size_t)((cur.pn / pn_mod) * ksplit_cols) * 2;
  PG8_STAGE(PG8_SB(0, 0), cB, voffB); PG8_STAGE(PG8_SA(0, 0), cA, voffA); PG8_STAGE(PG8_SB(0, 1), cB + hstep, voffB); PG8_STAGE(PG8_SA(0, 1), cA + hstepA, voffA);
  if (wr == 1) PG8_BAR;
  PG8_WAIT_V(4); PG8_BAR;
  PG8_STAGE(PG8_SB(1, 0), cB + kstep, voffB); PG8_STAGE(PG8_SA(1, 0), cA + kstep, voffA); PG8_STAGE(PG8_SB(1, 1), cB + hstep + kstep, voffB);
  PG8_WAIT_V(6); PG8_BAR;
  for (;;) {
    const long Ln = (long)(ui + 1) * G + c;
    const bool has_next = Ln < nunits;
    if (has_next) g8::unit_of((int)Ln, nM, nN, nxt.pm, nxt.pn);
    const char* nA = has_next ? (const char*)Ag + (size_t)nxt.pm * tstepA + (size_t)((nxt.pn < pn_split ? acol0 : acol1) + (nxt.pn / pn_mod) * ksplit_cols) * 2 : cA;
    const char* nB = has_next ? (const char*)Btg + (size_t)(nxt.pn % pn_mod) * tstep + (size_t)((nxt.pn / pn_mod) * ksplit_cols) * 2 : cB;
    for (int t = 0; t < nt; t += 2) {
      const bool last = (t == nt - 2);
      const char* a1 = cA + (size_t)(t + 1) * kstep;
      const char* a2 = last ? nA : cA + (size_t)(t + 2) * kstep; const char* b2 = last ? nB : cB + (size_t)(t + 2) * kstep;
      const char* a3 = a2 + kstep; const char* b3 = b2 + kstep;
      PG8_LDB(B0, 0, 0); PG8_SCHED; PG8_LDA(At, 0, 0); PG8_STAGE(PG8_SA(1, 1), a1 + hstepA, voffA);
      PG8_WAIT_L(8); PG8_BAR; PG8_WAIT_L(0); PG8_MMA(0, 0, At, B0); PG8_BAR; PG8_SCHED;
      PG8_LDB(B1, 0, 1); PG8_STAGE(PG8_SB(0, 0), b2, voffB);
      PG8_BAR; PG8_WAIT_L(0); PG8_MMA(0, 1, At, B1); PG8_BAR;
      PG8_LDA(At, 0, 1); PG8_STAGE(PG8_SA(0, 0), a2, voffA);
      PG8_BAR; PG8_WAIT_L(0); PG8_MMA(1, 0, At, B0); PG8_BAR; PG8_SCHED;
      PG8_STAGE(PG8_SB(0, 1), b2 + hstep, voffB);
      PG8_WAIT_V(6); PG8_BAR; PG8_MMA(1, 1, At, B1); PG8_BAR;
      PG8_LDB(B0, 1, 0); PG8_SCHED; PG8_LDA(At, 1, 0); PG8_STAGE(PG8_SA(0, 1), a2 + hstepA, voffA);
      PG8_WAIT_L(8); PG8_BAR; PG8_WAIT_L(0); PG8_MMA(0, 0, At, B0); PG8_BAR; PG8_SCHED;
      PG8_LDB(B1, 1, 1); PG8_STAGE(PG8_SB(1, 0), b3, voffB);
      PG8_BAR; PG8_WAIT_L(0); PG8_MMA(0, 1, At, B1); PG8_BAR;
      PG8_LDA(At, 1, 1); PG8_STAGE(PG8_SA(1, 0), a3, voffA);
      PG8_BAR; PG8_WAIT_L(0); PG8_MMA(1, 0, At, B0); PG8_BAR; PG8_SCHED;
      PG8_STAGE(PG8_SB(1, 1), b3 + hstep, voffB);
      PG8_WAIT_V(6); PG8_BAR; PG8_MMA(1, 1, At, B1); PG8_BAR;
    }
    E(acc, cur, wr, wc, fr, fq);
    if (!has_next) break;
#pragma unroll
    for (int a = 0; a < 2; ++a)
#pragma unroll
      for (int b = 0; b < 2; ++b)
#pragma unroll
        for (int m = 0; m < 4; ++m)
#pragma unroll
          for (int n = 0; n < 2; ++n) acc[a][b][m][n] = (f32x4){0.f, 0.f, 0.f, 0.f};
    cur = nxt; cA = nA; cB = nB; ++ui;
  }
  PG8_WAIT_V(0);
  if (wr == 0) PG8_BAR;
  PG8_BAR;
#undef PG8_SA
#undef PG8_SB
#undef PG8_STAGE
#undef PG8_LDA
#undef PG8_LDB
#undef PG8_MMA
}

struct EpiZ {
  bf16* Z;
  DEVI void operator()(const f32x4 (&acc)[2][2][4][2], const G8Unit& u, int wr, int wc, int fr, int fq) const {
    const int brow = u.pm * 256, bcol = u.pn * 256;
#pragma unroll
    for (int ai = 0; ai < 2; ++ai)
#pragma unroll
      for (int m = 0; m < 4; ++m) {
        const int row = brow + ai * 128 + wr * 64 + m * 16 + fr;
#pragma unroll
        for (int bj = 0; bj < 2; ++bj) {
          const int col = bcol + bj * 128 + wc * 32 + 8 * fq;
          if (col < DIN) {
            const f32x4 v0 = acc[ai][bj][m][0], v1 = acc[ai][bj][m][1];
            *reinterpret_cast<uint4*>(Z + (size_t)row * DIN + col) = make_uint4(pack2(v0[0], v0[1]), pack2(v0[2], v0[3]), pack2(v1[0], v1[1]), pack2(v1[2], v1[3]));
          }
        }
      }
  }
};
DEVI void phase_gemm1_8(const Params& P, int l, unsigned char* smem_base) {
  EpiZ E{P.Z};
  gemm8_phase((LAS unsigned char*)smem_base, P.H, P.WinT + (size_t)l * DINP * 1024, 1024, NT / 256, DINP / 256, E);
  const int c = blockIdx.x;
  if (c >= 136) {
    const int j = c - 136;
    if (l == 0) convert_rows_fp6(P, 0, j * 100, j * 100 + 100);
    else { const int b0 = 19200 + j * 114; convert_rows_fp6(P, 1, b0 < 32768 ? b0 : 32768, b0 + 114 < 32768 ? b0 + 114 : 32768); }
  }
}

struct EpiRAW {
  bf16* R;
  DEVI void operator()(const f32x4 (&acc)[2][2][4][2], const G8Unit& u, int wr, int wc, int fr, int fq) const {
    const int brow = u.pm * 256, bcol = u.pn * 256;
#pragma unroll
    for (int ai = 0; ai < 2; ++ai)
#pragma unroll
      for (int m = 0; m < 4; ++m) {
        const int row = brow + ai * 128 + wr * 64 + m * 16 + fr;
#pragma unroll
        for (int bj = 0; bj < 2; ++bj) {
          const int col = bcol + bj * 128 + wc * 32 + 8 * fq;
          const f32x4 v0 = acc[ai][bj][m][0], v1 = acc[ai][bj][m][1];
          *reinterpret_cast<uint4*>(R + (size_t)row * 1792 + col) = make_uint4(pack2(v0[0], v0[1]), pack2(v0[2], v0[3]), pack2(v1[0], v1[1]), pack2(v1[2], v1[3]));
        }
      }
  }
};
DEVI void phase_mla_raw(const Params& P, int l, unsigned char* smem_base) {
  {
    const int lane = threadIdx.x & 63;
    for (int t = blockIdx.x * 8 + (threadIdx.x >> 6); t < NT; t += gridDim.x * 8) {
      const bf16* zr = P.Z + (size_t)t * DIN;
      const uint2 uq = *reinterpret_cast<const uint2*>(zr + ZC_BQ + lane * 4);
      const unsigned uk = *reinterpret_cast<const unsigned*>(zr + ZC_BKV + lane * 2);
      float sq = lo2f(uq.x) * lo2f(uq.x) + hi2f(uq.x) * hi2f(uq.x) + lo2f(uq.y) * lo2f(uq.y) + hi2f(uq.y) * hi2f(uq.y);
      float sk = lo2f(uk) * lo2f(uk) + hi2f(uk) * hi2f(uk);
      sq = wave_sum(sq); sk = wave_sum(sk);
      if (lane == 0) { P.RS[(size_t)t * 2] = rsqrtf(sq * (1.f / 256.f) + EPS); P.RS[(size_t)t * 2 + 1] = rsqrtf(sk * (1.f / 128.f) + EPS); }
    }
  }
  EpiRAW E{P.RAW};
  gemm8_phase((LAS unsigned char*)smem_base, P.Z, P.WCOMB + (size_t)l * 1792 * 256, 256, NT / 256, 7, E, DIN, 3, ZC_BQ, ZC_BKV);
}

struct EpiX {
  const float* x; const float* ctx; bf16* X; const float* MODl; int l;
  DEVI void operator()(const f32x4 (&acc)[2][2][4][2], const G8Unit& u, int wr, int wc, int fr, int fq) const {
    const int brow = u.pm * 256, bcol = u.pn * 256;
    const float* gate = MODl + (size_t)batch_of_row(brow) * 6144 + 2048;
#pragma unroll
    for (int ai = 0; ai < 2; ++ai)
#pragma unroll
      for (int m = 0; m < 4; ++m) {
        const int row = brow + ai * 128 + wr * 64 + m * 16 + fr;
        const float* res = row < NL ? x + (size_t)row * 1024 : ctx + (size_t)(row - NL) * 1024;
#pragma unroll
        for (int bj = 0; bj < 2; ++bj) {
          const int col = bcol + bj * 128 + wc * 32 + 8 * fq;
          const f32x4 v0 = acc[ai][bj][m][0], v1 = acc[ai][bj][m][1];
          float4 ra, rb;
          if (l == 0) { ra = *reinterpret_cast<const float4*>(res + col); rb = *reinterpret_cast<const float4*>(res + col + 4); }
          else {
            const uint4 uu = *reinterpret_cast<const uint4*>(X + (size_t)row * 1024 + col);
            ra = make_float4(lo2f(uu.x), hi2f(uu.x), lo2f(uu.y), hi2f(uu.y)); rb = make_float4(lo2f(uu.z), hi2f(uu.z), lo2f(uu.w), hi2f(uu.w));
          }
          const float4 ga = *reinterpret_cast<const float4*>(gate + col), gb = *reinterpret_cast<const float4*>(gate + col + 4);
          *reinterpret_cast<uint4*>(X + (size_t)row * 1024 + col) =
              make_uint4(pack2(ra.x + ga.x * v0[0], ra.y + ga.y * v0[1]), pack2(ra.z + ga.z * v0[2], ra.w + ga.w * v0[3]),
                         pack2(rb.x + gb.x * v1[0], rb.y + gb.y * v1[1]), pack2(rb.z + gb.z * v1[2], rb.w + gb.w * v1[3]));
        }
      }
  }
};
struct EpiPart {
  float* PART;
  DEVI void operator()(const f32x4 (&acc)[2][2][4][2], const G8Unit& u, int wr, int wc, int fr, int fq) const {
    const int brow = u.pm * 256, bcol = (u.pn & 3) * 256;
    float* base = PART + (size_t)(u.pn >> 2) * 2048 * 1024;
#pragma unroll
    for (int ai = 0; ai < 2; ++ai)
#pragma unroll
      for (int m = 0; m < 4; ++m) {
        const int row = brow + ai * 128 + wr * 64 + m * 16 + fr;
#pragma unroll
        for (int bj = 0; bj < 2; ++bj) {
          const int col = bcol + bj * 128 + wc * 32 + 8 * fq;
          const f32x4 v0 = acc[ai][bj][m][0], v1 = acc[ai][bj][m][1];
          *reinterpret_cast<float4*>(base + (size_t)row * 1024 + col) = make_float4(v0[0], v0[1], v0[2], v0[3]);
          *reinterpret_cast<float4*>(base + (size_t)row * 1024 + col + 4) = make_float4(v1[0], v1[1], v1[2], v1[3]);
        }
      }
  }
};
DEVI void phase_gemm2_8(const Params& P, int l, unsigned char* smem_base) {
  EpiX E{P.x, P.ctx, P.X, P.MOD + (size_t)l * 9 * 6144, l};
  gemm8_phase((LAS unsigned char*)smem_base, P.H, P.WoutT + (size_t)l * 1024 * 1024, 1024, NL / 256, 4, E);
  if (l == 0) {
    EpiPart EP{P.PART};
    gemm8_phase((LAS unsigned char*)smem_base, P.H + (size_t)NL * 1024, P.WoutT, 512, 8, 8, EP, 1024, 1 << 30, 0, 0, 1024, 4, 512);
    const int c = blockIdx.x;
    if (c >= 64) {
      const int b0 = 12000 + (c - 64) * 109;
      convert_rows_fp6(P, 0, b0 < 32768 ? b0 : 32768, b0 + 109 < 32768 ? b0 + 109 : 32768);
    }
  }
}

struct EpiQP {
  bf16* QP;
  DEVI void operator()(const f32x4 (&acc)[2][2][4][2], const G8Unit& u, int wr, int wc, int fr, int fq) const {
    const int brow = u.pm * 256, bcol = u.pn * 256;
#pragma unroll
    for (int ai = 0; ai < 2; ++ai)
#pragma unroll
      for (int m = 0; m < 4; ++m) {
        const int row = brow + ai * 128 + wr * 64 + m * 16 + fr;
#pragma unroll
        for (int bj = 0; bj < 2; ++bj) {
          const int col = bcol + bj * 128 + wc * 32 + 8 * fq;
          const f32x4 v0 = acc[ai][bj][m][0], v1 = acc[ai][bj][m][1];
          *reinterpret_cast<uint4*>(QP + (size_t)row * 2048 + col) = make_uint4(pack2(v0[0], v0[1]), pack2(v0[2], v0[3]), pack2(v1[0], v1[1]), pack2(v1[2], v1[3]));
        }
      }
  }
};
DEVI void phase_gemm3_8(const Params& P, int l, unsigned char* smem_base) {
  EpiQP E{P.QP};
  gemm8_phase((LAS unsigned char*)smem_base, P.H, P.WpqT + (size_t)l * 2048 * 1024, 1024, (l == 1) ? NL / 256 : NT / 256, 8, E);
  const int c = blockIdx.x;
  if (l == 0 && c >= 64) convert_rows_fp6(P, 1, (c - 64) * 100, (c - 64) * 100 + 100);
}

constexpr int N_PHASES = 2 + 2 * 11;

#ifndef REP_MASK
#define REP_MASK 0
#endif
static_assert(sizeof(Params) % 8 == 0, "Params size");
DEVI Params load_params() {
#if defined(__HIP_DEVICE_COMPILE__)
  typedef const __attribute__((address_space(4))) Params* ParamsCP;
  ParamsCP pp = (ParamsCP)__builtin_amdgcn_kernarg_segment_ptr();
  asm volatile("" : "+s"(pp));
  return *pp;
#else
  return Params{};
#endif
}
__global__ void __launch_bounds__(512, 2) fwd_kernel(Params Pk) {
  extern __shared__ __attribute__((aligned(16))) unsigned char smem_base[];
  volatile LAS unsigned* xst = (volatile LAS unsigned*)(smem_base + SMEM_BYTES);
  if (threadIdx.x == 0) { xst[0] = 0u; xst[1] = 0u; xst[2] = 0u; xst[3] = 0u; }
  __syncthreads();
  XcdBarrier xb = xcd_barrier_post(Pk.bar, xst);
  const int phase_lo = Pk.phase_lo, phase_hi = Pk.phase_hi, coop = Pk.coop;
#define smem (smem_base + VHALF * HALF_LDS)
#define GSYNC(idx) { xcd_barrier(xb); }
#define RUN_PHASE2(idx, call, repcall) \
  if (phase_lo <= (idx) && (idx) <= phase_hi) { { const Params P = load_params(); call; } if (REP_MASK & (1 << (idx))) { GSYNC(1); const Params P = load_params(); repcall; } if (coop && (idx) < phase_hi) GSYNC(idx); }
#define RUN_PHASE(idx, call) RUN_PHASE2(idx, call, call)
  RUN_PHASE(0, phase_prologue(P, smem))
  RUN_PHASE(1, phase_norm(P, 0, 0, NT))
  RUN_PHASE(2, phase_gemm1_8(P, 0, smem_base))
  RUN_PHASE(3, phase_mla_raw(P, 0, smem_base))
  RUN_PHASE(4, { phase_mixA(P, 0, smem); phase_mla_proj(P, 0, smem); phase_hgrn_local(P, 0, smem); })
  RUN_PHASE2(5, phase_attn_scan(P, 0, smem_base), phase_attn_scan(P, 0, smem_base, true))
  RUN_PHASE(6, phase_hgrn_final(P, 0, smem))
  RUN_PHASE(7, phase_gemm2_8(P, 0, smem_base))
  RUN_PHASE(8, phase_norm(P, 0, 1, NT))
  RUN_PHASE(9, phase_gemm3_8(P, 0, smem_base))
  RUN_PHASE(10, phase_route(P, 0, smem))
  RUN_PHASE(11, phase_peer_u(P, 0))
  RUN_PHASE(12, phase_peer(P, 0))
  RUN_PHASE(13, phase_gemm1_8(P, 1, smem_base))
  RUN_PHASE(14, phase_mla_raw(P, 1, smem_base))
  RUN_PHASE(15, { phase_mixA(P, 1, smem); phase_mla_proj(P, 1, smem); phase_hgrn_local(P, 1, smem); })
  RUN_PHASE2(16, phase_attn_scan(P, 1, smem_base), phase_attn_scan(P, 1, smem_base, true))
  RUN_PHASE(17, phase_hgrn_final(P, 1, smem))
  RUN_PHASE(18, phase_gemm2_8(P, 1, smem_base))
  RUN_PHASE(19, phase_norm(P, 1, 1, NL))
  RUN_PHASE(20, phase_gemm3_8(P, 1, smem_base))
  RUN_PHASE(21, phase_route(P, 1, smem))
  RUN_PHASE(22, phase_peer_u(P, 1))
  RUN_PHASE(23, phase_peer(P, 1))
#undef smem
}

extern "C" void kernel_launch(void* const* d_in, const int* in_sizes, int n_in, void* d_out, int out_size, void* d_ws,
                              size_t ws_size, hipStream_t stream) {
  Params p{};
  const float* const* in = reinterpret_cast<const float* const*>(d_in);
  p.x = in[0]; p.c = in[1]; p.ctx = in[2]; p.c_ctx = in[3]; p.ln1_w = in[4]; p.ln2_w = in[5]; p.w_mod = in[6]; p.b_mod = in[7];
  p.w_in = in[8]; p.w_out = in[9]; p.a_norm_w = in[10]; p.a_w_s = in[11]; p.a_b_s = in[12]; p.b_q_norm_w = in[13]; p.b_w_uq = in[14];
  p.b_kv_norm_w = in[15]; p.b_w_ukv = in[16]; p.b_qh_w = in[17]; p.b_kh_w = in[18]; p.c_lb = in[19]; p.c_out_norm_w = in[20];
  p.p_w_q = in[21]; p.p_sub_keys = in[22]; p.p_u = in[23]; p.p_v = in[24];
  p.out = reinterpret_cast<float*>(d_out);
  unsigned char* ws = reinterpret_cast<unsigned char*>(d_ws);
  size_t off = 0;
  auto take = [&](size_t bytes) { unsigned char* r = ws + off; off += (bytes + 255) & ~(size_t)255; return r; };
  p.bar = (unsigned*)take((size_t)XCD_BAR_WORDS * 4);
  p.MOD = (float*)take((size_t)2 * 9 * 6144 * 4);
  p.ROPE = (float*)take((size_t)2048 * 32 * 4);
  p.WinT = (bf16*)take((size_t)2 * DINP * 1024 * 2);
  p.WoutT = (bf16*)take((size_t)2 * 1024 * 1024 * 2);
  p.WpqT = (bf16*)take((size_t)2 * 2048 * 1024 * 2);
  p.WCOMB = (bf16*)take((size_t)2 * 1792 * 256 * 2);
  p.RAW = (bf16*)take((size_t)NT * 1792 * 2);
  p.SK = (bf16*)take((size_t)2 * 16 * 128 * 128 * 2);
  p.AWS = (bf16*)take((size_t)2 * 4 * 128 * 128 * 2);
  p.PU8 = (unsigned char*)take((size_t)2 * 16384 * 576);
  p.PV8 = (unsigned char*)take((size_t)2 * 16384 * 576);
  p.PUS = (float*)take((size_t)2 * 16384 * 4);
  p.PVS = (float*)take((size_t)2 * 16384 * 4);
  p.X = (bf16*)take((size_t)NT * 1024 * 2);
  p.H = (bf16*)take((size_t)NT * 1024 * 2);
  p.Z = (bf16*)take((size_t)NT * DIN * 2);
  p.Q = (bf16*)take((size_t)64 * SEQP * 96 * 2);
  p.K = (bf16*)take((size_t)64 * SEQP * 96 * 2);
  p.VT = (bf16*)take((size_t)64 * 64 * SEQP * 2);
  p.ST = (bf16*)take((size_t)64 * 36 * 4096 * 2);
  p.DEC = (float*)take((size_t)64 * 36 * 64 * 4);
  p.OI = (bf16*)take((size_t)NT * 256 * 2);
  p.WPE = (float*)take((size_t)NT * 128 * 4);
  p.PART = (float*)take((size_t)2 * 2048 * 1024 * 4);
  p.RS = (float*)take((size_t)NT * 2 * 4);
  p.GQF = (bf16*)take((size_t)NT * 256 * 2);
  p.GQB = (bf16*)take((size_t)NT * 256 * 2);
  p.QP = p.Z;
  p.EIDX = (int*)p.Q;
  p.GATE = (float*)p.K;
  if (off > ws_size) { fprintf(stderr, "workspace too small: need %zu have %zu\n", off, ws_size); }
  static int grid_blocks = 0;
  if (!grid_blocks) {
    if (hipFuncSetAttribute((const void*)fwd_kernel, hipFuncAttributeMaxDynamicSharedMemorySize, SMEM_TOTAL) != hipSuccess)
      fprintf(stderr, "hipFuncSetAttribute failed\n");
    int dev = 0, cus = 0, per_cu = 0;
    hipGetDevice(&dev);
    hipDeviceGetAttribute(&cus, hipDeviceAttributeMultiprocessorCount, dev);
    hipOccupancyMaxActiveBlocksPerMultiprocessor(&per_cu, (const void*)fwd_kernel, 512, SMEM_TOTAL);
    if (per_cu > 1) per_cu = 1;
    if (per_cu < 1) { fprintf(stderr, "occupancy query returned %d\n", per_cu); per_cu = 1; }
    grid_blocks = cus * per_cu;
    fprintf(stderr, "grid_blocks=%d (cus=%d per_cu=%d) ws need=%zu have=%zu\n", grid_blocks, cus, per_cu, off, ws_size);
  }
  hipMemsetAsync(p.bar, 0, (size_t)XCD_BAR_WORDS * 4, stream);
  p.coop = 1; p.phase_lo = 0; p.phase_hi = N_PHASES - 1;
  hipLaunchKernelGGL(fwd_kernel, dim3(grid_blocks), dim3(512), SMEM_TOTAL, stream, p);
  const hipError_t e = hipPeekAtLastError();
  if (e != hipSuccess) fprintf(stderr, "launch failed: %s (grid %d)\n", hipGetErrorString(e), grid_blocks);
}
```

```cpp
#include <hip/hip_runtime.h>
#include <hip/hip_cooperative_groups.h>
#include <cstdio>
#include <cstdint>
namespace cg = cooperative_groups;

#define DEVI __device__ __forceinline__

typedef unsigned short bf16;
using bf16x8 = __attribute__((ext_vector_type(8))) __bf16;
using bf16x2 = __attribute__((ext_vector_type(2))) __bf16;
using f32x16 = __attribute__((ext_vector_type(16))) float;
typedef unsigned v6u __attribute__((ext_vector_type(6)));
typedef unsigned v3u __attribute__((ext_vector_type(3)));
typedef float v16f __attribute__((ext_vector_type(16)));
typedef float v32f __attribute__((ext_vector_type(32)));

constexpr int NL = 16384;
constexpr int NT = 18432;
constexpr int DM = 1024;
constexpr int DIN = 2208;
constexpr int DINP = 2304;
constexpr int SEQP = 2304;
constexpr float EPS = 1e-6f;
constexpr int ZC_AU = 0, ZC_AV = 256, ZC_BQ = 512, ZC_BKV = 768, ZC_BKR = 896, ZC_CQ = 928, ZC_CFF = 1184, ZC_CFB = 1440, ZC_CI = 1696, ZC_CG = 1952;
constexpr int SMEM_BYTES = 2 * 80896;
constexpr int SMEM_TOTAL = SMEM_BYTES + 16;

struct Params {
  const float *x, *c, *ctx, *c_ctx, *ln1_w, *ln2_w, *w_mod, *b_mod, *w_in, *w_out, *a_norm_w, *a_w_s, *a_b_s;
  const float *b_q_norm_w, *b_w_uq, *b_kv_norm_w, *b_w_ukv, *b_qh_w, *b_kh_w, *c_lb, *c_out_norm_w, *p_w_q, *p_sub_keys, *p_u, *p_v;
  float* out;
  unsigned* bar;
  float* MOD;
  float* ROPE;
  bf16* WinT;
  bf16* WoutT;
  bf16* WpqT;
  bf16* WCOMB;
  bf16* RAW;
  bf16* SK;
  bf16* AWS;
  unsigned char* PU8;
  unsigned char* PV8;
  float* PUS;
  float* PVS;
  bf16* X;
  bf16* H;
  bf16* Z;
  bf16* Q;
  bf16* K;
  bf16* VT;
  bf16* ST;
  float* DEC;
  bf16* OI;
  float* WPE;
  float* RS;
  float* PART;
  bf16* GQF;
  bf16* GQB;
  bf16* QP;
  int* EIDX;
  float* GATE;
  int phase_lo, phase_hi, coop, pad0;
};

DEVI float bf2f(bf16 v) { return __uint_as_float(((unsigned)v) << 16); }
DEVI bf16 f2bf(float a) { __bf16 v = (__bf16)a; return __builtin_bit_cast(unsigned short, v); }
DEVI unsigned pack2(float a, float b) { bf16x2 v; v[0] = (__bf16)a; v[1] = (__bf16)b; return __builtin_bit_cast(unsigned, v); }
DEVI float lo2f(unsigned u) { return __uint_as_float(u << 16); }
DEVI float hi2f(unsigned u) { return __uint_as_float(u & 0xffff0000u); }
DEVI f32x16 zero16() { f32x16 z;
#pragma unroll
  for (int i = 0; i < 16; ++i) z[i] = 0.f; return z; }
DEVI f32x16 mfma32(bf16x8 a, bf16x8 b, f32x16 c) { return __builtin_amdgcn_mfma_f32_32x32x16_bf16(a, b, c, 0, 0, 0); }
DEVI bf16x8 ldfrag(const bf16* p) { return *reinterpret_cast<const bf16x8*>(p); }
DEVI int drow(int r, int hh) { return (r & 3) + 8 * (r >> 2) + 4 * hh; }
DEVI int row_of(int b, int p) { return p < 256 ? NL + b * 256 + p : b * 2048 + (p - 256); }
DEVI int batch_of_row(int r) { return r < NL ? (r >> 11) : 8; }
DEVI float wave_sum(float v) {
#pragma unroll
  for (int o = 32; o > 0; o >>= 1) v += __shfl_xor(v, o);
  return v;
}
DEVI float sigmoidf_(float z) { return 1.f / (1.f + __expf(-z)); }


#define XB_TMO      128
#define XB_XCNT(j)  (256  + 64 * (j))
#define XB_XSUB(j)  (1280 + 64 * (j))
#define XB_XGEN(j)  (2304 + 64 * (j))
#define XB_TOP      3328
#define XB_TOPGEN   3392
#define XCD_BAR_WORDS 3456
#define XB_SPIN_CAP (1u << 22)
#define LAS __attribute__((address_space(3)))
DEVI unsigned xb_ld(unsigned* p)              { return __hip_atomic_load(p, __ATOMIC_RELAXED, __HIP_MEMORY_SCOPE_AGENT); }
DEVI unsigned xb_add(unsigned* p, unsigned v) { return __hip_atomic_fetch_add(p, v, __ATOMIC_RELAXED, __HIP_MEMORY_SCOPE_AGENT); }
DEVI unsigned xb_xcc_id() { return (unsigned)__builtin_amdgcn_s_getreg((3 << 11) | 20) & 0xFu; }
#define XB_SPIN(cond, bar) do { unsigned _sp = 0; while (cond) { __builtin_amdgcn_s_sleep(1); \
    if ((++_sp & 255u) == 0u) { if (xb_ld(&(bar)[XB_TMO])) break; if (_sp > XB_SPIN_CAP) { atomicAdd(&(bar)[XB_TMO], 1u); break; } } } } while (0)
struct XcdBarrier { unsigned* bar; unsigned x; volatile LAS unsigned* st; };
DEVI XcdBarrier xcd_barrier_post(unsigned* bar, volatile LAS unsigned* st) {
  XcdBarrier b; b.bar = bar; b.x = xb_xcc_id(); b.st = st;
  if (threadIdx.x == 0) (void)xb_add(&bar[XB_XCNT(b.x)], 1u);
  return b;
}
DEVI void xcd_barrier_complete(unsigned* bar, unsigned x, unsigned& nloc, unsigned& nx) {
  const unsigned G = gridDim.x * gridDim.y * gridDim.z;
  unsigned sum, cnt, mine, sp = 0u;
  for (;;) {
    sum = 0u; cnt = 0u; mine = 0u;
#pragma unroll
    for (unsigned j = 0; j < 16; ++j) { const unsigned c = xb_ld(&bar[XB_XCNT(j)]); sum += c; cnt += (c > 0u) ? 1u : 0u; mine = (j == x) ? c : mine; }
    if (sum == G) break;
    __builtin_amdgcn_s_sleep(1);
    if ((++sp & 255u) == 0u) { if (xb_ld(&bar[XB_TMO])) break; if (sp > XB_SPIN_CAP) { atomicAdd(&bar[XB_TMO], 1u); break; } }
  }
  nloc = mine > 0u ? mine : 1u; nx = cnt > 0u ? cnt : 1u;
}
DEVI void xcd_barrier(const XcdBarrier& b) {
  asm volatile("s_waitcnt vmcnt(0)" ::: "memory");
  __syncthreads();
  if (threadIdx.x == 0) {
    unsigned* bar = b.bar;
    __builtin_amdgcn_s_waitcnt(0);
    unsigned nloc = b.st[0], nx = b.st[1];
    if (nloc == 0u) { xcd_barrier_complete(bar, b.x, nloc, nx); b.st[0] = nloc; b.st[1] = nx; }
    const unsigned old = xb_add(&bar[XB_XSUB(b.x)], 1u);
    const unsigned gen = old / nloc;
    if (old + 1u == (gen + 1u) * nloc) {
      __builtin_amdgcn_fence(__ATOMIC_RELEASE, "agent");
      asm volatile("s_waitcnt vmcnt(0)" ::: "memory");
      const unsigned og = xb_add(&bar[XB_TOP], 1u);
      const unsigned tg = og / nx;
      if (og + 1u == (tg + 1u) * nx) xb_add(&bar[XB_TOPGEN], 1u);
      else XB_SPIN(xb_ld(&bar[XB_TOPGEN]) == tg, bar);
      __builtin_amdgcn_fence(__ATOMIC_ACQUIRE, "agent");
      xb_add(&bar[XB_XGEN(b.x)], 1u);
      asm volatile("s_waitcnt vmcnt(0)" ::: "memory");
    } else {
      XB_SPIN(xb_ld(&bar[XB_XGEN(b.x)]) == gen, bar);
      __builtin_amdgcn_fence(__ATOMIC_ACQUIRE, "agent");
      asm volatile("s_waitcnt vmcnt(0)" ::: "memory");
    }
  }
  __syncthreads();
}

#define VHALF ((int)__builtin_amdgcn_readfirstlane((int)(threadIdx.x >> 8)))
#define TIDX ((int)(threadIdx.x & 255))
#define VBID ((int)(blockIdx.x * 2 + VHALF))
#define NVB ((int)(gridDim.x * 2))
constexpr int HALF_LDS = 80896;

DEVI void hb_sync() {
  extern __shared__ __attribute__((aligned(16))) unsigned char hb_smem[];
  LAS unsigned* cnt = (LAS unsigned*)(hb_smem + SMEM_BYTES) + 2 + VHALF;
  __builtin_amdgcn_fence(__ATOMIC_RELEASE, "workgroup");
  if ((threadIdx.x & 63) == 0) {
    const unsigned old = __hip_atomic_fetch_add(cnt, 1u, __ATOMIC_RELAXED, __HIP_MEMORY_SCOPE_WORKGROUP);
    const unsigned target = (old / 4u + 1u) * 4u;
    while (__hip_atomic_load(cnt, __ATOMIC_RELAXED, __HIP_MEMORY_SCOPE_WORKGROUP) < target) __builtin_amdgcn_s_sleep(0);
  }
  __builtin_amdgcn_fence(__ATOMIC_ACQUIRE, "workgroup");
}

DEVI void phase_mod(const Params& P, unsigned char* smem) {
  const int tid = TIDX;
  float* s = (float*)smem;
  float* red = s + 9 * 1024;
  for (int item = VBID; item < 192; item += NVB) {
    const int l = item / 96, j = item % 96;
    hb_sync();
    for (int i = tid; i < 9 * 1024; i += 256) {
      int bi = i >> 10, k = i & 1023;
      float v = bi < 8 ? P.c[bi * 1024 + k] : P.c_ctx[k];
      s[i] = v * sigmoidf_(v);
    }
    hb_sync();
    const int c4 = tid & 15, kg = tid >> 4;
    float acc[9][4];
#pragma unroll
    for (int bi = 0; bi < 9; ++bi) { acc[bi][0] = acc[bi][1] = acc[bi][2] = acc[bi][3] = 0.f; }
    const float* w = P.w_mod + (size_t)l * 1024 * 6144 + j * 64 + c4 * 4;
#pragma unroll 4
    for (int kk = 0; kk < 64; ++kk) {
      const int k = kg * 64 + kk;
      const float4 w4 = *reinterpret_cast<const float4*>(w + (size_t)k * 6144);
#pragma unroll
      for (int bi = 0; bi < 9; ++bi) {
        const float sv = s[bi * 1024 + k];
        acc[bi][0] += sv * w4.x; acc[bi][1] += sv * w4.y; acc[bi][2] += sv * w4.z; acc[bi][3] += sv * w4.w;
      }
    }
#pragma unroll
    for (int bi = 0; bi < 9; ++bi)
#pragma unroll
      for (int e = 0; e < 4; ++e) red[(kg * 9 + bi) * 64 + c4 * 4 + e] = acc[bi][e];
    hb_sync();
    for (int o = tid; o < 576; o += 256) {
      const int bi = o >> 6, cc = o & 63;
      float sum = 0.f;
#pragma unroll
      for (int g = 0; g < 16; ++g) sum += red[(g * 9 + bi) * 64 + cc];
      P.MOD[(size_t)(l * 9 + bi) * 6144 + j * 64 + cc] = sum + P.b_mod[l * 6144 + j * 64 + cc];
    }
  }
}

DEVI void conv_T_tile(const float* __restrict__ src, int N, bf16* __restrict__ dst, int Kd, int k0, int n0,
                      const float* __restrict__ kscale, float* tile) {
  const int tid = TIDX;
  hb_sync();
  for (int e = tid; e < 4096; e += 256) {
    const int i = e >> 6, j = e & 63, n = n0 + j;
    float v = (n < N) ? src[(size_t)(k0 + i) * N + n] : 0.f;
    if (kscale) v *= kscale[k0 + i];
    tile[i * 65 + j] = v;
  }
  hb_sync();
  for (int e = tid; e < 2048; e += 256) {
    const int j = e >> 5, i2 = (e & 31) * 2;
    const unsigned pk = pack2(tile[i2 * 65 + j], tile[(i2 + 1) * 65 + j]);
    *reinterpret_cast<unsigned*>(&dst[(size_t)(n0 + j) * Kd + k0 + i2]) = pk;
  }
}

DEVI void conv_straight(const float* __restrict__ src, bf16* __restrict__ dst, size_t n8) {
  const size_t stride = (size_t)NVB * 256;
  for (size_t i = (size_t)VBID * 256 + TIDX; i < n8; i += stride) {
    const float4 a = reinterpret_cast<const float4*>(src)[2 * i];
    const float4 b = reinterpret_cast<const float4*>(src)[2 * i + 1];
    uint4 o; o.x = pack2(a.x, a.y); o.y = pack2(a.z, a.w); o.z = pack2(b.x, b.y); o.w = pack2(b.z, b.w);
    reinterpret_cast<uint4*>(dst)[i] = o;
  }
}

DEVI void convert_rows_fp6(const Params& P, int L, int i0, int i1) {
  const int lane = threadIdx.x & 63, half = lane >> 5, l32 = lane & 31;
  const int wv = threadIdx.x >> 6;
  for (int ib = i0 + wv * 2; ib < i1; ib += 16) {
    int i = ib + half; const bool live = i < i1; if (!live) i = i1 - 1;
    const int table = i >> 14, lr = L * 16384 + (i & 16383);
    const float* src = (table ? P.p_v : P.p_u) + (size_t)lr * 1024 + l32 * 32;
    float4 a[8];
    float m = 0.f;
#pragma unroll
    for (int q = 0; q < 8; ++q) {
      a[q] = *reinterpret_cast<const float4*>(src + q * 4);
      m = fmaxf(m, fmaxf(fmaxf(fabsf(a[q].x), fabsf(a[q].y)), fmaxf(fabsf(a[q].z), fabsf(a[q].w))));
    }
    const unsigned sb = (__float_as_uint(fmaxf(m, 1e-30f) * (1.f / 6.f)) + 0xffffu) >> 16;
    const float inv = 1.f / __uint_as_float(sb << 16);
    unsigned pk[4];
#pragma unroll
    for (int w = 0; w < 4; ++w) {
      unsigned word = 0u;
#pragma unroll
      for (int e = 0; e < 8; ++e) {
        const int idx = w * 8 + e;
        const float4 q4 = a[idx >> 2];
        const float xv = ((idx & 3) == 0 ? q4.x : (idx & 3) == 1 ? q4.y : (idx & 3) == 2 ? q4.z : q4.w) * inv;
        const float av = fabsf(xv);
        unsigned ci = (av > 0.25f) + (av > 0.75f) + (av > 1.25f) + (av > 1.75f) + (av > 2.5f) + (av > 3.5f) + (av > 5.f);
        ci |= (xv < 0.f) ? 8u : 0u;
        word |= ci << (4 * e);
      }
      pk[w] = word;
    }
    unsigned char* rowp = (table ? P.PV8 : P.PU8) + (size_t)lr * 576;
    if (live) {
      *reinterpret_cast<uint4*>(rowp + l32 * 16) = make_uint4(pk[0], pk[1], pk[2], pk[3]);
      *reinterpret_cast<unsigned short*>(rowp + 512 + l32 * 2) = (unsigned short)sb;
    }
  }
}

DEVI void phase_prologue(const Params& P, unsigned char* smem) {
  phase_mod(P, smem);
  float* tile = (float*)smem;
  for (int it = VBID; it < 2 * 1424; it += NVB) {
    const int l = it / 1424; int r = it % 1424;
    if (r < 576) { conv_T_tile(P.w_in + (size_t)l * 1024 * DIN, DIN, P.WinT + (size_t)l * DINP * 1024, 1024, (r % 16) * 64, (r / 16) * 64, nullptr, tile); continue; }
    r -= 576;
    if (r < 256) { conv_T_tile(P.w_out + (size_t)l * 1024 * 1024, 1024, P.WoutT + (size_t)l * 1024 * 1024, 1024, (r % 16) * 64, (r / 16) * 64, nullptr, tile); continue; }
    r -= 256;
    if (r < 512) continue;
    r -= 512;
    if (r < 48) { conv_T_tile(P.b_w_uq + (size_t)l * 256 * 768, 768, P.WCOMB + (size_t)l * 1792 * 256, 256, (r % 4) * 64, (r / 4) * 64, P.b_q_norm_w + l * 256, tile); continue; }
    r -= 48;
    conv_T_tile(P.b_w_ukv + (size_t)l * 128 * 1024, 1024, P.WCOMB + (size_t)l * 1792 * 256 + 768 * 256, 256, (r % 2) * 64, (r / 2) * 64, P.b_kv_norm_w + l * 128, tile);
  }
  {
    const int tid = TIDX, lane = tid & 63, wave = tid >> 6, l31 = lane & 31, hh = lane >> 5;
    for (int it = VBID; it < 2 * 16 * 8; it += NVB) {
      const int kt = it & 7, hp = (it >> 3) & 15, l = it >> 7;
      const float* keys = P.p_sub_keys + ((size_t)(l * 16 + hp) * 128 + wave * 32 + l31) * 128;
      const float* wq = P.p_w_q + (size_t)l * 1024 * 2048 + hp * 128;
      f32x16 acc[4];
#pragma unroll
      for (int j = 0; j < 4; ++j) acc[j] = zero16();
#pragma unroll 2
      for (int ks = 0; ks < 8; ++ks) {
        const float4 a0 = *reinterpret_cast<const float4*>(keys + ks * 16 + hh * 8), a1 = *reinterpret_cast<const float4*>(keys + ks * 16 + hh * 8 + 4);
        bf16x8 af;
        af[0] = (__bf16)a0.x; af[1] = (__bf16)a0.y; af[2] = (__bf16)a0.z; af[3] = (__bf16)a0.w; af[4] = (__bf16)a1.x; af[5] = (__bf16)a1.y; af[6] = (__bf16)a1.z; af[7] = (__bf16)a1.w;
#pragma unroll
        for (int j = 0; j < 4; ++j) {
          const float* wp = wq + (size_t)(kt * 128 + j * 32 + l31) * 2048 + ks * 16 + hh * 8;
          const float4 b0 = *reinterpret_cast<const float4*>(wp), b1 = *reinterpret_cast<const float4*>(wp + 4);
          bf16x8 bfr;
          bfr[0] = (__bf16)b0.x; bfr[1] = (__bf16)b0.y; bfr[2] = (__bf16)b0.z; bfr[3] = (__bf16)b0.w; bfr[4] = (__bf16)b1.x; bfr[5] = (__bf16)b1.y; bfr[6] = (__bf16)b1.z; bfr[7] = (__bf16)b1.w;
          acc[j] = mfma32(af, bfr, acc[j]);
        }
      }
      bf16* dst = P.WpqT + (size_t)l * 2048 * 1024 + (size_t)(hp * 128 + wave * 32) * 1024 + kt * 128;
#pragma unroll
      for (int j = 0; j < 4; ++j)
#pragma unroll
        for (int r = 0; r < 16; ++r) dst[(size_t)drow(r, hh) * 1024 + j * 32 + l31] = f2bf(acc[j][r]);
    }
  }
  for (int i = VBID * 256 + TIDX; i < 2 * 1024 * 16; i += NVB * 256) {
    const int l2 = i >> 14, rr = (i >> 4) & 1023, cc = i & 15;
    *reinterpret_cast<uint4*>(P.WCOMB + (size_t)l2 * 1792 * 256 + (size_t)(768 + rr) * 256 + 128 + cc * 8) = make_uint4(0u, 0u, 0u, 0u);
  }
  conv_straight(P.a_w_s, P.AWS, (size_t)2 * 4 * 128 * 128 / 8);
  for (int i = VBID * 256 + TIDX; i < 2048 * 16; i += NVB * 256) {
    const int t = i >> 4, a = (i >> 3) & 1, f = i & 7;
    const float inv = powf(10000.f, -(float)f / 8.f);
    const float pos = a ? (float)(t & 63) : (float)(t >> 6);
    const float ang = pos * inv;
    P.ROPE[t * 32 + a * 8 + f] = cosf(ang);
    P.ROPE[t * 32 + 16 + a * 8 + f] = sinf(ang);
  }
}

DEVI void phase_norm(const Params& P, int l, int which, int nrows) {
  const int lane = TIDX & 63;
  const int gw = VBID * 4 + (TIDX >> 6), nw = NVB * 4;
  const float* lnw = (which == 0 ? P.ln1_w : P.ln2_w) + l * 1024;
  for (int r = gw; r < nrows; r += nw) {
    const float* mod = P.MOD + (size_t)(l * 9 + batch_of_row(r)) * 6144 + which * 3072;
    float4 v[4];
    float ss = 0.f;
    if (which == 0 && l == 0) {
      const float* src = r < NL ? P.x + (size_t)r * 1024 : P.ctx + (size_t)(r - NL) * 1024;
#pragma unroll
      for (int i = 0; i < 4; ++i) v[i] = *reinterpret_cast<const float4*>(src + i * 256 + lane * 4);
    } else if (which == 1 && l == 0 && r >= NL) {
      const float* cin = P.ctx + (size_t)(r - NL) * 1024;
      const float* p0 = P.PART + (size_t)(r - NL) * 1024;
      const float* p1 = p0 + (size_t)2048 * 1024;
      const float* gate = P.MOD + (size_t)8 * 6144 + 2048;
#pragma unroll
      for (int i = 0; i < 4; ++i) {
        const int d = i * 256 + lane * 4;
        const float4 c4 = *reinterpret_cast<const float4*>(cin + d), a4 = *reinterpret_cast<const float4*>(p0 + d), b4 = *reinterpret_cast<const float4*>(p1 + d);
        const float4 g4 = *reinterpret_cast<const float4*>(gate + d);
        v[i] = make_float4(c4.x + g4.x * (a4.x + b4.x), c4.y + g4.y * (a4.y + b4.y), c4.z + g4.z * (a4.z + b4.z), c4.w + g4.w * (a4.w + b4.w));
        *reinterpret_cast<uint2*>(P.X + (size_t)r * 1024 + d) = make_uint2(pack2(v[i].x, v[i].y), pack2(v[i].z, v[i].w));
      }
    } else {
      const bf16* src = P.X + (size_t)r * 1024;
#pragma unroll
      for (int i = 0; i < 4; ++i) {
        const uint2 u = *reinterpret_cast<const uint2*>(src + i * 256 + lane * 4);
        v[i] = make_float4(lo2f(u.x), hi2f(u.x), lo2f(u.y), hi2f(u.y));
      }
    }
#pragma unroll
    for (int i = 0; i < 4; ++i) ss += v[i].x * v[i].x + v[i].y * v[i].y + v[i].z * v[i].z + v[i].w * v[i].w;
    ss = wave_sum(ss);
    const float rr = rsqrtf(ss * (1.f / 1024.f) + EPS);
#pragma unroll
    for (int i = 0; i < 4; ++i) {
      const int d = i * 256 + lane * 4;
      const float4 w = *reinterpret_cast<const float4*>(lnw + d);
      const float4 sh = *reinterpret_cast<const float4*>(mod + d);
      const float4 sc = *reinterpret_cast<const float4*>(mod + 1024 + d);
      const float o0 = v[i].x * rr * w.x * (1.f + sc.x) + sh.x;
      const float o1 = v[i].y * rr * w.y * (1.f + sc.y) + sh.y;
      const float o2 = v[i].z * rr * w.z * (1.f + sc.z) + sh.z;
      const float o3 = v[i].w * rr * w.w * (1.f + sc.w) + sh.w;
      uint2 o; o.x = pack2(o0, o1); o.y = pack2(o2, o3);
      *reinterpret_cast<uint2*>(P.H + (size_t)r * 1024 + d) = o;
    }
  }
}

template <int BM, int BN, int BK, int WM, int WN>
struct Gemm {
  static constexpr int LDK = BK + 8;
  static constexpr int TM = BM / WM / 32, TN = BN / WN / 32;
  static constexpr int CPR = BK / 8;
  static constexpr int NA = BM * CPR / 256, NB = BN * CPR / 256;
  static constexpr int A_BYTES = BM * LDK * 2, B_BYTES = BN * LDK * 2;
  static constexpr int STAGE_BYTES = A_BYTES + B_BYTES;
  static constexpr int SMEM = 2 * STAGE_BYTES;

  static DEVI void run(const bf16* __restrict__ A, int lda, const bf16* __restrict__ BT, int ldb, int K,
                       unsigned char* smem, f32x16 (&acc)[TM][TN]) {
    const int tid = TIDX, lane = tid & 63, wave = tid >> 6;
    const int wm = wave / WN, wn = wave % WN;
    const int l31 = lane & 31, hh = lane >> 5;
#pragma unroll
    for (int i = 0; i < TM; ++i)
#pragma unroll
      for (int j = 0; j < TN; ++j) acc[i][j] = zero16();
    uint4 ra[NA], rb[NB];
    const int nk = K / BK;
    auto gload = [&](int kt) {
#pragma unroll
      for (int i = 0; i < NA; ++i) { const int ch = tid + i * 256, row = ch / CPR, cc = ch % CPR;
        ra[i] = *reinterpret_cast<const uint4*>(A + (size_t)row * lda + kt * BK + cc * 8); }
#pragma unroll
      for (int i = 0; i < NB; ++i) { const int ch = tid + i * 256, row = ch / CPR, cc = ch % CPR;
        rb[i] = *reinterpret_cast<const uint4*>(BT + (size_t)row * ldb + kt * BK + cc * 8); }
    };
    auto swrite = [&](int buf) {
      bf16* sA = reinterpret_cast<bf16*>(smem + buf * STAGE_BYTES);
      bf16* sB = reinterpret_cast<bf16*>(smem + buf * STAGE_BYTES + A_BYTES);
#pragma unroll
      for (int i = 0; i < NA; ++i) { const int ch = tid + i * 256, row = ch / CPR, cc = ch % CPR;
        *reinterpret_cast<uint4*>(sA + row * LDK + cc * 8) = ra[i]; }
#pragma unroll
      for (int i = 0; i < NB; ++i) { const int ch = tid + i * 256, row = ch / CPR, cc = ch % CPR;
        *reinterpret_cast<uint4*>(sB + row * LDK + cc * 8) = rb[i]; }
    };
    __syncthreads();
    gload(0);
    swrite(0);
    __syncthreads();
    for (int kt = 0; kt < nk; ++kt) {
      const int cur = kt & 1;
      if (kt + 1 < nk) gload(kt + 1);
      const bf16* sA = reinterpret_cast<const bf16*>(smem + cur * STAGE_BYTES);
      const bf16* sB = reinterpret_cast<const bf16*>(smem + cur * STAGE_BYTES + A_BYTES);
#pragma unroll
      for (int ks = 0; ks < BK / 16; ++ks) {
        bf16x8 af[TM], bfr[TN];
#pragma unroll
        for (int i = 0; i < TM; ++i) af[i] = ldfrag(sA + (wm * (BM / WM) + i * 32 + l31) * LDK + ks * 16 + hh * 8);
#pragma unroll
        for (int j = 0; j < TN; ++j) bfr[j] = ldfrag(sB + (wn * (BN / WN) + j * 32 + l31) * LDK + ks * 16 + hh * 8);
#pragma unroll
        for (int i = 0; i < TM; ++i)
#pragma unroll
          for (int j = 0; j < TN; ++j) acc[i][j] = mfma32(af[i], bfr[j], acc[i][j]);
      }
      if (kt + 1 < nk) swrite(cur ^ 1);
      __syncthreads();
    }
  }
};

DEVI void phase_gemm1(const Params& P, int l, unsigned char* smem) {
  using G = Gemm<128, 128, 64, 2, 2>;
  const int lane = TIDX & 63, wave = TIDX >> 6, wm = wave >> 1, wn = wave & 1, l31 = lane & 31, hh = lane >> 5;
  const bf16* W = P.WinT + (size_t)l * DINP * 1024;
  for (int t = VBID; t < 144 * 18; t += NVB) {
    const int mt = t / 18, nt = t % 18;
    f32x16 acc[2][2];
    G::run(P.H + (size_t)mt * 128 * 1024, 1024, W + (size_t)nt * 128 * 1024, 1024, 1024, smem, acc);
#pragma unroll
    for (int i = 0; i < 2; ++i)
#pragma unroll
      for (int j = 0; j < 2; ++j) {
        const int col = nt * 128 + wn * 64 + j * 32 + l31;
        if (col < DIN) {
#pragma unroll
          for (int r = 0; r < 16; ++r) {
            const int row = mt * 128 + wm * 64 + i * 32 + drow(r, hh);
            P.Z[(size_t)row * DIN + col] = f2bf(acc[i][j][r]);
          }
        }
      }
  }
}

DEVI void phase_gemm2(const Params& P, int l, unsigned char* smem) {
  using G = Gemm<128, 128, 64, 2, 2>;
  const int lane = TIDX & 63, wave = TIDX >> 6, wm = wave >> 1, wn = wave & 1, l31 = lane & 31, hh = lane >> 5;
  const bf16* W = P.WoutT + (size_t)l * 1024 * 1024;
  const int mtiles = (l == 1) ? 128 : 144;
  for (int t = VBID; t < mtiles * 8; t += NVB) {
    const int mt = t / 8, nt = t % 8;
    f32x16 acc[2][2];
    G::run(P.H + (size_t)mt * 128 * 1024, 1024, W + (size_t)nt * 128 * 1024, 1024, 1024, smem, acc);
    const int bi = batch_of_row(mt * 128);
    const float* gate = P.MOD + (size_t)(l * 9 + bi) * 6144 + 2048;
#pragma unroll
    for (int i = 0; i < 2; ++i)
#pragma unroll
      for (int j = 0; j < 2; ++j) {
        const int col = nt * 128 + wn * 64 + j * 32 + l31;
        const float g = gate[col];
#pragma unroll
        for (int r = 0; r < 16; ++r) {
          const int row = mt * 128 + wm * 64 + i * 32 + drow(r, hh);
          float res;
          if (l == 0) res = row < NL ? P.x[(size_t)row * 1024 + col] : P.ctx[(size_t)(row - NL) * 1024 + col];
          else res = bf2f(P.X[(size_t)row * 1024 + col]);
          P.X[(size_t)row * 1024 + col] = f2bf(res + g * acc[i][j][r]);
        }
      }
  }
}

DEVI void phase_mixA(const Params& P, int l, unsigned char* smem) {
  const int tid = TIDX, lane = tid & 63, wave = tid >> 6, l31 = lane & 31, hh = lane >> 5;
  bf16* VNT = reinterpret_cast<bf16*>(smem);
  constexpr int LDV = 136;
  const int nseg = (l == 1) ? 16 : 18;
  const int seg0 = (l == 1) ? 2 : 0;
  for (int it = VBID; it < 8 * nseg * 4; it += NVB) {
    const int a = it & 3; const int sj = (it >> 2) % nseg + seg0; const int b = (it >> 2) / nseg;
    const int p0 = sj * 128;
    hb_sync();
    {
      const int q = tid >> 1, half = tid & 1;
      const int row = row_of(b, p0 + q);
      const bf16* src = P.Z + (size_t)row * DIN + ZC_AV + a * 64 + half * 32;
      float v[32];
      float ss = 0.f;
#pragma unroll
      for (int i = 0; i < 4; ++i) {
        const uint4 u = *reinterpret_cast<const uint4*>(src + i * 8);
        v[i * 8 + 0] = lo2f(u.x); v[i * 8 + 1] = hi2f(u.x); v[i * 8 + 2] = lo2f(u.y); v[i * 8 + 3] = hi2f(u.y);
        v[i * 8 + 4] = lo2f(u.z); v[i * 8 + 5] = hi2f(u.z); v[i * 8 + 6] = lo2f(u.w); v[i * 8 + 7] = hi2f(u.w);
      }
#pragma unroll
      for (int i = 0; i < 32; ++i) ss += v[i] * v[i];
      ss += __shfl_xor(ss, 1);
      const float rr = rsqrtf(ss * (1.f / 64.f) + EPS);
      const float* nw = P.a_norm_w + l * 256 + a * 64 + half * 32;
#pragma unroll
      for (int i = 0; i < 32; ++i) VNT[(half * 32 + i) * LDV + q] = f2bf(v[i] * rr * nw[i]);
    }
    hb_sync();
    f32x16 acc[2]; acc[0] = zero16(); acc[1] = zero16();
    const bf16* Aw = P.AWS + (size_t)(l * 4 + a) * 128 * 128 + (size_t)(wave * 32 + l31) * 128;
#pragma unroll
    for (int ks = 0; ks < 8; ++ks) {
      const bf16x8 af = ldfrag(Aw + ks * 16 + hh * 8);
#pragma unroll
      for (int j = 0; j < 2; ++j) {
        const bf16x8 bfr = ldfrag(VNT + (j * 32 + l31) * LDV + ks * 16 + hh * 8);
        acc[j] = mfma32(af, bfr, acc[j]);
      }
    }
    const float* bs = P.a_b_s + (l * 4 + a) * 128;
#pragma unroll
    for (int j = 0; j < 2; ++j)
#pragma unroll
      for (int r = 0; r < 16; ++r) {
        const int p = wave * 32 + drow(r, hh);
        const int row = row_of(b, p0 + p);
        const int col = a * 64 + j * 32 + l31;
        const float u = bf2f(P.Z[(size_t)row * DIN + ZC_AU + col]);
        P.H[(size_t)row * 1024 + col] = f2bf(u * (acc[j][r] + bs[p]));
      }
  }
}

DEVI void mla_norm_rope_store(const Params& P, const float* T, const float* nw, bool rope, float oscale,
                              bf16* dstbase  , int pos0, int tlat0) {
  const int tid = TIDX, tok = tid >> 1, half = tid & 1;
  float v[48];
  float ss = 0.f;
#pragma unroll
  for (int i = 0; i < 48; ++i) { v[i] = T[tok * 97 + half * 48 + i]; ss += v[i] * v[i]; }
  ss += __shfl_xor(ss, 1);
  const float rr = rsqrtf(ss * (1.f / 96.f) + EPS);
#pragma unroll
  for (int i = 0; i < 48; ++i) v[i] = v[i] * rr * nw[half * 48 + i];
  if (rope && half == 1) {
    const float* cs = P.ROPE + (size_t)(tlat0 + tok) * 32;
#pragma unroll
    for (int a = 0; a < 2; ++a)
#pragma unroll
      for (int f = 0; f < 8; ++f) {
        const float x1 = v[16 + a * 16 + f], x2 = v[16 + a * 16 + 8 + f];
        const float c = cs[a * 8 + f], s = cs[16 + a * 8 + f];
        v[16 + a * 16 + f] = x1 * c - x2 * s;
        v[16 + a * 16 + 8 + f] = x2 * c + x1 * s;
      }
  }
  bf16* dst = dstbase + (size_t)(pos0 + tok) * 96 + half * 48;
#pragma unroll
  for (int i = 0; i < 6; ++i) {
    uint4 o;
    o.x = pack2(v[i * 8 + 0] * oscale, v[i * 8 + 1] * oscale); o.y = pack2(v[i * 8 + 2] * oscale, v[i * 8 + 3] * oscale);
    o.z = pack2(v[i * 8 + 4] * oscale, v[i * 8 + 5] * oscale); o.w = pack2(v[i * 8 + 6] * oscale, v[i * 8 + 7] * oscale);
    *reinterpret_cast<uint4*>(dst + i * 8) = o;
  }
}

DEVI void phase_mla_proj(const Params& P, int l, unsigned char* smem) {
  const int tid = TIDX;
  float* T = reinterpret_cast<float*>(smem);
  bf16* TV = reinterpret_cast<bf16*>(smem + 128 * 97 * 4);
  const float qscale = 0.10206207261596577f * 1.4426950408889634f;
  const int tok = tid >> 1, half = tid & 1;
  for (int it = (VBID + NVB - 64) % NVB; it < 144 * 8; it += NVB) {
    const int h = it & 7;
    const int m0 = (it >> 3) * 128;
    const bool lat = m0 < NL;
    const int b = lat ? (m0 >> 11) : ((m0 - NL) >> 8);
    const int pos0 = lat ? 256 + (m0 & 2047) : ((m0 - NL) & 255);
    const int tlat0 = lat ? (m0 & 2047) : 0;
    const bool doq = lat || (l == 0);
    const bf16* zr = P.Z + (size_t)(m0 + tok) * DIN;
    const bf16* rr = P.RAW + (size_t)(m0 + tok) * 1792;
    hb_sync();
    const float rsq = P.RS[(size_t)(m0 + tok) * 2], rskv = P.RS[(size_t)(m0 + tok) * 2 + 1];
    {
      const bf16* kn = rr + 768 + h * 128 + half * 32;
      const bf16* vv = rr + 768 + h * 128 + 64 + half * 32;
#pragma unroll
      for (int i = 0; i < 4; ++i) {
        const uint4 u = *reinterpret_cast<const uint4*>(kn + i * 8);
        float* tp = T + tok * 97 + half * 32 + i * 8;
        tp[0] = lo2f(u.x) * rskv; tp[1] = hi2f(u.x) * rskv; tp[2] = lo2f(u.y) * rskv; tp[3] = hi2f(u.y) * rskv;
        tp[4] = lo2f(u.z) * rskv; tp[5] = hi2f(u.z) * rskv; tp[6] = lo2f(u.w) * rskv; tp[7] = hi2f(u.w) * rskv;
        const uint4 w = *reinterpret_cast<const uint4*>(vv + i * 8);
        bf16* vp = TV + (half * 32 + i * 8) * 136 + tok;
        vp[0 * 136] = f2bf(lo2f(w.x) * rskv); vp[1 * 136] = f2bf(hi2f(w.x) * rskv); vp[2 * 136] = f2bf(lo2f(w.y) * rskv); vp[3 * 136] = f2bf(hi2f(w.y) * rskv);
        vp[4 * 136] = f2bf(lo2f(w.z) * rskv); vp[5 * 136] = f2bf(hi2f(w.z) * rskv); vp[6 * 136] = f2bf(lo2f(w.w) * rskv); vp[7 * 136] = f2bf(hi2f(w.w) * rskv);
      }
#pragma unroll
      for (int i = 0; i < 2; ++i) {
        const uint4 u = *reinterpret_cast<const uint4*>(zr + ZC_BKR + half * 16 + i * 8);
        float* tp = T + tok * 97 + 64 + half * 16 + i * 8;
        tp[0] = lo2f(u.x); tp[1] = hi2f(u.x); tp[2] = lo2f(u.y); tp[3] = hi2f(u.y);
        tp[4] = lo2f(u.z); tp[5] = hi2f(u.z); tp[6] = lo2f(u.w); tp[7] = hi2f(u.w);
      }
    }
    hb_sync();
    mla_norm_rope_store(P, T, P.b_kh_w + l * 96, lat, 1.f, P.K + (size_t)(b * 8 + h) * SEQP * 96, pos0, tlat0);
    {
      const int d = tid >> 2, qtr = tid & 3;
      bf16* dst = P.VT + ((size_t)(b * 8 + h) * 64 + d) * SEQP + pos0 + qtr * 32;
      const bf16* src = TV + d * 136 + qtr * 32;
#pragma unroll
      for (int i = 0; i < 4; ++i) {
        const uint4 v = *reinterpret_cast<const uint4*>(src + i * 8);
        const int g16 = (i >> 1) * 16, odd = i & 1;
        *reinterpret_cast<uint2*>(dst + g16 + (odd ? 4 : 0)) = make_uint2(v.x, v.y);
        *reinterpret_cast<uint2*>(dst + g16 + (odd ? 12 : 8)) = make_uint2(v.z, v.w);
      }
    }
    if (doq) {
      hb_sync();
      const bf16* qq = rr + h * 96 + half * 48;
#pragma unroll
      for (int i = 0; i < 6; ++i) {
        const uint4 u = *reinterpret_cast<const uint4*>(qq + i * 8);
        float* tp = T + tok * 97 + half * 48 + i * 8;
        tp[0] = lo2f(u.x) * rsq; tp[1] = hi2f(u.x) * rsq; tp[2] = lo2f(u.y) * rsq; tp[3] = hi2f(u.y) * rsq;
        tp[4] = lo2f(u.z) * rsq; tp[5] = hi2f(u.z) * rsq; tp[6] = lo2f(u.w) * rsq; tp[7] = hi2f(u.w) * rsq;
      }
      hb_sync();
      mla_norm_rope_store(P, T, P.b_qh_w + l * 96, lat, qscale, P.Q + (size_t)(b * 8 + h) * SEQP * 96, pos0, tlat0);
    }
  }
}

DEVI void hgrn_load(const Params& P, int l, int b, int hd, int c, float* BF, float* RB, float* SEG,
                    float (&q)[16], float (&kf)[16], float (&kb)[16], float (&v)[16], bool need_kv) {
  const int tid = TIDX, t = tid >> 2, k0 = (tid & 3) * 16;
  const int row = row_of(b, c * 64 + t);
  const bf16* z = P.Z + (size_t)row * DIN + hd * 64 + k0;
  float zf[16], zb[16];
#pragma unroll
  for (int i = 0; i < 2; ++i) {
    const uint4 uq = *reinterpret_cast<const uint4*>(z + ZC_CQ + i * 8);
    const uint4 uf = *reinterpret_cast<const uint4*>(z + ZC_CFF + i * 8);
    const uint4 ub = *reinterpret_cast<const uint4*>(z + ZC_CFB + i * 8);
    q[i * 8 + 0] = lo2f(uq.x); q[i * 8 + 1] = hi2f(uq.x); q[i * 8 + 2] = lo2f(uq.y); q[i * 8 + 3] = hi2f(uq.y);
    q[i * 8 + 4] = lo2f(uq.z); q[i * 8 + 5] = hi2f(uq.z); q[i * 8 + 6] = lo2f(uq.w); q[i * 8 + 7] = hi2f(uq.w);
    zf[i * 8 + 0] = lo2f(uf.x); zf[i * 8 + 1] = hi2f(uf.x); zf[i * 8 + 2] = lo2f(uf.y); zf[i * 8 + 3] = hi2f(uf.y);
    zf[i * 8 + 4] = lo2f(uf.z); zf[i * 8 + 5] = hi2f(uf.z); zf[i * 8 + 6] = lo2f(uf.w); zf[i * 8 + 7] = hi2f(uf.w);
    zb[i * 8 + 0] = lo2f(ub.x); zb[i * 8 + 1] = hi2f(ub.x); zb[i * 8 + 2] = lo2f(ub.y); zb[i * 8 + 3] = hi2f(ub.y);
    zb[i * 8 + 4] = lo2f(ub.z); zb[i * 8 + 5] = hi2f(ub.z); zb[i * 8 + 6] = lo2f(ub.w); zb[i * 8 + 7] = hi2f(ub.w);
    if (need_kv) {
      const uint4 uv = *reinterpret_cast<const uint4*>(z + ZC_CI + i * 8);
      v[i * 8 + 0] = lo2f(uv.x); v[i * 8 + 1] = hi2f(uv.x); v[i * 8 + 2] = lo2f(uv.y); v[i * 8 + 3] = hi2f(uv.y);
      v[i * 8 + 4] = lo2f(uv.z); v[i * 8 + 5] = hi2f(uv.z); v[i * 8 + 6] = lo2f(uv.w); v[i * 8 + 7] = hi2f(uv.w);
    }
  }
#pragma unroll
  for (int i = 0; i < 16; ++i) {
    q[i] *= 0.125f;
    float lbf = 0.f;
    if (l == 1) { const int ch = hd * 64 + k0 + i; lbf = sigmoidf_(P.c_lb[512 + ch] - P.c_lb[ch]); }
    const float zz = zf[i];
    const float e = __expf(-fabsf(zz));
    const float sp = __builtin_amdgcn_rcpf(1.f + e);
    const float sig = zz >= 0.f ? sp : e * sp;
    const float nsig = zz >= 0.f ? e * sp : sp;
    const float lf = (l == 0) ? (fminf(zz, 0.f) - __logf(1.f + e)) : __logf(lbf + (1.f - lbf) * sig);
    kf[i] = (1.f - lbf) * nsig;
    BF[t * 65 + k0 + i] = lf;
  }
  __builtin_amdgcn_sched_barrier(0);
#pragma unroll
  for (int i = 0; i < 16; ++i) {
    float lbb = 0.f;
    if (l == 1) { const int ch = hd * 64 + k0 + i; lbb = sigmoidf_(P.c_lb[512 + 256 + ch] - P.c_lb[256 + ch]); }
    const float zz = zb[i];
    const float e = __expf(-fabsf(zz));
    const float sp = __builtin_amdgcn_rcpf(1.f + e);
    const float sig = zz >= 0.f ? sp : e * sp;
    const float nsig = zz >= 0.f ? e * sp : sp;
    const float lf = (l == 0) ? (fminf(zz, 0.f) - __logf(1.f + e)) : __logf(lbb + (1.f - lbb) * sig);
    kb[i] = (1.f - lbb) * nsig;
    RB[t * 65 + k0 + i] = lf;
  }
  hb_sync();
  {
    const int k = tid & 63, seg = tid >> 6;
    float sf = 0.f, sr = 0.f;
#pragma unroll
    for (int j = 0; j < 16; ++j) { sf += BF[(seg * 16 + j) * 65 + k]; BF[(seg * 16 + j) * 65 + k] = sf; }
#pragma unroll
    for (int j = 15; j >= 0; --j) { sr += RB[(seg * 16 + j) * 65 + k]; RB[(seg * 16 + j) * 65 + k] = sr; }
    SEG[seg * 64 + k] = sf; SEG[256 + seg * 64 + k] = sr;
    hb_sync();
    float offf = 0.f, offb = 0.f;
#pragma unroll
    for (int s2 = 0; s2 < 4; ++s2) {
      offf += (s2 < seg) ? SEG[s2 * 64 + k] : 0.f;
      offb += (s2 > seg) ? SEG[256 + s2 * 64 + k] : 0.f;
    }
#pragma unroll
    for (int j = 0; j < 16; ++j) { BF[(seg * 16 + j) * 65 + k] += offf; RB[(seg * 16 + j) * 65 + k] += offb; }
  }
  hb_sync();
}

DEVI f32x16 lds_mm(const bf16* A, const bf16* BT, int tm, int tn, int l31, int hh) {
  f32x16 acc = zero16();
#pragma unroll
  for (int ks = 0; ks < 4; ++ks) {
    const bf16x8 a = ldfrag(A + (tm * 32 + l31) * 72 + ks * 16 + hh * 8);
    const bf16x8 b = ldfrag(BT + (tn * 32 + l31) * 72 + ks * 16 + hh * 8);
    acc = mfma32(a, b, acc);
  }
  return acc;
}

DEVI void phase_hgrn_local(const Params& P, int l, unsigned char* smem) {
  const int tid = TIDX, lane = tid & 63, wave = tid >> 6, l31 = lane & 31, hh = lane >> 5;
  const int tm = wave >> 1, tn = wave & 1;
  float* BF = reinterpret_cast<float*>(smem);
  float* RB = BF + 64 * 65;
  bf16* QF = reinterpret_cast<bf16*>(smem + 33280);
  bf16* KF = QF + 64 * 72;
  bf16* QB = KF + 64 * 72;
  bf16* KB = QB + 64 * 72;
  bf16* VTt = KB + 64 * 72;
  bf16* KHF = reinterpret_cast<bf16*>(smem);
  bf16* KHB = KHF + 64 * 72;
  bf16* ATT = KHB + 64 * 72;
  for (int it = (VBID + NVB - 192) % NVB; it < 8 * 4 * 36; it += NVB) {
    const int c = it % 36, hd = (it / 36) & 3, b = it / 144;
    float q[16], kf[16], kb[16], v[16];
    hb_sync();
    hgrn_load(P, l, b, hd, c, BF, RB, reinterpret_cast<float*>(smem + 33280), q, kf, kb, v, true);
    const int t = tid >> 2, k0 = (tid & 3) * 16;
#pragma unroll
    for (int i = 0; i < 16; ++i) VTt[(k0 + i) * 72 + t] = f2bf(v[i]);
    float bfv[16], rbv[16];
#pragma unroll
    for (int i = 0; i < 16; ++i) { bfv[i] = BF[t * 65 + k0 + i]; rbv[i] = RB[t * 65 + k0 + i]; }
    {
      const size_t go = (size_t)row_of(b, c * 64 + t) * 256 + hd * 64 + k0;
#pragma unroll
      for (int hq = 0; hq < 2; ++hq) {
        unsigned pf[4], pb[4];
#pragma unroll
        for (int i = 0; i < 8; i += 2) {
          pf[i >> 1] = pack2(q[hq * 8 + i] * __expf(bfv[hq * 8 + i]), q[hq * 8 + i + 1] * __expf(bfv[hq * 8 + i + 1]));
          pb[i >> 1] = pack2(q[hq * 8 + i] * __expf(rbv[hq * 8 + i]), q[hq * 8 + i + 1] * __expf(rbv[hq * 8 + i + 1]));
        }
        *reinterpret_cast<uint4*>(P.GQF + go + hq * 8) = make_uint4(pf[0], pf[1], pf[2], pf[3]);
        *reinterpret_cast<uint4*>(P.GQB + go + hq * 8) = make_uint4(pb[0], pb[1], pb[2], pb[3]);
      }
    }
    if (t == 0) {
      float* dec = P.DEC + ((size_t)((b * 4 + hd) * 2) * 36 + c) * 64 + k0;
#pragma unroll
      for (int i = 0; i < 16; ++i) { dec[i] = __expf(BF[63 * 65 + k0 + i]); dec[36 * 64 + i] = __expf(RB[k0 + i]); }
    }
#pragma unroll
    for (int i = 0; i < 16; i += 2) {
      const int k = k0 + i;
      const float mF0 = BF[32 * 65 + k], mF1 = BF[32 * 65 + k + 1], mB0 = RB[32 * 65 + k], mB1 = RB[32 * 65 + k + 1];
      *reinterpret_cast<unsigned*>(&QF[t * 72 + k]) = pack2(q[i] * __expf(fminf(bfv[i] - mF0, 80.f)), q[i + 1] * __expf(fminf(bfv[i + 1] - mF1, 80.f)));
      *reinterpret_cast<unsigned*>(&KF[t * 72 + k]) = pack2(kf[i] * __expf(fminf(mF0 - bfv[i], 80.f)), kf[i + 1] * __expf(fminf(mF1 - bfv[i + 1], 80.f)));
      *reinterpret_cast<unsigned*>(&QB[t * 72 + k]) = pack2(q[i] * __expf(fminf(rbv[i] - mB0, 80.f)), q[i + 1] * __expf(fminf(rbv[i + 1] - mB1, 80.f)));
      *reinterpret_cast<unsigned*>(&KB[t * 72 + k]) = pack2(kb[i] * __expf(fminf(mB0 - rbv[i], 80.f)), kb[i + 1] * __expf(fminf(mB1 - rbv[i + 1], 80.f)));
    }
#pragma unroll
    for (int i = 0; i < 16; ++i) {
      kf[i] = kf[i] * __expf(BF[63 * 65 + k0 + i] - bfv[i]);
      kb[i] = kb[i] * __expf(RB[k0 + i] - rbv[i]);
    }
    hb_sync();
#pragma unroll
    for (int i = 0; i < 16; ++i) {
      KHF[(k0 + i) * 72 + t] = f2bf(kf[i]);
      KHB[(k0 + i) * 72 + t] = f2bf(kb[i]);
    }
    hb_sync();
    {
      const f32x16 af = lds_mm(QF, KF, tm, tn, l31, hh);
      const f32x16 ab = lds_mm(QB, KB, tm, tn, l31, hh);
      const int s = tn * 32 + l31;
#pragma unroll
      for (int r = 0; r < 16; ++r) {
        const int tt = tm * 32 + drow(r, hh);
        float a = 0.f;
        if (s <= tt) a += af[r];
        if (s >= tt) a += ab[r];
        ATT[tt * 72 + s] = f2bf(a);
      }
    }
    {
      const f32x16 lf = lds_mm(VTt, KHF, tm, tn, l31, hh);
      const f32x16 lb = lds_mm(VTt, KHB, tm, tn, l31, hh);
      bf16* stf = P.ST + ((size_t)((b * 4 + hd) * 2 + 0) * 36 + c) * 4096;
      bf16* stb = P.ST + ((size_t)((b * 4 + hd) * 2 + 1) * 36 + c) * 4096;
#pragma unroll
      for (int r = 0; r < 16; ++r) {
        const int kk = tm * 32 + drow(r, hh), d = tn * 32 + l31;
        stf[kk * 64 + d] = f2bf(lf[r]);
        stb[kk * 64 + d] = f2bf(lb[r]);
      }
    }
    hb_sync();
    {
      const f32x16 o = lds_mm(ATT, VTt, tm, tn, l31, hh);
#pragma unroll
      for (int r = 0; r < 16; ++r) {
        const int tt = tm * 32 + drow(r, hh), d = tn * 32 + l31;
        P.OI[(size_t)row_of(b, c * 64 + tt) * 256 + hd * 64 + d] = f2bf(o[r]);
      }
    }
  }
}

DEVI void hgrn_scan_item(const Params& P, int item) {
  const int tid = TIDX;
  const int chain = item >> 2, sl = item & 3;
  const int dir = chain & 1;
  const int dd = tid >> 2, k4 = sl * 16 + (tid & 3) * 4;
  float4 S = make_float4(0.f, 0.f, 0.f, 0.f);
  bf16* base = P.ST + (size_t)chain * 36 * 4096 + dd * 64 + k4;
  const float* dec = P.DEC + (size_t)chain * 36 * 64 + k4;
#pragma unroll 1
  for (int g = 0; g < 6; ++g) {
    float4 L[6], dc[6];
#pragma unroll
    for (int j = 0; j < 6; ++j) {
      const int step = g * 6 + j;
      const int c = dir == 0 ? step : (step < 4 ? 3 - step : 39 - step);
      { const uint2 u = *reinterpret_cast<const uint2*>(base + (size_t)c * 4096); L[j] = make_float4(lo2f(u.x), hi2f(u.x), lo2f(u.y), hi2f(u.y)); }
      dc[j] = *reinterpret_cast<const float4*>(dec + c * 64);
    }
#pragma unroll
    for (int j = 0; j < 6; ++j) {
      const int step = g * 6 + j;
      const int c = dir == 0 ? step : (step < 4 ? 3 - step : 39 - step);
      *reinterpret_cast<uint2*>(base + (size_t)c * 4096) = make_uint2(pack2(S.x, S.y), pack2(S.z, S.w));
      S.x = dc[j].x * S.x + L[j].x; S.y = dc[j].y * S.y + L[j].y; S.z = dc[j].z * S.z + L[j].z; S.w = dc[j].w * S.w + L[j].w;
    }
  }
}

DEVI void phase_hgrn_final(const Params& P, int l, unsigned char* smem) {
  const int tid = TIDX, lane = tid & 63, wave = tid >> 6, l31 = lane & 31, hh = lane >> 5;
  const int tm = wave >> 1, tn = wave & 1;
  float* O = reinterpret_cast<float*>(smem);
  bf16* QF = reinterpret_cast<bf16*>(smem + 33280);
  bf16* QB = QF + 64 * 72;
  bf16* SF = QB + 64 * 72;
  bf16* SB = SF + 64 * 72;
  const int c0 = (l == 1) ? 4 : 0;
  const int nc = 36 - c0;
  for (int it = VBID; it < 8 * 4 * nc; it += NVB) {
    const int c = it % nc + c0, hd = (it / nc) & 3, b = it / (nc * 4);
    const int t = tid >> 2, k0 = (tid & 3) * 16;
    const int row = row_of(b, c * 64 + t);
    hb_sync();
    {
      const size_t go = (size_t)row * 256 + hd * 64 + k0;
      *reinterpret_cast<uint4*>(QF + t * 72 + k0) = *reinterpret_cast<const uint4*>(P.GQF + go);
      *reinterpret_cast<uint4*>(QF + t * 72 + k0 + 8) = *reinterpret_cast<const uint4*>(P.GQF + go + 8);
      *reinterpret_cast<uint4*>(QB + t * 72 + k0) = *reinterpret_cast<const uint4*>(P.GQB + go);
      *reinterpret_cast<uint4*>(QB + t * 72 + k0 + 8) = *reinterpret_cast<const uint4*>(P.GQB + go + 8);
      const bf16* stf = P.ST + ((size_t)((b * 4 + hd) * 2 + 0) * 36 + c) * 4096 + t * 64 + k0;
      const bf16* stb = P.ST + ((size_t)((b * 4 + hd) * 2 + 1) * 36 + c) * 4096 + t * 64 + k0;
      *reinterpret_cast<uint4*>(SF + t * 72 + k0) = *reinterpret_cast<const uint4*>(stf);
      *reinterpret_cast<uint4*>(SF + t * 72 + k0 + 8) = *reinterpret_cast<const uint4*>(stf + 8);
      *reinterpret_cast<uint4*>(SB + t * 72 + k0) = *reinterpret_cast<const uint4*>(stb);
      *reinterpret_cast<uint4*>(SB + t * 72 + k0 + 8) = *reinterpret_cast<const uint4*>(stb + 8);
    }
    hb_sync();
    {
      f32x16 o = lds_mm(QF, SF, tm, tn, l31, hh);
      const f32x16 o2 = lds_mm(QB, SB, tm, tn, l31, hh);
#pragma unroll
      for (int r = 0; r < 16; ++r) {
        const int tt = tm * 32 + drow(r, hh), d = tn * 32 + l31;
        O[tt * 65 + d] = o[r] + o2[r] + bf2f(P.OI[(size_t)row_of(b, c * 64 + tt) * 256 + hd * 64 + d]);
      }
    }
    hb_sync();
    {
      float ov[16]; float ss = 0.f;
#pragma unroll
      for (int i = 0; i < 16; ++i) { ov[i] = O[t * 65 + k0 + i]; ss += ov[i] * ov[i]; }
      ss += __shfl_xor(ss, 1); ss += __shfl_xor(ss, 2);
      const float rr = rsqrtf(ss * (1.f / 64.f) + EPS);
      const bf16* g = P.Z + (size_t)row * DIN + ZC_CG + hd * 64 + k0;
      const float* nw = P.c_out_norm_w + l * 64 + k0;
      const uint4 gA = *reinterpret_cast<const uint4*>(g), gB = *reinterpret_cast<const uint4*>(g + 8);
      const unsigned gw[8] = {gA.x, gA.y, gA.z, gA.w, gB.x, gB.y, gB.z, gB.w};
      unsigned pk[8];
#pragma unroll
      for (int i = 0; i < 16; i += 2) {
        const float g0 = lo2f(gw[i >> 1]), g1 = hi2f(gw[i >> 1]);
        const float y0 = ov[i] * rr * nw[i] * (g0 * sigmoidf_(g0));
        const float y1 = ov[i + 1] * rr * nw[i + 1] * (g1 * sigmoidf_(g1));
        pk[i >> 1] = pack2(y0, y1);
      }
      uint4* dst = reinterpret_cast<uint4*>(P.H + (size_t)row * 1024 + 768 + hd * 64 + k0);
      dst[0] = make_uint4(pk[0], pk[1], pk[2], pk[3]);
      dst[1] = make_uint4(pk[4], pk[5], pk[6], pk[7]);
    }
  }
}

DEVI void attn_item8(const Params& P, int b, int h, int qpos0, int nkeys, float sref, unsigned char* smem_base) {
  const int tid = threadIdx.x, lane = tid & 63, wave = tid >> 6, l31 = lane & 31, hh = lane >> 5;
  constexpr int TK = 128, LDKS = 104, LDVS = 136;
  constexpr int KS_BYTES = TK * LDKS * 2, VS_BYTES = 64 * LDVS * 2, ST_BYTES = KS_BYTES + VS_BYTES;
  const bf16* Qg = P.Q + ((size_t)(b * 8 + h) * SEQP + qpos0 + wave * 32 + l31) * 96;
  const bf16* Kg = P.K + (size_t)(b * 8 + h) * SEQP * 96;
  const bf16* Vg = P.VT + (size_t)(b * 8 + h) * 64 * SEQP;
  bf16x8 qf[6];
#pragma unroll
  for (int ks = 0; ks < 6; ++ks) qf[ks] = ldfrag(Qg + ks * 16 + hh * 8);
  f32x16 oacc[2]; oacc[0] = zero16(); oacc[1] = zero16();
  float lsum = 0.f;
  const int ntiles = nkeys / TK;
  unsigned koff[4], voff[3];
#pragma unroll
  for (int i = 0; i < 4; ++i) { const int q = (i * 8 + wave) * 64 + lane, row = q / 13, cc = q - row * 13; koff[i] = (unsigned)(row * 96 + (cc < 12 ? cc : 0) * 8) * 2u; }
#pragma unroll
  for (int i = 0; i < 3; ++i) { const int q = (i * 8 + wave) * 64 + lane, row = q / 17, cc = q - row * 17; voff[i] = (unsigned)((row < 64 ? row : 63) * SEQP + (cc < 16 ? cc : 0) * 8) * 2u; }
  LAS unsigned char* ldsb = (LAS unsigned char*)smem_base;
  auto dma_tile = [&](int kt, int buf) {
    const char* kb_ = (const char*)(Kg + (size_t)kt * TK * 96);
    const char* vb_ = (const char*)(Vg + (size_t)kt * TK);
#pragma unroll
    for (int i = 0; i < 4; ++i) {
      const int g = i * 8 + wave;
      if (g < 26) __builtin_amdgcn_global_load_lds((const unsigned*)(kb_ + koff[i]), (LAS unsigned*)(ldsb + buf * ST_BYTES + g * 1024), 16, 0, 0);
    }
#pragma unroll
    for (int i = 0; i < 3; ++i) {
      const int g = i * 8 + wave;
      if (g < 17) __builtin_amdgcn_global_load_lds((const unsigned*)(vb_ + voff[i]), (LAS unsigned*)(ldsb + buf * ST_BYTES + KS_BYTES + g * 1024), 16, 0, 0);
    }
  };
  __syncthreads();
  dma_tile(0, 0);
  asm volatile("s_waitcnt vmcnt(0)" ::: "memory");
  __syncthreads();
  for (int kt = 0; kt < ntiles; ++kt) {
    const int cur = kt & 1;
    if (kt + 1 < ntiles) dma_tile(kt + 1, cur ^ 1);
    const bf16* sK = reinterpret_cast<const bf16*>(smem_base + cur * ST_BYTES);
    const bf16* sV = reinterpret_cast<const bf16*>(smem_base + cur * ST_BYTES + KS_BYTES);
#pragma unroll
    for (int kk = 0; kk < 4; ++kk) {
      f32x16 sacc;
#pragma unroll
      for (int r = 0; r < 16; ++r) sacc[r] = -sref;
#pragma unroll
      for (int ks = 0; ks < 6; ++ks) {
        const bf16x8 a = ldfrag(sK + (kk * 32 + l31) * LDKS + ks * 16 + hh * 8);
        sacc = mfma32(a, qf[ks], sacc);
      }
#pragma unroll
      for (int r = 0; r < 16; ++r) { const float p = __builtin_amdgcn_exp2f(sacc[r]); sacc[r] = p; lsum += p; }
#pragma unroll
      for (int s = 0; s < 2; ++s) {
        bf16x8 pb;
#pragma unroll
        for (int j = 0; j < 8; ++j) pb[j] = (__bf16)sacc[8 * s + j];
#pragma unroll
        for (int dt = 0; dt < 2; ++dt) {
          const bf16x8 a = ldfrag(sV + (dt * 32 + l31) * LDVS + kk * 32 + s * 16 + hh * 8);
          oacc[dt] = mfma32(a, pb, oacc[dt]);
        }
      }
    }
    asm volatile("s_waitcnt vmcnt(0)" ::: "memory");
    __syncthreads();
  }
  lsum += __shfl_xor(lsum, 32);
  const float inv = 1.f / lsum;
  const int row = row_of(b, qpos0 + wave * 32 + l31);
  bf16* dst = P.H + (size_t)row * 1024 + 256 + h * 64;
#pragma unroll
  for (int dt = 0; dt < 2; ++dt)
#pragma unroll
    for (int rg = 0; rg < 4; ++rg) {
      const int d = dt * 32 + 8 * rg + 4 * hh;
      uint2 o;
      o.x = pack2(oacc[dt][4 * rg + 0] * inv, oacc[dt][4 * rg + 1] * inv);
      o.y = pack2(oacc[dt][4 * rg + 2] * inv, oacc[dt][4 * rg + 3] * inv);
      *reinterpret_cast<uint2*>(dst + d) = o;
    }
}

DEVI void phase_attn_scan(const Params& P, int l, unsigned char* smem_base, bool skip_scan = false) {
  if (!skip_scan)
    for (int it = NVB - 1 - VBID; it < 256; it += NVB) hgrn_scan_item(P, it);
  float sref;
  {
    const int lane = threadIdx.x & 63;
    float mq = fmaxf(fabsf(P.b_qh_w[l * 96 + lane]), lane < 32 ? fabsf(P.b_qh_w[l * 96 + 64 + lane]) : 0.f);
    float mk = fmaxf(fabsf(P.b_kh_w[l * 96 + lane]), lane < 32 ? fabsf(P.b_kh_w[l * 96 + 64 + lane]) : 0.f);
#pragma unroll
    for (int o = 32; o > 0; o >>= 1) { mq = fmaxf(mq, __shfl_xor(mq, o)); mk = fmaxf(mk, __shfl_xor(mk, o)); }
    sref = fminf(1.4426950408889634f * 9.797958971132712f * mq * mk, 60.f);
  }
  const int c = blockIdx.x, xcd = c & 7, slot = c >> 3;
  const int nrounds = (l == 0) ? 3 : 2;
  for (int r = 0; r < nrounds; ++r) {
    if (r < 2) {
      const int u = r * 32 + slot;
      const int bh = xcd * 8 + (u >> 3), qt = u & 7;
      if (slot < 32) attn_item8(P, bh >> 3, bh & 7, 256 + 256 * qt, 2304, sref, smem_base);
    } else if (c < 64) {
      attn_item8(P, c >> 3, c & 7, 0, 256, sref, smem_base);
    }
  }
}

DEVI unsigned ordkey(float s) { const unsigned u = __float_as_uint(s); return (u & 0x80000000u) ? ~u : (u | 0x80000000u); }
DEVI float keyval(unsigned k, unsigned mask) { const unsigned u = k & ~mask; return __uint_as_float((u & 0x80000000u) ? (u & 0x7fffffffu) : ~u); }
DEVI void ins16(unsigned (&lst)[16], unsigned v) {
#pragma unroll
  for (int j = 0; j < 16; ++j) { const unsigned hi = max(lst[j], v); v = min(lst[j], v); lst[j] = hi; }
}
DEVI void merge16(unsigned (&lst)[16], int xm) {
  unsigned o[16];
#pragma unroll
  for (int j = 0; j < 16; ++j) o[j] = (unsigned)__shfl_xor((int)lst[j], xm);
#pragma unroll
  for (int j = 0; j < 16; ++j) lst[j] = max(lst[j], o[15 - j]);
#pragma unroll
  for (int d = 8; d >= 1; d >>= 1)
#pragma unroll
    for (int j = 0; j < 16; ++j)
      if ((j & d) == 0) { const unsigned a = lst[j], bb = lst[j + d]; lst[j] = max(a, bb); lst[j + d] = min(a, bb); }
}

DEVI void bitonic_sort_desc16(unsigned (&v)[16]) {
#pragma unroll
  for (int k = 2; k <= 16; k <<= 1)
#pragma unroll
    for (int j = k >> 1; j > 0; j >>= 1)
#pragma unroll
      for (int i = 0; i < 16; ++i) {
        const int l = i ^ j;
        if (l > i) {
          const bool desc = ((i & k) == 0);
          const unsigned a = v[i], b = v[l];
          const unsigned mx = max(a, b), mn = min(a, b);
          v[i] = desc ? mx : mn; v[l] = desc ? mn : mx;
        }
      }
}
DEVI void bitonic_merge_desc16(unsigned (&lst)[16]) {
#pragma unroll
  for (int d = 8; d >= 1; d >>= 1)
#pragma unroll
    for (int j = 0; j < 16; ++j)
      if ((j & d) == 0) { const unsigned a = lst[j], bb = lst[j + d]; lst[j] = max(a, bb); lst[j + d] = min(a, bb); }
}
struct CandTab { int a[52]; int b[52]; };
constexpr CandTab make_cand_tab() {
  CandTab t{};
  int n = 0;
  for (int a = 0; a < 16; ++a)
    for (int b = 0; b < 16; ++b)
      if ((a + 1) * (b + 1) <= 16) { t.a[n] = a; t.b[n] = b; ++n; }
  for (; n < 52; ++n) { t.a[n] = 0; t.b[n] = 0; }
  return t;
}

DEVI void phase_route(const Params& P, int l, unsigned char* smem) {
  const int tid = TIDX;
  const int mtiles = (l == 1) ? 256 : 288;
  for (int it = VBID; it < mtiles * 8; it += NVB) {
    const int mt = it >> 3, h = it & 7;
    unsigned lst[2][16];
    const int row = tid >> 2, part = tid & 3;
#pragma unroll
    for (int p = 0; p < 2; ++p) {
      float sc[32];
      {
        const bf16* sp = P.QP + (size_t)(mt * 64 + row) * 2048 + (h * 2 + p) * 128 + part * 32;
#pragma unroll
        for (int i = 0; i < 4; ++i) {
          const uint4 u = *reinterpret_cast<const uint4*>(sp + i * 8);
          sc[i * 8 + 0] = lo2f(u.x); sc[i * 8 + 1] = hi2f(u.x); sc[i * 8 + 2] = lo2f(u.y); sc[i * 8 + 3] = hi2f(u.y);
          sc[i * 8 + 4] = lo2f(u.z); sc[i * 8 + 5] = hi2f(u.z); sc[i * 8 + 6] = lo2f(u.w); sc[i * 8 + 7] = hi2f(u.w);
        }
      }
      unsigned B2[16];
#pragma unroll
      for (int i = 0; i < 16; ++i) {
        const int i0 = part * 32 + i, i1 = part * 32 + 16 + i;
        lst[p][i] = (ordkey(sc[i]) & ~0x7fu) | (unsigned)(127 - i0);
        B2[i] = (ordkey(sc[16 + i]) & ~0x7fu) | (unsigned)(127 - i1);
      }
      bitonic_sort_desc16(lst[p]);
      bitonic_sort_desc16(B2);
#pragma unroll
      for (int j = 0; j < 16; ++j) lst[p][j] = max(lst[p][j], B2[15 - j]);
      bitonic_merge_desc16(lst[p]);
      merge16(lst[p], 1);
      merge16(lst[p], 2);
    }
    float v0[16], v1[16];
#pragma unroll
    for (int j = 0; j < 16; ++j) { v0[j] = keyval(lst[0][j], 0x7fu); v1[j] = keyval(lst[1][j], 0x7fu); }
    unsigned best[16];
    {
      constexpr CandTab CT = make_cand_tab();
#pragma unroll
      for (int c = 0; c < 13; ++c) {
        const int a0 = CT.a[4 * c + 0], a1 = CT.a[4 * c + 1], a2 = CT.a[4 * c + 2], a3 = CT.a[4 * c + 3];
        const int b0 = CT.b[4 * c + 0], b1 = CT.b[4 * c + 1], b2 = CT.b[4 * c + 2], b3 = CT.b[4 * c + 3];
        const float x = part == 0 ? v0[a0] : part == 1 ? v0[a1] : part == 2 ? v0[a2] : v0[a3];
        const float y = part == 0 ? v1[b0] : part == 1 ? v1[b1] : part == 2 ? v1[b2] : v1[b3];
        const int flat = part == 0 ? (a0 * 16 + b0) : part == 1 ? (a1 * 16 + b1) : part == 2 ? (a2 * 16 + b2) : (a3 * 16 + b3);
        const bool valid = part == 0 ? (4 * c + 0 < 50) : part == 1 ? (4 * c + 1 < 50) : part == 2 ? (4 * c + 2 < 50) : (4 * c + 3 < 50);
        const unsigned key = (ordkey(x + y) & ~0xffu) | (unsigned)(255 - flat);
        best[c] = valid ? key : 0u;
      }
      best[13] = 0u; best[14] = 0u; best[15] = 0u;
      bitonic_sort_desc16(best);
      merge16(best, 1);
      merge16(best, 2);
    }
    {
      const float mx = keyval(best[0], 0xffu);
      float es = 0.f;
      float ev[4]; int ex[4];
#pragma unroll
      for (int jj = 0; jj < 4; ++jj) {
        const unsigned kk = part == 0 ? best[4 * jj + 0] : part == 1 ? best[4 * jj + 1] : part == 2 ? best[4 * jj + 2] : best[4 * jj + 3];
        ev[jj] = __expf(keyval(kk, 0xffu) - mx);
        es += ev[jj];
        const int flat = 255 - (int)(kk & 0xffu);
        const int a = flat >> 4, bq = flat & 15;
        int i1 = 0, i2 = 0;
#pragma unroll
        for (int u = 0; u < 16; ++u) {
          i1 = (a == u) ? (127 - (int)(lst[0][u] & 0x7fu)) : i1;
          i2 = (bq == u) ? (127 - (int)(lst[1][u] & 0x7fu)) : i2;
        }
        ex[jj] = i1 * 128 + i2;
      }
      es += __shfl_xor(es, 1); es += __shfl_xor(es, 2);
      const float inv = 1.f / es;
      const int tok = mt * 64 + row;
      int* ed = P.EIDX + (size_t)tok * 128 + h * 16;
      float* gd = P.GATE + (size_t)tok * 128 + h * 16;
#pragma unroll
      for (int jj = 0; jj < 4; ++jj) { ed[4 * jj + part] = ex[jj]; gd[4 * jj + part] = ev[jj] * inv; }
    }
  }
}

DEVI float gelu_exact(float a) { return 0.5f * a * (1.f + erff(a * 0.70710678118654752f)); }

typedef float f2 __attribute__((ext_vector_type(2)));
DEVI void phase_peer_u(const Params& P, int l) {
  const int lane = TIDX & 63, half = lane >> 5, l32 = lane & 31;
  const int gw = VBID * 4 + (TIDX >> 6), nw = NVB * 4;
  const int nrows = (l == 1) ? NL : NT;
  const unsigned char* PU = P.PU8 + (size_t)l * 16384 * 576;
  const bool b4 = lane & 16, b3 = lane & 8, b2 = lane & 4;
  for (int t = gw; t < nrows; t += nw) {
    f2 h2[16];
    {
      const bf16* hp = P.H + (size_t)t * 1024 + l32 * 32;
#pragma unroll
      for (int i = 0; i < 4; ++i) {
        const uint4 hv = *reinterpret_cast<const uint4*>(hp + i * 8);
        h2[4 * i + 0] = (f2){lo2f(hv.x), hi2f(hv.x)}; h2[4 * i + 1] = (f2){lo2f(hv.y), hi2f(hv.y)};
        h2[4 * i + 2] = (f2){lo2f(hv.z), hi2f(hv.z)}; h2[4 * i + 3] = (f2){lo2f(hv.w), hi2f(hv.w)};
      }
    }
    const int e0 = P.EIDX[(size_t)t * 128 + lane], e1 = P.EIDX[(size_t)t * 128 + 64 + lane];
    const float g0 = P.GATE[(size_t)t * 128 + lane], g1 = P.GATE[(size_t)t * 128 + 64 + lane];
    float* wrow = P.WPE + (size_t)t * 128;
    const bool b1 = lane & 2;
    for (int kb = 0; kb < 4; ++kb) {
      const int esrc = kb < 2 ? e0 : e1;
      uint4 ud[16];
      unsigned short us[16];
#pragma unroll
      for (int i = 0; i < 16; ++i) {
        const int e = __shfl(esrc, (kb * 32 + 2 * i + half) & 63);
        const unsigned char* ur = PU + (size_t)e * 576;
        ud[i] = *reinterpret_cast<const uint4*>(ur + l32 * 16);
        us[i] = *reinterpret_cast<const unsigned short*>(ur + 512 + l32 * 2);
      }
      float d[16];
#pragma unroll
      for (int i = 0; i < 16; ++i) {
        const unsigned uw[4] = {ud[i].x, ud[i].y, ud[i].z, ud[i].w};
        f2 sacc = (f2){0.f, 0.f};
#pragma unroll
        for (int c = 0; c < 4; ++c) {
          sacc = __builtin_elementwise_fma(__builtin_amdgcn_cvt_scalef32_pk_f32_fp4(uw[c], 1.0f, 0), h2[4 * c + 0], sacc);
          sacc = __builtin_elementwise_fma(__builtin_amdgcn_cvt_scalef32_pk_f32_fp4(uw[c], 1.0f, 1), h2[4 * c + 1], sacc);
          sacc = __builtin_elementwise_fma(__builtin_amdgcn_cvt_scalef32_pk_f32_fp4(uw[c], 1.0f, 2), h2[4 * c + 2], sacc);
          sacc = __builtin_elementwise_fma(__builtin_amdgcn_cvt_scalef32_pk_f32_fp4(uw[c], 1.0f, 3), h2[4 * c + 3], sacc);
        }
        d[i] = (sacc.x + sacc.y) * __uint_as_float((unsigned)us[i] << 16);
      }
      float r8[8], r4[4], r2[2], r1;
#pragma unroll
      for (int i = 0; i < 8; ++i) { const float mine = b4 ? d[8 + i] : d[i]; const float send = b4 ? d[i] : d[8 + i]; r8[i] = mine + __shfl_xor(send, 16); }
#pragma unroll
      for (int i = 0; i < 4; ++i) { const float mine = b3 ? r8[4 + i] : r8[i]; const float send = b3 ? r8[i] : r8[4 + i]; r4[i] = mine + __shfl_xor(send, 8); }
#pragma unroll
      for (int i = 0; i < 2; ++i) { const float mine = b2 ? r4[2 + i] : r4[i]; const float send = b2 ? r4[i] : r4[2 + i]; r2[i] = mine + __shfl_xor(send, 4); }
      { const float mine = b1 ? r2[1] : r2[0]; const float send = b1 ? r2[0] : r2[1]; r1 = mine + __shfl_xor(send, 2); }
      r1 += __shfl_xor(r1, 1);
      const int k = kb * 32 + 2 * ((lane >> 1) & 15) + half;
      const float gt = __shfl(kb < 2 ? g0 : g1, k & 63);
      if ((lane & 1) == 0) wrow[k] = gt * gelu_exact(r1);
    }
  }
}

DEVI void phase_peer(const Params& P, int l) {
  const int lane = TIDX & 63, half = lane >> 5, l32 = lane & 31;
  const int gw = VBID * 4 + (TIDX >> 6), nw = NVB * 4;
  const int nrows = (l == 1) ? NL : NT;
  const unsigned char* PV = P.PV8 + (size_t)l * 16384 * 576;
  for (int t = gw; t < nrows; t += nw) {
    const int e0 = P.EIDX[(size_t)t * 128 + lane], e1 = P.EIDX[(size_t)t * 128 + 64 + lane];
    const float w0 = P.WPE[(size_t)t * 128 + lane], w1 = P.WPE[(size_t)t * 128 + 64 + lane];
    f2 y2[16];
#pragma unroll
    for (int i = 0; i < 16; ++i) y2[i] = (f2){0.f, 0.f};
    for (int kb = 0; kb < 4; ++kb) {
      const int esrc = kb < 2 ? e0 : e1;
      const float wsrc = kb < 2 ? w0 : w1;
      uint4 vd[16];
      unsigned short vs[16];
      float wv[16];
#pragma unroll
      for (int i = 0; i < 16; ++i) {
        const int ks = (kb * 32 + 2 * i + half) & 63;
        const int e = __shfl(esrc, ks);
        wv[i] = __shfl(wsrc, ks);
        const unsigned char* vr = PV + (size_t)e * 576;
        vd[i] = *reinterpret_cast<const uint4*>(vr + l32 * 16);
        vs[i] = *reinterpret_cast<const unsigned short*>(vr + 512 + l32 * 2);
      }
#pragma unroll
      for (int i = 0; i < 16; ++i) {
        const float wi = wv[i] * __uint_as_float((unsigned)vs[i] << 16);
        const f2 ww = (f2){wi, wi};
        const unsigned vw[4] = {vd[i].x, vd[i].y, vd[i].z, vd[i].w};
#pragma unroll
        for (int c = 0; c < 4; ++c) {
          y2[4 * c + 0] = __builtin_elementwise_fma(ww, __builtin_amdgcn_cvt_scalef32_pk_f32_fp4(vw[c], 1.0f, 0), y2[4 * c + 0]);
          y2[4 * c + 1] = __builtin_elementwise_fma(ww, __builtin_amdgcn_cvt_scalef32_pk_f32_fp4(vw[c], 1.0f, 1), y2[4 * c + 1]);
          y2[4 * c + 2] = __builtin_elementwise_fma(ww, __builtin_amdgcn_cvt_scalef32_pk_f32_fp4(vw[c], 1.0f, 2), y2[4 * c + 2]);
          y2[4 * c + 3] = __builtin_elementwise_fma(ww, __builtin_amdgcn_cvt_scalef32_pk_f32_fp4(vw[c], 1.0f, 3), y2[4 * c + 3]);
        }
      }
    }
    float y[16];
#pragma unroll
    for (int j = 0; j < 8; ++j) {
      const float ax = y2[j].x + __shfl_xor(y2[j].x, 32), ay = y2[j].y + __shfl_xor(y2[j].y, 32);
      const float bx = y2[8 + j].x + __shfl_xor(y2[8 + j].x, 32), by = y2[8 + j].y + __shfl_xor(y2[8 + j].y, 32);
      y[2 * j] = half ? bx : ax; y[2 * j + 1] = half ? by : ay;
    }
    const int bi = batch_of_row(t);
    const float* gate2 = P.MOD + (size_t)(l * 9 + bi) * 6144 + 5 * 1024;
    const int d0 = l32 * 32 + half * 16;
    float xn[16];
    float ss = 0.f;
#pragma unroll
    for (int q4 = 0; q4 < 4; ++q4) {
      const int d = d0 + q4 * 4;
      const uint2 xu = *reinterpret_cast<const uint2*>(P.X + (size_t)t * 1024 + d);
      const float4 xo = make_float4(lo2f(xu.x), hi2f(xu.x), lo2f(xu.y), hi2f(xu.y));
      const float4 gg = *reinterpret_cast<const float4*>(gate2 + d);
      float4 o;
      o.x = xo.x + gg.x * y[q4 * 4 + 0]; o.y = xo.y + gg.y * y[q4 * 4 + 1];
      o.z = xo.z + gg.z * y[q4 * 4 + 2]; o.w = xo.w + gg.w * y[q4 * 4 + 3];
      xn[q4 * 4 + 0] = o.x; xn[q4 * 4 + 1] = o.y; xn[q4 * 4 + 2] = o.z; xn[q4 * 4 + 3] = o.w;
      ss += o.x * o.x + o.y * o.y + o.z * o.z + o.w * o.w;
      if (l == 1) *reinterpret_cast<float4*>(P.out + (size_t)t * 1024 + d) = o;
      else *reinterpret_cast<uint2*>(P.X + (size_t)t * 1024 + d) = make_uint2(pack2(o.x, o.y), pack2(o.z, o.w));
    }
    if (l == 0) {
      ss = wave_sum(ss);
      const float rr = rsqrtf(ss * (1.f / 1024.f) + EPS);
      const float* lnw = P.ln1_w + 1024;
      const float* mod = P.MOD + (size_t)(9 + bi) * 6144;
      unsigned pk[8];
#pragma unroll
      for (int i = 0; i < 16; i += 2) {
        const float o0 = xn[i] * rr * lnw[d0 + i] * (1.f + mod[1024 + d0 + i]) + mod[d0 + i];
        const float o1 = xn[i + 1] * rr * lnw[d0 + i + 1] * (1.f + mod[1024 + d0 + i + 1]) + mod[d0 + i + 1];
        pk[i >> 1] = pack2(o0, o1);
      }
      *reinterpret_cast<uint4*>(P.H + (size_t)t * 1024 + d0) = make_uint4(pk[0], pk[1], pk[2], pk[3]);
      *reinterpret_cast<uint4*>(P.H + (size_t)t * 1024 + d0 + 8) = make_uint4(pk[4], pk[5], pk[6], pk[7]);
    }
  }
}

using f32x4 = __attribute__((ext_vector_type(4))) float;
namespace g8 {
constexpr int BM = 256, BK = 64, HALF = 128, HT = HALF * BK;
DEVI int lds_byte(int r, int c) { const int st = (r >> 4) * 2 + (c >> 5), rr = r & 15, cc = c & 31, ob = rr * 64 + cc * 2; return st * 1024 + (ob ^ (((ob >> 9) & 1) << 5)); }
DEVI void stage_rc(int b, int& R, int& C) { const int st = b / 1024, sb = b % 1024, swz = sb ^ (((sb >> 9) & 1) << 5); R = (st >> 1) * 16 + swz / 64; C = (st & 1) * 32 + (swz % 64) / 2; }
DEVI int perm32(int rho) { const int n = rho >> 4, i = rho & 15; return 8 * (i >> 2) + 4 * n + (i & 3); }
DEVI void unit_of(int L, int nM, int nN, int& pm, int& pn) {
  const int nwg = nM * nN;
  int wgid = L;
  { const int q = nwg / 8, r = nwg % 8, xcd = wgid % 8, off = wgid / 8; wgid = (xcd < r ? xcd * (q + 1) : r * (q + 1) + (xcd - r) * q) + off; }
  const int nig = 8 * nN, gid = wgid / nig, fm = gid * 8, gsz = (nM - fm) < 8 ? (nM - fm) : 8;
  pm = fm + ((wgid % nig) % gsz); pn = (wgid % nig) / gsz;
}
}

struct G8Unit { int pm, pn; };
template <class Epi>
DEVI void gemm8_phase(LAS unsigned char* lds, const bf16* __restrict__ Ag, const bf16* __restrict__ Btg, const int K, const int nM, const int nN, const Epi& E,
                      const int lda = 0, const int pn_split = 1 << 30, const int acol0 = 0, const int acol1 = 0,
                      const int ldb = 0, const int pn_mod = 1 << 30, const int ksplit_cols = 0) {
  constexpr int BK = 64, HALF = 128, HTB = HALF * BK * 2;
  const int tid = threadIdx.x, wid = __builtin_amdgcn_readfirstlane(tid >> 6), lane = tid & 63, wr = wid >> 2, wc = wid & 3, fr = lane & 15, fq = lane >> 4;
  const int nt = K / BK;
  const int nunits = nM * nN, G = gridDim.x, c = blockIdx.x;
  const int LDA = lda ? lda : K, LDB = ldb ? ldb : K;
  unsigned voffA[2], voffB[2];
#pragma unroll
  for (int i = 0; i < 2; ++i) { int R, C; g8::stage_rc(tid * 16 + i * 8192, R, C); const int Rb = (R & ~31) + g8::perm32(R & 31); voffA[i] = (unsigned)(R * LDA + C) * 2u; voffB[i] = (unsigned)(Rb * LDB + C) * 2u; }
  const size_t kstep = (size_t)(BK * 2);
  const size_t hstepA = (size_t)HALF * LDA * 2, hstep = (size_t)HALF * LDB * 2;
  const size_t tstepA = 2 * hstepA, tstep = 2 * hstep;
  const unsigned ldsw = (unsigned)wid * 1024u;
  const int aoff = g8::lds_byte(wr * 64 + fr, fq * 8), boff = g8::lds_byte(wc * 32 + fr, fq * 8);
#define PG8_SA(b, h) (((b) * 2 + (h)) * HTB)
#define PG8_SB(b, h) ((4 + (b) * 2 + (h)) * HTB)
#define PG8_STAGE(bufoff, gbase, voff) do { _Pragma("unroll") for (int _i = 0; _i < 2; ++_i) \
        __builtin_amdgcn_global_load_lds((const unsigned*)((const char*)(gbase) + (voff)[_i]), (LAS unsigned*)(lds + (bufoff) + ldsw + _i * 8192), 16, 0, 0); } while (0)
#define PG8_LDA(dst, b, h) do { _Pragma("unroll") for (int m = 0; m < 4; ++m) _Pragma("unroll") for (int k = 0; k < 2; ++k) dst[m][k] = *(const LAS bf16x8*)(lds + PG8_SA(b, h) + aoff + m * 2048 + k * 1024); } while (0)
#define PG8_LDB(dst, b, h) do { _Pragma("unroll") for (int n = 0; n < 2; ++n) _Pragma("unroll") for (int k = 0; k < 2; ++k) dst[n][k] = *(const LAS bf16x8*)(lds + PG8_SB(b, h) + boff + n * 2048 + k * 1024); } while (0)
#define PG8_MMA(ai, bj, At_, Bt_) do { __builtin_amdgcn_s_setprio(1); _Pragma("unroll") for (int m = 0; m < 4; ++m) _Pragma("unroll") for (int n = 0; n < 2; ++n) _Pragma("unroll") for (int k = 0; k < 2; ++k) \
        acc[ai][bj][m][n] = __builtin_amdgcn_mfma_f32_16x16x32_bf16(Bt_[n][k], At_[m][k], acc[ai][bj][m][n], 0, 0, 0); __builtin_amdgcn_s_setprio(0); } while (0)
#define PG8_WAIT_V(n) asm volatile("s_waitcnt vmcnt(" #n ")" ::: "memory")
#define PG8_WAIT_L(n) asm volatile("s_waitcnt lgkmcnt(" #n ")" ::: "memory")
#define PG8_BAR __builtin_amdgcn_s_barrier()
#define PG8_SCHED __builtin_amdgcn_sched_barrier(0)
  G8Unit cur, nxt; int ui = 0;
  if (c >= nunits) return;
  g8::unit_of(c, nM, nN, cur.pm, cur.pn);
  f32x4 acc[2][2][4][2];
#pragma unroll
  for (int a = 0; a < 2; ++a)
#pragma unroll
    for (int b = 0; b < 2; ++b)
#pragma unroll
      for (int m = 0; m < 4; ++m)
#pragma unroll
        for (int n = 0; n < 2; ++n) acc[a][b][m][n] = (f32x4){0.f, 0.f, 0.f, 0.f};
  bf16x8 At[4][2], B0[2][2], B1[2][2];
  const char* cA = (const char*)Ag + (size_t)cur.pm * tstepA + (size_t)((cur.pn < pn_split ? acol0 : acol1) + (cur.pn / pn_mod) * ksplit_cols) * 2;
  const char* cB = (const char*)Btg + (size_t)(cur.pn % pn_mod) * tstep + (size_t)((cur.pn / pn_mod) * ksplit_cols) * 2;
  PG8_STAGE(PG8_SB(0, 0), cB, voffB); PG8_STAGE(PG8_SA(0, 0), cA, voffA); PG8_STAGE(PG8_SB(0, 1), cB + hstep, voffB); PG8_STAGE(PG8_SA(0, 1), cA + hstepA, voffA);
  if (wr == 1) PG8_BAR;
  PG8_WAIT_V(4); PG8_BAR;
  PG8_STAGE(PG8_SB(1, 0), cB + kstep, voffB); PG8_STAGE(PG8_SA(1, 0), cA + kstep, voffA); PG8_STAGE(PG8_SB(1, 1), cB + hstep + kstep, voffB);
  PG8_WAIT_V(6); PG8_BAR;
  for (;;) {
    const long Ln = (long)(ui + 1) * G + c;
    const bool has_next = Ln < nunits;
    if (has_next) g8::unit_of((int)Ln, nM, nN, nxt.pm, nxt.pn);
    const char* nA = has_next ? (const char*)Ag + (size_t)nxt.pm * tstepA + (size_t)((nxt.pn < pn_split ? acol0 : acol1) + (nxt.pn / pn_mod) * ksplit_cols) * 2 : cA;
    const char* nB = has_next ? (const char*)Btg + (size_t)(nxt.pn % pn_mod) * tstep + (size_t)((nxt.pn / pn_mod) * ksplit_cols) * 2 : cB;
    for (int t = 0; t < nt; t += 2) {
      const bool last = (t == nt - 2);
      const char* a1 = cA + (size_t)(t + 1) * kstep;
      const char* a2 = last ? nA : cA + (size_t)(t + 2) * kstep; const char* b2 = last ? nB : cB + (size_t)(t + 2) * kstep;
      const char* a3 = a2 + kstep; const char* b3 = b2 + kstep;
      PG8_LDB(B0, 0, 0); PG8_SCHED; PG8_LDA(At, 0, 0); PG8_STAGE(PG8_SA(1, 1), a1 + hstepA, voffA);
      PG8_WAIT_L(8); PG8_BAR; PG8_WAIT_L(0); PG8_MMA(0, 0, At, B0); PG8_BAR; PG8_SCHED;
      PG8_LDB(B1, 0, 1); PG8_STAGE(PG8_SB(0, 0), b2, voffB);
      PG8_BAR; PG8_WAIT_L(0); PG8_MMA(0, 1, At, B1); PG8_BAR;
      PG8_LDA(At, 0, 1); PG8_STAGE(PG8_SA(0, 0), a2, voffA);
      PG8_BAR; PG8_WAIT_L(0); PG8_MMA(1, 0, At, B0); PG8_BAR; PG8_SCHED;
      PG8_STAGE(PG8_SB(0, 1), b2 + hstep, voffB);
      PG8_WAIT_V(6); PG8_BAR; PG8_MMA(1, 1, At, B1); PG8_BAR;
      PG8_LDB(B0, 1, 0); PG8_SCHED; PG8_LDA(At, 1, 0); PG8_STAGE(PG8_SA(0, 1), a2 + hstepA, voffA);
      PG8_WAIT_L(8); PG8_BAR; PG8_WAIT_L(0); PG8_MMA(0, 0, At, B0); PG8_BAR; PG8_SCHED;
      PG8_LDB(B1, 1, 1); PG8_STAGE(PG8_SB(1, 0), b3, voffB);
      PG8_BAR; PG8_WAIT_L(0); PG8_MMA(0, 1, At, B1); PG8_BAR;
      PG8_LDA(At, 1, 1); PG8_STAGE(PG8_SA(1, 0), a3, voffA);
      PG8_BAR; PG8_WAIT_L(0); PG8_MMA(1, 0, At, B0); PG8_BAR; PG8_SCHED;
      PG8_STAGE(PG8_SB(1, 1), b3 + hstep, voffB);
      PG8_WAIT_V(6); PG8_BAR; PG8_MMA(1, 1, At, B1); PG8_BAR;
    }
    E(acc, cur, wr, wc, fr, fq);
    if (!has_next) break;
#pragma unroll
    for (int a = 0; a < 2; ++a)
#pragma unroll
      for (int b = 0; b < 2; ++b)
#pragma unroll
        for (int m = 0; m < 4; ++m)
#pragma unroll
          for (int n = 0; n < 2; ++n) acc[a][b][m][n] = (f32x4){0.f, 0.f, 0.f, 0.f};
    cur = nxt; cA = nA; cB = nB; ++ui;
  }
  PG8_WAIT_V(0);
  if (wr == 0) PG8_BAR;
  PG8_BAR;
#undef PG8_SA
#undef PG8_SB
#undef PG8_STAGE
#undef PG8_LDA
#undef PG8_LDB
#undef PG8_MMA
}

struct EpiZ {
  bf16* Z;
  DEVI void operator()(const f32x4 (&acc)[2][2][4][2], const G8Unit& u, int wr, int wc, int fr, int fq) const {
    const int brow = u.pm * 256, bcol = u.pn * 256;
#pragma unroll
    for (int ai = 0; ai < 2; ++ai)
#pragma unroll
      for (int m = 0; m < 4; ++m) {
        const int row = brow + ai * 128 + wr * 64 + m * 16 + fr;
#pragma unroll
        for (int bj = 0; bj < 2; ++bj) {
          const int col = bcol + bj * 128 + wc * 32 + 8 * fq;
          if (col < DIN) {
            const f32x4 v0 = acc[ai][bj][m][0], v1 = acc[ai][bj][m][1];
            *reinterpret_cast<uint4*>(Z + (size_t)row * DIN + col) = make_uint4(pack2(v0[0], v0[1]), pack2(v0[2], v0[3]), pack2(v1[0], v1[1]), pack2(v1[2], v1[3]));
          }
        }
      }
  }
};
DEVI void phase_gemm1_8(const Params& P, int l, unsigned char* smem_base) {
  EpiZ E{P.Z};
  gemm8_phase((LAS unsigned char*)smem_base, P.H, P.WinT + (size_t)l * DINP * 1024, 1024, NT / 256, DINP / 256, E);
  const int c = blockIdx.x;
  if (c >= 136) {
    const int j = c - 136;
    if (l == 0) convert_rows_fp6(P, 0, j * 100, j * 100 + 100);
    else { const int b0 = 19200 + j * 114; convert_rows_fp6(P, 1, b0 < 32768 ? b0 : 32768, b0 + 114 < 32768 ? b0 + 114 : 32768); }
  }
}

struct EpiRAW {
  bf16* R;
  DEVI void operator()(const f32x4 (&acc)[2][2][4][2], const G8Unit& u, int wr, int wc, int fr, int fq) const {
    const int brow = u.pm * 256, bcol = u.pn * 256;
#pragma unroll
    for (int ai = 0; ai < 2; ++ai)
#pragma unroll
      for (int m = 0; m < 4; ++m) {
        const int row = brow + ai * 128 + wr * 64 + m * 16 + fr;
#pragma unroll
        for (int bj = 0; bj < 2; ++bj) {
          const int col = bcol + bj * 128 + wc * 32 + 8 * fq;
          const f32x4 v0 = acc[ai][bj][m][0], v1 = acc[ai][bj][m][1];
          *reinterpret_cast<uint4*>(R + (size_t)row * 1792 + col) = make_uint4(pack2(v0[0], v0[1]), pack2(v0[2], v0[3]), pack2(v1[0], v1[1]), pack2(v1[2], v1[3]));
        }
      }
  }
};
DEVI void phase_mla_raw(const Params& P, int l, unsigned char* smem_base) {
  {
    const int lane = threadIdx.x & 63;
    for (int t = blockIdx.x * 8 + (threadIdx.x >> 6); t < NT; t += gridDim.x * 8) {
      const bf16* zr = P.Z + (size_t)t * DIN;
      const uint2 uq = *reinterpret_cast<const uint2*>(zr + ZC_BQ + lane * 4);
      const unsigned uk = *reinterpret_cast<const unsigned*>(zr + ZC_BKV + lane * 2);
      float sq = lo2f(uq.x) * lo2f(uq.x) + hi2f(uq.x) * hi2f(uq.x) + lo2f(uq.y) * lo2f(uq.y) + hi2f(uq.y) * hi2f(uq.y);
      float sk = lo2f(uk) * lo2f(uk) + hi2f(uk) * hi2f(uk);
      sq = wave_sum(sq); sk = wave_sum(sk);
      if (lane == 0) { P.RS[(size_t)t * 2] = rsqrtf(sq * (1.f / 256.f) + EPS); P.RS[(size_t)t * 2 + 1] = rsqrtf(sk * (1.f / 128.f) + EPS); }
    }
  }
  EpiRAW E{P.RAW};
  gemm8_phase((LAS unsigned char*)smem_base, P.Z, P.WCOMB + (size_t)l * 1792 * 256, 256, NT / 256, 7, E, DIN, 3, ZC_BQ, ZC_BKV);
}

struct EpiX {
  const float* x; const float* ctx; bf16* X; const float* MODl; int l;
  DEVI void operator()(const f32x4 (&acc)[2][2][4][2], const G8Unit& u, int wr, int wc, int fr, int fq) const {
    const int brow = u.pm * 256, bcol = u.pn * 256;
    const float* gate = MODl + (size_t)batch_of_row(brow) * 6144 + 2048;
#pragma unroll
    for (int ai = 0; ai < 2; ++ai)
#pragma unroll
      for (int m = 0; m < 4; ++m) {
        const int row = brow + ai * 128 + wr * 64 + m * 16 + fr;
        const float* res = row < NL ? x + (size_t)row * 1024 : ctx + (size_t)(row - NL) * 1024;
#pragma unroll
        for (int bj = 0; bj < 2; ++bj) {
          const int col = bcol + bj * 128 + wc * 32 + 8 * fq;
          const f32x4 v0 = acc[ai][bj][m][0], v1 = acc[ai][bj][m][1];
          float4 ra, rb;
          if (l == 0) { ra = *reinterpret_cast<const float4*>(res + col); rb = *reinterpret_cast<const float4*>(res + col + 4); }
          else {
            const uint4 uu = *reinterpret_cast<const uint4*>(X + (size_t)row * 1024 + col);
            ra = make_float4(lo2f(uu.x), hi2f(uu.x), lo2f(uu.y), hi2f(uu.y)); rb = make_float4(lo2f(uu.z), hi2f(uu.z), lo2f(uu.w), hi2f(uu.w));
          }
          const float4 ga = *reinterpret_cast<const float4*>(gate + col), gb = *reinterpret_cast<const float4*>(gate + col + 4);
          *reinterpret_cast<uint4*>(X + (size_t)row * 1024 + col) =
              make_uint4(pack2(ra.x + ga.x * v0[0], ra.y + ga.y * v0[1]), pack2(ra.z + ga.z * v0[2], ra.w + ga.w * v0[3]),
                         pack2(rb.x + gb.x * v1[0], rb.y + gb.y * v1[1]), pack2(rb.z + gb.z * v1[2], rb.w + gb.w * v1[3]));
        }
      }
  }
};
struct EpiPart {
  float* PART;
  DEVI void operator()(const f32x4 (&acc)[2][2][4][2], const G8Unit& u, int wr, int wc, int fr, int fq) const {
    const int brow = u.pm * 256, bcol = (u.pn & 3) * 256;
    float* base = PART + (size_t)(u.pn >> 2) * 2048 * 1024;
#pragma unroll
    for (int ai = 0; ai < 2; ++ai)
#pragma unroll
      for (int m = 0; m < 4; ++m) {
        const int row = brow + ai * 128 + wr * 64 + m * 16 + fr;
#pragma unroll
        for (int bj = 0; bj < 2; ++bj) {
          const int col = bcol + bj * 128 + wc * 32 + 8 * fq;
          const f32x4 v0 = acc[ai][bj][m][0], v1 = acc[ai][bj][m][1];
          *reinterpret_cast<float4*>(base + (size_t)row * 1024 + col) = make_float4(v0[0], v0[1], v0[2], v0[3]);
          *reinterpret_cast<float4*>(base + (size_t)row * 1024 + col + 4) = make_float4(v1[0], v1[1], v1[2], v1[3]);
        }
      }
  }
};
DEVI void phase_gemm2_8(const Params& P, int l, unsigned char* smem_base) {
  EpiX E{P.x, P.ctx, P.X, P.MOD + (size_t)l * 9 * 6144, l};
  gemm8_phase((LAS unsigned char*)smem_base, P.H, P.WoutT + (size_t)l * 1024 * 1024, 1024, NL / 256, 4, E);
  if (l == 0) {
    EpiPart EP{P.PART};
    gemm8_phase((LAS unsigned char*)smem_base, P.H + (size_t)NL * 1024, P.WoutT, 512, 8, 8, EP, 1024, 1 << 30, 0, 0, 1024, 4, 512);
    const int c = blockIdx.x;
    if (c >= 64) {
      const int b0 = 12000 + (c - 64) * 109;
      convert_rows_fp6(P, 0, b0 < 32768 ? b0 : 32768, b0 + 109 < 32768 ? b0 + 109 : 32768);
    }
  }
}

struct EpiQP {
  bf16* QP;
  DEVI void operator()(const f32x4 (&acc)[2][2][4][2], const G8Unit& u, int wr, int wc, int fr, int fq) const {
    const int brow = u.pm * 256, bcol = u.pn * 256;
#pragma unroll
    for (int ai = 0; ai < 2; ++ai)
#pragma unroll
      for (int m = 0; m < 4; ++m) {
        const int row = brow + ai * 128 + wr * 64 + m * 16 + fr;
#pragma unroll
        for (int bj = 0; bj < 2; ++bj) {
          const int col = bcol + bj * 128 + wc * 32 + 8 * fq;
          const f32x4 v0 = acc[ai][bj][m][0], v1 = acc[ai][bj][m][1];
          *reinterpret_cast<uint4*>(QP + (size_t)row * 2048 + col) = make_uint4(pack2(v0[0], v0[1]), pack2(v0[2], v0[3]), pack2(v1[0], v1[1]), pack2(v1[2], v1[3]));
        }
      }
  }
};
DEVI void phase_gemm3_8(const Params& P, int l, unsigned char* smem_base) {
  EpiQP E{P.QP};
  gemm8_phase((LAS unsigned char*)smem_base, P.H, P.WpqT + (size_t)l * 2048 * 1024, 1024, (l == 1) ? NL / 256 : NT / 256, 8, E);
  const int c = blockIdx.x;
  if (l == 0 && c >= 64) convert_rows_fp6(P, 1, (c - 64) * 100, (c - 64) * 100 + 100);
}

constexpr int N_PHASES = 2 + 2 * 11;

#ifndef REP_MASK
#define REP_MASK 0
#endif
static_assert(sizeof(Params) % 8 == 0, "Params size");
DEVI Params load_params() {
#if defined(__HIP_DEVICE_COMPILE__)
  typedef const __attribute__((address_space(4))) Params* ParamsCP;
  ParamsCP pp = (ParamsCP)__builtin_amdgcn_kernarg_segment_ptr();
  asm volatile("" : "+s"(pp));
  return *pp;
#else
  return Params{};
#endif
}
__global__ void __launch_bounds__(512, 2) fwd_kernel(Params Pk) {
  extern __shared__ __attribute__((aligned(16))) unsigned char smem_base[];
  volatile LAS unsigned* xst = (volatile LAS unsigned*)(smem_base + SMEM_BYTES);
  if (threadIdx.x == 0) { xst[0] = 0u; xst[1] = 0u; xst[2] = 0u; xst[3] = 0u; }
  __syncthreads();
  XcdBarrier xb = xcd_barrier_post(Pk.bar, xst);
  const int phase_lo = Pk.phase_lo, phase_hi = Pk.phase_hi, coop = Pk.coop;
#define smem (smem_base + VHALF * HALF_LDS)
#define GSYNC(idx) { xcd_barrier(xb); }
#define RUN_PHASE2(idx, call, repcall) \
  if (phase_lo <= (idx) && (idx) <= phase_hi) { { const Params P = load_params(); call; } if (REP_MASK & (1 << (idx))) { GSYNC(1); const Params P = load_params(); repcall; } if (coop && (idx) < phase_hi) GSYNC(idx); }
#define RUN_PHASE(idx, call) RUN_PHASE2(idx, call, call)
  RUN_PHASE(0, phase_prologue(P, smem))
  RUN_PHASE(1, phase_norm(P, 0, 0, NT))
  RUN_PHASE(2, phase_gemm1_8(P, 0, smem_base))
  RUN_PHASE(3, phase_mla_raw(P, 0, smem_base))
  RUN_PHASE(4, { phase_mixA(P, 0, smem); phase_mla_proj(P, 0, smem); phase_hgrn_local(P, 0, smem); })
  RUN_PHASE2(5, phase_attn_scan(P, 0, smem_base), phase_attn_scan(P, 0, smem_base, true))
  RUN_PHASE(6, phase_hgrn_final(P, 0, smem))
  RUN_PHASE(7, phase_gemm2_8(P, 0, smem_base))
  RUN_PHASE(8, phase_norm(P, 0, 1, NT))
  RUN_PHASE(9, phase_gemm3_8(P, 0, smem_base))
  RUN_PHASE(10, phase_route(P, 0, smem))
  RUN_PHASE(11, phase_peer_u(P, 0))
  RUN_PHASE(12, phase_peer(P, 0))
  RUN_PHASE(13, phase_gemm1_8(P, 1, smem_base))
  RUN_PHASE(14, phase_mla_raw(P, 1, smem_base))
  RUN_PHASE(15, { phase_mixA(P, 1, smem); phase_mla_proj(P, 1, smem); phase_hgrn_local(P, 1, smem); })
  RUN_PHASE2(16, phase_attn_scan(P, 1, smem_base), phase_attn_scan(P, 1, smem_base, true))
  RUN_PHASE(17, phase_hgrn_final(P, 1, smem))
  RUN_PHASE(18, phase_gemm2_8(P, 1, smem_base))
  RUN_PHASE(19, phase_norm(P, 1, 1, NL))
  RUN_PHASE(20, phase_gemm3_8(P, 1, smem_base))
  RUN_PHASE(21, phase_route(P, 1, smem))
  RUN_PHASE(22, phase_peer_u(P, 1))
  RUN_PHASE(23, phase_peer(P, 1))
#undef smem
}

extern "C" void kernel_launch(void* const* d_in, const int* in_sizes, int n_in, void* d_out, int out_size, void* d_ws,
                              size_t ws_size, hipStream_t stream) {
  Params p{};
  const float* const* in = reinterpret_cast<const float* const*>(d_in);
  p.x = in[0]; p.c = in[1]; p.ctx = in[2]; p.c_ctx = in[3]; p.ln1_w = in[4]; p.ln2_w = in[5]; p.w_mod = in[6]; p.b_mod = in[7];
  p.w_in = in[8]; p.w_out = in[9]; p.a_norm_w = in[10]; p.a_w_s = in[11]; p.a_b_s = in[12]; p.b_q_norm_w = in[13]; p.b_w_uq = in[14];
  p.b_kv_norm_w = in[15]; p.b_w_ukv = in[16]; p.b_qh_w = in[17]; p.b_kh_w = in[18]; p.c_lb = in[19]; p.c_out_norm_w = in[20];
  p.p_w_q = in[21]; p.p_sub_keys = in[22]; p.p_u = in[23]; p.p_v = in[24];
  p.out = reinterpret_cast<float*>(d_out);
  unsigned char* ws = reinterpret_cast<unsigned char*>(d_ws);
  size_t off = 0;
  auto take = [&](size_t bytes) { unsigned char* r = ws + off; off += (bytes + 255) & ~(size_t)255; return r; };
  p.bar = (unsigned*)take((size_t)XCD_BAR_WORDS * 4);
  p.MOD = (float*)take((size_t)2 * 9 * 6144 * 4);
  p.ROPE = (float*)take((size_t)2048 * 32 * 4);
  p.WinT = (bf16*)take((size_t)2 * DINP * 1024 * 2);
  p.WoutT = (bf16*)take((size_t)2 * 1024 * 1024 * 2);
  p.WpqT = (bf16*)take((size_t)2 * 2048 * 1024 * 2);
  p.WCOMB = (bf16*)take((size_t)2 * 1792 * 256 * 2);
  p.RAW = (bf16*)take((size_t)NT * 1792 * 2);
  p.SK = (bf16*)take((size_t)2 * 16 * 128 * 128 * 2);
  p.AWS = (bf16*)take((size_t)2 * 4 * 128 * 128 * 2);
  p.PU8 = (unsigned char*)take((size_t)2 * 16384 * 576);
  p.PV8 = (unsigned char*)take((size_t)2 * 16384 * 576);
  p.PUS = (float*)take((size_t)2 * 16384 * 4);
  p.PVS = (float*)take((size_t)2 * 16384 * 4);
  p.X = (bf16*)take((size_t)NT * 1024 * 2);
  p.H = (bf16*)take((size_t)NT * 1024 * 2);
  p.Z = (bf16*)take((size_t)NT * DIN * 2);
  p.Q = (bf16*)take((size_t)64 * SEQP * 96 * 2);
  p.K = (bf16*)take((size_t)64 * SEQP * 96 * 2);
  p.VT = (bf16*)take((size_t)64 * 64 * SEQP * 2);
  p.ST = (bf16*)take((size_t)64 * 36 * 4096 * 2);
  p.DEC = (float*)take((size_t)64 * 36 * 64 * 4);
  p.OI = (bf16*)take((size_t)NT * 256 * 2);
  p.WPE = (float*)take((size_t)NT * 128 * 4);
  p.PART = (float*)take((size_t)2 * 2048 * 1024 * 4);
  p.RS = (float*)take((size_t)NT * 2 * 4);
  p.GQF = (bf16*)take((size_t)NT * 256 * 2);
  p.GQB = (bf16*)take((size_t)NT * 256 * 2);
  p.QP = p.Z;
  p.EIDX = (int*)p.Q;
  p.GATE = (float*)p.K;
  if (off > ws_size) { fprintf(stderr, "workspace too small: need %zu have %zu\n", off, ws_size); }
  static int grid_blocks = 0;
  if (!grid_blocks) {
    if (hipFuncSetAttribute((const void*)fwd_kernel, hipFuncAttributeMaxDynamicSharedMemorySize, SMEM_TOTAL) != hipSuccess)
      fprintf(stderr, "hipFuncSetAttribute failed\n");
    int dev = 0, cus = 0, per_cu = 0;
    hipGetDevice(&dev);
    hipDeviceGetAttribute(&cus, hipDeviceAttributeMultiprocessorCount, dev);
    hipOccupancyMaxActiveBlocksPerMultiprocessor(&per_cu, (const void*)fwd_kernel, 512, SMEM_TOTAL);
    if (per_cu > 1) per_cu = 1;
    if (per_cu < 1) { fprintf(stderr, "occupancy query returned %d\n", per_cu); per_cu = 1; }
    grid_blocks = cus * per_cu;
    fprintf(stderr, "grid_blocks=%d (cus=%d per_cu=%d) ws need=%zu have=%zu\n", grid_blocks, cus, per_cu, off, ws_size);
  }
  hipMemsetAsync(p.bar, 0, (size_t)XCD_BAR_WORDS * 4, stream);
  p.coop = 1; p.phase_lo = 0; p.phase_hi = N_PHASES - 1;
  hipLaunchKernelGGL(fwd_kernel, dim3(grid_blocks), dim3(512), SMEM_TOTAL, stream, p);
  const hipError_t e = hipPeekAtLastError();
  if (e != hipSuccess) fprintf(stderr, "launch failed: %s (grid %d)\n", hipGetErrorString(e), grid_blocks);
}
```

```cpp
#include <hip/hip_runtime.h>
#include <hip/hip_cooperative_groups.h>
#include <cstdio>
#include <cstdint>
namespace cg = cooperative_groups;

#define DEVI __device__ __forceinline__

typedef unsigned short bf16;
using bf16x8 = __attribute__((ext_vector_type(8))) __bf16;
using bf16x2 = __attribute__((ext_vector_type(2))) __bf16;
using f32x16 = __attribute__((ext_vector_type(16))) float;
typedef unsigned v6u __attribute__((ext_vector_type(6)));
typedef unsigned v3u __attribute__((ext_vector_type(3)));
typedef float v16f __attribute__((ext_vector_type(16)));
typedef float v32f __attribute__((ext_vector_type(32)));

constexpr int NL = 16384;
constexpr int NT = 18432;
constexpr int DM = 1024;
constexpr int DIN = 2208;
constexpr int DINP = 2304;
constexpr int SEQP = 2304;
constexpr float EPS = 1e-6f;
constexpr int ZC_AU = 0, ZC_AV = 256, ZC_BQ = 512, ZC_BKV = 768, ZC_BKR = 896, ZC_CQ = 928, ZC_CFF = 1184, ZC_CFB = 1440, ZC_CI = 1696, ZC_CG = 1952;
constexpr int SMEM_BYTES = 2 * 80896;
constexpr int SMEM_TOTAL = SMEM_BYTES + 16;

struct Params {
  const float *x, *c, *ctx, *c_ctx, *ln1_w, *ln2_w, *w_mod, *b_mod, *w_in, *w_out, *a_norm_w, *a_w_s, *a_b_s;
  const float *b_q_norm_w, *b_w_uq, *b_kv_norm_w, *b_w_ukv, *b_qh_w, *b_kh_w, *c_lb, *c_out_norm_w, *p_w_q, *p_sub_keys, *p_u, *p_v;
  float* out;
  unsigned* bar;
  float* MOD;
  float* ROPE;
  bf16* WinT;
  bf16* WoutT;
  bf16* WpqT;
  bf16* WCOMB;
  bf16* RAW;
  bf16* SK;
  bf16* AWS;
  unsigned char* PU8;
  unsigned char* PV8;
  float* PUS;
  float* PVS;
  bf16* X;
  bf16* H;
  bf16* Z;
  bf16* Q;
  bf16* K;
  bf16* VT;
  bf16* ST;
  float* DEC;
  bf16* OI;
  float* WPE;
  float* RS;
  float* PART;
  bf16* GQF;
  bf16* GQB;
  bf16* QP;
  int* EIDX;
  float* GATE;
  int phase_lo, phase_hi, coop, pad0;
};

DEVI float bf2f(bf16 v) { return __uint_as_float(((unsigned)v) << 16); }
DEVI bf16 f2bf(float a) { __bf16 v = (__bf16)a; return __builtin_bit_cast(unsigned short, v); }
DEVI unsigned pack2(float a, float b) { bf16x2 v; v[0] = (__bf16)a; v[1] = (__bf16)b; return __builtin_bit_cast(unsigned, v); }
DEVI float lo2f(unsigned u) { return __uint_as_float(u << 16); }
DEVI float hi2f(unsigned u) { return __uint_as_float(u & 0xffff0000u); }
DEVI f32x16 zero16() { f32x16 z;
#pragma unroll
  for (int i = 0; i < 16; ++i) z[i] = 0.f; return z; }
DEVI f32x16 mfma32(bf16x8 a, bf16x8 b, f32x16 c) { return __builtin_amdgcn_mfma_f32_32x32x16_bf16(a, b, c, 0, 0, 0); }
DEVI bf16x8 ldfrag(const bf16* p) { return *reinterpret_cast<const bf16x8*>(p); }
DEVI int drow(int r, int hh) { return (r & 3) + 8 * (r >> 2) + 4 * hh; }
DEVI int row_of(int b, int p) { return p < 256 ? NL + b * 256 + p : b * 2048 + (p - 256); }
DEVI int batch_of_row(int r) { return r < NL ? (r >> 11) : 8; }
DEVI float wave_sum(float v) {
#pragma unroll
  for (int o = 32; o > 0; o >>= 1) v += __shfl_xor(v, o);
  return v;
}
DEVI float sigmoidf_(float z) { return 1.f / (1.f + __expf(-z)); }


#define XB_TMO      128
#define XB_XCNT(j)  (256  + 64 * (j))
#define XB_XSUB(j)  (1280 + 64 * (j))
#define XB_XGEN(j)  (2304 + 64 * (j))
#define XB_TOP      3328
#define XB_TOPGEN   3392
#define XCD_BAR_WORDS 3456
#define XB_SPIN_CAP (1u << 22)
#define LAS __attribute__((address_space(3)))
DEVI unsigned xb_ld(unsigned* p)              { return __hip_atomic_load(p, __ATOMIC_RELAXED, __HIP_MEMORY_SCOPE_AGENT); }
DEVI unsigned xb_add(unsigned* p, unsigned v) { return __hip_atomic_fetch_add(p, v, __ATOMIC_RELAXED, __HIP_MEMORY_SCOPE_AGENT); }
DEVI unsigned xb_xcc_id() { return (unsigned)__builtin_amdgcn_s_getreg((3 << 11) | 20) & 0xFu; }
#define XB_SPIN(cond, bar) do { unsigned _sp = 0; while (cond) { __builtin_amdgcn_s_sleep(1); \
    if ((++_sp & 255u) == 0u) { if (xb_ld(&(bar)[XB_TMO])) break; if (_sp > XB_SPIN_CAP) { atomicAdd(&(bar)[XB_TMO], 1u); break; } } } } while (0)
struct XcdBarrier { unsigned* bar; unsigned x; volatile LAS unsigned* st; };
DEVI XcdBarrier xcd_barrier_post(unsigned* bar, volatile LAS unsigned* st) {
  XcdBarrier b; b.bar = bar; b.x = xb_xcc_id(); b.st = st;
  if (threadIdx.x == 0) (void)xb_add(&bar[XB_XCNT(b.x)], 1u);
  return b;
}
DEVI void xcd_barrier_complete(unsigned* bar, unsigned x, unsigned& nloc, unsigned& nx) {
  const unsigned G = gridDim.x * gridDim.y * gridDim.z;
  unsigned sum, cnt, mine, sp = 0u;
  for (;;) {
    sum = 0u; cnt = 0u; mine = 0u;
#pragma unroll
    for (unsigned j = 0; j < 16; ++j) { const unsigned c = xb_ld(&bar[XB_XCNT(j)]); sum += c; cnt += (c > 0u) ? 1u : 0u; mine = (j == x) ? c : mine; }
    if (sum == G) break;
    __builtin_amdgcn_s_sleep(1);
    if ((++sp & 255u) == 0u) { if (xb_ld(&bar[XB_TMO])) break; if (sp > XB_SPIN_CAP) { atomicAdd(&bar[XB_TMO], 1u); break; } }
  }
  nloc = mine > 0u ? mine : 1u; nx = cnt > 0u ? cnt : 1u;
}
DEVI void xcd_barrier(const XcdBarrier& b) {
  asm volatile("s_waitcnt vmcnt(0)" ::: "memory");
  __syncthreads();
  if (threadIdx.x == 0) {
    unsigned* bar = b.bar;
    __builtin_amdgcn_s_waitcnt(0);
    unsigned nloc = b.st[0], nx = b.st[1];
    if (nloc == 0u) { xcd_barrier_complete(bar, b.x, nloc, nx); b.st[0] = nloc; b.st[1] = nx; }
    const unsigned old = xb_add(&bar[XB_XSUB(b.x)], 1u);
    const unsigned gen = old / nloc;
    if (old + 1u == (gen + 1u) * nloc) {
      __builtin_amdgcn_fence(__ATOMIC_RELEASE, "agent");
      asm volatile("s_waitcnt vmcnt(0)" ::: "memory");
      const unsigned og = xb_add(&bar[XB_TOP], 1u);
      const unsigned tg = og / nx;
      if (og + 1u == (tg + 1u) * nx) xb_add(&bar[XB_TOPGEN], 1u);
      else XB_SPIN(xb_ld(&bar[XB_TOPGEN]) == tg, bar);
      __builtin_amdgcn_fence(__ATOMIC_ACQUIRE, "agent");
      xb_add(&bar[XB_XGEN(b.x)], 1u);
      asm volatile("s_waitcnt vmcnt(0)" ::: "memory");
    } else {
      XB_SPIN(xb_ld(&bar[XB_XGEN(b.x)]) == gen, bar);
      __builtin_amdgcn_fence(__ATOMIC_ACQUIRE, "agent");
      asm volatile("s_waitcnt vmcnt(0)" ::: "memory");
    }
  }
  __syncthreads();
}

#define VHALF ((int)__builtin_amdgcn_readfirstlane((int)(threadIdx.x >> 8)))
#define TIDX ((int)(threadIdx.x & 255))
#define VBID ((int)(blockIdx.x * 2 + VHALF))
#define NVB ((int)(gridDim.x * 2))
constexpr int HALF_LDS = 80896;

DEVI void hb_sync() {
  extern __shared__ __attribute__((aligned(16))) unsigned char hb_smem[];
  LAS unsigned* cnt = (LAS unsigned*)(hb_smem + SMEM_BYTES) + 2 + VHALF;
  __builtin_amdgcn_fence(__ATOMIC_RELEASE, "workgroup");
  if ((threadIdx.x & 63) == 0) {
    const unsigned old = __hip_atomic_fetch_add(cnt, 1u, __ATOMIC_RELAXED, __HIP_MEMORY_SCOPE_WORKGROUP);
    const unsigned target = (old / 4u + 1u) * 4u;
    while (__hip_atomic_load(cnt, __ATOMIC_RELAXED, __HIP_MEMORY_SCOPE_WORKGROUP) < target) __builtin_amdgcn_s_sleep(0);
  }
  __builtin_amdgcn_fence(__ATOMIC_ACQUIRE, "workgroup");
}

DEVI void phase_mod(const Params& P, unsigned char* smem) {
  const int tid = TIDX;
  float* s = (float*)smem;
  float* red = s + 9 * 1024;
  for (int item = VBID; item < 192; item += NVB) {
    const int l = item / 96, j = item % 96;
    hb_sync();
    for (int i = tid; i < 9 * 1024; i += 256) {
      int bi = i >> 10, k = i & 1023;
      float v = bi < 8 ? P.c[bi * 1024 + k] : P.c_ctx[k];
      s[i] = v * sigmoidf_(v);
    }
    hb_sync();
    const int c4 = tid & 15, kg = tid >> 4;
    float acc[9][4];
#pragma unroll
    for (int bi = 0; bi < 9; ++bi) { acc[bi][0] = acc[bi][1] = acc[bi][2] = acc[bi][3] = 0.f; }
    const float* w = P.w_mod + (size_t)l * 1024 * 6144 + j * 64 + c4 * 4;
#pragma unroll 4
    for (int kk = 0; kk < 64; ++kk) {
      const int k = kg * 64 + kk;
      const float4 w4 = *reinterpret_cast<const float4*>(w + (size_t)k * 6144);
#pragma unroll
      for (int bi = 0; bi < 9; ++bi) {
        const float sv = s[bi * 1024 + k];
        acc[bi][0] += sv * w4.x; acc[bi][1] += sv * w4.y; acc[bi][2] += sv * w4.z; acc[bi][3] += sv * w4.w;
      }
    }
#pragma unroll
    for (int bi = 0; bi < 9; ++bi)
#pragma unroll
      for (int e = 0; e < 4; ++e) red[(kg * 9 + bi) * 64 + c4 * 4 + e] = acc[bi][e];
    hb_sync();
    for (int o = tid; o < 576; o += 256) {
      const int bi = o >> 6, cc = o & 63;
      float sum = 0.f;
#pragma unroll
      for (int g = 0; g < 16; ++g) sum += red[(g * 9 + bi) * 64 + cc];
      P.MOD[(size_t)(l * 9 + bi) * 6144 + j * 64 + cc] = sum + P.b_mod[l * 6144 + j * 64 + cc];
    }
  }
}

DEVI void conv_T_tile(const float* __restrict__ src, int N, bf16* __restrict__ dst, int Kd, int k0, int n0,
                      const float* __restrict__ kscale, float* tile) {
  const int tid = TIDX;
  hb_sync();
  for (int e = tid; e < 4096; e += 256) {
    const int i = e >> 6, j = e & 63, n = n0 + j;
    float v = (n < N) ? src[(size_t)(k0 + i) * N + n] : 0.f;
    if (kscale) v *= kscale[k0 + i];
    tile[i * 65 + j] = v;
  }
  hb_sync();
  for (int e = tid; e < 2048; e += 256) {
    const int j = e >> 5, i2 = (e & 31) * 2;
    const unsigned pk = pack2(tile[i2 * 65 + j], tile[(i2 + 1) * 65 + j]);
    *reinterpret_cast<unsigned*>(&dst[(size_t)(n0 + j) * Kd + k0 + i2]) = pk;
  }
}

DEVI void conv_straight(const float* __restrict__ src, bf16* __restrict__ dst, size_t n8) {
  const size_t stride = (size_t)NVB * 256;
  for (size_t i = (size_t)VBID * 256 + TIDX; i < n8; i += stride) {
    const float4 a = reinterpret_cast<const float4*>(src)[2 * i];
    const float4 b = reinterpret_cast<const float4*>(src)[2 * i + 1];
    uint4 o; o.x = pack2(a.x, a.y); o.y = pack2(a.z, a.w); o.z = pack2(b.x, b.y); o.w = pack2(b.z, b.w);
    reinterpret_cast<uint4*>(dst)[i] = o;
  }
}

DEVI void convert_rows_fp6(const Params& P, int L, int i0, int i1) {
  const int lane = threadIdx.x & 63, half = lane >> 5, l32 = lane & 31;
  const int wv = threadIdx.x >> 6;
  for (int ib = i0 + wv * 2; ib < i1; ib += 16) {
    int i = ib + half; const bool live = i < i1; if (!live) i = i1 - 1;
    const int table = i >> 14, lr = L * 16384 + (i & 16383);
    const float* src = (table ? P.p_v : P.p_u) + (size_t)lr * 1024 + l32 * 32;
    float4 a[8];
    float m = 0.f;
#pragma unroll
    for (int q = 0; q < 8; ++q) {
      a[q] = *reinterpret_cast<const float4*>(src + q * 4);
      m = fmaxf(m, fmaxf(fmaxf(fabsf(a[q].x), fabsf(a[q].y)), fmaxf(fabsf(a[q].z), fabsf(a[q].w))));
    }
    const unsigned sb = (__float_as_uint(fmaxf(m, 1e-30f) * (1.f / 6.f)) + 0xffffu) >> 16;
    const float inv = 1.f / __uint_as_float(sb << 16);
    unsigned pk[4];
#pragma unroll
    for (int w = 0; w < 4; ++w) {
      unsigned word = 0u;
#pragma unroll
      for (int e = 0; e < 8; ++e) {
        const int idx = w * 8 + e;
        const float4 q4 = a[idx >> 2];
        const float xv = ((idx & 3) == 0 ? q4.x : (idx & 3) == 1 ? q4.y : (idx & 3) == 2 ? q4.z : q4.w) * inv;
        const float av = fabsf(xv);
        unsigned ci = (av > 0.25f) + (av > 0.75f) + (av > 1.25f) + (av > 1.75f) + (av > 2.5f) + (av > 3.5f) + (av > 5.f);
        ci |= (xv < 0.f) ? 8u : 0u;
        word |= ci << (4 * e);
      }
      pk[w] = word;
    }
    unsigned char* rowp = (table ? P.PV8 : P.PU8) + (size_t)lr * 576;
    if (live) {
      *reinterpret_cast<uint4*>(rowp + l32 * 16) = make_uint4(pk[0], pk[1], pk[2], pk[3]);
      *reinterpret_cast<unsigned short*>(rowp + 512 + l32 * 2) = (unsigned short)sb;
    }
  }
}

DEVI void phase_prologue(const Params& P, unsigned char* smem) {
  phase_mod(P, smem);
  float* tile = (float*)smem;
  for (int it = VBID; it < 2 * 1424; it += NVB) {
    const int l = it / 1424; int r = it % 1424;
    if (r < 576) { conv_T_tile(P.w_in + (size_t)l * 1024 * DIN, DIN, P.WinT + (size_t)l * DINP * 1024, 1024, (r % 16) * 64, (r / 16) * 64, nullptr, tile); continue; }
    r -= 576;
    if (r < 256) { conv_T_tile(P.w_out + (size_t)l * 1024 * 1024, 1024, P.WoutT + (size_t)l * 1024 * 1024, 1024, (r % 16) * 64, (r / 16) * 64, nullptr, tile); continue; }
    r -= 256;
    if (r < 512) continue;
    r -= 512;
    if (r < 48) { conv_T_tile(P.b_w_uq + (size_t)l * 256 * 768, 768, P.WCOMB + (size_t)l * 1792 * 256, 256, (r % 4) * 64, (r / 4) * 64, P.b_q_norm_w + l * 256, tile); continue; }
    r -= 48;
    conv_T_tile(P.b_w_ukv + (size_t)l * 128 * 1024, 1024, P.WCOMB + (size_t)l * 1792 * 256 + 768 * 256, 256, (r % 2) * 64, (r / 2) * 64, P.b_kv_norm_w + l * 128, tile);
  }
  {
    const int tid = TIDX, lane = tid & 63, wave = tid >> 6, l31 = lane & 31, hh = lane >> 5;
    bf16* KA = reinterpret_cast<bf16*>(smem);
    bf16* WB = KA + 128 * 136;
    for (int it = VBID; it < 2 * 16 * 16; it += NVB) {
      const int kt = it & 15, hp = (it >> 4) & 15, l = it >> 8;
      hb_sync();
      {
        const float* keys = P.p_sub_keys + (size_t)(l * 16 + hp) * 128 * 128;
        for (int e = tid; e < 128 * 32; e += 256) {
          const int r = e >> 5, c4 = e & 31;
          const float4 v = *reinterpret_cast<const float4*>(keys + (size_t)r * 128 + c4 * 4);
          *reinterpret_cast<uint2*>(KA + r * 136 + c4 * 4) = make_uint2(pack2(v.x, v.y), pack2(v.z, v.w));
        }
        const float* wq = P.p_w_q + (size_t)l * 1024 * 2048 + (size_t)(kt * 64) * 2048 + hp * 128;
        for (int e = tid; e < 64 * 32; e += 256) {
          const int r = e >> 5, c4 = e & 31;
          const float4 v = *reinterpret_cast<const float4*>(wq + (size_t)r * 2048 + c4 * 4);
          *reinterpret_cast<uint2*>(WB + r * 136 + c4 * 4) = make_uint2(pack2(v.x, v.y), pack2(v.z, v.w));
        }
      }
      hb_sync();
      f32x16 acc[2]; acc[0] = zero16(); acc[1] = zero16();
#pragma unroll
      for (int ks = 0; ks < 8; ++ks) {
        const bf16x8 af = ldfrag(KA + (wave * 32 + l31) * 136 + ks * 16 + hh * 8);
#pragma unroll
        for (int j = 0; j < 2; ++j) {
          const bf16x8 bfr = ldfrag(WB + (j * 32 + l31) * 136 + ks * 16 + hh * 8);
          acc[j] = mfma32(af, bfr, acc[j]);
        }
      }
      bf16* dst = P.WpqT + (size_t)l * 2048 * 1024 + (size_t)(hp * 128 + wave * 32) * 1024 + kt * 64;
#pragma unroll
      for (int j = 0; j < 2; ++j)
#pragma unroll
        for (int r = 0; r < 16; ++r) dst[(size_t)drow(r, hh) * 1024 + j * 32 + l31] = f2bf(acc[j][r]);
    }
  }
  for (int i = VBID * 256 + TIDX; i < 2 * 1024 * 16; i += NVB * 256) {
    const int l2 = i >> 14, rr = (i >> 4) & 1023, cc = i & 15;
    *reinterpret_cast<uint4*>(P.WCOMB + (size_t)l2 * 1792 * 256 + (size_t)(768 + rr) * 256 + 128 + cc * 8) = make_uint4(0u, 0u, 0u, 0u);
  }
  conv_straight(P.a_w_s, P.AWS, (size_t)2 * 4 * 128 * 128 / 8);
  for (int i = VBID * 256 + TIDX; i < 2048 * 16; i += NVB * 256) {
    const int t = i >> 4, a = (i >> 3) & 1, f = i & 7;
    const float inv = powf(10000.f, -(float)f / 8.f);
    const float pos = a ? (float)(t & 63) : (float)(t >> 6);
    const float ang = pos * inv;
    P.ROPE[t * 32 + a * 8 + f] = cosf(ang);
    P.ROPE[t * 32 + 16 + a * 8 + f] = sinf(ang);
  }
}

DEVI void phase_norm(const Params& P, int l, int which, int nrows) {
  const int lane = TIDX & 63;
  const int gw = VBID * 4 + (TIDX >> 6), nw = NVB * 4;
  const float* lnw = (which == 0 ? P.ln1_w : P.ln2_w) + l * 1024;
  for (int r = gw; r < nrows; r += nw) {
    const float* mod = P.MOD + (size_t)(l * 9 + batch_of_row(r)) * 6144 + which * 3072;
    float4 v[4];
    float ss = 0.f;
    if (which == 0 && l == 0) {
      const float* src = r < NL ? P.x + (size_t)r * 1024 : P.ctx + (size_t)(r - NL) * 1024;
#pragma unroll
      for (int i = 0; i < 4; ++i) v[i] = *reinterpret_cast<const float4*>(src + i * 256 + lane * 4);
    } else if (which == 1 && l == 0 && r >= NL) {
      const float* cin = P.ctx + (size_t)(r - NL) * 1024;
      const float* p0 = P.PART + (size_t)(r - NL) * 1024;
      const float* p1 = p0 + (size_t)2048 * 1024;
      const float* gate = P.MOD + (size_t)8 * 6144 + 2048;
#pragma unroll
      for (int i = 0; i < 4; ++i) {
        const int d = i * 256 + lane * 4;
        const float4 c4 = *reinterpret_cast<const float4*>(cin + d), a4 = *reinterpret_cast<const float4*>(p0 + d), b4 = *reinterpret_cast<const float4*>(p1 + d);
        const float4 g4 = *reinterpret_cast<const float4*>(gate + d);
        v[i] = make_float4(c4.x + g4.x * (a4.x + b4.x), c4.y + g4.y * (a4.y + b4.y), c4.z + g4.z * (a4.z + b4.z), c4.w + g4.w * (a4.w + b4.w));
        *reinterpret_cast<uint2*>(P.X + (size_t)r * 1024 + d) = make_uint2(pack2(v[i].x, v[i].y), pack2(v[i].z, v[i].w));
      }
    } else {
      const bf16* src = P.X + (size_t)r * 1024;
#pragma unroll
      for (int i = 0; i < 4; ++i) {
        const uint2 u = *reinterpret_cast<const uint2*>(src + i * 256 + lane * 4);
        v[i] = make_float4(lo2f(u.x), hi2f(u.x), lo2f(u.y), hi2f(u.y));
      }
    }
#pragma unroll
    for (int i = 0; i < 4; ++i) ss += v[i].x * v[i].x + v[i].y * v[i].y + v[i].z * v[i].z + v[i].w * v[i].w;
    ss = wave_sum(ss);
    const float rr = rsqrtf(ss * (1.f / 1024.f) + EPS);
#pragma unroll
    for (int i = 0; i < 4; ++i) {
      const int d = i * 256 + lane * 4;
      const float4 w = *reinterpret_cast<const float4*>(lnw + d);
      const float4 sh = *reinterpret_cast<const float4*>(mod + d);
      const float4 sc = *reinterpret_cast<const float4*>(mod + 1024 + d);
      const float o0 = v[i].x * rr * w.x * (1.f + sc.x) + sh.x;
      const float o1 = v[i].y * rr * w.y * (1.f + sc.y) + sh.y;
      const float o2 = v[i].z * rr * w.z * (1.f + sc.z) + sh.z;
      const float o3 = v[i].w * rr * w.w * (1.f + sc.w) + sh.w;
      uint2 o; o.x = pack2(o0, o1); o.y = pack2(o2, o3);
      *reinterpret_cast<uint2*>(P.H + (size_t)r * 1024 + d) = o;
    }
  }
}

template <int BM, int BN, int BK, int WM, int WN>
struct Gemm {
  static constexpr int LDK = BK + 8;
  static constexpr int TM = BM / WM / 32, TN = BN / WN / 32;
  static constexpr int CPR = BK / 8;
  static constexpr int NA = BM * CPR / 256, NB = BN * CPR / 256;
  static constexpr int A_BYTES = BM * LDK * 2, B_BYTES = BN * LDK * 2;
  static constexpr int STAGE_BYTES = A_BYTES + B_BYTES;
  static constexpr int SMEM = 2 * STAGE_BYTES;

  static DEVI void run(const bf16* __restrict__ A, int lda, const bf16* __restrict__ BT, int ldb, int K,
                       unsigned char* smem, f32x16 (&acc)[TM][TN]) {
    const int tid = TIDX, lane = tid & 63, wave = tid >> 6;
    const int wm = wave / WN, wn = wave % WN;
    const int l31 = lane & 31, hh = lane >> 5;
#pragma unroll
    for (int i = 0; i < TM; ++i)
#pragma unroll
      for (int j = 0; j < TN; ++j) acc[i][j] = zero16();
    uint4 ra[NA], rb[NB];
    const int nk = K / BK;
    auto gload = [&](int kt) {
#pragma unroll
      for (int i = 0; i < NA; ++i) { const int ch = tid + i * 256, row = ch / CPR, cc = ch % CPR;
        ra[i] = *reinterpret_cast<const uint4*>(A + (size_t)row * lda + kt * BK + cc * 8); }
#pragma unroll
      for (int i = 0; i < NB; ++i) { const int ch = tid + i * 256, row = ch / CPR, cc = ch % CPR;
        rb[i] = *reinterpret_cast<const uint4*>(BT + (size_t)row * ldb + kt * BK + cc * 8); }
    };
    auto swrite = [&](int buf) {
      bf16* sA = reinterpret_cast<bf16*>(smem + buf * STAGE_BYTES);
      bf16* sB = reinterpret_cast<bf16*>(smem + buf * STAGE_BYTES + A_BYTES);
#pragma unroll
      for (int i = 0; i < NA; ++i) { const int ch = tid + i * 256, row = ch / CPR, cc = ch % CPR;
        *reinterpret_cast<uint4*>(sA + row * LDK + cc * 8) = ra[i]; }
#pragma unroll
      for (int i = 0; i < NB; ++i) { const int ch = tid + i * 256, row = ch / CPR, cc = ch % CPR;
        *reinterpret_cast<uint4*>(sB + row * LDK + cc * 8) = rb[i]; }
    };
    __syncthreads();
    gload(0);
    swrite(0);
    __syncthreads();
    for (int kt = 0; kt < nk; ++kt) {
      const int cur = kt & 1;
      if (kt + 1 < nk) gload(kt + 1);
      const bf16* sA = reinterpret_cast<const bf16*>(smem + cur * STAGE_BYTES);
      const bf16* sB = reinterpret_cast<const bf16*>(smem + cur * STAGE_BYTES + A_BYTES);
#pragma unroll
      for (int ks = 0; ks < BK / 16; ++ks) {
        bf16x8 af[TM], bfr[TN];
#pragma unroll
        for (int i = 0; i < TM; ++i) af[i] = ldfrag(sA + (wm * (BM / WM) + i * 32 + l31) * LDK + ks * 16 + hh * 8);
#pragma unroll
        for (int j = 0; j < TN; ++j) bfr[j] = ldfrag(sB + (wn * (BN / WN) + j * 32 + l31) * LDK + ks * 16 + hh * 8);
#pragma unroll
        for (int i = 0; i < TM; ++i)
#pragma unroll
          for (int j = 0; j < TN; ++j) acc[i][j] = mfma32(af[i], bfr[j], acc[i][j]);
      }
      if (kt + 1 < nk) swrite(cur ^ 1);
      __syncthreads();
    }
  }
};

DEVI void phase_gemm1(const Params& P, int l, unsigned char* smem) {
  using G = Gemm<128, 128, 64, 2, 2>;
  const int lane = TIDX & 63, wave = TIDX >> 6, wm = wave >> 1, wn = wave & 1, l31 = lane & 31, hh = lane >> 5;
  const bf16* W = P.WinT + (size_t)l * DINP * 1024;
  for (int t = VBID; t < 144 * 18; t += NVB) {
    const int mt = t / 18, nt = t % 18;
    f32x16 acc[2][2];
    G::run(P.H + (size_t)mt * 128 * 1024, 1024, W + (size_t)nt * 128 * 1024, 1024, 1024, smem, acc);
#pragma unroll
    for (int i = 0; i < 2; ++i)
#pragma unroll
      for (int j = 0; j < 2; ++j) {
        const int col = nt * 128 + wn * 64 + j * 32 + l31;
        if (col < DIN) {
#pragma unroll
          for (int r = 0; r < 16; ++r) {
            const int row = mt * 128 + wm * 64 + i * 32 + drow(r, hh);
            P.Z[(size_t)row * DIN + col] = f2bf(acc[i][j][r]);
          }
        }
      }
  }
}

DEVI void phase_gemm2(const Params& P, int l, unsigned char* smem) {
  using G = Gemm<128, 128, 64, 2, 2>;
  const int lane = TIDX & 63, wave = TIDX >> 6, wm = wave >> 1, wn = wave & 1, l31 = lane & 31, hh = lane >> 5;
  const bf16* W = P.WoutT + (size_t)l * 1024 * 1024;
  const int mtiles = (l == 1) ? 128 : 144;
  for (int t = VBID; t < mtiles * 8; t += NVB) {
    const int mt = t / 8, nt = t % 8;
    f32x16 acc[2][2];
    G::run(P.H + (size_t)mt * 128 * 1024, 1024, W + (size_t)nt * 128 * 1024, 1024, 1024, smem, acc);
    const int bi = batch_of_row(mt * 128);
    const float* gate = P.MOD + (size_t)(l * 9 + bi) * 6144 + 2048;
#pragma unroll
    for (int i = 0; i < 2; ++i)
#pragma unroll
      for (int j = 0; j < 2; ++j) {
        const int col = nt * 128 + wn * 64 + j * 32 + l31;
        const float g = gate[col];
#pragma unroll
        for (int r = 0; r < 16; ++r) {
          const int row = mt * 128 + wm * 64 + i * 32 + drow(r, hh);
          float res;
          if (l == 0) res = row < NL ? P.x[(size_t)row * 1024 + col] : P.ctx[(size_t)(row - NL) * 1024 + col];
          else res = bf2f(P.X[(size_t)row * 1024 + col]);
          P.X[(size_t)row * 1024 + col] = f2bf(res + g * acc[i][j][r]);
        }
      }
  }
}

DEVI void phase_mixA(const Params& P, int l, unsigned char* smem) {
  const int tid = TIDX, lane = tid & 63, wave = tid >> 6, l31 = lane & 31, hh = lane >> 5;
  bf16* VNT = reinterpret_cast<bf16*>(smem);
  constexpr int LDV = 136;
  const int nseg = (l == 1) ? 16 : 18;
  const int seg0 = (l == 1) ? 2 : 0;
  for (int it = VBID; it < 8 * nseg * 4; it += NVB) {
    const int a = it & 3; const int sj = (it >> 2) % nseg + seg0; const int b = (it >> 2) / nseg;
    const int p0 = sj * 128;
    hb_sync();
    {
      const int q = tid >> 1, half = tid & 1;
      const int row = row_of(b, p0 + q);
      const bf16* src = P.Z + (size_t)row * DIN + ZC_AV + a * 64 + half * 32;
      float v[32];
      float ss = 0.f;
#pragma unroll
      for (int i = 0; i < 4; ++i) {
        const uint4 u = *reinterpret_cast<const uint4*>(src + i * 8);
        v[i * 8 + 0] = lo2f(u.x); v[i * 8 + 1] = hi2f(u.x); v[i * 8 + 2] = lo2f(u.y); v[i * 8 + 3] = hi2f(u.y);
        v[i * 8 + 4] = lo2f(u.z); v[i * 8 + 5] = hi2f(u.z); v[i * 8 + 6] = lo2f(u.w); v[i * 8 + 7] = hi2f(u.w);
      }
#pragma unroll
      for (int i = 0; i < 32; ++i) ss += v[i] * v[i];
      ss += __shfl_xor(ss, 1);
      const float rr = rsqrtf(ss * (1.f / 64.f) + EPS);
      const float* nw = P.a_norm_w + l * 256 + a * 64 + half * 32;
#pragma unroll
      for (int i = 0; i < 32; ++i) VNT[(half * 32 + i) * LDV + q] = f2bf(v[i] * rr * nw[i]);
    }
    hb_sync();
    f32x16 acc[2]; acc[0] = zero16(); acc[1] = zero16();
    const bf16* Aw = P.AWS + (size_t)(l * 4 + a) * 128 * 128 + (size_t)(wave * 32 + l31) * 128;
#pragma unroll
    for (int ks = 0; ks < 8; ++ks) {
      const bf16x8 af = ldfrag(Aw + ks * 16 + hh * 8);
#pragma unroll
      for (int j = 0; j < 2; ++j) {
        const bf16x8 bfr = ldfrag(VNT + (j * 32 + l31) * LDV + ks * 16 + hh * 8);
        acc[j] = mfma32(af, bfr, acc[j]);
      }
    }
    const float* bs = P.a_b_s + (l * 4 + a) * 128;
#pragma unroll
    for (int j = 0; j < 2; ++j)
#pragma unroll
      for (int r = 0; r < 16; ++r) {
        const int p = wave * 32 + drow(r, hh);
        const int row = row_of(b, p0 + p);
        const int col = a * 64 + j * 32 + l31;
        const float u = bf2f(P.Z[(size_t)row * DIN + ZC_AU + col]);
        P.H[(size_t)row * 1024 + col] = f2bf(u * (acc[j][r] + bs[p]));
      }
  }
}

DEVI void mla_norm_rope_store(const Params& P, const float* T, const float* nw, bool rope, float oscale,
                              bf16* dstbase  , int pos0, int tlat0) {
  const int tid = TIDX, tok = tid >> 1, half = tid & 1;
  float v[48];
  float ss = 0.f;
#pragma unroll
  for (int i = 0; i < 48; ++i) { v[i] = T[tok * 97 + half * 48 + i]; ss += v[i] * v[i]; }
  ss += __shfl_xor(ss, 1);
  const float rr = rsqrtf(ss * (1.f / 96.f) + EPS);
#pragma unroll
  for (int i = 0; i < 48; ++i) v[i] = v[i] * rr * nw[half * 48 + i];
  if (rope && half == 1) {
    const float* cs = P.ROPE + (size_t)(tlat0 + tok) * 32;
#pragma unroll
    for (int a = 0; a < 2; ++a)
#pragma unroll
      for (int f = 0; f < 8; ++f) {
        const float x1 = v[16 + a * 16 + f], x2 = v[16 + a * 16 + 8 + f];
        const float c = cs[a * 8 + f], s = cs[16 + a * 8 + f];
        v[16 + a * 16 + f] = x1 * c - x2 * s;
        v[16 + a * 16 + 8 + f] = x2 * c + x1 * s;
      }
  }
  bf16* dst = dstbase + (size_t)(pos0 + tok) * 96 + half * 48;
#pragma unroll
  for (int i = 0; i < 6; ++i) {
    uint4 o;
    o.x = pack2(v[i * 8 + 0] * oscale, v[i * 8 + 1] * oscale); o.y = pack2(v[i * 8 + 2] * oscale, v[i * 8 + 3] * oscale);
    o.z = pack2(v[i * 8 + 4] * oscale, v[i * 8 + 5] * oscale); o.w = pack2(v[i * 8 + 6] * oscale, v[i * 8 + 7] * oscale);
    *reinterpret_cast<uint4*>(dst + i * 8) = o;
  }
}

DEVI void phase_mla_proj(const Params& P, int l, unsigned char* smem) {
  const int tid = TIDX;
  float* T = reinterpret_cast<float*>(smem);
  bf16* TV = reinterpret_cast<bf16*>(smem + 128 * 97 * 4);
  const float qscale = 0.10206207261596577f * 1.4426950408889634f;
  const int tok = tid >> 1, half = tid & 1;
  for (int it = (VBID + NVB - 64) % NVB; it < 144 * 8; it += NVB) {
    const int h = it & 7;
    const int m0 = (it >> 3) * 128;
    const bool lat = m0 < NL;
    const int b = lat ? (m0 >> 11) : ((m0 - NL) >> 8);
    const int pos0 = lat ? 256 + (m0 & 2047) : ((m0 - NL) & 255);
    const int tlat0 = lat ? (m0 & 2047) : 0;
    const bool doq = lat || (l == 0);
    const bf16* zr = P.Z + (size_t)(m0 + tok) * DIN;
    const bf16* rr = P.RAW + (size_t)(m0 + tok) * 1792;
    hb_sync();
    const float rsq = P.RS[(size_t)(m0 + tok) * 2], rskv = P.RS[(size_t)(m0 + tok) * 2 + 1];
    {
      const bf16* kn = rr + 768 + h * 128 + half * 32;
      const bf16* vv = rr + 768 + h * 128 + 64 + half * 32;
#pragma unroll
      for (int i = 0; i < 4; ++i) {
        const uint4 u = *reinterpret_cast<const uint4*>(kn + i * 8);
        float* tp = T + tok * 97 + half * 32 + i * 8;
        tp[0] = lo2f(u.x) * rskv; tp[1] = hi2f(u.x) * rskv; tp[2] = lo2f(u.y) * rskv; tp[3] = hi2f(u.y) * rskv;
        tp[4] = lo2f(u.z) * rskv; tp[5] = hi2f(u.z) * rskv; tp[6] = lo2f(u.w) * rskv; tp[7] = hi2f(u.w) * rskv;
        const uint4 w = *reinterpret_cast<const uint4*>(vv + i * 8);
        bf16* vp = TV + (half * 32 + i * 8) * 136 + tok;
        vp[0 * 136] = f2bf(lo2f(w.x) * rskv); vp[1 * 136] = f2bf(hi2f(w.x) * rskv); vp[2 * 136] = f2bf(lo2f(w.y) * rskv); vp[3 * 136] = f2bf(hi2f(w.y) * rskv);
        vp[4 * 136] = f2bf(lo2f(w.z) * rskv); vp[5 * 136] = f2bf(hi2f(w.z) * rskv); vp[6 * 136] = f2bf(lo2f(w.w) * rskv); vp[7 * 136] = f2bf(hi2f(w.w) * rskv);
      }
#pragma unroll
      for (int i = 0; i < 2; ++i) {
        const uint4 u = *reinterpret_cast<const uint4*>(zr + ZC_BKR + half * 16 + i * 8);
        float* tp = T + tok * 97 + 64 + half * 16 + i * 8;
        tp[0] = lo2f(u.x); tp[1] = hi2f(u.x); tp[2] = lo2f(u.y); tp[3] = hi2f(u.y);
        tp[4] = lo2f(u.z); tp[5] = hi2f(u.z); tp[6] = lo2f(u.w); tp[7] = hi2f(u.w);
      }
    }
    hb_sync();
    mla_norm_rope_store(P, T, P.b_kh_w + l * 96, lat, 1.f, P.K + (size_t)(b * 8 + h) * SEQP * 96, pos0, tlat0);
    {
      const int d = tid >> 2, qtr = tid & 3;
      bf16* dst = P.VT + ((size_t)(b * 8 + h) * 64 + d) * SEQP + pos0 + qtr * 32;
      const bf16* src = TV + d * 136 + qtr * 32;
#pragma unroll
      for (int i = 0; i < 4; ++i) {
        const uint4 v = *reinterpret_cast<const uint4*>(src + i * 8);
        const int g16 = (i >> 1) * 16, odd = i & 1;
        *reinterpret_cast<uint2*>(dst + g16 + (odd ? 4 : 0)) = make_uint2(v.x, v.y);
        *reinterpret_cast<uint2*>(dst + g16 + (odd ? 12 : 8)) = make_uint2(v.z, v.w);
      }
    }
    if (doq) {
      hb_sync();
      const bf16* qq = rr + h * 96 + half * 48;
#pragma unroll
      for (int i = 0; i < 6; ++i) {
        const uint4 u = *reinterpret_cast<const uint4*>(qq + i * 8);
        float* tp = T + tok * 97 + half * 48 + i * 8;
        tp[0] = lo2f(u.x) * rsq; tp[1] = hi2f(u.x) * rsq; tp[2] = lo2f(u.y) * rsq; tp[3] = hi2f(u.y) * rsq;
        tp[4] = lo2f(u.z) * rsq; tp[5] = hi2f(u.z) * rsq; tp[6] = lo2f(u.w) * rsq; tp[7] = hi2f(u.w) * rsq;
      }
      hb_sync();
      mla_norm_rope_store(P, T, P.b_qh_w + l * 96, lat, qscale, P.Q + (size_t)(b * 8 + h) * SEQP * 96, pos0, tlat0);
    }
  }
}

DEVI void hgrn_load(const Params& P, int l, int b, int hd, int c, float* BF, float* RB, float* SEG,
                    float (&q)[16], float (&kf)[16], float (&kb)[16], float (&v)[16], bool need_kv) {
  const int tid = TIDX, t = tid >> 2, k0 = (tid & 3) * 16;
  const int row = row_of(b, c * 64 + t);
  const bf16* z = P.Z + (size_t)row * DIN + hd * 64 + k0;
  float zf[16], zb[16];
#pragma unroll
  for (int i = 0; i < 2; ++i) {
    const uint4 uq = *reinterpret_cast<const uint4*>(z + ZC_CQ + i * 8);
    const uint4 uf = *reinterpret_cast<const uint4*>(z + ZC_CFF + i * 8);
    const uint4 ub = *reinterpret_cast<const uint4*>(z + ZC_CFB + i * 8);
    q[i * 8 + 0] = lo2f(uq.x); q[i * 8 + 1] = hi2f(uq.x); q[i * 8 + 2] = lo2f(uq.y); q[i * 8 + 3] = hi2f(uq.y);
    q[i * 8 + 4] = lo2f(uq.z); q[i * 8 + 5] = hi2f(uq.z); q[i * 8 + 6] = lo2f(uq.w); q[i * 8 + 7] = hi2f(uq.w);
    zf[i * 8 + 0] = lo2f(uf.x); zf[i * 8 + 1] = hi2f(uf.x); zf[i * 8 + 2] = lo2f(uf.y); zf[i * 8 + 3] = hi2f(uf.y);
    zf[i * 8 + 4] = lo2f(uf.z); zf[i * 8 + 5] = hi2f(uf.z); zf[i * 8 + 6] = lo2f(uf.w); zf[i * 8 + 7] = hi2f(uf.w);
    zb[i * 8 + 0] = lo2f(ub.x); zb[i * 8 + 1] = hi2f(ub.x); zb[i * 8 + 2] = lo2f(ub.y); zb[i * 8 + 3] = hi2f(ub.y);
    zb[i * 8 + 4] = lo2f(ub.z); zb[i * 8 + 5] = hi2f(ub.z); zb[i * 8 + 6] = lo2f(ub.w); zb[i * 8 + 7] = hi2f(ub.w);
    if (need_kv) {
      const uint4 uv = *reinterpret_cast<const uint4*>(z + ZC_CI + i * 8);
      v[i * 8 + 0] = lo2f(uv.x); v[i * 8 + 1] = hi2f(uv.x); v[i * 8 + 2] = lo2f(uv.y); v[i * 8 + 3] = hi2f(uv.y);
      v[i * 8 + 4] = lo2f(uv.z); v[i * 8 + 5] = hi2f(uv.z); v[i * 8 + 6] = lo2f(uv.w); v[i * 8 + 7] = hi2f(uv.w);
    }
  }
#pragma unroll
  for (int i = 0; i < 16; ++i) {
    q[i] *= 0.125f;
    float lbf = 0.f;
    if (l == 1) { const int ch = hd * 64 + k0 + i; lbf = sigmoidf_(P.c_lb[512 + ch] - P.c_lb[ch]); }
    const float zz = zf[i];
    const float e = __expf(-fabsf(zz));
    const float sp = __builtin_amdgcn_rcpf(1.f + e);
    const float sig = zz >= 0.f ? sp : e * sp;
    const float nsig = zz >= 0.f ? e * sp : sp;
    const float lf = (l == 0) ? (fminf(zz, 0.f) - __logf(1.f + e)) : __logf(lbf + (1.f - lbf) * sig);
    kf[i] = (1.f - lbf) * nsig;
    BF[t * 65 + k0 + i] = lf;
  }
  __builtin_amdgcn_sched_barrier(0);
#pragma unroll
  for (int i = 0; i < 16; ++i) {
    float lbb = 0.f;
    if (l == 1) { const int ch = hd * 64 + k0 + i; lbb = sigmoidf_(P.c_lb[512 + 256 + ch] - P.c_lb[256 + ch]); }
    const float zz = zb[i];
    const float e = __expf(-fabsf(zz));
    const float sp = __builtin_amdgcn_rcpf(1.f + e);
    const float sig = zz >= 0.f ? sp : e * sp;
    const float nsig = zz >= 0.f ? e * sp : sp;
    const float lf = (l == 0) ? (fminf(zz, 0.f) - __logf(1.f + e)) : __logf(lbb + (1.f - lbb) * sig);
    kb[i] = (1.f - lbb) * nsig;
    RB[t * 65 + k0 + i] = lf;
  }
  hb_sync();
  {
    const int k = tid & 63, seg = tid >> 6;
    float sf = 0.f, sr = 0.f;
#pragma unroll
    for (int j = 0; j < 16; ++j) { sf += BF[(seg * 16 + j) * 65 + k]; BF[(seg * 16 + j) * 65 + k] = sf; }
#pragma unroll
    for (int j = 15; j >= 0; --j) { sr += RB[(seg * 16 + j) * 65 + k]; RB[(seg * 16 + j) * 65 + k] = sr; }
    SEG[seg * 64 + k] = sf; SEG[256 + seg * 64 + k] = sr;
    hb_sync();
    float offf = 0.f, offb = 0.f;
#pragma unroll
    for (int s2 = 0; s2 < 4; ++s2) {
      offf += (s2 < seg) ? SEG[s2 * 64 + k] : 0.f;
      offb += (s2 > seg) ? SEG[256 + s2 * 64 + k] : 0.f;
    }
#pragma unroll
    for (int j = 0; j < 16; ++j) { BF[(seg * 16 + j) * 65 + k] += offf; RB[(seg * 16 + j) * 65 + k] += offb; }
  }
  hb_sync();
}

DEVI f32x16 lds_mm(const bf16* A, const bf16* BT, int tm, int tn, int l31, int hh) {
  f32x16 acc = zero16();
#pragma unroll
  for (int ks = 0; ks < 4; ++ks) {
    const bf16x8 a = ldfrag(A + (tm * 32 + l31) * 72 + ks * 16 + hh * 8);
    const bf16x8 b = ldfrag(BT + (tn * 32 + l31) * 72 + ks * 16 + hh * 8);
    acc = mfma32(a, b, acc);
  }
  return acc;
}

DEVI void phase_hgrn_local(const Params& P, int l, unsigned char* smem) {
  const int tid = TIDX, lane = tid & 63, wave = tid >> 6, l31 = lane & 31, hh = lane >> 5;
  const int tm = wave >> 1, tn = wave & 1;
  float* BF = reinterpret_cast<float*>(smem);
  float* RB = BF + 64 * 65;
  bf16* QF = reinterpret_cast<bf16*>(smem + 33280);
  bf16* KF = QF + 64 * 72;
  bf16* QB = KF + 64 * 72;
  bf16* KB = QB + 64 * 72;
  bf16* VTt = KB + 64 * 72;
  bf16* KHF = reinterpret_cast<bf16*>(smem);
  bf16* KHB = KHF + 64 * 72;
  bf16* ATT = KHB + 64 * 72;
  for (int it = (VBID + NVB - 192) % NVB; it < 8 * 4 * 36; it += NVB) {
    const int c = it % 36, hd = (it / 36) & 3, b = it / 144;
    float q[16], kf[16], kb[16], v[16];
    hb_sync();
    hgrn_load(P, l, b, hd, c, BF, RB, reinterpret_cast<float*>(smem + 33280), q, kf, kb, v, true);
    const int t = tid >> 2, k0 = (tid & 3) * 16;
#pragma unroll
    for (int i = 0; i < 16; ++i) VTt[(k0 + i) * 72 + t] = f2bf(v[i]);
    float bfv[16], rbv[16];
#pragma unroll
    for (int i = 0; i < 16; ++i) { bfv[i] = BF[t * 65 + k0 + i]; rbv[i] = RB[t * 65 + k0 + i]; }
    {
      const size_t go = (size_t)row_of(b, c * 64 + t) * 256 + hd * 64 + k0;
#pragma unroll
      for (int hq = 0; hq < 2; ++hq) {
        unsigned pf[4], pb[4];
#pragma unroll
        for (int i = 0; i < 8; i += 2) {
          pf[i >> 1] = pack2(q[hq * 8 + i] * __expf(bfv[hq * 8 + i]), q[hq * 8 + i + 1] * __expf(bfv[hq * 8 + i + 1]));
          pb[i >> 1] = pack2(q[hq * 8 + i] * __expf(rbv[hq * 8 + i]), q[hq * 8 + i + 1] * __expf(rbv[hq * 8 + i + 1]));
        }
        *reinterpret_cast<uint4*>(P.GQF + go + hq * 8) = make_uint4(pf[0], pf[1], pf[2], pf[3]);
        *reinterpret_cast<uint4*>(P.GQB + go + hq * 8) = make_uint4(pb[0], pb[1], pb[2], pb[3]);
      }
    }
    if (t == 0) {
      float* dec = P.DEC + ((size_t)((b * 4 + hd) * 2) * 36 + c) * 64 + k0;
#pragma unroll
      for (int i = 0; i < 16; ++i) { dec[i] = __expf(BF[63 * 65 + k0 + i]); dec[36 * 64 + i] = __expf(RB[k0 + i]); }
    }
#pragma unroll
    for (int i = 0; i < 16; i += 2) {
      const int k = k0 + i;
      const float mF0 = BF[32 * 65 + k], mF1 = BF[32 * 65 + k + 1], mB0 = RB[32 * 65 + k], mB1 = RB[32 * 65 + k + 1];
      *reinterpret_cast<unsigned*>(&QF[t * 72 + k]) = pack2(q[i] * __expf(fminf(bfv[i] - mF0, 80.f)), q[i + 1] * __expf(fminf(bfv[i + 1] - mF1, 80.f)));
      *reinterpret_cast<unsigned*>(&KF[t * 72 + k]) = pack2(kf[i] * __expf(fminf(mF0 - bfv[i], 80.f)), kf[i + 1] * __expf(fminf(mF1 - bfv[i + 1], 80.f)));
      *reinterpret_cast<unsigned*>(&QB[t * 72 + k]) = pack2(q[i] * __expf(fminf(rbv[i] - mB0, 80.f)), q[i + 1] * __expf(fminf(rbv[i + 1] - mB1, 80.f)));
      *reinterpret_cast<unsigned*>(&KB[t * 72 + k]) = pack2(kb[i] * __expf(fminf(mB0 - rbv[i], 80.f)), kb[i + 1] * __expf(fminf(mB1 - rbv[i + 1], 80.f)));
    }
#pragma unroll
    for (int i = 0; i < 16; ++i) {
      kf[i] = kf[i] * __expf(BF[63 * 65 + k0 + i] - bfv[i]);
      kb[i] = kb[i] * __expf(RB[k0 + i] - rbv[i]);
    }
    hb_sync();
#pragma unroll
    for (int i = 0; i < 16; ++i) {
      KHF[(k0 + i) * 72 + t] = f2bf(kf[i]);
      KHB[(k0 + i) * 72 + t] = f2bf(kb[i]);
    }
    hb_sync();
    {
      const f32x16 af = lds_mm(QF, KF, tm, tn, l31, hh);
      const f32x16 ab = lds_mm(QB, KB, tm, tn, l31, hh);
      const int s = tn * 32 + l31;
#pragma unroll
      for (int r = 0; r < 16; ++r) {
        const int tt = tm * 32 + drow(r, hh);
        float a = 0.f;
        if (s <= tt) a += af[r];
        if (s >= tt) a += ab[r];
        ATT[tt * 72 + s] = f2bf(a);
      }
    }
    {
      const f32x16 lf = lds_mm(VTt, KHF, tm, tn, l31, hh);
      const f32x16 lb = lds_mm(VTt, KHB, tm, tn, l31, hh);
      bf16* stf = P.ST + ((size_t)((b * 4 + hd) * 2 + 0) * 36 + c) * 4096;
      bf16* stb = P.ST + ((size_t)((b * 4 + hd) * 2 + 1) * 36 + c) * 4096;
#pragma unroll
      for (int r = 0; r < 16; ++r) {
        const int kk = tm * 32 + drow(r, hh), d = tn * 32 + l31;
        stf[kk * 64 + d] = f2bf(lf[r]);
        stb[kk * 64 + d] = f2bf(lb[r]);
      }
    }
    hb_sync();
    {
      const f32x16 o = lds_mm(ATT, VTt, tm, tn, l31, hh);
#pragma unroll
      for (int r = 0; r < 16; ++r) {
        const int tt = tm * 32 + drow(r, hh), d = tn * 32 + l31;
        P.OI[(size_t)row_of(b, c * 64 + tt) * 256 + hd * 64 + d] = f2bf(o[r]);
      }
    }
  }
}

DEVI void hgrn_scan_item(const Params& P, int item) {
  const int tid = TIDX;
  const int chain = item >> 2, sl = item & 3;
  const int dir = chain & 1;
  const int dd = tid >> 2, k4 = sl * 16 + (tid & 3) * 4;
  float4 S = make_float4(0.f, 0.f, 0.f, 0.f);
  bf16* base = P.ST + (size_t)chain * 36 * 4096 + dd * 64 + k4;
  const float* dec = P.DEC + (size_t)chain * 36 * 64 + k4;
#pragma unroll 1
  for (int g = 0; g < 6; ++g) {
    float4 L[6], dc[6];
#pragma unroll
    for (int j = 0; j < 6; ++j) {
      const int step = g * 6 + j;
      const int c = dir == 0 ? step : (step < 4 ? 3 - step : 39 - step);
      { const uint2 u = *reinterpret_cast<const uint2*>(base + (size_t)c * 4096); L[j] = make_float4(lo2f(u.x), hi2f(u.x), lo2f(u.y), hi2f(u.y)); }
      dc[j] = *reinterpret_cast<const float4*>(dec + c * 64);
    }
#pragma unroll
    for (int j = 0; j < 6; ++j) {
      const int step = g * 6 + j;
      const int c = dir == 0 ? step : (step < 4 ? 3 - step : 39 - step);
      *reinterpret_cast<uint2*>(base + (size_t)c * 4096) = make_uint2(pack2(S.x, S.y), pack2(S.z, S.w));
      S.x = dc[j].x * S.x + L[j].x; S.y = dc[j].y * S.y + L[j].y; S.z = dc[j].z * S.z + L[j].z; S.w = dc[j].w * S.w + L[j].w;
    }
  }
}

DEVI void phase_hgrn_final(const Params& P, int l, unsigned char* smem) {
  const int tid = TIDX, lane = tid & 63, wave = tid >> 6, l31 = lane & 31, hh = lane >> 5;
  const int tm = wave >> 1, tn = wave & 1;
  float* O = reinterpret_cast<float*>(smem);
  bf16* QF = reinterpret_cast<bf16*>(smem + 33280);
  bf16* QB = QF + 64 * 72;
  bf16* SF = QB + 64 * 72;
  bf16* SB = SF + 64 * 72;
  const int c0 = (l == 1) ? 4 : 0;
  const int nc = 36 - c0;
  for (int it = VBID; it < 8 * 4 * nc; it += NVB) {
    const int c = it % nc + c0, hd = (it / nc) & 3, b = it / (nc * 4);
    const int t = tid >> 2, k0 = (tid & 3) * 16;
    const int row = row_of(b, c * 64 + t);
    hb_sync();
    {
      const size_t go = (size_t)row * 256 + hd * 64 + k0;
      *reinterpret_cast<uint4*>(QF + t * 72 + k0) = *reinterpret_cast<const uint4*>(P.GQF + go);
      *reinterpret_cast<uint4*>(QF + t * 72 + k0 + 8) = *reinterpret_cast<const uint4*>(P.GQF + go + 8);
      *reinterpret_cast<uint4*>(QB + t * 72 + k0) = *reinterpret_cast<const uint4*>(P.GQB + go);
      *reinterpret_cast<uint4*>(QB + t * 72 + k0 + 8) = *reinterpret_cast<const uint4*>(P.GQB + go + 8);
      const bf16* stf = P.ST + ((size_t)((b * 4 + hd) * 2 + 0) * 36 + c) * 4096 + t * 64 + k0;
      const bf16* stb = P.ST + ((size_t)((b * 4 + hd) * 2 + 1) * 36 + c) * 4096 + t * 64 + k0;
      *reinterpret_cast<uint4*>(SF + t * 72 + k0) = *reinterpret_cast<const uint4*>(stf);
      *reinterpret_cast<uint4*>(SF + t * 72 + k0 + 8) = *reinterpret_cast<const uint4*>(stf + 8);
      *reinterpret_cast<uint4*>(SB + t * 72 + k0) = *reinterpret_cast<const uint4*>(stb);
      *reinterpret_cast<uint4*>(SB + t * 72 + k0 + 8) = *reinterpret_cast<const uint4*>(stb + 8);
    }
    hb_sync();
    {
      f32x16 o = lds_mm(QF, SF, tm, tn, l31, hh);
      const f32x16 o2 = lds_mm(QB, SB, tm, tn, l31, hh);
#pragma unroll
      for (int r = 0; r < 16; ++r) {
        const int tt = tm * 32 + drow(r, hh), d = tn * 32 + l31;
        O[tt * 65 + d] = o[r] + o2[r] + bf2f(P.OI[(size_t)row_of(b, c * 64 + tt) * 256 + hd * 64 + d]);
      }
    }
    hb_sync();
    {
      float ov[16]; float ss = 0.f;
#pragma unroll
      for (int i = 0; i < 16; ++i) { ov[i] = O[t * 65 + k0 + i]; ss += ov[i] * ov[i]; }
      ss += __shfl_xor(ss, 1); ss += __shfl_xor(ss, 2);
      const float rr = rsqrtf(ss * (1.f / 64.f) + EPS);
      const bf16* g = P.Z + (size_t)row * DIN + ZC_CG + hd * 64 + k0;
      const float* nw = P.c_out_norm_w + l * 64 + k0;
      const uint4 gA = *reinterpret_cast<const uint4*>(g), gB = *reinterpret_cast<const uint4*>(g + 8);
      const unsigned gw[8] = {gA.x, gA.y, gA.z, gA.w, gB.x, gB.y, gB.z, gB.w};
      unsigned pk[8];
#pragma unroll
      for (int i = 0; i < 16; i += 2) {
        const float g0 = lo2f(gw[i >> 1]), g1 = hi2f(gw[i >> 1]);
        const float y0 = ov[i] * rr * nw[i] * (g0 * sigmoidf_(g0));
        const float y1 = ov[i + 1] * rr * nw[i + 1] * (g1 * sigmoidf_(g1));
        pk[i >> 1] = pack2(y0, y1);
      }
      uint4* dst = reinterpret_cast<uint4*>(P.H + (size_t)row * 1024 + 768 + hd * 64 + k0);
      dst[0] = make_uint4(pk[0], pk[1], pk[2], pk[3]);
      dst[1] = make_uint4(pk[4], pk[5], pk[6], pk[7]);
    }
  }
}

DEVI void attn_item8(const Params& P, int b, int h, int qpos0, int nkeys, float sref, unsigned char* smem_base) {
  const int tid = threadIdx.x, lane = tid & 63, wave = tid >> 6, l31 = lane & 31, hh = lane >> 5;
  constexpr int TK = 128, LDKS = 104, LDVS = 136;
  constexpr int KS_BYTES = TK * LDKS * 2, VS_BYTES = 64 * LDVS * 2, ST_BYTES = KS_BYTES + VS_BYTES;
  const bf16* Qg = P.Q + ((size_t)(b * 8 + h) * SEQP + qpos0 + wave * 32 + l31) * 96;
  const bf16* Kg = P.K + (size_t)(b * 8 + h) * SEQP * 96;
  const bf16* Vg = P.VT + (size_t)(b * 8 + h) * 64 * SEQP;
  bf16x8 qf[6];
#pragma unroll
  for (int ks = 0; ks < 6; ++ks) qf[ks] = ldfrag(Qg + ks * 16 + hh * 8);
  f32x16 oacc[2]; oacc[0] = zero16(); oacc[1] = zero16();
  float lsum = 0.f;
  const int ntiles = nkeys / TK;
  unsigned koff[4], voff[3];
#pragma unroll
  for (int i = 0; i < 4; ++i) { const int q = (i * 8 + wave) * 64 + lane, row = q / 13, cc = q - row * 13; koff[i] = (unsigned)(row * 96 + (cc < 12 ? cc : 0) * 8) * 2u; }
#pragma unroll
  for (int i = 0; i < 3; ++i) { const int q = (i * 8 + wave) * 64 + lane, row = q / 17, cc = q - row * 17; voff[i] = (unsigned)((row < 64 ? row : 63) * SEQP + (cc < 16 ? cc : 0) * 8) * 2u; }
  LAS unsigned char* ldsb = (LAS unsigned char*)smem_base;
  auto dma_tile = [&](int kt, int buf) {
    const char* kb_ = (const char*)(Kg + (size_t)kt * TK * 96);
    const char* vb_ = (const char*)(Vg + (size_t)kt * TK);
#pragma unroll
    for (int i = 0; i < 4; ++i) {
      const int g = i * 8 + wave;
      if (g < 26) __builtin_amdgcn_global_load_lds((const unsigned*)(kb_ + koff[i]), (LAS unsigned*)(ldsb + buf * ST_BYTES + g * 1024), 16, 0, 0);
    }
#pragma unroll
    for (int i = 0; i < 3; ++i) {
      const int g = i * 8 + wave;
      if (g < 17) __builtin_amdgcn_global_load_lds((const unsigned*)(vb_ + voff[i]), (LAS unsigned*)(ldsb + buf * ST_BYTES + KS_BYTES + g * 1024), 16, 0, 0);
    }
  };
  __syncthreads();
  dma_tile(0, 0);
  asm volatile("s_waitcnt vmcnt(0)" ::: "memory");
  __syncthreads();
  for (int kt = 0; kt < ntiles; ++kt) {
    const int cur = kt & 1;
    if (kt + 1 < ntiles) dma_tile(kt + 1, cur ^ 1);
    const bf16* sK = reinterpret_cast<const bf16*>(smem_base + cur * ST_BYTES);
    const bf16* sV = reinterpret_cast<const bf16*>(smem_base + cur * ST_BYTES + KS_BYTES);
#pragma unroll
    for (int kk = 0; kk < 4; ++kk) {
      f32x16 sacc;
#pragma unroll
      for (int r = 0; r < 16; ++r) sacc[r] = -sref;
#pragma unroll
      for (int ks = 0; ks < 6; ++ks) {
        const bf16x8 a = ldfrag(sK + (kk * 32 + l31) * LDKS + ks * 16 + hh * 8);
        sacc = mfma32(a, qf[ks], sacc);
      }
#pragma unroll
      for (int r = 0; r < 16; ++r) { const float p = __builtin_amdgcn_exp2f(sacc[r]); sacc[r] = p; lsum += p; }
#pragma unroll
      for (int s = 0; s < 2; ++s) {
        bf16x8 pb;
#pragma unroll
        for (int j = 0; j < 8; ++j) pb[j] = (__bf16)sacc[8 * s + j];
#pragma unroll
        for (int dt = 0; dt < 2; ++dt) {
          const bf16x8 a = ldfrag(sV + (dt * 32 + l31) * LDVS + kk * 32 + s * 16 + hh * 8);
          oacc[dt] = mfma32(a, pb, oacc[dt]);
        }
      }
    }
    asm volatile("s_waitcnt vmcnt(0)" ::: "memory");
    __syncthreads();
  }
  lsum += __shfl_xor(lsum, 32);
  const float inv = 1.f / lsum;
  const int row = row_of(b, qpos0 + wave * 32 + l31);
  bf16* dst = P.H + (size_t)row * 1024 + 256 + h * 64;
#pragma unroll
  for (int dt = 0; dt < 2; ++dt)
#pragma unroll
    for (int rg = 0; rg < 4; ++rg) {
      const int d = dt * 32 + 8 * rg + 4 * hh;
      uint2 o;
      o.x = pack2(oacc[dt][4 * rg + 0] * inv, oacc[dt][4 * rg + 1] * inv);
      o.y = pack2(oacc[dt][4 * rg + 2] * inv, oacc[dt][4 * rg + 3] * inv);
      *reinterpret_cast<uint2*>(dst + d) = o;
    }
}

DEVI void phase_attn_scan(const Params& P, int l, unsigned char* smem_base, bool skip_scan = false) {
  if (!skip_scan)
    for (int it = NVB - 1 - VBID; it < 256; it += NVB) hgrn_scan_item(P, it);
  float sref;
  {
    const int lane = threadIdx.x & 63;
    float mq = fmaxf(fabsf(P.b_qh_w[l * 96 + lane]), lane < 32 ? fabsf(P.b_qh_w[l * 96 + 64 + lane]) : 0.f);
    float mk = fmaxf(fabsf(P.b_kh_w[l * 96 + lane]), lane < 32 ? fabsf(P.b_kh_w[l * 96 + 64 + lane]) : 0.f);
#pragma unroll
    for (int o = 32; o > 0; o >>= 1) { mq = fmaxf(mq, __shfl_xor(mq, o)); mk = fmaxf(mk, __shfl_xor(mk, o)); }
    sref = fminf(1.4426950408889634f * 9.797958971132712f * mq * mk, 60.f);
  }
  const int c = blockIdx.x, xcd = c & 7, slot = c >> 3;
  const int nrounds = (l == 0) ? 3 : 2;
  for (int r = 0; r < nrounds; ++r) {
    if (r < 2) {
      const int u = r * 32 + slot;
      const int bh = xcd * 8 + (u >> 3), qt = u & 7;
      if (slot < 32) attn_item8(P, bh >> 3, bh & 7, 256 + 256 * qt, 2304, sref, smem_base);
    } else if (c < 64) {
      attn_item8(P, c >> 3, c & 7, 0, 256, sref, smem_base);
    }
  }
}

DEVI unsigned ordkey(float s) { const unsigned u = __float_as_uint(s); return (u & 0x80000000u) ? ~u : (u | 0x80000000u); }
DEVI float keyval(unsigned k, unsigned mask) { const unsigned u = k & ~mask; return __uint_as_float((u & 0x80000000u) ? (u & 0x7fffffffu) : ~u); }
DEVI void ins16(unsigned (&lst)[16], unsigned v) {
#pragma unroll
  for (int j = 0; j < 16; ++j) { const unsigned hi = max(lst[j], v); v = min(lst[j], v); lst[j] = hi; }
}
DEVI void merge16(unsigned (&lst)[16], int xm) {
  unsigned o[16];
#pragma unroll
  for (int j = 0; j < 16; ++j) o[j] = (unsigned)__shfl_xor((int)lst[j], xm);
#pragma unroll
  for (int j = 0; j < 16; ++j) lst[j] = max(lst[j], o[15 - j]);
#pragma unroll
  for (int d = 8; d >= 1; d >>= 1)
#pragma unroll
    for (int j = 0; j < 16; ++j)
      if ((j & d) == 0) { const unsigned a = lst[j], bb = lst[j + d]; lst[j] = max(a, bb); lst[j + d] = min(a, bb); }
}

DEVI void bitonic_sort_desc16(unsigned (&v)[16]) {
#pragma unroll
  for (int k = 2; k <= 16; k <<= 1)
#pragma unroll
    for (int j = k >> 1; j > 0; j >>= 1)
#pragma unroll
      for (int i = 0; i < 16; ++i) {
        const int l = i ^ j;
        if (l > i) {
          const bool desc = ((i & k) == 0);
          const unsigned a = v[i], b = v[l];
          const unsigned mx = max(a, b), mn = min(a, b);
          v[i] = desc ? mx : mn; v[l] = desc ? mn : mx;
        }
      }
}
DEVI void bitonic_merge_desc16(unsigned (&lst)[16]) {
#pragma unroll
  for (int d = 8; d >= 1; d >>= 1)
#pragma unroll
    for (int j = 0; j < 16; ++j)
      if ((j & d) == 0) { const unsigned a = lst[j], bb = lst[j + d]; lst[j] = max(a, bb); lst[j + d] = min(a, bb); }
}
struct CandTab { int a[52]; int b[52]; };
constexpr CandTab make_cand_tab() {
  CandTab t{};
  int n = 0;
  for (int a = 0; a < 16; ++a)
    for (int b = 0; b < 16; ++b)
      if ((a + 1) * (b + 1) <= 16) { t.a[n] = a; t.b[n] = b; ++n; }
  for (; n < 52; ++n) { t.a[n] = 0; t.b[n] = 0; }
  return t;
}

DEVI void phase_route(const Params& P, int l, unsigned char* smem) {
  const int tid = TIDX;
  const int mtiles = (l == 1) ? 256 : 288;
  for (int it = VBID; it < mtiles * 8; it += NVB) {
    const int mt = it >> 3, h = it & 7;
    unsigned lst[2][16];
    const int row = tid >> 2, part = tid & 3;
#pragma unroll
    for (int p = 0; p < 2; ++p) {
      float sc[32];
      {
        const bf16* sp = P.QP + (size_t)(mt * 64 + row) * 2048 + (h * 2 + p) * 128 + part * 32;
#pragma unroll
        for (int i = 0; i < 4; ++i) {
          const uint4 u = *reinterpret_cast<const uint4*>(sp + i * 8);
          sc[i * 8 + 0] = lo2f(u.x); sc[i * 8 + 1] = hi2f(u.x); sc[i * 8 + 2] = lo2f(u.y); sc[i * 8 + 3] = hi2f(u.y);
          sc[i * 8 + 4] = lo2f(u.z); sc[i * 8 + 5] = hi2f(u.z); sc[i * 8 + 6] = lo2f(u.w); sc[i * 8 + 7] = hi2f(u.w);
        }
      }
      unsigned B2[16];
#pragma unroll
      for (int i = 0; i < 16; ++i) {
        const int i0 = part * 32 + i, i1 = part * 32 + 16 + i;
        lst[p][i] = (ordkey(sc[i]) & ~0x7fu) | (unsigned)(127 - i0);
        B2[i] = (ordkey(sc[16 + i]) & ~0x7fu) | (unsigned)(127 - i1);
      }
      bitonic_sort_desc16(lst[p]);
      bitonic_sort_desc16(B2);
#pragma unroll
      for (int j = 0; j < 16; ++j) lst[p][j] = max(lst[p][j], B2[15 - j]);
      bitonic_merge_desc16(lst[p]);
      merge16(lst[p], 1);
      merge16(lst[p], 2);
    }
    float v0[16], v1[16];
#pragma unroll
    for (int j = 0; j < 16; ++j) { v0[j] = keyval(lst[0][j], 0x7fu); v1[j] = keyval(lst[1][j], 0x7fu); }
    unsigned best[16];
    {
      constexpr CandTab CT = make_cand_tab();
#pragma unroll
      for (int c = 0; c < 13; ++c) {
        const int a0 = CT.a[4 * c + 0], a1 = CT.a[4 * c + 1], a2 = CT.a[4 * c + 2], a3 = CT.a[4 * c + 3];
        const int b0 = CT.b[4 * c + 0], b1 = CT.b[4 * c + 1], b2 = CT.b[4 * c + 2], b3 = CT.b[4 * c + 3];
        const float x = part == 0 ? v0[a0] : part == 1 ? v0[a1] : part == 2 ? v0[a2] : v0[a3];
        const float y = part == 0 ? v1[b0] : part == 1 ? v1[b1] : part == 2 ? v1[b2] : v1[b3];
        const int flat = part == 0 ? (a0 * 16 + b0) : part == 1 ? (a1 * 16 + b1) : part == 2 ? (a2 * 16 + b2) : (a3 * 16 + b3);
        const bool valid = part == 0 ? (4 * c + 0 < 50) : part == 1 ? (4 * c + 1 < 50) : part == 2 ? (4 * c + 2 < 50) : (4 * c + 3 < 50);
        const unsigned key = (ordkey(x + y) & ~0xffu) | (unsigned)(255 - flat);
        best[c] = valid ? key : 0u;
      }
      best[13] = 0u; best[14] = 0u; best[15] = 0u;
      bitonic_sort_desc16(best);
      merge16(best, 1);
      merge16(best, 2);
    }
    {
      const float mx = keyval(best[0], 0xffu);
      float es = 0.f;
      float ev[4]; int ex[4];
#pragma unroll
      for (int jj = 0; jj < 4; ++jj) {
        const unsigned kk = part == 0 ? best[4 * jj + 0] : part == 1 ? best[4 * jj + 1] : part == 2 ? best[4 * jj + 2] : best[4 * jj + 3];
        ev[jj] = __expf(keyval(kk, 0xffu) - mx);
        es += ev[jj];
        const int flat = 255 - (int)(kk & 0xffu);
        const int a = flat >> 4, bq = flat & 15;
        int i1 = 0, i2 = 0;
#pragma unroll
        for (int u = 0; u < 16; ++u) {
          i1 = (a == u) ? (127 - (int)(lst[0][u] & 0x7fu)) : i1;
          i2 = (bq == u) ? (127 - (int)(lst[1][u] & 0x7fu)) : i2;
        }
        ex[jj] = i1 * 128 + i2;
      }
      es += __shfl_xor(es, 1); es += __shfl_xor(es, 2);
      const float inv = 1.f / es;
      const int tok = mt * 64 + row;
      int* ed = P.EIDX + (size_t)tok * 128 + h * 16;
      float* gd = P.GATE + (size_t)tok * 128 + h * 16;
#pragma unroll
      for (int jj = 0; jj < 4; ++jj) { ed[4 * jj + part] = ex[jj]; gd[4 * jj + part] = ev[jj] * inv; }
    }
  }
}

DEVI float gelu_exact(float a) { return 0.5f * a * (1.f + erff(a * 0.70710678118654752f)); }

typedef float f2 __attribute__((ext_vector_type(2)));
DEVI void phase_peer_u(const Params& P, int l) {
  const int lane = TIDX & 63, half = lane >> 5, l32 = lane & 31;
  const int gw = VBID * 4 + (TIDX >> 6), nw = NVB * 4;
  const int nrows = (l == 1) ? NL : NT;
  const unsigned char* PU = P.PU8 + (size_t)l * 16384 * 576;
  const bool b4 = lane & 16, b3 = lane & 8, b2 = lane & 4;
  for (int t = gw; t < nrows; t += nw) {
    f2 h2[16];
    {
      const bf16* hp = P.H + (size_t)t * 1024 + l32 * 32;
#pragma unroll
      for (int i = 0; i < 4; ++i) {
        const uint4 hv = *reinterpret_cast<const uint4*>(hp + i * 8);
        h2[4 * i + 0] = (f2){lo2f(hv.x), hi2f(hv.x)}; h2[4 * i + 1] = (f2){lo2f(hv.y), hi2f(hv.y)};
        h2[4 * i + 2] = (f2){lo2f(hv.z), hi2f(hv.z)}; h2[4 * i + 3] = (f2){lo2f(hv.w), hi2f(hv.w)};
      }
    }
    const int e0 = P.EIDX[(size_t)t * 128 + lane], e1 = P.EIDX[(size_t)t * 128 + 64 + lane];
    const float g0 = P.GATE[(size_t)t * 128 + lane], g1 = P.GATE[(size_t)t * 128 + 64 + lane];
    float* wrow = P.WPE + (size_t)t * 128;
    const bool b1 = lane & 2;
    for (int kb = 0; kb < 4; ++kb) {
      const int esrc = kb < 2 ? e0 : e1;
      uint4 ud[16];
      unsigned short us[16];
#pragma unroll
      for (int i = 0; i < 16; ++i) {
        const int e = __shfl(esrc, (kb * 32 + 2 * i + half) & 63);
        const unsigned char* ur = PU + (size_t)e * 576;
        ud[i] = *reinterpret_cast<const uint4*>(ur + l32 * 16);
        us[i] = *reinterpret_cast<const unsigned short*>(ur + 512 + l32 * 2);
      }
      float d[16];
#pragma unroll
      for (int i = 0; i < 16; ++i) {
        const unsigned uw[4] = {ud[i].x, ud[i].y, ud[i].z, ud[i].w};
        f2 sacc = (f2){0.f, 0.f};
#pragma unroll
        for (int c = 0; c < 4; ++c) {
          sacc = __builtin_elementwise_fma(__builtin_amdgcn_cvt_scalef32_pk_f32_fp4(uw[c], 1.0f, 0), h2[4 * c + 0], sacc);
          sacc = __builtin_elementwise_fma(__builtin_amdgcn_cvt_scalef32_pk_f32_fp4(uw[c], 1.0f, 1), h2[4 * c + 1], sacc);
          sacc = __builtin_elementwise_fma(__builtin_amdgcn_cvt_scalef32_pk_f32_fp4(uw[c], 1.0f, 2), h2[4 * c + 2], sacc);
          sacc = __builtin_elementwise_fma(__builtin_amdgcn_cvt_scalef32_pk_f32_fp4(uw[c], 1.0f, 3), h2[4 * c + 3], sacc);
        }
        d[i] = (sacc.x + sacc.y) * __uint_as_float((unsigned)us[i] << 16);
      }
      float r8[8], r4[4], r2[2], r1;
#pragma unroll
      for (int i = 0; i < 8; ++i) { const float mine = b4 ? d[8 + i] : d[i]; const float send = b4 ? d[i] : d[8 + i]; r8[i] = mine + __shfl_xor(send, 16); }
#pragma unroll
      for (int i = 0; i < 4; ++i) { const float mine = b3 ? r8[4 + i] : r8[i]; const float send = b3 ? r8[i] : r8[4 + i]; r4[i] = mine + __shfl_xor(send, 8); }
#pragma unroll
      for (int i = 0; i < 2; ++i) { const float mine = b2 ? r4[2 + i] : r4[i]; const float send = b2 ? r4[i] : r4[2 + i]; r2[i] = mine + __shfl_xor(send, 4); }
      { const float mine = b1 ? r2[1] : r2[0]; const float send = b1 ? r2[0] : r2[1]; r1 = mine + __shfl_xor(send, 2); }
      r1 += __shfl_xor(r1, 1);
      const int k = kb * 32 + 2 * ((lane >> 1) & 15) + half;
      const float gt = __shfl(kb < 2 ? g0 : g1, k & 63);
      if ((lane & 1) == 0) wrow[k] = gt * gelu_exact(r1);
    }
  }
}

DEVI void phase_peer(const Params& P, int l) {
  const int lane = TIDX & 63, half = lane >> 5, l32 = lane & 31;
  const int gw = VBID * 4 + (TIDX >> 6), nw = NVB * 4;
  const int nrows = (l == 1) ? NL : NT;
  const unsigned char* PV = P.PV8 + (size_t)l * 16384 * 576;
  for (int t = gw; t < nrows; t += nw) {
    const int e0 = P.EIDX[(size_t)t * 128 + lane], e1 = P.EIDX[(size_t)t * 128 + 64 + lane];
    const float w0 = P.WPE[(size_t)t * 128 + lane], w1 = P.WPE[(size_t)t * 128 + 64 + lane];
    f2 y2[16];
#pragma unroll
    for (int i = 0; i < 16; ++i) y2[i] = (f2){0.f, 0.f};
    for (int kb = 0; kb < 4; ++kb) {
      const int esrc = kb < 2 ? e0 : e1;
      const float wsrc = kb < 2 ? w0 : w1;
      uint4 vd[16];
      unsigned short vs[16];
      float wv[16];
#pragma unroll
      for (int i = 0; i < 16; ++i) {
        const int ks = (kb * 32 + 2 * i + half) & 63;
        const int e = __shfl(esrc, ks);
        wv[i] = __shfl(wsrc, ks);
        const unsigned char* vr = PV + (size_t)e * 576;
        vd[i] = *reinterpret_cast<const uint4*>(vr + l32 * 16);
        vs[i] = *reinterpret_cast<const unsigned short*>(vr + 512 + l32 * 2);
      }
#pragma unroll
      for (int i = 0; i < 16; ++i) {
        const float wi = wv[i] * __uint_as_float((unsigned)vs[i] << 16);
        const f2 ww = (f2){wi, wi};
        const unsigned vw[4] = {vd[i].x, vd[i].y, vd[i].z, vd[i].w};
#pragma unroll
        for (int c = 0; c < 4; ++c) {
          y2[4 * c + 0] = __builtin_elementwise_fma(ww, __builtin_amdgcn_cvt_scalef32_pk_f32_fp4(vw[c], 1.0f, 0), y2[4 * c + 0]);
          y2[4 * c + 1] = __builtin_elementwise_fma(ww, __builtin_amdgcn_cvt_scalef32_pk_f32_fp4(vw[c], 1.0f, 1), y2[4 * c + 1]);
          y2[4 * c + 2] = __builtin_elementwise_fma(ww, __builtin_amdgcn_cvt_scalef32_pk_f32_fp4(vw[c], 1.0f, 2), y2[4 * c + 2]);
          y2[4 * c + 3] = __builtin_elementwise_fma(ww, __builtin_amdgcn_cvt_scalef32_pk_f32_fp4(vw[c], 1.0f, 3), y2[4 * c + 3]);
        }
      }
    }
    float y[16];
#pragma unroll
    for (int j = 0; j < 8; ++j) {
      const float ax = y2[j].x + __shfl_xor(y2[j].x, 32), ay = y2[j].y + __shfl_xor(y2[j].y, 32);
      const float bx = y2[8 + j].x + __shfl_xor(y2[8 + j].x, 32), by = y2[8 + j].y + __shfl_xor(y2[8 + j].y, 32);
      y[2 * j] = half ? bx : ax; y[2 * j + 1] = half ? by : ay;
    }
    const int bi = batch_of_row(t);
    const float* gate2 = P.MOD + (size_t)(l * 9 + bi) * 6144 + 5 * 1024;
    const int d0 = l32 * 32 + half * 16;
    float xn[16];
    float ss = 0.f;
#pragma unroll
    for (int q4 = 0; q4 < 4; ++q4) {
      const int d = d0 + q4 * 4;
      const uint2 xu = *reinterpret_cast<const uint2*>(P.X + (size_t)t * 1024 + d);
      const float4 xo = make_float4(lo2f(xu.x), hi2f(xu.x), lo2f(xu.y), hi2f(xu.y));
      const float4 gg = *reinterpret_cast<const float4*>(gate2 + d);
      float4 o;
      o.x = xo.x + gg.x * y[q4 * 4 + 0]; o.y = xo.y + gg.y * y[q4 * 4 + 1];
      o.z = xo.z + gg.z * y[q4 * 4 + 2]; o.w = xo.w + gg.w * y[q4 * 4 + 3];
      xn[q4 * 4 + 0] = o.x; xn[q4 * 4 + 1] = o.y; xn[q4 * 4 + 2] = o.z; xn[q4 * 4 + 3] = o.w;
      ss += o.x * o.x + o.y * o.y + o.z * o.z + o.w * o.w;
      if (l == 1) *reinterpret_cast<float4*>(P.out + (size_t)t * 1024 + d) = o;
      else *reinterpret_cast<uint2*>(P.X + (size_t)t * 1024 + d) = make_uint2(pack2(o.x, o.y), pack2(o.z, o.w));
    }
    if (l == 0) {
      ss = wave_sum(ss);
      const float rr = rsqrtf(ss * (1.f / 1024.f) + EPS);
      const float* lnw = P.ln1_w + 1024;
      const float* mod = P.MOD + (size_t)(9 + bi) * 6144;
      unsigned pk[8];
#pragma unroll
      for (int i = 0; i < 16; i += 2) {
        const float o0 = xn[i] * rr * lnw[d0 + i] * (1.f + mod[1024 + d0 + i]) + mod[d0 + i];
        const float o1 = xn[i + 1] * rr * lnw[d0 + i + 1] * (1.f + mod[1024 + d0 + i + 1]) + mod[d0 + i + 1];
        pk[i >> 1] = pack2(o0, o1);
      }
      *reinterpret_cast<uint4*>(P.H + (size_t)t * 1024 + d0) = make_uint4(pk[0], pk[1], pk[2], pk[3]);
      *reinterpret_cast<uint4*>(P.H + (size_t)t * 1024 + d0 + 8) = make_uint4(pk[4], pk[5], pk[6], pk[7]);
    }
  }
}

using f32x4 = __attribute__((ext_vector_type(4))) float;
namespace g8 {
constexpr int BM = 256, BK = 64, HALF = 128, HT = HALF * BK;
DEVI int lds_byte(int r, int c) { const int st = (r >> 4) * 2 + (c >> 5), rr = r & 15, cc = c & 31, ob = rr * 64 + cc * 2; return st * 1024 + (ob ^ (((ob >> 9) & 1) << 5)); }
DEVI void stage_rc(int b, int& R, int& C) { const int st = b / 1024, sb = b % 1024, swz = sb ^ (((sb >> 9) & 1) << 5); R = (st >> 1) * 16 + swz / 64; C = (st & 1) * 32 + (swz % 64) / 2; }
DEVI int perm32(int rho) { const int n = rho >> 4, i = rho & 15; return 8 * (i >> 2) + 4 * n + (i & 3); }
DEVI void unit_of(int L, int nM, int nN, int& pm, int& pn) {
  const int nwg = nM * nN;
  int wgid = L;
  { const int q = nwg / 8, r = nwg % 8, xcd = wgid % 8, off = wgid / 8; wgid = (xcd < r ? xcd * (q + 1) : r * (q + 1) + (xcd - r) * q) + off; }
  const int nig = 8 * nN, gid = wgid / nig, fm = gid * 8, gsz = (nM - fm) < 8 ? (nM - fm) : 8;
  pm = fm + ((wgid % nig) % gsz); pn = (wgid % nig) / gsz;
}
}

struct G8Unit { int pm, pn; };
template <class Epi>
DEVI void gemm8_phase(LAS unsigned char* lds, const bf16* __restrict__ Ag, const bf16* __restrict__ Btg, const int K, const int nM, const int nN, const Epi& E,
                      const int lda = 0, const int pn_split = 1 << 30, const int acol0 = 0, const int acol1 = 0,
                      const int ldb = 0, const int pn_mod = 1 << 30, const int ksplit_cols = 0) {
  constexpr int BK = 64, HALF = 128, HTB = HALF * BK * 2;
  const int tid = threadIdx.x, wid = __builtin_amdgcn_readfirstlane(tid >> 6), lane = tid & 63, wr = wid >> 2, wc = wid & 3, fr = lane & 15, fq = lane >> 4;
  const int nt = K / BK;
  const int nunits = nM * nN, G = gridDim.x, c = blockIdx.x;
  const int LDA = lda ? lda : K, LDB = ldb ? ldb : K;
  unsigned voffA[2], voffB[2];
#pragma unroll
  for (int i = 0; i < 2; ++i) { int R, C; g8::stage_rc(tid * 16 + i * 8192, R, C); const int Rb = (R & ~31) + g8::perm32(R & 31); voffA[i] = (unsigned)(R * LDA + C) * 2u; voffB[i] = (unsigned)(Rb * LDB + C) * 2u; }
  const size_t kstep = (size_t)(BK * 2);
  const size_t hstepA = (size_t)HALF * LDA * 2, hstep = (size_t)HALF * LDB * 2;
  const size_t tstepA = 2 * hstepA, tstep = 2 * hstep;
  const unsigned ldsw = (unsigned)wid * 1024u;
  const int aoff = g8::lds_byte(wr * 64 + fr, fq * 8), boff = g8::lds_byte(wc * 32 + fr, fq * 8);
#define PG8_SA(b, h) (((b) * 2 + (h)) * HTB)
#define PG8_SB(b, h) ((4 + (b) * 2 + (h)) * HTB)
#define PG8_STAGE(bufoff, gbase, voff) do { _Pragma("unroll") for (int _i = 0; _i < 2; ++_i) \
        __builtin_amdgcn_global_load_lds((const unsigned*)((const char*)(gbase) + (voff)[_i]), (LAS unsigned*)(lds + (bufoff) + ldsw + _i * 8192), 16, 0, 0); } while (0)
#define PG8_LDA(dst, b, h) do { _Pragma("unroll") for (int m = 0; m < 4; ++m) _Pragma("unroll") for (int k = 0; k < 2; ++k) dst[m][k] = *(const LAS bf16x8*)(lds + PG8_SA(b, h) + aoff + m * 2048 + k * 1024); } while (0)
#define PG8_LDB(dst, b, h) do { _Pragma("unroll") for (int n = 0; n < 2; ++n) _Pragma("unroll") for (int k = 0; k < 2; ++k) dst[n][k] = *(const LAS bf16x8*)(lds + PG8_SB(b, h) + boff + n * 2048 + k * 1024); } while (0)
#define PG8_MMA(ai, bj, At_, Bt_) do { __builtin_amdgcn_s_setprio(1); _Pragma("unroll") for (int m = 0; m < 4; ++m) _Pragma("unroll") for (int n = 0; n < 2; ++n) _Pragma("unroll") for (int k = 0; k < 2; ++k) \
        acc[ai][bj][m][n] = __builtin_amdgcn_mfma_f32_16x16x32_bf16(Bt_[n][k], At_[m][k], acc[ai][bj][m][n], 0, 0, 0); __builtin_amdgcn_s_setprio(0); } while (0)
#define PG8_WAIT_V(n) asm volatile("s_waitcnt vmcnt(" #n ")" ::: "memory")
#define PG8_WAIT_L(n) asm volatile("s_waitcnt lgkmcnt(" #n ")" ::: "memory")
#define PG8_BAR __builtin_amdgcn_s_barrier()
#define PG8_SCHED __builtin_amdgcn_sched_barrier(0)
  G8Unit cur, nxt; int ui = 0;
  if (c >= nunits) return;
  g8::unit_of(c, nM, nN, cur.pm, cur.pn);
  f32x4 acc[2][2][4][2];
#pragma unroll
  for (int a = 0; a < 2; ++a)
#pragma unroll
    for (int b = 0; b < 2; ++b)
#pragma unroll
      for (int m = 0; m < 4; ++m)
#pragma unroll
        for (int n = 0; n < 2; ++n) acc[a][b][m][n] = (f32x4){0.f, 0.f, 0.f, 0.f};
  bf16x8 At[4][2], B0[2][2], B1[2][2];
  const char* cA = (const char*)Ag + (size_t)cur.pm * tstepA + (size_t)((cur.pn < pn_split ? acol0 : acol1) + (cur.pn / pn_mod) * ksplit_cols) * 2;
  const char* cB = (const char*)Btg + (size_t)(cur.pn % pn_mod) * tstep + (size_t)((cur.pn / pn_mod) * ksplit_cols) * 2;
  PG8_STAGE(PG8_SB(0, 0), cB, voffB); PG8_STAGE(PG8_SA(0, 0), cA, voffA); PG8_STAGE(PG8_SB(0, 1), cB + hstep, voffB); PG8_STAGE(PG8_SA(0, 1), cA + hstepA, voffA);
  if (wr == 1) PG8_BAR;
  PG8_WAIT_V(4); PG8_BAR;
  PG8_STAGE(PG8_SB(1, 0), cB + kstep, voffB); PG8_STAGE(PG8_SA(1, 0), cA + kstep, voffA); PG8_STAGE(PG8_SB(1, 1), cB + hstep + kstep, voffB);
  PG8_WAIT_V(6); PG8_BAR;
  for (;;) {
    const long Ln = (long)(ui + 1) * G + c;
    const bool has_next = Ln < nunits;
    if (has_next) g8::unit_of((int)Ln, nM, nN, nxt.pm, nxt.pn);
    const char* nA = has_next ? (const char*)Ag + (size_t)nxt.pm * tstepA + (size_t)((nxt.pn < pn_split ? acol0 : acol1) + (nxt.pn / pn_mod) * ksplit_cols) * 2 : cA;
    const char* nB = has_next ? (const char*)Btg + (size_t)(nxt.pn % pn_mod) * tstep + (size_t)((nxt.pn / pn_mod) * ksplit_cols) * 2 : cB;
    for (int t = 0; t < nt; t += 2) {
      const bool last = (t == nt - 2);
      const char* a1 = cA + (size_t)(t + 1) * kstep;
      const char* a2 = last ? nA : cA + (size_t)(t + 2) * kstep; const char* b2 = last ? nB : cB + (size_t)(t + 2) * kstep;
      const char* a3 = a2 + kstep; const char* b3 = b2 + kstep;
      PG8_LDB(B0, 0, 0); PG8_SCHED; PG8_LDA(At, 0, 0); PG8_STAGE(PG8_SA(1, 1), a1 + hstepA, voffA);
      PG8_WAIT_L(8); PG8_BAR; PG8_WAIT_L(0); PG8_MMA(0, 0, At, B0); PG8_BAR; PG8_SCHED;
      PG8_LDB(B1, 0, 1); PG8_STAGE(PG8_SB(0, 0), b2, voffB);
      PG8_BAR; PG8_WAIT_L(0); PG8_MMA(0, 1, At, B1); PG8_BAR;
      PG8_LDA(At, 0, 1); PG8_STAGE(PG8_SA(0, 0), a2, voffA);
      PG8_BAR; PG8_WAIT_L(0); PG8_MMA(1, 0, At, B0); PG8_BAR; PG8_SCHED;
      PG8_STAGE(PG8_SB(0, 1), b2 + hstep, voffB);
      PG8_WAIT_V(6); PG8_BAR; PG8_MMA(1, 1, At, B1); PG8_BAR;
      PG8_LDB(B0, 1, 0); PG8_SCHED; PG8_LDA(At, 1, 0); PG8_STAGE(PG8_SA(0, 1), a2 + hstepA, voffA);
      PG8_WAIT_L(8); PG8_BAR; PG8_WAIT_L(0); PG8_MMA(0, 0, At, B0); PG8_BAR; PG8_SCHED;
      PG8_LDB(B1, 1, 1); PG8_STAGE(PG8_SB(1, 0), b3, voffB);
      PG8_BAR; PG8_WAIT_L(0); PG8_MMA(0, 1, At, B1); PG8_BAR;
      PG8_LDA(At, 1, 1); PG8_STAGE(PG8_SA(1, 0), a3, voffA);
      PG8_BAR; PG8_WAIT_L(0); PG8_MMA(1, 0, At, B0); PG8_BAR; PG8_SCHED;
      PG8_STAGE(PG8_SB(1, 1), b3 + hstep, voffB);
      PG8_WAIT_V(6); PG8_BAR; PG8_MMA(1, 1, At, B1); PG8_BAR;
    }
    E(acc, cur, wr, wc, fr, fq);
    if (!has_next) break;
#pragma unroll
    for (int a = 0; a < 2; ++a)
#pragma unroll
      for (int b = 0; b < 2; ++b)
#pragma unroll
        for (int m = 0; m < 4; ++m)
#pragma unroll
          for (int n = 0; n < 2; ++n) acc[a][b][m][n] = (f32x4){0.f, 0.f, 0.f, 0.f};
    cur = nxt; cA = nA; cB = nB; ++ui;
  }
  PG8_WAIT_V(0);
  if (wr == 0) PG8_BAR;
  PG8_BAR;
#undef PG8_SA
#undef PG8_SB
#undef PG8_STAGE
#undef PG8_LDA
#undef PG8_LDB
#undef PG8_MMA
}

struct EpiZ {
  bf16* Z;
  DEVI void operator()(const f32x4 (&acc)[2][2][4][2], const G8Unit& u, int wr, int wc, int fr, int fq) const {
    const int brow = u.pm * 256, bcol = u.pn * 256;
#pragma unroll
    for (int ai = 0; ai < 2; ++ai)
#pragma unroll
      for (int m = 0; m < 4; ++m) {
        const int row = brow + ai * 128 + wr * 64 + m * 16 + fr;
#pragma unroll
        for (int bj = 0; bj < 2; ++bj) {
          const int col = bcol + bj * 128 + wc * 32 + 8 * fq;
          if (col < DIN) {
            const f32x4 v0 = acc[ai][bj][m][0], v1 = acc[ai][bj][m][1];
            *reinterpret_cast<uint4*>(Z + (size_t)row * DIN + col) = make_uint4(pack2(v0[0], v0[1]), pack2(v0[2], v0[3]), pack2(v1[0], v1[1]), pack2(v1[2], v1[3]));
          }
        }
      }
  }
};
DEVI void phase_gemm1_8(const Params& P, int l, unsigned char* smem_base) {
  EpiZ E{P.Z};
  gemm8_phase((LAS unsigned char*)smem_base, P.H, P.WinT + (size_t)l * DINP * 1024, 1024, NT / 256, DINP / 256, E);
  const int c = blockIdx.x;
  if (c >= 136) {
    const int j = c - 136;
    if (l == 0) convert_rows_fp6(P, 0, j * 100, j * 100 + 100);
    else { const int b0 = 19200 + j * 114; convert_rows_fp6(P, 1, b0 < 32768 ? b0 : 32768, b0 + 114 < 32768 ? b0 + 114 : 32768); }
  }
}

struct EpiRAW {
  bf16* R;
  DEVI void operator()(const f32x4 (&acc)[2][2][4][2], const G8Unit& u, int wr, int wc, int fr, int fq) const {
    const int brow = u.pm * 256, bcol = u.pn * 256;
#pragma unroll
    for (int ai = 0; ai < 2; ++ai)
#pragma unroll
      for (int m = 0; m < 4; ++m) {
        const int row = brow + ai * 128 + wr * 64 + m * 16 + fr;
#pragma unroll
        for (int bj = 0; bj < 2; ++bj) {
          const int col = bcol + bj * 128 + wc * 32 + 8 * fq;
          const f32x4 v0 = acc[ai][bj][m][0], v1 = acc[ai][bj][m][1];
          *reinterpret_cast<uint4*>(R + (size_t)row * 1792 + col) = make_uint4(pack2(v0[0], v0[1]), pack2(v0[2], v0[3]), pack2(v1[0], v1[1]), pack2(v1[2], v1[3]));
        }
      }
  }
};
DEVI void phase_mla_raw(const Params& P, int l, unsigned char* smem_base) {
  {
    const int lane = threadIdx.x & 63;
    for (int t = blockIdx.x * 8 + (threadIdx.x >> 6); t < NT; t += gridDim.x * 8) {
      const bf16* zr = P.Z + (size_t)t * DIN;
      const uint2 uq = *reinterpret_cast<const uint2*>(zr + ZC_BQ + lane * 4);
      const unsigned uk = *reinterpret_cast<const unsigned*>(zr + ZC_BKV + lane * 2);
      float sq = lo2f(uq.x) * lo2f(uq.x) + hi2f(uq.x) * hi2f(uq.x) + lo2f(uq.y) * lo2f(uq.y) + hi2f(uq.y) * hi2f(uq.y);
      float sk = lo2f(uk) * lo2f(uk) + hi2f(uk) * hi2f(uk);
      sq = wave_sum(sq); sk = wave_sum(sk);
      if (lane == 0) { P.RS[(size_t)t * 2] = rsqrtf(sq * (1.f / 256.f) + EPS); P.RS[(size_t)t * 2 + 1] = rsqrtf(sk * (1.f / 128.f) + EPS); }
    }
  }
  EpiRAW E{P.RAW};
  gemm8_phase((LAS unsigned char*)smem_base, P.Z, P.WCOMB + (size_t)l * 1792 * 256, 256, NT / 256, 7, E, DIN, 3, ZC_BQ, ZC_BKV);
}

struct EpiX {
  const float* x; const float* ctx; bf16* X; const float* MODl; int l;
  DEVI void operator()(const f32x4 (&acc)[2][2][4][2], const G8Unit& u, int wr, int wc, int fr, int fq) const {
    const int brow = u.pm * 256, bcol = u.pn * 256;
    const float* gate = MODl + (size_t)batch_of_row(brow) * 6144 + 2048;
#pragma unroll
    for (int ai = 0; ai < 2; ++ai)
#pragma unroll
      for (int m = 0; m < 4; ++m) {
        const int row = brow + ai * 128 + wr * 64 + m * 16 + fr;
        const float* res = row < NL ? x + (size_t)row * 1024 : ctx + (size_t)(row - NL) * 1024;
#pragma unroll
        for (int bj = 0; bj < 2; ++bj) {
          const int col = bcol + bj * 128 + wc * 32 + 8 * fq;
          const f32x4 v0 = acc[ai][bj][m][0], v1 = acc[ai][bj][m][1];
          float4 ra, rb;
          if (l == 0) { ra = *reinterpret_cast<const float4*>(res + col); rb = *reinterpret_cast<const float4*>(res + col + 4); }
          else {
            const uint4 uu = *reinterpret_cast<const uint4*>(X + (size_t)row * 1024 + col);
            ra = make_float4(lo2f(uu.x), hi2f(uu.x), lo2f(uu.y), hi2f(uu.y)); rb = make_float4(lo2f(uu.z), hi2f(uu.z), lo2f(uu.w), hi2f(uu.w));
          }
          const float4 ga = *reinterpret_cast<const float4*>(gate + col), gb = *reinterpret_cast<const float4*>(gate + col + 4);
          *reinterpret_cast<uint4*>(X + (size_t)row * 1024 + col) =
              make_uint4(pack2(ra.x + ga.x * v0[0], ra.y + ga.y * v0[1]), pack2(ra.z + ga.z * v0[2], ra.w + ga.w * v0[3]),
                         pack2(rb.x + gb.x * v1[0], rb.y + gb.y * v1[1]), pack2(rb.z + gb.z * v1[2], rb.w + gb.w * v1[3]));
        }
      }
  }
};
struct EpiPart {
  float* PART;
  DEVI void operator()(const f32x4 (&acc)[2][2][4][2], const G8Unit& u, int wr, int wc, int fr, int fq) const {
    const int brow = u.pm * 256, bcol = (u.pn & 3) * 256;
    float* base = PART + (size_t)(u.pn >> 2) * 2048 * 1024;
#pragma unroll
    for (int ai = 0; ai < 2; ++ai)
#pragma unroll
      for (int m = 0; m < 4; ++m) {
        const int row = brow + ai * 128 + wr * 64 + m * 16 + fr;
#pragma unroll
        for (int bj = 0; bj < 2; ++bj) {
          const int col = bcol + bj * 128 + wc * 32 + 8 * fq;
          const f32x4 v0 = acc[ai][bj][m][0], v1 = acc[ai][bj][m][1];
          *reinterpret_cast<float4*>(base + (size_t)row * 1024 + col) = make_float4(v0[0], v0[1], v0[2], v0[3]);
          *reinterpret_cast<float4*>(base + (size_t)row * 1024 + col + 4) = make_float4(v1[0], v1[1], v1[2], v1[3]);
        }
      }
  }
};
DEVI void phase_gemm2_8(const Params& P, int l, unsigned char* smem_base) {
  EpiX E{P.x, P.ctx, P.X, P.MOD + (size_t)l * 9 * 6144, l};
  gemm8_phase((LAS unsigned char*)smem_base, P.H, P.WoutT + (size_t)l * 1024 * 1024, 1024, NL / 256, 4, E);
  if (l == 0) {
    EpiPart EP{P.PART};
    gemm8_phase((LAS unsigned char*)smem_base, P.H + (size_t)NL * 1024, P.WoutT, 512, 8, 8, EP, 1024, 1 << 30, 0, 0, 1024, 4, 512);
    const int c = blockIdx.x;
    if (c >= 64) {
      const int b0 = 12000 + (c - 64) * 109;
      convert_rows_fp6(P, 0, b0 < 32768 ? b0 : 32768, b0 + 109 < 32768 ? b0 + 109 : 32768);
    }
  }
}

struct EpiQP {
  bf16* QP;
  DEVI void operator()(const f32x4 (&acc)[2][2][4][2], const G8Unit& u, int wr, int wc, int fr, int fq) const {
    const int brow = u.pm * 256, bcol = u.pn * 256;
#pragma unroll
    for (int ai = 0; ai < 2; ++ai)
#pragma unroll
      for (int m = 0; m < 4; ++m) {
        const int row = brow + ai * 128 + wr * 64 + m * 16 + fr;
#pragma unroll
        for (int bj = 0; bj < 2; ++bj) {
          const int col = bcol + bj * 128 + wc * 32 + 8 * fq;
          const f32x4 v0 = acc[ai][bj][m][0], v1 = acc[ai][bj][m][1];
          *reinterpret_cast<uint4*>(QP + (size_t)row * 2048 + col) = make_uint4(pack2(v0[0], v0[1]), pack2(v0[2], v0[3]), pack2(v1[0], v1[1]), pack2(v1[2], v1[3]));
        }
      }
  }
};
DEVI void phase_gemm3_8(const Params& P, int l, unsigned char* smem_base) {
  EpiQP E{P.QP};
  gemm8_phase((LAS unsigned char*)smem_base, P.H, P.WpqT + (size_t)l * 2048 * 1024, 1024, (l == 1) ? NL / 256 : NT / 256, 8, E);
  const int c = blockIdx.x;
  if (l == 0 && c >= 64) convert_rows_fp6(P, 1, (c - 64) * 100, (c - 64) * 100 + 100);
}

constexpr int N_PHASES = 2 + 2 * 11;

#ifndef REP_MASK
#define REP_MASK 0
#endif
static_assert(sizeof(Params) % 8 == 0, "Params size");
DEVI Params load_params() {
#if defined(__HIP_DEVICE_COMPILE__)
  typedef const __attribute__((address_space(4))) Params* ParamsCP;
  ParamsCP pp = (ParamsCP)__builtin_amdgcn_kernarg_segment_ptr();
  asm volatile("" : "+s"(pp));
  return *pp;
#else
  return Params{};
#endif
}
__global__ void __launch_bounds__(512, 2) fwd_kernel(Params Pk) {
  extern __shared__ __attribute__((aligned(16))) unsigned char smem_base[];
  volatile LAS unsigned* xst = (volatile LAS unsigned*)(smem_base + SMEM_BYTES);
  if (threadIdx.x == 0) { xst[0] = 0u; xst[1] = 0u; xst[2] = 0u; xst[3] = 0u; }
  __syncthreads();
  XcdBarrier xb = xcd_barrier_post(Pk.bar, xst);
  const int phase_lo = Pk.phase_lo, phase_hi = Pk.phase_hi, coop = Pk.coop;
#define smem (smem_base + VHALF * HALF_LDS)
#define GSYNC(idx) { xcd_barrier(xb); }
#define RUN_PHASE2(idx, call, repcall) \
  if (phase_lo <= (idx) && (idx) <= phase_hi) { { const Params P = load_params(); call; } if (REP_MASK & (1 << (idx))) { GSYNC(1); const Params P = load_params(); repcall; } if (coop && (idx) < phase_hi) GSYNC(idx); }
#define RUN_PHASE(idx, call) RUN_PHASE2(idx, call, call)
  RUN_PHASE(0, phase_prologue(P, smem))
  RUN_PHASE(1, phase_norm(P, 0, 0, NT))
  RUN_PHASE(2, phase_gemm1_8(P, 0, smem_base))
  RUN_PHASE(3, phase_mla_raw(P, 0, smem_base))
  RUN_PHASE(4, { phase_mixA(P, 0, smem); phase_mla_proj(P, 0, smem); phase_hgrn_local(P, 0, smem); })
  RUN_PHASE2(5, phase_attn_scan(P, 0, smem_base), phase_attn_scan(P, 0, smem_base, true))
  RUN_PHASE(6, phase_hgrn_final(P, 0, smem))
  RUN_PHASE(7, phase_gemm2_8(P, 0, smem_base))
  RUN_PHASE(8, phase_norm(P, 0, 1, NT))
  RUN_PHASE(9, phase_gemm3_8(P, 0, smem_base))
  RUN_PHASE(10, phase_route(P, 0, smem))
  RUN_PHASE(11, phase_peer_u(P, 0))
  RUN_PHASE(12, phase_peer(P, 0))
  RUN_PHASE(13, phase_gemm1_8(P, 1, smem_base))
  RUN_PHASE(14, phase_mla_raw(P, 1, smem_base))
  RUN_PHASE(15, { phase_mixA(P, 1, smem); phase_mla_proj(P, 1, smem); phase_hgrn_local(P, 1, smem); })
  RUN_PHASE2(16, phase_attn_scan(P, 1, smem_base), phase_attn_scan(P, 1, smem_base, true))
  RUN_PHASE(17, phase_hgrn_final(P, 1, smem))
  RUN_PHASE(18, phase_gemm2_8(P, 1, smem_base))
  RUN_PHASE(19, phase_norm(P, 1, 1, NL))
  RUN_PHASE(20, phase_gemm3_8(P, 1, smem_base))
  RUN_PHASE(21, phase_route(P, 1, smem))
  RUN_PHASE(22, phase_peer_u(P, 1))
  RUN_PHASE(23, phase_peer(P, 1))
#undef smem
}

extern "C" void kernel_launch(void* const* d_in, const int* in_sizes, int n_in, void* d_out, int out_size, void* d_ws,
                              size_t ws_size, hipStream_t stream) {
  Params p{};
  const float* const* in = reinterpret_cast<const float* const*>(d_in);
  p.x = in[0]; p.c = in[1]; p.ctx = in[2]; p.c_ctx = in[3]; p.ln1_w = in[4]; p.ln2_w = in[5]; p.w_mod = in[6]; p.b_mod = in[7];
  p.w_in = in[8]; p.w_out = in[9]; p.a_norm_w = in[10]; p.a_w_s = in[11]; p.a_b_s = in[12]; p.b_q_norm_w = in[13]; p.b_w_uq = in[14];
  p.b_kv_norm_w = in[15]; p.b_w_ukv = in[16]; p.b_qh_w = in[17]; p.b_kh_w = in[18]; p.c_lb = in[19]; p.c_out_norm_w = in[20];
  p.p_w_q = in[21]; p.p_sub_keys = in[22]; p.p_u = in[23]; p.p_v = in[24];
  p.out = reinterpret_cast<float*>(d_out);
  unsigned char* ws = reinterpret_cast<unsigned char*>(d_ws);
  size_t off = 0;
  auto take = [&](size_t bytes) { unsigned char* r = ws + off; off += (bytes + 255) & ~(size_t)255; return r; };
  p.bar = (unsigned*)take((size_t)XCD_BAR_WORDS * 4);
  p.MOD = (float*)take((size_t)2 * 9 * 6144 * 4);
  p.ROPE = (float*)take((size_t)2048 * 32 * 4);
  p.WinT = (bf16*)take((size_t)2 * DINP * 1024 * 2);
  p.WoutT = (bf16*)take((size_t)2 * 1024 * 1024 * 2);
  p.WpqT = (bf16*)take((size_t)2 * 2048 * 1024 * 2);
  p.WCOMB = (bf16*)take((size_t)2 * 1792 * 256 * 2);
  p.RAW = (bf16*)take((size_t)NT * 1792 * 2);
  p.SK = (bf16*)take((size_t)2 * 16 * 128 * 128 * 2);
  p.AWS = (bf16*)take((size_t)2 * 4 * 128 * 128 * 2);
  p.PU8 = (unsigned char*)take((size_t)2 * 16384 * 576);
  p.PV8 = (unsigned char*)take((size_t)2 * 16384 * 576);
  p.PUS = (float*)take((size_t)2 * 16384 * 4);
  p.PVS = (float*)take((size_t)2 * 16384 * 4);
  p.X = (bf16*)take((size_t)NT * 1024 * 2);
  p.H = (bf16*)take((size_t)NT * 1024 * 2);
  p.Z = (bf16*)take((size_t)NT * DIN * 2);
  p.Q = (bf16*)take((size_t)64 * SEQP * 96 * 2);
  p.K = (bf16*)take((size_t)64 * SEQP * 96 * 2);
  p.VT = (bf16*)take((size_t)64 * 64 * SEQP * 2);
  p.ST = (bf16*)take((size_t)64 * 36 * 4096 * 2);
  p.DEC = (float*)take((size_t)64 * 36 * 64 * 4);
  p.OI = (bf16*)take((size_t)NT * 256 * 2);
  p.WPE = (float*)take((size_t)NT * 128 * 4);
  p.PART = (float*)take((size_t)2 * 2048 * 1024 * 4);
  p.RS = (float*)take((size_t)NT * 2 * 4);
  p.GQF = (bf16*)take((size_t)NT * 256 * 2);
  p.GQB = (bf16*)take((size_t)NT * 256 * 2);
  p.QP = p.Z;
  p.EIDX = (int*)p.Q;
  p.GATE = (float*)p.K;
  if (off > ws_size) { fprintf(stderr, "workspace too small: need %zu have %zu\n", off, ws_size); }
  static int grid_blocks = 0;
  if (!grid_blocks) {
    if (hipFuncSetAttribute((const void*)fwd_kernel, hipFuncAttributeMaxDynamicSharedMemorySize, SMEM_TOTAL) != hipSuccess)
      fprintf(stderr, "hipFuncSetAttribute failed\n");
    int dev = 0, cus = 0, per_cu = 0;
    hipGetDevice(&dev);
    hipDeviceGetAttribute(&cus, hipDeviceAttributeMultiprocessorCount, dev);
    hipOccupancyMaxActiveBlocksPerMultiprocessor(&per_cu, (const void*)fwd_kernel, 512, SMEM_TOTAL);
    if (per_cu > 1) per_cu = 1;
    if (per_cu < 1) { fprintf(stderr, "occupancy query returned %d\n", per_cu); per_cu = 1; }
    grid_blocks = cus * per_cu;
    fprintf(stderr, "grid_blocks=%d (cus=%d per_cu=%d) ws need=%zu have=%zu\n", grid_blocks, cus, per_cu, off, ws_size);
  }
  hipMemsetAsync(p.bar, 0, (size_t)XCD_BAR_WORDS * 4, stream);
  p.coop = 1; p.phase_lo = 0; p.phase_hi = N_PHASES - 1;
  hipLaunchKernelGGL(fwd_kernel, dim3(grid_blocks), dim3(512), SMEM_TOTAL, stream, p);
  const hipError_t e = hipPeekAtLastError();
  if (e != hipSuccess) fprintf(stderr, "launch failed: %s (grid %d)\n", hipGetErrorString(e), grid_blocks);
}
```

```cpp
#include <hip/hip_runtime.h>
#include <hip/hip_cooperative_groups.h>
#include <cstdio>
#include <cstdint>
namespace cg = cooperative_groups;

#define DEVI __device__ __forceinline__

typedef unsigned short bf16;
using bf16x8 = __attribute__((ext_vector_type(8))) __bf16;
using bf16x2 = __attribute__((ext_vector_type(2))) __bf16;
using f32x16 = __attribute__((ext_vector_type(16))) float;
typedef unsigned v6u __attribute__((ext_vector_type(6)));
typedef unsigned v3u __attribute__((ext_vector_type(3)));
typedef float v16f __attribute__((ext_vector_type(16)));
typedef float v32f __attribute__((ext_vector_type(32)));

constexpr int NL = 16384;
constexpr int NT = 18432;
constexpr int DM = 1024;
constexpr int DIN = 2208;
constexpr int DINP = 2304;
constexpr int SEQP = 2304;
constexpr float EPS = 1e-6f;
constexpr int ZC_AU = 0, ZC_AV = 256, ZC_BQ = 512, ZC_BKV = 768, ZC_BKR = 896, ZC_CQ = 928, ZC_CFF = 1184, ZC_CFB = 1440, ZC_CI = 1696, ZC_CG = 1952;
constexpr int SMEM_BYTES = 2 * 80896;
constexpr int SMEM_TOTAL = SMEM_BYTES + 16;

struct Params {
  const float *x, *c, *ctx, *c_ctx, *ln1_w, *ln2_w, *w_mod, *b_mod, *w_in, *w_out, *a_norm_w, *a_w_s, *a_b_s;
  const float *b_q_norm_w, *b_w_uq, *b_kv_norm_w, *b_w_ukv, *b_qh_w, *b_kh_w, *c_lb, *c_out_norm_w, *p_w_q, *p_sub_keys, *p_u, *p_v;
  float* out;
  unsigned* bar;
  float* MOD;
  float* ROPE;
  bf16* WinT;
  bf16* WoutT;
  bf16* WpqT;
  bf16* WCOMB;
  bf16* RAW;
  bf16* SK;
  bf16* AWS;
  unsigned char* PU8;
  unsigned char* PV8;
  float* PUS;
  float* PVS;
  bf16* X;
  bf16* H;
  bf16* Z;
  bf16* Q;
  bf16* K;
  bf16* VT;
  bf16* ST;
  float* DEC;
  bf16* OI;
  float* WPE;
  float* RS;
  float* PART;
  bf16* GQF;
  bf16* GQB;
  bf16* QP;
  int* EIDX;
  float* GATE;
  int phase_lo, phase_hi, coop, pad0;
};

DEVI float bf2f(bf16 v) { return __uint_as_float(((unsigned)v) << 16); }
DEVI bf16 f2bf(float a) { __bf16 v = (__bf16)a; return __builtin_bit_cast(unsigned short, v); }
DEVI unsigned pack2(float a, float b) { bf16x2 v; v[0] = (__bf16)a; v[1] = (__bf16)b; return __builtin_bit_cast(unsigned, v); }
DEVI float lo2f(unsigned u) { return __uint_as_float(u << 16); }
DEVI float hi2f(unsigned u) { return __uint_as_float(u & 0xffff0000u); }
DEVI f32x16 zero16() { f32x16 z;
#pragma unroll
  for (int i = 0; i < 16; ++i) z[i] = 0.f; return z; }
DEVI f32x16 mfma32(bf16x8 a, bf16x8 b, f32x16 c) { return __builtin_amdgcn_mfma_f32_32x32x16_bf16(a, b, c, 0, 0, 0); }
DEVI bf16x8 ldfrag(const bf16* p) { return *reinterpret_cast<const bf16x8*>(p); }
DEVI int drow(int r, int hh) { return (r & 3) + 8 * (r >> 2) + 4 * hh; }
DEVI int row_of(int b, int p) { return p < 256 ? NL + b * 256 + p : b * 2048 + (p - 256); }
DEVI int batch_of_row(int r) { return r < NL ? (r >> 11) : 8; }
DEVI float wave_sum(float v) {
#pragma unroll
  for (int o = 32; o > 0; o >>= 1) v += __shfl_xor(v, o);
  return v;
}
DEVI float sigmoidf_(float z) { return 1.f / (1.f + __expf(-z)); }


#define XB_TMO      128
#define XB_XCNT(j)  (256  + 64 * (j))
#define XB_XSUB(j)  (1280 + 64 * (j))
#define XB_XGEN(j)  (2304 + 64 * (j))
#define XB_TOP      3328
#define XB_TOPGEN   3392
#define XCD_BAR_WORDS 3456
#define XB_SPIN_CAP (1u << 22)
#define LAS __attribute__((address_space(3)))
DEVI unsigned xb_ld(unsigned* p)              { return __hip_atomic_load(p, __ATOMIC_RELAXED, __HIP_MEMORY_SCOPE_AGENT); }
DEVI unsigned xb_add(unsigned* p, unsigned v) { return __hip_atomic_fetch_add(p, v, __ATOMIC_RELAXED, __HIP_MEMORY_SCOPE_AGENT); }
DEVI unsigned xb_xcc_id() { return (unsigned)__builtin_amdgcn_s_getreg((3 << 11) | 20) & 0xFu; }
#define XB_SPIN(cond, bar) do { unsigned _sp = 0; while (cond) { __builtin_amdgcn_s_sleep(1); \
    if ((++_sp & 255u) == 0u) { if (xb_ld(&(bar)[XB_TMO])) break; if (_sp > XB_SPIN_CAP) { atomicAdd(&(bar)[XB_TMO], 1u); break; } } } } while (0)
struct XcdBarrier { unsigned* bar; unsigned x; volatile LAS unsigned* st; };
DEVI XcdBarrier xcd_barrier_post(unsigned* bar, volatile LAS unsigned* st) {
  XcdBarrier b; b.bar = bar; b.x = xb_xcc_id(); b.st = st;
  if (threadIdx.x == 0) (void)xb_add(&bar[XB_XCNT(b.x)], 1u);
  return b;
}
DEVI void xcd_barrier_complete(unsigned* bar, unsigned x, unsigned& nloc, unsigned& nx) {
  const unsigned G = gridDim.x * gridDim.y * gridDim.z;
  unsigned sum, cnt, mine, sp = 0u;
  for (;;) {
    sum = 0u; cnt = 0u; mine = 0u;
#pragma unroll
    for (unsigned j = 0; j < 16; ++j) { const unsigned c = xb_ld(&bar[XB_XCNT(j)]); sum += c; cnt += (c > 0u) ? 1u : 0u; mine = (j == x) ? c : mine; }
    if (sum == G) break;
    __builtin_amdgcn_s_sleep(1);
    if ((++sp & 255u) == 0u) { if (xb_ld(&bar[XB_TMO])) break; if (sp > XB_SPIN_CAP) { atomicAdd(&bar[XB_TMO], 1u); break; } }
  }
  nloc = mine > 0u ? mine : 1u; nx = cnt > 0u ? cnt : 1u;
}
DEVI void xcd_barrier(const XcdBarrier& b) {
  asm volatile("s_waitcnt vmcnt(0)" ::: "memory");
  __syncthreads();
  if (threadIdx.x == 0) {
    unsigned* bar = b.bar;
    __builtin_amdgcn_s_waitcnt(0);
    unsigned nloc = b.st[0], nx = b.st[1];
    if (nloc == 0u) { xcd_barrier_complete(bar, b.x, nloc, nx); b.st[0] = nloc; b.st[1] = nx; }
    const unsigned old = xb_add(&bar[XB_XSUB(b.x)], 1u);
    const unsigned gen = old / nloc;
    if (old + 1u == (gen + 1u) * nloc) {
      __builtin_amdgcn_fence(__ATOMIC_RELEASE, "agent");
      asm volatile("s_waitcnt vmcnt(0)" ::: "memory");
      const unsigned og = xb_add(&bar[XB_TOP], 1u);
      const unsigned tg = og / nx;
      if (og + 1u == (tg + 1u) * nx) xb_add(&bar[XB_TOPGEN], 1u);
      else XB_SPIN(xb_ld(&bar[XB_TOPGEN]) == tg, bar);
      __builtin_amdgcn_fence(__ATOMIC_ACQUIRE, "agent");
      xb_add(&bar[XB_XGEN(b.x)], 1u);
      asm volatile("s_waitcnt vmcnt(0)" ::: "memory");
    } else {
      XB_SPIN(xb_ld(&bar[XB_XGEN(b.x)]) == gen, bar);
      __builtin_amdgcn_fence(__ATOMIC_ACQUIRE, "agent");
      asm volatile("s_waitcnt vmcnt(0)" ::: "memory");
    }
  }
  __syncthreads();
}

#define VHALF ((int)__builtin_amdgcn_readfirstlane((int)(threadIdx.x >> 8)))
#define TIDX ((int)(threadIdx.x & 255))
#define VBID ((int)(blockIdx.x * 2 + VHALF))
#define NVB ((int)(gridDim.x * 2))
constexpr int HALF_LDS = 80896;

DEVI void hb_sync() {
  extern __shared__ __attribute__((aligned(16))) unsigned char hb_smem[];
  LAS unsigned* cnt = (LAS unsigned*)(hb_smem + SMEM_BYTES) + 2 + VHALF;
  __builtin_amdgcn_fence(__ATOMIC_RELEASE, "workgroup");
  if ((threadIdx.x & 63) == 0) {
    const unsigned old = __hip_atomic_fetch_add(cnt, 1u, __ATOMIC_RELAXED, __HIP_MEMORY_SCOPE_WORKGROUP);
    const unsigned target = (old / 4u + 1u) * 4u;
    while (__hip_atomic_load(cnt, __ATOMIC_RELAXED, __HIP_MEMORY_SCOPE_WORKGROUP) < target) __builtin_amdgcn_s_sleep(0);
  }
  __builtin_amdgcn_fence(__ATOMIC_ACQUIRE, "workgroup");
}

DEVI void phase_mod(const Params& P, unsigned char* smem) {
  const int tid = TIDX;
  float* s = (float*)smem;
  float* red = s + 9 * 1024;
  for (int item = VBID; item < 192; item += NVB) {
    const int l = item / 96, j = item % 96;
    hb_sync();
    for (int i = tid; i < 9 * 1024; i += 256) {
      int bi = i >> 10, k = i & 1023;
      float v = bi < 8 ? P.c[bi * 1024 + k] : P.c_ctx[k];
      s[i] = v * sigmoidf_(v);
    }
    hb_sync();
    const int c4 = tid & 15, kg = tid >> 4;
    float acc[9][4];
#pragma unroll
    for (int bi = 0; bi < 9; ++bi) { acc[bi][0] = acc[bi][1] = acc[bi][2] = acc[bi][3] = 0.f; }
    const float* w = P.w_mod + (size_t)l * 1024 * 6144 + j * 64 + c4 * 4;
#pragma unroll 4
    for (int kk = 0; kk < 64; ++kk) {
      const int k = kg * 64 + kk;
      const float4 w4 = *reinterpret_cast<const float4*>(w + (size_t)k * 6144);
#pragma unroll
      for (int bi = 0; bi < 9; ++bi) {
        const float sv = s[bi * 1024 + k];
        acc[bi][0] += sv * w4.x; acc[bi][1] += sv * w4.y; acc[bi][2] += sv * w4.z; acc[bi][3] += sv * w4.w;
      }
    }
#pragma unroll
    for (int bi = 0; bi < 9; ++bi)
#pragma unroll
      for (int e = 0; e < 4; ++e) red[(kg * 9 + bi) * 64 + c4 * 4 + e] = acc[bi][e];
    hb_sync();
    for (int o = tid; o < 576; o += 256) {
      const int bi = o >> 6, cc = o & 63;
      float sum = 0.f;
#pragma unroll
      for (int g = 0; g < 16; ++g) sum += red[(g * 9 + bi) * 64 + cc];
      P.MOD[(size_t)(l * 9 + bi) * 6144 + j * 64 + cc] = sum + P.b_mod[l * 6144 + j * 64 + cc];
    }
  }
}

DEVI void conv_T_tile(const float* __restrict__ src, int N, bf16* __restrict__ dst, int Kd, int k0, int n0,
                      const float* __restrict__ kscale, float* tile) {
  const int tid = TIDX;
  hb_sync();
  for (int e = tid; e < 4096; e += 256) {
    const int i = e >> 6, j = e & 63, n = n0 + j;
    float v = (n < N) ? src[(size_t)(k0 + i) * N + n] : 0.f;
    if (kscale) v *= kscale[k0 + i];
    tile[i * 65 + j] = v;
  }
  hb_sync();
  for (int e = tid; e < 2048; e += 256) {
    const int j = e >> 5, i2 = (e & 31) * 2;
    const unsigned pk = pack2(tile[i2 * 65 + j], tile[(i2 + 1) * 65 + j]);
    *reinterpret_cast<unsigned*>(&dst[(size_t)(n0 + j) * Kd + k0 + i2]) = pk;
  }
}

DEVI void conv_straight(const float* __restrict__ src, bf16* __restrict__ dst, size_t n8) {
  const size_t stride = (size_t)NVB * 256;
  for (size_t i = (size_t)VBID * 256 + TIDX; i < n8; i += stride) {
    const float4 a = reinterpret_cast<const float4*>(src)[2 * i];
    const float4 b = reinterpret_cast<const float4*>(src)[2 * i + 1];
    uint4 o; o.x = pack2(a.x, a.y); o.y = pack2(a.z, a.w); o.z = pack2(b.x, b.y); o.w = pack2(b.z, b.w);
    reinterpret_cast<uint4*>(dst)[i] = o;
  }
}

DEVI void convert_rows_fp6(const Params& P, int L, int i0, int i1) {
  const int lane = threadIdx.x & 63, half = lane >> 5, l32 = lane & 31;
  const int wv = threadIdx.x >> 6;
  for (int ib = i0 + wv * 2; ib < i1; ib += 16) {
    int i = ib + half; const bool live = i < i1; if (!live) i = i1 - 1;
    const int table = i >> 14, lr = L * 16384 + (i & 16383);
    const float* src = (table ? P.p_v : P.p_u) + (size_t)lr * 1024 + l32 * 32;
    float4 a[8];
    float m = 0.f;
#pragma unroll
    for (int q = 0; q < 8; ++q) {
      a[q] = *reinterpret_cast<const float4*>(src + q * 4);
      m = fmaxf(m, fmaxf(fmaxf(fabsf(a[q].x), fabsf(a[q].y)), fmaxf(fabsf(a[q].z), fabsf(a[q].w))));
    }
    const unsigned sb = (__float_as_uint(fmaxf(m, 1e-30f) * (1.f / 6.f)) + 0xffffu) >> 16;
    const float inv = 1.f / __uint_as_float(sb << 16);
    unsigned pk[4];
#pragma unroll
    for (int w = 0; w < 4; ++w) {
      unsigned word = 0u;
#pragma unroll
      for (int e = 0; e < 8; ++e) {
        const int idx = w * 8 + e;
        const float4 q4 = a[idx >> 2];
        const float xv = ((idx & 3) == 0 ? q4.x : (idx & 3) == 1 ? q4.y : (idx & 3) == 2 ? q4.z : q4.w) * inv;
        const float av = fabsf(xv);
        unsigned ci = (av > 0.25f) + (av > 0.75f) + (av > 1.25f) + (av > 1.75f) + (av > 2.5f) + (av > 3.5f) + (av > 5.f);
        ci |= (xv < 0.f) ? 8u : 0u;
        word |= ci << (4 * e);
      }
      pk[w] = word;
    }
    unsigned char* rowp = (table ? P.PV8 : P.PU8) + (size_t)lr * 576;
    if (live) {
      *reinterpret_cast<uint4*>(rowp + l32 * 16) = make_uint4(pk[0], pk[1], pk[2], pk[3]);
      *reinterpret_cast<unsigned short*>(rowp + 512 + l32 * 2) = (unsigned short)sb;
    }
  }
}

DEVI void phase_prologue(const Params& P, unsigned char* smem) {
  phase_mod(P, smem);
  float* tile = (float*)smem;
  for (int it = VBID; it < 2 * 1424; it += NVB) {
    const int l = it / 1424; int r = it % 1424;
    if (r < 576) { conv_T_tile(P.w_in + (size_t)l * 1024 * DIN, DIN, P.WinT + (size_t)l * DINP * 1024, 1024, (r % 16) * 64, (r / 16) * 64, nullptr, tile); continue; }
    r -= 576;
    if (r < 256) { conv_T_tile(P.w_out + (size_t)l * 1024 * 1024, 1024, P.WoutT + (size_t)l * 1024 * 1024, 1024, (r % 16) * 64, (r / 16) * 64, nullptr, tile); continue; }
    r -= 256;
    if (r < 512) continue;
    r -= 512;
    if (r < 48) { conv_T_tile(P.b_w_uq + (size_t)l * 256 * 768, 768, P.WCOMB + (size_t)l * 1792 * 256, 256, (r % 4) * 64, (r / 4) * 64, P.b_q_norm_w + l * 256, tile); continue; }
    r -= 48;
    conv_T_tile(P.b_w_ukv + (size_t)l * 128 * 1024, 1024, P.WCOMB + (size_t)l * 1792 * 256 + 768 * 256, 256, (r % 2) * 64, (r / 2) * 64, P.b_kv_norm_w + l * 128, tile);
  }
  {
    const int tid = TIDX, lane = tid & 63, wave = tid >> 6, l31 = lane & 31, hh = lane >> 5;
    bf16* KA = reinterpret_cast<bf16*>(smem);
    bf16* WB = KA + 128 * 136;
    for (int it = VBID; it < 2 * 16 * 16; it += NVB) {
      const int kt = it & 15, hp = (it >> 4) & 15, l = it >> 8;
      hb_sync();
      {
        const float* keys = P.p_sub_keys + (size_t)(l * 16 + hp) * 128 * 128;
        for (int e = tid; e < 128 * 32; e += 256) {
          const int r = e >> 5, c4 = e & 31;
          const float4 v = *reinterpret_cast<const float4*>(keys + (size_t)r * 128 + c4 * 4);
          *reinterpret_cast<uint2*>(KA + r * 136 + c4 * 4) = make_uint2(pack2(v.x, v.y), pack2(v.z, v.w));
        }
        const float* wq = P.p_w_q + (size_t)l * 1024 * 2048 + (size_t)(kt * 64) * 2048 + hp * 128;
        for (int e = tid; e < 64 * 32; e += 256) {
          const int r = e >> 5, c4 = e & 31;
          const float4 v = *reinterpret_cast<const float4*>(wq + (size_t)r * 2048 + c4 * 4);
          *reinterpret_cast<uint2*>(WB + r * 136 + c4 * 4) = make_uint2(pack2(v.x, v.y), pack2(v.z, v.w));
        }
      }
      hb_sync();
      f32x16 acc[2]; acc[0] = zero16(); acc[1] = zero16();
#pragma unroll
      for (int ks = 0; ks < 8; ++ks) {
        const bf16x8 af = ldfrag(KA + (wave * 32 + l31) * 136 + ks * 16 + hh * 8);
#pragma unroll
        for (int j = 0; j < 2; ++j) {
          const bf16x8 bfr = ldfrag(WB + (j * 32 + l31) * 136 + ks * 16 + hh * 8);
          acc[j] = mfma32(af, bfr, acc[j]);
        }
      }
      bf16* dst = P.WpqT + (size_t)l * 2048 * 1024 + (size_t)(hp * 128 + wave * 32) * 1024 + kt * 64;
#pragma unroll
      for (int j = 0; j < 2; ++j)
#pragma unroll
        for (int r = 0; r < 16; ++r) dst[(size_t)drow(r, hh) * 1024 + j * 32 + l31] = f2bf(acc[j][r]);
    }
  }
  for (int i = VBID * 256 + TIDX; i < 2 * 1024 * 16; i += NVB * 256) {
    const int l2 = i >> 14, rr = (i >> 4) & 1023, cc = i & 15;
    *reinterpret_cast<uint4*>(P.WCOMB + (size_t)l2 * 1792 * 256 + (size_t)(768 + rr) * 256 + 128 + cc * 8) = make_uint4(0u, 0u, 0u, 0u);
  }
  conv_straight(P.a_w_s, P.AWS, (size_t)2 * 4 * 128 * 128 / 8);
  for (int i = VBID * 256 + TIDX; i < 2048 * 16; i += NVB * 256) {
    const int t = i >> 4, a = (i >> 3) & 1, f = i & 7;
    const float inv = powf(10000.f, -(float)f / 8.f);
    const float pos = a ? (float)(t & 63) : (float)(t >> 6);
    const float ang = pos * inv;
    P.ROPE[t * 32 + a * 8 + f] = cosf(ang);
    P.ROPE[t * 32 + 16 + a * 8 + f] = sinf(ang);
  }
}

DEVI void phase_norm(const Params& P, int l, int which, int nrows) {
  const int lane = TIDX & 63;
  const int gw = VBID * 4 + (TIDX >> 6), nw = NVB * 4;
  const float* lnw = (which == 0 ? P.ln1_w : P.ln2_w) + l * 1024;
  for (int r = gw; r < nrows; r += nw) {
    const float* mod = P.MOD + (size_t)(l * 9 + batch_of_row(r)) * 6144 + which * 3072;
    float4 v[4];
    float ss = 0.f;
    if (which == 0 && l == 0) {
      const float* src = r < NL ? P.x + (size_t)r * 1024 : P.ctx + (size_t)(r - NL) * 1024;
#pragma unroll
      for (int i = 0; i < 4; ++i) v[i] = *reinterpret_cast<const float4*>(src + i * 256 + lane * 4);
    } else if (which == 1 && l == 0 && r >= NL) {
      const float* cin = P.ctx + (size_t)(r - NL) * 1024;
      const float* p0 = P.PART + (size_t)(r - NL) * 1024;
      const float* p1 = p0 + (size_t)2048 * 1024;
      const float* gate = P.MOD + (size_t)8 * 6144 + 2048;
#pragma unroll
      for (int i = 0; i < 4; ++i) {
        const int d = i * 256 + lane * 4;
        const float4 c4 = *reinterpret_cast<const float4*>(cin + d), a4 = *reinterpret_cast<const float4*>(p0 + d), b4 = *reinterpret_cast<const float4*>(p1 + d);
        const float4 g4 = *reinterpret_cast<const float4*>(gate + d);
        v[i] = make_float4(c4.x + g4.x * (a4.x + b4.x), c4.y + g4.y * (a4.y + b4.y), c4.z + g4.z * (a4.z + b4.z), c4.w + g4.w * (a4.w + b4.w));
        *reinterpret_cast<uint2*>(P.X + (size_t)r * 1024 + d) = make_uint2(pack2(v[i].x, v[i].y), pack2(v[i].z, v[i].w));
      }
    } else {
      const bf16* src = P.X + (size_t)r * 1024;
#pragma unroll
      for (int i = 0; i < 4; ++i) {
        const uint2 u = *reinterpret_cast<const uint2*>(src + i * 256 + lane * 4);
        v[i] = make_float4(lo2f(u.x), hi2f(u.x), lo2f(u.y), hi2f(u.y));
      }
    }
#pragma unroll
    for (int i = 0; i < 4; ++i) ss += v[i].x * v[i].x + v[i].y * v[i].y + v[i].z * v[i].z + v[i].w * v[i].w;
    ss = wave_sum(ss);
    const float rr = rsqrtf(ss * (1.f / 1024.f) + EPS);
#pragma unroll
    for (int i = 0; i < 4; ++i) {
      const int d = i * 256 + lane * 4;
      const float4 w = *reinterpret_cast<const float4*>(lnw + d);
      const float4 sh = *reinterpret_cast<const float4*>(mod + d);
      const float4 sc = *reinterpret_cast<const float4*>(mod + 1024 + d);
      const float o0 = v[i].x * rr * w.x * (1.f + sc.x) + sh.x;
      const float o1 = v[i].y * rr * w.y * (1.f + sc.y) + sh.y;
      const float o2 = v[i].z * rr * w.z * (1.f + sc.z) + sh.z;
      const float o3 = v[i].w * rr * w.w * (1.f + sc.w) + sh.w;
      uint2 o; o.x = pack2(o0, o1); o.y = pack2(o2, o3);
      *reinterpret_cast<uint2*>(P.H + (size_t)r * 1024 + d) = o;
    }
  }
}

DEVI void phase_mixA(const Params& P, int l, unsigned char* smem) {
  const int tid = TIDX, lane = tid & 63, wave = tid >> 6, l31 = lane & 31, hh = lane >> 5;
  bf16* VNT = reinterpret_cast<bf16*>(smem);
  constexpr int LDV = 136;
  const int nseg = (l == 1) ? 16 : 18;
  const int seg0 = (l == 1) ? 2 : 0;
  for (int it = VBID; it < 8 * nseg * 4; it += NVB) {
    const int a = it & 3; const int sj = (it >> 2) % nseg + seg0; const int b = (it >> 2) / nseg;
    const int p0 = sj * 128;
    hb_sync();
    {
      const int q = tid >> 1, half = tid & 1;
      const int row = row_of(b, p0 + q);
      const bf16* src = P.Z + (size_t)row * DIN + ZC_AV + a * 64 + half * 32;
      float v[32];
      float ss = 0.f;
#pragma unroll
      for (int i = 0; i < 4; ++i) {
        const uint4 u = *reinterpret_cast<const uint4*>(src + i * 8);
        v[i * 8 + 0] = lo2f(u.x); v[i * 8 + 1] = hi2f(u.x); v[i * 8 + 2] = lo2f(u.y); v[i * 8 + 3] = hi2f(u.y);
        v[i * 8 + 4] = lo2f(u.z); v[i * 8 + 5] = hi2f(u.z); v[i * 8 + 6] = lo2f(u.w); v[i * 8 + 7] = hi2f(u.w);
      }
#pragma unroll
      for (int i = 0; i < 32; ++i) ss += v[i] * v[i];
      ss += __shfl_xor(ss, 1);
      const float rr = rsqrtf(ss * (1.f / 64.f) + EPS);
      const float* nw = P.a_norm_w + l * 256 + a * 64 + half * 32;
#pragma unroll
      for (int i = 0; i < 32; ++i) VNT[(half * 32 + i) * LDV + q] = f2bf(v[i] * rr * nw[i]);
    }
    hb_sync();
    f32x16 acc[2]; acc[0] = zero16(); acc[1] = zero16();
    const bf16* Aw = P.AWS + (size_t)(l * 4 + a) * 128 * 128 + (size_t)(wave * 32 + l31) * 128;
#pragma unroll
    for (int ks = 0; ks < 8; ++ks) {
      const bf16x8 af = ldfrag(Aw + ks * 16 + hh * 8);
#pragma unroll
      for (int j = 0; j < 2; ++j) {
        const bf16x8 bfr = ldfrag(VNT + (j * 32 + l31) * LDV + ks * 16 + hh * 8);
        acc[j] = mfma32(af, bfr, acc[j]);
      }
    }
    const float* bs = P.a_b_s + (l * 4 + a) * 128;
#pragma unroll
    for (int j = 0; j < 2; ++j)
#pragma unroll
      for (int r = 0; r < 16; ++r) {
        const int p = wave * 32 + drow(r, hh);
        const int row = row_of(b, p0 + p);
        const int col = a * 64 + j * 32 + l31;
        const float u = bf2f(P.Z[(size_t)row * DIN + ZC_AU + col]);
        P.H[(size_t)row * 1024 + col] = f2bf(u * (acc[j][r] + bs[p]));
      }
  }
}

DEVI void mla_norm_rope_store(const Params& P, const float* T, const float* nw, bool rope, float oscale,
                              bf16* dstbase  , int pos0, int tlat0) {
  const int tid = TIDX, tok = tid >> 1, half = tid & 1;
  float v[48];
  float ss = 0.f;
#pragma unroll
  for (int i = 0; i < 48; ++i) { v[i] = T[tok * 97 + half * 48 + i]; ss += v[i] * v[i]; }
  ss += __shfl_xor(ss, 1);
  const float rr = rsqrtf(ss * (1.f / 96.f) + EPS);
#pragma unroll
  for (int i = 0; i < 48; ++i) v[i] = v[i] * rr * nw[half * 48 + i];
  if (rope && half == 1) {
    const float* cs = P.ROPE + (size_t)(tlat0 + tok) * 32;
#pragma unroll
    for (int a = 0; a < 2; ++a)
#pragma unroll
      for (int f = 0; f < 8; ++f) {
        const float x1 = v[16 + a * 16 + f], x2 = v[16 + a * 16 + 8 + f];
        const float c = cs[a * 8 + f], s = cs[16 + a * 8 + f];
        v[16 + a * 16 + f] = x1 * c - x2 * s;
        v[16 + a * 16 + 8 + f] = x2 * c + x1 * s;
      }
  }
  bf16* dst = dstbase + (size_t)(pos0 + tok) * 96 + half * 48;
#pragma unroll
  for (int i = 0; i < 6; ++i) {
    uint4 o;
    o.x = pack2(v[i * 8 + 0] * oscale, v[i * 8 + 1] * oscale); o.y = pack2(v[i * 8 + 2] * oscale, v[i * 8 + 3] * oscale);
    o.z = pack2(v[i * 8 + 4] * oscale, v[i * 8 + 5] * oscale); o.w = pack2(v[i * 8 + 6] * oscale, v[i * 8 + 7] * oscale);
    *reinterpret_cast<uint4*>(dst + i * 8) = o;
  }
}

DEVI void phase_mla_proj(const Params& P, int l, unsigned char* smem) {
  const int tid = TIDX;
  float* T = reinterpret_cast<float*>(smem);
  bf16* TV = reinterpret_cast<bf16*>(smem + 128 * 97 * 4);
  const float qscale = 0.10206207261596577f * 1.4426950408889634f;
  const int tok = tid >> 1, half = tid & 1;
  for (int it = (VBID + NVB - 64) % NVB; it < 144 * 8; it += NVB) {
    const int h = it & 7;
    const int m0 = (it >> 3) * 128;
    const bool lat = m0 < NL;
    const int b = lat ? (m0 >> 11) : ((m0 - NL) >> 8);
    const int pos0 = lat ? 256 + (m0 & 2047) : ((m0 - NL) & 255);
    const int tlat0 = lat ? (m0 & 2047) : 0;
    const bool doq = lat || (l == 0);
    const bf16* zr = P.Z + (size_t)(m0 + tok) * DIN;
    const bf16* rr = P.RAW + (size_t)(m0 + tok) * 1792;
    hb_sync();
    const float rsq = P.RS[(size_t)(m0 + tok) * 2], rskv = P.RS[(size_t)(m0 + tok) * 2 + 1];
    {
      const bf16* kn = rr + 768 + h * 128 + half * 32;
      const bf16* vv = rr + 768 + h * 128 + 64 + half * 32;
#pragma unroll
      for (int i = 0; i < 4; ++i) {
        const uint4 u = *reinterpret_cast<const uint4*>(kn + i * 8);
        float* tp = T + tok * 97 + half * 32 + i * 8;
        tp[0] = lo2f(u.x) * rskv; tp[1] = hi2f(u.x) * rskv; tp[2] = lo2f(u.y) * rskv; tp[3] = hi2f(u.y) * rskv;
        tp[4] = lo2f(u.z) * rskv; tp[5] = hi2f(u.z) * rskv; tp[6] = lo2f(u.w) * rskv; tp[7] = hi2f(u.w) * rskv;
        const uint4 w = *reinterpret_cast<const uint4*>(vv + i * 8);
        bf16* vp = TV + (half * 32 + i * 8) * 136 + tok;
        vp[0 * 136] = f2bf(lo2f(w.x) * rskv); vp[1 * 136] = f2bf(hi2f(w.x) * rskv); vp[2 * 136] = f2bf(lo2f(w.y) * rskv); vp[3 * 136] = f2bf(hi2f(w.y) * rskv);
        vp[4 * 136] = f2bf(lo2f(w.z) * rskv); vp[5 * 136] = f2bf(hi2f(w.z) * rskv); vp[6 * 136] = f2bf(lo2f(w.w) * rskv); vp[7 * 136] = f2bf(hi2f(w.w) * rskv);
      }
#pragma unroll
      for (int i = 0; i < 2; ++i) {
        const uint4 u = *reinterpret_cast<const uint4*>(zr + ZC_BKR + half * 16 + i * 8);
        float* tp = T + tok * 97 + 64 + half * 16 + i * 8;
        tp[0] = lo2f(u.x); tp[1] = hi2f(u.x); tp[2] = lo2f(u.y); tp[3] = hi2f(u.y);
        tp[4] = lo2f(u.z); tp[5] = hi2f(u.z); tp[6] = lo2f(u.w); tp[7] = hi2f(u.w);
      }
    }
    hb_sync();
    mla_norm_rope_store(P, T, P.b_kh_w + l * 96, lat, 1.f, P.K + (size_t)(b * 8 + h) * SEQP * 96, pos0, tlat0);
    {
      const int d = tid >> 2, qtr = tid & 3;
      bf16* dst = P.VT + ((size_t)(b * 8 + h) * 64 + d) * SEQP + pos0 + qtr * 32;
      const bf16* src = TV + d * 136 + qtr * 32;
#pragma unroll
      for (int i = 0; i < 4; ++i) {
        const uint4 v = *reinterpret_cast<const uint4*>(src + i * 8);
        const int g16 = (i >> 1) * 16, odd = i & 1;
        *reinterpret_cast<uint2*>(dst + g16 + (odd ? 4 : 0)) = make_uint2(v.x, v.y);
        *reinterpret_cast<uint2*>(dst + g16 + (odd ? 12 : 8)) = make_uint2(v.z, v.w);
      }
    }
    if (doq) {
      hb_sync();
      const bf16* qq = rr + h * 96 + half * 48;
#pragma unroll
      for (int i = 0; i < 6; ++i) {
        const uint4 u = *reinterpret_cast<const uint4*>(qq + i * 8);
        float* tp = T + tok * 97 + half * 48 + i * 8;
        tp[0] = lo2f(u.x) * rsq; tp[1] = hi2f(u.x) * rsq; tp[2] = lo2f(u.y) * rsq; tp[3] = hi2f(u.y) * rsq;
        tp[4] = lo2f(u.z) * rsq; tp[5] = hi2f(u.z) * rsq; tp[6] = lo2f(u.w) * rsq; tp[7] = hi2f(u.w) * rsq;
      }
      hb_sync();
      mla_norm_rope_store(P, T, P.b_qh_w + l * 96, lat, qscale, P.Q + (size_t)(b * 8 + h) * SEQP * 96, pos0, tlat0);
    }
  }
}

DEVI void hgrn_load(const Params& P, int l, int b, int hd, int c, float* BF, float* RB, float* SEG,
                    float (&q)[16], float (&kf)[16], float (&kb)[16], float (&v)[16], bool need_kv) {
  const int tid = TIDX, t = tid >> 2, k0 = (tid & 3) * 16;
  const int row = row_of(b, c * 64 + t);
  const bf16* z = P.Z + (size_t)row * DIN + hd * 64 + k0;
  float zf[16], zb[16];
#pragma unroll
  for (int i = 0; i < 2; ++i) {
    const uint4 uq = *reinterpret_cast<const uint4*>(z + ZC_CQ + i * 8);
    const uint4 uf = *reinterpret_cast<const uint4*>(z + ZC_CFF + i * 8);
    const uint4 ub = *reinterpret_cast<const uint4*>(z + ZC_CFB + i * 8);
    q[i * 8 + 0] = lo2f(uq.x); q[i * 8 + 1] = hi2f(uq.x); q[i * 8 + 2] = lo2f(uq.y); q[i * 8 + 3] = hi2f(uq.y);
    q[i * 8 + 4] = lo2f(uq.z); q[i * 8 + 5] = hi2f(uq.z); q[i * 8 + 6] = lo2f(uq.w); q[i * 8 + 7] = hi2f(uq.w);
    zf[i * 8 + 0] = lo2f(uf.x); zf[i * 8 + 1] = hi2f(uf.x); zf[i * 8 + 2] = lo2f(uf.y); zf[i * 8 + 3] = hi2f(uf.y);
    zf[i * 8 + 4] = lo2f(uf.z); zf[i * 8 + 5] = hi2f(uf.z); zf[i * 8 + 6] = lo2f(uf.w); zf[i * 8 + 7] = hi2f(uf.w);
    zb[i * 8 + 0] = lo2f(ub.x); zb[i * 8 + 1] = hi2f(ub.x); zb[i * 8 + 2] = lo2f(ub.y); zb[i * 8 + 3] = hi2f(ub.y);
    zb[i * 8 + 4] = lo2f(ub.z); zb[i * 8 + 5] = hi2f(ub.z); zb[i * 8 + 6] = lo2f(ub.w); zb[i * 8 + 7] = hi2f(ub.w);
    if (need_kv) {
      const uint4 uv = *reinterpret_cast<const uint4*>(z + ZC_CI + i * 8);
      v[i * 8 + 0] = lo2f(uv.x); v[i * 8 + 1] = hi2f(uv.x); v[i * 8 + 2] = lo2f(uv.y); v[i * 8 + 3] = hi2f(uv.y);
      v[i * 8 + 4] = lo2f(uv.z); v[i * 8 + 5] = hi2f(uv.z); v[i * 8 + 6] = lo2f(uv.w); v[i * 8 + 7] = hi2f(uv.w);
    }
  }
#pragma unroll
  for (int i = 0; i < 16; ++i) {
    q[i] *= 0.125f;
    float lbf = 0.f;
    if (l == 1) { const int ch = hd * 64 + k0 + i; lbf = sigmoidf_(P.c_lb[512 + ch] - P.c_lb[ch]); }
    const float zz = zf[i];
    const float e = __expf(-fabsf(zz));
    const float sp = __builtin_amdgcn_rcpf(1.f + e);
    const float sig = zz >= 0.f ? sp : e * sp;
    const float nsig = zz >= 0.f ? e * sp : sp;
    const float lf = (l == 0) ? (fminf(zz, 0.f) - __logf(1.f + e)) : __logf(lbf + (1.f - lbf) * sig);
    kf[i] = (1.f - lbf) * nsig;
    BF[t * 65 + k0 + i] = lf;
  }
  __builtin_amdgcn_sched_barrier(0);
#pragma unroll
  for (int i = 0; i < 16; ++i) {
    float lbb = 0.f;
    if (l == 1) { const int ch = hd * 64 + k0 + i; lbb = sigmoidf_(P.c_lb[512 + 256 + ch] - P.c_lb[256 + ch]); }
    const float zz = zb[i];
    const float e = __expf(-fabsf(zz));
    const float sp = __builtin_amdgcn_rcpf(1.f + e);
    const float sig = zz >= 0.f ? sp : e * sp;
    const float nsig = zz >= 0.f ? e * sp : sp;
    const float lf = (l == 0) ? (fminf(zz, 0.f) - __logf(1.f + e)) : __logf(lbb + (1.f - lbb) * sig);
    kb[i] = (1.f - lbb) * nsig;
    RB[t * 65 + k0 + i] = lf;
  }
  hb_sync();
  {
    const int k = tid & 63, seg = tid >> 6;
    float sf = 0.f, sr = 0.f;
#pragma unroll
    for (int j = 0; j < 16; ++j) { sf += BF[(seg * 16 + j) * 65 + k]; BF[(seg * 16 + j) * 65 + k] = sf; }
#pragma unroll
    for (int j = 15; j >= 0; --j) { sr += RB[(seg * 16 + j) * 65 + k]; RB[(seg * 16 + j) * 65 + k] = sr; }
    SEG[seg * 64 + k] = sf; SEG[256 + seg * 64 + k] = sr;
    hb_sync();
    float offf = 0.f, offb = 0.f;
#pragma unroll
    for (int s2 = 0; s2 < 4; ++s2) {
      offf += (s2 < seg) ? SEG[s2 * 64 + k] : 0.f;
      offb += (s2 > seg) ? SEG[256 + s2 * 64 + k] : 0.f;
    }
#pragma unroll
    for (int j = 0; j < 16; ++j) { BF[(seg * 16 + j) * 65 + k] += offf; RB[(seg * 16 + j) * 65 + k] += offb; }
  }
  hb_sync();
}

DEVI f32x16 lds_mm(const bf16* A, const bf16* BT, int tm, int tn, int l31, int hh) {
  f32x16 acc = zero16();
#pragma unroll
  for (int ks = 0; ks < 4; ++ks) {
    const bf16x8 a = ldfrag(A + (tm * 32 + l31) * 72 + ks * 16 + hh * 8);
    const bf16x8 b = ldfrag(BT + (tn * 32 + l31) * 72 + ks * 16 + hh * 8);
    acc = mfma32(a, b, acc);
  }
  return acc;
}

DEVI void phase_hgrn_local(const Params& P, int l, unsigned char* smem) {
  const int tid = TIDX, lane = tid & 63, wave = tid >> 6, l31 = lane & 31, hh = lane >> 5;
  const int tm = wave >> 1, tn = wave & 1;
  float* BF = reinterpret_cast<float*>(smem);
  float* RB = BF + 64 * 65;
  bf16* QF = reinterpret_cast<bf16*>(smem + 33280);
  bf16* KF = QF + 64 * 72;
  bf16* QB = KF + 64 * 72;
  bf16* KB = QB + 64 * 72;
  bf16* VTt = KB + 64 * 72;
  bf16* KHF = reinterpret_cast<bf16*>(smem);
  bf16* KHB = KHF + 64 * 72;
  bf16* ATT = KHB + 64 * 72;
  for (int it = (VBID + NVB - 192) % NVB; it < 8 * 4 * 36; it += NVB) {
    const int c = it % 36, hd = (it / 36) & 3, b = it / 144;
    float q[16], kf[16], kb[16], v[16];
    hb_sync();
    hgrn_load(P, l, b, hd, c, BF, RB, reinterpret_cast<float*>(smem + 33280), q, kf, kb, v, true);
    const int t = tid >> 2, k0 = (tid & 3) * 16;
#pragma unroll
    for (int i = 0; i < 16; ++i) VTt[(k0 + i) * 72 + t] = f2bf(v[i]);
    float bfv[16], rbv[16];
#pragma unroll
    for (int i = 0; i < 16; ++i) { bfv[i] = BF[t * 65 + k0 + i]; rbv[i] = RB[t * 65 + k0 + i]; }
    {
      const size_t go = (size_t)row_of(b, c * 64 + t) * 256 + hd * 64 + k0;
#pragma unroll
      for (int hq = 0; hq < 2; ++hq) {
        unsigned pf[4], pb[4];
#pragma unroll
        for (int i = 0; i < 8; i += 2) {
          pf[i >> 1] = pack2(q[hq * 8 + i] * __expf(bfv[hq * 8 + i]), q[hq * 8 + i + 1] * __expf(bfv[hq * 8 + i + 1]));
          pb[i >> 1] = pack2(q[hq * 8 + i] * __expf(rbv[hq * 8 + i]), q[hq * 8 + i + 1] * __expf(rbv[hq * 8 + i + 1]));
        }
        *reinterpret_cast<uint4*>(P.GQF + go + hq * 8) = make_uint4(pf[0], pf[1], pf[2], pf[3]);
        *reinterpret_cast<uint4*>(P.GQB + go + hq * 8) = make_uint4(pb[0], pb[1], pb[2], pb[3]);
      }
    }
    if (t == 0) {
      float* dec = P.DEC + ((size_t)((b * 4 + hd) * 2) * 36 + c) * 64 + k0;
#pragma unroll
      for (int i = 0; i < 16; ++i) { dec[i] = __expf(BF[63 * 65 + k0 + i]); dec[36 * 64 + i] = __expf(RB[k0 + i]); }
    }
#pragma unroll
    for (int i = 0; i < 16; i += 2) {
      const int k = k0 + i;
      const float mF0 = BF[32 * 65 + k], mF1 = BF[32 * 65 + k + 1], mB0 = RB[32 * 65 + k], mB1 = RB[32 * 65 + k + 1];
      *reinterpret_cast<unsigned*>(&QF[t * 72 + k]) = pack2(q[i] * __expf(fminf(bfv[i] - mF0, 80.f)), q[i + 1] * __expf(fminf(bfv[i + 1] - mF1, 80.f)));
      *reinterpret_cast<unsigned*>(&KF[t * 72 + k]) = pack2(kf[i] * __expf(fminf(mF0 - bfv[i], 80.f)), kf[i + 1] * __expf(fminf(mF1 - bfv[i + 1], 80.f)));
      *reinterpret_cast<unsigned*>(&QB[t * 72 + k]) = pack2(q[i] * __expf(fminf(rbv[i] - mB0, 80.f)), q[i + 1] * __expf(fminf(rbv[i + 1] - mB1, 80.f)));
      *reinterpret_cast<unsigned*>(&KB[t * 72 + k]) = pack2(kb[i] * __expf(fminf(mB0 - rbv[i], 80.f)), kb[i + 1] * __expf(fminf(mB1 - rbv[i + 1], 80.f)));
    }
#pragma unroll
    for (int i = 0; i < 16; ++i) {
      kf[i] = kf[i] * __expf(BF[63 * 65 + k0 + i] - bfv[i]);
      kb[i] = kb[i] * __expf(RB[k0 + i] - rbv[i]);
    }
    hb_sync();
#pragma unroll
    for (int i = 0; i < 16; ++i) {
      KHF[(k0 + i) * 72 + t] = f2bf(kf[i]);
      KHB[(k0 + i) * 72 + t] = f2bf(kb[i]);
    }
    hb_sync();
    {
      const f32x16 af = lds_mm(QF, KF, tm, tn, l31, hh);
      const f32x16 ab = lds_mm(QB, KB, tm, tn, l31, hh);
      const int s = tn * 32 + l31;
#pragma unroll
      for (int r = 0; r < 16; ++r) {
        const int tt = tm * 32 + drow(r, hh);
        float a = 0.f;
        if (s <= tt) a += af[r];
        if (s >= tt) a += ab[r];
        ATT[tt * 72 + s] = f2bf(a);
      }
    }
    {
      const f32x16 lf = lds_mm(VTt, KHF, tm, tn, l31, hh);
      const f32x16 lb = lds_mm(VTt, KHB, tm, tn, l31, hh);
      bf16* stf = P.ST + ((size_t)((b * 4 + hd) * 2 + 0) * 36 + c) * 4096;
      bf16* stb = P.ST + ((size_t)((b * 4 + hd) * 2 + 1) * 36 + c) * 4096;
#pragma unroll
      for (int r = 0; r < 16; ++r) {
        const int kk = tm * 32 + drow(r, hh), d = tn * 32 + l31;
        stf[kk * 64 + d] = f2bf(lf[r]);
        stb[kk * 64 + d] = f2bf(lb[r]);
      }
    }
    hb_sync();
    {
      const f32x16 o = lds_mm(ATT, VTt, tm, tn, l31, hh);
#pragma unroll
      for (int r = 0; r < 16; ++r) {
        const int tt = tm * 32 + drow(r, hh), d = tn * 32 + l31;
        P.OI[(size_t)row_of(b, c * 64 + tt) * 256 + hd * 64 + d] = f2bf(o[r]);
      }
    }
  }
}

DEVI void hgrn_scan_item(const Params& P, int item) {
  const int tid = TIDX;
  const int chain = item >> 2, sl = item & 3;
  const int dir = chain & 1;
  const int dd = tid >> 2, k4 = sl * 16 + (tid & 3) * 4;
  float4 S = make_float4(0.f, 0.f, 0.f, 0.f);
  bf16* base = P.ST + (size_t)chain * 36 * 4096 + dd * 64 + k4;
  const float* dec = P.DEC + (size_t)chain * 36 * 64 + k4;
#pragma unroll 1
  for (int g = 0; g < 6; ++g) {
    float4 L[6], dc[6];
#pragma unroll
    for (int j = 0; j < 6; ++j) {
      const int step = g * 6 + j;
      const int c = dir == 0 ? step : (step < 4 ? 3 - step : 39 - step);
      { const uint2 u = *reinterpret_cast<const uint2*>(base + (size_t)c * 4096); L[j] = make_float4(lo2f(u.x), hi2f(u.x), lo2f(u.y), hi2f(u.y)); }
      dc[j] = *reinterpret_cast<const float4*>(dec + c * 64);
    }
#pragma unroll
    for (int j = 0; j < 6; ++j) {
      const int step = g * 6 + j;
      const int c = dir == 0 ? step : (step < 4 ? 3 - step : 39 - step);
      *reinterpret_cast<uint2*>(base + (size_t)c * 4096) = make_uint2(pack2(S.x, S.y), pack2(S.z, S.w));
      S.x = dc[j].x * S.x + L[j].x; S.y = dc[j].y * S.y + L[j].y; S.z = dc[j].z * S.z + L[j].z; S.w = dc[j].w * S.w + L[j].w;
    }
  }
}

DEVI void phase_hgrn_final(const Params& P, int l, unsigned char* smem) {
  const int tid = TIDX, lane = tid & 63, wave = tid >> 6, l31 = lane & 31, hh = lane >> 5;
  const int tm = wave >> 1, tn = wave & 1;
  float* O = reinterpret_cast<float*>(smem);
  bf16* QF = reinterpret_cast<bf16*>(smem + 33280);
  bf16* QB = QF + 64 * 72;
  bf16* SF = QB + 64 * 72;
  bf16* SB = SF + 64 * 72;
  const int c0 = (l == 1) ? 4 : 0;
  const int nc = 36 - c0;
  for (int it = VBID; it < 8 * 4 * nc; it += NVB) {
    const int c = it % nc + c0, hd = (it / nc) & 3, b = it / (nc * 4);
    const int t = tid >> 2, k0 = (tid & 3) * 16;
    const int row = row_of(b, c * 64 + t);
    hb_sync();
    {
      const size_t go = (size_t)row * 256 + hd * 64 + k0;
      *reinterpret_cast<uint4*>(QF + t * 72 + k0) = *reinterpret_cast<const uint4*>(P.GQF + go);
      *reinterpret_cast<uint4*>(QF + t * 72 + k0 + 8) = *reinterpret_cast<const uint4*>(P.GQF + go + 8);
      *reinterpret_cast<uint4*>(QB + t * 72 + k0) = *reinterpret_cast<const uint4*>(P.GQB + go);
      *reinterpret_cast<uint4*>(QB + t * 72 + k0 + 8) = *reinterpret_cast<const uint4*>(P.GQB + go + 8);
      const bf16* stf = P.ST + ((size_t)((b * 4 + hd) * 2 + 0) * 36 + c) * 4096 + t * 64 + k0;
      const bf16* stb = P.ST + ((size_t)((b * 4 + hd) * 2 + 1) * 36 + c) * 4096 + t * 64 + k0;
      *reinterpret_cast<uint4*>(SF + t * 72 + k0) = *reinterpret_cast<const uint4*>(stf);
      *reinterpret_cast<uint4*>(SF + t * 72 + k0 + 8) = *reinterpret_cast<const uint4*>(stf + 8);
      *reinterpret_cast<uint4*>(SB + t * 72 + k0) = *reinterpret_cast<const uint4*>(stb);
      *reinterpret_cast<uint4*>(SB + t * 72 + k0 + 8) = *reinterpret_cast<const uint4*>(stb + 8);
    }
    hb_sync();
    {
      f32x16 o = lds_mm(QF, SF, tm, tn, l31, hh);
      const f32x16 o2 = lds_mm(QB, SB, tm, tn, l31, hh);
#pragma unroll
      for (int r = 0; r < 16; ++r) {
        const int tt = tm * 32 + drow(r, hh), d = tn * 32 + l31;
        O[tt * 65 + d] = o[r] + o2[r] + bf2f(P.OI[(size_t)row_of(b, c * 64 + tt) * 256 + hd * 64 + d]);
      }
    }
    hb_sync();
    {
      float ov[16]; float ss = 0.f;
#pragma unroll
      for (int i = 0; i < 16; ++i) { ov[i] = O[t * 65 + k0 + i]; ss += ov[i] * ov[i]; }
      ss += __shfl_xor(ss, 1); ss += __shfl_xor(ss, 2);
      const float rr = rsqrtf(ss * (1.f / 64.f) + EPS);
      const bf16* g = P.Z + (size_t)row * DIN + ZC_CG + hd * 64 + k0;
      const float* nw = P.c_out_norm_w + l * 64 + k0;
      const uint4 gA = *reinterpret_cast<const uint4*>(g), gB = *reinterpret_cast<const uint4*>(g + 8);
      const unsigned gw[8] = {gA.x, gA.y, gA.z, gA.w, gB.x, gB.y, gB.z, gB.w};
      unsigned pk[8];
#pragma unroll
      for (int i = 0; i < 16; i += 2) {
        const float g0 = lo2f(gw[i >> 1]), g1 = hi2f(gw[i >> 1]);
        const float y0 = ov[i] * rr * nw[i] * (g0 * sigmoidf_(g0));
        const float y1 = ov[i + 1] * rr * nw[i + 1] * (g1 * sigmoidf_(g1));
        pk[i >> 1] = pack2(y0, y1);
      }
      uint4* dst = reinterpret_cast<uint4*>(P.H + (size_t)row * 1024 + 768 + hd * 64 + k0);
      dst[0] = make_uint4(pk[0], pk[1], pk[2], pk[3]);
      dst[1] = make_uint4(pk[4], pk[5], pk[6], pk[7]);
    }
  }
}

DEVI void attn_item8(const Params& P, int b, int h, int qpos0, int nkeys, float sref, unsigned char* smem_base) {
  const int tid = threadIdx.x, lane = tid & 63, wave = tid >> 6, l31 = lane & 31, hh = lane >> 5;
  constexpr int TK = 128, LDKS = 104, LDVS = 136;
  constexpr int KS_BYTES = TK * LDKS * 2, VS_BYTES = 64 * LDVS * 2, ST_BYTES = KS_BYTES + VS_BYTES;
  const bf16* Qg = P.Q + ((size_t)(b * 8 + h) * SEQP + qpos0 + wave * 32 + l31) * 96;
  const bf16* Kg = P.K + (size_t)(b * 8 + h) * SEQP * 96;
  const bf16* Vg = P.VT + (size_t)(b * 8 + h) * 64 * SEQP;
  bf16x8 qf[6];
#pragma unroll
  for (int ks = 0; ks < 6; ++ks) qf[ks] = ldfrag(Qg + ks * 16 + hh * 8);
  f32x16 oacc[2]; oacc[0] = zero16(); oacc[1] = zero16();
  float lsum = 0.f;
  const int ntiles = nkeys / TK;
  unsigned koff[4], voff[3];
#pragma unroll
  for (int i = 0; i < 4; ++i) { const int q = (i * 8 + wave) * 64 + lane, row = q / 13, cc = q - row * 13; koff[i] = (unsigned)(row * 96 + (cc < 12 ? cc : 0) * 8) * 2u; }
#pragma unroll
  for (int i = 0; i < 3; ++i) { const int q = (i * 8 + wave) * 64 + lane, row = q / 17, cc = q - row * 17; voff[i] = (unsigned)((row < 64 ? row : 63) * SEQP + (cc < 16 ? cc : 0) * 8) * 2u; }
  LAS unsigned char* ldsb = (LAS unsigned char*)smem_base;
  auto dma_tile = [&](int kt, int buf) {
    const char* kb_ = (const char*)(Kg + (size_t)kt * TK * 96);
    const char* vb_ = (const char*)(Vg + (size_t)kt * TK);
#pragma unroll
    for (int i = 0; i < 4; ++i) {
      const int g = i * 8 + wave;
      if (g < 26) __builtin_amdgcn_global_load_lds((const unsigned*)(kb_ + koff[i]), (LAS unsigned*)(ldsb + buf * ST_BYTES + g * 1024), 16, 0, 0);
    }
#pragma unroll
    for (int i = 0; i < 3; ++i) {
      const int g = i * 8 + wave;
      if (g < 17) __builtin_amdgcn_global_load_lds((const unsigned*)(vb_ + voff[i]), (LAS unsigned*)(ldsb + buf * ST_BYTES + KS_BYTES + g * 1024), 16, 0, 0);
    }
  };
  __syncthreads();
  dma_tile(0, 0);
  asm volatile("s_waitcnt vmcnt(0)" ::: "memory");
  __syncthreads();
  for (int kt = 0; kt < ntiles; ++kt) {
    const int cur = kt & 1;
    if (kt + 1 < ntiles) dma_tile(kt + 1, cur ^ 1);
    const bf16* sK = reinterpret_cast<const bf16*>(smem_base + cur * ST_BYTES);
    const bf16* sV = reinterpret_cast<const bf16*>(smem_base + cur * ST_BYTES + KS_BYTES);
#pragma unroll
    for (int kk = 0; kk < 4; ++kk) {
      f32x16 sacc;
#pragma unroll
      for (int r = 0; r < 16; ++r) sacc[r] = -sref;
#pragma unroll
      for (int ks = 0; ks < 6; ++ks) {
        const bf16x8 a = ldfrag(sK + (kk * 32 + l31) * LDKS + ks * 16 + hh * 8);
        sacc = mfma32(a, qf[ks], sacc);
      }
#pragma unroll
      for (int r = 0; r < 16; ++r) { const float p = __builtin_amdgcn_exp2f(sacc[r]); sacc[r] = p; lsum += p; }
#pragma unroll
      for (int s = 0; s < 2; ++s) {
        bf16x8 pb;
#pragma unroll
        for (int j = 0; j < 8; ++j) pb[j] = (__bf16)sacc[8 * s + j];
#pragma unroll
        for (int dt = 0; dt < 2; ++dt) {
          const bf16x8 a = ldfrag(sV + (dt * 32 + l31) * LDVS + kk * 32 + s * 16 + hh * 8);
          oacc[dt] = mfma32(a, pb, oacc[dt]);
        }
      }
    }
    asm volatile("s_waitcnt vmcnt(0)" ::: "memory");
    __syncthreads();
  }
  lsum += __shfl_xor(lsum, 32);
  const float inv = 1.f / lsum;
  const int row = row_of(b, qpos0 + wave * 32 + l31);
  bf16* dst = P.H + (size_t)row * 1024 + 256 + h * 64;
#pragma unroll
  for (int dt = 0; dt < 2; ++dt)
#pragma unroll
    for (int rg = 0; rg < 4; ++rg) {
      const int d = dt * 32 + 8 * rg + 4 * hh;
      uint2 o;
      o.x = pack2(oacc[dt][4 * rg + 0] * inv, oacc[dt][4 * rg + 1] * inv);
      o.y = pack2(oacc[dt][4 * rg + 2] * inv, oacc[dt][4 * rg + 3] * inv);
      *reinterpret_cast<uint2*>(dst + d) = o;
    }
}

DEVI void phase_attn_scan(const Params& P, int l, unsigned char* smem_base, bool skip_scan = false) {
  if (!skip_scan)
    for (int it = NVB - 1 - VBID; it < 256; it += NVB) hgrn_scan_item(P, it);
  float sref;
  {
    const int lane = threadIdx.x & 63;
    float mq = fmaxf(fabsf(P.b_qh_w[l * 96 + lane]), lane < 32 ? fabsf(P.b_qh_w[l * 96 + 64 + lane]) : 0.f);
    float mk = fmaxf(fabsf(P.b_kh_w[l * 96 + lane]), lane < 32 ? fabsf(P.b_kh_w[l * 96 + 64 + lane]) : 0.f);
#pragma unroll
    for (int o = 32; o > 0; o >>= 1) { mq = fmaxf(mq, __shfl_xor(mq, o)); mk = fmaxf(mk, __shfl_xor(mk, o)); }
    sref = fminf(1.4426950408889634f * 9.797958971132712f * mq * mk, 60.f);
  }
  const int c = blockIdx.x, xcd = c & 7, slot = c >> 3;
  const int nrounds = (l == 0) ? 3 : 2;
  for (int r = 0; r < nrounds; ++r) {
    if (r < 2) {
      const int u = r * 32 + slot;
      const int bh = xcd * 8 + (u >> 3), qt = u & 7;
      if (slot < 32) attn_item8(P, bh >> 3, bh & 7, 256 + 256 * qt, 2304, sref, smem_base);
    } else if (c < 64) {
      attn_item8(P, c >> 3, c & 7, 0, 256, sref, smem_base);
    }
  }
}

DEVI unsigned ordkey(float s) { const unsigned u = __float_as_uint(s); return (u & 0x80000000u) ? ~u : (u | 0x80000000u); }
DEVI float keyval(unsigned k, unsigned mask) { const unsigned u = k & ~mask; return __uint_as_float((u & 0x80000000u) ? (u & 0x7fffffffu) : ~u); }
DEVI void ins16(unsigned (&lst)[16], unsigned v) {
#pragma unroll
  for (int j = 0; j < 16; ++j) { const unsigned hi = max(lst[j], v); v = min(lst[j], v); lst[j] = hi; }
}
DEVI void merge16(unsigned (&lst)[16], int xm) {
  unsigned o[16];
#pragma unroll
  for (int j = 0; j < 16; ++j) o[j] = (unsigned)__shfl_xor((int)lst[j], xm);
#pragma unroll
  for (int j = 0; j < 16; ++j) lst[j] = max(lst[j], o[15 - j]);
#pragma unroll
  for (int d = 8; d >= 1; d >>= 1)
#pragma unroll
    for (int j = 0; j < 16; ++j)
      if ((j & d) == 0) { const unsigned a = lst[j], bb = lst[j + d]; lst[j] = max(a, bb); lst[j + d] = min(a, bb); }
}

DEVI void bitonic_sort_desc16(unsigned (&v)[16]) {
#pragma unroll
  for (int k = 2; k <= 16; k <<= 1)
#pragma unroll
    for (int j = k >> 1; j > 0; j >>= 1)
#pragma unroll
      for (int i = 0; i < 16; ++i) {
        const int l = i ^ j;
        if (l > i) {
          const bool desc = ((i & k) == 0);
          const unsigned a = v[i], b = v[l];
          const unsigned mx = max(a, b), mn = min(a, b);
          v[i] = desc ? mx : mn; v[l] = desc ? mn : mx;
        }
      }
}
DEVI void bitonic_merge_desc16(unsigned (&lst)[16]) {
#pragma unroll
  for (int d = 8; d >= 1; d >>= 1)
#pragma unroll
    for (int j = 0; j < 16; ++j)
      if ((j & d) == 0) { const unsigned a = lst[j], bb = lst[j + d]; lst[j] = max(a, bb); lst[j + d] = min(a, bb); }
}
struct CandTab { int a[52]; int b[52]; };
constexpr CandTab make_cand_tab() {
  CandTab t{};
  int n = 0;
  for (int a = 0; a < 16; ++a)
    for (int b = 0; b < 16; ++b)
      if ((a + 1) * (b + 1) <= 16) { t.a[n] = a; t.b[n] = b; ++n; }
  for (; n < 52; ++n) { t.a[n] = 0; t.b[n] = 0; }
  return t;
}

DEVI void phase_route(const Params& P, int l, unsigned char* smem) {
  const int tid = TIDX;
  const int mtiles = (l == 1) ? 256 : 288;
  for (int it = VBID; it < mtiles * 8; it += NVB) {
    const int mt = it >> 3, h = it & 7;
    unsigned lst[2][16];
    const int row = tid >> 2, part = tid & 3;
#pragma unroll
    for (int p = 0; p < 2; ++p) {
      float sc[32];
      {
        const bf16* sp = P.QP + (size_t)(mt * 64 + row) * 2048 + (h * 2 + p) * 128 + part * 32;
#pragma unroll
        for (int i = 0; i < 4; ++i) {
          const uint4 u = *reinterpret_cast<const uint4*>(sp + i * 8);
          sc[i * 8 + 0] = lo2f(u.x); sc[i * 8 + 1] = hi2f(u.x); sc[i * 8 + 2] = lo2f(u.y); sc[i * 8 + 3] = hi2f(u.y);
          sc[i * 8 + 4] = lo2f(u.z); sc[i * 8 + 5] = hi2f(u.z); sc[i * 8 + 6] = lo2f(u.w); sc[i * 8 + 7] = hi2f(u.w);
        }
      }
      unsigned B2[16];
#pragma unroll
      for (int i = 0; i < 16; ++i) {
        const int i0 = part * 32 + i, i1 = part * 32 + 16 + i;
        lst[p][i] = (ordkey(sc[i]) & ~0x7fu) | (unsigned)(127 - i0);
        B2[i] = (ordkey(sc[16 + i]) & ~0x7fu) | (unsigned)(127 - i1);
      }
      bitonic_sort_desc16(lst[p]);
      bitonic_sort_desc16(B2);
#pragma unroll
      for (int j = 0; j < 16; ++j) lst[p][j] = max(lst[p][j], B2[15 - j]);
      bitonic_merge_desc16(lst[p]);
      merge16(lst[p], 1);
      merge16(lst[p], 2);
    }
    float v0[16], v1[16];
#pragma unroll
    for (int j = 0; j < 16; ++j) { v0[j] = keyval(lst[0][j], 0x7fu); v1[j] = keyval(lst[1][j], 0x7fu); }
    unsigned best[16];
    {
      constexpr CandTab CT = make_cand_tab();
#pragma unroll
      for (int c = 0; c < 13; ++c) {
        const int a0 = CT.a[4 * c + 0], a1 = CT.a[4 * c + 1], a2 = CT.a[4 * c + 2], a3 = CT.a[4 * c + 3];
        const int b0 = CT.b[4 * c + 0], b1 = CT.b[4 * c + 1], b2 = CT.b[4 * c + 2], b3 = CT.b[4 * c + 3];
        const float x = part == 0 ? v0[a0] : part == 1 ? v0[a1] : part == 2 ? v0[a2] : v0[a3];
        const float y = part == 0 ? v1[b0] : part == 1 ? v1[b1] : part == 2 ? v1[b2] : v1[b3];
        const int flat = part == 0 ? (a0 * 16 + b0) : part == 1 ? (a1 * 16 + b1) : part == 2 ? (a2 * 16 + b2) : (a3 * 16 + b3);
        const bool valid = part == 0 ? (4 * c + 0 < 50) : part == 1 ? (4 * c + 1 < 50) : part == 2 ? (4 * c + 2 < 50) : (4 * c + 3 < 50);
        const unsigned key = (ordkey(x + y) & ~0xffu) | (unsigned)(255 - flat);
        best[c] = valid ? key : 0u;
      }
      best[13] = 0u; best[14] = 0u; best[15] = 0u;
      bitonic_sort_desc16(best);
      merge16(best, 1);
      merge16(best, 2);
    }
    {
      const float mx = keyval(best[0], 0xffu);
      float es = 0.f;
      float ev[4]; int ex[4];
#pragma unroll
      for (int jj = 0; jj < 4; ++jj) {
        const unsigned kk = part == 0 ? best[4 * jj + 0] : part == 1 ? best[4 * jj + 1] : part == 2 ? best[4 * jj + 2] : best[4 * jj + 3];
        ev[jj] = __expf(keyval(kk, 0xffu) - mx);
        es += ev[jj];
        const int flat = 255 - (int)(kk & 0xffu);
        const int a = flat >> 4, bq = flat & 15;
        int i1 = 0, i2 = 0;
#pragma unroll
        for (int u = 0; u < 16; ++u) {
          i1 = (a == u) ? (127 - (int)(lst[0][u] & 0x7fu)) : i1;
          i2 = (bq == u) ? (127 - (int)(lst[1][u] & 0x7fu)) : i2;
        }
        ex[jj] = i1 * 128 + i2;
      }
      es += __shfl_xor(es, 1); es += __shfl_xor(es, 2);
      const float inv = 1.f / es;
      const int tok = mt * 64 + row;
      int* ed = P.EIDX + (size_t)tok * 128 + h * 16;
      float* gd = P.GATE + (size_t)tok * 128 + h * 16;
#pragma unroll
      for (int jj = 0; jj < 4; ++jj) { ed[4 * jj + part] = ex[jj]; gd[4 * jj + part] = ev[jj] * inv; }
    }
  }
}

DEVI float gelu_exact(float a) { return 0.5f * a * (1.f + erff(a * 0.70710678118654752f)); }

typedef float f2 __attribute__((ext_vector_type(2)));
DEVI void phase_peer_u(const Params& P, int l) {
  const int lane = TIDX & 63, half = lane >> 5, l32 = lane & 31;
  const int gw = VBID * 4 + (TIDX >> 6), nw = NVB * 4;
  const int nrows = (l == 1) ? NL : NT;
  const unsigned char* PU = P.PU8 + (size_t)l * 16384 * 576;
  const bool b4 = lane & 16, b3 = lane & 8, b2 = lane & 4;
  for (int t = gw; t < nrows; t += nw) {
    f2 h2[16];
    {
      const bf16* hp = P.H + (size_t)t * 1024 + l32 * 32;
#pragma unroll
      for (int i = 0; i < 4; ++i) {
        const uint4 hv = *reinterpret_cast<const uint4*>(hp + i * 8);
        h2[4 * i + 0] = (f2){lo2f(hv.x), hi2f(hv.x)}; h2[4 * i + 1] = (f2){lo2f(hv.y), hi2f(hv.y)};
        h2[4 * i + 2] = (f2){lo2f(hv.z), hi2f(hv.z)}; h2[4 * i + 3] = (f2){lo2f(hv.w), hi2f(hv.w)};
      }
    }
    const int e0 = P.EIDX[(size_t)t * 128 + lane], e1 = P.EIDX[(size_t)t * 128 + 64 + lane];
    const float g0 = P.GATE[(size_t)t * 128 + lane], g1 = P.GATE[(size_t)t * 128 + 64 + lane];
    float* wrow = P.WPE + (size_t)t * 128;
    const bool b1 = lane & 2;
    for (int kb = 0; kb < 4; ++kb) {
      const int esrc = kb < 2 ? e0 : e1;
      uint4 ud[16];
      unsigned short us[16];
#pragma unroll
      for (int i = 0; i < 16; ++i) {
        const int e = __shfl(esrc, (kb * 32 + 2 * i + half) & 63);
        const unsigned char* ur = PU + (size_t)e * 576;
        ud[i] = *reinterpret_cast<const uint4*>(ur + l32 * 16);
        us[i] = *reinterpret_cast<const unsigned short*>(ur + 512 + l32 * 2);
      }
      float d[16];
#pragma unroll
      for (int i = 0; i < 16; ++i) {
        const unsigned uw[4] = {ud[i].x, ud[i].y, ud[i].z, ud[i].w};
        f2 sacc = (f2){0.f, 0.f};
#pragma unroll
        for (int c = 0; c < 4; ++c) {
          sacc = __builtin_elementwise_fma(__builtin_amdgcn_cvt_scalef32_pk_f32_fp4(uw[c], 1.0f, 0), h2[4 * c + 0], sacc);
          sacc = __builtin_elementwise_fma(__builtin_amdgcn_cvt_scalef32_pk_f32_fp4(uw[c], 1.0f, 1), h2[4 * c + 1], sacc);
          sacc = __builtin_elementwise_fma(__builtin_amdgcn_cvt_scalef32_pk_f32_fp4(uw[c], 1.0f, 2), h2[4 * c + 2], sacc);
          sacc = __builtin_elementwise_fma(__builtin_amdgcn_cvt_scalef32_pk_f32_fp4(uw[c], 1.0f, 3), h2[4 * c + 3], sacc);
        }
        d[i] = (sacc.x + sacc.y) * __uint_as_float((unsigned)us[i] << 16);
      }
      float r8[8], r4[4], r2[2], r1;
#pragma unroll
      for (int i = 0; i < 8; ++i) { const float mine = b4 ? d[8 + i] : d[i]; const float send = b4 ? d[i] : d[8 + i]; r8[i] = mine + __shfl_xor(send, 16); }
#pragma unroll
      for (int i = 0; i < 4; ++i) { const float mine = b3 ? r8[4 + i] : r8[i]; const float send = b3 ? r8[i] : r8[4 + i]; r4[i] = mine + __shfl_xor(send, 8); }
#pragma unroll
      for (int i = 0; i < 2; ++i) { const float mine = b2 ? r4[2 + i] : r4[i]; const float send = b2 ? r4[i] : r4[2 + i]; r2[i] = mine + __shfl_xor(send, 4); }
      { const float mine = b1 ? r2[1] : r2[0]; const float send = b1 ? r2[0] : r2[1]; r1 = mine + __shfl_xor(send, 2); }
      r1 += __shfl_xor(r1, 1);
      const int k = kb * 32 + 2 * ((lane >> 1) & 15) + half;
      const float gt = __shfl(kb < 2 ? g0 : g1, k & 63);
      if ((lane & 1) == 0) wrow[k] = gt * gelu_exact(r1);
    }
  }
}

DEVI void phase_peer(const Params& P, int l) {
  const int lane = TIDX & 63, half = lane >> 5, l32 = lane & 31;
  const int gw = VBID * 4 + (TIDX >> 6), nw = NVB * 4;
  const int nrows = (l == 1) ? NL : NT;
  const unsigned char* PV = P.PV8 + (size_t)l * 16384 * 576;
  for (int t = gw; t < nrows; t += nw) {
    const int e0 = P.EIDX[(size_t)t * 128 + lane], e1 = P.EIDX[(size_t)t * 128 + 64 + lane];
    const float w0 = P.WPE[(size_t)t * 128 + lane], w1 = P.WPE[(size_t)t * 128 + 64 + lane];
    f2 y2[16];
#pragma unroll
    for (int i = 0; i < 16; ++i) y2[i] = (f2){0.f, 0.f};
    for (int kb = 0; kb < 4; ++kb) {
      const int esrc = kb < 2 ? e0 : e1;
      const float wsrc = kb < 2 ? w0 : w1;
      uint4 vd[16];
      unsigned short vs[16];
      float wv[16];
#pragma unroll
      for (int i = 0; i < 16; ++i) {
        const int ks = (kb * 32 + 2 * i + half) & 63;
        const int e = __shfl(esrc, ks);
        wv[i] = __shfl(wsrc, ks);
        const unsigned char* vr = PV + (size_t)e * 576;
        vd[i] = *reinterpret_cast<const uint4*>(vr + l32 * 16);
        vs[i] = *reinterpret_cast<const unsigned short*>(vr + 512 + l32 * 2);
      }
#pragma unroll
      for (int i = 0; i < 16; ++i) {
        const float wi = wv[i] * __uint_as_float((unsigned)vs[i] << 16);
        const f2 ww = (f2){wi, wi};
        const unsigned vw[4] = {vd[i].x, vd[i].y, vd[i].z, vd[i].w};
#pragma unroll
        for (int c = 0; c < 4; ++c) {
          y2[4 * c + 0] = __builtin_elementwise_fma(ww, __builtin_amdgcn_cvt_scalef32_pk_f32_fp4(vw[c], 1.0f, 0), y2[4 * c + 0]);
          y2[4 * c + 1] = __builtin_elementwise_fma(ww, __builtin_amdgcn_cvt_scalef32_pk_f32_fp4(vw[c], 1.0f, 1), y2[4 * c + 1]);
          y2[4 * c + 2] = __builtin_elementwise_fma(ww, __builtin_amdgcn_cvt_scalef32_pk_f32_fp4(vw[c], 1.0f, 2), y2[4 * c + 2]);
          y2[4 * c + 3] = __builtin_elementwise_fma(ww, __builtin_amdgcn_cvt_scalef32_pk_f32_fp4(vw[c], 1.0f, 3), y2[4 * c + 3]);
        }
      }
    }
    float y[16];
#pragma unroll
    for (int j = 0; j < 8; ++j) {
      const float ax = y2[j].x + __shfl_xor(y2[j].x, 32), ay = y2[j].y + __shfl_xor(y2[j].y, 32);
      const float bx = y2[8 + j].x + __shfl_xor(y2[8 + j].x, 32), by = y2[8 + j].y + __shfl_xor(y2[8 + j].y, 32);
      y[2 * j] = half ? bx : ax; y[2 * j + 1] = half ? by : ay;
    }
    const int bi = batch_of_row(t);
    const float* gate2 = P.MOD + (size_t)(l * 9 + bi) * 6144 + 5 * 1024;
    const int d0 = l32 * 32 + half * 16;
    float xn[16];
    float ss = 0.f;
#pragma unroll
    for (int q4 = 0; q4 < 4; ++q4) {
      const int d = d0 + q4 * 4;
      const uint2 xu = *reinterpret_cast<const uint2*>(P.X + (size_t)t * 1024 + d);
      const float4 xo = make_float4(lo2f(xu.x), hi2f(xu.x), lo2f(xu.y), hi2f(xu.y));
      const float4 gg = *reinterpret_cast<const float4*>(gate2 + d);
      float4 o;
      o.x = xo.x + gg.x * y[q4 * 4 + 0]; o.y = xo.y + gg.y * y[q4 * 4 + 1];
      o.z = xo.z + gg.z * y[q4 * 4 + 2]; o.w = xo.w + gg.w * y[q4 * 4 + 3];
      xn[q4 * 4 + 0] = o.x; xn[q4 * 4 + 1] = o.y; xn[q4 * 4 + 2] = o.z; xn[q4 * 4 + 3] = o.w;
      ss += o.x * o.x + o.y * o.y + o.z * o.z + o.w * o.w;
      if (l == 1) *reinterpret_cast<float4*>(P.out + (size_t)t * 1024 + d) = o;
      else *reinterpret_cast<uint2*>(P.X + (size_t)t * 1024 + d) = make_uint2(pack2(o.x, o.y), pack2(o.z, o.w));
    }
    if (l == 0) {
      ss = wave_sum(ss);
      const float rr = rsqrtf(ss * (1.f / 1024.f) + EPS);
      const float* lnw = P.ln1_w + 1024;
      const float* mod = P.MOD + (size_t)(9 + bi) * 6144;
      unsigned pk[8];
#pragma unroll
      for (int i = 0; i < 16; i += 2) {
        const float o0 = xn[i] * rr * lnw[d0 + i] * (1.f + mod[1024 + d0 + i]) + mod[d0 + i];
        const float o1 = xn[i + 1] * rr * lnw[d0 + i + 1] * (1.f + mod[1024 + d0 + i + 1]) + mod[d0 + i + 1];
        pk[i >> 1] = pack2(o0, o1);
      }
      *reinterpret_cast<uint4*>(P.H + (size_t)t * 1024 + d0) = make_uint4(pk[0], pk[1], pk[2], pk[3]);
      *reinterpret_cast<uint4*>(P.H + (size_t)t * 1024 + d0 + 8) = make_uint4(pk[4], pk[5], pk[6], pk[7]);
    }
  }
}

using f32x4 = __attribute__((ext_vector_type(4))) float;
namespace g8 {
constexpr int BM = 256, BK = 64, HALF = 128, HT = HALF * BK;
DEVI int lds_byte(int r, int c) { const int st = (r >> 4) * 2 + (c >> 5), rr = r & 15, cc = c & 31, ob = rr * 64 + cc * 2; return st * 1024 + (ob ^ (((ob >> 9) & 1) << 5)); }
DEVI void stage_rc(int b, int& R, int& C) { const int st = b / 1024, sb = b % 1024, swz = sb ^ (((sb >> 9) & 1) << 5); R = (st >> 1) * 16 + swz / 64; C = (st & 1) * 32 + (swz % 64) / 2; }
DEVI int perm32(int rho) { const int n = rho >> 4, i = rho & 15; return 8 * (i >> 2) + 4 * n + (i & 3); }
DEVI void unit_of(int L, int nM, int nN, int& pm, int& pn) {
  const int nwg = nM * nN;
  int wgid = L;
  { const int q = nwg / 8, r = nwg % 8, xcd = wgid % 8, off = wgid / 8; wgid = (xcd < r ? xcd * (q + 1) : r * (q + 1) + (xcd - r) * q) + off; }
  const int nig = 8 * nN, gid = wgid / nig, fm = gid * 8, gsz = (nM - fm) < 8 ? (nM - fm) : 8;
  pm = fm + ((wgid % nig) % gsz); pn = (wgid % nig) / gsz;
}
}

struct G8Unit { int pm, pn; };
template <class Epi>
DEVI void gemm8_phase(LAS unsigned char* lds, const bf16* __restrict__ Ag, const bf16* __restrict__ Btg, const int K, const int nM, const int nN, const Epi& E,
                      const int lda = 0, const int pn_split = 1 << 30, const int acol0 = 0, const int acol1 = 0,
                      const int ldb = 0, const int pn_mod = 1 << 30, const int ksplit_cols = 0) {
  constexpr int BK = 64, HALF = 128, HTB = HALF * BK * 2;
  const int tid = threadIdx.x, wid = __builtin_amdgcn_readfirstlane(tid >> 6), lane = tid & 63, wr = wid >> 2, wc = wid & 3, fr = lane & 15, fq = lane >> 4;
  const int nt = K / BK;
  const int nunits = nM * nN, G = gridDim.x, c = blockIdx.x;
  const int LDA = lda ? lda : K, LDB = ldb ? ldb : K;
  unsigned voffA[2], voffB[2];
#pragma unroll
  for (int i = 0; i < 2; ++i) { int R, C; g8::stage_rc(tid * 16 + i * 8192, R, C); const int Rb = (R & ~31) + g8::perm32(R & 31); voffA[i] = (unsigned)(R * LDA + C) * 2u; voffB[i] = (unsigned)(Rb * LDB + C) * 2u; }
  const size_t kstep = (size_t)(BK * 2);
  const size_t hstepA = (size_t)HALF * LDA * 2, hstep = (size_t)HALF * LDB * 2;
  const size_t tstepA = 2 * hstepA, tstep = 2 * hstep;
  const unsigned ldsw = (unsigned)wid * 1024u;
  const int aoff = g8::lds_byte(wr * 64 + fr, fq * 8), boff = g8::lds_byte(wc * 32 + fr, fq * 8);
#define PG8_SA(b, h) (((b) * 2 + (h)) * HTB)
#define PG8_SB(b, h) ((4 + (b) * 2 + (h)) * HTB)
#define PG8_STAGE(bufoff, gbase, voff) do { _Pragma("unroll") for (int _i = 0; _i < 2; ++_i) \
        __builtin_amdgcn_global_load_lds((const unsigned*)((const char*)(gbase) + (voff)[_i]), (LAS unsigned*)(lds + (bufoff) + ldsw + _i * 8192), 16, 0, 0); } while (0)
#define PG8_LDA(dst, b, h) do { _Pragma("unroll") for (int m = 0; m < 4; ++m) _Pragma("unroll") for (int k = 0; k < 2; ++k) dst[m][k] = *(const LAS bf16x8*)(lds + PG8_SA(b, h) + aoff + m * 2048 + k * 1024); } while (0)
#define PG8_LDB(dst, b, h) do { _Pragma("unroll") for (int n = 0; n < 2; ++n) _Pragma("unroll") for (int k = 0; k < 2; ++k) dst[n][k] = *(const LAS bf16x8*)(lds + PG8_SB(b, h) + boff + n * 2048 + k * 1024); } while (0)
#define PG8_MMA(ai, bj, At_, Bt_) do { __builtin_amdgcn_s_setprio(1); _Pragma("unroll") for (int m = 0; m < 4; ++m) _Pragma("unroll") for (int n = 0; n < 2; ++n) _Pragma("unroll") for (int k = 0; k < 2; ++k) \
        acc[ai][bj][m][n] = __builtin_amdgcn_mfma_f32_16x16x32_bf16(Bt_[n][k], At_[m][k], acc[ai][bj][m][n], 0, 0, 0); __builtin_amdgcn_s_setprio(0); } while (0)
#define PG8_WAIT_V(n) asm volatile("s_waitcnt vmcnt(" #n ")" ::: "memory")
#define PG8_WAIT_L(n) asm volatile("s_waitcnt lgkmcnt(" #n ")" ::: "memory")
#define PG8_BAR __builtin_amdgcn_s_barrier()
#define PG8_SCHED __builtin_amdgcn_sched_barrier(0)
  G8Unit cur, nxt; int ui = 0;
  if (c >= nunits) return;
  g8::unit_of(c, nM, nN, cur.pm, cur.pn);
  f32x4 acc[2][2][4][2];
#pragma unroll
  for (int a = 0; a < 2; ++a)
#pragma unroll
    for (int b = 0; b < 2; ++b)
#pragma unroll
      for (int m = 0; m < 4; ++m)
#pragma unroll
        for (int n = 0; n < 2; ++n) acc[a][b][m][n] = (f32x4){0.f, 0.f, 0.f, 0.f};
  bf16x8 At[4][2], B0[2][2], B1[2][2];
  const char* cA = (const char*)Ag + (size_t)cur.pm * tstepA + (size_t)((cur.pn < pn_split ? acol0 : acol1) + (cur.pn / pn_mod) * ksplit_cols) * 2;
  const char* cB = (const char*)Btg + (size_t)(cur.pn % pn_mod) * tstep + (size_t)((cur.pn / pn_mod) * ksplit_cols) * 2;
  PG8_STAGE(PG8_SB(0, 0), cB, voffB); PG8_STAGE(PG8_SA(0, 0), cA, voffA); PG8_STAGE(PG8_SB(0, 1), cB + hstep, voffB); PG8_STAGE(PG8_SA(0, 1), cA + hstepA, voffA);
  if (wr == 1) PG8_BAR;
  PG8_WAIT_V(4); PG8_BAR;
  PG8_STAGE(PG8_SB(1, 0), cB + kstep, voffB); PG8_STAGE(PG8_SA(1, 0), cA + kstep, voffA); PG8_STAGE(PG8_SB(1, 1), cB + hstep + kstep, voffB);
  PG8_WAIT_V(6); PG8_BAR;
  for (;;) {
    const long Ln = (long)(ui + 1) * G + c;
    const bool has_next = Ln < nunits;
    if (has_next) g8::unit_of((int)Ln, nM, nN, nxt.pm, nxt.pn);
    const char* nA = has_next ? (const char*)Ag + (size_t)nxt.pm * tstepA + (size_t)((nxt.pn < pn_split ? acol0 : acol1) + (nxt.pn / pn_mod) * ksplit_cols) * 2 : cA;
    const char* nB = has_next ? (const char*)Btg + (size_t)(nxt.pn % pn_mod) * tstep + (size_t)((nxt.pn / pn_mod) * ksplit_cols) * 2 : cB;
    for (int t = 0; t < nt; t += 2) {
      const bool last = (t == nt - 2);
      const char* a1 = cA + (size_t)(t + 1) * kstep;
      const char* a2 = last ? nA : cA + (size_t)(t + 2) * kstep; const char* b2 = last ? nB : cB + (size_t)(t + 2) * kstep;
      const char* a3 = a2 + kstep; const char* b3 = b2 + kstep;
      PG8_LDB(B0, 0, 0); PG8_SCHED; PG8_LDA(At, 0, 0); PG8_STAGE(PG8_SA(1, 1), a1 + hstepA, voffA);
      PG8_WAIT_L(8); PG8_BAR; PG8_WAIT_L(0); PG8_MMA(0, 0, At, B0); PG8_BAR; PG8_SCHED;
      PG8_LDB(B1, 0, 1); PG8_STAGE(PG8_SB(0, 0), b2, voffB);
      PG8_BAR; PG8_WAIT_L(0); PG8_MMA(0, 1, At, B1); PG8_BAR;
      PG8_LDA(At, 0, 1); PG8_STAGE(PG8_SA(0, 0), a2, voffA);
      PG8_BAR; PG8_WAIT_L(0); PG8_MMA(1, 0, At, B0); PG8_BAR; PG8_SCHED;
      PG8_STAGE(PG8_SB(0, 1), b2 + hstep, voffB);
      PG8_WAIT_V(6); PG8_BAR; PG8_MMA(1, 1, At, B1); PG8_BAR;
      PG8_LDB(B0, 1, 0); PG8_SCHED; PG8_LDA(At, 1, 0); PG8_STAGE(PG8_SA(0, 1), a2 + hstepA, voffA);
      PG8_WAIT_L(8); PG8_BAR; PG8_WAIT_L(0); PG8_MMA(0, 0, At, B0); PG8_BAR; PG8_SCHED;
      PG8_LDB(B1, 1, 1); PG8_STAGE(PG8_SB(1, 0), b3, voffB);
      PG8_BAR; PG8_WAIT_L(0); PG8_MMA(0, 1, At, B1); PG8_BAR;
      PG8_LDA(At, 1, 1); PG8_STAGE(PG8_SA(1, 0), a3, voffA);
      PG8_BAR; PG8_WAIT_L(0); PG8_MMA(1, 0, At, B0); PG8_BAR; PG8_SCHED;
      PG8_STAGE(PG8_SB(1, 1), b3 + hstep, voffB);
      PG8_WAIT_V(6); PG8_BAR; PG8_MMA(1, 1, At, B1); PG8_BAR;
    }
    E(acc, cur, wr, wc, fr, fq);
    if (!has_next) break;
#pragma unroll
    for (int a = 0; a < 2; ++a)
#pragma unroll
      for (int b = 0; b < 2; ++b)
#pragma unroll
        for (int m = 0; m < 4; ++m)
#pragma unroll
          for (int n = 0; n < 2; ++n) acc[a][b][m][n] = (f32x4){0.f, 0.f, 0.f, 0.f};
    cur = nxt; cA = nA; cB = nB; ++ui;
  }
  PG8_WAIT_V(0);
  if (wr == 0) PG8_BAR;
  PG8_BAR;
#undef PG8_SA
#undef PG8_SB
#undef PG8_STAGE
#undef PG8_LDA
#undef PG8_LDB
#undef PG8_MMA
}

struct EpiZ {
  bf16* Z;
  DEVI void operator()(const f32x4 (&acc)[2][2][4][2], const G8Unit& u, int wr, int wc, int fr, int fq) const {
    const int brow = u.pm * 256, bcol = u.pn * 256;
#pragma unroll
    for (int ai = 0; ai < 2; ++ai)
#pragma unroll
      for (int m = 0; m < 4; ++m) {
        const int row = brow + ai * 128 + wr * 64 + m * 16 + fr;
#pragma unroll
        for (int bj = 0; bj < 2; ++bj) {
          const int col = bcol + bj * 128 + wc * 32 + 8 * fq;
          if (col < DIN) {
            const f32x4 v0 = acc[ai][bj][m][0], v1 = acc[ai][bj][m][1];
            *reinterpret_cast<uint4*>(Z + (size_t)row * DIN + col) = make_uint4(pack2(v0[0], v0[1]), pack2(v0[2], v0[3]), pack2(v1[0], v1[1]), pack2(v1[2], v1[3]));
          }
        }
      }
  }
};
DEVI void phase_gemm1_8(const Params& P, int l, unsigned char* smem_base) {
  EpiZ E{P.Z};
  gemm8_phase((LAS unsigned char*)smem_base, P.H, P.WinT + (size_t)l * DINP * 1024, 1024, NT / 256, DINP / 256, E);
  const int c = blockIdx.x;
  if (c >= 136) {
    const int j = c - 136;
    if (l == 0) convert_rows_fp6(P, 0, j * 100, j * 100 + 100);
    else { const int b0 = 19200 + j * 114; convert_rows_fp6(P, 1, b0 < 32768 ? b0 : 32768, b0 + 114 < 32768 ? b0 + 114 : 32768); }
  }
}

struct EpiRAW {
  bf16* R;
  DEVI void operator()(const f32x4 (&acc)[2][2][4][2], const G8Unit& u, int wr, int wc, int fr, int fq) const {
    const int brow = u.pm * 256, bcol = u.pn * 256;
#pragma unroll
    for (int ai = 0; ai < 2; ++ai)
#pragma unroll
      for (int m = 0; m < 4; ++m) {
        const int row = brow + ai * 128 + wr * 64 + m * 16 + fr;
#pragma unroll
        for (int bj = 0; bj < 2; ++bj) {
          const int col = bcol + bj * 128 + wc * 32 + 8 * fq;
          const f32x4 v0 = acc[ai][bj][m][0], v1 = acc[ai][bj][m][1];
          *reinterpret_cast<uint4*>(R + (size_t)row * 1792 + col) = make_uint4(pack2(v0[0], v0[1]), pack2(v0[2], v0[3]), pack2(v1[0], v1[1]), pack2(v1[2], v1[3]));
        }
      }
  }
};
DEVI void phase_mla_raw(const Params& P, int l, unsigned char* smem_base) {
  {
    const int lane = threadIdx.x & 63;
    for (int t = blockIdx.x * 8 + (threadIdx.x >> 6); t < NT; t += gridDim.x * 8) {
      const bf16* zr = P.Z + (size_t)t * DIN;
      const uint2 uq = *reinterpret_cast<const uint2*>(zr + ZC_BQ + lane * 4);
      const unsigned uk = *reinterpret_cast<const unsigned*>(zr + ZC_BKV + lane * 2);
      float sq = lo2f(uq.x) * lo2f(uq.x) + hi2f(uq.x) * hi2f(uq.x) + lo2f(uq.y) * lo2f(uq.y) + hi2f(uq.y) * hi2f(uq.y);
      float sk = lo2f(uk) * lo2f(uk) + hi2f(uk) * hi2f(uk);
      sq = wave_sum(sq); sk = wave_sum(sk);
      if (lane == 0) { P.RS[(size_t)t * 2] = rsqrtf(sq * (1.f / 256.f) + EPS); P.RS[(size_t)t * 2 + 1] = rsqrtf(sk * (1.f / 128.f) + EPS); }
    }
  }
  EpiRAW E{P.RAW};
  gemm8_phase((LAS unsigned char*)smem_base, P.Z, P.WCOMB + (size_t)l * 1792 * 256, 256, NT / 256, 7, E, DIN, 3, ZC_BQ, ZC_BKV);
}

struct EpiX {
  const float* x; const float* ctx; bf16* X; const float* MODl; int l;
  DEVI void operator()(const f32x4 (&acc)[2][2][4][2], const G8Unit& u, int wr, int wc, int fr, int fq) const {
    const int brow = u.pm * 256, bcol = u.pn * 256;
    const float* gate = MODl + (size_t)batch_of_row(brow) * 6144 + 2048;
#pragma unroll
    for (int ai = 0; ai < 2; ++ai)
#pragma unroll
      for (int m = 0; m < 4; ++m) {
        const int row = brow + ai * 128 + wr * 64 + m * 16 + fr;
        const float* res = row < NL ? x + (size_t)row * 1024 : ctx + (size_t)(row - NL) * 1024;
#pragma unroll
        for (int bj = 0; bj < 2; ++bj) {
          const int col = bcol + bj * 128 + wc * 32 + 8 * fq;
          const f32x4 v0 = acc[ai][bj][m][0], v1 = acc[ai][bj][m][1];
          float4 ra, rb;
          if (l == 0) { ra = *reinterpret_cast<const float4*>(res + col); rb = *reinterpret_cast<const float4*>(res + col + 4); }
          else {
            const uint4 uu = *reinterpret_cast<const uint4*>(X + (size_t)row * 1024 + col);
            ra = make_float4(lo2f(uu.x), hi2f(uu.x), lo2f(uu.y), hi2f(uu.y)); rb = make_float4(lo2f(uu.z), hi2f(uu.z), lo2f(uu.w), hi2f(uu.w));
          }
          const float4 ga = *reinterpret_cast<const float4*>(gate + col), gb = *reinterpret_cast<const float4*>(gate + col + 4);
          *reinterpret_cast<uint4*>(X + (size_t)row * 1024 + col) =
              make_uint4(pack2(ra.x + ga.x * v0[0], ra.y + ga.y * v0[1]), pack2(ra.z + ga.z * v0[2], ra.w + ga.w * v0[3]),
                         pack2(rb.x + gb.x * v1[0], rb.y + gb.y * v1[1]), pack2(rb.z + gb.z * v1[2], rb.w + gb.w * v1[3]));
        }
      }
  }
};
struct EpiPart {
  float* PART;
  DEVI void operator()(const f32x4 (&acc)[2][2][4][2], const G8Unit& u, int wr, int wc, int fr, int fq) const {
    const int brow = u.pm * 256, bcol = (u.pn & 3) * 256;
    float* base = PART + (size_t)(u.pn >> 2) * 2048 * 1024;
#pragma unroll
    for (int ai = 0; ai < 2; ++ai)
#pragma unroll
      for (int m = 0; m < 4; ++m) {
        const int row = brow + ai * 128 + wr * 64 + m * 16 + fr;
#pragma unroll
        for (int bj = 0; bj < 2; ++bj) {
          const int col = bcol + bj * 128 + wc * 32 + 8 * fq;
          const f32x4 v0 = acc[ai][bj][m][0], v1 = acc[ai][bj][m][1];
          *reinterpret_cast<float4*>(base + (size_t)row * 1024 + col) = make_float4(v0[0], v0[1], v0[2], v0[3]);
          *reinterpret_cast<float4*>(base + (size_t)row * 1024 + col + 4) = make_float4(v1[0], v1[1], v1[2], v1[3]);
        }
      }
  }
};
DEVI void phase_gemm2_8(const Params& P, int l, unsigned char* smem_base) {
  EpiX E{P.x, P.ctx, P.X, P.MOD + (size_t)l * 9 * 6144, l};
  gemm8_phase((LAS unsigned char*)smem_base, P.H, P.WoutT + (size_t)l * 1024 * 1024, 1024, NL / 256, 4, E);
  if (l == 0) {
    EpiPart EP{P.PART};
    gemm8_phase((LAS unsigned char*)smem_base, P.H + (size_t)NL * 1024, P.WoutT, 512, 8, 8, EP, 1024, 1 << 30, 0, 0, 1024, 4, 512);
    const int c = blockIdx.x;
    if (c >= 64) {
      const int b0 = 12000 + (c - 64) * 109;
      convert_rows_fp6(P, 0, b0 < 32768 ? b0 : 32768, b0 + 109 < 32768 ? b0 + 109 : 32768);
    }
  }
}

struct EpiQP {
  bf16* QP;
  DEVI void operator()(const f32x4 (&acc)[2][2][4][2], const G8Unit& u, int wr, int wc, int fr, int fq) const {
    const int brow = u.pm * 256, bcol = u.pn * 256;
#pragma unroll
    for (int ai = 0; ai < 2; ++ai)
#pragma unroll
      for (int m = 0; m < 4; ++m) {
        const int row = brow + ai * 128 + wr * 64 + m * 16 + fr;
#pragma unroll
        for (int bj = 0; bj < 2; ++bj) {
          const int col = bcol + bj * 128 + wc * 32 + 8 * fq;
          const f32x4 v0 = acc[ai][bj][m][0], v1 = acc[ai][bj][m][1];
          *reinterpret_cast<uint4*>(QP + (size_t)row * 2048 + col) = make_uint4(pack2(v0[0], v0[1]), pack2(v0[2], v0[3]), pack2(v1[0], v1[1]), pack2(v1[2], v1[3]));
        }
      }
  }
};
DEVI void phase_gemm3_8(const Params& P, int l, unsigned char* smem_base) {
  EpiQP E{P.QP};
  gemm8_phase((LAS unsigned char*)smem_base, P.H, P.WpqT + (size_t)l * 2048 * 1024, 1024, (l == 1) ? NL / 256 : NT / 256, 8, E);
  const int c = blockIdx.x;
  if (l == 0 && c >= 64) convert_rows_fp6(P, 1, (c - 64) * 100, (c - 64) * 100 + 100);
}

constexpr int N_PHASES = 2 + 2 * 11;

#ifndef REP_MASK
#define REP_MASK 0
#endif
static_assert(sizeof(Params) % 8 == 0, "Params size");
DEVI Params load_params() {
#if defined(__HIP_DEVICE_COMPILE__)
  typedef const __attribute__((address_space(4))) Params* ParamsCP;
  ParamsCP pp = (ParamsCP)__builtin_amdgcn_kernarg_segment_ptr();
  asm volatile("" : "+s"(pp));
  return *pp;
#else
  return Params{};
#endif
}
__global__ void __launch_bounds__(512, 2) fwd_kernel(Params Pk) {
  extern __shared__ __attribute__((aligned(16))) unsigned char smem_base[];
  volatile LAS unsigned* xst = (volatile LAS unsigned*)(smem_base + SMEM_BYTES);
  if (threadIdx.x == 0) { xst[0] = 0u; xst[1] = 0u; xst[2] = 0u; xst[3] = 0u; }
  __syncthreads();
  XcdBarrier xb = xcd_barrier_post(Pk.bar, xst);
  const int phase_lo = Pk.phase_lo, phase_hi = Pk.phase_hi, coop = Pk.coop;
#define smem (smem_base + VHALF * HALF_LDS)
#define GSYNC(idx) { xcd_barrier(xb); }
#define RUN_PHASE2(idx, call, repcall) \
  if (phase_lo <= (idx) && (idx) <= phase_hi) { { const Params P = load_params(); call; } if (REP_MASK & (1 << (idx))) { GSYNC(1); const Params P = load_params(); repcall; } if (coop && (idx) < phase_hi) GSYNC(idx); }
#define RUN_PHASE(idx, call) RUN_PHASE2(idx, call, call)
  RUN_PHASE(0, phase_prologue(P, smem))
  RUN_PHASE(1, phase_norm(P, 0, 0, NT))
  RUN_PHASE(2, phase_gemm1_8(P, 0, smem_base))
  RUN_PHASE(3, phase_mla_raw(P, 0, smem_base))
  RUN_PHASE(4, { phase_mixA(P, 0, smem); phase_mla_proj(P, 0, smem); phase_hgrn_local(P, 0, smem); })
  RUN_PHASE2(5, phase_attn_scan(P, 0, smem_base), phase_attn_scan(P, 0, smem_base, true))
  RUN_PHASE(6, phase_hgrn_final(P, 0, smem))
  RUN_PHASE(7, phase_gemm2_8(P, 0, smem_base))
  RUN_PHASE(8, phase_norm(P, 0, 1, NT))
  RUN_PHASE(9, phase_gemm3_8(P, 0, smem_base))
  RUN_PHASE(10, phase_route(P, 0, smem))
  RUN_PHASE(11, phase_peer_u(P, 0))
  RUN_PHASE(12, phase_peer(P, 0))
  RUN_PHASE(13, phase_gemm1_8(P, 1, smem_base))
  RUN_PHASE(14, phase_mla_raw(P, 1, smem_base))
  RUN_PHASE(15, { phase_mixA(P, 1, smem); phase_mla_proj(P, 1, smem); phase_hgrn_local(P, 1, smem); })
  RUN_PHASE2(16, phase_attn_scan(P, 1, smem_base), phase_attn_scan(P, 1, smem_base, true))
  RUN_PHASE(17, phase_hgrn_final(P, 1, smem))
  RUN_PHASE(18, phase_gemm2_8(P, 1, smem_base))
  RUN_PHASE(19, phase_norm(P, 1, 1, NL))
  RUN_PHASE(20, phase_gemm3_8(P, 1, smem_base))
  RUN_PHASE(21, phase_route(P, 1, smem))
  RUN_PHASE(22, phase_peer_u(P, 1))
  RUN_PHASE(23, phase_peer(P, 1))
#undef smem
}

extern "C" void kernel_launch(void* const* d_in, const int* in_sizes, int n_in, void* d_out, int out_size, void* d_ws,
                              size_t ws_size, hipStream_t stream) {
  Params p{};
  const float* const* in = reinterpret_cast<const float* const*>(d_in);
  p.x = in[0]; p.c = in[1]; p.ctx = in[2]; p.c_ctx = in[3]; p.ln1_w = in[4]; p.ln2_w = in[5]; p.w_mod = in[6]; p.b_mod = in[7];
  p.w_in = in[8]; p.w_out = in[9]; p.a_norm_w = in[10]; p.a_w_s = in[11]; p.a_b_s = in[12]; p.b_q_norm_w = in[13]; p.b_w_uq = in[14];
  p.b_kv_norm_w = in[15]; p.b_w_ukv = in[16]; p.b_qh_w = in[17]; p.b_kh_w = in[18]; p.c_lb = in[19]; p.c_out_norm_w = in[20];
  p.p_w_q = in[21]; p.p_sub_keys = in[22]; p.p_u = in[23]; p.p_v = in[24];
  p.out = reinterpret_cast<float*>(d_out);
  unsigned char* ws = reinterpret_cast<unsigned char*>(d_ws);
  size_t off = 0;
  auto take = [&](size_t bytes) { unsigned char* r = ws + off; off += (bytes + 255) & ~(size_t)255; return r; };
  p.bar = (unsigned*)take((size_t)XCD_BAR_WORDS * 4);
  p.MOD = (float*)take((size_t)2 * 9 * 6144 * 4);
  p.ROPE = (float*)take((size_t)2048 * 32 * 4);
  p.WinT = (bf16*)take((size_t)2 * DINP * 1024 * 2);
  p.WoutT = (bf16*)take((size_t)2 * 1024 * 1024 * 2);
  p.WpqT = (bf16*)take((size_t)2 * 2048 * 1024 * 2);
  p.WCOMB = (bf16*)take((size_t)2 * 1792 * 256 * 2);
  p.RAW = (bf16*)take((size_t)NT * 1792 * 2);
  p.SK = (bf16*)take((size_t)2 * 16 * 128 * 128 * 2);
  p.AWS = (bf16*)take((size_t)2 * 4 * 128 * 128 * 2);
  p.PU8 = (unsigned char*)take((size_t)2 * 16384 * 576);
  p.PV8 = (unsigned char*)take((size_t)2 * 16384 * 576);
  p.PUS = (float*)take((size_t)2 * 16384 * 4);
  p.PVS = (float*)take((size_t)2 * 16384 * 4);
  p.X = (bf16*)take((size_t)NT * 1024 * 2);
  p.H = (bf16*)take((size_t)NT * 1024 * 2);
  p.Z = (bf16*)take((size_t)NT * DIN * 2);
  p.Q = (bf16*)take((size_t)64 * SEQP * 96 * 2);
  p.K = (bf16*)take((size_t)64 * SEQP * 96 * 2);
  p.VT = (bf16*)take((size_t)64 * 64 * SEQP * 2);
  p.ST = (bf16*)take((size_t)64 * 36 * 4096 * 2);
  p.DEC = (float*)take((size_t)64 * 36 * 64 * 4);
  p.OI = (bf16*)take((size_t)NT * 256 * 2);
  p.WPE = (float*)take((size_t)NT * 128 * 4);
  p.PART = (float*)take((size_t)2 * 2048 * 1024 * 4);
  p.RS = (float*)take((size_t)NT * 2 * 4);
  p.GQF = (bf16*)take((size_t)NT * 256 * 2);
  p.GQB = (bf16*)take((size_t)NT * 256 * 2);
  p.QP = p.Z;
  p.EIDX = (int*)p.Q;
  p.GATE = (float*)p.K;
  if (off > ws_size) { fprintf(stderr, "workspace too small: need %zu have %zu\n", off, ws_size); }
  static int grid_blocks = 0;
  if (!grid_blocks) {
    if (hipFuncSetAttribute((const void*)fwd_kernel, hipFuncAttributeMaxDynamicSharedMemorySize, SMEM_TOTAL) != hipSuccess)
      fprintf(stderr, "hipFuncSetAttribute failed\n");
    int dev = 0, cus = 0, per_cu = 0;
    hipGetDevice(&dev);
    hipDeviceGetAttribute(&cus, hipDeviceAttributeMultiprocessorCount, dev);
    hipOccupancyMaxActiveBlocksPerMultiprocessor(&per_cu, (const void*)fwd_kernel, 512, SMEM_TOTAL);
    if (per_cu > 1) per_cu = 1;
    if (per_cu < 1) { fprintf(stderr, "occupancy query returned %d\n", per_cu); per_cu = 1; }
    grid_blocks = cus * per_cu;
    fprintf(stderr, "grid_blocks=%d (cus=%d per_cu=%d) ws need=%zu have=%zu\n", grid_blocks, cus, per_cu, off, ws_size);
  }
  hipMemsetAsync(p.bar, 0, (size_t)XCD_BAR_WORDS * 4, stream);
  p.coop = 1; p.phase_lo = 0; p.phase_hi = N_PHASES - 1;
  hipLaunchKernelGGL(fwd_kernel, dim3(grid_blocks), dim3(512), SMEM_TOTAL, stream, p);
  const hipError_t e = hipPeekAtLastError();
  if (e != hipSuccess) fprintf(stderr, "launch failed: %s (grid %d)\n", hipGetErrorString(e), grid_blocks);
}
```

```cpp
#include <hip/hip_runtime.h>
#include <hip/hip_cooperative_groups.h>
#include <cstdio>
#include <cstdint>
namespace cg = cooperative_groups;

#define DEVI __device__ __forceinline__

typedef unsigned short bf16;
using bf16x8 = __attribute__((ext_vector_type(8))) __bf16;
using bf16x2 = __attribute__((ext_vector_type(2))) __bf16;
using f32x16 = __attribute__((ext_vector_type(16))) float;
typedef unsigned v6u __attribute__((ext_vector_type(6)));
typedef unsigned v3u __attribute__((ext_vector_type(3)));
typedef float v16f __attribute__((ext_vector_type(16)));
typedef float v32f __attribute__((ext_vector_type(32)));

constexpr int NL = 16384;
constexpr int NT = 18432;
constexpr int DM = 1024;
constexpr int DIN = 2208;
constexpr int DINP = 2304;
constexpr int SEQP = 2304;
constexpr float EPS = 1e-6f;
constexpr int ZC_AU = 0, ZC_AV = 256, ZC_BQ = 512, ZC_BKV = 768, ZC_BKR = 896, ZC_CQ = 928, ZC_CFF = 1184, ZC_CFB = 1440, ZC_CI = 1696, ZC_CG = 1952;
constexpr int SMEM_BYTES = 2 * 80896;
constexpr int SMEM_TOTAL = SMEM_BYTES + 16;

struct Params {
  const float *x, *c, *ctx, *c_ctx, *ln1_w, *ln2_w, *w_mod, *b_mod, *w_in, *w_out, *a_norm_w, *a_w_s, *a_b_s;
  const float *b_q_norm_w, *b_w_uq, *b_kv_norm_w, *b_w_ukv, *b_qh_w, *b_kh_w, *c_lb, *c_out_norm_w, *p_w_q, *p_sub_keys, *p_u, *p_v;
  float* out;
  unsigned* bar;
  float* MOD;
  float* ROPE;
  bf16* WinT;
  bf16* WoutT;
  bf16* WpqT;
  bf16* WCOMB;
  bf16* RAW;
  bf16* SK;
  bf16* AWS;
  unsigned char* PU8;
  unsigned char* PV8;
  float* PUS;
  float* PVS;
  bf16* X;
  bf16* H;
  bf16* Z;
  bf16* Q;
  bf16* K;
  bf16* VT;
  bf16* ST;
  float* DEC;
  bf16* OI;
  float* WPE;
  float* RS;
  float* PART;
  bf16* GQF;
  bf16* GQB;
  bf16* QP;
  int* EIDX;
  float* XB;
  unsigned* ncnt;
  float* GATE;
  int phase_lo, phase_hi, coop, pad0;
};

DEVI float bf2f(bf16 v) { return __uint_as_float(((unsigned)v) << 16); }
DEVI bf16 f2bf(float a) { __bf16 v = (__bf16)a; return __builtin_bit_cast(unsigned short, v); }
DEVI unsigned pack2(float a, float b) { bf16x2 v; v[0] = (__bf16)a; v[1] = (__bf16)b; return __builtin_bit_cast(unsigned, v); }
DEVI float lo2f(unsigned u) { return __uint_as_float(u << 16); }
DEVI float hi2f(unsigned u) { return __uint_as_float(u & 0xffff0000u); }
DEVI f32x16 zero16() { f32x16 z;
#pragma unroll
  for (int i = 0; i < 16; ++i) z[i] = 0.f; return z; }
DEVI f32x16 mfma32(bf16x8 a, bf16x8 b, f32x16 c) { return __builtin_amdgcn_mfma_f32_32x32x16_bf16(a, b, c, 0, 0, 0); }
DEVI bf16x8 ldfrag(const bf16* p) { return *reinterpret_cast<const bf16x8*>(p); }
DEVI int drow(int r, int hh) { return (r & 3) + 8 * (r >> 2) + 4 * hh; }
DEVI int row_of(int b, int p) { return p < 256 ? NL + b * 256 + p : b * 2048 + (p - 256); }
DEVI int batch_of_row(int r) { return r < NL ? (r >> 11) : 8; }
DEVI float wave_sum(float v) {
#pragma unroll
  for (int o = 32; o > 0; o >>= 1) v += __shfl_xor(v, o);
  return v;
}
DEVI float sigmoidf_(float z) { return 1.f / (1.f + __expf(-z)); }


#define XB_TMO      128
#define XB_XCNT(j)  (256  + 64 * (j))
#define XB_XSUB(j)  (1280 + 64 * (j))
#define XB_XGEN(j)  (2304 + 64 * (j))
#define XB_TOP      3328
#define XB_TOPGEN   3392
#define XCD_BAR_WORDS 3456
#define XB_SPIN_CAP (1u << 22)
#define LAS __attribute__((address_space(3)))
DEVI unsigned xb_ld(unsigned* p)              { return __hip_atomic_load(p, __ATOMIC_RELAXED, __HIP_MEMORY_SCOPE_AGENT); }
DEVI unsigned xb_add(unsigned* p, unsigned v) { return __hip_atomic_fetch_add(p, v, __ATOMIC_RELAXED, __HIP_MEMORY_SCOPE_AGENT); }
DEVI unsigned xb_xcc_id() { return (unsigned)__builtin_amdgcn_s_getreg((3 << 11) | 20) & 0xFu; }
#define XB_SPIN(cond, bar) do { unsigned _sp = 0; while (cond) { __builtin_amdgcn_s_sleep(1); \
    if ((++_sp & 255u) == 0u) { if (xb_ld(&(bar)[XB_TMO])) break; if (_sp > XB_SPIN_CAP) { atomicAdd(&(bar)[XB_TMO], 1u); break; } } } } while (0)
struct XcdBarrier { unsigned* bar; unsigned x; volatile LAS unsigned* st; };
DEVI XcdBarrier xcd_barrier_post(unsigned* bar, volatile LAS unsigned* st) {
  XcdBarrier b; b.bar = bar; b.x = xb_xcc_id(); b.st = st;
  if (threadIdx.x == 0) (void)xb_add(&bar[XB_XCNT(b.x)], 1u);
  return b;
}
DEVI void xcd_barrier_complete(unsigned* bar, unsigned x, unsigned& nloc, unsigned& nx) {
  const unsigned G = gridDim.x * gridDim.y * gridDim.z;
  unsigned sum, cnt, mine, sp = 0u;
  for (;;) {
    sum = 0u; cnt = 0u; mine = 0u;
#pragma unroll
    for (unsigned j = 0; j < 16; ++j) { const unsigned c = xb_ld(&bar[XB_XCNT(j)]); sum += c; cnt += (c > 0u) ? 1u : 0u; mine = (j == x) ? c : mine; }
    if (sum == G) break;
    __builtin_amdgcn_s_sleep(1);
    if ((++sp & 255u) == 0u) { if (xb_ld(&bar[XB_TMO])) break; if (sp > XB_SPIN_CAP) { atomicAdd(&bar[XB_TMO], 1u); break; } }
  }
  nloc = mine > 0u ? mine : 1u; nx = cnt > 0u ? cnt : 1u;
}
DEVI void xcd_barrier(const XcdBarrier& b) {
  asm volatile("s_waitcnt vmcnt(0)" ::: "memory");
  __syncthreads();
  if (threadIdx.x == 0) {
    unsigned* bar = b.bar;
    __builtin_amdgcn_s_waitcnt(0);
    unsigned nloc = b.st[0], nx = b.st[1];
    if (nloc == 0u) { xcd_barrier_complete(bar, b.x, nloc, nx); b.st[0] = nloc; b.st[1] = nx; }
    const unsigned old = xb_add(&bar[XB_XSUB(b.x)], 1u);
    const unsigned gen = old / nloc;
    if (old + 1u == (gen + 1u) * nloc) {
      __builtin_amdgcn_fence(__ATOMIC_RELEASE, "agent");
      asm volatile("s_waitcnt vmcnt(0)" ::: "memory");
      const unsigned og = xb_add(&bar[XB_TOP], 1u);
      const unsigned tg = og / nx;
      if (og + 1u == (tg + 1u) * nx) xb_add(&bar[XB_TOPGEN], 1u);
      else XB_SPIN(xb_ld(&bar[XB_TOPGEN]) == tg, bar);
      __builtin_amdgcn_fence(__ATOMIC_ACQUIRE, "agent");
      xb_add(&bar[XB_XGEN(b.x)], 1u);
      asm volatile("s_waitcnt vmcnt(0)" ::: "memory");
    } else {
      XB_SPIN(xb_ld(&bar[XB_XGEN(b.x)]) == gen, bar);
      __builtin_amdgcn_fence(__ATOMIC_ACQUIRE, "agent");
      asm volatile("s_waitcnt vmcnt(0)" ::: "memory");
    }
  }
  __syncthreads();
}

#define VHALF ((int)__builtin_amdgcn_readfirstlane((int)(threadIdx.x >> 8)))
#define TIDX ((int)(threadIdx.x & 255))
#define VBID ((int)(blockIdx.x * 2 + VHALF))
#define NVB ((int)(gridDim.x * 2))
constexpr int HALF_LDS = 80896;

DEVI void hb_sync() {
  extern __shared__ __attribute__((aligned(16))) unsigned char hb_smem[];
  LAS unsigned* cnt = (LAS unsigned*)(hb_smem + SMEM_BYTES) + 2 + VHALF;
  __builtin_amdgcn_fence(__ATOMIC_RELEASE, "workgroup");
  if ((threadIdx.x & 63) == 0) {
    const unsigned old = __hip_atomic_fetch_add(cnt, 1u, __ATOMIC_RELAXED, __HIP_MEMORY_SCOPE_WORKGROUP);
    const unsigned target = (old / 4u + 1u) * 4u;
    while (__hip_atomic_load(cnt, __ATOMIC_RELAXED, __HIP_MEMORY_SCOPE_WORKGROUP) < target) __builtin_amdgcn_s_sleep(0);
  }
  __builtin_amdgcn_fence(__ATOMIC_ACQUIRE, "workgroup");
}

DEVI void phase_mod(const Params& P, unsigned char* smem) {
  const int tid = TIDX;
  float* s = (float*)smem;
  float* red = s + 9 * 1024;
  for (int item = VBID; item < 192; item += NVB) {
    const int l = item / 96, j = item % 96;
    hb_sync();
    for (int i = tid; i < 9 * 1024; i += 256) {
      int bi = i >> 10, k = i & 1023;
      float v = bi < 8 ? P.c[bi * 1024 + k] : P.c_ctx[k];
      s[i] = v * sigmoidf_(v);
    }
    hb_sync();
    const int c4 = tid & 15, kg = tid >> 4;
    float acc[9][4];
#pragma unroll
    for (int bi = 0; bi < 9; ++bi) { acc[bi][0] = acc[bi][1] = acc[bi][2] = acc[bi][3] = 0.f; }
    const float* w = P.w_mod + (size_t)l * 1024 * 6144 + j * 64 + c4 * 4;
#pragma unroll 4
    for (int kk = 0; kk < 64; ++kk) {
      const int k = kg * 64 + kk;
      const float4 w4 = *reinterpret_cast<const float4*>(w + (size_t)k * 6144);
#pragma unroll
      for (int bi = 0; bi < 9; ++bi) {
        const float sv = s[bi * 1024 + k];
        acc[bi][0] += sv * w4.x; acc[bi][1] += sv * w4.y; acc[bi][2] += sv * w4.z; acc[bi][3] += sv * w4.w;
      }
    }
#pragma unroll
    for (int bi = 0; bi < 9; ++bi)
#pragma unroll
      for (int e = 0; e < 4; ++e) red[(kg * 9 + bi) * 64 + c4 * 4 + e] = acc[bi][e];
    hb_sync();
    for (int o = tid; o < 576; o += 256) {
      const int bi = o >> 6, cc = o & 63;
      float sum = 0.f;
#pragma unroll
      for (int g = 0; g < 16; ++g) sum += red[(g * 9 + bi) * 64 + cc];
      P.MOD[(size_t)(l * 9 + bi) * 6144 + j * 64 + cc] = sum + P.b_mod[l * 6144 + j * 64 + cc];
    }
  }
}

DEVI void conv_T_tile(const float* __restrict__ src, int N, bf16* __restrict__ dst, int Kd, int k0, int n0,
                      const float* __restrict__ kscale, float* tile) {
  const int tid = TIDX;
  hb_sync();
  for (int e = tid; e < 4096; e += 256) {
    const int i = e >> 6, j = e & 63, n = n0 + j;
    float v = (n < N) ? src[(size_t)(k0 + i) * N + n] : 0.f;
    if (kscale) v *= kscale[k0 + i];
    tile[i * 65 + j] = v;
  }
  hb_sync();
  for (int e = tid; e < 2048; e += 256) {
    const int j = e >> 5, i2 = (e & 31) * 2;
    const unsigned pk = pack2(tile[i2 * 65 + j], tile[(i2 + 1) * 65 + j]);
    *reinterpret_cast<unsigned*>(&dst[(size_t)(n0 + j) * Kd + k0 + i2]) = pk;
  }
}

DEVI void conv_straight(const float* __restrict__ src, bf16* __restrict__ dst, size_t n8) {
  const size_t stride = (size_t)NVB * 256;
  for (size_t i = (size_t)VBID * 256 + TIDX; i < n8; i += stride) {
    const float4 a = reinterpret_cast<const float4*>(src)[2 * i];
    const float4 b = reinterpret_cast<const float4*>(src)[2 * i + 1];
    uint4 o; o.x = pack2(a.x, a.y); o.y = pack2(a.z, a.w); o.z = pack2(b.x, b.y); o.w = pack2(b.z, b.w);
    reinterpret_cast<uint4*>(dst)[i] = o;
  }
}

DEVI void convert_rows_fp6(const Params& P, int L, int i0, int i1) {
  const int lane = threadIdx.x & 63, half = lane >> 5, l32 = lane & 31;
  const int wv = threadIdx.x >> 6;
  for (int ib = i0 + wv * 2; ib < i1; ib += 16) {
    int i = ib + half; const bool live = i < i1; if (!live) i = i1 - 1;
    const int table = i >> 14, lr = L * 16384 + (i & 16383);
    const float* src = (table ? P.p_v : P.p_u) + (size_t)lr * 1024 + l32 * 32;
    float4 a[8];
    float m = 0.f;
#pragma unroll
    for (int q = 0; q < 8; ++q) {
      a[q] = *reinterpret_cast<const float4*>(src + q * 4);
      m = fmaxf(m, fmaxf(fmaxf(fabsf(a[q].x), fabsf(a[q].y)), fmaxf(fabsf(a[q].z), fabsf(a[q].w))));
    }
    const unsigned sb = (__float_as_uint(fmaxf(m, 1e-30f) * (1.f / 6.f)) + 0xffffu) >> 16;
    const float inv = 1.f / __uint_as_float(sb << 16);
    unsigned pk[4];
#pragma unroll
    for (int w = 0; w < 4; ++w) {
      unsigned word = 0u;
#pragma unroll
      for (int e = 0; e < 8; ++e) {
        const int idx = w * 8 + e;
        const float4 q4 = a[idx >> 2];
        const float xv = ((idx & 3) == 0 ? q4.x : (idx & 3) == 1 ? q4.y : (idx & 3) == 2 ? q4.z : q4.w) * inv;
        const float av = fabsf(xv);
        unsigned ci = (av > 0.25f) + (av > 0.75f) + (av > 1.25f) + (av > 1.75f) + (av > 2.5f) + (av > 3.5f) + (av > 5.f);
        ci |= (xv < 0.f) ? 8u : 0u;
        word |= ci << (4 * e);
      }
      pk[w] = word;
    }
    unsigned char* rowp = (table ? P.PV8 : P.PU8) + (size_t)lr * 576;
    if (live) {
      *reinterpret_cast<uint4*>(rowp + l32 * 16) = make_uint4(pk[0], pk[1], pk[2], pk[3]);
      *reinterpret_cast<unsigned short*>(rowp + 512 + l32 * 2) = (unsigned short)sb;
    }
  }
}

DEVI void phase_prologue(const Params& P, unsigned char* smem) {
  phase_mod(P, smem);
  float* tile = (float*)smem;
  for (int it = VBID; it < 2 * 1424; it += NVB) {
    const int l = it / 1424; int r = it % 1424;
    if (r < 576) { conv_T_tile(P.w_in + (size_t)l * 1024 * DIN, DIN, P.WinT + (size_t)l * DINP * 1024, 1024, (r % 16) * 64, (r / 16) * 64, nullptr, tile); continue; }
    r -= 576;
    if (r < 256) { conv_T_tile(P.w_out + (size_t)l * 1024 * 1024, 1024, P.WoutT + (size_t)l * 1024 * 1024, 1024, (r % 16) * 64, (r / 16) * 64, nullptr, tile); continue; }
    r -= 256;
    if (r < 512) continue;
    r -= 512;
    if (r < 48) { conv_T_tile(P.b_w_uq + (size_t)l * 256 * 768, 768, P.WCOMB + (size_t)l * 1792 * 256, 256, (r % 4) * 64, (r / 4) * 64, P.b_q_norm_w + l * 256, tile); continue; }
    r -= 48;
    conv_T_tile(P.b_w_ukv + (size_t)l * 128 * 1024, 1024, P.WCOMB + (size_t)l * 1792 * 256 + 768 * 256, 256, (r % 2) * 64, (r / 2) * 64, P.b_kv_norm_w + l * 128, tile);
  }
  {
    const int tid = TIDX, lane = tid & 63, wave = tid >> 6, l31 = lane & 31, hh = lane >> 5;
    bf16* KA = reinterpret_cast<bf16*>(smem);
    bf16* WB = KA + 128 * 136;
    for (int it = VBID; it < 2 * 16 * 16; it += NVB) {
      const int kt = it & 15, hp = (it >> 4) & 15, l = it >> 8;
      hb_sync();
      {
        const float* keys = P.p_sub_keys + (size_t)(l * 16 + hp) * 128 * 128;
        for (int e = tid; e < 128 * 32; e += 256) {
          const int r = e >> 5, c4 = e & 31;
          const float4 v = *reinterpret_cast<const float4*>(keys + (size_t)r * 128 + c4 * 4);
          *reinterpret_cast<uint2*>(KA + r * 136 + c4 * 4) = make_uint2(pack2(v.x, v.y), pack2(v.z, v.w));
        }
        const float* wq = P.p_w_q + (size_t)l * 1024 * 2048 + (size_t)(kt * 64) * 2048 + hp * 128;
        for (int e = tid; e < 64 * 32; e += 256) {
          const int r = e >> 5, c4 = e & 31;
          const float4 v = *reinterpret_cast<const float4*>(wq + (size_t)r * 2048 + c4 * 4);
          *reinterpret_cast<uint2*>(WB + r * 136 + c4 * 4) = make_uint2(pack2(v.x, v.y), pack2(v.z, v.w));
        }
      }
      hb_sync();
      f32x16 acc[2]; acc[0] = zero16(); acc[1] = zero16();
#pragma unroll
      for (int ks = 0; ks < 8; ++ks) {
        const bf16x8 af = ldfrag(KA + (wave * 32 + l31) * 136 + ks * 16 + hh * 8);
#pragma unroll
        for (int j = 0; j < 2; ++j) {
          const bf16x8 bfr = ldfrag(WB + (j * 32 + l31) * 136 + ks * 16 + hh * 8);
          acc[j] = mfma32(af, bfr, acc[j]);
        }
      }
      bf16* dst = P.WpqT + (size_t)l * 2048 * 1024 + (size_t)(hp * 128 + wave * 32) * 1024 + kt * 64;
#pragma unroll
      for (int j = 0; j < 2; ++j)
#pragma unroll
        for (int r = 0; r < 16; ++r) dst[(size_t)drow(r, hh) * 1024 + j * 32 + l31] = f2bf(acc[j][r]);
    }
  }
  for (int i = VBID * 256 + TIDX; i < 2 * 1024 * 16; i += NVB * 256) {
    const int l2 = i >> 14, rr = (i >> 4) & 1023, cc = i & 15;
    *reinterpret_cast<uint4*>(P.WCOMB + (size_t)l2 * 1792 * 256 + (size_t)(768 + rr) * 256 + 128 + cc * 8) = make_uint4(0u, 0u, 0u, 0u);
  }
  conv_straight(P.a_w_s, P.AWS, (size_t)2 * 4 * 128 * 128 / 8);
  for (int i = VBID * 256 + TIDX; i < 2048 * 16; i += NVB * 256) {
    const int t = i >> 4, a = (i >> 3) & 1, f = i & 7;
    const float inv = powf(10000.f, -(float)f / 8.f);
    const float pos = a ? (float)(t & 63) : (float)(t >> 6);
    const float ang = pos * inv;
    P.ROPE[t * 32 + a * 8 + f] = cosf(ang);
    P.ROPE[t * 32 + 16 + a * 8 + f] = sinf(ang);
  }
}

DEVI void phase_norm(const Params& P, int l, int which, int nrows, int rbeg = 0) {
  const int lane = TIDX & 63;
  const int gw = VBID * 4 + (TIDX >> 6), nw = NVB * 4;
  const float* lnw = (which == 0 ? P.ln1_w : P.ln2_w) + l * 1024;
  for (int r = rbeg + gw; r < nrows; r += nw) {
    const float* mod = P.MOD + (size_t)(l * 9 + batch_of_row(r)) * 6144 + which * 3072;
    float4 v[4];
    float ss = 0.f;
    if (which == 0 && l == 0) {
      const float* src = r < NL ? P.x + (size_t)r * 1024 : P.ctx + (size_t)(r - NL) * 1024;
#pragma unroll
      for (int i = 0; i < 4; ++i) v[i] = *reinterpret_cast<const float4*>(src + i * 256 + lane * 4);
    } else if (which == 1 && l == 0 && r >= NL) {
      const float* cin = P.ctx + (size_t)(r - NL) * 1024;
      const float* p0 = P.PART + (size_t)(r - NL) * 1024;
      const float* p1 = p0 + (size_t)2048 * 1024;
      const float* gate = P.MOD + (size_t)8 * 6144 + 2048;
#pragma unroll
      for (int i = 0; i < 4; ++i) {
        const int d = i * 256 + lane * 4;
        const float4 c4 = *reinterpret_cast<const float4*>(cin + d), a4 = *reinterpret_cast<const float4*>(p0 + d), b4 = *reinterpret_cast<const float4*>(p1 + d);
        const float4 g4 = *reinterpret_cast<const float4*>(gate + d);
        v[i] = make_float4(c4.x + g4.x * (a4.x + b4.x), c4.y + g4.y * (a4.y + b4.y), c4.z + g4.z * (a4.z + b4.z), c4.w + g4.w * (a4.w + b4.w));
        *reinterpret_cast<uint2*>(P.X + (size_t)r * 1024 + d) = make_uint2(pack2(v[i].x, v[i].y), pack2(v[i].z, v[i].w));
      }
    } else {
      const bf16* src = P.X + (size_t)r * 1024;
#pragma unroll
      for (int i = 0; i < 4; ++i) {
        const uint2 u = *reinterpret_cast<const uint2*>(src + i * 256 + lane * 4);
        v[i] = make_float4(lo2f(u.x), hi2f(u.x), lo2f(u.y), hi2f(u.y));
      }
    }
#pragma unroll
    for (int i = 0; i < 4; ++i) ss += v[i].x * v[i].x + v[i].y * v[i].y + v[i].z * v[i].z + v[i].w * v[i].w;
    ss = wave_sum(ss);
    const float rr = rsqrtf(ss * (1.f / 1024.f) + EPS);
#pragma unroll
    for (int i = 0; i < 4; ++i) {
      const int d = i * 256 + lane * 4;
      const float4 w = *reinterpret_cast<const float4*>(lnw + d);
      const float4 sh = *reinterpret_cast<const float4*>(mod + d);
      const float4 sc = *reinterpret_cast<const float4*>(mod + 1024 + d);
      const float o0 = v[i].x * rr * w.x * (1.f + sc.x) + sh.x;
      const float o1 = v[i].y * rr * w.y * (1.f + sc.y) + sh.y;
      const float o2 = v[i].z * rr * w.z * (1.f + sc.z) + sh.z;
      const float o3 = v[i].w * rr * w.w * (1.f + sc.w) + sh.w;
      uint2 o; o.x = pack2(o0, o1); o.y = pack2(o2, o3);
      *reinterpret_cast<uint2*>(P.H + (size_t)r * 1024 + d) = o;
    }
  }
}

DEVI void phase_mixA(const Params& P, int l, unsigned char* smem) {
  const int tid = TIDX, lane = tid & 63, wave = tid >> 6, l31 = lane & 31, hh = lane >> 5;
  bf16* VNT = reinterpret_cast<bf16*>(smem);
  constexpr int LDV = 136;
  const int nseg = (l == 1) ? 16 : 18;
  const int seg0 = (l == 1) ? 2 : 0;
  for (int it = VBID; it < 8 * nseg * 4; it += NVB) {
    const int a = it & 3; const int sj = (it >> 2) % nseg + seg0; const int b = (it >> 2) / nseg;
    const int p0 = sj * 128;
    hb_sync();
    {
      const int q = tid >> 1, half = tid & 1;
      const int row = row_of(b, p0 + q);
      const bf16* src = P.Z + (size_t)row * DIN + ZC_AV + a * 64 + half * 32;
      float v[32];
      float ss = 0.f;
#pragma unroll
      for (int i = 0; i < 4; ++i) {
        const uint4 u = *reinterpret_cast<const uint4*>(src + i * 8);
        v[i * 8 + 0] = lo2f(u.x); v[i * 8 + 1] = hi2f(u.x); v[i * 8 + 2] = lo2f(u.y); v[i * 8 + 3] = hi2f(u.y);
        v[i * 8 + 4] = lo2f(u.z); v[i * 8 + 5] = hi2f(u.z); v[i * 8 + 6] = lo2f(u.w); v[i * 8 + 7] = hi2f(u.w);
      }
#pragma unroll
      for (int i = 0; i < 32; ++i) ss += v[i] * v[i];
      ss += __shfl_xor(ss, 1);
      const float rr = rsqrtf(ss * (1.f / 64.f) + EPS);
      const float* nw = P.a_norm_w + l * 256 + a * 64 + half * 32;
#pragma unroll
      for (int i = 0; i < 32; ++i) VNT[(half * 32 + i) * LDV + q] = f2bf(v[i] * rr * nw[i]);
    }
    hb_sync();
    f32x16 acc[2]; acc[0] = zero16(); acc[1] = zero16();
    const bf16* Aw = P.AWS + (size_t)(l * 4 + a) * 128 * 128 + (size_t)(wave * 32 + l31) * 128;
#pragma unroll
    for (int ks = 0; ks < 8; ++ks) {
      const bf16x8 af = ldfrag(Aw + ks * 16 + hh * 8);
#pragma unroll
      for (int j = 0; j < 2; ++j) {
        const bf16x8 bfr = ldfrag(VNT + (j * 32 + l31) * LDV + ks * 16 + hh * 8);
        acc[j] = mfma32(af, bfr, acc[j]);
      }
    }
    const float* bs = P.a_b_s + (l * 4 + a) * 128;
#pragma unroll
    for (int j = 0; j < 2; ++j)
#pragma unroll
      for (int r = 0; r < 16; ++r) {
        const int p = wave * 32 + drow(r, hh);
        const int row = row_of(b, p0 + p);
        const int col = a * 64 + j * 32 + l31;
        const float u = bf2f(P.Z[(size_t)row * DIN + ZC_AU + col]);
        P.H[(size_t)row * 1024 + col] = f2bf(u * (acc[j][r] + bs[p]));
      }
  }
}

DEVI void mla_norm_rope_store(const Params& P, const float* T, const float* nw, bool rope, float oscale,
                              bf16* dstbase  , int pos0, int tlat0) {
  const int tid = TIDX, tok = tid >> 1, half = tid & 1;
  float v[48];
  float ss = 0.f;
#pragma unroll
  for (int i = 0; i < 48; ++i) { v[i] = T[tok * 97 + half * 48 + i]; ss += v[i] * v[i]; }
  ss += __shfl_xor(ss, 1);
  const float rr = rsqrtf(ss * (1.f / 96.f) + EPS);
#pragma unroll
  for (int i = 0; i < 48; ++i) v[i] = v[i] * rr * nw[half * 48 + i];
  if (rope && half == 1) {
    const float* cs = P.ROPE + (size_t)(tlat0 + tok) * 32;
#pragma unroll
    for (int a = 0; a < 2; ++a)
#pragma unroll
      for (int f = 0; f < 8; ++f) {
        const float x1 = v[16 + a * 16 + f], x2 = v[16 + a * 16 + 8 + f];
        const float c = cs[a * 8 + f], s = cs[16 + a * 8 + f];
        v[16 + a * 16 + f] = x1 * c - x2 * s;
        v[16 + a * 16 + 8 + f] = x2 * c + x1 * s;
      }
  }
  bf16* dst = dstbase + (size_t)(pos0 + tok) * 96 + half * 48;
#pragma unroll
  for (int i = 0; i < 6; ++i) {
    uint4 o;
    o.x = pack2(v[i * 8 + 0] * oscale, v[i * 8 + 1] * oscale); o.y = pack2(v[i * 8 + 2] * oscale, v[i * 8 + 3] * oscale);
    o.z = pack2(v[i * 8 + 4] * oscale, v[i * 8 + 5] * oscale); o.w = pack2(v[i * 8 + 6] * oscale, v[i * 8 + 7] * oscale);
    *reinterpret_cast<uint4*>(dst + i * 8) = o;
  }
}

DEVI void phase_mla_proj(const Params& P, int l, unsigned char* smem) {
  const int tid = TIDX;
  float* T = reinterpret_cast<float*>(smem);
  bf16* TV = reinterpret_cast<bf16*>(smem + 128 * 97 * 4);
  const float qscale = 0.10206207261596577f * 1.4426950408889634f;
  const int tok = tid >> 1, half = tid & 1;
  for (int it = (VBID + NVB - 64) % NVB; it < 144 * 8; it += NVB) {
    const int h = it & 7;
    const int m0 = (it >> 3) * 128;
    const bool lat = m0 < NL;
    const int b = lat ? (m0 >> 11) : ((m0 - NL) >> 8);
    const int pos0 = lat ? 256 + (m0 & 2047) : ((m0 - NL) & 255);
    const int tlat0 = lat ? (m0 & 2047) : 0;
    const bool doq = lat || (l == 0);
    const bf16* zr = P.Z + (size_t)(m0 + tok) * DIN;
    const bf16* rr = P.RAW + (size_t)(m0 + tok) * 1792;
    hb_sync();
    const float rsq = P.RS[(size_t)(m0 + tok) * 2], rskv = P.RS[(size_t)(m0 + tok) * 2 + 1];
    {
      const bf16* kn = rr + 768 + h * 128 + half * 32;
      const bf16* vv = rr + 768 + h * 128 + 64 + half * 32;
#pragma unroll
      for (int i = 0; i < 4; ++i) {
        const uint4 u = *reinterpret_cast<const uint4*>(kn + i * 8);
        float* tp = T + tok * 97 + half * 32 + i * 8;
        tp[0] = lo2f(u.x) * rskv; tp[1] = hi2f(u.x) * rskv; tp[2] = lo2f(u.y) * rskv; tp[3] = hi2f(u.y) * rskv;
        tp[4] = lo2f(u.z) * rskv; tp[5] = hi2f(u.z) * rskv; tp[6] = lo2f(u.w) * rskv; tp[7] = hi2f(u.w) * rskv;
        const uint4 w = *reinterpret_cast<const uint4*>(vv + i * 8);
        bf16* vp = TV + (half * 32 + i * 8) * 136 + tok;
        vp[0 * 136] = f2bf(lo2f(w.x) * rskv); vp[1 * 136] = f2bf(hi2f(w.x) * rskv); vp[2 * 136] = f2bf(lo2f(w.y) * rskv); vp[3 * 136] = f2bf(hi2f(w.y) * rskv);
        vp[4 * 136] = f2bf(lo2f(w.z) * rskv); vp[5 * 136] = f2bf(hi2f(w.z) * rskv); vp[6 * 136] = f2bf(lo2f(w.w) * rskv); vp[7 * 136] = f2bf(hi2f(w.w) * rskv);
      }
#pragma unroll
      for (int i = 0; i < 2; ++i) {
        const uint4 u = *reinterpret_cast<const uint4*>(zr + ZC_BKR + half * 16 + i * 8);
        float* tp = T + tok * 97 + 64 + half * 16 + i * 8;
        tp[0] = lo2f(u.x); tp[1] = hi2f(u.x); tp[2] = lo2f(u.y); tp[3] = hi2f(u.y);
        tp[4] = lo2f(u.z); tp[5] = hi2f(u.z); tp[6] = lo2f(u.w); tp[7] = hi2f(u.w);
      }
    }
    hb_sync();
    mla_norm_rope_store(P, T, P.b_kh_w + l * 96, lat, 1.f, P.K + (size_t)(b * 8 + h) * SEQP * 96, pos0, tlat0);
    {
      const int d = tid >> 2, qtr = tid & 3;
      bf16* dst = P.VT + ((size_t)(b * 8 + h) * 64 + d) * SEQP + pos0 + qtr * 32;
      const bf16* src = TV + d * 136 + qtr * 32;
#pragma unroll
      for (int i = 0; i < 4; ++i) {
        const uint4 v = *reinterpret_cast<const uint4*>(src + i * 8);
        const int g16 = (i >> 1) * 16, odd = i & 1;
        *reinterpret_cast<uint2*>(dst + g16 + (odd ? 4 : 0)) = make_uint2(v.x, v.y);
        *reinterpret_cast<uint2*>(dst + g16 + (odd ? 12 : 8)) = make_uint2(v.z, v.w);
      }
    }
    if (doq) {
      hb_sync();
      const bf16* qq = rr + h * 96 + half * 48;
#pragma unroll
      for (int i = 0; i < 6; ++i) {
        const uint4 u = *reinterpret_cast<const uint4*>(qq + i * 8);
        float* tp = T + tok * 97 + half * 48 + i * 8;
        tp[0] = lo2f(u.x) * rsq; tp[1] = hi2f(u.x) * rsq; tp[2] = lo2f(u.y) * rsq; tp[3] = hi2f(u.y) * rsq;
        tp[4] = lo2f(u.z) * rsq; tp[5] = hi2f(u.z) * rsq; tp[6] = lo2f(u.w) * rsq; tp[7] = hi2f(u.w) * rsq;
      }
      hb_sync();
      mla_norm_rope_store(P, T, P.b_qh_w + l * 96, lat, qscale, P.Q + (size_t)(b * 8 + h) * SEQP * 96, pos0, tlat0);
    }
  }
}

DEVI void hgrn_load(const Params& P, int l, int b, int hd, int c, float* BF, float* RB, float* SEG,
                    float (&q)[16], float (&kf)[16], float (&kb)[16], float (&v)[16], bool need_kv) {
  const int tid = TIDX, t = tid >> 2, k0 = (tid & 3) * 16;
  const int row = row_of(b, c * 64 + t);
  const bf16* z = P.Z + (size_t)row * DIN + hd * 64 + k0;
  float zf[16], zb[16];
#pragma unroll
  for (int i = 0; i < 2; ++i) {
    const uint4 uq = *reinterpret_cast<const uint4*>(z + ZC_CQ + i * 8);
    const uint4 uf = *reinterpret_cast<const uint4*>(z + ZC_CFF + i * 8);
    const uint4 ub = *reinterpret_cast<const uint4*>(z + ZC_CFB + i * 8);
    q[i * 8 + 0] = lo2f(uq.x); q[i * 8 + 1] = hi2f(uq.x); q[i * 8 + 2] = lo2f(uq.y); q[i * 8 + 3] = hi2f(uq.y);
    q[i * 8 + 4] = lo2f(uq.z); q[i * 8 + 5] = hi2f(uq.z); q[i * 8 + 6] = lo2f(uq.w); q[i * 8 + 7] = hi2f(uq.w);
    zf[i * 8 + 0] = lo2f(uf.x); zf[i * 8 + 1] = hi2f(uf.x); zf[i * 8 + 2] = lo2f(uf.y); zf[i * 8 + 3] = hi2f(uf.y);
    zf[i * 8 + 4] = lo2f(uf.z); zf[i * 8 + 5] = hi2f(uf.z); zf[i * 8 + 6] = lo2f(uf.w); zf[i * 8 + 7] = hi2f(uf.w);
    zb[i * 8 + 0] = lo2f(ub.x); zb[i * 8 + 1] = hi2f(ub.x); zb[i * 8 + 2] = lo2f(ub.y); zb[i * 8 + 3] = hi2f(ub.y);
    zb[i * 8 + 4] = lo2f(ub.z); zb[i * 8 + 5] = hi2f(ub.z); zb[i * 8 + 6] = lo2f(ub.w); zb[i * 8 + 7] = hi2f(ub.w);
    if (need_kv) {
      const uint4 uv = *reinterpret_cast<const uint4*>(z + ZC_CI + i * 8);
      v[i * 8 + 0] = lo2f(uv.x); v[i * 8 + 1] = hi2f(uv.x); v[i * 8 + 2] = lo2f(uv.y); v[i * 8 + 3] = hi2f(uv.y);
      v[i * 8 + 4] = lo2f(uv.z); v[i * 8 + 5] = hi2f(uv.z); v[i * 8 + 6] = lo2f(uv.w); v[i * 8 + 7] = hi2f(uv.w);
    }
  }
#pragma unroll
  for (int i = 0; i < 16; ++i) {
    q[i] *= 0.125f;
    float lbf = 0.f;
    if (l == 1) { const int ch = hd * 64 + k0 + i; lbf = sigmoidf_(P.c_lb[512 + ch] - P.c_lb[ch]); }
    const float zz = zf[i];
    const float e = __expf(-fabsf(zz));
    const float sp = __builtin_amdgcn_rcpf(1.f + e);
    const float sig = zz >= 0.f ? sp : e * sp;
    const float nsig = zz >= 0.f ? e * sp : sp;
    const float lf = (l == 0) ? (fminf(zz, 0.f) - __logf(1.f + e)) : __logf(lbf + (1.f - lbf) * sig);
    kf[i] = (1.f - lbf) * nsig;
    BF[t * 65 + k0 + i] = lf;
  }
  __builtin_amdgcn_sched_barrier(0);
#pragma unroll
  for (int i = 0; i < 16; ++i) {
    float lbb = 0.f;
    if (l == 1) { const int ch = hd * 64 + k0 + i; lbb = sigmoidf_(P.c_lb[512 + 256 + ch] - P.c_lb[256 + ch]); }
    const float zz = zb[i];
    const float e = __expf(-fabsf(zz));
    const float sp = __builtin_amdgcn_rcpf(1.f + e);
    const float sig = zz >= 0.f ? sp : e * sp;
    const float nsig = zz >= 0.f ? e * sp : sp;
    const float lf = (l == 0) ? (fminf(zz, 0.f) - __logf(1.f + e)) : __logf(lbb + (1.f - lbb) * sig);
    kb[i] = (1.f - lbb) * nsig;
    RB[t * 65 + k0 + i] = lf;
  }
  hb_sync();
  {
    const int k = tid & 63, seg = tid >> 6;
    float sf = 0.f, sr = 0.f;
#pragma unroll
    for (int j = 0; j < 16; ++j) { sf += BF[(seg * 16 + j) * 65 + k]; BF[(seg * 16 + j) * 65 + k] = sf; }
#pragma unroll
    for (int j = 15; j >= 0; --j) { sr += RB[(seg * 16 + j) * 65 + k]; RB[(seg * 16 + j) * 65 + k] = sr; }
    SEG[seg * 64 + k] = sf; SEG[256 + seg * 64 + k] = sr;
    hb_sync();
    float offf = 0.f, offb = 0.f;
#pragma unroll
    for (int s2 = 0; s2 < 4; ++s2) {
      offf += (s2 < seg) ? SEG[s2 * 64 + k] : 0.f;
      offb += (s2 > seg) ? SEG[256 + s2 * 64 + k] : 0.f;
    }
#pragma unroll
    for (int j = 0; j < 16; ++j) { BF[(seg * 16 + j) * 65 + k] += offf; RB[(seg * 16 + j) * 65 + k] += offb; }
  }
  hb_sync();
}

DEVI f32x16 lds_mm(const bf16* A, const bf16* BT, int tm, int tn, int l31, int hh) {
  f32x16 acc = zero16();
#pragma unroll
  for (int ks = 0; ks < 4; ++ks) {
    const bf16x8 a = ldfrag(A + (tm * 32 + l31) * 72 + ks * 16 + hh * 8);
    const bf16x8 b = ldfrag(BT + (tn * 32 + l31) * 72 + ks * 16 + hh * 8);
    acc = mfma32(a, b, acc);
  }
  return acc;
}

DEVI void phase_hgrn_local(const Params& P, int l, unsigned char* smem) {
  const int tid = TIDX, lane = tid & 63, wave = tid >> 6, l31 = lane & 31, hh = lane >> 5;
  const int tm = wave >> 1, tn = wave & 1;
  float* BF = reinterpret_cast<float*>(smem);
  float* RB = BF + 64 * 65;
  bf16* QF = reinterpret_cast<bf16*>(smem + 33280);
  bf16* KF = QF + 64 * 72;
  bf16* QB = KF + 64 * 72;
  bf16* KB = QB + 64 * 72;
  bf16* VTt = KB + 64 * 72;
  bf16* KHF = reinterpret_cast<bf16*>(smem);
  bf16* KHB = KHF + 64 * 72;
  bf16* ATT = KHB + 64 * 72;
  for (int it = (VBID + NVB - 192) % NVB; it < 8 * 4 * 36; it += NVB) {
    const int c = it % 36, hd = (it / 36) & 3, b = it / 144;
    float q[16], kf[16], kb[16], v[16];
    hb_sync();
    hgrn_load(P, l, b, hd, c, BF, RB, reinterpret_cast<float*>(smem + 33280), q, kf, kb, v, true);
    const int t = tid >> 2, k0 = (tid & 3) * 16;
#pragma unroll
    for (int i = 0; i < 16; ++i) VTt[(k0 + i) * 72 + t] = f2bf(v[i]);
    float bfv[16], rbv[16];
#pragma unroll
    for (int i = 0; i < 16; ++i) { bfv[i] = BF[t * 65 + k0 + i]; rbv[i] = RB[t * 65 + k0 + i]; }
    {
      const size_t go = (size_t)row_of(b, c * 64 + t) * 256 + hd * 64 + k0;
#pragma unroll
      for (int hq = 0; hq < 2; ++hq) {
        unsigned pf[4], pb[4];
#pragma unroll
        for (int i = 0; i < 8; i += 2) {
          pf[i >> 1] = pack2(q[hq * 8 + i] * __expf(bfv[hq * 8 + i]), q[hq * 8 + i + 1] * __expf(bfv[hq * 8 + i + 1]));
          pb[i >> 1] = pack2(q[hq * 8 + i] * __expf(rbv[hq * 8 + i]), q[hq * 8 + i + 1] * __expf(rbv[hq * 8 + i + 1]));
        }
        *reinterpret_cast<uint4*>(P.GQF + go + hq * 8) = make_uint4(pf[0], pf[1], pf[2], pf[3]);
        *reinterpret_cast<uint4*>(P.GQB + go + hq * 8) = make_uint4(pb[0], pb[1], pb[2], pb[3]);
      }
    }
    if (t == 0) {
      float* dec = P.DEC + ((size_t)((b * 4 + hd) * 2) * 36 + c) * 64 + k0;
#pragma unroll
      for (int i = 0; i < 16; ++i) { dec[i] = __expf(BF[63 * 65 + k0 + i]); dec[36 * 64 + i] = __expf(RB[k0 + i]); }
    }
#pragma unroll
    for (int i = 0; i < 16; i += 2) {
      const int k = k0 + i;
      const float mF0 = BF[32 * 65 + k], mF1 = BF[32 * 65 + k + 1], mB0 = RB[32 * 65 + k], mB1 = RB[32 * 65 + k + 1];
      *reinterpret_cast<unsigned*>(&QF[t * 72 + k]) = pack2(q[i] * __expf(fminf(bfv[i] - mF0, 80.f)), q[i + 1] * __expf(fminf(bfv[i + 1] - mF1, 80.f)));
      *reinterpret_cast<unsigned*>(&KF[t * 72 + k]) = pack2(kf[i] * __expf(fminf(mF0 - bfv[i], 80.f)), kf[i + 1] * __expf(fminf(mF1 - bfv[i + 1], 80.f)));
      *reinterpret_cast<unsigned*>(&QB[t * 72 + k]) = pack2(q[i] * __expf(fminf(rbv[i] - mB0, 80.f)), q[i + 1] * __expf(fminf(rbv[i + 1] - mB1, 80.f)));
      *reinterpret_cast<unsigned*>(&KB[t * 72 + k]) = pack2(kb[i] * __expf(fminf(mB0 - rbv[i], 80.f)), kb[i + 1] * __expf(fminf(mB1 - rbv[i + 1], 80.f)));
    }
#pragma unroll
    for (int i = 0; i < 16; ++i) {
      kf[i] = kf[i] * __expf(BF[63 * 65 + k0 + i] - bfv[i]);
      kb[i] = kb[i] * __expf(RB[k0 + i] - rbv[i]);
    }
    hb_sync();
#pragma unroll
    for (int i = 0; i < 16; ++i) {
      KHF[(k0 + i) * 72 + t] = f2bf(kf[i]);
      KHB[(k0 + i) * 72 + t] = f2bf(kb[i]);
    }
    hb_sync();
    {
      const f32x16 af = lds_mm(QF, KF, tm, tn, l31, hh);
      const f32x16 ab = lds_mm(QB, KB, tm, tn, l31, hh);
      const int s = tn * 32 + l31;
#pragma unroll
      for (int r = 0; r < 16; ++r) {
        const int tt = tm * 32 + drow(r, hh);
        float a = 0.f;
        if (s <= tt) a += af[r];
        if (s >= tt) a += ab[r];
        ATT[tt * 72 + s] = f2bf(a);
      }
    }
    {
      const f32x16 lf = lds_mm(VTt, KHF, tm, tn, l31, hh);
      const f32x16 lb = lds_mm(VTt, KHB, tm, tn, l31, hh);
      bf16* stf = P.ST + ((size_t)((b * 4 + hd) * 2 + 0) * 36 + c) * 4096;
      bf16* stb = P.ST + ((size_t)((b * 4 + hd) * 2 + 1) * 36 + c) * 4096;
#pragma unroll
      for (int r = 0; r < 16; ++r) {
        const int kk = tm * 32 + drow(r, hh), d = tn * 32 + l31;
        stf[kk * 64 + d] = f2bf(lf[r]);
        stb[kk * 64 + d] = f2bf(lb[r]);
      }
    }
    hb_sync();
    {
      const f32x16 o = lds_mm(ATT, VTt, tm, tn, l31, hh);
#pragma unroll
      for (int r = 0; r < 16; ++r) {
        const int tt = tm * 32 + drow(r, hh), d = tn * 32 + l31;
        P.OI[(size_t)row_of(b, c * 64 + tt) * 256 + hd * 64 + d] = f2bf(o[r]);
      }
    }
  }
}

DEVI void hgrn_scan_item(const Params& P, int item) {
  const int tid = TIDX;
  const int chain = item >> 2, sl = item & 3;
  const int dir = chain & 1;
  const int dd = tid >> 2, k4 = sl * 16 + (tid & 3) * 4;
  float4 S = make_float4(0.f, 0.f, 0.f, 0.f);
  bf16* base = P.ST + (size_t)chain * 36 * 4096 + dd * 64 + k4;
  const float* dec = P.DEC + (size_t)chain * 36 * 64 + k4;
#pragma unroll 1
  for (int g = 0; g < 6; ++g) {
    float4 L[6], dc[6];
#pragma unroll
    for (int j = 0; j < 6; ++j) {
      const int step = g * 6 + j;
      const int c = dir == 0 ? step : (step < 4 ? 3 - step : 39 - step);
      { const uint2 u = *reinterpret_cast<const uint2*>(base + (size_t)c * 4096); L[j] = make_float4(lo2f(u.x), hi2f(u.x), lo2f(u.y), hi2f(u.y)); }
      dc[j] = *reinterpret_cast<const float4*>(dec + c * 64);
    }
#pragma unroll
    for (int j = 0; j < 6; ++j) {
      const int step = g * 6 + j;
      const int c = dir == 0 ? step : (step < 4 ? 3 - step : 39 - step);
      *reinterpret_cast<uint2*>(base + (size_t)c * 4096) = make_uint2(pack2(S.x, S.y), pack2(S.z, S.w));
      S.x = dc[j].x * S.x + L[j].x; S.y = dc[j].y * S.y + L[j].y; S.z = dc[j].z * S.z + L[j].z; S.w = dc[j].w * S.w + L[j].w;
    }
  }
}

DEVI void phase_hgrn_final(const Params& P, int l, unsigned char* smem) {
  const int tid = TIDX, lane = tid & 63, wave = tid >> 6, l31 = lane & 31, hh = lane >> 5;
  const int tm = wave >> 1, tn = wave & 1;
  float* O = reinterpret_cast<float*>(smem);
  bf16* QF = reinterpret_cast<bf16*>(smem + 33280);
  bf16* QB = QF + 64 * 72;
  bf16* SF = QB + 64 * 72;
  bf16* SB = SF + 64 * 72;
  const int c0 = (l == 1) ? 4 : 0;
  const int nc = 36 - c0;
  for (int it = VBID; it < 8 * 4 * nc; it += NVB) {
    const int c = it % nc + c0, hd = (it / nc) & 3, b = it / (nc * 4);
    const int t = tid >> 2, k0 = (tid & 3) * 16;
    const int row = row_of(b, c * 64 + t);
    hb_sync();
    {
      const size_t go = (size_t)row * 256 + hd * 64 + k0;
      *reinterpret_cast<uint4*>(QF + t * 72 + k0) = *reinterpret_cast<const uint4*>(P.GQF + go);
      *reinterpret_cast<uint4*>(QF + t * 72 + k0 + 8) = *reinterpret_cast<const uint4*>(P.GQF + go + 8);
      *reinterpret_cast<uint4*>(QB + t * 72 + k0) = *reinterpret_cast<const uint4*>(P.GQB + go);
      *reinterpret_cast<uint4*>(QB + t * 72 + k0 + 8) = *reinterpret_cast<const uint4*>(P.GQB + go + 8);
      const bf16* stf = P.ST + ((size_t)((b * 4 + hd) * 2 + 0) * 36 + c) * 4096 + t * 64 + k0;
      const bf16* stb = P.ST + ((size_t)((b * 4 + hd) * 2 + 1) * 36 + c) * 4096 + t * 64 + k0;
      *reinterpret_cast<uint4*>(SF + t * 72 + k0) = *reinterpret_cast<const uint4*>(stf);
      *reinterpret_cast<uint4*>(SF + t * 72 + k0 + 8) = *reinterpret_cast<const uint4*>(stf + 8);
      *reinterpret_cast<uint4*>(SB + t * 72 + k0) = *reinterpret_cast<const uint4*>(stb);
      *reinterpret_cast<uint4*>(SB + t * 72 + k0 + 8) = *reinterpret_cast<const uint4*>(stb + 8);
    }
    hb_sync();
    {
      f32x16 o = lds_mm(QF, SF, tm, tn, l31, hh);
      const f32x16 o2 = lds_mm(QB, SB, tm, tn, l31, hh);
#pragma unroll
      for (int r = 0; r < 16; ++r) {
        const int tt = tm * 32 + drow(r, hh), d = tn * 32 + l31;
        O[tt * 65 + d] = o[r] + o2[r] + bf2f(P.OI[(size_t)row_of(b, c * 64 + tt) * 256 + hd * 64 + d]);
      }
    }
    hb_sync();
    {
      float ov[16]; float ss = 0.f;
#pragma unroll
      for (int i = 0; i < 16; ++i) { ov[i] = O[t * 65 + k0 + i]; ss += ov[i] * ov[i]; }
      ss += __shfl_xor(ss, 1); ss += __shfl_xor(ss, 2);
      const float rr = rsqrtf(ss * (1.f / 64.f) + EPS);
      const bf16* g = P.Z + (size_t)row * DIN + ZC_CG + hd * 64 + k0;
      const float* nw = P.c_out_norm_w + l * 64 + k0;
      const uint4 gA = *reinterpret_cast<const uint4*>(g), gB = *reinterpret_cast<const uint4*>(g + 8);
      const unsigned gw[8] = {gA.x, gA.y, gA.z, gA.w, gB.x, gB.y, gB.z, gB.w};
      unsigned pk[8];
#pragma unroll
      for (int i = 0; i < 16; i += 2) {
        const float g0 = lo2f(gw[i >> 1]), g1 = hi2f(gw[i >> 1]);
        const float y0 = ov[i] * rr * nw[i] * (g0 * sigmoidf_(g0));
        const float y1 = ov[i + 1] * rr * nw[i + 1] * (g1 * sigmoidf_(g1));
        pk[i >> 1] = pack2(y0, y1);
      }
      uint4* dst = reinterpret_cast<uint4*>(P.H + (size_t)row * 1024 + 768 + hd * 64 + k0);
      dst[0] = make_uint4(pk[0], pk[1], pk[2], pk[3]);
      dst[1] = make_uint4(pk[4], pk[5], pk[6], pk[7]);
    }
  }
}

DEVI void attn_item8(const Params& P, int b, int h, int qpos0, int nkeys, float sref, unsigned char* smem_base) {
  const int tid = threadIdx.x, lane = tid & 63, wave = tid >> 6, l31 = lane & 31, hh = lane >> 5;
  constexpr int TK = 128, LDKS = 104, LDVS = 136;
  constexpr int KS_BYTES = TK * LDKS * 2, VS_BYTES = 64 * LDVS * 2, ST_BYTES = KS_BYTES + VS_BYTES;
  const bf16* Qg = P.Q + ((size_t)(b * 8 + h) * SEQP + qpos0 + wave * 32 + l31) * 96;
  const bf16* Kg = P.K + (size_t)(b * 8 + h) * SEQP * 96;
  const bf16* Vg = P.VT + (size_t)(b * 8 + h) * 64 * SEQP;
  bf16x8 qf[6];
#pragma unroll
  for (int ks = 0; ks < 6; ++ks) qf[ks] = ldfrag(Qg + ks * 16 + hh * 8);
  f32x16 oacc[2]; oacc[0] = zero16(); oacc[1] = zero16();
  float lsum = 0.f;
  const int ntiles = nkeys / TK;
  unsigned koff[4], voff[3];
#pragma unroll
  for (int i = 0; i < 4; ++i) { const int q = (i * 8 + wave) * 64 + lane, row = q / 13, cc = q - row * 13; koff[i] = (unsigned)(row * 96 + (cc < 12 ? cc : 0) * 8) * 2u; }
#pragma unroll
  for (int i = 0; i < 3; ++i) { const int q = (i * 8 + wave) * 64 + lane, row = q / 17, cc = q - row * 17; voff[i] = (unsigned)((row < 64 ? row : 63) * SEQP + (cc < 16 ? cc : 0) * 8) * 2u; }
  LAS unsigned char* ldsb = (LAS unsigned char*)smem_base;
  auto dma_tile = [&](int kt, int buf) {
    const char* kb_ = (const char*)(Kg + (size_t)kt * TK * 96);
    const char* vb_ = (const char*)(Vg + (size_t)kt * TK);
#pragma unroll
    for (int i = 0; i < 4; ++i) {
      const int g = i * 8 + wave;
      if (g < 26) __builtin_amdgcn_global_load_lds((const unsigned*)(kb_ + koff[i]), (LAS unsigned*)(ldsb + buf * ST_BYTES + g * 1024), 16, 0, 0);
    }
#pragma unroll
    for (int i = 0; i < 3; ++i) {
      const int g = i * 8 + wave;
      if (g < 17) __builtin_amdgcn_global_load_lds((const unsigned*)(vb_ + voff[i]), (LAS unsigned*)(ldsb + buf * ST_BYTES + KS_BYTES + g * 1024), 16, 0, 0);
    }
  };
  __syncthreads();
  dma_tile(0, 0);
  asm volatile("s_waitcnt vmcnt(0)" ::: "memory");
  __syncthreads();
  for (int kt = 0; kt < ntiles; ++kt) {
    const int cur = kt & 1;
    if (kt + 1 < ntiles) dma_tile(kt + 1, cur ^ 1);
    const bf16* sK = reinterpret_cast<const bf16*>(smem_base + cur * ST_BYTES);
    const bf16* sV = reinterpret_cast<const bf16*>(smem_base + cur * ST_BYTES + KS_BYTES);
#pragma unroll
    for (int kk = 0; kk < 4; ++kk) {
      f32x16 sacc;
#pragma unroll
      for (int r = 0; r < 16; ++r) sacc[r] = -sref;
#pragma unroll
      for (int ks = 0; ks < 6; ++ks) {
        const bf16x8 a = ldfrag(sK + (kk * 32 + l31) * LDKS + ks * 16 + hh * 8);
        sacc = mfma32(a, qf[ks], sacc);
      }
#pragma unroll
      for (int r = 0; r < 16; ++r) { const float p = __builtin_amdgcn_exp2f(sacc[r]); sacc[r] = p; lsum += p; }
#pragma unroll
      for (int s = 0; s < 2; ++s) {
        bf16x8 pb;
#pragma unroll
        for (int j = 0; j < 8; ++j) pb[j] = (__bf16)sacc[8 * s + j];
#pragma unroll
        for (int dt = 0; dt < 2; ++dt) {
          const bf16x8 a = ldfrag(sV + (dt * 32 + l31) * LDVS + kk * 32 + s * 16 + hh * 8);
          oacc[dt] = mfma32(a, pb, oacc[dt]);
        }
      }
    }
    asm volatile("s_waitcnt vmcnt(0)" ::: "memory");
    __syncthreads();
  }
  lsum += __shfl_xor(lsum, 32);
  const float inv = 1.f / lsum;
  const int row = row_of(b, qpos0 + wave * 32 + l31);
  bf16* dst = P.H + (size_t)row * 1024 + 256 + h * 64;
#pragma unroll
  for (int dt = 0; dt < 2; ++dt)
#pragma unroll
    for (int rg = 0; rg < 4; ++rg) {
      const int d = dt * 32 + 8 * rg + 4 * hh;
      uint2 o;
      o.x = pack2(oacc[dt][4 * rg + 0] * inv, oacc[dt][4 * rg + 1] * inv);
      o.y = pack2(oacc[dt][4 * rg + 2] * inv, oacc[dt][4 * rg + 3] * inv);
      *reinterpret_cast<uint2*>(dst + d) = o;
    }
}

DEVI void phase_attn_scan(const Params& P, int l, unsigned char* smem_base, bool skip_scan = false) {
  if (!skip_scan)
    for (int it = NVB - 1 - VBID; it < 256; it += NVB) hgrn_scan_item(P, it);
  float sref;
  {
    const int lane = threadIdx.x & 63;
    float mq = fmaxf(fabsf(P.b_qh_w[l * 96 + lane]), lane < 32 ? fabsf(P.b_qh_w[l * 96 + 64 + lane]) : 0.f);
    float mk = fmaxf(fabsf(P.b_kh_w[l * 96 + lane]), lane < 32 ? fabsf(P.b_kh_w[l * 96 + 64 + lane]) : 0.f);
#pragma unroll
    for (int o = 32; o > 0; o >>= 1) { mq = fmaxf(mq, __shfl_xor(mq, o)); mk = fmaxf(mk, __shfl_xor(mk, o)); }
    sref = fminf(1.4426950408889634f * 9.797958971132712f * mq * mk, 60.f);
  }
  const int c = blockIdx.x, xcd = c & 7, slot = c >> 3;
  const int nrounds = (l == 0) ? 3 : 2;
  for (int r = 0; r < nrounds; ++r) {
    if (r < 2) {
      const int u = r * 32 + slot;
      const int bh = xcd * 8 + (u >> 3), qt = u & 7;
      if (slot < 32) attn_item8(P, bh >> 3, bh & 7, 256 + 256 * qt, 2304, sref, smem_base);
    } else if (c < 64) {
      attn_item8(P, c >> 3, c & 7, 0, 256, sref, smem_base);
    }
  }
}

DEVI unsigned ordkey(float s) { const unsigned u = __float_as_uint(s); return (u & 0x80000000u) ? ~u : (u | 0x80000000u); }
DEVI float keyval(unsigned k, unsigned mask) { const unsigned u = k & ~mask; return __uint_as_float((u & 0x80000000u) ? (u & 0x7fffffffu) : ~u); }
DEVI void ins16(unsigned (&lst)[16], unsigned v) {
#pragma unroll
  for (int j = 0; j < 16; ++j) { const unsigned hi = max(lst[j], v); v = min(lst[j], v); lst[j] = hi; }
}
DEVI void merge16(unsigned (&lst)[16], int xm) {
  unsigned o[16];
#pragma unroll
  for (int j = 0; j < 16; ++j) o[j] = (unsigned)__shfl_xor((int)lst[j], xm);
#pragma unroll
  for (int j = 0; j < 16; ++j) lst[j] = max(lst[j], o[15 - j]);
#pragma unroll
  for (int d = 8; d >= 1; d >>= 1)
#pragma unroll
    for (int j = 0; j < 16; ++j)
      if ((j & d) == 0) { const unsigned a = lst[j], bb = lst[j + d]; lst[j] = max(a, bb); lst[j + d] = min(a, bb); }
}

DEVI void bitonic_sort_desc16(unsigned (&v)[16]) {
#pragma unroll
  for (int k = 2; k <= 16; k <<= 1)
#pragma unroll
    for (int j = k >> 1; j > 0; j >>= 1)
#pragma unroll
      for (int i = 0; i < 16; ++i) {
        const int l = i ^ j;
        if (l > i) {
          const bool desc = ((i & k) == 0);
          const unsigned a = v[i], b = v[l];
          const unsigned mx = max(a, b), mn = min(a, b);
          v[i] = desc ? mx : mn; v[l] = desc ? mn : mx;
        }
      }
}
DEVI void bitonic_merge_desc16(unsigned (&lst)[16]) {
#pragma unroll
  for (int d = 8; d >= 1; d >>= 1)
#pragma unroll
    for (int j = 0; j < 16; ++j)
      if ((j & d) == 0) { const unsigned a = lst[j], bb = lst[j + d]; lst[j] = max(a, bb); lst[j + d] = min(a, bb); }
}
struct CandTab { int a[52]; int b[52]; };
constexpr CandTab make_cand_tab() {
  CandTab t{};
  int n = 0;
  for (int a = 0; a < 16; ++a)
    for (int b = 0; b < 16; ++b)
      if ((a + 1) * (b + 1) <= 16) { t.a[n] = a; t.b[n] = b; ++n; }
  for (; n < 52; ++n) { t.a[n] = 0; t.b[n] = 0; }
  return t;
}

DEVI void phase_route(const Params& P, int l, unsigned char* smem) {
  const int tid = TIDX;
  const int mtiles = (l == 1) ? 256 : 288;
  for (int it = VBID; it < mtiles * 8; it += NVB) {
    const int mt = it >> 3, h = it & 7;
    unsigned lst[2][16];
    const int row = tid >> 2, part = tid & 3;
#pragma unroll
    for (int p = 0; p < 2; ++p) {
      float sc[32];
      {
        const bf16* sp = P.QP + (size_t)(mt * 64 + row) * 2048 + (h * 2 + p) * 128 + part * 32;
#pragma unroll
        for (int i = 0; i < 4; ++i) {
          const uint4 u = *reinterpret_cast<const uint4*>(sp + i * 8);
          sc[i * 8 + 0] = lo2f(u.x); sc[i * 8 + 1] = hi2f(u.x); sc[i * 8 + 2] = lo2f(u.y); sc[i * 8 + 3] = hi2f(u.y);
          sc[i * 8 + 4] = lo2f(u.z); sc[i * 8 + 5] = hi2f(u.z); sc[i * 8 + 6] = lo2f(u.w); sc[i * 8 + 7] = hi2f(u.w);
        }
      }
      unsigned B2[16];
#pragma unroll
      for (int i = 0; i < 16; ++i) {
        const int i0 = part * 32 + i, i1 = part * 32 + 16 + i;
        lst[p][i] = (ordkey(sc[i]) & ~0x7fu) | (unsigned)(127 - i0);
        B2[i] = (ordkey(sc[16 + i]) & ~0x7fu) | (unsigned)(127 - i1);
      }
      bitonic_sort_desc16(lst[p]);
      bitonic_sort_desc16(B2);
#pragma unroll
      for (int j = 0; j < 16; ++j) lst[p][j] = max(lst[p][j], B2[15 - j]);
      bitonic_merge_desc16(lst[p]);
      merge16(lst[p], 1);
      merge16(lst[p], 2);
    }
    float v0[16], v1[16];
#pragma unroll
    for (int j = 0; j < 16; ++j) { v0[j] = keyval(lst[0][j], 0x7fu); v1[j] = keyval(lst[1][j], 0x7fu); }
    unsigned best[16];
    {
      constexpr CandTab CT = make_cand_tab();
#pragma unroll
      for (int c = 0; c < 13; ++c) {
        const int a0 = CT.a[4 * c + 0], a1 = CT.a[4 * c + 1], a2 = CT.a[4 * c + 2], a3 = CT.a[4 * c + 3];
        const int b0 = CT.b[4 * c + 0], b1 = CT.b[4 * c + 1], b2 = CT.b[4 * c + 2], b3 = CT.b[4 * c + 3];
        const float x = part == 0 ? v0[a0] : part == 1 ? v0[a1] : part == 2 ? v0[a2] : v0[a3];
        const float y = part == 0 ? v1[b0] : part == 1 ? v1[b1] : part == 2 ? v1[b2] : v1[b3];
        const int flat = part == 0 ? (a0 * 16 + b0) : part == 1 ? (a1 * 16 + b1) : part == 2 ? (a2 * 16 + b2) : (a3 * 16 + b3);
        const bool valid = part == 0 ? (4 * c + 0 < 50) : part == 1 ? (4 * c + 1 < 50) : part == 2 ? (4 * c + 2 < 50) : (4 * c + 3 < 50);
        const unsigned key = (ordkey(x + y) & ~0xffu) | (unsigned)(255 - flat);
        best[c] = valid ? key : 0u;
      }
      best[13] = 0u; best[14] = 0u; best[15] = 0u;
      bitonic_sort_desc16(best);
      merge16(best, 1);
      merge16(best, 2);
    }
    {
      const float mx = keyval(best[0], 0xffu);
      float es = 0.f;
      float ev[4]; int ex[4];
#pragma unroll
      for (int jj = 0; jj < 4; ++jj) {
        const unsigned kk = part == 0 ? best[4 * jj + 0] : part == 1 ? best[4 * jj + 1] : part == 2 ? best[4 * jj + 2] : best[4 * jj + 3];
        ev[jj] = __expf(keyval(kk, 0xffu) - mx);
        es += ev[jj];
        const int flat = 255 - (int)(kk & 0xffu);
        const int a = flat >> 4, bq = flat & 15;
        int i1 = 0, i2 = 0;
#pragma unroll
        for (int u = 0; u < 16; ++u) {
          i1 = (a == u) ? (127 - (int)(lst[0][u] & 0x7fu)) : i1;
          i2 = (bq == u) ? (127 - (int)(lst[1][u] & 0x7fu)) : i2;
        }
        ex[jj] = i1 * 128 + i2;
      }
      es += __shfl_xor(es, 1); es += __shfl_xor(es, 2);
      const float inv = 1.f / es;
      const int tok = mt * 64 + row;
      int* ed = P.EIDX + (size_t)tok * 128 + h * 16;
      float* gd = P.GATE + (size_t)tok * 128 + h * 16;
#pragma unroll
      for (int jj = 0; jj < 4; ++jj) { ed[4 * jj + part] = ex[jj]; gd[4 * jj + part] = ev[jj] * inv; }
    }
  }
}

DEVI float gelu_exact(float a) { return 0.5f * a * (1.f + erff(a * 0.70710678118654752f)); }

typedef float f2 __attribute__((ext_vector_type(2)));
DEVI void phase_peer_u(const Params& P, int l) {
  const int lane = TIDX & 63, half = lane >> 5, l32 = lane & 31;
  const int gw = VBID * 4 + (TIDX >> 6), nw = NVB * 4;
  const int nrows = (l == 1) ? NL : NT;
  const unsigned char* PU = P.PU8 + (size_t)l * 16384 * 576;
  const bool b4 = lane & 16, b3 = lane & 8, b2 = lane & 4;
  for (int t = gw; t < nrows; t += nw) {
    f2 h2[16];
    {
      const bf16* hp = P.H + (size_t)t * 1024 + l32 * 32;
#pragma unroll
      for (int i = 0; i < 4; ++i) {
        const uint4 hv = *reinterpret_cast<const uint4*>(hp + i * 8);
        h2[4 * i + 0] = (f2){lo2f(hv.x), hi2f(hv.x)}; h2[4 * i + 1] = (f2){lo2f(hv.y), hi2f(hv.y)};
        h2[4 * i + 2] = (f2){lo2f(hv.z), hi2f(hv.z)}; h2[4 * i + 3] = (f2){lo2f(hv.w), hi2f(hv.w)};
      }
    }
    const int e0 = P.EIDX[(size_t)t * 128 + lane], e1 = P.EIDX[(size_t)t * 128 + 64 + lane];
    const float g0 = P.GATE[(size_t)t * 128 + lane], g1 = P.GATE[(size_t)t * 128 + 64 + lane];
    float* wrow = P.WPE + (size_t)t * 128;
    const bool b1 = lane & 2;
    for (int kb = 0; kb < 4; ++kb) {
      const int esrc = kb < 2 ? e0 : e1;
      uint4 ud[16];
      unsigned short us[16];
#pragma unroll
      for (int i = 0; i < 16; ++i) {
        const int e = __shfl(esrc, (kb * 32 + 2 * i + half) & 63);
        const unsigned char* ur = PU + (size_t)e * 576;
        ud[i] = *reinterpret_cast<const uint4*>(ur + l32 * 16);
        us[i] = *reinterpret_cast<const unsigned short*>(ur + 512 + l32 * 2);
      }
      float d[16];
#pragma unroll
      for (int i = 0; i < 16; ++i) {
        const unsigned uw[4] = {ud[i].x, ud[i].y, ud[i].z, ud[i].w};
        f2 sacc = (f2){0.f, 0.f};
#pragma unroll
        for (int c = 0; c < 4; ++c) {
          sacc = __builtin_elementwise_fma(__builtin_amdgcn_cvt_scalef32_pk_f32_fp4(uw[c], 1.0f, 0), h2[4 * c + 0], sacc);
          sacc = __builtin_elementwise_fma(__builtin_amdgcn_cvt_scalef32_pk_f32_fp4(uw[c], 1.0f, 1), h2[4 * c + 1], sacc);
          sacc = __builtin_elementwise_fma(__builtin_amdgcn_cvt_scalef32_pk_f32_fp4(uw[c], 1.0f, 2), h2[4 * c + 2], sacc);
          sacc = __builtin_elementwise_fma(__builtin_amdgcn_cvt_scalef32_pk_f32_fp4(uw[c], 1.0f, 3), h2[4 * c + 3], sacc);
        }
        d[i] = (sacc.x + sacc.y) * __uint_as_float((unsigned)us[i] << 16);
      }
      float r8[8], r4[4], r2[2], r1;
#pragma unroll
      for (int i = 0; i < 8; ++i) { const float mine = b4 ? d[8 + i] : d[i]; const float send = b4 ? d[i] : d[8 + i]; r8[i] = mine + __shfl_xor(send, 16); }
#pragma unroll
      for (int i = 0; i < 4; ++i) { const float mine = b3 ? r8[4 + i] : r8[i]; const float send = b3 ? r8[i] : r8[4 + i]; r4[i] = mine + __shfl_xor(send, 8); }
#pragma unroll
      for (int i = 0; i < 2; ++i) { const float mine = b2 ? r4[2 + i] : r4[i]; const float send = b2 ? r4[i] : r4[2 + i]; r2[i] = mine + __shfl_xor(send, 4); }
      { const float mine = b1 ? r2[1] : r2[0]; const float send = b1 ? r2[0] : r2[1]; r1 = mine + __shfl_xor(send, 2); }
      r1 += __shfl_xor(r1, 1);
      const int k = kb * 32 + 2 * ((lane >> 1) & 15) + half;
      const float gt = __shfl(kb < 2 ? g0 : g1, k & 63);
      if ((lane & 1) == 0) wrow[k] = gt * gelu_exact(r1);
    }
  }
}

DEVI void phase_peer(const Params& P, int l) {
  const int lane = TIDX & 63, half = lane >> 5, l32 = lane & 31;
  const int gw = VBID * 4 + (TIDX >> 6), nw = NVB * 4;
  const int nrows = (l == 1) ? NL : NT;
  const unsigned char* PV = P.PV8 + (size_t)l * 16384 * 576;
  for (int t = gw; t < nrows; t += nw) {
    const int e0 = P.EIDX[(size_t)t * 128 + lane], e1 = P.EIDX[(size_t)t * 128 + 64 + lane];
    const float w0 = P.WPE[(size_t)t * 128 + lane], w1 = P.WPE[(size_t)t * 128 + 64 + lane];
    f2 y2[16];
#pragma unroll
    for (int i = 0; i < 16; ++i) y2[i] = (f2){0.f, 0.f};
    for (int kb = 0; kb < 4; ++kb) {
      const int esrc = kb < 2 ? e0 : e1;
      const float wsrc = kb < 2 ? w0 : w1;
      uint4 vd[16];
      unsigned short vs[16];
      float wv[16];
#pragma unroll
      for (int i = 0; i < 16; ++i) {
        const int ks = (kb * 32 + 2 * i + half) & 63;
        const int e = __shfl(esrc, ks);
        wv[i] = __shfl(wsrc, ks);
        const unsigned char* vr = PV + (size_t)e * 576;
        vd[i] = *reinterpret_cast<const uint4*>(vr + l32 * 16);
        vs[i] = *reinterpret_cast<const unsigned short*>(vr + 512 + l32 * 2);
      }
#pragma unroll
      for (int i = 0; i < 16; ++i) {
        const float wi = wv[i] * __uint_as_float((unsigned)vs[i] << 16);
        const f2 ww = (f2){wi, wi};
        const unsigned vw[4] = {vd[i].x, vd[i].y, vd[i].z, vd[i].w};
#pragma unroll
        for (int c = 0; c < 4; ++c) {
          y2[4 * c + 0] = __builtin_elementwise_fma(ww, __builtin_amdgcn_cvt_scalef32_pk_f32_fp4(vw[c], 1.0f, 0), y2[4 * c + 0]);
          y2[4 * c + 1] = __builtin_elementwise_fma(ww, __builtin_amdgcn_cvt_scalef32_pk_f32_fp4(vw[c], 1.0f, 1), y2[4 * c + 1]);
          y2[4 * c + 2] = __builtin_elementwise_fma(ww, __builtin_amdgcn_cvt_scalef32_pk_f32_fp4(vw[c], 1.0f, 2), y2[4 * c + 2]);
          y2[4 * c + 3] = __builtin_elementwise_fma(ww, __builtin_amdgcn_cvt_scalef32_pk_f32_fp4(vw[c], 1.0f, 3), y2[4 * c + 3]);
        }
      }
    }
    float y[16];
#pragma unroll
    for (int j = 0; j < 8; ++j) {
      const float ax = y2[j].x + __shfl_xor(y2[j].x, 32), ay = y2[j].y + __shfl_xor(y2[j].y, 32);
      const float bx = y2[8 + j].x + __shfl_xor(y2[8 + j].x, 32), by = y2[8 + j].y + __shfl_xor(y2[8 + j].y, 32);
      y[2 * j] = half ? bx : ax; y[2 * j + 1] = half ? by : ay;
    }
    const int bi = batch_of_row(t);
    const float* gate2 = P.MOD + (size_t)(l * 9 + bi) * 6144 + 5 * 1024;
    const int d0 = l32 * 32 + half * 16;
    float xn[16];
    float ss = 0.f;
#pragma unroll
    for (int q4 = 0; q4 < 4; ++q4) {
      const int d = d0 + q4 * 4;
      const uint2 xu = *reinterpret_cast<const uint2*>(P.X + (size_t)t * 1024 + d);
      const float4 xo = make_float4(lo2f(xu.x), hi2f(xu.x), lo2f(xu.y), hi2f(xu.y));
      const float4 gg = *reinterpret_cast<const float4*>(gate2 + d);
      float4 o;
      o.x = xo.x + gg.x * y[q4 * 4 + 0]; o.y = xo.y + gg.y * y[q4 * 4 + 1];
      o.z = xo.z + gg.z * y[q4 * 4 + 2]; o.w = xo.w + gg.w * y[q4 * 4 + 3];
      xn[q4 * 4 + 0] = o.x; xn[q4 * 4 + 1] = o.y; xn[q4 * 4 + 2] = o.z; xn[q4 * 4 + 3] = o.w;
      ss += o.x * o.x + o.y * o.y + o.z * o.z + o.w * o.w;
      if (l == 1) *reinterpret_cast<float4*>(P.out + (size_t)t * 1024 + d) = o;
      else *reinterpret_cast<uint2*>(P.X + (size_t)t * 1024 + d) = make_uint2(pack2(o.x, o.y), pack2(o.z, o.w));
    }
    if (l == 0) {
      ss = wave_sum(ss);
      const float rr = rsqrtf(ss * (1.f / 1024.f) + EPS);
      const float* lnw = P.ln1_w + 1024;
      const float* mod = P.MOD + (size_t)(9 + bi) * 6144;
      unsigned pk[8];
#pragma unroll
      for (int i = 0; i < 16; i += 2) {
        const float o0 = xn[i] * rr * lnw[d0 + i] * (1.f + mod[1024 + d0 + i]) + mod[d0 + i];
        const float o1 = xn[i + 1] * rr * lnw[d0 + i + 1] * (1.f + mod[1024 + d0 + i + 1]) + mod[d0 + i + 1];
        pk[i >> 1] = pack2(o0, o1);
      }
      *reinterpret_cast<uint4*>(P.H + (size_t)t * 1024 + d0) = make_uint4(pk[0], pk[1], pk[2], pk[3]);
      *reinterpret_cast<uint4*>(P.H + (size_t)t * 1024 + d0 + 8) = make_uint4(pk[4], pk[5], pk[6], pk[7]);
    }
  }
}

using f32x4 = __attribute__((ext_vector_type(4))) float;
namespace g8 {
constexpr int BM = 256, BK = 64, HALF = 128, HT = HALF * BK;
DEVI int lds_byte(int r, int c) { const int st = (r >> 4) * 2 + (c >> 5), rr = r & 15, cc = c & 31, ob = rr * 64 + cc * 2; return st * 1024 + (ob ^ (((ob >> 9) & 1) << 5)); }
DEVI void stage_rc(int b, int& R, int& C) { const int st = b / 1024, sb = b % 1024, swz = sb ^ (((sb >> 9) & 1) << 5); R = (st >> 1) * 16 + swz / 64; C = (st & 1) * 32 + (swz % 64) / 2; }
DEVI int perm32(int rho) { const int n = rho >> 4, i = rho & 15; return 8 * (i >> 2) + 4 * n + (i & 3); }
DEVI void unit_of(int L, int nM, int nN, int& pm, int& pn) {
  const int nwg = nM * nN;
  int wgid = L;
  { const int q = nwg / 8, r = nwg % 8, xcd = wgid % 8, off = wgid / 8; wgid = (xcd < r ? xcd * (q + 1) : r * (q + 1) + (xcd - r) * q) + off; }
  const int nig = 8 * nN, gid = wgid / nig, fm = gid * 8, gsz = (nM - fm) < 8 ? (nM - fm) : 8;
  pm = fm + ((wgid % nig) % gsz); pn = (wgid % nig) / gsz;
}
}

struct G8Unit { int pm, pn; };
template <class Epi>
DEVI void gemm8_phase(LAS unsigned char* lds, const bf16* __restrict__ Ag, const bf16* __restrict__ Btg, const int K, const int nM, const int nN, const Epi& E,
                      const int lda = 0, const int pn_split = 1 << 30, const int acol0 = 0, const int acol1 = 0,
                      const int ldb = 0, const int pn_mod = 1 << 30, const int ksplit_cols = 0) {
  constexpr int BK = 64, HALF = 128, HTB = HALF * BK * 2;
  const int tid = threadIdx.x, wid = __builtin_amdgcn_readfirstlane(tid >> 6), lane = tid & 63, wr = wid >> 2, wc = wid & 3, fr = lane & 15, fq = lane >> 4;
  const int nt = K / BK;
  const int nunits = nM * nN, G = gridDim.x, c = blockIdx.x;
  const int LDA = lda ? lda : K, LDB = ldb ? ldb : K;
  unsigned voffA[2], voffB[2];
#pragma unroll
  for (int i = 0; i < 2; ++i) { int R, C; g8::stage_rc(tid * 16 + i * 8192, R, C); const int Rb = (R & ~31) + g8::perm32(R & 31); voffA[i] = (unsigned)(R * LDA + C) * 2u; voffB[i] = (unsigned)(Rb * LDB + C) * 2u; }
  const size_t kstep = (size_t)(BK * 2);
  const size_t hstepA = (size_t)HALF * LDA * 2, hstep = (size_t)HALF * LDB * 2;
  const size_t tstepA = 2 * hstepA, tstep = 2 * hstep;
  const unsigned ldsw = (unsigned)wid * 1024u;
  const int aoff = g8::lds_byte(wr * 64 + fr, fq * 8), boff = g8::lds_byte(wc * 32 + fr, fq * 8);
#define PG8_SA(b, h) (((b) * 2 + (h)) * HTB)
#define PG8_SB(b, h) ((4 + (b) * 2 + (h)) * HTB)
#define PG8_STAGE(bufoff, gbase, voff) do { _Pragma("unroll") for (int _i = 0; _i < 2; ++_i) \
        __builtin_amdgcn_global_load_lds((const unsigned*)((const char*)(gbase) + (voff)[_i]), (LAS unsigned*)(lds + (bufoff) + ldsw + _i * 8192), 16, 0, 0); } while (0)
#define PG8_LDA(dst, b, h) do { _Pragma("unroll") for (int m = 0; m < 4; ++m) _Pragma("unroll") for (int k = 0; k < 2; ++k) dst[m][k] = *(const LAS bf16x8*)(lds + PG8_SA(b, h) + aoff + m * 2048 + k * 1024); } while (0)
#define PG8_LDB(dst, b, h) do { _Pragma("unroll") for (int n = 0; n < 2; ++n) _Pragma("unroll") for (int k = 0; k < 2; ++k) dst[n][k] = *(const LAS bf16x8*)(lds + PG8_SB(b, h) + boff + n * 2048 + k * 1024); } while (0)
#define PG8_MMA(ai, bj, At_, Bt_) do { __builtin_amdgcn_s_setprio(1); _Pragma("unroll") for (int m = 0; m < 4; ++m) _Pragma("unroll") for (int n = 0; n < 2; ++n) _Pragma("unroll") for (int k = 0; k < 2; ++k) \
        acc[ai][bj][m][n] = __builtin_amdgcn_mfma_f32_16x16x32_bf16(Bt_[n][k], At_[m][k], acc[ai][bj][m][n], 0, 0, 0); __builtin_amdgcn_s_setprio(0); } while (0)
#define PG8_WAIT_V(n) asm volatile("s_waitcnt vmcnt(" #n ")" ::: "memory")
#define PG8_WAIT_L(n) asm volatile("s_waitcnt lgkmcnt(" #n ")" ::: "memory")
#define PG8_BAR __builtin_amdgcn_s_barrier()
#define PG8_SCHED __builtin_amdgcn_sched_barrier(0)
  G8Unit cur, nxt; int ui = 0;
  if (c >= nunits) return;
  g8::unit_of(c, nM, nN, cur.pm, cur.pn);
  f32x4 acc[2][2][4][2];
#pragma unroll
  for (int a = 0; a < 2; ++a)
#pragma unroll
    for (int b = 0; b < 2; ++b)
#pragma unroll
      for (int m = 0; m < 4; ++m)
#pragma unroll
        for (int n = 0; n < 2; ++n) acc[a][b][m][n] = (f32x4){0.f, 0.f, 0.f, 0.f};
  bf16x8 At[4][2], B0[2][2], B1[2][2];
  const char* cA = (const char*)Ag + (size_t)cur.pm * tstepA + (size_t)((cur.pn < pn_split ? acol0 : acol1) + (cur.pn / pn_mod) * ksplit_cols) * 2;
  const char* cB = (const char*)Btg + (size_t)(cur.pn % pn_mod) * tstep + (size_t)((cur.pn / pn_mod) * ksplit_cols) * 2;
  PG8_STAGE(PG8_SB(0, 0), cB, voffB); PG8_STAGE(PG8_SA(0, 0), cA, voffA); PG8_STAGE(PG8_SB(0, 1), cB + hstep, voffB); PG8_STAGE(PG8_SA(0, 1), cA + hstepA, voffA);
  if (wr == 1) PG8_BAR;
  PG8_WAIT_V(4); PG8_BAR;
  PG8_STAGE(PG8_SB(1, 0), cB + kstep, voffB); PG8_STAGE(PG8_SA(1, 0), cA + kstep, voffA); PG8_STAGE(PG8_SB(1, 1), cB + hstep + kstep, voffB);
  PG8_WAIT_V(6); PG8_BAR;
  for (;;) {
    const long Ln = (long)(ui + 1) * G + c;
    const bool has_next = Ln < nunits;
    if (has_next) g8::unit_of((int)Ln, nM, nN, nxt.pm, nxt.pn);
    const char* nA = has_next ? (const char*)Ag + (size_t)nxt.pm * tstepA + (size_t)((nxt.pn < pn_split ? acol0 : acol1) + (nxt.pn / pn_mod) * ksplit_cols) * 2 : cA;
    const char* nB = has_next ? (const char*)Btg + (size_t)(nxt.pn % pn_mod) * tstep + (size_t)((nxt.pn / pn_mod) * ksplit_cols) * 2 : cB;
    for (int t = 0; t < nt; t += 2) {
      const bool last = (t == nt - 2);
      const char* a1 = cA + (size_t)(t + 1) * kstep;
      const char* a2 = last ? nA : cA + (size_t)(t + 2) * kstep; const char* b2 = last ? nB : cB + (size_t)(t + 2) * kstep;
      const char* a3 = a2 + kstep; const char* b3 = b2 + kstep;
      PG8_LDB(B0, 0, 0); PG8_SCHED; PG8_LDA(At, 0, 0); PG8_STAGE(PG8_SA(1, 1), a1 + hstepA, voffA);
      PG8_WAIT_L(8); PG8_BAR; PG8_WAIT_L(0); PG8_MMA(0, 0, At, B0); PG8_BAR; PG8_SCHED;
      PG8_LDB(B1, 0, 1); PG8_STAGE(PG8_SB(0, 0), b2, voffB);
      PG8_BAR; PG8_WAIT_L(0); PG8_MMA(0, 1, At, B1); PG8_BAR;
      PG8_LDA(At, 0, 1); PG8_STAGE(PG8_SA(0, 0), a2, voffA);
      PG8_BAR; PG8_WAIT_L(0); PG8_MMA(1, 0, At, B0); PG8_BAR; PG8_SCHED;
      PG8_STAGE(PG8_SB(0, 1), b2 + hstep, voffB);
      PG8_WAIT_V(6); PG8_BAR; PG8_MMA(1, 1, At, B1); PG8_BAR;
      PG8_LDB(B0, 1, 0); PG8_SCHED; PG8_LDA(At, 1, 0); PG8_STAGE(PG8_SA(0, 1), a2 + hstepA, voffA);
      PG8_WAIT_L(8); PG8_BAR; PG8_WAIT_L(0); PG8_MMA(0, 0, At, B0); PG8_BAR; PG8_SCHED;
      PG8_LDB(B1, 1, 1); PG8_STAGE(PG8_SB(1, 0), b3, voffB);
      PG8_BAR; PG8_WAIT_L(0); PG8_MMA(0, 1, At, B1); PG8_BAR;
      PG8_LDA(At, 1, 1); PG8_STAGE(PG8_SA(1, 0), a3, voffA);
      PG8_BAR; PG8_WAIT_L(0); PG8_MMA(1, 0, At, B0); PG8_BAR; PG8_SCHED;
      PG8_STAGE(PG8_SB(1, 1), b3 + hstep, voffB);
      PG8_WAIT_V(6); PG8_BAR; PG8_MMA(1, 1, At, B1); PG8_BAR;
    }
    if constexpr (!Epi::AFTER_DRAIN) E(acc, cur, wr, wc, fr, fq);
    if (!has_next) break;
#pragma unroll
    for (int a = 0; a < 2; ++a)
#pragma unroll
      for (int b = 0; b < 2; ++b)
#pragma unroll
        for (int m = 0; m < 4; ++m)
#pragma unroll
          for (int n = 0; n < 2; ++n) acc[a][b][m][n] = (f32x4){0.f, 0.f, 0.f, 0.f};
    cur = nxt; cA = nA; cB = nB; ++ui;
  }
  PG8_WAIT_V(0);
  if (wr == 0) PG8_BAR;
  PG8_BAR;
  if constexpr (Epi::AFTER_DRAIN) E.fused(acc, cur, wr, wc, fr, fq, lds, wid, lane);
#undef PG8_SA
#undef PG8_SB
#undef PG8_STAGE
#undef PG8_LDA
#undef PG8_LDB
#undef PG8_MMA
}

struct EpiZ {
  static constexpr bool AFTER_DRAIN = false;
  bf16* Z;
  DEVI void operator()(const f32x4 (&acc)[2][2][4][2], const G8Unit& u, int wr, int wc, int fr, int fq) const {
    const int brow = u.pm * 256, bcol = u.pn * 256;
#pragma unroll
    for (int ai = 0; ai < 2; ++ai)
#pragma unroll
      for (int m = 0; m < 4; ++m) {
        const int row = brow + ai * 128 + wr * 64 + m * 16 + fr;
#pragma unroll
        for (int bj = 0; bj < 2; ++bj) {
          const int col = bcol + bj * 128 + wc * 32 + 8 * fq;
          if (col < DIN) {
            const f32x4 v0 = acc[ai][bj][m][0], v1 = acc[ai][bj][m][1];
            *reinterpret_cast<uint4*>(Z + (size_t)row * DIN + col) = make_uint4(pack2(v0[0], v0[1]), pack2(v0[2], v0[3]), pack2(v1[0], v1[1]), pack2(v1[2], v1[3]));
          }
        }
      }
  }
};
DEVI void phase_gemm1_8(const Params& P, int l, unsigned char* smem_base) {
  EpiZ E{P.Z};
  gemm8_phase((LAS unsigned char*)smem_base, P.H, P.WinT + (size_t)l * DINP * 1024, 1024, NT / 256, DINP / 256, E);
  const int c = blockIdx.x;
  if (c >= 136) {
    const int j = c - 136;
    if (l == 0) convert_rows_fp6(P, 0, j * 100, j * 100 + 100);
    else { const int b0 = 19200 + j * 114; convert_rows_fp6(P, 1, b0 < 32768 ? b0 : 32768, b0 + 114 < 32768 ? b0 + 114 : 32768); }
  }
}

struct EpiRAW {
  static constexpr bool AFTER_DRAIN = false;
  bf16* R;
  DEVI void operator()(const f32x4 (&acc)[2][2][4][2], const G8Unit& u, int wr, int wc, int fr, int fq) const {
    const int brow = u.pm * 256, bcol = u.pn * 256;
#pragma unroll
    for (int ai = 0; ai < 2; ++ai)
#pragma unroll
      for (int m = 0; m < 4; ++m) {
        const int row = brow + ai * 128 + wr * 64 + m * 16 + fr;
#pragma unroll
        for (int bj = 0; bj < 2; ++bj) {
          const int col = bcol + bj * 128 + wc * 32 + 8 * fq;
          const f32x4 v0 = acc[ai][bj][m][0], v1 = acc[ai][bj][m][1];
          *reinterpret_cast<uint4*>(R + (size_t)row * 1792 + col) = make_uint4(pack2(v0[0], v0[1]), pack2(v0[2], v0[3]), pack2(v1[0], v1[1]), pack2(v1[2], v1[3]));
        }
      }
  }
};
DEVI void phase_mla_raw(const Params& P, int l, unsigned char* smem_base) {
  {
    const int lane = threadIdx.x & 63;
    for (int t = blockIdx.x * 8 + (threadIdx.x >> 6); t < NT; t += gridDim.x * 8) {
      const bf16* zr = P.Z + (size_t)t * DIN;
      const uint2 uq = *reinterpret_cast<const uint2*>(zr + ZC_BQ + lane * 4);
      const unsigned uk = *reinterpret_cast<const unsigned*>(zr + ZC_BKV + lane * 2);
      float sq = lo2f(uq.x) * lo2f(uq.x) + hi2f(uq.x) * hi2f(uq.x) + lo2f(uq.y) * lo2f(uq.y) + hi2f(uq.y) * hi2f(uq.y);
      float sk = lo2f(uk) * lo2f(uk) + hi2f(uk) * hi2f(uk);
      sq = wave_sum(sq); sk = wave_sum(sk);
      if (lane == 0) { P.RS[(size_t)t * 2] = rsqrtf(sq * (1.f / 256.f) + EPS); P.RS[(size_t)t * 2 + 1] = rsqrtf(sk * (1.f / 128.f) + EPS); }
    }
  }
  EpiRAW E{P.RAW};
  gemm8_phase((LAS unsigned char*)smem_base, P.Z, P.WCOMB + (size_t)l * 1792 * 256, 256, NT / 256, 7, E, DIN, 3, ZC_BQ, ZC_BKV);
}

struct EpiX {
  static constexpr bool AFTER_DRAIN = false;
  const float* x; const float* ctx; bf16* X; const float* MODl; int l;
  DEVI void operator()(const f32x4 (&acc)[2][2][4][2], const G8Unit& u, int wr, int wc, int fr, int fq) const {
    const int brow = u.pm * 256, bcol = u.pn * 256;
    const float* gate = MODl + (size_t)batch_of_row(brow) * 6144 + 2048;
#pragma unroll
    for (int ai = 0; ai < 2; ++ai)
#pragma unroll
      for (int m = 0; m < 4; ++m) {
        const int row = brow + ai * 128 + wr * 64 + m * 16 + fr;
        const float* res = row < NL ? x + (size_t)row * 1024 : ctx + (size_t)(row - NL) * 1024;
#pragma unroll
        for (int bj = 0; bj < 2; ++bj) {
          const int col = bcol + bj * 128 + wc * 32 + 8 * fq;
          const f32x4 v0 = acc[ai][bj][m][0], v1 = acc[ai][bj][m][1];
          float4 ra, rb;
          if (l == 0) { ra = *reinterpret_cast<const float4*>(res + col); rb = *reinterpret_cast<const float4*>(res + col + 4); }
          else {
            const uint4 uu = *reinterpret_cast<const uint4*>(X + (size_t)row * 1024 + col);
            ra = make_float4(lo2f(uu.x), hi2f(uu.x), lo2f(uu.y), hi2f(uu.y)); rb = make_float4(lo2f(uu.z), hi2f(uu.z), lo2f(uu.w), hi2f(uu.w));
          }
          const float4 ga = *reinterpret_cast<const float4*>(gate + col), gb = *reinterpret_cast<const float4*>(gate + col + 4);
          *reinterpret_cast<uint4*>(X + (size_t)row * 1024 + col) =
              make_uint4(pack2(ra.x + ga.x * v0[0], ra.y + ga.y * v0[1]), pack2(ra.z + ga.z * v0[2], ra.w + ga.w * v0[3]),
                         pack2(rb.x + gb.x * v1[0], rb.y + gb.y * v1[1]), pack2(rb.z + gb.z * v1[2], rb.w + gb.w * v1[3]));
        }
      }
  }
};
struct EpiXN {
  static constexpr bool AFTER_DRAIN = true;
  const float* x; bf16* X; bf16* H; const float* MODl; const float* lnw; float* XB; unsigned* cnt; int l;
  DEVI void operator()(const f32x4 (&)[2][2][4][2], const G8Unit&, int, int, int, int) const {}
  DEVI void fused(f32x4 (&acc)[2][2][4][2], const G8Unit& u, int wr, int wc, int fr, int fq, LAS unsigned char* lds, int wid, int lane) const {
    const int brow = u.pm * 256, bcol = u.pn * 256;
    const float* modb = MODl + (size_t)batch_of_row(brow) * 6144;
    const float* gate = modb + 2048;
    LAS float* Pt = (LAS float*)lds;
    LAS float* St = (LAS float*)(lds + 8192);
#pragma unroll
    for (int ai = 0; ai < 2; ++ai)
#pragma unroll
      for (int m = 0; m < 4; ++m) {
        const int row = brow + ai * 128 + wr * 64 + m * 16 + fr;
        float ss = 0.f;
#pragma unroll
        for (int bj = 0; bj < 2; ++bj) {
          const int col = bcol + bj * 128 + wc * 32 + 8 * fq;
          float4 ra, rb;
          if (l == 0) { ra = *reinterpret_cast<const float4*>(x + (size_t)row * 1024 + col); rb = *reinterpret_cast<const float4*>(x + (size_t)row * 1024 + col + 4); }
          else {
            const uint4 uu = *reinterpret_cast<const uint4*>(X + (size_t)row * 1024 + col);
            ra = make_float4(lo2f(uu.x), hi2f(uu.x), lo2f(uu.y), hi2f(uu.y)); rb = make_float4(lo2f(uu.z), hi2f(uu.z), lo2f(uu.w), hi2f(uu.w));
          }
          const float4 ga = *reinterpret_cast<const float4*>(gate + col), gb = *reinterpret_cast<const float4*>(gate + col + 4);
          f32x4 v0 = acc[ai][bj][m][0], v1 = acc[ai][bj][m][1];
          v0[0] = ra.x + ga.x * v0[0]; v0[1] = ra.y + ga.y * v0[1]; v0[2] = ra.z + ga.z * v0[2]; v0[3] = ra.w + ga.w * v0[3];
          v1[0] = rb.x + gb.x * v1[0]; v1[1] = rb.y + gb.y * v1[1]; v1[2] = rb.z + gb.z * v1[2]; v1[3] = rb.w + gb.w * v1[3];
          acc[ai][bj][m][0] = v0; acc[ai][bj][m][1] = v1;
          ss += (v0[0] * v0[0] + v0[1] * v0[1]) + (v0[2] * v0[2] + v0[3] * v0[3]) + (v1[0] * v1[0] + v1[1] * v1[1]) + (v1[2] * v1[2] + v1[3] * v1[3]);
        }
        ss += __shfl_xor(ss, 16); ss += __shfl_xor(ss, 32);
        if (fq == 0) Pt[(ai * 128 + wr * 64 + m * 16 + fr) * 4 + wc] = ss;
      }
    asm volatile("s_waitcnt lgkmcnt(0)" ::: "memory"); __builtin_amdgcn_s_barrier(); asm volatile("" ::: "memory");
    const int rowl = wid * 32 + (lane & 31);
    if (lane < 32) {
      const float tot = (Pt[rowl * 4 + 0] + Pt[rowl * 4 + 1]) + (Pt[rowl * 4 + 2] + Pt[rowl * 4 + 3]);
      __hip_atomic_store(XB + (size_t)(brow + rowl) * 4 + u.pn, tot, __ATOMIC_RELAXED, __HIP_MEMORY_SCOPE_AGENT);
    }
    asm volatile("s_waitcnt vmcnt(0)" ::: "memory");
    if (lane == 0) (void)__hip_atomic_fetch_add(cnt + 64 * u.pm, 1u, __ATOMIC_RELAXED, __HIP_MEMORY_SCOPE_AGENT);
    if (wid == 0) {
      unsigned sp = 0;
      while ((unsigned)__builtin_amdgcn_readfirstlane((int)__hip_atomic_load(cnt + 64 * u.pm, __ATOMIC_RELAXED, __HIP_MEMORY_SCOPE_AGENT)) < 32u) {
        __builtin_amdgcn_s_sleep(2);
        if (++sp > XB_SPIN_CAP) break;
      }
      __builtin_amdgcn_fence(__ATOMIC_ACQUIRE, "agent");
    }
    asm volatile("s_waitcnt vmcnt(0) lgkmcnt(0)" ::: "memory"); __builtin_amdgcn_s_barrier(); asm volatile("" ::: "memory");
    if (lane < 32) {
      const float* sl = XB + (size_t)(brow + rowl) * 4;
      const float a0 = __hip_atomic_load(sl + 0, __ATOMIC_RELAXED, __HIP_MEMORY_SCOPE_AGENT), a1 = __hip_atomic_load(sl + 1, __ATOMIC_RELAXED, __HIP_MEMORY_SCOPE_AGENT);
      const float a2 = __hip_atomic_load(sl + 2, __ATOMIC_RELAXED, __HIP_MEMORY_SCOPE_AGENT), a3 = __hip_atomic_load(sl + 3, __ATOMIC_RELAXED, __HIP_MEMORY_SCOPE_AGENT);
      St[rowl] = rsqrtf(((a0 + a1) + (a2 + a3)) * (1.f / 1024.f) + EPS);
    }
    asm volatile("s_waitcnt vmcnt(0) lgkmcnt(0)" ::: "memory"); __builtin_amdgcn_s_barrier(); asm volatile("" ::: "memory");
    const float* shp = modb + 3072;
    const float* scp = modb + 3072 + 1024;
#pragma unroll
    for (int bj = 0; bj < 2; ++bj) {
      const int col = bcol + bj * 128 + wc * 32 + 8 * fq;
      const float4 wa = *reinterpret_cast<const float4*>(lnw + col), wb = *reinterpret_cast<const float4*>(lnw + col + 4);
      const float4 sa = *reinterpret_cast<const float4*>(scp + col), sb = *reinterpret_cast<const float4*>(scp + col + 4);
      const float4 ha = *reinterpret_cast<const float4*>(shp + col), hb = *reinterpret_cast<const float4*>(shp + col + 4);
      const float4 ma = make_float4(wa.x * (1.f + sa.x), wa.y * (1.f + sa.y), wa.z * (1.f + sa.z), wa.w * (1.f + sa.w));
      const float4 mb = make_float4(wb.x * (1.f + sb.x), wb.y * (1.f + sb.y), wb.z * (1.f + sb.z), wb.w * (1.f + sb.w));
#pragma unroll
      for (int ai = 0; ai < 2; ++ai)
#pragma unroll
        for (int m = 0; m < 4; ++m) {
          const int rl = ai * 128 + wr * 64 + m * 16 + fr;
          const float rr = St[rl];
          const f32x4 v0 = acc[ai][bj][m][0], v1 = acc[ai][bj][m][1];
          const size_t off = (size_t)(brow + rl) * 1024 + col;
          *reinterpret_cast<uint4*>(X + off) = make_uint4(pack2(v0[0], v0[1]), pack2(v0[2], v0[3]), pack2(v1[0], v1[1]), pack2(v1[2], v1[3]));
          *reinterpret_cast<uint4*>(H + off) =
              make_uint4(pack2(v0[0] * rr * ma.x + ha.x, v0[1] * rr * ma.y + ha.y), pack2(v0[2] * rr * ma.z + ha.z, v0[3] * rr * ma.w + ha.w),
                         pack2(v1[0] * rr * mb.x + hb.x, v1[1] * rr * mb.y + hb.y), pack2(v1[2] * rr * mb.z + hb.z, v1[3] * rr * mb.w + hb.w));
        }
    }
    asm volatile("s_waitcnt lgkmcnt(0)" ::: "memory"); __builtin_amdgcn_s_barrier(); asm volatile("" ::: "memory");
  }
};
struct EpiPart {
  static constexpr bool AFTER_DRAIN = false;
  float* PART;
  DEVI void operator()(const f32x4 (&acc)[2][2][4][2], const G8Unit& u, int wr, int wc, int fr, int fq) const {
    const int brow = u.pm * 256, bcol = (u.pn & 3) * 256;
    float* base = PART + (size_t)(u.pn >> 2) * 2048 * 1024;
#pragma unroll
    for (int ai = 0; ai < 2; ++ai)
#pragma unroll
      for (int m = 0; m < 4; ++m) {
        const int row = brow + ai * 128 + wr * 64 + m * 16 + fr;
#pragma unroll
        for (int bj = 0; bj < 2; ++bj) {
          const int col = bcol + bj * 128 + wc * 32 + 8 * fq;
          const f32x4 v0 = acc[ai][bj][m][0], v1 = acc[ai][bj][m][1];
          *reinterpret_cast<float4*>(base + (size_t)row * 1024 + col) = make_float4(v0[0], v0[1], v0[2], v0[3]);
          *reinterpret_cast<float4*>(base + (size_t)row * 1024 + col + 4) = make_float4(v1[0], v1[1], v1[2], v1[3]);
        }
      }
  }
};
DEVI void phase_gemm2_8(const Params& P, int l, unsigned char* smem_base) {
  EpiXN E{P.x, P.X, P.H, P.MOD + (size_t)l * 9 * 6144, P.ln2_w + l * 1024, P.XB, P.ncnt + l * 64 * 64, l};
  gemm8_phase((LAS unsigned char*)smem_base, P.H, P.WoutT + (size_t)l * 1024 * 1024, 1024, NL / 256, 4, E);
  if (l == 0) {
    EpiPart EP{P.PART};
    gemm8_phase((LAS unsigned char*)smem_base, P.H + (size_t)NL * 1024, P.WoutT, 512, 8, 8, EP, 1024, 1 << 30, 0, 0, 1024, 4, 512);
    const int c = blockIdx.x;
    if (c >= 64) {
      const int b0 = 12000 + (c - 64) * 109;
      convert_rows_fp6(P, 0, b0 < 32768 ? b0 : 32768, b0 + 109 < 32768 ? b0 + 109 : 32768);
    }
  }
}

struct EpiQP {
  static constexpr bool AFTER_DRAIN = false;
  bf16* QP;
  DEVI void operator()(const f32x4 (&acc)[2][2][4][2], const G8Unit& u, int wr, int wc, int fr, int fq) const {
    const int brow = u.pm * 256, bcol = u.pn * 256;
#pragma unroll
    for (int ai = 0; ai < 2; ++ai)
#pragma unroll
      for (int m = 0; m < 4; ++m) {
        const int row = brow + ai * 128 + wr * 64 + m * 16 + fr;
#pragma unroll
        for (int bj = 0; bj < 2; ++bj) {
          const int col = bcol + bj * 128 + wc * 32 + 8 * fq;
          const f32x4 v0 = acc[ai][bj][m][0], v1 = acc[ai][bj][m][1];
          *reinterpret_cast<uint4*>(QP + (size_t)row * 2048 + col) = make_uint4(pack2(v0[0], v0[1]), pack2(v0[2], v0[3]), pack2(v1[0], v1[1]), pack2(v1[2], v1[3]));
        }
      }
  }
};
DEVI void phase_gemm3_8(const Params& P, int l, unsigned char* smem_base) {
  EpiQP E{P.QP};
  gemm8_phase((LAS unsigned char*)smem_base, P.H, P.WpqT + (size_t)l * 2048 * 1024, 1024, (l == 1) ? NL / 256 : NT / 256, 8, E);
  const int c = blockIdx.x;
  if (l == 0 && c >= 64) convert_rows_fp6(P, 1, (c - 64) * 100, (c - 64) * 100 + 100);
}

constexpr int N_PHASES = 2 + 2 * 11 - 1;

#ifndef REP_MASK
#define REP_MASK 0
#endif
static_assert(sizeof(Params) % 8 == 0, "Params size");
DEVI Params load_params() {
#if defined(__HIP_DEVICE_COMPILE__)
  typedef const __attribute__((address_space(4))) Params* ParamsCP;
  ParamsCP pp = (ParamsCP)__builtin_amdgcn_kernarg_segment_ptr();
  asm volatile("" : "+s"(pp));
  return *pp;
#else
  return Params{};
#endif
}
__global__ void __launch_bounds__(512, 2) fwd_kernel(Params Pk) {
  extern __shared__ __attribute__((aligned(16))) unsigned char smem_base[];
  volatile LAS unsigned* xst = (volatile LAS unsigned*)(smem_base + SMEM_BYTES);
  if (threadIdx.x == 0) { xst[0] = 0u; xst[1] = 0u; xst[2] = 0u; xst[3] = 0u; }
  __syncthreads();
  XcdBarrier xb = xcd_barrier_post(Pk.bar, xst);
  const int phase_lo = Pk.phase_lo, phase_hi = Pk.phase_hi, coop = Pk.coop;
#define smem (smem_base + VHALF * HALF_LDS)
#define GSYNC(idx) { xcd_barrier(xb); }
#define RUN_PHASE2(idx, call, repcall) \
  if (phase_lo <= (idx) && (idx) <= phase_hi) { { const Params P = load_params(); call; } if (REP_MASK & (1 << (idx))) { GSYNC(1); const Params P = load_params(); repcall; } if (coop && (idx) < phase_hi) GSYNC(idx); }
#define RUN_PHASE(idx, call) RUN_PHASE2(idx, call, call)
  RUN_PHASE(0, phase_prologue(P, smem))
  RUN_PHASE(1, phase_norm(P, 0, 0, NT))
  RUN_PHASE(2, phase_gemm1_8(P, 0, smem_base))
  RUN_PHASE(3, phase_mla_raw(P, 0, smem_base))
  RUN_PHASE(4, { phase_mixA(P, 0, smem); phase_mla_proj(P, 0, smem); phase_hgrn_local(P, 0, smem); })
  RUN_PHASE2(5, phase_attn_scan(P, 0, smem_base), phase_attn_scan(P, 0, smem_base, true))
  RUN_PHASE(6, phase_hgrn_final(P, 0, smem))
  RUN_PHASE(7, phase_gemm2_8(P, 0, smem_base))
  RUN_PHASE(8, phase_norm(P, 0, 1, NT, NL))
  RUN_PHASE(9, phase_gemm3_8(P, 0, smem_base))
  RUN_PHASE(10, phase_route(P, 0, smem))
  RUN_PHASE(11, phase_peer_u(P, 0))
  RUN_PHASE(12, phase_peer(P, 0))
  RUN_PHASE(13, phase_gemm1_8(P, 1, smem_base))
  RUN_PHASE(14, phase_mla_raw(P, 1, smem_base))
  RUN_PHASE(15, { phase_mixA(P, 1, smem); phase_mla_proj(P, 1, smem); phase_hgrn_local(P, 1, smem); })
  RUN_PHASE2(16, phase_attn_scan(P, 1, smem_base), phase_attn_scan(P, 1, smem_base, true))
  RUN_PHASE(17, phase_hgrn_final(P, 1, smem))
  RUN_PHASE(18, phase_gemm2_8(P, 1, smem_base))
  RUN_PHASE(19, phase_gemm3_8(P, 1, smem_base))
  RUN_PHASE(20, phase_route(P, 1, smem))
  RUN_PHASE(21, phase_peer_u(P, 1))
  RUN_PHASE(22, phase_peer(P, 1))
#undef smem
}

extern "C" void kernel_launch(void* const* d_in, const int* in_sizes, int n_in, void* d_out, int out_size, void* d_ws,
                              size_t ws_size, hipStream_t stream) {
  Params p{};
  const float* const* in = reinterpret_cast<const float* const*>(d_in);
  p.x = in[0]; p.c = in[1]; p.ctx = in[2]; p.c_ctx = in[3]; p.ln1_w = in[4]; p.ln2_w = in[5]; p.w_mod = in[6]; p.b_mod = in[7];
  p.w_in = in[8]; p.w_out = in[9]; p.a_norm_w = in[10]; p.a_w_s = in[11]; p.a_b_s = in[12]; p.b_q_norm_w = in[13]; p.b_w_uq = in[14];
  p.b_kv_norm_w = in[15]; p.b_w_ukv = in[16]; p.b_qh_w = in[17]; p.b_kh_w = in[18]; p.c_lb = in[19]; p.c_out_norm_w = in[20];
  p.p_w_q = in[21]; p.p_sub_keys = in[22]; p.p_u = in[23]; p.p_v = in[24];
  p.out = reinterpret_cast<float*>(d_out);
  unsigned char* ws = reinterpret_cast<unsigned char*>(d_ws);
  size_t off = 0;
  auto take = [&](size_t bytes) { unsigned char* r = ws + off; off += (bytes + 255) & ~(size_t)255; return r; };
  p.bar = (unsigned*)take((size_t)(XCD_BAR_WORDS + 2 * 64 * 64) * 4);
  p.ncnt = p.bar + XCD_BAR_WORDS;
  p.XB = (float*)take((size_t)NL * 4 * 4);
  p.MOD = (float*)take((size_t)2 * 9 * 6144 * 4);
  p.ROPE = (float*)take((size_t)2048 * 32 * 4);
  p.WinT = (bf16*)take((size_t)2 * DINP * 1024 * 2);
  p.WoutT = (bf16*)take((size_t)2 * 1024 * 1024 * 2);
  p.WpqT = (bf16*)take((size_t)2 * 2048 * 1024 * 2);
  p.WCOMB = (bf16*)take((size_t)2 * 1792 * 256 * 2);
  p.RAW = (bf16*)take((size_t)NT * 1792 * 2);
  p.SK = (bf16*)take((size_t)2 * 16 * 128 * 128 * 2);
  p.AWS = (bf16*)take((size_t)2 * 4 * 128 * 128 * 2);
  p.PU8 = (unsigned char*)take((size_t)2 * 16384 * 576);
  p.PV8 = (unsigned char*)take((size_t)2 * 16384 * 576);
  p.PUS = (float*)take((size_t)2 * 16384 * 4);
  p.PVS = (float*)take((size_t)2 * 16384 * 4);
  p.X = (bf16*)take((size_t)NT * 1024 * 2);
  p.H = (bf16*)take((size_t)NT * 1024 * 2);
  p.Z = (bf16*)take((size_t)NT * DIN * 2);
  p.Q = (bf16*)take((size_t)64 * SEQP * 96 * 2);
  p.K = (bf16*)take((size_t)64 * SEQP * 96 * 2);
  p.VT = (bf16*)take((size_t)64 * 64 * SEQP * 2);
  p.ST = (bf16*)take((size_t)64 * 36 * 4096 * 2);
  p.DEC = (float*)take((size_t)64 * 36 * 64 * 4);
  p.OI = (bf16*)take((size_t)NT * 256 * 2);
  p.WPE = (float*)take((size_t)NT * 128 * 4);
  p.PART = (float*)take((size_t)2 * 2048 * 1024 * 4);
  p.RS = (float*)take((size_t)NT * 2 * 4);
  p.GQF = (bf16*)take((size_t)NT * 256 * 2);
  p.GQB = (bf16*)take((size_t)NT * 256 * 2);
  p.QP = p.Z;
  p.EIDX = (int*)p.Q;
  p.GATE = (float*)p.K;
  if (off > ws_size) { fprintf(stderr, "workspace too small: need %zu have %zu\n", off, ws_size); }
  static int grid_blocks = 0;
  if (!grid_blocks) {
    if (hipFuncSetAttribute((const void*)fwd_kernel, hipFuncAttributeMaxDynamicSharedMemorySize, SMEM_TOTAL) != hipSuccess)
      fprintf(stderr, "hipFuncSetAttribute failed\n");
    int dev = 0, cus = 0, per_cu = 0;
    hipGetDevice(&dev);
    hipDeviceGetAttribute(&cus, hipDeviceAttributeMultiprocessorCount, dev);
    hipOccupancyMaxActiveBlocksPerMultiprocessor(&per_cu, (const void*)fwd_kernel, 512, SMEM_TOTAL);
    if (per_cu > 1) per_cu = 1;
    if (per_cu < 1) { fprintf(stderr, "occupancy query returned %d\n", per_cu); per_cu = 1; }
    grid_blocks = cus * per_cu;
    fprintf(stderr, "grid_blocks=%d (cus=%d per_cu=%d) ws need=%zu have=%zu\n", grid_blocks, cus, per_cu, off, ws_size);
  }
  hipMemsetAsync(p.bar, 0, (size_t)(XCD_BAR_WORDS + 2 * 64 * 64) * 4, stream);
  p.coop = 1; p.phase_lo = 0; p.phase_hi = N_PHASES - 1;
  hipLaunchKernelGGL(fwd_kernel, dim3(grid_blocks), dim3(512), SMEM_TOTAL, stream, p);
  const hipError_t e = hipPeekAtLastError();
  if (e != hipSuccess) fprintf(stderr, "launch failed: %s (grid %d)\n", hipGetErrorString(e), grid_blocks);
}
```

```cpp
#include <hip/hip_runtime.h>
#include <hip/hip_cooperative_groups.h>
#include <cstdio>
#include <cstdint>
namespace cg = cooperative_groups;

#define DEVI __device__ __forceinline__

typedef unsigned short bf16;
using bf16x8 = __attribute__((ext_vector_type(8))) __bf16;
using bf16x2 = __attribute__((ext_vector_type(2))) __bf16;
using f32x16 = __attribute__((ext_vector_type(16))) float;
typedef unsigned v6u __attribute__((ext_vector_type(6)));
typedef unsigned v3u __attribute__((ext_vector_type(3)));
typedef float v16f __attribute__((ext_vector_type(16)));
typedef float v32f __attribute__((ext_vector_type(32)));

constexpr int NL = 16384;
constexpr int NT = 18432;
constexpr int DM = 1024;
constexpr int DIN = 2208;
constexpr int DINP = 2304;
constexpr int SEQP = 2304;
constexpr float EPS = 1e-6f;
constexpr int ZC_AU = 0, ZC_AV = 256, ZC_BQ = 512, ZC_BKV = 768, ZC_BKR = 896, ZC_CQ = 928, ZC_CFF = 1184, ZC_CFB = 1440, ZC_CI = 1696, ZC_CG = 1952;
constexpr int SMEM_BYTES = 2 * 80896;
constexpr int SMEM_TOTAL = SMEM_BYTES + 16;

struct Params {
  const float *x, *c, *ctx, *c_ctx, *ln1_w, *ln2_w, *w_mod, *b_mod, *w_in, *w_out, *a_norm_w, *a_w_s, *a_b_s;
  const float *b_q_norm_w, *b_w_uq, *b_kv_norm_w, *b_w_ukv, *b_qh_w, *b_kh_w, *c_lb, *c_out_norm_w, *p_w_q, *p_sub_keys, *p_u, *p_v;
  float* out;
  unsigned* bar;
  float* MOD;
  float* ROPE;
  bf16* WinT;
  bf16* WoutT;
  bf16* WpqT;
  bf16* WCOMB;
  bf16* RAW;
  bf16* SK;
  bf16* AWS;
  unsigned char* PU8;
  unsigned char* PV8;
  float* PUS;
  float* PVS;
  bf16* X;
  bf16* H;
  bf16* Z;
  bf16* Q;
  bf16* K;
  bf16* VT;
  bf16* ST;
  float* DEC;
  bf16* OI;
  float* WPE;
  float* RS;
  float* PART;
  bf16* GQF;
  bf16* GQB;
  bf16* QP;
  int* EIDX;
  float* XB;
  float* LBT;
  unsigned* ncnt;
  float* GATE;
  int phase_lo, phase_hi, coop, pad0;
};

DEVI float bf2f(bf16 v) { return __uint_as_float(((unsigned)v) << 16); }
DEVI bf16 f2bf(float a) { __bf16 v = (__bf16)a; return __builtin_bit_cast(unsigned short, v); }
DEVI unsigned pack2(float a, float b) { bf16x2 v; v[0] = (__bf16)a; v[1] = (__bf16)b; return __builtin_bit_cast(unsigned, v); }
DEVI float lo2f(unsigned u) { return __uint_as_float(u << 16); }
DEVI float hi2f(unsigned u) { return __uint_as_float(u & 0xffff0000u); }
DEVI f32x16 zero16() { f32x16 z;
#pragma unroll
  for (int i = 0; i < 16; ++i) z[i] = 0.f; return z; }
DEVI f32x16 mfma32(bf16x8 a, bf16x8 b, f32x16 c) { return __builtin_amdgcn_mfma_f32_32x32x16_bf16(a, b, c, 0, 0, 0); }
DEVI bf16x8 ldfrag(const bf16* p) { return *reinterpret_cast<const bf16x8*>(p); }
DEVI int drow(int r, int hh) { return (r & 3) + 8 * (r >> 2) + 4 * hh; }
DEVI int row_of(int b, int p) { return p < 256 ? NL + b * 256 + p : b * 2048 + (p - 256); }
DEVI int batch_of_row(int r) { return r < NL ? (r >> 11) : 8; }
template <int N> DEVI float dpp_xor(float x) {
  const int v = (int)__float_as_uint(x);
  int r;
  if (N == 1) r = __builtin_amdgcn_mov_dpp(v, 0xB1, 0xf, 0xf, true);
  else if (N == 2) r = __builtin_amdgcn_mov_dpp(v, 0x4E, 0xf, 0xf, true);
  else if (N == 4) r = __builtin_amdgcn_mov_dpp(__builtin_amdgcn_mov_dpp(v, 0x141, 0xf, 0xf, true), 0x1B, 0xf, 0xf, true);
  else r = __builtin_amdgcn_mov_dpp(v, 0x128, 0xf, 0xf, true);
  return __uint_as_float((unsigned)r);
}
DEVI float wave_sum(float v) {
  v += dpp_xor<1>(v); v += dpp_xor<2>(v); v += dpp_xor<4>(v); v += dpp_xor<8>(v);
  v += __shfl_xor(v, 16); v += __shfl_xor(v, 32);
  return v;
}
DEVI float sigmoidf_(float z) { return 1.f / (1.f + __expf(-z)); }


#define XB_TMO      128
#define XB_XCNT(j)  (256  + 64 * (j))
#define XB_XSUB(j)  (1280 + 64 * (j))
#define XB_XGEN(j)  (2304 + 64 * (j))
#define XB_TOP      3328
#define XB_TOPGEN   3392
#define XCD_BAR_WORDS 3456
#define XB_SPIN_CAP (1u << 22)
#define LAS __attribute__((address_space(3)))
DEVI unsigned xb_ld(unsigned* p)              { return __hip_atomic_load(p, __ATOMIC_RELAXED, __HIP_MEMORY_SCOPE_AGENT); }
DEVI unsigned xb_add(unsigned* p, unsigned v) { return __hip_atomic_fetch_add(p, v, __ATOMIC_RELAXED, __HIP_MEMORY_SCOPE_AGENT); }
DEVI unsigned xb_xcc_id() { return (unsigned)__builtin_amdgcn_s_getreg((3 << 11) | 20) & 0xFu; }
#define XB_SPIN(cond, bar) do { unsigned _sp = 0; while (cond) { __builtin_amdgcn_s_sleep(1); \
    if ((++_sp & 255u) == 0u) { if (xb_ld(&(bar)[XB_TMO])) break; if (_sp > XB_SPIN_CAP) { atomicAdd(&(bar)[XB_TMO], 1u); break; } } } } while (0)
struct XcdBarrier { unsigned* bar; unsigned x; volatile LAS unsigned* st; };
DEVI XcdBarrier xcd_barrier_post(unsigned* bar, volatile LAS unsigned* st) {
  XcdBarrier b; b.bar = bar; b.x = xb_xcc_id(); b.st = st;
  if (threadIdx.x == 0) (void)xb_add(&bar[XB_XCNT(b.x)], 1u);
  return b;
}
DEVI void xcd_barrier_complete(unsigned* bar, unsigned x, unsigned& nloc, unsigned& nx) {
  const unsigned G = gridDim.x * gridDim.y * gridDim.z;
  unsigned sum, cnt, mine, sp = 0u;
  for (;;) {
    sum = 0u; cnt = 0u; mine = 0u;
#pragma unroll
    for (unsigned j = 0; j < 16; ++j) { const unsigned c = xb_ld(&bar[XB_XCNT(j)]); sum += c; cnt += (c > 0u) ? 1u : 0u; mine = (j == x) ? c : mine; }
    if (sum == G) break;
    __builtin_amdgcn_s_sleep(1);
    if ((++sp & 255u) == 0u) { if (xb_ld(&bar[XB_TMO])) break; if (sp > XB_SPIN_CAP) { atomicAdd(&bar[XB_TMO], 1u); break; } }
  }
  nloc = mine > 0u ? mine : 1u; nx = cnt > 0u ? cnt : 1u;
}
DEVI void xcd_barrier(const XcdBarrier& b) {
  asm volatile("s_waitcnt vmcnt(0)" ::: "memory");
  __syncthreads();
  if (threadIdx.x == 0) {
    unsigned* bar = b.bar;
    __builtin_amdgcn_s_waitcnt(0);
    unsigned nloc = b.st[0], nx = b.st[1];
    if (nloc == 0u) { xcd_barrier_complete(bar, b.x, nloc, nx); b.st[0] = nloc; b.st[1] = nx; }
    const unsigned old = xb_add(&bar[XB_XSUB(b.x)], 1u);
    const unsigned gen = old / nloc;
    if (old + 1u == (gen + 1u) * nloc) {
      __builtin_amdgcn_fence(__ATOMIC_RELEASE, "agent");
      asm volatile("s_waitcnt vmcnt(0)" ::: "memory");
      const unsigned og = xb_add(&bar[XB_TOP], 1u);
      const unsigned tg = og / nx;
      if (og + 1u == (tg + 1u) * nx) xb_add(&bar[XB_TOPGEN], 1u);
      else XB_SPIN(xb_ld(&bar[XB_TOPGEN]) == tg, bar);
      __builtin_amdgcn_fence(__ATOMIC_ACQUIRE, "agent");
      xb_add(&bar[XB_XGEN(b.x)], 1u);
      asm volatile("s_waitcnt vmcnt(0)" ::: "memory");
    } else {
      XB_SPIN(xb_ld(&bar[XB_XGEN(b.x)]) == gen, bar);
      __builtin_amdgcn_fence(__ATOMIC_ACQUIRE, "agent");
      asm volatile("s_waitcnt vmcnt(0)" ::: "memory");
    }
  }
  __syncthreads();
}

#define VHALF ((int)__builtin_amdgcn_readfirstlane((int)(threadIdx.x >> 8)))
#define TIDX ((int)(threadIdx.x & 255))
#define VBID ((int)(VHALF * gridDim.x + blockIdx.x))
#define NVB ((int)(gridDim.x * 2))
constexpr int HALF_LDS = 80896;

DEVI void hb_sync() {
  extern __shared__ __attribute__((aligned(16))) unsigned char hb_smem[];
  LAS unsigned* cnt = (LAS unsigned*)(hb_smem + SMEM_BYTES) + 2 + VHALF;
  asm volatile("s_waitcnt lgkmcnt(0)" ::: "memory");
  if ((threadIdx.x & 63) == 0) {
    const unsigned old = __hip_atomic_fetch_add(cnt, 1u, __ATOMIC_RELAXED, __HIP_MEMORY_SCOPE_WORKGROUP);
    const unsigned target = (old / 4u + 1u) * 4u;
    while (__hip_atomic_load(cnt, __ATOMIC_RELAXED, __HIP_MEMORY_SCOPE_WORKGROUP) < target) __builtin_amdgcn_s_sleep(0);
  }
  asm volatile("" ::: "memory");
}

DEVI void phase_mod(const Params& P, unsigned char* smem) {
  const int tid = TIDX;
  float* s = (float*)smem;
  float* red = s + 9 * 1024;
  for (int item = VBID - (NVB - 192); item >= 0 && item < 192; item += NVB) {
    const int l = item / 96, j = item % 96;
    hb_sync();
    for (int i = tid; i < 9 * 1024; i += 256) {
      int bi = i >> 10, k = i & 1023;
      float v = bi < 8 ? P.c[bi * 1024 + k] : P.c_ctx[k];
      s[i] = v * sigmoidf_(v);
    }
    hb_sync();
    const int c4 = tid & 15, kg = tid >> 4;
    float acc[9][4];
#pragma unroll
    for (int bi = 0; bi < 9; ++bi) { acc[bi][0] = acc[bi][1] = acc[bi][2] = acc[bi][3] = 0.f; }
    const float* w = P.w_mod + (size_t)l * 1024 * 6144 + j * 64 + c4 * 4;
#pragma unroll 4
    for (int kk = 0; kk < 64; ++kk) {
      const int k = kg * 64 + kk;
      const float4 w4 = *reinterpret_cast<const float4*>(w + (size_t)k * 6144);
#pragma unroll
      for (int bi = 0; bi < 9; ++bi) {
        const float sv = s[bi * 1024 + k];
        acc[bi][0] += sv * w4.x; acc[bi][1] += sv * w4.y; acc[bi][2] += sv * w4.z; acc[bi][3] += sv * w4.w;
      }
    }
#pragma unroll
    for (int bi = 0; bi < 9; ++bi)
#pragma unroll
      for (int e = 0; e < 4; ++e) red[(kg * 9 + bi) * 64 + c4 * 4 + e] = acc[bi][e];
    hb_sync();
    for (int o = tid; o < 576; o += 256) {
      const int bi = o >> 6, cc = o & 63;
      float sum = 0.f;
#pragma unroll
      for (int g = 0; g < 16; ++g) sum += red[(g * 9 + bi) * 64 + cc];
      P.MOD[(size_t)(l * 9 + bi) * 6144 + j * 64 + cc] = sum + P.b_mod[l * 6144 + j * 64 + cc];
    }
  }
}

DEVI void conv_T_tile(const float* __restrict__ src, int N, bf16* __restrict__ dst, int Kd, int k0, int n0,
                      const float* __restrict__ kscale, float* tile) {
  const int tid = TIDX;
  hb_sync();
  for (int e = tid; e < 4096; e += 256) {
    const int i = e >> 6, j = e & 63, n = n0 + j;
    float v = (n < N) ? src[(size_t)(k0 + i) * N + n] : 0.f;
    if (kscale) v *= kscale[k0 + i];
    tile[i * 65 + j] = v;
  }
  hb_sync();
  for (int e = tid; e < 2048; e += 256) {
    const int j = e >> 5, i2 = (e & 31) * 2;
    const unsigned pk = pack2(tile[i2 * 65 + j], tile[(i2 + 1) * 65 + j]);
    *reinterpret_cast<unsigned*>(&dst[(size_t)(n0 + j) * Kd + k0 + i2]) = pk;
  }
}

DEVI void conv_straight(const float* __restrict__ src, bf16* __restrict__ dst, size_t n8) {
  const size_t stride = (size_t)NVB * 256;
  for (size_t i = (size_t)VBID * 256 + TIDX; i < n8; i += stride) {
    const float4 a = reinterpret_cast<const float4*>(src)[2 * i];
    const float4 b = reinterpret_cast<const float4*>(src)[2 * i + 1];
    uint4 o; o.x = pack2(a.x, a.y); o.y = pack2(a.z, a.w); o.z = pack2(b.x, b.y); o.w = pack2(b.z, b.w);
    reinterpret_cast<uint4*>(dst)[i] = o;
  }
}

DEVI void convert_rows_fp6(const Params& P, int L, int i0, int i1) {
  const int lane = threadIdx.x & 63, half = lane >> 5, l32 = lane & 31;
  const int wv = threadIdx.x >> 6;
  for (int ib = i0 + wv * 2; ib < i1; ib += 16) {
    int i = ib + half; const bool live = i < i1; if (!live) i = i1 - 1;
    const int table = i >> 14, lr = L * 16384 + (i & 16383);
    const float* src = (table ? P.p_v : P.p_u) + (size_t)lr * 1024 + l32 * 32;
    float4 a[8];
    float m = 0.f;
#pragma unroll
    for (int q = 0; q < 8; ++q) {
      a[q] = *reinterpret_cast<const float4*>(src + q * 4);
      m = fmaxf(m, fmaxf(fmaxf(fabsf(a[q].x), fabsf(a[q].y)), fmaxf(fabsf(a[q].z), fabsf(a[q].w))));
    }
    const unsigned sb = (__float_as_uint(fmaxf(m, 1e-30f) * (1.f / 6.f)) + 0xffffu) >> 16;
    const float inv = 1.f / __uint_as_float(sb << 16);
    unsigned pk[4];
#pragma unroll
    for (int w = 0; w < 4; ++w) {
      unsigned word = 0u;
#pragma unroll
      for (int e = 0; e < 8; ++e) {
        const int idx = w * 8 + e;
        const float4 q4 = a[idx >> 2];
        const float xv = ((idx & 3) == 0 ? q4.x : (idx & 3) == 1 ? q4.y : (idx & 3) == 2 ? q4.z : q4.w) * inv;
        const float av = fabsf(xv);
        unsigned ci = (av > 0.25f) + (av > 0.75f) + (av > 1.25f) + (av > 1.75f) + (av > 2.5f) + (av > 3.5f) + (av > 5.f);
        ci |= (xv < 0.f) ? 8u : 0u;
        word |= ci << (4 * e);
      }
      pk[w] = word;
    }
    unsigned char* rowp = (table ? P.PV8 : P.PU8) + (size_t)lr * 576;
    if (live) {
      *reinterpret_cast<uint4*>(rowp + l32 * 16) = make_uint4(pk[0], pk[1], pk[2], pk[3]);
      *reinterpret_cast<unsigned short*>(rowp + 512 + l32 * 2) = (unsigned short)sb;
    }
  }
}

DEVI void phase_prologue(const Params& P, unsigned char* smem) {
  phase_mod(P, smem);
  float* tile = (float*)smem;
  for (int kq = VBID; kq < 2 * 912 && VBID < NVB - 192; kq += NVB - 192) {
    const int l = kq / 912; int r = kq % 912; if (r >= 832) r += 512;
    if (r < 576) { conv_T_tile(P.w_in + (size_t)l * 1024 * DIN, DIN, P.WinT + (size_t)l * DINP * 1024, 1024, (r % 16) * 64, (r / 16) * 64, nullptr, tile); continue; }
    r -= 576;
    if (r < 256) { conv_T_tile(P.w_out + (size_t)l * 1024 * 1024, 1024, P.WoutT + (size_t)l * 1024 * 1024, 1024, (r % 16) * 64, (r / 16) * 64, nullptr, tile); continue; }
    r -= 256;
    if (r < 512) continue;
    r -= 512;
    if (r < 48) { conv_T_tile(P.b_w_uq + (size_t)l * 256 * 768, 768, P.WCOMB + (size_t)l * 1792 * 256, 256, (r % 4) * 64, (r / 4) * 64, P.b_q_norm_w + l * 256, tile); continue; }
    r -= 48;
    conv_T_tile(P.b_w_ukv + (size_t)l * 128 * 1024, 1024, P.WCOMB + (size_t)l * 1792 * 256 + 768 * 256, 256, (r % 2) * 64, (r / 2) * 64, P.b_kv_norm_w + l * 128, tile);
  }
  {
    const int tid = TIDX, lane = tid & 63, wave = tid >> 6, l31 = lane & 31, hh = lane >> 5;
    bf16* KA = reinterpret_cast<bf16*>(smem);
    bf16* WB = KA + 128 * 136;
    for (int it = VBID; it < 2 * 16 * 16; it += NVB) {
      const int kt = it & 15, hp = (it >> 4) & 15, l = it >> 8;
      hb_sync();
      {
        const float* keys = P.p_sub_keys + (size_t)(l * 16 + hp) * 128 * 128;
        for (int e = tid; e < 128 * 32; e += 256) {
          const int r = e >> 5, c4 = e & 31;
          const float4 v = *reinterpret_cast<const float4*>(keys + (size_t)r * 128 + c4 * 4);
          *reinterpret_cast<uint2*>(KA + r * 136 + c4 * 4) = make_uint2(pack2(v.x, v.y), pack2(v.z, v.w));
        }
        const float* wq = P.p_w_q + (size_t)l * 1024 * 2048 + (size_t)(kt * 64) * 2048 + hp * 128;
        for (int e = tid; e < 64 * 32; e += 256) {
          const int r = e >> 5, c4 = e & 31;
          const float4 v = *reinterpret_cast<const float4*>(wq + (size_t)r * 2048 + c4 * 4);
          *reinterpret_cast<uint2*>(WB + r * 136 + c4 * 4) = make_uint2(pack2(v.x, v.y), pack2(v.z, v.w));
        }
      }
      hb_sync();
      f32x16 acc[2]; acc[0] = zero16(); acc[1] = zero16();
#pragma unroll
      for (int ks = 0; ks < 8; ++ks) {
        const bf16x8 af = ldfrag(KA + (wave * 32 + l31) * 136 + ks * 16 + hh * 8);
#pragma unroll
        for (int j = 0; j < 2; ++j) {
          const bf16x8 bfr = ldfrag(WB + (j * 32 + l31) * 136 + ks * 16 + hh * 8);
          acc[j] = mfma32(af, bfr, acc[j]);
        }
      }
      bf16* dst = P.WpqT + (size_t)l * 2048 * 1024 + (size_t)(hp * 128 + wave * 32) * 1024 + kt * 64;
#pragma unroll
      for (int j = 0; j < 2; ++j)
#pragma unroll
        for (int r = 0; r < 16; ++r) dst[(size_t)drow(r, hh) * 1024 + j * 32 + l31] = f2bf(acc[j][r]);
    }
  }
  for (int i = VBID * 256 + TIDX; i < 2 * 1024 * 16; i += NVB * 256) {
    const int l2 = i >> 14, rr = (i >> 4) & 1023, cc = i & 15;
    *reinterpret_cast<uint4*>(P.WCOMB + (size_t)l2 * 1792 * 256 + (size_t)(768 + rr) * 256 + 128 + cc * 8) = make_uint4(0u, 0u, 0u, 0u);
  }
  conv_straight(P.a_w_s, P.AWS, (size_t)2 * 4 * 128 * 128 / 8);
  for (int i = VBID * 256 + TIDX; i < 512; i += NVB * 256) P.LBT[i] = sigmoidf_(P.c_lb[512 + i] - P.c_lb[i]);
  for (int i = VBID * 256 + TIDX; i < 2048 * 16; i += NVB * 256) {
    const int t = i >> 4, a = (i >> 3) & 1, f = i & 7;
    const float inv = powf(10000.f, -(float)f / 8.f);
    const float pos = a ? (float)(t & 63) : (float)(t >> 6);
    const float ang = pos * inv;
    P.ROPE[t * 32 + a * 8 + f] = cosf(ang);
    P.ROPE[t * 32 + 16 + a * 8 + f] = sinf(ang);
  }
}

DEVI void phase_norm(const Params& P, int l, int which, int nrows, int rbeg = 0) {
  const int lane = TIDX & 63;
  const int gw = VBID * 4 + (TIDX >> 6), nw = NVB * 4;
  const float* lnw = (which == 0 ? P.ln1_w : P.ln2_w) + l * 1024;
  for (int r = rbeg + gw; r < nrows; r += nw) {
    const float* mod = P.MOD + (size_t)(l * 9 + batch_of_row(r)) * 6144 + which * 3072;
    float4 v[4];
    float ss = 0.f;
    if (which == 0 && l == 0) {
      const float* src = r < NL ? P.x + (size_t)r * 1024 : P.ctx + (size_t)(r - NL) * 1024;
#pragma unroll
      for (int i = 0; i < 4; ++i) v[i] = *reinterpret_cast<const float4*>(src + i * 256 + lane * 4);
    } else if (which == 1 && l == 0 && r >= NL) {
      const float* cin = P.ctx + (size_t)(r - NL) * 1024;
      const float* p0 = P.PART + (size_t)(r - NL) * 1024;
      const float* p1 = p0 + (size_t)2048 * 1024;
      const float* gate = P.MOD + (size_t)8 * 6144 + 2048;
#pragma unroll
      for (int i = 0; i < 4; ++i) {
        const int d = i * 256 + lane * 4;
        const float4 c4 = *reinterpret_cast<const float4*>(cin + d), a4 = *reinterpret_cast<const float4*>(p0 + d), b4 = *reinterpret_cast<const float4*>(p1 + d);
        const float4 g4 = *reinterpret_cast<const float4*>(gate + d);
        v[i] = make_float4(c4.x + g4.x * (a4.x + b4.x), c4.y + g4.y * (a4.y + b4.y), c4.z + g4.z * (a4.z + b4.z), c4.w + g4.w * (a4.w + b4.w));
        *reinterpret_cast<uint2*>(P.X + (size_t)r * 1024 + d) = make_uint2(pack2(v[i].x, v[i].y), pack2(v[i].z, v[i].w));
      }
    } else {
      const bf16* src = P.X + (size_t)r * 1024;
#pragma unroll
      for (int i = 0; i < 4; ++i) {
        const uint2 u = *reinterpret_cast<const uint2*>(src + i * 256 + lane * 4);
        v[i] = make_float4(lo2f(u.x), hi2f(u.x), lo2f(u.y), hi2f(u.y));
      }
    }
#pragma unroll
    for (int i = 0; i < 4; ++i) ss += v[i].x * v[i].x + v[i].y * v[i].y + v[i].z * v[i].z + v[i].w * v[i].w;
    ss = wave_sum(ss);
    const float rr = rsqrtf(ss * (1.f / 1024.f) + EPS);
#pragma unroll
    for (int i = 0; i < 4; ++i) {
      const int d = i * 256 + lane * 4;
      const float4 w = *reinterpret_cast<const float4*>(lnw + d);
      const float4 sh = *reinterpret_cast<const float4*>(mod + d);
      const float4 sc = *reinterpret_cast<const float4*>(mod + 1024 + d);
      const float o0 = v[i].x * rr * w.x * (1.f + sc.x) + sh.x;
      const float o1 = v[i].y * rr * w.y * (1.f + sc.y) + sh.y;
      const float o2 = v[i].z * rr * w.z * (1.f + sc.z) + sh.z;
      const float o3 = v[i].w * rr * w.w * (1.f + sc.w) + sh.w;
      uint2 o; o.x = pack2(o0, o1); o.y = pack2(o2, o3);
      *reinterpret_cast<uint2*>(P.H + (size_t)r * 1024 + d) = o;
    }
  }
}

DEVI void phase_mixA(const Params& P, int l, unsigned char* smem) {
  const int tid = TIDX, lane = tid & 63, wave = tid >> 6, l31 = lane & 31, hh = lane >> 5;
  bf16* VNT = reinterpret_cast<bf16*>(smem);
  constexpr int LDV = 136;
  const int nseg = (l == 1) ? 16 : 18;
  const int seg0 = (l == 1) ? 2 : 0;
  for (int it = VBID; it < 8 * nseg * 4; it += NVB) {
    const int a = it & 3; const int sj = (it >> 2) % nseg + seg0; const int b = (it >> 2) / nseg;
    const int p0 = sj * 128;
    const bf16* Aw = P.AWS + (size_t)(l * 4 + a) * 128 * 128 + (size_t)(wave * 32 + l31) * 128;
    bf16x8 afr[8];
#pragma unroll
    for (int ks = 0; ks < 8; ++ks) afr[ks] = ldfrag(Aw + ks * 16 + hh * 8);
    const int p = wave * 32 + l31;
    const int rowp = row_of(b, p0 + p);
    const float bsv = P.a_b_s[(l * 4 + a) * 128 + p];
    uint2 uu8[8];
#pragma unroll
    for (int j = 0; j < 2; ++j)
#pragma unroll
      for (int rg = 0; rg < 4; ++rg) uu8[j * 4 + rg] = *reinterpret_cast<const uint2*>(P.Z + (size_t)rowp * DIN + ZC_AU + a * 64 + j * 32 + 8 * rg + 4 * hh);
    hb_sync();
    {
      const int q = tid >> 1, half = tid & 1;
      const int row = row_of(b, p0 + q);
      const bf16* src = P.Z + (size_t)row * DIN + ZC_AV + a * 64 + half * 32;
      float v[32];
      float ss = 0.f;
#pragma unroll
      for (int i = 0; i < 4; ++i) {
        const uint4 u = *reinterpret_cast<const uint4*>(src + i * 8);
        v[i * 8 + 0] = lo2f(u.x); v[i * 8 + 1] = hi2f(u.x); v[i * 8 + 2] = lo2f(u.y); v[i * 8 + 3] = hi2f(u.y);
        v[i * 8 + 4] = lo2f(u.z); v[i * 8 + 5] = hi2f(u.z); v[i * 8 + 6] = lo2f(u.w); v[i * 8 + 7] = hi2f(u.w);
      }
#pragma unroll
      for (int i = 0; i < 32; ++i) ss += v[i] * v[i];
      ss += dpp_xor<1>(ss);
      const float rr = rsqrtf(ss * (1.f / 64.f) + EPS);
      const float* nw = P.a_norm_w + l * 256 + a * 64 + half * 32;
#pragma unroll
      for (int i = 0; i < 32; ++i) VNT[(half * 32 + i) * LDV + q] = f2bf(v[i] * rr * nw[i]);
    }
    hb_sync();
    f32x16 acc[2]; acc[0] = zero16(); acc[1] = zero16();
#pragma unroll
    for (int ks = 0; ks < 8; ++ks) {
      const bf16x8 af = afr[ks];
#pragma unroll
      for (int j = 0; j < 2; ++j) {
        const bf16x8 bfr = ldfrag(VNT + (j * 32 + l31) * LDV + ks * 16 + hh * 8);
        acc[j] = mfma32(bfr, af, acc[j]);
      }
    }
    const int row = rowp;
#pragma unroll
    for (int j = 0; j < 2; ++j)
#pragma unroll
      for (int rg = 0; rg < 4; ++rg) {
        const int col = a * 64 + j * 32 + 8 * rg + 4 * hh;
        const uint2 uu = uu8[j * 4 + rg];
        const float o0 = lo2f(uu.x) * (acc[j][4 * rg + 0] + bsv), o1 = hi2f(uu.x) * (acc[j][4 * rg + 1] + bsv);
        const float o2 = lo2f(uu.y) * (acc[j][4 * rg + 2] + bsv), o3 = hi2f(uu.y) * (acc[j][4 * rg + 3] + bsv);
        *reinterpret_cast<uint2*>(P.H + (size_t)row * 1024 + col) = make_uint2(pack2(o0, o1), pack2(o2, o3));
      }
  }
}

template <int NA>
DEVI void mla_norm_rope_regs(const Params& P, float (&v)[48], const float* nw, int cA, int cB, bool rope, int r0, int a0, int ng,
                             float oscale, bf16* dstrow  , int tlat) {
  float ss = 0.f;
#pragma unroll
  for (int i = 0; i < 48; ++i) ss += v[i] * v[i];
  ss += dpp_xor<1>(ss);
  const float rr = rsqrtf(ss * (1.f / 96.f) + EPS);
#pragma unroll
  for (int i = 0; i < 48; ++i) v[i] = v[i] * rr * nw[(i < NA ? cA + i : cB + i - NA)];
  if (rope) {
    const float* cs = P.ROPE + (size_t)tlat * 32;
#pragma unroll
    for (int g = 0; g < 2; ++g)
      if (g < ng) {
        const int a = a0 + g;
#pragma unroll
        for (int f = 0; f < 8; ++f) {
          const float x1 = v[r0 + g * 16 + f], x2 = v[r0 + g * 16 + 8 + f];
          const float c = cs[a * 8 + f], sn = cs[16 + a * 8 + f];
          v[r0 + g * 16 + f] = x1 * c - x2 * sn;
          v[r0 + g * 16 + 8 + f] = x2 * c + x1 * sn;
        }
      }
  }
#pragma unroll
  for (int i = 0; i < 6; ++i) {
    uint4 o;
    o.x = pack2(v[i * 8 + 0] * oscale, v[i * 8 + 1] * oscale); o.y = pack2(v[i * 8 + 2] * oscale, v[i * 8 + 3] * oscale);
    o.z = pack2(v[i * 8 + 4] * oscale, v[i * 8 + 5] * oscale); o.w = pack2(v[i * 8 + 6] * oscale, v[i * 8 + 7] * oscale);
    const int col = (i * 8 < NA) ? cA + i * 8 : cB + i * 8 - NA;
    *reinterpret_cast<uint4*>(dstrow + col) = o;
  }
}

DEVI void phase_mla_proj(const Params& P, int l, unsigned char* smem) {
  const int tid = TIDX;
  float* T = reinterpret_cast<float*>(smem);
  bf16* TV = reinterpret_cast<bf16*>(smem + 128 * 97 * 4);
  const float qscale = 0.10206207261596577f * 1.4426950408889634f;
  const int tok = tid >> 1, half = tid & 1;
  for (int it = (VBID + NVB - 64) % NVB; it < 144 * 8; it += NVB) {
    const int h = it & 7;
    const int m0 = (it >> 3) * 128;
    const bool lat = m0 < NL;
    const int b = lat ? (m0 >> 11) : ((m0 - NL) >> 8);
    const int pos0 = lat ? 256 + (m0 & 2047) : ((m0 - NL) & 255);
    const int tlat0 = lat ? (m0 & 2047) : 0;
    const bool doq = lat || (l == 0);
    const bf16* zr = P.Z + (size_t)(m0 + tok) * DIN;
    const bf16* rr = P.RAW + (size_t)(m0 + tok) * 1792;
    hb_sync();
    const float rsq = P.RS[(size_t)(m0 + tok) * 2], rskv = P.RS[(size_t)(m0 + tok) * 2 + 1];
    {
      float kv[48];
      const bf16* kn = rr + 768 + h * 128 + half * 32;
      const bf16* vv = rr + 768 + h * 128 + 64 + half * 32;
#pragma unroll
      for (int i = 0; i < 4; ++i) {
        const uint4 u = *reinterpret_cast<const uint4*>(kn + i * 8);
        kv[i * 8 + 0] = lo2f(u.x) * rskv; kv[i * 8 + 1] = hi2f(u.x) * rskv; kv[i * 8 + 2] = lo2f(u.y) * rskv; kv[i * 8 + 3] = hi2f(u.y) * rskv;
        kv[i * 8 + 4] = lo2f(u.z) * rskv; kv[i * 8 + 5] = hi2f(u.z) * rskv; kv[i * 8 + 6] = lo2f(u.w) * rskv; kv[i * 8 + 7] = hi2f(u.w) * rskv;
        const uint4 w = *reinterpret_cast<const uint4*>(vv + i * 8);
        bf16* vp = TV + (half * 32 + i * 8) * 136 + tok;
        vp[0 * 136] = f2bf(lo2f(w.x) * rskv); vp[1 * 136] = f2bf(hi2f(w.x) * rskv); vp[2 * 136] = f2bf(lo2f(w.y) * rskv); vp[3 * 136] = f2bf(hi2f(w.y) * rskv);
        vp[4 * 136] = f2bf(lo2f(w.z) * rskv); vp[5 * 136] = f2bf(hi2f(w.z) * rskv); vp[6 * 136] = f2bf(lo2f(w.w) * rskv); vp[7 * 136] = f2bf(hi2f(w.w) * rskv);
      }
#pragma unroll
      for (int i = 0; i < 2; ++i) {
        const uint4 u = *reinterpret_cast<const uint4*>(zr + ZC_BKR + half * 16 + i * 8);
        kv[32 + i * 8 + 0] = lo2f(u.x); kv[32 + i * 8 + 1] = hi2f(u.x); kv[32 + i * 8 + 2] = lo2f(u.y); kv[32 + i * 8 + 3] = hi2f(u.y);
        kv[32 + i * 8 + 4] = lo2f(u.z); kv[32 + i * 8 + 5] = hi2f(u.z); kv[32 + i * 8 + 6] = lo2f(u.w); kv[32 + i * 8 + 7] = hi2f(u.w);
      }
      mla_norm_rope_regs<32>(P, kv, P.b_kh_w + l * 96, half * 32, 64 + half * 16, lat, 32, half, 1, 1.f,
                             P.K + ((size_t)(b * 8 + h) * SEQP + pos0 + tok) * 96, tlat0 + tok);
    }
    hb_sync();
    {
      const int d = tid >> 2, qtr = tid & 3;
      bf16* dst = P.VT + ((size_t)(b * 8 + h) * 64 + d) * SEQP + pos0 + qtr * 32;
      const bf16* src = TV + d * 136 + qtr * 32;
#pragma unroll
      for (int i = 0; i < 4; ++i) {
        const uint4 v = *reinterpret_cast<const uint4*>(src + i * 8);
        const int g16 = (i >> 1) * 16, odd = i & 1;
        *reinterpret_cast<uint2*>(dst + g16 + (odd ? 4 : 0)) = make_uint2(v.x, v.y);
        *reinterpret_cast<uint2*>(dst + g16 + (odd ? 12 : 8)) = make_uint2(v.z, v.w);
      }
    }
    if (doq) {
      float qv[48];
      const bf16* qq = rr + h * 96 + half * 48;
#pragma unroll
      for (int i = 0; i < 6; ++i) {
        const uint4 u = *reinterpret_cast<const uint4*>(qq + i * 8);
        qv[i * 8 + 0] = lo2f(u.x) * rsq; qv[i * 8 + 1] = hi2f(u.x) * rsq; qv[i * 8 + 2] = lo2f(u.y) * rsq; qv[i * 8 + 3] = hi2f(u.y) * rsq;
        qv[i * 8 + 4] = lo2f(u.z) * rsq; qv[i * 8 + 5] = hi2f(u.z) * rsq; qv[i * 8 + 6] = lo2f(u.w) * rsq; qv[i * 8 + 7] = hi2f(u.w) * rsq;
      }
      mla_norm_rope_regs<48>(P, qv, P.b_qh_w + l * 96, half * 48, 0, lat && half == 1, 16, 0, 2, qscale,
                             P.Q + ((size_t)(b * 8 + h) * SEQP + pos0 + tok) * 96, tlat0 + tok);
    }
  }
}

DEVI void hgrn_load(const Params& P, int l, int b, int hd, int c, float* BF, float* RB, float* SEG,
                    float (&q)[16], float (&kf)[16], float (&kb)[16], float (&v)[16], bool need_kv) {
  const int tid = TIDX, t = tid >> 2, k0 = (tid & 3) * 16;
  const int row = row_of(b, c * 64 + t);
  const bf16* z = P.Z + (size_t)row * DIN + hd * 64 + k0;
  float zf[16], zb[16];
  float lbt[32];
  if (l == 1) {
#pragma unroll
    for (int i = 0; i < 4; ++i) {
      const float4 a = *reinterpret_cast<const float4*>(P.LBT + hd * 64 + k0 + i * 4), bq = *reinterpret_cast<const float4*>(P.LBT + 256 + hd * 64 + k0 + i * 4);
      lbt[i * 4 + 0] = a.x; lbt[i * 4 + 1] = a.y; lbt[i * 4 + 2] = a.z; lbt[i * 4 + 3] = a.w;
      lbt[16 + i * 4 + 0] = bq.x; lbt[16 + i * 4 + 1] = bq.y; lbt[16 + i * 4 + 2] = bq.z; lbt[16 + i * 4 + 3] = bq.w;
    }
  }
#pragma unroll
  for (int i = 0; i < 2; ++i) {
    const uint4 uq = *reinterpret_cast<const uint4*>(z + ZC_CQ + i * 8);
    const uint4 uf = *reinterpret_cast<const uint4*>(z + ZC_CFF + i * 8);
    const uint4 ub = *reinterpret_cast<const uint4*>(z + ZC_CFB + i * 8);
    q[i * 8 + 0] = lo2f(uq.x); q[i * 8 + 1] = hi2f(uq.x); q[i * 8 + 2] = lo2f(uq.y); q[i * 8 + 3] = hi2f(uq.y);
    q[i * 8 + 4] = lo2f(uq.z); q[i * 8 + 5] = hi2f(uq.z); q[i * 8 + 6] = lo2f(uq.w); q[i * 8 + 7] = hi2f(uq.w);
    zf[i * 8 + 0] = lo2f(uf.x); zf[i * 8 + 1] = hi2f(uf.x); zf[i * 8 + 2] = lo2f(uf.y); zf[i * 8 + 3] = hi2f(uf.y);
    zf[i * 8 + 4] = lo2f(uf.z); zf[i * 8 + 5] = hi2f(uf.z); zf[i * 8 + 6] = lo2f(uf.w); zf[i * 8 + 7] = hi2f(uf.w);
    zb[i * 8 + 0] = lo2f(ub.x); zb[i * 8 + 1] = hi2f(ub.x); zb[i * 8 + 2] = lo2f(ub.y); zb[i * 8 + 3] = hi2f(ub.y);
    zb[i * 8 + 4] = lo2f(ub.z); zb[i * 8 + 5] = hi2f(ub.z); zb[i * 8 + 6] = lo2f(ub.w); zb[i * 8 + 7] = hi2f(ub.w);
    if (need_kv) {
      const uint4 uv = *reinterpret_cast<const uint4*>(z + ZC_CI + i * 8);
      v[i * 8 + 0] = lo2f(uv.x); v[i * 8 + 1] = hi2f(uv.x); v[i * 8 + 2] = lo2f(uv.y); v[i * 8 + 3] = hi2f(uv.y);
      v[i * 8 + 4] = lo2f(uv.z); v[i * 8 + 5] = hi2f(uv.z); v[i * 8 + 6] = lo2f(uv.w); v[i * 8 + 7] = hi2f(uv.w);
    }
  }
#pragma unroll
  for (int i = 0; i < 16; ++i) {
    q[i] *= 0.125f;
    float lbf = 0.f;
    if (l == 1) lbf = lbt[i];
    const float zz = zf[i];
    const float e = __expf(-fabsf(zz));
    const float sp = __builtin_amdgcn_rcpf(1.f + e);
    const float sig = zz >= 0.f ? sp : e * sp;
    const float nsig = zz >= 0.f ? e * sp : sp;
    const float lf = (l == 0) ? (fminf(zz, 0.f) - __logf(1.f + e)) : __logf(lbf + (1.f - lbf) * sig);
    kf[i] = (1.f - lbf) * nsig;
    BF[t * 65 + k0 + i] = lf;
  }
  __builtin_amdgcn_sched_barrier(0);
#pragma unroll
  for (int i = 0; i < 16; ++i) {
    float lbb = 0.f;
    if (l == 1) lbb = lbt[16 + i];
    const float zz = zb[i];
    const float e = __expf(-fabsf(zz));
    const float sp = __builtin_amdgcn_rcpf(1.f + e);
    const float sig = zz >= 0.f ? sp : e * sp;
    const float nsig = zz >= 0.f ? e * sp : sp;
    const float lf = (l == 0) ? (fminf(zz, 0.f) - __logf(1.f + e)) : __logf(lbb + (1.f - lbb) * sig);
    kb[i] = (1.f - lbb) * nsig;
    RB[t * 65 + k0 + i] = lf;
  }
  hb_sync();
  {
    const int k = tid & 63, seg = tid >> 6;
    float sf = 0.f, sr = 0.f;
#pragma unroll
    for (int j = 0; j < 16; ++j) { sf += BF[(seg * 16 + j) * 65 + k]; BF[(seg * 16 + j) * 65 + k] = sf; }
#pragma unroll
    for (int j = 15; j >= 0; --j) { sr += RB[(seg * 16 + j) * 65 + k]; RB[(seg * 16 + j) * 65 + k] = sr; }
    SEG[seg * 64 + k] = sf; SEG[256 + seg * 64 + k] = sr;
    hb_sync();
    float offf = 0.f, offb = 0.f;
#pragma unroll
    for (int s2 = 0; s2 < 4; ++s2) {
      offf += (s2 < seg) ? SEG[s2 * 64 + k] : 0.f;
      offb += (s2 > seg) ? SEG[256 + s2 * 64 + k] : 0.f;
    }
#pragma unroll
    for (int j = 0; j < 16; ++j) { BF[(seg * 16 + j) * 65 + k] += offf; RB[(seg * 16 + j) * 65 + k] += offb; }
  }
  hb_sync();
}

DEVI f32x16 lds_mm(const bf16* A, const bf16* BT, int tm, int tn, int l31, int hh) {
  f32x16 acc = zero16();
#pragma unroll
  for (int ks = 0; ks < 4; ++ks) {
    const bf16x8 a = ldfrag(A + (tm * 32 + l31) * 72 + ks * 16 + hh * 8);
    const bf16x8 b = ldfrag(BT + (tn * 32 + l31) * 72 + ks * 16 + hh * 8);
    acc = mfma32(a, b, acc);
  }
  return acc;
}

DEVI void phase_hgrn_local(const Params& P, int l, unsigned char* smem) {
  const int tid = TIDX, lane = tid & 63, wave = tid >> 6, l31 = lane & 31, hh = lane >> 5;
  const int tm = wave >> 1, tn = wave & 1;
  float* BF = reinterpret_cast<float*>(smem);
  float* RB = BF + 64 * 65;
  bf16* QF = reinterpret_cast<bf16*>(smem + 33280);
  bf16* KF = QF + 64 * 72;
  bf16* QB = KF + 64 * 72;
  bf16* KB = QB + 64 * 72;
  bf16* VTt = KB + 64 * 72;
  bf16* KHF = reinterpret_cast<bf16*>(smem);
  bf16* KHB = KHF + 64 * 72;
  bf16* ATT = KHB + 64 * 72;
  for (int it = (VBID + NVB - 192) % NVB; it < 8 * 4 * 36; it += NVB) {
    const int c = it % 36, hd = (it / 36) & 3, b = it / 144;
    float q[16], kf[16], kb[16], v[16];
    hb_sync();
    hgrn_load(P, l, b, hd, c, BF, RB, reinterpret_cast<float*>(smem + 33280), q, kf, kb, v, true);
    const int t = tid >> 2, k0 = (tid & 3) * 16;
#pragma unroll
    for (int i = 0; i < 16; ++i) VTt[(k0 + i) * 72 + t] = f2bf(v[i]);
    float bfv[16], rbv[16];
#pragma unroll
    for (int i = 0; i < 16; ++i) { bfv[i] = BF[t * 65 + k0 + i]; rbv[i] = RB[t * 65 + k0 + i]; }
    {
      const size_t go = (size_t)row_of(b, c * 64 + t) * 256 + hd * 64 + k0;
#pragma unroll
      for (int hq = 0; hq < 2; ++hq) {
        unsigned pf[4], pb[4];
#pragma unroll
        for (int i = 0; i < 8; i += 2) {
          pf[i >> 1] = pack2(q[hq * 8 + i] * __expf(bfv[hq * 8 + i]), q[hq * 8 + i + 1] * __expf(bfv[hq * 8 + i + 1]));
          pb[i >> 1] = pack2(q[hq * 8 + i] * __expf(rbv[hq * 8 + i]), q[hq * 8 + i + 1] * __expf(rbv[hq * 8 + i + 1]));
        }
        *reinterpret_cast<uint4*>(P.GQF + go + hq * 8) = make_uint4(pf[0], pf[1], pf[2], pf[3]);
        *reinterpret_cast<uint4*>(P.GQB + go + hq * 8) = make_uint4(pb[0], pb[1], pb[2], pb[3]);
      }
    }
    if (t == 0) {
      float* dec = P.DEC + ((size_t)((b * 4 + hd) * 2) * 36 + c) * 64 + k0;
#pragma unroll
      for (int i = 0; i < 16; ++i) { dec[i] = __expf(BF[63 * 65 + k0 + i]); dec[36 * 64 + i] = __expf(RB[k0 + i]); }
    }
#pragma unroll
    for (int i = 0; i < 16; i += 2) {
      const int k = k0 + i;
      const float mF0 = BF[32 * 65 + k], mF1 = BF[32 * 65 + k + 1], mB0 = RB[32 * 65 + k], mB1 = RB[32 * 65 + k + 1];
      *reinterpret_cast<unsigned*>(&QF[t * 72 + k]) = pack2(q[i] * __expf(fminf(bfv[i] - mF0, 80.f)), q[i + 1] * __expf(fminf(bfv[i + 1] - mF1, 80.f)));
      *reinterpret_cast<unsigned*>(&KF[t * 72 + k]) = pack2(kf[i] * __expf(fminf(mF0 - bfv[i], 80.f)), kf[i + 1] * __expf(fminf(mF1 - bfv[i + 1], 80.f)));
      *reinterpret_cast<unsigned*>(&QB[t * 72 + k]) = pack2(q[i] * __expf(fminf(rbv[i] - mB0, 80.f)), q[i + 1] * __expf(fminf(rbv[i + 1] - mB1, 80.f)));
      *reinterpret_cast<unsigned*>(&KB[t * 72 + k]) = pack2(kb[i] * __expf(fminf(mB0 - rbv[i], 80.f)), kb[i + 1] * __expf(fminf(mB1 - rbv[i + 1], 80.f)));
    }
#pragma unroll
    for (int i = 0; i < 16; ++i) {
      kf[i] = kf[i] * __expf(BF[63 * 65 + k0 + i] - bfv[i]);
      kb[i] = kb[i] * __expf(RB[k0 + i] - rbv[i]);
    }
    hb_sync();
#pragma unroll
    for (int i = 0; i < 16; ++i) {
      KHF[(k0 + i) * 72 + t] = f2bf(kf[i]);
      KHB[(k0 + i) * 72 + t] = f2bf(kb[i]);
    }
    hb_sync();
    {
      const f32x16 af = lds_mm(QF, KF, tm, tn, l31, hh);
      const f32x16 ab = lds_mm(QB, KB, tm, tn, l31, hh);
      const int s = tn * 32 + l31;
#pragma unroll
      for (int r = 0; r < 16; ++r) {
        const int tt = tm * 32 + drow(r, hh);
        float a = 0.f;
        if (s <= tt) a += af[r];
        if (s >= tt) a += ab[r];
        ATT[tt * 72 + s] = f2bf(a);
      }
    }
    {
      const f32x16 lf = lds_mm(VTt, KHF, tm, tn, l31, hh);
      const f32x16 lb = lds_mm(VTt, KHB, tm, tn, l31, hh);
      bf16* stf = P.ST + ((size_t)((b * 4 + hd) * 2 + 0) * 36 + c) * 4096;
      bf16* stb = P.ST + ((size_t)((b * 4 + hd) * 2 + 1) * 36 + c) * 4096;
#pragma unroll
      for (int r = 0; r < 16; ++r) {
        const int kk = tm * 32 + drow(r, hh), d = tn * 32 + l31;
        stf[kk * 64 + d] = f2bf(lf[r]);
        stb[kk * 64 + d] = f2bf(lb[r]);
      }
    }
    hb_sync();
    {
      const f32x16 o = lds_mm(ATT, VTt, tm, tn, l31, hh);
#pragma unroll
      for (int r = 0; r < 16; ++r) {
        const int tt = tm * 32 + drow(r, hh), d = tn * 32 + l31;
        P.OI[(size_t)row_of(b, c * 64 + tt) * 256 + hd * 64 + d] = f2bf(o[r]);
      }
    }
  }
}

DEVI void hgrn_scan_item(const Params& P, int item) {
  const int tid = TIDX;
  const int chain = item >> 2, sl = item & 3;
  const int dir = chain & 1;
  const int dd = tid >> 2, k4 = sl * 16 + (tid & 3) * 4;
  float4 S = make_float4(0.f, 0.f, 0.f, 0.f);
  bf16* base = P.ST + (size_t)chain * 36 * 4096 + dd * 64 + k4;
  const float* dec = P.DEC + (size_t)chain * 36 * 64 + k4;
#pragma unroll 1
  for (int g = 0; g < 6; ++g) {
    float4 L[6], dc[6];
#pragma unroll
    for (int j = 0; j < 6; ++j) {
      const int step = g * 6 + j;
      const int c = dir == 0 ? step : (step < 4 ? 3 - step : 39 - step);
      { const uint2 u = *reinterpret_cast<const uint2*>(base + (size_t)c * 4096); L[j] = make_float4(lo2f(u.x), hi2f(u.x), lo2f(u.y), hi2f(u.y)); }
      dc[j] = *reinterpret_cast<const float4*>(dec + c * 64);
    }
#pragma unroll
    for (int j = 0; j < 6; ++j) {
      const int step = g * 6 + j;
      const int c = dir == 0 ? step : (step < 4 ? 3 - step : 39 - step);
      *reinterpret_cast<uint2*>(base + (size_t)c * 4096) = make_uint2(pack2(S.x, S.y), pack2(S.z, S.w));
      S.x = dc[j].x * S.x + L[j].x; S.y = dc[j].y * S.y + L[j].y; S.z = dc[j].z * S.z + L[j].z; S.w = dc[j].w * S.w + L[j].w;
    }
  }
}

DEVI void phase_hgrn_final(const Params& P, int l, unsigned char* smem) {
  const int tid = TIDX, lane = tid & 63, wave = tid >> 6, l31 = lane & 31, hh = lane >> 5;
  const int tm = wave >> 1, tn = wave & 1;
  float* O = reinterpret_cast<float*>(smem);
  bf16* QF = reinterpret_cast<bf16*>(smem + 33280);
  bf16* QB = QF + 64 * 72;
  bf16* SF = QB + 64 * 72;
  bf16* SB = SF + 64 * 72;
  const int c0 = (l == 1) ? 4 : 0;
  const int nc = 36 - c0;
  for (int it = VBID; it < 8 * 4 * nc; it += NVB) {
    const int c = it % nc + c0, hd = (it / nc) & 3, b = it / (nc * 4);
    const int t = tid >> 2, k0 = (tid & 3) * 16;
    const int row = row_of(b, c * 64 + t);
    bf16 oiv[16];
#pragma unroll
    for (int r = 0; r < 16; ++r) oiv[r] = P.OI[(size_t)row_of(b, c * 64 + tm * 32 + drow(r, hh)) * 256 + hd * 64 + tn * 32 + l31];
    const bf16* gsrc = P.Z + (size_t)row * DIN + ZC_CG + hd * 64 + k0;
    const uint4 gA = *reinterpret_cast<const uint4*>(gsrc), gB = *reinterpret_cast<const uint4*>(gsrc + 8);
    hb_sync();
    {
      const size_t go = (size_t)row * 256 + hd * 64 + k0;
      *reinterpret_cast<uint4*>(QF + t * 72 + k0) = *reinterpret_cast<const uint4*>(P.GQF + go);
      *reinterpret_cast<uint4*>(QF + t * 72 + k0 + 8) = *reinterpret_cast<const uint4*>(P.GQF + go + 8);
      *reinterpret_cast<uint4*>(QB + t * 72 + k0) = *reinterpret_cast<const uint4*>(P.GQB + go);
      *reinterpret_cast<uint4*>(QB + t * 72 + k0 + 8) = *reinterpret_cast<const uint4*>(P.GQB + go + 8);
      const bf16* stf = P.ST + ((size_t)((b * 4 + hd) * 2 + 0) * 36 + c) * 4096 + t * 64 + k0;
      const bf16* stb = P.ST + ((size_t)((b * 4 + hd) * 2 + 1) * 36 + c) * 4096 + t * 64 + k0;
      *reinterpret_cast<uint4*>(SF + t * 72 + k0) = *reinterpret_cast<const uint4*>(stf);
      *reinterpret_cast<uint4*>(SF + t * 72 + k0 + 8) = *reinterpret_cast<const uint4*>(stf + 8);
      *reinterpret_cast<uint4*>(SB + t * 72 + k0) = *reinterpret_cast<const uint4*>(stb);
      *reinterpret_cast<uint4*>(SB + t * 72 + k0 + 8) = *reinterpret_cast<const uint4*>(stb + 8);
    }
    hb_sync();
    {
      f32x16 o = lds_mm(QF, SF, tm, tn, l31, hh);
      const f32x16 o2 = lds_mm(QB, SB, tm, tn, l31, hh);
#pragma unroll
      for (int r = 0; r < 16; ++r) {
        const int tt = tm * 32 + drow(r, hh), d = tn * 32 + l31;
        O[tt * 65 + d] = o[r] + o2[r] + bf2f(oiv[r]);
      }
    }
    hb_sync();
    {
      float ov[16]; float ss = 0.f;
#pragma unroll
      for (int i = 0; i < 16; ++i) { ov[i] = O[t * 65 + k0 + i]; ss += ov[i] * ov[i]; }
      ss += dpp_xor<1>(ss); ss += dpp_xor<2>(ss);
      const float rr = rsqrtf(ss * (1.f / 64.f) + EPS);
      const float* nw = P.c_out_norm_w + l * 64 + k0;
      const unsigned gw[8] = {gA.x, gA.y, gA.z, gA.w, gB.x, gB.y, gB.z, gB.w};
      unsigned pk[8];
#pragma unroll
      for (int i = 0; i < 16; i += 2) {
        const float g0 = lo2f(gw[i >> 1]), g1 = hi2f(gw[i >> 1]);
        const float y0 = ov[i] * rr * nw[i] * (g0 * sigmoidf_(g0));
        const float y1 = ov[i + 1] * rr * nw[i + 1] * (g1 * sigmoidf_(g1));
        pk[i >> 1] = pack2(y0, y1);
      }
      uint4* dst = reinterpret_cast<uint4*>(P.H + (size_t)row * 1024 + 768 + hd * 64 + k0);
      dst[0] = make_uint4(pk[0], pk[1], pk[2], pk[3]);
      dst[1] = make_uint4(pk[4], pk[5], pk[6], pk[7]);
    }
  }
}

DEVI void attn_item8(const Params& P, int b, int h, int qpos0, int nkeys, float sref, unsigned char* smem_base) {
  const int tid = threadIdx.x, lane = tid & 63, wave = tid >> 6, l31 = lane & 31, hh = lane >> 5;
  constexpr int TK = 128, LDKS = 104, LDVS = 136;
  constexpr int KS_BYTES = TK * LDKS * 2, VS_BYTES = 64 * LDVS * 2, ST_BYTES = KS_BYTES + VS_BYTES;
  const bf16* Qg = P.Q + ((size_t)(b * 8 + h) * SEQP + qpos0 + wave * 32 + l31) * 96;
  const bf16* Kg = P.K + (size_t)(b * 8 + h) * SEQP * 96;
  const bf16* Vg = P.VT + (size_t)(b * 8 + h) * 64 * SEQP;
  bf16x8 qf[6];
#pragma unroll
  for (int ks = 0; ks < 6; ++ks) qf[ks] = ldfrag(Qg + ks * 16 + hh * 8);
  f32x16 oacc[2]; oacc[0] = zero16(); oacc[1] = zero16();
  f32x16 cneg;
#pragma unroll
  for (int r = 0; r < 16; ++r) cneg[r] = -sref;
  float lsum = 0.f;
  const bf16x2 ones2 = (bf16x2){(__bf16)1.0f, (__bf16)1.0f};
  const int ntiles = nkeys / TK;
  unsigned koff[4], voff[3];
#pragma unroll
  for (int i = 0; i < 4; ++i) { const int q = (i * 8 + wave) * 64 + lane, row = q / 13, cc = q - row * 13; koff[i] = (unsigned)(row * 96 + (cc < 12 ? cc : 0) * 8) * 2u; }
#pragma unroll
  for (int i = 0; i < 3; ++i) { const int q = (i * 8 + wave) * 64 + lane, row = q / 17, cc = q - row * 17; voff[i] = (unsigned)((row < 64 ? row : 63) * SEQP + (cc < 16 ? cc : 0) * 8) * 2u; }
  LAS unsigned char* ldsb = (LAS unsigned char*)smem_base;
  auto dma_tile = [&](int kt, int buf) {
    const char* kb_ = (const char*)(Kg + (size_t)kt * TK * 96);
    const char* vb_ = (const char*)(Vg + (size_t)kt * TK);
#pragma unroll
    for (int i = 0; i < 4; ++i) {
      const int g = i * 8 + wave;
      if (g < 26) __builtin_amdgcn_global_load_lds((const unsigned*)(kb_ + koff[i]), (LAS unsigned*)(ldsb + buf * ST_BYTES + g * 1024), 16, 0, 0);
    }
#pragma unroll
    for (int i = 0; i < 3; ++i) {
      const int g = i * 8 + wave;
      if (g < 17) __builtin_amdgcn_global_load_lds((const unsigned*)(vb_ + voff[i]), (LAS unsigned*)(ldsb + buf * ST_BYTES + KS_BYTES + g * 1024), 16, 0, 0);
    }
  };
  __syncthreads();
  dma_tile(0, 0);
  asm volatile("s_waitcnt vmcnt(0)" ::: "memory");
  __syncthreads();
  for (int kt = 0; kt < ntiles; ++kt) {
    const int cur = kt & 1;
    if (kt + 1 < ntiles) dma_tile(kt + 1, cur ^ 1);
    const bf16* sK = reinterpret_cast<const bf16*>(smem_base + cur * ST_BYTES);
    const bf16* sV = reinterpret_cast<const bf16*>(smem_base + cur * ST_BYTES + KS_BYTES);
#pragma unroll
    for (int kk = 0; kk < 4; ++kk) {
      f32x16 sacc = mfma32(ldfrag(sK + (kk * 32 + l31) * LDKS + hh * 8), qf[0], cneg);
#pragma unroll
      for (int ks = 1; ks < 6; ++ks) {
        const bf16x8 a = ldfrag(sK + (kk * 32 + l31) * LDKS + ks * 16 + hh * 8);
        sacc = mfma32(a, qf[ks], sacc);
      }
#pragma unroll
      for (int r = 0; r < 16; ++r) sacc[r] = __builtin_amdgcn_exp2f(sacc[r]);
#pragma unroll
      for (int s = 0; s < 2; ++s) {
        bf16x8 pb;
#pragma unroll
        for (int j = 0; j < 8; ++j) pb[j] = (__bf16)sacc[8 * s + j];
#pragma unroll
        for (int j = 0; j < 4; ++j) lsum = __builtin_amdgcn_fdot2_f32_bf16((bf16x2){pb[2 * j], pb[2 * j + 1]}, ones2, lsum, false);
#pragma unroll
        for (int dt = 0; dt < 2; ++dt) {
          const bf16x8 a = ldfrag(sV + (dt * 32 + l31) * LDVS + kk * 32 + s * 16 + hh * 8);
          oacc[dt] = mfma32(a, pb, oacc[dt]);
        }
      }
    }
    asm volatile("s_waitcnt vmcnt(0)" ::: "memory");
    __syncthreads();
  }
  lsum += __shfl_xor(lsum, 32);
  const float inv = 1.f / lsum;
  const int row = row_of(b, qpos0 + wave * 32 + l31);
  bf16* dst = P.H + (size_t)row * 1024 + 256 + h * 64;
#pragma unroll
  for (int dt = 0; dt < 2; ++dt)
#pragma unroll
    for (int rg = 0; rg < 4; ++rg) {
      const int d = dt * 32 + 8 * rg + 4 * hh;
      uint2 o;
      o.x = pack2(oacc[dt][4 * rg + 0] * inv, oacc[dt][4 * rg + 1] * inv);
      o.y = pack2(oacc[dt][4 * rg + 2] * inv, oacc[dt][4 * rg + 3] * inv);
      *reinterpret_cast<uint2*>(dst + d) = o;
    }
}

DEVI void phase_attn_scan(const Params& P, int l, unsigned char* smem_base, bool skip_scan = false) {
  if (!skip_scan)
    if (blockIdx.x >= 128) hgrn_scan_item(P, ((int)blockIdx.x - 128) * 2 + VHALF);
  float sref;
  {
    const int lane = threadIdx.x & 63;
    float mq = fmaxf(fabsf(P.b_qh_w[l * 96 + lane]), lane < 32 ? fabsf(P.b_qh_w[l * 96 + 64 + lane]) : 0.f);
    float mk = fmaxf(fabsf(P.b_kh_w[l * 96 + lane]), lane < 32 ? fabsf(P.b_kh_w[l * 96 + 64 + lane]) : 0.f);
#pragma unroll
    for (int o = 32; o > 0; o >>= 1) { mq = fmaxf(mq, __shfl_xor(mq, o)); mk = fmaxf(mk, __shfl_xor(mk, o)); }
    sref = fminf(1.4426950408889634f * 9.797958971132712f * mq * mk, 60.f);
  }
  const int c = blockIdx.x, xcd = c & 7, slot = c >> 3;
  const int nrounds = (l == 0) ? 3 : 2;
  for (int r = 0; r < nrounds; ++r) {
    if (r < 2) {
      const int u = r * 32 + slot;
      const int bh = xcd * 8 + (u >> 3), qt = u & 7;
      if (slot < 32) attn_item8(P, bh >> 3, bh & 7, 256 + 256 * qt, 2304, sref, smem_base);
    } else if (c < 64) {
      attn_item8(P, c >> 3, c & 7, 0, 256, sref, smem_base);
    }
  }
}

DEVI unsigned ordkey(float s) { const unsigned u = __float_as_uint(s); return (u & 0x80000000u) ? ~u : (u | 0x80000000u); }
DEVI float keyval(unsigned k, unsigned mask) { const unsigned u = k & ~mask; return __uint_as_float((u & 0x80000000u) ? (u & 0x7fffffffu) : ~u); }
DEVI float keyval16(unsigned k) { return __uint_as_float((k & 0x80000000u) ? (k & 0x7fff0000u) : (~k & 0xffff0000u)); }
DEVI void ins16(unsigned (&lst)[16], unsigned v) {
#pragma unroll
  for (int j = 0; j < 16; ++j) { const unsigned hi = max(lst[j], v); v = min(lst[j], v); lst[j] = hi; }
}
template <int XM> DEVI unsigned quad_xor(unsigned v) {
  return (unsigned)__builtin_amdgcn_mov_dpp((int)v, XM == 1 ? 0xB1 : 0x4E, 0xf, 0xf, true);
}
DEVI void merge16(unsigned (&lst)[16], int xm) {
  unsigned o[16];
#pragma unroll
  for (int j = 0; j < 16; ++j) o[j] = (xm == 1) ? quad_xor<1>(lst[j]) : quad_xor<2>(lst[j]);
#pragma unroll
  for (int j = 0; j < 16; ++j) lst[j] = max(lst[j], o[15 - j]);
#pragma unroll
  for (int d = 8; d >= 1; d >>= 1)
#pragma unroll
    for (int j = 0; j < 16; ++j)
      if ((j & d) == 0) { const unsigned a = lst[j], bb = lst[j + d]; lst[j] = max(a, bb); lst[j + d] = min(a, bb); }
}

struct SortNet16 { int a[63]; int b[63]; };
constexpr SortNet16 SN16 = {{0, 2, 0, 1, 1, 4, 6, 4, 5, 5, 0, 2, 2, 1, 3, 3, 1, 3, 5, 8, 10, 8, 9, 9, 12, 14, 12, 13, 13, 8, 10, 10, 9, 11, 11, 9, 11, 13, 0, 4, 4, 2, 6, 6, 2, 6, 10, 1, 5, 5, 3, 7, 7, 3, 7, 11, 1, 3, 5, 7, 9, 11, 13}, {1, 3, 2, 3, 2, 5, 7, 6, 7, 6, 4, 6, 4, 5, 7, 5, 2, 4, 6, 9, 11, 10, 11, 10, 13, 15, 14, 15, 14, 12, 14, 12, 13, 15, 13, 10, 12, 14, 8, 12, 8, 10, 14, 10, 4, 8, 12, 9, 13, 9, 11, 15, 11, 5, 9, 13, 2, 4, 6, 8, 10, 12, 14}};
DEVI void bitonic_sort_desc16(unsigned (&v)[16]) {
#pragma unroll
  for (int c = 0; c < 63; ++c) {
    const unsigned x = v[SN16.a[c]], y = v[SN16.b[c]];
    v[SN16.a[c]] = max(x, y); v[SN16.b[c]] = min(x, y);
  }
}
DEVI void bitonic_merge_desc16(unsigned (&lst)[16]) {
#pragma unroll
  for (int d = 8; d >= 1; d >>= 1)
#pragma unroll
    for (int j = 0; j < 16; ++j)
      if ((j & d) == 0) { const unsigned a = lst[j], bb = lst[j + d]; lst[j] = max(a, bb); lst[j + d] = min(a, bb); }
}
template <class T> DEVI T sel4(bool b0, bool b1, T x0, T x1, T x2, T x3) { const T lo = b0 ? x1 : x0, hi = b0 ? x3 : x2; return b1 ? hi : lo; }
template <class T> DEVI T sel16(int i, const T (&x)[16]) {
  const bool b0 = i & 1, b1 = i & 2, b2 = i & 4, b3 = i & 8;
  const T q0 = sel4(b0, b1, x[0], x[1], x[2], x[3]), q1 = sel4(b0, b1, x[4], x[5], x[6], x[7]);
  const T q2 = sel4(b0, b1, x[8], x[9], x[10], x[11]), q3 = sel4(b0, b1, x[12], x[13], x[14], x[15]);
  return sel4(b2, b3, q0, q1, q2, q3);
}
struct CandTab { int a[52]; int b[52]; };
constexpr CandTab make_cand_tab() {
  CandTab t{};
  int n = 0;
  for (int a = 0; a < 16; ++a)
    for (int b = 0; b < 16; ++b)
      if ((a + 1) * (b + 1) <= 16) { t.a[n] = a; t.b[n] = b; ++n; }
  for (; n < 52; ++n) { t.a[n] = 0; t.b[n] = 0; }
  return t;
}

DEVI void phase_route(const Params& P, int l, unsigned char* smem) {
  const int tid = TIDX;
  const int mtiles = (l == 1) ? 256 : 288;
  for (int it = VBID; it < mtiles * 8; it += NVB) {
    const int mt = it >> 3, h = it & 7;
    unsigned lst[2][16];
    const int row = tid >> 2, part = tid & 3;
    const unsigned hbits = (unsigned)(3 - part) << 5;
#pragma unroll
    for (int p = 0; p < 2; ++p) {
      unsigned B2[16];
      {
        const bf16* sp = P.QP + (size_t)(mt * 64 + row) * 2048 + (h * 2 + p) * 128 + part * 32;
#pragma unroll
        for (int i = 0; i < 4; ++i) {
          const uint4 u = *reinterpret_cast<const uint4*>(sp + i * 8);
          const unsigned uw[4] = {u.x, u.y, u.z, u.w};
#pragma unroll
          for (int w = 0; w < 4; ++w) {
            const int e = i * 8 + w * 2;
            const unsigned m2 = (uw[w] >> 15) & 0x00010001u;
            const unsigned k = uw[w] ^ (m2 * 0x7fffu) ^ 0x80008000u;
            const unsigned klo = ((k << 16) | hbits) | (unsigned)(31 - (e & 31));
            const unsigned khi = ((k & 0xffff0000u) | hbits) | (unsigned)(31 - ((e + 1) & 31));
            if (e < 16) { lst[p][e] = klo; lst[p][e + 1] = khi; } else { B2[e - 16] = klo; B2[e - 15] = khi; }
          }
        }
      }
      bitonic_sort_desc16(lst[p]);
      bitonic_sort_desc16(B2);
#pragma unroll
      for (int j = 0; j < 16; ++j) lst[p][j] = max(lst[p][j], B2[15 - j]);
      bitonic_merge_desc16(lst[p]);
      merge16(lst[p], 1);
      merge16(lst[p], 2);
    }
    float v0[16], v1[16];
#pragma unroll
    for (int j = 0; j < 16; ++j) { v0[j] = keyval16(lst[0][j]); v1[j] = keyval16(lst[1][j]); }
    unsigned best[16];
    {
      constexpr CandTab CT = make_cand_tab();
      const bool pb0 = part & 1, pb1 = part & 2;
#pragma unroll
      for (int c = 0; c < 13; ++c) {
        const int a0 = CT.a[4 * c + 0], a1 = CT.a[4 * c + 1], a2 = CT.a[4 * c + 2], a3 = CT.a[4 * c + 3];
        const int b0 = CT.b[4 * c + 0], b1 = CT.b[4 * c + 1], b2 = CT.b[4 * c + 2], b3 = CT.b[4 * c + 3];
        const float x = sel4(pb0, pb1, v0[a0], v0[a1], v0[a2], v0[a3]);
        const float y = sel4(pb0, pb1, v1[b0], v1[b1], v1[b2], v1[b3]);
        const unsigned nflat = sel4(pb0, pb1, (unsigned)(255 - (a0 * 16 + b0)), (unsigned)(255 - (a1 * 16 + b1)), (unsigned)(255 - (a2 * 16 + b2)), (unsigned)(255 - (a3 * 16 + b3)));
        const unsigned key = (ordkey(x + y) & ~0xffu) | nflat;
        best[c] = (4 * c + 3 < 50) ? key : ((4 * c + part < 50) ? key : 0u);
      }
      best[13] = 0u; best[14] = 0u; best[15] = 0u;
      bitonic_sort_desc16(best);
      merge16(best, 1);
      merge16(best, 2);
    }
    {
      const float mx = keyval(best[0], 0xffu);
      float es = 0.f;
      float ev[4]; int ex[4];
#pragma unroll
      for (int jj = 0; jj < 4; ++jj) {
        const unsigned kk = sel4((bool)(part & 1), (bool)(part & 2), best[4 * jj + 0], best[4 * jj + 1], best[4 * jj + 2], best[4 * jj + 3]);
        ev[jj] = __expf(keyval(kk, 0xffu) - mx);
        es += ev[jj];
        const int flat = 255 - (int)(kk & 0xffu);
        const int a = flat >> 4, bq = flat & 15;
        const int i1 = 127 - (int)(sel16(a, lst[0]) & 0x7fu), i2 = 127 - (int)(sel16(bq, lst[1]) & 0x7fu);
        ex[jj] = i1 * 128 + i2;
      }
      es += __uint_as_float(quad_xor<1>(__float_as_uint(es))); es += __uint_as_float(quad_xor<2>(__float_as_uint(es)));
      const float inv = 1.f / es;
      const int tok = mt * 64 + row;
      int* ed = P.EIDX + (size_t)tok * 128 + h * 16;
      float* gd = P.GATE + (size_t)tok * 128 + h * 16;
#pragma unroll
      for (int jj = 0; jj < 4; ++jj) { ed[4 * jj + part] = ex[jj]; gd[4 * jj + part] = ev[jj] * inv; }
    }
  }
}

DEVI float gelu_exact(float a) { return 0.5f * a * (1.f + erff(a * 0.70710678118654752f)); }

typedef float f2 __attribute__((ext_vector_type(2)));
DEVI void phase_peer_u(const Params& P, int l) {
  const int lane = TIDX & 63, half = lane >> 5, l32 = lane & 31;
  const int gw = VBID * 4 + (TIDX >> 6), nw = NVB * 4;
  const int nrows = (l == 1) ? NL : NT;
  const unsigned char* PU = P.PU8 + (size_t)l * 16384 * 576;
  const bool b4 = lane & 16, b3 = lane & 8, b2 = lane & 4;
  if ((TIDX >> 6) & 1) __builtin_amdgcn_s_sleep(70);
  if (VHALF) __builtin_amdgcn_s_sleep(35);
  for (int t = gw; t < nrows; t += nw) {
    f2 h2[16];
    {
      const bf16* hp = P.H + (size_t)t * 1024 + l32 * 32;
#pragma unroll
      for (int i = 0; i < 4; ++i) {
        const uint4 hv = *reinterpret_cast<const uint4*>(hp + i * 8);
        h2[4 * i + 0] = (f2){lo2f(hv.x), hi2f(hv.x)}; h2[4 * i + 1] = (f2){lo2f(hv.y), hi2f(hv.y)};
        h2[4 * i + 2] = (f2){lo2f(hv.z), hi2f(hv.z)}; h2[4 * i + 3] = (f2){lo2f(hv.w), hi2f(hv.w)};
      }
    }
    const int e0 = P.EIDX[(size_t)t * 128 + lane] * 576, e1 = P.EIDX[(size_t)t * 128 + 64 + lane] * 576;
    const float g0 = P.GATE[(size_t)t * 128 + lane], g1 = P.GATE[(size_t)t * 128 + 64 + lane];
    float* wrow = P.WPE + (size_t)t * 128;
    const bool b1 = lane & 2;
    for (int kb = 0; kb < 4; ++kb) {
      const int esrc = kb < 2 ? e0 : e1;
      uint4 ud[16];
      unsigned short us[16];
#pragma unroll
      for (int i = 0; i < 16; ++i) {
        const unsigned uo = (unsigned)__shfl(esrc, (kb * 32 + 2 * i + half) & 63);
        ud[i] = *reinterpret_cast<const uint4*>(PU + (uo + (unsigned)l32 * 16u));
        us[i] = *reinterpret_cast<const unsigned short*>(PU + (uo + 512u + (unsigned)l32 * 2u));
      }
      float d[16];
#pragma unroll
      for (int i = 0; i < 16; ++i) {
        const unsigned uw[4] = {ud[i].x, ud[i].y, ud[i].z, ud[i].w};
        f2 sacc = (f2){0.f, 0.f};
#pragma unroll
        for (int c = 0; c < 4; ++c) {
          sacc = __builtin_elementwise_fma(__builtin_amdgcn_cvt_scalef32_pk_f32_fp4(uw[c], 1.0f, 0), h2[4 * c + 0], sacc);
          sacc = __builtin_elementwise_fma(__builtin_amdgcn_cvt_scalef32_pk_f32_fp4(uw[c], 1.0f, 1), h2[4 * c + 1], sacc);
          sacc = __builtin_elementwise_fma(__builtin_amdgcn_cvt_scalef32_pk_f32_fp4(uw[c], 1.0f, 2), h2[4 * c + 2], sacc);
          sacc = __builtin_elementwise_fma(__builtin_amdgcn_cvt_scalef32_pk_f32_fp4(uw[c], 1.0f, 3), h2[4 * c + 3], sacc);
        }
        d[i] = (sacc.x + sacc.y) * __uint_as_float((unsigned)us[i] << 16);
      }
      float r8[8], r4[4], r2[2], r1;
#pragma unroll
      for (int i = 0; i < 8; ++i) { const float mine = b4 ? d[8 + i] : d[i]; const float send = b4 ? d[i] : d[8 + i]; r8[i] = mine + __shfl_xor(send, 16); }
#pragma unroll
      for (int i = 0; i < 4; ++i) { const float mine = b3 ? r8[4 + i] : r8[i]; const float send = b3 ? r8[i] : r8[4 + i]; r4[i] = mine + dpp_xor<8>(send); }
#pragma unroll
      for (int i = 0; i < 2; ++i) { const float mine = b2 ? r4[2 + i] : r4[i]; const float send = b2 ? r4[i] : r4[2 + i]; r2[i] = mine + dpp_xor<4>(send); }
      { const float mine = b1 ? r2[1] : r2[0]; const float send = b1 ? r2[0] : r2[1]; r1 = mine + dpp_xor<2>(send); }
      r1 += dpp_xor<1>(r1);
      const int k = kb * 32 + 2 * ((lane >> 1) & 15) + half;
      const float gt = __shfl(kb < 2 ? g0 : g1, k & 63);
      if ((lane & 1) == 0) wrow[k] = gt * gelu_exact(r1);
    }
  }
}

DEVI void phase_peer(const Params& P, int l) {
  const int lane = TIDX & 63, half = lane >> 5, l32 = lane & 31;
  const int gw = VBID * 4 + (TIDX >> 6), nw = NVB * 4;
  const int nrows = (l == 1) ? NL : NT;
  const unsigned char* PV = P.PV8 + (size_t)l * 16384 * 576;
  if ((TIDX >> 6) & 1) __builtin_amdgcn_s_sleep(70);
  if (VHALF) __builtin_amdgcn_s_sleep(35);
  for (int t = gw; t < nrows; t += nw) {
    const int e0 = P.EIDX[(size_t)t * 128 + lane] * 576, e1 = P.EIDX[(size_t)t * 128 + 64 + lane] * 576;
    const float w0 = __hip_atomic_load(P.WPE + (size_t)t * 128 + lane, __ATOMIC_RELAXED, __HIP_MEMORY_SCOPE_AGENT);
    const float w1 = __hip_atomic_load(P.WPE + (size_t)t * 128 + 64 + lane, __ATOMIC_RELAXED, __HIP_MEMORY_SCOPE_AGENT);
    f2 y2[16];
#pragma unroll
    for (int i = 0; i < 16; ++i) y2[i] = (f2){0.f, 0.f};
    for (int kb = 0; kb < 4; ++kb) {
      const int esrc = kb < 2 ? e0 : e1;
      const float wsrc = kb < 2 ? w0 : w1;
      uint4 vd[16];
      unsigned short vs[16];
      float wv[16];
#pragma unroll
      for (int i = 0; i < 16; ++i) {
        const int ks = (kb * 32 + 2 * i + half) & 63;
        const unsigned vo = (unsigned)__shfl(esrc, ks);
        wv[i] = __shfl(wsrc, ks);
        vd[i] = *reinterpret_cast<const uint4*>(PV + (vo + (unsigned)l32 * 16u));
        vs[i] = *reinterpret_cast<const unsigned short*>(PV + (vo + 512u + (unsigned)l32 * 2u));
      }
#pragma unroll
      for (int i = 0; i < 16; ++i) {
        const float wi = wv[i] * __uint_as_float((unsigned)vs[i] << 16);
        const f2 ww = (f2){wi, wi};
        const unsigned vw[4] = {vd[i].x, vd[i].y, vd[i].z, vd[i].w};
#pragma unroll
        for (int c = 0; c < 4; ++c) {
          y2[4 * c + 0] = __builtin_elementwise_fma(ww, __builtin_amdgcn_cvt_scalef32_pk_f32_fp4(vw[c], 1.0f, 0), y2[4 * c + 0]);
          y2[4 * c + 1] = __builtin_elementwise_fma(ww, __builtin_amdgcn_cvt_scalef32_pk_f32_fp4(vw[c], 1.0f, 1), y2[4 * c + 1]);
          y2[4 * c + 2] = __builtin_elementwise_fma(ww, __builtin_amdgcn_cvt_scalef32_pk_f32_fp4(vw[c], 1.0f, 2), y2[4 * c + 2]);
          y2[4 * c + 3] = __builtin_elementwise_fma(ww, __builtin_amdgcn_cvt_scalef32_pk_f32_fp4(vw[c], 1.0f, 3), y2[4 * c + 3]);
        }
      }
    }
    float y[16];
#pragma unroll
    for (int j = 0; j < 8; ++j) {
      const float ax = y2[j].x + __shfl_xor(y2[j].x, 32), ay = y2[j].y + __shfl_xor(y2[j].y, 32);
      const float bx = y2[8 + j].x + __shfl_xor(y2[8 + j].x, 32), by = y2[8 + j].y + __shfl_xor(y2[8 + j].y, 32);
      y[2 * j] = half ? bx : ax; y[2 * j + 1] = half ? by : ay;
    }
    const int bi = batch_of_row(t);
    const float* gate2 = P.MOD + (size_t)(l * 9 + bi) * 6144 + 5 * 1024;
    const int d0 = l32 * 32 + half * 16;
    float xn[16];
    float ss = 0.f;
#pragma unroll
    for (int q4 = 0; q4 < 4; ++q4) {
      const int d = d0 + q4 * 4;
      const uint2 xu = *reinterpret_cast<const uint2*>(P.X + (size_t)t * 1024 + d);
      const float4 xo = make_float4(lo2f(xu.x), hi2f(xu.x), lo2f(xu.y), hi2f(xu.y));
      const float4 gg = *reinterpret_cast<const float4*>(gate2 + d);
      float4 o;
      o.x = xo.x + gg.x * y[q4 * 4 + 0]; o.y = xo.y + gg.y * y[q4 * 4 + 1];
      o.z = xo.z + gg.z * y[q4 * 4 + 2]; o.w = xo.w + gg.w * y[q4 * 4 + 3];
      xn[q4 * 4 + 0] = o.x; xn[q4 * 4 + 1] = o.y; xn[q4 * 4 + 2] = o.z; xn[q4 * 4 + 3] = o.w;
      ss += o.x * o.x + o.y * o.y + o.z * o.z + o.w * o.w;
      if (l == 1) *reinterpret_cast<float4*>(P.out + (size_t)t * 1024 + d) = o;
      else *reinterpret_cast<uint2*>(P.X + (size_t)t * 1024 + d) = make_uint2(pack2(o.x, o.y), pack2(o.z, o.w));
    }
    if (l == 0) {
      ss = wave_sum(ss);
      const float rr = rsqrtf(ss * (1.f / 1024.f) + EPS);
      const float* lnw = P.ln1_w + 1024;
      const float* mod = P.MOD + (size_t)(9 + bi) * 6144;
      unsigned pk[8];
#pragma unroll
      for (int i = 0; i < 16; i += 2) {
        const float o0 = xn[i] * rr * lnw[d0 + i] * (1.f + mod[1024 + d0 + i]) + mod[d0 + i];
        const float o1 = xn[i + 1] * rr * lnw[d0 + i + 1] * (1.f + mod[1024 + d0 + i + 1]) + mod[d0 + i + 1];
        pk[i >> 1] = pack2(o0, o1);
      }
      *reinterpret_cast<uint4*>(P.H + (size_t)t * 1024 + d0) = make_uint4(pk[0], pk[1], pk[2], pk[3]);
      *reinterpret_cast<uint4*>(P.H + (size_t)t * 1024 + d0 + 8) = make_uint4(pk[4], pk[5], pk[6], pk[7]);
    }
  }
}

using f32x4 = __attribute__((ext_vector_type(4))) float;
namespace g8 {
constexpr int BM = 256, BK = 64, HALF = 128, HT = HALF * BK;
DEVI int lds_byte(int r, int c) { const int st = (r >> 4) * 2 + (c >> 5), rr = r & 15, cc = c & 31, ob = rr * 64 + cc * 2; return st * 1024 + (ob ^ (((ob >> 9) & 1) << 5)); }
DEVI void stage_rc(int b, int& R, int& C) { const int st = b / 1024, sb = b % 1024, swz = sb ^ (((sb >> 9) & 1) << 5); R = (st >> 1) * 16 + swz / 64; C = (st & 1) * 32 + (swz % 64) / 2; }
DEVI int perm32(int rho) { const int n = rho >> 4, i = rho & 15; return 8 * (i >> 2) + 4 * n + (i & 3); }
DEVI void unit_of(int L, int nM, int nN, int& pm, int& pn) {
  const int nwg = nM * nN;
  int wgid = L;
  { const int q = nwg / 8, r = nwg % 8, xcd = wgid % 8, off = wgid / 8; wgid = (xcd < r ? xcd * (q + 1) : r * (q + 1) + (xcd - r) * q) + off; }
  const int nig = 8 * nN, gid = wgid / nig, fm = gid * 8, gsz = (nM - fm) < 8 ? (nM - fm) : 8;
  pm = fm + ((wgid % nig) % gsz); pn = (wgid % nig) / gsz;
}
}

struct G8Unit { int pm, pn; };
template <class Epi>
DEVI void gemm8_phase(LAS unsigned char* lds, const bf16* __restrict__ Ag, const bf16* __restrict__ Btg, const int K, const int nM, const int nN, const Epi& E,
                      const int lda = 0, const int pn_split = 1 << 30, const int acol0 = 0, const int acol1 = 0,
                      const int ldb = 0, const int pn_mod = 1 << 30, const int ksplit_cols = 0) {
  constexpr int BK = 64, HALF = 128, HTB = HALF * BK * 2;
  const int tid = threadIdx.x, wid = __builtin_amdgcn_readfirstlane(tid >> 6), lane = tid & 63, wr = wid >> 2, wc = wid & 3, fr = lane & 15, fq = lane >> 4;
  const int nt = K / BK;
  const int nunits = nM * nN, G = gridDim.x, c = blockIdx.x;
  const int LDA = lda ? lda : K, LDB = ldb ? ldb : K;
  unsigned voffA[2], voffB[2];
#pragma unroll
  for (int i = 0; i < 2; ++i) { int R, C; g8::stage_rc(tid * 16 + i * 8192, R, C); const int Rb = (R & ~31) + g8::perm32(R & 31); voffA[i] = (unsigned)(R * LDA + C) * 2u; voffB[i] = (unsigned)(Rb * LDB + C) * 2u; }
  const size_t kstep = (size_t)(BK * 2);
  const size_t hstepA = (size_t)HALF * LDA * 2, hstep = (size_t)HALF * LDB * 2;
  const size_t tstepA = 2 * hstepA, tstep = 2 * hstep;
  const unsigned ldsw = (unsigned)wid * 1024u;
  const int aoff = g8::lds_byte(wr * 64 + fr, fq * 8), boff = g8::lds_byte(wc * 32 + fr, fq * 8);
#define PG8_SA(b, h) (((b) * 2 + (h)) * HTB)
#define PG8_SB(b, h) ((4 + (b) * 2 + (h)) * HTB)
#define PG8_STAGE(bufoff, gbase, voff) do { _Pragma("unroll") for (int _i = 0; _i < 2; ++_i) \
        __builtin_amdgcn_global_load_lds((const unsigned*)((const char*)(gbase) + (voff)[_i]), (LAS unsigned*)(lds + (bufoff) + ldsw + _i * 8192), 16, 0, 0); } while (0)
#define PG8_LDA(dst, b, h) do { _Pragma("unroll") for (int m = 0; m < 4; ++m) _Pragma("unroll") for (int k = 0; k < 2; ++k) dst[m][k] = *(const LAS bf16x8*)(lds + PG8_SA(b, h) + aoff + m * 2048 + k * 1024); } while (0)
#define PG8_LDB(dst, b, h) do { _Pragma("unroll") for (int n = 0; n < 2; ++n) _Pragma("unroll") for (int k = 0; k < 2; ++k) dst[n][k] = *(const LAS bf16x8*)(lds + PG8_SB(b, h) + boff + n * 2048 + k * 1024); } while (0)
#define PG8_MMA(ai, bj, At_, Bt_) do { __builtin_amdgcn_s_setprio(1); _Pragma("unroll") for (int m = 0; m < 4; ++m) _Pragma("unroll") for (int n = 0; n < 2; ++n) _Pragma("unroll") for (int k = 0; k < 2; ++k) \
        acc[ai][bj][m][n] = __builtin_amdgcn_mfma_f32_16x16x32_bf16(Bt_[n][k], At_[m][k], acc[ai][bj][m][n], 0, 0, 0); __builtin_amdgcn_s_setprio(0); } while (0)
#define PG8_WAIT_V(n) asm volatile("s_waitcnt vmcnt(" #n ")" ::: "memory")
#define PG8_WAIT_L(n) asm volatile("s_waitcnt lgkmcnt(" #n ")" ::: "memory")
#define PG8_BAR __builtin_amdgcn_s_barrier()
#define PG8_SCHED __builtin_amdgcn_sched_barrier(0)
  G8Unit cur, nxt; int ui = 0;
  if (c >= nunits) return;
  g8::unit_of(c, nM, nN, cur.pm, cur.pn);
  f32x4 acc[2][2][4][2];
#pragma unroll
  for (int a = 0; a < 2; ++a)
#pragma unroll
    for (int b = 0; b < 2; ++b)
#pragma unroll
      for (int m = 0; m < 4; ++m)
#pragma unroll
        for (int n = 0; n < 2; ++n) acc[a][b][m][n] = (f32x4){0.f, 0.f, 0.f, 0.f};
  bf16x8 At[4][2], B0[2][2], B1[2][2];
  const char* cA = (const char*)Ag + (size_t)cur.pm * tstepA + (size_t)((cur.pn < pn_split ? acol0 : acol1) + (cur.pn / pn_mod) * ksplit_cols) * 2;
  const char* cB = (const char*)Btg + (size_t)(cur.pn % pn_mod) * tstep + (size_t)((cur.pn / pn_mod) * ksplit_cols) * 2;
  PG8_STAGE(PG8_SB(0, 0), cB, voffB); PG8_STAGE(PG8_SA(0, 0), cA, voffA); PG8_STAGE(PG8_SB(0, 1), cB + hstep, voffB); PG8_STAGE(PG8_SA(0, 1), cA + hstepA, voffA);
  if (wr == 1) PG8_BAR;
  PG8_WAIT_V(4); PG8_BAR;
  PG8_STAGE(PG8_SB(1, 0), cB + kstep, voffB); PG8_STAGE(PG8_SA(1, 0), cA + kstep, voffA); PG8_STAGE(PG8_SB(1, 1), cB + hstep + kstep, voffB);
  PG8_WAIT_V(6); PG8_BAR;
  for (;;) {
    const long Ln = (long)(ui + 1) * G + c;
    const bool has_next = Ln < nunits;
    if (has_next) g8::unit_of((int)Ln, nM, nN, nxt.pm, nxt.pn);
    const char* nA = has_next ? (const char*)Ag + (size_t)nxt.pm * tstepA + (size_t)((nxt.pn < pn_split ? acol0 : acol1) + (nxt.pn / pn_mod) * ksplit_cols) * 2 : cA;
    const char* nB = has_next ? (const char*)Btg + (size_t)(nxt.pn % pn_mod) * tstep + (size_t)((nxt.pn / pn_mod) * ksplit_cols) * 2 : cB;
    for (int t = 0; t < nt; t += 2) {
      const bool last = (t == nt - 2);
      const char* a1 = cA + (size_t)(t + 1) * kstep;
      const char* a2 = last ? nA : cA + (size_t)(t + 2) * kstep; const char* b2 = last ? nB : cB + (size_t)(t + 2) * kstep;
      const char* a3 = a2 + kstep; const char* b3 = b2 + kstep;
      PG8_LDB(B0, 0, 0); PG8_SCHED; PG8_LDA(At, 0, 0); PG8_STAGE(PG8_SA(1, 1), a1 + hstepA, voffA);
      PG8_WAIT_L(8); PG8_BAR; PG8_WAIT_L(0); PG8_MMA(0, 0, At, B0); PG8_BAR; PG8_SCHED;
      PG8_LDB(B1, 0, 1); PG8_STAGE(PG8_SB(0, 0), b2, voffB);
      PG8_BAR; PG8_WAIT_L(0); PG8_MMA(0, 1, At, B1); PG8_BAR;
      PG8_LDA(At, 0, 1); PG8_STAGE(PG8_SA(0, 0), a2, voffA);
      PG8_BAR; PG8_WAIT_L(0); PG8_MMA(1, 0, At, B0); PG8_BAR; PG8_SCHED;
      PG8_STAGE(PG8_SB(0, 1), b2 + hstep, voffB);
      PG8_WAIT_V(6); PG8_BAR; PG8_MMA(1, 1, At, B1); PG8_BAR;
      PG8_LDB(B0, 1, 0); PG8_SCHED; PG8_LDA(At, 1, 0); PG8_STAGE(PG8_SA(0, 1), a2 + hstepA, voffA);
      PG8_WAIT_L(8); PG8_BAR; PG8_WAIT_L(0); PG8_MMA(0, 0, At, B0); PG8_BAR; PG8_SCHED;
      PG8_LDB(B1, 1, 1); PG8_STAGE(PG8_SB(1, 0), b3, voffB);
      PG8_BAR; PG8_WAIT_L(0); PG8_MMA(0, 1, At, B1); PG8_BAR;
      PG8_LDA(At, 1, 1); PG8_STAGE(PG8_SA(1, 0), a3, voffA);
      PG8_BAR; PG8_WAIT_L(0); PG8_MMA(1, 0, At, B0); PG8_BAR; PG8_SCHED;
      PG8_STAGE(PG8_SB(1, 1), b3 + hstep, voffB);
      PG8_WAIT_V(6); PG8_BAR; PG8_MMA(1, 1, At, B1); PG8_BAR;
    }
    if constexpr (!Epi::AFTER_DRAIN) E(acc, cur, wr, wc, fr, fq);
    if (!has_next) break;
#pragma unroll
    for (int a = 0; a < 2; ++a)
#pragma unroll
      for (int b = 0; b < 2; ++b)
#pragma unroll
        for (int m = 0; m < 4; ++m)
#pragma unroll
          for (int n = 0; n < 2; ++n) acc[a][b][m][n] = (f32x4){0.f, 0.f, 0.f, 0.f};
    cur = nxt; cA = nA; cB = nB; ++ui;
  }
  PG8_WAIT_V(0);
  if (wr == 0) PG8_BAR;
  PG8_BAR;
  if constexpr (Epi::AFTER_DRAIN) E.fused(acc, cur, wr, wc, fr, fq, lds, wid, lane);
#undef PG8_SA
#undef PG8_SB
#undef PG8_STAGE
#undef PG8_LDA
#undef PG8_LDB
#undef PG8_MMA
}

struct EpiZ {
  static constexpr bool AFTER_DRAIN = false;
  bf16* Z;
  DEVI void operator()(const f32x4 (&acc)[2][2][4][2], const G8Unit& u, int wr, int wc, int fr, int fq) const {
    const int brow = u.pm * 256, bcol = u.pn * 256;
#pragma unroll
    for (int ai = 0; ai < 2; ++ai)
#pragma unroll
      for (int m = 0; m < 4; ++m) {
        const int row = brow + ai * 128 + wr * 64 + m * 16 + fr;
#pragma unroll
        for (int bj = 0; bj < 2; ++bj) {
          const int col = bcol + bj * 128 + wc * 32 + 8 * fq;
          if (col < DIN) {
            const f32x4 v0 = acc[ai][bj][m][0], v1 = acc[ai][bj][m][1];
            *reinterpret_cast<uint4*>(Z + (size_t)row * DIN + col) = make_uint4(pack2(v0[0], v0[1]), pack2(v0[2], v0[3]), pack2(v1[0], v1[1]), pack2(v1[2], v1[3]));
          }
        }
      }
  }
};
DEVI void phase_gemm1_8(const Params& P, int l, unsigned char* smem_base) {
  EpiZ E{P.Z};
  gemm8_phase((LAS unsigned char*)smem_base, P.H, P.WinT + (size_t)l * DINP * 1024, 1024, NT / 256, DINP / 256, E);
  const int c = blockIdx.x;
  if (c >= 136) {
    const int j = c - 136;
    if (l == 0) convert_rows_fp6(P, 0, j * 100, j * 100 + 100);
    else { const int b0 = 19200 + j * 114; convert_rows_fp6(P, 1, b0 < 32768 ? b0 : 32768, b0 + 114 < 32768 ? b0 + 114 : 32768); }
  }
}

struct EpiRAW {
  static constexpr bool AFTER_DRAIN = false;
  bf16* R;
  DEVI void operator()(const f32x4 (&acc)[2][2][4][2], const G8Unit& u, int wr, int wc, int fr, int fq) const {
    const int brow = u.pm * 256, bcol = u.pn * 256;
#pragma unroll
    for (int ai = 0; ai < 2; ++ai)
#pragma unroll
      for (int m = 0; m < 4; ++m) {
        const int row = brow + ai * 128 + wr * 64 + m * 16 + fr;
#pragma unroll
        for (int bj = 0; bj < 2; ++bj) {
          const int col = bcol + bj * 128 + wc * 32 + 8 * fq;
          const f32x4 v0 = acc[ai][bj][m][0], v1 = acc[ai][bj][m][1];
          *reinterpret_cast<uint4*>(R + (size_t)row * 1792 + col) = make_uint4(pack2(v0[0], v0[1]), pack2(v0[2], v0[3]), pack2(v1[0], v1[1]), pack2(v1[2], v1[3]));
        }
      }
  }
};
DEVI void phase_mla_raw(const Params& P, int l, unsigned char* smem_base) {
  {
    const int lane = threadIdx.x & 63;
    const int tstride = gridDim.x * 8;
    for (int t0 = blockIdx.x * 8 + (threadIdx.x >> 6); t0 < NT; t0 += 3 * tstride) {
      uint2 uq[3]; unsigned uk[3];
#pragma unroll
      for (int j = 0; j < 3; ++j) {
        const int t = t0 + j * tstride < NT ? t0 + j * tstride : t0;
        const bf16* zr = P.Z + (size_t)t * DIN;
        uq[j] = *reinterpret_cast<const uint2*>(zr + ZC_BQ + lane * 4);
        uk[j] = *reinterpret_cast<const unsigned*>(zr + ZC_BKV + lane * 2);
      }
#pragma unroll
      for (int j = 0; j < 3; ++j) {
        const int t = t0 + j * tstride;
        float sq = lo2f(uq[j].x) * lo2f(uq[j].x) + hi2f(uq[j].x) * hi2f(uq[j].x) + lo2f(uq[j].y) * lo2f(uq[j].y) + hi2f(uq[j].y) * hi2f(uq[j].y);
        float sk = lo2f(uk[j]) * lo2f(uk[j]) + hi2f(uk[j]) * hi2f(uk[j]);
        sq = wave_sum(sq); sk = wave_sum(sk);
        if (lane == 0 && t < NT) { P.RS[(size_t)t * 2] = rsqrtf(sq * (1.f / 256.f) + EPS); P.RS[(size_t)t * 2 + 1] = rsqrtf(sk * (1.f / 128.f) + EPS); }
      }
    }
  }
  EpiRAW E{P.RAW};
  gemm8_phase((LAS unsigned char*)smem_base, P.Z, P.WCOMB + (size_t)l * 1792 * 256, 256, NT / 256, 7, E, DIN, 3, ZC_BQ, ZC_BKV);
}

struct EpiX {
  static constexpr bool AFTER_DRAIN = false;
  const float* x; const float* ctx; bf16* X; const float* MODl; int l;
  DEVI void operator()(const f32x4 (&acc)[2][2][4][2], const G8Unit& u, int wr, int wc, int fr, int fq) const {
    const int brow = u.pm * 256, bcol = u.pn * 256;
    const float* gate = MODl + (size_t)batch_of_row(brow) * 6144 + 2048;
#pragma unroll
    for (int ai = 0; ai < 2; ++ai)
#pragma unroll
      for (int m = 0; m < 4; ++m) {
        const int row = brow + ai * 128 + wr * 64 + m * 16 + fr;
        const float* res = row < NL ? x + (size_t)row * 1024 : ctx + (size_t)(row - NL) * 1024;
#pragma unroll
        for (int bj = 0; bj < 2; ++bj) {
          const int col = bcol + bj * 128 + wc * 32 + 8 * fq;
          const f32x4 v0 = acc[ai][bj][m][0], v1 = acc[ai][bj][m][1];
          float4 ra, rb;
          if (l == 0) { ra = *reinterpret_cast<const float4*>(res + col); rb = *reinterpret_cast<const float4*>(res + col + 4); }
          else {
            const uint4 uu = *reinterpret_cast<const uint4*>(X + (size_t)row * 1024 + col);
            ra = make_float4(lo2f(uu.x), hi2f(uu.x), lo2f(uu.y), hi2f(uu.y)); rb = make_float4(lo2f(uu.z), hi2f(uu.z), lo2f(uu.w), hi2f(uu.w));
          }
          const float4 ga = *reinterpret_cast<const float4*>(gate + col), gb = *reinterpret_cast<const float4*>(gate + col + 4);
          *reinterpret_cast<uint4*>(X + (size_t)row * 1024 + col) =
              make_uint4(pack2(ra.x + ga.x * v0[0], ra.y + ga.y * v0[1]), pack2(ra.z + ga.z * v0[2], ra.w + ga.w * v0[3]),
                         pack2(rb.x + gb.x * v1[0], rb.y + gb.y * v1[1]), pack2(rb.z + gb.z * v1[2], rb.w + gb.w * v1[3]));
        }
      }
  }
};
struct EpiXN {
  static constexpr bool AFTER_DRAIN = true;
  const float* x; bf16* X; bf16* H; const float* MODl; const float* lnw; float* XB; unsigned* cnt; int l;
  DEVI void operator()(const f32x4 (&)[2][2][4][2], const G8Unit&, int, int, int, int) const {}
  DEVI void fused(f32x4 (&acc)[2][2][4][2], const G8Unit& u, int wr, int wc, int fr, int fq, LAS unsigned char* lds, int wid, int lane) const {
    const int brow = u.pm * 256, bcol = u.pn * 256;
    const float* modb = MODl + (size_t)batch_of_row(brow) * 6144;
    const float* gate = modb + 2048;
    LAS float* Pt = (LAS float*)lds;
    LAS float* St = (LAS float*)(lds + 8192);
#pragma unroll
    for (int ai = 0; ai < 2; ++ai)
#pragma unroll
      for (int m = 0; m < 4; ++m) {
        const int row = brow + ai * 128 + wr * 64 + m * 16 + fr;
        float ss = 0.f;
#pragma unroll
        for (int bj = 0; bj < 2; ++bj) {
          const int col = bcol + bj * 128 + wc * 32 + 8 * fq;
          float4 ra, rb;
          if (l == 0) { ra = *reinterpret_cast<const float4*>(x + (size_t)row * 1024 + col); rb = *reinterpret_cast<const float4*>(x + (size_t)row * 1024 + col + 4); }
          else {
            const uint4 uu = *reinterpret_cast<const uint4*>(X + (size_t)row * 1024 + col);
            ra = make_float4(lo2f(uu.x), hi2f(uu.x), lo2f(uu.y), hi2f(uu.y)); rb = make_float4(lo2f(uu.z), hi2f(uu.z), lo2f(uu.w), hi2f(uu.w));
          }
          const float4 ga = *reinterpret_cast<const float4*>(gate + col), gb = *reinterpret_cast<const float4*>(gate + col + 4);
          f32x4 v0 = acc[ai][bj][m][0], v1 = acc[ai][bj][m][1];
          v0[0] = ra.x + ga.x * v0[0]; v0[1] = ra.y + ga.y * v0[1]; v0[2] = ra.z + ga.z * v0[2]; v0[3] = ra.w + ga.w * v0[3];
          v1[0] = rb.x + gb.x * v1[0]; v1[1] = rb.y + gb.y * v1[1]; v1[2] = rb.z + gb.z * v1[2]; v1[3] = rb.w + gb.w * v1[3];
          acc[ai][bj][m][0] = v0; acc[ai][bj][m][1] = v1;
          ss += (v0[0] * v0[0] + v0[1] * v0[1]) + (v0[2] * v0[2] + v0[3] * v0[3]) + (v1[0] * v1[0] + v1[1] * v1[1]) + (v1[2] * v1[2] + v1[3] * v1[3]);
        }
        ss += __shfl_xor(ss, 16); ss += __shfl_xor(ss, 32);
        if (fq == 0) Pt[(ai * 128 + wr * 64 + m * 16 + fr) * 4 + wc] = ss;
      }
    asm volatile("s_waitcnt lgkmcnt(0)" ::: "memory"); __builtin_amdgcn_s_barrier(); asm volatile("" ::: "memory");
    const int rowl = wid * 32 + (lane & 31);
    if (lane < 32) {
      const float tot = (Pt[rowl * 4 + 0] + Pt[rowl * 4 + 1]) + (Pt[rowl * 4 + 2] + Pt[rowl * 4 + 3]);
      __hip_atomic_store(XB + (size_t)(brow + rowl) * 4 + u.pn, tot, __ATOMIC_RELAXED, __HIP_MEMORY_SCOPE_AGENT);
    }
    asm volatile("s_waitcnt vmcnt(0)" ::: "memory");
    if (lane == 0) (void)__hip_atomic_fetch_add(cnt + 64 * u.pm, 1u, __ATOMIC_RELAXED, __HIP_MEMORY_SCOPE_AGENT);
    if (wid == 0) {
      unsigned sp = 0;
      while ((unsigned)__builtin_amdgcn_readfirstlane((int)__hip_atomic_load(cnt + 64 * u.pm, __ATOMIC_RELAXED, __HIP_MEMORY_SCOPE_AGENT)) < 32u) {
        __builtin_amdgcn_s_sleep(2);
        if (++sp > XB_SPIN_CAP) break;
      }
      __builtin_amdgcn_fence(__ATOMIC_ACQUIRE, "agent");
    }
    asm volatile("s_waitcnt vmcnt(0) lgkmcnt(0)" ::: "memory"); __builtin_amdgcn_s_barrier(); asm volatile("" ::: "memory");
    if (lane < 32) {
      const float* sl = XB + (size_t)(brow + rowl) * 4;
      const float a0 = __hip_atomic_load(sl + 0, __ATOMIC_RELAXED, __HIP_MEMORY_SCOPE_AGENT), a1 = __hip_atomic_load(sl + 1, __ATOMIC_RELAXED, __HIP_MEMORY_SCOPE_AGENT);
      const float a2 = __hip_atomic_load(sl + 2, __ATOMIC_RELAXED, __HIP_MEMORY_SCOPE_AGENT), a3 = __hip_atomic_load(sl + 3, __ATOMIC_RELAXED, __HIP_MEMORY_SCOPE_AGENT);
      St[rowl] = rsqrtf(((a0 + a1) + (a2 + a3)) * (1.f / 1024.f) + EPS);
    }
    asm volatile("s_waitcnt vmcnt(0) lgkmcnt(0)" ::: "memory"); __builtin_amdgcn_s_barrier(); asm volatile("" ::: "memory");
    const float* shp = modb + 3072;
    const float* scp = modb + 3072 + 1024;
#pragma unroll
    for (int bj = 0; bj < 2; ++bj) {
      const int col = bcol + bj * 128 + wc * 32 + 8 * fq;
      const float4 wa = *reinterpret_cast<const float4*>(lnw + col), wb = *reinterpret_cast<const float4*>(lnw + col + 4);
      const float4 sa = *reinterpret_cast<const float4*>(scp + col), sb = *reinterpret_cast<const float4*>(scp + col + 4);
      const float4 ha = *reinterpret_cast<const float4*>(shp + col), hb = *reinterpret_cast<const float4*>(shp + col + 4);
      const float4 ma = make_float4(wa.x * (1.f + sa.x), wa.y * (1.f + sa.y), wa.z * (1.f + sa.z), wa.w * (1.f + sa.w));
      const float4 mb = make_float4(wb.x * (1.f + sb.x), wb.y * (1.f + sb.y), wb.z * (1.f + sb.z), wb.w * (1.f + sb.w));
#pragma unroll
      for (int ai = 0; ai < 2; ++ai)
#pragma unroll
        for (int m = 0; m < 4; ++m) {
          const int rl = ai * 128 + wr * 64 + m * 16 + fr;
          const float rr = St[rl];
          const f32x4 v0 = acc[ai][bj][m][0], v1 = acc[ai][bj][m][1];
          const size_t off = (size_t)(brow + rl) * 1024 + col;
          *reinterpret_cast<uint4*>(X + off) = make_uint4(pack2(v0[0], v0[1]), pack2(v0[2], v0[3]), pack2(v1[0], v1[1]), pack2(v1[2], v1[3]));
          *reinterpret_cast<uint4*>(H + off) =
              make_uint4(pack2(v0[0] * rr * ma.x + ha.x, v0[1] * rr * ma.y + ha.y), pack2(v0[2] * rr * ma.z + ha.z, v0[3] * rr * ma.w + ha.w),
                         pack2(v1[0] * rr * mb.x + hb.x, v1[1] * rr * mb.y + hb.y), pack2(v1[2] * rr * mb.z + hb.z, v1[3] * rr * mb.w + hb.w));
        }
    }
    asm volatile("s_waitcnt lgkmcnt(0)" ::: "memory"); __builtin_amdgcn_s_barrier(); asm volatile("" ::: "memory");
  }
};
struct EpiPart {
  static constexpr bool AFTER_DRAIN = false;
  float* PART;
  DEVI void operator()(const f32x4 (&acc)[2][2][4][2], const G8Unit& u, int wr, int wc, int fr, int fq) const {
    const int brow = u.pm * 256, bcol = (u.pn & 3) * 256;
    float* base = PART + (size_t)(u.pn >> 2) * 2048 * 1024;
#pragma unroll
    for (int ai = 0; ai < 2; ++ai)
#pragma unroll
      for (int m = 0; m < 4; ++m) {
        const int row = brow + ai * 128 + wr * 64 + m * 16 + fr;
#pragma unroll
        for (int bj = 0; bj < 2; ++bj) {
          const int col = bcol + bj * 128 + wc * 32 + 8 * fq;
          const f32x4 v0 = acc[ai][bj][m][0], v1 = acc[ai][bj][m][1];
          *reinterpret_cast<float4*>(base + (size_t)row * 1024 + col) = make_float4(v0[0], v0[1], v0[2], v0[3]);
          *reinterpret_cast<float4*>(base + (size_t)row * 1024 + col + 4) = make_float4(v1[0], v1[1], v1[2], v1[3]);
        }
      }
  }
};
DEVI void phase_gemm2_8(const Params& P, int l, unsigned char* smem_base) {
  EpiXN E{P.x, P.X, P.H, P.MOD + (size_t)l * 9 * 6144, P.ln2_w + l * 1024, P.XB, P.ncnt + l * 64 * 64, l};
  gemm8_phase((LAS unsigned char*)smem_base, P.H, P.WoutT + (size_t)l * 1024 * 1024, 1024, NL / 256, 4, E);
  if (l == 0) {
    EpiPart EP{P.PART};
    gemm8_phase((LAS unsigned char*)smem_base, P.H + (size_t)NL * 1024, P.WoutT, 512, 8, 8, EP, 1024, 1 << 30, 0, 0, 1024, 4, 512);
    const int c = blockIdx.x;
    if (c >= 64) {
      const int b0 = 12000 + (c - 64) * 109;
      convert_rows_fp6(P, 0, b0 < 32768 ? b0 : 32768, b0 + 109 < 32768 ? b0 + 109 : 32768);
    }
  }
}

struct EpiQP {
  static constexpr bool AFTER_DRAIN = false;
  bf16* QP;
  DEVI void operator()(const f32x4 (&acc)[2][2][4][2], const G8Unit& u, int wr, int wc, int fr, int fq) const {
    const int brow = u.pm * 256, bcol = u.pn * 256;
#pragma unroll
    for (int ai = 0; ai < 2; ++ai)
#pragma unroll
      for (int m = 0; m < 4; ++m) {
        const int row = brow + ai * 128 + wr * 64 + m * 16 + fr;
#pragma unroll
        for (int bj = 0; bj < 2; ++bj) {
          const int col = bcol + bj * 128 + wc * 32 + 8 * fq;
          const f32x4 v0 = acc[ai][bj][m][0], v1 = acc[ai][bj][m][1];
          *reinterpret_cast<uint4*>(QP + (size_t)row * 2048 + col) = make_uint4(pack2(v0[0], v0[1]), pack2(v0[2], v0[3]), pack2(v1[0], v1[1]), pack2(v1[2], v1[3]));
        }
      }
  }
};
DEVI void phase_gemm3_8(const Params& P, int l, unsigned char* smem_base) {
  EpiQP E{P.QP};
  gemm8_phase((LAS unsigned char*)smem_base, P.H, P.WpqT + (size_t)l * 2048 * 1024, 1024, (l == 1) ? NL / 256 : NT / 256, 8, E);
  const int c = blockIdx.x;
  if (l == 0 && c >= 64) convert_rows_fp6(P, 1, (c - 64) * 100, (c - 64) * 100 + 100);
}

constexpr int N_PHASES = 2 + 2 * 10 - 1;

#ifndef REP_MASK
#define REP_MASK 0
#endif
static_assert(sizeof(Params) % 8 == 0, "Params size");
DEVI Params load_params() {
#if defined(__HIP_DEVICE_COMPILE__)
  typedef const __attribute__((address_space(4))) Params* ParamsCP;
  ParamsCP pp = (ParamsCP)__builtin_amdgcn_kernarg_segment_ptr();
  asm volatile("" : "+s"(pp));
  return *pp;
#else
  return Params{};
#endif
}
__global__ void __launch_bounds__(512, 2) fwd_kernel(Params Pk) {
  extern __shared__ __attribute__((aligned(16))) unsigned char smem_base[];
  volatile LAS unsigned* xst = (volatile LAS unsigned*)(smem_base + SMEM_BYTES);
  if (threadIdx.x == 0) { xst[0] = 0u; xst[1] = 0u; xst[2] = 0u; xst[3] = 0u; }
  __syncthreads();
  XcdBarrier xb = xcd_barrier_post(Pk.bar, xst);
  const int phase_lo = Pk.phase_lo, phase_hi = Pk.phase_hi, coop = Pk.coop;
#define smem (smem_base + VHALF * HALF_LDS)
#define GSYNC(idx) { xcd_barrier(xb); }
#define RUN_PHASE2(idx, call, repcall) \
  if (phase_lo <= (idx) && (idx) <= phase_hi) { { const Params P = load_params(); call; } if (REP_MASK & (1 << (idx))) { GSYNC(1); const Params P = load_params(); repcall; } if (coop && (idx) < phase_hi) GSYNC(idx); }
#define RUN_PHASE(idx, call) RUN_PHASE2(idx, call, call)
  RUN_PHASE(0, phase_prologue(P, smem))
  RUN_PHASE(1, phase_norm(P, 0, 0, NT))
  RUN_PHASE(2, phase_gemm1_8(P, 0, smem_base))
  RUN_PHASE(3, phase_mla_raw(P, 0, smem_base))
  RUN_PHASE(4, { if (VHALF == 0) { phase_mixA(P, 0, smem); phase_mla_proj(P, 0, smem); phase_hgrn_local(P, 0, smem); } else { phase_hgrn_local(P, 0, smem); phase_mla_proj(P, 0, smem); phase_mixA(P, 0, smem); } })
  RUN_PHASE2(5, phase_attn_scan(P, 0, smem_base), phase_attn_scan(P, 0, smem_base, true))
  RUN_PHASE(6, phase_hgrn_final(P, 0, smem))
  RUN_PHASE(7, phase_gemm2_8(P, 0, smem_base))
  RUN_PHASE(8, phase_norm(P, 0, 1, NT, NL))
  RUN_PHASE(9, phase_gemm3_8(P, 0, smem_base))
  RUN_PHASE(10, phase_route(P, 0, smem))
  RUN_PHASE(11, { phase_peer_u(P, 0); asm volatile("s_waitcnt vmcnt(0)" ::: "memory"); phase_peer(P, 0); })
  RUN_PHASE(12, phase_gemm1_8(P, 1, smem_base))
  RUN_PHASE(13, phase_mla_raw(P, 1, smem_base))
  RUN_PHASE(14, { if (VHALF == 0) { phase_mixA(P, 1, smem); phase_mla_proj(P, 1, smem); phase_hgrn_local(P, 1, smem); } else { phase_hgrn_local(P, 1, smem); phase_mla_proj(P, 1, smem); phase_mixA(P, 1, smem); } })
  RUN_PHASE2(15, phase_attn_scan(P, 1, smem_base), phase_attn_scan(P, 1, smem_base, true))
  RUN_PHASE(16, phase_hgrn_final(P, 1, smem))
  RUN_PHASE(17, phase_gemm2_8(P, 1, smem_base))
  RUN_PHASE(18, phase_gemm3_8(P, 1, smem_base))
  RUN_PHASE(19, phase_route(P, 1, smem))
  RUN_PHASE(20, { phase_peer_u(P, 1); asm volatile("s_waitcnt vmcnt(0)" ::: "memory"); phase_peer(P, 1); })
#undef smem
}

extern "C" void kernel_launch(void* const* d_in, const int* in_sizes, int n_in, void* d_out, int out_size, void* d_ws,
                              size_t ws_size, hipStream_t stream) {
  Params p{};
  const float* const* in = reinterpret_cast<const float* const*>(d_in);
  p.x = in[0]; p.c = in[1]; p.ctx = in[2]; p.c_ctx = in[3]; p.ln1_w = in[4]; p.ln2_w = in[5]; p.w_mod = in[6]; p.b_mod = in[7];
  p.w_in = in[8]; p.w_out = in[9]; p.a_norm_w = in[10]; p.a_w_s = in[11]; p.a_b_s = in[12]; p.b_q_norm_w = in[13]; p.b_w_uq = in[14];
  p.b_kv_norm_w = in[15]; p.b_w_ukv = in[16]; p.b_qh_w = in[17]; p.b_kh_w = in[18]; p.c_lb = in[19]; p.c_out_norm_w = in[20];
  p.p_w_q = in[21]; p.p_sub_keys = in[22]; p.p_u = in[23]; p.p_v = in[24];
  p.out = reinterpret_cast<float*>(d_out);
  unsigned char* ws = reinterpret_cast<unsigned char*>(d_ws);
  size_t off = 0;
  auto take = [&](size_t bytes) { unsigned char* r = ws + off; off += (bytes + 255) & ~(size_t)255; return r; };
  p.bar = (unsigned*)take((size_t)(XCD_BAR_WORDS + 2 * 64 * 64) * 4);
  p.ncnt = p.bar + XCD_BAR_WORDS;
  p.XB = (float*)take((size_t)NL * 4 * 4);
  p.LBT = (float*)take((size_t)512 * 4);
  p.MOD = (float*)take((size_t)2 * 9 * 6144 * 4);
  p.ROPE = (float*)take((size_t)2048 * 32 * 4);
  p.WinT = (bf16*)take((size_t)2 * DINP * 1024 * 2);
  p.WoutT = (bf16*)take((size_t)2 * 1024 * 1024 * 2);
  p.WpqT = (bf16*)take((size_t)2 * 2048 * 1024 * 2);
  p.WCOMB = (bf16*)take((size_t)2 * 1792 * 256 * 2);
  p.RAW = (bf16*)take((size_t)NT * 1792 * 2);
  p.SK = (bf16*)take((size_t)2 * 16 * 128 * 128 * 2);
  p.AWS = (bf16*)take((size_t)2 * 4 * 128 * 128 * 2);
  p.PU8 = (unsigned char*)take((size_t)2 * 16384 * 576);
  p.PV8 = (unsigned char*)take((size_t)2 * 16384 * 576);
  p.PUS = (float*)take((size_t)2 * 16384 * 4);
  p.PVS = (float*)take((size_t)2 * 16384 * 4);
  p.X = (bf16*)take((size_t)NT * 1024 * 2);
  p.H = (bf16*)take((size_t)NT * 1024 * 2);
  p.Z = (bf16*)take((size_t)NT * DIN * 2);
  p.Q = (bf16*)take((size_t)64 * SEQP * 96 * 2);
  p.K = (bf16*)take((size_t)64 * SEQP * 96 * 2);
  p.VT = (bf16*)take((size_t)64 * 64 * SEQP * 2);
  p.ST = (bf16*)take((size_t)64 * 36 * 4096 * 2);
  p.DEC = (float*)take((size_t)64 * 36 * 64 * 4);
  p.OI = (bf16*)take((size_t)NT * 256 * 2);
  p.WPE = (float*)take((size_t)NT * 128 * 4);
  p.PART = (float*)take((size_t)2 * 2048 * 1024 * 4);
  p.RS = (float*)take((size_t)NT * 2 * 4);
  p.GQF = (bf16*)take((size_t)NT * 256 * 2);
  p.GQB = (bf16*)take((size_t)NT * 256 * 2);
  p.QP = p.Z;
  p.EIDX = (int*)p.Q;
  p.GATE = (float*)p.K;
  if (off > ws_size) { fprintf(stderr, "workspace too small: need %zu have %zu\n", off, ws_size); }
  static int grid_blocks = 0;
  if (!grid_blocks) {
    if (hipFuncSetAttribute((const void*)fwd_kernel, hipFuncAttributeMaxDynamicSharedMemorySize, SMEM_TOTAL) != hipSuccess)
      fprintf(stderr, "hipFuncSetAttribute failed\n");
    int dev = 0, cus = 0, per_cu = 0;
    hipGetDevice(&dev);
    hipDeviceGetAttribute(&cus, hipDeviceAttributeMultiprocessorCount, dev);
    hipOccupancyMaxActiveBlocksPerMultiprocessor(&per_cu, (const void*)fwd_kernel, 512, SMEM_TOTAL);
    if (per_cu > 1) per_cu = 1;
    if (per_cu < 1) { fprintf(stderr, "occupancy query returned %d\n", per_cu); per_cu = 1; }
    grid_blocks = cus * per_cu;
    fprintf(stderr, "grid_blocks=%d (cus=%d per_cu=%d) ws need=%zu have=%zu\n", grid_blocks, cus, per_cu, off, ws_size);
  }
  hipMemsetAsync(p.bar, 0, (size_t)(XCD_BAR_WORDS + 2 * 64 * 64) * 4, stream);
  p.coop = 1; p.phase_lo = 0; p.phase_hi = N_PHASES - 1;
  hipLaunchKernelGGL(fwd_kernel, dim3(grid_blocks), dim3(512), SMEM_TOTAL, stream, p);
  const hipError_t e = hipPeekAtLastError();
  if (e != hipSuccess) fprintf(stderr, "launch failed: %s (grid %d)\n", hipGetErrorString(e), grid_blocks);
}
```
